# Optimizing an MI355X kernel written in HIP

```python
import jax, jax.numpy as jnp
from jax import lax
import numpy as np

D_MODEL = 2048
BATCH = 2
SEQ = 4096
DEPTH = 1

GRID_W = 64
CTX_LEN = 256
HEAD_DIM = 128
N_HEADS = D_MODEL // HEAD_DIM
N_KV_HEADS = N_HEADS // 4
Q_GROUP = N_HEADS // N_KV_HEADS
ATT_WIDTH = N_HEADS * HEAD_DIM
KV_WIDTH = N_KV_HEADS * HEAD_DIM
ROPE_FREQS = HEAD_DIM // 4
ROPE_THETA = 10000.0
Q_BLOCK = 128
F_GROUP_DIM = 128
F_WIDTH = D_MODEL // 2
F_GROUPS = F_WIDTH // F_GROUP_DIM
N_EXPERTS = 64
N_EXPERT_GROUPS = 8
TOPK_GROUPS = 4
TOP_K = 8
EXPERT_FF = D_MODEL // 4
SHARED_FF = D_MODEL // 4
ROUTED_SCALE = 2.5
EXPERT_BLOCK = 128
EPS = 1e-6
Q_OFF = F_WIDTH
K_OFF = Q_OFF + ATT_WIDTH
V_OFF = K_OFF + KV_WIDTH
GF_OFF = V_OFF + KV_WIDTH
GA_OFF = GF_OFF + D_MODEL
IN_COLS = GA_OFF + D_MODEL

kernel_name = 'hybrid_fourier_gqa_moe_dit_block'


def rmsnorm(x, w):
    x32 = x.astype(jnp.float32)
    y = x32 * lax.rsqrt(jnp.mean(x32 * x32, axis=-1, keepdims=True) + EPS)
    return (y * w.astype(jnp.float32)).astype(x.dtype)


def modulate(h, shift, scale):
    return h * (1 + scale) + shift


def axial_rope(n_tokens):
    rows = n_tokens // GRID_W
    row = jnp.repeat(jnp.arange(rows), GRID_W)
    col = jnp.tile(jnp.arange(GRID_W), rows)
    pos = jnp.stack([row, col], axis=-1).astype(jnp.float32)
    inv_freq = ROPE_THETA ** (-jnp.arange(ROPE_FREQS, dtype=jnp.float32) / ROPE_FREQS)
    ang = pos[:, :, None] * inv_freq
    return jnp.cos(ang), jnp.sin(ang)


def apply_rope(x, cos, sin):
    b, s, h, _ = x.shape
    xr = x.reshape(b, s, h, 2, 2, ROPE_FREQS)
    xa, xb = xr[..., 0, :], xr[..., 1, :]
    c = cos[None, :, None].astype(x.dtype)
    sn = sin[None, :, None].astype(x.dtype)
    out = jnp.stack([xa * c - xb * sn, xb * c + xa * sn], axis=-2)
    return out.reshape(b, s, h, HEAD_DIM)


def to_heads(t, n_heads):
    return t.reshape(t.shape[0], t.shape[1], n_heads, HEAD_DIM)


def attend(qb, k, v):
    s = jnp.einsum('bqkgd,bskd->bkgqs', qb, k).astype(jnp.float32) * (HEAD_DIM ** -0.5)
    p = jax.nn.softmax(s, axis=-1).astype(v.dtype)
    return jnp.einsum('bkgqs,bskd->bqkgd', p, v)


def latent_attention(q, k, v, kc, vc):
    b, s = q.shape[:2]
    k_all = jnp.concatenate([k, kc], axis=1)
    v_all = jnp.concatenate([v, vc], axis=1)
    qb = q.reshape(b, s // Q_BLOCK, Q_BLOCK, N_KV_HEADS, Q_GROUP, HEAD_DIM).transpose(1, 0, 2, 3, 4, 5)
    o = lax.map(lambda qi: attend(qi, k_all, v_all), qb)
    return o.transpose(1, 0, 2, 3, 4, 5).reshape(b, s, ATT_WIDTH)


def context_attention(qc, kc, vc):
    b, n = qc.shape[:2]
    return attend(qc.reshape(b, n, N_KV_HEADS, Q_GROUP, HEAD_DIM), kc, vc).reshape(b, n, ATT_WIDTH)


def fourier_mix(u):
    b, n, _ = u.shape
    ug = u.astype(jnp.float32).reshape(b, n, F_GROUPS, F_GROUP_DIM)
    y = jnp.fft.fft2(ug, axes=(1, 3), norm='ortho').real
    return y.reshape(b, n, F_WIDTH).astype(u.dtype)


def split_projection(p):
    return (p[..., :Q_OFF], p[..., Q_OFF:K_OFF], p[..., K_OFF:V_OFF],
            p[..., V_OFF:GF_OFF], p[..., GF_OFF:GA_OFF], p[..., GA_OFF:])


def merge_branches(yf, ya, gf, ga, w_fo, w_ao, w_o):
    y = jax.nn.sigmoid(gf) * (yf @ w_fo) + jax.nn.sigmoid(ga) * (ya @ w_ao)
    return y @ w_o


def swiglu(x, wg, wu, wd):
    return (jax.nn.silu(x @ wg) * (x @ wu)) @ wd


def route(h, router_w, router_b):
    scores = jax.nn.sigmoid(h.astype(jnp.float32) @ router_w.astype(jnp.float32))
    biased = scores + router_b.astype(jnp.float32)
    grp = biased.reshape(-1, N_EXPERT_GROUPS, N_EXPERTS // N_EXPERT_GROUPS)
    gscore = lax.top_k(grp, 2)[0].sum(-1)
    _, gidx = lax.top_k(gscore, TOPK_GROUPS)
    gmask = jax.nn.one_hot(gidx, N_EXPERT_GROUPS, dtype=jnp.float32).sum(1) > 0
    emask = jnp.repeat(gmask, N_EXPERTS // N_EXPERT_GROUPS, axis=1)
    _, eidx = lax.top_k(jnp.where(emask, biased, -jnp.inf), TOP_K)
    w = jnp.take_along_axis(scores, eidx, axis=1)
    w = w / jnp.sum(w, axis=-1, keepdims=True) * ROUTED_SCALE
    return eidx, w


def moe(h, router_w, router_b, exp_gate, exp_up, exp_down, sh_gate, sh_up, sh_down):
    t = h.shape[0]
    eidx, w = route(h, router_w, router_b)
    n_assign = t * TOP_K
    flat_e = eidx.reshape(-1)
    flat_tok = jnp.repeat(jnp.arange(t, dtype=jnp.int32), TOP_K)
    flat_w = w.reshape(-1).astype(h.dtype)
    order = jnp.argsort(flat_e)
    se, stok, sw = flat_e[order], flat_tok[order], flat_w[order]
    counts = jnp.bincount(flat_e, length=N_EXPERTS)
    starts = jnp.cumsum(counts) - counts
    padded = (counts + EXPERT_BLOCK - 1) // EXPERT_BLOCK * EXPERT_BLOCK
    pends = jnp.cumsum(padded)
    pstarts = pends - padded
    dest = pstarts[se] + (jnp.arange(n_assign) - starts[se])
    n_blocks = -(-n_assign // EXPERT_BLOCK) + N_EXPERTS
    n_slots = n_blocks * EXPERT_BLOCK
    slot_tok = jnp.full((n_slots,), t, jnp.int32).at[dest].set(stok)
    slot_w = jnp.zeros((n_slots,), h.dtype).at[dest].set(sw)
    block_e = jnp.minimum(jnp.searchsorted(pends, jnp.arange(n_blocks) * EXPERT_BLOCK, side='right'), N_EXPERTS - 1)
    h_pad = jnp.concatenate([h, jnp.zeros((1, h.shape[1]), h.dtype)], axis=0)

    def expert_block(args):
        tok, wt, e = args
        return swiglu(h_pad[tok], exp_gate[e], exp_up[e], exp_down[e]) * wt[:, None]

    y = lax.map(expert_block, (slot_tok.reshape(n_blocks, EXPERT_BLOCK),
                               slot_w.reshape(n_blocks, EXPERT_BLOCK), block_e))
    routed = jax.ops.segment_sum(y.reshape(n_slots, -1), slot_tok, num_segments=t + 1)[:t]
    return routed + swiglu(h, sh_gate, sh_up, sh_down)


def setup_inputs(seed: int = 0) -> dict:
    key = jax.random.key(seed)
    ks = jax.random.split(key, 22)

    def nrm(k, shape, scale=1.0):
        return jax.random.normal(k, shape, jnp.float32) * scale

    D = D_MODEL
    L = DEPTH
    return {
        'x': nrm(ks[0], (BATCH, SEQ, D)),
        'c': nrm(ks[1], (BATCH, D)),
        'ctx': nrm(ks[2], (BATCH, CTX_LEN, D)),
        'c_ctx': nrm(ks[3], (D,)),
        'mod_w': nrm(ks[4], (L, D, 6 * D), 0.5 * D ** -0.5),
        'mod_b': nrm(ks[5], (L, 6 * D), 0.02),
        'norm1_w': 1.0 + nrm(ks[6], (L, D), 0.02),
        'w_in': nrm(ks[7], (L, D, IN_COLS), D ** -0.5),
        'q_norm_w': 1.0 + nrm(ks[8], (L, HEAD_DIM), 0.02),
        'k_norm_w': 1.0 + nrm(ks[9], (L, HEAD_DIM), 0.02),
        'w_fourier_out': nrm(ks[10], (L, F_WIDTH, D), F_WIDTH ** -0.5),
        'w_attn_out': nrm(ks[11], (L, ATT_WIDTH, D), ATT_WIDTH ** -0.5),
        'w_out': nrm(ks[12], (L, D, D), D ** -0.5),
        'norm2_w': 1.0 + nrm(ks[13], (L, D), 0.02),
        'router_w': nrm(ks[14], (L, D, N_EXPERTS), D ** -0.5),
        'router_b': nrm(ks[15], (L, N_EXPERTS), 0.01),
        'exp_gate': nrm(ks[16], (L, N_EXPERTS, D, EXPERT_FF), D ** -0.5),
        'exp_up': nrm(ks[17], (L, N_EXPERTS, D, EXPERT_FF), D ** -0.5),
        'exp_down': nrm(ks[18], (L, N_EXPERTS, EXPERT_FF, D), EXPERT_FF ** -0.5),
        'shared_gate': nrm(ks[19], (L, D, SHARED_FF), D ** -0.5),
        'shared_up': nrm(ks[20], (L, D, SHARED_FF), D ** -0.5),
        'shared_down': nrm(ks[21], (L, SHARED_FF, D), SHARED_FF ** -0.5),
    }


def reference(x, c, ctx, c_ctx, mod_w, mod_b, norm1_w, w_in, q_norm_w, k_norm_w,
              w_fourier_out, w_attn_out, w_out, norm2_w, router_w, router_b,
              exp_gate, exp_up, exp_down, shared_gate, shared_up, shared_down):
    b, s, d = x.shape
    n_ctx = ctx.shape[1]
    cos, sin = axial_rope(s)
    cond = jnp.concatenate([c, c_ctx[None]], axis=0)
    cx = ctx
    for l in range(DEPTH):
        last = l == DEPTH - 1
        mod = jax.nn.silu(cond) @ mod_w[l] + mod_b[l]
        sh1, sc1, g1, sh2, sc2, g2 = jnp.split(mod[:b][:, None], 6, axis=-1)
        csh1, csc1, cg1, csh2, csc2, cg2 = jnp.split(mod[b], 6, axis=-1)

        h = modulate(rmsnorm(x, norm1_w[l]), sh1, sc1)
        hc = modulate(rmsnorm(cx, norm1_w[l]), csh1, csc1)
        u, q, k, v, gf, ga = split_projection(h @ w_in[l])
        if last:
            kvc = hc @ w_in[l][:, K_OFF:GF_OFF]
        else:
            pc = hc @ w_in[l]
            kvc = pc[..., K_OFF:GF_OFF]
        kc = rmsnorm(to_heads(kvc[..., :KV_WIDTH], N_KV_HEADS), k_norm_w[l])
        vc = to_heads(kvc[..., KV_WIDTH:], N_KV_HEADS)
        q = apply_rope(rmsnorm(to_heads(q, N_HEADS), q_norm_w[l]), cos, sin)
        k = apply_rope(rmsnorm(to_heads(k, N_KV_HEADS), k_norm_w[l]), cos, sin)
        v = to_heads(v, N_KV_HEADS)
        ya = latent_attention(q, k, v, kc, vc)
        yf = fourier_mix(u)
        x = x + g1 * merge_branches(yf, ya, gf, ga, w_fourier_out[l], w_attn_out[l], w_out[l])

        if not last:
            uc, qc, _, _, gfc, gac = split_projection(pc)
            qc = rmsnorm(to_heads(qc, N_HEADS), q_norm_w[l])
            yac = context_attention(qc, kc, vc)
            yfc = fourier_mix(uc)
            cx = cx + cg1 * merge_branches(yfc, yac, gfc, gac, w_fourier_out[l], w_attn_out[l], w_out[l])

        h2 = modulate(rmsnorm(x, norm2_w[l]), sh2, sc2)
        x = x + g2 * moe(h2.reshape(b * s, d), router_w[l], router_b[l], exp_gate[l], exp_up[l],
                         exp_down[l], shared_gate[l], shared_up[l], shared_down[l]).reshape(b, s, d)
        if not last:
            h2c = modulate(rmsnorm(cx, norm2_w[l]), csh2, csc2)
            cx = cx + cg2 * moe(h2c.reshape(b * n_ctx, d), router_w[l], router_b[l], exp_gate[l], exp_up[l],
                                exp_down[l], shared_gate[l], shared_up[l], shared_down[l]).reshape(b, n_ctx, d)
    return x
```

```cpp
#include <hip/hip_runtime.h>
#include <stdint.h>
#include <math.h>

typedef unsigned short bf16_t;
typedef short bf16x8 __attribute__((ext_vector_type(8)));
typedef float f32x16 __attribute__((ext_vector_type(16)));
typedef float f32x4 __attribute__((ext_vector_type(4)));

constexpr int NB = 2, SEQ = 4096, DM = 2048, NTOK = NB * SEQ, CTXL = 256, NCTX = NB * CTXL, HD = 128, NH = 16, NKV = 4;
constexpr int SKV = SEQ + CTXL;
constexpr int FW = 1024, INC = 8192, Q_OFF = 1024, K_OFF = 3072, V_OFF = 3584, GF_OFF = 4096, GA_OFF = 6144;
constexpr int KVW = NKV * HD;
constexpr int NE = 64, TOPK = 8, EFF = 512, MODC = 6 * DM;
constexpr int NSLOT = NTOK * TOPK;
constexpr int NSLOT_ALL = NSLOT + NTOK;

constexpr size_t MiB = 1u << 20;
constexpr size_t WS_CTL = 0, CTL_ZERO_BYTES = 1 * MiB;
constexpr size_t CTL_CNT = 64 * 1024;
constexpr size_t WS_TW = 1 * MiB;
constexpr size_t WS_MOD = 1 * MiB + 64 * 1024;
constexpr size_t WS_OFFS = 1 * MiB + 256 * 1024;
constexpr size_t WS_EIDX = 2 * MiB;
constexpr size_t WS_EW = WS_EIDX + 256 * 1024;
constexpr size_t WS_EPOS = WS_EW + 256 * 1024;
constexpr size_t WS_SLOTOF = WS_EPOS + 256 * 1024;
constexpr size_t WS_TOK = 3 * MiB;
constexpr size_t WS_H = 4 * MiB;
constexpr size_t WS_U = 38 * MiB;
constexpr size_t WS_Q = 54 * MiB;
constexpr size_t WS_KALL = 86 * MiB;
constexpr size_t WS_VALL = 95 * MiB;
constexpr size_t WS_SGF = 104 * MiB;
constexpr size_t WS_SGA = 136 * MiB;
constexpr size_t WS_YA = 168 * MiB;
constexpr size_t WS_YF = 200 * MiB;
constexpr size_t WS_PR = 216 * MiB;
constexpr size_t WS_T1 = 248 * MiB;
constexpr size_t WS_YM = 312 * MiB;
constexpr size_t WS_QKRAW = 248 * MiB;
constexpr size_t WS_KCRAW = 330 * MiB;
constexpr size_t WS_H2 = 344 * MiB;
constexpr size_t WS_ACT = 376 * MiB;
constexpr size_t WS_YBIG = 4 * MiB;
constexpr size_t WS_END = 740 * MiB;

__device__ __forceinline__ float bf2f(bf16_t h) { return __uint_as_float(((unsigned)h) << 16); }
__device__ __forceinline__ bf16_t f2bf(float f) { unsigned u = __float_as_uint(f); return (bf16_t)((u + 0x7fffu + ((u >> 16) & 1u)) >> 16); }
__device__ __forceinline__ int crow(int r, int hi) { return (r & 3) + 8 * (r >> 2) + 4 * hi; }
__device__ __forceinline__ float wave_sum(float v) {
#pragma unroll
    for (int o = 1; o < 64; o <<= 1) v += __shfl_xor(v, o);
    return v;
}
__device__ __forceinline__ float sigmoidf_(float v) { return 1.0f / (1.0f + expf(-v)); }
__device__ __forceinline__ bf16x8 pack8(const float* f) {
    bf16x8 r;
#pragma unroll
    for (int i = 0; i < 8; ++i) r[i] = (short)f2bf(f[i]);
    return r;
}

template <int NBO, class LA, class LB, class EP>
__global__ void __launch_bounds__(256) ngemm(int K, LA la, LB lb, EP ep) {
    const int lane = threadIdx.x & 63, w = threadIdx.x >> 6, z = blockIdx.z;
    if (!ep.active(z, blockIdx.y * 64)) return;
    const int m0 = blockIdx.y * 64 + (w >> 1) * 32, n0 = blockIdx.x * 64 + (w & 1) * 32;
    const int r32 = lane & 31, hi = lane >> 5;
    f32x16 acc0 = {}, acc1 = {};
    for (int k0 = 0; k0 < K; k0 += 16) {
        const bf16x8 a = la.load(z, m0 + r32, k0 + hi * 8);
        const bf16x8 b0 = lb.load(z, k0 + hi * 8, n0 + r32, 0);
        acc0 = __builtin_amdgcn_mfma_f32_32x32x16_bf16(a, b0, acc0, 0, 0, 0);
        if (NBO == 2) {
            const bf16x8 b1 = lb.load(z, k0 + hi * 8, n0 + r32, 1);
            acc1 = __builtin_amdgcn_mfma_f32_32x32x16_bf16(a, b1, acc1, 0, 0, 0);
        }
    }
#pragma unroll
    for (int r = 0; r < 16; ++r) ep.store(z, m0 + crow(r, hi), n0 + r32, acc0[r], acc1[r]);
}

struct LA_bf16 { const bf16_t* p; long ld; long zs;
    __device__ bf16x8 load(int z, int m, int k) const { return *(const bf16x8*)(p + z * zs + (long)m * ld + k); } };
struct LA_gather { const bf16_t* p; long ld; const int* tok; const int* offs; const int* cnt;
    __device__ bf16x8 load(int z, int m, int k) const { int c = cnt[z]; int r = m < c ? m : c - 1; int t = tok[offs[z] + r]; return *(const bf16x8*)(p + (long)t * ld + k); } };
struct LA_slot { const bf16_t* p; long ld; const int* offs; const int* cnt;
    __device__ bf16x8 load(int z, int m, int k) const { int c = cnt[z]; int r = m < c ? m : c - 1; return *(const bf16x8*)(p + (long)(offs[z] + r) * ld + k); } };
struct LA_dft { const float* tw;
    __device__ bf16x8 load(int z, int m, int k) const { float f[8];
#pragma unroll
        for (int i = 0; i < 8; ++i) { int kk = k + i; f[i] = kk < 4096 ? tw[(m * kk) & 4095] : -tw[(m * (kk - 4096) - 1024) & 4095]; }
        return pack8(f); } };
struct LB_f32kn { const float* p; long ld; long zs; const float* p1; const float* psh; const float* psh1; int zsh;
    __device__ bf16x8 load(int z, int k, int n, int which) const { const float* b = (z == zsh) ? (which ? psh1 : psh) : ((which ? p1 : p) + z * zs); float f[8];
#pragma unroll
        for (int i = 0; i < 8; ++i) f[i] = b[(long)(k + i) * ld + n];
        return pack8(f); } };
struct LB_bf16kn { const bf16_t* p; long ld; long zs;
    __device__ bf16x8 load(int z, int k, int n, int) const { bf16x8 r;
#pragma unroll
        for (int i = 0; i < 8; ++i) r[i] = (short)p[z * zs + (long)(k + i) * ld + n];
        return r; } };
struct LB_dftc { const float* tw;
    __device__ bf16x8 load(int z, int k, int n, int) const { float f[8];
#pragma unroll
        for (int i = 0; i < 8; ++i) { int c = k + i; f[i] = n < 128 ? tw[(32 * c * n) & 4095] : tw[(32 * c * (n - 128) - 1024) & 4095]; }
        return pack8(f); } };

struct EP_inproj {
    bf16_t* U; float* QKRAW; bf16_t* VALL; bf16_t* SGF; bf16_t* SGA;
    __device__ bool active(int, int) const { return true; }
    __device__ void store(int z, int m, int n, float v, float) const {
        if (n < Q_OFF) U[(long)m * FW + n] = f2bf(v);
        else if (n < V_OFF) QKRAW[(long)m * 2560 + (n - Q_OFF)] = v;
        else if (n < GF_OFF) { int b = m / SEQ, t = m % SEQ; VALL[((long)b * SKV + t) * KVW + (n - V_OFF)] = f2bf(v); }
        else if (n < GA_OFF) SGF[(long)m * DM + (n - GF_OFF)] = f2bf(sigmoidf_(v));
        else SGA[(long)m * DM + (n - GA_OFF)] = f2bf(sigmoidf_(v));
    } };
struct EP_ctxkv {
    float* KCRAW; bf16_t* VALL;
    __device__ bool active(int, int) const { return true; }
    __device__ void store(int z, int m, int n, float v, float) const {
        if (n < KVW) KCRAW[(long)m * KVW + n] = v;
        else { int b = m / CTXL, j = m % CTXL; VALL[((long)b * SKV + SEQ + j) * KVW + (n - KVW)] = f2bf(v); }
    } };
struct EP_dftc {
    bf16_t* PR;
    __device__ bool active(int, int) const { return true; }
    __device__ void store(int z, int m, int n, float v, float) const {
        int b = m / SEQ, t = m % SEQ; int kk = n < 128 ? t : 4096 + t; int col = z * 128 + (n & 127);
        PR[((long)b * 8192 + kk) * FW + col] = f2bf(v);
    } };
struct EP_dftn {
    bf16_t* YF;
    __device__ bool active(int, int) const { return true; }
    __device__ void store(int z, int m, int n, float v, float) const { YF[((long)z * SEQ + m) * FW + n] = f2bf(v * 0.0013810679320049757f); } };
struct EP_t1 { const bf16_t* SGF; float* T1;
    __device__ bool active(int, int) const { return true; }
    __device__ void store(int z, int m, int n, float v, float) const { T1[(long)m * DM + n] = bf2f(SGF[(long)m * DM + n]) * v; } };
struct EP_ym { const bf16_t* SGA; const float* T1; bf16_t* YM;
    __device__ bool active(int, int) const { return true; }
    __device__ void store(int z, int m, int n, float v, float) const { YM[(long)m * DM + n] = f2bf(T1[(long)m * DM + n] + bf2f(SGA[(long)m * DM + n]) * v); } };
struct EP_x2 { const float* x; const float* mod; float* X2;
    __device__ bool active(int, int) const { return true; }
    __device__ void store(int z, int m, int n, float v, float) const { int b = m / SEQ; X2[(long)m * DM + n] = x[(long)m * DM + n] + mod[b * MODC + 2 * DM + n] * v; } };
struct EP_act { bf16_t* ACT; const int* offs; const int* cnt;
    __device__ bool active(int z, int mb) const { return mb < cnt[z]; }
    __device__ void store(int z, int m, int n, float g, float u) const { if (m < cnt[z]) ACT[(long)(offs[z] + m) * EFF + n] = f2bf(g / (1.0f + expf(-g)) * u); } };
struct EP_ybig { bf16_t* Y; const int* offs; const int* cnt;
    __device__ bool active(int z, int mb) const { return mb < cnt[z]; }
    __device__ void store(int z, int m, int n, float v, float) const { if (m < cnt[z]) Y[(long)(offs[z] + m) * DM + n] = f2bf(v); } };

__global__ void k_tw(float* tw) { int j = blockIdx.x * 256 + threadIdx.x; if (j < 4096) tw[j] = cospif((float)j / 2048.0f); }

__global__ void __launch_bounds__(256) k_mod(const float* c, const float* c_ctx, const float* mod_w, const float* mod_b, float* mod) {
    __shared__ float sc[3 * DM];
    for (int i = threadIdx.x; i < 3 * DM; i += 256) { int r = i / DM, k = i % DM; float v = r < 2 ? c[r * DM + k] : c_ctx[k]; sc[i] = v / (1.0f + expf(-v)); }
    __syncthreads();
    const int j = blockIdx.x * 256 + threadIdx.x;
    float a0 = 0.f, a1 = 0.f, a2 = 0.f;
    for (int k = 0; k < DM; ++k) { const float w = mod_w[(size_t)k * MODC + j]; a0 += sc[k] * w; a1 += sc[DM + k] * w; a2 += sc[2 * DM + k] * w; }
    const float bb = mod_b[j];
    mod[j] = a0 + bb; mod[MODC + j] = a1 + bb; mod[2 * MODC + j] = a2 + bb;
}

__global__ void __launch_bounds__(256) k_norm_mod(const float* x, const float* ctx, const float* nw, const float* mod, int sh_off, int sc_off, bf16_t* H, int nrows) {
    const int row = blockIdx.x * 4 + (threadIdx.x >> 6), lane = threadIdx.x & 63;
    if (row >= nrows) return;
    const float* src = row < NTOK ? x + (size_t)row * DM : ctx + (size_t)(row - NTOK) * DM;
    const float* mr = mod + (row < NTOK ? row / SEQ : 2) * MODC;
    f32x4 v[8]; float ss = 0.f;
#pragma unroll
    for (int j = 0; j < 8; ++j) { v[j] = *(const f32x4*)(src + (j * 64 + lane) * 4); ss += v[j].x * v[j].x + v[j].y * v[j].y + v[j].z * v[j].z + v[j].w * v[j].w; }
    ss = wave_sum(ss);
    const float rstd = 1.0f / sqrtf(ss * (1.0f / DM) + 1e-6f);
#pragma unroll
    for (int j = 0; j < 8; ++j) { const int i = (j * 64 + lane) * 4;
#pragma unroll
        for (int c = 0; c < 4; ++c) { float h = v[j][c] * rstd * nw[i + c]; h = h * (1.0f + mr[sc_off + i + c]) + mr[sh_off + i + c]; H[(size_t)row * DM + i + c] = f2bf(h); } }
}

__global__ void __launch_bounds__(256) k_qknorm_rope(const float* QKRAW, const float* KCRAW, const float* qnw, const float* knw, bf16_t* Q, bf16_t* KALL) {
    const int gw = blockIdx.x * 4 + (threadIdx.x >> 6), lane = threadIdx.x & 63;
    const int axis = lane >> 5, f = lane & 31, da = axis * 64 + f, db = da + 32;
    if (gw < NTOK * 20) {
        const int row = gw / 20, hh = gw % 20, b = row / SEQ, t = row % SEQ;
        const float* src = QKRAW + (size_t)row * 2560 + hh * HD;
        const float* nw = hh < 16 ? qnw : knw;
        float xa = src[da], xb = src[db];
        const float ss = wave_sum(xa * xa + xb * xb), rstd = 1.0f / sqrtf(ss * (1.0f / HD) + 1e-6f);
        xa = xa * rstd * nw[da]; xb = xb * rstd * nw[db];
        const float pos = (float)(axis == 0 ? t / 64 : t % 64);
        const float inv = exp2f(-(float)f * (13.287712379549449f / 32.0f));
        const float ang = pos * inv, cs = cosf(ang), sn = sinf(ang);
        const float oa = xa * cs - xb * sn, ob = xb * cs + xa * sn;
        bf16_t* dst = hh < 16 ? Q + (size_t)row * DM + hh * HD : KALL + ((size_t)b * SKV + t) * KVW + (hh - 16) * HD;
        dst[da] = f2bf(oa); dst[db] = f2bf(ob);
    } else {
        const int g2 = gw - NTOK * 20; if (g2 >= NCTX * 4) return;
        const int row = g2 / 4, hh = g2 % 4, b = row / CTXL, j = row % CTXL;
        const float* src = KCRAW + (size_t)row * KVW + hh * HD;
        float xa = src[da], xb = src[db];
        const float ss = wave_sum(xa * xa + xb * xb), rstd = 1.0f / sqrtf(ss * (1.0f / HD) + 1e-6f);
        bf16_t* dst = KALL + ((size_t)b * SKV + SEQ + j) * KVW + hh * HD;
        dst[da] = f2bf(xa * rstd * knw[da]); dst[db] = f2bf(xb * rstd * knw[db]);
    }
}

__global__ void __launch_bounds__(64) k_attn_naive(const bf16_t* Q, const bf16_t* KALL, const bf16_t* VALL, bf16_t* YA) {
    __shared__ __attribute__((aligned(16))) bf16_t Pl[32 * 40];
    __shared__ float al[32];
    const int lane = threadIdx.x, r32 = lane & 31, hi = lane >> 5;
    const int qt = blockIdx.x, h = blockIdx.y, b = blockIdx.z, kvh = h / 4;
    const bf16_t* Qb = Q + ((size_t)(b * SEQ + qt * 32)) * DM + h * HD;
    const bf16_t* Kb = KALL + (size_t)b * SKV * KVW + kvh * HD;
    const bf16_t* Vb = VALL + (size_t)b * SKV * KVW + kvh * HD;
    bf16x8 qf[8];
#pragma unroll
    for (int d0 = 0; d0 < 8; ++d0) qf[d0] = *(const bf16x8*)(Qb + (size_t)r32 * DM + d0 * 16 + hi * 8);
    f32x16 o[4] = {};
    float m = -1e30f, l = 0.f;
    const float SC = 0.08838834764831845f;
    for (int k0 = 0; k0 < SKV; k0 += 32) {
        f32x16 s = {};
#pragma unroll
        for (int d0 = 0; d0 < 8; ++d0) { const bf16x8 kf = *(const bf16x8*)(Kb + (size_t)(k0 + r32) * KVW + d0 * 16 + hi * 8); s = __builtin_amdgcn_mfma_f32_32x32x16_bf16(kf, qf[d0], s, 0, 0, 0); }
        float tm = -1e30f;
#pragma unroll
        for (int r = 0; r < 16; ++r) { s[r] *= SC; tm = fmaxf(tm, s[r]); }
        tm = fmaxf(tm, __shfl_xor(tm, 32));
        const float mn = fmaxf(m, tm), alpha = expf(m - mn);
        float ps = 0.f;
#pragma unroll
        for (int r = 0; r < 16; ++r) { const float p = expf(s[r] - mn); ps += p; Pl[r32 * 40 + crow(r, hi)] = f2bf(p); }
        ps += __shfl_xor(ps, 32);
        l = l * alpha + ps; m = mn;
        if (hi == 0) al[r32] = alpha;
        __syncthreads();
#pragma unroll
        for (int db = 0; db < 4; ++db)
#pragma unroll
            for (int r = 0; r < 16; ++r) o[db][r] *= al[crow(r, hi)];
#pragma unroll
        for (int ks = 0; ks < 2; ++ks) {
            const bf16x8 pf = *(const bf16x8*)(Pl + r32 * 40 + ks * 16 + hi * 8);
#pragma unroll
            for (int db = 0; db < 4; ++db) {
                bf16x8 vf;
#pragma unroll
                for (int i = 0; i < 8; ++i) vf[i] = (short)Vb[(size_t)(k0 + ks * 16 + hi * 8 + i) * KVW + db * 32 + r32];
                o[db] = __builtin_amdgcn_mfma_f32_32x32x16_bf16(pf, vf, o[db], 0, 0, 0);
            }
        }
        __syncthreads();
    }
    if (hi == 0) al[r32] = l;
    __syncthreads();
    bf16_t* Ob = YA + ((size_t)(b * SEQ + qt * 32)) * DM + h * HD;
#pragma unroll
    for (int db = 0; db < 4; ++db)
#pragma unroll
        for (int r = 0; r < 16; ++r) Ob[(size_t)crow(r, hi) * DM + db * 32 + r32] = f2bf(o[db][r] / al[crow(r, hi)]);
}

__global__ void __launch_bounds__(256) k_norm2_route(const float* X2, const float* nw, const float* mod, const float* rw, const float* rb,
                                                      bf16_t* H2, int* EIDX, float* EW, int* EPOS, int* CNT) {
    __shared__ float hrow[4][DM];
    const int wv = threadIdx.x >> 6, lane = threadIdx.x & 63, row = blockIdx.x * 4 + wv;
    const float* src = X2 + (size_t)row * DM; const float* mr = mod + (row / SEQ) * MODC;
    f32x4 v[8]; float ss = 0.f;
#pragma unroll
    for (int j = 0; j < 8; ++j) { v[j] = *(const f32x4*)(src + (j * 64 + lane) * 4); ss += v[j].x * v[j].x + v[j].y * v[j].y + v[j].z * v[j].z + v[j].w * v[j].w; }
    ss = wave_sum(ss);
    const float rstd = 1.0f / sqrtf(ss * (1.0f / DM) + 1e-6f);
#pragma unroll
    for (int j = 0; j < 8; ++j) { const int i = (j * 64 + lane) * 4;
#pragma unroll
        for (int c = 0; c < 4; ++c) { float h = v[j][c] * rstd * nw[i + c]; h = h * (1.0f + mr[4 * DM + i + c]) + mr[3 * DM + i + c]; hrow[wv][i + c] = h; H2[(size_t)row * DM + i + c] = f2bf(h); } }
    __syncthreads();
    float logit = 0.f;
    for (int k = 0; k < DM; ++k) logit += hrow[wv][k] * rw[(size_t)k * NE + lane];
    const float score = 1.0f / (1.0f + expf(-logit)), bsd = score + rb[lane];
    const int g = lane >> 3;
    int rk = 0;
    for (int i = 0; i < 8; ++i) { const int o = (lane & ~7) + i; const float vv = __shfl(bsd, o); rk += (vv > bsd) || (vv == bsd && o < lane); }
    float gs = rk < 2 ? bsd : 0.f;
    gs += __shfl_xor(gs, 1); gs += __shfl_xor(gs, 2); gs += __shfl_xor(gs, 4);
    int grk = 0;
    for (int gg = 0; gg < 8; ++gg) { const float vv = __shfl(gs, gg * 8); grk += (vv > gs) || (vv == gs && gg < g); }
    const bool gsel = grk < 4;
    const float mb = gsel ? bsd : -INFINITY;
    int erk = 0;
    for (int o = 0; o < 64; ++o) { const float vv = __shfl(mb, o); erk += (vv > mb) || (vv == mb && o < lane); }
    const bool sel = gsel && erk < TOPK;
    const float ssum = wave_sum(sel ? score : 0.f);
    if (sel) { const int pos = atomicAdd(&CNT[lane], 1); EIDX[row * TOPK + erk] = lane; EW[row * TOPK + erk] = score / ssum * 2.5f; EPOS[row * TOPK + erk] = pos; }
}

__global__ void k_offsets(int* CNT, int* OFFS) {
    if (threadIdx.x == 0) { int a = 0; for (int e = 0; e < NE; ++e) { OFFS[e] = a; a += CNT[e]; } OFFS[NE] = NSLOT; CNT[NE] = NTOK; }
}
__global__ void __launch_bounds__(256) k_fill(const int* EIDX, const int* EPOS, const int* OFFS, int* TOK, int* SLOTOF) {
    const int i = blockIdx.x * 256 + threadIdx.x;
    if (i < NSLOT) { const int slot = OFFS[EIDX[i]] + EPOS[i]; TOK[slot] = i / TOPK; SLOTOF[i] = slot; }
    if (i < NTOK) TOK[NSLOT + i] = i;
}
__global__ void __launch_bounds__(256) k_combine(float* out  , const float* mod, const float* EW, const int* SLOTOF, const bf16_t* YBIG) {
    const int t = blockIdx.x, b = t / SEQ;
    for (int n = threadIdx.x; n < DM; n += 256) {
        float a = bf2f(YBIG[(size_t)(NSLOT + t) * DM + n]);
        for (int k = 0; k < TOPK; ++k) a += EW[t * TOPK + k] * bf2f(YBIG[(size_t)SLOTOF[t * TOPK + k] * DM + n]);
        out[(size_t)t * DM + n] += mod[b * MODC + 5 * DM + n] * a;
    }
}

#define LAS __attribute__((address_space(3)))
#define GAS __attribute__((address_space(1)))
typedef unsigned u32x4 __attribute__((ext_vector_type(4)));
typedef GAS unsigned gu32;
#define RLX_AGENT __ATOMIC_RELAXED, __HIP_MEMORY_SCOPE_AGENT
#define LDS_WAIT() asm volatile("s_waitcnt lgkmcnt(0)" ::: "memory")
#define VM_WAIT() asm volatile("s_waitcnt vmcnt(0)" ::: "memory")

constexpr size_t CTL_BAR = 16384;
constexpr size_t CTL_MODZ = 512 * 1024;
constexpr size_t WS_UT = 38 * MiB;
constexpr size_t WS_TT = 216 * MiB;
constexpr size_t WS_WT_GU = 450 * MiB;
constexpr size_t WS_WT_D = 710 * MiB;
constexpr size_t WS_WT_IN = 840 * MiB;
constexpr size_t WS_WT_FO = 872 * MiB;
constexpr size_t WS_WT_AO = 876 * MiB;
constexpr size_t WS_WT_O = 884 * MiB;
constexpr size_t WS_CST = 892 * MiB;
constexpr size_t WS_BD2 = 956 * MiB;
constexpr size_t WS_END2 = 960 * MiB;

namespace mk {
constexpr int NWAVES = 8, NTHREADS = 512;
constexpr int RING_BYTES = 131072, SCR_BYTES = 8 * 16640, LDSCTL_OFF = 135168, MISC_OFF = LDSCTL_OFF + 320, LDS_BYTES = 147456;
static_assert(SCR_BYTES <= LDSCTL_OFF && MISC_OFF + 128 <= LDS_BYTES, "LDS map");

#define XB_TMO      128
#define XB_XCNT(j)  (256  + 64 * (j))
#define XB_XSUB(j)  (1280 + 64 * (j))
#define XB_XGEN(j)  (2304 + 64 * (j))
#define XB_TOP      3328
#define XB_TOPGEN   3392
#define XCD_BAR_WORDS 3456
#define XB_SPIN_CAP (1u << 18)
__device__ __forceinline__ unsigned xb_ld(unsigned* p)              { return __hip_atomic_load(p, __ATOMIC_RELAXED, __HIP_MEMORY_SCOPE_AGENT); }
__device__ __forceinline__ unsigned xb_add(unsigned* p, unsigned v) { return __hip_atomic_fetch_add(p, v, __ATOMIC_RELAXED, __HIP_MEMORY_SCOPE_AGENT); }
__device__ __forceinline__ unsigned xb_xcc_id() { return (unsigned)__builtin_amdgcn_s_getreg((3 << 11) | 20) & 0xFu; }
#define XB_SPIN(cond, bar) do { unsigned _sp = 0; while (cond) { __builtin_amdgcn_s_sleep(1); \
    if ((++_sp & 255u) == 0u) { if (xb_ld(&(bar)[XB_TMO])) break; if (_sp > XB_SPIN_CAP) { atomicAdd(&(bar)[XB_TMO], 1u); break; } } } } while (0)
struct XcdBarrier { unsigned* bar; unsigned x; volatile LAS unsigned* st; };
__device__ __forceinline__ XcdBarrier xcd_barrier_post(unsigned* bar, volatile LAS unsigned* st) {
    XcdBarrier b; b.bar = bar; b.x = xb_xcc_id(); b.st = st;
    if (threadIdx.x == 0) (void)xb_add(&bar[XB_XCNT(b.x)], 1u);
    return b;
}
__device__ __forceinline__ void xcd_barrier_complete(unsigned* bar, unsigned x, unsigned& nloc, unsigned& nx) {
    const unsigned G = gridDim.x * gridDim.y * gridDim.z;
    unsigned sum, cnt, mine, sp = 0u;
    for (;;) {
        sum = 0u; cnt = 0u; mine = 0u;
#pragma unroll
        for (unsigned j = 0; j < 16; ++j) { const unsigned c = xb_ld(&bar[XB_XCNT(j)]); sum += c; cnt += (c > 0u) ? 1u : 0u; mine = (j == x) ? c : mine; }
        if (sum == G) break;
        __builtin_amdgcn_s_sleep(1);
        if ((++sp & 255u) == 0u) { if (xb_ld(&bar[XB_TMO])) break; if (sp > XB_SPIN_CAP) { atomicAdd(&bar[XB_TMO], 1u); break; } }
    }
    nloc = mine > 0u ? mine : 1u; nx = cnt > 0u ? cnt : 1u;
}
__device__ __forceinline__ void xcd_barrier(const XcdBarrier& b) {
    asm volatile("s_waitcnt vmcnt(0)" ::: "memory");
    __syncthreads();
    if (threadIdx.x == 0) {
        unsigned* bar = b.bar;
        __builtin_amdgcn_s_waitcnt(0);
        unsigned nloc = b.st[0], nx = b.st[1];
        if (nloc == 0u) { xcd_barrier_complete(bar, b.x, nloc, nx); b.st[0] = nloc; b.st[1] = nx; }
        const unsigned old = xb_add(&bar[XB_XSUB(b.x)], 1u);
        const unsigned gen = old / nloc;
        if (old + 1u == (gen + 1u) * nloc) {
            __builtin_amdgcn_fence(__ATOMIC_RELEASE, "agent");
            asm volatile("s_waitcnt vmcnt(0)" ::: "memory");
            const unsigned og = xb_add(&bar[XB_TOP], 1u);
            const unsigned tg = og / nx;
            if (og + 1u == (tg + 1u) * nx) xb_add(&bar[XB_TOPGEN], 1u);
            else XB_SPIN(xb_ld(&bar[XB_TOPGEN]) == tg, bar);
            __builtin_amdgcn_fence(__ATOMIC_ACQUIRE, "agent");
            xb_add(&bar[XB_XGEN(b.x)], 1u);
            asm volatile("s_waitcnt vmcnt(0)" ::: "memory");
        } else {
            XB_SPIN(xb_ld(&bar[XB_XGEN(b.x)]) == gen, bar);
            __builtin_amdgcn_fence(__ATOMIC_ACQUIRE, "agent");
            asm volatile("s_waitcnt vmcnt(0)" ::: "memory");
        }
    }
    __syncthreads();
}

constexpr int BM = 256, BK = 64, HALF = 128, HTB = HALF * BK * 2, STAGE_BYTES = 8 * HTB;
__device__ __forceinline__ int lds_byte(int r, int c) { const int st = (r >> 4) * 2 + (c >> 5), rr = r & 15, cc = c & 31, ob = rr * 64 + cc * 2; return st * 1024 + (ob ^ (((ob >> 9) & 1) << 5)); }
__device__ __forceinline__ void stage_rc(int b, int& R, int& C) { const int st = b / 1024, sb = b % 1024, swz = sb ^ (((sb >> 9) & 1) << 5); R = (st >> 1) * 16 + swz / 64; C = (st & 1) * 32 + (swz % 64) / 2; }
__device__ __forceinline__ int perm32(int rho) { const int n = rho >> 4, i = rho & 15; return 8 * (i >> 2) + 4 * n + (i & 3); }
__device__ __forceinline__ unsigned cvt_pk_bf16(float lo, float hi) { unsigned r; asm volatile("v_cvt_pk_bf16_f32 %0, %1, %2" : "=v"(r) : "v"(lo), "v"(hi)); return r; }

__device__ __forceinline__ void glds16_s(const void* sbase, unsigned voff, unsigned lds_dst) { unsigned keep;
    asm volatile("s_mov_b32 %0, m0\n\ts_mov_b32 m0, %3\n\ts_nop 0\n\tglobal_load_lds_dwordx4 %1, %2\n\ts_mov_b32 m0, %0" : "=&s"(keep) : "v"(voff), "s"(sbase), "s"(lds_dst) : "memory"); }

struct Unit { const char* A; const char* B; char* C; int ldc; int mode; int rows; int aux; int pm, pn, bjs; };

template <class Epi, class Sched, bool GATHER>
__device__ __forceinline__ void gemm_phase(LAS unsigned char* lds, const int K, const int lda, const int ldb, const Sched& S, const Epi& E) {
    const int tid = threadIdx.x, wid = __builtin_amdgcn_readfirstlane(tid >> 6), lane = tid & 63, wr = wid >> 2, wc = wid & 3, fr = lane & 15, fq = lane >> 4;
    const int nt = K / BK;
    unsigned voffA[2], voffB[2];
#pragma unroll
    for (int i = 0; i < 2; ++i) { int R, C; stage_rc(tid * 16 + i * 8192, R, C); const int Rb = (R & ~31) + perm32(R & 31);
        voffA[i] = (unsigned)(R * lda + C) * 2u; voffB[i] = (unsigned)(Rb * ldb + C) * 2u; }
    const size_t kstep = (size_t)(BK * 2);
    const size_t hstepA = (size_t)HALF * lda * 2, hstepB = (size_t)HALF * ldb * 2;
    const unsigned ldsw = (unsigned)wid * 1024u;
    const unsigned ldsbase = (unsigned)__builtin_amdgcn_readfirstlane((int)(unsigned)(uintptr_t)lds);
    const int aoff = lds_byte(wr * 64 + fr, fq * 8), boff = lds_byte(wc * 32 + fr, fq * 8);
#define MK_SA(b, h) (((b) * 2 + (h)) * HTB)
#define MK_SB(b, h) ((4 + (b) * 2 + (h)) * HTB)
#define MK_STAGE2(bufoff, gbase, v0, v1) do { \
        __builtin_amdgcn_global_load_lds((const unsigned*)((const char*)(gbase) + (v0)), (LAS unsigned*)(lds + (bufoff) + ldsw), 16, 0, 0); \
        __builtin_amdgcn_global_load_lds((const unsigned*)((const char*)(gbase) + (v1)), (LAS unsigned*)(lds + (bufoff) + ldsw + 8192), 16, 0, 0); } while (0)
#define MK_STAGE_B(bufoff, gbase) MK_STAGE2(bufoff, gbase, voffB[0], voffB[1])
#define MK_STAGE_A(bufoff, gbase, h, VA) do { if constexpr (GATHER) { glds16_s((gbase), (VA)[h][0], ldsbase + (bufoff) + ldsw); glds16_s((gbase), (VA)[h][1], ldsbase + (bufoff) + ldsw + 8192u); } else MK_STAGE2(bufoff, (gbase) + (h) * hstepA, voffA[0], voffA[1]); } while (0)
#define MK_LDA(dst, b, h) do { _Pragma("unroll") for (int m = 0; m < 4; ++m) _Pragma("unroll") for (int k = 0; k < 2; ++k) dst[m][k] = *(const LAS bf16x8*)(lds + MK_SA(b, h) + aoff + m * 2048 + k * 1024); } while (0)
#define MK_LDB(dst, b, h) do { _Pragma("unroll") for (int n = 0; n < 2; ++n) _Pragma("unroll") for (int k = 0; k < 2; ++k) dst[n][k] = *(const LAS bf16x8*)(lds + MK_SB(b, h) + boff + n * 2048 + k * 1024); } while (0)
#define MK_MMA(ai, bj, At, Bt) do { __builtin_amdgcn_s_setprio(1); _Pragma("unroll") for (int m = 0; m < 4; ++m) _Pragma("unroll") for (int n = 0; n < 2; ++n) _Pragma("unroll") for (int k = 0; k < 2; ++k) \
        acc[ai][bj][m][n] = __builtin_amdgcn_mfma_f32_16x16x32_bf16(Bt[n][k], At[m][k], acc[ai][bj][m][n], 0, 0, 0); __builtin_amdgcn_s_setprio(0); } while (0)
#define MK_WAIT_V(n) asm volatile("s_waitcnt vmcnt(" #n ")" ::: "memory")
#define MK_WAIT_L(n) asm volatile("s_waitcnt lgkmcnt(" #n ")" ::: "memory")
#define MK_BAR __builtin_amdgcn_s_barrier()
#define MK_SCHED __builtin_amdgcn_sched_barrier(0)
    Unit cur, nxt; int ui = 0;
    if (!S.next(0, cur)) return;
    f32x4 acc[2][2][4][2];
#pragma unroll
    for (int a = 0; a < 2; ++a)
#pragma unroll
        for (int b = 0; b < 2; ++b)
#pragma unroll
            for (int m = 0; m < 4; ++m)
#pragma unroll
                for (int n = 0; n < 2; ++n) acc[a][b][m][n] = (f32x4){0.f, 0.f, 0.f, 0.f};
    bf16x8 At[4][2], B0[2][2], B1[2][2];
    unsigned vC[2][2], vN[2][2];
    if constexpr (GATHER) {
#pragma unroll
        for (int h = 0; h < 2; ++h)
#pragma unroll
            for (int i = 0; i < 2; ++i) { int R, C; stage_rc(tid * 16 + i * 8192, R, C); vC[h][i] = S.arow(cur, h * HALF + R) + (unsigned)(C * 2); }
    }
    const char* cA = cur.A; const char* cB = cur.B;
    MK_STAGE_B(MK_SB(0, 0), cB); MK_STAGE_B(MK_SB(0, 1), cB + hstepB); MK_STAGE_A(MK_SA(0, 0), cA, 0, vC); MK_STAGE_A(MK_SA(0, 1), cA, 1, vC);
    if (wr == 1) MK_BAR;
    MK_WAIT_V(2); MK_BAR;
    MK_STAGE_B(MK_SB(1, 0), cB + kstep); MK_STAGE_A(MK_SA(1, 0), cA + kstep, 0, vC); MK_STAGE_B(MK_SB(1, 1), cB + hstepB + kstep);
    MK_WAIT_V(6); MK_BAR;
    for (;;) {
        const bool has_next = S.next(ui + 1, nxt);
        const char* nA = has_next ? nxt.A : cA; const char* nB = has_next ? nxt.B : cB;
        if constexpr (GATHER) {
#pragma unroll
            for (int h = 0; h < 2; ++h)
#pragma unroll
                for (int i = 0; i < 2; ++i) { int R, C; stage_rc(tid * 16 + i * 8192, R, C); vN[h][i] = has_next ? (S.arow(nxt, h * HALF + R) + (unsigned)(C * 2)) : vC[h][i]; }
        }
        for (int t = 0; t < nt; t += 2) {
            const bool last = (t == nt - 2);
            const char* a1 = cA + (size_t)(t + 1) * kstep;
            const char* a2 = last ? nA : cA + (size_t)(t + 2) * kstep; const char* b2 = last ? nB : cB + (size_t)(t + 2) * kstep;
            const char* a3 = a2 + kstep; const char* b3 = b2 + kstep;
            MK_LDB(B0, 0, 0); MK_LDB(B1, 0, 1); MK_SCHED; MK_LDA(At, 0, 0); MK_STAGE_A(MK_SA(1, 1), a1, 1, vC);
            MK_WAIT_V(8); MK_WAIT_L(0); MK_BAR; MK_MMA(0, 0, At, B0); MK_MMA(0, 1, At, B1); MK_BAR; MK_SCHED;
            MK_LDA(At, 0, 1); MK_STAGE_B(MK_SB(0, 0), b2); MK_STAGE_B(MK_SB(0, 1), b2 + hstepB); if (GATHER && last) MK_STAGE_A(MK_SA(0, 0), a2, 0, vN); else MK_STAGE_A(MK_SA(0, 0), a2, 0, vC);
            MK_WAIT_V(8); MK_WAIT_L(0); MK_BAR; MK_MMA(1, 0, At, B0); MK_MMA(1, 1, At, B1); MK_BAR; MK_SCHED;
            MK_LDB(B0, 1, 0); MK_LDB(B1, 1, 1); MK_SCHED; MK_LDA(At, 1, 0); if (GATHER && last) MK_STAGE_A(MK_SA(0, 1), a2, 1, vN); else MK_STAGE_A(MK_SA(0, 1), a2, 1, vC);
            MK_WAIT_V(8); MK_WAIT_L(0); MK_BAR; MK_MMA(0, 0, At, B0); MK_MMA(0, 1, At, B1); MK_BAR; MK_SCHED;
            MK_LDA(At, 1, 1); MK_STAGE_B(MK_SB(1, 0), b3); MK_STAGE_B(MK_SB(1, 1), b3 + hstepB); if (GATHER && last) MK_STAGE_A(MK_SA(1, 0), a3, 0, vN); else MK_STAGE_A(MK_SA(1, 0), a3, 0, vC);
            MK_WAIT_V(8); MK_WAIT_L(0); MK_BAR; MK_MMA(1, 0, At, B0); MK_MMA(1, 1, At, B1); MK_BAR; MK_SCHED;
        }
        if (wr == 0) MK_BAR;
        E(acc, cur, wr, wc, fr, fq);
        if (!has_next) break;
#pragma unroll
        for (int a = 0; a < 2; ++a)
#pragma unroll
            for (int b = 0; b < 2; ++b)
#pragma unroll
                for (int m = 0; m < 4; ++m)
#pragma unroll
                    for (int n = 0; n < 2; ++n) acc[a][b][m][n] = (f32x4){0.f, 0.f, 0.f, 0.f};
        cur = nxt; cA = nA; cB = nB; ++ui;
        if constexpr (GATHER) {
#pragma unroll
            for (int h = 0; h < 2; ++h)
#pragma unroll
                for (int i = 0; i < 2; ++i) vC[h][i] = vN[h][i];
        }
        if (wr == 1) MK_BAR;
    }
    MK_WAIT_V(0);
    MK_BAR;
#undef MK_SA
#undef MK_SB
#undef MK_STAGE2
#undef MK_STAGE_B
#undef MK_STAGE_A
#undef MK_LDA
#undef MK_LDB
#undef MK_MMA
#undef MK_WAIT_V
#undef MK_WAIT_L
#undef MK_BAR
#undef MK_SCHED
}

__device__ __forceinline__ void grid_map(int L, int nM, int nN, int& pm, int& pn) {
    const int nwg = nM * nN, q = nwg / 8, xcd = L % 8, off = L / 8; const int wgid = xcd * q + off;
    const int nig = 8 * nN, gid = wgid / nig, fm = gid * 8, gsz = (nM - fm) < 8 ? (nM - fm) : 8;
    pm = fm + ((wgid % nig) % gsz); pn = (wgid % nig) / gsz;
}

struct EpiStore {
    __device__ __forceinline__ void operator()(const f32x4 (&acc)[2][2][4][2], const Unit& u, int wr, int wc, int fr, int fq) const {
        const int col0 = wc * 32 + 8 * fq;
#pragma unroll
        for (int ai = 0; ai < 2; ++ai)
#pragma unroll
            for (int m = 0; m < 4; ++m) {
                const int r = ai * HALF + wr * 64 + m * 16 + fr;
                if (r < u.rows) {
#pragma unroll
                    for (int bj = 0; bj < 2; ++bj) {
                        f32x4 v0 = acc[ai][bj][m][0], v1 = acc[ai][bj][m][1];
                        if (u.mode == 1) { float* p = (float*)u.C + (size_t)r * u.ldc + col0 + bj * u.bjs; *(f32x4*)p = v0; *(f32x4*)(p + 4) = v1; }
                        else {
                            if (u.mode == 2) {
#pragma unroll
                                for (int c = 0; c < 4; ++c) { v0[c] = __builtin_amdgcn_rcpf(1.0f + __expf(-v0[c])); v1[c] = __builtin_amdgcn_rcpf(1.0f + __expf(-v1[c])); }
                            }
                            u32x4 w; w.x = cvt_pk_bf16(v0[0], v0[1]); w.y = cvt_pk_bf16(v0[2], v0[3]); w.z = cvt_pk_bf16(v1[0], v1[1]); w.w = cvt_pk_bf16(v1[2], v1[3]);
                            *(u32x4*)((bf16_t*)u.C + (size_t)r * u.ldc + col0 + bj * u.bjs) = w;
                        }
                    }
                }
            }
    }
};

struct Frame {
    LAS unsigned char* lds; volatile LAS unsigned* MISC; unsigned char* ws;
    int tid, lane, wave, vcu, G;
    const float* in[22]; float* out;
};

__device__ __forceinline__ void transpose64(const float* W, int ldw, bf16_t* dst, int ldd, LAS float* scr, int lane) {
    f32x4 v[16];
    const int kk = lane >> 4, nc = (lane & 15) * 4;
#pragma unroll
    for (int j = 0; j < 16; ++j) v[j] = *(const GAS f32x4*)(W + (size_t)(j * 4 + kk) * ldw + nc);
#pragma unroll
    for (int j = 0; j < 16; ++j) {
#pragma unroll
        for (int c = 0; c < 4; ++c) scr[(j * 4 + kk) * 65 + nc + c] = v[j][c]; }
    LDS_WAIT(); asm volatile("" ::: "memory");
    const int kc = lane & 7;
#pragma unroll
    for (int jj = 0; jj < 8; ++jj) { const int n = (lane >> 3) + 8 * jj; const LAS float* s = scr + (8 * kc) * 65 + n;
        u32x4 o; o.x = cvt_pk_bf16(s[0 * 65], s[1 * 65]); o.y = cvt_pk_bf16(s[2 * 65], s[3 * 65]); o.z = cvt_pk_bf16(s[4 * 65], s[5 * 65]); o.w = cvt_pk_bf16(s[6 * 65], s[7 * 65]);
        *(GAS u32x4*)(dst + (size_t)n * ldd + 8 * kc) = o; }
    LDS_WAIT(); asm volatile("" ::: "memory");
}

constexpr int IT_IN = 32 * 128, IT_FO = 16 * 32, IT_AO = 32 * 32, IT_O = 32 * 32, IT_EG = 64 * 256, IT_EU = 64 * 256, IT_ED = 64 * 256, IT_SH = 256;
constexpr int IT_T_END = IT_IN + IT_FO + IT_AO + IT_O + IT_EG + IT_EU + IT_ED + 3 * IT_SH;
constexpr int IT_MOD = MODC / 32, IT_CST = 8192, IT_BD2 = 256;
constexpr int IT_ALL = IT_T_END + IT_MOD + IT_CST + IT_BD2;

__device__ __forceinline__ void p0_prologue(Frame& F) {
    LAS float* scr = (LAS float*)(F.lds + F.wave * 16640);
    const int gw = F.vcu * NWAVES + F.wave, NGW = F.G * NWAVES, lane = F.lane;
    unsigned char* ws = F.ws;
    bf16_t* WT_IN = (bf16_t*)(ws + WS_WT_IN); bf16_t* WT_FO = (bf16_t*)(ws + WS_WT_FO); bf16_t* WT_AO = (bf16_t*)(ws + WS_WT_AO); bf16_t* WT_O = (bf16_t*)(ws + WS_WT_O);
    bf16_t* WT_GU = (bf16_t*)(ws + WS_WT_GU); bf16_t* WT_D = (bf16_t*)(ws + WS_WT_D);
    for (int it = gw; it < IT_ALL; it += NGW) {
        int r = it < IT_MOD ? it + IT_T_END : (it < IT_T_END + IT_MOD ? it - IT_MOD : it);
        if (r < IT_IN) { const int kb = r / 128, nb = r % 128; transpose64(F.in[7] + (size_t)(kb * 64) * INC + nb * 64, INC, WT_IN + (size_t)(nb * 64) * DM + kb * 64, DM, scr, lane); continue; } r -= IT_IN;
        if (r < IT_FO) { const int kb = r / 32, nb = r % 32; transpose64(F.in[10] + (size_t)(kb * 64) * DM + nb * 64, DM, WT_FO + (size_t)(nb * 64) * FW + kb * 64, FW, scr, lane); continue; } r -= IT_FO;
        if (r < IT_AO) { const int kb = r / 32, nb = r % 32; transpose64(F.in[11] + (size_t)(kb * 64) * DM + nb * 64, DM, WT_AO + (size_t)(nb * 64) * DM + kb * 64, DM, scr, lane); continue; } r -= IT_AO;
        if (r < IT_O) { const int kb = r / 32, nb = r % 32; transpose64(F.in[12] + (size_t)(kb * 64) * DM + nb * 64, DM, WT_O + (size_t)(nb * 64) * DM + kb * 64, DM, scr, lane); continue; } r -= IT_O;
        if (r < IT_EG + IT_EU) {
            const int up = r >= IT_EG; if (up) r -= IT_EG;
            const int e = r / 256, q = r % 256, kb = q / 8, nb = q % 8, n0 = nb * 64;
            const float* W = (up ? F.in[17] : F.in[16]) + (size_t)e * DM * EFF + (size_t)(kb * 64) * EFF + n0;
            transpose64(W, EFF, WT_GU + ((size_t)e * 1024 + (n0 >> 7) * 256 + (up ? 128 : 0) + (n0 & 127)) * DM + kb * 64, DM, scr, lane); continue; } r -= IT_EG + IT_EU;
        if (r < IT_ED) { const int e = r / 256, q = r % 256, kb = q / 32, nb = q % 32;
            transpose64(F.in[18] + (size_t)e * EFF * DM + (size_t)(kb * 64) * DM + nb * 64, DM, WT_D + ((size_t)e * DM + nb * 64) * EFF + kb * 64, EFF, scr, lane); continue; } r -= IT_ED;
        if (r < 2 * IT_SH) { const int up = r >= IT_SH; if (up) r -= IT_SH; const int kb = r / 8, nb = r % 8, n0 = nb * 64;
            transpose64((up ? F.in[20] : F.in[19]) + (size_t)(kb * 64) * EFF + n0, EFF, WT_GU + ((size_t)64 * 1024 + (n0 >> 7) * 256 + (up ? 128 : 0) + (n0 & 127)) * DM + kb * 64, DM, scr, lane); continue; } r -= 2 * IT_SH;
        if (r < IT_SH) { const int kb = r / 32, nb = r % 32;
            transpose64(F.in[21] + (size_t)(kb * 64) * DM + nb * 64, DM, WT_D + ((size_t)64 * DM + nb * 64) * EFF + kb * 64, EFF, scr, lane); continue; } r -= IT_SH;
        if (r < IT_MOD) {
            const int kq = lane >> 3, col = r * 32 + (lane & 7) * 4;
            f32x4 a0 = {0.f, 0.f, 0.f, 0.f}, a1 = a0, a2 = a0;
#pragma unroll 16
            for (int j = 0; j < 256; ++j) { const int k = kq + 8 * j;
                const f32x4 w = *(const GAS f32x4*)(F.in[4] + (size_t)k * MODC + col);
                const float c0 = F.in[1][k], c1 = F.in[1][DM + k], c2 = F.in[3][k];
                a0 += w * (c0 / (1.0f + __expf(-c0))); a1 += w * (c1 / (1.0f + __expf(-c1))); a2 += w * (c2 / (1.0f + __expf(-c2))); }
#pragma unroll
            for (int c = 0; c < 4; ++c) {
#pragma unroll
                for (int o = 8; o < 64; o <<= 1) { a0[c] += __shfl_xor(a0[c], o); a1[c] += __shfl_xor(a1[c], o); a2[c] += __shfl_xor(a2[c], o); } }
            if (kq == 0) { const f32x4 bb = *(const GAS f32x4*)(F.in[5] + col); float* MODP = (float*)(ws + WS_MOD);
                *(GAS f32x4*)(MODP + col) = a0 + bb; *(GAS f32x4*)(MODP + MODC + col) = a1 + bb; *(GAS f32x4*)(MODP + 2 * MODC + col) = a2 + bb; }
            continue; } r -= IT_MOD;
        if (r < IT_CST) {
            const int k1 = r & 4095; bf16_t* dst = (bf16_t*)(ws + WS_CST) + (size_t)r * 4096;
#pragma unroll
            for (int j = 0; j < 8; ++j) { const int n0 = j * 512 + lane * 8; float f[8];
#pragma unroll
                for (int i = 0; i < 8; ++i) { const float ph = (float)((k1 * (n0 + i)) & 4095) * (1.0f / 2048.0f); f[i] = r < 4096 ? cospif(ph) : sinpif(ph); }
                u32x4 o; o.x = cvt_pk_bf16(f[0], f[1]); o.y = cvt_pk_bf16(f[2], f[3]); o.z = cvt_pk_bf16(f[4], f[5]); o.w = cvt_pk_bf16(f[6], f[7]);
                *(GAS u32x4*)(dst + n0) = o; }
            continue; } r -= IT_CST;
        {
            const int o = r, gp = o >> 7, k2 = o & 127; bf16_t* dst = (bf16_t*)(ws + WS_BD2) + (size_t)o * 512; float f[8];
#pragma unroll
            for (int i = 0; i < 8; ++i) { const int j = lane * 8 + i, cg = j >> 8, jj = j & 255, c = jj & 127; const float ph = (float)((32 * c * k2) & 4095) * (1.0f / 2048.0f);
                const float v = jj < 128 ? cospif(ph) : -sinpif(ph); f[i] = cg == gp ? v * 0.0013810679320049757f : 0.f; }
            u32x4 w; w.x = cvt_pk_bf16(f[0], f[1]); w.y = cvt_pk_bf16(f[2], f[3]); w.z = cvt_pk_bf16(f[4], f[5]); w.w = cvt_pk_bf16(f[6], f[7]);
            *(GAS u32x4*)(dst + lane * 8) = w;
        }
    }
}

struct SchedIn {
    int G, c; unsigned char* ws; int use_ut;
    __device__ __forceinline__ bool next(int i, Unit& u) const {
        const int L = i * G + c; if (L >= 1032) return false;
        const char* H = (const char*)(ws + WS_H); const char* WT = (const char*)(ws + WS_WT_IN);
        u.rows = 256; u.aux = 0; u.bjs = HALF; u.pm = 0; u.pn = 0;
        if (L < 1024) {
            int pm, ct; grid_map(L, 32, 32, pm, ct);
            const int row0 = pm * 256, b = row0 / SEQ, t0 = row0 % SEQ;
            u.A = H + (size_t)row0 * DM * 2; u.B = WT + (size_t)ct * 256 * DM * 2;
            if (ct < 4) {
                if (use_ut) { u.A = WT + (size_t)ct * 256 * DM * 2; u.B = H + (size_t)row0 * DM * 2;
                              u.C = (char*)(ws + WS_UT) + (((size_t)b * FW + ct * 256) * SEQ + t0) * 2; u.ldc = SEQ; u.mode = 0; }
                else { u.C = (char*)(ws + WS_U) + ((size_t)row0 * FW + ct * 256) * 2; u.ldc = FW; u.mode = 0; }
            }
            else if (ct < 14) { u.C = (char*)(ws + WS_QKRAW) + ((size_t)row0 * 2560 + (ct - 4) * 256) * 4; u.ldc = 2560; u.mode = 1; }
            else if (ct < 16) { u.C = (char*)(ws + WS_VALL) + (((size_t)b * SKV + t0) * KVW + (ct - 14) * 256) * 2; u.ldc = KVW; u.mode = 0; }
            else if (ct < 24) { u.C = (char*)(ws + WS_SGF) + ((size_t)row0 * DM + (ct - 16) * 256) * 2; u.ldc = DM; u.mode = 2; }
            else              { u.C = (char*)(ws + WS_SGA) + ((size_t)row0 * DM + (ct - 24) * 256) * 2; u.ldc = DM; u.mode = 2; }
        } else {
            const int l = L - 1024, pm = l & 1, ct = l >> 1;
            u.A = H + (size_t)(NTOK + pm * 256) * DM * 2; u.B = WT + (size_t)(K_OFF + ct * 256) * DM * 2;
            if (ct < 2) { u.C = (char*)(ws + WS_KCRAW) + ((size_t)(pm * 256) * KVW + ct * 256) * 4; u.ldc = KVW; u.mode = 1; }
            else        { u.C = (char*)(ws + WS_VALL) + (((size_t)pm * SKV + SEQ) * KVW + (ct - 2) * 256) * 2; u.ldc = KVW; u.mode = 0; }
        }
        return true;
    }
    __device__ __forceinline__ unsigned arow(const Unit&, int) const { return 0u; }
};


__device__ __forceinline__ void unpack8(u32x4 w, float (&f)[8]) {
#pragma unroll
    for (int i = 0; i < 4; ++i) { f[2 * i] = __uint_as_float(w[i] << 16); f[2 * i + 1] = __uint_as_float(w[i] & 0xffff0000u); }
}
struct EpiT1 { const bf16_t* SGF; float* T1;
    __device__ __forceinline__ void operator()(const f32x4 (&acc)[2][2][4][2], const Unit& u, int wr, int wc, int fr, int fq) const {
#pragma unroll
        for (int ai = 0; ai < 2; ++ai)
#pragma unroll
            for (int m = 0; m < 4; ++m) { const size_t row = (size_t)u.pm * 256 + ai * HALF + wr * 64 + m * 16 + fr;
#pragma unroll
                for (int bj = 0; bj < 2; ++bj) { const size_t o = row * DM + u.pn * 256 + bj * HALF + wc * 32 + 8 * fq;
                    float g[8]; unpack8(*(const u32x4*)(SGF + o), g); const f32x4 v0 = acc[ai][bj][m][0], v1 = acc[ai][bj][m][1];
                    *(f32x4*)(T1 + o) = (f32x4){g[0] * v0[0], g[1] * v0[1], g[2] * v0[2], g[3] * v0[3]};
                    *(f32x4*)(T1 + o + 4) = (f32x4){g[4] * v1[0], g[5] * v1[1], g[6] * v1[2], g[7] * v1[3]}; } }
    } };
struct EpiYM { const bf16_t* SGA; const float* T1; bf16_t* YM;
    __device__ __forceinline__ void operator()(const f32x4 (&acc)[2][2][4][2], const Unit& u, int wr, int wc, int fr, int fq) const {
#pragma unroll
        for (int ai = 0; ai < 2; ++ai)
#pragma unroll
            for (int m = 0; m < 4; ++m) { const size_t row = (size_t)u.pm * 256 + ai * HALF + wr * 64 + m * 16 + fr;
#pragma unroll
                for (int bj = 0; bj < 2; ++bj) { const size_t o = row * DM + u.pn * 256 + bj * HALF + wc * 32 + 8 * fq;
                    float g[8]; unpack8(*(const u32x4*)(SGA + o), g); const f32x4 v0 = acc[ai][bj][m][0], v1 = acc[ai][bj][m][1];
                    const f32x4 t0 = *(const f32x4*)(T1 + o), t1 = *(const f32x4*)(T1 + o + 4);
                    u32x4 w; w.x = cvt_pk_bf16(t0[0] + g[0] * v0[0], t0[1] + g[1] * v0[1]); w.y = cvt_pk_bf16(t0[2] + g[2] * v0[2], t0[3] + g[3] * v0[3]);
                    w.z = cvt_pk_bf16(t1[0] + g[4] * v1[0], t1[1] + g[5] * v1[1]); w.w = cvt_pk_bf16(t1[2] + g[6] * v1[2], t1[3] + g[7] * v1[3]);
                    *(u32x4*)(YM + o) = w; } }
    } };
struct EpiX2 { const float* x; const float* mod; float* X2;
    __device__ __forceinline__ void operator()(const f32x4 (&acc)[2][2][4][2], const Unit& u, int wr, int wc, int fr, int fq) const {
        const float* g1 = mod + ((u.pm * 256) / SEQ) * MODC + 2 * DM;
#pragma unroll
        for (int ai = 0; ai < 2; ++ai)
#pragma unroll
            for (int m = 0; m < 4; ++m) { const size_t row = (size_t)u.pm * 256 + ai * HALF + wr * 64 + m * 16 + fr;
#pragma unroll
                for (int bj = 0; bj < 2; ++bj) { const int col = u.pn * 256 + bj * HALF + wc * 32 + 8 * fq; const size_t o = row * DM + col;
#pragma unroll
                    for (int n = 0; n < 2; ++n) { const f32x4 xv = *(const f32x4*)(x + o + 4 * n), gv = *(const f32x4*)(g1 + col + 4 * n); *(f32x4*)(X2 + o + 4 * n) = xv + gv * acc[ai][bj][m][n]; } } }
    } };
struct EpiAct {
    __device__ __forceinline__ void operator()(const f32x4 (&acc)[2][2][4][2], const Unit& u, int wr, int wc, int fr, int fq) const {
#pragma unroll
        for (int ai = 0; ai < 2; ++ai)
#pragma unroll
            for (int m = 0; m < 4; ++m) { const int r = ai * HALF + wr * 64 + m * 16 + fr;
                if (r < u.rows) { float a[8];
#pragma unroll
                    for (int n = 0; n < 2; ++n)
#pragma unroll
                        for (int c = 0; c < 4; ++c) { const float g = acc[ai][0][m][n][c], up = acc[ai][1][m][n][c]; a[4 * n + c] = g * __builtin_amdgcn_rcpf(1.0f + __expf(-g)) * up; }
                    u32x4 w; w.x = cvt_pk_bf16(a[0], a[1]); w.y = cvt_pk_bf16(a[2], a[3]); w.z = cvt_pk_bf16(a[4], a[5]); w.w = cvt_pk_bf16(a[6], a[7]);
                    *(u32x4*)((bf16_t*)u.C + (size_t)r * u.ldc + wc * 32 + 8 * fq) = w; } }
    } };

struct SchedGrid {
    int G, c, nM, nN; const char* A; const char* B; char* C; size_t astride, bstride; int ldc, esz, mode;
    __device__ __forceinline__ bool next(int i, Unit& u) const {
        const int L = i * G + c; if (L >= nM * nN) return false;
        int pm, pn; grid_map(L, nM, nN, pm, pn);
        u.A = A + (size_t)pm * astride; u.B = B + (size_t)pn * bstride; u.C = C + ((size_t)pm * 256 * ldc + pn * 256) * esz; u.ldc = ldc; u.mode = mode; u.rows = 256; u.aux = 0; u.pm = pm; u.pn = pn; u.bjs = HALF;
        return true; }
    __device__ __forceinline__ unsigned arow(const Unit&, int) const { return 0u; } };
struct SchedF1 { int G, c; unsigned char* ws;
    __device__ __forceinline__ bool next(int i, Unit& u) const {
        const int L = i * G + c; if (L >= 256) return false;
        int pm, pn8; grid_map(L, 32, 8, pm, pn8); const int b = pn8 >> 2, pn = pn8 & 3, sn = pm >> 4, k1t = pm & 15;
        u.A = (const char*)(ws + WS_CST) + (size_t)pm * 256 * SEQ * 2; u.B = (const char*)(ws + WS_UT) + ((size_t)b * FW + pn * 256) * SEQ * 2;
        u.C = (char*)(ws + WS_TT) + (((size_t)b * SEQ + k1t * 256) * DM + pn * 512 + sn * 128) * 2; u.ldc = DM; u.mode = 0; u.rows = 256; u.aux = 0; u.pm = pm; u.pn = pn8; u.bjs = 256;
        return true; }
    __device__ __forceinline__ unsigned arow(const Unit&, int) const { return 0u; } };
struct SchedF2 { int G, c; unsigned char* ws;
    __device__ __forceinline__ bool next(int i, Unit& u) const {
        const int L = i * G + c; if (L >= 128) return false;
        int pm, j; grid_map(L, 32, 4, pm, j);
        u.A = (const char*)(ws + WS_TT) + ((size_t)pm * 256 * DM + j * 512) * 2; u.B = (const char*)(ws + WS_BD2);
        u.C = (char*)(ws + WS_YF) + ((size_t)pm * 256 * FW + j * 256) * 2; u.ldc = FW; u.mode = 0; u.rows = 256; u.aux = 0; u.pm = pm; u.pn = j; u.bjs = HALF;
        return true; }
    __device__ __forceinline__ unsigned arow(const Unit&, int) const { return 0u; } };
constexpr int SCHT_OFF = LDSCTL_OFF + 1024;
__device__ __forceinline__ void moe_tables(Frame& F, int ncol_tiles) {
    LAS int* T = (LAS int*)(F.lds + SCHT_OFF);
    __syncthreads();
    if (F.tid == 0) { const int* CNT = (const int*)(F.ws + CTL_CNT); int up = 0, of = 0;
        for (int e = 0; e <= NE; ++e) { const int cn = e < NE ? CNT[e] : NTOK; T[e] = up; T[80 + e] = e < NE ? of : NSLOT; T[160 + e] = cn; up += ((cn + 255) >> 8) * ncol_tiles; of += cn; }
        T[NE + 1] = up; }
    __syncthreads();
}
template <int NCT, bool FIRST> struct SchedMoe {
    int G, c; unsigned char* ws; LAS int* T; const int* TOK;
    __device__ __forceinline__ bool next(int i, Unit& u) const {
        const int L = i * G + c; if (L >= T[NE + 1]) return false;
        int lo = 0, hi = NE;
#pragma unroll 1
        while (lo < hi) { const int mid = (lo + hi + 1) >> 1; if (T[mid] <= L) lo = mid; else hi = mid - 1; }
        const int e = lo, cn = T[160 + e], ntile = (cn + 255) >> 8, local = L - T[e], ct = local / ntile, mt = local % ntile, slot0 = T[80 + e] + mt * 256;
        u.rows = (cn - mt * 256) < 256 ? (cn - mt * 256) : 256; u.aux = slot0; u.pm = mt; u.pn = ct; u.bjs = HALF; u.mode = 0;
        if (FIRST) { u.A = (const char*)(ws + WS_H2); u.B = (const char*)(ws + WS_WT_GU) + ((size_t)e * 4 + ct) * 256 * DM * 2; u.C = (char*)(ws + WS_ACT) + ((size_t)slot0 * EFF + ct * 128) * 2; u.ldc = EFF; }
        else { u.A = (const char*)(ws + WS_ACT) + (size_t)slot0 * EFF * 2; u.B = (const char*)(ws + WS_WT_D) + ((size_t)e * DM + ct * 256) * EFF * 2; u.C = (char*)(ws + WS_YBIG) + ((size_t)slot0 * DM + ct * 256) * 2; u.ldc = DM; }
        return true; }
    __device__ __forceinline__ unsigned arow(const Unit& u, int r) const { const int rr = r < u.rows ? r : u.rows - 1; return (unsigned)TOK[u.aux + rr] * (unsigned)(DM * 2); } };

namespace attn {
using s16x4 = __attribute__((ext_vector_type(4))) short;
using f32x8 = __attribute__((ext_vector_type(8))) float;
constexpr int D = 128, NW = 8, QBLK = 32, KVBLK = 64;
constexpr float SCALE = 0.088388347648318440f;
constexpr float THR = 8.f;
constexpr int LDQ = DM, LDK = KVW, LDO = DM;
constexpr size_t SHM_V = KVBLK * D * 2, SHM_K = KVBLK * D * 2, SHM_ATTN = 2 * SHM_V + 2 * SHM_K + NW * 64 * 4;
#define KSWZ(row, colB) ((row) * 256 + ((colB) ^ (((row) & 7) << 4)))
#define SBAR() __builtin_amdgcn_sched_barrier(0)
__device__ __forceinline__ unsigned cvtpk(float lo, float hi) { unsigned r; asm volatile("v_cvt_pk_bf16_f32 %0, %1, %2" : "=v"(r) : "v"(lo), "v"(hi)); return r; }
__device__ __forceinline__ void partialSM(f32x16& p0, f32x16& p1, float& m_reg, float& mn, float& alpha) {
  constexpr float C = SCALE * 1.4426950408889634f;
  float pmax = p0[0]; for (int r = 1; r < 16; ++r) pmax = fmaxf(pmax, p0[r]); for (int r = 0; r < 16; ++r) pmax = fmaxf(pmax, p1[r]);
  { auto rr = __builtin_amdgcn_permlane32_swap(__float_as_uint(pmax), __float_as_uint(pmax), false, false);
    pmax = fmaxf(__uint_as_float(rr[0]), __uint_as_float(rr[1])); }
  if (__builtin_expect(__all(pmax - m_reg <= THR / SCALE), 1)) { mn = m_reg; alpha = 1.f; }
  else { mn = fmaxf(m_reg, pmax); alpha = __builtin_amdgcn_exp2f((m_reg - mn) * C); m_reg = mn; }
  float mnC = -mn * C;
  for (int r = 0; r < 16; ++r) p0[r] = fmaf(p0[r], C, mnC); for (int r = 0; r < 16; ++r) p1[r] = fmaf(p1[r], C, mnC);
  for (int r = 0; r < 16; ++r) p0[r] = __builtin_amdgcn_exp2f(p0[r]);
}
__device__ __forceinline__ void finishSM(f32x16& p0, f32x16& p1, float alpha, float& l_reg, bf16x8& pa0, bf16x8& pa1, bf16x8& pa2, bf16x8& pa3) {
  for (int r = 0; r < 16; ++r) p1[r] = __builtin_amdgcn_exp2f(p1[r]);
  float ps = 0; for (int r = 0; r < 16; ++r) ps += p0[r]; for (int r = 0; r < 16; ++r) ps += p1[r];
  { auto rr = __builtin_amdgcn_permlane32_swap(__float_as_uint(ps), __float_as_uint(ps), false, false);
    ps = __uint_as_float(rr[0]) + __uint_as_float(rr[1]); }
  l_reg = l_reg * alpha + ps;
#define PK4(P, BASE, OUT) do { unsigned a0 = cvtpk(P[BASE + 0], P[BASE + 1]), a1 = cvtpk(P[BASE + 2], P[BASE + 3]);   \
    unsigned b0 = cvtpk(P[BASE + 4], P[BASE + 5]), b1 = cvtpk(P[BASE + 6], P[BASE + 7]);                              \
    auto r0 = __builtin_amdgcn_permlane32_swap(a0, b0, false, false); auto r1 = __builtin_amdgcn_permlane32_swap(a1, b1, false, false); \
    u32x4 w = {r0[0], r1[0], r0[1], r1[1]}; OUT = *reinterpret_cast<bf16x8*>(&w); } while (0)
  PK4(p0, 0, pa0); PK4(p0, 8, pa1); PK4(p1, 0, pa2); PK4(p1, 8, pa3);
#undef PK4
}
__device__ __forceinline__ void qkt(f32x16& p0, f32x16& p1, const bf16_t* Ks, const bf16x8* qr, int r32, int hi) {
  p0 = f32x16{}; p1 = f32x16{};
  for (int d0 = 0; d0 < 8; ++d0) { int cb = (d0 * 16 + hi * 8) * 2;
    bf16x8 b0 = *reinterpret_cast<const bf16x8*>((const char*)Ks + KSWZ(r32, cb));
    bf16x8 b1 = *reinterpret_cast<const bf16x8*>((const char*)Ks + KSWZ(32 + r32, cb));
    p0 = __builtin_amdgcn_mfma_f32_32x32x16_bf16(b0, qr[d0], p0, 0, 0, 0);
    p1 = __builtin_amdgcn_mfma_f32_32x32x16_bf16(b1, qr[d0], p1, 0, 0, 0); }
}
__device__ __forceinline__ int v_st(int k, int c) { const int kk = (k & ~0xC) | ((k & 4) << 1) | ((k & 8) >> 1); return ((kk >> 3) * 4 + (c >> 5)) * 512 + ((kk & 7) * 32 + (c & 31)) * 2; }
__device__ __forceinline__ int v_rd_base(int lane) { return ((lane & 3) << 3) | (((lane >> 2) & 3) << 6) | (((lane >> 4) & 1) << 5) | (((lane >> 5) & 1) << 8); }
constexpr int v_rd_off(int d0, int ks, int half) { return d0 * 512 + ks * 4096 + half * 2048; }
template <int OFF> __device__ __forceinline__ s16x4 tr_read(int vb) {
  s16x4 r; asm volatile("ds_read_b64_tr_b16 %0, %1 offset:%2" : "=&v"(r) : "v"(vb), "i"(OFF) : "memory"); return r;
}
template <int D0> __device__ __forceinline__ void pv_one(f32x16& od, int vb, bf16x8 pa0, bf16x8 pa1, bf16x8 pa2, bf16x8 pa3) {
  const s16x4 l0 = tr_read<v_rd_off(D0, 0, 0)>(vb), h0 = tr_read<v_rd_off(D0, 0, 1)>(vb), l1 = tr_read<v_rd_off(D0, 1, 0)>(vb), h1 = tr_read<v_rd_off(D0, 1, 1)>(vb);
  const s16x4 l2 = tr_read<v_rd_off(D0, 2, 0)>(vb), h2 = tr_read<v_rd_off(D0, 2, 1)>(vb), l3 = tr_read<v_rd_off(D0, 3, 0)>(vb), h3 = tr_read<v_rd_off(D0, 3, 1)>(vb);
  asm volatile("s_waitcnt lgkmcnt(0)" ::: "memory"); SBAR();
#define PK(L, H) (bf16x8){L[0], L[1], L[2], L[3], H[0], H[1], H[2], H[3]}
  od = __builtin_amdgcn_mfma_f32_32x32x16_bf16(pa0, PK(l0, h0), od, 0, 0, 0);
  od = __builtin_amdgcn_mfma_f32_32x32x16_bf16(pa1, PK(l1, h1), od, 0, 0, 0);
  od = __builtin_amdgcn_mfma_f32_32x32x16_bf16(pa2, PK(l2, h2), od, 0, 0, 0);
  od = __builtin_amdgcn_mfma_f32_32x32x16_bf16(pa3, PK(l3, h3), od, 0, 0, 0);
#undef PK
}
__device__ __forceinline__ void pv_d0(f32x16* o, int vb, bf16x8 pa0, bf16x8 pa1, bf16x8 pa2, bf16x8 pa3) {
  pv_one<0>(o[0], vb, pa0, pa1, pa2, pa3); pv_one<1>(o[1], vb, pa0, pa1, pa2, pa3); pv_one<2>(o[2], vb, pa0, pa1, pa2, pa3); pv_one<3>(o[3], vb, pa0, pa1, pa2, pa3);
}
__device__ __forceinline__ void attn_dense_body(const bf16_t* __restrict__ Qb, const bf16_t* __restrict__ Kh, const bf16_t* __restrict__ Vh, bf16_t* __restrict__ Ob, int seq, char* lds) {
  const int tid = threadIdx.x, wid = tid >> 6, lane = tid & 63, r32 = lane & 31, hi = lane >> 5;
  bf16_t* V_lds = (bf16_t*)lds; bf16_t* K_lds = (bf16_t*)(lds + 2 * SHM_V);
  float* ws = (float*)(lds + 2 * SHM_V + 2 * SHM_K) + wid * 64; float* li_l = ws; float* al_l = ws + 32;
  float m_reg = -1e30f, l_reg = 0; f32x16 o[4] = {}; bf16x8 qr[8];
  const bf16_t* Qw = Qb + (long)(wid * QBLK + r32) * LDQ + hi * 8;
#pragma unroll
  for (int d0 = 0; d0 < 8; ++d0) qr[d0] = *reinterpret_cast<const bf16x8*>(Qw + d0 * 16);
  const int sr = tid >> 4, sc = (tid & 15) * 8, vst0 = v_st(sr, sc), vst1 = v_st(32 + sr, sc);
  const int vb0 = (int)(uintptr_t)V_lds + v_rd_base(lane);
  struct { bf16x8 vs0, vs1, ks0, ks1; } sr_[2];
#define SLOAD(i, k0) do { sr_[i].vs0 = *reinterpret_cast<const bf16x8*>(&Vh[(long)((k0) + sr) * LDK + sc]); sr_[i].vs1 = *reinterpret_cast<const bf16x8*>(&Vh[(long)((k0) + 32 + sr) * LDK + sc]); \
    sr_[i].ks0 = *reinterpret_cast<const bf16x8*>(&Kh[(long)((k0) + sr) * LDK + sc]); sr_[i].ks1 = *reinterpret_cast<const bf16x8*>(&Kh[(long)((k0) + 32 + sr) * LDK + sc]); } while (0)
#define SWRITE(b, i) do { *(bf16x8*)((char*)V_lds + (b) * SHM_V + vst0) = sr_[i].vs0;          \
    *(bf16x8*)((char*)V_lds + (b) * SHM_V + vst1) = sr_[i].vs1; int kc = sc * 2;               \
    *(bf16x8*)((char*)K_lds + (b) * SHM_K + KSWZ(sr, kc)) = sr_[i].ks0;                       \
    *(bf16x8*)((char*)K_lds + (b) * SHM_K + KSWZ(32 + sr, kc)) = sr_[i].ks1; } while (0)
#define SWAIT() asm volatile("s_waitcnt vmcnt(4)" ::: "memory")
#define RESC(a) do { if (__any((a) < 1.f)) { if (hi == 0) al_l[r32] = (a); asm volatile("s_waitcnt lgkmcnt(0)" ::: "memory"); \
    for (int d = 0; d < 4; ++d) for (int r = 0; r < 16; ++r) o[d][r] *= al_l[crow(r, hi)]; } } while (0)
  f32x16 pA0, pA1, pB0, pB1; float mnA, mnB, alA, alB; bf16x8 pa0, pa1, pa2, pa3; const int NT = seq / KVBLK;
  constexpr int SE = 0, SO = 1;
  SLOAD(SE, 0); asm volatile("s_waitcnt vmcnt(0)" ::: "memory"); SWRITE(0, SE); __syncthreads();
  qkt(pA0, pA1, K_lds, qr, r32, hi); partialSM(pA0, pA1, m_reg, mnA, alA);
  SLOAD(SO, KVBLK); if (2 < NT) SLOAD(SE, 2 * KVBLK);
  SWAIT(); SWRITE(1, SO); __syncthreads();
  for (int j = 1; j + 1 < NT; j += 2) {
    SBAR(); qkt(pB0, pB1, (bf16_t*)((char*)K_lds + SHM_K), qr, r32, hi);
    finishSM(pA0, pA1, alA, l_reg, pa0, pa1, pa2, pa3); SBAR();
    SLOAD(SO, (j + 2) * KVBLK); SBAR();
    pv_d0(o, vb0, pa0, pa1, pa2, pa3); partialSM(pB0, pB1, m_reg, mnB, alB);
    __syncthreads(); SWAIT(); SWRITE(0, SE);
    RESC(alB); __syncthreads();
    SBAR(); qkt(pA0, pA1, K_lds, qr, r32, hi);
    finishSM(pB0, pB1, alB, l_reg, pa0, pa1, pa2, pa3); SBAR();
    if (j + 3 < NT) SLOAD(SE, (j + 3) * KVBLK); SBAR();
    pv_d0(o, vb0 + (int)SHM_V, pa0, pa1, pa2, pa3); partialSM(pA0, pA1, m_reg, mnA, alA);
    __syncthreads(); SWAIT(); SWRITE(1, SO);
    RESC(alA); __syncthreads();
  }
  SBAR(); qkt(pB0, pB1, (bf16_t*)((char*)K_lds + SHM_K), qr, r32, hi);
  finishSM(pA0, pA1, alA, l_reg, pa0, pa1, pa2, pa3); SBAR();
  pv_d0(o, vb0, pa0, pa1, pa2, pa3); partialSM(pB0, pB1, m_reg, mnB, alB);
  __syncthreads(); RESC(alB);
  finishSM(pB0, pB1, alB, l_reg, pa0, pa1, pa2, pa3); SBAR();
  pv_d0(o, vb0 + (int)SHM_V, pa0, pa1, pa2, pa3);
  if (hi == 0) li_l[r32] = l_reg; asm volatile("s_waitcnt lgkmcnt(0)" ::: "memory");
  float rli[16];
#pragma unroll
  for (int r = 0; r < 16; ++r) rli[r] = __builtin_amdgcn_rcpf(li_l[crow(r, hi)]);
  bf16_t* Ow = Ob + (long)(wid * QBLK) * LDO;
#pragma unroll
  for (int r = 0; r < 16; ++r) { int orow = crow(r, hi);
    for (int d0 = 0; d0 < 4; ++d0) Ow[(long)orow * LDO + d0 * 32 + r32] = f2bf(o[d0][r] * rli[r]); }
#undef SLOAD
#undef SWRITE
#undef SWAIT
#undef RESC
}
#undef KSWZ
#undef SBAR
}

__device__ __forceinline__ void ph_norm1(Frame& F, const float* mod) {
    const int gw = F.vcu * NWAVES + F.wave, NGW = F.G * NWAVES, lane = F.lane;
    bf16_t* H = (bf16_t*)(F.ws + WS_H); const float* nw = F.in[6];
    for (int row = gw; row < NTOK + NCTX; row += NGW) {
        const float* src = row < NTOK ? F.in[0] + (size_t)row * DM : F.in[2] + (size_t)(row - NTOK) * DM;
        const float* mr = mod + (row < NTOK ? row / SEQ : 2) * MODC;
        f32x4 v[8]; float ss = 0.f;
#pragma unroll
        for (int j = 0; j < 8; ++j) { v[j] = *(const GAS f32x4*)(src + (j * 64 + lane) * 4); ss += v[j].x * v[j].x + v[j].y * v[j].y + v[j].z * v[j].z + v[j].w * v[j].w; }
        ss = wave_sum(ss);
        const float rstd = 1.0f / sqrtf(ss * (1.0f / DM) + 1e-6f);
#pragma unroll
        for (int j = 0; j < 8; ++j) { const int i = (j * 64 + lane) * 4;
            const f32x4 w = *(const GAS f32x4*)(nw + i), sc = *(const GAS f32x4*)(mr + DM + i), sh = *(const GAS f32x4*)(mr + i);
            const f32x4 h = v[j] * rstd * w * (sc + 1.0f) + sh;
            unsigned lo = cvt_pk_bf16(h[0], h[1]), hi = cvt_pk_bf16(h[2], h[3]);
            *(GAS unsigned long long*)(H + (size_t)row * DM + i) = (unsigned long long)lo | ((unsigned long long)hi << 32); }
    }
}
__device__ __forceinline__ void ph_qknorm(Frame& F) {
    const int gw = F.vcu * NWAVES + F.wave, NGW = F.G * NWAVES, lane = F.lane;
    const float* QKRAW = (const float*)(F.ws + WS_QKRAW); const float* KCRAW = (const float*)(F.ws + WS_KCRAW);
    bf16_t* Q = (bf16_t*)(F.ws + WS_Q); bf16_t* KALL = (bf16_t*)(F.ws + WS_KALL);
    const int axis = lane >> 5, f = lane & 31, da = axis * 64 + f, db = da + 32;
    const float qwa = F.in[8][da], qwb = F.in[8][db], kwa = F.in[9][da], kwb = F.in[9][db];
    const float inv = exp2f(-(float)f * (13.287712379549449f / 32.0f));
    for (int row = gw; row < NTOK + NCTX; row += NGW) {
        if (row < NTOK) {
            const int b = row / SEQ, t = row % SEQ;
            const float pos = (float)(axis == 0 ? t / 64 : t % 64), ang = pos * inv, cs = cosf(ang), sn = sinf(ang);
            const float* src = QKRAW + (size_t)row * 2560;
#pragma unroll
            for (int hb = 0; hb < 20; hb += 5) {
                float xa[5], xb[5];
#pragma unroll
                for (int q = 0; q < 5; ++q) { xa[q] = src[(hb + q) * HD + da]; xb[q] = src[(hb + q) * HD + db]; }
#pragma unroll
                for (int q = 0; q < 5; ++q) { const int hh = hb + q;
                    const float ss = wave_sum(xa[q] * xa[q] + xb[q] * xb[q]), rstd = 1.0f / sqrtf(ss * (1.0f / HD) + 1e-6f);
                    const float a = xa[q] * rstd * (hh < 16 ? qwa : kwa), bb = xb[q] * rstd * (hh < 16 ? qwb : kwb);
                    bf16_t* dst = hh < 16 ? Q + (size_t)row * DM + hh * HD : KALL + ((size_t)b * SKV + t) * KVW + (hh - 16) * HD;
                    dst[da] = f2bf(a * cs - bb * sn); dst[db] = f2bf(bb * cs + a * sn); }
            }
        } else {
            const int r = row - NTOK, b = r / CTXL, j = r % CTXL; const float* src = KCRAW + (size_t)r * KVW;
#pragma unroll
            for (int hh = 0; hh < 4; ++hh) { const float xa = src[hh * HD + da], xb = src[hh * HD + db];
                const float ss = wave_sum(xa * xa + xb * xb), rstd = 1.0f / sqrtf(ss * (1.0f / HD) + 1e-6f);
                bf16_t* dst = KALL + ((size_t)b * SKV + SEQ + j) * KVW + hh * HD; dst[da] = f2bf(xa * rstd * kwa); dst[db] = f2bf(xb * rstd * kwb); }
        }
    }
}
__device__ __forceinline__ void ph_route(Frame& F, const float* mod) {
    const int lane = F.lane, wv = F.wave;
    LAS float* hrow = (LAS float*)F.lds;
    LAS float* part = (LAS float*)(F.lds + 65536);
    const float* X2 = F.out; const float* nw = F.in[13]; const float* rw = F.in[14]; const float* rb = F.in[15];
    bf16_t* H2 = (bf16_t*)(F.ws + WS_H2); int* EIDX = (int*)(F.ws + WS_EIDX); float* EW = (float*)(F.ws + WS_EW); int* EPOS = (int*)(F.ws + WS_EPOS); int* CNT = (int*)(F.ws + CTL_CNT);
    for (int blk = F.vcu; blk < NTOK / 8; blk += F.G) {
        const int row = blk * 8 + wv;
        { const float* src = X2 + (size_t)row * DM; const float* mr = mod + (row / SEQ) * MODC;
          f32x4 v[8]; float ss = 0.f;
#pragma unroll
          for (int j = 0; j < 8; ++j) { v[j] = *(const GAS f32x4*)(src + (j * 64 + lane) * 4); ss += v[j].x * v[j].x + v[j].y * v[j].y + v[j].z * v[j].z + v[j].w * v[j].w; }
          ss = wave_sum(ss);
          const float rstd = 1.0f / sqrtf(ss * (1.0f / DM) + 1e-6f);
#pragma unroll
          for (int j = 0; j < 8; ++j) { const int i = (j * 64 + lane) * 4;
              const f32x4 w = *(const GAS f32x4*)(nw + i), sc = *(const GAS f32x4*)(mr + 4 * DM + i), sh = *(const GAS f32x4*)(mr + 3 * DM + i);
              const f32x4 h = v[j] * rstd * w * (sc + 1.0f) + sh;
              *(LAS f32x4*)(hrow + wv * DM + i) = h;
              unsigned lo = cvt_pk_bf16(h[0], h[1]), hi = cvt_pk_bf16(h[2], h[3]);
              *(GAS unsigned long long*)(H2 + (size_t)row * DM + i) = (unsigned long long)lo | ((unsigned long long)hi << 32); } }
        __syncthreads();
        { float a[8];
#pragma unroll
          for (int r = 0; r < 8; ++r) a[r] = 0.f;
          const int k0 = wv * 256;
#pragma unroll 4
          for (int k = 0; k < 256; ++k) { const float w = rw[(size_t)(k0 + k) * NE + lane];
#pragma unroll
              for (int r = 0; r < 8; ++r) a[r] += hrow[r * DM + k0 + k] * w; }
#pragma unroll
          for (int r = 0; r < 8; ++r) part[(wv * 8 + r) * 64 + lane] = a[r]; }
        __syncthreads();
        { float logit = 0.f;
#pragma unroll
          for (int w = 0; w < 8; ++w) logit += part[(w * 8 + wv) * 64 + lane];
          const float score = 1.0f / (1.0f + expf(-logit)), bsd = score + rb[lane];
          const int g = lane >> 3;
          int rk = 0;
#pragma unroll
          for (int i = 0; i < 8; ++i) { const int o = (lane & ~7) + i; const float vv = __shfl(bsd, o); rk += (vv > bsd) || (vv == bsd && o < lane); }
          float gs = rk < 2 ? bsd : 0.f;
          gs += __shfl_xor(gs, 1); gs += __shfl_xor(gs, 2); gs += __shfl_xor(gs, 4);
          int grk = 0;
#pragma unroll
          for (int gg = 0; gg < 8; ++gg) { const float vv = __shfl(gs, gg * 8); grk += (vv > gs) || (vv == gs && gg < g); }
          const bool gsel = grk < 4;
          const float mb = gsel ? bsd : -INFINITY;
          int erk = 0;
          for (int o = 0; o < 64; ++o) { const float vv = __shfl(mb, o); erk += (vv > mb) || (vv == mb && o < lane); }
          const bool sel = gsel && erk < TOPK;
          const float ssum = wave_sum(sel ? score : 0.f);
          if (sel) { const int pos = atomicAdd(&CNT[lane], 1); EIDX[row * TOPK + erk] = lane; EW[row * TOPK + erk] = score / ssum * 2.5f; EPOS[row * TOPK + erk] = pos; } }
        __syncthreads();
    }
}
__device__ __forceinline__ void ph_fill(Frame& F) {
    moe_tables(F, 4);
    LAS int* T = (LAS int*)(F.lds + SCHT_OFF);
    const int* EIDX = (const int*)(F.ws + WS_EIDX); const int* EPOS = (const int*)(F.ws + WS_EPOS); int* TOK = (int*)(F.ws + WS_TOK); int* SLOTOF = (int*)(F.ws + WS_SLOTOF);
    for (int i = F.vcu * NTHREADS + F.tid; i < NSLOT; i += F.G * NTHREADS) { const int slot = T[80 + EIDX[i]] + EPOS[i]; TOK[slot] = i / TOPK; SLOTOF[i] = slot; if (i < NTOK) TOK[NSLOT + i] = i; }
}
__device__ __forceinline__ void ph_comb(Frame& F, const float* mod) {
    const int gw = F.vcu * NWAVES + F.wave, NGW = F.G * NWAVES, lane = F.lane;
    const float* EW = (const float*)(F.ws + WS_EW); const int* SLOTOF = (const int*)(F.ws + WS_SLOTOF); const bf16_t* Y = (const bf16_t*)(F.ws + WS_YBIG);
    for (int t = gw; t < NTOK; t += NGW) {
        const float* g2 = mod + (t / SEQ) * MODC + 5 * DM;
        int sl[TOPK]; float wk[TOPK];
#pragma unroll
        for (int k = 0; k < TOPK; ++k) { sl[k] = SLOTOF[t * TOPK + k]; wk[k] = EW[t * TOPK + k]; }
#pragma unroll
        for (int j = 0; j < 4; ++j) { const int col = j * 512 + lane * 8;
            float a[8]; unpack8(*(const GAS u32x4*)(Y + (size_t)(NSLOT + t) * DM + col), a);
#pragma unroll
            for (int k = 0; k < TOPK; ++k) { float y[8]; unpack8(*(const GAS u32x4*)(Y + (size_t)sl[k] * DM + col), y);
#pragma unroll
                for (int c = 0; c < 8; ++c) a[c] += wk[k] * y[c]; }
            float* o = F.out + (size_t)t * DM + col;
#pragma unroll
            for (int n = 0; n < 2; ++n) { const f32x4 xv = *(const GAS f32x4*)(o + 4 * n), gv = *(const GAS f32x4*)(g2 + col + 4 * n);
                *(GAS f32x4*)(o + 4 * n) = xv + gv * (f32x4){a[4 * n], a[4 * n + 1], a[4 * n + 2], a[4 * n + 3]}; } }
    }
}

enum { PH_PRO = 0, PH_NORM1, PH_INPROJ, PH_QKNORM, PH_ATTN, PH_F2, PH_MERGE, PH_OUT, PH_ROUTE, PH_FILL, PH_EXP1, PH_EXP2, PH_COMB, PH_END };

struct Args { const float* in[22]; float* out; unsigned char* ws; int ph_lo, ph_hi, use_ut, mod_off, do_attn, pad; };

__global__ void __launch_bounds__(NTHREADS, 2) fwd(Args args) {
    extern __shared__ __attribute__((aligned(16))) unsigned char lds_raw[];
    Frame F;
    F.lds = (LAS unsigned char*)lds_raw; F.MISC = (volatile LAS unsigned*)(F.lds + MISC_OFF); F.ws = args.ws;
    F.tid = threadIdx.x; F.lane = F.tid & 63; F.wave = __builtin_amdgcn_readfirstlane(F.tid >> 6);
    F.G = gridDim.x; { const int bx = blockIdx.x; F.vcu = (F.G % 8 == 0) ? (bx % 8) * (F.G / 8) + bx / 8 : bx; }
#pragma unroll
    for (int i = 0; i < 22; ++i) F.in[i] = args.in[i];
    F.out = args.out;
    for (int u = F.tid; u < (LDS_BYTES - LDSCTL_OFF) / 4; u += NTHREADS) ((LAS unsigned*)(F.lds + LDSCTL_OFF))[u] = 0u;
    __syncthreads();
    const int lo = args.ph_lo, hi = args.ph_hi;
    const bool multi = (hi - lo) > 1;
    XcdBarrier bar; bar.bar = (unsigned*)(args.ws + CTL_BAR); bar.x = 0; bar.st = nullptr;
    if (multi) bar = xcd_barrier_post((unsigned*)(args.ws + CTL_BAR), F.MISC + 8);
#define IN(k) (lo <= (k) && (k) < hi)
#define SEAM(k) do { if (IN((k) + 1)) xcd_barrier(bar); } while (0)

    const float* modp = (const float*)(args.ws + args.mod_off);
    if (IN(PH_PRO)) { p0_prologue(F); SEAM(PH_PRO); }
    if (IN(PH_NORM1)) { ph_norm1(F, modp); SEAM(PH_NORM1); }
    if (IN(PH_INPROJ)) {
        SchedIn S{F.G, (int)blockIdx.x, args.ws, args.use_ut};
        gemm_phase<EpiStore, SchedIn, false>(F.lds, DM, DM, DM, S, EpiStore{});
        SEAM(PH_INPROJ);
    }
    if (IN(PH_QKNORM)) { ph_qknorm(F); SEAM(PH_QKNORM); }
    if (IN(PH_ATTN)) {
        if (args.do_attn) {
            const bf16_t* Qp = (const bf16_t*)(args.ws + WS_Q); const bf16_t* Kp = (const bf16_t*)(args.ws + WS_KALL); const bf16_t* Vp = (const bf16_t*)(args.ws + WS_VALL); bf16_t* Op = (bf16_t*)(args.ws + WS_YA);
            for (int lin = F.vcu; lin < 512; lin += F.G) {
                const int x = (lin >> 5) & 7, j = (lin & 31) + 32 * (lin >> 8), b = x >> 2, kvh = x & 3, head = kvh * 4 + (j >> 4), qb = j & 15;
                const size_t qo = ((size_t)(b * SEQ + qb * 256)) * DM + head * HD, ko = (size_t)b * SKV * KVW + kvh * HD;
                attn::attn_dense_body(Qp + qo, Kp + ko, Vp + ko, Op + qo, SKV, (char*)lds_raw);
                __syncthreads();
            }
        }
        SchedF1 S{F.G, (int)blockIdx.x, args.ws};
        gemm_phase<EpiStore, SchedF1, false>(F.lds, SEQ, SEQ, SEQ, S, EpiStore{});
        SEAM(PH_ATTN);
    }
    if (IN(PH_F2)) {
        SchedF2 S{F.G, (int)blockIdx.x, args.ws};
        gemm_phase<EpiStore, SchedF2, false>(F.lds, 512, DM, 512, S, EpiStore{});
        SEAM(PH_F2);
    }
    if (IN(PH_MERGE)) {
        unsigned char* ws = args.ws;
        { SchedGrid S{F.G, (int)blockIdx.x, 32, 8, (const char*)(ws + WS_YF), (const char*)(ws + WS_WT_FO), nullptr, (size_t)256 * FW * 2, (size_t)256 * FW * 2, DM, 4, 1};
          gemm_phase<EpiT1, SchedGrid, false>(F.lds, FW, FW, FW, S, EpiT1{(const bf16_t*)(ws + WS_SGF), (float*)(ws + WS_T1)}); }
        { SchedGrid S{F.G, (int)blockIdx.x, 32, 8, (const char*)(ws + WS_YA), (const char*)(ws + WS_WT_AO), nullptr, (size_t)256 * DM * 2, (size_t)256 * DM * 2, DM, 2, 0};
          gemm_phase<EpiYM, SchedGrid, false>(F.lds, DM, DM, DM, S, EpiYM{(const bf16_t*)(ws + WS_SGA), (const float*)(ws + WS_T1), (bf16_t*)(ws + WS_YM)}); }
        SEAM(PH_MERGE);
    }
    if (IN(PH_OUT)) {
        unsigned char* ws = args.ws;
        SchedGrid S{F.G, (int)blockIdx.x, 32, 8, (const char*)(ws + WS_YM), (const char*)(ws + WS_WT_O), nullptr, (size_t)256 * DM * 2, (size_t)256 * DM * 2, DM, 4, 1};
        gemm_phase<EpiX2, SchedGrid, false>(F.lds, DM, DM, DM, S, EpiX2{F.in[0], modp, F.out});
        SEAM(PH_OUT);
    }
    if (IN(PH_ROUTE)) { ph_route(F, modp); SEAM(PH_ROUTE); }
    if (IN(PH_FILL)) { ph_fill(F); SEAM(PH_FILL); }
    if (IN(PH_EXP1)) {
        moe_tables(F, 4);
        SchedMoe<4, true> S{F.G, F.vcu, args.ws, (LAS int*)(F.lds + SCHT_OFF), (const int*)(args.ws + WS_TOK)};
        gemm_phase<EpiAct, SchedMoe<4, true>, true>(F.lds, DM, DM, DM, S, EpiAct{});
        SEAM(PH_EXP1);
    }
    if (IN(PH_EXP2)) {
        moe_tables(F, 8);
        SchedMoe<8, false> S{F.G, F.vcu, args.ws, (LAS int*)(F.lds + SCHT_OFF), (const int*)(args.ws + WS_TOK)};
        gemm_phase<EpiStore, SchedMoe<8, false>, false>(F.lds, EFF, EFF, EFF, S, EpiStore{});
        SEAM(PH_EXP2);
    }
    if (IN(PH_COMB)) { ph_comb(F, modp); }
#undef IN
#undef SEAM
}
}

extern "C" void kernel_launch(void* const* d_in, const int* in_sizes, int n_in, void* d_out, int out_size, void* d_ws, size_t ws_size, hipStream_t stream) {
    if (n_in != 22 || ws_size < WS_END2) return;
    const float* x = (const float*)d_in[0]; const float* c = (const float*)d_in[1]; const float* ctx = (const float*)d_in[2]; const float* c_ctx = (const float*)d_in[3];
    const float* mod_w = (const float*)d_in[4]; const float* mod_b = (const float*)d_in[5]; const float* norm1_w = (const float*)d_in[6]; const float* w_in = (const float*)d_in[7];
    const float* qnw = (const float*)d_in[8]; const float* knw = (const float*)d_in[9]; const float* w_fo = (const float*)d_in[10]; const float* w_ao = (const float*)d_in[11];
    const float* w_o = (const float*)d_in[12]; const float* norm2_w = (const float*)d_in[13]; const float* router_w = (const float*)d_in[14]; const float* router_b = (const float*)d_in[15];
    const float* exp_gate = (const float*)d_in[16]; const float* exp_up = (const float*)d_in[17]; const float* exp_down = (const float*)d_in[18];
    const float* sh_gate = (const float*)d_in[19]; const float* sh_up = (const float*)d_in[20]; const float* sh_down = (const float*)d_in[21];
    float* out = (float*)d_out;
    unsigned char* ws = (unsigned char*)d_ws;
    int* CNT = (int*)(ws + CTL_CNT); float* TW = (float*)(ws + WS_TW); float* MOD = (float*)(ws + WS_MOD); int* OFFS = (int*)(ws + WS_OFFS);
    int* EIDX = (int*)(ws + WS_EIDX); float* EW = (float*)(ws + WS_EW); int* EPOS = (int*)(ws + WS_EPOS); int* SLOTOF = (int*)(ws + WS_SLOTOF); int* TOK = (int*)(ws + WS_TOK);
    bf16_t* H = (bf16_t*)(ws + WS_H); bf16_t* U = (bf16_t*)(ws + WS_U); bf16_t* Q = (bf16_t*)(ws + WS_Q); bf16_t* KALL = (bf16_t*)(ws + WS_KALL); bf16_t* VALL = (bf16_t*)(ws + WS_VALL);
    bf16_t* SGF = (bf16_t*)(ws + WS_SGF); bf16_t* SGA = (bf16_t*)(ws + WS_SGA); bf16_t* YA = (bf16_t*)(ws + WS_YA); bf16_t* YF = (bf16_t*)(ws + WS_YF); bf16_t* PR = (bf16_t*)(ws + WS_PR);
    float* T1 = (float*)(ws + WS_T1); bf16_t* YM = (bf16_t*)(ws + WS_YM); float* QKRAW = (float*)(ws + WS_QKRAW); float* KCRAW = (float*)(ws + WS_KCRAW);
    bf16_t* H2 = (bf16_t*)(ws + WS_H2); bf16_t* ACT = (bf16_t*)(ws + WS_ACT); bf16_t* YBIG = (bf16_t*)(ws + WS_YBIG);

    hipMemsetAsync(ws + WS_CTL, 0, CTL_ZERO_BYTES, stream);
    static int grid = 0;
    if (!grid) {
        int dev = 0, cus = 0;
        if (hipGetDevice(&dev) != hipSuccess || hipDeviceGetAttribute(&cus, hipDeviceAttributeMultiprocessorCount, dev) != hipSuccess) { grid = -1; return; }
        if (hipFuncSetAttribute((const void*)mk::fwd, hipFuncAttributeMaxDynamicSharedMemorySize, mk::LDS_BYTES) != hipSuccess) { grid = -1; return; }
        grid = cus;
    }
    if (grid < 0) return;
    mk::Args a{};
    for (int i = 0; i < 22; ++i) a.in[i] = (const float*)d_in[i];
    a.out = out; a.ws = ws; a.use_ut = 1; a.mod_off = (int)WS_MOD; a.do_attn = 1;
#define MK_LAUNCH(lo_, hi_) do { a.ph_lo = (lo_); a.ph_hi = (hi_); hipLaunchKernelGGL(mk::fwd, dim3(grid), dim3(mk::NTHREADS), mk::LDS_BYTES, stream, a); } while (0)
    MK_LAUNCH(mk::PH_PRO, mk::PH_END);
}
```

```cpp
#include <hip/hip_runtime.h>
#include <stdint.h>
#include <math.h>

typedef unsigned short bf16_t;
typedef short bf16x8 __attribute__((ext_vector_type(8)));
typedef float f32x16 __attribute__((ext_vector_type(16)));
typedef float f32x4 __attribute__((ext_vector_type(4)));

constexpr int NB = 2, SEQ = 4096, DM = 2048, NTOK = NB * SEQ, CTXL = 256, NCTX = NB * CTXL, HD = 128, NH = 16, NKV = 4;
constexpr int SKV = SEQ + CTXL;
constexpr int FW = 1024, INC = 8192, Q_OFF = 1024, K_OFF = 3072, V_OFF = 3584, GF_OFF = 4096, GA_OFF = 6144;
constexpr int KVW = NKV * HD;
constexpr int NE = 64, TOPK = 8, EFF = 512, MODC = 6 * DM;
constexpr int NSLOT = NTOK * TOPK;
constexpr int NSLOT_ALL = NSLOT + NTOK;

constexpr size_t MiB = 1u << 20;
constexpr size_t WS_CTL = 0, CTL_ZERO_BYTES = 1 * MiB;
constexpr size_t CTL_CNT = 64 * 1024;
constexpr size_t WS_TW = 1 * MiB;
constexpr size_t WS_MOD = 1 * MiB + 64 * 1024;
constexpr size_t WS_OFFS = 1 * MiB + 256 * 1024;
constexpr size_t WS_EIDX = 2 * MiB;
constexpr size_t WS_EW = WS_EIDX + 256 * 1024;
constexpr size_t WS_EPOS = WS_EW + 256 * 1024;
constexpr size_t WS_SLOTOF = WS_EPOS + 256 * 1024;
constexpr size_t WS_TOK = 3 * MiB;
constexpr size_t WS_H = 4 * MiB;
constexpr size_t WS_U = 38 * MiB;
constexpr size_t WS_Q = 54 * MiB;
constexpr size_t WS_KALL = 86 * MiB;
constexpr size_t WS_VALL = 95 * MiB;
constexpr size_t WS_SGF = 104 * MiB;
constexpr size_t WS_SGA = 136 * MiB;
constexpr size_t WS_YA = 168 * MiB;
constexpr size_t WS_YF = 200 * MiB;
constexpr size_t WS_PR = 216 * MiB;
constexpr size_t WS_T1 = 248 * MiB;
constexpr size_t WS_YM = 312 * MiB;
constexpr size_t WS_QKRAW = 248 * MiB;
constexpr size_t WS_KCRAW = 330 * MiB;
constexpr size_t WS_H2 = 344 * MiB;
constexpr size_t WS_ACT = 376 * MiB;
constexpr size_t WS_YBIG = 4 * MiB;
constexpr size_t WS_END = 740 * MiB;

__device__ __forceinline__ float bf2f(bf16_t h) { return __uint_as_float(((unsigned)h) << 16); }
__device__ __forceinline__ bf16_t f2bf(float f) { unsigned u = __float_as_uint(f); return (bf16_t)((u + 0x7fffu + ((u >> 16) & 1u)) >> 16); }
__device__ __forceinline__ int crow(int r, int hi) { return (r & 3) + 8 * (r >> 2) + 4 * hi; }
__device__ __forceinline__ float wave_sum(float v) {
#pragma unroll
    for (int o = 1; o < 64; o <<= 1) v += __shfl_xor(v, o);
    return v;
}
__device__ __forceinline__ float sigmoidf_(float v) { return 1.0f / (1.0f + expf(-v)); }
__device__ __forceinline__ bf16x8 pack8(const float* f) {
    bf16x8 r;
#pragma unroll
    for (int i = 0; i < 8; ++i) r[i] = (short)f2bf(f[i]);
    return r;
}

#define LAS __attribute__((address_space(3)))
#define GAS __attribute__((address_space(1)))
typedef unsigned u32x4 __attribute__((ext_vector_type(4)));
typedef GAS unsigned gu32;
#define RLX_AGENT __ATOMIC_RELAXED, __HIP_MEMORY_SCOPE_AGENT
#define LDS_WAIT() asm volatile("s_waitcnt lgkmcnt(0)" ::: "memory")
#define VM_WAIT() asm volatile("s_waitcnt vmcnt(0)" ::: "memory")

constexpr size_t CTL_BAR = 16384;
constexpr size_t CTL_MODZ = 512 * 1024;
constexpr size_t WS_UT = 38 * MiB;
constexpr size_t WS_TT = 216 * MiB;
constexpr size_t WS_WT_GU = 450 * MiB;
constexpr size_t WS_WT_D = 710 * MiB;
constexpr size_t WS_WT_IN = 840 * MiB;
constexpr size_t WS_WT_FO = 872 * MiB;
constexpr size_t WS_WT_AO = 876 * MiB;
constexpr size_t WS_WT_O = 884 * MiB;
constexpr size_t WS_CST = 892 * MiB;
constexpr size_t WS_BD2 = 956 * MiB;
constexpr size_t WS_END2 = 960 * MiB;

namespace mk {
constexpr int NWAVES = 8, NTHREADS = 512;
constexpr int RING_BYTES = 131072, SCR_BYTES = 8 * 16640, LDSCTL_OFF = 135168, MISC_OFF = LDSCTL_OFF + 320, GPARK_OFF = LDSCTL_OFF + 2048  , LDS_BYTES = 147456;
static_assert(GPARK_OFF + 8192 <= LDS_BYTES, "LDS map");
static_assert(SCR_BYTES <= LDSCTL_OFF && MISC_OFF + 128 <= LDS_BYTES, "LDS map");

#define XB_TMO      128
#define XB_XCNT(j)  (256  + 64 * (j))
#define XB_XSUB(j)  (1280 + 64 * (j))
#define XB_XGEN(j)  (2304 + 64 * (j))
#define XB_TOP      3328
#define XB_TOPGEN   3392
#define XCD_BAR_WORDS 3456
#define XB_SPIN_CAP (1u << 18)
__device__ __forceinline__ unsigned xb_ld(unsigned* p)              { return __hip_atomic_load(p, __ATOMIC_RELAXED, __HIP_MEMORY_SCOPE_AGENT); }
__device__ __forceinline__ unsigned xb_add(unsigned* p, unsigned v) { return __hip_atomic_fetch_add(p, v, __ATOMIC_RELAXED, __HIP_MEMORY_SCOPE_AGENT); }
__device__ __forceinline__ unsigned xb_xcc_id() { return (unsigned)__builtin_amdgcn_s_getreg((3 << 11) | 20) & 0xFu; }
#define XB_SPIN(cond, bar) do { unsigned _sp = 0; while (cond) { __builtin_amdgcn_s_sleep(1); \
    if ((++_sp & 255u) == 0u) { if (xb_ld(&(bar)[XB_TMO])) break; if (_sp > XB_SPIN_CAP) { atomicAdd(&(bar)[XB_TMO], 1u); break; } } } } while (0)
struct XcdBarrier { unsigned* bar; unsigned x; volatile LAS unsigned* st; };
__device__ __forceinline__ XcdBarrier xcd_barrier_post(unsigned* bar, volatile LAS unsigned* st) {
    XcdBarrier b; b.bar = bar; b.x = xb_xcc_id(); b.st = st;
    if (threadIdx.x == 0) (void)xb_add(&bar[XB_XCNT(b.x)], 1u);
    return b;
}
__device__ __forceinline__ void xcd_barrier_complete(unsigned* bar, unsigned x, unsigned& nloc, unsigned& nx) {
    const unsigned G = gridDim.x * gridDim.y * gridDim.z;
    unsigned sum, cnt, mine, sp = 0u;
    for (;;) {
        sum = 0u; cnt = 0u; mine = 0u;
#pragma unroll
        for (unsigned j = 0; j < 16; ++j) { const unsigned c = xb_ld(&bar[XB_XCNT(j)]); sum += c; cnt += (c > 0u) ? 1u : 0u; mine = (j == x) ? c : mine; }
        if (sum == G) break;
        __builtin_amdgcn_s_sleep(1);
        if ((++sp & 255u) == 0u) { if (xb_ld(&bar[XB_TMO])) break; if (sp > XB_SPIN_CAP) { atomicAdd(&bar[XB_TMO], 1u); break; } }
    }
    nloc = mine > 0u ? mine : 1u; nx = cnt > 0u ? cnt : 1u;
}
__device__ __forceinline__ void xcd_barrier(const XcdBarrier& b) {
    asm volatile("s_waitcnt vmcnt(0)" ::: "memory");
    __syncthreads();
    if (threadIdx.x == 0) {
        unsigned* bar = b.bar;
        __builtin_amdgcn_s_waitcnt(0);
        unsigned nloc = b.st[0], nx = b.st[1];
        if (nloc == 0u) { xcd_barrier_complete(bar, b.x, nloc, nx); b.st[0] = nloc; b.st[1] = nx; }
        const unsigned old = xb_add(&bar[XB_XSUB(b.x)], 1u);
        const unsigned gen = old / nloc;
        if (old + 1u == (gen + 1u) * nloc) {
            __builtin_amdgcn_fence(__ATOMIC_RELEASE, "agent");
            asm volatile("s_waitcnt vmcnt(0)" ::: "memory");
            const unsigned og = xb_add(&bar[XB_TOP], 1u);
            const unsigned tg = og / nx;
            if (og + 1u == (tg + 1u) * nx) xb_add(&bar[XB_TOPGEN], 1u);
            else XB_SPIN(xb_ld(&bar[XB_TOPGEN]) == tg, bar);
            __builtin_amdgcn_fence(__ATOMIC_ACQUIRE, "agent");
            xb_add(&bar[XB_XGEN(b.x)], 1u);
            asm volatile("s_waitcnt vmcnt(0)" ::: "memory");
        } else {
            XB_SPIN(xb_ld(&bar[XB_XGEN(b.x)]) == gen, bar);
            __builtin_amdgcn_fence(__ATOMIC_ACQUIRE, "agent");
            asm volatile("s_waitcnt vmcnt(0)" ::: "memory");
        }
    }
    __syncthreads();
}

constexpr int BM = 256, BK = 64, HALF = 128, HTB = HALF * BK * 2, STAGE_BYTES = 8 * HTB;
__device__ __forceinline__ int lds_byte(int r, int c) { const int st = (r >> 4) * 2 + (c >> 5), rr = r & 15, cc = c & 31, ob = rr * 64 + cc * 2; return st * 1024 + (ob ^ (((ob >> 9) & 1) << 5)); }
__device__ __forceinline__ void stage_rc(int b, int& R, int& C) { const int st = b / 1024, sb = b % 1024, swz = sb ^ (((sb >> 9) & 1) << 5); R = (st >> 1) * 16 + swz / 64; C = (st & 1) * 32 + (swz % 64) / 2; }
__device__ __forceinline__ int perm32(int rho) { const int n = rho >> 4, i = rho & 15; return 8 * (i >> 2) + 4 * n + (i & 3); }
__device__ __forceinline__ unsigned cvt_pk_bf16(float lo, float hi) { unsigned r; asm volatile("v_cvt_pk_bf16_f32 %0, %1, %2" : "=v"(r) : "v"(lo), "v"(hi)); return r; }

__device__ __forceinline__ void glds16_s(const void* sbase, unsigned voff, unsigned lds_dst) { unsigned keep;
    asm volatile("s_mov_b32 %0, m0\n\ts_mov_b32 m0, %3\n\ts_nop 0\n\tglobal_load_lds_dwordx4 %1, %2\n\ts_mov_b32 m0, %0" : "=&s"(keep) : "v"(voff), "s"(sbase), "s"(lds_dst) : "memory"); }

struct Unit { const char* A; const char* B; char* C; int ldc; int mode; int rows; int aux; int pm, pn, bjs; };

template <class Epi, class Sched, bool GATHER>
__device__ __forceinline__ void gemm_phase(LAS unsigned char* lds, const int K, const int lda, const int ldb, const Sched& S, const Epi& E) {
    const int tid = threadIdx.x, wid = __builtin_amdgcn_readfirstlane(tid >> 6), lane = tid & 63, wr = wid >> 2, wc = wid & 3, fr = lane & 15, fq = lane >> 4;
    const int nt = K / BK;
    unsigned voffA[2], voffB[2];
#pragma unroll
    for (int i = 0; i < 2; ++i) { int R, C; stage_rc(tid * 16 + i * 8192, R, C); const int Rb = (R & ~31) + perm32(R & 31);
        voffA[i] = (unsigned)(R * lda + C) * 2u; voffB[i] = (unsigned)(Rb * ldb + C) * 2u; }
    const size_t kstep = (size_t)(BK * 2);
    const size_t hstepA = (size_t)HALF * lda * 2, hstepB = (size_t)HALF * ldb * 2;
    const unsigned ldsw = (unsigned)wid * 1024u;
    const unsigned ldsbase = (unsigned)__builtin_amdgcn_readfirstlane((int)(unsigned)(uintptr_t)lds);
    const int aoff = lds_byte(wr * 64 + fr, fq * 8), boff = lds_byte(wc * 32 + fr, fq * 8);
#define MK_SA(b, h) (((b) * 2 + (h)) * HTB)
#define MK_SB(b, h) ((4 + (b) * 2 + (h)) * HTB)
#define MK_STAGE2(bufoff, gbase, v0, v1) do { \
        __builtin_amdgcn_global_load_lds((const unsigned*)((const char*)(gbase) + (v0)), (LAS unsigned*)(lds + (bufoff) + ldsw), 16, 0, 0); \
        __builtin_amdgcn_global_load_lds((const unsigned*)((const char*)(gbase) + (v1)), (LAS unsigned*)(lds + (bufoff) + ldsw + 8192), 16, 0, 0); } while (0)
#define MK_STAGE_B(bufoff, gbase) do { if constexpr (GATHER) { glds16_s((gbase), voffB[0], ldsbase + (bufoff) + ldsw); glds16_s((gbase), voffB[1], ldsbase + (bufoff) + ldsw + 8192u); } else MK_STAGE2(bufoff, gbase, voffB[0], voffB[1]); } while (0)
#define MK_STAGE_A(bufoff, gbase, h, VA) do { if constexpr (GATHER) { glds16_s((gbase), (VA)[h][0], ldsbase + (bufoff) + ldsw); glds16_s((gbase), (VA)[h][1], ldsbase + (bufoff) + ldsw + 8192u); } else MK_STAGE2(bufoff, (gbase) + (h) * hstepA, voffA[0], voffA[1]); } while (0)
#define MK_LDA(dst, b, h) do { _Pragma("unroll") for (int m = 0; m < 4; ++m) _Pragma("unroll") for (int k = 0; k < 2; ++k) dst[m][k] = *(const LAS bf16x8*)(lds + MK_SA(b, h) + aoff + m * 2048 + k * 1024); } while (0)
#define MK_LDB(dst, b, h) do { _Pragma("unroll") for (int n = 0; n < 2; ++n) _Pragma("unroll") for (int k = 0; k < 2; ++k) dst[n][k] = *(const LAS bf16x8*)(lds + MK_SB(b, h) + boff + n * 2048 + k * 1024); } while (0)
#define MK_MMA(ai, bj, At, Bt) do { __builtin_amdgcn_s_setprio(1); _Pragma("unroll") for (int m = 0; m < 4; ++m) _Pragma("unroll") for (int n = 0; n < 2; ++n) _Pragma("unroll") for (int k = 0; k < 2; ++k) \
        acc[ai][bj][m][n] = __builtin_amdgcn_mfma_f32_16x16x32_bf16(Bt[n][k], At[m][k], acc[ai][bj][m][n], 0, 0, 0); __builtin_amdgcn_s_setprio(0); } while (0)
#define MK_WAIT_V(n) asm volatile("s_waitcnt vmcnt(" #n ")" ::: "memory")
#define MK_WAIT_L(n) asm volatile("s_waitcnt lgkmcnt(" #n ")" ::: "memory")
#define MK_BAR __builtin_amdgcn_s_barrier()
#define MK_SCHED __builtin_amdgcn_sched_barrier(0)
    Unit cur, nxt; int ui = 0;
    if (!S.next(0, cur)) return;
    f32x4 acc[2][2][4][2];
#pragma unroll
    for (int a = 0; a < 2; ++a)
#pragma unroll
        for (int b = 0; b < 2; ++b)
#pragma unroll
            for (int m = 0; m < 4; ++m)
#pragma unroll
                for (int n = 0; n < 2; ++n) acc[a][b][m][n] = (f32x4){0.f, 0.f, 0.f, 0.f};
    bf16x8 At[4][2], B0[2][2], B1[2][2];
    unsigned vC[2][2];
    LAS u32x4* vpark = (LAS u32x4*)(lds + GPARK_OFF) + tid;
    if constexpr (GATHER) {
#pragma unroll
        for (int h = 0; h < 2; ++h)
#pragma unroll
            for (int i = 0; i < 2; ++i) { int R, C; stage_rc(tid * 16 + i * 8192, R, C); vC[h][i] = S.arow(cur, h * HALF + R) + (unsigned)(C * 2); }
    }
    const char* cA = cur.A; const char* cB = cur.B;
    MK_STAGE_B(MK_SB(0, 0), cB); MK_STAGE_B(MK_SB(0, 1), cB + hstepB); MK_STAGE_A(MK_SA(0, 0), cA, 0, vC); MK_STAGE_A(MK_SA(0, 1), cA, 1, vC);
    if (wr == 1) MK_BAR;
    MK_WAIT_V(2); MK_BAR;
    MK_STAGE_B(MK_SB(1, 0), cB + kstep); MK_STAGE_A(MK_SA(1, 0), cA + kstep, 0, vC); MK_STAGE_B(MK_SB(1, 1), cB + hstepB + kstep);
    MK_WAIT_V(6); MK_BAR;
    for (;;) {
        const bool has_next = S.next(ui + 1, nxt);
        const char* nA = has_next ? nxt.A : cA; const char* nB = has_next ? nxt.B : cB;
        if constexpr (GATHER) {
            u32x4 pv;
#pragma unroll
            for (int h = 0; h < 2; ++h)
#pragma unroll
                for (int i = 0; i < 2; ++i) { int R, C; stage_rc(tid * 16 + i * 8192, R, C); pv[h * 2 + i] = has_next ? (S.arow(nxt, h * HALF + R) + (unsigned)(C * 2)) : vC[h][i]; }
            *vpark = pv;
        }
        for (int t = 0; t < nt; t += 2) {
            const bool last = (t == nt - 2);
            const char* a1 = cA + (size_t)(t + 1) * kstep;
            const char* a2 = last ? nA : cA + (size_t)(t + 2) * kstep; const char* b2 = last ? nB : cB + (size_t)(t + 2) * kstep;
            const char* a3 = a2 + kstep; const char* b3 = b2 + kstep;
            MK_LDB(B0, 0, 0); MK_LDB(B1, 0, 1); MK_SCHED; MK_LDA(At, 0, 0); MK_STAGE_A(MK_SA(1, 1), a1, 1, vC);
            if constexpr (GATHER) { if (last) { const u32x4 pv = *vpark; vC[0][0] = pv[0]; vC[0][1] = pv[1]; vC[1][0] = pv[2]; vC[1][1] = pv[3]; } }
            MK_WAIT_V(8); MK_WAIT_L(0); MK_BAR; MK_MMA(0, 0, At, B0); MK_MMA(0, 1, At, B1); MK_BAR; MK_SCHED;
            MK_LDA(At, 0, 1); MK_STAGE_B(MK_SB(0, 0), b2); MK_STAGE_B(MK_SB(0, 1), b2 + hstepB); MK_STAGE_A(MK_SA(0, 0), a2, 0, vC);
            MK_WAIT_V(8); MK_WAIT_L(0); MK_BAR; MK_MMA(1, 0, At, B0); MK_MMA(1, 1, At, B1); MK_BAR; MK_SCHED;
            MK_LDB(B0, 1, 0); MK_LDB(B1, 1, 1); MK_SCHED; MK_LDA(At, 1, 0); MK_STAGE_A(MK_SA(0, 1), a2, 1, vC);
            MK_WAIT_V(8); MK_WAIT_L(0); MK_BAR; MK_MMA(0, 0, At, B0); MK_MMA(0, 1, At, B1); MK_BAR; MK_SCHED;
            MK_LDA(At, 1, 1); MK_STAGE_B(MK_SB(1, 0), b3); MK_STAGE_B(MK_SB(1, 1), b3 + hstepB); MK_STAGE_A(MK_SA(1, 0), a3, 0, vC);
            MK_WAIT_V(8); MK_WAIT_L(0); MK_BAR; MK_MMA(1, 0, At, B0); MK_MMA(1, 1, At, B1); MK_BAR; MK_SCHED;
        }
        if (wr == 0) MK_BAR;
        E(acc, cur, wr, wc, fr, fq);
        if (!has_next) break;
#pragma unroll
        for (int a = 0; a < 2; ++a)
#pragma unroll
            for (int b = 0; b < 2; ++b)
#pragma unroll
                for (int m = 0; m < 4; ++m)
#pragma unroll
                    for (int n = 0; n < 2; ++n) acc[a][b][m][n] = (f32x4){0.f, 0.f, 0.f, 0.f};
        cur = nxt; cA = nA; cB = nB; ++ui;
        if (wr == 1) MK_BAR;
    }
    MK_WAIT_V(0);
    MK_BAR;
#undef MK_SA
#undef MK_SB
#undef MK_STAGE2
#undef MK_STAGE_B
#undef MK_STAGE_A
#undef MK_LDA
#undef MK_LDB
#undef MK_MMA
#undef MK_WAIT_V
#undef MK_WAIT_L
#undef MK_BAR
#undef MK_SCHED
}

__device__ __forceinline__ void grid_map(int L, int nM, int nN, int& pm, int& pn) {
    const int nwg = nM * nN, q = nwg / 8, xcd = L % 8, off = L / 8; const int wgid = xcd * q + off;
    const int nig = 8 * nN, gid = wgid / nig, fm = gid * 8, gsz = (nM - fm) < 8 ? (nM - fm) : 8;
    pm = fm + ((wgid % nig) % gsz); pn = (wgid % nig) / gsz;
}

struct EpiStore {
    __device__ __forceinline__ void operator()(const f32x4 (&acc)[2][2][4][2], const Unit& u, int wr, int wc, int fr, int fq) const {
        const int col0 = wc * 32 + 8 * fq;
#pragma unroll
        for (int ai = 0; ai < 2; ++ai)
#pragma unroll
            for (int m = 0; m < 4; ++m) {
                const int r = ai * HALF + wr * 64 + m * 16 + fr;
                if (r < u.rows) {
#pragma unroll
                    for (int bj = 0; bj < 2; ++bj) {
                        f32x4 v0 = acc[ai][bj][m][0], v1 = acc[ai][bj][m][1];
                        if (u.mode == 1) { float* p = (float*)u.C + (size_t)r * u.ldc + col0 + bj * u.bjs; *(f32x4*)p = v0; *(f32x4*)(p + 4) = v1; }
                        else {
                            if (u.mode == 2) {
#pragma unroll
                                for (int c = 0; c < 4; ++c) { v0[c] = __builtin_amdgcn_rcpf(1.0f + __expf(-v0[c])); v1[c] = __builtin_amdgcn_rcpf(1.0f + __expf(-v1[c])); }
                            }
                            u32x4 w; w.x = cvt_pk_bf16(v0[0], v0[1]); w.y = cvt_pk_bf16(v0[2], v0[3]); w.z = cvt_pk_bf16(v1[0], v1[1]); w.w = cvt_pk_bf16(v1[2], v1[3]);
                            *(u32x4*)((bf16_t*)u.C + (size_t)r * u.ldc + col0 + bj * u.bjs) = w;
                        }
                    }
                }
            }
    }
};

struct Frame {
    LAS unsigned char* lds; volatile LAS unsigned* MISC; unsigned char* ws;
    int tid, lane, wave, vcu, G;
    const float* in[22]; float* out;
};

__device__ __forceinline__ void transpose64(const float* W, int ldw, bf16_t* dst, int ldd, LAS float* scr, int lane) {
    f32x4 v[16];
    const int kk = lane >> 4, nc = (lane & 15) * 4;
#pragma unroll
    for (int j = 0; j < 16; ++j) v[j] = *(const GAS f32x4*)(W + (size_t)(j * 4 + kk) * ldw + nc);
#pragma unroll
    for (int j = 0; j < 16; ++j) {
#pragma unroll
        for (int c = 0; c < 4; ++c) scr[(j * 4 + kk) * 65 + nc + c] = v[j][c]; }
    LDS_WAIT(); asm volatile("" ::: "memory");
    const int kc = lane & 7;
#pragma unroll
    for (int jj = 0; jj < 8; ++jj) { const int n = (lane >> 3) + 8 * jj; const LAS float* s = scr + (8 * kc) * 65 + n;
        u32x4 o; o.x = cvt_pk_bf16(s[0 * 65], s[1 * 65]); o.y = cvt_pk_bf16(s[2 * 65], s[3 * 65]); o.z = cvt_pk_bf16(s[4 * 65], s[5 * 65]); o.w = cvt_pk_bf16(s[6 * 65], s[7 * 65]);
        *(GAS u32x4*)(dst + (size_t)n * ldd + 8 * kc) = o; }
    LDS_WAIT(); asm volatile("" ::: "memory");
}

constexpr int IT_IN = 32 * 128, IT_FO = 16 * 32, IT_AO = 32 * 32, IT_O = 32 * 32, IT_EG = 64 * 256, IT_EU = 64 * 256, IT_ED = 64 * 256, IT_SH = 256;
constexpr int IT_T_END = IT_IN + IT_FO + IT_AO + IT_O + IT_EG + IT_EU + IT_ED + 3 * IT_SH;
constexpr int IT_MOD = MODC / 32, IT_CST = 8192, IT_BD2 = 256;
constexpr int IT_ALL = IT_T_END + IT_MOD + IT_CST + IT_BD2;

__device__ __forceinline__ void p0_prologue(Frame& F) {
    LAS float* scr = (LAS float*)(F.lds + F.wave * 16640);
    const int gw = F.vcu * NWAVES + F.wave, NGW = F.G * NWAVES, lane = F.lane;
    unsigned char* ws = F.ws;
    bf16_t* WT_IN = (bf16_t*)(ws + WS_WT_IN); bf16_t* WT_FO = (bf16_t*)(ws + WS_WT_FO); bf16_t* WT_AO = (bf16_t*)(ws + WS_WT_AO); bf16_t* WT_O = (bf16_t*)(ws + WS_WT_O);
    bf16_t* WT_GU = (bf16_t*)(ws + WS_WT_GU); bf16_t* WT_D = (bf16_t*)(ws + WS_WT_D);
    for (int it = gw; it < IT_ALL; it += NGW) {
        int r = it < IT_MOD ? it + IT_T_END : (it < IT_T_END + IT_MOD ? it - IT_MOD : it);
        if (r < IT_IN) { const int kb = r / 128, nb = r % 128; transpose64(F.in[7] + (size_t)(kb * 64) * INC + nb * 64, INC, WT_IN + (size_t)(nb * 64) * DM + kb * 64, DM, scr, lane); continue; } r -= IT_IN;
        if (r < IT_FO) { const int kb = r / 32, nb = r % 32; transpose64(F.in[10] + (size_t)(kb * 64) * DM + nb * 64, DM, WT_FO + (size_t)(nb * 64) * FW + kb * 64, FW, scr, lane); continue; } r -= IT_FO;
        if (r < IT_AO) { const int kb = r / 32, nb = r % 32; transpose64(F.in[11] + (size_t)(kb * 64) * DM + nb * 64, DM, WT_AO + (size_t)(nb * 64) * DM + kb * 64, DM, scr, lane); continue; } r -= IT_AO;
        if (r < IT_O) { const int kb = r / 32, nb = r % 32; transpose64(F.in[12] + (size_t)(kb * 64) * DM + nb * 64, DM, WT_O + (size_t)(nb * 64) * DM + kb * 64, DM, scr, lane); continue; } r -= IT_O;
        if (r < IT_EG + IT_EU) {
            const int up = r >= IT_EG; if (up) r -= IT_EG;
            const int e = r / 256, q = r % 256, kb = q / 8, nb = q % 8, n0 = nb * 64;
            const float* W = (up ? F.in[17] : F.in[16]) + (size_t)e * DM * EFF + (size_t)(kb * 64) * EFF + n0;
            transpose64(W, EFF, WT_GU + ((size_t)e * 1024 + (n0 >> 7) * 256 + (up ? 128 : 0) + (n0 & 127)) * DM + kb * 64, DM, scr, lane); continue; } r -= IT_EG + IT_EU;
        if (r < IT_ED) { const int e = r / 256, q = r % 256, kb = q / 32, nb = q % 32;
            transpose64(F.in[18] + (size_t)e * EFF * DM + (size_t)(kb * 64) * DM + nb * 64, DM, WT_D + ((size_t)e * DM + nb * 64) * EFF + kb * 64, EFF, scr, lane); continue; } r -= IT_ED;
        if (r < 2 * IT_SH) { const int up = r >= IT_SH; if (up) r -= IT_SH; const int kb = r / 8, nb = r % 8, n0 = nb * 64;
            transpose64((up ? F.in[20] : F.in[19]) + (size_t)(kb * 64) * EFF + n0, EFF, WT_GU + ((size_t)64 * 1024 + (n0 >> 7) * 256 + (up ? 128 : 0) + (n0 & 127)) * DM + kb * 64, DM, scr, lane); continue; } r -= 2 * IT_SH;
        if (r < IT_SH) { const int kb = r / 32, nb = r % 32;
            transpose64(F.in[21] + (size_t)(kb * 64) * DM + nb * 64, DM, WT_D + ((size_t)64 * DM + nb * 64) * EFF + kb * 64, EFF, scr, lane); continue; } r -= IT_SH;
        if (r < IT_MOD) {
            const int kq = lane >> 3, col = r * 32 + (lane & 7) * 4;
            f32x4 a0 = {0.f, 0.f, 0.f, 0.f}, a1 = a0, a2 = a0;
#pragma unroll 16
            for (int j = 0; j < 256; ++j) { const int k = kq + 8 * j;
                const f32x4 w = *(const GAS f32x4*)(F.in[4] + (size_t)k * MODC + col);
                const float c0 = F.in[1][k], c1 = F.in[1][DM + k], c2 = F.in[3][k];
                a0 += w * (c0 / (1.0f + __expf(-c0))); a1 += w * (c1 / (1.0f + __expf(-c1))); a2 += w * (c2 / (1.0f + __expf(-c2))); }
#pragma unroll
            for (int c = 0; c < 4; ++c) {
#pragma unroll
                for (int o = 8; o < 64; o <<= 1) { a0[c] += __shfl_xor(a0[c], o); a1[c] += __shfl_xor(a1[c], o); a2[c] += __shfl_xor(a2[c], o); } }
            if (kq == 0) { const f32x4 bb = *(const GAS f32x4*)(F.in[5] + col); float* MODP = (float*)(ws + WS_MOD);
                *(GAS f32x4*)(MODP + col) = a0 + bb; *(GAS f32x4*)(MODP + MODC + col) = a1 + bb; *(GAS f32x4*)(MODP + 2 * MODC + col) = a2 + bb; }
            continue; } r -= IT_MOD;
        if (r < IT_CST) {
            const int k1 = r & 4095; bf16_t* dst = (bf16_t*)(ws + WS_CST) + (size_t)r * 4096;
#pragma unroll
            for (int j = 0; j < 8; ++j) { const int n0 = j * 512 + lane * 8; float f[8];
#pragma unroll
                for (int i = 0; i < 8; ++i) { const float ph = (float)((k1 * (n0 + i)) & 4095) * (1.0f / 2048.0f); f[i] = r < 4096 ? cospif(ph) : sinpif(ph); }
                u32x4 o; o.x = cvt_pk_bf16(f[0], f[1]); o.y = cvt_pk_bf16(f[2], f[3]); o.z = cvt_pk_bf16(f[4], f[5]); o.w = cvt_pk_bf16(f[6], f[7]);
                *(GAS u32x4*)(dst + n0) = o; }
            continue; } r -= IT_CST;
        {
            const int o = r, gp = o >> 7, k2 = o & 127; bf16_t* dst = (bf16_t*)(ws + WS_BD2) + (size_t)o * 512; float f[8];
#pragma unroll
            for (int i = 0; i < 8; ++i) { const int j = lane * 8 + i, cg = j >> 8, jj = j & 255, c = jj & 127; const float ph = (float)((32 * c * k2) & 4095) * (1.0f / 2048.0f);
                const float v = jj < 128 ? cospif(ph) : -sinpif(ph); f[i] = cg == gp ? v * 0.0013810679320049757f : 0.f; }
            u32x4 w; w.x = cvt_pk_bf16(f[0], f[1]); w.y = cvt_pk_bf16(f[2], f[3]); w.z = cvt_pk_bf16(f[4], f[5]); w.w = cvt_pk_bf16(f[6], f[7]);
            *(GAS u32x4*)(dst + lane * 8) = w;
        }
    }
}

struct SchedIn {
    int G, c; unsigned char* ws; int use_ut;
    __device__ __forceinline__ bool next(int i, Unit& u) const {
        const int L = i * G + c; if (L >= 1032) return false;
        const char* H = (const char*)(ws + WS_H); const char* WT = (const char*)(ws + WS_WT_IN);
        u.rows = 256; u.aux = 0; u.bjs = HALF; u.pm = 0; u.pn = 0;
        if (L < 1024) {
            int pm, ct; grid_map(L, 32, 32, pm, ct);
            const int row0 = pm * 256, b = row0 / SEQ, t0 = row0 % SEQ;
            u.A = H + (size_t)row0 * DM * 2; u.B = WT + (size_t)ct * 256 * DM * 2;
            if (ct < 4) {
                if (use_ut) { u.A = WT + (size_t)ct * 256 * DM * 2; u.B = H + (size_t)row0 * DM * 2;
                              u.C = (char*)(ws + WS_UT) + (((size_t)b * FW + ct * 256) * SEQ + t0) * 2; u.ldc = SEQ; u.mode = 0; }
                else { u.C = (char*)(ws + WS_U) + ((size_t)row0 * FW + ct * 256) * 2; u.ldc = FW; u.mode = 0; }
            }
            else if (ct < 14) { u.C = (char*)(ws + WS_QKRAW) + ((size_t)row0 * 2560 + (ct - 4) * 256) * 4; u.ldc = 2560; u.mode = 1; }
            else if (ct < 16) { u.C = (char*)(ws + WS_VALL) + (((size_t)b * SKV + t0) * KVW + (ct - 14) * 256) * 2; u.ldc = KVW; u.mode = 0; }
            else if (ct < 24) { u.C = (char*)(ws + WS_SGF) + ((size_t)row0 * DM + (ct - 16) * 256) * 2; u.ldc = DM; u.mode = 2; }
            else              { u.C = (char*)(ws + WS_SGA) + ((size_t)row0 * DM + (ct - 24) * 256) * 2; u.ldc = DM; u.mode = 2; }
        } else {
            const int l = L - 1024, pm = l & 1, ct = l >> 1;
            u.A = H + (size_t)(NTOK + pm * 256) * DM * 2; u.B = WT + (size_t)(K_OFF + ct * 256) * DM * 2;
            if (ct < 2) { u.C = (char*)(ws + WS_KCRAW) + ((size_t)(pm * 256) * KVW + ct * 256) * 4; u.ldc = KVW; u.mode = 1; }
            else        { u.C = (char*)(ws + WS_VALL) + (((size_t)pm * SKV + SEQ) * KVW + (ct - 2) * 256) * 2; u.ldc = KVW; u.mode = 0; }
        }
        return true;
    }
    __device__ __forceinline__ unsigned arow(const Unit&, int) const { return 0u; }
};


__device__ __forceinline__ void unpack8(u32x4 w, float (&f)[8]) {
#pragma unroll
    for (int i = 0; i < 4; ++i) { f[2 * i] = __uint_as_float(w[i] << 16); f[2 * i + 1] = __uint_as_float(w[i] & 0xffff0000u); }
}
struct EpiT1 { const bf16_t* SGF; float* T1;
    __device__ __forceinline__ void operator()(const f32x4 (&acc)[2][2][4][2], const Unit& u, int wr, int wc, int fr, int fq) const {
#pragma unroll
        for (int ai = 0; ai < 2; ++ai)
#pragma unroll
            for (int m = 0; m < 4; ++m) { const size_t row = (size_t)u.pm * 256 + ai * HALF + wr * 64 + m * 16 + fr;
#pragma unroll
                for (int bj = 0; bj < 2; ++bj) { const size_t o = row * DM + u.pn * 256 + bj * HALF + wc * 32 + 8 * fq;
                    float g[8]; unpack8(*(const u32x4*)(SGF + o), g); const f32x4 v0 = acc[ai][bj][m][0], v1 = acc[ai][bj][m][1];
                    *(f32x4*)(T1 + o) = (f32x4){g[0] * v0[0], g[1] * v0[1], g[2] * v0[2], g[3] * v0[3]};
                    *(f32x4*)(T1 + o + 4) = (f32x4){g[4] * v1[0], g[5] * v1[1], g[6] * v1[2], g[7] * v1[3]}; } }
    } };
struct EpiYM { const bf16_t* SGA; const float* T1; bf16_t* YM;
    __device__ __forceinline__ void operator()(const f32x4 (&acc)[2][2][4][2], const Unit& u, int wr, int wc, int fr, int fq) const {
#pragma unroll
        for (int ai = 0; ai < 2; ++ai)
#pragma unroll
            for (int m = 0; m < 4; ++m) { const size_t row = (size_t)u.pm * 256 + ai * HALF + wr * 64 + m * 16 + fr;
#pragma unroll
                for (int bj = 0; bj < 2; ++bj) { const size_t o = row * DM + u.pn * 256 + bj * HALF + wc * 32 + 8 * fq;
                    float g[8]; unpack8(*(const u32x4*)(SGA + o), g); const f32x4 v0 = acc[ai][bj][m][0], v1 = acc[ai][bj][m][1];
                    const f32x4 t0 = *(const f32x4*)(T1 + o), t1 = *(const f32x4*)(T1 + o + 4);
                    u32x4 w; w.x = cvt_pk_bf16(t0[0] + g[0] * v0[0], t0[1] + g[1] * v0[1]); w.y = cvt_pk_bf16(t0[2] + g[2] * v0[2], t0[3] + g[3] * v0[3]);
                    w.z = cvt_pk_bf16(t1[0] + g[4] * v1[0], t1[1] + g[5] * v1[1]); w.w = cvt_pk_bf16(t1[2] + g[6] * v1[2], t1[3] + g[7] * v1[3]);
                    *(u32x4*)(YM + o) = w; } }
    } };
struct EpiX2 { const float* x; const float* mod; float* X2;
    __device__ __forceinline__ void operator()(const f32x4 (&acc)[2][2][4][2], const Unit& u, int wr, int wc, int fr, int fq) const {
        const float* g1 = mod + ((u.pm * 256) / SEQ) * MODC + 2 * DM;
#pragma unroll
        for (int ai = 0; ai < 2; ++ai)
#pragma unroll
            for (int m = 0; m < 4; ++m) { const size_t row = (size_t)u.pm * 256 + ai * HALF + wr * 64 + m * 16 + fr;
#pragma unroll
                for (int bj = 0; bj < 2; ++bj) { const int col = u.pn * 256 + bj * HALF + wc * 32 + 8 * fq; const size_t o = row * DM + col;
#pragma unroll
                    for (int n = 0; n < 2; ++n) { const f32x4 xv = *(const f32x4*)(x + o + 4 * n), gv = *(const f32x4*)(g1 + col + 4 * n); *(f32x4*)(X2 + o + 4 * n) = xv + gv * acc[ai][bj][m][n]; } } }
    } };
struct EpiAct {
    __device__ __forceinline__ void operator()(const f32x4 (&acc)[2][2][4][2], const Unit& u, int wr, int wc, int fr, int fq) const {
#pragma unroll
        for (int ai = 0; ai < 2; ++ai)
#pragma unroll
            for (int m = 0; m < 4; ++m) { const int r = ai * HALF + wr * 64 + m * 16 + fr;
                if (r < u.rows) { float a[8];
#pragma unroll
                    for (int n = 0; n < 2; ++n)
#pragma unroll
                        for (int c = 0; c < 4; ++c) { const float g = acc[ai][0][m][n][c], up = acc[ai][1][m][n][c]; a[4 * n + c] = g * __builtin_amdgcn_rcpf(1.0f + __expf(-g)) * up; }
                    u32x4 w; w.x = cvt_pk_bf16(a[0], a[1]); w.y = cvt_pk_bf16(a[2], a[3]); w.z = cvt_pk_bf16(a[4], a[5]); w.w = cvt_pk_bf16(a[6], a[7]);
                    *(u32x4*)((bf16_t*)u.C + (size_t)r * u.ldc + wc * 32 + 8 * fq) = w; } }
    } };

struct SchedGrid {
    int G, c, nM, nN; const char* A; const char* B; char* C; size_t astride, bstride; int ldc, esz, mode;
    __device__ __forceinline__ bool next(int i, Unit& u) const {
        const int L = i * G + c; if (L >= nM * nN) return false;
        int pm, pn; grid_map(L, nM, nN, pm, pn);
        u.A = A + (size_t)pm * astride; u.B = B + (size_t)pn * bstride; u.C = C + ((size_t)pm * 256 * ldc + pn * 256) * esz; u.ldc = ldc; u.mode = mode; u.rows = 256; u.aux = 0; u.pm = pm; u.pn = pn; u.bjs = HALF;
        return true; }
    __device__ __forceinline__ unsigned arow(const Unit&, int) const { return 0u; } };
struct SchedF1 { int G, c; unsigned char* ws;
    __device__ __forceinline__ bool next(int i, Unit& u) const {
        const int L = i * G + c; if (L >= 256) return false;
        int pm, pn8; grid_map(L, 32, 8, pm, pn8); const int b = pn8 >> 2, pn = pn8 & 3, sn = pm >> 4, k1t = pm & 15;
        u.A = (const char*)(ws + WS_CST) + (size_t)pm * 256 * SEQ * 2; u.B = (const char*)(ws + WS_UT) + ((size_t)b * FW + pn * 256) * SEQ * 2;
        u.C = (char*)(ws + WS_TT) + (((size_t)b * SEQ + k1t * 256) * DM + pn * 512 + sn * 128) * 2; u.ldc = DM; u.mode = 0; u.rows = 256; u.aux = 0; u.pm = pm; u.pn = pn8; u.bjs = 256;
        return true; }
    __device__ __forceinline__ unsigned arow(const Unit&, int) const { return 0u; } };
struct SchedF2 { int G, c; unsigned char* ws;
    __device__ __forceinline__ bool next(int i, Unit& u) const {
        const int L = i * G + c; if (L >= 128) return false;
        int pm, j; grid_map(L, 32, 4, pm, j);
        u.A = (const char*)(ws + WS_TT) + ((size_t)pm * 256 * DM + j * 512) * 2; u.B = (const char*)(ws + WS_BD2);
        u.C = (char*)(ws + WS_YF) + ((size_t)pm * 256 * FW + j * 256) * 2; u.ldc = FW; u.mode = 0; u.rows = 256; u.aux = 0; u.pm = pm; u.pn = j; u.bjs = HALF;
        return true; }
    __device__ __forceinline__ unsigned arow(const Unit&, int) const { return 0u; } };
constexpr int SCHT_OFF = LDSCTL_OFF + 1024;
__device__ __forceinline__ void moe_tables(Frame& F, int ncol_tiles) {
    LAS int* T = (LAS int*)(F.lds + SCHT_OFF);
    __syncthreads();
    if (F.tid == 0) { const int* CNT = (const int*)(F.ws + CTL_CNT); int up = 0, of = 0;
        for (int e = 0; e <= NE; ++e) { const int cn = e < NE ? CNT[e * 64] : NTOK; T[e] = up; T[80 + e] = e < NE ? of : NSLOT; T[160 + e] = cn; up += ((cn + 255) >> 8) * ncol_tiles; of += cn; }
        T[NE + 1] = up; }
    __syncthreads();
}
template <int NCT, bool FIRST> struct SchedMoe {
    int G, c; unsigned char* ws; LAS int* T; const int* TOK;
    __device__ __forceinline__ bool next(int i, Unit& u) const {
        const int L = i * G + c; if (L >= T[NE + 1]) return false;
        int lo = 0, hi = NE;
#pragma unroll 1
        while (lo < hi) { const int mid = (lo + hi + 1) >> 1; if (T[mid] <= L) lo = mid; else hi = mid - 1; }
        const int e = lo, cn = T[160 + e], ntile = (cn + 255) >> 8, local = L - T[e], ct = local / ntile, mt = local % ntile, slot0 = T[80 + e] + mt * 256;
        u.rows = (cn - mt * 256) < 256 ? (cn - mt * 256) : 256; u.aux = slot0; u.pm = mt; u.pn = ct; u.bjs = HALF; u.mode = 0;
        if (FIRST) { u.A = (const char*)(ws + WS_H2); u.B = (const char*)(ws + WS_WT_GU) + ((size_t)e * 4 + ct) * 256 * DM * 2; u.C = (char*)(ws + WS_ACT) + ((size_t)slot0 * EFF + ct * 128) * 2; u.ldc = EFF; }
        else { u.A = (const char*)(ws + WS_ACT) + (size_t)slot0 * EFF * 2; u.B = (const char*)(ws + WS_WT_D) + ((size_t)e * DM + ct * 256) * EFF * 2; u.C = (char*)(ws + WS_YBIG) + ((size_t)slot0 * DM + ct * 256) * 2; u.ldc = DM; }
        return true; }
    __device__ __forceinline__ unsigned arow(const Unit& u, int r) const { const int rr = r < u.rows ? r : u.rows - 1; return (unsigned)TOK[u.aux + rr] * (unsigned)(DM * 2); } };

namespace attn {
using s16x4 = __attribute__((ext_vector_type(4))) short;
using f32x8 = __attribute__((ext_vector_type(8))) float;
constexpr int D = 128, NW = 8, QBLK = 32, KVBLK = 64;
constexpr float SCALE = 0.088388347648318440f;
constexpr float THR = 8.f;
constexpr int LDQ = DM, LDK = KVW, LDO = DM;
constexpr size_t SHM_V = KVBLK * D * 2, SHM_K = KVBLK * D * 2, SHM_ATTN = 2 * SHM_V + 2 * SHM_K + NW * 64 * 4;
#define KSWZ(row, colB) ((row) * 256 + ((colB) ^ (((row) & 7) << 4)))
#define SBAR() __builtin_amdgcn_sched_barrier(0)
__device__ __forceinline__ unsigned cvtpk(float lo, float hi) { unsigned r; asm volatile("v_cvt_pk_bf16_f32 %0, %1, %2" : "=v"(r) : "v"(lo), "v"(hi)); return r; }
__device__ __forceinline__ void partialSM(f32x16& p0, f32x16& p1, float& m_reg, float& mn, float& alpha) {
  constexpr float C = SCALE * 1.4426950408889634f;
  float pmax = p0[0]; for (int r = 1; r < 16; ++r) pmax = fmaxf(pmax, p0[r]); for (int r = 0; r < 16; ++r) pmax = fmaxf(pmax, p1[r]);
  { auto rr = __builtin_amdgcn_permlane32_swap(__float_as_uint(pmax), __float_as_uint(pmax), false, false);
    pmax = fmaxf(__uint_as_float(rr[0]), __uint_as_float(rr[1])); }
  if (__builtin_expect(__all(pmax - m_reg <= THR / SCALE), 1)) { mn = m_reg; alpha = 1.f; }
  else { mn = fmaxf(m_reg, pmax); alpha = __builtin_amdgcn_exp2f((m_reg - mn) * C); m_reg = mn; }
  float mnC = -mn * C;
  for (int r = 0; r < 16; ++r) p0[r] = fmaf(p0[r], C, mnC); for (int r = 0; r < 16; ++r) p1[r] = fmaf(p1[r], C, mnC);
  for (int r = 0; r < 16; ++r) p0[r] = __builtin_amdgcn_exp2f(p0[r]);
}
__device__ __forceinline__ void finishSM(f32x16& p0, f32x16& p1, float alpha, float& l_reg, bf16x8& pa0, bf16x8& pa1, bf16x8& pa2, bf16x8& pa3) {
  for (int r = 0; r < 16; ++r) p1[r] = __builtin_amdgcn_exp2f(p1[r]);
  float ps = 0; for (int r = 0; r < 16; ++r) ps += p0[r]; for (int r = 0; r < 16; ++r) ps += p1[r];
  { auto rr = __builtin_amdgcn_permlane32_swap(__float_as_uint(ps), __float_as_uint(ps), false, false);
    ps = __uint_as_float(rr[0]) + __uint_as_float(rr[1]); }
  l_reg = l_reg * alpha + ps;
#define PK4(P, BASE, OUT) do { unsigned a0 = cvtpk(P[BASE + 0], P[BASE + 1]), a1 = cvtpk(P[BASE + 2], P[BASE + 3]);   \
    unsigned b0 = cvtpk(P[BASE + 4], P[BASE + 5]), b1 = cvtpk(P[BASE + 6], P[BASE + 7]);                              \
    auto r0 = __builtin_amdgcn_permlane32_swap(a0, b0, false, false); auto r1 = __builtin_amdgcn_permlane32_swap(a1, b1, false, false); \
    u32x4 w = {r0[0], r1[0], r0[1], r1[1]}; OUT = *reinterpret_cast<bf16x8*>(&w); } while (0)
  PK4(p0, 0, pa0); PK4(p0, 8, pa1); PK4(p1, 0, pa2); PK4(p1, 8, pa3);
#undef PK4
}
__device__ __forceinline__ void qkt(f32x16& p0, f32x16& p1, const bf16_t* Ks, const bf16x8* qr, int r32, int hi) {
  p0 = f32x16{}; p1 = f32x16{};
  for (int d0 = 0; d0 < 8; ++d0) { int cb = (d0 * 16 + hi * 8) * 2;
    bf16x8 b0 = *reinterpret_cast<const bf16x8*>((const char*)Ks + KSWZ(r32, cb));
    bf16x8 b1 = *reinterpret_cast<const bf16x8*>((const char*)Ks + KSWZ(32 + r32, cb));
    p0 = __builtin_amdgcn_mfma_f32_32x32x16_bf16(b0, qr[d0], p0, 0, 0, 0);
    p1 = __builtin_amdgcn_mfma_f32_32x32x16_bf16(b1, qr[d0], p1, 0, 0, 0); }
}
__device__ __forceinline__ int v_st(int k, int c) { const int kk = (k & ~0xC) | ((k & 4) << 1) | ((k & 8) >> 1); return ((kk >> 3) * 4 + (c >> 5)) * 512 + ((kk & 7) * 32 + (c & 31)) * 2; }
__device__ __forceinline__ int v_rd_base(int lane) { return ((lane & 3) << 3) | (((lane >> 2) & 3) << 6) | (((lane >> 4) & 1) << 5) | (((lane >> 5) & 1) << 8); }
constexpr int v_rd_off(int d0, int ks, int half) { return d0 * 512 + ks * 4096 + half * 2048; }
template <int OFF> __device__ __forceinline__ s16x4 tr_read(int vb) {
  s16x4 r; asm volatile("ds_read_b64_tr_b16 %0, %1 offset:%2" : "=&v"(r) : "v"(vb), "i"(OFF) : "memory"); return r;
}
template <int D0> __device__ __forceinline__ void pv_one(f32x16& od, int vb, bf16x8 pa0, bf16x8 pa1, bf16x8 pa2, bf16x8 pa3) {
  const s16x4 l0 = tr_read<v_rd_off(D0, 0, 0)>(vb), h0 = tr_read<v_rd_off(D0, 0, 1)>(vb), l1 = tr_read<v_rd_off(D0, 1, 0)>(vb), h1 = tr_read<v_rd_off(D0, 1, 1)>(vb);
  const s16x4 l2 = tr_read<v_rd_off(D0, 2, 0)>(vb), h2 = tr_read<v_rd_off(D0, 2, 1)>(vb), l3 = tr_read<v_rd_off(D0, 3, 0)>(vb), h3 = tr_read<v_rd_off(D0, 3, 1)>(vb);
  asm volatile("s_waitcnt lgkmcnt(0)" ::: "memory"); SBAR();
#define PK(L, H) (bf16x8){L[0], L[1], L[2], L[3], H[0], H[1], H[2], H[3]}
  od = __builtin_amdgcn_mfma_f32_32x32x16_bf16(pa0, PK(l0, h0), od, 0, 0, 0);
  od = __builtin_amdgcn_mfma_f32_32x32x16_bf16(pa1, PK(l1, h1), od, 0, 0, 0);
  od = __builtin_amdgcn_mfma_f32_32x32x16_bf16(pa2, PK(l2, h2), od, 0, 0, 0);
  od = __builtin_amdgcn_mfma_f32_32x32x16_bf16(pa3, PK(l3, h3), od, 0, 0, 0);
#undef PK
}
__device__ __forceinline__ void pv_d0(f32x16* o, int vb, bf16x8 pa0, bf16x8 pa1, bf16x8 pa2, bf16x8 pa3) {
  pv_one<0>(o[0], vb, pa0, pa1, pa2, pa3); pv_one<1>(o[1], vb, pa0, pa1, pa2, pa3); pv_one<2>(o[2], vb, pa0, pa1, pa2, pa3); pv_one<3>(o[3], vb, pa0, pa1, pa2, pa3);
}
__device__ __forceinline__ void attn_dense_body(const bf16_t* __restrict__ Qb, const bf16_t* __restrict__ Kh, const bf16_t* __restrict__ Vh, bf16_t* __restrict__ Ob, int seq, char* lds) {
  const int tid = threadIdx.x, wid = tid >> 6, lane = tid & 63, r32 = lane & 31, hi = lane >> 5;
  bf16_t* V_lds = (bf16_t*)lds; bf16_t* K_lds = (bf16_t*)(lds + 2 * SHM_V);
  float* ws = (float*)(lds + 2 * SHM_V + 2 * SHM_K) + wid * 64; float* li_l = ws; float* al_l = ws + 32;
  float m_reg = -1e30f, l_reg = 0; f32x16 o[4] = {}; bf16x8 qr[8];
  const bf16_t* Qw = Qb + (long)(wid * QBLK + r32) * LDQ + hi * 8;
#pragma unroll
  for (int d0 = 0; d0 < 8; ++d0) qr[d0] = *reinterpret_cast<const bf16x8*>(Qw + d0 * 16);
  const int sr = tid >> 4, sc = (tid & 15) * 8, vst0 = v_st(sr, sc), vst1 = v_st(32 + sr, sc);
  const int vb0 = (int)(uintptr_t)V_lds + v_rd_base(lane);
  struct { bf16x8 vs0, vs1, ks0, ks1; } sr_[2];
#define SLOAD(i, k0) do { sr_[i].vs0 = *reinterpret_cast<const bf16x8*>(&Vh[(long)((k0) + sr) * LDK + sc]); sr_[i].vs1 = *reinterpret_cast<const bf16x8*>(&Vh[(long)((k0) + 32 + sr) * LDK + sc]); \
    sr_[i].ks0 = *reinterpret_cast<const bf16x8*>(&Kh[(long)((k0) + sr) * LDK + sc]); sr_[i].ks1 = *reinterpret_cast<const bf16x8*>(&Kh[(long)((k0) + 32 + sr) * LDK + sc]); } while (0)
#define SWRITE(b, i) do { *(bf16x8*)((char*)V_lds + (b) * SHM_V + vst0) = sr_[i].vs0;          \
    *(bf16x8*)((char*)V_lds + (b) * SHM_V + vst1) = sr_[i].vs1; int kc = sc * 2;               \
    *(bf16x8*)((char*)K_lds + (b) * SHM_K + KSWZ(sr, kc)) = sr_[i].ks0;                       \
    *(bf16x8*)((char*)K_lds + (b) * SHM_K + KSWZ(32 + sr, kc)) = sr_[i].ks1; } while (0)
#define SWAIT() asm volatile("s_waitcnt vmcnt(4)" ::: "memory")
#define RESC(a) do { if (__any((a) < 1.f)) { if (hi == 0) al_l[r32] = (a); asm volatile("s_waitcnt lgkmcnt(0)" ::: "memory"); \
    for (int d = 0; d < 4; ++d) for (int r = 0; r < 16; ++r) o[d][r] *= al_l[crow(r, hi)]; } } while (0)
  f32x16 pA0, pA1, pB0, pB1; float mnA, mnB, alA, alB; bf16x8 pa0, pa1, pa2, pa3; const int NT = seq / KVBLK;
  constexpr int SE = 0, SO = 1;
  SLOAD(SE, 0); asm volatile("s_waitcnt vmcnt(0)" ::: "memory"); SWRITE(0, SE); __syncthreads();
  qkt(pA0, pA1, K_lds, qr, r32, hi); partialSM(pA0, pA1, m_reg, mnA, alA);
  SLOAD(SO, KVBLK); if (2 < NT) SLOAD(SE, 2 * KVBLK);
  SWAIT(); SWRITE(1, SO); __syncthreads();
  for (int j = 1; j + 1 < NT; j += 2) {
    SBAR(); qkt(pB0, pB1, (bf16_t*)((char*)K_lds + SHM_K), qr, r32, hi);
    finishSM(pA0, pA1, alA, l_reg, pa0, pa1, pa2, pa3); SBAR();
    SLOAD(SO, (j + 2) * KVBLK); SBAR();
    pv_d0(o, vb0, pa0, pa1, pa2, pa3); partialSM(pB0, pB1, m_reg, mnB, alB);
    __syncthreads(); SWAIT(); SWRITE(0, SE);
    RESC(alB); __syncthreads();
    SBAR(); qkt(pA0, pA1, K_lds, qr, r32, hi);
    finishSM(pB0, pB1, alB, l_reg, pa0, pa1, pa2, pa3); SBAR();
    if (j + 3 < NT) SLOAD(SE, (j + 3) * KVBLK); SBAR();
    pv_d0(o, vb0 + (int)SHM_V, pa0, pa1, pa2, pa3); partialSM(pA0, pA1, m_reg, mnA, alA);
    __syncthreads(); SWAIT(); SWRITE(1, SO);
    RESC(alA); __syncthreads();
  }
  SBAR(); qkt(pB0, pB1, (bf16_t*)((char*)K_lds + SHM_K), qr, r32, hi);
  finishSM(pA0, pA1, alA, l_reg, pa0, pa1, pa2, pa3); SBAR();
  pv_d0(o, vb0, pa0, pa1, pa2, pa3); partialSM(pB0, pB1, m_reg, mnB, alB);
  __syncthreads(); RESC(alB);
  finishSM(pB0, pB1, alB, l_reg, pa0, pa1, pa2, pa3); SBAR();
  pv_d0(o, vb0 + (int)SHM_V, pa0, pa1, pa2, pa3);
  if (hi == 0) li_l[r32] = l_reg; asm volatile("s_waitcnt lgkmcnt(0)" ::: "memory");
  float rli[16];
#pragma unroll
  for (int r = 0; r < 16; ++r) rli[r] = __builtin_amdgcn_rcpf(li_l[crow(r, hi)]);
  bf16_t* Ow = Ob + (long)(wid * QBLK) * LDO;
#pragma unroll
  for (int r = 0; r < 16; ++r) { int orow = crow(r, hi);
    for (int d0 = 0; d0 < 4; ++d0) Ow[(long)orow * LDO + d0 * 32 + r32] = f2bf(o[d0][r] * rli[r]); }
#undef SLOAD
#undef SWRITE
#undef SWAIT
#undef RESC
}
#undef KSWZ
#undef SBAR
}

__device__ __forceinline__ void ph_norm1(Frame& F, const float* mod) {
    const int gw = F.vcu * NWAVES + F.wave, NGW = F.G * NWAVES, lane = F.lane;
    bf16_t* H = (bf16_t*)(F.ws + WS_H); const float* nw = F.in[6];
    for (int row = gw; row < NTOK + NCTX; row += NGW) {
        const float* src = row < NTOK ? F.in[0] + (size_t)row * DM : F.in[2] + (size_t)(row - NTOK) * DM;
        const float* mr = mod + (row < NTOK ? row / SEQ : 2) * MODC;
        f32x4 v[8]; float ss = 0.f;
#pragma unroll
        for (int j = 0; j < 8; ++j) { v[j] = *(const GAS f32x4*)(src + (j * 64 + lane) * 4); ss += v[j].x * v[j].x + v[j].y * v[j].y + v[j].z * v[j].z + v[j].w * v[j].w; }
        ss = wave_sum(ss);
        const float rstd = 1.0f / sqrtf(ss * (1.0f / DM) + 1e-6f);
#pragma unroll
        for (int j = 0; j < 8; ++j) { const int i = (j * 64 + lane) * 4;
            const f32x4 w = *(const GAS f32x4*)(nw + i), sc = *(const GAS f32x4*)(mr + DM + i), sh = *(const GAS f32x4*)(mr + i);
            const f32x4 h = v[j] * rstd * w * (sc + 1.0f) + sh;
            unsigned lo = cvt_pk_bf16(h[0], h[1]), hi = cvt_pk_bf16(h[2], h[3]);
            *(GAS unsigned long long*)(H + (size_t)row * DM + i) = (unsigned long long)lo | ((unsigned long long)hi << 32); }
    }
}
__device__ __forceinline__ void ph_qknorm(Frame& F) {
    const int gw = F.vcu * NWAVES + F.wave, NGW = F.G * NWAVES, lane = F.lane;
    const float* QKRAW = (const float*)(F.ws + WS_QKRAW); const float* KCRAW = (const float*)(F.ws + WS_KCRAW);
    bf16_t* Q = (bf16_t*)(F.ws + WS_Q); bf16_t* KALL = (bf16_t*)(F.ws + WS_KALL);
    const int axis = lane >> 5, f = lane & 31, da = axis * 64 + f, db = da + 32;
    const float qwa = F.in[8][da], qwb = F.in[8][db], kwa = F.in[9][da], kwb = F.in[9][db];
    const float inv = exp2f(-(float)f * (13.287712379549449f / 32.0f));
    for (int row = gw; row < NTOK + NCTX; row += NGW) {
        if (row < NTOK) {
            const int b = row / SEQ, t = row % SEQ;
            const float pos = (float)(axis == 0 ? t / 64 : t % 64), ang = pos * inv, cs = cosf(ang), sn = sinf(ang);
            const float* src = QKRAW + (size_t)row * 2560;
#pragma unroll
            for (int hb = 0; hb < 20; hb += 5) {
                float xa[5], xb[5];
#pragma unroll
                for (int q = 0; q < 5; ++q) { xa[q] = src[(hb + q) * HD + da]; xb[q] = src[(hb + q) * HD + db]; }
#pragma unroll
                for (int q = 0; q < 5; ++q) { const int hh = hb + q;
                    const float ss = wave_sum(xa[q] * xa[q] + xb[q] * xb[q]), rstd = 1.0f / sqrtf(ss * (1.0f / HD) + 1e-6f);
                    const float a = xa[q] * rstd * (hh < 16 ? qwa : kwa), bb = xb[q] * rstd * (hh < 16 ? qwb : kwb);
                    bf16_t* dst = hh < 16 ? Q + (size_t)row * DM + hh * HD : KALL + ((size_t)b * SKV + t) * KVW + (hh - 16) * HD;
                    dst[da] = f2bf(a * cs - bb * sn); dst[db] = f2bf(bb * cs + a * sn); }
            }
        } else {
            const int r = row - NTOK, b = r / CTXL, j = r % CTXL; const float* src = KCRAW + (size_t)r * KVW;
#pragma unroll
            for (int hh = 0; hh < 4; ++hh) { const float xa = src[hh * HD + da], xb = src[hh * HD + db];
                const float ss = wave_sum(xa * xa + xb * xb), rstd = 1.0f / sqrtf(ss * (1.0f / HD) + 1e-6f);
                bf16_t* dst = KALL + ((size_t)b * SKV + SEQ + j) * KVW + hh * HD; dst[da] = f2bf(xa * rstd * kwa); dst[db] = f2bf(xb * rstd * kwb); }
        }
    }
}
__device__ __forceinline__ void ph_route(Frame& F, const float* mod) {
    const int lane = F.lane, wv = F.wave;
    LAS float* hrow = (LAS float*)F.lds;
    LAS float* part = (LAS float*)(F.lds + 65536);
    const float* X2 = F.out; const float* nw = F.in[13]; const float* rw = F.in[14]; const float* rb = F.in[15];
    bf16_t* H2 = (bf16_t*)(F.ws + WS_H2); int* EIDX = (int*)(F.ws + WS_EIDX); float* EW = (float*)(F.ws + WS_EW); int* EPOS = (int*)(F.ws + WS_EPOS); int* CNT = (int*)(F.ws + CTL_CNT);
    LAS int* lcnt = (LAS int*)(F.lds + 65536 + 16384);
    LAS int* lbase = lcnt + 64;
    LAS int* lent = lcnt + 128;
    if (F.tid < NE) lcnt[F.tid] = 0;
    __syncthreads();
    int nb = 0;
    for (int blk = F.vcu; blk < NTOK / 8; blk += F.G, ++nb) {
        const int row = blk * 8 + wv;
        { const float* src = X2 + (size_t)row * DM; const float* mr = mod + (row / SEQ) * MODC;
          f32x4 v[8]; float ss = 0.f;
#pragma unroll
          for (int j = 0; j < 8; ++j) { v[j] = *(const GAS f32x4*)(src + (j * 64 + lane) * 4); ss += v[j].x * v[j].x + v[j].y * v[j].y + v[j].z * v[j].z + v[j].w * v[j].w; }
          ss = wave_sum(ss);
          const float rstd = 1.0f / sqrtf(ss * (1.0f / DM) + 1e-6f);
#pragma unroll
          for (int j = 0; j < 8; ++j) { const int i = (j * 64 + lane) * 4;
              const f32x4 w = *(const GAS f32x4*)(nw + i), sc = *(const GAS f32x4*)(mr + 4 * DM + i), sh = *(const GAS f32x4*)(mr + 3 * DM + i);
              const f32x4 h = v[j] * rstd * w * (sc + 1.0f) + sh;
              *(LAS f32x4*)(hrow + wv * DM + i) = h;
              unsigned lo = cvt_pk_bf16(h[0], h[1]), hi = cvt_pk_bf16(h[2], h[3]);
              *(GAS unsigned long long*)(H2 + (size_t)row * DM + i) = (unsigned long long)lo | ((unsigned long long)hi << 32); } }
        __syncthreads();
        { float a[8];
#pragma unroll
          for (int r = 0; r < 8; ++r) a[r] = 0.f;
          const int k0 = wv * 256;
#pragma unroll 16
          for (int k = 0; k < 256; ++k) { const float w = rw[(size_t)(k0 + k) * NE + lane];
#pragma unroll
              for (int r = 0; r < 8; ++r) a[r] += hrow[r * DM + k0 + k] * w; }
#pragma unroll
          for (int r = 0; r < 8; ++r) part[(wv * 8 + r) * 64 + lane] = a[r]; }
        __syncthreads();
        { float logit = 0.f;
#pragma unroll
          for (int w = 0; w < 8; ++w) logit += part[(w * 8 + wv) * 64 + lane];
          const float score = 1.0f / (1.0f + expf(-logit)), bsd = score + rb[lane];
          const int g = lane >> 3;
          int rk = 0;
#pragma unroll
          for (int i = 0; i < 8; ++i) { const int o = (lane & ~7) + i; const float vv = __shfl(bsd, o); rk += (vv > bsd) || (vv == bsd && o < lane); }
          float gs = rk < 2 ? bsd : 0.f;
          gs += __shfl_xor(gs, 1); gs += __shfl_xor(gs, 2); gs += __shfl_xor(gs, 4);
          int grk = 0;
#pragma unroll
          for (int gg = 0; gg < 8; ++gg) { const float vv = __shfl(gs, gg * 8); grk += (vv > gs) || (vv == gs && gg < g); }
          const bool gsel = grk < 4;
          const float mb = gsel ? bsd : -INFINITY;
          int erk = 0;
          for (int o = 0; o < 64; ++o) { const float vv = __shfl(mb, o); erk += (vv > mb) || (vv == mb && o < lane); }
          const bool sel = gsel && erk < TOPK;
          const float ssum = wave_sum(sel ? score : 0.f);
          if (sel) { const int lp = __hip_atomic_fetch_add(lcnt + lane, 1, __ATOMIC_RELAXED, __HIP_MEMORY_SCOPE_WORKGROUP);
                     EIDX[row * TOPK + erk] = lane; EW[row * TOPK + erk] = score / ssum * 2.5f; lent[(nb * 8 + wv) * TOPK + erk] = (lane << 16) | lp; } }
        __syncthreads();
    }
    if (F.tid < NE) { const int c = lcnt[F.tid]; lbase[F.tid] = c ? atomicAdd(&CNT[F.tid * 64], c) : 0; }
    __syncthreads();
    for (int i = F.tid; i < nb * 64; i += NTHREADS) { const int blk = F.vcu + (i >> 6) * F.G, row = blk * 8 + ((i >> 3) & 7), v = lent[i]; EPOS[row * TOPK + (i & 7)] = lbase[v >> 16] + (v & 0xffff); }
    __syncthreads();
}
__device__ __forceinline__ void ph_fill(Frame& F) {
    moe_tables(F, 4);
    LAS int* T = (LAS int*)(F.lds + SCHT_OFF);
    const int* EIDX = (const int*)(F.ws + WS_EIDX); const int* EPOS = (const int*)(F.ws + WS_EPOS); int* TOK = (int*)(F.ws + WS_TOK); int* SLOTOF = (int*)(F.ws + WS_SLOTOF);
    for (int i = F.vcu * NTHREADS + F.tid; i < NSLOT; i += F.G * NTHREADS) { const int slot = T[80 + EIDX[i]] + EPOS[i]; TOK[slot] = i / TOPK; SLOTOF[i] = slot; if (i < NTOK) TOK[NSLOT + i] = i; }
}
__device__ __forceinline__ void ph_comb(Frame& F, const float* mod) {
    const int gw = F.vcu * NWAVES + F.wave, NGW = F.G * NWAVES, lane = F.lane;
    const float* EW = (const float*)(F.ws + WS_EW); const int* SLOTOF = (const int*)(F.ws + WS_SLOTOF); const bf16_t* Y = (const bf16_t*)(F.ws + WS_YBIG);
    for (int t = gw; t < NTOK; t += NGW) {
        const float* g2 = mod + (t / SEQ) * MODC + 5 * DM;
        int sl[TOPK]; float wk[TOPK];
#pragma unroll
        for (int k = 0; k < TOPK; ++k) { sl[k] = SLOTOF[t * TOPK + k]; wk[k] = EW[t * TOPK + k]; }
#pragma unroll
        for (int j = 0; j < 4; ++j) { const int col = j * 512 + lane * 8;
            float a[8]; unpack8(*(const GAS u32x4*)(Y + (size_t)(NSLOT + t) * DM + col), a);
#pragma unroll
            for (int k = 0; k < TOPK; ++k) { float y[8]; unpack8(*(const GAS u32x4*)(Y + (size_t)sl[k] * DM + col), y);
#pragma unroll
                for (int c = 0; c < 8; ++c) a[c] += wk[k] * y[c]; }
            float* o = F.out + (size_t)t * DM + col;
#pragma unroll
            for (int n = 0; n < 2; ++n) { const f32x4 xv = *(const GAS f32x4*)(o + 4 * n), gv = *(const GAS f32x4*)(g2 + col + 4 * n);
                *(GAS f32x4*)(o + 4 * n) = xv + gv * (f32x4){a[4 * n], a[4 * n + 1], a[4 * n + 2], a[4 * n + 3]}; } }
    }
}

enum { PH_PRO = 0, PH_NORM1, PH_INPROJ, PH_QKNORM, PH_ATTN, PH_F2, PH_MERGE, PH_OUT, PH_ROUTE, PH_FILL, PH_EXP1, PH_EXP2, PH_COMB, PH_END };

struct Args { const float* in[22]; float* out; unsigned char* ws; int ph_lo, ph_hi, use_ut, mod_off, do_attn, bar_idx; };

__global__ void __launch_bounds__(NTHREADS, 2) fwd(Args args) {
    extern __shared__ __attribute__((aligned(16))) unsigned char lds_raw[];
    Frame F;
    F.lds = (LAS unsigned char*)lds_raw; F.MISC = (volatile LAS unsigned*)(F.lds + MISC_OFF); F.ws = args.ws;
    F.tid = threadIdx.x; F.lane = F.tid & 63; F.wave = __builtin_amdgcn_readfirstlane(F.tid >> 6);
    F.G = gridDim.x; { const int bx = blockIdx.x; F.vcu = (F.G % 8 == 0) ? (bx % 8) * (F.G / 8) + bx / 8 : bx; }
#pragma unroll
    for (int i = 0; i < 22; ++i) F.in[i] = args.in[i];
    F.out = args.out;
    for (int u = F.tid; u < (LDS_BYTES - LDSCTL_OFF) / 4; u += NTHREADS) ((LAS unsigned*)(F.lds + LDSCTL_OFF))[u] = 0u;
    __syncthreads();
    const int lo = args.ph_lo, hi = args.ph_hi;
    const bool multi = (hi - lo) > 1;
    unsigned* barw = (unsigned*)(args.ws + CTL_BAR) + args.bar_idx * XCD_BAR_WORDS;
    XcdBarrier bar; bar.bar = barw; bar.x = 0; bar.st = nullptr;
    if (multi) bar = xcd_barrier_post(barw, F.MISC + 8);
#define IN(k) (lo <= (k) && (k) < hi)
#define SEAM(k) do { if (IN((k) + 1)) xcd_barrier(bar); } while (0)

    const float* modp = (const float*)(args.ws + args.mod_off);
    if (IN(PH_PRO)) { p0_prologue(F); SEAM(PH_PRO); }
    if (IN(PH_NORM1)) { ph_norm1(F, modp); SEAM(PH_NORM1); }
    if (IN(PH_INPROJ)) {
        SchedIn S{F.G, (int)blockIdx.x, args.ws, args.use_ut};
        gemm_phase<EpiStore, SchedIn, false>(F.lds, DM, DM, DM, S, EpiStore{});
        SEAM(PH_INPROJ);
    }
    if (IN(PH_QKNORM)) { ph_qknorm(F); SEAM(PH_QKNORM); }
    if (IN(PH_ATTN)) {
        if (args.do_attn) {
            const bf16_t* Qp = (const bf16_t*)(args.ws + WS_Q); const bf16_t* Kp = (const bf16_t*)(args.ws + WS_KALL); const bf16_t* Vp = (const bf16_t*)(args.ws + WS_VALL); bf16_t* Op = (bf16_t*)(args.ws + WS_YA);
            for (int lin = F.vcu; lin < 512; lin += F.G) {
                const int x = (lin >> 5) & 7, j = (lin & 31) + 32 * (lin >> 8), b = x >> 2, kvh = x & 3, head = kvh * 4 + (j >> 4), qb = j & 15;
                const size_t qo = ((size_t)(b * SEQ + qb * 256)) * DM + head * HD, ko = (size_t)b * SKV * KVW + kvh * HD;
                attn::attn_dense_body(Qp + qo, Kp + ko, Vp + ko, Op + qo, SKV, (char*)lds_raw);
                __syncthreads();
            }
        }
        SchedF1 S{F.G, (int)blockIdx.x, args.ws};
        gemm_phase<EpiStore, SchedF1, false>(F.lds, SEQ, SEQ, SEQ, S, EpiStore{});
        SEAM(PH_ATTN);
    }
    if (IN(PH_F2)) {
        SchedF2 S{F.G, (int)blockIdx.x, args.ws};
        gemm_phase<EpiStore, SchedF2, false>(F.lds, 512, DM, 512, S, EpiStore{});
        SEAM(PH_F2);
    }
    if (IN(PH_MERGE)) {
        unsigned char* ws = args.ws;
        { SchedGrid S{F.G, (int)blockIdx.x, 32, 8, (const char*)(ws + WS_YF), (const char*)(ws + WS_WT_FO), nullptr, (size_t)256 * FW * 2, (size_t)256 * FW * 2, DM, 4, 1};
          gemm_phase<EpiT1, SchedGrid, false>(F.lds, FW, FW, FW, S, EpiT1{(const bf16_t*)(ws + WS_SGF), (float*)(ws + WS_T1)}); }
        { SchedGrid S{F.G, (int)blockIdx.x, 32, 8, (const char*)(ws + WS_YA), (const char*)(ws + WS_WT_AO), nullptr, (size_t)256 * DM * 2, (size_t)256 * DM * 2, DM, 2, 0};
          gemm_phase<EpiYM, SchedGrid, false>(F.lds, DM, DM, DM, S, EpiYM{(const bf16_t*)(ws + WS_SGA), (const float*)(ws + WS_T1), (bf16_t*)(ws + WS_YM)}); }
        SEAM(PH_MERGE);
    }
    if (IN(PH_OUT)) {
        unsigned char* ws = args.ws;
        SchedGrid S{F.G, (int)blockIdx.x, 32, 8, (const char*)(ws + WS_YM), (const char*)(ws + WS_WT_O), nullptr, (size_t)256 * DM * 2, (size_t)256 * DM * 2, DM, 4, 1};
        gemm_phase<EpiX2, SchedGrid, false>(F.lds, DM, DM, DM, S, EpiX2{F.in[0], modp, F.out});
        SEAM(PH_OUT);
    }
    if (IN(PH_ROUTE)) { ph_route(F, modp); SEAM(PH_ROUTE); }
    if (IN(PH_FILL)) { ph_fill(F); SEAM(PH_FILL); }
    if (IN(PH_EXP1)) {
        moe_tables(F, 4);
        SchedMoe<4, true> S{F.G, F.vcu, args.ws, (LAS int*)(F.lds + SCHT_OFF), (const int*)(args.ws + WS_TOK)};
        gemm_phase<EpiAct, SchedMoe<4, true>, true>(F.lds, DM, DM, DM, S, EpiAct{});
        SEAM(PH_EXP1);
    }
    if (IN(PH_EXP2)) {
        moe_tables(F, 8);
        SchedMoe<8, false> S{F.G, F.vcu, args.ws, (LAS int*)(F.lds + SCHT_OFF), (const int*)(args.ws + WS_TOK)};
        gemm_phase<EpiStore, SchedMoe<8, false>, false>(F.lds, EFF, EFF, EFF, S, EpiStore{});
        SEAM(PH_EXP2);
    }
    if (IN(PH_COMB)) { ph_comb(F, modp); }
#undef IN
#undef SEAM
}
}

extern "C" void kernel_launch(void* const* d_in, const int* in_sizes, int n_in, void* d_out, int out_size, void* d_ws, size_t ws_size, hipStream_t stream) {
    if (n_in != 22 || ws_size < WS_END2) return;
    float* out = (float*)d_out;
    unsigned char* ws = (unsigned char*)d_ws;
    hipMemsetAsync(ws + WS_CTL, 0, CTL_ZERO_BYTES, stream);
    static int grid = 0;
    if (!grid) {
        int dev = 0, cus = 0;
        if (hipGetDevice(&dev) != hipSuccess || hipDeviceGetAttribute(&cus, hipDeviceAttributeMultiprocessorCount, dev) != hipSuccess) { grid = -1; return; }
        if (hipFuncSetAttribute((const void*)mk::fwd, hipFuncAttributeMaxDynamicSharedMemorySize, mk::LDS_BYTES) != hipSuccess) { grid = -1; return; }
        grid = cus;
    }
    if (grid < 0) return;
    mk::Args a{}; int nlaunch = 0;
    for (int i = 0; i < 22; ++i) a.in[i] = (const float*)d_in[i];
    a.out = out; a.ws = ws; a.use_ut = 1; a.mod_off = (int)WS_MOD; a.do_attn = 1;
#define MK_LAUNCH(lo_, hi_) do { a.ph_lo = (lo_); a.ph_hi = (hi_); a.bar_idx = nlaunch++; hipLaunchKernelGGL(mk::fwd, dim3(grid), dim3(mk::NTHREADS), mk::LDS_BYTES, stream, a); } while (0)
    MK_LAUNCH(mk::PH_PRO, mk::PH_END);
}
```

```cpp
#include <hip/hip_runtime.h>
#include <stdint.h>
#include <math.h>

typedef unsigned short bf16_t;
typedef short bf16x8 __attribute__((ext_vector_type(8)));
typedef float f32x16 __attribute__((ext_vector_type(16)));
typedef float f32x4 __attribute__((ext_vector_type(4)));

constexpr int NB = 2, SEQ = 4096, DM = 2048, NTOK = NB * SEQ, CTXL = 256, NCTX = NB * CTXL, HD = 128, NH = 16, NKV = 4;
constexpr int SKV = SEQ + CTXL;
constexpr int FW = 1024, INC = 8192, Q_OFF = 1024, K_OFF = 3072, V_OFF = 3584, GF_OFF = 4096, GA_OFF = 6144;
constexpr int KVW = NKV * HD;
constexpr int NE = 64, TOPK = 8, EFF = 512, MODC = 6 * DM;
constexpr int NSLOT = NTOK * TOPK;
constexpr int NSLOT_ALL = NSLOT + NTOK;

constexpr size_t MiB = 1u << 20;
constexpr size_t WS_CTL = 0, CTL_ZERO_BYTES = 1 * MiB;
constexpr size_t CTL_CNT = 64 * 1024;
constexpr size_t WS_TW = 1 * MiB;
constexpr size_t WS_MOD = 1 * MiB + 64 * 1024;
constexpr size_t WS_OFFS = 1 * MiB + 256 * 1024;
constexpr size_t WS_EIDX = 2 * MiB;
constexpr size_t WS_EW = WS_EIDX + 256 * 1024;
constexpr size_t WS_EPOS = WS_EW + 256 * 1024;
constexpr size_t WS_SLOTOF = WS_EPOS + 256 * 1024;
constexpr size_t WS_TOK = 3 * MiB;
constexpr size_t WS_H = 4 * MiB;
constexpr size_t WS_U = 38 * MiB;
constexpr size_t WS_Q = 54 * MiB;
constexpr size_t WS_KALL = 86 * MiB;
constexpr size_t WS_VALL = 95 * MiB;
constexpr size_t WS_SGF = 104 * MiB;
constexpr size_t WS_SGA = 136 * MiB;
constexpr size_t WS_YA = 168 * MiB;
constexpr size_t WS_YF = 200 * MiB;
constexpr size_t WS_PR = 216 * MiB;
constexpr size_t WS_T1 = 248 * MiB;
constexpr size_t WS_YM = 312 * MiB;
constexpr size_t WS_QKRAW = 248 * MiB;
constexpr size_t WS_KCRAW = 330 * MiB;
constexpr size_t WS_H2 = 344 * MiB;
constexpr size_t WS_ACT = 376 * MiB;
constexpr size_t WS_YBIG = 4 * MiB;
constexpr size_t WS_END = 740 * MiB;

__device__ __forceinline__ float bf2f(bf16_t h) { return __uint_as_float(((unsigned)h) << 16); }
__device__ __forceinline__ bf16_t f2bf(float f) { unsigned u = __float_as_uint(f); return (bf16_t)((u + 0x7fffu + ((u >> 16) & 1u)) >> 16); }
__device__ __forceinline__ int crow(int r, int hi) { return (r & 3) + 8 * (r >> 2) + 4 * hi; }
__device__ __forceinline__ float wave_sum(float v) {
#pragma unroll
    for (int o = 1; o < 64; o <<= 1) v += __shfl_xor(v, o);
    return v;
}
__device__ __forceinline__ float sigmoidf_(float v) { return 1.0f / (1.0f + expf(-v)); }
__device__ __forceinline__ bf16x8 pack8(const float* f) {
    bf16x8 r;
#pragma unroll
    for (int i = 0; i < 8; ++i) r[i] = (short)f2bf(f[i]);
    return r;
}

#define LAS __attribute__((address_space(3)))
#define GAS __attribute__((address_space(1)))
typedef unsigned u32x4 __attribute__((ext_vector_type(4)));
typedef GAS unsigned gu32;
#define RLX_AGENT __ATOMIC_RELAXED, __HIP_MEMORY_SCOPE_AGENT
#define LDS_WAIT() asm volatile("s_waitcnt lgkmcnt(0)" ::: "memory")
#define VM_WAIT() asm volatile("s_waitcnt vmcnt(0)" ::: "memory")

constexpr size_t CTL_BAR = 16384;
constexpr size_t CTL_MODZ = 512 * 1024;
constexpr size_t WS_UT = 38 * MiB;
constexpr size_t WS_TT = 216 * MiB;
constexpr size_t WS_WT_GU = 450 * MiB;
constexpr size_t WS_WT_D = 710 * MiB;
constexpr size_t WS_WT_IN = 840 * MiB;
constexpr size_t WS_WT_FO = 872 * MiB;
constexpr size_t WS_WT_AO = 876 * MiB;
constexpr size_t WS_WT_O = 884 * MiB;
constexpr size_t WS_CST = 892 * MiB;
constexpr size_t WS_ET = 908 * MiB;
constexpr size_t WS_OT = 916 * MiB;
constexpr size_t WS_W2048 = 1 * MiB + 512 * 1024;
constexpr size_t WS_ALT = 1 * MiB + 520 * 1024;
constexpr size_t WS_BD2 = 956 * MiB;
constexpr size_t WS_X2 = 960 * MiB;
constexpr size_t WS_END2 = 1024 * MiB;

namespace mk {
constexpr int NWAVES = 8, NTHREADS = 512;
constexpr int RING_BYTES = 131072, SCR_BYTES = 8 * 16640, LDSCTL_OFF = 135168, MISC_OFF = LDSCTL_OFF + 320, GPARK_OFF = LDSCTL_OFF + 2048  , LDS_BYTES = 147456;
static_assert(GPARK_OFF + 8192 <= LDS_BYTES, "LDS map");
static_assert(SCR_BYTES <= LDSCTL_OFF && MISC_OFF + 128 <= LDS_BYTES, "LDS map");

#define XB_TMO      128
#define XB_XCNT(j)  (256  + 64 * (j))
#define XB_XSUB(j)  (1280 + 64 * (j))
#define XB_XGEN(j)  (2304 + 64 * (j))
#define XB_TOP      3328
#define XB_TOPGEN   3392
#define XCD_BAR_WORDS 3456
#define XB_SPIN_CAP (1u << 18)
__device__ __forceinline__ unsigned xb_ld(unsigned* p)              { return __hip_atomic_load(p, __ATOMIC_RELAXED, __HIP_MEMORY_SCOPE_AGENT); }
__device__ __forceinline__ unsigned xb_add(unsigned* p, unsigned v) { return __hip_atomic_fetch_add(p, v, __ATOMIC_RELAXED, __HIP_MEMORY_SCOPE_AGENT); }
__device__ __forceinline__ unsigned xb_xcc_id() { return (unsigned)__builtin_amdgcn_s_getreg((3 << 11) | 20) & 0xFu; }
#define XB_SPIN(cond, bar) do { unsigned _sp = 0; while (cond) { __builtin_amdgcn_s_sleep(1); \
    if ((++_sp & 255u) == 0u) { if (xb_ld(&(bar)[XB_TMO])) break; if (_sp > XB_SPIN_CAP) { atomicAdd(&(bar)[XB_TMO], 1u); break; } } } } while (0)
struct XcdBarrier { unsigned* bar; unsigned x; volatile LAS unsigned* st; };
__device__ __forceinline__ XcdBarrier xcd_barrier_post(unsigned* bar, volatile LAS unsigned* st) {
    XcdBarrier b; b.bar = bar; b.x = xb_xcc_id(); b.st = st;
    if (threadIdx.x == 0) (void)xb_add(&bar[XB_XCNT(b.x)], 1u);
    return b;
}
__device__ __forceinline__ void xcd_barrier_complete(unsigned* bar, unsigned x, unsigned& nloc, unsigned& nx) {
    const unsigned G = gridDim.x * gridDim.y * gridDim.z;
    unsigned sum, cnt, mine, sp = 0u;
    for (;;) {
        sum = 0u; cnt = 0u; mine = 0u;
#pragma unroll
        for (unsigned j = 0; j < 16; ++j) { const unsigned c = xb_ld(&bar[XB_XCNT(j)]); sum += c; cnt += (c > 0u) ? 1u : 0u; mine = (j == x) ? c : mine; }
        if (sum == G) break;
        __builtin_amdgcn_s_sleep(1);
        if ((++sp & 255u) == 0u) { if (xb_ld(&bar[XB_TMO])) break; if (sp > XB_SPIN_CAP) { atomicAdd(&bar[XB_TMO], 1u); break; } }
    }
    nloc = mine > 0u ? mine : 1u; nx = cnt > 0u ? cnt : 1u;
}
__device__ __forceinline__ void xcd_barrier(const XcdBarrier& b) {
    asm volatile("s_waitcnt vmcnt(0)" ::: "memory");
    __syncthreads();
    if (threadIdx.x == 0) {
        unsigned* bar = b.bar;
        __builtin_amdgcn_s_waitcnt(0);
        unsigned nloc = b.st[0], nx = b.st[1];
        if (nloc == 0u) { xcd_barrier_complete(bar, b.x, nloc, nx); b.st[0] = nloc; b.st[1] = nx; }
        const unsigned old = xb_add(&bar[XB_XSUB(b.x)], 1u);
        const unsigned gen = old / nloc;
        if (old + 1u == (gen + 1u) * nloc) {
            __builtin_amdgcn_fence(__ATOMIC_RELEASE, "agent");
            asm volatile("s_waitcnt vmcnt(0)" ::: "memory");
            const unsigned og = xb_add(&bar[XB_TOP], 1u);
            const unsigned tg = og / nx;
            if (og + 1u == (tg + 1u) * nx) xb_add(&bar[XB_TOPGEN], 1u);
            else XB_SPIN(xb_ld(&bar[XB_TOPGEN]) == tg, bar);
            __builtin_amdgcn_fence(__ATOMIC_ACQUIRE, "agent");
            xb_add(&bar[XB_XGEN(b.x)], 1u);
            asm volatile("s_waitcnt vmcnt(0)" ::: "memory");
        } else {
            XB_SPIN(xb_ld(&bar[XB_XGEN(b.x)]) == gen, bar);
            __builtin_amdgcn_fence(__ATOMIC_ACQUIRE, "agent");
            asm volatile("s_waitcnt vmcnt(0)" ::: "memory");
        }
    }
    __syncthreads();
}

constexpr int BM = 256, BK = 64, HALF = 128, HTB = HALF * BK * 2, STAGE_BYTES = 8 * HTB;
__device__ __forceinline__ int lds_byte(int r, int c) { const int st = (r >> 4) * 2 + (c >> 5), rr = r & 15, cc = c & 31, ob = rr * 64 + cc * 2; return st * 1024 + (ob ^ (((ob >> 9) & 1) << 5)); }
__device__ __forceinline__ void stage_rc(int b, int& R, int& C) { const int st = b / 1024, sb = b % 1024, swz = sb ^ (((sb >> 9) & 1) << 5); R = (st >> 1) * 16 + swz / 64; C = (st & 1) * 32 + (swz % 64) / 2; }
__device__ __forceinline__ int perm32(int rho) { const int n = rho >> 4, i = rho & 15; return 8 * (i >> 2) + 4 * n + (i & 3); }
__device__ __forceinline__ unsigned cvt_pk_bf16(float lo, float hi) { unsigned r; asm volatile("v_cvt_pk_bf16_f32 %0, %1, %2" : "=v"(r) : "v"(lo), "v"(hi)); return r; }

__device__ __forceinline__ void glds16_s(const void* sbase, unsigned voff, unsigned lds_dst) { unsigned keep;
    asm volatile("s_mov_b32 %0, m0\n\ts_mov_b32 m0, %3\n\ts_nop 0\n\tglobal_load_lds_dwordx4 %1, %2\n\ts_mov_b32 m0, %0" : "=&s"(keep) : "v"(voff), "s"(sbase), "s"(lds_dst) : "memory"); }

struct Unit { const char* A; const char* B; char* C; int ldc; int mode; int rows; int aux; int pm, pn, bjs, rmin; };

template <class Epi, class Sched, bool GATHER>
__device__ __forceinline__ void gemm_phase(LAS unsigned char* lds, const int K, const int lda, const int ldb, const Sched& S, const Epi& E) {
    const int tid = threadIdx.x, wid = __builtin_amdgcn_readfirstlane(tid >> 6), lane = tid & 63, wr = wid >> 2, wc = wid & 3, fr = lane & 15, fq = lane >> 4;
    const int nt = K / BK;
    unsigned voffA[2], voffB[2];
#pragma unroll
    for (int i = 0; i < 2; ++i) { int R, C; stage_rc(tid * 16 + i * 8192, R, C); const int Rb = (R & ~31) + perm32(R & 31);
        voffA[i] = (unsigned)(R * lda + C) * 2u; voffB[i] = (unsigned)(Rb * ldb + C) * 2u; }
    const size_t kstep = (size_t)(BK * 2);
    const size_t hstepA = (size_t)HALF * lda * 2, hstepB = (size_t)HALF * ldb * 2;
    const unsigned ldsw = (unsigned)wid * 1024u;
    const unsigned ldsbase = (unsigned)__builtin_amdgcn_readfirstlane((int)(unsigned)(uintptr_t)lds);
    const int aoff = lds_byte(wr * 64 + fr, fq * 8), boff = lds_byte(wc * 32 + fr, fq * 8);
#define MK_SA(b, h) (((b) * 2 + (h)) * HTB)
#define MK_SB(b, h) ((4 + (b) * 2 + (h)) * HTB)
#define MK_STAGE2(bufoff, gbase, v0, v1) do { \
        __builtin_amdgcn_global_load_lds((const unsigned*)((const char*)(gbase) + (v0)), (LAS unsigned*)(lds + (bufoff) + ldsw), 16, 0, 0); \
        __builtin_amdgcn_global_load_lds((const unsigned*)((const char*)(gbase) + (v1)), (LAS unsigned*)(lds + (bufoff) + ldsw + 8192), 16, 0, 0); } while (0)
#define MK_STAGE_B(bufoff, gbase) do { glds16_s((gbase), voffB[0], ldsbase + (bufoff) + ldsw); glds16_s((gbase), voffB[1], ldsbase + (bufoff) + ldsw + 8192u); } while (0)
#define MK_STAGE_A(bufoff, gbase, h, VA) do { if constexpr (GATHER) { glds16_s((gbase), (VA)[h][0], ldsbase + (bufoff) + ldsw); glds16_s((gbase), (VA)[h][1], ldsbase + (bufoff) + ldsw + 8192u); } \
        else { glds16_s((gbase) + (h) * hstepA, voffA[0], ldsbase + (bufoff) + ldsw); glds16_s((gbase) + (h) * hstepA, voffA[1], ldsbase + (bufoff) + ldsw + 8192u); } } while (0)
#define MK_LDA(dst, b, h) do { _Pragma("unroll") for (int m = 0; m < 4; ++m) _Pragma("unroll") for (int k = 0; k < 2; ++k) dst[m][k] = *(const LAS bf16x8*)(lds + MK_SA(b, h) + aoff + m * 2048 + k * 1024); } while (0)
#define MK_LDB(dst, b, h) do { _Pragma("unroll") for (int n = 0; n < 2; ++n) _Pragma("unroll") for (int k = 0; k < 2; ++k) dst[n][k] = *(const LAS bf16x8*)(lds + MK_SB(b, h) + boff + n * 2048 + k * 1024); } while (0)
#define MK_MMA(ai, bj, At, Bt) do { __builtin_amdgcn_s_setprio(1); _Pragma("unroll") for (int m = 0; m < 4; ++m) _Pragma("unroll") for (int n = 0; n < 2; ++n) _Pragma("unroll") for (int k = 0; k < 2; ++k) \
        acc[ai][bj][m][n] = __builtin_amdgcn_mfma_f32_16x16x32_bf16(Bt[n][k], At[m][k], acc[ai][bj][m][n], 0, 0, 0); __builtin_amdgcn_s_setprio(0); } while (0)
#define MK_WAIT_V(n) asm volatile("s_waitcnt vmcnt(" #n ")" ::: "memory")
#define MK_WAIT_L(n) asm volatile("s_waitcnt lgkmcnt(" #n ")" ::: "memory")
#define MK_BAR __builtin_amdgcn_s_barrier()
#define MK_SCHED __builtin_amdgcn_sched_barrier(0)
    Unit cur, nxt; int ui = 0;
    if (!S.next(0, cur)) return;
    f32x4 acc[2][2][4][2];
#pragma unroll
    for (int a = 0; a < 2; ++a)
#pragma unroll
        for (int b = 0; b < 2; ++b)
#pragma unroll
            for (int m = 0; m < 4; ++m)
#pragma unroll
                for (int n = 0; n < 2; ++n) acc[a][b][m][n] = (f32x4){0.f, 0.f, 0.f, 0.f};
    bf16x8 At[4][2], B0[2][2], B1[2][2];
    unsigned vC[2][2];
    LAS u32x4* vpark = (LAS u32x4*)(lds + GPARK_OFF) + tid;
    if constexpr (GATHER) {
#pragma unroll
        for (int h = 0; h < 2; ++h)
#pragma unroll
            for (int i = 0; i < 2; ++i) { int R, C; stage_rc(tid * 16 + i * 8192, R, C); vC[h][i] = S.arow(cur, h * HALF + R) + (unsigned)(C * 2); }
    }
    const char* cA = cur.A; const char* cB = cur.B;
    MK_STAGE_B(MK_SB(0, 0), cB); MK_STAGE_B(MK_SB(0, 1), cB + hstepB); MK_STAGE_A(MK_SA(0, 0), cA, 0, vC); MK_STAGE_A(MK_SA(0, 1), cA, 1, vC);
    if (wr == 1) MK_BAR;
    MK_WAIT_V(2); MK_BAR;
    MK_STAGE_B(MK_SB(1, 0), cB + kstep); MK_STAGE_A(MK_SA(1, 0), cA + kstep, 0, vC); MK_STAGE_B(MK_SB(1, 1), cB + hstepB + kstep);
    MK_WAIT_V(6); MK_BAR;
    for (;;) {
        const bool has_next = S.next(ui + 1, nxt);
        const char* nA = has_next ? nxt.A : cA; const char* nB = has_next ? nxt.B : cB;
        if constexpr (GATHER) {
            u32x4 pv;
#pragma unroll
            for (int h = 0; h < 2; ++h)
#pragma unroll
                for (int i = 0; i < 2; ++i) { int R, C; stage_rc(tid * 16 + i * 8192, R, C); pv[h * 2 + i] = has_next ? (S.arow(nxt, h * HALF + R) + (unsigned)(C * 2)) : vC[h][i]; }
            *vpark = pv;
        }
        for (int t = 0; t < nt; t += 2) {
            const bool last = (t == nt - 2);
            const char* a1 = cA + (size_t)(t + 1) * kstep;
            const char* a2 = last ? nA : cA + (size_t)(t + 2) * kstep; const char* b2 = last ? nB : cB + (size_t)(t + 2) * kstep;
            const char* a3 = a2 + kstep; const char* b3 = b2 + kstep;
            MK_LDB(B0, 0, 0); MK_LDB(B1, 0, 1); MK_SCHED; MK_LDA(At, 0, 0); MK_STAGE_A(MK_SA(1, 1), a1, 1, vC);
            if constexpr (GATHER) { if (last) { const u32x4 pv = *vpark; vC[0][0] = pv[0]; vC[0][1] = pv[1]; vC[1][0] = pv[2]; vC[1][1] = pv[3]; } }
            MK_WAIT_V(8); MK_WAIT_L(0); MK_BAR; MK_MMA(0, 0, At, B0); MK_MMA(0, 1, At, B1); MK_BAR; MK_SCHED;
            MK_LDA(At, 0, 1); MK_STAGE_B(MK_SB(0, 0), b2); MK_STAGE_B(MK_SB(0, 1), b2 + hstepB); MK_STAGE_A(MK_SA(0, 0), a2, 0, vC);
            MK_WAIT_V(8); MK_WAIT_L(0); MK_BAR; MK_MMA(1, 0, At, B0); MK_MMA(1, 1, At, B1); MK_BAR; MK_SCHED;
            MK_LDB(B0, 1, 0); MK_LDB(B1, 1, 1); MK_SCHED; MK_LDA(At, 1, 0); MK_STAGE_A(MK_SA(0, 1), a2, 1, vC);
            MK_WAIT_V(8); MK_WAIT_L(0); MK_BAR; MK_MMA(0, 0, At, B0); MK_MMA(0, 1, At, B1); MK_BAR; MK_SCHED;
            MK_LDA(At, 1, 1); MK_STAGE_B(MK_SB(1, 0), b3); MK_STAGE_B(MK_SB(1, 1), b3 + hstepB); MK_STAGE_A(MK_SA(1, 0), a3, 0, vC);
            MK_WAIT_V(8); MK_WAIT_L(0); MK_BAR; MK_MMA(1, 0, At, B0); MK_MMA(1, 1, At, B1); MK_BAR; MK_SCHED;
        }
        if (wr == 0) MK_BAR;
        E(acc, cur, wr, wc, fr, fq);
        if (!has_next) break;
#pragma unroll
        for (int a = 0; a < 2; ++a)
#pragma unroll
            for (int b = 0; b < 2; ++b)
#pragma unroll
                for (int m = 0; m < 4; ++m)
#pragma unroll
                    for (int n = 0; n < 2; ++n) acc[a][b][m][n] = (f32x4){0.f, 0.f, 0.f, 0.f};
        cur = nxt; cA = nA; cB = nB; ++ui;
        if (wr == 1) MK_BAR;
    }
    MK_WAIT_V(0);
    MK_BAR;
#undef MK_SA
#undef MK_SB
#undef MK_STAGE2
#undef MK_STAGE_B
#undef MK_STAGE_A
#undef MK_LDA
#undef MK_LDB
#undef MK_MMA
#undef MK_WAIT_V
#undef MK_WAIT_L
#undef MK_BAR
#undef MK_SCHED
}

__device__ __forceinline__ void grid_map(int L, int nM, int nN, int& pm, int& pn) {
    const int nwg = nM * nN, q = nwg / 8, xcd = L % 8, off = L / 8; const int wgid = xcd * q + off;
    const int nig = 8 * nN, gid = wgid / nig, fm = gid * 8, gsz = (nM - fm) < 8 ? (nM - fm) : 8;
    pm = fm + ((wgid % nig) % gsz); pn = (wgid % nig) / gsz;
}

struct EpiStore {
    const float* w2048;
    __device__ __forceinline__ void operator()(const f32x4 (&acc)[2][2][4][2], const Unit& u, int wr, int wc, int fr, int fq) const {
        const int col0 = wc * 32 + 8 * fq;
#pragma unroll
        for (int ai = 0; ai < 2; ++ai)
#pragma unroll
            for (int m = 0; m < 4; ++m) {
                const int r = ai * HALF + wr * 64 + m * 16 + fr;
                if (r < u.rows && r >= u.rmin) {
#pragma unroll
                    for (int bj = 0; bj < 2; ++bj) {
                        f32x4 v0 = acc[ai][bj][m][0], v1 = acc[ai][bj][m][1];
                        if (u.mode == 1) { float* p = (float*)u.C + (long)r * u.ldc + col0 + bj * u.bjs; *(f32x4*)p = v0; *(f32x4*)(p + 4) = v1; }
                        else {
                            if (u.mode == 2) {
#pragma unroll
                                for (int c = 0; c < 4; ++c) { v0[c] = __builtin_amdgcn_rcpf(1.0f + __expf(-v0[c])); v1[c] = __builtin_amdgcn_rcpf(1.0f + __expf(-v1[c])); }
                            } else if (u.mode == 3) {
                                const float* wp = w2048 + u.pn + bj * HALF + col0; const float sg = (r & 1) ? -1.0f : 1.0f;
                                v0 += *(const f32x4*)wp * sg; v1 += *(const f32x4*)(wp + 4) * sg;
                            }
                            u32x4 w; w.x = cvt_pk_bf16(v0[0], v0[1]); w.y = cvt_pk_bf16(v0[2], v0[3]); w.z = cvt_pk_bf16(v1[0], v1[1]); w.w = cvt_pk_bf16(v1[2], v1[3]);
                            *(u32x4*)((bf16_t*)u.C + (long)r * u.ldc + col0 + bj * u.bjs) = w;
                        }
                    }
                }
            }
    }
};

struct Frame {
    LAS unsigned char* lds; volatile LAS unsigned* MISC; unsigned char* ws;
    int tid, lane, wave, vcu, G;
    const float* in[22]; float* out;
};

__device__ __forceinline__ void transpose64(const float* W, int ldw, bf16_t* dst, int ldd, LAS float* scr, int lane) {
    f32x4 v[16];
    const int kk = lane >> 4, nc = (lane & 15) * 4;
#pragma unroll
    for (int j = 0; j < 16; ++j) v[j] = *(const GAS f32x4*)(W + (size_t)(j * 4 + kk) * ldw + nc);
#pragma unroll
    for (int j = 0; j < 16; ++j) {
#pragma unroll
        for (int c = 0; c < 4; ++c) scr[(j * 4 + kk) * 65 + nc + c] = v[j][c]; }
    LDS_WAIT(); asm volatile("" ::: "memory");
    const int kc = lane & 7;
#pragma unroll
    for (int jj = 0; jj < 8; ++jj) { const int n = (lane >> 3) + 8 * jj; const LAS float* s = scr + (8 * kc) * 65 + n;
        u32x4 o; o.x = cvt_pk_bf16(s[0 * 65], s[1 * 65]); o.y = cvt_pk_bf16(s[2 * 65], s[3 * 65]); o.z = cvt_pk_bf16(s[4 * 65], s[5 * 65]); o.w = cvt_pk_bf16(s[6 * 65], s[7 * 65]);
        *(GAS u32x4*)(dst + (size_t)n * ldd + 8 * kc) = o; }
    LDS_WAIT(); asm volatile("" ::: "memory");
}

constexpr int IT_IN = 32 * 128, IT_FO = 16 * 32, IT_AO = 32 * 32, IT_O = 32 * 32, IT_EG = 64 * 256, IT_EU = 64 * 256, IT_ED = 64 * 256, IT_SH = 256;
constexpr int IT_T_END = IT_IN + IT_FO + IT_AO + IT_O + IT_EG + IT_EU + IT_ED + 3 * IT_SH;
constexpr int IT_MOD = MODC / 32, IT_CST = 4096, IT_BD2 = 512;
constexpr int IT_ALL = IT_T_END + IT_MOD + IT_CST + IT_BD2;

__device__ __forceinline__ void p0_prologue(Frame& F) {
    LAS float* scr = (LAS float*)(F.lds + F.wave * 16640);
    const int gw = F.vcu * NWAVES + F.wave, NGW = F.G * NWAVES, lane = F.lane;
    unsigned char* ws = F.ws;
    bf16_t* WT_IN = (bf16_t*)(ws + WS_WT_IN); bf16_t* WT_FO = (bf16_t*)(ws + WS_WT_FO); bf16_t* WT_AO = (bf16_t*)(ws + WS_WT_AO); bf16_t* WT_O = (bf16_t*)(ws + WS_WT_O);
    bf16_t* WT_GU = (bf16_t*)(ws + WS_WT_GU); bf16_t* WT_D = (bf16_t*)(ws + WS_WT_D);
    for (int it = gw; it < IT_ALL; it += NGW) {
        int r = it < IT_MOD ? it + IT_T_END : (it < IT_T_END + IT_MOD ? it - IT_MOD : it);
        if (r < IT_IN) { const int kb = r / 128, nb = r % 128; transpose64(F.in[7] + (size_t)(kb * 64) * INC + nb * 64, INC, WT_IN + (size_t)(nb * 64) * DM + kb * 64, DM, scr, lane); continue; } r -= IT_IN;
        if (r < IT_FO) { const int kb = r / 32, nb = r % 32; transpose64(F.in[10] + (size_t)(kb * 64) * DM + nb * 64, DM, WT_FO + (size_t)(nb * 64) * FW + kb * 64, FW, scr, lane); continue; } r -= IT_FO;
        if (r < IT_AO) { const int kb = r / 32, nb = r % 32; transpose64(F.in[11] + (size_t)(kb * 64) * DM + nb * 64, DM, WT_AO + (size_t)(nb * 64) * DM + kb * 64, DM, scr, lane); continue; } r -= IT_AO;
        if (r < IT_O) { const int kb = r / 32, nb = r % 32; transpose64(F.in[12] + (size_t)(kb * 64) * DM + nb * 64, DM, WT_O + (size_t)(nb * 64) * DM + kb * 64, DM, scr, lane); continue; } r -= IT_O;
        if (r < IT_EG + IT_EU) {
            const int up = r >= IT_EG; if (up) r -= IT_EG;
            const int e = r / 256, q = r % 256, kb = q / 8, nb = q % 8, n0 = nb * 64;
            const float* W = (up ? F.in[17] : F.in[16]) + (size_t)e * DM * EFF + (size_t)(kb * 64) * EFF + n0;
            transpose64(W, EFF, WT_GU + ((size_t)e * 1024 + (n0 >> 7) * 256 + (up ? 128 : 0) + (n0 & 127)) * DM + kb * 64, DM, scr, lane); continue; } r -= IT_EG + IT_EU;
        if (r < IT_ED) { const int e = r / 256, q = r % 256, kb = q / 32, nb = q % 32;
            transpose64(F.in[18] + (size_t)e * EFF * DM + (size_t)(kb * 64) * DM + nb * 64, DM, WT_D + ((size_t)e * DM + nb * 64) * EFF + kb * 64, EFF, scr, lane); continue; } r -= IT_ED;
        if (r < 2 * IT_SH) { const int up = r >= IT_SH; if (up) r -= IT_SH; const int kb = r / 8, nb = r % 8, n0 = nb * 64;
            transpose64((up ? F.in[20] : F.in[19]) + (size_t)(kb * 64) * EFF + n0, EFF, WT_GU + ((size_t)64 * 1024 + (n0 >> 7) * 256 + (up ? 128 : 0) + (n0 & 127)) * DM + kb * 64, DM, scr, lane); continue; } r -= 2 * IT_SH;
        if (r < IT_SH) { const int kb = r / 32, nb = r % 32;
            transpose64(F.in[21] + (size_t)(kb * 64) * DM + nb * 64, DM, WT_D + ((size_t)64 * DM + nb * 64) * EFF + kb * 64, EFF, scr, lane); continue; } r -= IT_SH;
        if (r < IT_MOD) {
            const int kq = lane >> 3, col = r * 32 + (lane & 7) * 4;
            f32x4 a0 = {0.f, 0.f, 0.f, 0.f}, a1 = a0, a2 = a0;
#pragma unroll 16
            for (int j = 0; j < 256; ++j) { const int k = kq + 8 * j;
                const f32x4 w = *(const GAS f32x4*)(F.in[4] + (size_t)k * MODC + col);
                const float c0 = F.in[1][k], c1 = F.in[1][DM + k], c2 = F.in[3][k];
                a0 += w * (c0 / (1.0f + __expf(-c0))); a1 += w * (c1 / (1.0f + __expf(-c1))); a2 += w * (c2 / (1.0f + __expf(-c2))); }
#pragma unroll
            for (int c = 0; c < 4; ++c) {
#pragma unroll
                for (int o = 8; o < 64; o <<= 1) { a0[c] += __shfl_xor(a0[c], o); a1[c] += __shfl_xor(a1[c], o); a2[c] += __shfl_xor(a2[c], o); } }
            if (kq == 0) { const f32x4 bb = *(const GAS f32x4*)(F.in[5] + col); float* MODP = (float*)(ws + WS_MOD);
                *(GAS f32x4*)(MODP + col) = a0 + bb; *(GAS f32x4*)(MODP + MODC + col) = a1 + bb; *(GAS f32x4*)(MODP + 2 * MODC + col) = a2 + bb; }
            continue; } r -= IT_MOD;
        if (r < IT_CST) {
            const int k1 = r & 2047; bf16_t* dst = (bf16_t*)(ws + WS_CST) + (size_t)r * 2048;
#pragma unroll
            for (int j = 0; j < 4; ++j) { const int n0 = j * 512 + lane * 8; float f[8];
#pragma unroll
                for (int i = 0; i < 8; ++i) { const float ph = (float)((k1 * (n0 + i)) & 4095) * (1.0f / 2048.0f); f[i] = r < 2048 ? cospif(ph) : sinpif(ph); }
                u32x4 o; o.x = cvt_pk_bf16(f[0], f[1]); o.y = cvt_pk_bf16(f[2], f[3]); o.z = cvt_pk_bf16(f[4], f[5]); o.w = cvt_pk_bf16(f[6], f[7]);
                *(GAS u32x4*)(dst + n0) = o; }
            continue; } r -= IT_CST;
        {
            const int t = r >> 8, o = r & 255, gp = o >> 7, k2 = o & 127; bf16_t* dst = (bf16_t*)(ws + WS_BD2) + (size_t)r * 512; float f[8];
#pragma unroll
            for (int i = 0; i < 8; ++i) { const int j = lane * 8 + i, cg = j >> 8, jj = j & 255, c = jj & 127; const float ph = (float)((32 * c * k2) & 4095) * (1.0f / 2048.0f);
                const float v = jj < 128 ? cospif(ph) : (t ? sinpif(ph) : -sinpif(ph)); f[i] = cg == gp ? v * 0.0013810679320049757f : 0.f; }
            u32x4 w; w.x = cvt_pk_bf16(f[0], f[1]); w.y = cvt_pk_bf16(f[2], f[3]); w.z = cvt_pk_bf16(f[4], f[5]); w.w = cvt_pk_bf16(f[6], f[7]);
            *(GAS u32x4*)(dst + lane * 8) = w;
        }
    }
}

struct SchedIn {
    int G, c; unsigned char* ws; int use_ut;
    __device__ __forceinline__ bool next(int i, Unit& u) const {
        const int L = i * G + c; if (L >= 904) return false;
        const char* H = (const char*)(ws + WS_H); const char* WT = (const char*)(ws + WS_WT_IN);
        u.rows = 256; u.aux = 0; u.bjs = HALF; u.pm = 0; u.pn = 0; u.rmin = 0;
        if (L < 896) {
            int pm, ct; grid_map(L, 32, 28, pm, ct);
            const int row0 = pm * 256, b = row0 / SEQ, t0 = row0 % SEQ;
            u.A = H + (size_t)row0 * DM * 2; u.B = WT + (size_t)ct * 256 * DM * 2;
            if (ct < 4) {
                if (use_ut) { u.A = WT + (size_t)ct * 256 * DM * 2; u.B = H + (size_t)row0 * DM * 2;
                              u.C = (char*)(ws + WS_UT) + (((size_t)b * FW + ct * 256) * SEQ + t0) * 2; u.ldc = SEQ; u.mode = 0; }
                else { u.C = (char*)(ws + WS_U) + ((size_t)row0 * FW + ct * 256) * 2; u.ldc = FW; u.mode = 0; }
            }
            else if (ct < 14) { u.C = (char*)(ws + WS_QKRAW) + ((size_t)row0 * 2560 + (ct - 4) * 256) * 4; u.ldc = 2560; u.mode = 1; }
            else if (ct < 16) { u.C = (char*)(ws + WS_VALL) + (((size_t)b * SKV + t0) * KVW + (ct - 14) * 256) * 2; u.ldc = KVW; u.mode = 0; }
            else if (ct < 24) { u.C = (char*)(ws + WS_SGF) + ((size_t)row0 * DM + (ct - 16) * 256) * 2; u.ldc = DM; u.mode = 2; }
            else              { u.C = (char*)(ws + WS_SGA) + ((size_t)row0 * DM + (ct - 24) * 256) * 2; u.ldc = DM; u.mode = 2; }
        } else {
            const int l = L - 896, pm = l & 1, ct = l >> 1;
            u.A = H + (size_t)(NTOK + pm * 256) * DM * 2; u.B = WT + (size_t)(K_OFF + ct * 256) * DM * 2;
            if (ct < 2) { u.C = (char*)(ws + WS_KCRAW) + ((size_t)(pm * 256) * KVW + ct * 256) * 4; u.ldc = KVW; u.mode = 1; }
            else        { u.C = (char*)(ws + WS_VALL) + (((size_t)pm * SKV + SEQ) * KVW + (ct - 2) * 256) * 2; u.ldc = KVW; u.mode = 0; }
        }
        return true;
    }
    __device__ __forceinline__ unsigned arow(const Unit&, int) const { return 0u; }
};


__device__ __forceinline__ void unpack8(u32x4 w, float (&f)[8]) {
#pragma unroll
    for (int i = 0; i < 4; ++i) { f[2 * i] = __uint_as_float(w[i] << 16); f[2 * i + 1] = __uint_as_float(w[i] & 0xffff0000u); }
}
struct EpiT1 { const bf16_t* SGF; float* T1;
    __device__ __forceinline__ void operator()(const f32x4 (&acc)[2][2][4][2], const Unit& u, int wr, int wc, int fr, int fq) const {
#pragma unroll
        for (int ai = 0; ai < 2; ++ai)
#pragma unroll
            for (int m = 0; m < 4; ++m) { const size_t row = (size_t)u.pm * 256 + ai * HALF + wr * 64 + m * 16 + fr;
#pragma unroll
                for (int bj = 0; bj < 2; ++bj) { const size_t o = row * DM + u.pn * 256 + bj * HALF + wc * 32 + 8 * fq;
                    float g[8]; unpack8(*(const u32x4*)(SGF + o), g); const f32x4 v0 = acc[ai][bj][m][0], v1 = acc[ai][bj][m][1];
                    *(f32x4*)(T1 + o) = (f32x4){g[0] * v0[0], g[1] * v0[1], g[2] * v0[2], g[3] * v0[3]};
                    *(f32x4*)(T1 + o + 4) = (f32x4){g[4] * v1[0], g[5] * v1[1], g[6] * v1[2], g[7] * v1[3]}; } }
    } };
struct EpiYM { const bf16_t* SGA; const float* T1; bf16_t* YM;
    __device__ __forceinline__ void operator()(const f32x4 (&acc)[2][2][4][2], const Unit& u, int wr, int wc, int fr, int fq) const {
#pragma unroll
        for (int ai = 0; ai < 2; ++ai)
#pragma unroll
            for (int m = 0; m < 4; ++m) { const size_t row = (size_t)u.pm * 256 + ai * HALF + wr * 64 + m * 16 + fr;
#pragma unroll
                for (int bj = 0; bj < 2; ++bj) { const size_t o = row * DM + u.pn * 256 + bj * HALF + wc * 32 + 8 * fq;
                    float g[8]; unpack8(*(const u32x4*)(SGA + o), g); const f32x4 v0 = acc[ai][bj][m][0], v1 = acc[ai][bj][m][1];
                    const f32x4 t0 = *(const f32x4*)(T1 + o), t1 = *(const f32x4*)(T1 + o + 4);
                    u32x4 w; w.x = cvt_pk_bf16(t0[0] + g[0] * v0[0], t0[1] + g[1] * v0[1]); w.y = cvt_pk_bf16(t0[2] + g[2] * v0[2], t0[3] + g[3] * v0[3]);
                    w.z = cvt_pk_bf16(t1[0] + g[4] * v1[0], t1[1] + g[5] * v1[1]); w.w = cvt_pk_bf16(t1[2] + g[6] * v1[2], t1[3] + g[7] * v1[3]);
                    *(u32x4*)(YM + o) = w; } }
    } };
struct EpiX2 { const float* x; const float* mod; float* X2;
    __device__ __forceinline__ void operator()(const f32x4 (&acc)[2][2][4][2], const Unit& u, int wr, int wc, int fr, int fq) const {
        const float* g1 = mod + ((u.pm * 256) / SEQ) * MODC + 2 * DM;
#pragma unroll
        for (int ai = 0; ai < 2; ++ai)
#pragma unroll
            for (int m = 0; m < 4; ++m) { const size_t row = (size_t)u.pm * 256 + ai * HALF + wr * 64 + m * 16 + fr;
#pragma unroll
                for (int bj = 0; bj < 2; ++bj) { const int col = u.pn * 256 + bj * HALF + wc * 32 + 8 * fq; const size_t o = row * DM + col;
#pragma unroll
                    for (int n = 0; n < 2; ++n) { const f32x4 xv = *(const f32x4*)(x + o + 4 * n), gv = *(const f32x4*)(g1 + col + 4 * n); *(f32x4*)(X2 + o + 4 * n) = xv + gv * acc[ai][bj][m][n]; } } }
    } };
struct EpiAct {
    __device__ __forceinline__ void operator()(const f32x4 (&acc)[2][2][4][2], const Unit& u, int wr, int wc, int fr, int fq) const {
#pragma unroll
        for (int ai = 0; ai < 2; ++ai)
#pragma unroll
            for (int m = 0; m < 4; ++m) { const int r = ai * HALF + wr * 64 + m * 16 + fr;
                if (r < u.rows) { float a[8];
#pragma unroll
                    for (int n = 0; n < 2; ++n)
#pragma unroll
                        for (int c = 0; c < 4; ++c) { const float g = acc[ai][0][m][n][c], up = acc[ai][1][m][n][c]; a[4 * n + c] = g * __builtin_amdgcn_rcpf(1.0f + __expf(-g)) * up; }
                    u32x4 w; w.x = cvt_pk_bf16(a[0], a[1]); w.y = cvt_pk_bf16(a[2], a[3]); w.z = cvt_pk_bf16(a[4], a[5]); w.w = cvt_pk_bf16(a[6], a[7]);
                    *(u32x4*)((bf16_t*)u.C + (size_t)r * u.ldc + wc * 32 + 8 * fq) = w; } }
    } };

struct SchedGrid {
    int G, c, nM, nN; const char* A; const char* B; char* C; size_t astride, bstride; int ldc, esz, mode;
    __device__ __forceinline__ bool next(int i, Unit& u) const {
        const int L = i * G + c; if (L >= nM * nN) return false;
        int pm, pn; grid_map(L, nM, nN, pm, pn);
        u.A = A + (size_t)pm * astride; u.B = B + (size_t)pn * bstride; u.C = C + ((size_t)pm * 256 * ldc + pn * 256) * esz; u.ldc = ldc; u.mode = mode; u.rows = 256; u.aux = 0; u.pm = pm; u.pn = pn; u.bjs = HALF; u.rmin = 0;
        return true; }
    __device__ __forceinline__ unsigned arow(const Unit&, int) const { return 0u; } };
struct SchedAG { int G, c; unsigned char* ws;
    __device__ __forceinline__ bool next(int i, Unit& u) const {
        const int L = i * G + c; if (L >= 256) return false;
        u.rows = 256; u.aux = 0; u.rmin = 0;
        if (L < 128) {
            int pm, pn8; grid_map(L, 16, 8, pm, pn8); const int b = pn8 >> 2, pn = pn8 & 3, sn = pm >> 3, k1t = pm & 7;
            u.A = (const char*)(ws + WS_CST) + (size_t)pm * 256 * 2048 * 2; u.B = (const char*)(ws + (sn ? WS_OT : WS_ET)) + ((size_t)b * FW + pn * 256) * 2048 * 2;
            u.C = (char*)(ws + WS_TT) + (((size_t)b * 2048 + k1t * 256) * DM + pn * 512 + sn * 128) * 2; u.ldc = DM; u.mode = sn ? 0 : 3; u.pm = k1t; u.pn = b * FW + pn * 256; u.bjs = 256;
        } else {
            int pm, q; grid_map(L - 128, 32, 4, pm, q); const int ct = 28 + q;
            u.A = (const char*)(ws + WS_H) + (size_t)pm * 256 * DM * 2; u.B = (const char*)(ws + WS_WT_IN) + (size_t)ct * 256 * DM * 2;
            u.C = (char*)(ws + WS_SGA) + ((size_t)pm * 256 * DM + (ct - 24) * 256) * 2; u.ldc = DM; u.mode = 2; u.pm = pm; u.pn = ct; u.bjs = HALF;
        }
        return true; }
    __device__ __forceinline__ unsigned arow(const Unit&, int) const { return 0u; } };
struct SchedF2 { int G, c; unsigned char* ws;
    __device__ __forceinline__ bool next(int i, Unit& u) const {
        const int L = i * G + c; if (L >= 128) return false;
        int pm, q; grid_map(L, 16, 8, pm, q); const int b = pm >> 3, k1t = pm & 7, j = q & 3, mir = q >> 2;
        u.A = (const char*)(ws + WS_TT) + (((size_t)b * 2048 + k1t * 256) * DM + j * 512) * 2; u.B = (const char*)(ws + WS_BD2) + (size_t)mir * 256 * 512 * 2;
        u.mode = 0; u.rows = 256; u.aux = 0; u.pm = pm; u.pn = j; u.bjs = HALF;
        if (!mir) { u.C = (char*)(ws + WS_YF) + (((size_t)b * SEQ + k1t * 256) * FW + j * 256) * 2; u.ldc = FW; u.rmin = 0; }
        else { u.C = (char*)(ws + WS_YF) + (((size_t)b * SEQ + SEQ - k1t * 256) * FW + j * 256) * 2; u.ldc = -FW; u.rmin = k1t == 0 ? 1 : 0; }
        return true; }
    __device__ __forceinline__ unsigned arow(const Unit&, int) const { return 0u; } };
constexpr int SCHT_OFF = LDSCTL_OFF + 1024;
__device__ __forceinline__ void moe_tables(Frame& F, int ncol_tiles) {
    LAS int* T = (LAS int*)(F.lds + SCHT_OFF);
    __syncthreads();
    if (F.tid == 0) { const int* CNT = (const int*)(F.ws + CTL_CNT); int up = 0, of = 0;
        for (int e = 0; e <= NE; ++e) { const int cn = e < NE ? CNT[e * 64] : NTOK; T[e] = up; T[80 + e] = e < NE ? of : NSLOT; T[160 + e] = cn; up += ((cn + 255) >> 8) * ncol_tiles; of += cn; }
        T[NE + 1] = up; }
    __syncthreads();
}
template <int NCT, bool FIRST> struct SchedMoe {
    int G, c; unsigned char* ws; LAS int* T; const int* TOK;
    __device__ __forceinline__ bool next(int i, Unit& u) const {
        const int L = i * G + c; if (L >= T[NE + 1]) return false;
        int lo = 0, hi = NE;
#pragma unroll 1
        while (lo < hi) { const int mid = (lo + hi + 1) >> 1; if (T[mid] <= L) lo = mid; else hi = mid - 1; }
        const int e = lo, cn = T[160 + e], ntile = (cn + 255) >> 8, local = L - T[e], ct = local / ntile, mt = local % ntile, slot0 = T[80 + e] + mt * 256;
        u.rows = (cn - mt * 256) < 256 ? (cn - mt * 256) : 256; u.aux = slot0; u.pm = mt; u.pn = ct; u.bjs = HALF; u.mode = 0; u.rmin = 0;
        if (FIRST) { u.A = (const char*)(ws + WS_H2); u.B = (const char*)(ws + WS_WT_GU) + ((size_t)e * 4 + ct) * 256 * DM * 2; u.C = (char*)(ws + WS_ACT) + ((size_t)slot0 * EFF + ct * 128) * 2; u.ldc = EFF; }
        else { u.A = (const char*)(ws + WS_ACT) + (size_t)slot0 * EFF * 2; u.B = (const char*)(ws + WS_WT_D) + ((size_t)e * DM + ct * 256) * EFF * 2; u.C = (char*)(ws + WS_YBIG) + ((size_t)slot0 * DM + ct * 256) * 2; u.ldc = DM; }
        return true; }
    __device__ __forceinline__ unsigned arow(const Unit& u, int r) const { const int rr = r < u.rows ? r : u.rows - 1; return (unsigned)TOK[u.aux + rr] * (unsigned)(DM * 2); } };

namespace attn {
using s16x4 = __attribute__((ext_vector_type(4))) short;
using f32x8 = __attribute__((ext_vector_type(8))) float;
constexpr int D = 128, NW = 8, QBLK = 32, KVBLK = 64;
constexpr float SCALE = 0.088388347648318440f;
constexpr float THR = 8.f;
constexpr int LDQ = DM, LDK = KVW, LDO = DM;
constexpr size_t SHM_V = KVBLK * D * 2, SHM_K = KVBLK * D * 2, SHM_ATTN = 2 * SHM_V + 2 * SHM_K + NW * 64 * 4;
#define KSWZ(row, colB) ((row) * 256 + ((colB) ^ (((row) & 7) << 4)))
#define SBAR() __builtin_amdgcn_sched_barrier(0)
__device__ __forceinline__ unsigned cvtpk(float lo, float hi) { unsigned r; asm volatile("v_cvt_pk_bf16_f32 %0, %1, %2" : "=v"(r) : "v"(lo), "v"(hi)); return r; }
__device__ __forceinline__ void partialSM(f32x16& p0, f32x16& p1, float& m_reg, float& mn, float& alpha) {
  constexpr float C = SCALE * 1.4426950408889634f;
  float pmax = p0[0]; for (int r = 1; r < 16; ++r) pmax = fmaxf(pmax, p0[r]); for (int r = 0; r < 16; ++r) pmax = fmaxf(pmax, p1[r]);
  { auto rr = __builtin_amdgcn_permlane32_swap(__float_as_uint(pmax), __float_as_uint(pmax), false, false);
    pmax = fmaxf(__uint_as_float(rr[0]), __uint_as_float(rr[1])); }
  if (__builtin_expect(__all(pmax - m_reg <= THR / SCALE), 1)) { mn = m_reg; alpha = 1.f; }
  else { mn = fmaxf(m_reg, pmax); alpha = __builtin_amdgcn_exp2f((m_reg - mn) * C); m_reg = mn; }
  float mnC = -mn * C;
  for (int r = 0; r < 16; ++r) p0[r] = fmaf(p0[r], C, mnC); for (int r = 0; r < 16; ++r) p1[r] = fmaf(p1[r], C, mnC);
  for (int r = 0; r < 16; ++r) p0[r] = __builtin_amdgcn_exp2f(p0[r]);
}
__device__ __forceinline__ void finishSM(f32x16& p0, f32x16& p1, float alpha, float& l_reg, bf16x8& pa0, bf16x8& pa1, bf16x8& pa2, bf16x8& pa3) {
  for (int r = 0; r < 16; ++r) p1[r] = __builtin_amdgcn_exp2f(p1[r]);
  float ps = 0; for (int r = 0; r < 16; ++r) ps += p0[r]; for (int r = 0; r < 16; ++r) ps += p1[r];
  { auto rr = __builtin_amdgcn_permlane32_swap(__float_as_uint(ps), __float_as_uint(ps), false, false);
    ps = __uint_as_float(rr[0]) + __uint_as_float(rr[1]); }
  l_reg = l_reg * alpha + ps;
#define PK4(P, BASE, OUT) do { unsigned a0 = cvtpk(P[BASE + 0], P[BASE + 1]), a1 = cvtpk(P[BASE + 2], P[BASE + 3]);   \
    unsigned b0 = cvtpk(P[BASE + 4], P[BASE + 5]), b1 = cvtpk(P[BASE + 6], P[BASE + 7]);                              \
    auto r0 = __builtin_amdgcn_permlane32_swap(a0, b0, false, false); auto r1 = __builtin_amdgcn_permlane32_swap(a1, b1, false, false); \
    u32x4 w = {r0[0], r1[0], r0[1], r1[1]}; OUT = *reinterpret_cast<bf16x8*>(&w); } while (0)
  PK4(p0, 0, pa0); PK4(p0, 8, pa1); PK4(p1, 0, pa2); PK4(p1, 8, pa3);
#undef PK4
}
__device__ __forceinline__ void qkt(f32x16& p0, f32x16& p1, const bf16_t* Ks, const bf16x8* qr, int r32, int hi) {
  p0 = f32x16{}; p1 = f32x16{};
  for (int d0 = 0; d0 < 8; ++d0) { int cb = (d0 * 16 + hi * 8) * 2;
    bf16x8 b0 = *reinterpret_cast<const bf16x8*>((const char*)Ks + KSWZ(r32, cb));
    bf16x8 b1 = *reinterpret_cast<const bf16x8*>((const char*)Ks + KSWZ(32 + r32, cb));
    p0 = __builtin_amdgcn_mfma_f32_32x32x16_bf16(b0, qr[d0], p0, 0, 0, 0);
    p1 = __builtin_amdgcn_mfma_f32_32x32x16_bf16(b1, qr[d0], p1, 0, 0, 0); }
}
__device__ __forceinline__ int v_st(int k, int c) { const int kk = (k & ~0xC) | ((k & 4) << 1) | ((k & 8) >> 1); return ((kk >> 3) * 4 + (c >> 5)) * 512 + ((kk & 7) * 32 + (c & 31)) * 2; }
__device__ __forceinline__ int v_rd_base(int lane) { return ((lane & 3) << 3) | (((lane >> 2) & 3) << 6) | (((lane >> 4) & 1) << 5) | (((lane >> 5) & 1) << 8); }
constexpr int v_rd_off(int d0, int ks, int half) { return d0 * 512 + ks * 4096 + half * 2048; }
template <int OFF> __device__ __forceinline__ s16x4 tr_read(int vb) {
  s16x4 r; asm volatile("ds_read_b64_tr_b16 %0, %1 offset:%2" : "=&v"(r) : "v"(vb), "i"(OFF) : "memory"); return r;
}
template <int D0> __device__ __forceinline__ void pv_one(f32x16& od, int vb, bf16x8 pa0, bf16x8 pa1, bf16x8 pa2, bf16x8 pa3) {
  const s16x4 l0 = tr_read<v_rd_off(D0, 0, 0)>(vb), h0 = tr_read<v_rd_off(D0, 0, 1)>(vb), l1 = tr_read<v_rd_off(D0, 1, 0)>(vb), h1 = tr_read<v_rd_off(D0, 1, 1)>(vb);
  const s16x4 l2 = tr_read<v_rd_off(D0, 2, 0)>(vb), h2 = tr_read<v_rd_off(D0, 2, 1)>(vb), l3 = tr_read<v_rd_off(D0, 3, 0)>(vb), h3 = tr_read<v_rd_off(D0, 3, 1)>(vb);
  asm volatile("s_waitcnt lgkmcnt(0)" ::: "memory"); SBAR();
#define PK(L, H) (bf16x8){L[0], L[1], L[2], L[3], H[0], H[1], H[2], H[3]}
  od = __builtin_amdgcn_mfma_f32_32x32x16_bf16(pa0, PK(l0, h0), od, 0, 0, 0);
  od = __builtin_amdgcn_mfma_f32_32x32x16_bf16(pa1, PK(l1, h1), od, 0, 0, 0);
  od = __builtin_amdgcn_mfma_f32_32x32x16_bf16(pa2, PK(l2, h2), od, 0, 0, 0);
  od = __builtin_amdgcn_mfma_f32_32x32x16_bf16(pa3, PK(l3, h3), od, 0, 0, 0);
#undef PK
}
__device__ __forceinline__ void pv_d0(f32x16* o, int vb, bf16x8 pa0, bf16x8 pa1, bf16x8 pa2, bf16x8 pa3) {
  pv_one<0>(o[0], vb, pa0, pa1, pa2, pa3); pv_one<1>(o[1], vb, pa0, pa1, pa2, pa3); pv_one<2>(o[2], vb, pa0, pa1, pa2, pa3); pv_one<3>(o[3], vb, pa0, pa1, pa2, pa3);
}
__device__ __forceinline__ void attn_dense_body(const bf16_t* __restrict__ Qb, const bf16_t* __restrict__ Kh, const bf16_t* __restrict__ Vh, bf16_t* __restrict__ Ob, int seq, char* lds) {
  const int tid = threadIdx.x, wid = tid >> 6, lane = tid & 63, r32 = lane & 31, hi = lane >> 5;
  bf16_t* V_lds = (bf16_t*)lds; bf16_t* K_lds = (bf16_t*)(lds + 2 * SHM_V);
  float* ws = (float*)(lds + 2 * SHM_V + 2 * SHM_K) + wid * 64; float* li_l = ws; float* al_l = ws + 32;
  float m_reg = -1e30f, l_reg = 0; f32x16 o[4] = {}; bf16x8 qr[8];
  const bf16_t* Qw = Qb + (long)(wid * QBLK + r32) * LDQ + hi * 8;
#pragma unroll
  for (int d0 = 0; d0 < 8; ++d0) qr[d0] = *reinterpret_cast<const bf16x8*>(Qw + d0 * 16);
  const int sr = tid >> 4, sc = (tid & 15) * 8, vst0 = v_st(sr, sc), vst1 = v_st(32 + sr, sc);
  const int vb0 = (int)(uintptr_t)V_lds + v_rd_base(lane);
  struct { bf16x8 vs0, vs1, ks0, ks1; } sr_[2];
#define SLOAD(i, k0) do { sr_[i].vs0 = *reinterpret_cast<const bf16x8*>(&Vh[(long)((k0) + sr) * LDK + sc]); sr_[i].vs1 = *reinterpret_cast<const bf16x8*>(&Vh[(long)((k0) + 32 + sr) * LDK + sc]); \
    sr_[i].ks0 = *reinterpret_cast<const bf16x8*>(&Kh[(long)((k0) + sr) * LDK + sc]); sr_[i].ks1 = *reinterpret_cast<const bf16x8*>(&Kh[(long)((k0) + 32 + sr) * LDK + sc]); } while (0)
#define SWRITE(b, i) do { *(bf16x8*)((char*)V_lds + (b) * SHM_V + vst0) = sr_[i].vs0;          \
    *(bf16x8*)((char*)V_lds + (b) * SHM_V + vst1) = sr_[i].vs1; int kc = sc * 2;               \
    *(bf16x8*)((char*)K_lds + (b) * SHM_K + KSWZ(sr, kc)) = sr_[i].ks0;                       \
    *(bf16x8*)((char*)K_lds + (b) * SHM_K + KSWZ(32 + sr, kc)) = sr_[i].ks1; } while (0)
#define SWAIT() asm volatile("s_waitcnt vmcnt(4)" ::: "memory")
#define RESC(a) do { if (__any((a) < 1.f)) { if (hi == 0) al_l[r32] = (a); asm volatile("s_waitcnt lgkmcnt(0)" ::: "memory"); \
    for (int d = 0; d < 4; ++d) for (int r = 0; r < 16; ++r) o[d][r] *= al_l[crow(r, hi)]; } } while (0)
  f32x16 pA0, pA1, pB0, pB1; float mnA, mnB, alA, alB; bf16x8 pa0, pa1, pa2, pa3; const int NT = seq / KVBLK;
  constexpr int SE = 0, SO = 1;
  SLOAD(SE, 0); asm volatile("s_waitcnt vmcnt(0)" ::: "memory"); SWRITE(0, SE); __syncthreads();
  qkt(pA0, pA1, K_lds, qr, r32, hi); partialSM(pA0, pA1, m_reg, mnA, alA);
  SLOAD(SO, KVBLK); if (2 < NT) SLOAD(SE, 2 * KVBLK);
  SWAIT(); SWRITE(1, SO); __syncthreads();
  for (int j = 1; j + 1 < NT; j += 2) {
    SBAR(); qkt(pB0, pB1, (bf16_t*)((char*)K_lds + SHM_K), qr, r32, hi);
    finishSM(pA0, pA1, alA, l_reg, pa0, pa1, pa2, pa3); SBAR();
    SLOAD(SO, (j + 2) * KVBLK); SBAR();
    pv_d0(o, vb0, pa0, pa1, pa2, pa3); partialSM(pB0, pB1, m_reg, mnB, alB);
    __syncthreads(); SWAIT(); SWRITE(0, SE);
    RESC(alB); __syncthreads();
    SBAR(); qkt(pA0, pA1, K_lds, qr, r32, hi);
    finishSM(pB0, pB1, alB, l_reg, pa0, pa1, pa2, pa3); SBAR();
    if (j + 3 < NT) SLOAD(SE, (j + 3) * KVBLK); SBAR();
    pv_d0(o, vb0 + (int)SHM_V, pa0, pa1, pa2, pa3); partialSM(pA0, pA1, m_reg, mnA, alA);
    __syncthreads(); SWAIT(); SWRITE(1, SO);
    RESC(alA); __syncthreads();
  }
  SBAR(); qkt(pB0, pB1, (bf16_t*)((char*)K_lds + SHM_K), qr, r32, hi);
  finishSM(pA0, pA1, alA, l_reg, pa0, pa1, pa2, pa3); SBAR();
  pv_d0(o, vb0, pa0, pa1, pa2, pa3); partialSM(pB0, pB1, m_reg, mnB, alB);
  __syncthreads(); RESC(alB);
  finishSM(pB0, pB1, alB, l_reg, pa0, pa1, pa2, pa3); SBAR();
  pv_d0(o, vb0 + (int)SHM_V, pa0, pa1, pa2, pa3);
  if (hi == 0) li_l[r32] = l_reg; asm volatile("s_waitcnt lgkmcnt(0)" ::: "memory");
  float rli[16];
#pragma unroll
  for (int r = 0; r < 16; ++r) rli[r] = __builtin_amdgcn_rcpf(li_l[crow(r, hi)]);
  bf16_t* Ow = Ob + (long)(wid * QBLK) * LDO;
#pragma unroll
  for (int r = 0; r < 16; ++r) { int orow = crow(r, hi);
    for (int d0 = 0; d0 < 4; ++d0) Ow[(long)orow * LDO + d0 * 32 + r32] = f2bf(o[d0][r] * rli[r]); }
#undef SLOAD
#undef SWRITE
#undef SWAIT
#undef RESC
}
#undef KSWZ
#undef SBAR
}

__device__ __forceinline__ void ph_norm1(Frame& F, const float* mod) {
    const int gw = F.vcu * NWAVES + F.wave, NGW = F.G * NWAVES, lane = F.lane;
    bf16_t* H = (bf16_t*)(F.ws + WS_H); const float* nw = F.in[6];
    for (int row = gw; row < NTOK + NCTX; row += NGW) {
        const float* src = row < NTOK ? F.in[0] + (size_t)row * DM : F.in[2] + (size_t)(row - NTOK) * DM;
        const float* mr = mod + (row < NTOK ? row / SEQ : 2) * MODC;
        f32x4 v[8]; float ss = 0.f;
#pragma unroll
        for (int j = 0; j < 8; ++j) { v[j] = *(const GAS f32x4*)(src + (j * 64 + lane) * 4); ss += v[j].x * v[j].x + v[j].y * v[j].y + v[j].z * v[j].z + v[j].w * v[j].w; }
        ss = wave_sum(ss);
        const float rstd = 1.0f / sqrtf(ss * (1.0f / DM) + 1e-6f);
#pragma unroll
        for (int j = 0; j < 8; ++j) { const int i = (j * 64 + lane) * 4;
            const f32x4 w = *(const GAS f32x4*)(nw + i), sc = *(const GAS f32x4*)(mr + DM + i), sh = *(const GAS f32x4*)(mr + i);
            const f32x4 h = v[j] * rstd * w * (sc + 1.0f) + sh;
            unsigned lo = cvt_pk_bf16(h[0], h[1]), hi = cvt_pk_bf16(h[2], h[3]);
            *(GAS unsigned long long*)(H + (size_t)row * DM + i) = (unsigned long long)lo | ((unsigned long long)hi << 32); }
    }
}
__device__ __forceinline__ void ph_qknorm(Frame& F) {
    const int gw = F.vcu * NWAVES + F.wave, NGW = F.G * NWAVES, lane = F.lane;
    const float* QKRAW = (const float*)(F.ws + WS_QKRAW); const float* KCRAW = (const float*)(F.ws + WS_KCRAW);
    bf16_t* Q = (bf16_t*)(F.ws + WS_Q); bf16_t* KALL = (bf16_t*)(F.ws + WS_KALL);
    const int axis = lane >> 5, f = lane & 31, da = axis * 64 + f, db = da + 32;
    const float qwa = F.in[8][da], qwb = F.in[8][db], kwa = F.in[9][da], kwb = F.in[9][db];
    const float inv = exp2f(-(float)f * (13.287712379549449f / 32.0f));
    for (int row = gw; row < NTOK + NCTX; row += NGW) {
        if (row < NTOK) {
            const int b = row / SEQ, t = row % SEQ;
            const float pos = (float)(axis == 0 ? t / 64 : t % 64), ang = pos * inv, cs = cosf(ang), sn = sinf(ang);
            const float* src = QKRAW + (size_t)row * 2560;
#pragma unroll
            for (int hb = 0; hb < 20; hb += 5) {
                float xa[5], xb[5];
#pragma unroll
                for (int q = 0; q < 5; ++q) { xa[q] = src[(hb + q) * HD + da]; xb[q] = src[(hb + q) * HD + db]; }
#pragma unroll
                for (int q = 0; q < 5; ++q) { const int hh = hb + q;
                    const float ss = wave_sum(xa[q] * xa[q] + xb[q] * xb[q]), rstd = 1.0f / sqrtf(ss * (1.0f / HD) + 1e-6f);
                    const float a = xa[q] * rstd * (hh < 16 ? qwa : kwa), bb = xb[q] * rstd * (hh < 16 ? qwb : kwb);
                    bf16_t* dst = hh < 16 ? Q + (size_t)row * DM + hh * HD : KALL + ((size_t)b * SKV + t) * KVW + (hh - 16) * HD;
                    dst[da] = f2bf(a * cs - bb * sn); dst[db] = f2bf(bb * cs + a * sn); }
            }
        } else {
            const int r = row - NTOK, b = r / CTXL, j = r % CTXL; const float* src = KCRAW + (size_t)r * KVW;
#pragma unroll
            for (int hh = 0; hh < 4; ++hh) { const float xa = src[hh * HD + da], xb = src[hh * HD + db];
                const float ss = wave_sum(xa * xa + xb * xb), rstd = 1.0f / sqrtf(ss * (1.0f / HD) + 1e-6f);
                bf16_t* dst = KALL + ((size_t)b * SKV + SEQ + j) * KVW + hh * HD; dst[da] = f2bf(xa * rstd * kwa); dst[db] = f2bf(xb * rstd * kwb); }
        }
    }
}
__device__ __forceinline__ void ph_evenodd(Frame& F) {
    const int gw = F.vcu * NWAVES + F.wave, NGW = F.G * NWAVES, lane = F.lane;
    LAS bf16_t* scr = (LAS bf16_t*)(F.lds + F.wave * 16640);
    const bf16_t* UT = (const bf16_t*)(F.ws + WS_UT); bf16_t* ET = (bf16_t*)(F.ws + WS_ET); bf16_t* OT = (bf16_t*)(F.ws + WS_OT);
    float* W2 = (float*)(F.ws + WS_W2048); float* AL = (float*)(F.ws + WS_ALT);
    for (int row = gw; row < 2 * FW; row += NGW) {
        const bf16_t* src = UT + (size_t)row * SEQ; float alt = 0.f;
#pragma unroll
        for (int j = 0; j < 8; ++j) { const u32x4 w = *(const GAS u32x4*)(src + (j * 64 + lane) * 8); *(LAS u32x4*)(scr + (j * 64 + lane) * 8) = w;
            float f[8]; unpack8(w, f); alt += (f[0] - f[1]) + (f[2] - f[3]) + (f[4] - f[5]) + (f[6] - f[7]); }
        alt = wave_sum(alt);
        LDS_WAIT(); asm volatile("" ::: "memory");
        if (lane == 0) { AL[row] = alt; W2[row] = bf2f(scr[SEQ / 2]); }
#pragma unroll
        for (int j = 0; j < 4; ++j) { const int n0 = (j * 64 + lane) * 8; float e[8], o[8];
#pragma unroll
            for (int i = 0; i < 8; ++i) { const int n = n0 + i; const float a = bf2f(scr[n]), bb = bf2f(scr[(SEQ - n) & (SEQ - 1)]); e[i] = n == 0 ? a : a + bb; o[i] = n == 0 ? 0.f : a - bb; }
            u32x4 we, wo; we.x = cvt_pk_bf16(e[0], e[1]); we.y = cvt_pk_bf16(e[2], e[3]); we.z = cvt_pk_bf16(e[4], e[5]); we.w = cvt_pk_bf16(e[6], e[7]);
            wo.x = cvt_pk_bf16(o[0], o[1]); wo.y = cvt_pk_bf16(o[2], o[3]); wo.z = cvt_pk_bf16(o[4], o[5]); wo.w = cvt_pk_bf16(o[6], o[7]);
            *(GAS u32x4*)(ET + (size_t)row * 2048 + n0) = we; *(GAS u32x4*)(OT + (size_t)row * 2048 + n0) = wo; }
        LDS_WAIT(); asm volatile("" ::: "memory");
    }
}
__device__ __forceinline__ void ph_route(Frame& F, const float* mod) {
    const int lane = F.lane, wv = F.wave;
    LAS float* hrow = (LAS float*)F.lds;
    LAS float* part = (LAS float*)(F.lds + 65536);
    const float* X2 = (const float*)(F.ws + WS_X2); const float* nw = F.in[13]; const float* rw = F.in[14]; const float* rb = F.in[15];
    bf16_t* H2 = (bf16_t*)(F.ws + WS_H2); int* EIDX = (int*)(F.ws + WS_EIDX); float* EW = (float*)(F.ws + WS_EW); int* EPOS = (int*)(F.ws + WS_EPOS); int* CNT = (int*)(F.ws + CTL_CNT);
    LAS int* lcnt = (LAS int*)(F.lds + 65536 + 16384);
    LAS int* lbase = lcnt + 64;
    LAS int* lent = lcnt + 128;
    if (F.tid < NE) lcnt[F.tid] = 0;
    __syncthreads();
    int nb = 0;
    for (int blk = F.vcu; blk < NTOK / 8; blk += F.G, ++nb) {
        const int row = blk * 8 + wv;
        { const float* src = X2 + (size_t)row * DM; const float* mr = mod + (row / SEQ) * MODC;
          f32x4 v[8]; float ss = 0.f;
#pragma unroll
          for (int j = 0; j < 8; ++j) { v[j] = *(const GAS f32x4*)(src + (j * 64 + lane) * 4); ss += v[j].x * v[j].x + v[j].y * v[j].y + v[j].z * v[j].z + v[j].w * v[j].w; }
          ss = wave_sum(ss);
          const float rstd = 1.0f / sqrtf(ss * (1.0f / DM) + 1e-6f);
#pragma unroll
          for (int j = 0; j < 8; ++j) { const int i = (j * 64 + lane) * 4;
              const f32x4 w = *(const GAS f32x4*)(nw + i), sc = *(const GAS f32x4*)(mr + 4 * DM + i), sh = *(const GAS f32x4*)(mr + 3 * DM + i);
              const f32x4 h = v[j] * rstd * w * (sc + 1.0f) + sh;
              *(LAS f32x4*)(hrow + wv * DM + i) = h;
              unsigned lo = cvt_pk_bf16(h[0], h[1]), hi = cvt_pk_bf16(h[2], h[3]);
              *(GAS unsigned long long*)(H2 + (size_t)row * DM + i) = (unsigned long long)lo | ((unsigned long long)hi << 32); } }
        __syncthreads();
        { float a[8];
#pragma unroll
          for (int r = 0; r < 8; ++r) a[r] = 0.f;
          const int k0 = wv * 256;
#pragma unroll 16
          for (int k = 0; k < 256; ++k) { const float w = rw[(size_t)(k0 + k) * NE + lane];
#pragma unroll
              for (int r = 0; r < 8; ++r) a[r] += hrow[r * DM + k0 + k] * w; }
#pragma unroll
          for (int r = 0; r < 8; ++r) part[(wv * 8 + r) * 64 + lane] = a[r]; }
        __syncthreads();
        { float logit = 0.f;
#pragma unroll
          for (int w = 0; w < 8; ++w) logit += part[(w * 8 + wv) * 64 + lane];
          const float score = 1.0f / (1.0f + expf(-logit)), bsd = score + rb[lane];
          const int g = lane >> 3;
          int rk = 0;
#pragma unroll
          for (int i = 0; i < 8; ++i) { const int o = (lane & ~7) + i; const float vv = __shfl(bsd, o); rk += (vv > bsd) || (vv == bsd && o < lane); }
          float gs = rk < 2 ? bsd : 0.f;
          gs += __shfl_xor(gs, 1); gs += __shfl_xor(gs, 2); gs += __shfl_xor(gs, 4);
          int grk = 0;
#pragma unroll
          for (int gg = 0; gg < 8; ++gg) { const float vv = __shfl(gs, gg * 8); grk += (vv > gs) || (vv == gs && gg < g); }
          const bool gsel = grk < 4;
          const float mb = gsel ? bsd : -INFINITY;
          int erk = 0;
          for (int o = 0; o < 64; ++o) { const float vv = __shfl(mb, o); erk += (vv > mb) || (vv == mb && o < lane); }
          const bool sel = gsel && erk < TOPK;
          const float ssum = wave_sum(sel ? score : 0.f);
          if (sel) { const int lp = __hip_atomic_fetch_add(lcnt + lane, 1, __ATOMIC_RELAXED, __HIP_MEMORY_SCOPE_WORKGROUP);
                     EIDX[row * TOPK + erk] = lane; EW[row * TOPK + erk] = score / ssum * 2.5f; lent[(nb * 8 + wv) * TOPK + erk] = (lane << 16) | lp; } }
        __syncthreads();
    }
    if (F.tid < NE) { const int c = lcnt[F.tid]; lbase[F.tid] = c ? atomicAdd(&CNT[F.tid * 64], c) : 0; }
    __syncthreads();
    for (int i = F.tid; i < nb * 64; i += NTHREADS) { const int blk = F.vcu + (i >> 6) * F.G, row = blk * 8 + ((i >> 3) & 7), v = lent[i]; EPOS[row * TOPK + (i & 7)] = lbase[v >> 16] + (v & 0xffff); }
    __syncthreads();
}
__device__ __forceinline__ void ph_fill(Frame& F) {
    moe_tables(F, 4);
    LAS int* T = (LAS int*)(F.lds + SCHT_OFF);
    const int* EIDX = (const int*)(F.ws + WS_EIDX); const int* EPOS = (const int*)(F.ws + WS_EPOS); int* TOK = (int*)(F.ws + WS_TOK); int* SLOTOF = (int*)(F.ws + WS_SLOTOF);
    for (int i = F.vcu * NTHREADS + F.tid; i < NSLOT; i += F.G * NTHREADS) { const int slot = T[80 + EIDX[i]] + EPOS[i]; TOK[slot] = i / TOPK; SLOTOF[i] = slot; if (i < NTOK) TOK[NSLOT + i] = i; }
}
__device__ __forceinline__ void ph_comb(Frame& F, const float* mod) {
    const int gw = F.vcu * NWAVES + F.wave, NGW = F.G * NWAVES, lane = F.lane;
    const float* EW = (const float*)(F.ws + WS_EW); const int* SLOTOF = (const int*)(F.ws + WS_SLOTOF); const bf16_t* Y = (const bf16_t*)(F.ws + WS_YBIG);
    for (int t = gw; t < NTOK; t += NGW) {
        const float* g2 = mod + (t / SEQ) * MODC + 5 * DM;
        int sl[TOPK]; float wk[TOPK];
#pragma unroll
        for (int k = 0; k < TOPK; ++k) { sl[k] = SLOTOF[t * TOPK + k]; wk[k] = EW[t * TOPK + k]; }
#pragma unroll
        for (int j = 0; j < 4; ++j) { const int col = j * 512 + lane * 8;
            float a[8]; unpack8(*(const GAS u32x4*)(Y + (size_t)(NSLOT + t) * DM + col), a);
#pragma unroll
            for (int k = 0; k < TOPK; ++k) { float y[8]; unpack8(*(const GAS u32x4*)(Y + (size_t)sl[k] * DM + col), y);
#pragma unroll
                for (int c = 0; c < 8; ++c) a[c] += wk[k] * y[c]; }
            float* o = F.out + (size_t)t * DM + col; const float* xi = (const float*)(F.ws + WS_X2) + (size_t)t * DM + col;
#pragma unroll
            for (int n = 0; n < 2; ++n) { const f32x4 xv = *(const GAS f32x4*)(xi + 4 * n), gv = *(const GAS f32x4*)(g2 + col + 4 * n);
                *(GAS f32x4*)(o + 4 * n) = xv + gv * (f32x4){a[4 * n], a[4 * n + 1], a[4 * n + 2], a[4 * n + 3]}; } }
    }
}

enum { PH_PRO = 0, PH_NORM1, PH_INPROJ, PH_QKNORM, PH_ATTN, PH_F2, PH_MERGE, PH_OUT, PH_ROUTE, PH_FILL, PH_EXP1, PH_EXP2, PH_COMB, PH_END };

struct Args { const float* in[22]; float* out; unsigned char* ws; int ph_lo, ph_hi, use_ut, mod_off, do_attn, bar_idx; };

__global__ void __launch_bounds__(NTHREADS, 2) fwd(Args args) {
    extern __shared__ __attribute__((aligned(16))) unsigned char lds_raw[];
    Frame F;
    F.lds = (LAS unsigned char*)lds_raw; F.MISC = (volatile LAS unsigned*)(F.lds + MISC_OFF); F.ws = args.ws;
    F.tid = threadIdx.x; F.lane = F.tid & 63; F.wave = __builtin_amdgcn_readfirstlane(F.tid >> 6);
    F.G = gridDim.x; { const int bx = blockIdx.x; F.vcu = (F.G % 8 == 0) ? (bx % 8) * (F.G / 8) + bx / 8 : bx; }
#pragma unroll
    for (int i = 0; i < 22; ++i) F.in[i] = args.in[i];
    F.out = args.out;
    for (int u = F.tid; u < (LDS_BYTES - LDSCTL_OFF) / 4; u += NTHREADS) ((LAS unsigned*)(F.lds + LDSCTL_OFF))[u] = 0u;
    __syncthreads();
    const int lo = args.ph_lo, hi = args.ph_hi;
    const bool multi = (hi - lo) > 1;
    unsigned* barw = (unsigned*)(args.ws + CTL_BAR) + args.bar_idx * XCD_BAR_WORDS;
    XcdBarrier bar; bar.bar = barw; bar.x = 0; bar.st = nullptr;
    if (multi) bar = xcd_barrier_post(barw, F.MISC + 8);
#define IN(k) (lo <= (k) && (k) < hi)
#define SEAM(k) do { if (IN((k) + 1)) xcd_barrier(bar); } while (0)

    const float* modp = (const float*)(args.ws + args.mod_off);
    if (IN(PH_PRO)) { p0_prologue(F); SEAM(PH_PRO); }
    if (IN(PH_NORM1)) { ph_norm1(F, modp); SEAM(PH_NORM1); }
    if (IN(PH_INPROJ)) {
        SchedIn S{F.G, (int)blockIdx.x, args.ws, args.use_ut};
        gemm_phase<EpiStore, SchedIn, false>(F.lds, DM, DM, DM, S, EpiStore{(const float*)(args.ws + WS_W2048)});
        SEAM(PH_INPROJ);
    }
    if (IN(PH_QKNORM)) { ph_qknorm(F); ph_evenodd(F); SEAM(PH_QKNORM); }
    if (IN(PH_ATTN)) {
        if (args.do_attn) {
            const bf16_t* Qp = (const bf16_t*)(args.ws + WS_Q); const bf16_t* Kp = (const bf16_t*)(args.ws + WS_KALL); const bf16_t* Vp = (const bf16_t*)(args.ws + WS_VALL); bf16_t* Op = (bf16_t*)(args.ws + WS_YA);
            for (int lin = F.vcu; lin < 512; lin += F.G) {
                const int x = (lin >> 5) & 7, j = (lin & 31) + 32 * (lin >> 8), b = x >> 2, kvh = x & 3, head = kvh * 4 + (j >> 4), qb = j & 15;
                const size_t qo = ((size_t)(b * SEQ + qb * 256)) * DM + head * HD, ko = (size_t)b * SKV * KVW + kvh * HD;
                attn::attn_dense_body(Qp + qo, Kp + ko, Vp + ko, Op + qo, SKV, (char*)lds_raw);
                __syncthreads();
            }
        }
        SchedAG S{F.G, (int)blockIdx.x, args.ws};
        gemm_phase<EpiStore, SchedAG, false>(F.lds, DM, DM, DM, S, EpiStore{(const float*)(args.ws + WS_W2048)});
        SEAM(PH_ATTN);
    }
    if (IN(PH_F2)) {
        SchedF2 S{F.G, (int)blockIdx.x, args.ws};
        gemm_phase<EpiStore, SchedF2, false>(F.lds, 512, DM, 512, S, EpiStore{(const float*)(args.ws + WS_W2048)});
        {
            const int idx = F.vcu * NTHREADS + F.tid;
            if (idx < 2 * FW) { const int b = idx >> 10, col = idx & 1023, k2 = col & 127; const float* al = (const float*)(args.ws + WS_ALT) + b * FW + (col & ~127); float s = 0.f;
                for (int c = 0; c < 128; ++c) s += al[c] * cospif((float)((c * k2) & 127) * (1.0f / 64.0f));
                ((bf16_t*)(args.ws + WS_YF))[((size_t)b * SEQ + SEQ / 2) * FW + col] = f2bf(s * 0.0013810679320049757f); }
        }
        SEAM(PH_F2);
    }
    if (IN(PH_MERGE)) {
        unsigned char* ws = args.ws;
        { SchedGrid S{F.G, (int)blockIdx.x, 32, 8, (const char*)(ws + WS_YF), (const char*)(ws + WS_WT_FO), nullptr, (size_t)256 * FW * 2, (size_t)256 * FW * 2, DM, 4, 1};
          gemm_phase<EpiT1, SchedGrid, false>(F.lds, FW, FW, FW, S, EpiT1{(const bf16_t*)(ws + WS_SGF), (float*)(ws + WS_T1)}); }
        { SchedGrid S{F.G, (int)blockIdx.x, 32, 8, (const char*)(ws + WS_YA), (const char*)(ws + WS_WT_AO), nullptr, (size_t)256 * DM * 2, (size_t)256 * DM * 2, DM, 2, 0};
          gemm_phase<EpiYM, SchedGrid, false>(F.lds, DM, DM, DM, S, EpiYM{(const bf16_t*)(ws + WS_SGA), (const float*)(ws + WS_T1), (bf16_t*)(ws + WS_YM)}); }
        SEAM(PH_MERGE);
    }
    if (IN(PH_OUT)) {
        unsigned char* ws = args.ws;
        SchedGrid S{F.G, (int)blockIdx.x, 32, 8, (const char*)(ws + WS_YM), (const char*)(ws + WS_WT_O), nullptr, (size_t)256 * DM * 2, (size_t)256 * DM * 2, DM, 4, 1};
        gemm_phase<EpiX2, SchedGrid, false>(F.lds, DM, DM, DM, S, EpiX2{F.in[0], modp, (float*)(ws + WS_X2)});
        SEAM(PH_OUT);
    }
    if (IN(PH_ROUTE)) { ph_route(F, modp); SEAM(PH_ROUTE); }
    if (IN(PH_FILL)) { ph_fill(F); SEAM(PH_FILL); }
    if (IN(PH_EXP1)) {
        moe_tables(F, 4);
        SchedMoe<4, true> S{F.G, F.vcu, args.ws, (LAS int*)(F.lds + SCHT_OFF), (const int*)(args.ws + WS_TOK)};
        gemm_phase<EpiAct, SchedMoe<4, true>, true>(F.lds, DM, DM, DM, S, EpiAct{});
        SEAM(PH_EXP1);
    }
    if (IN(PH_EXP2)) {
        moe_tables(F, 8);
        SchedMoe<8, false> S{F.G, F.vcu, args.ws, (LAS int*)(F.lds + SCHT_OFF), (const int*)(args.ws + WS_TOK)};
        gemm_phase<EpiStore, SchedMoe<8, false>, false>(F.lds, EFF, EFF, EFF, S, EpiStore{(const float*)(args.ws + WS_W2048)});
        SEAM(PH_EXP2);
    }
    if (IN(PH_COMB)) { ph_comb(F, modp); }
#undef IN
#undef SEAM
}
}

extern "C" void kernel_launch(void* const* d_in, const int* in_sizes, int n_in, void* d_out, int out_size, void* d_ws, size_t ws_size, hipStream_t stream) {
    if (n_in != 22 || ws_size < WS_END2) return;
    float* out = (float*)d_out;
    unsigned char* ws = (unsigned char*)d_ws;
    hipMemsetAsync(ws + WS_CTL, 0, CTL_ZERO_BYTES, stream);
    static int grid = 0;
    if (!grid) {
        int dev = 0, cus = 0;
        if (hipGetDevice(&dev) != hipSuccess || hipDeviceGetAttribute(&cus, hipDeviceAttributeMultiprocessorCount, dev) != hipSuccess) { grid = -1; return; }
        if (hipFuncSetAttribute((const void*)mk::fwd, hipFuncAttributeMaxDynamicSharedMemorySize, mk::LDS_BYTES) != hipSuccess) { grid = -1; return; }
        grid = cus;
    }
    if (grid < 0) return;
    mk::Args a{}; int nlaunch = 0;
    for (int i = 0; i < 22; ++i) a.in[i] = (const float*)d_in[i];
    a.out = out; a.ws = ws; a.use_ut = 1; a.mod_off = (int)WS_MOD; a.do_attn = 1;
#define MK_LAUNCH(lo_, hi_) do { a.ph_lo = (lo_); a.ph_hi = (hi_); a.bar_idx = nlaunch++; hipLaunchKernelGGL(mk::fwd, dim3(grid), dim3(mk::NTHREADS), mk::LDS_BYTES, stream, a); } while (0)
    MK_LAUNCH(mk::PH_PRO, mk::PH_END);
}
```

```cpp
#include <hip/hip_runtime.h>
#include <stdint.h>
#include <math.h>

typedef unsigned short bf16_t;
typedef short bf16x8 __attribute__((ext_vector_type(8)));
typedef float f32x16 __attribute__((ext_vector_type(16)));
typedef float f32x4 __attribute__((ext_vector_type(4)));

constexpr int NB = 2, SEQ = 4096, DM = 2048, NTOK = NB * SEQ, CTXL = 256, NCTX = NB * CTXL, HD = 128, NH = 16, NKV = 4;
constexpr int SKV = SEQ + CTXL;
constexpr int FW = 1024, INC = 8192, Q_OFF = 1024, K_OFF = 3072, V_OFF = 3584, GF_OFF = 4096, GA_OFF = 6144;
constexpr int KVW = NKV * HD;
constexpr int NE = 64, TOPK = 8, EFF = 512, MODC = 6 * DM;
constexpr int NSLOT = NTOK * TOPK;
constexpr int NSLOT_ALL = NSLOT + NTOK;

constexpr size_t MiB = 1u << 20;
constexpr size_t WS_CTL = 0, CTL_ZERO_BYTES = 1 * MiB;
constexpr size_t CTL_CNT = 64 * 1024;
constexpr size_t WS_TW = 1 * MiB;
constexpr size_t WS_MOD = 1 * MiB + 64 * 1024;
constexpr size_t WS_OFFS = 1 * MiB + 256 * 1024;
constexpr size_t WS_EIDX = 2 * MiB;
constexpr size_t WS_EW = WS_EIDX + 256 * 1024;
constexpr size_t WS_EPOS = WS_EW + 256 * 1024;
constexpr size_t WS_SLOTOF = WS_EPOS + 256 * 1024;
constexpr size_t WS_TOK = 3 * MiB;
constexpr size_t WS_H = 4 * MiB;
constexpr size_t WS_U = 38 * MiB;
constexpr size_t WS_Q = 54 * MiB;
constexpr size_t WS_KALL = 86 * MiB;
constexpr size_t WS_VALL = 95 * MiB;
constexpr size_t WS_SGF = 104 * MiB;
constexpr size_t WS_SGA = 136 * MiB;
constexpr size_t WS_YA = 168 * MiB;
constexpr size_t WS_YF = 200 * MiB;
constexpr size_t WS_PR = 216 * MiB;
constexpr size_t WS_T1 = 248 * MiB;
constexpr size_t WS_YM = 312 * MiB;
constexpr size_t WS_QKRAW = 248 * MiB;
constexpr size_t WS_KCRAW = 330 * MiB;
constexpr size_t WS_H2 = 344 * MiB;
constexpr size_t WS_ACT = 376 * MiB;
constexpr size_t WS_YBIG = 4 * MiB;
constexpr size_t WS_END = 740 * MiB;

__device__ __forceinline__ float bf2f(bf16_t h) { return __uint_as_float(((unsigned)h) << 16); }
__device__ __forceinline__ bf16_t f2bf(float f) { unsigned u = __float_as_uint(f); return (bf16_t)((u + 0x7fffu + ((u >> 16) & 1u)) >> 16); }
__device__ __forceinline__ int crow(int r, int hi) { return (r & 3) + 8 * (r >> 2) + 4 * hi; }
__device__ __forceinline__ float wave_sum(float v) {
#pragma unroll
    for (int o = 1; o < 64; o <<= 1) v += __shfl_xor(v, o);
    return v;
}
__device__ __forceinline__ float sigmoidf_(float v) { return 1.0f / (1.0f + expf(-v)); }
__device__ __forceinline__ bf16x8 pack8(const float* f) {
    bf16x8 r;
#pragma unroll
    for (int i = 0; i < 8; ++i) r[i] = (short)f2bf(f[i]);
    return r;
}

#define LAS __attribute__((address_space(3)))
#define GAS __attribute__((address_space(1)))
typedef unsigned u32x4 __attribute__((ext_vector_type(4)));
typedef GAS unsigned gu32;
#define RLX_AGENT __ATOMIC_RELAXED, __HIP_MEMORY_SCOPE_AGENT
#define LDS_WAIT() asm volatile("s_waitcnt lgkmcnt(0)" ::: "memory")
#define VM_WAIT() asm volatile("s_waitcnt vmcnt(0)" ::: "memory")

constexpr size_t CTL_BAR = 16384;
constexpr size_t CTL_MODZ = 512 * 1024;
constexpr size_t WS_UT = 38 * MiB;
constexpr size_t WS_TT = 216 * MiB;
constexpr size_t WS_WT_GU = 450 * MiB;
constexpr size_t WS_WT_D = 710 * MiB;
constexpr size_t WS_WT_IN = 840 * MiB;
constexpr size_t WS_WT_FO = 872 * MiB;
constexpr size_t WS_WT_AO = 876 * MiB;
constexpr size_t WS_WT_O = 884 * MiB;
constexpr size_t WS_CST = 892 * MiB;
constexpr size_t WS_ET = 908 * MiB;
constexpr size_t WS_OT = 916 * MiB;
constexpr size_t WS_W2048 = 1 * MiB + 512 * 1024;
constexpr size_t WS_ALT = 1 * MiB + 520 * 1024;
constexpr size_t WS_BD2 = 956 * MiB;
constexpr size_t WS_X2 = 960 * MiB;
constexpr size_t WS_END2 = 1024 * MiB;

namespace mk {
constexpr int NWAVES = 8, NTHREADS = 512;
constexpr int RING_BYTES = 131072, SCR_BYTES = 8 * 16640, LDSCTL_OFF = 135168, MISC_OFF = LDSCTL_OFF + 320, GPARK_OFF = LDSCTL_OFF + 2048  , LDS_BYTES = 147456;
static_assert(GPARK_OFF + 8192 <= LDS_BYTES, "LDS map");
static_assert(SCR_BYTES <= LDSCTL_OFF && MISC_OFF + 128 <= LDS_BYTES, "LDS map");

#define XB_TMO      128
#define XB_XCNT(j)  (256  + 64 * (j))
#define XB_XSUB(j)  (1280 + 64 * (j))
#define XB_XGEN(j)  (2304 + 64 * (j))
#define XB_TOP      3328
#define XB_TOPGEN   3392
#define XCD_BAR_WORDS 3456
#define XB_SPIN_CAP (1u << 18)
__device__ __forceinline__ unsigned xb_ld(unsigned* p)              { return __hip_atomic_load(p, __ATOMIC_RELAXED, __HIP_MEMORY_SCOPE_AGENT); }
__device__ __forceinline__ unsigned xb_add(unsigned* p, unsigned v) { return __hip_atomic_fetch_add(p, v, __ATOMIC_RELAXED, __HIP_MEMORY_SCOPE_AGENT); }
__device__ __forceinline__ unsigned xb_xcc_id() { return (unsigned)__builtin_amdgcn_s_getreg((3 << 11) | 20) & 0xFu; }
#define XB_SPIN(cond, bar) do { unsigned _sp = 0; while (cond) { __builtin_amdgcn_s_sleep(1); \
    if ((++_sp & 255u) == 0u) { if (xb_ld(&(bar)[XB_TMO])) break; if (_sp > XB_SPIN_CAP) { atomicAdd(&(bar)[XB_TMO], 1u); break; } } } } while (0)
struct XcdBarrier { unsigned* bar; unsigned x; volatile LAS unsigned* st; };
__device__ __forceinline__ XcdBarrier xcd_barrier_post(unsigned* bar, volatile LAS unsigned* st) {
    XcdBarrier b; b.bar = bar; b.x = xb_xcc_id(); b.st = st;
    if (threadIdx.x == 0) (void)xb_add(&bar[XB_XCNT(b.x)], 1u);
    return b;
}
__device__ __forceinline__ void xcd_barrier_complete(unsigned* bar, unsigned x, unsigned& nloc, unsigned& nx) {
    const unsigned G = gridDim.x * gridDim.y * gridDim.z;
    unsigned sum, cnt, mine, sp = 0u;
    for (;;) {
        sum = 0u; cnt = 0u; mine = 0u;
#pragma unroll
        for (unsigned j = 0; j < 16; ++j) { const unsigned c = xb_ld(&bar[XB_XCNT(j)]); sum += c; cnt += (c > 0u) ? 1u : 0u; mine = (j == x) ? c : mine; }
        if (sum == G) break;
        __builtin_amdgcn_s_sleep(1);
        if ((++sp & 255u) == 0u) { if (xb_ld(&bar[XB_TMO])) break; if (sp > XB_SPIN_CAP) { atomicAdd(&bar[XB_TMO], 1u); break; } }
    }
    nloc = mine > 0u ? mine : 1u; nx = cnt > 0u ? cnt : 1u;
}
__device__ __forceinline__ void xcd_barrier(const XcdBarrier& b) {
    asm volatile("s_waitcnt vmcnt(0)" ::: "memory");
    __syncthreads();
    if (threadIdx.x == 0) {
        unsigned* bar = b.bar;
        __builtin_amdgcn_s_waitcnt(0);
        unsigned nloc = b.st[0], nx = b.st[1];
        if (nloc == 0u) { xcd_barrier_complete(bar, b.x, nloc, nx); b.st[0] = nloc; b.st[1] = nx; }
        const unsigned old = xb_add(&bar[XB_XSUB(b.x)], 1u);
        const unsigned gen = old / nloc;
        if (old + 1u == (gen + 1u) * nloc) {
            __builtin_amdgcn_fence(__ATOMIC_RELEASE, "agent");
            asm volatile("s_waitcnt vmcnt(0)" ::: "memory");
            const unsigned og = xb_add(&bar[XB_TOP], 1u);
            const unsigned tg = og / nx;
            if (og + 1u == (tg + 1u) * nx) xb_add(&bar[XB_TOPGEN], 1u);
            else XB_SPIN(xb_ld(&bar[XB_TOPGEN]) == tg, bar);
            __builtin_amdgcn_fence(__ATOMIC_ACQUIRE, "agent");
            xb_add(&bar[XB_XGEN(b.x)], 1u);
            asm volatile("s_waitcnt vmcnt(0)" ::: "memory");
        } else {
            XB_SPIN(xb_ld(&bar[XB_XGEN(b.x)]) == gen, bar);
            __builtin_amdgcn_fence(__ATOMIC_ACQUIRE, "agent");
            asm volatile("s_waitcnt vmcnt(0)" ::: "memory");
        }
    }
    __syncthreads();
}

constexpr int BM = 256, BK = 64, HALF = 128, HTB = HALF * BK * 2, STAGE_BYTES = 8 * HTB;
__device__ __forceinline__ int lds_byte(int r, int c) { const int st = (r >> 4) * 2 + (c >> 5), rr = r & 15, cc = c & 31, ob = rr * 64 + cc * 2; return st * 1024 + (ob ^ (((ob >> 9) & 1) << 5)); }
__device__ __forceinline__ void stage_rc(int b, int& R, int& C) { const int st = b / 1024, sb = b % 1024, swz = sb ^ (((sb >> 9) & 1) << 5); R = (st >> 1) * 16 + swz / 64; C = (st & 1) * 32 + (swz % 64) / 2; }
__device__ __forceinline__ int perm32(int rho) { const int n = rho >> 4, i = rho & 15; return 8 * (i >> 2) + 4 * n + (i & 3); }
__device__ __forceinline__ unsigned cvt_pk_bf16(float lo, float hi) { unsigned r; asm("v_cvt_pk_bf16_f32 %0, %1, %2" : "=v"(r) : "v"(lo), "v"(hi)); return r; }

__device__ __forceinline__ void glds16_s(const void* sbase, unsigned voff, unsigned lds_dst) { unsigned keep;
    asm volatile("s_mov_b32 %0, m0\n\ts_mov_b32 m0, %3\n\ts_nop 0\n\tglobal_load_lds_dwordx4 %1, %2\n\ts_mov_b32 m0, %0" : "=&s"(keep) : "v"(voff), "s"(sbase), "s"(lds_dst) : "memory"); }

struct Unit { const char* A; const char* B; char* C; int ldc; int mode; int rows; int aux; int pm, pn, bjs, rmin; };

template <class Epi, class Sched, bool GATHER>
__device__ __forceinline__ void gemm_phase(LAS unsigned char* lds, const int K, const int lda, const int ldb, const Sched& S, const Epi& E, const int i0 = 0, const int i1 = 0x7fffffff) {
    const int tid = threadIdx.x, wid = __builtin_amdgcn_readfirstlane(tid >> 6), lane = tid & 63, wr = wid >> 2, wc = wid & 3, fr = lane & 15, fq = lane >> 4;
    const int nt = K / BK;
    unsigned voffA[2], voffB[2];
#pragma unroll
    for (int i = 0; i < 2; ++i) { int R, C; stage_rc(tid * 16 + i * 8192, R, C); const int Rb = (R & ~31) + perm32(R & 31);
        voffA[i] = (unsigned)(R * lda + C) * 2u; voffB[i] = (unsigned)(Rb * ldb + C) * 2u; }
    const size_t kstep = (size_t)(BK * 2);
    const size_t hstepA = (size_t)HALF * lda * 2, hstepB = (size_t)HALF * ldb * 2;
    const unsigned ldsw = (unsigned)wid * 1024u;
    const unsigned ldsbase = (unsigned)__builtin_amdgcn_readfirstlane((int)(unsigned)(uintptr_t)lds);
    const int aoff = lds_byte(wr * 64 + fr, fq * 8), boff = lds_byte(wc * 32 + fr, fq * 8);
#define MK_SA(b, h) (((b) * 2 + (h)) * HTB)
#define MK_SB(b, h) ((4 + (b) * 2 + (h)) * HTB)
#define MK_STAGE2(bufoff, gbase, v0, v1) do { \
        __builtin_amdgcn_global_load_lds((const unsigned*)((const char*)(gbase) + (v0)), (LAS unsigned*)(lds + (bufoff) + ldsw), 16, 0, 0); \
        __builtin_amdgcn_global_load_lds((const unsigned*)((const char*)(gbase) + (v1)), (LAS unsigned*)(lds + (bufoff) + ldsw + 8192), 16, 0, 0); } while (0)
#define MK_STAGE_B(bufoff, gbase) do { glds16_s((gbase), voffB[0], ldsbase + (bufoff) + ldsw); glds16_s((gbase), voffB[1], ldsbase + (bufoff) + ldsw + 8192u); } while (0)
#define MK_STAGE_A(bufoff, gbase, h, VA) do { if constexpr (GATHER) { glds16_s((gbase), (VA)[h][0], ldsbase + (bufoff) + ldsw); glds16_s((gbase), (VA)[h][1], ldsbase + (bufoff) + ldsw + 8192u); } \
        else { glds16_s((gbase) + (h) * hstepA, voffA[0], ldsbase + (bufoff) + ldsw); glds16_s((gbase) + (h) * hstepA, voffA[1], ldsbase + (bufoff) + ldsw + 8192u); } } while (0)
#define MK_LDA(dst, b, h) do { _Pragma("unroll") for (int m = 0; m < 4; ++m) _Pragma("unroll") for (int k = 0; k < 2; ++k) dst[m][k] = *(const LAS bf16x8*)(lds + MK_SA(b, h) + aoff + m * 2048 + k * 1024); } while (0)
#define MK_LDB(dst, b, h) do { _Pragma("unroll") for (int n = 0; n < 2; ++n) _Pragma("unroll") for (int k = 0; k < 2; ++k) dst[n][k] = *(const LAS bf16x8*)(lds + MK_SB(b, h) + boff + n * 2048 + k * 1024); } while (0)
#define MK_MMA(ai, bj, At, Bt) do { __builtin_amdgcn_s_setprio(1); _Pragma("unroll") for (int m = 0; m < 4; ++m) _Pragma("unroll") for (int n = 0; n < 2; ++n) _Pragma("unroll") for (int k = 0; k < 2; ++k) \
        acc[ai][bj][m][n] = __builtin_amdgcn_mfma_f32_16x16x32_bf16(Bt[n][k], At[m][k], acc[ai][bj][m][n], 0, 0, 0); __builtin_amdgcn_s_setprio(0); } while (0)
#define MK_WAIT_V(n) asm volatile("s_waitcnt vmcnt(" #n ")" ::: "memory")
#define MK_WAIT_L(n) asm volatile("s_waitcnt lgkmcnt(" #n ")" ::: "memory")
#define MK_BAR __builtin_amdgcn_s_barrier()
#define MK_SCHED __builtin_amdgcn_sched_barrier(0)
    Unit cur, nxt; int ui = i0;
    if (i0 >= i1 || !S.next(i0, cur)) return;
    f32x4 acc[2][2][4][2];
#pragma unroll
    for (int a = 0; a < 2; ++a)
#pragma unroll
        for (int b = 0; b < 2; ++b)
#pragma unroll
            for (int m = 0; m < 4; ++m)
#pragma unroll
                for (int n = 0; n < 2; ++n) acc[a][b][m][n] = (f32x4){0.f, 0.f, 0.f, 0.f};
    bf16x8 At[4][2], B0[2][2], B1[2][2];
    unsigned vC[2][2];
    LAS u32x4* vpark = (LAS u32x4*)(lds + GPARK_OFF) + tid;
    if constexpr (GATHER) {
#pragma unroll
        for (int h = 0; h < 2; ++h)
#pragma unroll
            for (int i = 0; i < 2; ++i) { int R, C; stage_rc(tid * 16 + i * 8192, R, C); vC[h][i] = S.arow(cur, h * HALF + R) + (unsigned)(C * 2); }
    }
    const char* cA = cur.A; const char* cB = cur.B;
    MK_STAGE_B(MK_SB(0, 0), cB); MK_STAGE_B(MK_SB(0, 1), cB + hstepB); MK_STAGE_A(MK_SA(0, 0), cA, 0, vC); MK_STAGE_A(MK_SA(0, 1), cA, 1, vC);
    if (wr == 1) MK_BAR;
    MK_WAIT_V(2); MK_BAR;
    MK_STAGE_B(MK_SB(1, 0), cB + kstep); MK_STAGE_A(MK_SA(1, 0), cA + kstep, 0, vC); MK_STAGE_B(MK_SB(1, 1), cB + hstepB + kstep);
    MK_WAIT_V(6); MK_BAR;
    for (;;) {
        const bool has_next = (ui + 1 < i1) && S.next(ui + 1, nxt);
        const char* nA = has_next ? nxt.A : cA; const char* nB = has_next ? nxt.B : cB;
        if constexpr (GATHER) {
            u32x4 pv;
#pragma unroll
            for (int h = 0; h < 2; ++h)
#pragma unroll
                for (int i = 0; i < 2; ++i) { int R, C; stage_rc(tid * 16 + i * 8192, R, C); pv[h * 2 + i] = has_next ? (S.arow(nxt, h * HALF + R) + (unsigned)(C * 2)) : vC[h][i]; }
            *vpark = pv;
        }
        for (int t = 0; t < nt; t += 2) {
            const bool last = (t == nt - 2);
            const char* a1 = cA + (size_t)(t + 1) * kstep;
            const char* a2 = last ? nA : cA + (size_t)(t + 2) * kstep; const char* b2 = last ? nB : cB + (size_t)(t + 2) * kstep;
            const char* a3 = a2 + kstep; const char* b3 = b2 + kstep;
            MK_LDB(B0, 0, 0); MK_LDB(B1, 0, 1); MK_SCHED; MK_LDA(At, 0, 0); MK_STAGE_A(MK_SA(1, 1), a1, 1, vC);
            if constexpr (GATHER) { if (last) { const u32x4 pv = *vpark; vC[0][0] = pv[0]; vC[0][1] = pv[1]; vC[1][0] = pv[2]; vC[1][1] = pv[3]; } }
            MK_WAIT_V(8); MK_WAIT_L(0); MK_BAR; MK_MMA(0, 0, At, B0); MK_MMA(0, 1, At, B1); MK_BAR; MK_SCHED;
            MK_LDA(At, 0, 1); MK_STAGE_B(MK_SB(0, 0), b2); MK_STAGE_B(MK_SB(0, 1), b2 + hstepB); MK_STAGE_A(MK_SA(0, 0), a2, 0, vC);
            MK_WAIT_V(8); MK_WAIT_L(0); MK_BAR; MK_MMA(1, 0, At, B0); MK_MMA(1, 1, At, B1); MK_BAR; MK_SCHED;
            MK_LDB(B0, 1, 0); MK_LDB(B1, 1, 1); MK_SCHED; MK_LDA(At, 1, 0); MK_STAGE_A(MK_SA(0, 1), a2, 1, vC);
            MK_WAIT_V(8); MK_WAIT_L(0); MK_BAR; MK_MMA(0, 0, At, B0); MK_MMA(0, 1, At, B1); MK_BAR; MK_SCHED;
            MK_LDA(At, 1, 1); MK_STAGE_B(MK_SB(1, 0), b3); MK_STAGE_B(MK_SB(1, 1), b3 + hstepB); MK_STAGE_A(MK_SA(1, 0), a3, 0, vC);
            MK_WAIT_V(8); MK_WAIT_L(0); MK_BAR; MK_MMA(1, 0, At, B0); MK_MMA(1, 1, At, B1); MK_BAR; MK_SCHED;
        }
        if (wr == 0) MK_BAR;
        E(acc, cur, wr, wc, fr, fq);
        if (!has_next) break;
#pragma unroll
        for (int a = 0; a < 2; ++a)
#pragma unroll
            for (int b = 0; b < 2; ++b)
#pragma unroll
                for (int m = 0; m < 4; ++m)
#pragma unroll
                    for (int n = 0; n < 2; ++n) acc[a][b][m][n] = (f32x4){0.f, 0.f, 0.f, 0.f};
        cur = nxt; cA = nA; cB = nB; ++ui;
        if (wr == 1) MK_BAR;
    }
    MK_WAIT_V(0);
    MK_BAR;
#undef MK_SA
#undef MK_SB
#undef MK_STAGE2
#undef MK_STAGE_B
#undef MK_STAGE_A
#undef MK_LDA
#undef MK_LDB
#undef MK_MMA
#undef MK_WAIT_V
#undef MK_WAIT_L
#undef MK_BAR
#undef MK_SCHED
}

__device__ __forceinline__ void grid_map(int L, int nM, int nN, int& pm, int& pn) {
    const int nwg = nM * nN, q = nwg / 8, xcd = L % 8, off = L / 8; const int wgid = xcd * q + off;
    const int nig = 8 * nN, gid = wgid / nig, fm = gid * 8, gsz = (nM - fm) < 8 ? (nM - fm) : 8;
    pm = fm + ((wgid % nig) % gsz); pn = (wgid % nig) / gsz;
}

struct EpiStore {
    const float* w2048;
    __device__ __forceinline__ void operator()(const f32x4 (&acc)[2][2][4][2], const Unit& u, int wr, int wc, int fr, int fq) const {
        const int col0 = wc * 32 + 8 * fq;
#pragma unroll
        for (int ai = 0; ai < 2; ++ai)
#pragma unroll
            for (int m = 0; m < 4; ++m) {
                const int r = ai * HALF + wr * 64 + m * 16 + fr;
                if (r < u.rows && r >= u.rmin) {
#pragma unroll
                    for (int bj = 0; bj < 2; ++bj) {
                        f32x4 v0 = acc[ai][bj][m][0], v1 = acc[ai][bj][m][1];
                        if (u.mode == 1) { float* p = (float*)u.C + (long)r * u.ldc + col0 + bj * u.bjs; *(f32x4*)p = v0; *(f32x4*)(p + 4) = v1; }
                        else {
                            if (u.mode == 2) {
#pragma unroll
                                for (int c = 0; c < 4; ++c) { v0[c] = __builtin_amdgcn_rcpf(1.0f + __expf(-v0[c])); v1[c] = __builtin_amdgcn_rcpf(1.0f + __expf(-v1[c])); }
                            } else if (u.mode == 3) {
                                const float* wp = w2048 + u.pn + bj * HALF + col0; const float sg = (r & 1) ? -1.0f : 1.0f;
                                v0 += *(const f32x4*)wp * sg; v1 += *(const f32x4*)(wp + 4) * sg;
                            }
                            u32x4 w; w.x = cvt_pk_bf16(v0[0], v0[1]); w.y = cvt_pk_bf16(v0[2], v0[3]); w.z = cvt_pk_bf16(v1[0], v1[1]); w.w = cvt_pk_bf16(v1[2], v1[3]);
                            *(u32x4*)((bf16_t*)u.C + (long)r * u.ldc + col0 + bj * u.bjs) = w;
                        }
                    }
                }
            }
    }
};

struct Args { const float* in[22]; float* out; unsigned char* ws; int ph_lo, ph_hi, use_ut, mod_off, do_attn, bar_idx; };
struct Frame {
    LAS unsigned char* lds; volatile LAS unsigned* MISC; unsigned char* ws;
    int tid, lane, wave, vcu, G;
};

__device__ __forceinline__ void t64_load(f32x4 (&v)[16], const float* W, int ldw, int lane) {
    const int kk = lane >> 4, nc = (lane & 15) * 4;
#pragma unroll
    for (int j = 0; j < 16; ++j) v[j] = *(const GAS f32x4*)(W + (size_t)(j * 4 + kk) * ldw + nc);
}
__device__ __forceinline__ void t64_store(const f32x4 (&v)[16], bf16_t* dst, int ldd, LAS float* scr, int lane) {
    const int kk = lane >> 4, nc = (lane & 15) * 4;
#pragma unroll
    for (int j = 0; j < 16; ++j) {
#pragma unroll
        for (int c = 0; c < 4; ++c) scr[(j * 4 + kk) * 65 + nc + c] = v[j][c]; }
    LDS_WAIT(); asm volatile("" ::: "memory");
    const int kc = lane & 7;
#pragma unroll
    for (int jj = 0; jj < 8; jj += 2) {
        float t[2][8];
#pragma unroll
        for (int q = 0; q < 2; ++q) { const int n = (lane >> 3) + 8 * (jj + q); const LAS float* s = scr + (8 * kc) * 65 + n;
#pragma unroll
            for (int i = 0; i < 8; ++i) t[q][i] = s[i * 65]; }
#pragma unroll
        for (int q = 0; q < 2; ++q) { const int n = (lane >> 3) + 8 * (jj + q);
            u32x4 o; o.x = cvt_pk_bf16(t[q][0], t[q][1]); o.y = cvt_pk_bf16(t[q][2], t[q][3]); o.z = cvt_pk_bf16(t[q][4], t[q][5]); o.w = cvt_pk_bf16(t[q][6], t[q][7]);
            *(GAS u32x4*)(dst + (size_t)n * ldd + 8 * kc) = o; } }
    LDS_WAIT(); asm volatile("" ::: "memory");
}
__device__ __forceinline__ void transpose64(const float* W, int ldw, bf16_t* dst, int ldd, LAS float* scr, int lane) {
    f32x4 v[16]; t64_load(v, W, ldw, lane); t64_store(v, dst, ldd, scr, lane);
}

constexpr int IT_IN = 32 * 128, IT_FO = 16 * 32, IT_AO = 32 * 32, IT_O = 32 * 32, IT_EG = 64 * 256, IT_EU = 64 * 256, IT_ED = 64 * 256, IT_SH = 256;
constexpr int IT_T_END = IT_IN + IT_FO + IT_AO + IT_O + 3 * IT_SH;
constexpr int IT_MOD = MODC / 32, IT_CST = 4096, IT_BD2 = 512;
constexpr int IT_ALL = IT_T_END + IT_MOD + IT_CST + IT_BD2;

__device__ __forceinline__ void p0_prologue(Frame& F, const Args& args) {
    LAS float* scr = (LAS float*)(F.lds + F.wave * 16640);
    const int gw = F.vcu * NWAVES + F.wave, NGW = F.G * NWAVES, lane = F.lane;
    unsigned char* ws = F.ws;
    bf16_t* WT_IN = (bf16_t*)(ws + WS_WT_IN); bf16_t* WT_FO = (bf16_t*)(ws + WS_WT_FO); bf16_t* WT_AO = (bf16_t*)(ws + WS_WT_AO); bf16_t* WT_O = (bf16_t*)(ws + WS_WT_O);
    bf16_t* WT_GU = (bf16_t*)(ws + WS_WT_GU); bf16_t* WT_D = (bf16_t*)(ws + WS_WT_D);
    for (int it = gw; it < IT_ALL; it += NGW) {
        int r = it < IT_MOD ? it + IT_T_END : (it < IT_T_END + IT_MOD ? it - IT_MOD : it);
        if (r < IT_IN) { const int kb = r / 128, nb = r % 128; transpose64(args.in[7] + (size_t)(kb * 64) * INC + nb * 64, INC, WT_IN + (size_t)(nb * 64) * DM + kb * 64, DM, scr, lane); continue; } r -= IT_IN;
        if (r < IT_FO) { const int kb = r / 32, nb = r % 32; transpose64(args.in[10] + (size_t)(kb * 64) * DM + nb * 64, DM, WT_FO + (size_t)(nb * 64) * FW + kb * 64, FW, scr, lane); continue; } r -= IT_FO;
        if (r < IT_AO) { const int kb = r / 32, nb = r % 32; transpose64(args.in[11] + (size_t)(kb * 64) * DM + nb * 64, DM, WT_AO + (size_t)(nb * 64) * DM + kb * 64, DM, scr, lane); continue; } r -= IT_AO;
        if (r < IT_O) { const int kb = r / 32, nb = r % 32; transpose64(args.in[12] + (size_t)(kb * 64) * DM + nb * 64, DM, WT_O + (size_t)(nb * 64) * DM + kb * 64, DM, scr, lane); continue; } r -= IT_O;
        if (r < 2 * IT_SH) { const int up = r >= IT_SH; if (up) r -= IT_SH; const int kb = r / 8, nb = r % 8, n0 = nb * 64;
            transpose64((up ? args.in[20] : args.in[19]) + (size_t)(kb * 64) * EFF + n0, EFF, WT_GU + ((size_t)64 * 1024 + (n0 >> 7) * 256 + (up ? 128 : 0) + (n0 & 127)) * DM + kb * 64, DM, scr, lane); continue; } r -= 2 * IT_SH;
        if (r < IT_SH) { const int kb = r / 32, nb = r % 32;
            transpose64(args.in[21] + (size_t)(kb * 64) * DM + nb * 64, DM, WT_D + ((size_t)64 * DM + nb * 64) * EFF + kb * 64, EFF, scr, lane); continue; } r -= IT_SH;
        if (r < IT_MOD) {
            const int kq = lane >> 3, col = r * 32 + (lane & 7) * 4;
            f32x4 a0 = {0.f, 0.f, 0.f, 0.f}, a1 = a0, a2 = a0;
            for (int jb = 0; jb < 256; jb += 8) {
                f32x4 w[8]; float c0[8], c1[8], c2[8];
#pragma unroll
                for (int j = 0; j < 8; ++j) { const int k = kq + 8 * (jb + j); w[j] = *(const GAS f32x4*)(args.in[4] + (size_t)k * MODC + col); c0[j] = args.in[1][k]; c1[j] = args.in[1][DM + k]; c2[j] = args.in[3][k]; }
#pragma unroll
                for (int j = 0; j < 8; ++j) { a0 += w[j] * (c0[j] * __builtin_amdgcn_rcpf(1.0f + __expf(-c0[j]))); a1 += w[j] * (c1[j] * __builtin_amdgcn_rcpf(1.0f + __expf(-c1[j]))); a2 += w[j] * (c2[j] * __builtin_amdgcn_rcpf(1.0f + __expf(-c2[j]))); }
            }
#pragma unroll
            for (int c = 0; c < 4; ++c) {
#pragma unroll
                for (int o = 8; o < 64; o <<= 1) { a0[c] += __shfl_xor(a0[c], o); a1[c] += __shfl_xor(a1[c], o); a2[c] += __shfl_xor(a2[c], o); } }
            if (kq == 0) { const f32x4 bb = *(const GAS f32x4*)(args.in[5] + col); float* MODP = (float*)(ws + WS_MOD);
                *(GAS f32x4*)(MODP + col) = a0 + bb; *(GAS f32x4*)(MODP + MODC + col) = a1 + bb; *(GAS f32x4*)(MODP + 2 * MODC + col) = a2 + bb; }
            continue; } r -= IT_MOD;
        if (r < IT_CST) {
            const int k1 = r & 2047; bf16_t* dst = (bf16_t*)(ws + WS_CST) + (size_t)r * 2048;
#pragma unroll
            for (int j = 0; j < 4; ++j) { const int n0 = j * 512 + lane * 8; float f[8];
#pragma unroll
                for (int i = 0; i < 8; ++i) { const float ph = (float)((k1 * (n0 + i)) & 4095) * (1.0f / 2048.0f); f[i] = r < 2048 ? cospif(ph) : sinpif(ph); }
                u32x4 o; o.x = cvt_pk_bf16(f[0], f[1]); o.y = cvt_pk_bf16(f[2], f[3]); o.z = cvt_pk_bf16(f[4], f[5]); o.w = cvt_pk_bf16(f[6], f[7]);
                *(GAS u32x4*)(dst + n0) = o; }
            continue; } r -= IT_CST;
        {
            const int t = r >> 8, o = r & 255, gp = o >> 7, k2 = o & 127; bf16_t* dst = (bf16_t*)(ws + WS_BD2) + (size_t)r * 512; float f[8];
#pragma unroll
            for (int i = 0; i < 8; ++i) { const int j = lane * 8 + i, cg = j >> 8, jj = j & 255, c = jj & 127; const float ph = (float)((32 * c * k2) & 4095) * (1.0f / 2048.0f);
                const float v = jj < 128 ? cospif(ph) : (t ? sinpif(ph) : -sinpif(ph)); f[i] = cg == gp ? v * 0.0013810679320049757f : 0.f; }
            u32x4 w; w.x = cvt_pk_bf16(f[0], f[1]); w.y = cvt_pk_bf16(f[2], f[3]); w.z = cvt_pk_bf16(f[4], f[5]); w.w = cvt_pk_bf16(f[6], f[7]);
            *(GAS u32x4*)(dst + lane * 8) = w;
        }
    }
}


__device__ __forceinline__ void conv_addr(const Args& args, unsigned char* ws, bool down, int it, const float*& W, int& ldw, bf16_t*& dst, int& ldd) {
    if (!down) { int r = it; const int up = r >= IT_EG; if (up) r -= IT_EG;
        const int e = r / 256, q = r % 256, kb = q / 8, nb = q % 8, n0 = nb * 64;
        W = (up ? args.in[17] : args.in[16]) + (size_t)e * DM * EFF + (size_t)(kb * 64) * EFF + n0; ldw = EFF;
        dst = (bf16_t*)(ws + WS_WT_GU) + ((size_t)e * 1024 + (n0 >> 7) * 256 + (up ? 128 : 0) + (n0 & 127)) * DM + kb * 64; ldd = DM;
    } else { const int r = it, e = r / 256, q = r % 256, kb = q / 32, nb = q % 32;
        W = args.in[18] + (size_t)e * EFF * DM + (size_t)(kb * 64) * DM + nb * 64; ldw = DM;
        dst = (bf16_t*)(ws + WS_WT_D) + ((size_t)e * DM + nb * 64) * EFF + kb * 64; ldd = EFF; }
}
__device__ __forceinline__ void conv_items(Frame& F, const Args& args, bool down, int first, int count) {
    LAS float* scr = (LAS float*)(F.lds + F.wave * 16640);
    const int end = first + count; int it = first + F.wave;
    if (it >= end) return;
    f32x4 va[16], vb[16]; const float* W; int ldw; bf16_t* da; bf16_t* db; int ldd;
    conv_addr(args, F.ws, down, it, W, ldw, da, ldd); t64_load(va, W, ldw, F.lane);
    for (;;) {
        const bool hb = it + NWAVES < end;
        if (hb) { conv_addr(args, F.ws, down, it + NWAVES, W, ldw, db, ldd); t64_load(vb, W, ldw, F.lane); }
        t64_store(va, da, ldd, scr, F.lane);
        if (!hb) break;
        const bool ha = it + 2 * NWAVES < end;
        if (ha) { conv_addr(args, F.ws, down, it + 2 * NWAVES, W, ldw, da, ldd); t64_load(va, W, ldw, F.lane); }
        t64_store(vb, db, ldd, scr, F.lane);
        if (!ha) break;
        it += 2 * NWAVES;
    }
}
struct SchedIn {
    int G, c; unsigned char* ws; int use_ut;
    __device__ __forceinline__ bool next(int i, Unit& u) const {
        const int L = i * G + c; if (L >= 904) return false;
        const char* H = (const char*)(ws + WS_H); const char* WT = (const char*)(ws + WS_WT_IN);
        u.rows = 256; u.aux = 0; u.bjs = HALF; u.pm = 0; u.pn = 0; u.rmin = 0;
        if (L < 896) {
            int pm, ct; grid_map(L, 32, 28, pm, ct);
            const int row0 = pm * 256, b = row0 / SEQ, t0 = row0 % SEQ;
            u.A = H + (size_t)row0 * DM * 2; u.B = WT + (size_t)ct * 256 * DM * 2;
            if (ct < 4) {
                if (use_ut) { u.A = WT + (size_t)ct * 256 * DM * 2; u.B = H + (size_t)row0 * DM * 2;
                              u.C = (char*)(ws + WS_UT) + (((size_t)b * FW + ct * 256) * SEQ + t0) * 2; u.ldc = SEQ; u.mode = 0; }
                else { u.C = (char*)(ws + WS_U) + ((size_t)row0 * FW + ct * 256) * 2; u.ldc = FW; u.mode = 0; }
            }
            else if (ct < 14) { u.C = (char*)(ws + WS_QKRAW) + ((size_t)row0 * 2560 + (ct - 4) * 256) * 4; u.ldc = 2560; u.mode = 1; }
            else if (ct < 16) { u.C = (char*)(ws + WS_VALL) + (((size_t)b * SKV + t0) * KVW + (ct - 14) * 256) * 2; u.ldc = KVW; u.mode = 0; }
            else if (ct < 24) { u.C = (char*)(ws + WS_SGF) + ((size_t)row0 * DM + (ct - 16) * 256) * 2; u.ldc = DM; u.mode = 2; }
            else              { u.C = (char*)(ws + WS_SGA) + ((size_t)row0 * DM + (ct - 24) * 256) * 2; u.ldc = DM; u.mode = 2; }
        } else {
            const int l = L - 896, pm = l & 1, ct = l >> 1;
            u.A = H + (size_t)(NTOK + pm * 256) * DM * 2; u.B = WT + (size_t)(K_OFF + ct * 256) * DM * 2;
            if (ct < 2) { u.C = (char*)(ws + WS_KCRAW) + ((size_t)(pm * 256) * KVW + ct * 256) * 4; u.ldc = KVW; u.mode = 1; }
            else        { u.C = (char*)(ws + WS_VALL) + (((size_t)pm * SKV + SEQ) * KVW + (ct - 2) * 256) * 2; u.ldc = KVW; u.mode = 0; }
        }
        return true;
    }
    __device__ __forceinline__ unsigned arow(const Unit&, int) const { return 0u; }
};


__device__ __forceinline__ void unpack8(u32x4 w, float (&f)[8]) {
#pragma unroll
    for (int i = 0; i < 4; ++i) { f[2 * i] = __uint_as_float(w[i] << 16); f[2 * i + 1] = __uint_as_float(w[i] & 0xffff0000u); }
}
struct EpiT1 { const bf16_t* SGF; float* T1;
    __device__ __forceinline__ void operator()(const f32x4 (&acc)[2][2][4][2], const Unit& u, int wr, int wc, int fr, int fq) const {
#pragma unroll
        for (int ai = 0; ai < 2; ++ai)
#pragma unroll
            for (int m = 0; m < 4; ++m) { const size_t row = (size_t)u.pm * 256 + ai * HALF + wr * 64 + m * 16 + fr;
#pragma unroll
                for (int bj = 0; bj < 2; ++bj) { const size_t o = row * DM + u.pn * 256 + bj * HALF + wc * 32 + 8 * fq;
                    float g[8]; unpack8(*(const u32x4*)(SGF + o), g); const f32x4 v0 = acc[ai][bj][m][0], v1 = acc[ai][bj][m][1];
                    *(f32x4*)(T1 + o) = (f32x4){g[0] * v0[0], g[1] * v0[1], g[2] * v0[2], g[3] * v0[3]};
                    *(f32x4*)(T1 + o + 4) = (f32x4){g[4] * v1[0], g[5] * v1[1], g[6] * v1[2], g[7] * v1[3]}; } }
    } };
struct EpiYM { const bf16_t* SGA; const float* T1; bf16_t* YM;
    __device__ __forceinline__ void operator()(const f32x4 (&acc)[2][2][4][2], const Unit& u, int wr, int wc, int fr, int fq) const {
#pragma unroll
        for (int ai = 0; ai < 2; ++ai)
#pragma unroll
            for (int m = 0; m < 4; ++m) { const size_t row = (size_t)u.pm * 256 + ai * HALF + wr * 64 + m * 16 + fr;
#pragma unroll
                for (int bj = 0; bj < 2; ++bj) { const size_t o = row * DM + u.pn * 256 + bj * HALF + wc * 32 + 8 * fq;
                    float g[8]; unpack8(*(const u32x4*)(SGA + o), g); const f32x4 v0 = acc[ai][bj][m][0], v1 = acc[ai][bj][m][1];
                    const f32x4 t0 = *(const f32x4*)(T1 + o), t1 = *(const f32x4*)(T1 + o + 4);
                    u32x4 w; w.x = cvt_pk_bf16(t0[0] + g[0] * v0[0], t0[1] + g[1] * v0[1]); w.y = cvt_pk_bf16(t0[2] + g[2] * v0[2], t0[3] + g[3] * v0[3]);
                    w.z = cvt_pk_bf16(t1[0] + g[4] * v1[0], t1[1] + g[5] * v1[1]); w.w = cvt_pk_bf16(t1[2] + g[6] * v1[2], t1[3] + g[7] * v1[3]);
                    *(u32x4*)(YM + o) = w; } }
    } };
struct EpiX2 { const float* x; const float* mod; float* X2;
    __device__ __forceinline__ void operator()(const f32x4 (&acc)[2][2][4][2], const Unit& u, int wr, int wc, int fr, int fq) const {
        const float* g1 = mod + ((u.pm * 256) / SEQ) * MODC + 2 * DM;
#pragma unroll
        for (int ai = 0; ai < 2; ++ai)
#pragma unroll
            for (int m = 0; m < 4; ++m) { const size_t row = (size_t)u.pm * 256 + ai * HALF + wr * 64 + m * 16 + fr;
#pragma unroll
                for (int bj = 0; bj < 2; ++bj) { const int col = u.pn * 256 + bj * HALF + wc * 32 + 8 * fq; const size_t o = row * DM + col;
#pragma unroll
                    for (int n = 0; n < 2; ++n) { const f32x4 xv = *(const f32x4*)(x + o + 4 * n), gv = *(const f32x4*)(g1 + col + 4 * n); *(f32x4*)(X2 + o + 4 * n) = xv + gv * acc[ai][bj][m][n]; } } }
    } };
struct EpiAct {
    __device__ __forceinline__ void operator()(const f32x4 (&acc)[2][2][4][2], const Unit& u, int wr, int wc, int fr, int fq) const {
#pragma unroll
        for (int ai = 0; ai < 2; ++ai)
#pragma unroll
            for (int m = 0; m < 4; ++m) { const int r = ai * HALF + wr * 64 + m * 16 + fr;
                if (r < u.rows) { float a[8];
#pragma unroll
                    for (int n = 0; n < 2; ++n)
#pragma unroll
                        for (int c = 0; c < 4; ++c) { const float g = acc[ai][0][m][n][c], up = acc[ai][1][m][n][c]; a[4 * n + c] = g * __builtin_amdgcn_rcpf(1.0f + __expf(-g)) * up; }
                    u32x4 w; w.x = cvt_pk_bf16(a[0], a[1]); w.y = cvt_pk_bf16(a[2], a[3]); w.z = cvt_pk_bf16(a[4], a[5]); w.w = cvt_pk_bf16(a[6], a[7]);
                    *(u32x4*)((bf16_t*)u.C + (size_t)r * u.ldc + wc * 32 + 8 * fq) = w; } }
    } };

struct SchedGrid {
    int G, c, nM, nN; const char* A; const char* B; char* C; size_t astride, bstride; int ldc, esz, mode;
    __device__ __forceinline__ bool next(int i, Unit& u) const {
        const int L = i * G + c; if (L >= nM * nN) return false;
        int pm, pn; grid_map(L, nM, nN, pm, pn);
        u.A = A + (size_t)pm * astride; u.B = B + (size_t)pn * bstride; u.C = C + ((size_t)pm * 256 * ldc + pn * 256) * esz; u.ldc = ldc; u.mode = mode; u.rows = 256; u.aux = 0; u.pm = pm; u.pn = pn; u.bjs = HALF; u.rmin = 0;
        return true; }
    __device__ __forceinline__ unsigned arow(const Unit&, int) const { return 0u; } };
struct SchedAG { int G, c; unsigned char* ws;
    __device__ __forceinline__ bool next(int i, Unit& u) const {
        const int L = i * G + c; if (L >= 256) return false;
        u.rows = 256; u.aux = 0; u.rmin = 0;
        if (L < 128) {
            int pm, pn8; grid_map(L, 16, 8, pm, pn8); const int b = pn8 >> 2, pn = pn8 & 3, sn = pm >> 3, k1t = pm & 7;
            u.A = (const char*)(ws + WS_CST) + (size_t)pm * 256 * 2048 * 2; u.B = (const char*)(ws + (sn ? WS_OT : WS_ET)) + ((size_t)b * FW + pn * 256) * 2048 * 2;
            u.C = (char*)(ws + WS_TT) + (((size_t)b * 2048 + k1t * 256) * DM + pn * 512 + sn * 128) * 2; u.ldc = DM; u.mode = sn ? 0 : 3; u.pm = k1t; u.pn = b * FW + pn * 256; u.bjs = 256;
        } else {
            int pm, q; grid_map(L - 128, 32, 4, pm, q); const int ct = 28 + q;
            u.A = (const char*)(ws + WS_H) + (size_t)pm * 256 * DM * 2; u.B = (const char*)(ws + WS_WT_IN) + (size_t)ct * 256 * DM * 2;
            u.C = (char*)(ws + WS_SGA) + ((size_t)pm * 256 * DM + (ct - 24) * 256) * 2; u.ldc = DM; u.mode = 2; u.pm = pm; u.pn = ct; u.bjs = HALF;
        }
        return true; }
    __device__ __forceinline__ unsigned arow(const Unit&, int) const { return 0u; } };
struct SchedF2 { int G, c; unsigned char* ws;
    __device__ __forceinline__ bool next(int i, Unit& u) const {
        const int L = i * G + c; if (L >= 128) return false;
        int pm, q; grid_map(L, 16, 8, pm, q); const int b = pm >> 3, k1t = pm & 7, j = q & 3, mir = q >> 2;
        u.A = (const char*)(ws + WS_TT) + (((size_t)b * 2048 + k1t * 256) * DM + j * 512) * 2; u.B = (const char*)(ws + WS_BD2) + (size_t)mir * 256 * 512 * 2;
        u.mode = 0; u.rows = 256; u.aux = 0; u.pm = pm; u.pn = j; u.bjs = HALF;
        if (!mir) { u.C = (char*)(ws + WS_YF) + (((size_t)b * SEQ + k1t * 256) * FW + j * 256) * 2; u.ldc = FW; u.rmin = 0; }
        else { u.C = (char*)(ws + WS_YF) + (((size_t)b * SEQ + SEQ - k1t * 256) * FW + j * 256) * 2; u.ldc = -FW; u.rmin = k1t == 0 ? 1 : 0; }
        return true; }
    __device__ __forceinline__ unsigned arow(const Unit&, int) const { return 0u; } };
constexpr int SCHT_OFF = LDSCTL_OFF + 1024;
__device__ __forceinline__ void moe_tables(Frame& F, int ncol_tiles) {
    LAS int* T = (LAS int*)(F.lds + SCHT_OFF);
    __syncthreads();
    if (F.tid == 0) { const int* CNT = (const int*)(F.ws + CTL_CNT); int up = 0, of = 0;
        for (int e = 0; e <= NE; ++e) { const int cn = e < NE ? CNT[e * 64] : NTOK; T[e] = up; T[80 + e] = e < NE ? of : NSLOT; T[160 + e] = cn; up += ((cn + 255) >> 8) * ncol_tiles; of += cn; }
        T[NE + 1] = up; }
    __syncthreads();
}
template <int NCT, bool FIRST> struct SchedMoe {
    int G, c; unsigned char* ws; LAS int* T; const int* TOK;
    __device__ __forceinline__ bool next(int i, Unit& u) const {
        const int L = i * G + c; if (L >= T[NE + 1]) return false;
        int lo = 0, hi = NE;
#pragma unroll 1
        while (lo < hi) { const int mid = (lo + hi + 1) >> 1; if (T[mid] <= L) lo = mid; else hi = mid - 1; }
        const int e = lo, cn = T[160 + e], ntile = (cn + 255) >> 8, local = L - T[e], ct = local / ntile, mt = local % ntile, slot0 = T[80 + e] + mt * 256;
        u.rows = (cn - mt * 256) < 256 ? (cn - mt * 256) : 256; u.aux = slot0; u.pm = mt; u.pn = ct; u.bjs = HALF; u.mode = 0; u.rmin = 0;
        if (FIRST) { u.A = (const char*)(ws + WS_H2); u.B = (const char*)(ws + WS_WT_GU) + ((size_t)e * 4 + ct) * 256 * DM * 2; u.C = (char*)(ws + WS_ACT) + ((size_t)slot0 * EFF + ct * 128) * 2; u.ldc = EFF; }
        else { u.A = (const char*)(ws + WS_ACT) + (size_t)slot0 * EFF * 2; u.B = (const char*)(ws + WS_WT_D) + ((size_t)e * DM + ct * 256) * EFF * 2; u.C = (char*)(ws + WS_YBIG) + ((size_t)slot0 * DM + ct * 256) * 2; u.ldc = DM; }
        return true; }
    __device__ __forceinline__ unsigned arow(const Unit& u, int r) const { const int rr = r < u.rows ? r : u.rows - 1; return (unsigned)TOK[u.aux + rr] * (unsigned)(DM * 2); } };

namespace attn {
using s16x4 = __attribute__((ext_vector_type(4))) short;
using f32x8 = __attribute__((ext_vector_type(8))) float;
constexpr int D = 128, NW = 8, QBLK = 32, KVBLK = 64;
constexpr float SCALE = 0.088388347648318440f;
constexpr float THR = 8.f;
constexpr int LDQ = DM, LDK = KVW, LDO = DM;
constexpr size_t SHM_V = KVBLK * D * 2, SHM_K = KVBLK * D * 2, SHM_ATTN = 2 * SHM_V + 2 * SHM_K + NW * 64 * 4;
#define KSWZ(row, colB) ((row) * 256 + ((colB) ^ (((row) & 7) << 4)))
#define SBAR() __builtin_amdgcn_sched_barrier(0)
__device__ __forceinline__ unsigned cvtpk(float lo, float hi) { unsigned r; asm volatile("v_cvt_pk_bf16_f32 %0, %1, %2" : "=v"(r) : "v"(lo), "v"(hi)); return r; }
__device__ __forceinline__ void partialSM(f32x16& p0, f32x16& p1, float& m_reg, float& mn, float& alpha) {
  constexpr float C = SCALE * 1.4426950408889634f;
  float pmax = p0[0]; for (int r = 1; r < 16; ++r) pmax = fmaxf(pmax, p0[r]); for (int r = 0; r < 16; ++r) pmax = fmaxf(pmax, p1[r]);
  { auto rr = __builtin_amdgcn_permlane32_swap(__float_as_uint(pmax), __float_as_uint(pmax), false, false);
    pmax = fmaxf(__uint_as_float(rr[0]), __uint_as_float(rr[1])); }
  if (__builtin_expect(__all(pmax - m_reg <= THR / SCALE), 1)) { mn = m_reg; alpha = 1.f; }
  else { mn = fmaxf(m_reg, pmax); alpha = __builtin_amdgcn_exp2f((m_reg - mn) * C); m_reg = mn; }
  float mnC = -mn * C;
  for (int r = 0; r < 16; ++r) p0[r] = fmaf(p0[r], C, mnC); for (int r = 0; r < 16; ++r) p1[r] = fmaf(p1[r], C, mnC);
  for (int r = 0; r < 16; ++r) p0[r] = __builtin_amdgcn_exp2f(p0[r]);
}
__device__ __forceinline__ void finishSM(f32x16& p0, f32x16& p1, float alpha, float& l_reg, bf16x8& pa0, bf16x8& pa1, bf16x8& pa2, bf16x8& pa3) {
  for (int r = 0; r < 16; ++r) p1[r] = __builtin_amdgcn_exp2f(p1[r]);
  float ps = 0; for (int r = 0; r < 16; ++r) ps += p0[r]; for (int r = 0; r < 16; ++r) ps += p1[r];
  { auto rr = __builtin_amdgcn_permlane32_swap(__float_as_uint(ps), __float_as_uint(ps), false, false);
    ps = __uint_as_float(rr[0]) + __uint_as_float(rr[1]); }
  l_reg = l_reg * alpha + ps;
#define PK4(P, BASE, OUT) do { unsigned a0 = cvtpk(P[BASE + 0], P[BASE + 1]), a1 = cvtpk(P[BASE + 2], P[BASE + 3]);   \
    unsigned b0 = cvtpk(P[BASE + 4], P[BASE + 5]), b1 = cvtpk(P[BASE + 6], P[BASE + 7]);                              \
    auto r0 = __builtin_amdgcn_permlane32_swap(a0, b0, false, false); auto r1 = __builtin_amdgcn_permlane32_swap(a1, b1, false, false); \
    u32x4 w = {r0[0], r1[0], r0[1], r1[1]}; OUT = *reinterpret_cast<bf16x8*>(&w); } while (0)
  PK4(p0, 0, pa0); PK4(p0, 8, pa1); PK4(p1, 0, pa2); PK4(p1, 8, pa3);
#undef PK4
}
__device__ __forceinline__ void qkt(f32x16& p0, f32x16& p1, const bf16_t* Ks, const bf16x8* qr, int r32, int hi) {
  p0 = f32x16{}; p1 = f32x16{};
  for (int d0 = 0; d0 < 8; ++d0) { int cb = (d0 * 16 + hi * 8) * 2;
    bf16x8 b0 = *reinterpret_cast<const bf16x8*>((const char*)Ks + KSWZ(r32, cb));
    bf16x8 b1 = *reinterpret_cast<const bf16x8*>((const char*)Ks + KSWZ(32 + r32, cb));
    p0 = __builtin_amdgcn_mfma_f32_32x32x16_bf16(b0, qr[d0], p0, 0, 0, 0);
    p1 = __builtin_amdgcn_mfma_f32_32x32x16_bf16(b1, qr[d0], p1, 0, 0, 0); }
}
__device__ __forceinline__ int v_st(int k, int c) { const int kk = (k & ~0xC) | ((k & 4) << 1) | ((k & 8) >> 1); return ((kk >> 3) * 4 + (c >> 5)) * 512 + ((kk & 7) * 32 + (c & 31)) * 2; }
__device__ __forceinline__ int v_rd_base(int lane) { return ((lane & 3) << 3) | (((lane >> 2) & 3) << 6) | (((lane >> 4) & 1) << 5) | (((lane >> 5) & 1) << 8); }
constexpr int v_rd_off(int d0, int ks, int half) { return d0 * 512 + ks * 4096 + half * 2048; }
template <int OFF> __device__ __forceinline__ s16x4 tr_read(int vb) {
  s16x4 r; asm volatile("ds_read_b64_tr_b16 %0, %1 offset:%2" : "=&v"(r) : "v"(vb), "i"(OFF) : "memory"); return r;
}
template <int D0> __device__ __forceinline__ void pv_one(f32x16& od, int vb, bf16x8 pa0, bf16x8 pa1, bf16x8 pa2, bf16x8 pa3) {
  const s16x4 l0 = tr_read<v_rd_off(D0, 0, 0)>(vb), h0 = tr_read<v_rd_off(D0, 0, 1)>(vb), l1 = tr_read<v_rd_off(D0, 1, 0)>(vb), h1 = tr_read<v_rd_off(D0, 1, 1)>(vb);
  const s16x4 l2 = tr_read<v_rd_off(D0, 2, 0)>(vb), h2 = tr_read<v_rd_off(D0, 2, 1)>(vb), l3 = tr_read<v_rd_off(D0, 3, 0)>(vb), h3 = tr_read<v_rd_off(D0, 3, 1)>(vb);
  asm volatile("s_waitcnt lgkmcnt(0)" ::: "memory"); SBAR();
#define PK(L, H) (bf16x8){L[0], L[1], L[2], L[3], H[0], H[1], H[2], H[3]}
  od = __builtin_amdgcn_mfma_f32_32x32x16_bf16(pa0, PK(l0, h0), od, 0, 0, 0);
  od = __builtin_amdgcn_mfma_f32_32x32x16_bf16(pa1, PK(l1, h1), od, 0, 0, 0);
  od = __builtin_amdgcn_mfma_f32_32x32x16_bf16(pa2, PK(l2, h2), od, 0, 0, 0);
  od = __builtin_amdgcn_mfma_f32_32x32x16_bf16(pa3, PK(l3, h3), od, 0, 0, 0);
#undef PK
}
__device__ __forceinline__ void pv_d0(f32x16* o, int vb, bf16x8 pa0, bf16x8 pa1, bf16x8 pa2, bf16x8 pa3) {
  pv_one<0>(o[0], vb, pa0, pa1, pa2, pa3); pv_one<1>(o[1], vb, pa0, pa1, pa2, pa3); pv_one<2>(o[2], vb, pa0, pa1, pa2, pa3); pv_one<3>(o[3], vb, pa0, pa1, pa2, pa3);
}
__device__ __forceinline__ void attn_dense_body(const bf16_t* __restrict__ Qb, const bf16_t* __restrict__ Kh, const bf16_t* __restrict__ Vh, bf16_t* __restrict__ Ob, int seq, char* lds) {
  const int tid = threadIdx.x, wid = tid >> 6, lane = tid & 63, r32 = lane & 31, hi = lane >> 5;
  bf16_t* V_lds = (bf16_t*)lds; bf16_t* K_lds = (bf16_t*)(lds + 2 * SHM_V);
  float* ws = (float*)(lds + 2 * SHM_V + 2 * SHM_K) + wid * 64; float* li_l = ws; float* al_l = ws + 32;
  float m_reg = -1e30f, l_reg = 0; f32x16 o[4] = {}; bf16x8 qr[8];
  const bf16_t* Qw = Qb + (long)(wid * QBLK + r32) * LDQ + hi * 8;
#pragma unroll
  for (int d0 = 0; d0 < 8; ++d0) qr[d0] = *reinterpret_cast<const bf16x8*>(Qw + d0 * 16);
  const int sr = tid >> 4, sc = (tid & 15) * 8, vst0 = v_st(sr, sc), vst1 = v_st(32 + sr, sc);
  const int vb0 = (int)(uintptr_t)V_lds + v_rd_base(lane);
  struct { bf16x8 vs0, vs1, ks0, ks1; } sr_[2];
#define SLOAD(i, k0) do { sr_[i].vs0 = *reinterpret_cast<const bf16x8*>(&Vh[(long)((k0) + sr) * LDK + sc]); sr_[i].vs1 = *reinterpret_cast<const bf16x8*>(&Vh[(long)((k0) + 32 + sr) * LDK + sc]); \
    sr_[i].ks0 = *reinterpret_cast<const bf16x8*>(&Kh[(long)((k0) + sr) * LDK + sc]); sr_[i].ks1 = *reinterpret_cast<const bf16x8*>(&Kh[(long)((k0) + 32 + sr) * LDK + sc]); } while (0)
#define SWRITE(b, i) do { *(bf16x8*)((char*)V_lds + (b) * SHM_V + vst0) = sr_[i].vs0;          \
    *(bf16x8*)((char*)V_lds + (b) * SHM_V + vst1) = sr_[i].vs1; int kc = sc * 2;               \
    *(bf16x8*)((char*)K_lds + (b) * SHM_K + KSWZ(sr, kc)) = sr_[i].ks0;                       \
    *(bf16x8*)((char*)K_lds + (b) * SHM_K + KSWZ(32 + sr, kc)) = sr_[i].ks1; } while (0)
#define SWAIT() asm volatile("s_waitcnt vmcnt(4)" ::: "memory")
#define RESC(a) do { if (__any((a) < 1.f)) { if (hi == 0) al_l[r32] = (a); asm volatile("s_waitcnt lgkmcnt(0)" ::: "memory"); \
    for (int d = 0; d < 4; ++d) for (int r = 0; r < 16; ++r) o[d][r] *= al_l[crow(r, hi)]; } } while (0)
  f32x16 pA0, pA1, pB0, pB1; float mnA, mnB, alA, alB; bf16x8 pa0, pa1, pa2, pa3; const int NT = seq / KVBLK;
  constexpr int SE = 0, SO = 1;
  SLOAD(SE, 0); asm volatile("s_waitcnt vmcnt(0)" ::: "memory"); SWRITE(0, SE); __syncthreads();
  qkt(pA0, pA1, K_lds, qr, r32, hi); partialSM(pA0, pA1, m_reg, mnA, alA);
  SLOAD(SO, KVBLK); if (2 < NT) SLOAD(SE, 2 * KVBLK);
  SWAIT(); SWRITE(1, SO); __syncthreads();
  for (int j = 1; j + 1 < NT; j += 2) {
    SBAR(); qkt(pB0, pB1, (bf16_t*)((char*)K_lds + SHM_K), qr, r32, hi);
    finishSM(pA0, pA1, alA, l_reg, pa0, pa1, pa2, pa3); SBAR();
    SLOAD(SO, (j + 2) * KVBLK); SBAR();
    pv_d0(o, vb0, pa0, pa1, pa2, pa3); partialSM(pB0, pB1, m_reg, mnB, alB);
    __syncthreads(); SWAIT(); SWRITE(0, SE);
    RESC(alB); __syncthreads();
    SBAR(); qkt(pA0, pA1, K_lds, qr, r32, hi);
    finishSM(pB0, pB1, alB, l_reg, pa0, pa1, pa2, pa3); SBAR();
    if (j + 3 < NT) SLOAD(SE, (j + 3) * KVBLK); SBAR();
    pv_d0(o, vb0 + (int)SHM_V, pa0, pa1, pa2, pa3); partialSM(pA0, pA1, m_reg, mnA, alA);
    __syncthreads(); SWAIT(); SWRITE(1, SO);
    RESC(alA); __syncthreads();
  }
  SBAR(); qkt(pB0, pB1, (bf16_t*)((char*)K_lds + SHM_K), qr, r32, hi);
  finishSM(pA0, pA1, alA, l_reg, pa0, pa1, pa2, pa3); SBAR();
  pv_d0(o, vb0, pa0, pa1, pa2, pa3); partialSM(pB0, pB1, m_reg, mnB, alB);
  __syncthreads(); RESC(alB);
  finishSM(pB0, pB1, alB, l_reg, pa0, pa1, pa2, pa3); SBAR();
  pv_d0(o, vb0 + (int)SHM_V, pa0, pa1, pa2, pa3);
  if (hi == 0) li_l[r32] = l_reg; asm volatile("s_waitcnt lgkmcnt(0)" ::: "memory");
  float rli[16];
#pragma unroll
  for (int r = 0; r < 16; ++r) rli[r] = __builtin_amdgcn_rcpf(li_l[crow(r, hi)]);
  bf16_t* Ow = Ob + (long)(wid * QBLK) * LDO;
#pragma unroll
  for (int r = 0; r < 16; ++r) { int orow = crow(r, hi);
    for (int d0 = 0; d0 < 4; ++d0) Ow[(long)orow * LDO + d0 * 32 + r32] = f2bf(o[d0][r] * rli[r]); }
#undef SLOAD
#undef SWRITE
#undef SWAIT
#undef RESC
}
#undef KSWZ
#undef SBAR
}

__device__ __forceinline__ void ph_norm1(Frame& F, const Args& args, const float* mod) {
    const int gw = F.vcu * NWAVES + F.wave, NGW = F.G * NWAVES, lane = F.lane;
    bf16_t* H = (bf16_t*)(F.ws + WS_H); const float* nw = args.in[6];
    for (int row = gw; row < NTOK + NCTX; row += NGW) {
        const float* src = row < NTOK ? args.in[0] + (size_t)row * DM : args.in[2] + (size_t)(row - NTOK) * DM;
        const float* mr = mod + (row < NTOK ? row / SEQ : 2) * MODC;
        f32x4 v[8]; float ss = 0.f;
#pragma unroll
        for (int j = 0; j < 8; ++j) { v[j] = *(const GAS f32x4*)(src + (j * 64 + lane) * 4); ss += v[j].x * v[j].x + v[j].y * v[j].y + v[j].z * v[j].z + v[j].w * v[j].w; }
        ss = wave_sum(ss);
        const float rstd = 1.0f / sqrtf(ss * (1.0f / DM) + 1e-6f);
#pragma unroll
        for (int j = 0; j < 8; ++j) { const int i = (j * 64 + lane) * 4;
            const f32x4 w = *(const GAS f32x4*)(nw + i), sc = *(const GAS f32x4*)(mr + DM + i), sh = *(const GAS f32x4*)(mr + i);
            const f32x4 h = v[j] * rstd * w * (sc + 1.0f) + sh;
            unsigned lo = cvt_pk_bf16(h[0], h[1]), hi = cvt_pk_bf16(h[2], h[3]);
            *(GAS unsigned long long*)(H + (size_t)row * DM + i) = (unsigned long long)lo | ((unsigned long long)hi << 32); }
    }
}
__device__ __forceinline__ void ph_qknorm(Frame& F, const Args& args) {
    const int gw = F.vcu * NWAVES + F.wave, NGW = F.G * NWAVES, lane = F.lane;
    const float* QKRAW = (const float*)(F.ws + WS_QKRAW); const float* KCRAW = (const float*)(F.ws + WS_KCRAW);
    bf16_t* Q = (bf16_t*)(F.ws + WS_Q); bf16_t* KALL = (bf16_t*)(F.ws + WS_KALL);
    const int axis = lane >> 5, f = lane & 31, da = axis * 64 + f, db = da + 32;
    const float qwa = args.in[8][da], qwb = args.in[8][db], kwa = args.in[9][da], kwb = args.in[9][db];
    const float inv = exp2f(-(float)f * (13.287712379549449f / 32.0f));
    for (int row = gw; row < NTOK + NCTX; row += NGW) {
        if (row < NTOK) {
            const int b = row / SEQ, t = row % SEQ;
            const float pos = (float)(axis == 0 ? t / 64 : t % 64), ang = pos * inv, cs = cosf(ang), sn = sinf(ang);
            const float* src = QKRAW + (size_t)row * 2560;
#pragma unroll
            for (int hb = 0; hb < 20; hb += 5) {
                float xa[5], xb[5];
#pragma unroll
                for (int q = 0; q < 5; ++q) { xa[q] = src[(hb + q) * HD + da]; xb[q] = src[(hb + q) * HD + db]; }
#pragma unroll
                for (int q = 0; q < 5; ++q) { const int hh = hb + q;
                    const float ss = wave_sum(xa[q] * xa[q] + xb[q] * xb[q]), rstd = 1.0f / sqrtf(ss * (1.0f / HD) + 1e-6f);
                    const float a = xa[q] * rstd * (hh < 16 ? qwa : kwa), bb = xb[q] * rstd * (hh < 16 ? qwb : kwb);
                    bf16_t* dst = hh < 16 ? Q + (size_t)row * DM + hh * HD : KALL + ((size_t)b * SKV + t) * KVW + (hh - 16) * HD;
                    dst[da] = f2bf(a * cs - bb * sn); dst[db] = f2bf(bb * cs + a * sn); }
            }
        } else {
            const int r = row - NTOK, b = r / CTXL, j = r % CTXL; const float* src = KCRAW + (size_t)r * KVW;
#pragma unroll
            for (int hh = 0; hh < 4; ++hh) { const float xa = src[hh * HD + da], xb = src[hh * HD + db];
                const float ss = wave_sum(xa * xa + xb * xb), rstd = 1.0f / sqrtf(ss * (1.0f / HD) + 1e-6f);
                bf16_t* dst = KALL + ((size_t)b * SKV + SEQ + j) * KVW + hh * HD; dst[da] = f2bf(xa * rstd * kwa); dst[db] = f2bf(xb * rstd * kwb); }
        }
    }
}
__device__ __forceinline__ void ph_evenodd(Frame& F, const Args& args) {
    const int gw = F.vcu * NWAVES + F.wave, NGW = F.G * NWAVES, lane = F.lane;
    LAS bf16_t* scr = (LAS bf16_t*)(F.lds + F.wave * 16640);
    const bf16_t* UT = (const bf16_t*)(F.ws + WS_UT); bf16_t* ET = (bf16_t*)(F.ws + WS_ET); bf16_t* OT = (bf16_t*)(F.ws + WS_OT);
    float* W2 = (float*)(F.ws + WS_W2048); float* AL = (float*)(F.ws + WS_ALT);
    for (int row = gw; row < 2 * FW; row += NGW) {
        const bf16_t* src = UT + (size_t)row * SEQ; float alt = 0.f;
#pragma unroll
        for (int j = 0; j < 8; ++j) { const u32x4 w = *(const GAS u32x4*)(src + (j * 64 + lane) * 8); *(LAS u32x4*)(scr + (j * 64 + lane) * 8) = w;
            float f[8]; unpack8(w, f); alt += (f[0] - f[1]) + (f[2] - f[3]) + (f[4] - f[5]) + (f[6] - f[7]); }
        alt = wave_sum(alt);
        LDS_WAIT(); asm volatile("" ::: "memory");
        if (lane == 0) { AL[row] = alt; W2[row] = bf2f(scr[SEQ / 2]); }
#pragma unroll
        for (int j = 0; j < 4; ++j) { const int n0 = (j * 64 + lane) * 8; float e[8], o[8];
#pragma unroll
            for (int i = 0; i < 8; ++i) { const int n = n0 + i; const float a = bf2f(scr[n]), bb = bf2f(scr[(SEQ - n) & (SEQ - 1)]); e[i] = n == 0 ? a : a + bb; o[i] = n == 0 ? 0.f : a - bb; }
            u32x4 we, wo; we.x = cvt_pk_bf16(e[0], e[1]); we.y = cvt_pk_bf16(e[2], e[3]); we.z = cvt_pk_bf16(e[4], e[5]); we.w = cvt_pk_bf16(e[6], e[7]);
            wo.x = cvt_pk_bf16(o[0], o[1]); wo.y = cvt_pk_bf16(o[2], o[3]); wo.z = cvt_pk_bf16(o[4], o[5]); wo.w = cvt_pk_bf16(o[6], o[7]);
            *(GAS u32x4*)(ET + (size_t)row * 2048 + n0) = we; *(GAS u32x4*)(OT + (size_t)row * 2048 + n0) = wo; }
        LDS_WAIT(); asm volatile("" ::: "memory");
    }
}
__device__ __forceinline__ void ph_route(Frame& F, const Args& args, const float* mod) {
    const int lane = F.lane, wv = F.wave;
    LAS float* hrow = (LAS float*)F.lds;
    LAS float* part = (LAS float*)(F.lds + 65536);
    const float* X2 = (const float*)(F.ws + WS_X2); const float* nw = args.in[13]; const float* rw = args.in[14]; const float* rb = args.in[15];
    bf16_t* H2 = (bf16_t*)(F.ws + WS_H2); int* EIDX = (int*)(F.ws + WS_EIDX); float* EW = (float*)(F.ws + WS_EW); int* EPOS = (int*)(F.ws + WS_EPOS); int* CNT = (int*)(F.ws + CTL_CNT);
    LAS int* lcnt = (LAS int*)(F.lds + 65536 + 16384);
    LAS int* lbase = lcnt + 64;
    LAS int* lent = lcnt + 128;
    if (F.tid < NE) lcnt[F.tid] = 0;
    __syncthreads();
    int nb = 0;
    for (int blk = F.vcu; blk < NTOK / 8; blk += F.G, ++nb) {
        const int row = blk * 8 + wv;
        { const float* src = X2 + (size_t)row * DM; const float* mr = mod + (row / SEQ) * MODC;
          f32x4 v[8]; float ss = 0.f;
#pragma unroll
          for (int j = 0; j < 8; ++j) { v[j] = *(const GAS f32x4*)(src + (j * 64 + lane) * 4); ss += v[j].x * v[j].x + v[j].y * v[j].y + v[j].z * v[j].z + v[j].w * v[j].w; }
          ss = wave_sum(ss);
          const float rstd = 1.0f / sqrtf(ss * (1.0f / DM) + 1e-6f);
#pragma unroll
          for (int j = 0; j < 8; ++j) { const int i = (j * 64 + lane) * 4;
              const f32x4 w = *(const GAS f32x4*)(nw + i), sc = *(const GAS f32x4*)(mr + 4 * DM + i), sh = *(const GAS f32x4*)(mr + 3 * DM + i);
              const f32x4 h = v[j] * rstd * w * (sc + 1.0f) + sh;
              *(LAS f32x4*)(hrow + wv * DM + i) = h;
              unsigned lo = cvt_pk_bf16(h[0], h[1]), hi = cvt_pk_bf16(h[2], h[3]);
              *(GAS unsigned long long*)(H2 + (size_t)row * DM + i) = (unsigned long long)lo | ((unsigned long long)hi << 32); } }
        __syncthreads();
        { float a[8];
#pragma unroll
          for (int r = 0; r < 8; ++r) a[r] = 0.f;
          const int k0 = wv * 256;
#pragma unroll 16
          for (int k = 0; k < 256; ++k) { const float w = rw[(size_t)(k0 + k) * NE + lane];
#pragma unroll
              for (int r = 0; r < 8; ++r) a[r] += hrow[r * DM + k0 + k] * w; }
#pragma unroll
          for (int r = 0; r < 8; ++r) part[(wv * 8 + r) * 64 + lane] = a[r]; }
        __syncthreads();
        { float logit = 0.f;
#pragma unroll
          for (int w = 0; w < 8; ++w) logit += part[(w * 8 + wv) * 64 + lane];
          const float score = 1.0f / (1.0f + expf(-logit)), bsd = score + rb[lane];
          const int g = lane >> 3;
          int rk = 0;
#pragma unroll
          for (int i = 0; i < 8; ++i) { const int o = (lane & ~7) + i; const float vv = __shfl(bsd, o); rk += (vv > bsd) || (vv == bsd && o < lane); }
          float gs = rk < 2 ? bsd : 0.f;
          gs += __shfl_xor(gs, 1); gs += __shfl_xor(gs, 2); gs += __shfl_xor(gs, 4);
          int grk = 0;
#pragma unroll
          for (int gg = 0; gg < 8; ++gg) { const float vv = __shfl(gs, gg * 8); grk += (vv > gs) || (vv == gs && gg < g); }
          const bool gsel = grk < 4;
          const float mb = gsel ? bsd : -INFINITY;
          int erk = 0;
          for (int o = 0; o < 64; ++o) { const float vv = __shfl(mb, o); erk += (vv > mb) || (vv == mb && o < lane); }
          const bool sel = gsel && erk < TOPK;
          const float ssum = wave_sum(sel ? score : 0.f);
          if (sel) { const int lp = __hip_atomic_fetch_add(lcnt + lane, 1, __ATOMIC_RELAXED, __HIP_MEMORY_SCOPE_WORKGROUP);
                     EIDX[row * TOPK + erk] = lane; EW[row * TOPK + erk] = score / ssum * 2.5f; lent[(nb * 8 + wv) * TOPK + erk] = (lane << 16) | lp; } }
        __syncthreads();
    }
    if (F.tid < NE) { const int c = lcnt[F.tid]; lbase[F.tid] = c ? atomicAdd(&CNT[F.tid * 64], c) : 0; }
    __syncthreads();
    for (int i = F.tid; i < nb * 64; i += NTHREADS) { const int blk = F.vcu + (i >> 6) * F.G, row = blk * 8 + ((i >> 3) & 7), v = lent[i]; EPOS[row * TOPK + (i & 7)] = lbase[v >> 16] + (v & 0xffff); }
    __syncthreads();
}
__device__ __forceinline__ void ph_fill(Frame& F, const Args& args) {
    moe_tables(F, 4);
    LAS int* T = (LAS int*)(F.lds + SCHT_OFF);
    const int* EIDX = (const int*)(F.ws + WS_EIDX); const int* EPOS = (const int*)(F.ws + WS_EPOS); int* TOK = (int*)(F.ws + WS_TOK); int* SLOTOF = (int*)(F.ws + WS_SLOTOF);
    for (int i = F.vcu * NTHREADS + F.tid; i < NSLOT; i += F.G * NTHREADS) { const int slot = T[80 + EIDX[i]] + EPOS[i]; TOK[slot] = i / TOPK; SLOTOF[i] = slot; if (i < NTOK) TOK[NSLOT + i] = i; }
}
__device__ __forceinline__ void ph_comb(Frame& F, const Args& args, const float* mod) {
    const int gw = F.vcu * NWAVES + F.wave, NGW = F.G * NWAVES, lane = F.lane;
    const float* EW = (const float*)(F.ws + WS_EW); const int* SLOTOF = (const int*)(F.ws + WS_SLOTOF); const bf16_t* Y = (const bf16_t*)(F.ws + WS_YBIG);
    for (int t = gw; t < NTOK; t += NGW) {
        const float* g2 = mod + (t / SEQ) * MODC + 5 * DM;
        int sl[TOPK]; float wk[TOPK];
#pragma unroll
        for (int k = 0; k < TOPK; ++k) { sl[k] = SLOTOF[t * TOPK + k]; wk[k] = EW[t * TOPK + k]; }
#pragma unroll
        for (int j = 0; j < 4; ++j) { const int col = j * 512 + lane * 8;
            float a[8]; unpack8(*(const GAS u32x4*)(Y + (size_t)(NSLOT + t) * DM + col), a);
#pragma unroll
            for (int k = 0; k < TOPK; ++k) { float y[8]; unpack8(*(const GAS u32x4*)(Y + (size_t)sl[k] * DM + col), y);
#pragma unroll
                for (int c = 0; c < 8; ++c) a[c] += wk[k] * y[c]; }
            float* o = args.out + (size_t)t * DM + col; const float* xi = (const float*)(F.ws + WS_X2) + (size_t)t * DM + col;
#pragma unroll
            for (int n = 0; n < 2; ++n) { const f32x4 xv = *(const GAS f32x4*)(xi + 4 * n), gv = *(const GAS f32x4*)(g2 + col + 4 * n);
                *(GAS f32x4*)(o + 4 * n) = xv + gv * (f32x4){a[4 * n], a[4 * n + 1], a[4 * n + 2], a[4 * n + 3]}; } }
    }
}

enum { PH_PRO = 0, PH_NORM1, PH_INPROJ, PH_QKNORM, PH_ATTN, PH_F2, PH_MERGE, PH_OUT, PH_ROUTE, PH_FILL, PH_EXP1, PH_EXP2, PH_COMB, PH_END };


__global__ void __launch_bounds__(NTHREADS, 2) fwd(Args args) {
    extern __shared__ __attribute__((aligned(16))) unsigned char lds_raw[];
    Frame F;
    F.lds = (LAS unsigned char*)lds_raw; F.MISC = (volatile LAS unsigned*)(F.lds + MISC_OFF); F.ws = args.ws;
    F.tid = threadIdx.x; F.lane = F.tid & 63; F.wave = __builtin_amdgcn_readfirstlane(F.tid >> 6);
    F.G = gridDim.x; { const int bx = blockIdx.x; F.vcu = (F.G % 8 == 0) ? (bx % 8) * (F.G / 8) + bx / 8 : bx; }
    for (int u = F.tid; u < (LDS_BYTES - LDSCTL_OFF) / 4; u += NTHREADS) ((LAS unsigned*)(F.lds + LDSCTL_OFF))[u] = 0u;
    __syncthreads();
    const int lo = args.ph_lo, hi = args.ph_hi;
    const bool multi = (hi - lo) > 1;
    unsigned* barw = (unsigned*)(args.ws + CTL_BAR) + args.bar_idx * XCD_BAR_WORDS;
    XcdBarrier bar; bar.bar = barw; bar.x = 0; bar.st = nullptr;
    if (multi) bar = xcd_barrier_post(barw, F.MISC + 8);
#define IN(k) (lo <= (k) && (k) < hi)
#define SEAM(k) do { if (IN((k) + 1)) xcd_barrier(bar); } while (0)

    const float* modp = (const float*)(args.ws + args.mod_off);
    if (IN(PH_PRO)) { p0_prologue(F, args); SEAM(PH_PRO); }
    if (IN(PH_NORM1)) { ph_norm1(F, args, modp); SEAM(PH_NORM1); }
    if (IN(PH_INPROJ)) {
        SchedIn S{F.G, (int)blockIdx.x, args.ws, args.use_ut};
        const int nu = (904 - (int)blockIdx.x + F.G - 1) / F.G, s0 = F.vcu % 5, s = s0 < nu ? s0 : nu;
        gemm_phase<EpiStore, SchedIn, false>(F.lds, DM, DM, DM, S, EpiStore{(const float*)(args.ws + WS_W2048)}, 0, s);
        __syncthreads();
        { const int per = (IT_EG + IT_EU + F.G - 1) / F.G; const int first = F.vcu * per; const int cnt = first + per <= IT_EG + IT_EU ? per : (IT_EG + IT_EU - first > 0 ? IT_EG + IT_EU - first : 0);
          conv_items(F, args, false, first, cnt); }
        __syncthreads();
        gemm_phase<EpiStore, SchedIn, false>(F.lds, DM, DM, DM, S, EpiStore{(const float*)(args.ws + WS_W2048)}, s);
        SEAM(PH_INPROJ);
    }
    if (IN(PH_QKNORM)) { ph_qknorm(F, args); ph_evenodd(F, args); SEAM(PH_QKNORM); }
    if (IN(PH_ATTN)) {
        const int cs = F.vcu & 3;
        const int cper = (IT_ED + F.G - 1) / F.G, cfirst = F.vcu * cper, ccnt = cfirst + cper <= IT_ED ? cper : (IT_ED - cfirst > 0 ? IT_ED - cfirst : 0);
        const bf16_t* Qp = (const bf16_t*)(args.ws + WS_Q); const bf16_t* Kp = (const bf16_t*)(args.ws + WS_KALL); const bf16_t* Vp = (const bf16_t*)(args.ws + WS_VALL); bf16_t* Op = (bf16_t*)(args.ws + WS_YA);
#define ATTN_UNIT(lin_) do { const int lin = (lin_); if (lin < 512) { const int x = (lin >> 5) & 7, j = (lin & 31) + 32 * (lin >> 8), b = x >> 2, kvh = x & 3, head = kvh * 4 + (j >> 4), qb = j & 15; \
            const size_t qo = ((size_t)(b * SEQ + qb * 256)) * DM + head * HD, ko = (size_t)b * SKV * KVW + kvh * HD; \
            attn::attn_dense_body(Qp + qo, Kp + ko, Vp + ko, Op + qo, SKV, (char*)lds_raw); __syncthreads(); } } while (0)
        if (cs == 0) { conv_items(F, args, true, cfirst, ccnt); __syncthreads(); }
        ATTN_UNIT(F.vcu);
        if (cs == 1) { conv_items(F, args, true, cfirst, ccnt); __syncthreads(); }
        ATTN_UNIT(F.vcu + F.G);
        for (int lin2 = F.vcu + 2 * F.G; lin2 < 512; lin2 += F.G) ATTN_UNIT(lin2);
        if (cs == 2) { conv_items(F, args, true, cfirst, ccnt); __syncthreads(); }
#undef ATTN_UNIT
        SchedAG S{F.G, (int)blockIdx.x, args.ws};
        gemm_phase<EpiStore, SchedAG, false>(F.lds, DM, DM, DM, S, EpiStore{(const float*)(args.ws + WS_W2048)});
        if (cs == 3) { __syncthreads(); conv_items(F, args, true, cfirst, ccnt); }
        SEAM(PH_ATTN);
    }
    if (IN(PH_F2)) {
        SchedF2 S{F.G, (int)blockIdx.x, args.ws};
        gemm_phase<EpiStore, SchedF2, false>(F.lds, 512, DM, 512, S, EpiStore{(const float*)(args.ws + WS_W2048)});
        {
            const int idx = F.vcu * NTHREADS + F.tid;
            if (idx < 2 * FW) { const int b = idx >> 10, col = idx & 1023, k2 = col & 127; const float* al = (const float*)(args.ws + WS_ALT) + b * FW + (col & ~127); float s = 0.f;
                for (int c = 0; c < 128; ++c) s += al[c] * cospif((float)((c * k2) & 127) * (1.0f / 64.0f));
                ((bf16_t*)(args.ws + WS_YF))[((size_t)b * SEQ + SEQ / 2) * FW + col] = f2bf(s * 0.0013810679320049757f); }
        }
        SEAM(PH_F2);
    }
    if (IN(PH_MERGE)) {
        unsigned char* ws = args.ws;
        { SchedGrid S{F.G, (int)blockIdx.x, 32, 8, (const char*)(ws + WS_YF), (const char*)(ws + WS_WT_FO), nullptr, (size_t)256 * FW * 2, (size_t)256 * FW * 2, DM, 4, 1};
          gemm_phase<EpiT1, SchedGrid, false>(F.lds, FW, FW, FW, S, EpiT1{(const bf16_t*)(ws + WS_SGF), (float*)(ws + WS_T1)}); }
        { SchedGrid S{F.G, (int)blockIdx.x, 32, 8, (const char*)(ws + WS_YA), (const char*)(ws + WS_WT_AO), nullptr, (size_t)256 * DM * 2, (size_t)256 * DM * 2, DM, 2, 0};
          gemm_phase<EpiYM, SchedGrid, false>(F.lds, DM, DM, DM, S, EpiYM{(const bf16_t*)(ws + WS_SGA), (const float*)(ws + WS_T1), (bf16_t*)(ws + WS_YM)}); }
        SEAM(PH_MERGE);
    }
    if (IN(PH_OUT)) {
        unsigned char* ws = args.ws;
        SchedGrid S{F.G, (int)blockIdx.x, 32, 8, (const char*)(ws + WS_YM), (const char*)(ws + WS_WT_O), nullptr, (size_t)256 * DM * 2, (size_t)256 * DM * 2, DM, 4, 1};
        gemm_phase<EpiX2, SchedGrid, false>(F.lds, DM, DM, DM, S, EpiX2{args.in[0], modp, (float*)(ws + WS_X2)});
        SEAM(PH_OUT);
    }
    if (IN(PH_ROUTE)) { ph_route(F, args, modp); SEAM(PH_ROUTE); }
    if (IN(PH_FILL)) { ph_fill(F, args); SEAM(PH_FILL); }
    if (IN(PH_EXP1)) {
        moe_tables(F, 4);
        SchedMoe<4, true> S{F.G, F.vcu, args.ws, (LAS int*)(F.lds + SCHT_OFF), (const int*)(args.ws + WS_TOK)};
        gemm_phase<EpiAct, SchedMoe<4, true>, true>(F.lds, DM, DM, DM, S, EpiAct{});
        SEAM(PH_EXP1);
    }
    if (IN(PH_EXP2)) {
        moe_tables(F, 8);
        SchedMoe<8, false> S{F.G, F.vcu, args.ws, (LAS int*)(F.lds + SCHT_OFF), (const int*)(args.ws + WS_TOK)};
        gemm_phase<EpiStore, SchedMoe<8, false>, false>(F.lds, EFF, EFF, EFF, S, EpiStore{(const float*)(args.ws + WS_W2048)});
        SEAM(PH_EXP2);
    }
    if (IN(PH_COMB)) { ph_comb(F, args, modp); }
#undef IN
#undef SEAM
}
}

extern "C" void kernel_launch(void* const* d_in, const int* in_sizes, int n_in, void* d_out, int out_size, void* d_ws, size_t ws_size, hipStream_t stream) {
    if (n_in != 22 || ws_size < WS_END2) return;
    float* out = (float*)d_out;
    unsigned char* ws = (unsigned char*)d_ws;
    hipMemsetAsync(ws + WS_CTL, 0, CTL_ZERO_BYTES, stream);
    static int grid = 0;
    if (!grid) {
        int dev = 0, cus = 0;
        if (hipGetDevice(&dev) != hipSuccess || hipDeviceGetAttribute(&cus, hipDeviceAttributeMultiprocessorCount, dev) != hipSuccess) { grid = -1; return; }
        if (hipFuncSetAttribute((const void*)mk::fwd, hipFuncAttributeMaxDynamicSharedMemorySize, mk::LDS_BYTES) != hipSuccess) { grid = -1; return; }
        grid = cus;
    }
    if (grid < 0) return;
    mk::Args a{}; int nlaunch = 0;
    for (int i = 0; i < 22; ++i) a.in[i] = (const float*)d_in[i];
    a.out = out; a.ws = ws; a.use_ut = 1; a.mod_off = (int)WS_MOD; a.do_attn = 1;
#define MK_LAUNCH(lo_, hi_) do { a.ph_lo = (lo_); a.ph_hi = (hi_); a.bar_idx = nlaunch++; hipLaunchKernelGGL(mk::fwd, dim3(grid), dim3(mk::NTHREADS), mk::LDS_BYTES, stream, a); } while (0)
    MK_LAUNCH(mk::PH_PRO, mk::PH_END);
}
```

```cpp
#include <hip/hip_runtime.h>
#include <stdint.h>
#include <math.h>

typedef unsigned short bf16_t;
typedef short bf16x8 __attribute__((ext_vector_type(8)));
typedef float f32x16 __attribute__((ext_vector_type(16)));
typedef float f32x4 __attribute__((ext_vector_type(4)));

constexpr int NB = 2, SEQ = 4096, DM = 2048, NTOK = NB * SEQ, CTXL = 256, NCTX = NB * CTXL, HD = 128, NH = 16, NKV = 4;
constexpr int SKV = SEQ + CTXL;
constexpr int FW = 1024, INC = 8192, Q_OFF = 1024, K_OFF = 3072, V_OFF = 3584, GF_OFF = 4096, GA_OFF = 6144;
constexpr int KVW = NKV * HD;
constexpr int NE = 64, TOPK = 8, EFF = 512, MODC = 6 * DM;
constexpr int NSLOT = NTOK * TOPK;
constexpr int NSLOT_ALL = NSLOT + NTOK;

constexpr size_t MiB = 1u << 20;
constexpr size_t WS_CTL = 0, CTL_ZERO_BYTES = 1 * MiB;
constexpr size_t CTL_CNT = 64 * 1024;
constexpr size_t WS_TW = 1 * MiB;
constexpr size_t WS_MOD = 1 * MiB + 64 * 1024;
constexpr size_t WS_OFFS = 1 * MiB + 256 * 1024;
constexpr size_t WS_EIDX = 2 * MiB;
constexpr size_t WS_EW = WS_EIDX + 256 * 1024;
constexpr size_t WS_EPOS = WS_EW + 256 * 1024;
constexpr size_t WS_SLOTOF = WS_EPOS + 256 * 1024;
constexpr size_t WS_TOK = 3 * MiB;
constexpr size_t WS_H = 4 * MiB;
constexpr size_t WS_U = 38 * MiB;
constexpr size_t WS_Q = 54 * MiB;
constexpr size_t WS_KALL = 86 * MiB;
constexpr size_t WS_VALL = 95 * MiB;
constexpr size_t WS_SGF = 104 * MiB;
constexpr size_t WS_SGA = 136 * MiB;
constexpr size_t WS_YA = 168 * MiB;
constexpr size_t WS_YF = 200 * MiB;
constexpr size_t WS_PR = 216 * MiB;
constexpr size_t WS_T1 = 248 * MiB;
constexpr size_t WS_YM = 312 * MiB;
constexpr size_t WS_QKRAW = 248 * MiB;
constexpr size_t WS_KCRAW = 330 * MiB;
constexpr size_t WS_H2 = 344 * MiB;
constexpr size_t WS_ACT = 376 * MiB;
constexpr size_t WS_YBIG = 4 * MiB;
constexpr size_t WS_END = 740 * MiB;

__device__ __forceinline__ float bf2f(bf16_t h) { return __uint_as_float(((unsigned)h) << 16); }
__device__ __forceinline__ bf16_t f2bf(float f) { unsigned u = __float_as_uint(f); return (bf16_t)((u + 0x7fffu + ((u >> 16) & 1u)) >> 16); }
__device__ __forceinline__ int crow(int r, int hi) { return (r & 3) + 8 * (r >> 2) + 4 * hi; }
__device__ __forceinline__ float wave_sum(float v) {
#pragma unroll
    for (int o = 1; o < 64; o <<= 1) v += __shfl_xor(v, o);
    return v;
}
__device__ __forceinline__ float sigmoidf_(float v) { return 1.0f / (1.0f + expf(-v)); }
__device__ __forceinline__ bf16x8 pack8(const float* f) {
    bf16x8 r;
#pragma unroll
    for (int i = 0; i < 8; ++i) r[i] = (short)f2bf(f[i]);
    return r;
}

#define LAS __attribute__((address_space(3)))
#define GAS __attribute__((address_space(1)))
typedef unsigned u32x4 __attribute__((ext_vector_type(4)));
typedef GAS unsigned gu32;
#define RLX_AGENT __ATOMIC_RELAXED, __HIP_MEMORY_SCOPE_AGENT
#define LDS_WAIT() asm volatile("s_waitcnt lgkmcnt(0)" ::: "memory")
#define VM_WAIT() asm volatile("s_waitcnt vmcnt(0)" ::: "memory")

constexpr size_t CTL_BAR = 16384;
constexpr size_t CTL_MODZ = 512 * 1024;
constexpr size_t WS_UT = 38 * MiB;
constexpr size_t WS_TT = 216 * MiB;
constexpr size_t WS_WT_GU = 450 * MiB;
constexpr size_t WS_WT_D = 710 * MiB;
constexpr size_t WS_WT_IN = 840 * MiB;
constexpr size_t WS_WT_FO = 872 * MiB;
constexpr size_t WS_WT_AO = 876 * MiB;
constexpr size_t WS_WT_O = 884 * MiB;
constexpr size_t WS_CST = 892 * MiB;
constexpr size_t WS_ET = 908 * MiB;
constexpr size_t WS_OT = 916 * MiB;
constexpr size_t WS_W2048 = 1 * MiB + 512 * 1024;
constexpr size_t WS_ALT = 1 * MiB + 520 * 1024;
constexpr size_t WS_BD2 = 956 * MiB;
constexpr size_t WS_X2 = 960 * MiB;
constexpr size_t WS_END2 = 1024 * MiB;

namespace mk {
constexpr int NWAVES = 8, NTHREADS = 512;
constexpr int RING_BYTES = 131072, SCR_BYTES = 8 * 16640, LDSCTL_OFF = 135168, MISC_OFF = LDSCTL_OFF + 320, GPARK_OFF = LDSCTL_OFF + 2048  , LDS_BYTES = 147456;
static_assert(GPARK_OFF + 8192 <= LDS_BYTES, "LDS map");
static_assert(SCR_BYTES <= LDSCTL_OFF && MISC_OFF + 128 <= LDS_BYTES, "LDS map");

#define XB_TMO      128
#define XB_XCNT(j)  (256  + 64 * (j))
#define XB_XSUB(j)  (1280 + 64 * (j))
#define XB_XGEN(j)  (2304 + 64 * (j))
#define XB_TOP      3328
#define XB_TOPGEN   3392
#define XCD_BAR_WORDS 3456
#define XB_SPIN_CAP (1u << 18)
__device__ __forceinline__ unsigned xb_ld(unsigned* p)              { return __hip_atomic_load(p, __ATOMIC_RELAXED, __HIP_MEMORY_SCOPE_AGENT); }
__device__ __forceinline__ unsigned xb_add(unsigned* p, unsigned v) { return __hip_atomic_fetch_add(p, v, __ATOMIC_RELAXED, __HIP_MEMORY_SCOPE_AGENT); }
__device__ __forceinline__ unsigned xb_xcc_id() { return (unsigned)__builtin_amdgcn_s_getreg((3 << 11) | 20) & 0xFu; }
#define XB_SPIN(cond, bar) do { unsigned _sp = 0; while (cond) { __builtin_amdgcn_s_sleep(1); \
    if ((++_sp & 255u) == 0u) { if (xb_ld(&(bar)[XB_TMO])) break; if (_sp > XB_SPIN_CAP) { atomicAdd(&(bar)[XB_TMO], 1u); break; } } } } while (0)
struct XcdBarrier { unsigned* bar; unsigned x; volatile LAS unsigned* st; };
__device__ __forceinline__ XcdBarrier xcd_barrier_post(unsigned* bar, volatile LAS unsigned* st) {
    XcdBarrier b; b.bar = bar; b.x = xb_xcc_id(); b.st = st;
    if (threadIdx.x == 0) (void)xb_add(&bar[XB_XCNT(b.x)], 1u);
    return b;
}
__device__ __forceinline__ void xcd_barrier_complete(unsigned* bar, unsigned x, unsigned& nloc, unsigned& nx) {
    const unsigned G = gridDim.x * gridDim.y * gridDim.z;
    unsigned sum, cnt, mine, sp = 0u;
    for (;;) {
        sum = 0u; cnt = 0u; mine = 0u;
#pragma unroll
        for (unsigned j = 0; j < 16; ++j) { const unsigned c = xb_ld(&bar[XB_XCNT(j)]); sum += c; cnt += (c > 0u) ? 1u : 0u; mine = (j == x) ? c : mine; }
        if (sum == G) break;
        __builtin_amdgcn_s_sleep(1);
        if ((++sp & 255u) == 0u) { if (xb_ld(&bar[XB_TMO])) break; if (sp > XB_SPIN_CAP) { atomicAdd(&bar[XB_TMO], 1u); break; } }
    }
    nloc = mine > 0u ? mine : 1u; nx = cnt > 0u ? cnt : 1u;
}
__device__ __forceinline__ void xcd_barrier(const XcdBarrier& b) {
    asm volatile("s_waitcnt vmcnt(0)" ::: "memory");
    __syncthreads();
    if (threadIdx.x == 0) {
        unsigned* bar = b.bar;
        __builtin_amdgcn_s_waitcnt(0);
        unsigned nloc = b.st[0], nx = b.st[1];
        if (nloc == 0u) { xcd_barrier_complete(bar, b.x, nloc, nx); b.st[0] = nloc; b.st[1] = nx; }
        const unsigned old = xb_add(&bar[XB_XSUB(b.x)], 1u);
        const unsigned gen = old / nloc;
        if (old + 1u == (gen + 1u) * nloc) {
            __builtin_amdgcn_fence(__ATOMIC_RELEASE, "agent");
            asm volatile("s_waitcnt vmcnt(0)" ::: "memory");
            const unsigned og = xb_add(&bar[XB_TOP], 1u);
            const unsigned tg = og / nx;
            if (og + 1u == (tg + 1u) * nx) xb_add(&bar[XB_TOPGEN], 1u);
            else XB_SPIN(xb_ld(&bar[XB_TOPGEN]) == tg, bar);
            __builtin_amdgcn_fence(__ATOMIC_ACQUIRE, "agent");
            xb_add(&bar[XB_XGEN(b.x)], 1u);
            asm volatile("s_waitcnt vmcnt(0)" ::: "memory");
        } else {
            XB_SPIN(xb_ld(&bar[XB_XGEN(b.x)]) == gen, bar);
            __builtin_amdgcn_fence(__ATOMIC_ACQUIRE, "agent");
            asm volatile("s_waitcnt vmcnt(0)" ::: "memory");
        }
    }
    __syncthreads();
}

constexpr int BM = 256, BK = 64, HALF = 128, HTB = HALF * BK * 2, STAGE_BYTES = 8 * HTB;
__device__ __forceinline__ int lds_byte(int r, int c) { const int st = (r >> 4) * 2 + (c >> 5), rr = r & 15, cc = c & 31, ob = rr * 64 + cc * 2; return st * 1024 + (ob ^ (((ob >> 9) & 1) << 5)); }
__device__ __forceinline__ void stage_rc(int b, int& R, int& C) { const int st = b / 1024, sb = b % 1024, swz = sb ^ (((sb >> 9) & 1) << 5); R = (st >> 1) * 16 + swz / 64; C = (st & 1) * 32 + (swz % 64) / 2; }
__device__ __forceinline__ int perm32(int rho) { const int n = rho >> 4, i = rho & 15; return 8 * (i >> 2) + 4 * n + (i & 3); }
__device__ __forceinline__ unsigned cvt_pk_bf16(float lo, float hi) { unsigned r; asm("v_cvt_pk_bf16_f32 %0, %1, %2" : "=v"(r) : "v"(lo), "v"(hi)); return r; }

__device__ __forceinline__ void glds16_s(const void* sbase, unsigned voff, unsigned lds_dst) { unsigned keep;
    asm volatile("s_mov_b32 %0, m0\n\ts_mov_b32 m0, %3\n\ts_nop 0\n\tglobal_load_lds_dwordx4 %1, %2\n\ts_mov_b32 m0, %0" : "=&s"(keep) : "v"(voff), "s"(sbase), "s"(lds_dst) : "memory"); }

struct Unit { const char* A; const char* B; char* C; int ldc; int mode; int rows; int aux; int pm, pn, bjs, rmin; };

template <class Epi, class Sched, bool GATHER>
__device__ __forceinline__ void gemm_phase(LAS unsigned char* lds, const int K, const int lda, const int ldb, const Sched& S, const Epi& E, const int i0 = 0, const int i1 = 0x7fffffff) {
    const int tid = threadIdx.x, wid = __builtin_amdgcn_readfirstlane(tid >> 6), lane = tid & 63, wr = wid >> 2, wc = wid & 3, fr = lane & 15, fq = lane >> 4;
    const int nt = K / BK;
    unsigned voffA[2], voffB[2];
#pragma unroll
    for (int i = 0; i < 2; ++i) { int R, C; stage_rc(tid * 16 + i * 8192, R, C); const int Rb = (R & ~31) + perm32(R & 31);
        voffA[i] = (unsigned)(R * lda + C) * 2u; voffB[i] = (unsigned)(Rb * ldb + C) * 2u; }
    const size_t kstep = (size_t)(BK * 2);
    const size_t hstepA = (size_t)HALF * lda * 2, hstepB = (size_t)HALF * ldb * 2;
    const unsigned ldsw = (unsigned)wid * 1024u;
    const unsigned ldsbase = (unsigned)__builtin_amdgcn_readfirstlane((int)(unsigned)(uintptr_t)lds);
    const int aoff = lds_byte(wr * 64 + fr, fq * 8), boff = lds_byte(wc * 32 + fr, fq * 8);
#define MK_SA(b, h) (((b) * 2 + (h)) * HTB)
#define MK_SB(b, h) ((4 + (b) * 2 + (h)) * HTB)
#define MK_STAGE2(bufoff, gbase, v0, v1) do { \
        __builtin_amdgcn_global_load_lds((const unsigned*)((const char*)(gbase) + (v0)), (LAS unsigned*)(lds + (bufoff) + ldsw), 16, 0, 0); \
        __builtin_amdgcn_global_load_lds((const unsigned*)((const char*)(gbase) + (v1)), (LAS unsigned*)(lds + (bufoff) + ldsw + 8192), 16, 0, 0); } while (0)
#define MK_STAGE_B(bufoff, gbase) do { glds16_s((gbase), voffB[0], ldsbase + (bufoff) + ldsw); glds16_s((gbase), voffB[1], ldsbase + (bufoff) + ldsw + 8192u); } while (0)
#define MK_STAGE_A(bufoff, gbase, h, VA) do { if constexpr (GATHER) { glds16_s((gbase), (VA)[h][0], ldsbase + (bufoff) + ldsw); glds16_s((gbase), (VA)[h][1], ldsbase + (bufoff) + ldsw + 8192u); } \
        else { glds16_s((gbase) + (h) * hstepA, voffA[0], ldsbase + (bufoff) + ldsw); glds16_s((gbase) + (h) * hstepA, voffA[1], ldsbase + (bufoff) + ldsw + 8192u); } } while (0)
#define MK_LDA(dst, b, h) do { _Pragma("unroll") for (int m = 0; m < 4; ++m) _Pragma("unroll") for (int k = 0; k < 2; ++k) dst[m][k] = *(const LAS bf16x8*)(lds + MK_SA(b, h) + aoff + m * 2048 + k * 1024); } while (0)
#define MK_LDB(dst, b, h) do { _Pragma("unroll") for (int n = 0; n < 2; ++n) _Pragma("unroll") for (int k = 0; k < 2; ++k) dst[n][k] = *(const LAS bf16x8*)(lds + MK_SB(b, h) + boff + n * 2048 + k * 1024); } while (0)
#define MK_MMA(ai, bj, At, Bt) do { __builtin_amdgcn_s_setprio(1); _Pragma("unroll") for (int m = 0; m < 4; ++m) _Pragma("unroll") for (int n = 0; n < 2; ++n) _Pragma("unroll") for (int k = 0; k < 2; ++k) \
        acc[ai][bj][m][n] = __builtin_amdgcn_mfma_f32_16x16x32_bf16(Bt[n][k], At[m][k], acc[ai][bj][m][n], 0, 0, 0); __builtin_amdgcn_s_setprio(0); } while (0)
#define MK_WAIT_V(n) asm volatile("s_waitcnt vmcnt(" #n ")" ::: "memory")
#define MK_WAIT_L(n) asm volatile("s_waitcnt lgkmcnt(" #n ")" ::: "memory")
#define MK_BAR __builtin_amdgcn_s_barrier()
#define MK_SCHED __builtin_amdgcn_sched_barrier(0)
    Unit cur, nxt; int ui = i0;
    if (i0 >= i1 || !S.next(i0, cur)) return;
    f32x4 acc[2][2][4][2];
#pragma unroll
    for (int a = 0; a < 2; ++a)
#pragma unroll
        for (int b = 0; b < 2; ++b)
#pragma unroll
            for (int m = 0; m < 4; ++m)
#pragma unroll
                for (int n = 0; n < 2; ++n) acc[a][b][m][n] = (f32x4){0.f, 0.f, 0.f, 0.f};
    bf16x8 At[4][2], B0[2][2], B1[2][2];
    unsigned vC[2][2];
    LAS u32x4* vpark = (LAS u32x4*)(lds + GPARK_OFF) + tid;
    if constexpr (GATHER) {
#pragma unroll
        for (int h = 0; h < 2; ++h)
#pragma unroll
            for (int i = 0; i < 2; ++i) { int R, C; stage_rc(tid * 16 + i * 8192, R, C); vC[h][i] = S.arow(cur, h * HALF + R) + (unsigned)(C * 2); }
    }
    const char* cA = cur.A; const char* cB = cur.B;
    MK_STAGE_B(MK_SB(0, 0), cB); MK_STAGE_B(MK_SB(0, 1), cB + hstepB); MK_STAGE_A(MK_SA(0, 0), cA, 0, vC); MK_STAGE_A(MK_SA(0, 1), cA, 1, vC);
    if (wr == 1) MK_BAR;
    MK_WAIT_V(2); MK_BAR;
    MK_STAGE_B(MK_SB(1, 0), cB + kstep); MK_STAGE_A(MK_SA(1, 0), cA + kstep, 0, vC); MK_STAGE_B(MK_SB(1, 1), cB + hstepB + kstep);
    MK_WAIT_V(6); MK_BAR;
    for (;;) {
        const bool has_next = (ui + 1 < i1) && S.next(ui + 1, nxt);
        const char* nA = has_next ? nxt.A : cA; const char* nB = has_next ? nxt.B : cB;
        if constexpr (GATHER) {
            u32x4 pv;
#pragma unroll
            for (int h = 0; h < 2; ++h)
#pragma unroll
                for (int i = 0; i < 2; ++i) { int R, C; stage_rc(tid * 16 + i * 8192, R, C); pv[h * 2 + i] = has_next ? (S.arow(nxt, h * HALF + R) + (unsigned)(C * 2)) : vC[h][i]; }
            *vpark = pv;
        }
        for (int t = 0; t < nt; t += 2) {
            const bool last = (t == nt - 2);
            const char* a1 = cA + (size_t)(t + 1) * kstep;
            const char* a2 = last ? nA : cA + (size_t)(t + 2) * kstep; const char* b2 = last ? nB : cB + (size_t)(t + 2) * kstep;
            const char* a3 = a2 + kstep; const char* b3 = b2 + kstep;
            MK_LDB(B0, 0, 0); MK_LDB(B1, 0, 1); MK_SCHED; MK_LDA(At, 0, 0); MK_STAGE_A(MK_SA(1, 1), a1, 1, vC);
            if constexpr (GATHER) { if (last) { const u32x4 pv = *vpark; vC[0][0] = pv[0]; vC[0][1] = pv[1]; vC[1][0] = pv[2]; vC[1][1] = pv[3]; } }
            MK_WAIT_V(8); MK_WAIT_L(0); MK_BAR; MK_MMA(0, 0, At, B0); MK_MMA(0, 1, At, B1); MK_BAR; MK_SCHED;
            MK_LDA(At, 0, 1); MK_STAGE_B(MK_SB(0, 0), b2); MK_STAGE_B(MK_SB(0, 1), b2 + hstepB); MK_STAGE_A(MK_SA(0, 0), a2, 0, vC);
            MK_WAIT_V(8); MK_WAIT_L(0); MK_BAR; MK_MMA(1, 0, At, B0); MK_MMA(1, 1, At, B1); MK_BAR; MK_SCHED;
            MK_LDB(B0, 1, 0); MK_LDB(B1, 1, 1); MK_SCHED; MK_LDA(At, 1, 0); MK_STAGE_A(MK_SA(0, 1), a2, 1, vC);
            MK_WAIT_V(8); MK_WAIT_L(0); MK_BAR; MK_MMA(0, 0, At, B0); MK_MMA(0, 1, At, B1); MK_BAR; MK_SCHED;
            MK_LDA(At, 1, 1); MK_STAGE_B(MK_SB(1, 0), b3); MK_STAGE_B(MK_SB(1, 1), b3 + hstepB); MK_STAGE_A(MK_SA(1, 0), a3, 0, vC);
            MK_WAIT_V(8); MK_WAIT_L(0); MK_BAR; MK_MMA(1, 0, At, B0); MK_MMA(1, 1, At, B1); MK_BAR; MK_SCHED;
        }
        if (wr == 0) MK_BAR;
        E(acc, cur, wr, wc, fr, fq);
        if (!has_next) break;
#pragma unroll
        for (int a = 0; a < 2; ++a)
#pragma unroll
            for (int b = 0; b < 2; ++b)
#pragma unroll
                for (int m = 0; m < 4; ++m)
#pragma unroll
                    for (int n = 0; n < 2; ++n) acc[a][b][m][n] = (f32x4){0.f, 0.f, 0.f, 0.f};
        cur = nxt; cA = nA; cB = nB; ++ui;
        if (wr == 1) MK_BAR;
    }
    MK_WAIT_V(0);
    MK_BAR;
#undef MK_SA
#undef MK_SB
#undef MK_STAGE2
#undef MK_STAGE_B
#undef MK_STAGE_A
#undef MK_LDA
#undef MK_LDB
#undef MK_MMA
#undef MK_WAIT_V
#undef MK_WAIT_L
#undef MK_BAR
#undef MK_SCHED
}

__device__ __forceinline__ void grid_map(int L, int nM, int nN, int& pm, int& pn) {
    const int nwg = nM * nN, q = nwg / 8, xcd = L % 8, off = L / 8; const int wgid = xcd * q + off;
    const int nig = 8 * nN, gid = wgid / nig, fm = gid * 8, gsz = (nM - fm) < 8 ? (nM - fm) : 8;
    pm = fm + ((wgid % nig) % gsz); pn = (wgid % nig) / gsz;
}

struct EpiStore {
    const float* w2048;
    __device__ __forceinline__ void operator()(const f32x4 (&acc)[2][2][4][2], const Unit& u, int wr, int wc, int fr, int fq) const {
        const int col0 = wc * 32 + 8 * fq;
#pragma unroll
        for (int ai = 0; ai < 2; ++ai)
#pragma unroll
            for (int m = 0; m < 4; ++m) {
                const int r = ai * HALF + wr * 64 + m * 16 + fr;
                if (r < u.rows && r >= u.rmin) {
#pragma unroll
                    for (int bj = 0; bj < 2; ++bj) {
                        f32x4 v0 = acc[ai][bj][m][0], v1 = acc[ai][bj][m][1];
                        if (u.mode == 1) { float* p = (float*)u.C + (long)r * u.ldc + col0 + bj * u.bjs; *(f32x4*)p = v0; *(f32x4*)(p + 4) = v1; }
                        else {
                            if (u.mode == 2) {
#pragma unroll
                                for (int c = 0; c < 4; ++c) { v0[c] = __builtin_amdgcn_rcpf(1.0f + __expf(-v0[c])); v1[c] = __builtin_amdgcn_rcpf(1.0f + __expf(-v1[c])); }
                            } else if (u.mode == 3) {
                                const float* wp = w2048 + u.pn + bj * HALF + col0; const float sg = (r & 1) ? -1.0f : 1.0f;
                                v0 += *(const f32x4*)wp * sg; v1 += *(const f32x4*)(wp + 4) * sg;
                            }
                            u32x4 w; w.x = cvt_pk_bf16(v0[0], v0[1]); w.y = cvt_pk_bf16(v0[2], v0[3]); w.z = cvt_pk_bf16(v1[0], v1[1]); w.w = cvt_pk_bf16(v1[2], v1[3]);
                            *(u32x4*)((bf16_t*)u.C + (long)r * u.ldc + col0 + bj * u.bjs) = w;
                        }
                    }
                }
            }
    }
};

struct Args { const float* in[22]; float* out; unsigned char* ws; int ph_lo, ph_hi, use_ut, mod_off, do_attn, bar_idx; };
struct Frame {
    LAS unsigned char* lds; volatile LAS unsigned* MISC; unsigned char* ws;
    int tid, lane, wave, vcu, G;
};

__device__ __forceinline__ void t64_load(f32x4 (&v)[16], const float* W, int ldw, int lane) {
    const int kk = lane >> 4, nc = (lane & 15) * 4;
#pragma unroll
    for (int j = 0; j < 16; ++j) v[j] = __builtin_nontemporal_load((const GAS f32x4*)(W + (size_t)(j * 4 + kk) * ldw + nc));
}
__device__ __forceinline__ void t64_store(const f32x4 (&v)[16], bf16_t* dst, int ldd, LAS float* scr, int lane) {
    const int kk = lane >> 4, nc = (lane & 15) * 4;
#pragma unroll
    for (int j = 0; j < 16; ++j) {
#pragma unroll
        for (int c = 0; c < 4; ++c) scr[(j * 4 + kk) * 65 + nc + c] = v[j][c]; }
    LDS_WAIT(); asm volatile("" ::: "memory");
    const int kc = lane & 7;
#pragma unroll
    for (int jj = 0; jj < 8; jj += 2) {
        float t[2][8];
#pragma unroll
        for (int q = 0; q < 2; ++q) { const int n = (lane >> 3) + 8 * (jj + q); const LAS float* s = scr + (8 * kc) * 65 + n;
#pragma unroll
            for (int i = 0; i < 8; ++i) t[q][i] = s[i * 65]; }
#pragma unroll
        for (int q = 0; q < 2; ++q) { const int n = (lane >> 3) + 8 * (jj + q);
            u32x4 o; o.x = cvt_pk_bf16(t[q][0], t[q][1]); o.y = cvt_pk_bf16(t[q][2], t[q][3]); o.z = cvt_pk_bf16(t[q][4], t[q][5]); o.w = cvt_pk_bf16(t[q][6], t[q][7]);
            __builtin_nontemporal_store(o, (GAS u32x4*)(dst + (size_t)n * ldd + 8 * kc)); } }
    LDS_WAIT(); asm volatile("" ::: "memory");
}
__device__ __forceinline__ void transpose64(const float* W, int ldw, bf16_t* dst, int ldd, LAS float* scr, int lane) {
    f32x4 v[16]; t64_load(v, W, ldw, lane); t64_store(v, dst, ldd, scr, lane);
}

constexpr int IT_IN = 32 * 128, IT_FO = 16 * 32, IT_AO = 32 * 32, IT_O = 32 * 32, IT_EG = 64 * 256, IT_EU = 64 * 256, IT_ED = 64 * 256, IT_SH = 256;
constexpr int IT_T_END = IT_IN + IT_FO + IT_AO + IT_O + 3 * IT_SH;
constexpr int IT_MOD = MODC / 32, IT_CST = 4096, IT_BD2 = 512;
constexpr int IT_ALL = IT_T_END + IT_MOD + IT_CST + IT_BD2;

__device__ __forceinline__ void p0_prologue(Frame& F, const Args& args) {
    LAS float* scr = (LAS float*)(F.lds + F.wave * 16640);
    const int gw = F.vcu * NWAVES + F.wave, NGW = F.G * NWAVES, lane = F.lane;
    unsigned char* ws = F.ws;
    bf16_t* WT_IN = (bf16_t*)(ws + WS_WT_IN); bf16_t* WT_FO = (bf16_t*)(ws + WS_WT_FO); bf16_t* WT_AO = (bf16_t*)(ws + WS_WT_AO); bf16_t* WT_O = (bf16_t*)(ws + WS_WT_O);
    bf16_t* WT_GU = (bf16_t*)(ws + WS_WT_GU); bf16_t* WT_D = (bf16_t*)(ws + WS_WT_D);
    for (int it = gw; it < IT_ALL; it += NGW) {
        int r = it < IT_MOD ? it + IT_T_END : (it < IT_T_END + IT_MOD ? it - IT_MOD : it);
        if (r < IT_IN) { const int kb = r / 128, nb = r % 128; transpose64(args.in[7] + (size_t)(kb * 64) * INC + nb * 64, INC, WT_IN + (size_t)(nb * 64) * DM + kb * 64, DM, scr, lane); continue; } r -= IT_IN;
        if (r < IT_FO) { const int kb = r / 32, nb = r % 32; transpose64(args.in[10] + (size_t)(kb * 64) * DM + nb * 64, DM, WT_FO + (size_t)(nb * 64) * FW + kb * 64, FW, scr, lane); continue; } r -= IT_FO;
        if (r < IT_AO) { const int kb = r / 32, nb = r % 32; transpose64(args.in[11] + (size_t)(kb * 64) * DM + nb * 64, DM, WT_AO + (size_t)(nb * 64) * DM + kb * 64, DM, scr, lane); continue; } r -= IT_AO;
        if (r < IT_O) { const int kb = r / 32, nb = r % 32; transpose64(args.in[12] + (size_t)(kb * 64) * DM + nb * 64, DM, WT_O + (size_t)(nb * 64) * DM + kb * 64, DM, scr, lane); continue; } r -= IT_O;
        if (r < 2 * IT_SH) { const int up = r >= IT_SH; if (up) r -= IT_SH; const int kb = r / 8, nb = r % 8, n0 = nb * 64;
            transpose64((up ? args.in[20] : args.in[19]) + (size_t)(kb * 64) * EFF + n0, EFF, WT_GU + ((size_t)64 * 1024 + (n0 >> 7) * 256 + (up ? 128 : 0) + (n0 & 127)) * DM + kb * 64, DM, scr, lane); continue; } r -= 2 * IT_SH;
        if (r < IT_SH) { const int kb = r / 32, nb = r % 32;
            transpose64(args.in[21] + (size_t)(kb * 64) * DM + nb * 64, DM, WT_D + ((size_t)64 * DM + nb * 64) * EFF + kb * 64, EFF, scr, lane); continue; } r -= IT_SH;
        if (r < IT_MOD) {
            const int kq = lane >> 3, col = r * 32 + (lane & 7) * 4;
            f32x4 a0 = {0.f, 0.f, 0.f, 0.f}, a1 = a0, a2 = a0;
            for (int jb = 0; jb < 256; jb += 8) {
                f32x4 w[8]; float c0[8], c1[8], c2[8];
#pragma unroll
                for (int j = 0; j < 8; ++j) { const int k = kq + 8 * (jb + j); w[j] = *(const GAS f32x4*)(args.in[4] + (size_t)k * MODC + col); c0[j] = args.in[1][k]; c1[j] = args.in[1][DM + k]; c2[j] = args.in[3][k]; }
#pragma unroll
                for (int j = 0; j < 8; ++j) { a0 += w[j] * (c0[j] * __builtin_amdgcn_rcpf(1.0f + __expf(-c0[j]))); a1 += w[j] * (c1[j] * __builtin_amdgcn_rcpf(1.0f + __expf(-c1[j]))); a2 += w[j] * (c2[j] * __builtin_amdgcn_rcpf(1.0f + __expf(-c2[j]))); }
            }
#pragma unroll
            for (int c = 0; c < 4; ++c) {
#pragma unroll
                for (int o = 8; o < 64; o <<= 1) { a0[c] += __shfl_xor(a0[c], o); a1[c] += __shfl_xor(a1[c], o); a2[c] += __shfl_xor(a2[c], o); } }
            if (kq == 0) { const f32x4 bb = *(const GAS f32x4*)(args.in[5] + col); float* MODP = (float*)(ws + WS_MOD);
                *(GAS f32x4*)(MODP + col) = a0 + bb; *(GAS f32x4*)(MODP + MODC + col) = a1 + bb; *(GAS f32x4*)(MODP + 2 * MODC + col) = a2 + bb; }
            continue; } r -= IT_MOD;
        if (r < IT_CST) {
            const int k1 = r & 2047; bf16_t* dst = (bf16_t*)(ws + WS_CST) + (size_t)r * 2048;
#pragma unroll
            for (int j = 0; j < 4; ++j) { const int n0 = j * 512 + lane * 8; float f[8];
#pragma unroll
                for (int i = 0; i < 8; ++i) { const float ph = (float)((k1 * (n0 + i)) & 4095) * (1.0f / 2048.0f); f[i] = r < 2048 ? cospif(ph) : sinpif(ph); }
                u32x4 o; o.x = cvt_pk_bf16(f[0], f[1]); o.y = cvt_pk_bf16(f[2], f[3]); o.z = cvt_pk_bf16(f[4], f[5]); o.w = cvt_pk_bf16(f[6], f[7]);
                *(GAS u32x4*)(dst + n0) = o; }
            continue; } r -= IT_CST;
        {
            const int t = r >> 8, o = r & 255, gp = o >> 7, k2 = o & 127; bf16_t* dst = (bf16_t*)(ws + WS_BD2) + (size_t)r * 512; float f[8];
#pragma unroll
            for (int i = 0; i < 8; ++i) { const int j = lane * 8 + i, cg = j >> 8, jj = j & 255, c = jj & 127; const float ph = (float)((32 * c * k2) & 4095) * (1.0f / 2048.0f);
                const float v = jj < 128 ? cospif(ph) : (t ? sinpif(ph) : -sinpif(ph)); f[i] = cg == gp ? v * 0.0013810679320049757f : 0.f; }
            u32x4 w; w.x = cvt_pk_bf16(f[0], f[1]); w.y = cvt_pk_bf16(f[2], f[3]); w.z = cvt_pk_bf16(f[4], f[5]); w.w = cvt_pk_bf16(f[6], f[7]);
            *(GAS u32x4*)(dst + lane * 8) = w;
        }
    }
}


__device__ __forceinline__ void conv_addr(const Args& args, unsigned char* ws, bool down, int it, const float*& W, int& ldw, bf16_t*& dst, int& ldd) {
    if (!down) { int r = it; const int up = r >= IT_EG; if (up) r -= IT_EG;
        const int e = r / 256, q = r % 256, kb = q / 8, nb = q % 8, n0 = nb * 64;
        W = (up ? args.in[17] : args.in[16]) + (size_t)e * DM * EFF + (size_t)(kb * 64) * EFF + n0; ldw = EFF;
        dst = (bf16_t*)(ws + WS_WT_GU) + ((size_t)e * 1024 + (n0 >> 7) * 256 + (up ? 128 : 0) + (n0 & 127)) * DM + kb * 64; ldd = DM;
    } else { const int r = it, e = r / 256, q = r % 256, kb = q / 32, nb = q % 32;
        W = args.in[18] + (size_t)e * EFF * DM + (size_t)(kb * 64) * DM + nb * 64; ldw = DM;
        dst = (bf16_t*)(ws + WS_WT_D) + ((size_t)e * DM + nb * 64) * EFF + kb * 64; ldd = EFF; }
}
__device__ __forceinline__ void conv_items(Frame& F, const Args& args, bool down, int first, int count) {
    LAS float* scr = (LAS float*)(F.lds + F.wave * 16640);
    const int end = first + count; int it = first + F.wave;
    if (it >= end) return;
    f32x4 va[16], vb[16]; const float* W; int ldw; bf16_t* da; bf16_t* db; int ldd;
    conv_addr(args, F.ws, down, it, W, ldw, da, ldd); t64_load(va, W, ldw, F.lane);
    for (;;) {
        const bool hb = it + NWAVES < end;
        if (hb) { conv_addr(args, F.ws, down, it + NWAVES, W, ldw, db, ldd); t64_load(vb, W, ldw, F.lane); }
        t64_store(va, da, ldd, scr, F.lane);
        if (!hb) break;
        const bool ha = it + 2 * NWAVES < end;
        if (ha) { conv_addr(args, F.ws, down, it + 2 * NWAVES, W, ldw, da, ldd); t64_load(va, W, ldw, F.lane); }
        t64_store(vb, db, ldd, scr, F.lane);
        if (!ha) break;
        it += 2 * NWAVES;
    }
}
struct SchedIn {
    int G, c; unsigned char* ws; int use_ut;
    __device__ __forceinline__ bool next(int i, Unit& u) const {
        const int L = i * G + c; if (L >= 904) return false;
        const char* H = (const char*)(ws + WS_H); const char* WT = (const char*)(ws + WS_WT_IN);
        u.rows = 256; u.aux = 0; u.bjs = HALF; u.pm = 0; u.pn = 0; u.rmin = 0;
        if (L < 896) {
            int pm, ct; grid_map(L, 32, 28, pm, ct);
            const int row0 = pm * 256, b = row0 / SEQ, t0 = row0 % SEQ;
            u.A = H + (size_t)row0 * DM * 2; u.B = WT + (size_t)ct * 256 * DM * 2;
            if (ct < 4) {
                if (use_ut) { u.A = WT + (size_t)ct * 256 * DM * 2; u.B = H + (size_t)row0 * DM * 2;
                              u.C = (char*)(ws + WS_UT) + (((size_t)b * FW + ct * 256) * SEQ + t0) * 2; u.ldc = SEQ; u.mode = 0; }
                else { u.C = (char*)(ws + WS_U) + ((size_t)row0 * FW + ct * 256) * 2; u.ldc = FW; u.mode = 0; }
            }
            else if (ct < 14) { u.C = (char*)(ws + WS_QKRAW) + ((size_t)row0 * 2560 + (ct - 4) * 256) * 4; u.ldc = 2560; u.mode = 1; }
            else if (ct < 16) { u.C = (char*)(ws + WS_VALL) + (((size_t)b * SKV + t0) * KVW + (ct - 14) * 256) * 2; u.ldc = KVW; u.mode = 0; }
            else if (ct < 24) { u.C = (char*)(ws + WS_SGF) + ((size_t)row0 * DM + (ct - 16) * 256) * 2; u.ldc = DM; u.mode = 2; }
            else              { u.C = (char*)(ws + WS_SGA) + ((size_t)row0 * DM + (ct - 24) * 256) * 2; u.ldc = DM; u.mode = 2; }
        } else {
            const int l = L - 896, pm = l & 1, ct = l >> 1;
            u.A = H + (size_t)(NTOK + pm * 256) * DM * 2; u.B = WT + (size_t)(K_OFF + ct * 256) * DM * 2;
            if (ct < 2) { u.C = (char*)(ws + WS_KCRAW) + ((size_t)(pm * 256) * KVW + ct * 256) * 4; u.ldc = KVW; u.mode = 1; }
            else        { u.C = (char*)(ws + WS_VALL) + (((size_t)pm * SKV + SEQ) * KVW + (ct - 2) * 256) * 2; u.ldc = KVW; u.mode = 0; }
        }
        return true;
    }
    __device__ __forceinline__ unsigned arow(const Unit&, int) const { return 0u; }
};


__device__ __forceinline__ void unpack8(u32x4 w, float (&f)[8]) {
#pragma unroll
    for (int i = 0; i < 4; ++i) { f[2 * i] = __uint_as_float(w[i] << 16); f[2 * i + 1] = __uint_as_float(w[i] & 0xffff0000u); }
}
struct EpiT1 { const bf16_t* SGF; float* T1;
    __device__ __forceinline__ void operator()(const f32x4 (&acc)[2][2][4][2], const Unit& u, int wr, int wc, int fr, int fq) const {
#pragma unroll
        for (int ai = 0; ai < 2; ++ai)
#pragma unroll
            for (int m = 0; m < 4; ++m) { const size_t row = (size_t)u.pm * 256 + ai * HALF + wr * 64 + m * 16 + fr;
#pragma unroll
                for (int bj = 0; bj < 2; ++bj) { const size_t o = row * DM + u.pn * 256 + bj * HALF + wc * 32 + 8 * fq;
                    float g[8]; unpack8(*(const u32x4*)(SGF + o), g); const f32x4 v0 = acc[ai][bj][m][0], v1 = acc[ai][bj][m][1];
                    *(f32x4*)(T1 + o) = (f32x4){g[0] * v0[0], g[1] * v0[1], g[2] * v0[2], g[3] * v0[3]};
                    *(f32x4*)(T1 + o + 4) = (f32x4){g[4] * v1[0], g[5] * v1[1], g[6] * v1[2], g[7] * v1[3]}; } }
    } };
struct EpiYM { const bf16_t* SGA; const float* T1; bf16_t* YM;
    __device__ __forceinline__ void operator()(const f32x4 (&acc)[2][2][4][2], const Unit& u, int wr, int wc, int fr, int fq) const {
#pragma unroll
        for (int ai = 0; ai < 2; ++ai)
#pragma unroll
            for (int m = 0; m < 4; ++m) { const size_t row = (size_t)u.pm * 256 + ai * HALF + wr * 64 + m * 16 + fr;
#pragma unroll
                for (int bj = 0; bj < 2; ++bj) { const size_t o = row * DM + u.pn * 256 + bj * HALF + wc * 32 + 8 * fq;
                    float g[8]; unpack8(*(const u32x4*)(SGA + o), g); const f32x4 v0 = acc[ai][bj][m][0], v1 = acc[ai][bj][m][1];
                    const f32x4 t0 = *(const f32x4*)(T1 + o), t1 = *(const f32x4*)(T1 + o + 4);
                    u32x4 w; w.x = cvt_pk_bf16(t0[0] + g[0] * v0[0], t0[1] + g[1] * v0[1]); w.y = cvt_pk_bf16(t0[2] + g[2] * v0[2], t0[3] + g[3] * v0[3]);
                    w.z = cvt_pk_bf16(t1[0] + g[4] * v1[0], t1[1] + g[5] * v1[1]); w.w = cvt_pk_bf16(t1[2] + g[6] * v1[2], t1[3] + g[7] * v1[3]);
                    *(u32x4*)(YM + o) = w; } }
    } };
struct EpiX2 { const float* x; const float* mod; float* X2;
    __device__ __forceinline__ void operator()(const f32x4 (&acc)[2][2][4][2], const Unit& u, int wr, int wc, int fr, int fq) const {
        const float* g1 = mod + ((u.pm * 256) / SEQ) * MODC + 2 * DM;
#pragma unroll
        for (int ai = 0; ai < 2; ++ai)
#pragma unroll
            for (int m = 0; m < 4; ++m) { const size_t row = (size_t)u.pm * 256 + ai * HALF + wr * 64 + m * 16 + fr;
#pragma unroll
                for (int bj = 0; bj < 2; ++bj) { const int col = u.pn * 256 + bj * HALF + wc * 32 + 8 * fq; const size_t o = row * DM + col;
#pragma unroll
                    for (int n = 0; n < 2; ++n) { const f32x4 xv = *(const f32x4*)(x + o + 4 * n), gv = *(const f32x4*)(g1 + col + 4 * n); *(f32x4*)(X2 + o + 4 * n) = xv + gv * acc[ai][bj][m][n]; } } }
    } };
struct EpiAct {
    __device__ __forceinline__ void operator()(const f32x4 (&acc)[2][2][4][2], const Unit& u, int wr, int wc, int fr, int fq) const {
#pragma unroll
        for (int ai = 0; ai < 2; ++ai)
#pragma unroll
            for (int m = 0; m < 4; ++m) { const int r = ai * HALF + wr * 64 + m * 16 + fr;
                if (r < u.rows) { float a[8];
#pragma unroll
                    for (int n = 0; n < 2; ++n)
#pragma unroll
                        for (int c = 0; c < 4; ++c) { const float g = acc[ai][0][m][n][c], up = acc[ai][1][m][n][c]; a[4 * n + c] = g * __builtin_amdgcn_rcpf(1.0f + __expf(-g)) * up; }
                    u32x4 w; w.x = cvt_pk_bf16(a[0], a[1]); w.y = cvt_pk_bf16(a[2], a[3]); w.z = cvt_pk_bf16(a[4], a[5]); w.w = cvt_pk_bf16(a[6], a[7]);
                    *(u32x4*)((bf16_t*)u.C + (size_t)r * u.ldc + wc * 32 + 8 * fq) = w; } }
    } };

struct SchedGrid {
    int G, c, nM, nN; const char* A; const char* B; char* C; size_t astride, bstride; int ldc, esz, mode;
    __device__ __forceinline__ bool next(int i, Unit& u) const {
        const int L = i * G + c; if (L >= nM * nN) return false;
        int pm, pn; grid_map(L, nM, nN, pm, pn);
        u.A = A + (size_t)pm * astride; u.B = B + (size_t)pn * bstride; u.C = C + ((size_t)pm * 256 * ldc + pn * 256) * esz; u.ldc = ldc; u.mode = mode; u.rows = 256; u.aux = 0; u.pm = pm; u.pn = pn; u.bjs = HALF; u.rmin = 0;
        return true; }
    __device__ __forceinline__ unsigned arow(const Unit&, int) const { return 0u; } };
struct SchedAG { int G, c; unsigned char* ws;
    __device__ __forceinline__ bool next(int i, Unit& u) const {
        const int L = i * G + c; if (L >= 256) return false;
        u.rows = 256; u.aux = 0; u.rmin = 0;
        if (L < 128) {
            int pm, pn8; grid_map(L, 16, 8, pm, pn8); const int b = pn8 >> 2, pn = pn8 & 3, sn = pm >> 3, k1t = pm & 7;
            u.A = (const char*)(ws + WS_CST) + (size_t)pm * 256 * 2048 * 2; u.B = (const char*)(ws + (sn ? WS_OT : WS_ET)) + ((size_t)b * FW + pn * 256) * 2048 * 2;
            u.C = (char*)(ws + WS_TT) + (((size_t)b * 2048 + k1t * 256) * DM + pn * 512 + sn * 128) * 2; u.ldc = DM; u.mode = sn ? 0 : 3; u.pm = k1t; u.pn = b * FW + pn * 256; u.bjs = 256;
        } else {
            int pm, q; grid_map(L - 128, 32, 4, pm, q); const int ct = 28 + q;
            u.A = (const char*)(ws + WS_H) + (size_t)pm * 256 * DM * 2; u.B = (const char*)(ws + WS_WT_IN) + (size_t)ct * 256 * DM * 2;
            u.C = (char*)(ws + WS_SGA) + ((size_t)pm * 256 * DM + (ct - 24) * 256) * 2; u.ldc = DM; u.mode = 2; u.pm = pm; u.pn = ct; u.bjs = HALF;
        }
        return true; }
    __device__ __forceinline__ unsigned arow(const Unit&, int) const { return 0u; } };
struct SchedF2 { int G, c; unsigned char* ws;
    __device__ __forceinline__ bool next(int i, Unit& u) const {
        const int L = i * G + c; if (L >= 128) return false;
        int pm, q; grid_map(L, 16, 8, pm, q); const int b = pm >> 3, k1t = pm & 7, j = q & 3, mir = q >> 2;
        u.A = (const char*)(ws + WS_TT) + (((size_t)b * 2048 + k1t * 256) * DM + j * 512) * 2; u.B = (const char*)(ws + WS_BD2) + (size_t)mir * 256 * 512 * 2;
        u.mode = 0; u.rows = 256; u.aux = 0; u.pm = pm; u.pn = j; u.bjs = HALF;
        if (!mir) { u.C = (char*)(ws + WS_YF) + (((size_t)b * SEQ + k1t * 256) * FW + j * 256) * 2; u.ldc = FW; u.rmin = 0; }
        else { u.C = (char*)(ws + WS_YF) + (((size_t)b * SEQ + SEQ - k1t * 256) * FW + j * 256) * 2; u.ldc = -FW; u.rmin = k1t == 0 ? 1 : 0; }
        return true; }
    __device__ __forceinline__ unsigned arow(const Unit&, int) const { return 0u; } };
constexpr int SCHT_OFF = LDSCTL_OFF + 1024;
__device__ __forceinline__ void moe_tables(Frame& F, int ncol_tiles) {
    LAS int* T = (LAS int*)(F.lds + SCHT_OFF);
    __syncthreads();
    if (F.tid == 0) { const int* CNT = (const int*)(F.ws + CTL_CNT); int up = 0, of = 0;
        for (int e = 0; e <= NE; ++e) { const int cn = e < NE ? CNT[e * 64] : NTOK; T[e] = up; T[80 + e] = e < NE ? of : NSLOT; T[160 + e] = cn; up += ((cn + 255) >> 8) * ncol_tiles; of += cn; }
        T[NE + 1] = up; }
    __syncthreads();
}
template <int NCT, bool FIRST> struct SchedMoe {
    int G, c; unsigned char* ws; LAS int* T; const int* TOK;
    __device__ __forceinline__ bool next(int i, Unit& u) const {
        const int L = i * G + c; if (L >= T[NE + 1]) return false;
        int lo = 0, hi = NE;
#pragma unroll 1
        while (lo < hi) { const int mid = (lo + hi + 1) >> 1; if (T[mid] <= L) lo = mid; else hi = mid - 1; }
        const int e = lo, cn = T[160 + e], ntile = (cn + 255) >> 8, local = L - T[e], ct = local / ntile, mt = local % ntile, slot0 = T[80 + e] + mt * 256;
        u.rows = (cn - mt * 256) < 256 ? (cn - mt * 256) : 256; u.aux = slot0; u.pm = mt; u.pn = ct; u.bjs = HALF; u.mode = 0; u.rmin = 0;
        if (FIRST) { u.A = (const char*)(ws + WS_H2); u.B = (const char*)(ws + WS_WT_GU) + ((size_t)e * 4 + ct) * 256 * DM * 2; u.C = (char*)(ws + WS_ACT) + ((size_t)slot0 * EFF + ct * 128) * 2; u.ldc = EFF; }
        else { u.A = (const char*)(ws + WS_ACT) + (size_t)slot0 * EFF * 2; u.B = (const char*)(ws + WS_WT_D) + ((size_t)e * DM + ct * 256) * EFF * 2; u.C = (char*)(ws + WS_YBIG) + ((size_t)slot0 * DM + ct * 256) * 2; u.ldc = DM; }
        return true; }
    __device__ __forceinline__ unsigned arow(const Unit& u, int r) const { const int rr = r < u.rows ? r : u.rows - 1; return (unsigned)TOK[u.aux + rr] * (unsigned)(DM * 2); } };

namespace attn {
using s16x4 = __attribute__((ext_vector_type(4))) short;
using f32x8 = __attribute__((ext_vector_type(8))) float;
constexpr int D = 128, NW = 8, QBLK = 32, KVBLK = 64;
constexpr float SCALE = 0.088388347648318440f;
constexpr float THR = 8.f;
constexpr int LDQ = DM, LDK = KVW, LDO = DM;
constexpr size_t SHM_V = KVBLK * D * 2, SHM_K = KVBLK * D * 2, SHM_ATTN = 2 * SHM_V + 2 * SHM_K + NW * 64 * 4;
#define KSWZ(row, colB) ((row) * 256 + ((colB) ^ (((row) & 7) << 4)))
#define SBAR() __builtin_amdgcn_sched_barrier(0)
__device__ __forceinline__ unsigned cvtpk(float lo, float hi) { unsigned r; asm volatile("v_cvt_pk_bf16_f32 %0, %1, %2" : "=v"(r) : "v"(lo), "v"(hi)); return r; }
__device__ __forceinline__ void partialSM(f32x16& p0, f32x16& p1, float& m_reg, float& mn, float& alpha) {
  constexpr float C = SCALE * 1.4426950408889634f;
  float pmax = p0[0]; for (int r = 1; r < 16; ++r) pmax = fmaxf(pmax, p0[r]); for (int r = 0; r < 16; ++r) pmax = fmaxf(pmax, p1[r]);
  { auto rr = __builtin_amdgcn_permlane32_swap(__float_as_uint(pmax), __float_as_uint(pmax), false, false);
    pmax = fmaxf(__uint_as_float(rr[0]), __uint_as_float(rr[1])); }
  if (__builtin_expect(__all(pmax - m_reg <= THR / SCALE), 1)) { mn = m_reg; alpha = 1.f; }
  else { mn = fmaxf(m_reg, pmax); alpha = __builtin_amdgcn_exp2f((m_reg - mn) * C); m_reg = mn; }
  float mnC = -mn * C;
  for (int r = 0; r < 16; ++r) p0[r] = fmaf(p0[r], C, mnC); for (int r = 0; r < 16; ++r) p1[r] = fmaf(p1[r], C, mnC);
  for (int r = 0; r < 16; ++r) p0[r] = __builtin_amdgcn_exp2f(p0[r]);
}
__device__ __forceinline__ void finishSM(f32x16& p0, f32x16& p1, float alpha, float& l_reg, bf16x8& pa0, bf16x8& pa1, bf16x8& pa2, bf16x8& pa3) {
  for (int r = 0; r < 16; ++r) p1[r] = __builtin_amdgcn_exp2f(p1[r]);
  float ps = 0; for (int r = 0; r < 16; ++r) ps += p0[r]; for (int r = 0; r < 16; ++r) ps += p1[r];
  { auto rr = __builtin_amdgcn_permlane32_swap(__float_as_uint(ps), __float_as_uint(ps), false, false);
    ps = __uint_as_float(rr[0]) + __uint_as_float(rr[1]); }
  l_reg = l_reg * alpha + ps;
#define PK4(P, BASE, OUT) do { unsigned a0 = cvtpk(P[BASE + 0], P[BASE + 1]), a1 = cvtpk(P[BASE + 2], P[BASE + 3]);   \
    unsigned b0 = cvtpk(P[BASE + 4], P[BASE + 5]), b1 = cvtpk(P[BASE + 6], P[BASE + 7]);                              \
    auto r0 = __builtin_amdgcn_permlane32_swap(a0, b0, false, false); auto r1 = __builtin_amdgcn_permlane32_swap(a1, b1, false, false); \
    u32x4 w = {r0[0], r1[0], r0[1], r1[1]}; OUT = *reinterpret_cast<bf16x8*>(&w); } while (0)
  PK4(p0, 0, pa0); PK4(p0, 8, pa1); PK4(p1, 0, pa2); PK4(p1, 8, pa3);
#undef PK4
}
__device__ __forceinline__ void qkt(f32x16& p0, f32x16& p1, const bf16_t* Ks, const bf16x8* qr, int r32, int hi) {
  p0 = f32x16{}; p1 = f32x16{};
  for (int d0 = 0; d0 < 8; ++d0) { int cb = (d0 * 16 + hi * 8) * 2;
    bf16x8 b0 = *reinterpret_cast<const bf16x8*>((const char*)Ks + KSWZ(r32, cb));
    bf16x8 b1 = *reinterpret_cast<const bf16x8*>((const char*)Ks + KSWZ(32 + r32, cb));
    p0 = __builtin_amdgcn_mfma_f32_32x32x16_bf16(b0, qr[d0], p0, 0, 0, 0);
    p1 = __builtin_amdgcn_mfma_f32_32x32x16_bf16(b1, qr[d0], p1, 0, 0, 0); }
}
__device__ __forceinline__ int v_st(int k, int c) { const int kk = (k & ~0xC) | ((k & 4) << 1) | ((k & 8) >> 1); return ((kk >> 3) * 4 + (c >> 5)) * 512 + ((kk & 7) * 32 + (c & 31)) * 2; }
__device__ __forceinline__ int v_rd_base(int lane) { return ((lane & 3) << 3) | (((lane >> 2) & 3) << 6) | (((lane >> 4) & 1) << 5) | (((lane >> 5) & 1) << 8); }
constexpr int v_rd_off(int d0, int ks, int half) { return d0 * 512 + ks * 4096 + half * 2048; }
template <int OFF> __device__ __forceinline__ s16x4 tr_read(int vb) {
  s16x4 r; asm volatile("ds_read_b64_tr_b16 %0, %1 offset:%2" : "=&v"(r) : "v"(vb), "i"(OFF) : "memory"); return r;
}
template <int D0> __device__ __forceinline__ void pv_one(f32x16& od, int vb, bf16x8 pa0, bf16x8 pa1, bf16x8 pa2, bf16x8 pa3) {
  const s16x4 l0 = tr_read<v_rd_off(D0, 0, 0)>(vb), h0 = tr_read<v_rd_off(D0, 0, 1)>(vb), l1 = tr_read<v_rd_off(D0, 1, 0)>(vb), h1 = tr_read<v_rd_off(D0, 1, 1)>(vb);
  const s16x4 l2 = tr_read<v_rd_off(D0, 2, 0)>(vb), h2 = tr_read<v_rd_off(D0, 2, 1)>(vb), l3 = tr_read<v_rd_off(D0, 3, 0)>(vb), h3 = tr_read<v_rd_off(D0, 3, 1)>(vb);
  asm volatile("s_waitcnt lgkmcnt(0)" ::: "memory"); SBAR();
#define PK(L, H) (bf16x8){L[0], L[1], L[2], L[3], H[0], H[1], H[2], H[3]}
  od = __builtin_amdgcn_mfma_f32_32x32x16_bf16(pa0, PK(l0, h0), od, 0, 0, 0);
  od = __builtin_amdgcn_mfma_f32_32x32x16_bf16(pa1, PK(l1, h1), od, 0, 0, 0);
  od = __builtin_amdgcn_mfma_f32_32x32x16_bf16(pa2, PK(l2, h2), od, 0, 0, 0);
  od = __builtin_amdgcn_mfma_f32_32x32x16_bf16(pa3, PK(l3, h3), od, 0, 0, 0);
#undef PK
}
__device__ __forceinline__ void pv_d0(f32x16* o, int vb, bf16x8 pa0, bf16x8 pa1, bf16x8 pa2, bf16x8 pa3) {
  pv_one<0>(o[0], vb, pa0, pa1, pa2, pa3); pv_one<1>(o[1], vb, pa0, pa1, pa2, pa3); pv_one<2>(o[2], vb, pa0, pa1, pa2, pa3); pv_one<3>(o[3], vb, pa0, pa1, pa2, pa3);
}
__device__ __forceinline__ void attn_dense_body(const bf16_t* __restrict__ Qb, const bf16_t* __restrict__ Kh, const bf16_t* __restrict__ Vh, bf16_t* __restrict__ Ob, int seq, char* lds) {
  const int tid = threadIdx.x, wid = tid >> 6, lane = tid & 63, r32 = lane & 31, hi = lane >> 5;
  bf16_t* V_lds = (bf16_t*)lds; bf16_t* K_lds = (bf16_t*)(lds + 2 * SHM_V);
  float* ws = (float*)(lds + 2 * SHM_V + 2 * SHM_K) + wid * 64; float* li_l = ws; float* al_l = ws + 32;
  float m_reg = -1e30f, l_reg = 0; f32x16 o[4] = {}; bf16x8 qr[8];
  const bf16_t* Qw = Qb + (long)(wid * QBLK + r32) * LDQ + hi * 8;
#pragma unroll
  for (int d0 = 0; d0 < 8; ++d0) qr[d0] = *reinterpret_cast<const bf16x8*>(Qw + d0 * 16);
  const int sr = tid >> 4, sc = (tid & 15) * 8, vst0 = v_st(sr, sc), vst1 = v_st(32 + sr, sc);
  const int vb0 = (int)(uintptr_t)V_lds + v_rd_base(lane);
  struct { bf16x8 vs0, vs1, ks0, ks1; } sr_[2];
#define SLOAD(i, k0) do { sr_[i].vs0 = *reinterpret_cast<const bf16x8*>(&Vh[(long)((k0) + sr) * LDK + sc]); sr_[i].vs1 = *reinterpret_cast<const bf16x8*>(&Vh[(long)((k0) + 32 + sr) * LDK + sc]); \
    sr_[i].ks0 = *reinterpret_cast<const bf16x8*>(&Kh[(long)((k0) + sr) * LDK + sc]); sr_[i].ks1 = *reinterpret_cast<const bf16x8*>(&Kh[(long)((k0) + 32 + sr) * LDK + sc]); } while (0)
#define SWRITE(b, i) do { *(bf16x8*)((char*)V_lds + (b) * SHM_V + vst0) = sr_[i].vs0;          \
    *(bf16x8*)((char*)V_lds + (b) * SHM_V + vst1) = sr_[i].vs1; int kc = sc * 2;               \
    *(bf16x8*)((char*)K_lds + (b) * SHM_K + KSWZ(sr, kc)) = sr_[i].ks0;                       \
    *(bf16x8*)((char*)K_lds + (b) * SHM_K + KSWZ(32 + sr, kc)) = sr_[i].ks1; } while (0)
#define SWAIT() asm volatile("s_waitcnt vmcnt(4)" ::: "memory")
#define RESC(a) do { if (__any((a) < 1.f)) { if (hi == 0) al_l[r32] = (a); asm volatile("s_waitcnt lgkmcnt(0)" ::: "memory"); \
    for (int d = 0; d < 4; ++d) for (int r = 0; r < 16; ++r) o[d][r] *= al_l[crow(r, hi)]; } } while (0)
  f32x16 pA0, pA1, pB0, pB1; float mnA, mnB, alA, alB; bf16x8 pa0, pa1, pa2, pa3; const int NT = seq / KVBLK;
  constexpr int SE = 0, SO = 1;
  SLOAD(SE, 0); asm volatile("s_waitcnt vmcnt(0)" ::: "memory"); SWRITE(0, SE); __syncthreads();
  qkt(pA0, pA1, K_lds, qr, r32, hi); partialSM(pA0, pA1, m_reg, mnA, alA);
  SLOAD(SO, KVBLK); if (2 < NT) SLOAD(SE, 2 * KVBLK);
  SWAIT(); SWRITE(1, SO); __syncthreads();
  for (int j = 1; j + 1 < NT; j += 2) {
    SBAR(); qkt(pB0, pB1, (bf16_t*)((char*)K_lds + SHM_K), qr, r32, hi);
    finishSM(pA0, pA1, alA, l_reg, pa0, pa1, pa2, pa3); SBAR();
    SLOAD(SO, (j + 2) * KVBLK); SBAR();
    pv_d0(o, vb0, pa0, pa1, pa2, pa3); partialSM(pB0, pB1, m_reg, mnB, alB);
    __syncthreads(); SWAIT(); SWRITE(0, SE);
    RESC(alB); __syncthreads();
    SBAR(); qkt(pA0, pA1, K_lds, qr, r32, hi);
    finishSM(pB0, pB1, alB, l_reg, pa0, pa1, pa2, pa3); SBAR();
    if (j + 3 < NT) SLOAD(SE, (j + 3) * KVBLK); SBAR();
    pv_d0(o, vb0 + (int)SHM_V, pa0, pa1, pa2, pa3); partialSM(pA0, pA1, m_reg, mnA, alA);
    __syncthreads(); SWAIT(); SWRITE(1, SO);
    RESC(alA); __syncthreads();
  }
  SBAR(); qkt(pB0, pB1, (bf16_t*)((char*)K_lds + SHM_K), qr, r32, hi);
  finishSM(pA0, pA1, alA, l_reg, pa0, pa1, pa2, pa3); SBAR();
  pv_d0(o, vb0, pa0, pa1, pa2, pa3); partialSM(pB0, pB1, m_reg, mnB, alB);
  __syncthreads(); RESC(alB);
  finishSM(pB0, pB1, alB, l_reg, pa0, pa1, pa2, pa3); SBAR();
  pv_d0(o, vb0 + (int)SHM_V, pa0, pa1, pa2, pa3);
  if (hi == 0) li_l[r32] = l_reg; asm volatile("s_waitcnt lgkmcnt(0)" ::: "memory");
  float rli[16];
#pragma unroll
  for (int r = 0; r < 16; ++r) rli[r] = __builtin_amdgcn_rcpf(li_l[crow(r, hi)]);
  bf16_t* Ow = Ob + (long)(wid * QBLK) * LDO;
#pragma unroll
  for (int r = 0; r < 16; ++r) { int orow = crow(r, hi);
    for (int d0 = 0; d0 < 4; ++d0) Ow[(long)orow * LDO + d0 * 32 + r32] = f2bf(o[d0][r] * rli[r]); }
#undef SLOAD
#undef SWRITE
#undef SWAIT
#undef RESC
}
#undef KSWZ
#undef SBAR
}

__device__ __forceinline__ void ph_norm1(Frame& F, const Args& args, const float* mod) {
    const int gw = F.vcu * NWAVES + F.wave, NGW = F.G * NWAVES, lane = F.lane;
    bf16_t* H = (bf16_t*)(F.ws + WS_H); const float* nw = args.in[6];
    for (int row = gw; row < NTOK + NCTX; row += NGW) {
        const float* src = row < NTOK ? args.in[0] + (size_t)row * DM : args.in[2] + (size_t)(row - NTOK) * DM;
        const float* mr = mod + (row < NTOK ? row / SEQ : 2) * MODC;
        f32x4 v[8]; float ss = 0.f;
#pragma unroll
        for (int j = 0; j < 8; ++j) { v[j] = *(const GAS f32x4*)(src + (j * 64 + lane) * 4); ss += v[j].x * v[j].x + v[j].y * v[j].y + v[j].z * v[j].z + v[j].w * v[j].w; }
        ss = wave_sum(ss);
        const float rstd = 1.0f / sqrtf(ss * (1.0f / DM) + 1e-6f);
#pragma unroll
        for (int j = 0; j < 8; ++j) { const int i = (j * 64 + lane) * 4;
            const f32x4 w = *(const GAS f32x4*)(nw + i), sc = *(const GAS f32x4*)(mr + DM + i), sh = *(const GAS f32x4*)(mr + i);
            const f32x4 h = v[j] * rstd * w * (sc + 1.0f) + sh;
            unsigned lo = cvt_pk_bf16(h[0], h[1]), hi = cvt_pk_bf16(h[2], h[3]);
            *(GAS unsigned long long*)(H + (size_t)row * DM + i) = (unsigned long long)lo | ((unsigned long long)hi << 32); }
    }
}
__device__ __forceinline__ void ph_qknorm(Frame& F, const Args& args) {
    const int gw = F.vcu * NWAVES + F.wave, NGW = F.G * NWAVES, lane = F.lane;
    const float* QKRAW = (const float*)(F.ws + WS_QKRAW); const float* KCRAW = (const float*)(F.ws + WS_KCRAW);
    bf16_t* Q = (bf16_t*)(F.ws + WS_Q); bf16_t* KALL = (bf16_t*)(F.ws + WS_KALL);
    const int axis = lane >> 5, f = lane & 31, da = axis * 64 + f, db = da + 32;
    const float qwa = args.in[8][da], qwb = args.in[8][db], kwa = args.in[9][da], kwb = args.in[9][db];
    const float inv = exp2f(-(float)f * (13.287712379549449f / 32.0f));
    for (int row = gw; row < NTOK + NCTX; row += NGW) {
        if (row < NTOK) {
            const int b = row / SEQ, t = row % SEQ;
            const float pos = (float)(axis == 0 ? t / 64 : t % 64), ang = pos * inv, cs = cosf(ang), sn = sinf(ang);
            const float* src = QKRAW + (size_t)row * 2560;
#pragma unroll
            for (int hb = 0; hb < 20; hb += 5) {
                float xa[5], xb[5];
#pragma unroll
                for (int q = 0; q < 5; ++q) { xa[q] = src[(hb + q) * HD + da]; xb[q] = src[(hb + q) * HD + db]; }
#pragma unroll
                for (int q = 0; q < 5; ++q) { const int hh = hb + q;
                    const float ss = wave_sum(xa[q] * xa[q] + xb[q] * xb[q]), rstd = 1.0f / sqrtf(ss * (1.0f / HD) + 1e-6f);
                    const float a = xa[q] * rstd * (hh < 16 ? qwa : kwa), bb = xb[q] * rstd * (hh < 16 ? qwb : kwb);
                    bf16_t* dst = hh < 16 ? Q + (size_t)row * DM + hh * HD : KALL + ((size_t)b * SKV + t) * KVW + (hh - 16) * HD;
                    dst[da] = f2bf(a * cs - bb * sn); dst[db] = f2bf(bb * cs + a * sn); }
            }
        } else {
            const int r = row - NTOK, b = r / CTXL, j = r % CTXL; const float* src = KCRAW + (size_t)r * KVW;
#pragma unroll
            for (int hh = 0; hh < 4; ++hh) { const float xa = src[hh * HD + da], xb = src[hh * HD + db];
                const float ss = wave_sum(xa * xa + xb * xb), rstd = 1.0f / sqrtf(ss * (1.0f / HD) + 1e-6f);
                bf16_t* dst = KALL + ((size_t)b * SKV + SEQ + j) * KVW + hh * HD; dst[da] = f2bf(xa * rstd * kwa); dst[db] = f2bf(xb * rstd * kwb); }
        }
    }
}
__device__ __forceinline__ void ph_evenodd(Frame& F, const Args& args) {
    const int gw = F.vcu * NWAVES + F.wave, NGW = F.G * NWAVES, lane = F.lane;
    LAS bf16_t* scr = (LAS bf16_t*)(F.lds + F.wave * 16640);
    const bf16_t* UT = (const bf16_t*)(F.ws + WS_UT); bf16_t* ET = (bf16_t*)(F.ws + WS_ET); bf16_t* OT = (bf16_t*)(F.ws + WS_OT);
    float* W2 = (float*)(F.ws + WS_W2048); float* AL = (float*)(F.ws + WS_ALT);
    for (int row = gw; row < 2 * FW; row += NGW) {
        const bf16_t* src = UT + (size_t)row * SEQ; float alt = 0.f;
#pragma unroll
        for (int j = 0; j < 8; ++j) { const u32x4 w = *(const GAS u32x4*)(src + (j * 64 + lane) * 8); *(LAS u32x4*)(scr + (j * 64 + lane) * 8) = w;
            float f[8]; unpack8(w, f); alt += (f[0] - f[1]) + (f[2] - f[3]) + (f[4] - f[5]) + (f[6] - f[7]); }
        alt = wave_sum(alt);
        LDS_WAIT(); asm volatile("" ::: "memory");
        if (lane == 0) { AL[row] = alt; W2[row] = bf2f(scr[SEQ / 2]); }
#pragma unroll
        for (int j = 0; j < 4; ++j) { const int n0 = (j * 64 + lane) * 8; float e[8], o[8];
#pragma unroll
            for (int i = 0; i < 8; ++i) { const int n = n0 + i; const float a = bf2f(scr[n]), bb = bf2f(scr[(SEQ - n) & (SEQ - 1)]); e[i] = n == 0 ? a : a + bb; o[i] = n == 0 ? 0.f : a - bb; }
            u32x4 we, wo; we.x = cvt_pk_bf16(e[0], e[1]); we.y = cvt_pk_bf16(e[2], e[3]); we.z = cvt_pk_bf16(e[4], e[5]); we.w = cvt_pk_bf16(e[6], e[7]);
            wo.x = cvt_pk_bf16(o[0], o[1]); wo.y = cvt_pk_bf16(o[2], o[3]); wo.z = cvt_pk_bf16(o[4], o[5]); wo.w = cvt_pk_bf16(o[6], o[7]);
            *(GAS u32x4*)(ET + (size_t)row * 2048 + n0) = we; *(GAS u32x4*)(OT + (size_t)row * 2048 + n0) = wo; }
        LDS_WAIT(); asm volatile("" ::: "memory");
    }
}
__device__ __forceinline__ void ph_route(Frame& F, const Args& args, const float* mod) {
    const int lane = F.lane, wv = F.wave;
    LAS float* hrow = (LAS float*)F.lds;
    LAS float* part = (LAS float*)(F.lds + 65536);
    const float* X2 = (const float*)(F.ws + WS_X2); const float* nw = args.in[13]; const float* rw = args.in[14]; const float* rb = args.in[15];
    bf16_t* H2 = (bf16_t*)(F.ws + WS_H2); int* EIDX = (int*)(F.ws + WS_EIDX); float* EW = (float*)(F.ws + WS_EW); int* EPOS = (int*)(F.ws + WS_EPOS); int* CNT = (int*)(F.ws + CTL_CNT);
    LAS int* lcnt = (LAS int*)(F.lds + 65536 + 16384);
    LAS int* lbase = lcnt + 64;
    LAS int* lent = lcnt + 128;
    if (F.tid < NE) lcnt[F.tid] = 0;
    __syncthreads();
    int nb = 0;
    for (int blk = F.vcu; blk < NTOK / 8; blk += F.G, ++nb) {
        const int row = blk * 8 + wv;
        { const float* src = X2 + (size_t)row * DM; const float* mr = mod + (row / SEQ) * MODC;
          f32x4 v[8]; float ss = 0.f;
#pragma unroll
          for (int j = 0; j < 8; ++j) { v[j] = *(const GAS f32x4*)(src + (j * 64 + lane) * 4); ss += v[j].x * v[j].x + v[j].y * v[j].y + v[j].z * v[j].z + v[j].w * v[j].w; }
          ss = wave_sum(ss);
          const float rstd = 1.0f / sqrtf(ss * (1.0f / DM) + 1e-6f);
#pragma unroll
          for (int j = 0; j < 8; ++j) { const int i = (j * 64 + lane) * 4;
              const f32x4 w = *(const GAS f32x4*)(nw + i), sc = *(const GAS f32x4*)(mr + 4 * DM + i), sh = *(const GAS f32x4*)(mr + 3 * DM + i);
              const f32x4 h = v[j] * rstd * w * (sc + 1.0f) + sh;
              *(LAS f32x4*)(hrow + wv * DM + i) = h;
              unsigned lo = cvt_pk_bf16(h[0], h[1]), hi = cvt_pk_bf16(h[2], h[3]);
              *(GAS unsigned long long*)(H2 + (size_t)row * DM + i) = (unsigned long long)lo | ((unsigned long long)hi << 32); } }
        __syncthreads();
        { float a[8];
#pragma unroll
          for (int r = 0; r < 8; ++r) a[r] = 0.f;
          const int k0 = wv * 256;
#pragma unroll 16
          for (int k = 0; k < 256; ++k) { const float w = rw[(size_t)(k0 + k) * NE + lane];
#pragma unroll
              for (int r = 0; r < 8; ++r) a[r] += hrow[r * DM + k0 + k] * w; }
#pragma unroll
          for (int r = 0; r < 8; ++r) part[(wv * 8 + r) * 64 + lane] = a[r]; }
        __syncthreads();
        { float logit = 0.f;
#pragma unroll
          for (int w = 0; w < 8; ++w) logit += part[(w * 8 + wv) * 64 + lane];
          const float score = 1.0f / (1.0f + expf(-logit)), bsd = score + rb[lane];
          const int g = lane >> 3;
          int rk = 0;
#pragma unroll
          for (int i = 0; i < 8; ++i) { const int o = (lane & ~7) + i; const float vv = __shfl(bsd, o); rk += (vv > bsd) || (vv == bsd && o < lane); }
          float gs = rk < 2 ? bsd : 0.f;
          gs += __shfl_xor(gs, 1); gs += __shfl_xor(gs, 2); gs += __shfl_xor(gs, 4);
          int grk = 0;
#pragma unroll
          for (int gg = 0; gg < 8; ++gg) { const float vv = __shfl(gs, gg * 8); grk += (vv > gs) || (vv == gs && gg < g); }
          const bool gsel = grk < 4;
          const float mb = gsel ? bsd : -INFINITY;
          int erk = 0;
          for (int o = 0; o < 64; ++o) { const float vv = __shfl(mb, o); erk += (vv > mb) || (vv == mb && o < lane); }
          const bool sel = gsel && erk < TOPK;
          const float ssum = wave_sum(sel ? score : 0.f);
          if (sel) { const int lp = __hip_atomic_fetch_add(lcnt + lane, 1, __ATOMIC_RELAXED, __HIP_MEMORY_SCOPE_WORKGROUP);
                     EIDX[row * TOPK + erk] = lane; EW[row * TOPK + erk] = score / ssum * 2.5f; lent[(nb * 8 + wv) * TOPK + erk] = (lane << 16) | lp; } }
        __syncthreads();
    }
    if (F.tid < NE) { const int c = lcnt[F.tid]; lbase[F.tid] = c ? atomicAdd(&CNT[F.tid * 64], c) : 0; }
    __syncthreads();
    for (int i = F.tid; i < nb * 64; i += NTHREADS) { const int blk = F.vcu + (i >> 6) * F.G, row = blk * 8 + ((i >> 3) & 7), v = lent[i]; EPOS[row * TOPK + (i & 7)] = lbase[v >> 16] + (v & 0xffff); }
    __syncthreads();
}
__device__ __forceinline__ void ph_fill(Frame& F, const Args& args) {
    moe_tables(F, 4);
    LAS int* T = (LAS int*)(F.lds + SCHT_OFF);
    const int* EIDX = (const int*)(F.ws + WS_EIDX); const int* EPOS = (const int*)(F.ws + WS_EPOS); int* TOK = (int*)(F.ws + WS_TOK); int* SLOTOF = (int*)(F.ws + WS_SLOTOF);
    for (int i = F.vcu * NTHREADS + F.tid; i < NSLOT; i += F.G * NTHREADS) { const int slot = T[80 + EIDX[i]] + EPOS[i]; TOK[slot] = i / TOPK; SLOTOF[i] = slot; if (i < NTOK) TOK[NSLOT + i] = i; }
}
__device__ __forceinline__ void ph_comb(Frame& F, const Args& args, const float* mod) {
    const int gw = F.vcu * NWAVES + F.wave, NGW = F.G * NWAVES, lane = F.lane;
    const float* EW = (const float*)(F.ws + WS_EW); const int* SLOTOF = (const int*)(F.ws + WS_SLOTOF); const bf16_t* Y = (const bf16_t*)(F.ws + WS_YBIG);
    for (int t = gw; t < NTOK; t += NGW) {
        const float* g2 = mod + (t / SEQ) * MODC + 5 * DM;
        int sl[TOPK]; float wk[TOPK];
#pragma unroll
        for (int k = 0; k < TOPK; ++k) { sl[k] = SLOTOF[t * TOPK + k]; wk[k] = EW[t * TOPK + k]; }
#pragma unroll
        for (int j = 0; j < 4; ++j) { const int col = j * 512 + lane * 8;
            float a[8]; unpack8(*(const GAS u32x4*)(Y + (size_t)(NSLOT + t) * DM + col), a);
#pragma unroll
            for (int k = 0; k < TOPK; ++k) { float y[8]; unpack8(*(const GAS u32x4*)(Y + (size_t)sl[k] * DM + col), y);
#pragma unroll
                for (int c = 0; c < 8; ++c) a[c] += wk[k] * y[c]; }
            float* o = args.out + (size_t)t * DM + col; const float* xi = (const float*)(F.ws + WS_X2) + (size_t)t * DM + col;
#pragma unroll
            for (int n = 0; n < 2; ++n) { const f32x4 xv = *(const GAS f32x4*)(xi + 4 * n), gv = *(const GAS f32x4*)(g2 + col + 4 * n);
                *(GAS f32x4*)(o + 4 * n) = xv + gv * (f32x4){a[4 * n], a[4 * n + 1], a[4 * n + 2], a[4 * n + 3]}; } }
    }
}

enum { PH_PRO = 0, PH_NORM1, PH_INPROJ, PH_QKNORM, PH_ATTN, PH_F2, PH_MERGE, PH_OUT, PH_ROUTE, PH_FILL, PH_EXP1, PH_EXP2, PH_COMB, PH_END };


__global__ void __launch_bounds__(NTHREADS, 2) fwd(Args args) {
    extern __shared__ __attribute__((aligned(16))) unsigned char lds_raw[];
    Frame F;
    F.lds = (LAS unsigned char*)lds_raw; F.MISC = (volatile LAS unsigned*)(F.lds + MISC_OFF); F.ws = args.ws;
    F.tid = threadIdx.x; F.lane = F.tid & 63; F.wave = __builtin_amdgcn_readfirstlane(F.tid >> 6);
    F.G = gridDim.x; { const int bx = blockIdx.x; F.vcu = (F.G % 8 == 0) ? (bx % 8) * (F.G / 8) + bx / 8 : bx; }
    for (int u = F.tid; u < (LDS_BYTES - LDSCTL_OFF) / 4; u += NTHREADS) ((LAS unsigned*)(F.lds + LDSCTL_OFF))[u] = 0u;
    __syncthreads();
    const int lo = args.ph_lo, hi = args.ph_hi;
    const bool multi = (hi - lo) > 1;
    unsigned* barw = (unsigned*)(args.ws + CTL_BAR) + args.bar_idx * XCD_BAR_WORDS;
    XcdBarrier bar; bar.bar = barw; bar.x = 0; bar.st = nullptr;
    if (multi) bar = xcd_barrier_post(barw, F.MISC + 8);
#define IN(k) (lo <= (k) && (k) < hi)
#define SEAM(k) do { if (IN((k) + 1)) xcd_barrier(bar); } while (0)

    const float* modp = (const float*)(args.ws + args.mod_off);
    if (IN(PH_PRO)) { p0_prologue(F, args); SEAM(PH_PRO); }
    if (IN(PH_NORM1)) { ph_norm1(F, args, modp); SEAM(PH_NORM1); }
    if (IN(PH_INPROJ)) {
        SchedIn S{F.G, (int)blockIdx.x, args.ws, args.use_ut};
        gemm_phase<EpiStore, SchedIn, false>(F.lds, DM, DM, DM, S, EpiStore{(const float*)(args.ws + WS_W2048)});
        SEAM(PH_INPROJ);
    }
    if (IN(PH_QKNORM)) { ph_qknorm(F, args); ph_evenodd(F, args); SEAM(PH_QKNORM); }
    if (IN(PH_ATTN)) {
        const int cs = F.vcu & 3;
        const int gper = (IT_EG + IT_EU + F.G - 1) / F.G, gfirst = F.vcu * gper, gcnt = gfirst + gper <= IT_EG + IT_EU ? gper : (IT_EG + IT_EU - gfirst > 0 ? IT_EG + IT_EU - gfirst : 0);
        const int cper = (IT_ED + F.G - 1) / F.G, cfirst = F.vcu * cper, ccnt = cfirst + cper <= IT_ED ? cper : (IT_ED - cfirst > 0 ? IT_ED - cfirst : 0);
#define CONV_ALL() do { conv_items(F, args, false, gfirst, gcnt); conv_items(F, args, true, cfirst, ccnt); } while (0)
        const bf16_t* Qp = (const bf16_t*)(args.ws + WS_Q); const bf16_t* Kp = (const bf16_t*)(args.ws + WS_KALL); const bf16_t* Vp = (const bf16_t*)(args.ws + WS_VALL); bf16_t* Op = (bf16_t*)(args.ws + WS_YA);
#define ATTN_UNIT(lin_) do { const int lin = (lin_); if (lin < 512) { const int x = (lin >> 5) & 7, j = (lin & 31) + 32 * (lin >> 8), b = x >> 2, kvh = x & 3, head = kvh * 4 + (j >> 4), qb = j & 15; \
            const size_t qo = ((size_t)(b * SEQ + qb * 256)) * DM + head * HD, ko = (size_t)b * SKV * KVW + kvh * HD; \
            attn::attn_dense_body(Qp + qo, Kp + ko, Vp + ko, Op + qo, SKV, (char*)lds_raw); __syncthreads(); } } while (0)
        if (cs == 0) { CONV_ALL(); __syncthreads(); }
        ATTN_UNIT(F.vcu);
        if (cs == 1) { CONV_ALL(); __syncthreads(); }
        ATTN_UNIT(F.vcu + F.G);
        for (int lin2 = F.vcu + 2 * F.G; lin2 < 512; lin2 += F.G) ATTN_UNIT(lin2);
        if (cs == 2) { CONV_ALL(); __syncthreads(); }
#undef ATTN_UNIT
        SchedAG S{F.G, (int)blockIdx.x, args.ws};
        gemm_phase<EpiStore, SchedAG, false>(F.lds, DM, DM, DM, S, EpiStore{(const float*)(args.ws + WS_W2048)});
        if (cs == 3) { __syncthreads(); CONV_ALL(); }
#undef CONV_ALL
        SEAM(PH_ATTN);
    }
    if (IN(PH_F2)) {
        SchedF2 S{F.G, (int)blockIdx.x, args.ws};
        gemm_phase<EpiStore, SchedF2, false>(F.lds, 512, DM, 512, S, EpiStore{(const float*)(args.ws + WS_W2048)});
        {
            const int idx = F.vcu * NTHREADS + F.tid;
            if (idx < 2 * FW) { const int b = idx >> 10, col = idx & 1023, k2 = col & 127; const float* al = (const float*)(args.ws + WS_ALT) + b * FW + (col & ~127); float s = 0.f;
                for (int c = 0; c < 128; ++c) s += al[c] * cospif((float)((c * k2) & 127) * (1.0f / 64.0f));
                ((bf16_t*)(args.ws + WS_YF))[((size_t)b * SEQ + SEQ / 2) * FW + col] = f2bf(s * 0.0013810679320049757f); }
        }
        SEAM(PH_F2);
    }
    if (IN(PH_MERGE)) {
        unsigned char* ws = args.ws;
        { SchedGrid S{F.G, (int)blockIdx.x, 32, 8, (const char*)(ws + WS_YF), (const char*)(ws + WS_WT_FO), nullptr, (size_t)256 * FW * 2, (size_t)256 * FW * 2, DM, 4, 1};
          gemm_phase<EpiT1, SchedGrid, false>(F.lds, FW, FW, FW, S, EpiT1{(const bf16_t*)(ws + WS_SGF), (float*)(ws + WS_T1)}); }
        { SchedGrid S{F.G, (int)blockIdx.x, 32, 8, (const char*)(ws + WS_YA), (const char*)(ws + WS_WT_AO), nullptr, (size_t)256 * DM * 2, (size_t)256 * DM * 2, DM, 2, 0};
          gemm_phase<EpiYM, SchedGrid, false>(F.lds, DM, DM, DM, S, EpiYM{(const bf16_t*)(ws + WS_SGA), (const float*)(ws + WS_T1), (bf16_t*)(ws + WS_YM)}); }
        SEAM(PH_MERGE);
    }
    if (IN(PH_OUT)) {
        unsigned char* ws = args.ws;
        SchedGrid S{F.G, (int)blockIdx.x, 32, 8, (const char*)(ws + WS_YM), (const char*)(ws + WS_WT_O), nullptr, (size_t)256 * DM * 2, (size_t)256 * DM * 2, DM, 4, 1};
        gemm_phase<EpiX2, SchedGrid, false>(F.lds, DM, DM, DM, S, EpiX2{args.in[0], modp, (float*)(ws + WS_X2)});
        SEAM(PH_OUT);
    }
    if (IN(PH_ROUTE)) { ph_route(F, args, modp); SEAM(PH_ROUTE); }
    if (IN(PH_FILL)) { ph_fill(F, args); SEAM(PH_FILL); }
    if (IN(PH_EXP1)) {
        moe_tables(F, 4);
        SchedMoe<4, true> S{F.G, F.vcu, args.ws, (LAS int*)(F.lds + SCHT_OFF), (const int*)(args.ws + WS_TOK)};
        gemm_phase<EpiAct, SchedMoe<4, true>, true>(F.lds, DM, DM, DM, S, EpiAct{});
        SEAM(PH_EXP1);
    }
    if (IN(PH_EXP2)) {
        moe_tables(F, 8);
        SchedMoe<8, false> S{F.G, F.vcu, args.ws, (LAS int*)(F.lds + SCHT_OFF), (const int*)(args.ws + WS_TOK)};
        gemm_phase<EpiStore, SchedMoe<8, false>, false>(F.lds, EFF, EFF, EFF, S, EpiStore{(const float*)(args.ws + WS_W2048)});
        SEAM(PH_EXP2);
    }
    if (IN(PH_COMB)) { ph_comb(F, args, modp); }
#undef IN
#undef SEAM
}
}

extern "C" void kernel_launch(void* const* d_in, const int* in_sizes, int n_in, void* d_out, int out_size, void* d_ws, size_t ws_size, hipStream_t stream) {
    if (n_in != 22 || ws_size < WS_END2) return;
    float* out = (float*)d_out;
    unsigned char* ws = (unsigned char*)d_ws;
    hipMemsetAsync(ws + WS_CTL, 0, CTL_ZERO_BYTES, stream);
    static int grid = 0;
    if (!grid) {
        int dev = 0, cus = 0;
        if (hipGetDevice(&dev) != hipSuccess || hipDeviceGetAttribute(&cus, hipDeviceAttributeMultiprocessorCount, dev) != hipSuccess) { grid = -1; return; }
        if (hipFuncSetAttribute((const void*)mk::fwd, hipFuncAttributeMaxDynamicSharedMemorySize, mk::LDS_BYTES) != hipSuccess) { grid = -1; return; }
        grid = cus;
    }
    if (grid < 0) return;
    mk::Args a{}; int nlaunch = 0;
    for (int i = 0; i < 22; ++i) a.in[i] = (const float*)d_in[i];
    a.out = out; a.ws = ws; a.use_ut = 1; a.mod_off = (int)WS_MOD; a.do_attn = 1;
#define MK_LAUNCH(lo_, hi_) do { a.ph_lo = (lo_); a.ph_hi = (hi_); a.bar_idx = nlaunch++; hipLaunchKernelGGL(mk::fwd, dim3(grid), dim3(mk::NTHREADS), mk::LDS_BYTES, stream, a); } while (0)
    MK_LAUNCH(mk::PH_PRO, mk::PH_END);
}
```

```cpp
#include <hip/hip_runtime.h>
#include <stdint.h>
#include <math.h>

typedef unsigned short bf16_t;
typedef short bf16x8 __attribute__((ext_vector_type(8)));
typedef float f32x16 __attribute__((ext_vector_type(16)));
typedef float f32x4 __attribute__((ext_vector_type(4)));

constexpr int NB = 2, SEQ = 4096, DM = 2048, NTOK = NB * SEQ, CTXL = 256, NCTX = NB * CTXL, HD = 128, NH = 16, NKV = 4;
constexpr int SKV = SEQ + CTXL;
constexpr int FW = 1024, INC = 8192, Q_OFF = 1024, K_OFF = 3072, V_OFF = 3584, GF_OFF = 4096, GA_OFF = 6144;
constexpr int KVW = NKV * HD;
constexpr int NE = 64, TOPK = 8, EFF = 512, MODC = 6 * DM;
constexpr int NSLOT = NTOK * TOPK;
constexpr int NSLOT_ALL = NSLOT + NTOK;

constexpr size_t MiB = 1u << 20;
constexpr size_t WS_CTL = 0, CTL_ZERO_BYTES = 1 * MiB;
constexpr size_t CTL_CNT = 64 * 1024;
constexpr size_t WS_TW = 1 * MiB;
constexpr size_t WS_MOD = 1 * MiB + 64 * 1024;
constexpr size_t WS_OFFS = 1 * MiB + 256 * 1024;
constexpr size_t WS_EIDX = 2 * MiB;
constexpr size_t WS_EW = WS_EIDX + 256 * 1024;
constexpr size_t WS_EPOS = WS_EW + 256 * 1024;
constexpr size_t WS_SLOTOF = WS_EPOS + 256 * 1024;
constexpr size_t WS_TOK = 3 * MiB;
constexpr size_t WS_H = 4 * MiB;
constexpr size_t WS_U = 38 * MiB;
constexpr size_t WS_Q = 54 * MiB;
constexpr size_t WS_KALL = 86 * MiB;
constexpr size_t WS_VALL = 95 * MiB;
constexpr size_t WS_SGF = 104 * MiB;
constexpr size_t WS_SGA = 136 * MiB;
constexpr size_t WS_YA = 168 * MiB;
constexpr size_t WS_YF = 200 * MiB;
constexpr size_t WS_PR = 216 * MiB;
constexpr size_t WS_T1 = 248 * MiB;
constexpr size_t WS_YM = 312 * MiB;
constexpr size_t WS_QKRAW = 248 * MiB;
constexpr size_t WS_KCRAW = 330 * MiB;
constexpr size_t WS_H2 = 344 * MiB;
constexpr size_t WS_ACT = 376 * MiB;
constexpr size_t WS_YBIG = 4 * MiB;
constexpr size_t WS_END = 740 * MiB;

__device__ __forceinline__ float bf2f(bf16_t h) { return __uint_as_float(((unsigned)h) << 16); }
__device__ __forceinline__ bf16_t f2bf(float f) { unsigned u = __float_as_uint(f); return (bf16_t)((u + 0x7fffu + ((u >> 16) & 1u)) >> 16); }
__device__ __forceinline__ int crow(int r, int hi) { return (r & 3) + 8 * (r >> 2) + 4 * hi; }
__device__ __forceinline__ float wave_sum(float v) {
#pragma unroll
    for (int o = 1; o < 64; o <<= 1) v += __shfl_xor(v, o);
    return v;
}
__device__ __forceinline__ float sigmoidf_(float v) { return 1.0f / (1.0f + expf(-v)); }
__device__ __forceinline__ bf16x8 pack8(const float* f) {
    bf16x8 r;
#pragma unroll
    for (int i = 0; i < 8; ++i) r[i] = (short)f2bf(f[i]);
    return r;
}

#define LAS __attribute__((address_space(3)))
#define GAS __attribute__((address_space(1)))
typedef unsigned u32x4 __attribute__((ext_vector_type(4)));
typedef GAS unsigned gu32;
#define RLX_AGENT __ATOMIC_RELAXED, __HIP_MEMORY_SCOPE_AGENT
#define LDS_WAIT() asm volatile("s_waitcnt lgkmcnt(0)" ::: "memory")
#define VM_WAIT() asm volatile("s_waitcnt vmcnt(0)" ::: "memory")

constexpr size_t CTL_BAR = 16384;
constexpr size_t CTL_MODZ = 512 * 1024;
constexpr size_t WS_UT = 38 * MiB;
constexpr size_t WS_TT = 216 * MiB;
constexpr size_t WS_WT_GU = 450 * MiB;
constexpr size_t WS_WT_D = 710 * MiB;
constexpr size_t WS_WT_IN = 840 * MiB;
constexpr size_t WS_WT_FO = 872 * MiB;
constexpr size_t WS_WT_AO = 876 * MiB;
constexpr size_t WS_WT_O = 884 * MiB;
constexpr size_t WS_CST = 892 * MiB;
constexpr size_t WS_ET = 908 * MiB;
constexpr size_t WS_OT = 916 * MiB;
constexpr size_t WS_W2048 = 1 * MiB + 512 * 1024;
constexpr size_t WS_ALT = 1 * MiB + 520 * 1024;
constexpr size_t WS_RWT = 3 * MiB + 512 * 1024;
constexpr size_t WS_BD2 = 956 * MiB;
constexpr size_t WS_X2 = 960 * MiB;
constexpr size_t WS_END2 = 1024 * MiB;

namespace mk {
constexpr int NWAVES = 8, NTHREADS = 512;
constexpr int RING_BYTES = 131072, SCR_BYTES = 8 * 16640, LDSCTL_OFF = 135168, MISC_OFF = LDSCTL_OFF + 320, GPARK_OFF = LDSCTL_OFF + 2048  , LDS_BYTES = 147456;
static_assert(GPARK_OFF + 8192 <= LDS_BYTES, "LDS map");
static_assert(SCR_BYTES <= LDSCTL_OFF && MISC_OFF + 128 <= LDS_BYTES, "LDS map");

#define XB_TMO      128
#define XB_XCNT(j)  (256  + 64 * (j))
#define XB_XSUB(j)  (1280 + 64 * (j))
#define XB_XGEN(j)  (2304 + 64 * (j))
#define XB_TOP      3328
#define XB_TOPGEN   3392
#define XCD_BAR_WORDS 3456
#define XB_SPIN_CAP (1u << 18)
__device__ __forceinline__ unsigned xb_ld(unsigned* p)              { return __hip_atomic_load(p, __ATOMIC_RELAXED, __HIP_MEMORY_SCOPE_AGENT); }
__device__ __forceinline__ unsigned xb_add(unsigned* p, unsigned v) { return __hip_atomic_fetch_add(p, v, __ATOMIC_RELAXED, __HIP_MEMORY_SCOPE_AGENT); }
__device__ __forceinline__ unsigned xb_xcc_id() { return (unsigned)__builtin_amdgcn_s_getreg((3 << 11) | 20) & 0xFu; }
#define XB_SPIN(cond, bar) do { unsigned _sp = 0; while (cond) { __builtin_amdgcn_s_sleep(1); \
    if ((++_sp & 255u) == 0u) { if (xb_ld(&(bar)[XB_TMO])) break; if (_sp > XB_SPIN_CAP) { atomicAdd(&(bar)[XB_TMO], 1u); break; } } } } while (0)
struct XcdBarrier { unsigned* bar; unsigned x; volatile LAS unsigned* st; };
__device__ __forceinline__ XcdBarrier xcd_barrier_post(unsigned* bar, volatile LAS unsigned* st) {
    XcdBarrier b; b.bar = bar; b.x = xb_xcc_id(); b.st = st;
    if (threadIdx.x == 0) (void)xb_add(&bar[XB_XCNT(b.x)], 1u);
    return b;
}
__device__ __forceinline__ void xcd_barrier_complete(unsigned* bar, unsigned x, unsigned& nloc, unsigned& nx) {
    const unsigned G = gridDim.x * gridDim.y * gridDim.z;
    unsigned sum, cnt, mine, sp = 0u;
    for (;;) {
        sum = 0u; cnt = 0u; mine = 0u;
#pragma unroll
        for (unsigned j = 0; j < 16; ++j) { const unsigned c = xb_ld(&bar[XB_XCNT(j)]); sum += c; cnt += (c > 0u) ? 1u : 0u; mine = (j == x) ? c : mine; }
        if (sum == G) break;
        __builtin_amdgcn_s_sleep(1);
        if ((++sp & 255u) == 0u) { if (xb_ld(&bar[XB_TMO])) break; if (sp > XB_SPIN_CAP) { atomicAdd(&bar[XB_TMO], 1u); break; } }
    }
    nloc = mine > 0u ? mine : 1u; nx = cnt > 0u ? cnt : 1u;
}
__device__ __forceinline__ void xcd_barrier(const XcdBarrier& b) {
    asm volatile("s_waitcnt vmcnt(0)" ::: "memory");
    __syncthreads();
    if (threadIdx.x == 0) {
        unsigned* bar = b.bar;
        __builtin_amdgcn_s_waitcnt(0);
        unsigned nloc = b.st[0], nx = b.st[1];
        if (nloc == 0u) { xcd_barrier_complete(bar, b.x, nloc, nx); b.st[0] = nloc; b.st[1] = nx; }
        const unsigned old = xb_add(&bar[XB_XSUB(b.x)], 1u);
        const unsigned gen = old / nloc;
        if (old + 1u == (gen + 1u) * nloc) {
            __builtin_amdgcn_fence(__ATOMIC_RELEASE, "agent");
            asm volatile("s_waitcnt vmcnt(0)" ::: "memory");
            const unsigned og = xb_add(&bar[XB_TOP], 1u);
            const unsigned tg = og / nx;
            if (og + 1u == (tg + 1u) * nx) xb_add(&bar[XB_TOPGEN], 1u);
            else XB_SPIN(xb_ld(&bar[XB_TOPGEN]) == tg, bar);
            __builtin_amdgcn_fence(__ATOMIC_ACQUIRE, "agent");
            xb_add(&bar[XB_XGEN(b.x)], 1u);
            asm volatile("s_waitcnt vmcnt(0)" ::: "memory");
        } else {
            XB_SPIN(xb_ld(&bar[XB_XGEN(b.x)]) == gen, bar);
            __builtin_amdgcn_fence(__ATOMIC_ACQUIRE, "agent");
            asm volatile("s_waitcnt vmcnt(0)" ::: "memory");
        }
    }
    __syncthreads();
}

constexpr int BM = 256, BK = 64, HALF = 128, HTB = HALF * BK * 2, STAGE_BYTES = 8 * HTB;
__device__ __forceinline__ int lds_byte(int r, int c) { const int st = (r >> 4) * 2 + (c >> 5), rr = r & 15, cc = c & 31, ob = rr * 64 + cc * 2; return st * 1024 + (ob ^ (((ob >> 9) & 1) << 5)); }
__device__ __forceinline__ void stage_rc(int b, int& R, int& C) { const int st = b / 1024, sb = b % 1024, swz = sb ^ (((sb >> 9) & 1) << 5); R = (st >> 1) * 16 + swz / 64; C = (st & 1) * 32 + (swz % 64) / 2; }
__device__ __forceinline__ int perm32(int rho) { const int n = rho >> 4, i = rho & 15; return 8 * (i >> 2) + 4 * n + (i & 3); }
__device__ __forceinline__ unsigned cvt_pk_bf16(float lo, float hi) { unsigned r; asm("v_cvt_pk_bf16_f32 %0, %1, %2" : "=v"(r) : "v"(lo), "v"(hi)); return r; }

__device__ __forceinline__ void glds16_s(const void* sbase, unsigned voff, unsigned lds_dst) { unsigned keep;
    asm volatile("s_mov_b32 %0, m0\n\ts_mov_b32 m0, %3\n\ts_nop 0\n\tglobal_load_lds_dwordx4 %1, %2\n\ts_mov_b32 m0, %0" : "=&s"(keep) : "v"(voff), "s"(sbase), "s"(lds_dst) : "memory"); }

struct Unit { const char* A; const char* B; char* C; int ldc; int mode; int rows; int aux; int pm, pn, bjs, rmin; };

template <class Epi, class Sched, bool GATHER>
__device__ __forceinline__ void gemm_phase(LAS unsigned char* lds, const int K, const int lda, const int ldb, const Sched& S, const Epi& E, const int i0 = 0, const int i1 = 0x7fffffff) {
    const int tid = threadIdx.x, wid = __builtin_amdgcn_readfirstlane(tid >> 6), lane = tid & 63, wr = wid >> 2, wc = wid & 3, fr = lane & 15, fq = lane >> 4;
    const int nt = K / BK;
    unsigned voffA[2], voffB[2];
#pragma unroll
    for (int i = 0; i < 2; ++i) { int R, C; stage_rc(tid * 16 + i * 8192, R, C); const int Rb = (R & ~31) + perm32(R & 31);
        voffA[i] = (unsigned)(R * lda + C) * 2u; voffB[i] = (unsigned)(Rb * ldb + C) * 2u; }
    const size_t kstep = (size_t)(BK * 2);
    const size_t hstepA = (size_t)HALF * lda * 2, hstepB = (size_t)HALF * ldb * 2;
    const unsigned ldsw = (unsigned)wid * 1024u;
    const unsigned ldsbase = (unsigned)__builtin_amdgcn_readfirstlane((int)(unsigned)(uintptr_t)lds);
    const int aoff = lds_byte(wr * 64 + fr, fq * 8), boff = lds_byte(wc * 32 + fr, fq * 8);
#define MK_SA(b, h) (((b) * 2 + (h)) * HTB)
#define MK_SB(b, h) ((4 + (b) * 2 + (h)) * HTB)
#define MK_STAGE2(bufoff, gbase, v0, v1) do { \
        __builtin_amdgcn_global_load_lds((const unsigned*)((const char*)(gbase) + (v0)), (LAS unsigned*)(lds + (bufoff) + ldsw), 16, 0, 0); \
        __builtin_amdgcn_global_load_lds((const unsigned*)((const char*)(gbase) + (v1)), (LAS unsigned*)(lds + (bufoff) + ldsw + 8192), 16, 0, 0); } while (0)
#define MK_STAGE_B(bufoff, gbase) do { glds16_s((gbase), voffB[0], ldsbase + (bufoff) + ldsw); glds16_s((gbase), voffB[1], ldsbase + (bufoff) + ldsw + 8192u); } while (0)
#define MK_STAGE_A(bufoff, gbase, h, VA) do { if constexpr (GATHER) { glds16_s((gbase), (VA)[h][0], ldsbase + (bufoff) + ldsw); glds16_s((gbase), (VA)[h][1], ldsbase + (bufoff) + ldsw + 8192u); } \
        else { glds16_s((gbase) + (h) * hstepA, voffA[0], ldsbase + (bufoff) + ldsw); glds16_s((gbase) + (h) * hstepA, voffA[1], ldsbase + (bufoff) + ldsw + 8192u); } } while (0)
#define MK_LDA(dst, b, h) do { _Pragma("unroll") for (int m = 0; m < 4; ++m) _Pragma("unroll") for (int k = 0; k < 2; ++k) dst[m][k] = *(const LAS bf16x8*)(lds + MK_SA(b, h) + aoff + m * 2048 + k * 1024); } while (0)
#define MK_LDB(dst, b, h) do { _Pragma("unroll") for (int n = 0; n < 2; ++n) _Pragma("unroll") for (int k = 0; k < 2; ++k) dst[n][k] = *(const LAS bf16x8*)(lds + MK_SB(b, h) + boff + n * 2048 + k * 1024); } while (0)
#define MK_MMA(ai, bj, At, Bt) do { __builtin_amdgcn_s_setprio(1); _Pragma("unroll") for (int m = 0; m < 4; ++m) _Pragma("unroll") for (int n = 0; n < 2; ++n) _Pragma("unroll") for (int k = 0; k < 2; ++k) \
        acc[ai][bj][m][n] = __builtin_amdgcn_mfma_f32_16x16x32_bf16(Bt[n][k], At[m][k], acc[ai][bj][m][n], 0, 0, 0); __builtin_amdgcn_s_setprio(0); } while (0)
#define MK_WAIT_V(n) asm volatile("s_waitcnt vmcnt(" #n ")" ::: "memory")
#define MK_WAIT_L(n) asm volatile("s_waitcnt lgkmcnt(" #n ")" ::: "memory")
#define MK_BAR __builtin_amdgcn_s_barrier()
#define MK_SCHED __builtin_amdgcn_sched_barrier(0)
    Unit cur, nxt; int ui = i0;
    if (i0 >= i1 || !S.next(i0, cur)) return;
    f32x4 acc[2][2][4][2];
#pragma unroll
    for (int a = 0; a < 2; ++a)
#pragma unroll
        for (int b = 0; b < 2; ++b)
#pragma unroll
            for (int m = 0; m < 4; ++m)
#pragma unroll
                for (int n = 0; n < 2; ++n) acc[a][b][m][n] = (f32x4){0.f, 0.f, 0.f, 0.f};
    bf16x8 At[4][2], B0[2][2], B1[2][2];
    unsigned vC[2][2];
    LAS u32x4* vpark = (LAS u32x4*)(lds + GPARK_OFF) + tid;
    if constexpr (GATHER) {
#pragma unroll
        for (int h = 0; h < 2; ++h)
#pragma unroll
            for (int i = 0; i < 2; ++i) { int R, C; stage_rc(tid * 16 + i * 8192, R, C); vC[h][i] = S.arow(cur, h * HALF + R) + (unsigned)(C * 2); }
    }
    const char* cA = cur.A; const char* cB = cur.B;
    MK_STAGE_B(MK_SB(0, 0), cB); MK_STAGE_B(MK_SB(0, 1), cB + hstepB); MK_STAGE_A(MK_SA(0, 0), cA, 0, vC); MK_STAGE_A(MK_SA(0, 1), cA, 1, vC);
    if (wr == 1) MK_BAR;
    MK_WAIT_V(2); MK_BAR;
    MK_STAGE_B(MK_SB(1, 0), cB + kstep); MK_STAGE_A(MK_SA(1, 0), cA + kstep, 0, vC); MK_STAGE_B(MK_SB(1, 1), cB + hstepB + kstep);
    MK_WAIT_V(6); MK_BAR;
    for (;;) {
        const bool has_next = (ui + 1 < i1) && S.next(ui + 1, nxt);
        const char* nA = has_next ? nxt.A : cA; const char* nB = has_next ? nxt.B : cB;
        if constexpr (GATHER) {
            u32x4 pv;
#pragma unroll
            for (int h = 0; h < 2; ++h)
#pragma unroll
                for (int i = 0; i < 2; ++i) { int R, C; stage_rc(tid * 16 + i * 8192, R, C); pv[h * 2 + i] = has_next ? (S.arow(nxt, h * HALF + R) + (unsigned)(C * 2)) : vC[h][i]; }
            *vpark = pv;
        }
        for (int t = 0; t < nt; t += 2) {
            const bool last = (t == nt - 2);
            const char* a1 = cA + (size_t)(t + 1) * kstep;
            const char* a2 = last ? nA : cA + (size_t)(t + 2) * kstep; const char* b2 = last ? nB : cB + (size_t)(t + 2) * kstep;
            const char* a3 = a2 + kstep; const char* b3 = b2 + kstep;
            MK_LDB(B0, 0, 0); MK_LDB(B1, 0, 1); MK_SCHED; MK_LDA(At, 0, 0); MK_STAGE_A(MK_SA(1, 1), a1, 1, vC);
            if constexpr (GATHER) { if (last) { const u32x4 pv = *vpark; vC[0][0] = pv[0]; vC[0][1] = pv[1]; vC[1][0] = pv[2]; vC[1][1] = pv[3]; } }
            MK_WAIT_V(8); MK_WAIT_L(0); MK_BAR; MK_MMA(0, 0, At, B0); MK_MMA(0, 1, At, B1); MK_BAR; MK_SCHED;
            MK_LDA(At, 0, 1); MK_STAGE_B(MK_SB(0, 0), b2); MK_STAGE_B(MK_SB(0, 1), b2 + hstepB); MK_STAGE_A(MK_SA(0, 0), a2, 0, vC);
            MK_WAIT_V(8); MK_WAIT_L(0); MK_BAR; MK_MMA(1, 0, At, B0); MK_MMA(1, 1, At, B1); MK_BAR; MK_SCHED;
            MK_LDB(B0, 1, 0); MK_LDB(B1, 1, 1); MK_SCHED; MK_LDA(At, 1, 0); MK_STAGE_A(MK_SA(0, 1), a2, 1, vC);
            MK_WAIT_V(8); MK_WAIT_L(0); MK_BAR; MK_MMA(0, 0, At, B0); MK_MMA(0, 1, At, B1); MK_BAR; MK_SCHED;
            MK_LDA(At, 1, 1); MK_STAGE_B(MK_SB(1, 0), b3); MK_STAGE_B(MK_SB(1, 1), b3 + hstepB); MK_STAGE_A(MK_SA(1, 0), a3, 0, vC);
            MK_WAIT_V(8); MK_WAIT_L(0); MK_BAR; MK_MMA(1, 0, At, B0); MK_MMA(1, 1, At, B1); MK_BAR; MK_SCHED;
        }
        if (wr == 0) MK_BAR;
        E(acc, cur, wr, wc, fr, fq);
        if (!has_next) break;
#pragma unroll
        for (int a = 0; a < 2; ++a)
#pragma unroll
            for (int b = 0; b < 2; ++b)
#pragma unroll
                for (int m = 0; m < 4; ++m)
#pragma unroll
                    for (int n = 0; n < 2; ++n) acc[a][b][m][n] = (f32x4){0.f, 0.f, 0.f, 0.f};
        cur = nxt; cA = nA; cB = nB; ++ui;
        if (wr == 1) MK_BAR;
    }
    MK_WAIT_V(0);
    MK_BAR;
#undef MK_SA
#undef MK_SB
#undef MK_STAGE2
#undef MK_STAGE_B
#undef MK_STAGE_A
#undef MK_LDA
#undef MK_LDB
#undef MK_MMA
#undef MK_WAIT_V
#undef MK_WAIT_L
#undef MK_BAR
#undef MK_SCHED
}

__device__ __forceinline__ void grid_map(int L, int nM, int nN, int& pm, int& pn) {
    const int nwg = nM * nN, q = nwg / 8, xcd = L % 8, off = L / 8; const int wgid = xcd * q + off;
    const int nig = 8 * nN, gid = wgid / nig, fm = gid * 8, gsz = (nM - fm) < 8 ? (nM - fm) : 8;
    pm = fm + ((wgid % nig) % gsz); pn = (wgid % nig) / gsz;
}

struct EpiStore {
    const float* w2048;
    __device__ __forceinline__ void operator()(const f32x4 (&acc)[2][2][4][2], const Unit& u, int wr, int wc, int fr, int fq) const {
        const int col0 = wc * 32 + 8 * fq;
#pragma unroll
        for (int ai = 0; ai < 2; ++ai)
#pragma unroll
            for (int m = 0; m < 4; ++m) {
                const int r = ai * HALF + wr * 64 + m * 16 + fr;
                if (r < u.rows && r >= u.rmin) {
#pragma unroll
                    for (int bj = 0; bj < 2; ++bj) {
                        f32x4 v0 = acc[ai][bj][m][0], v1 = acc[ai][bj][m][1];
                        if (u.mode == 1) { float* p = (float*)u.C + (long)r * u.ldc + col0 + bj * u.bjs; *(f32x4*)p = v0; *(f32x4*)(p + 4) = v1; }
                        else {
                            if (u.mode == 2) {
#pragma unroll
                                for (int c = 0; c < 4; ++c) { v0[c] = __builtin_amdgcn_rcpf(1.0f + __expf(-v0[c])); v1[c] = __builtin_amdgcn_rcpf(1.0f + __expf(-v1[c])); }
                            } else if (u.mode == 3) {
                                const float* wp = w2048 + u.pn + bj * HALF + col0; const float sg = (r & 1) ? -1.0f : 1.0f;
                                v0 += *(const f32x4*)wp * sg; v1 += *(const f32x4*)(wp + 4) * sg;
                            }
                            u32x4 w; w.x = cvt_pk_bf16(v0[0], v0[1]); w.y = cvt_pk_bf16(v0[2], v0[3]); w.z = cvt_pk_bf16(v1[0], v1[1]); w.w = cvt_pk_bf16(v1[2], v1[3]);
                            *(u32x4*)((bf16_t*)u.C + (long)r * u.ldc + col0 + bj * u.bjs) = w;
                        }
                    }
                }
            }
    }
};

struct Args { const float* in[22]; float* out; unsigned char* ws; int ph_lo, ph_hi, use_ut, mod_off, do_attn, bar_idx; };
struct Frame {
    LAS unsigned char* lds; volatile LAS unsigned* MISC; unsigned char* ws;
    int tid, lane, wave, vcu, G;
};

__device__ __forceinline__ void t64_load(f32x4 (&v)[16], const float* W, int ldw, int lane) {
    const unsigned off = (unsigned)(((lane >> 4) * ldw + (lane & 15) * 4) * 4);
#pragma unroll
    for (int j = 0; j < 16; ++j) { const char* bj = (const char*)W + (size_t)(j * 4) * ldw * 4; v[j] = __builtin_nontemporal_load((const GAS f32x4*)(bj + off)); }
}
__device__ __forceinline__ void t64_store(const f32x4 (&v)[16], bf16_t* dst, int ldd, LAS float* scr, int lane) {
    const int kk = lane >> 4, nc = (lane & 15) * 4;
#pragma unroll
    for (int j = 0; j < 16; ++j) {
#pragma unroll
        for (int c = 0; c < 4; ++c) scr[(j * 4 + kk) * 65 + nc + c] = v[j][c]; }
    LDS_WAIT(); asm volatile("" ::: "memory");
    const int kc = lane & 7; const unsigned soff = (unsigned)(((lane >> 3) * ldd + 8 * kc) * 2);
#pragma unroll
    for (int jj = 0; jj < 8; jj += 2) {
        float t[2][8];
#pragma unroll
        for (int q = 0; q < 2; ++q) { const int n = (lane >> 3) + 8 * (jj + q); const LAS float* s = scr + (8 * kc) * 65 + n;
#pragma unroll
            for (int i = 0; i < 8; ++i) t[q][i] = s[i * 65]; }
#pragma unroll
        for (int q = 0; q < 2; ++q) { char* bq = (char*)dst + (size_t)(8 * (jj + q)) * ldd * 2;
            u32x4 o; o.x = cvt_pk_bf16(t[q][0], t[q][1]); o.y = cvt_pk_bf16(t[q][2], t[q][3]); o.z = cvt_pk_bf16(t[q][4], t[q][5]); o.w = cvt_pk_bf16(t[q][6], t[q][7]);
            __builtin_nontemporal_store(o, (GAS u32x4*)(bq + soff)); } }
    LDS_WAIT(); asm volatile("" ::: "memory");
}
__device__ __forceinline__ void transpose64(const float* W, int ldw, bf16_t* dst, int ldd, LAS float* scr, int lane) {
    f32x4 v[16]; t64_load(v, W, ldw, lane); t64_store(v, dst, ldd, scr, lane);
}

constexpr int IT_IN = 32 * 128, IT_FO = 16 * 32, IT_AO = 32 * 32, IT_O = 32 * 32, IT_EG = 64 * 256, IT_EU = 64 * 256, IT_ED = 64 * 256, IT_SH = 256;
constexpr int IT_T_END = IT_IN + IT_FO + IT_AO + IT_O + 3 * IT_SH;
constexpr int IT_MOD = MODC / 32, IT_CST = 4096, IT_BD2 = 512, IT_RWT = 32;
constexpr int IT_ALL = IT_T_END + IT_MOD + IT_CST + IT_BD2 + IT_RWT;

__device__ __forceinline__ void mod_item(const Args& args, unsigned char* ws, int r, int lane) {
            const int kq = lane >> 3, col = r * 32 + (lane & 7) * 4;
            f32x4 a0 = {0.f, 0.f, 0.f, 0.f}, a1 = a0, a2 = a0;
            for (int jb = 0; jb < 256; jb += 8) {
                f32x4 w[8]; float c0[8], c1[8], c2[8];
#pragma unroll
                for (int j = 0; j < 8; ++j) { const int k = kq + 8 * (jb + j); w[j] = *(const GAS f32x4*)(args.in[4] + (size_t)k * MODC + col); c0[j] = args.in[1][k]; c1[j] = args.in[1][DM + k]; c2[j] = args.in[3][k]; }
#pragma unroll
                for (int j = 0; j < 8; ++j) { a0 += w[j] * (c0[j] * __builtin_amdgcn_rcpf(1.0f + __expf(-c0[j]))); a1 += w[j] * (c1[j] * __builtin_amdgcn_rcpf(1.0f + __expf(-c1[j]))); a2 += w[j] * (c2[j] * __builtin_amdgcn_rcpf(1.0f + __expf(-c2[j]))); }
            }
#pragma unroll
            for (int c = 0; c < 4; ++c) {
#pragma unroll
                for (int o = 8; o < 64; o <<= 1) { a0[c] += __shfl_xor(a0[c], o); a1[c] += __shfl_xor(a1[c], o); a2[c] += __shfl_xor(a2[c], o); } }
            if (kq == 0) { const f32x4 bb = *(const GAS f32x4*)(args.in[5] + col); float* MODP = (float*)(ws + WS_MOD);
                *(GAS f32x4*)(MODP + col) = a0 + bb; *(GAS f32x4*)(MODP + MODC + col) = a1 + bb; *(GAS f32x4*)(MODP + 2 * MODC + col) = a2 + bb; }
}
__device__ __forceinline__ void p0_prologue(Frame& F, const Args& args) {
    LAS float* scr = (LAS float*)(F.lds + F.wave * 16640);
    const int gw = F.vcu * NWAVES + F.wave, NGW = F.G * NWAVES, lane = F.lane;
    unsigned char* ws = F.ws;
    bf16_t* WT_IN = (bf16_t*)(ws + WS_WT_IN); bf16_t* WT_FO = (bf16_t*)(ws + WS_WT_FO); bf16_t* WT_AO = (bf16_t*)(ws + WS_WT_AO); bf16_t* WT_O = (bf16_t*)(ws + WS_WT_O);
    bf16_t* WT_GU = (bf16_t*)(ws + WS_WT_GU); bf16_t* WT_D = (bf16_t*)(ws + WS_WT_D);
    if (NGW >= 5 * IT_MOD) { if (gw % 5 == 0 && gw / 5 < IT_MOD) mod_item(args, ws, gw / 5, lane); }
    else for (int m = gw; m < IT_MOD; m += NGW) mod_item(args, ws, m, lane);
    for (int it = gw; it < IT_ALL - IT_MOD; it += NGW) {
        int r = it;
        if (r < IT_IN) { const int kb = r / 128, nb = r % 128; transpose64(args.in[7] + (size_t)(kb * 64) * INC + nb * 64, INC, WT_IN + (size_t)(nb * 64) * DM + kb * 64, DM, scr, lane); continue; } r -= IT_IN;
        if (r < IT_FO) { const int kb = r / 32, nb = r % 32; transpose64(args.in[10] + (size_t)(kb * 64) * DM + nb * 64, DM, WT_FO + (size_t)(nb * 64) * FW + kb * 64, FW, scr, lane); continue; } r -= IT_FO;
        if (r < IT_AO) { const int kb = r / 32, nb = r % 32; transpose64(args.in[11] + (size_t)(kb * 64) * DM + nb * 64, DM, WT_AO + (size_t)(nb * 64) * DM + kb * 64, DM, scr, lane); continue; } r -= IT_AO;
        if (r < IT_O) { const int kb = r / 32, nb = r % 32; transpose64(args.in[12] + (size_t)(kb * 64) * DM + nb * 64, DM, WT_O + (size_t)(nb * 64) * DM + kb * 64, DM, scr, lane); continue; } r -= IT_O;
        if (r < 2 * IT_SH) { const int up = r >= IT_SH; if (up) r -= IT_SH; const int kb = r / 8, nb = r % 8, n0 = nb * 64;
            transpose64((up ? args.in[20] : args.in[19]) + (size_t)(kb * 64) * EFF + n0, EFF, WT_GU + ((size_t)64 * 1024 + (n0 >> 7) * 256 + (up ? 128 : 0) + (n0 & 127)) * DM + kb * 64, DM, scr, lane); continue; } r -= 2 * IT_SH;
        if (r < IT_SH) { const int kb = r / 32, nb = r % 32;
            transpose64(args.in[21] + (size_t)(kb * 64) * DM + nb * 64, DM, WT_D + ((size_t)64 * DM + nb * 64) * EFF + kb * 64, EFF, scr, lane); continue; } r -= IT_SH;

        if (r < IT_CST) {
            const int k1 = r & 2047; bf16_t* dst = (bf16_t*)(ws + WS_CST) + (size_t)r * 2048;
#pragma unroll
            for (int j = 0; j < 4; ++j) { const int n0 = j * 512 + lane * 8; float f[8];
#pragma unroll
                for (int i = 0; i < 8; ++i) { const float ph = (float)((k1 * (n0 + i)) & 4095) * (1.0f / 2048.0f); f[i] = r < 2048 ? cospif(ph) : sinpif(ph); }
                u32x4 o; o.x = cvt_pk_bf16(f[0], f[1]); o.y = cvt_pk_bf16(f[2], f[3]); o.z = cvt_pk_bf16(f[4], f[5]); o.w = cvt_pk_bf16(f[6], f[7]);
                *(GAS u32x4*)(dst + n0) = o; }
            continue; } r -= IT_CST;
        if (r < IT_BD2) {
            const int t = r >> 8, o = r & 255, gp = o >> 7, k2 = o & 127; bf16_t* dst = (bf16_t*)(ws + WS_BD2) + (size_t)r * 512; float f[8];
#pragma unroll
            for (int i = 0; i < 8; ++i) { const int j = lane * 8 + i, cg = j >> 8, jj = j & 255, c = jj & 127; const float ph = (float)((32 * c * k2) & 4095) * (1.0f / 2048.0f);
                const float v = jj < 128 ? cospif(ph) : (t ? sinpif(ph) : -sinpif(ph)); f[i] = cg == gp ? v * 0.0013810679320049757f : 0.f; }
            u32x4 w; w.x = cvt_pk_bf16(f[0], f[1]); w.y = cvt_pk_bf16(f[2], f[3]); w.z = cvt_pk_bf16(f[4], f[5]); w.w = cvt_pk_bf16(f[6], f[7]);
            *(GAS u32x4*)(dst + lane * 8) = w;
            continue; } r -= IT_BD2;
        {
            f32x4 v[16]; t64_load(v, args.in[14] + (size_t)(r * 64) * NE, NE, lane);
            const int kk = lane >> 4, nc = (lane & 15) * 4;
#pragma unroll
            for (int j = 0; j < 16; ++j) {
#pragma unroll
                for (int c = 0; c < 4; ++c) scr[(j * 4 + kk) * 65 + nc + c] = v[j][c]; }
            LDS_WAIT(); asm volatile("" ::: "memory");
            const int kc = lane & 7; bf16_t* RWT = (bf16_t*)(ws + WS_RWT);
#pragma unroll
            for (int jj = 0; jj < 8; ++jj) { const int e = (lane >> 3) + 8 * jj; const LAS float* s = scr + (8 * kc) * 65 + e; float t[8], l[8];
#pragma unroll
                for (int i = 0; i < 8; ++i) { t[i] = s[i * 65]; l[i] = t[i] - bf2f(f2bf(t[i])); }
                u32x4 h, lo; h.x = cvt_pk_bf16(t[0], t[1]); h.y = cvt_pk_bf16(t[2], t[3]); h.z = cvt_pk_bf16(t[4], t[5]); h.w = cvt_pk_bf16(t[6], t[7]);
                lo.x = cvt_pk_bf16(l[0], l[1]); lo.y = cvt_pk_bf16(l[2], l[3]); lo.z = cvt_pk_bf16(l[4], l[5]); lo.w = cvt_pk_bf16(l[6], l[7]);
                *(GAS u32x4*)(RWT + (size_t)e * DM + r * 64 + 8 * kc) = h; *(GAS u32x4*)(RWT + (size_t)(NE + e) * DM + r * 64 + 8 * kc) = lo; }
            LDS_WAIT(); asm volatile("" ::: "memory");
        }
    }
}


__device__ __forceinline__ void conv_addr(const Args& args, unsigned char* ws, bool down, int it, const float*& W, int& ldw, bf16_t*& dst, int& ldd) {
    if (!down) { int r = it; const int up = r >= IT_EG; if (up) r -= IT_EG;
        const int e = r / 256, q = r % 256, kb = q / 8, nb = q % 8, n0 = nb * 64;
        W = (up ? args.in[17] : args.in[16]) + (size_t)e * DM * EFF + (size_t)(kb * 64) * EFF + n0; ldw = EFF;
        dst = (bf16_t*)(ws + WS_WT_GU) + ((size_t)e * 1024 + (n0 >> 7) * 256 + (up ? 128 : 0) + (n0 & 127)) * DM + kb * 64; ldd = DM;
    } else { const int r = it, e = r / 256, q = r % 256, kb = q / 32, nb = q % 32;
        W = args.in[18] + (size_t)e * EFF * DM + (size_t)(kb * 64) * DM + nb * 64; ldw = DM;
        dst = (bf16_t*)(ws + WS_WT_D) + ((size_t)e * DM + nb * 64) * EFF + kb * 64; ldd = EFF; }
}
__device__ __forceinline__ void conv_items(Frame& F, const Args& args, bool down, int first, int count) {
    LAS float* scr = (LAS float*)(F.lds + F.wave * 16640);
    const int end = first + count; int it = first + F.wave;
    if (it >= end) return;
    f32x4 va[16], vb[16]; const float* W; int ldw; bf16_t* da; bf16_t* db; int ldd;
    conv_addr(args, F.ws, down, it, W, ldw, da, ldd); t64_load(va, W, ldw, F.lane);
    for (;;) {
        const bool hb = it + NWAVES < end;
        if (hb) { conv_addr(args, F.ws, down, it + NWAVES, W, ldw, db, ldd); t64_load(vb, W, ldw, F.lane); }
        t64_store(va, da, ldd, scr, F.lane);
        if (!hb) break;
        const bool ha = it + 2 * NWAVES < end;
        if (ha) { conv_addr(args, F.ws, down, it + 2 * NWAVES, W, ldw, da, ldd); t64_load(va, W, ldw, F.lane); }
        t64_store(vb, db, ldd, scr, F.lane);
        if (!ha) break;
        it += 2 * NWAVES;
    }
}
struct SchedIn {
    int G, c; unsigned char* ws; int use_ut;
    __device__ __forceinline__ bool next(int i, Unit& u) const {
        const int L = i * G + c; if (L >= 904) return false;
        const char* H = (const char*)(ws + WS_H); const char* WT = (const char*)(ws + WS_WT_IN);
        u.rows = 256; u.aux = 0; u.bjs = HALF; u.pm = 0; u.pn = 0; u.rmin = 0;
        if (L < 896) {
            int pm, ct; grid_map(L, 32, 28, pm, ct);
            const int row0 = pm * 256, b = row0 / SEQ, t0 = row0 % SEQ;
            u.A = H + (size_t)row0 * DM * 2; u.B = WT + (size_t)ct * 256 * DM * 2;
            if (ct < 4) {
                if (use_ut) { u.A = WT + (size_t)ct * 256 * DM * 2; u.B = H + (size_t)row0 * DM * 2;
                              u.C = (char*)(ws + WS_UT) + (((size_t)b * FW + ct * 256) * SEQ + t0) * 2; u.ldc = SEQ; u.mode = 0; }
                else { u.C = (char*)(ws + WS_U) + ((size_t)row0 * FW + ct * 256) * 2; u.ldc = FW; u.mode = 0; }
            }
            else if (ct < 14) { u.C = (char*)(ws + WS_QKRAW) + ((size_t)row0 * 2560 + (ct - 4) * 256) * 4; u.ldc = 2560; u.mode = 1; }
            else if (ct < 16) { u.C = (char*)(ws + WS_VALL) + (((size_t)b * SKV + t0) * KVW + (ct - 14) * 256) * 2; u.ldc = KVW; u.mode = 0; }
            else if (ct < 24) { u.C = (char*)(ws + WS_SGF) + ((size_t)row0 * DM + (ct - 16) * 256) * 2; u.ldc = DM; u.mode = 2; }
            else              { u.C = (char*)(ws + WS_SGA) + ((size_t)row0 * DM + (ct - 24) * 256) * 2; u.ldc = DM; u.mode = 2; }
        } else {
            const int l = L - 896, pm = l & 1, ct = l >> 1;
            u.A = H + (size_t)(NTOK + pm * 256) * DM * 2; u.B = WT + (size_t)(K_OFF + ct * 256) * DM * 2;
            if (ct < 2) { u.C = (char*)(ws + WS_KCRAW) + ((size_t)(pm * 256) * KVW + ct * 256) * 4; u.ldc = KVW; u.mode = 1; }
            else        { u.C = (char*)(ws + WS_VALL) + (((size_t)pm * SKV + SEQ) * KVW + (ct - 2) * 256) * 2; u.ldc = KVW; u.mode = 0; }
        }
        return true;
    }
    __device__ __forceinline__ unsigned arow(const Unit&, int) const { return 0u; }
};


__device__ __forceinline__ void unpack8(u32x4 w, float (&f)[8]) {
#pragma unroll
    for (int i = 0; i < 4; ++i) { f[2 * i] = __uint_as_float(w[i] << 16); f[2 * i + 1] = __uint_as_float(w[i] & 0xffff0000u); }
}
struct EpiT1 { const bf16_t* SGF; float* T1;
    __device__ __forceinline__ void operator()(const f32x4 (&acc)[2][2][4][2], const Unit& u, int wr, int wc, int fr, int fq) const {
#pragma unroll
        for (int ai = 0; ai < 2; ++ai)
#pragma unroll
            for (int m = 0; m < 4; ++m) { const size_t row = (size_t)u.pm * 256 + ai * HALF + wr * 64 + m * 16 + fr;
#pragma unroll
                for (int bj = 0; bj < 2; ++bj) { const size_t o = row * DM + u.pn * 256 + bj * HALF + wc * 32 + 8 * fq;
                    float g[8]; unpack8(*(const u32x4*)(SGF + o), g); const f32x4 v0 = acc[ai][bj][m][0], v1 = acc[ai][bj][m][1];
                    *(f32x4*)(T1 + o) = (f32x4){g[0] * v0[0], g[1] * v0[1], g[2] * v0[2], g[3] * v0[3]};
                    *(f32x4*)(T1 + o + 4) = (f32x4){g[4] * v1[0], g[5] * v1[1], g[6] * v1[2], g[7] * v1[3]}; } }
    } };
struct EpiYM { const bf16_t* SGA; const float* T1; bf16_t* YM;
    __device__ __forceinline__ void operator()(const f32x4 (&acc)[2][2][4][2], const Unit& u, int wr, int wc, int fr, int fq) const {
#pragma unroll
        for (int ai = 0; ai < 2; ++ai)
#pragma unroll
            for (int m = 0; m < 4; ++m) { const size_t row = (size_t)u.pm * 256 + ai * HALF + wr * 64 + m * 16 + fr;
#pragma unroll
                for (int bj = 0; bj < 2; ++bj) { const size_t o = row * DM + u.pn * 256 + bj * HALF + wc * 32 + 8 * fq;
                    float g[8]; unpack8(*(const u32x4*)(SGA + o), g); const f32x4 v0 = acc[ai][bj][m][0], v1 = acc[ai][bj][m][1];
                    const f32x4 t0 = *(const f32x4*)(T1 + o), t1 = *(const f32x4*)(T1 + o + 4);
                    u32x4 w; w.x = cvt_pk_bf16(t0[0] + g[0] * v0[0], t0[1] + g[1] * v0[1]); w.y = cvt_pk_bf16(t0[2] + g[2] * v0[2], t0[3] + g[3] * v0[3]);
                    w.z = cvt_pk_bf16(t1[0] + g[4] * v1[0], t1[1] + g[5] * v1[1]); w.w = cvt_pk_bf16(t1[2] + g[6] * v1[2], t1[3] + g[7] * v1[3]);
                    *(u32x4*)(YM + o) = w; } }
    } };
struct EpiX2 { const float* x; const float* mod; float* X2;
    __device__ __forceinline__ void operator()(const f32x4 (&acc)[2][2][4][2], const Unit& u, int wr, int wc, int fr, int fq) const {
        const float* g1 = mod + ((u.pm * 256) / SEQ) * MODC + 2 * DM;
#pragma unroll
        for (int ai = 0; ai < 2; ++ai)
#pragma unroll
            for (int m = 0; m < 4; ++m) { const size_t row = (size_t)u.pm * 256 + ai * HALF + wr * 64 + m * 16 + fr;
#pragma unroll
                for (int bj = 0; bj < 2; ++bj) { const int col = u.pn * 256 + bj * HALF + wc * 32 + 8 * fq; const size_t o = row * DM + col;
#pragma unroll
                    for (int n = 0; n < 2; ++n) { const f32x4 xv = *(const f32x4*)(x + o + 4 * n), gv = *(const f32x4*)(g1 + col + 4 * n); *(f32x4*)(X2 + o + 4 * n) = xv + gv * acc[ai][bj][m][n]; } } }
    } };
struct EpiAct {
    __device__ __forceinline__ void operator()(const f32x4 (&acc)[2][2][4][2], const Unit& u, int wr, int wc, int fr, int fq) const {
#pragma unroll
        for (int ai = 0; ai < 2; ++ai)
#pragma unroll
            for (int m = 0; m < 4; ++m) { const int r = ai * HALF + wr * 64 + m * 16 + fr;
                if (r < u.rows) { float a[8];
#pragma unroll
                    for (int n = 0; n < 2; ++n)
#pragma unroll
                        for (int c = 0; c < 4; ++c) { const float g = acc[ai][0][m][n][c], up = acc[ai][1][m][n][c]; a[4 * n + c] = g * __builtin_amdgcn_rcpf(1.0f + __expf(-g)) * up; }
                    u32x4 w; w.x = cvt_pk_bf16(a[0], a[1]); w.y = cvt_pk_bf16(a[2], a[3]); w.z = cvt_pk_bf16(a[4], a[5]); w.w = cvt_pk_bf16(a[6], a[7]);
                    *(u32x4*)((bf16_t*)u.C + (size_t)r * u.ldc + wc * 32 + 8 * fq) = w; } }
    } };

struct SchedGrid {
    int G, c, nM, nN; const char* A; const char* B; char* C; size_t astride, bstride; int ldc, esz, mode;
    __device__ __forceinline__ bool next(int i, Unit& u) const {
        const int L = i * G + c; if (L >= nM * nN) return false;
        int pm, pn; grid_map(L, nM, nN, pm, pn);
        u.A = A + (size_t)pm * astride; u.B = B + (size_t)pn * bstride; u.C = C + ((size_t)pm * 256 * ldc + pn * 256) * esz; u.ldc = ldc; u.mode = mode; u.rows = 256; u.aux = 0; u.pm = pm; u.pn = pn; u.bjs = HALF; u.rmin = 0;
        return true; }
    __device__ __forceinline__ unsigned arow(const Unit&, int) const { return 0u; } };
struct SchedAG { int G, c; unsigned char* ws;
    __device__ __forceinline__ bool next(int i, Unit& u) const {
        const int L = i * G + c; if (L >= 256) return false;
        u.rows = 256; u.aux = 0; u.rmin = 0;
        if (L < 128) {
            int pm, pn8; grid_map(L, 16, 8, pm, pn8); const int b = pn8 >> 2, pn = pn8 & 3, sn = pm >> 3, k1t = pm & 7;
            u.A = (const char*)(ws + WS_CST) + (size_t)pm * 256 * 2048 * 2; u.B = (const char*)(ws + (sn ? WS_OT : WS_ET)) + ((size_t)b * FW + pn * 256) * 2048 * 2;
            u.C = (char*)(ws + WS_TT) + (((size_t)b * 2048 + k1t * 256) * DM + pn * 512 + sn * 128) * 2; u.ldc = DM; u.mode = sn ? 0 : 3; u.pm = k1t; u.pn = b * FW + pn * 256; u.bjs = 256;
        } else {
            int pm, q; grid_map(L - 128, 32, 4, pm, q); const int ct = 28 + q;
            u.A = (const char*)(ws + WS_H) + (size_t)pm * 256 * DM * 2; u.B = (const char*)(ws + WS_WT_IN) + (size_t)ct * 256 * DM * 2;
            u.C = (char*)(ws + WS_SGA) + ((size_t)pm * 256 * DM + (ct - 24) * 256) * 2; u.ldc = DM; u.mode = 2; u.pm = pm; u.pn = ct; u.bjs = HALF;
        }
        return true; }
    __device__ __forceinline__ unsigned arow(const Unit&, int) const { return 0u; } };
struct SchedF2 { int G, c; unsigned char* ws;
    __device__ __forceinline__ bool next(int i, Unit& u) const {
        const int L = i * G + c; if (L >= 128) return false;
        int pm, q; grid_map(L, 16, 8, pm, q); const int b = pm >> 3, k1t = pm & 7, j = q & 3, mir = q >> 2;
        u.A = (const char*)(ws + WS_TT) + (((size_t)b * 2048 + k1t * 256) * DM + j * 512) * 2; u.B = (const char*)(ws + WS_BD2) + (size_t)mir * 256 * 512 * 2;
        u.mode = 0; u.rows = 256; u.aux = 0; u.pm = pm; u.pn = j; u.bjs = HALF;
        if (!mir) { u.C = (char*)(ws + WS_YF) + (((size_t)b * SEQ + k1t * 256) * FW + j * 256) * 2; u.ldc = FW; u.rmin = 0; }
        else { u.C = (char*)(ws + WS_YF) + (((size_t)b * SEQ + SEQ - k1t * 256) * FW + j * 256) * 2; u.ldc = -FW; u.rmin = k1t == 0 ? 1 : 0; }
        return true; }
    __device__ __forceinline__ unsigned arow(const Unit&, int) const { return 0u; } };
constexpr int SCHT_OFF = LDSCTL_OFF + 1024;
__device__ __forceinline__ void moe_tables(Frame& F, int ncol_tiles) {
    LAS int* T = (LAS int*)(F.lds + SCHT_OFF);
    __syncthreads();
    if (F.tid == 0) { const int* CNT = (const int*)(F.ws + CTL_CNT); int up = 0, of = 0;
        for (int e = 0; e <= NE; ++e) { const int cn = e < NE ? CNT[e * 64] : NTOK; T[e] = up; T[80 + e] = e < NE ? of : NSLOT; T[160 + e] = cn; up += ((cn + 255) >> 8) * ncol_tiles; of += cn; }
        T[NE + 1] = up; }
    __syncthreads();
}
template <int NCT, bool FIRST> struct SchedMoe {
    int G, c; unsigned char* ws; LAS int* T; const int* TOK;
    __device__ __forceinline__ bool next(int i, Unit& u) const {
        const int L = i * G + c; if (L >= T[NE + 1]) return false;
        int lo = 0, hi = NE;
#pragma unroll 1
        while (lo < hi) { const int mid = (lo + hi + 1) >> 1; if (T[mid] <= L) lo = mid; else hi = mid - 1; }
        const int e = lo, cn = T[160 + e], ntile = (cn + 255) >> 8, local = L - T[e], ct = local / ntile, mt = local % ntile, slot0 = T[80 + e] + mt * 256;
        u.rows = (cn - mt * 256) < 256 ? (cn - mt * 256) : 256; u.aux = slot0; u.pm = mt; u.pn = ct; u.bjs = HALF; u.mode = 0; u.rmin = 0;
        if (FIRST) { u.A = (const char*)(ws + WS_H2); u.B = (const char*)(ws + WS_WT_GU) + ((size_t)e * 4 + ct) * 256 * DM * 2; u.C = (char*)(ws + WS_ACT) + ((size_t)slot0 * EFF + ct * 128) * 2; u.ldc = EFF; }
        else { u.A = (const char*)(ws + WS_ACT) + (size_t)slot0 * EFF * 2; u.B = (const char*)(ws + WS_WT_D) + ((size_t)e * DM + ct * 256) * EFF * 2; u.C = (char*)(ws + WS_YBIG) + ((size_t)slot0 * DM + ct * 256) * 2; u.ldc = DM; }
        return true; }
    __device__ __forceinline__ unsigned arow(const Unit& u, int r) const { const int rr = r < u.rows ? r : u.rows - 1; return (unsigned)TOK[u.aux + rr] * (unsigned)(DM * 2); } };

namespace attn {
using s16x4 = __attribute__((ext_vector_type(4))) short;
using f32x8 = __attribute__((ext_vector_type(8))) float;
constexpr int D = 128, NW = 8, QBLK = 32, KVBLK = 64;
constexpr float SCALE = 0.088388347648318440f;
constexpr float THR = 8.f;
constexpr int LDQ = DM, LDK = KVW, LDO = DM;
constexpr size_t SHM_V = KVBLK * D * 2, SHM_K = KVBLK * D * 2, SHM_ATTN = 2 * SHM_V + 2 * SHM_K + NW * 64 * 4;
#define KSWZ(row, colB) ((row) * 256 + ((colB) ^ (((row) & 7) << 4)))
#define SBAR() __builtin_amdgcn_sched_barrier(0)
__device__ __forceinline__ unsigned cvtpk(float lo, float hi) { unsigned r; asm volatile("v_cvt_pk_bf16_f32 %0, %1, %2" : "=v"(r) : "v"(lo), "v"(hi)); return r; }
__device__ __forceinline__ void partialSM(f32x16& p0, f32x16& p1, float& m_reg, float& mn, float& alpha) {
  constexpr float C = SCALE * 1.4426950408889634f;
  float pmax = p0[0]; for (int r = 1; r < 16; ++r) pmax = fmaxf(pmax, p0[r]); for (int r = 0; r < 16; ++r) pmax = fmaxf(pmax, p1[r]);
  { auto rr = __builtin_amdgcn_permlane32_swap(__float_as_uint(pmax), __float_as_uint(pmax), false, false);
    pmax = fmaxf(__uint_as_float(rr[0]), __uint_as_float(rr[1])); }
  if (__builtin_expect(__all(pmax - m_reg <= THR / SCALE), 1)) { mn = m_reg; alpha = 1.f; }
  else { mn = fmaxf(m_reg, pmax); alpha = __builtin_amdgcn_exp2f((m_reg - mn) * C); m_reg = mn; }
  float mnC = -mn * C;
  for (int r = 0; r < 16; ++r) p0[r] = fmaf(p0[r], C, mnC); for (int r = 0; r < 16; ++r) p1[r] = fmaf(p1[r], C, mnC);
  for (int r = 0; r < 16; ++r) p0[r] = __builtin_amdgcn_exp2f(p0[r]);
}
__device__ __forceinline__ void finishSM(f32x16& p0, f32x16& p1, float alpha, float& l_reg, bf16x8& pa0, bf16x8& pa1, bf16x8& pa2, bf16x8& pa3) {
  for (int r = 0; r < 16; ++r) p1[r] = __builtin_amdgcn_exp2f(p1[r]);
  float ps = 0; for (int r = 0; r < 16; ++r) ps += p0[r]; for (int r = 0; r < 16; ++r) ps += p1[r];
  { auto rr = __builtin_amdgcn_permlane32_swap(__float_as_uint(ps), __float_as_uint(ps), false, false);
    ps = __uint_as_float(rr[0]) + __uint_as_float(rr[1]); }
  l_reg = l_reg * alpha + ps;
#define PK4(P, BASE, OUT) do { unsigned a0 = cvtpk(P[BASE + 0], P[BASE + 1]), a1 = cvtpk(P[BASE + 2], P[BASE + 3]);   \
    unsigned b0 = cvtpk(P[BASE + 4], P[BASE + 5]), b1 = cvtpk(P[BASE + 6], P[BASE + 7]);                              \
    auto r0 = __builtin_amdgcn_permlane32_swap(a0, b0, false, false); auto r1 = __builtin_amdgcn_permlane32_swap(a1, b1, false, false); \
    u32x4 w = {r0[0], r1[0], r0[1], r1[1]}; OUT = *reinterpret_cast<bf16x8*>(&w); } while (0)
  PK4(p0, 0, pa0); PK4(p0, 8, pa1); PK4(p1, 0, pa2); PK4(p1, 8, pa3);
#undef PK4
}
__device__ __forceinline__ void qkt(f32x16& p0, f32x16& p1, const bf16_t* Ks, const bf16x8* qr, int r32, int hi) {
  p0 = f32x16{}; p1 = f32x16{};
  for (int d0 = 0; d0 < 8; ++d0) { int cb = (d0 * 16 + hi * 8) * 2;
    bf16x8 b0 = *reinterpret_cast<const bf16x8*>((const char*)Ks + KSWZ(r32, cb));
    bf16x8 b1 = *reinterpret_cast<const bf16x8*>((const char*)Ks + KSWZ(32 + r32, cb));
    p0 = __builtin_amdgcn_mfma_f32_32x32x16_bf16(b0, qr[d0], p0, 0, 0, 0);
    p1 = __builtin_amdgcn_mfma_f32_32x32x16_bf16(b1, qr[d0], p1, 0, 0, 0); }
}
__device__ __forceinline__ int v_st(int k, int c) { const int kk = (k & ~0xC) | ((k & 4) << 1) | ((k & 8) >> 1); return ((kk >> 3) * 4 + (c >> 5)) * 512 + ((kk & 7) * 32 + (c & 31)) * 2; }
__device__ __forceinline__ int v_rd_base(int lane) { return ((lane & 3) << 3) | (((lane >> 2) & 3) << 6) | (((lane >> 4) & 1) << 5) | (((lane >> 5) & 1) << 8); }
constexpr int v_rd_off(int d0, int ks, int half) { return d0 * 512 + ks * 4096 + half * 2048; }
template <int OFF> __device__ __forceinline__ s16x4 tr_read(int vb) {
  s16x4 r; asm volatile("ds_read_b64_tr_b16 %0, %1 offset:%2" : "=&v"(r) : "v"(vb), "i"(OFF) : "memory"); return r;
}
template <int D0> __device__ __forceinline__ void pv_one(f32x16& od, int vb, bf16x8 pa0, bf16x8 pa1, bf16x8 pa2, bf16x8 pa3) {
  const s16x4 l0 = tr_read<v_rd_off(D0, 0, 0)>(vb), h0 = tr_read<v_rd_off(D0, 0, 1)>(vb), l1 = tr_read<v_rd_off(D0, 1, 0)>(vb), h1 = tr_read<v_rd_off(D0, 1, 1)>(vb);
  const s16x4 l2 = tr_read<v_rd_off(D0, 2, 0)>(vb), h2 = tr_read<v_rd_off(D0, 2, 1)>(vb), l3 = tr_read<v_rd_off(D0, 3, 0)>(vb), h3 = tr_read<v_rd_off(D0, 3, 1)>(vb);
  asm volatile("s_waitcnt lgkmcnt(0)" ::: "memory"); SBAR();
#define PK(L, H) (bf16x8){L[0], L[1], L[2], L[3], H[0], H[1], H[2], H[3]}
  od = __builtin_amdgcn_mfma_f32_32x32x16_bf16(pa0, PK(l0, h0), od, 0, 0, 0);
  od = __builtin_amdgcn_mfma_f32_32x32x16_bf16(pa1, PK(l1, h1), od, 0, 0, 0);
  od = __builtin_amdgcn_mfma_f32_32x32x16_bf16(pa2, PK(l2, h2), od, 0, 0, 0);
  od = __builtin_amdgcn_mfma_f32_32x32x16_bf16(pa3, PK(l3, h3), od, 0, 0, 0);
#undef PK
}
__device__ __forceinline__ void pv_d0(f32x16* o, int vb, bf16x8 pa0, bf16x8 pa1, bf16x8 pa2, bf16x8 pa3) {
  pv_one<0>(o[0], vb, pa0, pa1, pa2, pa3); pv_one<1>(o[1], vb, pa0, pa1, pa2, pa3); pv_one<2>(o[2], vb, pa0, pa1, pa2, pa3); pv_one<3>(o[3], vb, pa0, pa1, pa2, pa3);
}
__device__ __forceinline__ void attn_dense_body(const bf16_t* __restrict__ Qb, const bf16_t* __restrict__ Kh, const bf16_t* __restrict__ Vh, bf16_t* __restrict__ Ob, int seq, char* lds) {
  const int tid = threadIdx.x, wid = tid >> 6, lane = tid & 63, r32 = lane & 31, hi = lane >> 5;
  bf16_t* V_lds = (bf16_t*)lds; bf16_t* K_lds = (bf16_t*)(lds + 2 * SHM_V);
  float* ws = (float*)(lds + 2 * SHM_V + 2 * SHM_K) + wid * 64; float* li_l = ws; float* al_l = ws + 32;
  float m_reg = -1e30f, l_reg = 0; f32x16 o[4] = {}; bf16x8 qr[8];
  const bf16_t* Qw = Qb + (long)(wid * QBLK + r32) * LDQ + hi * 8;
#pragma unroll
  for (int d0 = 0; d0 < 8; ++d0) qr[d0] = *reinterpret_cast<const bf16x8*>(Qw + d0 * 16);
  const int sr = tid >> 4, sc = (tid & 15) * 8, vst0 = v_st(sr, sc), vst1 = v_st(32 + sr, sc);
  const int vb0 = (int)(uintptr_t)V_lds + v_rd_base(lane);
  struct { bf16x8 vs0, vs1, ks0, ks1; } sr_[2];
#define SLOAD(i, k0) do { sr_[i].vs0 = *reinterpret_cast<const bf16x8*>(&Vh[(long)((k0) + sr) * LDK + sc]); sr_[i].vs1 = *reinterpret_cast<const bf16x8*>(&Vh[(long)((k0) + 32 + sr) * LDK + sc]); \
    sr_[i].ks0 = *reinterpret_cast<const bf16x8*>(&Kh[(long)((k0) + sr) * LDK + sc]); sr_[i].ks1 = *reinterpret_cast<const bf16x8*>(&Kh[(long)((k0) + 32 + sr) * LDK + sc]); } while (0)
#define SWRITE(b, i) do { *(bf16x8*)((char*)V_lds + (b) * SHM_V + vst0) = sr_[i].vs0;          \
    *(bf16x8*)((char*)V_lds + (b) * SHM_V + vst1) = sr_[i].vs1; int kc = sc * 2;               \
    *(bf16x8*)((char*)K_lds + (b) * SHM_K + KSWZ(sr, kc)) = sr_[i].ks0;                       \
    *(bf16x8*)((char*)K_lds + (b) * SHM_K + KSWZ(32 + sr, kc)) = sr_[i].ks1; } while (0)
#define SWAIT() asm volatile("s_waitcnt vmcnt(4)" ::: "memory")
#define RESC(a) do { if (__any((a) < 1.f)) { if (hi == 0) al_l[r32] = (a); asm volatile("s_waitcnt lgkmcnt(0)" ::: "memory"); \
    for (int d = 0; d < 4; ++d) for (int r = 0; r < 16; ++r) o[d][r] *= al_l[crow(r, hi)]; } } while (0)
  f32x16 pA0, pA1, pB0, pB1; float mnA, mnB, alA, alB; bf16x8 pa0, pa1, pa2, pa3; const int NT = seq / KVBLK;
  constexpr int SE = 0, SO = 1;
  SLOAD(SE, 0); asm volatile("s_waitcnt vmcnt(0)" ::: "memory"); SWRITE(0, SE); __syncthreads();
  qkt(pA0, pA1, K_lds, qr, r32, hi); partialSM(pA0, pA1, m_reg, mnA, alA);
  SLOAD(SO, KVBLK); if (2 < NT) SLOAD(SE, 2 * KVBLK);
  SWAIT(); SWRITE(1, SO); __syncthreads();
  for (int j = 1; j + 1 < NT; j += 2) {
    SBAR(); qkt(pB0, pB1, (bf16_t*)((char*)K_lds + SHM_K), qr, r32, hi);
    finishSM(pA0, pA1, alA, l_reg, pa0, pa1, pa2, pa3); SBAR();
    SLOAD(SO, (j + 2) * KVBLK); SBAR();
    pv_d0(o, vb0, pa0, pa1, pa2, pa3); partialSM(pB0, pB1, m_reg, mnB, alB);
    __syncthreads(); SWAIT(); SWRITE(0, SE);
    RESC(alB); __syncthreads();
    SBAR(); qkt(pA0, pA1, K_lds, qr, r32, hi);
    finishSM(pB0, pB1, alB, l_reg, pa0, pa1, pa2, pa3); SBAR();
    if (j + 3 < NT) SLOAD(SE, (j + 3) * KVBLK); SBAR();
    pv_d0(o, vb0 + (int)SHM_V, pa0, pa1, pa2, pa3); partialSM(pA0, pA1, m_reg, mnA, alA);
    __syncthreads(); SWAIT(); SWRITE(1, SO);
    RESC(alA); __syncthreads();
  }
  SBAR(); qkt(pB0, pB1, (bf16_t*)((char*)K_lds + SHM_K), qr, r32, hi);
  finishSM(pA0, pA1, alA, l_reg, pa0, pa1, pa2, pa3); SBAR();
  pv_d0(o, vb0, pa0, pa1, pa2, pa3); partialSM(pB0, pB1, m_reg, mnB, alB);
  __syncthreads(); RESC(alB);
  finishSM(pB0, pB1, alB, l_reg, pa0, pa1, pa2, pa3); SBAR();
  pv_d0(o, vb0 + (int)SHM_V, pa0, pa1, pa2, pa3);
  if (hi == 0) li_l[r32] = l_reg; asm volatile("s_waitcnt lgkmcnt(0)" ::: "memory");
  float rli[16];
#pragma unroll
  for (int r = 0; r < 16; ++r) rli[r] = __builtin_amdgcn_rcpf(li_l[crow(r, hi)]);
  bf16_t* Ow = Ob + (long)(wid * QBLK) * LDO;
#pragma unroll
  for (int r = 0; r < 16; ++r) { int orow = crow(r, hi);
    for (int d0 = 0; d0 < 4; ++d0) Ow[(long)orow * LDO + d0 * 32 + r32] = f2bf(o[d0][r] * rli[r]); }
#undef SLOAD
#undef SWRITE
#undef SWAIT
#undef RESC
}
#undef KSWZ
#undef SBAR
}

__device__ __forceinline__ void ph_norm1(Frame& F, const Args& args, const float* mod) {
    const int gw = F.vcu * NWAVES + F.wave, NGW = F.G * NWAVES, lane = F.lane;
    bf16_t* H = (bf16_t*)(F.ws + WS_H); const float* nw = args.in[6];
    for (int row = gw; row < NTOK + NCTX; row += NGW) {
        const float* src = row < NTOK ? args.in[0] + (size_t)row * DM : args.in[2] + (size_t)(row - NTOK) * DM;
        const float* mr = mod + (row < NTOK ? row / SEQ : 2) * MODC;
        f32x4 v[8]; float ss = 0.f;
#pragma unroll
        for (int j = 0; j < 8; ++j) { v[j] = *(const GAS f32x4*)(src + (j * 64 + lane) * 4); ss += v[j].x * v[j].x + v[j].y * v[j].y + v[j].z * v[j].z + v[j].w * v[j].w; }
        ss = wave_sum(ss);
        const float rstd = 1.0f / sqrtf(ss * (1.0f / DM) + 1e-6f);
#pragma unroll
        for (int j = 0; j < 8; ++j) { const int i = (j * 64 + lane) * 4;
            const f32x4 w = *(const GAS f32x4*)(nw + i), sc = *(const GAS f32x4*)(mr + DM + i), sh = *(const GAS f32x4*)(mr + i);
            const f32x4 h = v[j] * rstd * w * (sc + 1.0f) + sh;
            unsigned lo = cvt_pk_bf16(h[0], h[1]), hi = cvt_pk_bf16(h[2], h[3]);
            *(GAS unsigned long long*)(H + (size_t)row * DM + i) = (unsigned long long)lo | ((unsigned long long)hi << 32); }
    }
}
__device__ __forceinline__ void ph_qknorm(Frame& F, const Args& args) {
    const int gw = F.vcu * NWAVES + F.wave, NGW = F.G * NWAVES, lane = F.lane;
    const float* QKRAW = (const float*)(F.ws + WS_QKRAW); const float* KCRAW = (const float*)(F.ws + WS_KCRAW);
    bf16_t* Q = (bf16_t*)(F.ws + WS_Q); bf16_t* KALL = (bf16_t*)(F.ws + WS_KALL);
    const int axis = lane >> 5, f = lane & 31, da = axis * 64 + f, db = da + 32;
    const float qwa = args.in[8][da], qwb = args.in[8][db], kwa = args.in[9][da], kwb = args.in[9][db];
    const float inv = exp2f(-(float)f * (13.287712379549449f / 32.0f));
    for (int row = gw; row < NTOK + NCTX; row += NGW) {
        if (row < NTOK) {
            const int b = row / SEQ, t = row % SEQ;
            const float pos = (float)(axis == 0 ? t / 64 : t % 64), ang = pos * inv, cs = cosf(ang), sn = sinf(ang);
            const float* src = QKRAW + (size_t)row * 2560;
#pragma unroll
            for (int hb = 0; hb < 20; hb += 5) {
                float xa[5], xb[5];
#pragma unroll
                for (int q = 0; q < 5; ++q) { xa[q] = src[(hb + q) * HD + da]; xb[q] = src[(hb + q) * HD + db]; }
#pragma unroll
                for (int q = 0; q < 5; ++q) { const int hh = hb + q;
                    const float ss = wave_sum(xa[q] * xa[q] + xb[q] * xb[q]), rstd = 1.0f / sqrtf(ss * (1.0f / HD) + 1e-6f);
                    const float a = xa[q] * rstd * (hh < 16 ? qwa : kwa), bb = xb[q] * rstd * (hh < 16 ? qwb : kwb);
                    bf16_t* dst = hh < 16 ? Q + (size_t)row * DM + hh * HD : KALL + ((size_t)b * SKV + t) * KVW + (hh - 16) * HD;
                    dst[da] = f2bf(a * cs - bb * sn); dst[db] = f2bf(bb * cs + a * sn); }
            }
        } else {
            const int r = row - NTOK, b = r / CTXL, j = r % CTXL; const float* src = KCRAW + (size_t)r * KVW;
#pragma unroll
            for (int hh = 0; hh < 4; ++hh) { const float xa = src[hh * HD + da], xb = src[hh * HD + db];
                const float ss = wave_sum(xa * xa + xb * xb), rstd = 1.0f / sqrtf(ss * (1.0f / HD) + 1e-6f);
                bf16_t* dst = KALL + ((size_t)b * SKV + SEQ + j) * KVW + hh * HD; dst[da] = f2bf(xa * rstd * kwa); dst[db] = f2bf(xb * rstd * kwb); }
        }
    }
}
__device__ __forceinline__ void ph_evenodd(Frame& F, const Args& args) {
    const int gw = F.vcu * NWAVES + F.wave, NGW = F.G * NWAVES, lane = F.lane;
    LAS bf16_t* scr = (LAS bf16_t*)(F.lds + F.wave * 16640);
    const bf16_t* UT = (const bf16_t*)(F.ws + WS_UT); bf16_t* ET = (bf16_t*)(F.ws + WS_ET); bf16_t* OT = (bf16_t*)(F.ws + WS_OT);
    float* W2 = (float*)(F.ws + WS_W2048); float* AL = (float*)(F.ws + WS_ALT);
    for (int row = gw; row < 2 * FW; row += NGW) {
        const bf16_t* src = UT + (size_t)row * SEQ; float alt = 0.f;
#pragma unroll
        for (int j = 0; j < 8; ++j) { const u32x4 w = *(const GAS u32x4*)(src + (j * 64 + lane) * 8); *(LAS u32x4*)(scr + (j * 64 + lane) * 8) = w;
            float f[8]; unpack8(w, f); alt += (f[0] - f[1]) + (f[2] - f[3]) + (f[4] - f[5]) + (f[6] - f[7]); }
        alt = wave_sum(alt);
        LDS_WAIT(); asm volatile("" ::: "memory");
        if (lane == 0) { AL[row] = alt; W2[row] = bf2f(scr[SEQ / 2]); }
#pragma unroll
        for (int j = 0; j < 4; ++j) { const int n0 = (j * 64 + lane) * 8; float e[8], o[8];
#pragma unroll
            for (int i = 0; i < 8; ++i) { const int n = n0 + i; const float a = bf2f(scr[n]), bb = bf2f(scr[(SEQ - n) & (SEQ - 1)]); e[i] = n == 0 ? a : a + bb; o[i] = n == 0 ? 0.f : a - bb; }
            u32x4 we, wo; we.x = cvt_pk_bf16(e[0], e[1]); we.y = cvt_pk_bf16(e[2], e[3]); we.z = cvt_pk_bf16(e[4], e[5]); we.w = cvt_pk_bf16(e[6], e[7]);
            wo.x = cvt_pk_bf16(o[0], o[1]); wo.y = cvt_pk_bf16(o[2], o[3]); wo.z = cvt_pk_bf16(o[4], o[5]); wo.w = cvt_pk_bf16(o[6], o[7]);
            *(GAS u32x4*)(ET + (size_t)row * 2048 + n0) = we; *(GAS u32x4*)(OT + (size_t)row * 2048 + n0) = wo; }
        LDS_WAIT(); asm volatile("" ::: "memory");
    }
}
__device__ __forceinline__ void ph_route(Frame& F, const Args& args, const float* mod) {
    const int lane = F.lane, wv = F.wave, r32 = lane & 31, hi = lane >> 5;
    LAS float* rs = (LAS float*)F.lds;
    LAS float* part = (LAS float*)(F.lds + 1024);
    LAS int* lcnt = (LAS int*)(F.lds + 1024 + 65536);
    LAS int* lbase = lcnt + 64;
    LAS int* lent = lcnt + 128;
    const float* X2 = (const float*)(F.ws + WS_X2); const float* nw = args.in[13]; const float* rb = args.in[15];
    const bf16_t* RWT = (const bf16_t*)(F.ws + WS_RWT);
    bf16_t* H2 = (bf16_t*)(F.ws + WS_H2); int* EIDX = (int*)(F.ws + WS_EIDX); float* EW = (float*)(F.ws + WS_EW); int* EPOS = (int*)(F.ws + WS_EPOS); int* CNT = (int*)(F.ws + CTL_CNT);
    if (F.tid < NE) lcnt[F.tid] = 0;
    __syncthreads();
    int nb = 0;
    for (int blk = F.vcu; blk < NTOK / 32; blk += F.G, ++nb) {
        const int row0 = blk * 32; const float* mr = mod + (row0 / SEQ) * MODC;
#pragma unroll
        for (int i = 0; i < 4; ++i) { const float* src = X2 + (size_t)(row0 + wv * 4 + i) * DM; float ss = 0.f;
#pragma unroll
            for (int j = 0; j < 8; ++j) { const f32x4 v = *(const GAS f32x4*)(src + (j * 64 + lane) * 4); ss += v.x * v.x + v.y * v.y + v.z * v.z + v.w * v.w; }
            ss = wave_sum(ss);
            if (lane == 0) rs[wv * 4 + i] = 1.0f / sqrtf(ss * (1.0f / DM) + 1e-6f); }
        __syncthreads();
        { const float rstd = rs[r32]; const float* xr = X2 + (size_t)(row0 + r32) * DM; bf16_t* hr = H2 + (size_t)(row0 + r32) * DM;
          f32x16 acc0 = {}, acc1 = {};
#pragma unroll 4
          for (int ks = 0; ks < 16; ++ks) { const int k = wv * 256 + ks * 16 + hi * 8;
              float h[8];
#pragma unroll
              for (int q = 0; q < 2; ++q) { const f32x4 x = *(const GAS f32x4*)(xr + k + 4 * q), w = *(const GAS f32x4*)(nw + k + 4 * q), sc = *(const GAS f32x4*)(mr + 4 * DM + k + 4 * q), sh = *(const GAS f32x4*)(mr + 3 * DM + k + 4 * q);
                  const f32x4 t = x * rstd * w * (sc + 1.0f) + sh; h[4 * q] = t[0]; h[4 * q + 1] = t[1]; h[4 * q + 2] = t[2]; h[4 * q + 3] = t[3]; }
              u32x4 wh, wl; float l[8];
              wh.x = cvt_pk_bf16(h[0], h[1]); wh.y = cvt_pk_bf16(h[2], h[3]); wh.z = cvt_pk_bf16(h[4], h[5]); wh.w = cvt_pk_bf16(h[6], h[7]);
#pragma unroll
              for (int i = 0; i < 4; ++i) { l[2 * i] = h[2 * i] - __uint_as_float(wh[i] << 16); l[2 * i + 1] = h[2 * i + 1] - __uint_as_float(wh[i] & 0xffff0000u); }
              wl.x = cvt_pk_bf16(l[0], l[1]); wl.y = cvt_pk_bf16(l[2], l[3]); wl.z = cvt_pk_bf16(l[4], l[5]); wl.w = cvt_pk_bf16(l[6], l[7]);
              *(GAS u32x4*)(hr + k) = wh;
              const bf16x8 ah = __builtin_bit_cast(bf16x8, wh), al = __builtin_bit_cast(bf16x8, wl);
              const bf16x8 bh0 = *(const GAS bf16x8*)(RWT + (size_t)r32 * DM + k), bh1 = *(const GAS bf16x8*)(RWT + (size_t)(32 + r32) * DM + k);
              const bf16x8 bl0 = *(const GAS bf16x8*)(RWT + (size_t)(NE + r32) * DM + k), bl1 = *(const GAS bf16x8*)(RWT + (size_t)(NE + 32 + r32) * DM + k);
              acc0 = __builtin_amdgcn_mfma_f32_32x32x16_bf16(ah, bh0, acc0, 0, 0, 0); acc0 = __builtin_amdgcn_mfma_f32_32x32x16_bf16(ah, bl0, acc0, 0, 0, 0); acc0 = __builtin_amdgcn_mfma_f32_32x32x16_bf16(al, bh0, acc0, 0, 0, 0);
              acc1 = __builtin_amdgcn_mfma_f32_32x32x16_bf16(ah, bh1, acc1, 0, 0, 0); acc1 = __builtin_amdgcn_mfma_f32_32x32x16_bf16(ah, bl1, acc1, 0, 0, 0); acc1 = __builtin_amdgcn_mfma_f32_32x32x16_bf16(al, bh1, acc1, 0, 0, 0); }
#pragma unroll
          for (int r = 0; r < 16; ++r) { part[(wv * 32 + crow(r, hi)) * 64 + r32] = acc0[r]; part[(wv * 32 + crow(r, hi)) * 64 + 32 + r32] = acc1[r]; } }
        __syncthreads();
        for (int i = 0; i < 4; ++i) { const int rbk = wv * 4 + i, row = row0 + rbk; float logit = 0.f;
#pragma unroll
          for (int w = 0; w < 8; ++w) logit += part[(w * 32 + rbk) * 64 + lane];
          const float score = 1.0f / (1.0f + expf(-logit)), bsd = score + rb[lane];
          const int g = lane >> 3;
          int rk = 0;
#pragma unroll
          for (int q = 0; q < 8; ++q) { const int o = (lane & ~7) + q; const float vv = __shfl(bsd, o); rk += (vv > bsd) || (vv == bsd && o < lane); }
          float gs = rk < 2 ? bsd : 0.f;
          gs += __shfl_xor(gs, 1); gs += __shfl_xor(gs, 2); gs += __shfl_xor(gs, 4);
          int grk = 0;
#pragma unroll
          for (int gg = 0; gg < 8; ++gg) { const float vv = __shfl(gs, gg * 8); grk += (vv > gs) || (vv == gs && gg < g); }
          const bool gsel = grk < 4;
          const float mb = gsel ? bsd : -INFINITY;
          int erk = 0;
          for (int o = 0; o < 64; ++o) { const float vv = __shfl(mb, o); erk += (vv > mb) || (vv == mb && o < lane); }
          const bool sel = gsel && erk < TOPK;
          const float ssum = wave_sum(sel ? score : 0.f);
          if (sel) { const int lp = __hip_atomic_fetch_add(lcnt + lane, 1, __ATOMIC_RELAXED, __HIP_MEMORY_SCOPE_WORKGROUP);
                     EIDX[row * TOPK + erk] = lane; EW[row * TOPK + erk] = score / ssum * 2.5f; lent[(nb * 32 + rbk) * TOPK + erk] = (lane << 16) | lp; } }
        __syncthreads();
    }
    if (F.tid < NE) { const int c = lcnt[F.tid]; lbase[F.tid] = c ? atomicAdd(&CNT[F.tid * 64], c) : 0; }
    __syncthreads();
    for (int i = F.tid; i < nb * 256; i += NTHREADS) { const int blk = F.vcu + (i >> 8) * F.G, row = blk * 32 + ((i >> 3) & 31), v = lent[i]; EPOS[row * TOPK + (i & 7)] = lbase[v >> 16] + (v & 0xffff); }
    __syncthreads();
}
__device__ __forceinline__ void ph_fill(Frame& F, const Args& args) {
    moe_tables(F, 4);
    LAS int* T = (LAS int*)(F.lds + SCHT_OFF);
    const int* EIDX = (const int*)(F.ws + WS_EIDX); const int* EPOS = (const int*)(F.ws + WS_EPOS); int* TOK = (int*)(F.ws + WS_TOK); int* SLOTOF = (int*)(F.ws + WS_SLOTOF);
    for (int i = F.vcu * NTHREADS + F.tid; i < NSLOT; i += F.G * NTHREADS) { const int slot = T[80 + EIDX[i]] + EPOS[i]; TOK[slot] = i / TOPK; SLOTOF[i] = slot; if (i < NTOK) TOK[NSLOT + i] = i; }
}
__device__ __forceinline__ void ph_comb(Frame& F, const Args& args, const float* mod) {
    const int gw = F.vcu * NWAVES + F.wave, NGW = F.G * NWAVES, lane = F.lane;
    const float* EW = (const float*)(F.ws + WS_EW); const int* SLOTOF = (const int*)(F.ws + WS_SLOTOF); const bf16_t* Y = (const bf16_t*)(F.ws + WS_YBIG);
    for (int t = gw; t < NTOK; t += NGW) {
        const float* g2 = mod + (t / SEQ) * MODC + 5 * DM;
        int sl[TOPK]; float wk[TOPK];
#pragma unroll
        for (int k = 0; k < TOPK; ++k) { sl[k] = SLOTOF[t * TOPK + k]; wk[k] = EW[t * TOPK + k]; }
#pragma unroll
        for (int j = 0; j < 4; ++j) { const int col = j * 512 + lane * 8;
            float a[8]; unpack8(*(const GAS u32x4*)(Y + (size_t)(NSLOT + t) * DM + col), a);
#pragma unroll
            for (int k = 0; k < TOPK; ++k) { float y[8]; unpack8(*(const GAS u32x4*)(Y + (size_t)sl[k] * DM + col), y);
#pragma unroll
                for (int c = 0; c < 8; ++c) a[c] += wk[k] * y[c]; }
            float* o = args.out + (size_t)t * DM + col; const float* xi = (const float*)(F.ws + WS_X2) + (size_t)t * DM + col;
#pragma unroll
            for (int n = 0; n < 2; ++n) { const f32x4 xv = *(const GAS f32x4*)(xi + 4 * n), gv = *(const GAS f32x4*)(g2 + col + 4 * n);
                *(GAS f32x4*)(o + 4 * n) = xv + gv * (f32x4){a[4 * n], a[4 * n + 1], a[4 * n + 2], a[4 * n + 3]}; } }
    }
}

enum { PH_PRO = 0, PH_NORM1, PH_INPROJ, PH_QKNORM, PH_ATTN, PH_F2, PH_MERGE, PH_OUT, PH_ROUTE, PH_FILL, PH_EXP1, PH_EXP2, PH_COMB, PH_END };


__global__ void __launch_bounds__(NTHREADS, 2) fwd(Args args) {
    extern __shared__ __attribute__((aligned(16))) unsigned char lds_raw[];
    Frame F;
    F.lds = (LAS unsigned char*)lds_raw; F.MISC = (volatile LAS unsigned*)(F.lds + MISC_OFF); F.ws = args.ws;
    F.tid = threadIdx.x; F.lane = F.tid & 63; F.wave = __builtin_amdgcn_readfirstlane(F.tid >> 6);
    F.G = gridDim.x; { const int bx = blockIdx.x; F.vcu = (F.G % 8 == 0) ? (bx % 8) * (F.G / 8) + bx / 8 : bx; }
    for (int u = F.tid; u < (LDS_BYTES - LDSCTL_OFF) / 4; u += NTHREADS) ((LAS unsigned*)(F.lds + LDSCTL_OFF))[u] = 0u;
    __syncthreads();
    const int lo = args.ph_lo, hi = args.ph_hi;
    const bool multi = (hi - lo) > 1;
    unsigned* barw = (unsigned*)(args.ws + CTL_BAR) + args.bar_idx * XCD_BAR_WORDS;
    XcdBarrier bar; bar.bar = barw; bar.x = 0; bar.st = nullptr;
    if (multi) bar = xcd_barrier_post(barw, F.MISC + 8);
#define IN(k) (lo <= (k) && (k) < hi)
#define SEAM(k) do { if (IN((k) + 1)) xcd_barrier(bar); } while (0)

    const float* modp = (const float*)(args.ws + args.mod_off);
    if (IN(PH_PRO)) { p0_prologue(F, args); SEAM(PH_PRO); }
    if (IN(PH_NORM1)) { ph_norm1(F, args, modp); SEAM(PH_NORM1); }
    if (IN(PH_INPROJ)) {
        SchedIn S{F.G, (int)blockIdx.x, args.ws, args.use_ut};
        gemm_phase<EpiStore, SchedIn, false>(F.lds, DM, DM, DM, S, EpiStore{(const float*)(args.ws + WS_W2048)});
        SEAM(PH_INPROJ);
    }
    if (IN(PH_QKNORM)) { ph_qknorm(F, args); ph_evenodd(F, args); SEAM(PH_QKNORM); }
    if (IN(PH_ATTN)) {
        const int cs = F.vcu & 3;
        const int gper = (IT_EG + IT_EU + F.G - 1) / F.G, gfirst = F.vcu * gper, gcnt = gfirst + gper <= IT_EG + IT_EU ? gper : (IT_EG + IT_EU - gfirst > 0 ? IT_EG + IT_EU - gfirst : 0);
        const int cper = (IT_ED + F.G - 1) / F.G, cfirst = F.vcu * cper, ccnt = cfirst + cper <= IT_ED ? cper : (IT_ED - cfirst > 0 ? IT_ED - cfirst : 0);
#define CONV_ALL() do { conv_items(F, args, false, gfirst, gcnt); conv_items(F, args, true, cfirst, ccnt); } while (0)
        const bf16_t* Qp = (const bf16_t*)(args.ws + WS_Q); const bf16_t* Kp = (const bf16_t*)(args.ws + WS_KALL); const bf16_t* Vp = (const bf16_t*)(args.ws + WS_VALL); bf16_t* Op = (bf16_t*)(args.ws + WS_YA);
#define ATTN_UNIT(lin_) do { const int lin = (lin_); if (lin < 512) { const int x = (lin >> 5) & 7, j = (lin & 31) + 32 * (lin >> 8), b = x >> 2, kvh = x & 3, head = kvh * 4 + (j >> 4), qb = j & 15; \
            const size_t qo = ((size_t)(b * SEQ + qb * 256)) * DM + head * HD, ko = (size_t)b * SKV * KVW + kvh * HD; \
            attn::attn_dense_body(Qp + qo, Kp + ko, Vp + ko, Op + qo, SKV, (char*)lds_raw); __syncthreads(); } } while (0)
        if (cs == 0) { CONV_ALL(); __syncthreads(); }
        ATTN_UNIT(F.vcu);
        if (cs == 1) { CONV_ALL(); __syncthreads(); }
        ATTN_UNIT(F.vcu + F.G);
        for (int lin2 = F.vcu + 2 * F.G; lin2 < 512; lin2 += F.G) ATTN_UNIT(lin2);
        if (cs == 2) { CONV_ALL(); __syncthreads(); }
#undef ATTN_UNIT
        SchedAG S{F.G, (int)blockIdx.x, args.ws};
        gemm_phase<EpiStore, SchedAG, false>(F.lds, DM, DM, DM, S, EpiStore{(const float*)(args.ws + WS_W2048)});
        if (cs == 3) { __syncthreads(); CONV_ALL(); }
#undef CONV_ALL
        SEAM(PH_ATTN);
    }
    if (IN(PH_F2)) {
        SchedF2 S{F.G, (int)blockIdx.x, args.ws};
        gemm_phase<EpiStore, SchedF2, false>(F.lds, 512, DM, 512, S, EpiStore{(const float*)(args.ws + WS_W2048)});
        {
            const int idx = F.vcu * NTHREADS + F.tid;
            if (idx < 2 * FW) { const int b = idx >> 10, col = idx & 1023, k2 = col & 127; const float* al = (const float*)(args.ws + WS_ALT) + b * FW + (col & ~127); float s = 0.f;
                for (int c = 0; c < 128; ++c) s += al[c] * cospif((float)((c * k2) & 127) * (1.0f / 64.0f));
                ((bf16_t*)(args.ws + WS_YF))[((size_t)b * SEQ + SEQ / 2) * FW + col] = f2bf(s * 0.0013810679320049757f); }
        }
        SEAM(PH_F2);
    }
    if (IN(PH_MERGE)) {
        unsigned char* ws = args.ws;
        { SchedGrid S{F.G, (int)blockIdx.x, 32, 8, (const char*)(ws + WS_YF), (const char*)(ws + WS_WT_FO), nullptr, (size_t)256 * FW * 2, (size_t)256 * FW * 2, DM, 4, 1};
          gemm_phase<EpiT1, SchedGrid, false>(F.lds, FW, FW, FW, S, EpiT1{(const bf16_t*)(ws + WS_SGF), (float*)(ws + WS_T1)}); }
        { SchedGrid S{F.G, (int)blockIdx.x, 32, 8, (const char*)(ws + WS_YA), (const char*)(ws + WS_WT_AO), nullptr, (size_t)256 * DM * 2, (size_t)256 * DM * 2, DM, 2, 0};
          gemm_phase<EpiYM, SchedGrid, false>(F.lds, DM, DM, DM, S, EpiYM{(const bf16_t*)(ws + WS_SGA), (const float*)(ws + WS_T1), (bf16_t*)(ws + WS_YM)}); }
        SEAM(PH_MERGE);
    }
    if (IN(PH_OUT)) {
        unsigned char* ws = args.ws;
        SchedGrid S{F.G, (int)blockIdx.x, 32, 8, (const char*)(ws + WS_YM), (const char*)(ws + WS_WT_O), nullptr, (size_t)256 * DM * 2, (size_t)256 * DM * 2, DM, 4, 1};
        gemm_phase<EpiX2, SchedGrid, false>(F.lds, DM, DM, DM, S, EpiX2{args.in[0], modp, (float*)(ws + WS_X2)});
        SEAM(PH_OUT);
    }
    if (IN(PH_ROUTE)) { ph_route(F, args, modp); SEAM(PH_ROUTE); }
    if (IN(PH_FILL)) { ph_fill(F, args); SEAM(PH_FILL); }
    if (IN(PH_EXP1)) {
        moe_tables(F, 4);
        SchedMoe<4, true> S{F.G, F.vcu, args.ws, (LAS int*)(F.lds + SCHT_OFF), (const int*)(args.ws + WS_TOK)};
        gemm_phase<EpiAct, SchedMoe<4, true>, true>(F.lds, DM, DM, DM, S, EpiAct{});
        SEAM(PH_EXP1);
    }
    if (IN(PH_EXP2)) {
        moe_tables(F, 8);
        SchedMoe<8, false> S{F.G, F.vcu, args.ws, (LAS int*)(F.lds + SCHT_OFF), (const int*)(args.ws + WS_TOK)};
        gemm_phase<EpiStore, SchedMoe<8, false>, false>(F.lds, EFF, EFF, EFF, S, EpiStore{(const float*)(args.ws + WS_W2048)});
        SEAM(PH_EXP2);
    }
    if (IN(PH_COMB)) { ph_comb(F, args, modp); }
#undef IN
#undef SEAM
}
}

extern "C" void kernel_launch(void* const* d_in, const int* in_sizes, int n_in, void* d_out, int out_size, void* d_ws, size_t ws_size, hipStream_t stream) {
    if (n_in != 22 || ws_size < WS_END2) return;
    float* out = (float*)d_out;
    unsigned char* ws = (unsigned char*)d_ws;
    hipMemsetAsync(ws + WS_CTL, 0, CTL_ZERO_BYTES, stream);
    static int grid = 0;
    if (!grid) {
        int dev = 0, cus = 0;
        if (hipGetDevice(&dev) != hipSuccess || hipDeviceGetAttribute(&cus, hipDeviceAttributeMultiprocessorCount, dev) != hipSuccess) { grid = -1; return; }
        if (hipFuncSetAttribute((const void*)mk::fwd, hipFuncAttributeMaxDynamicSharedMemorySize, mk::LDS_BYTES) != hipSuccess) { grid = -1; return; }
        grid = cus;
    }
    if (grid < 0) return;
    mk::Args a{}; int nlaunch = 0;
    for (int i = 0; i < 22; ++i) a.in[i] = (const float*)d_in[i];
    a.out = out; a.ws = ws; a.use_ut = 1; a.mod_off = (int)WS_MOD; a.do_attn = 1;
#define MK_LAUNCH(lo_, hi_) do { a.ph_lo = (lo_); a.ph_hi = (hi_); a.bar_idx = nlaunch++; hipLaunchKernelGGL(mk::fwd, dim3(grid), dim3(mk::NTHREADS), mk::LDS_BYTES, stream, a); } while (0)
    MK_LAUNCH(mk::PH_PRO, mk::PH_END);
}
```

```cpp
#include <hip/hip_runtime.h>
#include <stdint.h>
#include <math.h>

typedef unsigned short bf16_t;
typedef short bf16x8 __attribute__((ext_vector_type(8)));
typedef float f32x16 __attribute__((ext_vector_type(16)));
typedef float f32x4 __attribute__((ext_vector_type(4)));

constexpr int NB = 2, SEQ = 4096, DM = 2048, NTOK = NB * SEQ, CTXL = 256, NCTX = NB * CTXL, HD = 128, NH = 16, NKV = 4;
constexpr int SKV = SEQ + CTXL;
constexpr int FW = 1024, INC = 8192, Q_OFF = 1024, K_OFF = 3072, V_OFF = 3584, GF_OFF = 4096, GA_OFF = 6144;
constexpr int KVW = NKV * HD;
constexpr int NE = 64, TOPK = 8, EFF = 512, MODC = 6 * DM;
constexpr int NSLOT = NTOK * TOPK;
constexpr int NSLOT_ALL = NSLOT + NTOK;

constexpr size_t MiB = 1u << 20;
constexpr size_t WS_CTL = 0, CTL_ZERO_BYTES = 1 * MiB;
constexpr size_t CTL_CNT = 64 * 1024;
constexpr size_t WS_TW = 1 * MiB;
constexpr size_t WS_MOD = 1 * MiB + 64 * 1024;
constexpr size_t WS_OFFS = 1 * MiB + 256 * 1024;
constexpr size_t WS_EIDX = 2 * MiB;
constexpr size_t WS_EW = WS_EIDX + 256 * 1024;
constexpr size_t WS_EPOS = WS_EW + 256 * 1024;
constexpr size_t WS_SLOTOF = WS_EPOS + 256 * 1024;
constexpr size_t WS_TOK = 3 * MiB;
constexpr size_t WS_H = 4 * MiB;
constexpr size_t WS_U = 38 * MiB;
constexpr size_t WS_Q = 54 * MiB;
constexpr size_t WS_KALL = 86 * MiB;
constexpr size_t WS_VALL = 95 * MiB;
constexpr size_t WS_SGF = 104 * MiB;
constexpr size_t WS_SGA = 136 * MiB;
constexpr size_t WS_YA = 168 * MiB;
constexpr size_t WS_YF = 200 * MiB;
constexpr size_t WS_PR = 216 * MiB;
constexpr size_t WS_T1 = 248 * MiB;
constexpr size_t WS_YM = 312 * MiB;
constexpr size_t WS_QKRAW = 248 * MiB;
constexpr size_t WS_KCRAW = 330 * MiB;
constexpr size_t WS_H2 = 344 * MiB;
constexpr size_t WS_ACT = 376 * MiB;
constexpr size_t WS_YBIG = 4 * MiB;
constexpr size_t WS_END = 740 * MiB;

__device__ __forceinline__ float bf2f(bf16_t h) { return __uint_as_float(((unsigned)h) << 16); }
__device__ __forceinline__ bf16_t f2bf(float f) { unsigned u = __float_as_uint(f); return (bf16_t)((u + 0x7fffu + ((u >> 16) & 1u)) >> 16); }
__device__ __forceinline__ int crow(int r, int hi) { return (r & 3) + 8 * (r >> 2) + 4 * hi; }
__device__ __forceinline__ float wave_sum(float v) {
#pragma unroll
    for (int o = 1; o < 64; o <<= 1) v += __shfl_xor(v, o);
    return v;
}
__device__ __forceinline__ float sigmoidf_(float v) { return 1.0f / (1.0f + expf(-v)); }
__device__ __forceinline__ bf16x8 pack8(const float* f) {
    bf16x8 r;
#pragma unroll
    for (int i = 0; i < 8; ++i) r[i] = (short)f2bf(f[i]);
    return r;
}

#define LAS __attribute__((address_space(3)))
#define GAS __attribute__((address_space(1)))
typedef unsigned u32x4 __attribute__((ext_vector_type(4)));
typedef GAS unsigned gu32;
#define RLX_AGENT __ATOMIC_RELAXED, __HIP_MEMORY_SCOPE_AGENT
#define LDS_WAIT() asm volatile("s_waitcnt lgkmcnt(0)" ::: "memory")
#define VM_WAIT() asm volatile("s_waitcnt vmcnt(0)" ::: "memory")

constexpr size_t CTL_BAR = 16384;
constexpr size_t CTL_MODZ = 512 * 1024;
constexpr size_t WS_UT = 38 * MiB;
constexpr size_t WS_TT = 216 * MiB;
constexpr size_t WS_WT_GU = 450 * MiB;
constexpr size_t WS_WT_D = 710 * MiB;
constexpr size_t WS_WT_IN = 840 * MiB;
constexpr size_t WS_WT_FO = 872 * MiB;
constexpr size_t WS_WT_AO = 876 * MiB;
constexpr size_t WS_WT_O = 884 * MiB;
constexpr size_t WS_CST = 892 * MiB;
constexpr size_t WS_ET = 908 * MiB;
constexpr size_t WS_OT = 916 * MiB;
constexpr size_t WS_W2048 = 1 * MiB + 512 * 1024;
constexpr size_t WS_ALT = 1 * MiB + 520 * 1024;
constexpr size_t WS_RWT = 3 * MiB + 512 * 1024;
constexpr size_t WS_BD2 = 956 * MiB;
constexpr size_t WS_X2 = 960 * MiB;
constexpr size_t WS_END2 = 1024 * MiB;

namespace mk {
constexpr int NWAVES = 8, NTHREADS = 512;
constexpr int RING_BYTES = 131072, SCR_BYTES = 8 * 16640, LDSCTL_OFF = 135168, MISC_OFF = LDSCTL_OFF + 320, GPARK_OFF = LDSCTL_OFF + 2048  , LDS_BYTES = 147456;
static_assert(GPARK_OFF + 8192 <= LDS_BYTES, "LDS map");
static_assert(SCR_BYTES <= LDSCTL_OFF && MISC_OFF + 128 <= LDS_BYTES, "LDS map");

#define XB_TMO      128
#define XB_XCNT(j)  (256  + 64 * (j))
#define XB_XSUB(j)  (1280 + 64 * (j))
#define XB_XGEN(j)  (2304 + 64 * (j))
#define XB_TOP      3328
#define XB_TOPGEN   3392
#define XCD_BAR_WORDS 3456
#define XB_SPIN_CAP (1u << 18)
__device__ __forceinline__ unsigned xb_ld(unsigned* p)              { return __hip_atomic_load(p, __ATOMIC_RELAXED, __HIP_MEMORY_SCOPE_AGENT); }
__device__ __forceinline__ unsigned xb_add(unsigned* p, unsigned v) { return __hip_atomic_fetch_add(p, v, __ATOMIC_RELAXED, __HIP_MEMORY_SCOPE_AGENT); }
__device__ __forceinline__ unsigned xb_xcc_id() { return (unsigned)__builtin_amdgcn_s_getreg((3 << 11) | 20) & 0xFu; }
#define XB_SPIN(cond, bar) do { unsigned _sp = 0; while (cond) { __builtin_amdgcn_s_sleep(1); \
    if ((++_sp & 255u) == 0u) { if (xb_ld(&(bar)[XB_TMO])) break; if (_sp > XB_SPIN_CAP) { atomicAdd(&(bar)[XB_TMO], 1u); break; } } } } while (0)
struct XcdBarrier { unsigned* bar; unsigned x; volatile LAS unsigned* st; };
__device__ __forceinline__ XcdBarrier xcd_barrier_post(unsigned* bar, volatile LAS unsigned* st) {
    XcdBarrier b; b.bar = bar; b.x = xb_xcc_id(); b.st = st;
    if (threadIdx.x == 0) (void)xb_add(&bar[XB_XCNT(b.x)], 1u);
    return b;
}
__device__ __forceinline__ void xcd_barrier_complete(unsigned* bar, unsigned x, unsigned& nloc, unsigned& nx) {
    const unsigned G = gridDim.x * gridDim.y * gridDim.z;
    unsigned sum, cnt, mine, sp = 0u;
    for (;;) {
        sum = 0u; cnt = 0u; mine = 0u;
#pragma unroll
        for (unsigned j = 0; j < 16; ++j) { const unsigned c = xb_ld(&bar[XB_XCNT(j)]); sum += c; cnt += (c > 0u) ? 1u : 0u; mine = (j == x) ? c : mine; }
        if (sum == G) break;
        __builtin_amdgcn_s_sleep(1);
        if ((++sp & 255u) == 0u) { if (xb_ld(&bar[XB_TMO])) break; if (sp > XB_SPIN_CAP) { atomicAdd(&bar[XB_TMO], 1u); break; } }
    }
    nloc = mine > 0u ? mine : 1u; nx = cnt > 0u ? cnt : 1u;
}
__device__ __forceinline__ void xcd_barrier(const XcdBarrier& b) {
    asm volatile("s_waitcnt vmcnt(0)" ::: "memory");
    __syncthreads();
    if (threadIdx.x == 0) {
        unsigned* bar = b.bar;
        __builtin_amdgcn_s_waitcnt(0);
        unsigned nloc = b.st[0], nx = b.st[1];
        if (nloc == 0u) { xcd_barrier_complete(bar, b.x, nloc, nx); b.st[0] = nloc; b.st[1] = nx; }
        const unsigned old = xb_add(&bar[XB_XSUB(b.x)], 1u);
        const unsigned gen = old / nloc;
        if (old + 1u == (gen + 1u) * nloc) {
            __builtin_amdgcn_fence(__ATOMIC_RELEASE, "agent");
            asm volatile("s_waitcnt vmcnt(0)" ::: "memory");
            const unsigned og = xb_add(&bar[XB_TOP], 1u);
            const unsigned tg = og / nx;
            if (og + 1u == (tg + 1u) * nx) xb_add(&bar[XB_TOPGEN], 1u);
            else XB_SPIN(xb_ld(&bar[XB_TOPGEN]) == tg, bar);
            __builtin_amdgcn_fence(__ATOMIC_ACQUIRE, "agent");
            xb_add(&bar[XB_XGEN(b.x)], 1u);
            asm volatile("s_waitcnt vmcnt(0)" ::: "memory");
        } else {
            XB_SPIN(xb_ld(&bar[XB_XGEN(b.x)]) == gen, bar);
            __builtin_amdgcn_fence(__ATOMIC_ACQUIRE, "agent");
            asm volatile("s_waitcnt vmcnt(0)" ::: "memory");
        }
    }
    __syncthreads();
}

constexpr int BM = 256, BK = 64, HALF = 128, HTB = HALF * BK * 2, STAGE_BYTES = 8 * HTB;
__device__ __forceinline__ int lds_byte(int r, int c) { const int st = (r >> 4) * 2 + (c >> 5), rr = r & 15, cc = c & 31, ob = rr * 64 + cc * 2; return st * 1024 + (ob ^ (((ob >> 9) & 1) << 5)); }
__device__ __forceinline__ void stage_rc(int b, int& R, int& C) { const int st = b / 1024, sb = b % 1024, swz = sb ^ (((sb >> 9) & 1) << 5); R = (st >> 1) * 16 + swz / 64; C = (st & 1) * 32 + (swz % 64) / 2; }
__device__ __forceinline__ int perm32(int rho) { const int n = rho >> 4, i = rho & 15; return 8 * (i >> 2) + 4 * n + (i & 3); }
__device__ __forceinline__ unsigned cvt_pk_bf16(float lo, float hi) { unsigned r; asm("v_cvt_pk_bf16_f32 %0, %1, %2" : "=v"(r) : "v"(lo), "v"(hi)); return r; }

__device__ __forceinline__ void glds16_s(const void* sbase, unsigned voff, unsigned lds_dst) { unsigned keep;
    asm volatile("s_mov_b32 %0, m0\n\ts_mov_b32 m0, %3\n\ts_nop 0\n\tglobal_load_lds_dwordx4 %1, %2\n\ts_mov_b32 m0, %0" : "=&s"(keep) : "v"(voff), "s"(sbase), "s"(lds_dst) : "memory"); }

struct Unit { const char* A; const char* B; char* C; int ldc; int mode; int rows; int aux; int pm, pn, bjs, rmin; };

template <class Epi, class Sched, bool GATHER>
__device__ __forceinline__ void gemm_phase(LAS unsigned char* lds, const int K, const int lda, const int ldb, const Sched& S, const Epi& E, const int i0 = 0, const int i1 = 0x7fffffff) {
    const int tid = threadIdx.x, wid = __builtin_amdgcn_readfirstlane(tid >> 6), lane = tid & 63, wr = wid >> 2, wc = wid & 3, fr = lane & 15, fq = lane >> 4;
    const int nt = K / BK;
    unsigned voffA[2], voffB[2];
#pragma unroll
    for (int i = 0; i < 2; ++i) { int R, C; stage_rc(tid * 16 + i * 8192, R, C); const int Rb = (R & ~31) + perm32(R & 31);
        voffA[i] = (unsigned)(R * lda + C) * 2u; voffB[i] = (unsigned)(Rb * ldb + C) * 2u; }
    const size_t kstep = (size_t)(BK * 2);
    const size_t hstepA = (size_t)HALF * lda * 2, hstepB = (size_t)HALF * ldb * 2;
    const unsigned ldsw = (unsigned)wid * 1024u;
    const unsigned ldsbase = (unsigned)__builtin_amdgcn_readfirstlane((int)(unsigned)(uintptr_t)lds);
    const int aoff = lds_byte(wr * 64 + fr, fq * 8), boff = lds_byte(wc * 32 + fr, fq * 8);
#define MK_SA(b, h) (((b) * 2 + (h)) * HTB)
#define MK_SB(b, h) ((4 + (b) * 2 + (h)) * HTB)
#define MK_STAGE2(bufoff, gbase, v0, v1) do { \
        __builtin_amdgcn_global_load_lds((const unsigned*)((const char*)(gbase) + (v0)), (LAS unsigned*)(lds + (bufoff) + ldsw), 16, 0, 0); \
        __builtin_amdgcn_global_load_lds((const unsigned*)((const char*)(gbase) + (v1)), (LAS unsigned*)(lds + (bufoff) + ldsw + 8192), 16, 0, 0); } while (0)
#define MK_STAGE_B(bufoff, gbase) do { glds16_s((gbase), voffB[0], ldsbase + (bufoff) + ldsw); glds16_s((gbase), voffB[1], ldsbase + (bufoff) + ldsw + 8192u); } while (0)
#define MK_STAGE_A(bufoff, gbase, h, VA) do { if constexpr (GATHER) { glds16_s((gbase), (VA)[h][0], ldsbase + (bufoff) + ldsw); glds16_s((gbase), (VA)[h][1], ldsbase + (bufoff) + ldsw + 8192u); } \
        else { glds16_s((gbase) + (h) * hstepA, voffA[0], ldsbase + (bufoff) + ldsw); glds16_s((gbase) + (h) * hstepA, voffA[1], ldsbase + (bufoff) + ldsw + 8192u); } } while (0)
#define MK_LDA(dst, b, h) do { _Pragma("unroll") for (int m = 0; m < 4; ++m) _Pragma("unroll") for (int k = 0; k < 2; ++k) dst[m][k] = *(const LAS bf16x8*)(lds + MK_SA(b, h) + aoff + m * 2048 + k * 1024); } while (0)
#define MK_LDB(dst, b, h) do { _Pragma("unroll") for (int n = 0; n < 2; ++n) _Pragma("unroll") for (int k = 0; k < 2; ++k) dst[n][k] = *(const LAS bf16x8*)(lds + MK_SB(b, h) + boff + n * 2048 + k * 1024); } while (0)
#define MK_MMA(ai, bj, At, Bt) do { __builtin_amdgcn_s_setprio(1); _Pragma("unroll") for (int m = 0; m < 4; ++m) _Pragma("unroll") for (int n = 0; n < 2; ++n) _Pragma("unroll") for (int k = 0; k < 2; ++k) \
        acc[ai][bj][m][n] = __builtin_amdgcn_mfma_f32_16x16x32_bf16(Bt[n][k], At[m][k], acc[ai][bj][m][n], 0, 0, 0); __builtin_amdgcn_s_setprio(0); } while (0)
#define MK_WAIT_V(n) asm volatile("s_waitcnt vmcnt(" #n ")" ::: "memory")
#define MK_WAIT_L(n) asm volatile("s_waitcnt lgkmcnt(" #n ")" ::: "memory")
#define MK_BAR __builtin_amdgcn_s_barrier()
#define MK_SCHED __builtin_amdgcn_sched_barrier(0)
    Unit cur, nxt; int ui = i0;
    if (i0 >= i1 || !S.next(i0, cur)) return;
    f32x4 acc[2][2][4][2];
#pragma unroll
    for (int a = 0; a < 2; ++a)
#pragma unroll
        for (int b = 0; b < 2; ++b)
#pragma unroll
            for (int m = 0; m < 4; ++m)
#pragma unroll
                for (int n = 0; n < 2; ++n) acc[a][b][m][n] = (f32x4){0.f, 0.f, 0.f, 0.f};
    bf16x8 At[4][2], B0[2][2], B1[2][2];
    unsigned vC[2][2];
    LAS u32x4* vpark = (LAS u32x4*)(lds + GPARK_OFF) + tid;
    if constexpr (GATHER) {
#pragma unroll
        for (int h = 0; h < 2; ++h)
#pragma unroll
            for (int i = 0; i < 2; ++i) { int R, C; stage_rc(tid * 16 + i * 8192, R, C); vC[h][i] = S.arow(cur, h * HALF + R) + (unsigned)(C * 2); }
    }
    const char* cA = cur.A; const char* cB = cur.B;
    MK_STAGE_B(MK_SB(0, 0), cB); MK_STAGE_B(MK_SB(0, 1), cB + hstepB); MK_STAGE_A(MK_SA(0, 0), cA, 0, vC); MK_STAGE_A(MK_SA(0, 1), cA, 1, vC);
    if (wr == 1) MK_BAR;
    MK_WAIT_V(2); MK_BAR;
    MK_STAGE_B(MK_SB(1, 0), cB + kstep); MK_STAGE_A(MK_SA(1, 0), cA + kstep, 0, vC); MK_STAGE_B(MK_SB(1, 1), cB + hstepB + kstep);
    MK_WAIT_V(6); MK_BAR;
    for (;;) {
        const bool has_next = (ui + 1 < i1) && S.next(ui + 1, nxt);
        const char* nA = has_next ? nxt.A : cA; const char* nB = has_next ? nxt.B : cB;
        if constexpr (GATHER) {
            u32x4 pv;
#pragma unroll
            for (int h = 0; h < 2; ++h)
#pragma unroll
                for (int i = 0; i < 2; ++i) { int R, C; stage_rc(tid * 16 + i * 8192, R, C); pv[h * 2 + i] = has_next ? (S.arow(nxt, h * HALF + R) + (unsigned)(C * 2)) : vC[h][i]; }
            *vpark = pv;
        }
        for (int t = 0; t < nt; t += 2) {
            const bool last = (t == nt - 2);
            const char* a1 = cA + (size_t)(t + 1) * kstep;
            const char* a2 = last ? nA : cA + (size_t)(t + 2) * kstep; const char* b2 = last ? nB : cB + (size_t)(t + 2) * kstep;
            const char* a3 = a2 + kstep; const char* b3 = b2 + kstep;
            MK_LDB(B0, 0, 0); MK_LDB(B1, 0, 1); MK_SCHED; MK_LDA(At, 0, 0); MK_STAGE_A(MK_SA(1, 1), a1, 1, vC);
            if constexpr (GATHER) { if (last) { const u32x4 pv = *vpark; vC[0][0] = pv[0]; vC[0][1] = pv[1]; vC[1][0] = pv[2]; vC[1][1] = pv[3]; } }
            MK_WAIT_V(8); MK_WAIT_L(0); MK_BAR; MK_MMA(0, 0, At, B0); MK_MMA(0, 1, At, B1); MK_BAR; MK_SCHED;
            MK_LDA(At, 0, 1); MK_STAGE_B(MK_SB(0, 0), b2); MK_STAGE_B(MK_SB(0, 1), b2 + hstepB); MK_STAGE_A(MK_SA(0, 0), a2, 0, vC);
            MK_WAIT_V(8); MK_WAIT_L(0); MK_BAR; MK_MMA(1, 0, At, B0); MK_MMA(1, 1, At, B1); MK_BAR; MK_SCHED;
            MK_LDB(B0, 1, 0); MK_LDB(B1, 1, 1); MK_SCHED; MK_LDA(At, 1, 0); MK_STAGE_A(MK_SA(0, 1), a2, 1, vC);
            MK_WAIT_V(8); MK_WAIT_L(0); MK_BAR; MK_MMA(0, 0, At, B0); MK_MMA(0, 1, At, B1); MK_BAR; MK_SCHED;
            MK_LDA(At, 1, 1); MK_STAGE_B(MK_SB(1, 0), b3); MK_STAGE_B(MK_SB(1, 1), b3 + hstepB); MK_STAGE_A(MK_SA(1, 0), a3, 0, vC);
            MK_WAIT_V(8); MK_WAIT_L(0); MK_BAR; MK_MMA(1, 0, At, B0); MK_MMA(1, 1, At, B1); MK_BAR; MK_SCHED;
        }
        if (wr == 0) MK_BAR;
        E(acc, cur, wr, wc, fr, fq);
        if (!has_next) break;
#pragma unroll
        for (int a = 0; a < 2; ++a)
#pragma unroll
            for (int b = 0; b < 2; ++b)
#pragma unroll
                for (int m = 0; m < 4; ++m)
#pragma unroll
                    for (int n = 0; n < 2; ++n) acc[a][b][m][n] = (f32x4){0.f, 0.f, 0.f, 0.f};
        cur = nxt; cA = nA; cB = nB; ++ui;
        if (wr == 1) MK_BAR;
    }
    MK_WAIT_V(0);
    MK_BAR;
#undef MK_SA
#undef MK_SB
#undef MK_STAGE2
#undef MK_STAGE_B
#undef MK_STAGE_A
#undef MK_LDA
#undef MK_LDB
#undef MK_MMA
#undef MK_WAIT_V
#undef MK_WAIT_L
#undef MK_BAR
#undef MK_SCHED
}

__device__ __forceinline__ void grid_map(int L, int nM, int nN, int& pm, int& pn) {
    const int nwg = nM * nN, q = nwg / 8, xcd = L % 8, off = L / 8; const int wgid = xcd * q + off;
    const int nig = 8 * nN, gid = wgid / nig, fm = gid * 8, gsz = (nM - fm) < 8 ? (nM - fm) : 8;
    pm = fm + ((wgid % nig) % gsz); pn = (wgid % nig) / gsz;
}

struct EpiStore {
    const float* w2048;
    __device__ __forceinline__ void operator()(const f32x4 (&acc)[2][2][4][2], const Unit& u, int wr, int wc, int fr, int fq) const {
        const int col0 = wc * 32 + 8 * fq;
#pragma unroll
        for (int ai = 0; ai < 2; ++ai)
#pragma unroll
            for (int m = 0; m < 4; ++m) {
                const int r = ai * HALF + wr * 64 + m * 16 + fr;
                if (r < u.rows && r >= u.rmin) {
#pragma unroll
                    for (int bj = 0; bj < 2; ++bj) {
                        f32x4 v0 = acc[ai][bj][m][0], v1 = acc[ai][bj][m][1];
                        if (u.mode == 1) { float* p = (float*)u.C + (long)r * u.ldc + col0 + bj * u.bjs; *(f32x4*)p = v0; *(f32x4*)(p + 4) = v1; }
                        else {
                            if (u.mode == 2) {
#pragma unroll
                                for (int c = 0; c < 4; ++c) { v0[c] = __builtin_amdgcn_rcpf(1.0f + __expf(-v0[c])); v1[c] = __builtin_amdgcn_rcpf(1.0f + __expf(-v1[c])); }
                            } else if (u.mode == 3) {
                                const float* wp = w2048 + u.pn + bj * HALF + col0; const float sg = (r & 1) ? -1.0f : 1.0f;
                                v0 += *(const f32x4*)wp * sg; v1 += *(const f32x4*)(wp + 4) * sg;
                            }
                            u32x4 w; w.x = cvt_pk_bf16(v0[0], v0[1]); w.y = cvt_pk_bf16(v0[2], v0[3]); w.z = cvt_pk_bf16(v1[0], v1[1]); w.w = cvt_pk_bf16(v1[2], v1[3]);
                            *(u32x4*)((bf16_t*)u.C + (long)r * u.ldc + col0 + bj * u.bjs) = w;
                        }
                    }
                }
            }
    }
};

struct Args { const float* in[22]; float* out; unsigned char* ws; int ph_lo, ph_hi, use_ut, mod_off, do_attn, bar_idx; };
struct Frame {
    LAS unsigned char* lds; volatile LAS unsigned* MISC; unsigned char* ws;
    int tid, lane, wave, vcu, G;
};

__device__ __forceinline__ void t64_load(f32x4 (&v)[16], const float* W, int ldw, int lane) {
    const unsigned off = (unsigned)(((lane >> 4) * ldw + (lane & 15) * 4) * 4);
#pragma unroll
    for (int j = 0; j < 16; ++j) { const char* bj = (const char*)W + (size_t)(j * 4) * ldw * 4; v[j] = __builtin_nontemporal_load((const GAS f32x4*)(bj + off)); }
}
__device__ __forceinline__ void t64_store(const f32x4 (&v)[16], bf16_t* dst, int ldd, LAS float* scr, int lane) {
    const int kk = lane >> 4, nc = (lane & 15) * 4;
#pragma unroll
    for (int j = 0; j < 16; ++j) {
#pragma unroll
        for (int c = 0; c < 4; ++c) scr[(j * 4 + kk) * 65 + nc + c] = v[j][c]; }
    LDS_WAIT(); asm volatile("" ::: "memory");
    const int kc = lane & 7; const unsigned soff = (unsigned)(((lane >> 3) * ldd + 8 * kc) * 2);
#pragma unroll
    for (int jj = 0; jj < 8; jj += 2) {
        float t[2][8];
#pragma unroll
        for (int q = 0; q < 2; ++q) { const int n = (lane >> 3) + 8 * (jj + q); const LAS float* s = scr + (8 * kc) * 65 + n;
#pragma unroll
            for (int i = 0; i < 8; ++i) t[q][i] = s[i * 65]; }
#pragma unroll
        for (int q = 0; q < 2; ++q) { char* bq = (char*)dst + (size_t)(8 * (jj + q)) * ldd * 2;
            u32x4 o; o.x = cvt_pk_bf16(t[q][0], t[q][1]); o.y = cvt_pk_bf16(t[q][2], t[q][3]); o.z = cvt_pk_bf16(t[q][4], t[q][5]); o.w = cvt_pk_bf16(t[q][6], t[q][7]);
            __builtin_nontemporal_store(o, (GAS u32x4*)(bq + soff)); } }
    LDS_WAIT(); asm volatile("" ::: "memory");
}
__device__ __forceinline__ void transpose64(const float* W, int ldw, bf16_t* dst, int ldd, LAS float* scr, int lane) {
    f32x4 v[16]; t64_load(v, W, ldw, lane); t64_store(v, dst, ldd, scr, lane);
}

constexpr int IT_IN = 32 * 128, IT_FO = 16 * 32, IT_AO = 32 * 32, IT_O = 32 * 32, IT_EG = 64 * 256, IT_EU = 64 * 256, IT_ED = 64 * 256, IT_SH = 256;
constexpr int IT_T_END = IT_IN + IT_FO + IT_AO + IT_O + 3 * IT_SH;
constexpr int IT_MOD = MODC / 32, IT_CST = 4096, IT_BD2 = 512, IT_RWT = 32;
constexpr int IT_ALL = IT_T_END + IT_MOD + IT_CST + IT_BD2 + IT_RWT;

__device__ __forceinline__ void mod_item(const Args& args, unsigned char* ws, int r, int lane) {
            const int kq = lane >> 3, col = r * 32 + (lane & 7) * 4;
            f32x4 a0 = {0.f, 0.f, 0.f, 0.f}, a1 = a0, a2 = a0;
            for (int jb = 0; jb < 256; jb += 8) {
                f32x4 w[8]; float c0[8], c1[8], c2[8];
#pragma unroll
                for (int j = 0; j < 8; ++j) { const int k = kq + 8 * (jb + j); w[j] = *(const GAS f32x4*)(args.in[4] + (size_t)k * MODC + col); c0[j] = args.in[1][k]; c1[j] = args.in[1][DM + k]; c2[j] = args.in[3][k]; }
#pragma unroll
                for (int j = 0; j < 8; ++j) { a0 += w[j] * (c0[j] * __builtin_amdgcn_rcpf(1.0f + __expf(-c0[j]))); a1 += w[j] * (c1[j] * __builtin_amdgcn_rcpf(1.0f + __expf(-c1[j]))); a2 += w[j] * (c2[j] * __builtin_amdgcn_rcpf(1.0f + __expf(-c2[j]))); }
            }
#pragma unroll
            for (int c = 0; c < 4; ++c) {
#pragma unroll
                for (int o = 8; o < 64; o <<= 1) { a0[c] += __shfl_xor(a0[c], o); a1[c] += __shfl_xor(a1[c], o); a2[c] += __shfl_xor(a2[c], o); } }
            if (kq == 0) { const f32x4 bb = *(const GAS f32x4*)(args.in[5] + col); float* MODP = (float*)(ws + WS_MOD);
                *(GAS f32x4*)(MODP + col) = a0 + bb; *(GAS f32x4*)(MODP + MODC + col) = a1 + bb; *(GAS f32x4*)(MODP + 2 * MODC + col) = a2 + bb; }
}
__device__ __forceinline__ void p0_prologue(Frame& F, const Args& args) {
    LAS float* scr = (LAS float*)(F.lds + F.wave * 16640);
    const int gw = F.vcu * NWAVES + F.wave, NGW = F.G * NWAVES, lane = F.lane;
    unsigned char* ws = F.ws;
    bf16_t* WT_IN = (bf16_t*)(ws + WS_WT_IN); bf16_t* WT_FO = (bf16_t*)(ws + WS_WT_FO); bf16_t* WT_AO = (bf16_t*)(ws + WS_WT_AO); bf16_t* WT_O = (bf16_t*)(ws + WS_WT_O);
    bf16_t* WT_GU = (bf16_t*)(ws + WS_WT_GU); bf16_t* WT_D = (bf16_t*)(ws + WS_WT_D);
    if (NGW >= 5 * IT_MOD) { if (gw % 5 == 0 && gw / 5 < IT_MOD) mod_item(args, ws, gw / 5, lane); }
    else for (int m = gw; m < IT_MOD; m += NGW) mod_item(args, ws, m, lane);
    for (int it = gw; it < IT_ALL - IT_MOD; it += NGW) {
        int r = it;
        if (r < IT_IN) { const int kb = r / 128, nb = r % 128; transpose64(args.in[7] + (size_t)(kb * 64) * INC + nb * 64, INC, WT_IN + (size_t)(nb * 64) * DM + kb * 64, DM, scr, lane); continue; } r -= IT_IN;
        if (r < IT_FO) { const int kb = r / 32, nb = r % 32; transpose64(args.in[10] + (size_t)(kb * 64) * DM + nb * 64, DM, WT_FO + (size_t)(nb * 64) * FW + kb * 64, FW, scr, lane); continue; } r -= IT_FO;
        if (r < IT_AO) { const int kb = r / 32, nb = r % 32; transpose64(args.in[11] + (size_t)(kb * 64) * DM + nb * 64, DM, WT_AO + (size_t)(nb * 64) * DM + kb * 64, DM, scr, lane); continue; } r -= IT_AO;
        if (r < IT_O) { const int kb = r / 32, nb = r % 32; transpose64(args.in[12] + (size_t)(kb * 64) * DM + nb * 64, DM, WT_O + (size_t)(nb * 64) * DM + kb * 64, DM, scr, lane); continue; } r -= IT_O;
        if (r < 2 * IT_SH) { const int up = r >= IT_SH; if (up) r -= IT_SH; const int kb = r / 8, nb = r % 8, n0 = nb * 64;
            transpose64((up ? args.in[20] : args.in[19]) + (size_t)(kb * 64) * EFF + n0, EFF, WT_GU + ((size_t)64 * 1024 + (n0 >> 7) * 256 + (up ? 128 : 0) + (n0 & 127)) * DM + kb * 64, DM, scr, lane); continue; } r -= 2 * IT_SH;
        if (r < IT_SH) { const int kb = r / 32, nb = r % 32;
            transpose64(args.in[21] + (size_t)(kb * 64) * DM + nb * 64, DM, WT_D + ((size_t)64 * DM + nb * 64) * EFF + kb * 64, EFF, scr, lane); continue; } r -= IT_SH;

        if (r < IT_CST) {
            const int k1 = r & 2047; bf16_t* dst = (bf16_t*)(ws + WS_CST) + (size_t)r * 2048;
#pragma unroll
            for (int j = 0; j < 4; ++j) { const int n0 = j * 512 + lane * 8; float f[8];
#pragma unroll
                for (int i = 0; i < 8; ++i) { const float ph = (float)((k1 * (n0 + i)) & 4095) * (1.0f / 2048.0f); f[i] = r < 2048 ? cospif(ph) : sinpif(ph); }
                u32x4 o; o.x = cvt_pk_bf16(f[0], f[1]); o.y = cvt_pk_bf16(f[2], f[3]); o.z = cvt_pk_bf16(f[4], f[5]); o.w = cvt_pk_bf16(f[6], f[7]);
                *(GAS u32x4*)(dst + n0) = o; }
            continue; } r -= IT_CST;
        if (r < IT_BD2) {
            const int t = r >> 8, o = r & 255, gp = o >> 7, k2 = o & 127; bf16_t* dst = (bf16_t*)(ws + WS_BD2) + (size_t)r * 512; float f[8];
#pragma unroll
            for (int i = 0; i < 8; ++i) { const int j = lane * 8 + i, cg = j >> 8, jj = j & 255, c = jj & 127; const float ph = (float)((32 * c * k2) & 4095) * (1.0f / 2048.0f);
                const float v = jj < 128 ? cospif(ph) : (t ? sinpif(ph) : -sinpif(ph)); f[i] = cg == gp ? v * 0.0013810679320049757f : 0.f; }
            u32x4 w; w.x = cvt_pk_bf16(f[0], f[1]); w.y = cvt_pk_bf16(f[2], f[3]); w.z = cvt_pk_bf16(f[4], f[5]); w.w = cvt_pk_bf16(f[6], f[7]);
            *(GAS u32x4*)(dst + lane * 8) = w;
            continue; } r -= IT_BD2;
        {
            f32x4 v[16]; t64_load(v, args.in[14] + (size_t)(r * 64) * NE, NE, lane);
            const int kk = lane >> 4, nc = (lane & 15) * 4;
#pragma unroll
            for (int j = 0; j < 16; ++j) {
#pragma unroll
                for (int c = 0; c < 4; ++c) scr[(j * 4 + kk) * 65 + nc + c] = v[j][c]; }
            LDS_WAIT(); asm volatile("" ::: "memory");
            const int kc = lane & 7; bf16_t* RWT = (bf16_t*)(ws + WS_RWT);
#pragma unroll
            for (int jj = 0; jj < 8; ++jj) { const int e = (lane >> 3) + 8 * jj; const LAS float* s = scr + (8 * kc) * 65 + e; float t[8], l[8];
#pragma unroll
                for (int i = 0; i < 8; ++i) { t[i] = s[i * 65]; l[i] = t[i] - bf2f(f2bf(t[i])); }
                u32x4 h, lo; h.x = cvt_pk_bf16(t[0], t[1]); h.y = cvt_pk_bf16(t[2], t[3]); h.z = cvt_pk_bf16(t[4], t[5]); h.w = cvt_pk_bf16(t[6], t[7]);
                lo.x = cvt_pk_bf16(l[0], l[1]); lo.y = cvt_pk_bf16(l[2], l[3]); lo.z = cvt_pk_bf16(l[4], l[5]); lo.w = cvt_pk_bf16(l[6], l[7]);
                *(GAS u32x4*)(RWT + (size_t)e * DM + r * 64 + 8 * kc) = h; *(GAS u32x4*)(RWT + (size_t)(NE + e) * DM + r * 64 + 8 * kc) = lo; }
            LDS_WAIT(); asm volatile("" ::: "memory");
        }
    }
}


__device__ __forceinline__ void conv_addr(const Args& args, unsigned char* ws, bool down, int it, const float*& W, int& ldw, bf16_t*& dst, int& ldd) {
    if (!down) { int r = it; const int up = r >= IT_EG; if (up) r -= IT_EG;
        const int e = r / 256, q = r % 256, kb = q / 8, nb = q % 8, n0 = nb * 64;
        W = (up ? args.in[17] : args.in[16]) + (size_t)e * DM * EFF + (size_t)(kb * 64) * EFF + n0; ldw = EFF;
        dst = (bf16_t*)(ws + WS_WT_GU) + ((size_t)e * 1024 + (n0 >> 7) * 256 + (up ? 128 : 0) + (n0 & 127)) * DM + kb * 64; ldd = DM;
    } else { const int r = it, e = r / 256, q = r % 256, kb = q / 32, nb = q % 32;
        W = args.in[18] + (size_t)e * EFF * DM + (size_t)(kb * 64) * DM + nb * 64; ldw = DM;
        dst = (bf16_t*)(ws + WS_WT_D) + ((size_t)e * DM + nb * 64) * EFF + kb * 64; ldd = EFF; }
}
__device__ __forceinline__ void conv_items(Frame& F, const Args& args, bool down, int first, int count) {
    LAS float* scr = (LAS float*)(F.lds + F.wave * 16640);
    const int end = first + count; int it = first + F.wave;
    if (it >= end) return;
    f32x4 va[16], vb[16]; const float* W; int ldw; bf16_t* da; bf16_t* db; int ldd;
    conv_addr(args, F.ws, down, it, W, ldw, da, ldd); t64_load(va, W, ldw, F.lane);
    for (;;) {
        const bool hb = it + NWAVES < end;
        if (hb) { conv_addr(args, F.ws, down, it + NWAVES, W, ldw, db, ldd); t64_load(vb, W, ldw, F.lane); }
        t64_store(va, da, ldd, scr, F.lane);
        if (!hb) break;
        const bool ha = it + 2 * NWAVES < end;
        if (ha) { conv_addr(args, F.ws, down, it + 2 * NWAVES, W, ldw, da, ldd); t64_load(va, W, ldw, F.lane); }
        t64_store(vb, db, ldd, scr, F.lane);
        if (!ha) break;
        it += 2 * NWAVES;
    }
}
struct SchedIn {
    int G, c; unsigned char* ws; int use_ut;
    __device__ __forceinline__ bool next(int i, Unit& u) const {
        const int L = i * G + c; if (L >= 1024) return false;
        const char* H = (const char*)(ws + WS_H); const char* WT = (const char*)(ws + WS_WT_IN);
        u.rows = 256; u.aux = 0; u.bjs = HALF; u.pm = 0; u.pn = 0; u.rmin = 0;
        if (L < 896) {
            int pm, ct; grid_map(L, 32, 28, pm, ct);
            const int row0 = pm * 256, b = row0 / SEQ, t0 = row0 % SEQ;
            u.A = H + (size_t)row0 * DM * 2; u.B = WT + (size_t)ct * 256 * DM * 2;
            if (ct < 4) {
                if (use_ut) { u.A = WT + (size_t)ct * 256 * DM * 2; u.B = H + (size_t)row0 * DM * 2;
                              u.C = (char*)(ws + WS_UT) + (((size_t)b * FW + ct * 256) * SEQ + t0) * 2; u.ldc = SEQ; u.mode = 0; }
                else { u.C = (char*)(ws + WS_U) + ((size_t)row0 * FW + ct * 256) * 2; u.ldc = FW; u.mode = 0; }
            }
            else if (ct < 14) { u.C = (char*)(ws + WS_QKRAW) + ((size_t)row0 * 2560 + (ct - 4) * 256) * 4; u.ldc = 2560; u.mode = 1; }
            else if (ct < 16) { u.C = (char*)(ws + WS_VALL) + (((size_t)b * SKV + t0) * KVW + (ct - 14) * 256) * 2; u.ldc = KVW; u.mode = 0; }
            else if (ct < 24) { u.C = (char*)(ws + WS_SGF) + ((size_t)row0 * DM + (ct - 16) * 256) * 2; u.ldc = DM; u.mode = 2; }
            else              { u.C = (char*)(ws + WS_SGA) + ((size_t)row0 * DM + (ct - 24) * 256) * 2; u.ldc = DM; u.mode = 2; }
        } else if (L >= 904) {
            int pm, q; grid_map(L - 904, 32, 4, pm, q); const int ct = 28 + q;
            u.A = H + (size_t)pm * 256 * DM * 2; u.B = WT + (size_t)ct * 256 * DM * 2;
            u.C = (char*)(ws + WS_SGA) + ((size_t)pm * 256 * DM + (ct - 24) * 256) * 2; u.ldc = DM; u.mode = 2;
        } else {
            const int l = L - 896, pm = l & 1, ct = l >> 1;
            u.A = H + (size_t)(NTOK + pm * 256) * DM * 2; u.B = WT + (size_t)(K_OFF + ct * 256) * DM * 2;
            if (ct < 2) { u.C = (char*)(ws + WS_KCRAW) + ((size_t)(pm * 256) * KVW + ct * 256) * 4; u.ldc = KVW; u.mode = 1; }
            else        { u.C = (char*)(ws + WS_VALL) + (((size_t)pm * SKV + SEQ) * KVW + (ct - 2) * 256) * 2; u.ldc = KVW; u.mode = 0; }
        }
        return true;
    }
    __device__ __forceinline__ unsigned arow(const Unit&, int) const { return 0u; }
};


__device__ __forceinline__ void unpack8(u32x4 w, float (&f)[8]) {
#pragma unroll
    for (int i = 0; i < 4; ++i) { f[2 * i] = __uint_as_float(w[i] << 16); f[2 * i + 1] = __uint_as_float(w[i] & 0xffff0000u); }
}
struct EpiT1 { const bf16_t* SGF; float* T1;
    __device__ __forceinline__ void operator()(const f32x4 (&acc)[2][2][4][2], const Unit& u, int wr, int wc, int fr, int fq) const {
#pragma unroll
        for (int ai = 0; ai < 2; ++ai)
#pragma unroll
            for (int m = 0; m < 4; ++m) { const size_t row = (size_t)u.pm * 256 + ai * HALF + wr * 64 + m * 16 + fr;
#pragma unroll
                for (int bj = 0; bj < 2; ++bj) { const size_t o = row * DM + u.pn * 256 + bj * HALF + wc * 32 + 8 * fq;
                    float g[8]; unpack8(*(const u32x4*)(SGF + o), g); const f32x4 v0 = acc[ai][bj][m][0], v1 = acc[ai][bj][m][1];
                    *(f32x4*)(T1 + o) = (f32x4){g[0] * v0[0], g[1] * v0[1], g[2] * v0[2], g[3] * v0[3]};
                    *(f32x4*)(T1 + o + 4) = (f32x4){g[4] * v1[0], g[5] * v1[1], g[6] * v1[2], g[7] * v1[3]}; } }
    } };
struct EpiYM { const bf16_t* SGA; const float* T1; bf16_t* YM;
    __device__ __forceinline__ void operator()(const f32x4 (&acc)[2][2][4][2], const Unit& u, int wr, int wc, int fr, int fq) const {
#pragma unroll
        for (int ai = 0; ai < 2; ++ai)
#pragma unroll
            for (int m = 0; m < 4; ++m) { const size_t row = (size_t)u.pm * 256 + ai * HALF + wr * 64 + m * 16 + fr;
#pragma unroll
                for (int bj = 0; bj < 2; ++bj) { const size_t o = row * DM + u.pn * 256 + bj * HALF + wc * 32 + 8 * fq;
                    float g[8]; unpack8(*(const u32x4*)(SGA + o), g); const f32x4 v0 = acc[ai][bj][m][0], v1 = acc[ai][bj][m][1];
                    const f32x4 t0 = *(const f32x4*)(T1 + o), t1 = *(const f32x4*)(T1 + o + 4);
                    u32x4 w; w.x = cvt_pk_bf16(t0[0] + g[0] * v0[0], t0[1] + g[1] * v0[1]); w.y = cvt_pk_bf16(t0[2] + g[2] * v0[2], t0[3] + g[3] * v0[3]);
                    w.z = cvt_pk_bf16(t1[0] + g[4] * v1[0], t1[1] + g[5] * v1[1]); w.w = cvt_pk_bf16(t1[2] + g[6] * v1[2], t1[3] + g[7] * v1[3]);
                    *(u32x4*)(YM + o) = w; } }
    } };
struct EpiX2 { const float* x; const float* mod; float* X2;
    __device__ __forceinline__ void operator()(const f32x4 (&acc)[2][2][4][2], const Unit& u, int wr, int wc, int fr, int fq) const {
        const float* g1 = mod + ((u.pm * 256) / SEQ) * MODC + 2 * DM;
#pragma unroll
        for (int ai = 0; ai < 2; ++ai)
#pragma unroll
            for (int m = 0; m < 4; ++m) { const size_t row = (size_t)u.pm * 256 + ai * HALF + wr * 64 + m * 16 + fr;
#pragma unroll
                for (int bj = 0; bj < 2; ++bj) { const int col = u.pn * 256 + bj * HALF + wc * 32 + 8 * fq; const size_t o = row * DM + col;
#pragma unroll
                    for (int n = 0; n < 2; ++n) { const f32x4 xv = *(const f32x4*)(x + o + 4 * n), gv = *(const f32x4*)(g1 + col + 4 * n); *(f32x4*)(X2 + o + 4 * n) = xv + gv * acc[ai][bj][m][n]; } } }
    } };
struct EpiAct {
    __device__ __forceinline__ void operator()(const f32x4 (&acc)[2][2][4][2], const Unit& u, int wr, int wc, int fr, int fq) const {
#pragma unroll
        for (int ai = 0; ai < 2; ++ai)
#pragma unroll
            for (int m = 0; m < 4; ++m) { const int r = ai * HALF + wr * 64 + m * 16 + fr;
                if (r < u.rows) { float a[8];
#pragma unroll
                    for (int n = 0; n < 2; ++n)
#pragma unroll
                        for (int c = 0; c < 4; ++c) { const float g = acc[ai][0][m][n][c], up = acc[ai][1][m][n][c]; a[4 * n + c] = g * __builtin_amdgcn_rcpf(1.0f + __expf(-g)) * up; }
                    u32x4 w; w.x = cvt_pk_bf16(a[0], a[1]); w.y = cvt_pk_bf16(a[2], a[3]); w.z = cvt_pk_bf16(a[4], a[5]); w.w = cvt_pk_bf16(a[6], a[7]);
                    *(u32x4*)((bf16_t*)u.C + (size_t)r * u.ldc + wc * 32 + 8 * fq) = w; } }
    } };

struct SchedGrid {
    int G, c, nM, nN; const char* A; const char* B; char* C; size_t astride, bstride; int ldc, esz, mode;
    __device__ __forceinline__ bool next(int i, Unit& u) const {
        const int L = i * G + c; if (L >= nM * nN) return false;
        int pm, pn; grid_map(L, nM, nN, pm, pn);
        u.A = A + (size_t)pm * astride; u.B = B + (size_t)pn * bstride; u.C = C + ((size_t)pm * 256 * ldc + pn * 256) * esz; u.ldc = ldc; u.mode = mode; u.rows = 256; u.aux = 0; u.pm = pm; u.pn = pn; u.bjs = HALF; u.rmin = 0;
        return true; }
    __device__ __forceinline__ unsigned arow(const Unit&, int) const { return 0u; } };
struct SchedAG { int G, c; unsigned char* ws;
    __device__ __forceinline__ bool next(int i, Unit& u) const {
        const int L = i * G + c; if (L >= 136) return false;
        u.rows = 256; u.aux = 0; u.rmin = 0;
        if (L < 128) {
            int pm, pn8; grid_map(L, 16, 8, pm, pn8); const int b = pn8 >> 2, pn = pn8 & 3, sn = pm >> 3, k1t = pm & 7;
            u.A = (const char*)(ws + WS_CST) + (size_t)pm * 256 * 2048 * 2; u.B = (const char*)(ws + (sn ? WS_OT : WS_ET)) + ((size_t)b * FW + pn * 256) * 2048 * 2;
            u.C = (char*)(ws + WS_TT) + (((size_t)b * 2048 + k1t * 256) * DM + pn * 512 + sn * 128) * 2; u.ldc = DM; u.mode = sn ? 0 : 3; u.pm = k1t; u.pn = b * FW + pn * 256; u.bjs = 256;
        } else {
            int pm, q; grid_map(L - 128 + 120, 32, 4, pm, q); const int ct = 28 + q;
            u.A = (const char*)(ws + WS_H) + (size_t)pm * 256 * DM * 2; u.B = (const char*)(ws + WS_WT_IN) + (size_t)ct * 256 * DM * 2;
            u.C = (char*)(ws + WS_SGA) + ((size_t)pm * 256 * DM + (ct - 24) * 256) * 2; u.ldc = DM; u.mode = 2; u.pm = pm; u.pn = ct; u.bjs = HALF;
        }
        return true; }
    __device__ __forceinline__ unsigned arow(const Unit&, int) const { return 0u; } };
struct SchedF2 { int G, c; unsigned char* ws;
    __device__ __forceinline__ bool next(int i, Unit& u) const {
        const int L = i * G + c; if (L >= 128) return false;
        int pm, q; grid_map(L, 16, 8, pm, q); const int b = pm >> 3, k1t = pm & 7, j = q & 3, mir = q >> 2;
        u.A = (const char*)(ws + WS_TT) + (((size_t)b * 2048 + k1t * 256) * DM + j * 512) * 2; u.B = (const char*)(ws + WS_BD2) + (size_t)mir * 256 * 512 * 2;
        u.mode = 0; u.rows = 256; u.aux = 0; u.pm = pm; u.pn = j; u.bjs = HALF;
        if (!mir) { u.C = (char*)(ws + WS_YF) + (((size_t)b * SEQ + k1t * 256) * FW + j * 256) * 2; u.ldc = FW; u.rmin = 0; }
        else { u.C = (char*)(ws + WS_YF) + (((size_t)b * SEQ + SEQ - k1t * 256) * FW + j * 256) * 2; u.ldc = -FW; u.rmin = k1t == 0 ? 1 : 0; }
        return true; }
    __device__ __forceinline__ unsigned arow(const Unit&, int) const { return 0u; } };
constexpr int SCHT_OFF = LDSCTL_OFF + 1024;
__device__ __forceinline__ void moe_tables(Frame& F, int ncol_tiles) {
    LAS int* T = (LAS int*)(F.lds + SCHT_OFF);
    __syncthreads();
    if (F.tid == 0) { const int* CNT = (const int*)(F.ws + CTL_CNT); int up = 0, of = 0;
        for (int e = 0; e <= NE; ++e) { const int cn = e < NE ? CNT[e * 64] : NTOK; T[e] = up; T[80 + e] = e < NE ? of : NSLOT; T[160 + e] = cn; up += ((cn + 255) >> 8) * ncol_tiles; of += cn; }
        T[NE + 1] = up; }
    __syncthreads();
}
template <int NCT, bool FIRST> struct SchedMoe {
    int G, c; unsigned char* ws; LAS int* T; const int* TOK;
    __device__ __forceinline__ bool next(int i, Unit& u) const {
        const int L = i * G + c; if (L >= T[NE + 1]) return false;
        int lo = 0, hi = NE;
#pragma unroll 1
        while (lo < hi) { const int mid = (lo + hi + 1) >> 1; if (T[mid] <= L) lo = mid; else hi = mid - 1; }
        const int e = lo, cn = T[160 + e], ntile = (cn + 255) >> 8, local = L - T[e], ct = local / ntile, mt = local % ntile, slot0 = T[80 + e] + mt * 256;
        u.rows = (cn - mt * 256) < 256 ? (cn - mt * 256) : 256; u.aux = slot0; u.pm = mt; u.pn = ct; u.bjs = HALF; u.mode = 0; u.rmin = 0;
        if (FIRST) { u.A = (const char*)(ws + WS_H2); u.B = (const char*)(ws + WS_WT_GU) + ((size_t)e * 4 + ct) * 256 * DM * 2; u.C = (char*)(ws + WS_ACT) + ((size_t)slot0 * EFF + ct * 128) * 2; u.ldc = EFF; }
        else { u.A = (const char*)(ws + WS_ACT) + (size_t)slot0 * EFF * 2; u.B = (const char*)(ws + WS_WT_D) + ((size_t)e * DM + ct * 256) * EFF * 2; u.C = (char*)(ws + WS_YBIG) + ((size_t)slot0 * DM + ct * 256) * 2; u.ldc = DM; }
        return true; }
    __device__ __forceinline__ unsigned arow(const Unit& u, int r) const { const int rr = r < u.rows ? r : u.rows - 1; return (unsigned)TOK[u.aux + rr] * (unsigned)(DM * 2); } };

namespace attn {
using s16x4 = __attribute__((ext_vector_type(4))) short;
using f32x8 = __attribute__((ext_vector_type(8))) float;
constexpr int D = 128, NW = 8, QBLK = 32, KVBLK = 64;
constexpr float SCALE = 0.088388347648318440f;
constexpr float THR = 8.f;
constexpr int LDQ = DM, LDK = KVW, LDO = DM;
constexpr size_t SHM_V = KVBLK * D * 2, SHM_K = KVBLK * D * 2, SHM_ATTN = 2 * SHM_V + 2 * SHM_K + NW * 64 * 4;
#define KSWZ(row, colB) ((row) * 256 + ((colB) ^ (((row) & 7) << 4)))
#define SBAR() __builtin_amdgcn_sched_barrier(0)
__device__ __forceinline__ unsigned cvtpk(float lo, float hi) { unsigned r; asm volatile("v_cvt_pk_bf16_f32 %0, %1, %2" : "=v"(r) : "v"(lo), "v"(hi)); return r; }
__device__ __forceinline__ void partialSM(f32x16& p0, f32x16& p1, float& m_reg, float& mn, float& alpha) {
  constexpr float C = SCALE * 1.4426950408889634f;
  float pmax = p0[0]; for (int r = 1; r < 16; ++r) pmax = fmaxf(pmax, p0[r]); for (int r = 0; r < 16; ++r) pmax = fmaxf(pmax, p1[r]);
  { auto rr = __builtin_amdgcn_permlane32_swap(__float_as_uint(pmax), __float_as_uint(pmax), false, false);
    pmax = fmaxf(__uint_as_float(rr[0]), __uint_as_float(rr[1])); }
  if (__builtin_expect(__all(pmax - m_reg <= THR / SCALE), 1)) { mn = m_reg; alpha = 1.f; }
  else { mn = fmaxf(m_reg, pmax); alpha = __builtin_amdgcn_exp2f((m_reg - mn) * C); m_reg = mn; }
  float mnC = -mn * C;
  for (int r = 0; r < 16; ++r) p0[r] = fmaf(p0[r], C, mnC); for (int r = 0; r < 16; ++r) p1[r] = fmaf(p1[r], C, mnC);
  for (int r = 0; r < 16; ++r) p0[r] = __builtin_amdgcn_exp2f(p0[r]);
}
__device__ __forceinline__ void finishSM(f32x16& p0, f32x16& p1, float alpha, float& l_reg, bf16x8& pa0, bf16x8& pa1, bf16x8& pa2, bf16x8& pa3) {
  for (int r = 0; r < 16; ++r) p1[r] = __builtin_amdgcn_exp2f(p1[r]);
  float ps = 0; for (int r = 0; r < 16; ++r) ps += p0[r]; for (int r = 0; r < 16; ++r) ps += p1[r];
  { auto rr = __builtin_amdgcn_permlane32_swap(__float_as_uint(ps), __float_as_uint(ps), false, false);
    ps = __uint_as_float(rr[0]) + __uint_as_float(rr[1]); }
  l_reg = l_reg * alpha + ps;
#define PK4(P, BASE, OUT) do { unsigned a0 = cvtpk(P[BASE + 0], P[BASE + 1]), a1 = cvtpk(P[BASE + 2], P[BASE + 3]);   \
    unsigned b0 = cvtpk(P[BASE + 4], P[BASE + 5]), b1 = cvtpk(P[BASE + 6], P[BASE + 7]);                              \
    auto r0 = __builtin_amdgcn_permlane32_swap(a0, b0, false, false); auto r1 = __builtin_amdgcn_permlane32_swap(a1, b1, false, false); \
    u32x4 w = {r0[0], r1[0], r0[1], r1[1]}; OUT = *reinterpret_cast<bf16x8*>(&w); } while (0)
  PK4(p0, 0, pa0); PK4(p0, 8, pa1); PK4(p1, 0, pa2); PK4(p1, 8, pa3);
#undef PK4
}
__device__ __forceinline__ void qkt(f32x16& p0, f32x16& p1, const bf16_t* Ks, const bf16x8* qr, int r32, int hi) {
  p0 = f32x16{}; p1 = f32x16{};
  for (int d0 = 0; d0 < 8; ++d0) { int cb = (d0 * 16 + hi * 8) * 2;
    bf16x8 b0 = *reinterpret_cast<const bf16x8*>((const char*)Ks + KSWZ(r32, cb));
    bf16x8 b1 = *reinterpret_cast<const bf16x8*>((const char*)Ks + KSWZ(32 + r32, cb));
    p0 = __builtin_amdgcn_mfma_f32_32x32x16_bf16(b0, qr[d0], p0, 0, 0, 0);
    p1 = __builtin_amdgcn_mfma_f32_32x32x16_bf16(b1, qr[d0], p1, 0, 0, 0); }
}
__device__ __forceinline__ int v_st(int k, int c) { const int kk = (k & ~0xC) | ((k & 4) << 1) | ((k & 8) >> 1); return ((kk >> 3) * 4 + (c >> 5)) * 512 + ((kk & 7) * 32 + (c & 31)) * 2; }
__device__ __forceinline__ int v_rd_base(int lane) { return ((lane & 3) << 3) | (((lane >> 2) & 3) << 6) | (((lane >> 4) & 1) << 5) | (((lane >> 5) & 1) << 8); }
constexpr int v_rd_off(int d0, int ks, int half) { return d0 * 512 + ks * 4096 + half * 2048; }
template <int OFF> __device__ __forceinline__ s16x4 tr_read(int vb) {
  s16x4 r; asm volatile("ds_read_b64_tr_b16 %0, %1 offset:%2" : "=&v"(r) : "v"(vb), "i"(OFF) : "memory"); return r;
}
template <int D0> __device__ __forceinline__ void pv_one(f32x16& od, int vb, bf16x8 pa0, bf16x8 pa1, bf16x8 pa2, bf16x8 pa3) {
  const s16x4 l0 = tr_read<v_rd_off(D0, 0, 0)>(vb), h0 = tr_read<v_rd_off(D0, 0, 1)>(vb), l1 = tr_read<v_rd_off(D0, 1, 0)>(vb), h1 = tr_read<v_rd_off(D0, 1, 1)>(vb);
  const s16x4 l2 = tr_read<v_rd_off(D0, 2, 0)>(vb), h2 = tr_read<v_rd_off(D0, 2, 1)>(vb), l3 = tr_read<v_rd_off(D0, 3, 0)>(vb), h3 = tr_read<v_rd_off(D0, 3, 1)>(vb);
  asm volatile("s_waitcnt lgkmcnt(0)" ::: "memory"); SBAR();
#define PK(L, H) (bf16x8){L[0], L[1], L[2], L[3], H[0], H[1], H[2], H[3]}
  od = __builtin_amdgcn_mfma_f32_32x32x16_bf16(pa0, PK(l0, h0), od, 0, 0, 0);
  od = __builtin_amdgcn_mfma_f32_32x32x16_bf16(pa1, PK(l1, h1), od, 0, 0, 0);
  od = __builtin_amdgcn_mfma_f32_32x32x16_bf16(pa2, PK(l2, h2), od, 0, 0, 0);
  od = __builtin_amdgcn_mfma_f32_32x32x16_bf16(pa3, PK(l3, h3), od, 0, 0, 0);
#undef PK
}
__device__ __forceinline__ void pv_d0(f32x16* o, int vb, bf16x8 pa0, bf16x8 pa1, bf16x8 pa2, bf16x8 pa3) {
  pv_one<0>(o[0], vb, pa0, pa1, pa2, pa3); pv_one<1>(o[1], vb, pa0, pa1, pa2, pa3); pv_one<2>(o[2], vb, pa0, pa1, pa2, pa3); pv_one<3>(o[3], vb, pa0, pa1, pa2, pa3);
}
__device__ __forceinline__ void attn_dense_body(const bf16_t* __restrict__ Qb, const bf16_t* __restrict__ Kh, const bf16_t* __restrict__ Vh, bf16_t* __restrict__ Ob, int seq, char* lds) {
  const int tid = threadIdx.x, wid = tid >> 6, lane = tid & 63, r32 = lane & 31, hi = lane >> 5;
  bf16_t* V_lds = (bf16_t*)lds; bf16_t* K_lds = (bf16_t*)(lds + 2 * SHM_V);
  float* ws = (float*)(lds + 2 * SHM_V + 2 * SHM_K) + wid * 64; float* li_l = ws; float* al_l = ws + 32;
  float m_reg = -1e30f, l_reg = 0; f32x16 o[4] = {}; bf16x8 qr[8];
  const bf16_t* Qw = Qb + (long)(wid * QBLK + r32) * LDQ + hi * 8;
#pragma unroll
  for (int d0 = 0; d0 < 8; ++d0) qr[d0] = *reinterpret_cast<const bf16x8*>(Qw + d0 * 16);
  const int sr = tid >> 4, sc = (tid & 15) * 8, vst0 = v_st(sr, sc), vst1 = v_st(32 + sr, sc);
  const int vb0 = (int)(uintptr_t)V_lds + v_rd_base(lane);
  struct { bf16x8 vs0, vs1, ks0, ks1; } sr_[2];
#define SLOAD(i, k0) do { sr_[i].vs0 = *reinterpret_cast<const bf16x8*>(&Vh[(long)((k0) + sr) * LDK + sc]); sr_[i].vs1 = *reinterpret_cast<const bf16x8*>(&Vh[(long)((k0) + 32 + sr) * LDK + sc]); \
    sr_[i].ks0 = *reinterpret_cast<const bf16x8*>(&Kh[(long)((k0) + sr) * LDK + sc]); sr_[i].ks1 = *reinterpret_cast<const bf16x8*>(&Kh[(long)((k0) + 32 + sr) * LDK + sc]); } while (0)
#define SWRITE(b, i) do { *(bf16x8*)((char*)V_lds + (b) * SHM_V + vst0) = sr_[i].vs0;          \
    *(bf16x8*)((char*)V_lds + (b) * SHM_V + vst1) = sr_[i].vs1; int kc = sc * 2;               \
    *(bf16x8*)((char*)K_lds + (b) * SHM_K + KSWZ(sr, kc)) = sr_[i].ks0;                       \
    *(bf16x8*)((char*)K_lds + (b) * SHM_K + KSWZ(32 + sr, kc)) = sr_[i].ks1; } while (0)
#define SWAIT() asm volatile("s_waitcnt vmcnt(4)" ::: "memory")
#define RESC(a) do { if (__any((a) < 1.f)) { if (hi == 0) al_l[r32] = (a); asm volatile("s_waitcnt lgkmcnt(0)" ::: "memory"); \
    for (int d = 0; d < 4; ++d) for (int r = 0; r < 16; ++r) o[d][r] *= al_l[crow(r, hi)]; } } while (0)
  f32x16 pA0, pA1, pB0, pB1; float mnA, mnB, alA, alB; bf16x8 pa0, pa1, pa2, pa3; const int NT = seq / KVBLK;
  constexpr int SE = 0, SO = 1;
  SLOAD(SE, 0); asm volatile("s_waitcnt vmcnt(0)" ::: "memory"); SWRITE(0, SE); __syncthreads();
  qkt(pA0, pA1, K_lds, qr, r32, hi); partialSM(pA0, pA1, m_reg, mnA, alA);
  SLOAD(SO, KVBLK); if (2 < NT) SLOAD(SE, 2 * KVBLK);
  SWAIT(); SWRITE(1, SO); __syncthreads();
  for (int j = 1; j + 1 < NT; j += 2) {
    SBAR(); qkt(pB0, pB1, (bf16_t*)((char*)K_lds + SHM_K), qr, r32, hi);
    finishSM(pA0, pA1, alA, l_reg, pa0, pa1, pa2, pa3); SBAR();
    SLOAD(SO, (j + 2) * KVBLK); SBAR();
    pv_d0(o, vb0, pa0, pa1, pa2, pa3); partialSM(pB0, pB1, m_reg, mnB, alB);
    __syncthreads(); SWAIT(); SWRITE(0, SE);
    RESC(alB); __syncthreads();
    SBAR(); qkt(pA0, pA1, K_lds, qr, r32, hi);
    finishSM(pB0, pB1, alB, l_reg, pa0, pa1, pa2, pa3); SBAR();
    if (j + 3 < NT) SLOAD(SE, (j + 3) * KVBLK); SBAR();
    pv_d0(o, vb0 + (int)SHM_V, pa0, pa1, pa2, pa3); partialSM(pA0, pA1, m_reg, mnA, alA);
    __syncthreads(); SWAIT(); SWRITE(1, SO);
    RESC(alA); __syncthreads();
  }
  SBAR(); qkt(pB0, pB1, (bf16_t*)((char*)K_lds + SHM_K), qr, r32, hi);
  finishSM(pA0, pA1, alA, l_reg, pa0, pa1, pa2, pa3); SBAR();
  pv_d0(o, vb0, pa0, pa1, pa2, pa3); partialSM(pB0, pB1, m_reg, mnB, alB);
  __syncthreads(); RESC(alB);
  finishSM(pB0, pB1, alB, l_reg, pa0, pa1, pa2, pa3); SBAR();
  pv_d0(o, vb0 + (int)SHM_V, pa0, pa1, pa2, pa3);
  if (hi == 0) li_l[r32] = l_reg; asm volatile("s_waitcnt lgkmcnt(0)" ::: "memory");
  float rli[16];
#pragma unroll
  for (int r = 0; r < 16; ++r) rli[r] = __builtin_amdgcn_rcpf(li_l[crow(r, hi)]);
  bf16_t* Ow = Ob + (long)(wid * QBLK) * LDO;
#pragma unroll
  for (int r = 0; r < 16; ++r) { int orow = crow(r, hi);
    for (int d0 = 0; d0 < 4; ++d0) Ow[(long)orow * LDO + d0 * 32 + r32] = f2bf(o[d0][r] * rli[r]); }
#undef SLOAD
#undef SWRITE
#undef SWAIT
#undef RESC
}
#undef KSWZ
#undef SBAR
}

__device__ __forceinline__ void ph_norm1(Frame& F, const Args& args, const float* mod) {
    const int gw = F.vcu * NWAVES + F.wave, NGW = F.G * NWAVES, lane = F.lane;
    bf16_t* H = (bf16_t*)(F.ws + WS_H); const float* nw = args.in[6];
    for (int row = gw; row < NTOK + NCTX; row += NGW) {
        const float* src = row < NTOK ? args.in[0] + (size_t)row * DM : args.in[2] + (size_t)(row - NTOK) * DM;
        const float* mr = mod + (row < NTOK ? row / SEQ : 2) * MODC;
        f32x4 v[8]; float ss = 0.f;
#pragma unroll
        for (int j = 0; j < 8; ++j) { v[j] = *(const GAS f32x4*)(src + (j * 64 + lane) * 4); ss += v[j].x * v[j].x + v[j].y * v[j].y + v[j].z * v[j].z + v[j].w * v[j].w; }
        ss = wave_sum(ss);
        const float rstd = 1.0f / sqrtf(ss * (1.0f / DM) + 1e-6f);
#pragma unroll
        for (int j = 0; j < 8; ++j) { const int i = (j * 64 + lane) * 4;
            const f32x4 w = *(const GAS f32x4*)(nw + i), sc = *(const GAS f32x4*)(mr + DM + i), sh = *(const GAS f32x4*)(mr + i);
            const f32x4 h = v[j] * rstd * w * (sc + 1.0f) + sh;
            unsigned lo = cvt_pk_bf16(h[0], h[1]), hi = cvt_pk_bf16(h[2], h[3]);
            *(GAS unsigned long long*)(H + (size_t)row * DM + i) = (unsigned long long)lo | ((unsigned long long)hi << 32); }
    }
}
__device__ __forceinline__ void ph_qknorm(Frame& F, const Args& args) {
    const int gw = F.vcu * NWAVES + F.wave, NGW = F.G * NWAVES, lane = F.lane;
    const float* QKRAW = (const float*)(F.ws + WS_QKRAW); const float* KCRAW = (const float*)(F.ws + WS_KCRAW);
    bf16_t* Q = (bf16_t*)(F.ws + WS_Q); bf16_t* KALL = (bf16_t*)(F.ws + WS_KALL);
    const int axis = lane >> 5, f = lane & 31, da = axis * 64 + f, db = da + 32;
    const float qwa = args.in[8][da], qwb = args.in[8][db], kwa = args.in[9][da], kwb = args.in[9][db];
    const float inv = exp2f(-(float)f * (13.287712379549449f / 32.0f));
    for (int row = gw; row < NTOK + NCTX; row += NGW) {
        if (row < NTOK) {
            const int b = row / SEQ, t = row % SEQ;
            const float pos = (float)(axis == 0 ? t / 64 : t % 64), ang = pos * inv, cs = cosf(ang), sn = sinf(ang);
            const float* src = QKRAW + (size_t)row * 2560;
#pragma unroll
            for (int hb = 0; hb < 20; hb += 5) {
                float xa[5], xb[5];
#pragma unroll
                for (int q = 0; q < 5; ++q) { xa[q] = src[(hb + q) * HD + da]; xb[q] = src[(hb + q) * HD + db]; }
#pragma unroll
                for (int q = 0; q < 5; ++q) { const int hh = hb + q;
                    const float ss = wave_sum(xa[q] * xa[q] + xb[q] * xb[q]), rstd = 1.0f / sqrtf(ss * (1.0f / HD) + 1e-6f);
                    const float a = xa[q] * rstd * (hh < 16 ? qwa : kwa), bb = xb[q] * rstd * (hh < 16 ? qwb : kwb);
                    bf16_t* dst = hh < 16 ? Q + (size_t)row * DM + hh * HD : KALL + ((size_t)b * SKV + t) * KVW + (hh - 16) * HD;
                    dst[da] = f2bf(a * cs - bb * sn); dst[db] = f2bf(bb * cs + a * sn); }
            }
        } else {
            const int r = row - NTOK, b = r / CTXL, j = r % CTXL; const float* src = KCRAW + (size_t)r * KVW;
#pragma unroll
            for (int hh = 0; hh < 4; ++hh) { const float xa = src[hh * HD + da], xb = src[hh * HD + db];
                const float ss = wave_sum(xa * xa + xb * xb), rstd = 1.0f / sqrtf(ss * (1.0f / HD) + 1e-6f);
                bf16_t* dst = KALL + ((size_t)b * SKV + SEQ + j) * KVW + hh * HD; dst[da] = f2bf(xa * rstd * kwa); dst[db] = f2bf(xb * rstd * kwb); }
        }
    }
}
__device__ __forceinline__ void ph_evenodd(Frame& F, const Args& args) {
    const int gw = F.vcu * NWAVES + F.wave, NGW = F.G * NWAVES, lane = F.lane;
    LAS bf16_t* scr = (LAS bf16_t*)(F.lds + F.wave * 16640);
    const bf16_t* UT = (const bf16_t*)(F.ws + WS_UT); bf16_t* ET = (bf16_t*)(F.ws + WS_ET); bf16_t* OT = (bf16_t*)(F.ws + WS_OT);
    float* W2 = (float*)(F.ws + WS_W2048); float* AL = (float*)(F.ws + WS_ALT);
    for (int row = gw; row < 2 * FW; row += NGW) {
        const bf16_t* src = UT + (size_t)row * SEQ; float alt = 0.f;
#pragma unroll
        for (int j = 0; j < 8; ++j) { const u32x4 w = *(const GAS u32x4*)(src + (j * 64 + lane) * 8); *(LAS u32x4*)(scr + (j * 64 + lane) * 8) = w;
            float f[8]; unpack8(w, f); alt += (f[0] - f[1]) + (f[2] - f[3]) + (f[4] - f[5]) + (f[6] - f[7]); }
        alt = wave_sum(alt);
        LDS_WAIT(); asm volatile("" ::: "memory");
        if (lane == 0) { AL[row] = alt; W2[row] = bf2f(scr[SEQ / 2]); }
#pragma unroll
        for (int j = 0; j < 4; ++j) { const int n0 = (j * 64 + lane) * 8; float e[8], o[8];
#pragma unroll
            for (int i = 0; i < 8; ++i) { const int n = n0 + i; const float a = bf2f(scr[n]), bb = bf2f(scr[(SEQ - n) & (SEQ - 1)]); e[i] = n == 0 ? a : a + bb; o[i] = n == 0 ? 0.f : a - bb; }
            u32x4 we, wo; we.x = cvt_pk_bf16(e[0], e[1]); we.y = cvt_pk_bf16(e[2], e[3]); we.z = cvt_pk_bf16(e[4], e[5]); we.w = cvt_pk_bf16(e[6], e[7]);
            wo.x = cvt_pk_bf16(o[0], o[1]); wo.y = cvt_pk_bf16(o[2], o[3]); wo.z = cvt_pk_bf16(o[4], o[5]); wo.w = cvt_pk_bf16(o[6], o[7]);
            *(GAS u32x4*)(ET + (size_t)row * 2048 + n0) = we; *(GAS u32x4*)(OT + (size_t)row * 2048 + n0) = wo; }
        LDS_WAIT(); asm volatile("" ::: "memory");
    }
}
__device__ __forceinline__ void ph_route(Frame& F, const Args& args, const float* mod) {
    const int lane = F.lane, wv = F.wave, r32 = lane & 31, hi = lane >> 5;
    LAS float* rs = (LAS float*)F.lds;
    LAS float* part = (LAS float*)(F.lds + 1024);
    LAS int* lcnt = (LAS int*)(F.lds + 1024 + 65536);
    LAS int* lbase = lcnt + 64;
    LAS int* lent = lcnt + 128;
    const float* X2 = (const float*)(F.ws + WS_X2); const float* nw = args.in[13]; const float* rb = args.in[15];
    const bf16_t* RWT = (const bf16_t*)(F.ws + WS_RWT);
    bf16_t* H2 = (bf16_t*)(F.ws + WS_H2); int* EIDX = (int*)(F.ws + WS_EIDX); float* EW = (float*)(F.ws + WS_EW); int* EPOS = (int*)(F.ws + WS_EPOS); int* CNT = (int*)(F.ws + CTL_CNT);
    if (F.tid < NE) lcnt[F.tid] = 0;
    __syncthreads();
    int nb = 0;
    for (int blk = F.vcu; blk < NTOK / 32; blk += F.G, ++nb) {
        const int row0 = blk * 32; const float* mr = mod + (row0 / SEQ) * MODC;
#pragma unroll
        for (int i = 0; i < 4; ++i) { const float* src = X2 + (size_t)(row0 + wv * 4 + i) * DM; float ss = 0.f;
#pragma unroll
            for (int j = 0; j < 8; ++j) { const f32x4 v = *(const GAS f32x4*)(src + (j * 64 + lane) * 4); ss += v.x * v.x + v.y * v.y + v.z * v.z + v.w * v.w; }
            ss = wave_sum(ss);
            if (lane == 0) rs[wv * 4 + i] = 1.0f / sqrtf(ss * (1.0f / DM) + 1e-6f); }
        __syncthreads();
        { const float rstd = rs[r32]; const float* xr = X2 + (size_t)(row0 + r32) * DM; bf16_t* hr = H2 + (size_t)(row0 + r32) * DM;
          f32x16 acc0 = {}, acc1 = {};
#pragma unroll 4
          for (int ks = 0; ks < 16; ++ks) { const int k = wv * 256 + ks * 16 + hi * 8;
              float h[8];
#pragma unroll
              for (int q = 0; q < 2; ++q) { const f32x4 x = *(const GAS f32x4*)(xr + k + 4 * q), w = *(const GAS f32x4*)(nw + k + 4 * q), sc = *(const GAS f32x4*)(mr + 4 * DM + k + 4 * q), sh = *(const GAS f32x4*)(mr + 3 * DM + k + 4 * q);
                  const f32x4 t = x * rstd * w * (sc + 1.0f) + sh; h[4 * q] = t[0]; h[4 * q + 1] = t[1]; h[4 * q + 2] = t[2]; h[4 * q + 3] = t[3]; }
              u32x4 wh, wl; float l[8];
              wh.x = cvt_pk_bf16(h[0], h[1]); wh.y = cvt_pk_bf16(h[2], h[3]); wh.z = cvt_pk_bf16(h[4], h[5]); wh.w = cvt_pk_bf16(h[6], h[7]);
#pragma unroll
              for (int i = 0; i < 4; ++i) { l[2 * i] = h[2 * i] - __uint_as_float(wh[i] << 16); l[2 * i + 1] = h[2 * i + 1] - __uint_as_float(wh[i] & 0xffff0000u); }
              wl.x = cvt_pk_bf16(l[0], l[1]); wl.y = cvt_pk_bf16(l[2], l[3]); wl.z = cvt_pk_bf16(l[4], l[5]); wl.w = cvt_pk_bf16(l[6], l[7]);
              *(GAS u32x4*)(hr + k) = wh;
              const bf16x8 ah = __builtin_bit_cast(bf16x8, wh), al = __builtin_bit_cast(bf16x8, wl);
              const bf16x8 bh0 = *(const GAS bf16x8*)(RWT + (size_t)r32 * DM + k), bh1 = *(const GAS bf16x8*)(RWT + (size_t)(32 + r32) * DM + k);
              const bf16x8 bl0 = *(const GAS bf16x8*)(RWT + (size_t)(NE + r32) * DM + k), bl1 = *(const GAS bf16x8*)(RWT + (size_t)(NE + 32 + r32) * DM + k);
              acc0 = __builtin_amdgcn_mfma_f32_32x32x16_bf16(ah, bh0, acc0, 0, 0, 0); acc0 = __builtin_amdgcn_mfma_f32_32x32x16_bf16(ah, bl0, acc0, 0, 0, 0); acc0 = __builtin_amdgcn_mfma_f32_32x32x16_bf16(al, bh0, acc0, 0, 0, 0);
              acc1 = __builtin_amdgcn_mfma_f32_32x32x16_bf16(ah, bh1, acc1, 0, 0, 0); acc1 = __builtin_amdgcn_mfma_f32_32x32x16_bf16(ah, bl1, acc1, 0, 0, 0); acc1 = __builtin_amdgcn_mfma_f32_32x32x16_bf16(al, bh1, acc1, 0, 0, 0); }
#pragma unroll
          for (int r = 0; r < 16; ++r) { part[(wv * 32 + crow(r, hi)) * 64 + r32] = acc0[r]; part[(wv * 32 + crow(r, hi)) * 64 + 32 + r32] = acc1[r]; } }
        __syncthreads();
        for (int i = 0; i < 4; ++i) { const int rbk = wv * 4 + i, row = row0 + rbk; float logit = 0.f;
#pragma unroll
          for (int w = 0; w < 8; ++w) logit += part[(w * 32 + rbk) * 64 + lane];
          const float score = 1.0f / (1.0f + expf(-logit)), bsd = score + rb[lane];
          const int g = lane >> 3;
          int rk = 0;
#pragma unroll
          for (int q = 0; q < 8; ++q) { const int o = (lane & ~7) + q; const float vv = __shfl(bsd, o); rk += (vv > bsd) || (vv == bsd && o < lane); }
          float gs = rk < 2 ? bsd : 0.f;
          gs += __shfl_xor(gs, 1); gs += __shfl_xor(gs, 2); gs += __shfl_xor(gs, 4);
          int grk = 0;
#pragma unroll
          for (int gg = 0; gg < 8; ++gg) { const float vv = __shfl(gs, gg * 8); grk += (vv > gs) || (vv == gs && gg < g); }
          const bool gsel = grk < 4;
          const float mb = gsel ? bsd : -INFINITY;
          int erk = 0;
          for (int o = 0; o < 64; ++o) { const float vv = __shfl(mb, o); erk += (vv > mb) || (vv == mb && o < lane); }
          const bool sel = gsel && erk < TOPK;
          const float ssum = wave_sum(sel ? score : 0.f);
          if (sel) { const int lp = __hip_atomic_fetch_add(lcnt + lane, 1, __ATOMIC_RELAXED, __HIP_MEMORY_SCOPE_WORKGROUP);
                     EIDX[row * TOPK + erk] = lane; EW[row * TOPK + erk] = score / ssum * 2.5f; lent[(nb * 32 + rbk) * TOPK + erk] = (lane << 16) | lp; } }
        __syncthreads();
    }
    if (F.tid < NE) { const int c = lcnt[F.tid]; lbase[F.tid] = c ? atomicAdd(&CNT[F.tid * 64], c) : 0; }
    __syncthreads();
    for (int i = F.tid; i < nb * 256; i += NTHREADS) { const int blk = F.vcu + (i >> 8) * F.G, row = blk * 32 + ((i >> 3) & 31), v = lent[i]; EPOS[row * TOPK + (i & 7)] = lbase[v >> 16] + (v & 0xffff); }
    __syncthreads();
}
__device__ __forceinline__ void ph_fill(Frame& F, const Args& args) {
    moe_tables(F, 4);
    LAS int* T = (LAS int*)(F.lds + SCHT_OFF);
    const int* EIDX = (const int*)(F.ws + WS_EIDX); const int* EPOS = (const int*)(F.ws + WS_EPOS); int* TOK = (int*)(F.ws + WS_TOK); int* SLOTOF = (int*)(F.ws + WS_SLOTOF);
    for (int i = F.vcu * NTHREADS + F.tid; i < NSLOT; i += F.G * NTHREADS) { const int slot = T[80 + EIDX[i]] + EPOS[i]; TOK[slot] = i / TOPK; SLOTOF[i] = slot; if (i < NTOK) TOK[NSLOT + i] = i; }
}
__device__ __forceinline__ void ph_comb(Frame& F, const Args& args, const float* mod) {
    const int gw = F.vcu * NWAVES + F.wave, NGW = F.G * NWAVES, lane = F.lane;
    const float* EW = (const float*)(F.ws + WS_EW); const int* SLOTOF = (const int*)(F.ws + WS_SLOTOF); const bf16_t* Y = (const bf16_t*)(F.ws + WS_YBIG);
    for (int t = gw; t < NTOK; t += NGW) {
        const float* g2 = mod + (t / SEQ) * MODC + 5 * DM;
        int sl[TOPK]; float wk[TOPK];
#pragma unroll
        for (int k = 0; k < TOPK; ++k) { sl[k] = SLOTOF[t * TOPK + k]; wk[k] = EW[t * TOPK + k]; }
#pragma unroll
        for (int j = 0; j < 4; ++j) { const int col = j * 512 + lane * 8;
            float a[8]; unpack8(*(const GAS u32x4*)(Y + (size_t)(NSLOT + t) * DM + col), a);
#pragma unroll
            for (int k = 0; k < TOPK; ++k) { float y[8]; unpack8(*(const GAS u32x4*)(Y + (size_t)sl[k] * DM + col), y);
#pragma unroll
                for (int c = 0; c < 8; ++c) a[c] += wk[k] * y[c]; }
            float* o = args.out + (size_t)t * DM + col; const float* xi = (const float*)(F.ws + WS_X2) + (size_t)t * DM + col;
#pragma unroll
            for (int n = 0; n < 2; ++n) { const f32x4 xv = *(const GAS f32x4*)(xi + 4 * n), gv = *(const GAS f32x4*)(g2 + col + 4 * n);
                *(GAS f32x4*)(o + 4 * n) = xv + gv * (f32x4){a[4 * n], a[4 * n + 1], a[4 * n + 2], a[4 * n + 3]}; } }
    }
}

enum { PH_PRO = 0, PH_NORM1, PH_INPROJ, PH_QKNORM, PH_ATTN, PH_F2, PH_MERGE, PH_OUT, PH_ROUTE, PH_FILL, PH_EXP1, PH_EXP2, PH_COMB, PH_END };


__global__ void __launch_bounds__(NTHREADS, 2) fwd(Args args) {
    extern __shared__ __attribute__((aligned(16))) unsigned char lds_raw[];
    Frame F;
    F.lds = (LAS unsigned char*)lds_raw; F.MISC = (volatile LAS unsigned*)(F.lds + MISC_OFF); F.ws = args.ws;
    F.tid = threadIdx.x; F.lane = F.tid & 63; F.wave = __builtin_amdgcn_readfirstlane(F.tid >> 6);
    F.G = gridDim.x; { const int bx = blockIdx.x; F.vcu = (F.G % 8 == 0) ? (bx % 8) * (F.G / 8) + bx / 8 : bx; }
    for (int u = F.tid; u < (LDS_BYTES - LDSCTL_OFF) / 4; u += NTHREADS) ((LAS unsigned*)(F.lds + LDSCTL_OFF))[u] = 0u;
    __syncthreads();
    const int lo = args.ph_lo, hi = args.ph_hi;
    const bool multi = (hi - lo) > 1;
    unsigned* barw = (unsigned*)(args.ws + CTL_BAR) + args.bar_idx * XCD_BAR_WORDS;
    XcdBarrier bar; bar.bar = barw; bar.x = 0; bar.st = nullptr;
    if (multi) bar = xcd_barrier_post(barw, F.MISC + 8);
#define IN(k) (lo <= (k) && (k) < hi)
#define SEAM(k) do { if (IN((k) + 1)) xcd_barrier(bar); } while (0)

    const float* modp = (const float*)(args.ws + args.mod_off);
    if (IN(PH_PRO)) { p0_prologue(F, args); SEAM(PH_PRO); }
    if (IN(PH_NORM1)) { ph_norm1(F, args, modp); SEAM(PH_NORM1); }
    if (IN(PH_INPROJ)) {
        SchedIn S{F.G, (int)blockIdx.x, args.ws, args.use_ut};
        gemm_phase<EpiStore, SchedIn, false>(F.lds, DM, DM, DM, S, EpiStore{(const float*)(args.ws + WS_W2048)});
        SEAM(PH_INPROJ);
    }
    if (IN(PH_QKNORM)) { ph_qknorm(F, args); ph_evenodd(F, args); SEAM(PH_QKNORM); }
    if (IN(PH_ATTN)) {
        const int cs = F.vcu & 3;
        constexpr int NCONV = IT_EG + IT_EU + IT_ED;
        int qfirst, qcnt; { const int c = (int)blockIdx.x; if (F.G == 256) { qfirst = c < 136 ? c * 162 : 136 * 162 + (c - 136) * 226; qcnt = c < 136 ? 162 : 226; }
                             else { const int per = (NCONV + F.G - 1) / F.G; qfirst = c * per; qcnt = qfirst + per <= NCONV ? per : (NCONV - qfirst > 0 ? NCONV - qfirst : 0); } }
        const int gcnt = qfirst < IT_EG + IT_EU ? (qfirst + qcnt <= IT_EG + IT_EU ? qcnt : IT_EG + IT_EU - qfirst) : 0, gfirst = qfirst;
        const int ccnt = qcnt - gcnt, cfirst = qfirst + gcnt - (IT_EG + IT_EU);
#define CONV_ALL() do { conv_items(F, args, false, gfirst, gcnt); conv_items(F, args, true, cfirst, ccnt); } while (0)
        const bf16_t* Qp = (const bf16_t*)(args.ws + WS_Q); const bf16_t* Kp = (const bf16_t*)(args.ws + WS_KALL); const bf16_t* Vp = (const bf16_t*)(args.ws + WS_VALL); bf16_t* Op = (bf16_t*)(args.ws + WS_YA);
#define ATTN_UNIT(lin_) do { const int lin = (lin_); if (lin < 512) { const int x = (lin >> 5) & 7, j = (lin & 31) + 32 * (lin >> 8), b = x >> 2, kvh = x & 3, head = kvh * 4 + (j >> 4), qb = j & 15; \
            const size_t qo = ((size_t)(b * SEQ + qb * 256)) * DM + head * HD, ko = (size_t)b * SKV * KVW + kvh * HD; \
            attn::attn_dense_body(Qp + qo, Kp + ko, Vp + ko, Op + qo, SKV, (char*)lds_raw); __syncthreads(); } } while (0)
        if (cs == 0) { CONV_ALL(); __syncthreads(); }
        ATTN_UNIT(F.vcu);
        if (cs == 1) { CONV_ALL(); __syncthreads(); }
        ATTN_UNIT(F.vcu + F.G);
        for (int lin2 = F.vcu + 2 * F.G; lin2 < 512; lin2 += F.G) ATTN_UNIT(lin2);
        if (cs == 2) { CONV_ALL(); __syncthreads(); }
#undef ATTN_UNIT
        SchedAG S{F.G, (int)blockIdx.x, args.ws};
        gemm_phase<EpiStore, SchedAG, false>(F.lds, DM, DM, DM, S, EpiStore{(const float*)(args.ws + WS_W2048)});
        if (cs == 3) { __syncthreads(); CONV_ALL(); }
#undef CONV_ALL
        SEAM(PH_ATTN);
    }
    if (IN(PH_F2)) {
        SchedF2 S{F.G, (int)blockIdx.x, args.ws};
        gemm_phase<EpiStore, SchedF2, false>(F.lds, 512, DM, 512, S, EpiStore{(const float*)(args.ws + WS_W2048)});
        {
            const int idx = F.vcu * NTHREADS + F.tid;
            if (idx < 2 * FW) { const int b = idx >> 10, col = idx & 1023, k2 = col & 127; const float* al = (const float*)(args.ws + WS_ALT) + b * FW + (col & ~127); float s = 0.f;
                for (int c = 0; c < 128; ++c) s += al[c] * cospif((float)((c * k2) & 127) * (1.0f / 64.0f));
                ((bf16_t*)(args.ws + WS_YF))[((size_t)b * SEQ + SEQ / 2) * FW + col] = f2bf(s * 0.0013810679320049757f); }
        }
        SEAM(PH_F2);
    }
    if (IN(PH_MERGE)) {
        unsigned char* ws = args.ws;
        { SchedGrid S{F.G, (int)blockIdx.x, 32, 8, (const char*)(ws + WS_YF), (const char*)(ws + WS_WT_FO), nullptr, (size_t)256 * FW * 2, (size_t)256 * FW * 2, DM, 4, 1};
          gemm_phase<EpiT1, SchedGrid, false>(F.lds, FW, FW, FW, S, EpiT1{(const bf16_t*)(ws + WS_SGF), (float*)(ws + WS_T1)}); }
        { SchedGrid S{F.G, (int)blockIdx.x, 32, 8, (const char*)(ws + WS_YA), (const char*)(ws + WS_WT_AO), nullptr, (size_t)256 * DM * 2, (size_t)256 * DM * 2, DM, 2, 0};
          gemm_phase<EpiYM, SchedGrid, false>(F.lds, DM, DM, DM, S, EpiYM{(const bf16_t*)(ws + WS_SGA), (const float*)(ws + WS_T1), (bf16_t*)(ws + WS_YM)}); }
        SEAM(PH_MERGE);
    }
    if (IN(PH_OUT)) {
        unsigned char* ws = args.ws;
        SchedGrid S{F.G, (int)blockIdx.x, 32, 8, (const char*)(ws + WS_YM), (const char*)(ws + WS_WT_O), nullptr, (size_t)256 * DM * 2, (size_t)256 * DM * 2, DM, 4, 1};
        gemm_phase<EpiX2, SchedGrid, false>(F.lds, DM, DM, DM, S, EpiX2{args.in[0], modp, (float*)(ws + WS_X2)});
        SEAM(PH_OUT);
    }
    if (IN(PH_ROUTE)) { ph_route(F, args, modp); SEAM(PH_ROUTE); }
    if (IN(PH_FILL)) { ph_fill(F, args); SEAM(PH_FILL); }
    if (IN(PH_EXP1)) {
        moe_tables(F, 4);
        SchedMoe<4, true> S{F.G, F.vcu, args.ws, (LAS int*)(F.lds + SCHT_OFF), (const int*)(args.ws + WS_TOK)};
        gemm_phase<EpiAct, SchedMoe<4, true>, true>(F.lds, DM, DM, DM, S, EpiAct{});
        SEAM(PH_EXP1);
    }
    if (IN(PH_EXP2)) {
        moe_tables(F, 8);
        SchedMoe<8, false> S{F.G, F.vcu, args.ws, (LAS int*)(F.lds + SCHT_OFF), (const int*)(args.ws + WS_TOK)};
        gemm_phase<EpiStore, SchedMoe<8, false>, false>(F.lds, EFF, EFF, EFF, S, EpiStore{(const float*)(args.ws + WS_W2048)});
        SEAM(PH_EXP2);
    }
    if (IN(PH_COMB)) { ph_comb(F, args, modp); }
#undef IN
#undef SEAM
}
}

extern "C" void kernel_launch(void* const* d_in, const int* in_sizes, int n_in, void* d_out, int out_size, void* d_ws, size_t ws_size, hipStream_t stream) {
    if (n_in != 22 || ws_size < WS_END2) return;
    float* out = (float*)d_out;
    unsigned char* ws = (unsigned char*)d_ws;
    hipMemsetAsync(ws + WS_CTL, 0, CTL_ZERO_BYTES, stream);
    static int grid = 0;
    if (!grid) {
        int dev = 0, cus = 0;
        if (hipGetDevice(&dev) != hipSuccess || hipDeviceGetAttribute(&cus, hipDeviceAttributeMultiprocessorCount, dev) != hipSuccess) { grid = -1; return; }
        if (hipFuncSetAttribute((const void*)mk::fwd, hipFuncAttributeMaxDynamicSharedMemorySize, mk::LDS_BYTES) != hipSuccess) { grid = -1; return; }
        grid = cus;
    }
    if (grid < 0) return;
    mk::Args a{}; int nlaunch = 0;
    for (int i = 0; i < 22; ++i) a.in[i] = (const float*)d_in[i];
    a.out = out; a.ws = ws; a.use_ut = 1; a.mod_off = (int)WS_MOD; a.do_attn = 1;
#define MK_LAUNCH(lo_, hi_) do { a.ph_lo = (lo_); a.ph_hi = (hi_); a.bar_idx = nlaunch++; hipLaunchKernelGGL(mk::fwd, dim3(grid), dim3(mk::NTHREADS), mk::LDS_BYTES, stream, a); } while (0)
    MK_LAUNCH(mk::PH_PRO, mk::PH_END);
}
```

```cpp
#include <hip/hip_runtime.h>
#include <stdint.h>
#include <math.h>

typedef unsigned short bf16_t;
typedef short bf16x8 __attribute__((ext_vector_type(8)));
typedef float f32x16 __attribute__((ext_vector_type(16)));
typedef float f32x4 __attribute__((ext_vector_type(4)));

constexpr int NB = 2, SEQ = 4096, DM = 2048, NTOK = NB * SEQ, CTXL = 256, NCTX = NB * CTXL, HD = 128, NH = 16, NKV = 4;
constexpr int SKV = SEQ + CTXL;
constexpr int FW = 1024, INC = 8192, Q_OFF = 1024, K_OFF = 3072, V_OFF = 3584, GF_OFF = 4096, GA_OFF = 6144;
constexpr int KVW = NKV * HD;
constexpr int NE = 64, TOPK = 8, EFF = 512, MODC = 6 * DM;
constexpr int NSLOT = NTOK * TOPK;
constexpr int NSLOT_ALL = NSLOT + NTOK;

constexpr size_t MiB = 1u << 20;
constexpr size_t WS_CTL = 0, CTL_ZERO_BYTES = 1 * MiB;
constexpr size_t CTL_CNT = 64 * 1024;
constexpr size_t WS_TW = 1 * MiB;
constexpr size_t WS_MOD = 1 * MiB + 64 * 1024;
constexpr size_t WS_OFFS = 1 * MiB + 256 * 1024;
constexpr size_t WS_EIDX = 2 * MiB;
constexpr size_t WS_EW = WS_EIDX + 256 * 1024;
constexpr size_t WS_EPOS = WS_EW + 256 * 1024;
constexpr size_t WS_SLOTOF = WS_EPOS + 256 * 1024;
constexpr size_t WS_TOKE = 300 * MiB;
constexpr size_t WS_H = 4 * MiB;
constexpr size_t WS_U = 38 * MiB;
constexpr size_t WS_Q = 54 * MiB;
constexpr size_t WS_KALL = 86 * MiB;
constexpr size_t WS_VALL = 95 * MiB;
constexpr size_t WS_SGF = 104 * MiB;
constexpr size_t WS_SGA = 136 * MiB;
constexpr size_t WS_YA = 168 * MiB;
constexpr size_t WS_YF = 200 * MiB;
constexpr size_t WS_PR = 216 * MiB;
constexpr size_t WS_T1 = 248 * MiB;
constexpr size_t WS_YM = 312 * MiB;
constexpr size_t WS_QKRAW = 248 * MiB;
constexpr size_t WS_KCRAW = 330 * MiB;
constexpr size_t WS_H2 = 344 * MiB;
constexpr size_t WS_ACT = 376 * MiB;
constexpr size_t WS_YBIG = 4 * MiB;
constexpr size_t WS_END = 740 * MiB;

__device__ __forceinline__ float bf2f(bf16_t h) { return __uint_as_float(((unsigned)h) << 16); }
__device__ __forceinline__ bf16_t f2bf(float f) { unsigned u = __float_as_uint(f); return (bf16_t)((u + 0x7fffu + ((u >> 16) & 1u)) >> 16); }
__device__ __forceinline__ int crow(int r, int hi) { return (r & 3) + 8 * (r >> 2) + 4 * hi; }
__device__ __forceinline__ float wave_sum(float v) {
#pragma unroll
    for (int o = 1; o < 64; o <<= 1) v += __shfl_xor(v, o);
    return v;
}
__device__ __forceinline__ float sigmoidf_(float v) { return 1.0f / (1.0f + expf(-v)); }
__device__ __forceinline__ bf16x8 pack8(const float* f) {
    bf16x8 r;
#pragma unroll
    for (int i = 0; i < 8; ++i) r[i] = (short)f2bf(f[i]);
    return r;
}

#define LAS __attribute__((address_space(3)))
#define GAS __attribute__((address_space(1)))
typedef unsigned u32x4 __attribute__((ext_vector_type(4)));
typedef GAS unsigned gu32;
#define RLX_AGENT __ATOMIC_RELAXED, __HIP_MEMORY_SCOPE_AGENT
#define LDS_WAIT() asm volatile("s_waitcnt lgkmcnt(0)" ::: "memory")
#define VM_WAIT() asm volatile("s_waitcnt vmcnt(0)" ::: "memory")

constexpr size_t CTL_BAR = 16384;
constexpr size_t CTL_MODZ = 512 * 1024;
constexpr size_t WS_UT = 38 * MiB;
constexpr size_t WS_TT = 216 * MiB;
constexpr size_t WS_WT_GU = 450 * MiB;
constexpr size_t WS_WT_D = 710 * MiB;
constexpr size_t WS_WT_IN = 840 * MiB;
constexpr size_t WS_WT_FO = 872 * MiB;
constexpr size_t WS_WT_AO = 876 * MiB;
constexpr size_t WS_WT_O = 884 * MiB;
constexpr size_t WS_CST = 892 * MiB;
constexpr size_t WS_ET = 908 * MiB;
constexpr size_t WS_OT = 916 * MiB;
constexpr size_t WS_W2048 = 1 * MiB + 512 * 1024;
constexpr size_t WS_ALT = 1 * MiB + 520 * 1024;
constexpr size_t WS_RWT = 3 * MiB + 512 * 1024;
constexpr size_t WS_BD2 = 956 * MiB;
constexpr size_t WS_X2 = 960 * MiB;
constexpr size_t WS_END2 = 1024 * MiB;

namespace mk {
constexpr int NWAVES = 8, NTHREADS = 512;
constexpr int RING_BYTES = 131072, SCR_BYTES = 8 * 16640, LDSCTL_OFF = 135168, MISC_OFF = LDSCTL_OFF + 320, GPARK_OFF = LDSCTL_OFF + 2048  , LDS_BYTES = 147456;
static_assert(GPARK_OFF + 8192 <= LDS_BYTES, "LDS map");
static_assert(SCR_BYTES <= LDSCTL_OFF && MISC_OFF + 128 <= LDS_BYTES, "LDS map");

#define XB_TMO      128
#define XB_XCNT(j)  (256  + 64 * (j))
#define XB_XSUB(j)  (1280 + 64 * (j))
#define XB_XGEN(j)  (2304 + 64 * (j))
#define XB_TOP      3328
#define XB_TOPGEN   3392
#define XCD_BAR_WORDS 3456
#define XB_SPIN_CAP (1u << 18)
__device__ __forceinline__ unsigned xb_ld(unsigned* p)              { return __hip_atomic_load(p, __ATOMIC_RELAXED, __HIP_MEMORY_SCOPE_AGENT); }
__device__ __forceinline__ unsigned xb_add(unsigned* p, unsigned v) { return __hip_atomic_fetch_add(p, v, __ATOMIC_RELAXED, __HIP_MEMORY_SCOPE_AGENT); }
__device__ __forceinline__ unsigned xb_xcc_id() { return (unsigned)__builtin_amdgcn_s_getreg((3 << 11) | 20) & 0xFu; }
#define XB_SPIN(cond, bar) do { unsigned _sp = 0; while (cond) { __builtin_amdgcn_s_sleep(1); \
    if ((++_sp & 255u) == 0u) { if (xb_ld(&(bar)[XB_TMO])) break; if (_sp > XB_SPIN_CAP) { atomicAdd(&(bar)[XB_TMO], 1u); break; } } } } while (0)
struct XcdBarrier { unsigned* bar; unsigned x; volatile LAS unsigned* st; };
__device__ __forceinline__ XcdBarrier xcd_barrier_post(unsigned* bar, volatile LAS unsigned* st) {
    XcdBarrier b; b.bar = bar; b.x = xb_xcc_id(); b.st = st;
    if (threadIdx.x == 0) (void)xb_add(&bar[XB_XCNT(b.x)], 1u);
    return b;
}
__device__ __forceinline__ void xcd_barrier_complete(unsigned* bar, unsigned x, unsigned& nloc, unsigned& nx) {
    const unsigned G = gridDim.x * gridDim.y * gridDim.z;
    unsigned sum, cnt, mine, sp = 0u;
    for (;;) {
        sum = 0u; cnt = 0u; mine = 0u;
#pragma unroll
        for (unsigned j = 0; j < 16; ++j) { const unsigned c = xb_ld(&bar[XB_XCNT(j)]); sum += c; cnt += (c > 0u) ? 1u : 0u; mine = (j == x) ? c : mine; }
        if (sum == G) break;
        __builtin_amdgcn_s_sleep(1);
        if ((++sp & 255u) == 0u) { if (xb_ld(&bar[XB_TMO])) break; if (sp > XB_SPIN_CAP) { atomicAdd(&bar[XB_TMO], 1u); break; } }
    }
    nloc = mine > 0u ? mine : 1u; nx = cnt > 0u ? cnt : 1u;
}
__device__ __forceinline__ void xcd_barrier(const XcdBarrier& b) {
    asm volatile("s_waitcnt vmcnt(0)" ::: "memory");
    __syncthreads();
    if (threadIdx.x == 0) {
        unsigned* bar = b.bar;
        __builtin_amdgcn_s_waitcnt(0);
        unsigned nloc = b.st[0], nx = b.st[1];
        if (nloc == 0u) { xcd_barrier_complete(bar, b.x, nloc, nx); b.st[0] = nloc; b.st[1] = nx; }
        const unsigned old = xb_add(&bar[XB_XSUB(b.x)], 1u);
        const unsigned gen = old / nloc;
        if (old + 1u == (gen + 1u) * nloc) {
            __builtin_amdgcn_fence(__ATOMIC_RELEASE, "agent");
            asm volatile("s_waitcnt vmcnt(0)" ::: "memory");
            const unsigned og = xb_add(&bar[XB_TOP], 1u);
            const unsigned tg = og / nx;
            if (og + 1u == (tg + 1u) * nx) xb_add(&bar[XB_TOPGEN], 1u);
            else XB_SPIN(xb_ld(&bar[XB_TOPGEN]) == tg, bar);
            __builtin_amdgcn_fence(__ATOMIC_ACQUIRE, "agent");
            xb_add(&bar[XB_XGEN(b.x)], 1u);
            asm volatile("s_waitcnt vmcnt(0)" ::: "memory");
        } else {
            XB_SPIN(xb_ld(&bar[XB_XGEN(b.x)]) == gen, bar);
            __builtin_amdgcn_fence(__ATOMIC_ACQUIRE, "agent");
            asm volatile("s_waitcnt vmcnt(0)" ::: "memory");
        }
    }
    __syncthreads();
}

constexpr int BM = 256, BK = 64, HALF = 128, HTB = HALF * BK * 2, STAGE_BYTES = 8 * HTB;
__device__ __forceinline__ int lds_byte(int r, int c) { const int st = (r >> 4) * 2 + (c >> 5), rr = r & 15, cc = c & 31, ob = rr * 64 + cc * 2; return st * 1024 + (ob ^ (((ob >> 9) & 1) << 5)); }
__device__ __forceinline__ void stage_rc(int b, int& R, int& C) { const int st = b / 1024, sb = b % 1024, swz = sb ^ (((sb >> 9) & 1) << 5); R = (st >> 1) * 16 + swz / 64; C = (st & 1) * 32 + (swz % 64) / 2; }
__device__ __forceinline__ int perm32(int rho) { const int n = rho >> 4, i = rho & 15; return 8 * (i >> 2) + 4 * n + (i & 3); }
__device__ __forceinline__ unsigned cvt_pk_bf16(float lo, float hi) { unsigned r; asm("v_cvt_pk_bf16_f32 %0, %1, %2" : "=v"(r) : "v"(lo), "v"(hi)); return r; }

__device__ __forceinline__ void glds16_s(const void* sbase, unsigned voff, unsigned lds_dst) { unsigned keep;
    asm volatile("s_mov_b32 %0, m0\n\ts_mov_b32 m0, %3\n\ts_nop 0\n\tglobal_load_lds_dwordx4 %1, %2\n\ts_mov_b32 m0, %0" : "=&s"(keep) : "v"(voff), "s"(sbase), "s"(lds_dst) : "memory"); }

struct Unit { const char* A; const char* B; char* C; int ldc; int mode; int rows; int aux; int pm, pn, bjs, rmin, e; };

template <class Epi, class Sched, bool GATHER>
__device__ __forceinline__ void gemm_phase(LAS unsigned char* lds, const int K, const int lda, const int ldb, const Sched& S, const Epi& E, const int i0 = 0, const int i1 = 0x7fffffff) {
    const int tid = threadIdx.x, wid = __builtin_amdgcn_readfirstlane(tid >> 6), lane = tid & 63, wr = wid >> 2, wc = wid & 3, fr = lane & 15, fq = lane >> 4;
    const int nt = K / BK;
    unsigned voffA[2], voffB[2];
#pragma unroll
    for (int i = 0; i < 2; ++i) { int R, C; stage_rc(tid * 16 + i * 8192, R, C); const int Rb = (R & ~31) + perm32(R & 31);
        voffA[i] = (unsigned)(R * lda + C) * 2u; voffB[i] = (unsigned)(Rb * ldb + C) * 2u; }
    const size_t kstep = (size_t)(BK * 2);
    const size_t hstepA = (size_t)HALF * lda * 2, hstepB = (size_t)HALF * ldb * 2;
    const unsigned ldsw = (unsigned)wid * 1024u;
    const unsigned ldsbase = (unsigned)__builtin_amdgcn_readfirstlane((int)(unsigned)(uintptr_t)lds);
    const int aoff = lds_byte(wr * 64 + fr, fq * 8), boff = lds_byte(wc * 32 + fr, fq * 8);
#define MK_SA(b, h) (((b) * 2 + (h)) * HTB)
#define MK_SB(b, h) ((4 + (b) * 2 + (h)) * HTB)
#define MK_STAGE2(bufoff, gbase, v0, v1) do { \
        __builtin_amdgcn_global_load_lds((const unsigned*)((const char*)(gbase) + (v0)), (LAS unsigned*)(lds + (bufoff) + ldsw), 16, 0, 0); \
        __builtin_amdgcn_global_load_lds((const unsigned*)((const char*)(gbase) + (v1)), (LAS unsigned*)(lds + (bufoff) + ldsw + 8192), 16, 0, 0); } while (0)
#define MK_STAGE_B(bufoff, gbase) do { glds16_s((gbase), voffB[0], ldsbase + (bufoff) + ldsw); glds16_s((gbase), voffB[1], ldsbase + (bufoff) + ldsw + 8192u); } while (0)
#define MK_STAGE_A(bufoff, gbase, h, VA) do { if constexpr (GATHER) { glds16_s((gbase), (VA)[h][0], ldsbase + (bufoff) + ldsw); glds16_s((gbase), (VA)[h][1], ldsbase + (bufoff) + ldsw + 8192u); } \
        else { glds16_s((gbase) + (h) * hstepA, voffA[0], ldsbase + (bufoff) + ldsw); glds16_s((gbase) + (h) * hstepA, voffA[1], ldsbase + (bufoff) + ldsw + 8192u); } } while (0)
#define MK_LDA(dst, b, h) do { _Pragma("unroll") for (int m = 0; m < 4; ++m) _Pragma("unroll") for (int k = 0; k < 2; ++k) dst[m][k] = *(const LAS bf16x8*)(lds + MK_SA(b, h) + aoff + m * 2048 + k * 1024); } while (0)
#define MK_LDB(dst, b, h) do { _Pragma("unroll") for (int n = 0; n < 2; ++n) _Pragma("unroll") for (int k = 0; k < 2; ++k) dst[n][k] = *(const LAS bf16x8*)(lds + MK_SB(b, h) + boff + n * 2048 + k * 1024); } while (0)
#define MK_MMA(ai, bj, At, Bt) do { __builtin_amdgcn_s_setprio(1); _Pragma("unroll") for (int m = 0; m < 4; ++m) _Pragma("unroll") for (int n = 0; n < 2; ++n) _Pragma("unroll") for (int k = 0; k < 2; ++k) \
        acc[ai][bj][m][n] = __builtin_amdgcn_mfma_f32_16x16x32_bf16(Bt[n][k], At[m][k], acc[ai][bj][m][n], 0, 0, 0); __builtin_amdgcn_s_setprio(0); } while (0)
#define MK_WAIT_V(n) asm volatile("s_waitcnt vmcnt(" #n ")" ::: "memory")
#define MK_WAIT_L(n) asm volatile("s_waitcnt lgkmcnt(" #n ")" ::: "memory")
#define MK_BAR __builtin_amdgcn_s_barrier()
#define MK_SCHED __builtin_amdgcn_sched_barrier(0)
    Unit cur, nxt; int ui = i0;
    if (i0 >= i1 || !S.next(i0, cur)) return;
    f32x4 acc[2][2][4][2];
#pragma unroll
    for (int a = 0; a < 2; ++a)
#pragma unroll
        for (int b = 0; b < 2; ++b)
#pragma unroll
            for (int m = 0; m < 4; ++m)
#pragma unroll
                for (int n = 0; n < 2; ++n) acc[a][b][m][n] = (f32x4){0.f, 0.f, 0.f, 0.f};
    bf16x8 At[4][2], B0[2][2], B1[2][2];
    unsigned vC[2][2];
    LAS u32x4* vpark = (LAS u32x4*)(lds + GPARK_OFF) + tid;
    if constexpr (GATHER) {
#pragma unroll
        for (int h = 0; h < 2; ++h)
#pragma unroll
            for (int i = 0; i < 2; ++i) { int R, C; stage_rc(tid * 16 + i * 8192, R, C); vC[h][i] = S.arow(cur, h * HALF + R) + (unsigned)(C * 2); }
    }
    const char* cA = cur.A; const char* cB = cur.B;
    MK_STAGE_B(MK_SB(0, 0), cB); MK_STAGE_B(MK_SB(0, 1), cB + hstepB); MK_STAGE_A(MK_SA(0, 0), cA, 0, vC); MK_STAGE_A(MK_SA(0, 1), cA, 1, vC);
    if (wr == 1) MK_BAR;
    MK_WAIT_V(2); MK_BAR;
    MK_STAGE_B(MK_SB(1, 0), cB + kstep); MK_STAGE_A(MK_SA(1, 0), cA + kstep, 0, vC); MK_STAGE_B(MK_SB(1, 1), cB + hstepB + kstep);
    MK_WAIT_V(6); MK_BAR;
    for (;;) {
        const bool has_next = (ui + 1 < i1) && S.next(ui + 1, nxt);
        const char* nA = has_next ? nxt.A : cA; const char* nB = has_next ? nxt.B : cB;
        if constexpr (GATHER) {
            u32x4 pv;
#pragma unroll
            for (int h = 0; h < 2; ++h)
#pragma unroll
                for (int i = 0; i < 2; ++i) { int R, C; stage_rc(tid * 16 + i * 8192, R, C); pv[h * 2 + i] = has_next ? (S.arow(nxt, h * HALF + R) + (unsigned)(C * 2)) : vC[h][i]; }
            *vpark = pv;
        }
        for (int t = 0; t < nt; t += 2) {
            const bool last = (t == nt - 2);
            const char* a1 = cA + (size_t)(t + 1) * kstep;
            const char* a2 = last ? nA : cA + (size_t)(t + 2) * kstep; const char* b2 = last ? nB : cB + (size_t)(t + 2) * kstep;
            const char* a3 = a2 + kstep; const char* b3 = b2 + kstep;
            MK_LDB(B0, 0, 0); MK_LDB(B1, 0, 1); MK_SCHED; MK_LDA(At, 0, 0); MK_STAGE_A(MK_SA(1, 1), a1, 1, vC);
            if constexpr (GATHER) { if (last) { const u32x4 pv = *vpark; vC[0][0] = pv[0]; vC[0][1] = pv[1]; vC[1][0] = pv[2]; vC[1][1] = pv[3]; } }
            MK_WAIT_V(8); MK_WAIT_L(0); MK_BAR; MK_MMA(0, 0, At, B0); MK_MMA(0, 1, At, B1); MK_BAR; MK_SCHED;
            MK_LDA(At, 0, 1); MK_STAGE_B(MK_SB(0, 0), b2); MK_STAGE_B(MK_SB(0, 1), b2 + hstepB); MK_STAGE_A(MK_SA(0, 0), a2, 0, vC);
            MK_WAIT_V(8); MK_WAIT_L(0); MK_BAR; MK_MMA(1, 0, At, B0); MK_MMA(1, 1, At, B1); MK_BAR; MK_SCHED;
            MK_LDB(B0, 1, 0); MK_LDB(B1, 1, 1); MK_SCHED; MK_LDA(At, 1, 0); MK_STAGE_A(MK_SA(0, 1), a2, 1, vC);
            MK_WAIT_V(8); MK_WAIT_L(0); MK_BAR; MK_MMA(0, 0, At, B0); MK_MMA(0, 1, At, B1); MK_BAR; MK_SCHED;
            MK_LDA(At, 1, 1); MK_STAGE_B(MK_SB(1, 0), b3); MK_STAGE_B(MK_SB(1, 1), b3 + hstepB); MK_STAGE_A(MK_SA(1, 0), a3, 0, vC);
            MK_WAIT_V(8); MK_WAIT_L(0); MK_BAR; MK_MMA(1, 0, At, B0); MK_MMA(1, 1, At, B1); MK_BAR; MK_SCHED;
        }
        if (wr == 0) MK_BAR;
        E(acc, cur, wr, wc, fr, fq);
        if (!has_next) break;
#pragma unroll
        for (int a = 0; a < 2; ++a)
#pragma unroll
            for (int b = 0; b < 2; ++b)
#pragma unroll
                for (int m = 0; m < 4; ++m)
#pragma unroll
                    for (int n = 0; n < 2; ++n) acc[a][b][m][n] = (f32x4){0.f, 0.f, 0.f, 0.f};
        cur = nxt; cA = nA; cB = nB; ++ui;
        if (wr == 1) MK_BAR;
    }
    MK_WAIT_V(0);
    MK_BAR;
#undef MK_SA
#undef MK_SB
#undef MK_STAGE2
#undef MK_STAGE_B
#undef MK_STAGE_A
#undef MK_LDA
#undef MK_LDB
#undef MK_MMA
#undef MK_WAIT_V
#undef MK_WAIT_L
#undef MK_BAR
#undef MK_SCHED
}

__device__ __forceinline__ void grid_map(int L, int nM, int nN, int& pm, int& pn) {
    const int nwg = nM * nN, q = nwg / 8, xcd = L % 8, off = L / 8; const int wgid = xcd * q + off;
    const int nig = 8 * nN, gid = wgid / nig, fm = gid * 8, gsz = (nM - fm) < 8 ? (nM - fm) : 8;
    pm = fm + ((wgid % nig) % gsz); pn = (wgid % nig) / gsz;
}

struct EpiStore {
    const float* w2048;
    __device__ __forceinline__ void operator()(const f32x4 (&acc)[2][2][4][2], const Unit& u, int wr, int wc, int fr, int fq) const {
        const int col0 = wc * 32 + 8 * fq;
#pragma unroll
        for (int ai = 0; ai < 2; ++ai)
#pragma unroll
            for (int m = 0; m < 4; ++m) {
                const int r = ai * HALF + wr * 64 + m * 16 + fr;
                if (r < u.rows && r >= u.rmin) {
#pragma unroll
                    for (int bj = 0; bj < 2; ++bj) {
                        f32x4 v0 = acc[ai][bj][m][0], v1 = acc[ai][bj][m][1];
                        if (u.mode == 1) { float* p = (float*)u.C + (long)r * u.ldc + col0 + bj * u.bjs; *(f32x4*)p = v0; *(f32x4*)(p + 4) = v1; }
                        else {
                            if (u.mode == 2) {
#pragma unroll
                                for (int c = 0; c < 4; ++c) { v0[c] = __builtin_amdgcn_rcpf(1.0f + __expf(-v0[c])); v1[c] = __builtin_amdgcn_rcpf(1.0f + __expf(-v1[c])); }
                            } else if (u.mode == 3) {
                                const float* wp = w2048 + u.pn + bj * HALF + col0; const float sg = (r & 1) ? -1.0f : 1.0f;
                                v0 += *(const f32x4*)wp * sg; v1 += *(const f32x4*)(wp + 4) * sg;
                            }
                            u32x4 w; w.x = cvt_pk_bf16(v0[0], v0[1]); w.y = cvt_pk_bf16(v0[2], v0[3]); w.z = cvt_pk_bf16(v1[0], v1[1]); w.w = cvt_pk_bf16(v1[2], v1[3]);
                            *(u32x4*)((bf16_t*)u.C + (long)r * u.ldc + col0 + bj * u.bjs) = w;
                        }
                    }
                }
            }
    }
};

struct Args { const float* in[22]; float* out; unsigned char* ws; int ph_lo, ph_hi, use_ut, mod_off, do_attn, bar_idx; };
struct Frame {
    LAS unsigned char* lds; volatile LAS unsigned* MISC; unsigned char* ws;
    int tid, lane, wave, vcu, G;
};

__device__ __forceinline__ void t64_load(f32x4 (&v)[16], const float* W, int ldw, int lane) {
    const unsigned off = (unsigned)(((lane >> 4) * ldw + (lane & 15) * 4) * 4);
#pragma unroll
    for (int j = 0; j < 16; ++j) { const char* bj = (const char*)W + (size_t)(j * 4) * ldw * 4; v[j] = __builtin_nontemporal_load((const GAS f32x4*)(bj + off)); }
}
__device__ __forceinline__ void t64_store(const f32x4 (&v)[16], bf16_t* dst, int ldd, LAS float* scr, int lane) {
    const int kk = lane >> 4, nc = (lane & 15) * 4;
#pragma unroll
    for (int j = 0; j < 16; ++j) {
#pragma unroll
        for (int c = 0; c < 4; ++c) scr[(j * 4 + kk) * 65 + nc + c] = v[j][c]; }
    LDS_WAIT(); asm volatile("" ::: "memory");
    const int kc = lane & 7; const unsigned soff = (unsigned)(((lane >> 3) * ldd + 8 * kc) * 2);
#pragma unroll
    for (int jj = 0; jj < 8; jj += 2) {
        float t[2][8];
#pragma unroll
        for (int q = 0; q < 2; ++q) { const int n = (lane >> 3) + 8 * (jj + q); const LAS float* s = scr + (8 * kc) * 65 + n;
#pragma unroll
            for (int i = 0; i < 8; ++i) t[q][i] = s[i * 65]; }
#pragma unroll
        for (int q = 0; q < 2; ++q) { char* bq = (char*)dst + (size_t)(8 * (jj + q)) * ldd * 2;
            u32x4 o; o.x = cvt_pk_bf16(t[q][0], t[q][1]); o.y = cvt_pk_bf16(t[q][2], t[q][3]); o.z = cvt_pk_bf16(t[q][4], t[q][5]); o.w = cvt_pk_bf16(t[q][6], t[q][7]);
            __builtin_nontemporal_store(o, (GAS u32x4*)(bq + soff)); } }
    LDS_WAIT(); asm volatile("" ::: "memory");
}
__device__ __forceinline__ void transpose64(const float* W, int ldw, bf16_t* dst, int ldd, LAS float* scr, int lane) {
    f32x4 v[16]; t64_load(v, W, ldw, lane); t64_store(v, dst, ldd, scr, lane);
}

constexpr int IT_IN = 32 * 128, IT_FO = 16 * 32, IT_AO = 32 * 32, IT_O = 32 * 32, IT_EG = 64 * 256, IT_EU = 64 * 256, IT_ED = 64 * 256, IT_SH = 256;
constexpr int IT_T_END = IT_IN + IT_FO + IT_AO + IT_O + 3 * IT_SH;
constexpr int IT_MOD = MODC / 32, IT_CST = 4096, IT_BD2 = 512, IT_RWT = 32;
constexpr int IT_ALL = IT_T_END + IT_MOD + IT_CST + IT_BD2 + IT_RWT;

__device__ __forceinline__ void mod_item(const Args& args, unsigned char* ws, int r, int lane) {
            const int kq = lane >> 3, col = r * 32 + (lane & 7) * 4;
            f32x4 a0 = {0.f, 0.f, 0.f, 0.f}, a1 = a0, a2 = a0;
            for (int jb = 0; jb < 256; jb += 8) {
                f32x4 w[8]; float c0[8], c1[8], c2[8];
#pragma unroll
                for (int j = 0; j < 8; ++j) { const int k = kq + 8 * (jb + j); w[j] = *(const GAS f32x4*)(args.in[4] + (size_t)k * MODC + col); c0[j] = args.in[1][k]; c1[j] = args.in[1][DM + k]; c2[j] = args.in[3][k]; }
#pragma unroll
                for (int j = 0; j < 8; ++j) { a0 += w[j] * (c0[j] * __builtin_amdgcn_rcpf(1.0f + __expf(-c0[j]))); a1 += w[j] * (c1[j] * __builtin_amdgcn_rcpf(1.0f + __expf(-c1[j]))); a2 += w[j] * (c2[j] * __builtin_amdgcn_rcpf(1.0f + __expf(-c2[j]))); }
            }
#pragma unroll
            for (int c = 0; c < 4; ++c) {
#pragma unroll
                for (int o = 8; o < 64; o <<= 1) { a0[c] += __shfl_xor(a0[c], o); a1[c] += __shfl_xor(a1[c], o); a2[c] += __shfl_xor(a2[c], o); } }
            if (kq == 0) { const f32x4 bb = *(const GAS f32x4*)(args.in[5] + col); float* MODP = (float*)(ws + WS_MOD);
                *(GAS f32x4*)(MODP + col) = a0 + bb; *(GAS f32x4*)(MODP + MODC + col) = a1 + bb; *(GAS f32x4*)(MODP + 2 * MODC + col) = a2 + bb; }
}
__device__ __forceinline__ void p0_prologue(Frame& F, const Args& args) {
    LAS float* scr = (LAS float*)(F.lds + F.wave * 16640);
    const int gw = F.vcu * NWAVES + F.wave, NGW = F.G * NWAVES, lane = F.lane;
    unsigned char* ws = F.ws;
    bf16_t* WT_IN = (bf16_t*)(ws + WS_WT_IN); bf16_t* WT_FO = (bf16_t*)(ws + WS_WT_FO); bf16_t* WT_AO = (bf16_t*)(ws + WS_WT_AO); bf16_t* WT_O = (bf16_t*)(ws + WS_WT_O);
    bf16_t* WT_GU = (bf16_t*)(ws + WS_WT_GU); bf16_t* WT_D = (bf16_t*)(ws + WS_WT_D);
    if (NGW >= 5 * IT_MOD) { if (gw % 5 == 0 && gw / 5 < IT_MOD) mod_item(args, ws, gw / 5, lane); }
    else for (int m = gw; m < IT_MOD; m += NGW) mod_item(args, ws, m, lane);
    for (int it = gw; it < IT_ALL - IT_MOD; it += NGW) {
        int r = it;
        if (r < IT_IN) { const int kb = r / 128, nb = r % 128; transpose64(args.in[7] + (size_t)(kb * 64) * INC + nb * 64, INC, WT_IN + (size_t)(nb * 64) * DM + kb * 64, DM, scr, lane); continue; } r -= IT_IN;
        if (r < IT_FO) { const int kb = r / 32, nb = r % 32; transpose64(args.in[10] + (size_t)(kb * 64) * DM + nb * 64, DM, WT_FO + (size_t)(nb * 64) * FW + kb * 64, FW, scr, lane); continue; } r -= IT_FO;
        if (r < IT_AO) { const int kb = r / 32, nb = r % 32; transpose64(args.in[11] + (size_t)(kb * 64) * DM + nb * 64, DM, WT_AO + (size_t)(nb * 64) * DM + kb * 64, DM, scr, lane); continue; } r -= IT_AO;
        if (r < IT_O) { const int kb = r / 32, nb = r % 32; transpose64(args.in[12] + (size_t)(kb * 64) * DM + nb * 64, DM, WT_O + (size_t)(nb * 64) * DM + kb * 64, DM, scr, lane); continue; } r -= IT_O;
        if (r < 2 * IT_SH) { const int up = r >= IT_SH; if (up) r -= IT_SH; const int kb = r / 8, nb = r % 8, n0 = nb * 64;
            transpose64((up ? args.in[20] : args.in[19]) + (size_t)(kb * 64) * EFF + n0, EFF, WT_GU + ((size_t)64 * 1024 + (n0 >> 7) * 256 + (up ? 128 : 0) + (n0 & 127)) * DM + kb * 64, DM, scr, lane); continue; } r -= 2 * IT_SH;
        if (r < IT_SH) { const int kb = r / 32, nb = r % 32;
            transpose64(args.in[21] + (size_t)(kb * 64) * DM + nb * 64, DM, WT_D + ((size_t)64 * DM + nb * 64) * EFF + kb * 64, EFF, scr, lane); continue; } r -= IT_SH;

        if (r < IT_CST) {
            const int k1 = r & 2047; bf16_t* dst = (bf16_t*)(ws + WS_CST) + (size_t)r * 2048;
#pragma unroll
            for (int j = 0; j < 4; ++j) { const int n0 = j * 512 + lane * 8; float f[8];
#pragma unroll
                for (int i = 0; i < 8; ++i) { const float ph = (float)((k1 * (n0 + i)) & 4095) * (1.0f / 2048.0f); f[i] = r < 2048 ? cospif(ph) : sinpif(ph); }
                u32x4 o; o.x = cvt_pk_bf16(f[0], f[1]); o.y = cvt_pk_bf16(f[2], f[3]); o.z = cvt_pk_bf16(f[4], f[5]); o.w = cvt_pk_bf16(f[6], f[7]);
                *(GAS u32x4*)(dst + n0) = o; }
            continue; } r -= IT_CST;
        if (r < IT_BD2) {
            const int t = r >> 8, o = r & 255, gp = o >> 7, k2 = o & 127; bf16_t* dst = (bf16_t*)(ws + WS_BD2) + (size_t)r * 512; float f[8];
#pragma unroll
            for (int i = 0; i < 8; ++i) { const int j = lane * 8 + i, cg = j >> 8, jj = j & 255, c = jj & 127; const float ph = (float)((32 * c * k2) & 4095) * (1.0f / 2048.0f);
                const float v = jj < 128 ? cospif(ph) : (t ? sinpif(ph) : -sinpif(ph)); f[i] = cg == gp ? v * 0.0013810679320049757f : 0.f; }
            u32x4 w; w.x = cvt_pk_bf16(f[0], f[1]); w.y = cvt_pk_bf16(f[2], f[3]); w.z = cvt_pk_bf16(f[4], f[5]); w.w = cvt_pk_bf16(f[6], f[7]);
            *(GAS u32x4*)(dst + lane * 8) = w;
            continue; } r -= IT_BD2;
        {
            f32x4 v[16]; t64_load(v, args.in[14] + (size_t)(r * 64) * NE, NE, lane);
            const int kk = lane >> 4, nc = (lane & 15) * 4;
#pragma unroll
            for (int j = 0; j < 16; ++j) {
#pragma unroll
                for (int c = 0; c < 4; ++c) scr[(j * 4 + kk) * 65 + nc + c] = v[j][c]; }
            LDS_WAIT(); asm volatile("" ::: "memory");
            const int kc = lane & 7; bf16_t* RWT = (bf16_t*)(ws + WS_RWT);
#pragma unroll
            for (int jj = 0; jj < 8; ++jj) { const int e = (lane >> 3) + 8 * jj; const LAS float* s = scr + (8 * kc) * 65 + e; float t[8], l[8];
#pragma unroll
                for (int i = 0; i < 8; ++i) { t[i] = s[i * 65]; l[i] = t[i] - bf2f(f2bf(t[i])); }
                u32x4 h, lo; h.x = cvt_pk_bf16(t[0], t[1]); h.y = cvt_pk_bf16(t[2], t[3]); h.z = cvt_pk_bf16(t[4], t[5]); h.w = cvt_pk_bf16(t[6], t[7]);
                lo.x = cvt_pk_bf16(l[0], l[1]); lo.y = cvt_pk_bf16(l[2], l[3]); lo.z = cvt_pk_bf16(l[4], l[5]); lo.w = cvt_pk_bf16(l[6], l[7]);
                *(GAS u32x4*)(RWT + (size_t)e * DM + r * 64 + 8 * kc) = h; *(GAS u32x4*)(RWT + (size_t)(NE + e) * DM + r * 64 + 8 * kc) = lo; }
            LDS_WAIT(); asm volatile("" ::: "memory");
        }
    }
}


__device__ __forceinline__ void conv_addr(const Args& args, unsigned char* ws, bool down, int it, const float*& W, int& ldw, bf16_t*& dst, int& ldd) {
    if (!down) { int r = it; const int up = r >= IT_EG; if (up) r -= IT_EG;
        const int e = r / 256, q = r % 256, kb = q / 8, nb = q % 8, n0 = nb * 64;
        W = (up ? args.in[17] : args.in[16]) + (size_t)e * DM * EFF + (size_t)(kb * 64) * EFF + n0; ldw = EFF;
        dst = (bf16_t*)(ws + WS_WT_GU) + ((size_t)e * 1024 + (n0 >> 7) * 256 + (up ? 128 : 0) + (n0 & 127)) * DM + kb * 64; ldd = DM;
    } else { const int r = it, e = r / 256, q = r % 256, kb = q / 32, nb = q % 32;
        W = args.in[18] + (size_t)e * EFF * DM + (size_t)(kb * 64) * DM + nb * 64; ldw = DM;
        dst = (bf16_t*)(ws + WS_WT_D) + ((size_t)e * DM + nb * 64) * EFF + kb * 64; ldd = EFF; }
}
__device__ __forceinline__ void conv_items(Frame& F, const Args& args, bool down, int first, int count) {
    LAS float* scr = (LAS float*)(F.lds + F.wave * 16640);
    const int end = first + count; int it = first + F.wave;
    if (it >= end) return;
    f32x4 va[16], vb[16]; const float* W; int ldw; bf16_t* da; bf16_t* db; int ldd;
    conv_addr(args, F.ws, down, it, W, ldw, da, ldd); t64_load(va, W, ldw, F.lane);
    for (;;) {
        const bool hb = it + NWAVES < end;
        if (hb) { conv_addr(args, F.ws, down, it + NWAVES, W, ldw, db, ldd); t64_load(vb, W, ldw, F.lane); }
        t64_store(va, da, ldd, scr, F.lane);
        if (!hb) break;
        const bool ha = it + 2 * NWAVES < end;
        if (ha) { conv_addr(args, F.ws, down, it + 2 * NWAVES, W, ldw, da, ldd); t64_load(va, W, ldw, F.lane); }
        t64_store(vb, db, ldd, scr, F.lane);
        if (!ha) break;
        it += 2 * NWAVES;
    }
}
struct SchedIn {
    int G, c; unsigned char* ws; int use_ut;
    __device__ __forceinline__ bool next(int i, Unit& u) const {
        const int L = i * G + c; if (L >= 1024) return false;
        const char* H = (const char*)(ws + WS_H); const char* WT = (const char*)(ws + WS_WT_IN);
        u.rows = 256; u.aux = 0; u.bjs = HALF; u.pm = 0; u.pn = 0; u.rmin = 0;
        if (L < 896) {
            int pm, ct; grid_map(L, 32, 28, pm, ct);
            const int row0 = pm * 256, b = row0 / SEQ, t0 = row0 % SEQ;
            u.A = H + (size_t)row0 * DM * 2; u.B = WT + (size_t)ct * 256 * DM * 2;
            if (ct < 4) {
                if (use_ut) { u.A = WT + (size_t)ct * 256 * DM * 2; u.B = H + (size_t)row0 * DM * 2;
                              u.C = (char*)(ws + WS_UT) + (((size_t)b * FW + ct * 256) * SEQ + t0) * 2; u.ldc = SEQ; u.mode = 0; }
                else { u.C = (char*)(ws + WS_U) + ((size_t)row0 * FW + ct * 256) * 2; u.ldc = FW; u.mode = 0; }
            }
            else if (ct < 14) { u.C = (char*)(ws + WS_QKRAW) + ((size_t)row0 * 2560 + (ct - 4) * 256) * 4; u.ldc = 2560; u.mode = 1; }
            else if (ct < 16) { u.C = (char*)(ws + WS_VALL) + (((size_t)b * SKV + t0) * KVW + (ct - 14) * 256) * 2; u.ldc = KVW; u.mode = 0; }
            else if (ct < 24) { u.C = (char*)(ws + WS_SGF) + ((size_t)row0 * DM + (ct - 16) * 256) * 2; u.ldc = DM; u.mode = 2; }
            else              { u.C = (char*)(ws + WS_SGA) + ((size_t)row0 * DM + (ct - 24) * 256) * 2; u.ldc = DM; u.mode = 2; }
        } else if (L >= 904) {
            int pm, q; grid_map(L - 904, 32, 4, pm, q); const int ct = 28 + q;
            u.A = H + (size_t)pm * 256 * DM * 2; u.B = WT + (size_t)ct * 256 * DM * 2;
            u.C = (char*)(ws + WS_SGA) + ((size_t)pm * 256 * DM + (ct - 24) * 256) * 2; u.ldc = DM; u.mode = 2;
        } else {
            const int l = L - 896, pm = l & 1, ct = l >> 1;
            u.A = H + (size_t)(NTOK + pm * 256) * DM * 2; u.B = WT + (size_t)(K_OFF + ct * 256) * DM * 2;
            if (ct < 2) { u.C = (char*)(ws + WS_KCRAW) + ((size_t)(pm * 256) * KVW + ct * 256) * 4; u.ldc = KVW; u.mode = 1; }
            else        { u.C = (char*)(ws + WS_VALL) + (((size_t)pm * SKV + SEQ) * KVW + (ct - 2) * 256) * 2; u.ldc = KVW; u.mode = 0; }
        }
        return true;
    }
    __device__ __forceinline__ unsigned arow(const Unit&, int) const { return 0u; }
};


__device__ __forceinline__ void unpack8(u32x4 w, float (&f)[8]) {
#pragma unroll
    for (int i = 0; i < 4; ++i) { f[2 * i] = __uint_as_float(w[i] << 16); f[2 * i + 1] = __uint_as_float(w[i] & 0xffff0000u); }
}
struct EpiT1 { const bf16_t* SGF; float* T1;
    __device__ __forceinline__ void operator()(const f32x4 (&acc)[2][2][4][2], const Unit& u, int wr, int wc, int fr, int fq) const {
#pragma unroll
        for (int ai = 0; ai < 2; ++ai)
#pragma unroll
            for (int m = 0; m < 4; ++m) { const size_t row = (size_t)u.pm * 256 + ai * HALF + wr * 64 + m * 16 + fr;
#pragma unroll
                for (int bj = 0; bj < 2; ++bj) { const size_t o = row * DM + u.pn * 256 + bj * HALF + wc * 32 + 8 * fq;
                    float g[8]; unpack8(*(const u32x4*)(SGF + o), g); const f32x4 v0 = acc[ai][bj][m][0], v1 = acc[ai][bj][m][1];
                    *(f32x4*)(T1 + o) = (f32x4){g[0] * v0[0], g[1] * v0[1], g[2] * v0[2], g[3] * v0[3]};
                    *(f32x4*)(T1 + o + 4) = (f32x4){g[4] * v1[0], g[5] * v1[1], g[6] * v1[2], g[7] * v1[3]}; } }
    } };
struct EpiYM { const bf16_t* SGA; const float* T1; bf16_t* YM;
    __device__ __forceinline__ void operator()(const f32x4 (&acc)[2][2][4][2], const Unit& u, int wr, int wc, int fr, int fq) const {
#pragma unroll
        for (int ai = 0; ai < 2; ++ai)
#pragma unroll
            for (int m = 0; m < 4; ++m) { const size_t row = (size_t)u.pm * 256 + ai * HALF + wr * 64 + m * 16 + fr;
#pragma unroll
                for (int bj = 0; bj < 2; ++bj) { const size_t o = row * DM + u.pn * 256 + bj * HALF + wc * 32 + 8 * fq;
                    float g[8]; unpack8(*(const u32x4*)(SGA + o), g); const f32x4 v0 = acc[ai][bj][m][0], v1 = acc[ai][bj][m][1];
                    const f32x4 t0 = *(const f32x4*)(T1 + o), t1 = *(const f32x4*)(T1 + o + 4);
                    u32x4 w; w.x = cvt_pk_bf16(t0[0] + g[0] * v0[0], t0[1] + g[1] * v0[1]); w.y = cvt_pk_bf16(t0[2] + g[2] * v0[2], t0[3] + g[3] * v0[3]);
                    w.z = cvt_pk_bf16(t1[0] + g[4] * v1[0], t1[1] + g[5] * v1[1]); w.w = cvt_pk_bf16(t1[2] + g[6] * v1[2], t1[3] + g[7] * v1[3]);
                    *(u32x4*)(YM + o) = w; } }
    } };
struct EpiX2 { const float* x; const float* mod; float* X2;
    __device__ __forceinline__ void operator()(const f32x4 (&acc)[2][2][4][2], const Unit& u, int wr, int wc, int fr, int fq) const {
        const float* g1 = mod + ((u.pm * 256) / SEQ) * MODC + 2 * DM;
#pragma unroll
        for (int ai = 0; ai < 2; ++ai)
#pragma unroll
            for (int m = 0; m < 4; ++m) { const size_t row = (size_t)u.pm * 256 + ai * HALF + wr * 64 + m * 16 + fr;
#pragma unroll
                for (int bj = 0; bj < 2; ++bj) { const int col = u.pn * 256 + bj * HALF + wc * 32 + 8 * fq; const size_t o = row * DM + col;
#pragma unroll
                    for (int n = 0; n < 2; ++n) { const f32x4 xv = *(const f32x4*)(x + o + 4 * n), gv = *(const f32x4*)(g1 + col + 4 * n); *(f32x4*)(X2 + o + 4 * n) = xv + gv * acc[ai][bj][m][n]; } } }
    } };
struct EpiAct {
    __device__ __forceinline__ void operator()(const f32x4 (&acc)[2][2][4][2], const Unit& u, int wr, int wc, int fr, int fq) const {
#pragma unroll
        for (int ai = 0; ai < 2; ++ai)
#pragma unroll
            for (int m = 0; m < 4; ++m) { const int r = ai * HALF + wr * 64 + m * 16 + fr;
                if (r < u.rows) { float a[8];
#pragma unroll
                    for (int n = 0; n < 2; ++n)
#pragma unroll
                        for (int c = 0; c < 4; ++c) { const float g = acc[ai][0][m][n][c], up = acc[ai][1][m][n][c]; a[4 * n + c] = g * __builtin_amdgcn_rcpf(1.0f + __expf(-g)) * up; }
                    u32x4 w; w.x = cvt_pk_bf16(a[0], a[1]); w.y = cvt_pk_bf16(a[2], a[3]); w.z = cvt_pk_bf16(a[4], a[5]); w.w = cvt_pk_bf16(a[6], a[7]);
                    *(u32x4*)((bf16_t*)u.C + (size_t)r * u.ldc + wc * 32 + 8 * fq) = w; } }
    } };

struct SchedGrid {
    int G, c, nM, nN; const char* A; const char* B; char* C; size_t astride, bstride; int ldc, esz, mode;
    __device__ __forceinline__ bool next(int i, Unit& u) const {
        const int L = i * G + c; if (L >= nM * nN) return false;
        int pm, pn; grid_map(L, nM, nN, pm, pn);
        u.A = A + (size_t)pm * astride; u.B = B + (size_t)pn * bstride; u.C = C + ((size_t)pm * 256 * ldc + pn * 256) * esz; u.ldc = ldc; u.mode = mode; u.rows = 256; u.aux = 0; u.pm = pm; u.pn = pn; u.bjs = HALF; u.rmin = 0;
        return true; }
    __device__ __forceinline__ unsigned arow(const Unit&, int) const { return 0u; } };
struct SchedAG { int G, c; unsigned char* ws;
    __device__ __forceinline__ bool next(int i, Unit& u) const {
        const int L = i * G + c; if (L >= 136) return false;
        u.rows = 256; u.aux = 0; u.rmin = 0;
        if (L < 128) {
            int pm, pn8; grid_map(L, 16, 8, pm, pn8); const int b = pn8 >> 2, pn = pn8 & 3, sn = pm >> 3, k1t = pm & 7;
            u.A = (const char*)(ws + WS_CST) + (size_t)pm * 256 * 2048 * 2; u.B = (const char*)(ws + (sn ? WS_OT : WS_ET)) + ((size_t)b * FW + pn * 256) * 2048 * 2;
            u.C = (char*)(ws + WS_TT) + (((size_t)b * 2048 + k1t * 256) * DM + pn * 512 + sn * 128) * 2; u.ldc = DM; u.mode = sn ? 0 : 3; u.pm = k1t; u.pn = b * FW + pn * 256; u.bjs = 256;
        } else {
            int pm, q; grid_map(L - 128 + 120, 32, 4, pm, q); const int ct = 28 + q;
            u.A = (const char*)(ws + WS_H) + (size_t)pm * 256 * DM * 2; u.B = (const char*)(ws + WS_WT_IN) + (size_t)ct * 256 * DM * 2;
            u.C = (char*)(ws + WS_SGA) + ((size_t)pm * 256 * DM + (ct - 24) * 256) * 2; u.ldc = DM; u.mode = 2; u.pm = pm; u.pn = ct; u.bjs = HALF;
        }
        return true; }
    __device__ __forceinline__ unsigned arow(const Unit&, int) const { return 0u; } };
struct SchedF2 { int G, c; unsigned char* ws;
    __device__ __forceinline__ bool next(int i, Unit& u) const {
        const int L = i * G + c; if (L >= 128) return false;
        int pm, q; grid_map(L, 16, 8, pm, q); const int b = pm >> 3, k1t = pm & 7, j = q & 3, mir = q >> 2;
        u.A = (const char*)(ws + WS_TT) + (((size_t)b * 2048 + k1t * 256) * DM + j * 512) * 2; u.B = (const char*)(ws + WS_BD2) + (size_t)mir * 256 * 512 * 2;
        u.mode = 0; u.rows = 256; u.aux = 0; u.pm = pm; u.pn = j; u.bjs = HALF;
        if (!mir) { u.C = (char*)(ws + WS_YF) + (((size_t)b * SEQ + k1t * 256) * FW + j * 256) * 2; u.ldc = FW; u.rmin = 0; }
        else { u.C = (char*)(ws + WS_YF) + (((size_t)b * SEQ + SEQ - k1t * 256) * FW + j * 256) * 2; u.ldc = -FW; u.rmin = k1t == 0 ? 1 : 0; }
        return true; }
    __device__ __forceinline__ unsigned arow(const Unit&, int) const { return 0u; } };
constexpr int SCHT_OFF = LDSCTL_OFF + 1024;
__device__ __forceinline__ void moe_tables(Frame& F, int ncol_tiles) {
    LAS int* T = (LAS int*)(F.lds + SCHT_OFF);
    __syncthreads();
    if (F.tid == 0) { const int* CNT = (const int*)(F.ws + CTL_CNT); int up = 0, of = 0;
        for (int e = 0; e <= NE; ++e) { const int cn = e < NE ? CNT[e * 64] : NTOK; T[e] = up; T[80 + e] = e < NE ? of : NSLOT; T[160 + e] = cn; up += ((cn + 255) >> 8) * ncol_tiles; of += cn; }
        T[NE + 1] = up; }
    __syncthreads();
}
template <int NCT, bool FIRST> struct SchedMoe {
    int G, c; unsigned char* ws; LAS int* T; const int* TOK;
    __device__ __forceinline__ bool next(int i, Unit& u) const {
        const int L = i * G + c; if (L >= T[NE + 1]) return false;
        int lo = 0, hi = NE;
#pragma unroll 1
        while (lo < hi) { const int mid = (lo + hi + 1) >> 1; if (T[mid] <= L) lo = mid; else hi = mid - 1; }
        const int e = lo, cn = T[160 + e], ntile = (cn + 255) >> 8, local = L - T[e], ct = local / ntile, mt = local % ntile, slot0 = T[80 + e] + mt * 256;
        u.rows = (cn - mt * 256) < 256 ? (cn - mt * 256) : 256; u.aux = slot0; u.pm = mt; u.pn = ct; u.bjs = HALF; u.mode = 0; u.rmin = 0; u.e = e;
        if (FIRST) { u.A = (const char*)(ws + WS_H2); u.B = (const char*)(ws + WS_WT_GU) + ((size_t)e * 4 + ct) * 256 * DM * 2; u.C = (char*)(ws + WS_ACT) + ((size_t)slot0 * EFF + ct * 128) * 2; u.ldc = EFF; }
        else { u.A = (const char*)(ws + WS_ACT) + (size_t)slot0 * EFF * 2; u.B = (const char*)(ws + WS_WT_D) + ((size_t)e * DM + ct * 256) * EFF * 2; u.C = (char*)(ws + WS_YBIG) + ((size_t)slot0 * DM + ct * 256) * 2; u.ldc = DM; }
        return true; }
    __device__ __forceinline__ unsigned arow(const Unit& u, int r) const { const int rr = u.pm * 256 + (r < u.rows ? r : u.rows - 1); const int tok = u.e < NE ? TOK[u.e * NTOK + rr] : rr; return (unsigned)tok * (unsigned)(DM * 2); } };

namespace attn {
using s16x4 = __attribute__((ext_vector_type(4))) short;
using f32x8 = __attribute__((ext_vector_type(8))) float;
constexpr int D = 128, NW = 8, QBLK = 32, KVBLK = 64;
constexpr float SCALE = 0.088388347648318440f;
constexpr float THR = 8.f;
constexpr int LDQ = DM, LDK = KVW, LDO = DM;
constexpr size_t SHM_V = KVBLK * D * 2, SHM_K = KVBLK * D * 2, SHM_ATTN = 2 * SHM_V + 2 * SHM_K + NW * 64 * 4;
#define KSWZ(row, colB) ((row) * 256 + ((colB) ^ (((row) & 7) << 4)))
#define SBAR() __builtin_amdgcn_sched_barrier(0)
__device__ __forceinline__ unsigned cvtpk(float lo, float hi) { unsigned r; asm volatile("v_cvt_pk_bf16_f32 %0, %1, %2" : "=v"(r) : "v"(lo), "v"(hi)); return r; }
__device__ __forceinline__ void partialSM(f32x16& p0, f32x16& p1, float& m_reg, float& mn, float& alpha) {
  constexpr float C = SCALE * 1.4426950408889634f;
  float pmax = p0[0]; for (int r = 1; r < 16; ++r) pmax = fmaxf(pmax, p0[r]); for (int r = 0; r < 16; ++r) pmax = fmaxf(pmax, p1[r]);
  { auto rr = __builtin_amdgcn_permlane32_swap(__float_as_uint(pmax), __float_as_uint(pmax), false, false);
    pmax = fmaxf(__uint_as_float(rr[0]), __uint_as_float(rr[1])); }
  if (__builtin_expect(__all(pmax - m_reg <= THR / SCALE), 1)) { mn = m_reg; alpha = 1.f; }
  else { mn = fmaxf(m_reg, pmax); alpha = __builtin_amdgcn_exp2f((m_reg - mn) * C); m_reg = mn; }
  float mnC = -mn * C;
  for (int r = 0; r < 16; ++r) p0[r] = fmaf(p0[r], C, mnC); for (int r = 0; r < 16; ++r) p1[r] = fmaf(p1[r], C, mnC);
  for (int r = 0; r < 16; ++r) p0[r] = __builtin_amdgcn_exp2f(p0[r]);
}
__device__ __forceinline__ void finishSM(f32x16& p0, f32x16& p1, float alpha, float& l_reg, bf16x8& pa0, bf16x8& pa1, bf16x8& pa2, bf16x8& pa3) {
  for (int r = 0; r < 16; ++r) p1[r] = __builtin_amdgcn_exp2f(p1[r]);
  float ps = 0; for (int r = 0; r < 16; ++r) ps += p0[r]; for (int r = 0; r < 16; ++r) ps += p1[r];
  { auto rr = __builtin_amdgcn_permlane32_swap(__float_as_uint(ps), __float_as_uint(ps), false, false);
    ps = __uint_as_float(rr[0]) + __uint_as_float(rr[1]); }
  l_reg = l_reg * alpha + ps;
#define PK4(P, BASE, OUT) do { unsigned a0 = cvtpk(P[BASE + 0], P[BASE + 1]), a1 = cvtpk(P[BASE + 2], P[BASE + 3]);   \
    unsigned b0 = cvtpk(P[BASE + 4], P[BASE + 5]), b1 = cvtpk(P[BASE + 6], P[BASE + 7]);                              \
    auto r0 = __builtin_amdgcn_permlane32_swap(a0, b0, false, false); auto r1 = __builtin_amdgcn_permlane32_swap(a1, b1, false, false); \
    u32x4 w = {r0[0], r1[0], r0[1], r1[1]}; OUT = *reinterpret_cast<bf16x8*>(&w); } while (0)
  PK4(p0, 0, pa0); PK4(p0, 8, pa1); PK4(p1, 0, pa2); PK4(p1, 8, pa3);
#undef PK4
}
__device__ __forceinline__ void qkt(f32x16& p0, f32x16& p1, const bf16_t* Ks, const bf16x8* qr, int r32, int hi) {
  p0 = f32x16{}; p1 = f32x16{};
  for (int d0 = 0; d0 < 8; ++d0) { int cb = (d0 * 16 + hi * 8) * 2;
    bf16x8 b0 = *reinterpret_cast<const bf16x8*>((const char*)Ks + KSWZ(r32, cb));
    bf16x8 b1 = *reinterpret_cast<const bf16x8*>((const char*)Ks + KSWZ(32 + r32, cb));
    p0 = __builtin_amdgcn_mfma_f32_32x32x16_bf16(b0, qr[d0], p0, 0, 0, 0);
    p1 = __builtin_amdgcn_mfma_f32_32x32x16_bf16(b1, qr[d0], p1, 0, 0, 0); }
}
__device__ __forceinline__ int v_st(int k, int c) { const int kk = (k & ~0xC) | ((k & 4) << 1) | ((k & 8) >> 1); return ((kk >> 3) * 4 + (c >> 5)) * 512 + ((kk & 7) * 32 + (c & 31)) * 2; }
__device__ __forceinline__ int v_rd_base(int lane) { return ((lane & 3) << 3) | (((lane >> 2) & 3) << 6) | (((lane >> 4) & 1) << 5) | (((lane >> 5) & 1) << 8); }
constexpr int v_rd_off(int d0, int ks, int half) { return d0 * 512 + ks * 4096 + half * 2048; }
template <int OFF> __device__ __forceinline__ s16x4 tr_read(int vb) {
  s16x4 r; asm volatile("ds_read_b64_tr_b16 %0, %1 offset:%2" : "=&v"(r) : "v"(vb), "i"(OFF) : "memory"); return r;
}
template <int D0> __device__ __forceinline__ void pv_one(f32x16& od, int vb, bf16x8 pa0, bf16x8 pa1, bf16x8 pa2, bf16x8 pa3) {
  const s16x4 l0 = tr_read<v_rd_off(D0, 0, 0)>(vb), h0 = tr_read<v_rd_off(D0, 0, 1)>(vb), l1 = tr_read<v_rd_off(D0, 1, 0)>(vb), h1 = tr_read<v_rd_off(D0, 1, 1)>(vb);
  const s16x4 l2 = tr_read<v_rd_off(D0, 2, 0)>(vb), h2 = tr_read<v_rd_off(D0, 2, 1)>(vb), l3 = tr_read<v_rd_off(D0, 3, 0)>(vb), h3 = tr_read<v_rd_off(D0, 3, 1)>(vb);
  asm volatile("s_waitcnt lgkmcnt(0)" ::: "memory"); SBAR();
#define PK(L, H) (bf16x8){L[0], L[1], L[2], L[3], H[0], H[1], H[2], H[3]}
  od = __builtin_amdgcn_mfma_f32_32x32x16_bf16(pa0, PK(l0, h0), od, 0, 0, 0);
  od = __builtin_amdgcn_mfma_f32_32x32x16_bf16(pa1, PK(l1, h1), od, 0, 0, 0);
  od = __builtin_amdgcn_mfma_f32_32x32x16_bf16(pa2, PK(l2, h2), od, 0, 0, 0);
  od = __builtin_amdgcn_mfma_f32_32x32x16_bf16(pa3, PK(l3, h3), od, 0, 0, 0);
#undef PK
}
__device__ __forceinline__ void pv_d0(f32x16* o, int vb, bf16x8 pa0, bf16x8 pa1, bf16x8 pa2, bf16x8 pa3) {
  pv_one<0>(o[0], vb, pa0, pa1, pa2, pa3); pv_one<1>(o[1], vb, pa0, pa1, pa2, pa3); pv_one<2>(o[2], vb, pa0, pa1, pa2, pa3); pv_one<3>(o[3], vb, pa0, pa1, pa2, pa3);
}
__device__ __forceinline__ void attn_dense_body(const bf16_t* __restrict__ Qb, const bf16_t* __restrict__ Kh, const bf16_t* __restrict__ Vh, bf16_t* __restrict__ Ob, int seq, char* lds) {
  const int tid = threadIdx.x, wid = tid >> 6, lane = tid & 63, r32 = lane & 31, hi = lane >> 5;
  bf16_t* V_lds = (bf16_t*)lds; bf16_t* K_lds = (bf16_t*)(lds + 2 * SHM_V);
  float* ws = (float*)(lds + 2 * SHM_V + 2 * SHM_K) + wid * 64; float* li_l = ws; float* al_l = ws + 32;
  float m_reg = -1e30f, l_reg = 0; f32x16 o[4] = {}; bf16x8 qr[8];
  const bf16_t* Qw = Qb + (long)(wid * QBLK + r32) * LDQ + hi * 8;
#pragma unroll
  for (int d0 = 0; d0 < 8; ++d0) qr[d0] = *reinterpret_cast<const bf16x8*>(Qw + d0 * 16);
  const int sr = tid >> 4, sc = (tid & 15) * 8, vst0 = v_st(sr, sc), vst1 = v_st(32 + sr, sc);
  const int vb0 = (int)(uintptr_t)V_lds + v_rd_base(lane);
  struct { bf16x8 vs0, vs1, ks0, ks1; } sr_[2];
#define SLOAD(i, k0) do { sr_[i].vs0 = *reinterpret_cast<const bf16x8*>(&Vh[(long)((k0) + sr) * LDK + sc]); sr_[i].vs1 = *reinterpret_cast<const bf16x8*>(&Vh[(long)((k0) + 32 + sr) * LDK + sc]); \
    sr_[i].ks0 = *reinterpret_cast<const bf16x8*>(&Kh[(long)((k0) + sr) * LDK + sc]); sr_[i].ks1 = *reinterpret_cast<const bf16x8*>(&Kh[(long)((k0) + 32 + sr) * LDK + sc]); } while (0)
#define SWRITE(b, i) do { *(bf16x8*)((char*)V_lds + (b) * SHM_V + vst0) = sr_[i].vs0;          \
    *(bf16x8*)((char*)V_lds + (b) * SHM_V + vst1) = sr_[i].vs1; int kc = sc * 2;               \
    *(bf16x8*)((char*)K_lds + (b) * SHM_K + KSWZ(sr, kc)) = sr_[i].ks0;                       \
    *(bf16x8*)((char*)K_lds + (b) * SHM_K + KSWZ(32 + sr, kc)) = sr_[i].ks1; } while (0)
#define SWAIT() asm volatile("s_waitcnt vmcnt(4)" ::: "memory")
#define RESC(a) do { if (__any((a) < 1.f)) { if (hi == 0) al_l[r32] = (a); asm volatile("s_waitcnt lgkmcnt(0)" ::: "memory"); \
    for (int d = 0; d < 4; ++d) for (int r = 0; r < 16; ++r) o[d][r] *= al_l[crow(r, hi)]; } } while (0)
  f32x16 pA0, pA1, pB0, pB1; float mnA, mnB, alA, alB; bf16x8 pa0, pa1, pa2, pa3; const int NT = seq / KVBLK;
  constexpr int SE = 0, SO = 1;
  SLOAD(SE, 0); asm volatile("s_waitcnt vmcnt(0)" ::: "memory"); SWRITE(0, SE); __syncthreads();
  qkt(pA0, pA1, K_lds, qr, r32, hi); partialSM(pA0, pA1, m_reg, mnA, alA);
  SLOAD(SO, KVBLK); if (2 < NT) SLOAD(SE, 2 * KVBLK);
  SWAIT(); SWRITE(1, SO); __syncthreads();
  for (int j = 1; j + 1 < NT; j += 2) {
    SBAR(); qkt(pB0, pB1, (bf16_t*)((char*)K_lds + SHM_K), qr, r32, hi);
    finishSM(pA0, pA1, alA, l_reg, pa0, pa1, pa2, pa3); SBAR();
    SLOAD(SO, (j + 2) * KVBLK); SBAR();
    pv_d0(o, vb0, pa0, pa1, pa2, pa3); partialSM(pB0, pB1, m_reg, mnB, alB);
    __syncthreads(); SWAIT(); SWRITE(0, SE);
    RESC(alB); __syncthreads();
    SBAR(); qkt(pA0, pA1, K_lds, qr, r32, hi);
    finishSM(pB0, pB1, alB, l_reg, pa0, pa1, pa2, pa3); SBAR();
    if (j + 3 < NT) SLOAD(SE, (j + 3) * KVBLK); SBAR();
    pv_d0(o, vb0 + (int)SHM_V, pa0, pa1, pa2, pa3); partialSM(pA0, pA1, m_reg, mnA, alA);
    __syncthreads(); SWAIT(); SWRITE(1, SO);
    RESC(alA); __syncthreads();
  }
  SBAR(); qkt(pB0, pB1, (bf16_t*)((char*)K_lds + SHM_K), qr, r32, hi);
  finishSM(pA0, pA1, alA, l_reg, pa0, pa1, pa2, pa3); SBAR();
  pv_d0(o, vb0, pa0, pa1, pa2, pa3); partialSM(pB0, pB1, m_reg, mnB, alB);
  __syncthreads(); RESC(alB);
  finishSM(pB0, pB1, alB, l_reg, pa0, pa1, pa2, pa3); SBAR();
  pv_d0(o, vb0 + (int)SHM_V, pa0, pa1, pa2, pa3);
  if (hi == 0) li_l[r32] = l_reg; asm volatile("s_waitcnt lgkmcnt(0)" ::: "memory");
  float rli[16];
#pragma unroll
  for (int r = 0; r < 16; ++r) rli[r] = __builtin_amdgcn_rcpf(li_l[crow(r, hi)]);
  bf16_t* Ow = Ob + (long)(wid * QBLK) * LDO;
#pragma unroll
  for (int r = 0; r < 16; ++r) { int orow = crow(r, hi);
    for (int d0 = 0; d0 < 4; ++d0) Ow[(long)orow * LDO + d0 * 32 + r32] = f2bf(o[d0][r] * rli[r]); }
#undef SLOAD
#undef SWRITE
#undef SWAIT
#undef RESC
}
#undef KSWZ
#undef SBAR
}

__device__ __forceinline__ void ph_norm1(Frame& F, const Args& args, const float* mod) {
    const int gw = F.vcu * NWAVES + F.wave, NGW = F.G * NWAVES, lane = F.lane;
    bf16_t* H = (bf16_t*)(F.ws + WS_H); const float* nw = args.in[6];
    for (int row = gw; row < NTOK + NCTX; row += NGW) {
        const float* src = row < NTOK ? args.in[0] + (size_t)row * DM : args.in[2] + (size_t)(row - NTOK) * DM;
        const float* mr = mod + (row < NTOK ? row / SEQ : 2) * MODC;
        f32x4 v[8]; float ss = 0.f;
#pragma unroll
        for (int j = 0; j < 8; ++j) { v[j] = *(const GAS f32x4*)(src + (j * 64 + lane) * 4); ss += v[j].x * v[j].x + v[j].y * v[j].y + v[j].z * v[j].z + v[j].w * v[j].w; }
        ss = wave_sum(ss);
        const float rstd = 1.0f / sqrtf(ss * (1.0f / DM) + 1e-6f);
#pragma unroll
        for (int j = 0; j < 8; ++j) { const int i = (j * 64 + lane) * 4;
            const f32x4 w = *(const GAS f32x4*)(nw + i), sc = *(const GAS f32x4*)(mr + DM + i), sh = *(const GAS f32x4*)(mr + i);
            const f32x4 h = v[j] * rstd * w * (sc + 1.0f) + sh;
            unsigned lo = cvt_pk_bf16(h[0], h[1]), hi = cvt_pk_bf16(h[2], h[3]);
            *(GAS unsigned long long*)(H + (size_t)row * DM + i) = (unsigned long long)lo | ((unsigned long long)hi << 32); }
    }
}
__device__ __forceinline__ void ph_qknorm(Frame& F, const Args& args) {
    const int gw = F.vcu * NWAVES + F.wave, NGW = F.G * NWAVES, lane = F.lane;
    const float* QKRAW = (const float*)(F.ws + WS_QKRAW); const float* KCRAW = (const float*)(F.ws + WS_KCRAW);
    bf16_t* Q = (bf16_t*)(F.ws + WS_Q); bf16_t* KALL = (bf16_t*)(F.ws + WS_KALL);
    const int axis = lane >> 5, f = lane & 31, da = axis * 64 + f, db = da + 32;
    const float qwa = args.in[8][da], qwb = args.in[8][db], kwa = args.in[9][da], kwb = args.in[9][db];
    const float inv = exp2f(-(float)f * (13.287712379549449f / 32.0f));
    for (int row = gw; row < NTOK + NCTX; row += NGW) {
        if (row < NTOK) {
            const int b = row / SEQ, t = row % SEQ;
            const float pos = (float)(axis == 0 ? t / 64 : t % 64), ang = pos * inv, cs = cosf(ang), sn = sinf(ang);
            const float* src = QKRAW + (size_t)row * 2560;
#pragma unroll
            for (int hb = 0; hb < 20; hb += 5) {
                float xa[5], xb[5];
#pragma unroll
                for (int q = 0; q < 5; ++q) { xa[q] = src[(hb + q) * HD + da]; xb[q] = src[(hb + q) * HD + db]; }
#pragma unroll
                for (int q = 0; q < 5; ++q) { const int hh = hb + q;
                    const float ss = wave_sum(xa[q] * xa[q] + xb[q] * xb[q]), rstd = 1.0f / sqrtf(ss * (1.0f / HD) + 1e-6f);
                    const float a = xa[q] * rstd * (hh < 16 ? qwa : kwa), bb = xb[q] * rstd * (hh < 16 ? qwb : kwb);
                    bf16_t* dst = hh < 16 ? Q + (size_t)row * DM + hh * HD : KALL + ((size_t)b * SKV + t) * KVW + (hh - 16) * HD;
                    dst[da] = f2bf(a * cs - bb * sn); dst[db] = f2bf(bb * cs + a * sn); }
            }
        } else {
            const int r = row - NTOK, b = r / CTXL, j = r % CTXL; const float* src = KCRAW + (size_t)r * KVW;
#pragma unroll
            for (int hh = 0; hh < 4; ++hh) { const float xa = src[hh * HD + da], xb = src[hh * HD + db];
                const float ss = wave_sum(xa * xa + xb * xb), rstd = 1.0f / sqrtf(ss * (1.0f / HD) + 1e-6f);
                bf16_t* dst = KALL + ((size_t)b * SKV + SEQ + j) * KVW + hh * HD; dst[da] = f2bf(xa * rstd * kwa); dst[db] = f2bf(xb * rstd * kwb); }
        }
    }
}
__device__ __forceinline__ void ph_evenodd(Frame& F, const Args& args) {
    const int gw = F.vcu * NWAVES + F.wave, NGW = F.G * NWAVES, lane = F.lane;
    LAS bf16_t* scr = (LAS bf16_t*)(F.lds + F.wave * 16640);
    const bf16_t* UT = (const bf16_t*)(F.ws + WS_UT); bf16_t* ET = (bf16_t*)(F.ws + WS_ET); bf16_t* OT = (bf16_t*)(F.ws + WS_OT);
    float* W2 = (float*)(F.ws + WS_W2048); float* AL = (float*)(F.ws + WS_ALT);
    for (int row = gw; row < 2 * FW; row += NGW) {
        const bf16_t* src = UT + (size_t)row * SEQ; float alt = 0.f;
#pragma unroll
        for (int j = 0; j < 8; ++j) { const u32x4 w = *(const GAS u32x4*)(src + (j * 64 + lane) * 8); *(LAS u32x4*)(scr + (j * 64 + lane) * 8) = w;
            float f[8]; unpack8(w, f); alt += (f[0] - f[1]) + (f[2] - f[3]) + (f[4] - f[5]) + (f[6] - f[7]); }
        alt = wave_sum(alt);
        LDS_WAIT(); asm volatile("" ::: "memory");
        if (lane == 0) { AL[row] = alt; W2[row] = bf2f(scr[SEQ / 2]); }
#pragma unroll
        for (int j = 0; j < 4; ++j) { const int n0 = (j * 64 + lane) * 8; float e[8], o[8];
#pragma unroll
            for (int i = 0; i < 8; ++i) { const int n = n0 + i; const float a = bf2f(scr[n]), bb = bf2f(scr[(SEQ - n) & (SEQ - 1)]); e[i] = n == 0 ? a : a + bb; o[i] = n == 0 ? 0.f : a - bb; }
            u32x4 we, wo; we.x = cvt_pk_bf16(e[0], e[1]); we.y = cvt_pk_bf16(e[2], e[3]); we.z = cvt_pk_bf16(e[4], e[5]); we.w = cvt_pk_bf16(e[6], e[7]);
            wo.x = cvt_pk_bf16(o[0], o[1]); wo.y = cvt_pk_bf16(o[2], o[3]); wo.z = cvt_pk_bf16(o[4], o[5]); wo.w = cvt_pk_bf16(o[6], o[7]);
            *(GAS u32x4*)(ET + (size_t)row * 2048 + n0) = we; *(GAS u32x4*)(OT + (size_t)row * 2048 + n0) = wo; }
        LDS_WAIT(); asm volatile("" ::: "memory");
    }
}
__device__ __forceinline__ void ph_route(Frame& F, const Args& args, const float* mod) {
    const int lane = F.lane, wv = F.wave, r32 = lane & 31, hi = lane >> 5;
    LAS float* rs = (LAS float*)F.lds;
    LAS float* part = (LAS float*)(F.lds + 1024);
    LAS int* lcnt = (LAS int*)(F.lds + 1024 + 65536);
    LAS int* lbase = lcnt + 64;
    LAS int* lent = lcnt + 128;
    const float* X2 = (const float*)(F.ws + WS_X2); const float* nw = args.in[13]; const float* rb = args.in[15];
    const bf16_t* RWT = (const bf16_t*)(F.ws + WS_RWT);
    bf16_t* H2 = (bf16_t*)(F.ws + WS_H2); int* EIDX = (int*)(F.ws + WS_EIDX); float* EW = (float*)(F.ws + WS_EW); int* EPOS = (int*)(F.ws + WS_EPOS); int* CNT = (int*)(F.ws + CTL_CNT); int* TOKE = (int*)(F.ws + WS_TOKE);
    if (F.tid < NE) lcnt[F.tid] = 0;
    __syncthreads();
    int nb = 0;
    for (int blk = F.vcu; blk < NTOK / 32; blk += F.G, ++nb) {
        const int row0 = blk * 32; const float* mr = mod + (row0 / SEQ) * MODC;
#pragma unroll
        for (int i = 0; i < 4; ++i) { const float* src = X2 + (size_t)(row0 + wv * 4 + i) * DM; float ss = 0.f;
#pragma unroll
            for (int j = 0; j < 8; ++j) { const f32x4 v = *(const GAS f32x4*)(src + (j * 64 + lane) * 4); ss += v.x * v.x + v.y * v.y + v.z * v.z + v.w * v.w; }
            ss = wave_sum(ss);
            if (lane == 0) rs[wv * 4 + i] = 1.0f / sqrtf(ss * (1.0f / DM) + 1e-6f); }
        __syncthreads();
        { const float rstd = rs[r32]; const float* xr = X2 + (size_t)(row0 + r32) * DM; bf16_t* hr = H2 + (size_t)(row0 + r32) * DM;
          f32x16 acc0 = {}, acc1 = {};
#pragma unroll 4
          for (int ks = 0; ks < 16; ++ks) { const int k = wv * 256 + ks * 16 + hi * 8;
              float h[8];
#pragma unroll
              for (int q = 0; q < 2; ++q) { const f32x4 x = *(const GAS f32x4*)(xr + k + 4 * q), w = *(const GAS f32x4*)(nw + k + 4 * q), sc = *(const GAS f32x4*)(mr + 4 * DM + k + 4 * q), sh = *(const GAS f32x4*)(mr + 3 * DM + k + 4 * q);
                  const f32x4 t = x * rstd * w * (sc + 1.0f) + sh; h[4 * q] = t[0]; h[4 * q + 1] = t[1]; h[4 * q + 2] = t[2]; h[4 * q + 3] = t[3]; }
              u32x4 wh, wl; float l[8];
              wh.x = cvt_pk_bf16(h[0], h[1]); wh.y = cvt_pk_bf16(h[2], h[3]); wh.z = cvt_pk_bf16(h[4], h[5]); wh.w = cvt_pk_bf16(h[6], h[7]);
#pragma unroll
              for (int i = 0; i < 4; ++i) { l[2 * i] = h[2 * i] - __uint_as_float(wh[i] << 16); l[2 * i + 1] = h[2 * i + 1] - __uint_as_float(wh[i] & 0xffff0000u); }
              wl.x = cvt_pk_bf16(l[0], l[1]); wl.y = cvt_pk_bf16(l[2], l[3]); wl.z = cvt_pk_bf16(l[4], l[5]); wl.w = cvt_pk_bf16(l[6], l[7]);
              *(GAS u32x4*)(hr + k) = wh;
              const bf16x8 ah = __builtin_bit_cast(bf16x8, wh), al = __builtin_bit_cast(bf16x8, wl);
              const bf16x8 bh0 = *(const GAS bf16x8*)(RWT + (size_t)r32 * DM + k), bh1 = *(const GAS bf16x8*)(RWT + (size_t)(32 + r32) * DM + k);
              const bf16x8 bl0 = *(const GAS bf16x8*)(RWT + (size_t)(NE + r32) * DM + k), bl1 = *(const GAS bf16x8*)(RWT + (size_t)(NE + 32 + r32) * DM + k);
              acc0 = __builtin_amdgcn_mfma_f32_32x32x16_bf16(ah, bh0, acc0, 0, 0, 0); acc0 = __builtin_amdgcn_mfma_f32_32x32x16_bf16(ah, bl0, acc0, 0, 0, 0); acc0 = __builtin_amdgcn_mfma_f32_32x32x16_bf16(al, bh0, acc0, 0, 0, 0);
              acc1 = __builtin_amdgcn_mfma_f32_32x32x16_bf16(ah, bh1, acc1, 0, 0, 0); acc1 = __builtin_amdgcn_mfma_f32_32x32x16_bf16(ah, bl1, acc1, 0, 0, 0); acc1 = __builtin_amdgcn_mfma_f32_32x32x16_bf16(al, bh1, acc1, 0, 0, 0); }
#pragma unroll
          for (int r = 0; r < 16; ++r) { part[(wv * 32 + crow(r, hi)) * 64 + r32] = acc0[r]; part[(wv * 32 + crow(r, hi)) * 64 + 32 + r32] = acc1[r]; } }
        __syncthreads();
        for (int i = 0; i < 4; ++i) { const int rbk = wv * 4 + i, row = row0 + rbk; float logit = 0.f;
#pragma unroll
          for (int w = 0; w < 8; ++w) logit += part[(w * 32 + rbk) * 64 + lane];
          const float score = 1.0f / (1.0f + expf(-logit)), bsd = score + rb[lane];
          const int g = lane >> 3;
          int rk = 0;
#pragma unroll
          for (int q = 0; q < 8; ++q) { const int o = (lane & ~7) + q; const float vv = __shfl(bsd, o); rk += (vv > bsd) || (vv == bsd && o < lane); }
          float gs = rk < 2 ? bsd : 0.f;
          gs += __shfl_xor(gs, 1); gs += __shfl_xor(gs, 2); gs += __shfl_xor(gs, 4);
          int grk = 0;
#pragma unroll
          for (int gg = 0; gg < 8; ++gg) { const float vv = __shfl(gs, gg * 8); grk += (vv > gs) || (vv == gs && gg < g); }
          const bool gsel = grk < 4;
          const float mb = gsel ? bsd : -INFINITY;
          int erk = 0;
          for (int o = 0; o < 64; ++o) { const float vv = __shfl(mb, o); erk += (vv > mb) || (vv == mb && o < lane); }
          const bool sel = gsel && erk < TOPK;
          const float ssum = wave_sum(sel ? score : 0.f);
          if (sel) { const int lp = __hip_atomic_fetch_add(lcnt + lane, 1, __ATOMIC_RELAXED, __HIP_MEMORY_SCOPE_WORKGROUP);
                     EIDX[row * TOPK + erk] = lane; EW[row * TOPK + erk] = score / ssum * 2.5f; lent[(nb * 32 + rbk) * TOPK + erk] = (lane << 16) | lp; } }
        __syncthreads();
    }
    if (F.tid < NE) { const int c = lcnt[F.tid]; lbase[F.tid] = c ? atomicAdd(&CNT[F.tid * 64], c) : 0; }
    __syncthreads();
    for (int i = F.tid; i < nb * 256; i += NTHREADS) { const int blk = F.vcu + (i >> 8) * F.G, row = blk * 32 + ((i >> 3) & 31), v = lent[i]; const int pos = lbase[v >> 16] + (v & 0xffff); EPOS[row * TOPK + (i & 7)] = pos; TOKE[(v >> 16) * NTOK + pos] = row; }
    __syncthreads();
}
__device__ __forceinline__ void ph_comb(Frame& F, const Args& args, const float* mod) {
    const int gw = F.vcu * NWAVES + F.wave, NGW = F.G * NWAVES, lane = F.lane;
    moe_tables(F, 4);
    LAS int* T = (LAS int*)(F.lds + SCHT_OFF);
    const float* EW = (const float*)(F.ws + WS_EW); const int* EIDX = (const int*)(F.ws + WS_EIDX); const int* EPOS = (const int*)(F.ws + WS_EPOS); const bf16_t* Y = (const bf16_t*)(F.ws + WS_YBIG);
    for (int t = gw; t < NTOK; t += NGW) {
        const float* g2 = mod + (t / SEQ) * MODC + 5 * DM;
        int sl[TOPK]; float wk[TOPK];
#pragma unroll
        for (int k = 0; k < TOPK; ++k) { sl[k] = T[80 + EIDX[t * TOPK + k]] + EPOS[t * TOPK + k]; wk[k] = EW[t * TOPK + k]; }
#pragma unroll
        for (int j = 0; j < 4; ++j) { const int col = j * 512 + lane * 8;
            float a[8]; unpack8(*(const GAS u32x4*)(Y + (size_t)(NSLOT + t) * DM + col), a);
#pragma unroll
            for (int k = 0; k < TOPK; ++k) { float y[8]; unpack8(*(const GAS u32x4*)(Y + (size_t)sl[k] * DM + col), y);
#pragma unroll
                for (int c = 0; c < 8; ++c) a[c] += wk[k] * y[c]; }
            float* o = args.out + (size_t)t * DM + col; const float* xi = (const float*)(F.ws + WS_X2) + (size_t)t * DM + col;
#pragma unroll
            for (int n = 0; n < 2; ++n) { const f32x4 xv = *(const GAS f32x4*)(xi + 4 * n), gv = *(const GAS f32x4*)(g2 + col + 4 * n);
                *(GAS f32x4*)(o + 4 * n) = xv + gv * (f32x4){a[4 * n], a[4 * n + 1], a[4 * n + 2], a[4 * n + 3]}; } }
    }
}

enum { PH_PRO = 0, PH_NORM1, PH_INPROJ, PH_QKNORM, PH_ATTN, PH_F2, PH_MERGE, PH_OUT, PH_ROUTE, PH_EXP1, PH_EXP2, PH_COMB, PH_END };


__global__ void __launch_bounds__(NTHREADS, 2) fwd(Args args) {
    extern __shared__ __attribute__((aligned(16))) unsigned char lds_raw[];
    Frame F;
    F.lds = (LAS unsigned char*)lds_raw; F.MISC = (volatile LAS unsigned*)(F.lds + MISC_OFF); F.ws = args.ws;
    F.tid = threadIdx.x; F.lane = F.tid & 63; F.wave = __builtin_amdgcn_readfirstlane(F.tid >> 6);
    F.G = gridDim.x; { const int bx = blockIdx.x; F.vcu = (F.G % 8 == 0) ? (bx % 8) * (F.G / 8) + bx / 8 : bx; }
    for (int u = F.tid; u < (LDS_BYTES - LDSCTL_OFF) / 4; u += NTHREADS) ((LAS unsigned*)(F.lds + LDSCTL_OFF))[u] = 0u;
    __syncthreads();
    const int lo = args.ph_lo, hi = args.ph_hi;
    const bool multi = (hi - lo) > 1;
    unsigned* barw = (unsigned*)(args.ws + CTL_BAR) + args.bar_idx * XCD_BAR_WORDS;
    XcdBarrier bar; bar.bar = barw; bar.x = 0; bar.st = nullptr;
    if (multi) bar = xcd_barrier_post(barw, F.MISC + 8);
#define IN(k) (lo <= (k) && (k) < hi)
#define SEAM(k) do { if (IN((k) + 1)) xcd_barrier(bar); } while (0)

    const float* modp = (const float*)(args.ws + args.mod_off);
    if (IN(PH_PRO)) { p0_prologue(F, args); SEAM(PH_PRO); }
    if (IN(PH_NORM1)) { ph_norm1(F, args, modp); SEAM(PH_NORM1); }
    if (IN(PH_INPROJ)) {
        SchedIn S{F.G, (int)blockIdx.x, args.ws, args.use_ut};
        gemm_phase<EpiStore, SchedIn, false>(F.lds, DM, DM, DM, S, EpiStore{(const float*)(args.ws + WS_W2048)});
        SEAM(PH_INPROJ);
    }
    if (IN(PH_QKNORM)) { ph_qknorm(F, args); ph_evenodd(F, args); SEAM(PH_QKNORM); }
    if (IN(PH_ATTN)) {
        const int cs = F.vcu & 3;
        constexpr int NCONV = IT_EG + IT_EU + IT_ED;
        int qfirst, qcnt; { const int c = (int)blockIdx.x; if (F.G == 256) { qfirst = c < 136 ? c * 162 : 136 * 162 + (c - 136) * 226; qcnt = c < 136 ? 162 : 226; }
                             else { const int per = (NCONV + F.G - 1) / F.G; qfirst = c * per; qcnt = qfirst + per <= NCONV ? per : (NCONV - qfirst > 0 ? NCONV - qfirst : 0); } }
        const int gcnt = qfirst < IT_EG + IT_EU ? (qfirst + qcnt <= IT_EG + IT_EU ? qcnt : IT_EG + IT_EU - qfirst) : 0, gfirst = qfirst;
        const int ccnt = qcnt - gcnt, cfirst = qfirst + gcnt - (IT_EG + IT_EU);
#define CONV_ALL() do { conv_items(F, args, false, gfirst, gcnt); conv_items(F, args, true, cfirst, ccnt); } while (0)
        const bf16_t* Qp = (const bf16_t*)(args.ws + WS_Q); const bf16_t* Kp = (const bf16_t*)(args.ws + WS_KALL); const bf16_t* Vp = (const bf16_t*)(args.ws + WS_VALL); bf16_t* Op = (bf16_t*)(args.ws + WS_YA);
#define ATTN_UNIT(lin_) do { const int lin = (lin_); if (lin < 512) { const int x = (lin >> 5) & 7, j = (lin & 31) + 32 * (lin >> 8), b = x >> 2, kvh = x & 3, head = kvh * 4 + (j >> 4), qb = j & 15; \
            const size_t qo = ((size_t)(b * SEQ + qb * 256)) * DM + head * HD, ko = (size_t)b * SKV * KVW + kvh * HD; \
            attn::attn_dense_body(Qp + qo, Kp + ko, Vp + ko, Op + qo, SKV, (char*)lds_raw); __syncthreads(); } } while (0)
        if (cs == 0) { CONV_ALL(); __syncthreads(); }
        ATTN_UNIT(F.vcu);
        if (cs == 1) { CONV_ALL(); __syncthreads(); }
        ATTN_UNIT(F.vcu + F.G);
        for (int lin2 = F.vcu + 2 * F.G; lin2 < 512; lin2 += F.G) ATTN_UNIT(lin2);
        if (cs == 2) { CONV_ALL(); __syncthreads(); }
#undef ATTN_UNIT
        SchedAG S{F.G, (int)blockIdx.x, args.ws};
        gemm_phase<EpiStore, SchedAG, false>(F.lds, DM, DM, DM, S, EpiStore{(const float*)(args.ws + WS_W2048)});
        if (cs == 3) { __syncthreads(); CONV_ALL(); }
#undef CONV_ALL
        SEAM(PH_ATTN);
    }
    if (IN(PH_F2)) {
        SchedF2 S{F.G, (int)blockIdx.x, args.ws};
        gemm_phase<EpiStore, SchedF2, false>(F.lds, 512, DM, 512, S, EpiStore{(const float*)(args.ws + WS_W2048)});
        {
            const int idx = F.vcu * NTHREADS + F.tid;
            if (idx < 2 * FW) { const int b = idx >> 10, col = idx & 1023, k2 = col & 127; const float* al = (const float*)(args.ws + WS_ALT) + b * FW + (col & ~127); float s = 0.f;
                for (int c = 0; c < 128; ++c) s += al[c] * cospif((float)((c * k2) & 127) * (1.0f / 64.0f));
                ((bf16_t*)(args.ws + WS_YF))[((size_t)b * SEQ + SEQ / 2) * FW + col] = f2bf(s * 0.0013810679320049757f); }
        }
        SEAM(PH_F2);
    }
    if (IN(PH_MERGE)) {
        unsigned char* ws = args.ws;
        { SchedGrid S{F.G, (int)blockIdx.x, 32, 8, (const char*)(ws + WS_YF), (const char*)(ws + WS_WT_FO), nullptr, (size_t)256 * FW * 2, (size_t)256 * FW * 2, DM, 4, 1};
          gemm_phase<EpiT1, SchedGrid, false>(F.lds, FW, FW, FW, S, EpiT1{(const bf16_t*)(ws + WS_SGF), (float*)(ws + WS_T1)}); }
        { SchedGrid S{F.G, (int)blockIdx.x, 32, 8, (const char*)(ws + WS_YA), (const char*)(ws + WS_WT_AO), nullptr, (size_t)256 * DM * 2, (size_t)256 * DM * 2, DM, 2, 0};
          gemm_phase<EpiYM, SchedGrid, false>(F.lds, DM, DM, DM, S, EpiYM{(const bf16_t*)(ws + WS_SGA), (const float*)(ws + WS_T1), (bf16_t*)(ws + WS_YM)}); }
        SEAM(PH_MERGE);
    }
    if (IN(PH_OUT)) {
        unsigned char* ws = args.ws;
        SchedGrid S{F.G, (int)blockIdx.x, 32, 8, (const char*)(ws + WS_YM), (const char*)(ws + WS_WT_O), nullptr, (size_t)256 * DM * 2, (size_t)256 * DM * 2, DM, 4, 1};
        gemm_phase<EpiX2, SchedGrid, false>(F.lds, DM, DM, DM, S, EpiX2{args.in[0], modp, (float*)(ws + WS_X2)});
        SEAM(PH_OUT);
    }
    if (IN(PH_ROUTE)) { ph_route(F, args, modp); SEAM(PH_ROUTE); }
    if (IN(PH_EXP1)) {
        moe_tables(F, 4);
        SchedMoe<4, true> S{F.G, F.vcu, args.ws, (LAS int*)(F.lds + SCHT_OFF), (const int*)(args.ws + WS_TOKE)};
        gemm_phase<EpiAct, SchedMoe<4, true>, true>(F.lds, DM, DM, DM, S, EpiAct{});
        SEAM(PH_EXP1);
    }
    if (IN(PH_EXP2)) {
        moe_tables(F, 8);
        SchedMoe<8, false> S{F.G, F.vcu, args.ws, (LAS int*)(F.lds + SCHT_OFF), (const int*)(args.ws + WS_TOKE)};
        gemm_phase<EpiStore, SchedMoe<8, false>, false>(F.lds, EFF, EFF, EFF, S, EpiStore{(const float*)(args.ws + WS_W2048)});
        SEAM(PH_EXP2);
    }
    if (IN(PH_COMB)) { ph_comb(F, args, modp); }
#undef IN
#undef SEAM
}
}

extern "C" void kernel_launch(void* const* d_in, const int* in_sizes, int n_in, void* d_out, int out_size, void* d_ws, size_t ws_size, hipStream_t stream) {
    if (n_in != 22 || ws_size < WS_END2) return;
    float* out = (float*)d_out;
    unsigned char* ws = (unsigned char*)d_ws;
    hipMemsetAsync(ws + WS_CTL, 0, CTL_ZERO_BYTES, stream);
    static int grid = 0;
    if (!grid) {
        int dev = 0, cus = 0;
        if (hipGetDevice(&dev) != hipSuccess || hipDeviceGetAttribute(&cus, hipDeviceAttributeMultiprocessorCount, dev) != hipSuccess) { grid = -1; return; }
        if (hipFuncSetAttribute((const void*)mk::fwd, hipFuncAttributeMaxDynamicSharedMemorySize, mk::LDS_BYTES) != hipSuccess) { grid = -1; return; }
        grid = cus;
    }
    if (grid < 0) return;
    mk::Args a{}; int nlaunch = 0;
    for (int i = 0; i < 22; ++i) a.in[i] = (const float*)d_in[i];
    a.out = out; a.ws = ws; a.use_ut = 1; a.mod_off = (int)WS_MOD; a.do_attn = 1;
#define MK_LAUNCH(lo_, hi_) do { a.ph_lo = (lo_); a.ph_hi = (hi_); a.bar_idx = nlaunch++; hipLaunchKernelGGL(mk::fwd, dim3(grid), dim3(mk::NTHREADS), mk::LDS_BYTES, stream, a); } while (0)
    MK_LAUNCH(mk::PH_PRO, mk::PH_END);
}
```

```cpp
#include <hip/hip_runtime.h>
#include <stdint.h>
#include <math.h>

typedef unsigned short bf16_t;
typedef short bf16x8 __attribute__((ext_vector_type(8)));
typedef float f32x16 __attribute__((ext_vector_type(16)));
typedef float f32x4 __attribute__((ext_vector_type(4)));

constexpr int NB = 2, SEQ = 4096, DM = 2048, NTOK = NB * SEQ, CTXL = 256, NCTX = NB * CTXL, HD = 128, NH = 16, NKV = 4;
constexpr int SKV = SEQ + CTXL;
constexpr int FW = 1024, INC = 8192, Q_OFF = 1024, K_OFF = 3072, V_OFF = 3584, GF_OFF = 4096, GA_OFF = 6144;
constexpr int KVW = NKV * HD;
constexpr int NE = 64, TOPK = 8, EFF = 512, MODC = 6 * DM;
constexpr int NSLOT = NTOK * TOPK;
constexpr int NSLOT_ALL = NSLOT + NTOK;

constexpr size_t MiB = 1u << 20;
constexpr size_t WS_CTL = 0, CTL_ZERO_BYTES = 1 * MiB;
constexpr size_t CTL_CNT = 64 * 1024;
constexpr size_t WS_TW = 1 * MiB;
constexpr size_t WS_MOD = 1 * MiB + 64 * 1024;
constexpr size_t WS_OFFS = 1 * MiB + 256 * 1024;
constexpr size_t WS_EIDX = 2 * MiB;
constexpr size_t WS_EW = WS_EIDX + 256 * 1024;
constexpr size_t WS_EPOS = WS_EW + 256 * 1024;
constexpr size_t WS_SLOTOF = WS_EPOS + 256 * 1024;
constexpr size_t WS_TOKE = 300 * MiB;
constexpr size_t WS_H = 4 * MiB;
constexpr size_t WS_U = 38 * MiB;
constexpr size_t WS_Q = 54 * MiB;
constexpr size_t WS_KALL = 86 * MiB;
constexpr size_t WS_VALL = 95 * MiB;
constexpr size_t WS_SGF = 104 * MiB;
constexpr size_t WS_SGA = 136 * MiB;
constexpr size_t WS_YA = 168 * MiB;
constexpr size_t WS_YF = 38 * MiB;
constexpr int YFP = 2048;
constexpr size_t WS_PR = 216 * MiB;
constexpr size_t WS_T1 = 248 * MiB;
constexpr size_t WS_YM = 312 * MiB;
constexpr size_t WS_QKRAW = 248 * MiB;
constexpr size_t WS_KCRAW = 330 * MiB;
constexpr size_t WS_H2 = 344 * MiB;
constexpr size_t WS_ACT = 376 * MiB;
constexpr size_t WS_YBIG = 4 * MiB;
constexpr size_t WS_END = 740 * MiB;

__device__ __forceinline__ float bf2f(bf16_t h) { return __uint_as_float(((unsigned)h) << 16); }
__device__ __forceinline__ bf16_t f2bf(float f) { unsigned u = __float_as_uint(f); return (bf16_t)((u + 0x7fffu + ((u >> 16) & 1u)) >> 16); }
__device__ __forceinline__ int crow(int r, int hi) { return (r & 3) + 8 * (r >> 2) + 4 * hi; }
__device__ __forceinline__ float wave_sum(float v) {
#pragma unroll
    for (int o = 1; o < 64; o <<= 1) v += __shfl_xor(v, o);
    return v;
}
__device__ __forceinline__ float sigmoidf_(float v) { return 1.0f / (1.0f + expf(-v)); }
__device__ __forceinline__ bf16x8 pack8(const float* f) {
    bf16x8 r;
#pragma unroll
    for (int i = 0; i < 8; ++i) r[i] = (short)f2bf(f[i]);
    return r;
}

#define LAS __attribute__((address_space(3)))
#define GAS __attribute__((address_space(1)))
typedef unsigned u32x4 __attribute__((ext_vector_type(4)));
typedef GAS unsigned gu32;
#define RLX_AGENT __ATOMIC_RELAXED, __HIP_MEMORY_SCOPE_AGENT
#define LDS_WAIT() asm volatile("s_waitcnt lgkmcnt(0)" ::: "memory")
#define VM_WAIT() asm volatile("s_waitcnt vmcnt(0)" ::: "memory")

constexpr size_t CTL_BAR = 16384;
constexpr size_t CTL_MODZ = 512 * 1024;
constexpr size_t WS_UT = 38 * MiB;
constexpr size_t WS_TT = 216 * MiB;
constexpr size_t WS_WT_GU = 450 * MiB;
constexpr size_t WS_WT_D = 710 * MiB;
constexpr size_t WS_WT_IN = 840 * MiB;
constexpr size_t WS_WT_FO = 924 * MiB;
constexpr size_t WS_WT_AO = 876 * MiB;
constexpr size_t WS_WT_O = 884 * MiB;
constexpr size_t WS_CST = 892 * MiB;
constexpr size_t WS_ET = 908 * MiB;
constexpr size_t WS_OT = 916 * MiB;
constexpr size_t WS_W2048 = 1 * MiB + 512 * 1024;
constexpr size_t WS_ALT = 1 * MiB + 520 * 1024;
constexpr size_t WS_RWT = 3 * MiB + 512 * 1024;
constexpr size_t WS_BD2 = 956 * MiB;
constexpr size_t WS_X2 = 960 * MiB;
constexpr size_t WS_END2 = 1024 * MiB;

namespace mk {
constexpr int NWAVES = 8, NTHREADS = 512;
constexpr int RING_BYTES = 131072, SCR_BYTES = 8 * 16640, LDSCTL_OFF = 135168, MISC_OFF = LDSCTL_OFF + 320, GPARK_OFF = LDSCTL_OFF + 2048  , LDS_BYTES = 147456;
static_assert(GPARK_OFF + 8192 <= LDS_BYTES, "LDS map");
static_assert(SCR_BYTES <= LDSCTL_OFF && MISC_OFF + 128 <= LDS_BYTES, "LDS map");

#define XB_TMO      128
#define XB_XCNT(j)  (256  + 64 * (j))
#define XB_XSUB(j)  (1280 + 64 * (j))
#define XB_XGEN(j)  (2304 + 64 * (j))
#define XB_TOP      3328
#define XB_TOPGEN   3392
#define XCD_BAR_WORDS 3456
#define XB_SPIN_CAP (1u << 18)
__device__ __forceinline__ unsigned xb_ld(unsigned* p)              { return __hip_atomic_load(p, __ATOMIC_RELAXED, __HIP_MEMORY_SCOPE_AGENT); }
__device__ __forceinline__ unsigned xb_add(unsigned* p, unsigned v) { return __hip_atomic_fetch_add(p, v, __ATOMIC_RELAXED, __HIP_MEMORY_SCOPE_AGENT); }
__device__ __forceinline__ unsigned xb_xcc_id() { return (unsigned)__builtin_amdgcn_s_getreg((3 << 11) | 20) & 0xFu; }
#define XB_SPIN(cond, bar) do { unsigned _sp = 0; while (cond) { __builtin_amdgcn_s_sleep(1); \
    if ((++_sp & 255u) == 0u) { if (xb_ld(&(bar)[XB_TMO])) break; if (_sp > XB_SPIN_CAP) { atomicAdd(&(bar)[XB_TMO], 1u); break; } } } } while (0)
struct XcdBarrier { unsigned* bar; unsigned x; volatile LAS unsigned* st; };
__device__ __forceinline__ XcdBarrier xcd_barrier_post(unsigned* bar, volatile LAS unsigned* st) {
    XcdBarrier b; b.bar = bar; b.x = xb_xcc_id(); b.st = st;
    if (threadIdx.x == 0) (void)xb_add(&bar[XB_XCNT(b.x)], 1u);
    return b;
}
__device__ __forceinline__ void xcd_barrier_complete(unsigned* bar, unsigned x, unsigned& nloc, unsigned& nx) {
    const unsigned G = gridDim.x * gridDim.y * gridDim.z;
    unsigned sum, cnt, mine, sp = 0u;
    for (;;) {
        sum = 0u; cnt = 0u; mine = 0u;
#pragma unroll
        for (unsigned j = 0; j < 16; ++j) { const unsigned c = xb_ld(&bar[XB_XCNT(j)]); sum += c; cnt += (c > 0u) ? 1u : 0u; mine = (j == x) ? c : mine; }
        if (sum == G) break;
        __builtin_amdgcn_s_sleep(1);
        if ((++sp & 255u) == 0u) { if (xb_ld(&bar[XB_TMO])) break; if (sp > XB_SPIN_CAP) { atomicAdd(&bar[XB_TMO], 1u); break; } }
    }
    nloc = mine > 0u ? mine : 1u; nx = cnt > 0u ? cnt : 1u;
}
__device__ __forceinline__ void xcd_barrier(const XcdBarrier& b) {
    asm volatile("s_waitcnt vmcnt(0)" ::: "memory");
    __syncthreads();
    if (threadIdx.x == 0) {
        unsigned* bar = b.bar;
        __builtin_amdgcn_s_waitcnt(0);
        unsigned nloc = b.st[0], nx = b.st[1];
        if (nloc == 0u) { xcd_barrier_complete(bar, b.x, nloc, nx); b.st[0] = nloc; b.st[1] = nx; }
        const unsigned old = xb_add(&bar[XB_XSUB(b.x)], 1u);
        const unsigned gen = old / nloc;
        if (old + 1u == (gen + 1u) * nloc) {
            __builtin_amdgcn_fence(__ATOMIC_RELEASE, "agent");
            asm volatile("s_waitcnt vmcnt(0)" ::: "memory");
            const unsigned og = xb_add(&bar[XB_TOP], 1u);
            const unsigned tg = og / nx;
            if (og + 1u == (tg + 1u) * nx) xb_add(&bar[XB_TOPGEN], 1u);
            else XB_SPIN(xb_ld(&bar[XB_TOPGEN]) == tg, bar);
            __builtin_amdgcn_fence(__ATOMIC_ACQUIRE, "agent");
            xb_add(&bar[XB_XGEN(b.x)], 1u);
            asm volatile("s_waitcnt vmcnt(0)" ::: "memory");
        } else {
            XB_SPIN(xb_ld(&bar[XB_XGEN(b.x)]) == gen, bar);
            __builtin_amdgcn_fence(__ATOMIC_ACQUIRE, "agent");
            asm volatile("s_waitcnt vmcnt(0)" ::: "memory");
        }
    }
    __syncthreads();
}

constexpr int BM = 256, BK = 64, HALF = 128, HTB = HALF * BK * 2, STAGE_BYTES = 8 * HTB;
__device__ __forceinline__ int lds_byte(int r, int c) { const int st = (r >> 4) * 2 + (c >> 5), rr = r & 15, cc = c & 31, ob = rr * 64 + cc * 2; return st * 1024 + (ob ^ (((ob >> 9) & 1) << 5)); }
__device__ __forceinline__ void stage_rc(int b, int& R, int& C) { const int st = b / 1024, sb = b % 1024, swz = sb ^ (((sb >> 9) & 1) << 5); R = (st >> 1) * 16 + swz / 64; C = (st & 1) * 32 + (swz % 64) / 2; }
__device__ __forceinline__ int perm32(int rho) { const int n = rho >> 4, i = rho & 15; return 8 * (i >> 2) + 4 * n + (i & 3); }
__device__ __forceinline__ unsigned cvt_pk_bf16(float lo, float hi) { unsigned r; asm("v_cvt_pk_bf16_f32 %0, %1, %2" : "=v"(r) : "v"(lo), "v"(hi)); return r; }

__device__ __forceinline__ void glds16_s(const void* sbase, unsigned voff, unsigned lds_dst) { unsigned keep;
    asm volatile("s_mov_b32 %0, m0\n\ts_mov_b32 m0, %3\n\ts_nop 0\n\tglobal_load_lds_dwordx4 %1, %2\n\ts_mov_b32 m0, %0" : "=&s"(keep) : "v"(voff), "s"(sbase), "s"(lds_dst) : "memory"); }

struct Unit { const char* A; const char* B; char* C; int ldc; int mode; int rows; int aux; int pm, pn, bjs, rmin, e, nt, keep; };

template <class Epi, class Sched, bool GATHER>
__device__ __forceinline__ void gemm_phase(LAS unsigned char* lds, const int K, const int lda, const int ldb, const Sched& S, const Epi& E, const int i0 = 0, const int i1 = 0x7fffffff) {
    const int tid = threadIdx.x, wid = __builtin_amdgcn_readfirstlane(tid >> 6), lane = tid & 63, wr = wid >> 2, wc = wid & 3, fr = lane & 15, fq = lane >> 4;
    unsigned voffA[2], voffB[2];
#pragma unroll
    for (int i = 0; i < 2; ++i) { int R, C; stage_rc(tid * 16 + i * 8192, R, C); const int Rb = (R & ~31) + perm32(R & 31);
        voffA[i] = (unsigned)(R * lda + C) * 2u; voffB[i] = (unsigned)(Rb * ldb + C) * 2u; }
    const size_t kstep = (size_t)(BK * 2);
    const size_t hstepA = (size_t)HALF * lda * 2, hstepB = (size_t)HALF * ldb * 2;
    const unsigned ldsw = (unsigned)wid * 1024u;
    const unsigned ldsbase = (unsigned)__builtin_amdgcn_readfirstlane((int)(unsigned)(uintptr_t)lds);
    const int aoff = lds_byte(wr * 64 + fr, fq * 8), boff = lds_byte(wc * 32 + fr, fq * 8);
#define MK_SA(b, h) (((b) * 2 + (h)) * HTB)
#define MK_SB(b, h) ((4 + (b) * 2 + (h)) * HTB)
#define MK_STAGE2(bufoff, gbase, v0, v1) do { \
        __builtin_amdgcn_global_load_lds((const unsigned*)((const char*)(gbase) + (v0)), (LAS unsigned*)(lds + (bufoff) + ldsw), 16, 0, 0); \
        __builtin_amdgcn_global_load_lds((const unsigned*)((const char*)(gbase) + (v1)), (LAS unsigned*)(lds + (bufoff) + ldsw + 8192), 16, 0, 0); } while (0)
#define MK_STAGE_B(bufoff, gbase) do { glds16_s((gbase), voffB[0], ldsbase + (bufoff) + ldsw); glds16_s((gbase), voffB[1], ldsbase + (bufoff) + ldsw + 8192u); } while (0)
#define MK_STAGE_A(bufoff, gbase, h, VA) do { if constexpr (GATHER) { glds16_s((gbase), (VA)[h][0], ldsbase + (bufoff) + ldsw); glds16_s((gbase), (VA)[h][1], ldsbase + (bufoff) + ldsw + 8192u); } \
        else { glds16_s((gbase) + (h) * hstepA, voffA[0], ldsbase + (bufoff) + ldsw); glds16_s((gbase) + (h) * hstepA, voffA[1], ldsbase + (bufoff) + ldsw + 8192u); } } while (0)
#define MK_LDA(dst, b, h) do { _Pragma("unroll") for (int m = 0; m < 4; ++m) _Pragma("unroll") for (int k = 0; k < 2; ++k) dst[m][k] = *(const LAS bf16x8*)(lds + MK_SA(b, h) + aoff + m * 2048 + k * 1024); } while (0)
#define MK_LDB(dst, b, h) do { _Pragma("unroll") for (int n = 0; n < 2; ++n) _Pragma("unroll") for (int k = 0; k < 2; ++k) dst[n][k] = *(const LAS bf16x8*)(lds + MK_SB(b, h) + boff + n * 2048 + k * 1024); } while (0)
#define MK_MMA(ai, bj, At, Bt) do { __builtin_amdgcn_s_setprio(1); _Pragma("unroll") for (int m = 0; m < 4; ++m) _Pragma("unroll") for (int n = 0; n < 2; ++n) _Pragma("unroll") for (int k = 0; k < 2; ++k) \
        acc[ai][bj][m][n] = __builtin_amdgcn_mfma_f32_16x16x32_bf16(Bt[n][k], At[m][k], acc[ai][bj][m][n], 0, 0, 0); __builtin_amdgcn_s_setprio(0); } while (0)
#define MK_WAIT_V(n) asm volatile("s_waitcnt vmcnt(" #n ")" ::: "memory")
#define MK_WAIT_L(n) asm volatile("s_waitcnt lgkmcnt(" #n ")" ::: "memory")
#define MK_BAR __builtin_amdgcn_s_barrier()
#define MK_SCHED __builtin_amdgcn_sched_barrier(0)
    Unit cur, nxt; int ui = i0;
    if (i0 >= i1 || !S.next(i0, cur)) return;
    f32x4 acc[2][2][4][2];
#pragma unroll
    for (int a = 0; a < 2; ++a)
#pragma unroll
        for (int b = 0; b < 2; ++b)
#pragma unroll
            for (int m = 0; m < 4; ++m)
#pragma unroll
                for (int n = 0; n < 2; ++n) acc[a][b][m][n] = (f32x4){0.f, 0.f, 0.f, 0.f};
    bf16x8 At[4][2], B0[2][2], B1[2][2];
    unsigned vC[2][2];
    LAS u32x4* vpark = (LAS u32x4*)(lds + GPARK_OFF) + tid;
    if constexpr (GATHER) {
#pragma unroll
        for (int h = 0; h < 2; ++h)
#pragma unroll
            for (int i = 0; i < 2; ++i) { int R, C; stage_rc(tid * 16 + i * 8192, R, C); vC[h][i] = S.arow(cur, h * HALF + R) + (unsigned)(C * 2); }
    }
    const char* cA = cur.A; const char* cB = cur.B;
    MK_STAGE_B(MK_SB(0, 0), cB); MK_STAGE_B(MK_SB(0, 1), cB + hstepB); MK_STAGE_A(MK_SA(0, 0), cA, 0, vC); MK_STAGE_A(MK_SA(0, 1), cA, 1, vC);
    if (wr == 1) MK_BAR;
    MK_WAIT_V(2); MK_BAR;
    MK_STAGE_B(MK_SB(1, 0), cB + kstep); MK_STAGE_A(MK_SA(1, 0), cA + kstep, 0, vC); MK_STAGE_B(MK_SB(1, 1), cB + hstepB + kstep);
    MK_WAIT_V(6); MK_BAR;
    for (;;) {
        const bool has_next = (ui + 1 < i1) && S.next(ui + 1, nxt);
        const char* nA = has_next ? nxt.A : cA; const char* nB = has_next ? nxt.B : cB;
        if constexpr (GATHER) {
            u32x4 pv;
#pragma unroll
            for (int h = 0; h < 2; ++h)
#pragma unroll
                for (int i = 0; i < 2; ++i) { int R, C; stage_rc(tid * 16 + i * 8192, R, C); pv[h * 2 + i] = has_next ? (S.arow(nxt, h * HALF + R) + (unsigned)(C * 2)) : vC[h][i]; }
            *vpark = pv;
        }
        const int nt = cur.nt;
        for (int t = 0; t < nt; t += 2) {
            const bool last = (t == nt - 2);
            const char* a1 = cA + (size_t)(t + 1) * kstep;
            const char* a2 = last ? nA : cA + (size_t)(t + 2) * kstep; const char* b2 = last ? nB : cB + (size_t)(t + 2) * kstep;
            const char* a3 = a2 + kstep; const char* b3 = b2 + kstep;
            MK_LDB(B0, 0, 0); MK_LDB(B1, 0, 1); MK_SCHED; MK_LDA(At, 0, 0); MK_STAGE_A(MK_SA(1, 1), a1, 1, vC);
            if constexpr (GATHER) { if (last) { const u32x4 pv = *vpark; vC[0][0] = pv[0]; vC[0][1] = pv[1]; vC[1][0] = pv[2]; vC[1][1] = pv[3]; } }
            MK_WAIT_V(8); MK_WAIT_L(0); MK_BAR; MK_MMA(0, 0, At, B0); MK_MMA(0, 1, At, B1); MK_BAR; MK_SCHED;
            MK_LDA(At, 0, 1); MK_STAGE_B(MK_SB(0, 0), b2); MK_STAGE_B(MK_SB(0, 1), b2 + hstepB); MK_STAGE_A(MK_SA(0, 0), a2, 0, vC);
            MK_WAIT_V(8); MK_WAIT_L(0); MK_BAR; MK_MMA(1, 0, At, B0); MK_MMA(1, 1, At, B1); MK_BAR; MK_SCHED;
            MK_LDB(B0, 1, 0); MK_LDB(B1, 1, 1); MK_SCHED; MK_LDA(At, 1, 0); MK_STAGE_A(MK_SA(0, 1), a2, 1, vC);
            MK_WAIT_V(8); MK_WAIT_L(0); MK_BAR; MK_MMA(0, 0, At, B0); MK_MMA(0, 1, At, B1); MK_BAR; MK_SCHED;
            MK_LDA(At, 1, 1); MK_STAGE_B(MK_SB(1, 0), b3); MK_STAGE_B(MK_SB(1, 1), b3 + hstepB); MK_STAGE_A(MK_SA(1, 0), a3, 0, vC);
            MK_WAIT_V(8); MK_WAIT_L(0); MK_BAR; MK_MMA(1, 0, At, B0); MK_MMA(1, 1, At, B1); MK_BAR; MK_SCHED;
        }
        if (wr == 0) MK_BAR;
        E(acc, cur, wr, wc, fr, fq);
        if (!has_next) break;
        if (!cur.keep)
#pragma unroll
        for (int a = 0; a < 2; ++a)
#pragma unroll
            for (int b = 0; b < 2; ++b)
#pragma unroll
                for (int m = 0; m < 4; ++m)
#pragma unroll
                    for (int n = 0; n < 2; ++n) acc[a][b][m][n] = (f32x4){0.f, 0.f, 0.f, 0.f};
        cur = nxt; cA = nA; cB = nB; ++ui;
        if (wr == 1) MK_BAR;
    }
    MK_WAIT_V(0);
    MK_BAR;
#undef MK_SA
#undef MK_SB
#undef MK_STAGE2
#undef MK_STAGE_B
#undef MK_STAGE_A
#undef MK_LDA
#undef MK_LDB
#undef MK_MMA
#undef MK_WAIT_V
#undef MK_WAIT_L
#undef MK_BAR
#undef MK_SCHED
}

__device__ __forceinline__ void grid_map(int L, int nM, int nN, int& pm, int& pn) {
    const int nwg = nM * nN, q = nwg / 8, xcd = L % 8, off = L / 8; const int wgid = xcd * q + off;
    const int nig = 8 * nN, gid = wgid / nig, fm = gid * 8, gsz = (nM - fm) < 8 ? (nM - fm) : 8;
    pm = fm + ((wgid % nig) % gsz); pn = (wgid % nig) / gsz;
}

struct EpiStore {
    const float* w2048;
    __device__ __forceinline__ void operator()(f32x4 (&acc)[2][2][4][2], const Unit& u, int wr, int wc, int fr, int fq) const {
        const int col0 = wc * 32 + 8 * fq;
#pragma unroll
        for (int ai = 0; ai < 2; ++ai)
#pragma unroll
            for (int m = 0; m < 4; ++m) {
                const int r = ai * HALF + wr * 64 + m * 16 + fr;
                if (r < u.rows && r >= u.rmin) {
#pragma unroll
                    for (int bj = 0; bj < 2; ++bj) {
                        f32x4 v0 = acc[ai][bj][m][0], v1 = acc[ai][bj][m][1];
                        if (u.mode == 1) { float* p = (float*)u.C + (long)r * u.ldc + col0 + bj * u.bjs; *(f32x4*)p = v0; *(f32x4*)(p + 4) = v1; }
                        else {
                            if (u.mode == 2) {
#pragma unroll
                                for (int c = 0; c < 4; ++c) { v0[c] = __builtin_amdgcn_rcpf(1.0f + __expf(-v0[c])); v1[c] = __builtin_amdgcn_rcpf(1.0f + __expf(-v1[c])); }
                            } else if (u.mode == 3) {
                                const float* wp = w2048 + u.pn + bj * HALF + col0; const float sg = (r & 1) ? -1.0f : 1.0f;
                                v0 += *(const f32x4*)wp * sg; v1 += *(const f32x4*)(wp + 4) * sg;
                            }
                            u32x4 w; w.x = cvt_pk_bf16(v0[0], v0[1]); w.y = cvt_pk_bf16(v0[2], v0[3]); w.z = cvt_pk_bf16(v1[0], v1[1]); w.w = cvt_pk_bf16(v1[2], v1[3]);
                            *(u32x4*)((bf16_t*)u.C + (long)r * u.ldc + col0 + bj * u.bjs) = w;
                        }
                    }
                }
            }
    }
};

struct Args { const float* in[22]; float* out; unsigned char* ws; int ph_lo, ph_hi, use_ut, mod_off, do_attn, bar_idx; };
struct Frame {
    LAS unsigned char* lds; volatile LAS unsigned* MISC; unsigned char* ws;
    int tid, lane, wave, vcu, G;
};

__device__ __forceinline__ void t64_load(f32x4 (&v)[16], const float* W, int ldw, int lane) {
    const unsigned off = (unsigned)(((lane >> 4) * ldw + (lane & 15) * 4) * 4);
#pragma unroll
    for (int j = 0; j < 16; ++j) { const char* bj = (const char*)W + (size_t)(j * 4) * ldw * 4; v[j] = __builtin_nontemporal_load((const GAS f32x4*)(bj + off)); }
}
__device__ __forceinline__ void t64_store(const f32x4 (&v)[16], bf16_t* dst, int ldd, LAS float* scr, int lane) {
    const int kk = lane >> 4, nc = (lane & 15) * 4;
#pragma unroll
    for (int j = 0; j < 16; ++j) {
#pragma unroll
        for (int c = 0; c < 4; ++c) scr[(j * 4 + kk) * 65 + nc + c] = v[j][c]; }
    LDS_WAIT(); asm volatile("" ::: "memory");
    const int kc = lane & 7; const unsigned soff = (unsigned)(((lane >> 3) * ldd + 8 * kc) * 2);
#pragma unroll
    for (int jj = 0; jj < 8; jj += 2) {
        float t[2][8];
#pragma unroll
        for (int q = 0; q < 2; ++q) { const int n = (lane >> 3) + 8 * (jj + q); const LAS float* s = scr + (8 * kc) * 65 + n;
#pragma unroll
            for (int i = 0; i < 8; ++i) t[q][i] = s[i * 65]; }
#pragma unroll
        for (int q = 0; q < 2; ++q) { char* bq = (char*)dst + (size_t)(8 * (jj + q)) * ldd * 2;
            u32x4 o; o.x = cvt_pk_bf16(t[q][0], t[q][1]); o.y = cvt_pk_bf16(t[q][2], t[q][3]); o.z = cvt_pk_bf16(t[q][4], t[q][5]); o.w = cvt_pk_bf16(t[q][6], t[q][7]);
            __builtin_nontemporal_store(o, (GAS u32x4*)(bq + soff)); } }
    LDS_WAIT(); asm volatile("" ::: "memory");
}
__device__ __forceinline__ void transpose64(const float* W, int ldw, bf16_t* dst, int ldd, LAS float* scr, int lane) {
    f32x4 v[16]; t64_load(v, W, ldw, lane); t64_store(v, dst, ldd, scr, lane);
}

constexpr int IT_IN = 32 * 128, IT_FO = 16 * 32, IT_AO = 32 * 32, IT_O = 32 * 32, IT_EG = 64 * 256, IT_EU = 64 * 256, IT_ED = 64 * 256, IT_SH = 256;
constexpr int IT_T_END = IT_IN + IT_FO + IT_AO + IT_O + 3 * IT_SH;
constexpr int IT_MOD = MODC / 32, IT_CST = 4096, IT_BD2 = 512, IT_RWT = 32;
constexpr int IT_ALL = IT_T_END + IT_MOD + IT_CST + IT_BD2 + IT_RWT;

__device__ __forceinline__ void mod_item(const Args& args, unsigned char* ws, int r, int lane) {
            const int kq = lane >> 3, col = r * 32 + (lane & 7) * 4;
            f32x4 a0 = {0.f, 0.f, 0.f, 0.f}, a1 = a0, a2 = a0;
            for (int jb = 0; jb < 256; jb += 8) {
                f32x4 w[8]; float c0[8], c1[8], c2[8];
#pragma unroll
                for (int j = 0; j < 8; ++j) { const int k = kq + 8 * (jb + j); w[j] = *(const GAS f32x4*)(args.in[4] + (size_t)k * MODC + col); c0[j] = args.in[1][k]; c1[j] = args.in[1][DM + k]; c2[j] = args.in[3][k]; }
#pragma unroll
                for (int j = 0; j < 8; ++j) { a0 += w[j] * (c0[j] * __builtin_amdgcn_rcpf(1.0f + __expf(-c0[j]))); a1 += w[j] * (c1[j] * __builtin_amdgcn_rcpf(1.0f + __expf(-c1[j]))); a2 += w[j] * (c2[j] * __builtin_amdgcn_rcpf(1.0f + __expf(-c2[j]))); }
            }
#pragma unroll
            for (int c = 0; c < 4; ++c) {
#pragma unroll
                for (int o = 8; o < 64; o <<= 1) { a0[c] += __shfl_xor(a0[c], o); a1[c] += __shfl_xor(a1[c], o); a2[c] += __shfl_xor(a2[c], o); } }
            if (kq == 0) { const f32x4 bb = *(const GAS f32x4*)(args.in[5] + col); float* MODP = (float*)(ws + WS_MOD);
                *(GAS f32x4*)(MODP + col) = a0 + bb; *(GAS f32x4*)(MODP + MODC + col) = a1 + bb; *(GAS f32x4*)(MODP + 2 * MODC + col) = a2 + bb; }
}
__device__ __forceinline__ void p0_prologue(Frame& F, const Args& args) {
    LAS float* scr = (LAS float*)(F.lds + F.wave * 16640);
    const int gw = F.vcu * NWAVES + F.wave, NGW = F.G * NWAVES, lane = F.lane;
    unsigned char* ws = F.ws;
    bf16_t* WT_IN = (bf16_t*)(ws + WS_WT_IN); bf16_t* WT_FO = (bf16_t*)(ws + WS_WT_FO); bf16_t* WT_AO = (bf16_t*)(ws + WS_WT_AO); bf16_t* WT_O = (bf16_t*)(ws + WS_WT_O);
    bf16_t* WT_GU = (bf16_t*)(ws + WS_WT_GU); bf16_t* WT_D = (bf16_t*)(ws + WS_WT_D);
    if (NGW >= 5 * IT_MOD) { if (gw % 5 == 0 && gw / 5 < IT_MOD) mod_item(args, ws, gw / 5, lane); }
    else for (int m = gw; m < IT_MOD; m += NGW) mod_item(args, ws, m, lane);
    for (int it = gw; it < IT_ALL - IT_MOD; it += NGW) {
        int r = it;
        if (r < IT_IN) { const int kb = r / 128, nb = r % 128; transpose64(args.in[7] + (size_t)(kb * 64) * INC + nb * 64, INC, WT_IN + (size_t)(nb * 64) * DM + kb * 64, DM, scr, lane); continue; } r -= IT_IN;
        if (r < IT_FO) { const int kb = r / 32, nb = r % 32; transpose64(args.in[10] + (size_t)(kb * 64) * DM + nb * 64, DM, WT_FO + (size_t)(nb * 64) * YFP + kb * 64, YFP, scr, lane); continue; } r -= IT_FO;
        if (r < IT_AO) { const int kb = r / 32, nb = r % 32; transpose64(args.in[11] + (size_t)(kb * 64) * DM + nb * 64, DM, WT_AO + (size_t)(nb * 64) * DM + kb * 64, DM, scr, lane); continue; } r -= IT_AO;
        if (r < IT_O) { const int kb = r / 32, nb = r % 32; transpose64(args.in[12] + (size_t)(kb * 64) * DM + nb * 64, DM, WT_O + (size_t)(nb * 64) * DM + kb * 64, DM, scr, lane); continue; } r -= IT_O;
        if (r < 2 * IT_SH) { const int up = r >= IT_SH; if (up) r -= IT_SH; const int kb = r / 8, nb = r % 8, n0 = nb * 64;
            transpose64((up ? args.in[20] : args.in[19]) + (size_t)(kb * 64) * EFF + n0, EFF, WT_GU + ((size_t)64 * 1024 + (n0 >> 7) * 256 + (up ? 128 : 0) + (n0 & 127)) * DM + kb * 64, DM, scr, lane); continue; } r -= 2 * IT_SH;
        if (r < IT_SH) { const int kb = r / 32, nb = r % 32;
            transpose64(args.in[21] + (size_t)(kb * 64) * DM + nb * 64, DM, WT_D + ((size_t)64 * DM + nb * 64) * EFF + kb * 64, EFF, scr, lane); continue; } r -= IT_SH;

        if (r < IT_CST) {
            const int k1 = r & 2047; bf16_t* dst = (bf16_t*)(ws + WS_CST) + (size_t)r * 2048;
#pragma unroll
            for (int j = 0; j < 4; ++j) { const int n0 = j * 512 + lane * 8; float f[8];
#pragma unroll
                for (int i = 0; i < 8; ++i) { const float ph = (float)((k1 * (n0 + i)) & 4095) * (1.0f / 2048.0f); f[i] = r < 2048 ? cospif(ph) : sinpif(ph); }
                u32x4 o; o.x = cvt_pk_bf16(f[0], f[1]); o.y = cvt_pk_bf16(f[2], f[3]); o.z = cvt_pk_bf16(f[4], f[5]); o.w = cvt_pk_bf16(f[6], f[7]);
                *(GAS u32x4*)(dst + n0) = o; }
            continue; } r -= IT_CST;
        if (r < IT_BD2) {
            const int t = r >> 8, o = r & 255, gp = o >> 7, k2 = o & 127; bf16_t* dst = (bf16_t*)(ws + WS_BD2) + (size_t)r * 512; float f[8];
#pragma unroll
            for (int i = 0; i < 8; ++i) { const int j = lane * 8 + i, cg = j >> 8, jj = j & 255, c = jj & 127; const float ph = (float)((32 * c * k2) & 4095) * (1.0f / 2048.0f);
                const float v = jj < 128 ? cospif(ph) : (t ? sinpif(ph) : -sinpif(ph)); f[i] = cg == gp ? v * 0.0013810679320049757f : 0.f; }
            u32x4 w; w.x = cvt_pk_bf16(f[0], f[1]); w.y = cvt_pk_bf16(f[2], f[3]); w.z = cvt_pk_bf16(f[4], f[5]); w.w = cvt_pk_bf16(f[6], f[7]);
            *(GAS u32x4*)(dst + lane * 8) = w;
            continue; } r -= IT_BD2;
        {
            f32x4 v[16]; t64_load(v, args.in[14] + (size_t)(r * 64) * NE, NE, lane);
            const int kk = lane >> 4, nc = (lane & 15) * 4;
#pragma unroll
            for (int j = 0; j < 16; ++j) {
#pragma unroll
                for (int c = 0; c < 4; ++c) scr[(j * 4 + kk) * 65 + nc + c] = v[j][c]; }
            LDS_WAIT(); asm volatile("" ::: "memory");
            const int kc = lane & 7; bf16_t* RWT = (bf16_t*)(ws + WS_RWT);
#pragma unroll
            for (int jj = 0; jj < 8; ++jj) { const int e = (lane >> 3) + 8 * jj; const LAS float* s = scr + (8 * kc) * 65 + e; float t[8], l[8];
#pragma unroll
                for (int i = 0; i < 8; ++i) { t[i] = s[i * 65]; l[i] = t[i] - bf2f(f2bf(t[i])); }
                u32x4 h, lo; h.x = cvt_pk_bf16(t[0], t[1]); h.y = cvt_pk_bf16(t[2], t[3]); h.z = cvt_pk_bf16(t[4], t[5]); h.w = cvt_pk_bf16(t[6], t[7]);
                lo.x = cvt_pk_bf16(l[0], l[1]); lo.y = cvt_pk_bf16(l[2], l[3]); lo.z = cvt_pk_bf16(l[4], l[5]); lo.w = cvt_pk_bf16(l[6], l[7]);
                *(GAS u32x4*)(RWT + (size_t)e * DM + r * 64 + 8 * kc) = h; *(GAS u32x4*)(RWT + (size_t)(NE + e) * DM + r * 64 + 8 * kc) = lo; }
            LDS_WAIT(); asm volatile("" ::: "memory");
        }
    }
}


__device__ __forceinline__ void conv_addr(const Args& args, unsigned char* ws, bool down, int it, const float*& W, int& ldw, bf16_t*& dst, int& ldd) {
    if (!down) { int r = it; const int up = r >= IT_EG; if (up) r -= IT_EG;
        const int e = r / 256, q = r % 256, kb = q / 8, nb = q % 8, n0 = nb * 64;
        W = (up ? args.in[17] : args.in[16]) + (size_t)e * DM * EFF + (size_t)(kb * 64) * EFF + n0; ldw = EFF;
        dst = (bf16_t*)(ws + WS_WT_GU) + ((size_t)e * 1024 + (n0 >> 7) * 256 + (up ? 128 : 0) + (n0 & 127)) * DM + kb * 64; ldd = DM;
    } else { const int r = it, e = r / 256, q = r % 256, kb = q / 32, nb = q % 32;
        W = args.in[18] + (size_t)e * EFF * DM + (size_t)(kb * 64) * DM + nb * 64; ldw = DM;
        dst = (bf16_t*)(ws + WS_WT_D) + ((size_t)e * DM + nb * 64) * EFF + kb * 64; ldd = EFF; }
}
__device__ __forceinline__ void conv_items(Frame& F, const Args& args, bool down, int first, int count) {
    LAS float* scr = (LAS float*)(F.lds + F.wave * 16640);
    const int end = first + count; int it = first + F.wave;
    if (it >= end) return;
    f32x4 va[16], vb[16]; const float* W; int ldw; bf16_t* da; bf16_t* db; int ldd;
    conv_addr(args, F.ws, down, it, W, ldw, da, ldd); t64_load(va, W, ldw, F.lane);
    for (;;) {
        const bool hb = it + NWAVES < end;
        if (hb) { conv_addr(args, F.ws, down, it + NWAVES, W, ldw, db, ldd); t64_load(vb, W, ldw, F.lane); }
        t64_store(va, da, ldd, scr, F.lane);
        if (!hb) break;
        const bool ha = it + 2 * NWAVES < end;
        if (ha) { conv_addr(args, F.ws, down, it + 2 * NWAVES, W, ldw, da, ldd); t64_load(va, W, ldw, F.lane); }
        t64_store(vb, db, ldd, scr, F.lane);
        if (!ha) break;
        it += 2 * NWAVES;
    }
}
struct SchedIn {
    int G, c; unsigned char* ws; int use_ut;
    __device__ __forceinline__ bool next(int i, Unit& u) const {
        const int L = i * G + c; if (L >= 1024) return false;
        const char* H = (const char*)(ws + WS_H); const char* WT = (const char*)(ws + WS_WT_IN);
        u.rows = 256; u.aux = 0; u.bjs = HALF; u.pm = 0; u.pn = 0; u.rmin = 0; u.nt = DM / BK; u.keep = 0;
        if (L < 896) {
            int pm, ct; grid_map(L, 32, 28, pm, ct);
            const int row0 = pm * 256, b = row0 / SEQ, t0 = row0 % SEQ;
            u.A = H + (size_t)row0 * DM * 2; u.B = WT + (size_t)ct * 256 * DM * 2;
            if (ct < 4) {
                if (use_ut) { u.A = WT + (size_t)ct * 256 * DM * 2; u.B = H + (size_t)row0 * DM * 2;
                              u.C = (char*)(ws + WS_UT) + (((size_t)b * FW + ct * 256) * SEQ + t0) * 2; u.ldc = SEQ; u.mode = 0; }
                else { u.C = (char*)(ws + WS_U) + ((size_t)row0 * FW + ct * 256) * 2; u.ldc = FW; u.mode = 0; }
            }
            else if (ct < 14) { u.C = (char*)(ws + WS_QKRAW) + ((size_t)row0 * 2560 + (ct - 4) * 256) * 4; u.ldc = 2560; u.mode = 1; }
            else if (ct < 16) { u.C = (char*)(ws + WS_VALL) + (((size_t)b * SKV + t0) * KVW + (ct - 14) * 256) * 2; u.ldc = KVW; u.mode = 0; }
            else if (ct < 24) { u.C = (char*)(ws + WS_SGF) + ((size_t)row0 * DM + (ct - 16) * 256) * 2; u.ldc = DM; u.mode = 2; }
            else              { u.C = (char*)(ws + WS_SGA) + ((size_t)row0 * DM + (ct - 24) * 256) * 2; u.ldc = DM; u.mode = 2; }
        } else if (L >= 904) {
            int pm, q; grid_map(L - 904, 32, 4, pm, q); const int ct = 28 + q;
            u.A = H + (size_t)pm * 256 * DM * 2; u.B = WT + (size_t)ct * 256 * DM * 2;
            u.C = (char*)(ws + WS_SGA) + ((size_t)pm * 256 * DM + (ct - 24) * 256) * 2; u.ldc = DM; u.mode = 2;
        } else {
            const int l = L - 896, pm = l & 1, ct = l >> 1;
            u.A = H + (size_t)(NTOK + pm * 256) * DM * 2; u.B = WT + (size_t)(K_OFF + ct * 256) * DM * 2;
            if (ct < 2) { u.C = (char*)(ws + WS_KCRAW) + ((size_t)(pm * 256) * KVW + ct * 256) * 4; u.ldc = KVW; u.mode = 1; }
            else        { u.C = (char*)(ws + WS_VALL) + (((size_t)pm * SKV + SEQ) * KVW + (ct - 2) * 256) * 2; u.ldc = KVW; u.mode = 0; }
        }
        return true;
    }
    __device__ __forceinline__ unsigned arow(const Unit&, int) const { return 0u; }
};


__device__ __forceinline__ void unpack8(u32x4 w, float (&f)[8]) {
#pragma unroll
    for (int i = 0; i < 4; ++i) { f[2 * i] = __uint_as_float(w[i] << 16); f[2 * i + 1] = __uint_as_float(w[i] & 0xffff0000u); }
}
struct EpiMerge { const bf16_t* SGF; const bf16_t* SGA; bf16_t* YM;
    __device__ __forceinline__ void operator()(f32x4 (&acc)[2][2][4][2], const Unit& u, int wr, int wc, int fr, int fq) const {
#pragma unroll
        for (int ai = 0; ai < 2; ++ai)
#pragma unroll
            for (int m = 0; m < 4; ++m) { const size_t row = (size_t)u.pm * 256 + ai * HALF + wr * 64 + m * 16 + fr;
#pragma unroll
                for (int bj = 0; bj < 2; ++bj) { const size_t o = row * DM + u.pn * 256 + bj * HALF + wc * 32 + 8 * fq;
                    float ga[8]; unpack8(*(const u32x4*)(SGA + o), ga);
#pragma unroll
                    for (int c = 0; c < 8; ++c) ga[c] = fmaxf(ga[c], 1e-20f);
                    if (u.keep) { float gf[8]; unpack8(*(const u32x4*)(SGF + o), gf);
#pragma unroll
                        for (int c = 0; c < 4; ++c) { acc[ai][bj][m][0][c] *= gf[c] * __builtin_amdgcn_rcpf(ga[c]); acc[ai][bj][m][1][c] *= gf[4 + c] * __builtin_amdgcn_rcpf(ga[4 + c]); }
                    } else { const f32x4 v0 = acc[ai][bj][m][0], v1 = acc[ai][bj][m][1];
                        u32x4 w; w.x = cvt_pk_bf16(ga[0] * v0[0], ga[1] * v0[1]); w.y = cvt_pk_bf16(ga[2] * v0[2], ga[3] * v0[3]); w.z = cvt_pk_bf16(ga[4] * v1[0], ga[5] * v1[1]); w.w = cvt_pk_bf16(ga[6] * v1[2], ga[7] * v1[3]);
                        *(u32x4*)(YM + o) = w; } } }
    } };
struct SchedMerge { int G, c; unsigned char* ws;
    __device__ __forceinline__ bool next(int i, Unit& u) const {
        const int L = (i >> 1) * G + c; if (L >= 256) return false;
        int pm, pn; grid_map(L, 32, 8, pm, pn); const int kb = i & 1;
        u.A = (const char*)(ws + (kb ? WS_YA : WS_YF)) + (size_t)pm * 256 * DM * 2; u.B = (const char*)(ws + (kb ? WS_WT_AO : WS_WT_FO)) + (size_t)pn * 256 * DM * 2;
        u.C = nullptr; u.ldc = DM; u.mode = 0; u.rows = 256; u.aux = 0; u.pm = pm; u.pn = pn; u.bjs = HALF; u.rmin = 0; u.nt = kb ? DM / BK : FW / BK; u.keep = kb ? 0 : 1;
        return true; }
    __device__ __forceinline__ unsigned arow(const Unit&, int) const { return 0u; } };
struct EpiX2 { const float* x; const float* mod; float* X2;
    __device__ __forceinline__ void operator()(f32x4 (&acc)[2][2][4][2], const Unit& u, int wr, int wc, int fr, int fq) const {
        const float* g1 = mod + ((u.pm * 256) / SEQ) * MODC + 2 * DM;
#pragma unroll
        for (int ai = 0; ai < 2; ++ai)
#pragma unroll
            for (int m = 0; m < 4; ++m) { const size_t row = (size_t)u.pm * 256 + ai * HALF + wr * 64 + m * 16 + fr;
#pragma unroll
                for (int bj = 0; bj < 2; ++bj) { const int col = u.pn * 256 + bj * HALF + wc * 32 + 8 * fq; const size_t o = row * DM + col;
#pragma unroll
                    for (int n = 0; n < 2; ++n) { const f32x4 xv = *(const f32x4*)(x + o + 4 * n), gv = *(const f32x4*)(g1 + col + 4 * n); *(f32x4*)(X2 + o + 4 * n) = xv + gv * acc[ai][bj][m][n]; } } }
    } };
struct EpiAct {
    __device__ __forceinline__ void operator()(f32x4 (&acc)[2][2][4][2], const Unit& u, int wr, int wc, int fr, int fq) const {
#pragma unroll
        for (int ai = 0; ai < 2; ++ai)
#pragma unroll
            for (int m = 0; m < 4; ++m) { const int r = ai * HALF + wr * 64 + m * 16 + fr;
                if (r < u.rows) { float a[8];
#pragma unroll
                    for (int n = 0; n < 2; ++n)
#pragma unroll
                        for (int c = 0; c < 4; ++c) { const float g = acc[ai][0][m][n][c], up = acc[ai][1][m][n][c]; a[4 * n + c] = g * __builtin_amdgcn_rcpf(1.0f + __expf(-g)) * up; }
                    u32x4 w; w.x = cvt_pk_bf16(a[0], a[1]); w.y = cvt_pk_bf16(a[2], a[3]); w.z = cvt_pk_bf16(a[4], a[5]); w.w = cvt_pk_bf16(a[6], a[7]);
                    *(u32x4*)((bf16_t*)u.C + (size_t)r * u.ldc + wc * 32 + 8 * fq) = w; } }
    } };

struct SchedGrid {
    int G, c, nM, nN; const char* A; const char* B; char* C; size_t astride, bstride; int ldc, esz, mode, nt;
    __device__ __forceinline__ bool next(int i, Unit& u) const {
        const int L = i * G + c; if (L >= nM * nN) return false;
        int pm, pn; grid_map(L, nM, nN, pm, pn);
        u.A = A + (size_t)pm * astride; u.B = B + (size_t)pn * bstride; u.C = C + ((size_t)pm * 256 * ldc + pn * 256) * esz; u.ldc = ldc; u.mode = mode; u.rows = 256; u.aux = 0; u.pm = pm; u.pn = pn; u.bjs = HALF; u.rmin = 0; u.nt = nt; u.keep = 0;
        return true; }
    __device__ __forceinline__ unsigned arow(const Unit&, int) const { return 0u; } };
struct SchedAG { int G, c; unsigned char* ws;
    __device__ __forceinline__ bool next(int i, Unit& u) const {
        const int L = i * G + c; if (L >= 136) return false;
        u.rows = 256; u.aux = 0; u.rmin = 0; u.nt = DM / BK; u.keep = 0;
        if (L < 128) {
            int pm, pn8; grid_map(L, 16, 8, pm, pn8); const int b = pn8 >> 2, pn = pn8 & 3, sn = pm >> 3, k1t = pm & 7;
            u.A = (const char*)(ws + WS_CST) + (size_t)pm * 256 * 2048 * 2; u.B = (const char*)(ws + (sn ? WS_OT : WS_ET)) + ((size_t)b * FW + pn * 256) * 2048 * 2;
            u.C = (char*)(ws + WS_TT) + (((size_t)b * 2048 + k1t * 256) * DM + pn * 512 + sn * 128) * 2; u.ldc = DM; u.mode = sn ? 0 : 3; u.pm = k1t; u.pn = b * FW + pn * 256; u.bjs = 256;
        } else {
            int pm, q; grid_map(L - 128 + 120, 32, 4, pm, q); const int ct = 28 + q;
            u.A = (const char*)(ws + WS_H) + (size_t)pm * 256 * DM * 2; u.B = (const char*)(ws + WS_WT_IN) + (size_t)ct * 256 * DM * 2;
            u.C = (char*)(ws + WS_SGA) + ((size_t)pm * 256 * DM + (ct - 24) * 256) * 2; u.ldc = DM; u.mode = 2; u.pm = pm; u.pn = ct; u.bjs = HALF;
        }
        return true; }
    __device__ __forceinline__ unsigned arow(const Unit&, int) const { return 0u; } };
struct SchedF2 { int G, c; unsigned char* ws;
    __device__ __forceinline__ bool next(int i, Unit& u) const {
        const int L = i * G + c; if (L >= 128) return false;
        int pm, q; grid_map(L, 16, 8, pm, q); const int b = pm >> 3, k1t = pm & 7, j = q & 3, mir = q >> 2;
        u.A = (const char*)(ws + WS_TT) + (((size_t)b * 2048 + k1t * 256) * DM + j * 512) * 2; u.B = (const char*)(ws + WS_BD2) + (size_t)mir * 256 * 512 * 2;
        u.mode = 0; u.rows = 256; u.aux = 0; u.pm = pm; u.pn = j; u.bjs = HALF; u.nt = 512 / BK; u.keep = 0;
        if (!mir) { u.C = (char*)(ws + WS_YF) + (((size_t)b * SEQ + k1t * 256) * YFP + j * 256) * 2; u.ldc = YFP; u.rmin = 0; }
        else { u.C = (char*)(ws + WS_YF) + (((size_t)b * SEQ + SEQ - k1t * 256) * YFP + j * 256) * 2; u.ldc = -YFP; u.rmin = k1t == 0 ? 1 : 0; }
        return true; }
    __device__ __forceinline__ unsigned arow(const Unit&, int) const { return 0u; } };
constexpr int SCHT_OFF = LDSCTL_OFF + 1024;
__device__ __forceinline__ void moe_tables(Frame& F, int ncol_tiles) {
    LAS int* T = (LAS int*)(F.lds + SCHT_OFF);
    __syncthreads();
    if (F.tid == 0) { const int* CNT = (const int*)(F.ws + CTL_CNT); int up = 0, of = 0;
        for (int e = 0; e <= NE; ++e) { const int cn = e < NE ? CNT[e * 64] : NTOK; T[e] = up; T[80 + e] = e < NE ? of : NSLOT; T[160 + e] = cn; up += ((cn + 255) >> 8) * ncol_tiles; of += cn; }
        T[NE + 1] = up; }
    __syncthreads();
}
template <int NCT, bool FIRST> struct SchedMoe {
    int G, c; unsigned char* ws; LAS int* T; const int* TOK;
    __device__ __forceinline__ bool next(int i, Unit& u) const {
        const int L = i * G + c; if (L >= T[NE + 1]) return false;
        int lo = 0, hi = NE;
#pragma unroll 1
        while (lo < hi) { const int mid = (lo + hi + 1) >> 1; if (T[mid] <= L) lo = mid; else hi = mid - 1; }
        const int e = lo, cn = T[160 + e], ntile = (cn + 255) >> 8, local = L - T[e], ct = local / ntile, mt = local % ntile, slot0 = T[80 + e] + mt * 256;
        u.rows = (cn - mt * 256) < 256 ? (cn - mt * 256) : 256; u.aux = slot0; u.pm = mt; u.pn = ct; u.bjs = HALF; u.mode = 0; u.rmin = 0; u.e = e; u.nt = (FIRST ? DM : EFF) / BK; u.keep = 0;
        if (FIRST) { u.A = (const char*)(ws + WS_H2); u.B = (const char*)(ws + WS_WT_GU) + ((size_t)e * 4 + ct) * 256 * DM * 2; u.C = (char*)(ws + WS_ACT) + ((size_t)slot0 * EFF + ct * 128) * 2; u.ldc = EFF; }
        else { u.A = (const char*)(ws + WS_ACT) + (size_t)slot0 * EFF * 2; u.B = (const char*)(ws + WS_WT_D) + ((size_t)e * DM + ct * 256) * EFF * 2; u.C = (char*)(ws + WS_YBIG) + ((size_t)slot0 * DM + ct * 256) * 2; u.ldc = DM; }
        return true; }
    __device__ __forceinline__ unsigned arow(const Unit& u, int r) const { const int rr = u.pm * 256 + (r < u.rows ? r : u.rows - 1); const int tok = u.e < NE ? TOK[u.e * NTOK + rr] : rr; return (unsigned)tok * (unsigned)(DM * 2); } };

namespace attn {
using s16x4 = __attribute__((ext_vector_type(4))) short;
using f32x8 = __attribute__((ext_vector_type(8))) float;
constexpr int D = 128, NW = 8, QBLK = 32, KVBLK = 64;
constexpr float SCALE = 0.088388347648318440f;
constexpr float THR = 8.f;
constexpr int LDQ = DM, LDK = KVW, LDO = DM;
constexpr size_t SHM_V = KVBLK * D * 2, SHM_K = KVBLK * D * 2, SHM_ATTN = 2 * SHM_V + 2 * SHM_K + NW * 64 * 4;
#define KSWZ(row, colB) ((row) * 256 + ((colB) ^ (((row) & 7) << 4)))
#define SBAR() __builtin_amdgcn_sched_barrier(0)
__device__ __forceinline__ unsigned cvtpk(float lo, float hi) { unsigned r; asm volatile("v_cvt_pk_bf16_f32 %0, %1, %2" : "=v"(r) : "v"(lo), "v"(hi)); return r; }
__device__ __forceinline__ void partialSM(f32x16& p0, f32x16& p1, float& m_reg, float& mn, float& alpha) {
  constexpr float C = SCALE * 1.4426950408889634f;
  float pmax = p0[0]; for (int r = 1; r < 16; ++r) pmax = fmaxf(pmax, p0[r]); for (int r = 0; r < 16; ++r) pmax = fmaxf(pmax, p1[r]);
  { auto rr = __builtin_amdgcn_permlane32_swap(__float_as_uint(pmax), __float_as_uint(pmax), false, false);
    pmax = fmaxf(__uint_as_float(rr[0]), __uint_as_float(rr[1])); }
  if (__builtin_expect(__all(pmax - m_reg <= THR / SCALE), 1)) { mn = m_reg; alpha = 1.f; }
  else { mn = fmaxf(m_reg, pmax); alpha = __builtin_amdgcn_exp2f((m_reg - mn) * C); m_reg = mn; }
  float mnC = -mn * C;
  for (int r = 0; r < 16; ++r) p0[r] = fmaf(p0[r], C, mnC); for (int r = 0; r < 16; ++r) p1[r] = fmaf(p1[r], C, mnC);
  for (int r = 0; r < 16; ++r) p0[r] = __builtin_amdgcn_exp2f(p0[r]);
}
__device__ __forceinline__ void finishSM(f32x16& p0, f32x16& p1, float alpha, float& l_reg, bf16x8& pa0, bf16x8& pa1, bf16x8& pa2, bf16x8& pa3) {
  for (int r = 0; r < 16; ++r) p1[r] = __builtin_amdgcn_exp2f(p1[r]);
  float ps = 0; for (int r = 0; r < 16; ++r) ps += p0[r]; for (int r = 0; r < 16; ++r) ps += p1[r];
  { auto rr = __builtin_amdgcn_permlane32_swap(__float_as_uint(ps), __float_as_uint(ps), false, false);
    ps = __uint_as_float(rr[0]) + __uint_as_float(rr[1]); }
  l_reg = l_reg * alpha + ps;
#define PK4(P, BASE, OUT) do { unsigned a0 = cvtpk(P[BASE + 0], P[BASE + 1]), a1 = cvtpk(P[BASE + 2], P[BASE + 3]);   \
    unsigned b0 = cvtpk(P[BASE + 4], P[BASE + 5]), b1 = cvtpk(P[BASE + 6], P[BASE + 7]);                              \
    auto r0 = __builtin_amdgcn_permlane32_swap(a0, b0, false, false); auto r1 = __builtin_amdgcn_permlane32_swap(a1, b1, false, false); \
    u32x4 w = {r0[0], r1[0], r0[1], r1[1]}; OUT = *reinterpret_cast<bf16x8*>(&w); } while (0)
  PK4(p0, 0, pa0); PK4(p0, 8, pa1); PK4(p1, 0, pa2); PK4(p1, 8, pa3);
#undef PK4
}
__device__ __forceinline__ void qkt(f32x16& p0, f32x16& p1, const bf16_t* Ks, const bf16x8* qr, int r32, int hi) {
  p0 = f32x16{}; p1 = f32x16{};
  for (int d0 = 0; d0 < 8; ++d0) { int cb = (d0 * 16 + hi * 8) * 2;
    bf16x8 b0 = *reinterpret_cast<const bf16x8*>((const char*)Ks + KSWZ(r32, cb));
    bf16x8 b1 = *reinterpret_cast<const bf16x8*>((const char*)Ks + KSWZ(32 + r32, cb));
    p0 = __builtin_amdgcn_mfma_f32_32x32x16_bf16(b0, qr[d0], p0, 0, 0, 0);
    p1 = __builtin_amdgcn_mfma_f32_32x32x16_bf16(b1, qr[d0], p1, 0, 0, 0); }
}
__device__ __forceinline__ int v_st(int k, int c) { const int kk = (k & ~0xC) | ((k & 4) << 1) | ((k & 8) >> 1); return ((kk >> 3) * 4 + (c >> 5)) * 512 + ((kk & 7) * 32 + (c & 31)) * 2; }
__device__ __forceinline__ int v_rd_base(int lane) { return ((lane & 3) << 3) | (((lane >> 2) & 3) << 6) | (((lane >> 4) & 1) << 5) | (((lane >> 5) & 1) << 8); }
constexpr int v_rd_off(int d0, int ks, int half) { return d0 * 512 + ks * 4096 + half * 2048; }
template <int OFF> __device__ __forceinline__ s16x4 tr_read(int vb) {
  s16x4 r; asm volatile("ds_read_b64_tr_b16 %0, %1 offset:%2" : "=&v"(r) : "v"(vb), "i"(OFF) : "memory"); return r;
}
template <int D0> __device__ __forceinline__ void pv_one(f32x16& od, int vb, bf16x8 pa0, bf16x8 pa1, bf16x8 pa2, bf16x8 pa3) {
  const s16x4 l0 = tr_read<v_rd_off(D0, 0, 0)>(vb), h0 = tr_read<v_rd_off(D0, 0, 1)>(vb), l1 = tr_read<v_rd_off(D0, 1, 0)>(vb), h1 = tr_read<v_rd_off(D0, 1, 1)>(vb);
  const s16x4 l2 = tr_read<v_rd_off(D0, 2, 0)>(vb), h2 = tr_read<v_rd_off(D0, 2, 1)>(vb), l3 = tr_read<v_rd_off(D0, 3, 0)>(vb), h3 = tr_read<v_rd_off(D0, 3, 1)>(vb);
  asm volatile("s_waitcnt lgkmcnt(0)" ::: "memory"); SBAR();
#define PK(L, H) (bf16x8){L[0], L[1], L[2], L[3], H[0], H[1], H[2], H[3]}
  od = __builtin_amdgcn_mfma_f32_32x32x16_bf16(pa0, PK(l0, h0), od, 0, 0, 0);
  od = __builtin_amdgcn_mfma_f32_32x32x16_bf16(pa1, PK(l1, h1), od, 0, 0, 0);
  od = __builtin_amdgcn_mfma_f32_32x32x16_bf16(pa2, PK(l2, h2), od, 0, 0, 0);
  od = __builtin_amdgcn_mfma_f32_32x32x16_bf16(pa3, PK(l3, h3), od, 0, 0, 0);
#undef PK
}
__device__ __forceinline__ void pv_d0(f32x16* o, int vb, bf16x8 pa0, bf16x8 pa1, bf16x8 pa2, bf16x8 pa3) {
  pv_one<0>(o[0], vb, pa0, pa1, pa2, pa3); pv_one<1>(o[1], vb, pa0, pa1, pa2, pa3); pv_one<2>(o[2], vb, pa0, pa1, pa2, pa3); pv_one<3>(o[3], vb, pa0, pa1, pa2, pa3);
}
__device__ __forceinline__ void attn_dense_body(const bf16_t* __restrict__ Qb, const bf16_t* __restrict__ Kh, const bf16_t* __restrict__ Vh, bf16_t* __restrict__ Ob, int seq, char* lds) {
  const int tid = threadIdx.x, wid = tid >> 6, lane = tid & 63, r32 = lane & 31, hi = lane >> 5;
  bf16_t* V_lds = (bf16_t*)lds; bf16_t* K_lds = (bf16_t*)(lds + 2 * SHM_V);
  float* ws = (float*)(lds + 2 * SHM_V + 2 * SHM_K) + wid * 64; float* li_l = ws; float* al_l = ws + 32;
  float m_reg = -1e30f, l_reg = 0; f32x16 o[4] = {}; bf16x8 qr[8];
  const bf16_t* Qw = Qb + (long)(wid * QBLK + r32) * LDQ + hi * 8;
#pragma unroll
  for (int d0 = 0; d0 < 8; ++d0) qr[d0] = *reinterpret_cast<const bf16x8*>(Qw + d0 * 16);
  const int sr = tid >> 4, sc = (tid & 15) * 8, vst0 = v_st(sr, sc), vst1 = v_st(32 + sr, sc);
  const int vb0 = (int)(uintptr_t)V_lds + v_rd_base(lane);
  struct { bf16x8 vs0, vs1, ks0, ks1; } sr_[2];
#define SLOAD(i, k0) do { sr_[i].vs0 = *reinterpret_cast<const bf16x8*>(&Vh[(long)((k0) + sr) * LDK + sc]); sr_[i].vs1 = *reinterpret_cast<const bf16x8*>(&Vh[(long)((k0) + 32 + sr) * LDK + sc]); \
    sr_[i].ks0 = *reinterpret_cast<const bf16x8*>(&Kh[(long)((k0) + sr) * LDK + sc]); sr_[i].ks1 = *reinterpret_cast<const bf16x8*>(&Kh[(long)((k0) + 32 + sr) * LDK + sc]); } while (0)
#define SWRITE(b, i) do { *(bf16x8*)((char*)V_lds + (b) * SHM_V + vst0) = sr_[i].vs0;          \
    *(bf16x8*)((char*)V_lds + (b) * SHM_V + vst1) = sr_[i].vs1; int kc = sc * 2;               \
    *(bf16x8*)((char*)K_lds + (b) * SHM_K + KSWZ(sr, kc)) = sr_[i].ks0;                       \
    *(bf16x8*)((char*)K_lds + (b) * SHM_K + KSWZ(32 + sr, kc)) = sr_[i].ks1; } while (0)
#define SWAIT() asm volatile("s_waitcnt vmcnt(4)" ::: "memory")
#define RESC(a) do { if (__any((a) < 1.f)) { if (hi == 0) al_l[r32] = (a); asm volatile("s_waitcnt lgkmcnt(0)" ::: "memory"); \
    for (int d = 0; d < 4; ++d) for (int r = 0; r < 16; ++r) o[d][r] *= al_l[crow(r, hi)]; } } while (0)
  f32x16 pA0, pA1, pB0, pB1; float mnA, mnB, alA, alB; bf16x8 pa0, pa1, pa2, pa3; const int NT = seq / KVBLK;
  constexpr int SE = 0, SO = 1;
  SLOAD(SE, 0); asm volatile("s_waitcnt vmcnt(0)" ::: "memory"); SWRITE(0, SE); __syncthreads();
  qkt(pA0, pA1, K_lds, qr, r32, hi); partialSM(pA0, pA1, m_reg, mnA, alA);
  SLOAD(SO, KVBLK); if (2 < NT) SLOAD(SE, 2 * KVBLK);
  SWAIT(); SWRITE(1, SO); __syncthreads();
  for (int j = 1; j + 1 < NT; j += 2) {
    SBAR(); qkt(pB0, pB1, (bf16_t*)((char*)K_lds + SHM_K), qr, r32, hi);
    finishSM(pA0, pA1, alA, l_reg, pa0, pa1, pa2, pa3); SBAR();
    SLOAD(SO, (j + 2) * KVBLK); SBAR();
    pv_d0(o, vb0, pa0, pa1, pa2, pa3); partialSM(pB0, pB1, m_reg, mnB, alB);
    __syncthreads(); SWAIT(); SWRITE(0, SE);
    RESC(alB); __syncthreads();
    SBAR(); qkt(pA0, pA1, K_lds, qr, r32, hi);
    finishSM(pB0, pB1, alB, l_reg, pa0, pa1, pa2, pa3); SBAR();
    if (j + 3 < NT) SLOAD(SE, (j + 3) * KVBLK); SBAR();
    pv_d0(o, vb0 + (int)SHM_V, pa0, pa1, pa2, pa3); partialSM(pA0, pA1, m_reg, mnA, alA);
    __syncthreads(); SWAIT(); SWRITE(1, SO);
    RESC(alA); __syncthreads();
  }
  SBAR(); qkt(pB0, pB1, (bf16_t*)((char*)K_lds + SHM_K), qr, r32, hi);
  finishSM(pA0, pA1, alA, l_reg, pa0, pa1, pa2, pa3); SBAR();
  pv_d0(o, vb0, pa0, pa1, pa2, pa3); partialSM(pB0, pB1, m_reg, mnB, alB);
  __syncthreads(); RESC(alB);
  finishSM(pB0, pB1, alB, l_reg, pa0, pa1, pa2, pa3); SBAR();
  pv_d0(o, vb0 + (int)SHM_V, pa0, pa1, pa2, pa3);
  if (hi == 0) li_l[r32] = l_reg; asm volatile("s_waitcnt lgkmcnt(0)" ::: "memory");
  float rli[16];
#pragma unroll
  for (int r = 0; r < 16; ++r) rli[r] = __builtin_amdgcn_rcpf(li_l[crow(r, hi)]);
  bf16_t* Ow = Ob + (long)(wid * QBLK) * LDO;
#pragma unroll
  for (int r = 0; r < 16; ++r) { int orow = crow(r, hi);
    for (int d0 = 0; d0 < 4; ++d0) Ow[(long)orow * LDO + d0 * 32 + r32] = f2bf(o[d0][r] * rli[r]); }
#undef SLOAD
#undef SWRITE
#undef SWAIT
#undef RESC
}
#undef KSWZ
#undef SBAR
}

__device__ __forceinline__ void ph_norm1(Frame& F, const Args& args, const float* mod) {
    const int gw = F.vcu * NWAVES + F.wave, NGW = F.G * NWAVES, lane = F.lane;
    bf16_t* H = (bf16_t*)(F.ws + WS_H); const float* nw = args.in[6];
    for (int row = gw; row < NTOK + NCTX; row += NGW) {
        const float* src = row < NTOK ? args.in[0] + (size_t)row * DM : args.in[2] + (size_t)(row - NTOK) * DM;
        const float* mr = mod + (row < NTOK ? row / SEQ : 2) * MODC;
        f32x4 v[8]; float ss = 0.f;
#pragma unroll
        for (int j = 0; j < 8; ++j) { v[j] = *(const GAS f32x4*)(src + (j * 64 + lane) * 4); ss += v[j].x * v[j].x + v[j].y * v[j].y + v[j].z * v[j].z + v[j].w * v[j].w; }
        ss = wave_sum(ss);
        const float rstd = 1.0f / sqrtf(ss * (1.0f / DM) + 1e-6f);
#pragma unroll
        for (int j = 0; j < 8; ++j) { const int i = (j * 64 + lane) * 4;
            const f32x4 w = *(const GAS f32x4*)(nw + i), sc = *(const GAS f32x4*)(mr + DM + i), sh = *(const GAS f32x4*)(mr + i);
            const f32x4 h = v[j] * rstd * w * (sc + 1.0f) + sh;
            unsigned lo = cvt_pk_bf16(h[0], h[1]), hi = cvt_pk_bf16(h[2], h[3]);
            *(GAS unsigned long long*)(H + (size_t)row * DM + i) = (unsigned long long)lo | ((unsigned long long)hi << 32); }
    }
}
__device__ __forceinline__ void ph_qknorm(Frame& F, const Args& args) {
    const int gw = F.vcu * NWAVES + F.wave, NGW = F.G * NWAVES, lane = F.lane;
    const float* QKRAW = (const float*)(F.ws + WS_QKRAW); const float* KCRAW = (const float*)(F.ws + WS_KCRAW);
    bf16_t* Q = (bf16_t*)(F.ws + WS_Q); bf16_t* KALL = (bf16_t*)(F.ws + WS_KALL);
    const int axis = lane >> 5, f = lane & 31, da = axis * 64 + f, db = da + 32;
    const float qwa = args.in[8][da], qwb = args.in[8][db], kwa = args.in[9][da], kwb = args.in[9][db];
    const float inv = exp2f(-(float)f * (13.287712379549449f / 32.0f));
    for (int row = gw; row < NTOK + NCTX; row += NGW) {
        if (row < NTOK) {
            const int b = row / SEQ, t = row % SEQ;
            const float pos = (float)(axis == 0 ? t / 64 : t % 64), ang = pos * inv, cs = cosf(ang), sn = sinf(ang);
            const float* src = QKRAW + (size_t)row * 2560;
#pragma unroll
            for (int hb = 0; hb < 20; hb += 5) {
                float xa[5], xb[5];
#pragma unroll
                for (int q = 0; q < 5; ++q) { xa[q] = src[(hb + q) * HD + da]; xb[q] = src[(hb + q) * HD + db]; }
#pragma unroll
                for (int q = 0; q < 5; ++q) { const int hh = hb + q;
                    const float ss = wave_sum(xa[q] * xa[q] + xb[q] * xb[q]), rstd = 1.0f / sqrtf(ss * (1.0f / HD) + 1e-6f);
                    const float a = xa[q] * rstd * (hh < 16 ? qwa : kwa), bb = xb[q] * rstd * (hh < 16 ? qwb : kwb);
                    bf16_t* dst = hh < 16 ? Q + (size_t)row * DM + hh * HD : KALL + ((size_t)b * SKV + t) * KVW + (hh - 16) * HD;
                    dst[da] = f2bf(a * cs - bb * sn); dst[db] = f2bf(bb * cs + a * sn); }
            }
        } else {
            const int r = row - NTOK, b = r / CTXL, j = r % CTXL; const float* src = KCRAW + (size_t)r * KVW;
#pragma unroll
            for (int hh = 0; hh < 4; ++hh) { const float xa = src[hh * HD + da], xb = src[hh * HD + db];
                const float ss = wave_sum(xa * xa + xb * xb), rstd = 1.0f / sqrtf(ss * (1.0f / HD) + 1e-6f);
                bf16_t* dst = KALL + ((size_t)b * SKV + SEQ + j) * KVW + hh * HD; dst[da] = f2bf(xa * rstd * kwa); dst[db] = f2bf(xb * rstd * kwb); }
        }
    }
}
__device__ __forceinline__ void ph_evenodd(Frame& F, const Args& args) {
    const int gw = F.vcu * NWAVES + F.wave, NGW = F.G * NWAVES, lane = F.lane;
    LAS bf16_t* scr = (LAS bf16_t*)(F.lds + F.wave * 16640);
    const bf16_t* UT = (const bf16_t*)(F.ws + WS_UT); bf16_t* ET = (bf16_t*)(F.ws + WS_ET); bf16_t* OT = (bf16_t*)(F.ws + WS_OT);
    float* W2 = (float*)(F.ws + WS_W2048); float* AL = (float*)(F.ws + WS_ALT);
    for (int row = gw; row < 2 * FW; row += NGW) {
        const bf16_t* src = UT + (size_t)row * SEQ; float alt = 0.f;
#pragma unroll
        for (int j = 0; j < 8; ++j) { const u32x4 w = *(const GAS u32x4*)(src + (j * 64 + lane) * 8); *(LAS u32x4*)(scr + (j * 64 + lane) * 8) = w;
            float f[8]; unpack8(w, f); alt += (f[0] - f[1]) + (f[2] - f[3]) + (f[4] - f[5]) + (f[6] - f[7]); }
        alt = wave_sum(alt);
        LDS_WAIT(); asm volatile("" ::: "memory");
        if (lane == 0) { AL[row] = alt; W2[row] = bf2f(scr[SEQ / 2]); }
#pragma unroll
        for (int j = 0; j < 4; ++j) { const int n0 = (j * 64 + lane) * 8; float e[8], o[8];
#pragma unroll
            for (int i = 0; i < 8; ++i) { const int n = n0 + i; const float a = bf2f(scr[n]), bb = bf2f(scr[(SEQ - n) & (SEQ - 1)]); e[i] = n == 0 ? a : a + bb; o[i] = n == 0 ? 0.f : a - bb; }
            u32x4 we, wo; we.x = cvt_pk_bf16(e[0], e[1]); we.y = cvt_pk_bf16(e[2], e[3]); we.z = cvt_pk_bf16(e[4], e[5]); we.w = cvt_pk_bf16(e[6], e[7]);
            wo.x = cvt_pk_bf16(o[0], o[1]); wo.y = cvt_pk_bf16(o[2], o[3]); wo.z = cvt_pk_bf16(o[4], o[5]); wo.w = cvt_pk_bf16(o[6], o[7]);
            *(GAS u32x4*)(ET + (size_t)row * 2048 + n0) = we; *(GAS u32x4*)(OT + (size_t)row * 2048 + n0) = wo; }
        LDS_WAIT(); asm volatile("" ::: "memory");
    }
}
__device__ __forceinline__ void ph_route(Frame& F, const Args& args, const float* mod) {
    const int lane = F.lane, wv = F.wave, r32 = lane & 31, hi = lane >> 5;
    LAS float* rs = (LAS float*)F.lds;
    LAS float* part = (LAS float*)(F.lds + 1024);
    LAS int* lcnt = (LAS int*)(F.lds + 1024 + 65536);
    LAS int* lbase = lcnt + 64;
    LAS int* lent = lcnt + 128;
    const float* X2 = (const float*)(F.ws + WS_X2); const float* nw = args.in[13]; const float* rb = args.in[15];
    const bf16_t* RWT = (const bf16_t*)(F.ws + WS_RWT);
    bf16_t* H2 = (bf16_t*)(F.ws + WS_H2); int* EIDX = (int*)(F.ws + WS_EIDX); float* EW = (float*)(F.ws + WS_EW); int* EPOS = (int*)(F.ws + WS_EPOS); int* CNT = (int*)(F.ws + CTL_CNT); int* TOKE = (int*)(F.ws + WS_TOKE);
    if (F.tid < NE) lcnt[F.tid] = 0;
    __syncthreads();
    int nb = 0;
    for (int blk = F.vcu; blk < NTOK / 32; blk += F.G, ++nb) {
        const int row0 = blk * 32; const float* mr = mod + (row0 / SEQ) * MODC;
#pragma unroll
        for (int i = 0; i < 4; ++i) { const float* src = X2 + (size_t)(row0 + wv * 4 + i) * DM; float ss = 0.f;
#pragma unroll
            for (int j = 0; j < 8; ++j) { const f32x4 v = *(const GAS f32x4*)(src + (j * 64 + lane) * 4); ss += v.x * v.x + v.y * v.y + v.z * v.z + v.w * v.w; }
            ss = wave_sum(ss);
            if (lane == 0) rs[wv * 4 + i] = 1.0f / sqrtf(ss * (1.0f / DM) + 1e-6f); }
        __syncthreads();
        { const float rstd = rs[r32]; const float* xr = X2 + (size_t)(row0 + r32) * DM; bf16_t* hr = H2 + (size_t)(row0 + r32) * DM;
          f32x16 acc0 = {}, acc1 = {};
#pragma unroll 4
          for (int ks = 0; ks < 16; ++ks) { const int k = wv * 256 + ks * 16 + hi * 8;
              float h[8];
#pragma unroll
              for (int q = 0; q < 2; ++q) { const f32x4 x = *(const GAS f32x4*)(xr + k + 4 * q), w = *(const GAS f32x4*)(nw + k + 4 * q), sc = *(const GAS f32x4*)(mr + 4 * DM + k + 4 * q), sh = *(const GAS f32x4*)(mr + 3 * DM + k + 4 * q);
                  const f32x4 t = x * rstd * w * (sc + 1.0f) + sh; h[4 * q] = t[0]; h[4 * q + 1] = t[1]; h[4 * q + 2] = t[2]; h[4 * q + 3] = t[3]; }
              u32x4 wh, wl; float l[8];
              wh.x = cvt_pk_bf16(h[0], h[1]); wh.y = cvt_pk_bf16(h[2], h[3]); wh.z = cvt_pk_bf16(h[4], h[5]); wh.w = cvt_pk_bf16(h[6], h[7]);
#pragma unroll
              for (int i = 0; i < 4; ++i) { l[2 * i] = h[2 * i] - __uint_as_float(wh[i] << 16); l[2 * i + 1] = h[2 * i + 1] - __uint_as_float(wh[i] & 0xffff0000u); }
              wl.x = cvt_pk_bf16(l[0], l[1]); wl.y = cvt_pk_bf16(l[2], l[3]); wl.z = cvt_pk_bf16(l[4], l[5]); wl.w = cvt_pk_bf16(l[6], l[7]);
              *(GAS u32x4*)(hr + k) = wh;
              const bf16x8 ah = __builtin_bit_cast(bf16x8, wh), al = __builtin_bit_cast(bf16x8, wl);
              const bf16x8 bh0 = *(const GAS bf16x8*)(RWT + (size_t)r32 * DM + k), bh1 = *(const GAS bf16x8*)(RWT + (size_t)(32 + r32) * DM + k);
              const bf16x8 bl0 = *(const GAS bf16x8*)(RWT + (size_t)(NE + r32) * DM + k), bl1 = *(const GAS bf16x8*)(RWT + (size_t)(NE + 32 + r32) * DM + k);
              acc0 = __builtin_amdgcn_mfma_f32_32x32x16_bf16(ah, bh0, acc0, 0, 0, 0); acc0 = __builtin_amdgcn_mfma_f32_32x32x16_bf16(ah, bl0, acc0, 0, 0, 0); acc0 = __builtin_amdgcn_mfma_f32_32x32x16_bf16(al, bh0, acc0, 0, 0, 0);
              acc1 = __builtin_amdgcn_mfma_f32_32x32x16_bf16(ah, bh1, acc1, 0, 0, 0); acc1 = __builtin_amdgcn_mfma_f32_32x32x16_bf16(ah, bl1, acc1, 0, 0, 0); acc1 = __builtin_amdgcn_mfma_f32_32x32x16_bf16(al, bh1, acc1, 0, 0, 0); }
#pragma unroll
          for (int r = 0; r < 16; ++r) { part[(wv * 32 + crow(r, hi)) * 64 + r32] = acc0[r]; part[(wv * 32 + crow(r, hi)) * 64 + 32 + r32] = acc1[r]; } }
        __syncthreads();
        for (int i = 0; i < 4; ++i) { const int rbk = wv * 4 + i, row = row0 + rbk; float logit = 0.f;
#pragma unroll
          for (int w = 0; w < 8; ++w) logit += part[(w * 32 + rbk) * 64 + lane];
          const float score = 1.0f / (1.0f + expf(-logit)), bsd = score + rb[lane];
          const int g = lane >> 3;
          int rk = 0;
#pragma unroll
          for (int q = 0; q < 8; ++q) { const int o = (lane & ~7) + q; const float vv = __shfl(bsd, o); rk += (vv > bsd) || (vv == bsd && o < lane); }
          float gs = rk < 2 ? bsd : 0.f;
          gs += __shfl_xor(gs, 1); gs += __shfl_xor(gs, 2); gs += __shfl_xor(gs, 4);
          int grk = 0;
#pragma unroll
          for (int gg = 0; gg < 8; ++gg) { const float vv = __shfl(gs, gg * 8); grk += (vv > gs) || (vv == gs && gg < g); }
          const bool gsel = grk < 4;
          const float mb = gsel ? bsd : -INFINITY;
          int erk = 0;
          for (int o = 0; o < 64; ++o) { const float vv = __shfl(mb, o); erk += (vv > mb) || (vv == mb && o < lane); }
          const bool sel = gsel && erk < TOPK;
          const float ssum = wave_sum(sel ? score : 0.f);
          if (sel) { const int lp = __hip_atomic_fetch_add(lcnt + lane, 1, __ATOMIC_RELAXED, __HIP_MEMORY_SCOPE_WORKGROUP);
                     EIDX[row * TOPK + erk] = lane; EW[row * TOPK + erk] = score / ssum * 2.5f; lent[(nb * 32 + rbk) * TOPK + erk] = (lane << 16) | lp; } }
        __syncthreads();
    }
    if (F.tid < NE) { const int c = lcnt[F.tid]; lbase[F.tid] = c ? atomicAdd(&CNT[F.tid * 64], c) : 0; }
    __syncthreads();
    for (int i = F.tid; i < nb * 256; i += NTHREADS) { const int blk = F.vcu + (i >> 8) * F.G, row = blk * 32 + ((i >> 3) & 31), v = lent[i]; const int pos = lbase[v >> 16] + (v & 0xffff); EPOS[row * TOPK + (i & 7)] = pos; TOKE[(v >> 16) * NTOK + pos] = row; }
    __syncthreads();
}
__device__ __forceinline__ void ph_comb(Frame& F, const Args& args, const float* mod) {
    const int gw = F.vcu * NWAVES + F.wave, NGW = F.G * NWAVES, lane = F.lane;
    moe_tables(F, 4);
    LAS int* T = (LAS int*)(F.lds + SCHT_OFF);
    const float* EW = (const float*)(F.ws + WS_EW); const int* EIDX = (const int*)(F.ws + WS_EIDX); const int* EPOS = (const int*)(F.ws + WS_EPOS); const bf16_t* Y = (const bf16_t*)(F.ws + WS_YBIG);
    for (int t = gw; t < NTOK; t += NGW) {
        const float* g2 = mod + (t / SEQ) * MODC + 5 * DM;
        int sl[TOPK]; float wk[TOPK];
#pragma unroll
        for (int k = 0; k < TOPK; ++k) { sl[k] = T[80 + EIDX[t * TOPK + k]] + EPOS[t * TOPK + k]; wk[k] = EW[t * TOPK + k]; }
#pragma unroll
        for (int j = 0; j < 4; ++j) { const int col = j * 512 + lane * 8;
            float a[8]; unpack8(*(const GAS u32x4*)(Y + (size_t)(NSLOT + t) * DM + col), a);
#pragma unroll
            for (int k = 0; k < TOPK; ++k) { float y[8]; unpack8(*(const GAS u32x4*)(Y + (size_t)sl[k] * DM + col), y);
#pragma unroll
                for (int c = 0; c < 8; ++c) a[c] += wk[k] * y[c]; }
            float* o = args.out + (size_t)t * DM + col; const float* xi = (const float*)(F.ws + WS_X2) + (size_t)t * DM + col;
#pragma unroll
            for (int n = 0; n < 2; ++n) { const f32x4 xv = *(const GAS f32x4*)(xi + 4 * n), gv = *(const GAS f32x4*)(g2 + col + 4 * n);
                *(GAS f32x4*)(o + 4 * n) = xv + gv * (f32x4){a[4 * n], a[4 * n + 1], a[4 * n + 2], a[4 * n + 3]}; } }
    }
}

enum { PH_PRO = 0, PH_NORM1, PH_INPROJ, PH_QKNORM, PH_ATTN, PH_F2, PH_MERGE, PH_OUT, PH_ROUTE, PH_EXP1, PH_EXP2, PH_COMB, PH_END };


__global__ void __launch_bounds__(NTHREADS, 2) fwd(Args args) {
    extern __shared__ __attribute__((aligned(16))) unsigned char lds_raw[];
    Frame F;
    F.lds = (LAS unsigned char*)lds_raw; F.MISC = (volatile LAS unsigned*)(F.lds + MISC_OFF); F.ws = args.ws;
    F.tid = threadIdx.x; F.lane = F.tid & 63; F.wave = __builtin_amdgcn_readfirstlane(F.tid >> 6);
    F.G = gridDim.x; { const int bx = blockIdx.x; F.vcu = (F.G % 8 == 0) ? (bx % 8) * (F.G / 8) + bx / 8 : bx; }
    for (int u = F.tid; u < (LDS_BYTES - LDSCTL_OFF) / 4; u += NTHREADS) ((LAS unsigned*)(F.lds + LDSCTL_OFF))[u] = 0u;
    __syncthreads();
    const int lo = args.ph_lo, hi = args.ph_hi;
    const bool multi = (hi - lo) > 1;
    unsigned* barw = (unsigned*)(args.ws + CTL_BAR) + args.bar_idx * XCD_BAR_WORDS;
    XcdBarrier bar; bar.bar = barw; bar.x = 0; bar.st = nullptr;
    if (multi) bar = xcd_barrier_post(barw, F.MISC + 8);
#define IN(k) (lo <= (k) && (k) < hi)
#define SEAM(k) do { if (IN((k) + 1)) xcd_barrier(bar); } while (0)

    const float* modp = (const float*)(args.ws + args.mod_off);
    if (IN(PH_PRO)) { p0_prologue(F, args); SEAM(PH_PRO); }
    if (IN(PH_NORM1)) { ph_norm1(F, args, modp); SEAM(PH_NORM1); }
    if (IN(PH_INPROJ)) {
        SchedIn S{F.G, (int)blockIdx.x, args.ws, args.use_ut};
        gemm_phase<EpiStore, SchedIn, false>(F.lds, DM, DM, DM, S, EpiStore{(const float*)(args.ws + WS_W2048)});
        SEAM(PH_INPROJ);
    }
    if (IN(PH_QKNORM)) { ph_qknorm(F, args); ph_evenodd(F, args); SEAM(PH_QKNORM); }
    if (IN(PH_ATTN)) {
        const int cs = F.vcu & 3;
        constexpr int NCONV = IT_EG + IT_EU + IT_ED;
        int qfirst, qcnt; { const int c = (int)blockIdx.x; if (F.G == 256) { qfirst = c < 136 ? c * 162 : 136 * 162 + (c - 136) * 226; qcnt = c < 136 ? 162 : 226; }
                             else { const int per = (NCONV + F.G - 1) / F.G; qfirst = c * per; qcnt = qfirst + per <= NCONV ? per : (NCONV - qfirst > 0 ? NCONV - qfirst : 0); } }
        const int gcnt = qfirst < IT_EG + IT_EU ? (qfirst + qcnt <= IT_EG + IT_EU ? qcnt : IT_EG + IT_EU - qfirst) : 0, gfirst = qfirst;
        const int ccnt = qcnt - gcnt, cfirst = qfirst + gcnt - (IT_EG + IT_EU);
#define CONV_ALL() do { conv_items(F, args, false, gfirst, gcnt); conv_items(F, args, true, cfirst, ccnt); } while (0)
        const bf16_t* Qp = (const bf16_t*)(args.ws + WS_Q); const bf16_t* Kp = (const bf16_t*)(args.ws + WS_KALL); const bf16_t* Vp = (const bf16_t*)(args.ws + WS_VALL); bf16_t* Op = (bf16_t*)(args.ws + WS_YA);
#define ATTN_UNIT(lin_) do { const int lin = (lin_); if (lin < 512) { const int x = (lin >> 5) & 7, j = (lin & 31) + 32 * (lin >> 8), b = x >> 2, kvh = x & 3, head = kvh * 4 + (j >> 4), qb = j & 15; \
            const size_t qo = ((size_t)(b * SEQ + qb * 256)) * DM + head * HD, ko = (size_t)b * SKV * KVW + kvh * HD; \
            attn::attn_dense_body(Qp + qo, Kp + ko, Vp + ko, Op + qo, SKV, (char*)lds_raw); __syncthreads(); } } while (0)
        if (cs == 0) { CONV_ALL(); __syncthreads(); }
        ATTN_UNIT(F.vcu);
        if (cs == 1) { CONV_ALL(); __syncthreads(); }
        ATTN_UNIT(F.vcu + F.G);
        for (int lin2 = F.vcu + 2 * F.G; lin2 < 512; lin2 += F.G) ATTN_UNIT(lin2);
        if (cs == 2) { CONV_ALL(); __syncthreads(); }
#undef ATTN_UNIT
        SchedAG S{F.G, (int)blockIdx.x, args.ws};
        gemm_phase<EpiStore, SchedAG, false>(F.lds, DM, DM, DM, S, EpiStore{(const float*)(args.ws + WS_W2048)});
        if (cs == 3) { __syncthreads(); CONV_ALL(); }
#undef CONV_ALL
        SEAM(PH_ATTN);
    }
    if (IN(PH_F2)) {
        SchedF2 S{F.G, (int)blockIdx.x, args.ws};
        gemm_phase<EpiStore, SchedF2, false>(F.lds, 512, DM, 512, S, EpiStore{(const float*)(args.ws + WS_W2048)});
        {
            const int idx = F.vcu * NTHREADS + F.tid;
            if (idx < 2 * FW) { const int b = idx >> 10, col = idx & 1023, k2 = col & 127; const float* al = (const float*)(args.ws + WS_ALT) + b * FW + (col & ~127); float s = 0.f;
                for (int c = 0; c < 128; ++c) s += al[c] * cospif((float)((c * k2) & 127) * (1.0f / 64.0f));
                ((bf16_t*)(args.ws + WS_YF))[((size_t)b * SEQ + SEQ / 2) * YFP + col] = f2bf(s * 0.0013810679320049757f); }
        }
        SEAM(PH_F2);
    }
    if (IN(PH_MERGE)) {
        unsigned char* ws = args.ws;
        SchedMerge S{F.G, (int)blockIdx.x, ws};
        gemm_phase<EpiMerge, SchedMerge, false>(F.lds, DM, DM, DM, S, EpiMerge{(const bf16_t*)(ws + WS_SGF), (const bf16_t*)(ws + WS_SGA), (bf16_t*)(ws + WS_YM)});
        SEAM(PH_MERGE);
    }
    if (IN(PH_OUT)) {
        unsigned char* ws = args.ws;
        SchedGrid S{F.G, (int)blockIdx.x, 32, 8, (const char*)(ws + WS_YM), (const char*)(ws + WS_WT_O), nullptr, (size_t)256 * DM * 2, (size_t)256 * DM * 2, DM, 4, 1, DM / BK};
        gemm_phase<EpiX2, SchedGrid, false>(F.lds, DM, DM, DM, S, EpiX2{args.in[0], modp, (float*)(ws + WS_X2)});
        SEAM(PH_OUT);
    }
    if (IN(PH_ROUTE)) { ph_route(F, args, modp); SEAM(PH_ROUTE); }
    if (IN(PH_EXP1)) {
        moe_tables(F, 4);
        SchedMoe<4, true> S{F.G, F.vcu, args.ws, (LAS int*)(F.lds + SCHT_OFF), (const int*)(args.ws + WS_TOKE)};
        gemm_phase<EpiAct, SchedMoe<4, true>, true>(F.lds, DM, DM, DM, S, EpiAct{});
        SEAM(PH_EXP1);
    }
    if (IN(PH_EXP2)) {
        moe_tables(F, 8);
        SchedMoe<8, false> S{F.G, F.vcu, args.ws, (LAS int*)(F.lds + SCHT_OFF), (const int*)(args.ws + WS_TOKE)};
        gemm_phase<EpiStore, SchedMoe<8, false>, false>(F.lds, EFF, EFF, EFF, S, EpiStore{(const float*)(args.ws + WS_W2048)});
        SEAM(PH_EXP2);
    }
    if (IN(PH_COMB)) { ph_comb(F, args, modp); }
#undef IN
#undef SEAM
}
}

extern "C" void kernel_launch(void* const* d_in, const int* in_sizes, int n_in, void* d_out, int out_size, void* d_ws, size_t ws_size, hipStream_t stream) {
    if (n_in != 22 || ws_size < WS_END2) return;
    float* out = (float*)d_out;
    unsigned char* ws = (unsigned char*)d_ws;
    hipMemsetAsync(ws + WS_CTL, 0, CTL_ZERO_BYTES, stream);
    static int grid = 0;
    if (!grid) {
        int dev = 0, cus = 0;
        if (hipGetDevice(&dev) != hipSuccess || hipDeviceGetAttribute(&cus, hipDeviceAttributeMultiprocessorCount, dev) != hipSuccess) { grid = -1; return; }
        if (hipFuncSetAttribute((const void*)mk::fwd, hipFuncAttributeMaxDynamicSharedMemorySize, mk::LDS_BYTES) != hipSuccess) { grid = -1; return; }
        grid = cus;
    }
    if (grid < 0) return;
    mk::Args a{}; int nlaunch = 0;
    for (int i = 0; i < 22; ++i) a.in[i] = (const float*)d_in[i];
    a.out = out; a.ws = ws; a.use_ut = 1; a.mod_off = (int)WS_MOD; a.do_attn = 1;
#define MK_LAUNCH(lo_, hi_) do { a.ph_lo = (lo_); a.ph_hi = (hi_); a.bar_idx = nlaunch++; hipLaunchKernelGGL(mk::fwd, dim3(grid), dim3(mk::NTHREADS), mk::LDS_BYTES, stream, a); } while (0)
    MK_LAUNCH(mk::PH_PRO, mk::PH_END);
}
```

```cpp
#include <hip/hip_runtime.h>
#include <stdint.h>
#include <math.h>

typedef unsigned short bf16_t;
typedef short bf16x8 __attribute__((ext_vector_type(8)));
typedef float f32x16 __attribute__((ext_vector_type(16)));
typedef float f32x4 __attribute__((ext_vector_type(4)));

constexpr int NB = 2, SEQ = 4096, DM = 2048, NTOK = NB * SEQ, CTXL = 256, NCTX = NB * CTXL, HD = 128, NH = 16, NKV = 4;
constexpr int SKV = SEQ + CTXL;
constexpr int FW = 1024, INC = 8192, Q_OFF = 1024, K_OFF = 3072, V_OFF = 3584, GF_OFF = 4096, GA_OFF = 6144;
constexpr int KVW = NKV * HD;
constexpr int NE = 64, TOPK = 8, EFF = 512, MODC = 6 * DM;
constexpr int NSLOT = NTOK * TOPK;
constexpr int NSLOT_ALL = NSLOT + NTOK;

constexpr size_t MiB = 1u << 20;
constexpr size_t WS_CTL = 0, CTL_ZERO_BYTES = 1 * MiB;
constexpr size_t CTL_CNT = 64 * 1024;
constexpr size_t WS_TW = 1 * MiB;
constexpr size_t WS_MOD = 1 * MiB + 64 * 1024;
constexpr size_t WS_OFFS = 1 * MiB + 256 * 1024;
constexpr size_t WS_EIDX = 2 * MiB;
constexpr size_t WS_EW = WS_EIDX + 256 * 1024;
constexpr size_t WS_EPOS = WS_EW + 256 * 1024;
constexpr size_t WS_SLOTOF = WS_EPOS + 256 * 1024;
constexpr size_t WS_TOKE = 300 * MiB;
constexpr size_t WS_H = 4 * MiB;
constexpr size_t WS_U = 38 * MiB;
constexpr size_t WS_Q = 54 * MiB;
constexpr size_t WS_KALL = 86 * MiB;
constexpr size_t WS_VALL = 95 * MiB;
constexpr size_t WS_SGF = 104 * MiB;
constexpr size_t WS_SGA = 136 * MiB;
constexpr size_t WS_YA = 168 * MiB;
constexpr size_t WS_YF = 38 * MiB;
constexpr int YFP = 2048;
constexpr size_t WS_PR = 216 * MiB;
constexpr size_t WS_T1 = 248 * MiB;
constexpr size_t WS_YM = 312 * MiB;
constexpr size_t WS_QKRAW = 248 * MiB;
constexpr size_t WS_KCRAW = 330 * MiB;
constexpr size_t WS_H2 = 344 * MiB;
constexpr size_t WS_ACT = 376 * MiB;
constexpr size_t WS_YBIG = 4 * MiB;
constexpr size_t WS_END = 740 * MiB;

__device__ __forceinline__ float bf2f(bf16_t h) { return __uint_as_float(((unsigned)h) << 16); }
__device__ __forceinline__ bf16_t f2bf(float f) { unsigned u = __float_as_uint(f); return (bf16_t)((u + 0x7fffu + ((u >> 16) & 1u)) >> 16); }
__device__ __forceinline__ int crow(int r, int hi) { return (r & 3) + 8 * (r >> 2) + 4 * hi; }
__device__ __forceinline__ float wave_sum(float v) {
#pragma unroll
    for (int o = 1; o < 64; o <<= 1) v += __shfl_xor(v, o);
    return v;
}
__device__ __forceinline__ float sigmoidf_(float v) { return 1.0f / (1.0f + expf(-v)); }
__device__ __forceinline__ bf16x8 pack8(const float* f) {
    bf16x8 r;
#pragma unroll
    for (int i = 0; i < 8; ++i) r[i] = (short)f2bf(f[i]);
    return r;
}

#define LAS __attribute__((address_space(3)))
#define GAS __attribute__((address_space(1)))
typedef unsigned u32x4 __attribute__((ext_vector_type(4)));
typedef GAS unsigned gu32;
#define RLX_AGENT __ATOMIC_RELAXED, __HIP_MEMORY_SCOPE_AGENT
#define LDS_WAIT() asm volatile("s_waitcnt lgkmcnt(0)" ::: "memory")
#define VM_WAIT() asm volatile("s_waitcnt vmcnt(0)" ::: "memory")

constexpr size_t CTL_BAR = 16384;
constexpr size_t CTL_MODZ = 512 * 1024;
constexpr size_t WS_UT = 38 * MiB;
constexpr size_t WS_TT = 216 * MiB;
constexpr size_t WS_WT_GU = 450 * MiB;
constexpr size_t WS_WT_D = 710 * MiB;
constexpr size_t WS_WT_IN = 840 * MiB;
constexpr size_t WS_WT_FO = 924 * MiB;
constexpr size_t WS_WT_AO = 876 * MiB;
constexpr size_t WS_WT_O = 884 * MiB;
constexpr size_t WS_CST = 892 * MiB;
constexpr size_t WS_ET = 908 * MiB;
constexpr size_t WS_OT = 916 * MiB;
constexpr size_t WS_W2048 = 1 * MiB + 512 * 1024;
constexpr size_t WS_ALT = 1 * MiB + 520 * 1024;
constexpr size_t WS_ROPE = 1 * MiB + 528 * 1024;
constexpr size_t WS_RWT = 3 * MiB + 512 * 1024;
constexpr size_t WS_BD2 = 956 * MiB;
constexpr size_t WS_X2 = 960 * MiB;
constexpr size_t WS_END2 = 1024 * MiB;

namespace mk {
constexpr int NWAVES = 8, NTHREADS = 512;
constexpr int RING_BYTES = 131072, SCR_BYTES = 8 * 16640, LDSCTL_OFF = 135168, MISC_OFF = LDSCTL_OFF + 320, GPARK_OFF = LDSCTL_OFF + 2048  , LDS_BYTES = 147456;
static_assert(GPARK_OFF + 8192 <= LDS_BYTES, "LDS map");
static_assert(SCR_BYTES <= LDSCTL_OFF && MISC_OFF + 128 <= LDS_BYTES, "LDS map");

#define XB_TMO      128
#define XB_XCNT(j)  (256  + 64 * (j))
#define XB_XSUB(j)  (1280 + 64 * (j))
#define XB_XGEN(j)  (2304 + 64 * (j))
#define XB_TOP      3328
#define XB_TOPGEN   3392
#define XCD_BAR_WORDS 3456
#define XB_SPIN_CAP (1u << 18)
__device__ __forceinline__ unsigned xb_ld(unsigned* p)              { return __hip_atomic_load(p, __ATOMIC_RELAXED, __HIP_MEMORY_SCOPE_AGENT); }
__device__ __forceinline__ unsigned xb_add(unsigned* p, unsigned v) { return __hip_atomic_fetch_add(p, v, __ATOMIC_RELAXED, __HIP_MEMORY_SCOPE_AGENT); }
__device__ __forceinline__ unsigned xb_xcc_id() { return (unsigned)__builtin_amdgcn_s_getreg((3 << 11) | 20) & 0xFu; }
#define XB_SPIN(cond, bar) do { unsigned _sp = 0; while (cond) { __builtin_amdgcn_s_sleep(1); \
    if ((++_sp & 255u) == 0u) { if (xb_ld(&(bar)[XB_TMO])) break; if (_sp > XB_SPIN_CAP) { atomicAdd(&(bar)[XB_TMO], 1u); break; } } } } while (0)
struct XcdBarrier { unsigned* bar; unsigned x; volatile LAS unsigned* st; };
__device__ __forceinline__ XcdBarrier xcd_barrier_post(unsigned* bar, volatile LAS unsigned* st) {
    XcdBarrier b; b.bar = bar; b.x = xb_xcc_id(); b.st = st;
    if (threadIdx.x == 0) (void)xb_add(&bar[XB_XCNT(b.x)], 1u);
    return b;
}
__device__ __forceinline__ void xcd_barrier_complete(unsigned* bar, unsigned x, unsigned& nloc, unsigned& nx) {
    const unsigned G = gridDim.x * gridDim.y * gridDim.z;
    unsigned sum, cnt, mine, sp = 0u;
    for (;;) {
        sum = 0u; cnt = 0u; mine = 0u;
#pragma unroll
        for (unsigned j = 0; j < 16; ++j) { const unsigned c = xb_ld(&bar[XB_XCNT(j)]); sum += c; cnt += (c > 0u) ? 1u : 0u; mine = (j == x) ? c : mine; }
        if (sum == G) break;
        __builtin_amdgcn_s_sleep(1);
        if ((++sp & 255u) == 0u) { if (xb_ld(&bar[XB_TMO])) break; if (sp > XB_SPIN_CAP) { atomicAdd(&bar[XB_TMO], 1u); break; } }
    }
    nloc = mine > 0u ? mine : 1u; nx = cnt > 0u ? cnt : 1u;
}
__device__ __forceinline__ void xcd_barrier(const XcdBarrier& b) {
    asm volatile("s_waitcnt vmcnt(0)" ::: "memory");
    __syncthreads();
    if (threadIdx.x == 0) {
        unsigned* bar = b.bar;
        __builtin_amdgcn_s_waitcnt(0);
        unsigned nloc = b.st[0], nx = b.st[1];
        if (nloc == 0u) { xcd_barrier_complete(bar, b.x, nloc, nx); b.st[0] = nloc; b.st[1] = nx; }
        const unsigned old = xb_add(&bar[XB_XSUB(b.x)], 1u);
        const unsigned gen = old / nloc;
        if (old + 1u == (gen + 1u) * nloc) {
            __builtin_amdgcn_fence(__ATOMIC_RELEASE, "agent");
            asm volatile("s_waitcnt vmcnt(0)" ::: "memory");
            const unsigned og = xb_add(&bar[XB_TOP], 1u);
            const unsigned tg = og / nx;
            if (og + 1u == (tg + 1u) * nx) xb_add(&bar[XB_TOPGEN], 1u);
            else XB_SPIN(xb_ld(&bar[XB_TOPGEN]) == tg, bar);
            __builtin_amdgcn_fence(__ATOMIC_ACQUIRE, "agent");
            xb_add(&bar[XB_XGEN(b.x)], 1u);
            asm volatile("s_waitcnt vmcnt(0)" ::: "memory");
        } else {
            XB_SPIN(xb_ld(&bar[XB_XGEN(b.x)]) == gen, bar);
            __builtin_amdgcn_fence(__ATOMIC_ACQUIRE, "agent");
            asm volatile("s_waitcnt vmcnt(0)" ::: "memory");
        }
    }
    __syncthreads();
}

constexpr int BM = 256, BK = 64, HALF = 128, HTB = HALF * BK * 2, STAGE_BYTES = 8 * HTB;
__device__ __forceinline__ int lds_byte(int r, int c) { const int st = (r >> 4) * 2 + (c >> 5), rr = r & 15, cc = c & 31, ob = rr * 64 + cc * 2; return st * 1024 + (ob ^ (((ob >> 9) & 1) << 5)); }
__device__ __forceinline__ void stage_rc(int b, int& R, int& C) { const int st = b / 1024, sb = b % 1024, swz = sb ^ (((sb >> 9) & 1) << 5); R = (st >> 1) * 16 + swz / 64; C = (st & 1) * 32 + (swz % 64) / 2; }
__device__ __forceinline__ int perm32(int rho) { const int n = rho >> 4, i = rho & 15; return 8 * (i >> 2) + 4 * n + (i & 3); }
__device__ __forceinline__ unsigned cvt_pk_bf16(float lo, float hi) { unsigned r; asm("v_cvt_pk_bf16_f32 %0, %1, %2" : "=v"(r) : "v"(lo), "v"(hi)); return r; }

__device__ __forceinline__ void glds16_s(const void* sbase, unsigned voff, unsigned lds_dst) { unsigned keep;
    asm volatile("s_mov_b32 %0, m0\n\ts_mov_b32 m0, %3\n\ts_nop 0\n\tglobal_load_lds_dwordx4 %1, %2\n\ts_mov_b32 m0, %0" : "=&s"(keep) : "v"(voff), "s"(sbase), "s"(lds_dst) : "memory"); }

struct Unit { const char* A; const char* B; char* C; int ldc; int mode; int rows; int aux; int pm, pn, bjs, rmin, e, nt, keep; };

template <class Epi, class Sched, bool GATHER>
__device__ __forceinline__ void gemm_phase(LAS unsigned char* lds, const int K, const int lda, const int ldb, const Sched& S, const Epi& E, const int i0 = 0, const int i1 = 0x7fffffff) {
    const int tid = threadIdx.x, wid = __builtin_amdgcn_readfirstlane(tid >> 6), lane = tid & 63, wr = wid >> 2, wc = wid & 3, fr = lane & 15, fq = lane >> 4;
    unsigned voffA[2], voffB[2];
#pragma unroll
    for (int i = 0; i < 2; ++i) { int R, C; stage_rc(tid * 16 + i * 8192, R, C); const int Rb = (R & ~31) + perm32(R & 31);
        voffA[i] = (unsigned)(R * lda + C) * 2u; voffB[i] = (unsigned)(Rb * ldb + C) * 2u; }
    const size_t kstep = (size_t)(BK * 2);
    const size_t hstepA = (size_t)HALF * lda * 2, hstepB = (size_t)HALF * ldb * 2;
    const unsigned ldsw = (unsigned)wid * 1024u;
    const unsigned ldsbase = (unsigned)__builtin_amdgcn_readfirstlane((int)(unsigned)(uintptr_t)lds);
    const int aoff = lds_byte(wr * 64 + fr, fq * 8), boff = lds_byte(wc * 32 + fr, fq * 8);
#define MK_SA(b, h) (((b) * 2 + (h)) * HTB)
#define MK_SB(b, h) ((4 + (b) * 2 + (h)) * HTB)
#define MK_STAGE2(bufoff, gbase, v0, v1) do { \
        __builtin_amdgcn_global_load_lds((const unsigned*)((const char*)(gbase) + (v0)), (LAS unsigned*)(lds + (bufoff) + ldsw), 16, 0, 0); \
        __builtin_amdgcn_global_load_lds((const unsigned*)((const char*)(gbase) + (v1)), (LAS unsigned*)(lds + (bufoff) + ldsw + 8192), 16, 0, 0); } while (0)
#define MK_STAGE_B(bufoff, gbase) do { glds16_s((gbase), voffB[0], ldsbase + (bufoff) + ldsw); glds16_s((gbase), voffB[1], ldsbase + (bufoff) + ldsw + 8192u); } while (0)
#define MK_STAGE_A(bufoff, gbase, h, VA) do { if constexpr (GATHER) { glds16_s((gbase), (VA)[h][0], ldsbase + (bufoff) + ldsw); glds16_s((gbase), (VA)[h][1], ldsbase + (bufoff) + ldsw + 8192u); } \
        else { glds16_s((gbase) + (h) * hstepA, voffA[0], ldsbase + (bufoff) + ldsw); glds16_s((gbase) + (h) * hstepA, voffA[1], ldsbase + (bufoff) + ldsw + 8192u); } } while (0)
#define MK_LDA(dst, b, h) do { _Pragma("unroll") for (int m = 0; m < 4; ++m) _Pragma("unroll") for (int k = 0; k < 2; ++k) dst[m][k] = *(const LAS bf16x8*)(lds + MK_SA(b, h) + aoff + m * 2048 + k * 1024); } while (0)
#define MK_LDB(dst, b, h) do { _Pragma("unroll") for (int n = 0; n < 2; ++n) _Pragma("unroll") for (int k = 0; k < 2; ++k) dst[n][k] = *(const LAS bf16x8*)(lds + MK_SB(b, h) + boff + n * 2048 + k * 1024); } while (0)
#define MK_MMA(ai, bj, At, Bt) do { __builtin_amdgcn_s_setprio(1); _Pragma("unroll") for (int m = 0; m < 4; ++m) _Pragma("unroll") for (int n = 0; n < 2; ++n) _Pragma("unroll") for (int k = 0; k < 2; ++k) \
        acc[ai][bj][m][n] = __builtin_amdgcn_mfma_f32_16x16x32_bf16(Bt[n][k], At[m][k], acc[ai][bj][m][n], 0, 0, 0); __builtin_amdgcn_s_setprio(0); } while (0)
#define MK_WAIT_V(n) asm volatile("s_waitcnt vmcnt(" #n ")" ::: "memory")
#define MK_WAIT_L(n) asm volatile("s_waitcnt lgkmcnt(" #n ")" ::: "memory")
#define MK_BAR __builtin_amdgcn_s_barrier()
#define MK_SCHED __builtin_amdgcn_sched_barrier(0)
    Unit cur, nxt; int ui = i0;
    if (i0 >= i1 || !S.next(i0, cur)) return;
    f32x4 acc[2][2][4][2];
#pragma unroll
    for (int a = 0; a < 2; ++a)
#pragma unroll
        for (int b = 0; b < 2; ++b)
#pragma unroll
            for (int m = 0; m < 4; ++m)
#pragma unroll
                for (int n = 0; n < 2; ++n) acc[a][b][m][n] = (f32x4){0.f, 0.f, 0.f, 0.f};
    bf16x8 At[4][2], B0[2][2], B1[2][2];
    unsigned vC[2][2];
    LAS u32x4* vpark = (LAS u32x4*)(lds + GPARK_OFF) + tid;
    if constexpr (GATHER) {
#pragma unroll
        for (int h = 0; h < 2; ++h)
#pragma unroll
            for (int i = 0; i < 2; ++i) { int R, C; stage_rc(tid * 16 + i * 8192, R, C); vC[h][i] = S.arow(cur, h * HALF + R) + (unsigned)(C * 2); }
    }
    const char* cA = cur.A; const char* cB = cur.B;
    MK_STAGE_B(MK_SB(0, 0), cB); MK_STAGE_B(MK_SB(0, 1), cB + hstepB); MK_STAGE_A(MK_SA(0, 0), cA, 0, vC); MK_STAGE_A(MK_SA(0, 1), cA, 1, vC);
    if (wr == 1) MK_BAR;
    MK_WAIT_V(2); MK_BAR;
    MK_STAGE_B(MK_SB(1, 0), cB + kstep); MK_STAGE_A(MK_SA(1, 0), cA + kstep, 0, vC); MK_STAGE_B(MK_SB(1, 1), cB + hstepB + kstep);
    MK_WAIT_V(6); MK_BAR;
    for (;;) {
        const bool has_next = (ui + 1 < i1) && S.next(ui + 1, nxt);
        const char* nA = has_next ? nxt.A : cA; const char* nB = has_next ? nxt.B : cB;
        if constexpr (GATHER) {
            u32x4 pv;
#pragma unroll
            for (int h = 0; h < 2; ++h)
#pragma unroll
                for (int i = 0; i < 2; ++i) { int R, C; stage_rc(tid * 16 + i * 8192, R, C); pv[h * 2 + i] = has_next ? (S.arow(nxt, h * HALF + R) + (unsigned)(C * 2)) : vC[h][i]; }
            *vpark = pv;
        }
        const int nt = cur.nt;
        for (int t = 0; t < nt; t += 2) {
            const bool last = (t == nt - 2);
            const char* a1 = cA + (size_t)(t + 1) * kstep;
            const char* a2 = last ? nA : cA + (size_t)(t + 2) * kstep; const char* b2 = last ? nB : cB + (size_t)(t + 2) * kstep;
            const char* a3 = a2 + kstep; const char* b3 = b2 + kstep;
            MK_LDB(B0, 0, 0); MK_LDB(B1, 0, 1); MK_SCHED; MK_LDA(At, 0, 0); MK_STAGE_A(MK_SA(1, 1), a1, 1, vC);
            if constexpr (GATHER) { if (last) { const u32x4 pv = *vpark; vC[0][0] = pv[0]; vC[0][1] = pv[1]; vC[1][0] = pv[2]; vC[1][1] = pv[3]; } }
            MK_WAIT_V(8); MK_WAIT_L(0); MK_BAR; MK_MMA(0, 0, At, B0); MK_MMA(0, 1, At, B1); MK_BAR; MK_SCHED;
            MK_LDA(At, 0, 1); MK_STAGE_B(MK_SB(0, 0), b2); MK_STAGE_B(MK_SB(0, 1), b2 + hstepB); MK_STAGE_A(MK_SA(0, 0), a2, 0, vC);
            MK_WAIT_V(8); MK_WAIT_L(0); MK_BAR; MK_MMA(1, 0, At, B0); MK_MMA(1, 1, At, B1); MK_BAR; MK_SCHED;
            MK_LDB(B0, 1, 0); MK_LDB(B1, 1, 1); MK_SCHED; MK_LDA(At, 1, 0); MK_STAGE_A(MK_SA(0, 1), a2, 1, vC);
            MK_WAIT_V(8); MK_WAIT_L(0); MK_BAR; MK_MMA(0, 0, At, B0); MK_MMA(0, 1, At, B1); MK_BAR; MK_SCHED;
            MK_LDA(At, 1, 1); MK_STAGE_B(MK_SB(1, 0), b3); MK_STAGE_B(MK_SB(1, 1), b3 + hstepB); MK_STAGE_A(MK_SA(1, 0), a3, 0, vC);
            MK_WAIT_V(8); MK_WAIT_L(0); MK_BAR; MK_MMA(1, 0, At, B0); MK_MMA(1, 1, At, B1); MK_BAR; MK_SCHED;
        }
        if (wr == 0) MK_BAR;
        E(acc, cur, wr, wc, fr, fq);
        if (!has_next) break;
        if (!cur.keep)
#pragma unroll
        for (int a = 0; a < 2; ++a)
#pragma unroll
            for (int b = 0; b < 2; ++b)
#pragma unroll
                for (int m = 0; m < 4; ++m)
#pragma unroll
                    for (int n = 0; n < 2; ++n) acc[a][b][m][n] = (f32x4){0.f, 0.f, 0.f, 0.f};
        cur = nxt; cA = nA; cB = nB; ++ui;
        if (wr == 1) MK_BAR;
    }
    MK_WAIT_V(0);
    MK_BAR;
#undef MK_SA
#undef MK_SB
#undef MK_STAGE2
#undef MK_STAGE_B
#undef MK_STAGE_A
#undef MK_LDA
#undef MK_LDB
#undef MK_MMA
#undef MK_WAIT_V
#undef MK_WAIT_L
#undef MK_BAR
#undef MK_SCHED
}

__device__ __forceinline__ void grid_map(int L, int nM, int nN, int& pm, int& pn) {
    const int nwg = nM * nN, q = nwg / 8, xcd = L % 8, off = L / 8; const int wgid = xcd * q + off;
    const int nig = 8 * nN, gid = wgid / nig, fm = gid * 8, gsz = (nM - fm) < 8 ? (nM - fm) : 8;
    pm = fm + ((wgid % nig) % gsz); pn = (wgid % nig) / gsz;
}

struct EpiStore {
    const float* w2048;
    __device__ __forceinline__ void operator()(f32x4 (&acc)[2][2][4][2], const Unit& u, int wr, int wc, int fr, int fq) const {
        const int col0 = wc * 32 + 8 * fq;
#pragma unroll
        for (int ai = 0; ai < 2; ++ai)
#pragma unroll
            for (int m = 0; m < 4; ++m) {
                const int r = ai * HALF + wr * 64 + m * 16 + fr;
                if (r < u.rows && r >= u.rmin) {
#pragma unroll
                    for (int bj = 0; bj < 2; ++bj) {
                        f32x4 v0 = acc[ai][bj][m][0], v1 = acc[ai][bj][m][1];
                        if (u.mode == 1) { float* p = (float*)u.C + (long)r * u.ldc + col0 + bj * u.bjs; *(f32x4*)p = v0; *(f32x4*)(p + 4) = v1; }
                        else {
                            if (u.mode == 2) {
#pragma unroll
                                for (int c = 0; c < 4; ++c) { v0[c] = __builtin_amdgcn_rcpf(1.0f + __expf(-v0[c])); v1[c] = __builtin_amdgcn_rcpf(1.0f + __expf(-v1[c])); }
                            } else if (u.mode == 3) {
                                const float* wp = w2048 + u.pn + bj * HALF + col0; const float sg = (r & 1) ? -1.0f : 1.0f;
                                v0 += *(const f32x4*)wp * sg; v1 += *(const f32x4*)(wp + 4) * sg;
                            }
                            u32x4 w; w.x = cvt_pk_bf16(v0[0], v0[1]); w.y = cvt_pk_bf16(v0[2], v0[3]); w.z = cvt_pk_bf16(v1[0], v1[1]); w.w = cvt_pk_bf16(v1[2], v1[3]);
                            *(u32x4*)((bf16_t*)u.C + (long)r * u.ldc + col0 + bj * u.bjs) = w;
                        }
                    }
                }
            }
    }
};


struct EpiIn { EpiStore base; LAS float* red; const float* qnw; const float* knw; const float* rope;
    __device__ __forceinline__ void operator()(f32x4 (&acc)[2][2][4][2], const Unit& u, int wr, int wc, int fr, int fq) const {
        if (u.mode < 5) { base(acc, u, wr, wc, fr, fq); return; }
#pragma unroll
        for (int ai = 0; ai < 2; ++ai)
#pragma unroll
            for (int m = 0; m < 4; ++m)
#pragma unroll
                for (int bj = 0; bj < 2; ++bj) { const f32x4 a = acc[ai][bj][m][0], b = acc[ai][bj][m][1];
                    float s = (a[0] * a[0] + a[1] * a[1]) + (a[2] * a[2] + a[3] * a[3]) + (b[0] * b[0] + b[1] * b[1]) + (b[2] * b[2] + b[3] * b[3]);
                    s += __shfl_xor(s, 16); s += __shfl_xor(s, 32);
                    if (fq == 0) red[((ai * HALF + wr * 64 + m * 16 + fr) * 2 + bj) * 4 + wc] = s; }
        asm volatile("s_waitcnt lgkmcnt(0)" ::: "memory"); __builtin_amdgcn_s_barrier(); asm volatile("" ::: "memory");
        const float* nw = u.mode == 5 ? qnw : knw;
        const int axis = wc >> 1, f0 = (wc & 1) * 16 + fq * 4, da = axis * 64 + f0;
        const f32x4 wa = *(const f32x4*)(nw + da), wb = *(const f32x4*)(nw + da + 32);
#pragma unroll
        for (int ai = 0; ai < 2; ++ai)
#pragma unroll
            for (int m = 0; m < 4; ++m) { const int r = ai * HALF + wr * 64 + m * 16 + fr;
                f32x4 cs = {1.f, 1.f, 1.f, 1.f}, sn = {0.f, 0.f, 0.f, 0.f};
                if (u.mode != 7) { const int t = u.pm + r, pos = axis ? (t & 63) : (t >> 6); const float* rp = rope + (pos * 32 + f0) * 2;
                    const f32x4 p0 = *(const f32x4*)rp, p1 = *(const f32x4*)(rp + 4); cs = (f32x4){p0[0], p0[2], p1[0], p1[2]}; sn = (f32x4){p0[1], p0[3], p1[1], p1[3]}; }
#pragma unroll
                for (int bj = 0; bj < 2; ++bj) { const LAS f32x4* pp = (const LAS f32x4*)(red + (r * 2 + bj) * 4); const f32x4 ps = *pp;
                    const float rstd = 1.0f / sqrtf(((ps[0] + ps[1]) + (ps[2] + ps[3])) * (1.0f / HD) + 1e-6f);
                    const f32x4 xa = acc[ai][bj][m][0] * rstd * wa, xb = acc[ai][bj][m][1] * rstd * wb;
                    const f32x4 oa = xa * cs - xb * sn, ob = xb * cs + xa * sn;
                    u32x4 w; w.x = cvt_pk_bf16(oa[0], oa[1]); w.y = cvt_pk_bf16(oa[2], oa[3]); w.z = cvt_pk_bf16(ob[0], ob[1]); w.w = cvt_pk_bf16(ob[2], ob[3]);
                    *(u32x4*)((bf16_t*)u.C + (long)r * u.ldc + bj * HALF + wc * 32 + 8 * fq) = w; } }
    } };

struct Args { const float* in[22]; float* out; unsigned char* ws; int ph_lo, ph_hi, use_ut, mod_off, do_attn, bar_idx; };
struct Frame {
    LAS unsigned char* lds; volatile LAS unsigned* MISC; unsigned char* ws;
    int tid, lane, wave, vcu, G;
};

__device__ __forceinline__ int qk_col_of_dim(int d) { const int a = d >> 6, half = (d >> 5) & 1, f = d & 31; return 32 * (2 * a + (f >> 4)) + 8 * ((f >> 2) & 3) + 4 * half + (f & 3); }
__device__ __forceinline__ void t64_load(f32x4 (&v)[16], const float* W, int ldw, int lane) {
    const unsigned off = (unsigned)(((lane >> 4) * ldw + (lane & 15) * 4) * 4);
#pragma unroll
    for (int j = 0; j < 16; ++j) { const char* bj = (const char*)W + (size_t)(j * 4) * ldw * 4; v[j] = __builtin_nontemporal_load((const GAS f32x4*)(bj + off)); }
}
template <bool QKPERM = false>
__device__ __forceinline__ void t64_store(const f32x4 (&v)[16], bf16_t* dst, int ldd, LAS float* scr, int lane, int d0 = 0) {
    const int kk = lane >> 4, nc = (lane & 15) * 4;
#pragma unroll
    for (int j = 0; j < 16; ++j) {
#pragma unroll
        for (int c = 0; c < 4; ++c) scr[(j * 4 + kk) * 65 + nc + c] = v[j][c]; }
    LDS_WAIT(); asm volatile("" ::: "memory");
    const int kc = lane & 7; const unsigned soff = (unsigned)(((lane >> 3) * ldd + 8 * kc) * 2);
#pragma unroll
    for (int jj = 0; jj < 8; jj += 2) {
        float t[2][8];
#pragma unroll
        for (int q = 0; q < 2; ++q) { const int n = (lane >> 3) + 8 * (jj + q); const LAS float* s = scr + (8 * kc) * 65 + n;
#pragma unroll
            for (int i = 0; i < 8; ++i) t[q][i] = s[i * 65]; }
#pragma unroll
        for (int q = 0; q < 2; ++q) { char* bq = (char*)dst + (size_t)(8 * (jj + q)) * ldd * 2;
            if constexpr (QKPERM) bq = (char*)dst + (size_t)(qk_col_of_dim(d0 + (lane >> 3) + 8 * (jj + q)) - (lane >> 3)) * ldd * 2;
            u32x4 o; o.x = cvt_pk_bf16(t[q][0], t[q][1]); o.y = cvt_pk_bf16(t[q][2], t[q][3]); o.z = cvt_pk_bf16(t[q][4], t[q][5]); o.w = cvt_pk_bf16(t[q][6], t[q][7]);
            __builtin_nontemporal_store(o, (GAS u32x4*)(bq + soff)); } }
    LDS_WAIT(); asm volatile("" ::: "memory");
}
__device__ __forceinline__ void transpose64(const float* W, int ldw, bf16_t* dst, int ldd, LAS float* scr, int lane) {
    f32x4 v[16]; t64_load(v, W, ldw, lane); t64_store(v, dst, ldd, scr, lane);
}

constexpr int IT_IN = 32 * 128, IT_FO = 16 * 32, IT_AO = 32 * 32, IT_O = 32 * 32, IT_EG = 64 * 256, IT_EU = 64 * 256, IT_ED = 64 * 256, IT_SH = 256;
constexpr int IT_T_END = IT_IN + IT_FO + IT_AO + IT_O + 3 * IT_SH;
constexpr int IT_MOD = MODC / 32, IT_CST = 4096, IT_BD2 = 512, IT_RWT = 32, IT_ROPE = 1;
constexpr int IT_ALL = IT_T_END + IT_MOD + IT_CST + IT_BD2 + IT_RWT + IT_ROPE;

__device__ __forceinline__ void mod_item(const Args& args, unsigned char* ws, int r, int lane) {
            const int kq = lane >> 3, col = r * 32 + (lane & 7) * 4;
            f32x4 a0 = {0.f, 0.f, 0.f, 0.f}, a1 = a0, a2 = a0;
            for (int jb = 0; jb < 256; jb += 8) {
                f32x4 w[8]; float c0[8], c1[8], c2[8];
#pragma unroll
                for (int j = 0; j < 8; ++j) { const int k = kq + 8 * (jb + j); w[j] = *(const GAS f32x4*)(args.in[4] + (size_t)k * MODC + col); c0[j] = args.in[1][k]; c1[j] = args.in[1][DM + k]; c2[j] = args.in[3][k]; }
#pragma unroll
                for (int j = 0; j < 8; ++j) { a0 += w[j] * (c0[j] * __builtin_amdgcn_rcpf(1.0f + __expf(-c0[j]))); a1 += w[j] * (c1[j] * __builtin_amdgcn_rcpf(1.0f + __expf(-c1[j]))); a2 += w[j] * (c2[j] * __builtin_amdgcn_rcpf(1.0f + __expf(-c2[j]))); }
            }
#pragma unroll
            for (int c = 0; c < 4; ++c) {
#pragma unroll
                for (int o = 8; o < 64; o <<= 1) { a0[c] += __shfl_xor(a0[c], o); a1[c] += __shfl_xor(a1[c], o); a2[c] += __shfl_xor(a2[c], o); } }
            if (kq == 0) { const f32x4 bb = *(const GAS f32x4*)(args.in[5] + col); float* MODP = (float*)(ws + WS_MOD);
                *(GAS f32x4*)(MODP + col) = a0 + bb; *(GAS f32x4*)(MODP + MODC + col) = a1 + bb; *(GAS f32x4*)(MODP + 2 * MODC + col) = a2 + bb; }
}
__device__ __forceinline__ void p0_prologue(Frame& F, const Args& args) {
    LAS float* scr = (LAS float*)(F.lds + F.wave * 16640);
    const int gw = F.vcu * NWAVES + F.wave, NGW = F.G * NWAVES, lane = F.lane;
    unsigned char* ws = F.ws;
    bf16_t* WT_IN = (bf16_t*)(ws + WS_WT_IN); bf16_t* WT_FO = (bf16_t*)(ws + WS_WT_FO); bf16_t* WT_AO = (bf16_t*)(ws + WS_WT_AO); bf16_t* WT_O = (bf16_t*)(ws + WS_WT_O);
    bf16_t* WT_GU = (bf16_t*)(ws + WS_WT_GU); bf16_t* WT_D = (bf16_t*)(ws + WS_WT_D);
    if (NGW >= 5 * IT_MOD) { if (gw % 5 == 0 && gw / 5 < IT_MOD) mod_item(args, ws, gw / 5, lane); }
    else for (int m = gw; m < IT_MOD; m += NGW) mod_item(args, ws, m, lane);
    for (int it = gw; it < IT_ALL - IT_MOD; it += NGW) {
        int r = it;
        if (r < IT_IN) { const int kb = r / 128, nb = r % 128, n0 = nb * 64;
            if (n0 >= Q_OFF && n0 < V_OFF) { f32x4 v[16]; t64_load(v, args.in[7] + (size_t)(kb * 64) * INC + n0, INC, lane);
                t64_store<true>(v, WT_IN + (size_t)(n0 & ~127) * DM + kb * 64, DM, scr, lane, n0 & 127); }
            else transpose64(args.in[7] + (size_t)(kb * 64) * INC + n0, INC, WT_IN + (size_t)n0 * DM + kb * 64, DM, scr, lane);
            continue; } r -= IT_IN;
        if (r < IT_FO) { const int kb = r / 32, nb = r % 32; transpose64(args.in[10] + (size_t)(kb * 64) * DM + nb * 64, DM, WT_FO + (size_t)(nb * 64) * YFP + kb * 64, YFP, scr, lane); continue; } r -= IT_FO;
        if (r < IT_AO) { const int kb = r / 32, nb = r % 32; transpose64(args.in[11] + (size_t)(kb * 64) * DM + nb * 64, DM, WT_AO + (size_t)(nb * 64) * DM + kb * 64, DM, scr, lane); continue; } r -= IT_AO;
        if (r < IT_O) { const int kb = r / 32, nb = r % 32; transpose64(args.in[12] + (size_t)(kb * 64) * DM + nb * 64, DM, WT_O + (size_t)(nb * 64) * DM + kb * 64, DM, scr, lane); continue; } r -= IT_O;
        if (r < 2 * IT_SH) { const int up = r >= IT_SH; if (up) r -= IT_SH; const int kb = r / 8, nb = r % 8, n0 = nb * 64;
            transpose64((up ? args.in[20] : args.in[19]) + (size_t)(kb * 64) * EFF + n0, EFF, WT_GU + ((size_t)64 * 1024 + (n0 >> 7) * 256 + (up ? 128 : 0) + (n0 & 127)) * DM + kb * 64, DM, scr, lane); continue; } r -= 2 * IT_SH;
        if (r < IT_SH) { const int kb = r / 32, nb = r % 32;
            transpose64(args.in[21] + (size_t)(kb * 64) * DM + nb * 64, DM, WT_D + ((size_t)64 * DM + nb * 64) * EFF + kb * 64, EFF, scr, lane); continue; } r -= IT_SH;

        if (r < IT_CST) {
            const int k1 = r & 2047; bf16_t* dst = (bf16_t*)(ws + WS_CST) + (size_t)r * 2048;
#pragma unroll
            for (int j = 0; j < 4; ++j) { const int n0 = j * 512 + lane * 8; float f[8];
#pragma unroll
                for (int i = 0; i < 8; ++i) { const float ph = (float)((k1 * (n0 + i)) & 4095) * (1.0f / 2048.0f); f[i] = r < 2048 ? cospif(ph) : sinpif(ph); }
                u32x4 o; o.x = cvt_pk_bf16(f[0], f[1]); o.y = cvt_pk_bf16(f[2], f[3]); o.z = cvt_pk_bf16(f[4], f[5]); o.w = cvt_pk_bf16(f[6], f[7]);
                *(GAS u32x4*)(dst + n0) = o; }
            continue; } r -= IT_CST;
        if (r < IT_BD2) {
            const int t = r >> 8, o = r & 255, gp = o >> 7, k2 = o & 127; bf16_t* dst = (bf16_t*)(ws + WS_BD2) + (size_t)r * 512; float f[8];
#pragma unroll
            for (int i = 0; i < 8; ++i) { const int j = lane * 8 + i, cg = j >> 8, jj = j & 255, c = jj & 127; const float ph = (float)((32 * c * k2) & 4095) * (1.0f / 2048.0f);
                const float v = jj < 128 ? cospif(ph) : (t ? sinpif(ph) : -sinpif(ph)); f[i] = cg == gp ? v * 0.0013810679320049757f : 0.f; }
            u32x4 w; w.x = cvt_pk_bf16(f[0], f[1]); w.y = cvt_pk_bf16(f[2], f[3]); w.z = cvt_pk_bf16(f[4], f[5]); w.w = cvt_pk_bf16(f[6], f[7]);
            *(GAS u32x4*)(dst + lane * 8) = w;
            continue; } r -= IT_BD2;
        if (r >= IT_RWT) {
            float* RT = (float*)(ws + WS_ROPE);
            for (int idx = lane; idx < 64 * 32; idx += 64) { const float ang = (float)(idx >> 5) * exp2f(-(float)(idx & 31) * (13.287712379549449f / 32.0f)); RT[2 * idx] = cosf(ang); RT[2 * idx + 1] = sinf(ang); }
            continue; }
        {
            f32x4 v[16]; t64_load(v, args.in[14] + (size_t)(r * 64) * NE, NE, lane);
            const int kk = lane >> 4, nc = (lane & 15) * 4;
#pragma unroll
            for (int j = 0; j < 16; ++j) {
#pragma unroll
                for (int c = 0; c < 4; ++c) scr[(j * 4 + kk) * 65 + nc + c] = v[j][c]; }
            LDS_WAIT(); asm volatile("" ::: "memory");
            const int kc = lane & 7; bf16_t* RWT = (bf16_t*)(ws + WS_RWT);
#pragma unroll
            for (int jj = 0; jj < 8; ++jj) { const int e = (lane >> 3) + 8 * jj; const LAS float* s = scr + (8 * kc) * 65 + e; float t[8], l[8];
#pragma unroll
                for (int i = 0; i < 8; ++i) { t[i] = s[i * 65]; l[i] = t[i] - bf2f(f2bf(t[i])); }
                u32x4 h, lo; h.x = cvt_pk_bf16(t[0], t[1]); h.y = cvt_pk_bf16(t[2], t[3]); h.z = cvt_pk_bf16(t[4], t[5]); h.w = cvt_pk_bf16(t[6], t[7]);
                lo.x = cvt_pk_bf16(l[0], l[1]); lo.y = cvt_pk_bf16(l[2], l[3]); lo.z = cvt_pk_bf16(l[4], l[5]); lo.w = cvt_pk_bf16(l[6], l[7]);
                *(GAS u32x4*)(RWT + (size_t)e * DM + r * 64 + 8 * kc) = h; *(GAS u32x4*)(RWT + (size_t)(NE + e) * DM + r * 64 + 8 * kc) = lo; }
            LDS_WAIT(); asm volatile("" ::: "memory");
        }
    }
}


__device__ __forceinline__ void conv_addr(const Args& args, unsigned char* ws, bool down, int it, const float*& W, int& ldw, bf16_t*& dst, int& ldd) {
    if (!down) { int r = it; const int up = r >= IT_EG; if (up) r -= IT_EG;
        const int e = r / 256, q = r % 256, kb = q / 8, nb = q % 8, n0 = nb * 64;
        W = (up ? args.in[17] : args.in[16]) + (size_t)e * DM * EFF + (size_t)(kb * 64) * EFF + n0; ldw = EFF;
        dst = (bf16_t*)(ws + WS_WT_GU) + ((size_t)e * 1024 + (n0 >> 7) * 256 + (up ? 128 : 0) + (n0 & 127)) * DM + kb * 64; ldd = DM;
    } else { const int r = it, e = r / 256, q = r % 256, kb = q / 32, nb = q % 32;
        W = args.in[18] + (size_t)e * EFF * DM + (size_t)(kb * 64) * DM + nb * 64; ldw = DM;
        dst = (bf16_t*)(ws + WS_WT_D) + ((size_t)e * DM + nb * 64) * EFF + kb * 64; ldd = EFF; }
}
__device__ __forceinline__ void conv_items(Frame& F, const Args& args, bool down, int first, int count) {
    LAS float* scr = (LAS float*)(F.lds + F.wave * 16640);
    const int end = first + count; int it = first + F.wave;
    if (it >= end) return;
    f32x4 va[16], vb[16]; const float* W; int ldw; bf16_t* da; bf16_t* db; int ldd;
    conv_addr(args, F.ws, down, it, W, ldw, da, ldd); t64_load(va, W, ldw, F.lane);
    for (;;) {
        const bool hb = it + NWAVES < end;
        if (hb) { conv_addr(args, F.ws, down, it + NWAVES, W, ldw, db, ldd); t64_load(vb, W, ldw, F.lane); }
        t64_store(va, da, ldd, scr, F.lane);
        if (!hb) break;
        const bool ha = it + 2 * NWAVES < end;
        if (ha) { conv_addr(args, F.ws, down, it + 2 * NWAVES, W, ldw, da, ldd); t64_load(va, W, ldw, F.lane); }
        t64_store(vb, db, ldd, scr, F.lane);
        if (!ha) break;
        it += 2 * NWAVES;
    }
}
struct SchedIn {
    int G, c; unsigned char* ws; int use_ut;
    __device__ __forceinline__ bool next(int i, Unit& u) const {
        const int L = i * G + c; if (L >= 1024) return false;
        const char* H = (const char*)(ws + WS_H); const char* WT = (const char*)(ws + WS_WT_IN);
        u.rows = 256; u.aux = 0; u.bjs = HALF; u.pm = 0; u.pn = 0; u.rmin = 0; u.nt = DM / BK; u.keep = 0;
        if (L < 896) {
            int pm, ct; grid_map(L, 32, 28, pm, ct);
            const int row0 = pm * 256, b = row0 / SEQ, t0 = row0 % SEQ;
            u.A = H + (size_t)row0 * DM * 2; u.B = WT + (size_t)ct * 256 * DM * 2;
            if (ct < 4) {
                if (use_ut) { u.A = WT + (size_t)ct * 256 * DM * 2; u.B = H + (size_t)row0 * DM * 2;
                              u.C = (char*)(ws + WS_UT) + (((size_t)b * FW + ct * 256) * SEQ + t0) * 2; u.ldc = SEQ; u.mode = 0; }
                else { u.C = (char*)(ws + WS_U) + ((size_t)row0 * FW + ct * 256) * 2; u.ldc = FW; u.mode = 0; }
            }
            else if (ct < 12) { u.C = (char*)(ws + WS_Q) + ((size_t)row0 * DM + (ct - 4) * 256) * 2; u.ldc = DM; u.mode = 5; u.pm = t0; }
            else if (ct < 14) { u.C = (char*)(ws + WS_KALL) + (((size_t)b * SKV + t0) * KVW + (ct - 12) * 256) * 2; u.ldc = KVW; u.mode = 6; u.pm = t0; }
            else if (ct < 16) { u.C = (char*)(ws + WS_VALL) + (((size_t)b * SKV + t0) * KVW + (ct - 14) * 256) * 2; u.ldc = KVW; u.mode = 0; }
            else if (ct < 24) { u.C = (char*)(ws + WS_SGF) + ((size_t)row0 * DM + (ct - 16) * 256) * 2; u.ldc = DM; u.mode = 2; }
            else              { u.C = (char*)(ws + WS_SGA) + ((size_t)row0 * DM + (ct - 24) * 256) * 2; u.ldc = DM; u.mode = 2; }
        } else if (L >= 904) {
            int pm, q; grid_map(L - 904, 32, 4, pm, q); const int ct = 28 + q;
            u.A = H + (size_t)pm * 256 * DM * 2; u.B = WT + (size_t)ct * 256 * DM * 2;
            u.C = (char*)(ws + WS_SGA) + ((size_t)pm * 256 * DM + (ct - 24) * 256) * 2; u.ldc = DM; u.mode = 2;
        } else {
            const int l = L - 896, pm = l & 1, ct = l >> 1;
            u.A = H + (size_t)(NTOK + pm * 256) * DM * 2; u.B = WT + (size_t)(K_OFF + ct * 256) * DM * 2;
            if (ct < 2) { u.C = (char*)(ws + WS_KALL) + (((size_t)pm * SKV + SEQ) * KVW + ct * 256) * 2; u.ldc = KVW; u.mode = 7; }
            else        { u.C = (char*)(ws + WS_VALL) + (((size_t)pm * SKV + SEQ) * KVW + (ct - 2) * 256) * 2; u.ldc = KVW; u.mode = 0; }
        }
        return true;
    }
    __device__ __forceinline__ unsigned arow(const Unit&, int) const { return 0u; }
};


__device__ __forceinline__ void unpack8(u32x4 w, float (&f)[8]) {
#pragma unroll
    for (int i = 0; i < 4; ++i) { f[2 * i] = __uint_as_float(w[i] << 16); f[2 * i + 1] = __uint_as_float(w[i] & 0xffff0000u); }
}
struct EpiMerge { const bf16_t* SGF; const bf16_t* SGA; bf16_t* YM;
    __device__ __forceinline__ void operator()(f32x4 (&acc)[2][2][4][2], const Unit& u, int wr, int wc, int fr, int fq) const {
#pragma unroll
        for (int ai = 0; ai < 2; ++ai)
#pragma unroll
            for (int m = 0; m < 4; ++m) { const size_t row = (size_t)u.pm * 256 + ai * HALF + wr * 64 + m * 16 + fr;
#pragma unroll
                for (int bj = 0; bj < 2; ++bj) { const size_t o = row * DM + u.pn * 256 + bj * HALF + wc * 32 + 8 * fq;
                    float ga[8]; unpack8(*(const u32x4*)(SGA + o), ga);
#pragma unroll
                    for (int c = 0; c < 8; ++c) ga[c] = fmaxf(ga[c], 1e-20f);
                    if (u.keep) { float gf[8]; unpack8(*(const u32x4*)(SGF + o), gf);
#pragma unroll
                        for (int c = 0; c < 4; ++c) { acc[ai][bj][m][0][c] *= gf[c] * __builtin_amdgcn_rcpf(ga[c]); acc[ai][bj][m][1][c] *= gf[4 + c] * __builtin_amdgcn_rcpf(ga[4 + c]); }
                    } else { const f32x4 v0 = acc[ai][bj][m][0], v1 = acc[ai][bj][m][1];
                        u32x4 w; w.x = cvt_pk_bf16(ga[0] * v0[0], ga[1] * v0[1]); w.y = cvt_pk_bf16(ga[2] * v0[2], ga[3] * v0[3]); w.z = cvt_pk_bf16(ga[4] * v1[0], ga[5] * v1[1]); w.w = cvt_pk_bf16(ga[6] * v1[2], ga[7] * v1[3]);
                        *(u32x4*)(YM + o) = w; } } }
    } };
struct SchedMerge { int G, c; unsigned char* ws;
    __device__ __forceinline__ bool next(int i, Unit& u) const {
        const int L = (i >> 1) * G + c; if (L >= 256) return false;
        int pm, pn; grid_map(L, 32, 8, pm, pn); const int kb = i & 1;
        u.A = (const char*)(ws + (kb ? WS_YA : WS_YF)) + (size_t)pm * 256 * DM * 2; u.B = (const char*)(ws + (kb ? WS_WT_AO : WS_WT_FO)) + (size_t)pn * 256 * DM * 2;
        u.C = nullptr; u.ldc = DM; u.mode = 0; u.rows = 256; u.aux = 0; u.pm = pm; u.pn = pn; u.bjs = HALF; u.rmin = 0; u.nt = kb ? DM / BK : FW / BK; u.keep = kb ? 0 : 1;
        return true; }
    __device__ __forceinline__ unsigned arow(const Unit&, int) const { return 0u; } };
struct EpiX2 { const float* x; const float* mod; float* X2;
    __device__ __forceinline__ void operator()(f32x4 (&acc)[2][2][4][2], const Unit& u, int wr, int wc, int fr, int fq) const {
        const float* g1 = mod + ((u.pm * 256) / SEQ) * MODC + 2 * DM;
#pragma unroll
        for (int ai = 0; ai < 2; ++ai)
#pragma unroll
            for (int m = 0; m < 4; ++m) { const size_t row = (size_t)u.pm * 256 + ai * HALF + wr * 64 + m * 16 + fr;
#pragma unroll
                for (int bj = 0; bj < 2; ++bj) { const int col = u.pn * 256 + bj * HALF + wc * 32 + 8 * fq; const size_t o = row * DM + col;
#pragma unroll
                    for (int n = 0; n < 2; ++n) { const f32x4 xv = *(const f32x4*)(x + o + 4 * n), gv = *(const f32x4*)(g1 + col + 4 * n); *(f32x4*)(X2 + o + 4 * n) = xv + gv * acc[ai][bj][m][n]; } } }
    } };
struct EpiAct {
    __device__ __forceinline__ void operator()(f32x4 (&acc)[2][2][4][2], const Unit& u, int wr, int wc, int fr, int fq) const {
#pragma unroll
        for (int ai = 0; ai < 2; ++ai)
#pragma unroll
            for (int m = 0; m < 4; ++m) { const int r = ai * HALF + wr * 64 + m * 16 + fr;
                if (r < u.rows) { float a[8];
#pragma unroll
                    for (int n = 0; n < 2; ++n)
#pragma unroll
                        for (int c = 0; c < 4; ++c) { const float g = acc[ai][0][m][n][c], up = acc[ai][1][m][n][c]; a[4 * n + c] = g * __builtin_amdgcn_rcpf(1.0f + __expf(-g)) * up; }
                    u32x4 w; w.x = cvt_pk_bf16(a[0], a[1]); w.y = cvt_pk_bf16(a[2], a[3]); w.z = cvt_pk_bf16(a[4], a[5]); w.w = cvt_pk_bf16(a[6], a[7]);
                    *(u32x4*)((bf16_t*)u.C + (size_t)r * u.ldc + wc * 32 + 8 * fq) = w; } }
    } };

struct SchedGrid {
    int G, c, nM, nN; const char* A; const char* B; char* C; size_t astride, bstride; int ldc, esz, mode, nt;
    __device__ __forceinline__ bool next(int i, Unit& u) const {
        const int L = i * G + c; if (L >= nM * nN) return false;
        int pm, pn; grid_map(L, nM, nN, pm, pn);
        u.A = A + (size_t)pm * astride; u.B = B + (size_t)pn * bstride; u.C = C + ((size_t)pm * 256 * ldc + pn * 256) * esz; u.ldc = ldc; u.mode = mode; u.rows = 256; u.aux = 0; u.pm = pm; u.pn = pn; u.bjs = HALF; u.rmin = 0; u.nt = nt; u.keep = 0;
        return true; }
    __device__ __forceinline__ unsigned arow(const Unit&, int) const { return 0u; } };
struct SchedAG { int G, c; unsigned char* ws;
    __device__ __forceinline__ bool next(int i, Unit& u) const {
        const int L = i * G + c; if (L >= 136) return false;
        u.rows = 256; u.aux = 0; u.rmin = 0; u.nt = DM / BK; u.keep = 0;
        if (L < 128) {
            int pm, pn8; grid_map(L, 16, 8, pm, pn8); const int b = pn8 >> 2, pn = pn8 & 3, sn = pm >> 3, k1t = pm & 7;
            u.A = (const char*)(ws + WS_CST) + (size_t)pm * 256 * 2048 * 2; u.B = (const char*)(ws + (sn ? WS_OT : WS_ET)) + ((size_t)b * FW + pn * 256) * 2048 * 2;
            u.C = (char*)(ws + WS_TT) + (((size_t)b * 2048 + k1t * 256) * DM + pn * 512 + sn * 128) * 2; u.ldc = DM; u.mode = sn ? 0 : 3; u.pm = k1t; u.pn = b * FW + pn * 256; u.bjs = 256;
        } else {
            int pm, q; grid_map(L - 128 + 120, 32, 4, pm, q); const int ct = 28 + q;
            u.A = (const char*)(ws + WS_H) + (size_t)pm * 256 * DM * 2; u.B = (const char*)(ws + WS_WT_IN) + (size_t)ct * 256 * DM * 2;
            u.C = (char*)(ws + WS_SGA) + ((size_t)pm * 256 * DM + (ct - 24) * 256) * 2; u.ldc = DM; u.mode = 2; u.pm = pm; u.pn = ct; u.bjs = HALF;
        }
        return true; }
    __device__ __forceinline__ unsigned arow(const Unit&, int) const { return 0u; } };
struct SchedF2 { int G, c; unsigned char* ws;
    __device__ __forceinline__ bool next(int i, Unit& u) const {
        const int L = i * G + c; if (L >= 128) return false;
        int pm, q; grid_map(L, 16, 8, pm, q); const int b = pm >> 3, k1t = pm & 7, j = q & 3, mir = q >> 2;
        u.A = (const char*)(ws + WS_TT) + (((size_t)b * 2048 + k1t * 256) * DM + j * 512) * 2; u.B = (const char*)(ws + WS_BD2) + (size_t)mir * 256 * 512 * 2;
        u.mode = 0; u.rows = 256; u.aux = 0; u.pm = pm; u.pn = j; u.bjs = HALF; u.nt = 512 / BK; u.keep = 0;
        if (!mir) { u.C = (char*)(ws + WS_YF) + (((size_t)b * SEQ + k1t * 256) * YFP + j * 256) * 2; u.ldc = YFP; u.rmin = 0; }
        else { u.C = (char*)(ws + WS_YF) + (((size_t)b * SEQ + SEQ - k1t * 256) * YFP + j * 256) * 2; u.ldc = -YFP; u.rmin = k1t == 0 ? 1 : 0; }
        return true; }
    __device__ __forceinline__ unsigned arow(const Unit&, int) const { return 0u; } };
constexpr int SCHT_OFF = LDSCTL_OFF + 1024;
__device__ __forceinline__ void moe_tables(Frame& F, int ncol_tiles) {
    LAS int* T = (LAS int*)(F.lds + SCHT_OFF);
    __syncthreads();
    if (F.tid == 0) { const int* CNT = (const int*)(F.ws + CTL_CNT); int up = 0, of = 0;
        for (int e = 0; e <= NE; ++e) { const int cn = e < NE ? CNT[e * 64] : NTOK; T[e] = up; T[80 + e] = e < NE ? of : NSLOT; T[160 + e] = cn; up += ((cn + 255) >> 8) * ncol_tiles; of += cn; }
        T[NE + 1] = up; }
    __syncthreads();
}
template <int NCT, bool FIRST> struct SchedMoe {
    int G, c; unsigned char* ws; LAS int* T; const int* TOK;
    __device__ __forceinline__ bool next(int i, Unit& u) const {
        const int L = i * G + c; if (L >= T[NE + 1]) return false;
        int lo = 0, hi = NE;
#pragma unroll 1
        while (lo < hi) { const int mid = (lo + hi + 1) >> 1; if (T[mid] <= L) lo = mid; else hi = mid - 1; }
        const int e = lo, cn = T[160 + e], ntile = (cn + 255) >> 8, local = L - T[e], ct = local / ntile, mt = local % ntile, slot0 = T[80 + e] + mt * 256;
        u.rows = (cn - mt * 256) < 256 ? (cn - mt * 256) : 256; u.aux = slot0; u.pm = mt; u.pn = ct; u.bjs = HALF; u.mode = 0; u.rmin = 0; u.e = e; u.nt = (FIRST ? DM : EFF) / BK; u.keep = 0;
        if (FIRST) { u.A = (const char*)(ws + WS_H2); u.B = (const char*)(ws + WS_WT_GU) + ((size_t)e * 4 + ct) * 256 * DM * 2; u.C = (char*)(ws + WS_ACT) + ((size_t)slot0 * EFF + ct * 128) * 2; u.ldc = EFF; }
        else { u.A = (const char*)(ws + WS_ACT) + (size_t)slot0 * EFF * 2; u.B = (const char*)(ws + WS_WT_D) + ((size_t)e * DM + ct * 256) * EFF * 2; u.C = (char*)(ws + WS_YBIG) + ((size_t)slot0 * DM + ct * 256) * 2; u.ldc = DM; }
        return true; }
    __device__ __forceinline__ unsigned arow(const Unit& u, int r) const { const int rr = u.pm * 256 + (r < u.rows ? r : u.rows - 1); const int tok = u.e < NE ? TOK[u.e * NTOK + rr] : rr; return (unsigned)tok * (unsigned)(DM * 2); } };

namespace attn {
using s16x4 = __attribute__((ext_vector_type(4))) short;
using f32x8 = __attribute__((ext_vector_type(8))) float;
constexpr int D = 128, NW = 8, QBLK = 32, KVBLK = 64;
constexpr float SCALE = 0.088388347648318440f;
constexpr float THR = 8.f;
constexpr int LDQ = DM, LDK = KVW, LDO = DM;
constexpr size_t SHM_V = KVBLK * D * 2, SHM_K = KVBLK * D * 2, SHM_ATTN = 2 * SHM_V + 2 * SHM_K + NW * 64 * 4;
#define KSWZ(row, colB) ((row) * 256 + ((colB) ^ (((row) & 7) << 4)))
#define SBAR() __builtin_amdgcn_sched_barrier(0)
__device__ __forceinline__ unsigned cvtpk(float lo, float hi) { unsigned r; asm volatile("v_cvt_pk_bf16_f32 %0, %1, %2" : "=v"(r) : "v"(lo), "v"(hi)); return r; }
__device__ __forceinline__ void partialSM(f32x16& p0, f32x16& p1, float& m_reg, float& mn, float& alpha) {
  constexpr float C = SCALE * 1.4426950408889634f;
  float pmax = p0[0]; for (int r = 1; r < 16; ++r) pmax = fmaxf(pmax, p0[r]); for (int r = 0; r < 16; ++r) pmax = fmaxf(pmax, p1[r]);
  { auto rr = __builtin_amdgcn_permlane32_swap(__float_as_uint(pmax), __float_as_uint(pmax), false, false);
    pmax = fmaxf(__uint_as_float(rr[0]), __uint_as_float(rr[1])); }
  if (__builtin_expect(__all(pmax - m_reg <= THR / SCALE), 1)) { mn = m_reg; alpha = 1.f; }
  else { mn = fmaxf(m_reg, pmax); alpha = __builtin_amdgcn_exp2f((m_reg - mn) * C); m_reg = mn; }
  float mnC = -mn * C;
  for (int r = 0; r < 16; ++r) p0[r] = fmaf(p0[r], C, mnC); for (int r = 0; r < 16; ++r) p1[r] = fmaf(p1[r], C, mnC);
  for (int r = 0; r < 16; ++r) p0[r] = __builtin_amdgcn_exp2f(p0[r]);
}
__device__ __forceinline__ void finishSM(f32x16& p0, f32x16& p1, float alpha, float& l_reg, bf16x8& pa0, bf16x8& pa1, bf16x8& pa2, bf16x8& pa3) {
  for (int r = 0; r < 16; ++r) p1[r] = __builtin_amdgcn_exp2f(p1[r]);
  float ps = 0; for (int r = 0; r < 16; ++r) ps += p0[r]; for (int r = 0; r < 16; ++r) ps += p1[r];
  { auto rr = __builtin_amdgcn_permlane32_swap(__float_as_uint(ps), __float_as_uint(ps), false, false);
    ps = __uint_as_float(rr[0]) + __uint_as_float(rr[1]); }
  l_reg = l_reg * alpha + ps;
#define PK4(P, BASE, OUT) do { unsigned a0 = cvtpk(P[BASE + 0], P[BASE + 1]), a1 = cvtpk(P[BASE + 2], P[BASE + 3]);   \
    unsigned b0 = cvtpk(P[BASE + 4], P[BASE + 5]), b1 = cvtpk(P[BASE + 6], P[BASE + 7]);                              \
    auto r0 = __builtin_amdgcn_permlane32_swap(a0, b0, false, false); auto r1 = __builtin_amdgcn_permlane32_swap(a1, b1, false, false); \
    u32x4 w = {r0[0], r1[0], r0[1], r1[1]}; OUT = *reinterpret_cast<bf16x8*>(&w); } while (0)
  PK4(p0, 0, pa0); PK4(p0, 8, pa1); PK4(p1, 0, pa2); PK4(p1, 8, pa3);
#undef PK4
}
__device__ __forceinline__ void qkt(f32x16& p0, f32x16& p1, const bf16_t* Ks, const bf16x8* qr, int r32, int hi) {
  p0 = f32x16{}; p1 = f32x16{};
  for (int d0 = 0; d0 < 8; ++d0) { int cb = (d0 * 16 + hi * 8) * 2;
    bf16x8 b0 = *reinterpret_cast<const bf16x8*>((const char*)Ks + KSWZ(r32, cb));
    bf16x8 b1 = *reinterpret_cast<const bf16x8*>((const char*)Ks + KSWZ(32 + r32, cb));
    p0 = __builtin_amdgcn_mfma_f32_32x32x16_bf16(b0, qr[d0], p0, 0, 0, 0);
    p1 = __builtin_amdgcn_mfma_f32_32x32x16_bf16(b1, qr[d0], p1, 0, 0, 0); }
}
__device__ __forceinline__ int v_st(int k, int c) { const int kk = (k & ~0xC) | ((k & 4) << 1) | ((k & 8) >> 1); return ((kk >> 3) * 4 + (c >> 5)) * 512 + ((kk & 7) * 32 + (c & 31)) * 2; }
__device__ __forceinline__ int v_rd_base(int lane) { return ((lane & 3) << 3) | (((lane >> 2) & 3) << 6) | (((lane >> 4) & 1) << 5) | (((lane >> 5) & 1) << 8); }
constexpr int v_rd_off(int d0, int ks, int half) { return d0 * 512 + ks * 4096 + half * 2048; }
template <int OFF> __device__ __forceinline__ s16x4 tr_read(int vb) {
  s16x4 r; asm volatile("ds_read_b64_tr_b16 %0, %1 offset:%2" : "=&v"(r) : "v"(vb), "i"(OFF) : "memory"); return r;
}
template <int D0> __device__ __forceinline__ void pv_one(f32x16& od, int vb, bf16x8 pa0, bf16x8 pa1, bf16x8 pa2, bf16x8 pa3) {
  const s16x4 l0 = tr_read<v_rd_off(D0, 0, 0)>(vb), h0 = tr_read<v_rd_off(D0, 0, 1)>(vb), l1 = tr_read<v_rd_off(D0, 1, 0)>(vb), h1 = tr_read<v_rd_off(D0, 1, 1)>(vb);
  const s16x4 l2 = tr_read<v_rd_off(D0, 2, 0)>(vb), h2 = tr_read<v_rd_off(D0, 2, 1)>(vb), l3 = tr_read<v_rd_off(D0, 3, 0)>(vb), h3 = tr_read<v_rd_off(D0, 3, 1)>(vb);
  asm volatile("s_waitcnt lgkmcnt(0)" ::: "memory"); SBAR();
#define PK(L, H) (bf16x8){L[0], L[1], L[2], L[3], H[0], H[1], H[2], H[3]}
  od = __builtin_amdgcn_mfma_f32_32x32x16_bf16(pa0, PK(l0, h0), od, 0, 0, 0);
  od = __builtin_amdgcn_mfma_f32_32x32x16_bf16(pa1, PK(l1, h1), od, 0, 0, 0);
  od = __builtin_amdgcn_mfma_f32_32x32x16_bf16(pa2, PK(l2, h2), od, 0, 0, 0);
  od = __builtin_amdgcn_mfma_f32_32x32x16_bf16(pa3, PK(l3, h3), od, 0, 0, 0);
#undef PK
}
__device__ __forceinline__ void pv_d0(f32x16* o, int vb, bf16x8 pa0, bf16x8 pa1, bf16x8 pa2, bf16x8 pa3) {
  pv_one<0>(o[0], vb, pa0, pa1, pa2, pa3); pv_one<1>(o[1], vb, pa0, pa1, pa2, pa3); pv_one<2>(o[2], vb, pa0, pa1, pa2, pa3); pv_one<3>(o[3], vb, pa0, pa1, pa2, pa3);
}
__device__ __forceinline__ void attn_dense_body(const bf16_t* __restrict__ Qb, const bf16_t* __restrict__ Kh, const bf16_t* __restrict__ Vh, bf16_t* __restrict__ Ob, int seq, char* lds) {
  const int tid = threadIdx.x, wid = tid >> 6, lane = tid & 63, r32 = lane & 31, hi = lane >> 5;
  bf16_t* V_lds = (bf16_t*)lds; bf16_t* K_lds = (bf16_t*)(lds + 2 * SHM_V);
  float* ws = (float*)(lds + 2 * SHM_V + 2 * SHM_K) + wid * 64; float* li_l = ws; float* al_l = ws + 32;
  float m_reg = -1e30f, l_reg = 0; f32x16 o[4] = {}; bf16x8 qr[8];
  const bf16_t* Qw = Qb + (long)(wid * QBLK + r32) * LDQ + hi * 8;
#pragma unroll
  for (int d0 = 0; d0 < 8; ++d0) qr[d0] = *reinterpret_cast<const bf16x8*>(Qw + d0 * 16);
  const int sr = tid >> 4, sc = (tid & 15) * 8, vst0 = v_st(sr, sc), vst1 = v_st(32 + sr, sc);
  const int vb0 = (int)(uintptr_t)V_lds + v_rd_base(lane);
  struct { bf16x8 vs0, vs1, ks0, ks1; } sr_[2];
#define SLOAD(i, k0) do { sr_[i].vs0 = *reinterpret_cast<const bf16x8*>(&Vh[(long)((k0) + sr) * LDK + sc]); sr_[i].vs1 = *reinterpret_cast<const bf16x8*>(&Vh[(long)((k0) + 32 + sr) * LDK + sc]); \
    sr_[i].ks0 = *reinterpret_cast<const bf16x8*>(&Kh[(long)((k0) + sr) * LDK + sc]); sr_[i].ks1 = *reinterpret_cast<const bf16x8*>(&Kh[(long)((k0) + 32 + sr) * LDK + sc]); } while (0)
#define SWRITE(b, i) do { *(bf16x8*)((char*)V_lds + (b) * SHM_V + vst0) = sr_[i].vs0;          \
    *(bf16x8*)((char*)V_lds + (b) * SHM_V + vst1) = sr_[i].vs1; int kc = sc * 2;               \
    *(bf16x8*)((char*)K_lds + (b) * SHM_K + KSWZ(sr, kc)) = sr_[i].ks0;                       \
    *(bf16x8*)((char*)K_lds + (b) * SHM_K + KSWZ(32 + sr, kc)) = sr_[i].ks1; } while (0)
#define SWAIT() asm volatile("s_waitcnt vmcnt(4)" ::: "memory")
#define RESC(a) do { if (__any((a) < 1.f)) { if (hi == 0) al_l[r32] = (a); asm volatile("s_waitcnt lgkmcnt(0)" ::: "memory"); \
    for (int d = 0; d < 4; ++d) for (int r = 0; r < 16; ++r) o[d][r] *= al_l[crow(r, hi)]; } } while (0)
  f32x16 pA0, pA1, pB0, pB1; float mnA, mnB, alA, alB; bf16x8 pa0, pa1, pa2, pa3; const int NT = seq / KVBLK;
  constexpr int SE = 0, SO = 1;
  SLOAD(SE, 0); asm volatile("s_waitcnt vmcnt(0)" ::: "memory"); SWRITE(0, SE); __syncthreads();
  qkt(pA0, pA1, K_lds, qr, r32, hi); partialSM(pA0, pA1, m_reg, mnA, alA);
  SLOAD(SO, KVBLK); if (2 < NT) SLOAD(SE, 2 * KVBLK);
  SWAIT(); SWRITE(1, SO); __syncthreads();
  for (int j = 1; j + 1 < NT; j += 2) {
    SBAR(); qkt(pB0, pB1, (bf16_t*)((char*)K_lds + SHM_K), qr, r32, hi);
    finishSM(pA0, pA1, alA, l_reg, pa0, pa1, pa2, pa3); SBAR();
    SLOAD(SO, (j + 2) * KVBLK); SBAR();
    pv_d0(o, vb0, pa0, pa1, pa2, pa3); partialSM(pB0, pB1, m_reg, mnB, alB);
    __syncthreads(); SWAIT(); SWRITE(0, SE);
    RESC(alB); __syncthreads();
    SBAR(); qkt(pA0, pA1, K_lds, qr, r32, hi);
    finishSM(pB0, pB1, alB, l_reg, pa0, pa1, pa2, pa3); SBAR();
    if (j + 3 < NT) SLOAD(SE, (j + 3) * KVBLK); SBAR();
    pv_d0(o, vb0 + (int)SHM_V, pa0, pa1, pa2, pa3); partialSM(pA0, pA1, m_reg, mnA, alA);
    __syncthreads(); SWAIT(); SWRITE(1, SO);
    RESC(alA); __syncthreads();
  }
  SBAR(); qkt(pB0, pB1, (bf16_t*)((char*)K_lds + SHM_K), qr, r32, hi);
  finishSM(pA0, pA1, alA, l_reg, pa0, pa1, pa2, pa3); SBAR();
  pv_d0(o, vb0, pa0, pa1, pa2, pa3); partialSM(pB0, pB1, m_reg, mnB, alB);
  __syncthreads(); RESC(alB);
  finishSM(pB0, pB1, alB, l_reg, pa0, pa1, pa2, pa3); SBAR();
  pv_d0(o, vb0 + (int)SHM_V, pa0, pa1, pa2, pa3);
  if (hi == 0) li_l[r32] = l_reg; asm volatile("s_waitcnt lgkmcnt(0)" ::: "memory");
  float rli[16];
#pragma unroll
  for (int r = 0; r < 16; ++r) rli[r] = __builtin_amdgcn_rcpf(li_l[crow(r, hi)]);
  bf16_t* Ow = Ob + (long)(wid * QBLK) * LDO;
#pragma unroll
  for (int r = 0; r < 16; ++r) { int orow = crow(r, hi);
    for (int d0 = 0; d0 < 4; ++d0) Ow[(long)orow * LDO + d0 * 32 + r32] = f2bf(o[d0][r] * rli[r]); }
#undef SLOAD
#undef SWRITE
#undef SWAIT
#undef RESC
}
#undef KSWZ
#undef SBAR
}

__device__ __forceinline__ void ph_norm1(Frame& F, const Args& args, const float* mod) {
    const int gw = F.vcu * NWAVES + F.wave, NGW = F.G * NWAVES, lane = F.lane;
    bf16_t* H = (bf16_t*)(F.ws + WS_H); const float* nw = args.in[6];
    for (int row = gw; row < NTOK + NCTX; row += NGW) {
        const float* src = row < NTOK ? args.in[0] + (size_t)row * DM : args.in[2] + (size_t)(row - NTOK) * DM;
        const float* mr = mod + (row < NTOK ? row / SEQ : 2) * MODC;
        f32x4 v[8]; float ss = 0.f;
#pragma unroll
        for (int j = 0; j < 8; ++j) { v[j] = *(const GAS f32x4*)(src + (j * 64 + lane) * 4); ss += v[j].x * v[j].x + v[j].y * v[j].y + v[j].z * v[j].z + v[j].w * v[j].w; }
        ss = wave_sum(ss);
        const float rstd = 1.0f / sqrtf(ss * (1.0f / DM) + 1e-6f);
#pragma unroll
        for (int j = 0; j < 8; ++j) { const int i = (j * 64 + lane) * 4;
            const f32x4 w = *(const GAS f32x4*)(nw + i), sc = *(const GAS f32x4*)(mr + DM + i), sh = *(const GAS f32x4*)(mr + i);
            const f32x4 h = v[j] * rstd * w * (sc + 1.0f) + sh;
            unsigned lo = cvt_pk_bf16(h[0], h[1]), hi = cvt_pk_bf16(h[2], h[3]);
            *(GAS unsigned long long*)(H + (size_t)row * DM + i) = (unsigned long long)lo | ((unsigned long long)hi << 32); }
    }
}
__device__ __forceinline__ void ph_evenodd(Frame& F, const Args& args) {
    const int gw = F.vcu * NWAVES + F.wave, NGW = F.G * NWAVES, lane = F.lane;
    LAS bf16_t* scr = (LAS bf16_t*)(F.lds + F.wave * 16640);
    const bf16_t* UT = (const bf16_t*)(F.ws + WS_UT); bf16_t* ET = (bf16_t*)(F.ws + WS_ET); bf16_t* OT = (bf16_t*)(F.ws + WS_OT);
    float* W2 = (float*)(F.ws + WS_W2048); float* AL = (float*)(F.ws + WS_ALT);
    for (int row = gw; row < 2 * FW; row += NGW) {
        const bf16_t* src = UT + (size_t)row * SEQ; float alt = 0.f;
#pragma unroll
        for (int j = 0; j < 8; ++j) { const u32x4 w = *(const GAS u32x4*)(src + (j * 64 + lane) * 8); *(LAS u32x4*)(scr + (j * 64 + lane) * 8) = w;
            float f[8]; unpack8(w, f); alt += (f[0] - f[1]) + (f[2] - f[3]) + (f[4] - f[5]) + (f[6] - f[7]); }
        alt = wave_sum(alt);
        LDS_WAIT(); asm volatile("" ::: "memory");
        if (lane == 0) { AL[row] = alt; W2[row] = bf2f(scr[SEQ / 2]); }
#pragma unroll
        for (int j = 0; j < 4; ++j) { const int n0 = (j * 64 + lane) * 8; float e[8], o[8];
#pragma unroll
            for (int i = 0; i < 8; ++i) { const int n = n0 + i; const float a = bf2f(scr[n]), bb = bf2f(scr[(SEQ - n) & (SEQ - 1)]); e[i] = n == 0 ? a : a + bb; o[i] = n == 0 ? 0.f : a - bb; }
            u32x4 we, wo; we.x = cvt_pk_bf16(e[0], e[1]); we.y = cvt_pk_bf16(e[2], e[3]); we.z = cvt_pk_bf16(e[4], e[5]); we.w = cvt_pk_bf16(e[6], e[7]);
            wo.x = cvt_pk_bf16(o[0], o[1]); wo.y = cvt_pk_bf16(o[2], o[3]); wo.z = cvt_pk_bf16(o[4], o[5]); wo.w = cvt_pk_bf16(o[6], o[7]);
            *(GAS u32x4*)(ET + (size_t)row * 2048 + n0) = we; *(GAS u32x4*)(OT + (size_t)row * 2048 + n0) = wo; }
        LDS_WAIT(); asm volatile("" ::: "memory");
    }
}
__device__ __forceinline__ void ph_route(Frame& F, const Args& args, const float* mod) {
    const int lane = F.lane, wv = F.wave, r32 = lane & 31, hi = lane >> 5;
    LAS float* rs = (LAS float*)F.lds;
    LAS float* part = (LAS float*)(F.lds + 1024);
    LAS int* lcnt = (LAS int*)(F.lds + 1024 + 65536);
    LAS int* lbase = lcnt + 64;
    LAS int* lent = lcnt + 128;
    const float* X2 = (const float*)(F.ws + WS_X2); const float* nw = args.in[13]; const float* rb = args.in[15];
    const bf16_t* RWT = (const bf16_t*)(F.ws + WS_RWT);
    bf16_t* H2 = (bf16_t*)(F.ws + WS_H2); int* EIDX = (int*)(F.ws + WS_EIDX); float* EW = (float*)(F.ws + WS_EW); int* EPOS = (int*)(F.ws + WS_EPOS); int* CNT = (int*)(F.ws + CTL_CNT); int* TOKE = (int*)(F.ws + WS_TOKE);
    if (F.tid < NE) lcnt[F.tid] = 0;
    __syncthreads();
    int nb = 0;
    for (int blk = F.vcu; blk < NTOK / 32; blk += F.G, ++nb) {
        const int row0 = blk * 32; const float* mr = mod + (row0 / SEQ) * MODC;
#pragma unroll
        for (int i = 0; i < 4; ++i) { const float* src = X2 + (size_t)(row0 + wv * 4 + i) * DM; float ss = 0.f;
#pragma unroll
            for (int j = 0; j < 8; ++j) { const f32x4 v = *(const GAS f32x4*)(src + (j * 64 + lane) * 4); ss += v.x * v.x + v.y * v.y + v.z * v.z + v.w * v.w; }
            ss = wave_sum(ss);
            if (lane == 0) rs[wv * 4 + i] = 1.0f / sqrtf(ss * (1.0f / DM) + 1e-6f); }
        __syncthreads();
        { const float rstd = rs[r32]; const float* xr = X2 + (size_t)(row0 + r32) * DM; bf16_t* hr = H2 + (size_t)(row0 + r32) * DM;
          f32x16 acc0 = {}, acc1 = {};
#pragma unroll 4
          for (int ks = 0; ks < 16; ++ks) { const int k = wv * 256 + ks * 16 + hi * 8;
              float h[8];
#pragma unroll
              for (int q = 0; q < 2; ++q) { const f32x4 x = *(const GAS f32x4*)(xr + k + 4 * q), w = *(const GAS f32x4*)(nw + k + 4 * q), sc = *(const GAS f32x4*)(mr + 4 * DM + k + 4 * q), sh = *(const GAS f32x4*)(mr + 3 * DM + k + 4 * q);
                  const f32x4 t = x * rstd * w * (sc + 1.0f) + sh; h[4 * q] = t[0]; h[4 * q + 1] = t[1]; h[4 * q + 2] = t[2]; h[4 * q + 3] = t[3]; }
              u32x4 wh, wl; float l[8];
              wh.x = cvt_pk_bf16(h[0], h[1]); wh.y = cvt_pk_bf16(h[2], h[3]); wh.z = cvt_pk_bf16(h[4], h[5]); wh.w = cvt_pk_bf16(h[6], h[7]);
#pragma unroll
              for (int i = 0; i < 4; ++i) { l[2 * i] = h[2 * i] - __uint_as_float(wh[i] << 16); l[2 * i + 1] = h[2 * i + 1] - __uint_as_float(wh[i] & 0xffff0000u); }
              wl.x = cvt_pk_bf16(l[0], l[1]); wl.y = cvt_pk_bf16(l[2], l[3]); wl.z = cvt_pk_bf16(l[4], l[5]); wl.w = cvt_pk_bf16(l[6], l[7]);
              *(GAS u32x4*)(hr + k) = wh;
              const bf16x8 ah = __builtin_bit_cast(bf16x8, wh), al = __builtin_bit_cast(bf16x8, wl);
              const bf16x8 bh0 = *(const GAS bf16x8*)(RWT + (size_t)r32 * DM + k), bh1 = *(const GAS bf16x8*)(RWT + (size_t)(32 + r32) * DM + k);
              const bf16x8 bl0 = *(const GAS bf16x8*)(RWT + (size_t)(NE + r32) * DM + k), bl1 = *(const GAS bf16x8*)(RWT + (size_t)(NE + 32 + r32) * DM + k);
              acc0 = __builtin_amdgcn_mfma_f32_32x32x16_bf16(ah, bh0, acc0, 0, 0, 0); acc0 = __builtin_amdgcn_mfma_f32_32x32x16_bf16(ah, bl0, acc0, 0, 0, 0); acc0 = __builtin_amdgcn_mfma_f32_32x32x16_bf16(al, bh0, acc0, 0, 0, 0);
              acc1 = __builtin_amdgcn_mfma_f32_32x32x16_bf16(ah, bh1, acc1, 0, 0, 0); acc1 = __builtin_amdgcn_mfma_f32_32x32x16_bf16(ah, bl1, acc1, 0, 0, 0); acc1 = __builtin_amdgcn_mfma_f32_32x32x16_bf16(al, bh1, acc1, 0, 0, 0); }
#pragma unroll
          for (int r = 0; r < 16; ++r) { part[(wv * 32 + crow(r, hi)) * 64 + r32] = acc0[r]; part[(wv * 32 + crow(r, hi)) * 64 + 32 + r32] = acc1[r]; } }
        __syncthreads();
        for (int i = 0; i < 4; ++i) { const int rbk = wv * 4 + i, row = row0 + rbk; float logit = 0.f;
#pragma unroll
          for (int w = 0; w < 8; ++w) logit += part[(w * 32 + rbk) * 64 + lane];
          const float score = 1.0f / (1.0f + expf(-logit)), bsd = score + rb[lane];
          const int g = lane >> 3;
          int rk = 0;
#pragma unroll
          for (int q = 0; q < 8; ++q) { const int o = (lane & ~7) + q; const float vv = __shfl(bsd, o); rk += (vv > bsd) || (vv == bsd && o < lane); }
          float gs = rk < 2 ? bsd : 0.f;
          gs += __shfl_xor(gs, 1); gs += __shfl_xor(gs, 2); gs += __shfl_xor(gs, 4);
          int grk = 0;
#pragma unroll
          for (int gg = 0; gg < 8; ++gg) { const float vv = __shfl(gs, gg * 8); grk += (vv > gs) || (vv == gs && gg < g); }
          const bool gsel = grk < 4;
          const float mb = gsel ? bsd : -INFINITY;
          int erk = 0;
          for (int o = 0; o < 64; ++o) { const float vv = __shfl(mb, o); erk += (vv > mb) || (vv == mb && o < lane); }
          const bool sel = gsel && erk < TOPK;
          const float ssum = wave_sum(sel ? score : 0.f);
          if (sel) { const int lp = __hip_atomic_fetch_add(lcnt + lane, 1, __ATOMIC_RELAXED, __HIP_MEMORY_SCOPE_WORKGROUP);
                     EIDX[row * TOPK + erk] = lane; EW[row * TOPK + erk] = score / ssum * 2.5f; lent[(nb * 32 + rbk) * TOPK + erk] = (lane << 16) | lp; } }
        __syncthreads();
    }
    if (F.tid < NE) { const int c = lcnt[F.tid]; lbase[F.tid] = c ? atomicAdd(&CNT[F.tid * 64], c) : 0; }
    __syncthreads();
    for (int i = F.tid; i < nb * 256; i += NTHREADS) { const int blk = F.vcu + (i >> 8) * F.G, row = blk * 32 + ((i >> 3) & 31), v = lent[i]; const int pos = lbase[v >> 16] + (v & 0xffff); EPOS[row * TOPK + (i & 7)] = pos; TOKE[(v >> 16) * NTOK + pos] = row; }
    __syncthreads();
}
__device__ __forceinline__ void ph_comb(Frame& F, const Args& args, const float* mod) {
    const int gw = F.vcu * NWAVES + F.wave, NGW = F.G * NWAVES, lane = F.lane;
    moe_tables(F, 4);
    LAS int* T = (LAS int*)(F.lds + SCHT_OFF);
    const float* EW = (const float*)(F.ws + WS_EW); const int* EIDX = (const int*)(F.ws + WS_EIDX); const int* EPOS = (const int*)(F.ws + WS_EPOS); const bf16_t* Y = (const bf16_t*)(F.ws + WS_YBIG);
    for (int t = gw; t < NTOK; t += NGW) {
        const float* g2 = mod + (t / SEQ) * MODC + 5 * DM;
        int sl[TOPK]; float wk[TOPK];
#pragma unroll
        for (int k = 0; k < TOPK; ++k) { sl[k] = T[80 + EIDX[t * TOPK + k]] + EPOS[t * TOPK + k]; wk[k] = EW[t * TOPK + k]; }
#pragma unroll
        for (int j = 0; j < 4; ++j) { const int col = j * 512 + lane * 8;
            float a[8]; unpack8(*(const GAS u32x4*)(Y + (size_t)(NSLOT + t) * DM + col), a);
#pragma unroll
            for (int k = 0; k < TOPK; ++k) { float y[8]; unpack8(*(const GAS u32x4*)(Y + (size_t)sl[k] * DM + col), y);
#pragma unroll
                for (int c = 0; c < 8; ++c) a[c] += wk[k] * y[c]; }
            float* o = args.out + (size_t)t * DM + col; const float* xi = (const float*)(F.ws + WS_X2) + (size_t)t * DM + col;
#pragma unroll
            for (int n = 0; n < 2; ++n) { const f32x4 xv = *(const GAS f32x4*)(xi + 4 * n), gv = *(const GAS f32x4*)(g2 + col + 4 * n);
                *(GAS f32x4*)(o + 4 * n) = xv + gv * (f32x4){a[4 * n], a[4 * n + 1], a[4 * n + 2], a[4 * n + 3]}; } }
    }
}

enum { PH_PRO = 0, PH_NORM1, PH_INPROJ, PH_QKNORM, PH_ATTN, PH_F2, PH_MERGE, PH_OUT, PH_ROUTE, PH_EXP1, PH_EXP2, PH_COMB, PH_END };


__global__ void __launch_bounds__(NTHREADS, 2) fwd(Args args) {
    extern __shared__ __attribute__((aligned(16))) unsigned char lds_raw[];
    Frame F;
    F.lds = (LAS unsigned char*)lds_raw; F.MISC = (volatile LAS unsigned*)(F.lds + MISC_OFF); F.ws = args.ws;
    F.tid = threadIdx.x; F.lane = F.tid & 63; F.wave = __builtin_amdgcn_readfirstlane(F.tid >> 6);
    F.G = gridDim.x; { const int bx = blockIdx.x; F.vcu = (F.G % 8 == 0) ? (bx % 8) * (F.G / 8) + bx / 8 : bx; }
    for (int u = F.tid; u < (LDS_BYTES - LDSCTL_OFF) / 4; u += NTHREADS) ((LAS unsigned*)(F.lds + LDSCTL_OFF))[u] = 0u;
    __syncthreads();
    const int lo = args.ph_lo, hi = args.ph_hi;
    const bool multi = (hi - lo) > 1;
    unsigned* barw = (unsigned*)(args.ws + CTL_BAR) + args.bar_idx * XCD_BAR_WORDS;
    XcdBarrier bar; bar.bar = barw; bar.x = 0; bar.st = nullptr;
    if (multi) bar = xcd_barrier_post(barw, F.MISC + 8);
#define IN(k) (lo <= (k) && (k) < hi)
#define SEAM(k) do { if (IN((k) + 1)) xcd_barrier(bar); } while (0)

    const float* modp = (const float*)(args.ws + args.mod_off);
    if (IN(PH_PRO)) { p0_prologue(F, args); SEAM(PH_PRO); }
    if (IN(PH_NORM1)) { ph_norm1(F, args, modp); SEAM(PH_NORM1); }
    if (IN(PH_INPROJ)) {
        SchedIn S{F.G, (int)blockIdx.x, args.ws, args.use_ut};
        EpiIn E{EpiStore{(const float*)(args.ws + WS_W2048)}, (LAS float*)(F.lds + GPARK_OFF), args.in[8], args.in[9], (const float*)(args.ws + WS_ROPE)};
        gemm_phase<EpiIn, SchedIn, false>(F.lds, DM, DM, DM, S, E);
        SEAM(PH_INPROJ);
    }
    if (IN(PH_QKNORM)) { ph_evenodd(F, args); SEAM(PH_QKNORM); }
    if (IN(PH_ATTN)) {
        const int cs = F.vcu & 3;
        constexpr int NCONV = IT_EG + IT_EU + IT_ED;
        int qfirst, qcnt; { const int c = (int)blockIdx.x; if (F.G == 256) { qfirst = c < 136 ? c * 162 : 136 * 162 + (c - 136) * 226; qcnt = c < 136 ? 162 : 226; }
                             else { const int per = (NCONV + F.G - 1) / F.G; qfirst = c * per; qcnt = qfirst + per <= NCONV ? per : (NCONV - qfirst > 0 ? NCONV - qfirst : 0); } }
        const int gcnt = qfirst < IT_EG + IT_EU ? (qfirst + qcnt <= IT_EG + IT_EU ? qcnt : IT_EG + IT_EU - qfirst) : 0, gfirst = qfirst;
        const int ccnt = qcnt - gcnt, cfirst = qfirst + gcnt - (IT_EG + IT_EU);
#define CONV_ALL() do { conv_items(F, args, false, gfirst, gcnt); conv_items(F, args, true, cfirst, ccnt); } while (0)
        const bf16_t* Qp = (const bf16_t*)(args.ws + WS_Q); const bf16_t* Kp = (const bf16_t*)(args.ws + WS_KALL); const bf16_t* Vp = (const bf16_t*)(args.ws + WS_VALL); bf16_t* Op = (bf16_t*)(args.ws + WS_YA);
#define ATTN_UNIT(lin_) do { const int lin = (lin_); if (lin < 512) { const int x = (lin >> 5) & 7, j = (lin & 31) + 32 * (lin >> 8), b = x >> 2, kvh = x & 3, head = kvh * 4 + (j >> 4), qb = j & 15; \
            const size_t qo = ((size_t)(b * SEQ + qb * 256)) * DM + head * HD, ko = (size_t)b * SKV * KVW + kvh * HD; \
            attn::attn_dense_body(Qp + qo, Kp + ko, Vp + ko, Op + qo, SKV, (char*)lds_raw); __syncthreads(); } } while (0)
        if (cs == 0) { CONV_ALL(); __syncthreads(); }
        ATTN_UNIT(F.vcu);
        if (cs == 1) { CONV_ALL(); __syncthreads(); }
        ATTN_UNIT(F.vcu + F.G);
        for (int lin2 = F.vcu + 2 * F.G; lin2 < 512; lin2 += F.G) ATTN_UNIT(lin2);
        if (cs == 2) { CONV_ALL(); __syncthreads(); }
#undef ATTN_UNIT
        SchedAG S{F.G, (int)blockIdx.x, args.ws};
        gemm_phase<EpiStore, SchedAG, false>(F.lds, DM, DM, DM, S, EpiStore{(const float*)(args.ws + WS_W2048)});
        if (cs == 3) { __syncthreads(); CONV_ALL(); }
#undef CONV_ALL
        SEAM(PH_ATTN);
    }
    if (IN(PH_F2)) {
        SchedF2 S{F.G, (int)blockIdx.x, args.ws};
        gemm_phase<EpiStore, SchedF2, false>(F.lds, 512, DM, 512, S, EpiStore{(const float*)(args.ws + WS_W2048)});
        {
            const int idx = F.vcu * NTHREADS + F.tid;
            if (idx < 2 * FW) { const int b = idx >> 10, col = idx & 1023, k2 = col & 127; const float* al = (const float*)(args.ws + WS_ALT) + b * FW + (col & ~127); float s = 0.f;
                for (int c = 0; c < 128; ++c) s += al[c] * cospif((float)((c * k2) & 127) * (1.0f / 64.0f));
                ((bf16_t*)(args.ws + WS_YF))[((size_t)b * SEQ + SEQ / 2) * YFP + col] = f2bf(s * 0.0013810679320049757f); }
        }
        SEAM(PH_F2);
    }
    if (IN(PH_MERGE)) {
        unsigned char* ws = args.ws;
        SchedMerge S{F.G, (int)blockIdx.x, ws};
        gemm_phase<EpiMerge, SchedMerge, false>(F.lds, DM, DM, DM, S, EpiMerge{(const bf16_t*)(ws + WS_SGF), (const bf16_t*)(ws + WS_SGA), (bf16_t*)(ws + WS_YM)});
        SEAM(PH_MERGE);
    }
    if (IN(PH_OUT)) {
        unsigned char* ws = args.ws;
        SchedGrid S{F.G, (int)blockIdx.x, 32, 8, (const char*)(ws + WS_YM), (const char*)(ws + WS_WT_O), nullptr, (size_t)256 * DM * 2, (size_t)256 * DM * 2, DM, 4, 1, DM / BK};
        gemm_phase<EpiX2, SchedGrid, false>(F.lds, DM, DM, DM, S, EpiX2{args.in[0], modp, (float*)(ws + WS_X2)});
        SEAM(PH_OUT);
    }
    if (IN(PH_ROUTE)) { ph_route(F, args, modp); SEAM(PH_ROUTE); }
    if (IN(PH_EXP1)) {
        moe_tables(F, 4);
        SchedMoe<4, true> S{F.G, F.vcu, args.ws, (LAS int*)(F.lds + SCHT_OFF), (const int*)(args.ws + WS_TOKE)};
        gemm_phase<EpiAct, SchedMoe<4, true>, true>(F.lds, DM, DM, DM, S, EpiAct{});
        SEAM(PH_EXP1);
    }
    if (IN(PH_EXP2)) {
        moe_tables(F, 8);
        SchedMoe<8, false> S{F.G, F.vcu, args.ws, (LAS int*)(F.lds + SCHT_OFF), (const int*)(args.ws + WS_TOKE)};
        gemm_phase<EpiStore, SchedMoe<8, false>, false>(F.lds, EFF, EFF, EFF, S, EpiStore{(const float*)(args.ws + WS_W2048)});
        SEAM(PH_EXP2);
    }
    if (IN(PH_COMB)) { ph_comb(F, args, modp); }
#undef IN
#undef SEAM
}
}

extern "C" void kernel_launch(void* const* d_in, const int* in_sizes, int n_in, void* d_out, int out_size, void* d_ws, size_t ws_size, hipStream_t stream) {
    if (n_in != 22 || ws_size < WS_END2) return;
    float* out = (float*)d_out;
    unsigned char* ws = (unsigned char*)d_ws;
    hipMemsetAsync(ws + WS_CTL, 0, CTL_ZERO_BYTES, stream);
    static int grid = 0;
    if (!grid) {
        int dev = 0, cus = 0;
        if (hipGetDevice(&dev) != hipSuccess || hipDeviceGetAttribute(&cus, hipDeviceAttributeMultiprocessorCount, dev) != hipSuccess) { grid = -1; return; }
        if (hipFuncSetAttribute((const void*)mk::fwd, hipFuncAttributeMaxDynamicSharedMemorySize, mk::LDS_BYTES) != hipSuccess) { grid = -1; return; }
        grid = cus;
    }
    if (grid < 0) return;
    mk::Args a{}; int nlaunch = 0;
    for (int i = 0; i < 22; ++i) a.in[i] = (const float*)d_in[i];
    a.out = out; a.ws = ws; a.use_ut = 1; a.mod_off = (int)WS_MOD; a.do_attn = 1;
#define MK_LAUNCH(lo_, hi_) do { a.ph_lo = (lo_); a.ph_hi = (hi_); a.bar_idx = nlaunch++; hipLaunchKernelGGL(mk::fwd, dim3(grid), dim3(mk::NTHREADS), mk::LDS_BYTES, stream, a); } while (0)
    MK_LAUNCH(mk::PH_PRO, mk::PH_END);
}
```

```cpp
#include <hip/hip_runtime.h>
#include <stdint.h>
#include <math.h>

typedef unsigned short bf16_t;
typedef short bf16x8 __attribute__((ext_vector_type(8)));
typedef float f32x16 __attribute__((ext_vector_type(16)));
typedef float f32x4 __attribute__((ext_vector_type(4)));

constexpr int NB = 2, SEQ = 4096, DM = 2048, NTOK = NB * SEQ, CTXL = 256, NCTX = NB * CTXL, HD = 128, NH = 16, NKV = 4;
constexpr int SKV = SEQ + CTXL;
constexpr int FW = 1024, INC = 8192, Q_OFF = 1024, K_OFF = 3072, V_OFF = 3584, GF_OFF = 4096, GA_OFF = 6144;
constexpr int KVW = NKV * HD;
constexpr int NE = 64, TOPK = 8, EFF = 512, MODC = 6 * DM;
constexpr int NSLOT = NTOK * TOPK;
constexpr int NSLOT_ALL = NSLOT + NTOK;

constexpr size_t MiB = 1u << 20;
constexpr size_t WS_CTL = 0, CTL_ZERO_BYTES = 1 * MiB;
constexpr size_t CTL_CNT = 64 * 1024;
constexpr size_t WS_TW = 1 * MiB;
constexpr size_t WS_MOD = 1 * MiB + 64 * 1024;
constexpr size_t WS_OFFS = 1 * MiB + 256 * 1024;
constexpr size_t WS_EIDX = 2 * MiB;
constexpr size_t WS_EW = WS_EIDX + 256 * 1024;
constexpr size_t WS_EPOS = WS_EW + 256 * 1024;
constexpr size_t WS_SLOTOF = WS_EPOS + 256 * 1024;
constexpr size_t WS_TOKE = 300 * MiB;
constexpr size_t WS_H = 4 * MiB;
constexpr size_t WS_U = 38 * MiB;
constexpr size_t WS_Q = 54 * MiB;
constexpr size_t WS_KALL = 86 * MiB;
constexpr size_t WS_VALL = 95 * MiB;
constexpr size_t WS_SGF = 104 * MiB;
constexpr size_t WS_SGA = 136 * MiB;
constexpr size_t WS_YA = 168 * MiB;
constexpr size_t WS_YF = 38 * MiB;
constexpr int YFP = 2048;
constexpr size_t WS_PR = 216 * MiB;
constexpr size_t WS_T1 = 248 * MiB;
constexpr size_t WS_YM = 312 * MiB;
constexpr size_t WS_QKRAW = 248 * MiB;
constexpr size_t WS_KCRAW = 330 * MiB;
constexpr size_t WS_H2 = 344 * MiB;
constexpr size_t WS_ACT = 376 * MiB;
constexpr size_t WS_YBIG = 4 * MiB;
constexpr size_t WS_END = 740 * MiB;

__device__ __forceinline__ float bf2f(bf16_t h) { return __uint_as_float(((unsigned)h) << 16); }
__device__ __forceinline__ bf16_t f2bf(float f) { unsigned u = __float_as_uint(f); return (bf16_t)((u + 0x7fffu + ((u >> 16) & 1u)) >> 16); }
__device__ __forceinline__ int crow(int r, int hi) { return (r & 3) + 8 * (r >> 2) + 4 * hi; }
__device__ __forceinline__ float wave_sum(float v) {
#pragma unroll
    for (int o = 1; o < 64; o <<= 1) v += __shfl_xor(v, o);
    return v;
}
__device__ __forceinline__ float sigmoidf_(float v) { return 1.0f / (1.0f + expf(-v)); }
__device__ __forceinline__ bf16x8 pack8(const float* f) {
    bf16x8 r;
#pragma unroll
    for (int i = 0; i < 8; ++i) r[i] = (short)f2bf(f[i]);
    return r;
}

#define LAS __attribute__((address_space(3)))
#define GAS __attribute__((address_space(1)))
typedef unsigned u32x4 __attribute__((ext_vector_type(4)));
typedef GAS unsigned gu32;
#define RLX_AGENT __ATOMIC_RELAXED, __HIP_MEMORY_SCOPE_AGENT
#define LDS_WAIT() asm volatile("s_waitcnt lgkmcnt(0)" ::: "memory")
#define VM_WAIT() asm volatile("s_waitcnt vmcnt(0)" ::: "memory")

constexpr size_t CTL_BAR = 16384;
constexpr size_t CTL_MODZ = 512 * 1024;
constexpr size_t WS_UT = 38 * MiB;
constexpr size_t WS_TT = 216 * MiB;
constexpr size_t WS_WT_GU = 450 * MiB;
constexpr size_t WS_WT_D = 710 * MiB;
constexpr size_t WS_WT_IN = 840 * MiB;
constexpr size_t WS_WT_FO = 924 * MiB;
constexpr size_t WS_WT_AO = 876 * MiB;
constexpr size_t WS_WT_O = 884 * MiB;
constexpr size_t WS_CST = 892 * MiB;
constexpr size_t WS_ET = 908 * MiB;
constexpr size_t WS_OT = 916 * MiB;
constexpr size_t WS_W2048 = 1 * MiB + 512 * 1024;
constexpr size_t WS_ALT = 1 * MiB + 520 * 1024;
constexpr size_t WS_ROPE = 1 * MiB + 528 * 1024;
constexpr size_t WS_RWT = 3 * MiB + 512 * 1024;
constexpr size_t WS_BD2 = 956 * MiB;
constexpr size_t WS_X2 = 960 * MiB;
constexpr size_t WS_END2 = 1024 * MiB;

namespace mk {
constexpr int NWAVES = 8, NTHREADS = 512;
constexpr int RING_BYTES = 131072, SCR_BYTES = 8 * 16640, LDSCTL_OFF = 135168, MISC_OFF = LDSCTL_OFF + 320, GPARK_OFF = LDSCTL_OFF + 2048  , LDS_BYTES = 147456;
static_assert(GPARK_OFF + 8192 <= LDS_BYTES, "LDS map");
static_assert(SCR_BYTES <= LDSCTL_OFF && MISC_OFF + 128 <= LDS_BYTES, "LDS map");

#define XB_TMO      128
#define XB_XCNT(j)  (256  + 64 * (j))
#define XB_XSUB(j)  (1280 + 64 * (j))
#define XB_XGEN(j)  (2304 + 64 * (j))
#define XB_TOP      3328
#define XB_TOPGEN   3392
#define XCD_BAR_WORDS 3456
#define XB_SPIN_CAP (1u << 18)
__device__ __forceinline__ unsigned xb_ld(unsigned* p)              { return __hip_atomic_load(p, __ATOMIC_RELAXED, __HIP_MEMORY_SCOPE_AGENT); }
__device__ __forceinline__ unsigned xb_add(unsigned* p, unsigned v) { return __hip_atomic_fetch_add(p, v, __ATOMIC_RELAXED, __HIP_MEMORY_SCOPE_AGENT); }
__device__ __forceinline__ unsigned xb_xcc_id() { return (unsigned)__builtin_amdgcn_s_getreg((3 << 11) | 20) & 0xFu; }
#define XB_SPIN(cond, bar) do { unsigned _sp = 0; while (cond) { __builtin_amdgcn_s_sleep(1); \
    if ((++_sp & 255u) == 0u) { if (xb_ld(&(bar)[XB_TMO])) break; if (_sp > XB_SPIN_CAP) { atomicAdd(&(bar)[XB_TMO], 1u); break; } } } } while (0)
struct XcdBarrier { unsigned* bar; unsigned x; volatile LAS unsigned* st; };
__device__ __forceinline__ XcdBarrier xcd_barrier_post(unsigned* bar, volatile LAS unsigned* st) {
    XcdBarrier b; b.bar = bar; b.x = xb_xcc_id(); b.st = st;
    if (threadIdx.x == 0) (void)xb_add(&bar[XB_XCNT(b.x)], 1u);
    return b;
}
__device__ __forceinline__ void xcd_barrier_complete(unsigned* bar, unsigned x, unsigned& nloc, unsigned& nx) {
    const unsigned G = gridDim.x * gridDim.y * gridDim.z;
    unsigned sum, cnt, mine, sp = 0u;
    for (;;) {
        sum = 0u; cnt = 0u; mine = 0u;
#pragma unroll
        for (unsigned j = 0; j < 16; ++j) { const unsigned c = xb_ld(&bar[XB_XCNT(j)]); sum += c; cnt += (c > 0u) ? 1u : 0u; mine = (j == x) ? c : mine; }
        if (sum == G) break;
        __builtin_amdgcn_s_sleep(1);
        if ((++sp & 255u) == 0u) { if (xb_ld(&bar[XB_TMO])) break; if (sp > XB_SPIN_CAP) { atomicAdd(&bar[XB_TMO], 1u); break; } }
    }
    nloc = mine > 0u ? mine : 1u; nx = cnt > 0u ? cnt : 1u;
}
__device__ __forceinline__ void xcd_barrier(const XcdBarrier& b) {
    asm volatile("s_waitcnt vmcnt(0)" ::: "memory");
    __syncthreads();
    if (threadIdx.x == 0) {
        unsigned* bar = b.bar;
        __builtin_amdgcn_s_waitcnt(0);
        unsigned nloc = b.st[0], nx = b.st[1];
        if (nloc == 0u) { xcd_barrier_complete(bar, b.x, nloc, nx); b.st[0] = nloc; b.st[1] = nx; }
        const unsigned old = xb_add(&bar[XB_XSUB(b.x)], 1u);
        const unsigned gen = old / nloc;
        if (old + 1u == (gen + 1u) * nloc) {
            __builtin_amdgcn_fence(__ATOMIC_RELEASE, "agent");
            asm volatile("s_waitcnt vmcnt(0)" ::: "memory");
            const unsigned og = xb_add(&bar[XB_TOP], 1u);
            const unsigned tg = og / nx;
            if (og + 1u == (tg + 1u) * nx) xb_add(&bar[XB_TOPGEN], 1u);
            else XB_SPIN(xb_ld(&bar[XB_TOPGEN]) == tg, bar);
            __builtin_amdgcn_fence(__ATOMIC_ACQUIRE, "agent");
            xb_add(&bar[XB_XGEN(b.x)], 1u);
            asm volatile("s_waitcnt vmcnt(0)" ::: "memory");
        } else {
            XB_SPIN(xb_ld(&bar[XB_XGEN(b.x)]) == gen, bar);
            __builtin_amdgcn_fence(__ATOMIC_ACQUIRE, "agent");
            asm volatile("s_waitcnt vmcnt(0)" ::: "memory");
        }
    }
    __syncthreads();
}

constexpr int BM = 256, BK = 64, HALF = 128, HTB = HALF * BK * 2, STAGE_BYTES = 8 * HTB;
__device__ __forceinline__ int lds_byte(int r, int c) { const int st = (r >> 4) * 2 + (c >> 5), rr = r & 15, cc = c & 31, ob = rr * 64 + cc * 2; return st * 1024 + (ob ^ (((ob >> 9) & 1) << 5)); }
__device__ __forceinline__ void stage_rc(int b, int& R, int& C) { const int st = b / 1024, sb = b % 1024, swz = sb ^ (((sb >> 9) & 1) << 5); R = (st >> 1) * 16 + swz / 64; C = (st & 1) * 32 + (swz % 64) / 2; }
__device__ __forceinline__ int perm32(int rho) { const int n = rho >> 4, i = rho & 15; return 8 * (i >> 2) + 4 * n + (i & 3); }
__device__ __forceinline__ unsigned cvt_pk_bf16(float lo, float hi) { unsigned r; asm("v_cvt_pk_bf16_f32 %0, %1, %2" : "=v"(r) : "v"(lo), "v"(hi)); return r; }

__device__ __forceinline__ void glds16_s(const void* sbase, unsigned voff, unsigned lds_dst) { unsigned keep;
    asm volatile("s_mov_b32 %0, m0\n\ts_mov_b32 m0, %3\n\ts_nop 0\n\tglobal_load_lds_dwordx4 %1, %2\n\ts_mov_b32 m0, %0" : "=&s"(keep) : "v"(voff), "s"(sbase), "s"(lds_dst) : "memory"); }

struct Unit { const char* A; const char* B; char* C; int ldc; int mode; int rows; int aux; int pm, pn, bjs, rmin, e, nt, keep; };

template <class Epi, class Sched, bool GATHER>
__device__ __forceinline__ void gemm_phase(LAS unsigned char* lds, const int K, const int lda, const int ldb, const Sched& S, const Epi& E, const int i0 = 0, const int i1 = 0x7fffffff) {
    const int tid = threadIdx.x, wid = __builtin_amdgcn_readfirstlane(tid >> 6), lane = tid & 63, wr = wid >> 2, wc = wid & 3, fr = lane & 15, fq = lane >> 4;
    unsigned voffA[2], voffB[2];
#pragma unroll
    for (int i = 0; i < 2; ++i) { int R, C; stage_rc(tid * 16 + i * 8192, R, C); const int Rb = (R & ~31) + perm32(R & 31);
        voffA[i] = (unsigned)(R * lda + C) * 2u; voffB[i] = (unsigned)(Rb * ldb + C) * 2u; }
    const size_t kstep = (size_t)(BK * 2);
    const size_t hstepA = (size_t)HALF * lda * 2, hstepB = (size_t)HALF * ldb * 2;
    const unsigned ldsw = (unsigned)wid * 1024u;
    const unsigned ldsbase = (unsigned)__builtin_amdgcn_readfirstlane((int)(unsigned)(uintptr_t)lds);
    const int aoff = lds_byte(wr * 64 + fr, fq * 8), boff = lds_byte(wc * 32 + fr, fq * 8);
#define MK_SA(b, h) (((b) * 2 + (h)) * HTB)
#define MK_SB(b, h) ((4 + (b) * 2 + (h)) * HTB)
#define MK_STAGE2(bufoff, gbase, v0, v1) do { \
        __builtin_amdgcn_global_load_lds((const unsigned*)((const char*)(gbase) + (v0)), (LAS unsigned*)(lds + (bufoff) + ldsw), 16, 0, 0); \
        __builtin_amdgcn_global_load_lds((const unsigned*)((const char*)(gbase) + (v1)), (LAS unsigned*)(lds + (bufoff) + ldsw + 8192), 16, 0, 0); } while (0)
#define MK_STAGE_B(bufoff, gbase) do { glds16_s((gbase), voffB[0], ldsbase + (bufoff) + ldsw); glds16_s((gbase), voffB[1], ldsbase + (bufoff) + ldsw + 8192u); } while (0)
#define MK_STAGE_A(bufoff, gbase, h, VA) do { if constexpr (GATHER) { glds16_s((gbase), (VA)[h][0], ldsbase + (bufoff) + ldsw); glds16_s((gbase), (VA)[h][1], ldsbase + (bufoff) + ldsw + 8192u); } \
        else { glds16_s((gbase) + (h) * hstepA, voffA[0], ldsbase + (bufoff) + ldsw); glds16_s((gbase) + (h) * hstepA, voffA[1], ldsbase + (bufoff) + ldsw + 8192u); } } while (0)
#define MK_LDA(dst, b, h) do { _Pragma("unroll") for (int m = 0; m < 4; ++m) _Pragma("unroll") for (int k = 0; k < 2; ++k) dst[m][k] = *(const LAS bf16x8*)(lds + MK_SA(b, h) + aoff + m * 2048 + k * 1024); } while (0)
#define MK_LDB(dst, b, h) do { _Pragma("unroll") for (int n = 0; n < 2; ++n) _Pragma("unroll") for (int k = 0; k < 2; ++k) dst[n][k] = *(const LAS bf16x8*)(lds + MK_SB(b, h) + boff + n * 2048 + k * 1024); } while (0)
#define MK_MMA(ai, bj, At, Bt) do { __builtin_amdgcn_s_setprio(1); _Pragma("unroll") for (int m = 0; m < 4; ++m) _Pragma("unroll") for (int n = 0; n < 2; ++n) _Pragma("unroll") for (int k = 0; k < 2; ++k) \
        acc[ai][bj][m][n] = __builtin_amdgcn_mfma_f32_16x16x32_bf16(Bt[n][k], At[m][k], acc[ai][bj][m][n], 0, 0, 0); __builtin_amdgcn_s_setprio(0); } while (0)
#define MK_WAIT_V(n) asm volatile("s_waitcnt vmcnt(" #n ")" ::: "memory")
#define MK_WAIT_L(n) asm volatile("s_waitcnt lgkmcnt(" #n ")" ::: "memory")
#define MK_BAR __builtin_amdgcn_s_barrier()
#define MK_SCHED __builtin_amdgcn_sched_barrier(0)
    Unit cur, nxt; int ui = i0;
    if (i0 >= i1 || !S.next(i0, cur)) return;
    f32x4 acc[2][2][4][2];
#pragma unroll
    for (int a = 0; a < 2; ++a)
#pragma unroll
        for (int b = 0; b < 2; ++b)
#pragma unroll
            for (int m = 0; m < 4; ++m)
#pragma unroll
                for (int n = 0; n < 2; ++n) acc[a][b][m][n] = (f32x4){0.f, 0.f, 0.f, 0.f};
    bf16x8 At[4][2], B0[2][2], B1[2][2];
    unsigned vC[2][2];
    LAS u32x4* vpark = (LAS u32x4*)(lds + GPARK_OFF) + tid;
    if constexpr (GATHER) {
#pragma unroll
        for (int h = 0; h < 2; ++h)
#pragma unroll
            for (int i = 0; i < 2; ++i) { int R, C; stage_rc(tid * 16 + i * 8192, R, C); vC[h][i] = S.arow(cur, h * HALF + R) + (unsigned)(C * 2); }
    }
    const char* cA = cur.A; const char* cB = cur.B;
    MK_STAGE_B(MK_SB(0, 0), cB); MK_STAGE_B(MK_SB(0, 1), cB + hstepB); MK_STAGE_A(MK_SA(0, 0), cA, 0, vC); MK_STAGE_A(MK_SA(0, 1), cA, 1, vC);
    if (wr == 1) MK_BAR;
    MK_WAIT_V(2); MK_BAR;
    MK_STAGE_B(MK_SB(1, 0), cB + kstep); MK_STAGE_A(MK_SA(1, 0), cA + kstep, 0, vC); MK_STAGE_B(MK_SB(1, 1), cB + hstepB + kstep);
    MK_WAIT_V(6); MK_BAR;
    for (;;) {
        const bool has_next = (ui + 1 < i1) && S.next(ui + 1, nxt);
        const char* nA = has_next ? nxt.A : cA; const char* nB = has_next ? nxt.B : cB;
        if constexpr (GATHER) {
            u32x4 pv;
#pragma unroll
            for (int h = 0; h < 2; ++h)
#pragma unroll
                for (int i = 0; i < 2; ++i) { int R, C; stage_rc(tid * 16 + i * 8192, R, C); pv[h * 2 + i] = has_next ? (S.arow(nxt, h * HALF + R) + (unsigned)(C * 2)) : vC[h][i]; }
            *vpark = pv;
        }
        const int nt = cur.nt;
        for (int t = 0; t < nt; t += 2) {
            const bool last = (t == nt - 2);
            const char* a1 = cA + (size_t)(t + 1) * kstep;
            const char* a2 = last ? nA : cA + (size_t)(t + 2) * kstep; const char* b2 = last ? nB : cB + (size_t)(t + 2) * kstep;
            const char* a3 = a2 + kstep; const char* b3 = b2 + kstep;
            MK_LDB(B0, 0, 0); MK_LDB(B1, 0, 1); MK_SCHED; MK_LDA(At, 0, 0); MK_STAGE_A(MK_SA(1, 1), a1, 1, vC);
            if constexpr (GATHER) { if (last) { const u32x4 pv = *vpark; vC[0][0] = pv[0]; vC[0][1] = pv[1]; vC[1][0] = pv[2]; vC[1][1] = pv[3]; } }
            MK_WAIT_V(8); MK_WAIT_L(0); MK_BAR; MK_MMA(0, 0, At, B0); MK_MMA(0, 1, At, B1); MK_BAR; MK_SCHED;
            MK_LDA(At, 0, 1); MK_STAGE_B(MK_SB(0, 0), b2); MK_STAGE_B(MK_SB(0, 1), b2 + hstepB); MK_STAGE_A(MK_SA(0, 0), a2, 0, vC);
            MK_WAIT_V(8); MK_WAIT_L(0); MK_BAR; MK_MMA(1, 0, At, B0); MK_MMA(1, 1, At, B1); MK_BAR; MK_SCHED;
            MK_LDB(B0, 1, 0); MK_LDB(B1, 1, 1); MK_SCHED; MK_LDA(At, 1, 0); MK_STAGE_A(MK_SA(0, 1), a2, 1, vC);
            MK_WAIT_V(8); MK_WAIT_L(0); MK_BAR; MK_MMA(0, 0, At, B0); MK_MMA(0, 1, At, B1); MK_BAR; MK_SCHED;
            MK_LDA(At, 1, 1); MK_STAGE_B(MK_SB(1, 0), b3); MK_STAGE_B(MK_SB(1, 1), b3 + hstepB); MK_STAGE_A(MK_SA(1, 0), a3, 0, vC);
            MK_WAIT_V(8); MK_WAIT_L(0); MK_BAR; MK_MMA(1, 0, At, B0); MK_MMA(1, 1, At, B1); MK_BAR; MK_SCHED;
        }
        if (wr == 0) MK_BAR;
        E(acc, cur, wr, wc, fr, fq);
        if (!has_next) break;
        if (!cur.keep)
#pragma unroll
        for (int a = 0; a < 2; ++a)
#pragma unroll
            for (int b = 0; b < 2; ++b)
#pragma unroll
                for (int m = 0; m < 4; ++m)
#pragma unroll
                    for (int n = 0; n < 2; ++n) acc[a][b][m][n] = (f32x4){0.f, 0.f, 0.f, 0.f};
        cur = nxt; cA = nA; cB = nB; ++ui;
        if (wr == 1) MK_BAR;
    }
    MK_WAIT_V(0);
    MK_BAR;
#undef MK_SA
#undef MK_SB
#undef MK_STAGE2
#undef MK_STAGE_B
#undef MK_STAGE_A
#undef MK_LDA
#undef MK_LDB
#undef MK_MMA
#undef MK_WAIT_V
#undef MK_WAIT_L
#undef MK_BAR
#undef MK_SCHED
}

__device__ __forceinline__ void grid_map(int L, int nM, int nN, int& pm, int& pn) {
    const int nwg = nM * nN, q = nwg / 8, xcd = L % 8, off = L / 8; const int wgid = xcd * q + off;
    const int nig = 8 * nN, gid = wgid / nig, fm = gid * 8, gsz = (nM - fm) < 8 ? (nM - fm) : 8;
    pm = fm + ((wgid % nig) % gsz); pn = (wgid % nig) / gsz;
}

struct EpiStore {
    const float* w2048;
    __device__ __forceinline__ void operator()(f32x4 (&acc)[2][2][4][2], const Unit& u, int wr, int wc, int fr, int fq) const {
        const int col0 = wc * 32 + 8 * fq;
#pragma unroll
        for (int ai = 0; ai < 2; ++ai)
#pragma unroll
            for (int m = 0; m < 4; ++m) {
                const int r = ai * HALF + wr * 64 + m * 16 + fr;
                if (r < u.rows && r >= u.rmin) {
#pragma unroll
                    for (int bj = 0; bj < 2; ++bj) {
                        f32x4 v0 = acc[ai][bj][m][0], v1 = acc[ai][bj][m][1];
                        if (u.mode == 1) { float* p = (float*)u.C + (long)r * u.ldc + col0 + bj * u.bjs; *(f32x4*)p = v0; *(f32x4*)(p + 4) = v1; }
                        else {
                            if (u.mode == 2) {
#pragma unroll
                                for (int c = 0; c < 4; ++c) { v0[c] = __builtin_amdgcn_rcpf(1.0f + __expf(-v0[c])); v1[c] = __builtin_amdgcn_rcpf(1.0f + __expf(-v1[c])); }
                            } else if (u.mode == 3) {
                                const float* wp = w2048 + u.pn + bj * HALF + col0; const float sg = (r & 1) ? -1.0f : 1.0f;
                                v0 += *(const f32x4*)wp * sg; v1 += *(const f32x4*)(wp + 4) * sg;
                            }
                            u32x4 w; w.x = cvt_pk_bf16(v0[0], v0[1]); w.y = cvt_pk_bf16(v0[2], v0[3]); w.z = cvt_pk_bf16(v1[0], v1[1]); w.w = cvt_pk_bf16(v1[2], v1[3]);
                            *(u32x4*)((bf16_t*)u.C + (long)r * u.ldc + col0 + bj * u.bjs) = w;
                        }
                    }
                }
            }
    }
};


struct EpiIn { EpiStore base; LAS float* red; const float* qnw; const float* knw; const float* rope;
    __device__ __forceinline__ void operator()(f32x4 (&acc)[2][2][4][2], const Unit& u, int wr, int wc, int fr, int fq) const {
        if (u.mode < 5) { base(acc, u, wr, wc, fr, fq); return; }
#pragma unroll
        for (int ai = 0; ai < 2; ++ai)
#pragma unroll
            for (int m = 0; m < 4; ++m)
#pragma unroll
                for (int bj = 0; bj < 2; ++bj) { const f32x4 a = acc[ai][bj][m][0], b = acc[ai][bj][m][1];
                    float s = (a[0] * a[0] + a[1] * a[1]) + (a[2] * a[2] + a[3] * a[3]) + (b[0] * b[0] + b[1] * b[1]) + (b[2] * b[2] + b[3] * b[3]);
                    s += __shfl_xor(s, 16); s += __shfl_xor(s, 32);
                    if (fq == 0) red[((ai * HALF + wr * 64 + m * 16 + fr) * 2 + bj) * 4 + wc] = s; }
        asm volatile("s_waitcnt lgkmcnt(0)" ::: "memory"); __builtin_amdgcn_s_barrier(); asm volatile("" ::: "memory");
        const float* nw = u.mode == 5 ? qnw : knw;
        const int axis = wc >> 1, f0 = (wc & 1) * 16 + fq * 4, da = axis * 64 + f0;
        const f32x4 wa = *(const f32x4*)(nw + da), wb = *(const f32x4*)(nw + da + 32);
#pragma unroll
        for (int ai = 0; ai < 2; ++ai)
#pragma unroll
            for (int m = 0; m < 4; ++m) { const int r = ai * HALF + wr * 64 + m * 16 + fr;
                f32x4 cs = {1.f, 1.f, 1.f, 1.f}, sn = {0.f, 0.f, 0.f, 0.f};
                if (u.mode != 7) { const int t = u.pm + r, pos = axis ? (t & 63) : (t >> 6); const float* rp = rope + (pos * 32 + f0) * 2;
                    const f32x4 p0 = *(const f32x4*)rp, p1 = *(const f32x4*)(rp + 4); cs = (f32x4){p0[0], p0[2], p1[0], p1[2]}; sn = (f32x4){p0[1], p0[3], p1[1], p1[3]}; }
#pragma unroll
                for (int bj = 0; bj < 2; ++bj) { const LAS f32x4* pp = (const LAS f32x4*)(red + (r * 2 + bj) * 4); const f32x4 ps = *pp;
                    const float rstd = 1.0f / sqrtf(((ps[0] + ps[1]) + (ps[2] + ps[3])) * (1.0f / HD) + 1e-6f);
                    const f32x4 xa = acc[ai][bj][m][0] * rstd * wa, xb = acc[ai][bj][m][1] * rstd * wb;
                    const f32x4 oa = xa * cs - xb * sn, ob = xb * cs + xa * sn;
                    u32x4 w; w.x = cvt_pk_bf16(oa[0], oa[1]); w.y = cvt_pk_bf16(oa[2], oa[3]); w.z = cvt_pk_bf16(ob[0], ob[1]); w.w = cvt_pk_bf16(ob[2], ob[3]);
                    *(u32x4*)((bf16_t*)u.C + (long)r * u.ldc + bj * HALF + wc * 32 + 8 * fq) = w; } }
    } };


struct EpiY8 {
    __device__ __forceinline__ void operator()(f32x4 (&acc)[2][2][4][2], const Unit& u, int wr, int wc, int fr, int fq) const {
        unsigned char* base = (unsigned char*)u.C + (size_t)(wr * 64 + fr) * u.ldc + wc * 32 + 8 * fq;
        const int r0 = wr * 64 + fr;
#pragma unroll
        for (int ai = 0; ai < 2; ++ai)
#pragma unroll
            for (int m = 0; m < 4; ++m) {
                if (r0 + ai * HALF + m * 16 < u.rows) { unsigned char* p = base + (size_t)(ai * HALF + m * 16) * u.ldc;
#pragma unroll
                    for (int bj = 0; bj < 2; ++bj) { f32x4 v0 = acc[ai][bj][m][0], v1 = acc[ai][bj][m][1];
#pragma unroll
                        for (int c = 0; c < 4; ++c) { v0[c] = fminf(fmaxf(v0[c], -448.f), 448.f); v1[c] = fminf(fmaxf(v1[c], -448.f), 448.f); }
                        int w0 = 0, w1 = 0;
                        w0 = __builtin_amdgcn_cvt_pk_fp8_f32(v0[0], v0[1], w0, false); w0 = __builtin_amdgcn_cvt_pk_fp8_f32(v0[2], v0[3], w0, true);
                        w1 = __builtin_amdgcn_cvt_pk_fp8_f32(v1[0], v1[1], w1, false); w1 = __builtin_amdgcn_cvt_pk_fp8_f32(v1[2], v1[3], w1, true);
                        *(unsigned long long*)(p + bj * HALF) = (unsigned long long)(unsigned)w0 | ((unsigned long long)(unsigned)w1 << 32); } } }
    } };

struct Args { const float* in[22]; float* out; unsigned char* ws; int ph_lo, ph_hi, use_ut, mod_off, do_attn, bar_idx; };
struct Frame {
    LAS unsigned char* lds; volatile LAS unsigned* MISC; unsigned char* ws;
    int tid, lane, wave, vcu, G;
};

__device__ __forceinline__ int qk_col_of_dim(int d) { const int a = d >> 6, half = (d >> 5) & 1, f = d & 31; return 32 * (2 * a + (f >> 4)) + 8 * ((f >> 2) & 3) + 4 * half + (f & 3); }
__device__ __forceinline__ void t64_load(f32x4 (&v)[16], const float* W, int ldw, int lane) {
    const unsigned off = (unsigned)(((lane >> 4) * ldw + (lane & 15) * 4) * 4);
#pragma unroll
    for (int j = 0; j < 16; ++j) { const char* bj = (const char*)W + (size_t)(j * 4) * ldw * 4; v[j] = __builtin_nontemporal_load((const GAS f32x4*)(bj + off)); }
}
template <bool QKPERM = false>
__device__ __forceinline__ void t64_store(const f32x4 (&v)[16], bf16_t* dst, int ldd, LAS float* scr, int lane, int d0 = 0) {
    const int kk = lane >> 4, nc = (lane & 15) * 4;
#pragma unroll
    for (int j = 0; j < 16; ++j) {
#pragma unroll
        for (int c = 0; c < 4; ++c) scr[(j * 4 + kk) * 65 + nc + c] = v[j][c]; }
    LDS_WAIT(); asm volatile("" ::: "memory");
    const int kc = lane & 7; const unsigned soff = (unsigned)(((lane >> 3) * ldd + 8 * kc) * 2);
#pragma unroll
    for (int jj = 0; jj < 8; jj += 2) {
        float t[2][8];
#pragma unroll
        for (int q = 0; q < 2; ++q) { const int n = (lane >> 3) + 8 * (jj + q); const LAS float* s = scr + (8 * kc) * 65 + n;
#pragma unroll
            for (int i = 0; i < 8; ++i) t[q][i] = s[i * 65]; }
#pragma unroll
        for (int q = 0; q < 2; ++q) { char* bq = (char*)dst + (size_t)(8 * (jj + q)) * ldd * 2;
            if constexpr (QKPERM) bq = (char*)dst + (size_t)(qk_col_of_dim(d0 + (lane >> 3) + 8 * (jj + q)) - (lane >> 3)) * ldd * 2;
            u32x4 o; o.x = cvt_pk_bf16(t[q][0], t[q][1]); o.y = cvt_pk_bf16(t[q][2], t[q][3]); o.z = cvt_pk_bf16(t[q][4], t[q][5]); o.w = cvt_pk_bf16(t[q][6], t[q][7]);
            __builtin_nontemporal_store(o, (GAS u32x4*)(bq + soff)); } }
    LDS_WAIT(); asm volatile("" ::: "memory");
}
__device__ __forceinline__ void transpose64(const float* W, int ldw, bf16_t* dst, int ldd, LAS float* scr, int lane) {
    f32x4 v[16]; t64_load(v, W, ldw, lane); t64_store(v, dst, ldd, scr, lane);
}

constexpr int IT_IN = 32 * 128, IT_FO = 16 * 32, IT_AO = 32 * 32, IT_O = 32 * 32, IT_EG = 64 * 256, IT_EU = 64 * 256, IT_ED = 64 * 256, IT_SH = 256;
constexpr int IT_T_END = IT_IN + IT_FO + IT_AO + IT_O + 3 * IT_SH;
constexpr int IT_MOD = MODC / 32, IT_CST = 4096, IT_BD2 = 512, IT_RWT = 32, IT_ROPE = 1;
constexpr int IT_ALL = IT_T_END + IT_MOD + IT_CST + IT_BD2 + IT_RWT + IT_ROPE;

__device__ __forceinline__ void mod_item(const Args& args, unsigned char* ws, int r, int lane) {
            const int kq = lane >> 3, col = r * 32 + (lane & 7) * 4;
            f32x4 a0 = {0.f, 0.f, 0.f, 0.f}, a1 = a0, a2 = a0;
            for (int jb = 0; jb < 256; jb += 8) {
                f32x4 w[8]; float c0[8], c1[8], c2[8];
#pragma unroll
                for (int j = 0; j < 8; ++j) { const int k = kq + 8 * (jb + j); w[j] = *(const GAS f32x4*)(args.in[4] + (size_t)k * MODC + col); c0[j] = args.in[1][k]; c1[j] = args.in[1][DM + k]; c2[j] = args.in[3][k]; }
#pragma unroll
                for (int j = 0; j < 8; ++j) { a0 += w[j] * (c0[j] * __builtin_amdgcn_rcpf(1.0f + __expf(-c0[j]))); a1 += w[j] * (c1[j] * __builtin_amdgcn_rcpf(1.0f + __expf(-c1[j]))); a2 += w[j] * (c2[j] * __builtin_amdgcn_rcpf(1.0f + __expf(-c2[j]))); }
            }
#pragma unroll
            for (int c = 0; c < 4; ++c) {
#pragma unroll
                for (int o = 8; o < 64; o <<= 1) { a0[c] += __shfl_xor(a0[c], o); a1[c] += __shfl_xor(a1[c], o); a2[c] += __shfl_xor(a2[c], o); } }
            if (kq == 0) { const f32x4 bb = *(const GAS f32x4*)(args.in[5] + col); float* MODP = (float*)(ws + WS_MOD);
                *(GAS f32x4*)(MODP + col) = a0 + bb; *(GAS f32x4*)(MODP + MODC + col) = a1 + bb; *(GAS f32x4*)(MODP + 2 * MODC + col) = a2 + bb; }
}
__device__ __forceinline__ void p0_prologue(Frame& F, const Args& args) {
    LAS float* scr = (LAS float*)(F.lds + F.wave * 16640);
    const int gw = F.vcu * NWAVES + F.wave, NGW = F.G * NWAVES, lane = F.lane;
    unsigned char* ws = F.ws;
    bf16_t* WT_IN = (bf16_t*)(ws + WS_WT_IN); bf16_t* WT_FO = (bf16_t*)(ws + WS_WT_FO); bf16_t* WT_AO = (bf16_t*)(ws + WS_WT_AO); bf16_t* WT_O = (bf16_t*)(ws + WS_WT_O);
    bf16_t* WT_GU = (bf16_t*)(ws + WS_WT_GU); bf16_t* WT_D = (bf16_t*)(ws + WS_WT_D);
    if (NGW >= 5 * IT_MOD) { if (gw % 5 == 0 && gw / 5 < IT_MOD) mod_item(args, ws, gw / 5, lane); }
    else for (int m = gw; m < IT_MOD; m += NGW) mod_item(args, ws, m, lane);
    for (int it = gw; it < IT_ALL - IT_MOD; it += NGW) {
        int r = it;
        if (r < IT_IN) { const int kb = r / 128, nb = r % 128, n0 = nb * 64;
            if (n0 >= Q_OFF && n0 < V_OFF) { f32x4 v[16]; t64_load(v, args.in[7] + (size_t)(kb * 64) * INC + n0, INC, lane);
                t64_store<true>(v, WT_IN + (size_t)(n0 & ~127) * DM + kb * 64, DM, scr, lane, n0 & 127); }
            else transpose64(args.in[7] + (size_t)(kb * 64) * INC + n0, INC, WT_IN + (size_t)n0 * DM + kb * 64, DM, scr, lane);
            continue; } r -= IT_IN;
        if (r < IT_FO) { const int kb = r / 32, nb = r % 32; transpose64(args.in[10] + (size_t)(kb * 64) * DM + nb * 64, DM, WT_FO + (size_t)(nb * 64) * YFP + kb * 64, YFP, scr, lane); continue; } r -= IT_FO;
        if (r < IT_AO) { const int kb = r / 32, nb = r % 32; transpose64(args.in[11] + (size_t)(kb * 64) * DM + nb * 64, DM, WT_AO + (size_t)(nb * 64) * DM + kb * 64, DM, scr, lane); continue; } r -= IT_AO;
        if (r < IT_O) { const int kb = r / 32, nb = r % 32; transpose64(args.in[12] + (size_t)(kb * 64) * DM + nb * 64, DM, WT_O + (size_t)(nb * 64) * DM + kb * 64, DM, scr, lane); continue; } r -= IT_O;
        if (r < 2 * IT_SH) { const int up = r >= IT_SH; if (up) r -= IT_SH; const int kb = r / 8, nb = r % 8, n0 = nb * 64;
            transpose64((up ? args.in[20] : args.in[19]) + (size_t)(kb * 64) * EFF + n0, EFF, WT_GU + ((size_t)64 * 1024 + (n0 >> 7) * 256 + (up ? 128 : 0) + (n0 & 127)) * DM + kb * 64, DM, scr, lane); continue; } r -= 2 * IT_SH;
        if (r < IT_SH) { const int kb = r / 32, nb = r % 32;
            transpose64(args.in[21] + (size_t)(kb * 64) * DM + nb * 64, DM, WT_D + ((size_t)64 * DM + nb * 64) * EFF + kb * 64, EFF, scr, lane); continue; } r -= IT_SH;

        if (r < IT_CST) {
            const int k1 = r & 2047; bf16_t* dst = (bf16_t*)(ws + WS_CST) + (size_t)r * 2048;
#pragma unroll
            for (int j = 0; j < 4; ++j) { const int n0 = j * 512 + lane * 8; float f[8];
#pragma unroll
                for (int i = 0; i < 8; ++i) { const float ph = (float)((k1 * (n0 + i)) & 4095) * (1.0f / 2048.0f); f[i] = r < 2048 ? cospif(ph) : sinpif(ph); }
                u32x4 o; o.x = cvt_pk_bf16(f[0], f[1]); o.y = cvt_pk_bf16(f[2], f[3]); o.z = cvt_pk_bf16(f[4], f[5]); o.w = cvt_pk_bf16(f[6], f[7]);
                *(GAS u32x4*)(dst + n0) = o; }
            continue; } r -= IT_CST;
        if (r < IT_BD2) {
            const int t = r >> 8, o = r & 255, gp = o >> 7, k2 = o & 127; bf16_t* dst = (bf16_t*)(ws + WS_BD2) + (size_t)r * 512; float f[8];
#pragma unroll
            for (int i = 0; i < 8; ++i) { const int j = lane * 8 + i, cg = j >> 8, jj = j & 255, c = jj & 127; const float ph = (float)((32 * c * k2) & 4095) * (1.0f / 2048.0f);
                const float v = jj < 128 ? cospif(ph) : (t ? sinpif(ph) : -sinpif(ph)); f[i] = cg == gp ? v * 0.0013810679320049757f : 0.f; }
            u32x4 w; w.x = cvt_pk_bf16(f[0], f[1]); w.y = cvt_pk_bf16(f[2], f[3]); w.z = cvt_pk_bf16(f[4], f[5]); w.w = cvt_pk_bf16(f[6], f[7]);
            *(GAS u32x4*)(dst + lane * 8) = w;
            continue; } r -= IT_BD2;
        if (r >= IT_RWT) {
            float* RT = (float*)(ws + WS_ROPE);
            for (int idx = lane; idx < 64 * 32; idx += 64) { const float ang = (float)(idx >> 5) * exp2f(-(float)(idx & 31) * (13.287712379549449f / 32.0f)); RT[2 * idx] = cosf(ang); RT[2 * idx + 1] = sinf(ang); }
            continue; }
        {
            f32x4 v[16]; t64_load(v, args.in[14] + (size_t)(r * 64) * NE, NE, lane);
            const int kk = lane >> 4, nc = (lane & 15) * 4;
#pragma unroll
            for (int j = 0; j < 16; ++j) {
#pragma unroll
                for (int c = 0; c < 4; ++c) scr[(j * 4 + kk) * 65 + nc + c] = v[j][c]; }
            LDS_WAIT(); asm volatile("" ::: "memory");
            const int kc = lane & 7; bf16_t* RWT = (bf16_t*)(ws + WS_RWT);
#pragma unroll
            for (int jj = 0; jj < 8; ++jj) { const int e = (lane >> 3) + 8 * jj; const LAS float* s = scr + (8 * kc) * 65 + e; float t[8], l[8];
#pragma unroll
                for (int i = 0; i < 8; ++i) { t[i] = s[i * 65]; l[i] = t[i] - bf2f(f2bf(t[i])); }
                u32x4 h, lo; h.x = cvt_pk_bf16(t[0], t[1]); h.y = cvt_pk_bf16(t[2], t[3]); h.z = cvt_pk_bf16(t[4], t[5]); h.w = cvt_pk_bf16(t[6], t[7]);
                lo.x = cvt_pk_bf16(l[0], l[1]); lo.y = cvt_pk_bf16(l[2], l[3]); lo.z = cvt_pk_bf16(l[4], l[5]); lo.w = cvt_pk_bf16(l[6], l[7]);
                *(GAS u32x4*)(RWT + (size_t)e * DM + r * 64 + 8 * kc) = h; *(GAS u32x4*)(RWT + (size_t)(NE + e) * DM + r * 64 + 8 * kc) = lo; }
            LDS_WAIT(); asm volatile("" ::: "memory");
        }
    }
}


__device__ __forceinline__ void conv_addr(const Args& args, unsigned char* ws, bool down, int it, const float*& W, int& ldw, bf16_t*& dst, int& ldd) {
    if (!down) { int r = it; const int up = r >= IT_EG; if (up) r -= IT_EG;
        const int e = r / 256, q = r % 256, kb = q / 8, nb = q % 8, n0 = nb * 64;
        W = (up ? args.in[17] : args.in[16]) + (size_t)e * DM * EFF + (size_t)(kb * 64) * EFF + n0; ldw = EFF;
        dst = (bf16_t*)(ws + WS_WT_GU) + ((size_t)e * 1024 + (n0 >> 7) * 256 + (up ? 128 : 0) + (n0 & 127)) * DM + kb * 64; ldd = DM;
    } else { const int r = it, e = r / 256, q = r % 256, kb = q / 32, nb = q % 32;
        W = args.in[18] + (size_t)e * EFF * DM + (size_t)(kb * 64) * DM + nb * 64; ldw = DM;
        dst = (bf16_t*)(ws + WS_WT_D) + ((size_t)e * DM + nb * 64) * EFF + kb * 64; ldd = EFF; }
}
__device__ __forceinline__ void conv_items(Frame& F, const Args& args, bool down, int first, int count) {
    LAS float* scr = (LAS float*)(F.lds + F.wave * 16640);
    const int end = first + count; int it = first + F.wave;
    if (it >= end) return;
    f32x4 va[16], vb[16]; const float* W; int ldw; bf16_t* da; bf16_t* db; int ldd;
    conv_addr(args, F.ws, down, it, W, ldw, da, ldd); t64_load(va, W, ldw, F.lane);
    for (;;) {
        const bool hb = it + NWAVES < end;
        if (hb) { conv_addr(args, F.ws, down, it + NWAVES, W, ldw, db, ldd); t64_load(vb, W, ldw, F.lane); }
        t64_store(va, da, ldd, scr, F.lane);
        if (!hb) break;
        const bool ha = it + 2 * NWAVES < end;
        if (ha) { conv_addr(args, F.ws, down, it + 2 * NWAVES, W, ldw, da, ldd); t64_load(va, W, ldw, F.lane); }
        t64_store(vb, db, ldd, scr, F.lane);
        if (!ha) break;
        it += 2 * NWAVES;
    }
}
struct SchedIn {
    int G, c; unsigned char* ws; int use_ut;
    __device__ __forceinline__ bool next(int i, Unit& u) const {
        const int L = i * G + c; if (L >= 1024) return false;
        const char* H = (const char*)(ws + WS_H); const char* WT = (const char*)(ws + WS_WT_IN);
        u.rows = 256; u.aux = 0; u.bjs = HALF; u.pm = 0; u.pn = 0; u.rmin = 0; u.nt = DM / BK; u.keep = 0;
        if (L < 896) {
            int pm, ct; grid_map(L, 32, 28, pm, ct);
            const int row0 = pm * 256, b = row0 / SEQ, t0 = row0 % SEQ;
            u.A = H + (size_t)row0 * DM * 2; u.B = WT + (size_t)ct * 256 * DM * 2;
            if (ct < 4) {
                if (use_ut) { u.A = WT + (size_t)ct * 256 * DM * 2; u.B = H + (size_t)row0 * DM * 2;
                              u.C = (char*)(ws + WS_UT) + (((size_t)b * FW + ct * 256) * SEQ + t0) * 2; u.ldc = SEQ; u.mode = 0; }
                else { u.C = (char*)(ws + WS_U) + ((size_t)row0 * FW + ct * 256) * 2; u.ldc = FW; u.mode = 0; }
            }
            else if (ct < 12) { u.C = (char*)(ws + WS_Q) + ((size_t)row0 * DM + (ct - 4) * 256) * 2; u.ldc = DM; u.mode = 5; u.pm = t0; }
            else if (ct < 14) { u.C = (char*)(ws + WS_KALL) + (((size_t)b * SKV + t0) * KVW + (ct - 12) * 256) * 2; u.ldc = KVW; u.mode = 6; u.pm = t0; }
            else if (ct < 16) { u.C = (char*)(ws + WS_VALL) + (((size_t)b * SKV + t0) * KVW + (ct - 14) * 256) * 2; u.ldc = KVW; u.mode = 0; }
            else if (ct < 24) { u.C = (char*)(ws + WS_SGF) + ((size_t)row0 * DM + (ct - 16) * 256) * 2; u.ldc = DM; u.mode = 2; }
            else              { u.C = (char*)(ws + WS_SGA) + ((size_t)row0 * DM + (ct - 24) * 256) * 2; u.ldc = DM; u.mode = 2; }
        } else if (L >= 904) {
            int pm, q; grid_map(L - 904, 32, 4, pm, q); const int ct = 28 + q;
            u.A = H + (size_t)pm * 256 * DM * 2; u.B = WT + (size_t)ct * 256 * DM * 2;
            u.C = (char*)(ws + WS_SGA) + ((size_t)pm * 256 * DM + (ct - 24) * 256) * 2; u.ldc = DM; u.mode = 2;
        } else {
            const int l = L - 896, pm = l & 1, ct = l >> 1;
            u.A = H + (size_t)(NTOK + pm * 256) * DM * 2; u.B = WT + (size_t)(K_OFF + ct * 256) * DM * 2;
            if (ct < 2) { u.C = (char*)(ws + WS_KALL) + (((size_t)pm * SKV + SEQ) * KVW + ct * 256) * 2; u.ldc = KVW; u.mode = 7; }
            else        { u.C = (char*)(ws + WS_VALL) + (((size_t)pm * SKV + SEQ) * KVW + (ct - 2) * 256) * 2; u.ldc = KVW; u.mode = 0; }
        }
        return true;
    }
    __device__ __forceinline__ unsigned arow(const Unit&, int) const { return 0u; }
};


__device__ __forceinline__ void unpack8(u32x4 w, float (&f)[8]) {
#pragma unroll
    for (int i = 0; i < 4; ++i) { f[2 * i] = __uint_as_float(w[i] << 16); f[2 * i + 1] = __uint_as_float(w[i] & 0xffff0000u); }
}
struct EpiMerge { const bf16_t* SGF; const bf16_t* SGA; bf16_t* YM;
    __device__ __forceinline__ void operator()(f32x4 (&acc)[2][2][4][2], const Unit& u, int wr, int wc, int fr, int fq) const {
#pragma unroll
        for (int ai = 0; ai < 2; ++ai)
#pragma unroll
            for (int m = 0; m < 4; ++m) { const size_t row = (size_t)u.pm * 256 + ai * HALF + wr * 64 + m * 16 + fr;
#pragma unroll
                for (int bj = 0; bj < 2; ++bj) { const size_t o = row * DM + u.pn * 256 + bj * HALF + wc * 32 + 8 * fq;
                    float ga[8]; unpack8(*(const u32x4*)(SGA + o), ga);
#pragma unroll
                    for (int c = 0; c < 8; ++c) ga[c] = fmaxf(ga[c], 1e-20f);
                    if (u.keep) { float gf[8]; unpack8(*(const u32x4*)(SGF + o), gf);
#pragma unroll
                        for (int c = 0; c < 4; ++c) { acc[ai][bj][m][0][c] *= gf[c] * __builtin_amdgcn_rcpf(ga[c]); acc[ai][bj][m][1][c] *= gf[4 + c] * __builtin_amdgcn_rcpf(ga[4 + c]); }
                    } else { const f32x4 v0 = acc[ai][bj][m][0], v1 = acc[ai][bj][m][1];
                        u32x4 w; w.x = cvt_pk_bf16(ga[0] * v0[0], ga[1] * v0[1]); w.y = cvt_pk_bf16(ga[2] * v0[2], ga[3] * v0[3]); w.z = cvt_pk_bf16(ga[4] * v1[0], ga[5] * v1[1]); w.w = cvt_pk_bf16(ga[6] * v1[2], ga[7] * v1[3]);
                        *(u32x4*)(YM + o) = w; } } }
    } };
struct SchedMerge { int G, c; unsigned char* ws;
    __device__ __forceinline__ bool next(int i, Unit& u) const {
        const int L = (i >> 1) * G + c; if (L >= 256) return false;
        int pm, pn; grid_map(L, 32, 8, pm, pn); const int kb = i & 1;
        u.A = (const char*)(ws + (kb ? WS_YA : WS_YF)) + (size_t)pm * 256 * DM * 2; u.B = (const char*)(ws + (kb ? WS_WT_AO : WS_WT_FO)) + (size_t)pn * 256 * DM * 2;
        u.C = nullptr; u.ldc = DM; u.mode = 0; u.rows = 256; u.aux = 0; u.pm = pm; u.pn = pn; u.bjs = HALF; u.rmin = 0; u.nt = kb ? DM / BK : FW / BK; u.keep = kb ? 0 : 1;
        return true; }
    __device__ __forceinline__ unsigned arow(const Unit&, int) const { return 0u; } };
struct EpiX2 { const float* x; const float* mod; float* X2;
    __device__ __forceinline__ void operator()(f32x4 (&acc)[2][2][4][2], const Unit& u, int wr, int wc, int fr, int fq) const {
        const float* g1 = mod + ((u.pm * 256) / SEQ) * MODC + 2 * DM;
#pragma unroll
        for (int ai = 0; ai < 2; ++ai)
#pragma unroll
            for (int m = 0; m < 4; ++m) { const size_t row = (size_t)u.pm * 256 + ai * HALF + wr * 64 + m * 16 + fr;
#pragma unroll
                for (int bj = 0; bj < 2; ++bj) { const int col = u.pn * 256 + bj * HALF + wc * 32 + 8 * fq; const size_t o = row * DM + col;
#pragma unroll
                    for (int n = 0; n < 2; ++n) { const f32x4 xv = *(const f32x4*)(x + o + 4 * n), gv = *(const f32x4*)(g1 + col + 4 * n); *(f32x4*)(X2 + o + 4 * n) = xv + gv * acc[ai][bj][m][n]; } } }
    } };
struct EpiAct {
    __device__ __forceinline__ void operator()(f32x4 (&acc)[2][2][4][2], const Unit& u, int wr, int wc, int fr, int fq) const {
#pragma unroll
        for (int ai = 0; ai < 2; ++ai)
#pragma unroll
            for (int m = 0; m < 4; ++m) { const int r = ai * HALF + wr * 64 + m * 16 + fr;
                if (r < u.rows) { float a[8];
#pragma unroll
                    for (int n = 0; n < 2; ++n)
#pragma unroll
                        for (int c = 0; c < 4; ++c) { const float g = acc[ai][0][m][n][c], up = acc[ai][1][m][n][c]; a[4 * n + c] = g * __builtin_amdgcn_rcpf(1.0f + __expf(-g)) * up; }
                    u32x4 w; w.x = cvt_pk_bf16(a[0], a[1]); w.y = cvt_pk_bf16(a[2], a[3]); w.z = cvt_pk_bf16(a[4], a[5]); w.w = cvt_pk_bf16(a[6], a[7]);
                    *(u32x4*)((bf16_t*)u.C + (size_t)r * u.ldc + wc * 32 + 8 * fq) = w; } }
    } };

struct SchedGrid {
    int G, c, nM, nN; const char* A; const char* B; char* C; size_t astride, bstride; int ldc, esz, mode, nt;
    __device__ __forceinline__ bool next(int i, Unit& u) const {
        const int L = i * G + c; if (L >= nM * nN) return false;
        int pm, pn; grid_map(L, nM, nN, pm, pn);
        u.A = A + (size_t)pm * astride; u.B = B + (size_t)pn * bstride; u.C = C + ((size_t)pm * 256 * ldc + pn * 256) * esz; u.ldc = ldc; u.mode = mode; u.rows = 256; u.aux = 0; u.pm = pm; u.pn = pn; u.bjs = HALF; u.rmin = 0; u.nt = nt; u.keep = 0;
        return true; }
    __device__ __forceinline__ unsigned arow(const Unit&, int) const { return 0u; } };
struct SchedAG { int G, c; unsigned char* ws;
    __device__ __forceinline__ bool next(int i, Unit& u) const {
        const int L = i * G + c; if (L >= 136) return false;
        u.rows = 256; u.aux = 0; u.rmin = 0; u.nt = DM / BK; u.keep = 0;
        if (L < 128) {
            int pm, pn8; grid_map(L, 16, 8, pm, pn8); const int b = pn8 >> 2, pn = pn8 & 3, sn = pm >> 3, k1t = pm & 7;
            u.A = (const char*)(ws + WS_CST) + (size_t)pm * 256 * 2048 * 2; u.B = (const char*)(ws + (sn ? WS_OT : WS_ET)) + ((size_t)b * FW + pn * 256) * 2048 * 2;
            u.C = (char*)(ws + WS_TT) + (((size_t)b * 2048 + k1t * 256) * DM + pn * 512 + sn * 128) * 2; u.ldc = DM; u.mode = sn ? 0 : 3; u.pm = k1t; u.pn = b * FW + pn * 256; u.bjs = 256;
        } else {
            int pm, q; grid_map(L - 128 + 120, 32, 4, pm, q); const int ct = 28 + q;
            u.A = (const char*)(ws + WS_H) + (size_t)pm * 256 * DM * 2; u.B = (const char*)(ws + WS_WT_IN) + (size_t)ct * 256 * DM * 2;
            u.C = (char*)(ws + WS_SGA) + ((size_t)pm * 256 * DM + (ct - 24) * 256) * 2; u.ldc = DM; u.mode = 2; u.pm = pm; u.pn = ct; u.bjs = HALF;
        }
        return true; }
    __device__ __forceinline__ unsigned arow(const Unit&, int) const { return 0u; } };
struct SchedF2 { int G, c; unsigned char* ws;
    __device__ __forceinline__ bool next(int i, Unit& u) const {
        const int L = i * G + c; if (L >= 128) return false;
        int pm, q; grid_map(L, 16, 8, pm, q); const int b = pm >> 3, k1t = pm & 7, j = q & 3, mir = q >> 2;
        u.A = (const char*)(ws + WS_TT) + (((size_t)b * 2048 + k1t * 256) * DM + j * 512) * 2; u.B = (const char*)(ws + WS_BD2) + (size_t)mir * 256 * 512 * 2;
        u.mode = 0; u.rows = 256; u.aux = 0; u.pm = pm; u.pn = j; u.bjs = HALF; u.nt = 512 / BK; u.keep = 0;
        if (!mir) { u.C = (char*)(ws + WS_YF) + (((size_t)b * SEQ + k1t * 256) * YFP + j * 256) * 2; u.ldc = YFP; u.rmin = 0; }
        else { u.C = (char*)(ws + WS_YF) + (((size_t)b * SEQ + SEQ - k1t * 256) * YFP + j * 256) * 2; u.ldc = -YFP; u.rmin = k1t == 0 ? 1 : 0; }
        return true; }
    __device__ __forceinline__ unsigned arow(const Unit&, int) const { return 0u; } };
constexpr int SCHT_OFF = LDSCTL_OFF + 1024;
__device__ __forceinline__ void moe_tables(Frame& F, int ncol_tiles) {
    LAS int* T = (LAS int*)(F.lds + SCHT_OFF);
    __syncthreads();
    if (F.tid == 0) { const int* CNT = (const int*)(F.ws + CTL_CNT); int up = 0, of = 0;
        for (int e = 0; e <= NE; ++e) { const int cn = e < NE ? CNT[e * 64] : NTOK; T[e] = up; T[80 + e] = e < NE ? of : NSLOT; T[160 + e] = cn; up += ((cn + 255) >> 8) * ncol_tiles; of += cn; }
        T[NE + 1] = up; }
    __syncthreads();
}
template <int NCT, bool FIRST> struct SchedMoe {
    int G, c; unsigned char* ws; LAS int* T; const int* TOK;
    __device__ __forceinline__ bool next(int i, Unit& u) const {
        const int L = i * G + c; if (L >= T[NE + 1]) return false;
        int lo = 0, hi = NE;
#pragma unroll 1
        while (lo < hi) { const int mid = (lo + hi + 1) >> 1; if (T[mid] <= L) lo = mid; else hi = mid - 1; }
        const int e = lo, cn = T[160 + e], ntile = (cn + 255) >> 8, local = L - T[e], ct = local / ntile, mt = local % ntile, slot0 = T[80 + e] + mt * 256;
        u.rows = (cn - mt * 256) < 256 ? (cn - mt * 256) : 256; u.aux = slot0; u.pm = mt; u.pn = ct; u.bjs = HALF; u.mode = 0; u.rmin = 0; u.e = e; u.nt = (FIRST ? DM : EFF) / BK; u.keep = 0;
        if (FIRST) { u.A = (const char*)(ws + WS_H2); u.B = (const char*)(ws + WS_WT_GU) + ((size_t)e * 4 + ct) * 256 * DM * 2; u.C = (char*)(ws + WS_ACT) + ((size_t)slot0 * EFF + ct * 128) * 2; u.ldc = EFF; }
        else { u.A = (const char*)(ws + WS_ACT) + (size_t)slot0 * EFF * 2; u.B = (const char*)(ws + WS_WT_D) + ((size_t)e * DM + ct * 256) * EFF * 2; u.C = (char*)(ws + WS_YBIG) + ((size_t)slot0 * DM + ct * 256); u.ldc = DM; u.mode = 8; }
        return true; }
    __device__ __forceinline__ unsigned arow(const Unit& u, int r) const { const int rr = u.pm * 256 + (r < u.rows ? r : u.rows - 1); const int tok = u.e < NE ? TOK[u.e * NTOK + rr] : rr; return (unsigned)tok * (unsigned)(DM * 2); } };

namespace attn {
using s16x4 = __attribute__((ext_vector_type(4))) short;
using f32x8 = __attribute__((ext_vector_type(8))) float;
constexpr int D = 128, NW = 8, QBLK = 32, KVBLK = 64;
constexpr float SCALE = 0.088388347648318440f;
constexpr float THR = 8.f;
constexpr int LDQ = DM, LDK = KVW, LDO = DM;
constexpr size_t SHM_V = KVBLK * D * 2, SHM_K = KVBLK * D * 2, SHM_ATTN = 2 * SHM_V + 2 * SHM_K + NW * 64 * 4;
#define KSWZ(row, colB) ((row) * 256 + ((colB) ^ (((row) & 7) << 4)))
#define SBAR() __builtin_amdgcn_sched_barrier(0)
__device__ __forceinline__ unsigned cvtpk(float lo, float hi) { unsigned r; asm volatile("v_cvt_pk_bf16_f32 %0, %1, %2" : "=v"(r) : "v"(lo), "v"(hi)); return r; }
__device__ __forceinline__ void partialSM(f32x16& p0, f32x16& p1, float& m_reg, float& mn, float& alpha) {
  constexpr float C = SCALE * 1.4426950408889634f;
  float pmax = p0[0]; for (int r = 1; r < 16; ++r) pmax = fmaxf(pmax, p0[r]); for (int r = 0; r < 16; ++r) pmax = fmaxf(pmax, p1[r]);
  { auto rr = __builtin_amdgcn_permlane32_swap(__float_as_uint(pmax), __float_as_uint(pmax), false, false);
    pmax = fmaxf(__uint_as_float(rr[0]), __uint_as_float(rr[1])); }
  if (__builtin_expect(__all(pmax - m_reg <= THR / SCALE), 1)) { mn = m_reg; alpha = 1.f; }
  else { mn = fmaxf(m_reg, pmax); alpha = __builtin_amdgcn_exp2f((m_reg - mn) * C); m_reg = mn; }
  float mnC = -mn * C;
  for (int r = 0; r < 16; ++r) p0[r] = fmaf(p0[r], C, mnC); for (int r = 0; r < 16; ++r) p1[r] = fmaf(p1[r], C, mnC);
  for (int r = 0; r < 16; ++r) p0[r] = __builtin_amdgcn_exp2f(p0[r]);
}
__device__ __forceinline__ void finishSM(f32x16& p0, f32x16& p1, float alpha, float& l_reg, bf16x8& pa0, bf16x8& pa1, bf16x8& pa2, bf16x8& pa3) {
  for (int r = 0; r < 16; ++r) p1[r] = __builtin_amdgcn_exp2f(p1[r]);
  float ps = 0; for (int r = 0; r < 16; ++r) ps += p0[r]; for (int r = 0; r < 16; ++r) ps += p1[r];
  { auto rr = __builtin_amdgcn_permlane32_swap(__float_as_uint(ps), __float_as_uint(ps), false, false);
    ps = __uint_as_float(rr[0]) + __uint_as_float(rr[1]); }
  l_reg = l_reg * alpha + ps;
#define PK4(P, BASE, OUT) do { unsigned a0 = cvtpk(P[BASE + 0], P[BASE + 1]), a1 = cvtpk(P[BASE + 2], P[BASE + 3]);   \
    unsigned b0 = cvtpk(P[BASE + 4], P[BASE + 5]), b1 = cvtpk(P[BASE + 6], P[BASE + 7]);                              \
    auto r0 = __builtin_amdgcn_permlane32_swap(a0, b0, false, false); auto r1 = __builtin_amdgcn_permlane32_swap(a1, b1, false, false); \
    u32x4 w = {r0[0], r1[0], r0[1], r1[1]}; OUT = *reinterpret_cast<bf16x8*>(&w); } while (0)
  PK4(p0, 0, pa0); PK4(p0, 8, pa1); PK4(p1, 0, pa2); PK4(p1, 8, pa3);
#undef PK4
}
__device__ __forceinline__ void qkt(f32x16& p0, f32x16& p1, const bf16_t* Ks, const bf16x8* qr, int r32, int hi) {
  p0 = f32x16{}; p1 = f32x16{};
  for (int d0 = 0; d0 < 8; ++d0) { int cb = (d0 * 16 + hi * 8) * 2;
    bf16x8 b0 = *reinterpret_cast<const bf16x8*>((const char*)Ks + KSWZ(r32, cb));
    bf16x8 b1 = *reinterpret_cast<const bf16x8*>((const char*)Ks + KSWZ(32 + r32, cb));
    p0 = __builtin_amdgcn_mfma_f32_32x32x16_bf16(b0, qr[d0], p0, 0, 0, 0);
    p1 = __builtin_amdgcn_mfma_f32_32x32x16_bf16(b1, qr[d0], p1, 0, 0, 0); }
}
__device__ __forceinline__ int v_st(int k, int c) { const int kk = (k & ~0xC) | ((k & 4) << 1) | ((k & 8) >> 1); return ((kk >> 3) * 4 + (c >> 5)) * 512 + ((kk & 7) * 32 + (c & 31)) * 2; }
__device__ __forceinline__ int v_rd_base(int lane) { return ((lane & 3) << 3) | (((lane >> 2) & 3) << 6) | (((lane >> 4) & 1) << 5) | (((lane >> 5) & 1) << 8); }
constexpr int v_rd_off(int d0, int ks, int half) { return d0 * 512 + ks * 4096 + half * 2048; }
template <int OFF> __device__ __forceinline__ s16x4 tr_read(int vb) {
  s16x4 r; asm volatile("ds_read_b64_tr_b16 %0, %1 offset:%2" : "=&v"(r) : "v"(vb), "i"(OFF) : "memory"); return r;
}
template <int D0> __device__ __forceinline__ void pv_one(f32x16& od, int vb, bf16x8 pa0, bf16x8 pa1, bf16x8 pa2, bf16x8 pa3) {
  const s16x4 l0 = tr_read<v_rd_off(D0, 0, 0)>(vb), h0 = tr_read<v_rd_off(D0, 0, 1)>(vb), l1 = tr_read<v_rd_off(D0, 1, 0)>(vb), h1 = tr_read<v_rd_off(D0, 1, 1)>(vb);
  const s16x4 l2 = tr_read<v_rd_off(D0, 2, 0)>(vb), h2 = tr_read<v_rd_off(D0, 2, 1)>(vb), l3 = tr_read<v_rd_off(D0, 3, 0)>(vb), h3 = tr_read<v_rd_off(D0, 3, 1)>(vb);
  asm volatile("s_waitcnt lgkmcnt(0)" ::: "memory"); SBAR();
#define PK(L, H) (bf16x8){L[0], L[1], L[2], L[3], H[0], H[1], H[2], H[3]}
  od = __builtin_amdgcn_mfma_f32_32x32x16_bf16(pa0, PK(l0, h0), od, 0, 0, 0);
  od = __builtin_amdgcn_mfma_f32_32x32x16_bf16(pa1, PK(l1, h1), od, 0, 0, 0);
  od = __builtin_amdgcn_mfma_f32_32x32x16_bf16(pa2, PK(l2, h2), od, 0, 0, 0);
  od = __builtin_amdgcn_mfma_f32_32x32x16_bf16(pa3, PK(l3, h3), od, 0, 0, 0);
#undef PK
}
__device__ __forceinline__ void pv_d0(f32x16* o, int vb, bf16x8 pa0, bf16x8 pa1, bf16x8 pa2, bf16x8 pa3) {
  pv_one<0>(o[0], vb, pa0, pa1, pa2, pa3); pv_one<1>(o[1], vb, pa0, pa1, pa2, pa3); pv_one<2>(o[2], vb, pa0, pa1, pa2, pa3); pv_one<3>(o[3], vb, pa0, pa1, pa2, pa3);
}
__device__ __forceinline__ void attn_dense_body(const bf16_t* __restrict__ Qb, const bf16_t* __restrict__ Kh, const bf16_t* __restrict__ Vh, bf16_t* __restrict__ Ob, int seq, char* lds) {
  const int tid = threadIdx.x, wid = tid >> 6, lane = tid & 63, r32 = lane & 31, hi = lane >> 5;
  bf16_t* V_lds = (bf16_t*)lds; bf16_t* K_lds = (bf16_t*)(lds + 2 * SHM_V);
  float* ws = (float*)(lds + 2 * SHM_V + 2 * SHM_K) + wid * 64; float* li_l = ws; float* al_l = ws + 32;
  float m_reg = -1e30f, l_reg = 0; f32x16 o[4] = {}; bf16x8 qr[8];
  const bf16_t* Qw = Qb + (long)(wid * QBLK + r32) * LDQ + hi * 8;
#pragma unroll
  for (int d0 = 0; d0 < 8; ++d0) qr[d0] = *reinterpret_cast<const bf16x8*>(Qw + d0 * 16);
  const int sr = tid >> 4, sc = (tid & 15) * 8, vst0 = v_st(sr, sc), vst1 = v_st(32 + sr, sc);
  const int vb0 = (int)(uintptr_t)V_lds + v_rd_base(lane);
  struct { bf16x8 vs0, vs1, ks0, ks1; } sr_[2];
#define SLOAD(i, k0) do { sr_[i].vs0 = *reinterpret_cast<const bf16x8*>(&Vh[(long)((k0) + sr) * LDK + sc]); sr_[i].vs1 = *reinterpret_cast<const bf16x8*>(&Vh[(long)((k0) + 32 + sr) * LDK + sc]); \
    sr_[i].ks0 = *reinterpret_cast<const bf16x8*>(&Kh[(long)((k0) + sr) * LDK + sc]); sr_[i].ks1 = *reinterpret_cast<const bf16x8*>(&Kh[(long)((k0) + 32 + sr) * LDK + sc]); } while (0)
#define SWRITE(b, i) do { *(bf16x8*)((char*)V_lds + (b) * SHM_V + vst0) = sr_[i].vs0;          \
    *(bf16x8*)((char*)V_lds + (b) * SHM_V + vst1) = sr_[i].vs1; int kc = sc * 2;               \
    *(bf16x8*)((char*)K_lds + (b) * SHM_K + KSWZ(sr, kc)) = sr_[i].ks0;                       \
    *(bf16x8*)((char*)K_lds + (b) * SHM_K + KSWZ(32 + sr, kc)) = sr_[i].ks1; } while (0)
#define SWAIT() asm volatile("s_waitcnt vmcnt(4)" ::: "memory")
#define RESC(a) do { if (__any((a) < 1.f)) { if (hi == 0) al_l[r32] = (a); asm volatile("s_waitcnt lgkmcnt(0)" ::: "memory"); \
    for (int d = 0; d < 4; ++d) for (int r = 0; r < 16; ++r) o[d][r] *= al_l[crow(r, hi)]; } } while (0)
  f32x16 pA0, pA1, pB0, pB1; float mnA, mnB, alA, alB; bf16x8 pa0, pa1, pa2, pa3; const int NT = seq / KVBLK;
  constexpr int SE = 0, SO = 1;
  SLOAD(SE, 0); asm volatile("s_waitcnt vmcnt(0)" ::: "memory"); SWRITE(0, SE); __syncthreads();
  qkt(pA0, pA1, K_lds, qr, r32, hi); partialSM(pA0, pA1, m_reg, mnA, alA);
  SLOAD(SO, KVBLK); if (2 < NT) SLOAD(SE, 2 * KVBLK);
  SWAIT(); SWRITE(1, SO); __syncthreads();
  for (int j = 1; j + 1 < NT; j += 2) {
    SBAR(); qkt(pB0, pB1, (bf16_t*)((char*)K_lds + SHM_K), qr, r32, hi);
    finishSM(pA0, pA1, alA, l_reg, pa0, pa1, pa2, pa3); SBAR();
    SLOAD(SO, (j + 2) * KVBLK); SBAR();
    pv_d0(o, vb0, pa0, pa1, pa2, pa3); partialSM(pB0, pB1, m_reg, mnB, alB);
    __syncthreads(); SWAIT(); SWRITE(0, SE);
    RESC(alB); __syncthreads();
    SBAR(); qkt(pA0, pA1, K_lds, qr, r32, hi);
    finishSM(pB0, pB1, alB, l_reg, pa0, pa1, pa2, pa3); SBAR();
    if (j + 3 < NT) SLOAD(SE, (j + 3) * KVBLK); SBAR();
    pv_d0(o, vb0 + (int)SHM_V, pa0, pa1, pa2, pa3); partialSM(pA0, pA1, m_reg, mnA, alA);
    __syncthreads(); SWAIT(); SWRITE(1, SO);
    RESC(alA); __syncthreads();
  }
  SBAR(); qkt(pB0, pB1, (bf16_t*)((char*)K_lds + SHM_K), qr, r32, hi);
  finishSM(pA0, pA1, alA, l_reg, pa0, pa1, pa2, pa3); SBAR();
  pv_d0(o, vb0, pa0, pa1, pa2, pa3); partialSM(pB0, pB1, m_reg, mnB, alB);
  __syncthreads(); RESC(alB);
  finishSM(pB0, pB1, alB, l_reg, pa0, pa1, pa2, pa3); SBAR();
  pv_d0(o, vb0 + (int)SHM_V, pa0, pa1, pa2, pa3);
  if (hi == 0) li_l[r32] = l_reg; asm volatile("s_waitcnt lgkmcnt(0)" ::: "memory");
  float rli[16];
#pragma unroll
  for (int r = 0; r < 16; ++r) rli[r] = __builtin_amdgcn_rcpf(li_l[crow(r, hi)]);
  bf16_t* Ow = Ob + (long)(wid * QBLK) * LDO;
#pragma unroll
  for (int r = 0; r < 16; ++r) { int orow = crow(r, hi);
    for (int d0 = 0; d0 < 4; ++d0) Ow[(long)orow * LDO + d0 * 32 + r32] = f2bf(o[d0][r] * rli[r]); }
#undef SLOAD
#undef SWRITE
#undef SWAIT
#undef RESC
}
#undef KSWZ
#undef SBAR
}

__device__ __forceinline__ void ph_norm1(Frame& F, const Args& args, const float* mod) {
    const int gw = F.vcu * NWAVES + F.wave, NGW = F.G * NWAVES, lane = F.lane;
    bf16_t* H = (bf16_t*)(F.ws + WS_H); const float* nw = args.in[6];
    for (int row = gw; row < NTOK + NCTX; row += NGW) {
        const float* src = row < NTOK ? args.in[0] + (size_t)row * DM : args.in[2] + (size_t)(row - NTOK) * DM;
        const float* mr = mod + (row < NTOK ? row / SEQ : 2) * MODC;
        f32x4 v[8]; float ss = 0.f;
#pragma unroll
        for (int j = 0; j < 8; ++j) { v[j] = *(const GAS f32x4*)(src + (j * 64 + lane) * 4); ss += v[j].x * v[j].x + v[j].y * v[j].y + v[j].z * v[j].z + v[j].w * v[j].w; }
        ss = wave_sum(ss);
        const float rstd = 1.0f / sqrtf(ss * (1.0f / DM) + 1e-6f);
#pragma unroll
        for (int j = 0; j < 8; ++j) { const int i = (j * 64 + lane) * 4;
            const f32x4 w = *(const GAS f32x4*)(nw + i), sc = *(const GAS f32x4*)(mr + DM + i), sh = *(const GAS f32x4*)(mr + i);
            const f32x4 h = v[j] * rstd * w * (sc + 1.0f) + sh;
            unsigned lo = cvt_pk_bf16(h[0], h[1]), hi = cvt_pk_bf16(h[2], h[3]);
            *(GAS unsigned long long*)(H + (size_t)row * DM + i) = (unsigned long long)lo | ((unsigned long long)hi << 32); }
    }
}
__device__ __forceinline__ void ph_evenodd(Frame& F, const Args& args) {
    const int gw = F.vcu * NWAVES + F.wave, NGW = F.G * NWAVES, lane = F.lane;
    LAS bf16_t* scr = (LAS bf16_t*)(F.lds + F.wave * 16640);
    const bf16_t* UT = (const bf16_t*)(F.ws + WS_UT); bf16_t* ET = (bf16_t*)(F.ws + WS_ET); bf16_t* OT = (bf16_t*)(F.ws + WS_OT);
    float* W2 = (float*)(F.ws + WS_W2048); float* AL = (float*)(F.ws + WS_ALT);
    for (int row = gw; row < 2 * FW; row += NGW) {
        const bf16_t* src = UT + (size_t)row * SEQ; float alt = 0.f;
#pragma unroll
        for (int j = 0; j < 8; ++j) { const u32x4 w = *(const GAS u32x4*)(src + (j * 64 + lane) * 8); *(LAS u32x4*)(scr + (j * 64 + lane) * 8) = w;
            float f[8]; unpack8(w, f); alt += (f[0] - f[1]) + (f[2] - f[3]) + (f[4] - f[5]) + (f[6] - f[7]); }
        alt = wave_sum(alt);
        LDS_WAIT(); asm volatile("" ::: "memory");
        if (lane == 0) { AL[row] = alt; W2[row] = bf2f(scr[SEQ / 2]); }
#pragma unroll
        for (int j = 0; j < 4; ++j) { const int n0 = (j * 64 + lane) * 8; float e[8], o[8];
#pragma unroll
            for (int i = 0; i < 8; ++i) { const int n = n0 + i; const float a = bf2f(scr[n]), bb = bf2f(scr[(SEQ - n) & (SEQ - 1)]); e[i] = n == 0 ? a : a + bb; o[i] = n == 0 ? 0.f : a - bb; }
            u32x4 we, wo; we.x = cvt_pk_bf16(e[0], e[1]); we.y = cvt_pk_bf16(e[2], e[3]); we.z = cvt_pk_bf16(e[4], e[5]); we.w = cvt_pk_bf16(e[6], e[7]);
            wo.x = cvt_pk_bf16(o[0], o[1]); wo.y = cvt_pk_bf16(o[2], o[3]); wo.z = cvt_pk_bf16(o[4], o[5]); wo.w = cvt_pk_bf16(o[6], o[7]);
            *(GAS u32x4*)(ET + (size_t)row * 2048 + n0) = we; *(GAS u32x4*)(OT + (size_t)row * 2048 + n0) = wo; }
        LDS_WAIT(); asm volatile("" ::: "memory");
    }
}
__device__ __forceinline__ void ph_route(Frame& F, const Args& args, const float* mod) {
    const int lane = F.lane, wv = F.wave, r32 = lane & 31, hi = lane >> 5;
    LAS float* rs = (LAS float*)F.lds;
    LAS float* part = (LAS float*)(F.lds + 1024);
    LAS int* lcnt = (LAS int*)(F.lds + 1024 + 65536);
    LAS int* lbase = lcnt + 64;
    LAS int* lent = lcnt + 128;
    const float* X2 = (const float*)(F.ws + WS_X2); const float* nw = args.in[13]; const float* rb = args.in[15];
    const bf16_t* RWT = (const bf16_t*)(F.ws + WS_RWT);
    bf16_t* H2 = (bf16_t*)(F.ws + WS_H2); int* EIDX = (int*)(F.ws + WS_EIDX); float* EW = (float*)(F.ws + WS_EW); int* EPOS = (int*)(F.ws + WS_EPOS); int* CNT = (int*)(F.ws + CTL_CNT); int* TOKE = (int*)(F.ws + WS_TOKE);
    if (F.tid < NE) lcnt[F.tid] = 0;
    __syncthreads();
    int nb = 0;
    for (int blk = F.vcu; blk < NTOK / 32; blk += F.G, ++nb) {
        const int row0 = blk * 32; const float* mr = mod + (row0 / SEQ) * MODC;
#pragma unroll
        for (int i = 0; i < 4; ++i) { const float* src = X2 + (size_t)(row0 + wv * 4 + i) * DM; float ss = 0.f;
#pragma unroll
            for (int j = 0; j < 8; ++j) { const f32x4 v = *(const GAS f32x4*)(src + (j * 64 + lane) * 4); ss += v.x * v.x + v.y * v.y + v.z * v.z + v.w * v.w; }
            ss = wave_sum(ss);
            if (lane == 0) rs[wv * 4 + i] = 1.0f / sqrtf(ss * (1.0f / DM) + 1e-6f); }
        __syncthreads();
        { const float rstd = rs[r32]; const float* xr = X2 + (size_t)(row0 + r32) * DM; bf16_t* hr = H2 + (size_t)(row0 + r32) * DM;
          f32x16 acc0 = {}, acc1 = {};
#pragma unroll 4
          for (int ks = 0; ks < 16; ++ks) { const int k = wv * 256 + ks * 16 + hi * 8;
              float h[8];
#pragma unroll
              for (int q = 0; q < 2; ++q) { const f32x4 x = *(const GAS f32x4*)(xr + k + 4 * q), w = *(const GAS f32x4*)(nw + k + 4 * q), sc = *(const GAS f32x4*)(mr + 4 * DM + k + 4 * q), sh = *(const GAS f32x4*)(mr + 3 * DM + k + 4 * q);
                  const f32x4 t = x * rstd * w * (sc + 1.0f) + sh; h[4 * q] = t[0]; h[4 * q + 1] = t[1]; h[4 * q + 2] = t[2]; h[4 * q + 3] = t[3]; }
              u32x4 wh, wl; float l[8];
              wh.x = cvt_pk_bf16(h[0], h[1]); wh.y = cvt_pk_bf16(h[2], h[3]); wh.z = cvt_pk_bf16(h[4], h[5]); wh.w = cvt_pk_bf16(h[6], h[7]);
#pragma unroll
              for (int i = 0; i < 4; ++i) { l[2 * i] = h[2 * i] - __uint_as_float(wh[i] << 16); l[2 * i + 1] = h[2 * i + 1] - __uint_as_float(wh[i] & 0xffff0000u); }
              wl.x = cvt_pk_bf16(l[0], l[1]); wl.y = cvt_pk_bf16(l[2], l[3]); wl.z = cvt_pk_bf16(l[4], l[5]); wl.w = cvt_pk_bf16(l[6], l[7]);
              *(GAS u32x4*)(hr + k) = wh;
              const bf16x8 ah = __builtin_bit_cast(bf16x8, wh), al = __builtin_bit_cast(bf16x8, wl);
              const bf16x8 bh0 = *(const GAS bf16x8*)(RWT + (size_t)r32 * DM + k), bh1 = *(const GAS bf16x8*)(RWT + (size_t)(32 + r32) * DM + k);
              const bf16x8 bl0 = *(const GAS bf16x8*)(RWT + (size_t)(NE + r32) * DM + k), bl1 = *(const GAS bf16x8*)(RWT + (size_t)(NE + 32 + r32) * DM + k);
              acc0 = __builtin_amdgcn_mfma_f32_32x32x16_bf16(ah, bh0, acc0, 0, 0, 0); acc0 = __builtin_amdgcn_mfma_f32_32x32x16_bf16(ah, bl0, acc0, 0, 0, 0); acc0 = __builtin_amdgcn_mfma_f32_32x32x16_bf16(al, bh0, acc0, 0, 0, 0);
              acc1 = __builtin_amdgcn_mfma_f32_32x32x16_bf16(ah, bh1, acc1, 0, 0, 0); acc1 = __builtin_amdgcn_mfma_f32_32x32x16_bf16(ah, bl1, acc1, 0, 0, 0); acc1 = __builtin_amdgcn_mfma_f32_32x32x16_bf16(al, bh1, acc1, 0, 0, 0); }
#pragma unroll
          for (int r = 0; r < 16; ++r) { part[(wv * 32 + crow(r, hi)) * 64 + r32] = acc0[r]; part[(wv * 32 + crow(r, hi)) * 64 + 32 + r32] = acc1[r]; } }
        __syncthreads();
        for (int i = 0; i < 4; ++i) { const int rbk = wv * 4 + i, row = row0 + rbk; float logit = 0.f;
#pragma unroll
          for (int w = 0; w < 8; ++w) logit += part[(w * 32 + rbk) * 64 + lane];
          const float score = 1.0f / (1.0f + expf(-logit)), bsd = score + rb[lane];
          const int g = lane >> 3;
          int rk = 0;
#pragma unroll
          for (int q = 0; q < 8; ++q) { const int o = (lane & ~7) + q; const float vv = __shfl(bsd, o); rk += (vv > bsd) || (vv == bsd && o < lane); }
          float gs = rk < 2 ? bsd : 0.f;
          gs += __shfl_xor(gs, 1); gs += __shfl_xor(gs, 2); gs += __shfl_xor(gs, 4);
          int grk = 0;
#pragma unroll
          for (int gg = 0; gg < 8; ++gg) { const float vv = __shfl(gs, gg * 8); grk += (vv > gs) || (vv == gs && gg < g); }
          const bool gsel = grk < 4;
          const float mb = gsel ? bsd : -INFINITY;
          int erk = 0;
          for (int o = 0; o < 64; ++o) { const float vv = __shfl(mb, o); erk += (vv > mb) || (vv == mb && o < lane); }
          const bool sel = gsel && erk < TOPK;
          const float ssum = wave_sum(sel ? score : 0.f);
          if (sel) { const int lp = __hip_atomic_fetch_add(lcnt + lane, 1, __ATOMIC_RELAXED, __HIP_MEMORY_SCOPE_WORKGROUP);
                     EIDX[row * TOPK + erk] = lane; EW[row * TOPK + erk] = score / ssum * 2.5f; lent[(nb * 32 + rbk) * TOPK + erk] = (lane << 16) | lp; } }
        __syncthreads();
    }
    if (F.tid < NE) { const int c = lcnt[F.tid]; lbase[F.tid] = c ? atomicAdd(&CNT[F.tid * 64], c) : 0; }
    __syncthreads();
    for (int i = F.tid; i < nb * 256; i += NTHREADS) { const int blk = F.vcu + (i >> 8) * F.G, row = blk * 32 + ((i >> 3) & 31), v = lent[i]; const int pos = lbase[v >> 16] + (v & 0xffff); EPOS[row * TOPK + (i & 7)] = pos; TOKE[(v >> 16) * NTOK + pos] = row; }
    __syncthreads();
}
__device__ __forceinline__ void y16(const unsigned char* p, float (&f)[16]) {
    const u32x4 w = *(const GAS u32x4*)p;
#pragma unroll
    for (int i = 0; i < 4; ++i) { const auto lo = __builtin_amdgcn_cvt_pk_f32_fp8((int)w[i], false), hi = __builtin_amdgcn_cvt_pk_f32_fp8((int)w[i], true); f[4 * i] = lo[0]; f[4 * i + 1] = lo[1]; f[4 * i + 2] = hi[0]; f[4 * i + 3] = hi[1]; }
}
__device__ __forceinline__ void ph_comb(Frame& F, const Args& args, const float* mod) {
    const int gw = F.vcu * NWAVES + F.wave, NGW = F.G * NWAVES, lane = F.lane;
    moe_tables(F, 4);
    LAS int* T = (LAS int*)(F.lds + SCHT_OFF);
    const float* EW = (const float*)(F.ws + WS_EW); const int* EIDX = (const int*)(F.ws + WS_EIDX); const int* EPOS = (const int*)(F.ws + WS_EPOS); const unsigned char* Y = (const unsigned char*)(F.ws + WS_YBIG);
    for (int t = gw; t < NTOK; t += NGW) {
        const float* g2 = mod + (t / SEQ) * MODC + 5 * DM;
        int sl[TOPK]; float wk[TOPK];
#pragma unroll
        for (int k = 0; k < TOPK; ++k) { sl[k] = T[80 + EIDX[t * TOPK + k]] + EPOS[t * TOPK + k]; wk[k] = EW[t * TOPK + k]; }
#pragma unroll
        for (int j = 0; j < 2; ++j) { const int col = j * 1024 + lane * 16;
            float a[16]; y16(Y + (size_t)(NSLOT + t) * DM + col, a);
#pragma unroll
            for (int k = 0; k < TOPK; ++k) { float y[16]; y16(Y + (size_t)sl[k] * DM + col, y);
#pragma unroll
                for (int c = 0; c < 16; ++c) a[c] += wk[k] * y[c]; }
            float* o = args.out + (size_t)t * DM + col; const float* xi = (const float*)(F.ws + WS_X2) + (size_t)t * DM + col;
#pragma unroll
            for (int n = 0; n < 4; ++n) { const f32x4 xv = *(const GAS f32x4*)(xi + 4 * n), gv = *(const GAS f32x4*)(g2 + col + 4 * n);
                *(GAS f32x4*)(o + 4 * n) = xv + gv * (f32x4){a[4 * n], a[4 * n + 1], a[4 * n + 2], a[4 * n + 3]}; } }
    }
}

enum { PH_PRO = 0, PH_NORM1, PH_INPROJ, PH_QKNORM, PH_ATTN, PH_F2, PH_MERGE, PH_OUT, PH_ROUTE, PH_EXP1, PH_EXP2, PH_COMB, PH_END };


__global__ void __launch_bounds__(NTHREADS, 2) fwd(Args args) {
    extern __shared__ __attribute__((aligned(16))) unsigned char lds_raw[];
    Frame F;
    F.lds = (LAS unsigned char*)lds_raw; F.MISC = (volatile LAS unsigned*)(F.lds + MISC_OFF); F.ws = args.ws;
    F.tid = threadIdx.x; F.lane = F.tid & 63; F.wave = __builtin_amdgcn_readfirstlane(F.tid >> 6);
    F.G = gridDim.x; { const int bx = blockIdx.x; F.vcu = (F.G % 8 == 0) ? (bx % 8) * (F.G / 8) + bx / 8 : bx; }
    for (int u = F.tid; u < (LDS_BYTES - LDSCTL_OFF) / 4; u += NTHREADS) ((LAS unsigned*)(F.lds + LDSCTL_OFF))[u] = 0u;
    __syncthreads();
    const int lo = args.ph_lo, hi = args.ph_hi;
    const bool multi = (hi - lo) > 1;
    unsigned* barw = (unsigned*)(args.ws + CTL_BAR) + args.bar_idx * XCD_BAR_WORDS;
    XcdBarrier bar; bar.bar = barw; bar.x = 0; bar.st = nullptr;
    if (multi) bar = xcd_barrier_post(barw, F.MISC + 8);
#define IN(k) (lo <= (k) && (k) < hi)
#define SEAM(k) do { if (IN((k) + 1)) xcd_barrier(bar); } while (0)

    const float* modp = (const float*)(args.ws + args.mod_off);
    if (IN(PH_PRO)) { p0_prologue(F, args); SEAM(PH_PRO); }
    if (IN(PH_NORM1)) { ph_norm1(F, args, modp); SEAM(PH_NORM1); }
    if (IN(PH_INPROJ)) {
        SchedIn S{F.G, (int)blockIdx.x, args.ws, args.use_ut};
        EpiIn E{EpiStore{(const float*)(args.ws + WS_W2048)}, (LAS float*)(F.lds + GPARK_OFF), args.in[8], args.in[9], (const float*)(args.ws + WS_ROPE)};
        gemm_phase<EpiIn, SchedIn, false>(F.lds, DM, DM, DM, S, E);
        SEAM(PH_INPROJ);
    }
    if (IN(PH_QKNORM)) { ph_evenodd(F, args); SEAM(PH_QKNORM); }
    if (IN(PH_ATTN)) {
        const int cs = F.vcu & 3;
        constexpr int NCONV = IT_EG + IT_EU + IT_ED;
        int qfirst, qcnt; { const int c = (int)blockIdx.x; if (F.G == 256) { qfirst = c < 136 ? c * 162 : 136 * 162 + (c - 136) * 226; qcnt = c < 136 ? 162 : 226; }
                             else { const int per = (NCONV + F.G - 1) / F.G; qfirst = c * per; qcnt = qfirst + per <= NCONV ? per : (NCONV - qfirst > 0 ? NCONV - qfirst : 0); } }
        const int gcnt = qfirst < IT_EG + IT_EU ? (qfirst + qcnt <= IT_EG + IT_EU ? qcnt : IT_EG + IT_EU - qfirst) : 0, gfirst = qfirst;
        const int ccnt = qcnt - gcnt, cfirst = qfirst + gcnt - (IT_EG + IT_EU);
#define CONV_ALL() do { conv_items(F, args, false, gfirst, gcnt); conv_items(F, args, true, cfirst, ccnt); } while (0)
        const bf16_t* Qp = (const bf16_t*)(args.ws + WS_Q); const bf16_t* Kp = (const bf16_t*)(args.ws + WS_KALL); const bf16_t* Vp = (const bf16_t*)(args.ws + WS_VALL); bf16_t* Op = (bf16_t*)(args.ws + WS_YA);
#define ATTN_UNIT(lin_) do { const int lin = (lin_); if (lin < 512) { const int x = (lin >> 5) & 7, j = (lin & 31) + 32 * (lin >> 8), b = x >> 2, kvh = x & 3, head = kvh * 4 + (j >> 4), qb = j & 15; \
            const size_t qo = ((size_t)(b * SEQ + qb * 256)) * DM + head * HD, ko = (size_t)b * SKV * KVW + kvh * HD; \
            attn::attn_dense_body(Qp + qo, Kp + ko, Vp + ko, Op + qo, SKV, (char*)lds_raw); __syncthreads(); } } while (0)
        if (cs == 0) { CONV_ALL(); __syncthreads(); }
        ATTN_UNIT(F.vcu);
        if (cs == 1) { CONV_ALL(); __syncthreads(); }
        ATTN_UNIT(F.vcu + F.G);
        for (int lin2 = F.vcu + 2 * F.G; lin2 < 512; lin2 += F.G) ATTN_UNIT(lin2);
        if (cs == 2) { CONV_ALL(); __syncthreads(); }
#undef ATTN_UNIT
        SchedAG S{F.G, (int)blockIdx.x, args.ws};
        gemm_phase<EpiStore, SchedAG, false>(F.lds, DM, DM, DM, S, EpiStore{(const float*)(args.ws + WS_W2048)});
        if (cs == 3) { __syncthreads(); CONV_ALL(); }
#undef CONV_ALL
        SEAM(PH_ATTN);
    }
    if (IN(PH_F2)) {
        SchedF2 S{F.G, (int)blockIdx.x, args.ws};
        gemm_phase<EpiStore, SchedF2, false>(F.lds, 512, DM, 512, S, EpiStore{(const float*)(args.ws + WS_W2048)});
        {
            const int idx = F.vcu * NTHREADS + F.tid;
            if (idx < 2 * FW) { const int b = idx >> 10, col = idx & 1023, k2 = col & 127; const float* al = (const float*)(args.ws + WS_ALT) + b * FW + (col & ~127); float s = 0.f;
                for (int c = 0; c < 128; ++c) s += al[c] * cospif((float)((c * k2) & 127) * (1.0f / 64.0f));
                ((bf16_t*)(args.ws + WS_YF))[((size_t)b * SEQ + SEQ / 2) * YFP + col] = f2bf(s * 0.0013810679320049757f); }
        }
        SEAM(PH_F2);
    }
    if (IN(PH_MERGE)) {
        unsigned char* ws = args.ws;
        SchedMerge S{F.G, (int)blockIdx.x, ws};
        gemm_phase<EpiMerge, SchedMerge, false>(F.lds, DM, DM, DM, S, EpiMerge{(const bf16_t*)(ws + WS_SGF), (const bf16_t*)(ws + WS_SGA), (bf16_t*)(ws + WS_YM)});
        SEAM(PH_MERGE);
    }
    if (IN(PH_OUT)) {
        unsigned char* ws = args.ws;
        SchedGrid S{F.G, (int)blockIdx.x, 32, 8, (const char*)(ws + WS_YM), (const char*)(ws + WS_WT_O), nullptr, (size_t)256 * DM * 2, (size_t)256 * DM * 2, DM, 4, 1, DM / BK};
        gemm_phase<EpiX2, SchedGrid, false>(F.lds, DM, DM, DM, S, EpiX2{args.in[0], modp, (float*)(ws + WS_X2)});
        SEAM(PH_OUT);
    }
    if (IN(PH_ROUTE)) { ph_route(F, args, modp); SEAM(PH_ROUTE); }
    if (IN(PH_EXP1)) {
        moe_tables(F, 4);
        SchedMoe<4, true> S{F.G, F.vcu, args.ws, (LAS int*)(F.lds + SCHT_OFF), (const int*)(args.ws + WS_TOKE)};
        gemm_phase<EpiAct, SchedMoe<4, true>, true>(F.lds, DM, DM, DM, S, EpiAct{});
        SEAM(PH_EXP1);
    }
    if (IN(PH_EXP2)) {
        moe_tables(F, 8);
        SchedMoe<8, false> S{F.G, F.vcu, args.ws, (LAS int*)(F.lds + SCHT_OFF), (const int*)(args.ws + WS_TOKE)};
        gemm_phase<EpiY8, SchedMoe<8, false>, false>(F.lds, EFF, EFF, EFF, S, EpiY8{});
        SEAM(PH_EXP2);
    }
    if (IN(PH_COMB)) { ph_comb(F, args, modp); }
#undef IN
#undef SEAM
}
}

extern "C" void kernel_launch(void* const* d_in, const int* in_sizes, int n_in, void* d_out, int out_size, void* d_ws, size_t ws_size, hipStream_t stream) {
    if (n_in != 22 || ws_size < WS_END2) return;
    float* out = (float*)d_out;
    unsigned char* ws = (unsigned char*)d_ws;
    hipMemsetAsync(ws + WS_CTL, 0, CTL_ZERO_BYTES, stream);
    static int grid = 0;
    if (!grid) {
        int dev = 0, cus = 0;
        if (hipGetDevice(&dev) != hipSuccess || hipDeviceGetAttribute(&cus, hipDeviceAttributeMultiprocessorCount, dev) != hipSuccess) { grid = -1; return; }
        if (hipFuncSetAttribute((const void*)mk::fwd, hipFuncAttributeMaxDynamicSharedMemorySize, mk::LDS_BYTES) != hipSuccess) { grid = -1; return; }
        grid = cus;
    }
    if (grid < 0) return;
    mk::Args a{}; int nlaunch = 0;
    for (int i = 0; i < 22; ++i) a.in[i] = (const float*)d_in[i];
    a.out = out; a.ws = ws; a.use_ut = 1; a.mod_off = (int)WS_MOD; a.do_attn = 1;
#define MK_LAUNCH(lo_, hi_) do { a.ph_lo = (lo_); a.ph_hi = (hi_); a.bar_idx = nlaunch++; hipLaunchKernelGGL(mk::fwd, dim3(grid), dim3(mk::NTHREADS), mk::LDS_BYTES, stream, a); } while (0)
    MK_LAUNCH(mk::PH_PRO, mk::PH_END);
}
```

```cpp
#include <hip/hip_runtime.h>
#include <stdint.h>
#include <math.h>

typedef unsigned short bf16_t;
typedef short bf16x8 __attribute__((ext_vector_type(8)));
typedef float f32x16 __attribute__((ext_vector_type(16)));
typedef float f32x4 __attribute__((ext_vector_type(4)));

constexpr int NB = 2, SEQ = 4096, DM = 2048, NTOK = NB * SEQ, CTXL = 256, NCTX = NB * CTXL, HD = 128, NH = 16, NKV = 4;
constexpr int SKV = SEQ + CTXL;
constexpr int FW = 1024, INC = 8192, Q_OFF = 1024, K_OFF = 3072, V_OFF = 3584, GF_OFF = 4096, GA_OFF = 6144;
constexpr int KVW = NKV * HD;
constexpr int NE = 64, TOPK = 8, EFF = 512, MODC = 6 * DM;
constexpr int NSLOT = NTOK * TOPK;
constexpr int NSLOT_ALL = NSLOT + NTOK;

constexpr size_t MiB = 1u << 20;
constexpr size_t WS_CTL = 0, CTL_ZERO_BYTES = 1 * MiB;
constexpr size_t CTL_CNT = 64 * 1024;
constexpr size_t WS_TW = 1 * MiB;
constexpr size_t WS_MOD = 1 * MiB + 64 * 1024;
constexpr size_t WS_OFFS = 1 * MiB + 256 * 1024;
constexpr size_t WS_EIDX = 2 * MiB;
constexpr size_t WS_EW = WS_EIDX + 256 * 1024;
constexpr size_t WS_EPOS = WS_EW + 256 * 1024;
constexpr size_t WS_SLOTOF = WS_EPOS + 256 * 1024;
constexpr size_t WS_TOKE = 300 * MiB;
constexpr size_t WS_H = 4 * MiB;
constexpr size_t WS_U = 38 * MiB;
constexpr size_t WS_Q = 54 * MiB;
constexpr size_t WS_KALL = 86 * MiB;
constexpr size_t WS_VALL = 95 * MiB;
constexpr size_t WS_SGF = 104 * MiB;
constexpr size_t WS_SGA = 136 * MiB;
constexpr size_t WS_YA = 168 * MiB;
constexpr size_t WS_YF = 38 * MiB;
constexpr int YFP = 2048;
constexpr size_t WS_PR = 216 * MiB;
constexpr size_t WS_T1 = 248 * MiB;
constexpr size_t WS_YM = 312 * MiB;
constexpr size_t WS_QKRAW = 248 * MiB;
constexpr size_t WS_KCRAW = 330 * MiB;
constexpr size_t WS_H2 = 344 * MiB;
constexpr size_t WS_ACT = 376 * MiB;
constexpr size_t WS_YBIG = 4 * MiB;
constexpr size_t WS_END = 740 * MiB;

__device__ __forceinline__ float bf2f(bf16_t h) { return __uint_as_float(((unsigned)h) << 16); }
__device__ __forceinline__ bf16_t f2bf(float f) { unsigned u = __float_as_uint(f); return (bf16_t)((u + 0x7fffu + ((u >> 16) & 1u)) >> 16); }
__device__ __forceinline__ int crow(int r, int hi) { return (r & 3) + 8 * (r >> 2) + 4 * hi; }
__device__ __forceinline__ float wave_sum(float v) {
#pragma unroll
    for (int o = 1; o < 64; o <<= 1) v += __shfl_xor(v, o);
    return v;
}
__device__ __forceinline__ float sigmoidf_(float v) { return 1.0f / (1.0f + expf(-v)); }
__device__ __forceinline__ bf16x8 pack8(const float* f) {
    bf16x8 r;
#pragma unroll
    for (int i = 0; i < 8; ++i) r[i] = (short)f2bf(f[i]);
    return r;
}

#define LAS __attribute__((address_space(3)))
#define GAS __attribute__((address_space(1)))
typedef unsigned u32x4 __attribute__((ext_vector_type(4)));
typedef GAS unsigned gu32;
#define RLX_AGENT __ATOMIC_RELAXED, __HIP_MEMORY_SCOPE_AGENT
#define LDS_WAIT() asm volatile("s_waitcnt lgkmcnt(0)" ::: "memory")
#define VM_WAIT() asm volatile("s_waitcnt vmcnt(0)" ::: "memory")

constexpr size_t CTL_BAR = 16384;
constexpr size_t CTL_MODZ = 512 * 1024;
constexpr size_t WS_UT = 38 * MiB;
constexpr size_t WS_TT = 216 * MiB;
constexpr size_t WS_WT_GU = 450 * MiB;
constexpr size_t WS_WT_D = 710 * MiB;
constexpr size_t WS_WT_IN = 840 * MiB;
constexpr size_t WS_WT_FO = 924 * MiB;
constexpr size_t WS_WT_AO = 876 * MiB;
constexpr size_t WS_WT_O = 884 * MiB;
constexpr size_t WS_CST = 892 * MiB;
constexpr size_t WS_ET = 908 * MiB;
constexpr size_t WS_OT = 916 * MiB;
constexpr size_t WS_W2048 = 1 * MiB + 512 * 1024;
constexpr size_t WS_ALT = 1 * MiB + 520 * 1024;
constexpr size_t WS_ROPE = 1 * MiB + 528 * 1024;
constexpr size_t WS_RWT = 3 * MiB + 512 * 1024;
constexpr size_t WS_BD2 = 956 * MiB;
constexpr size_t WS_X2 = 960 * MiB;
constexpr size_t WS_END2 = 1024 * MiB;

namespace mk {
constexpr int NWAVES = 8, NTHREADS = 512;
constexpr int RING_BYTES = 131072, SCR_BYTES = 8 * 16640, LDSCTL_OFF = 135168, MISC_OFF = LDSCTL_OFF + 320, GPARK_OFF = LDSCTL_OFF + 2048  , LDS_BYTES = 147456;
static_assert(GPARK_OFF + 8192 <= LDS_BYTES, "LDS map");
static_assert(SCR_BYTES <= LDSCTL_OFF && MISC_OFF + 128 <= LDS_BYTES, "LDS map");

#define XB_TMO      128
#define XB_XCNT(j)  (256  + 64 * (j))
#define XB_XSUB(j)  (1280 + 64 * (j))
#define XB_XGEN(j)  (2304 + 64 * (j))
#define XB_TOP      3328
#define XB_TOPGEN   3392
#define XCD_BAR_WORDS 3456
#define XB_SPIN_CAP (1u << 18)
__device__ __forceinline__ unsigned xb_ld(unsigned* p)              { return __hip_atomic_load(p, __ATOMIC_RELAXED, __HIP_MEMORY_SCOPE_AGENT); }
__device__ __forceinline__ unsigned xb_add(unsigned* p, unsigned v) { return __hip_atomic_fetch_add(p, v, __ATOMIC_RELAXED, __HIP_MEMORY_SCOPE_AGENT); }
__device__ __forceinline__ unsigned xb_xcc_id() { return (unsigned)__builtin_amdgcn_s_getreg((3 << 11) | 20) & 0xFu; }
#define XB_SPIN(cond, bar) do { unsigned _sp = 0; while (cond) { __builtin_amdgcn_s_sleep(1); \
    if ((++_sp & 255u) == 0u) { if (xb_ld(&(bar)[XB_TMO])) break; if (_sp > XB_SPIN_CAP) { atomicAdd(&(bar)[XB_TMO], 1u); break; } } } } while (0)
struct XcdBarrier { unsigned* bar; unsigned x; volatile LAS unsigned* st; };
__device__ __forceinline__ XcdBarrier xcd_barrier_post(unsigned* bar, volatile LAS unsigned* st) {
    XcdBarrier b; b.bar = bar; b.x = xb_xcc_id(); b.st = st;
    if (threadIdx.x == 0) (void)xb_add(&bar[XB_XCNT(b.x)], 1u);
    return b;
}
__device__ __forceinline__ void xcd_barrier_complete(unsigned* bar, unsigned x, unsigned& nloc, unsigned& nx) {
    const unsigned G = gridDim.x * gridDim.y * gridDim.z;
    unsigned sum, cnt, mine, sp = 0u;
    for (;;) {
        sum = 0u; cnt = 0u; mine = 0u;
#pragma unroll
        for (unsigned j = 0; j < 16; ++j) { const unsigned c = xb_ld(&bar[XB_XCNT(j)]); sum += c; cnt += (c > 0u) ? 1u : 0u; mine = (j == x) ? c : mine; }
        if (sum == G) break;
        __builtin_amdgcn_s_sleep(1);
        if ((++sp & 255u) == 0u) { if (xb_ld(&bar[XB_TMO])) break; if (sp > XB_SPIN_CAP) { atomicAdd(&bar[XB_TMO], 1u); break; } }
    }
    nloc = mine > 0u ? mine : 1u; nx = cnt > 0u ? cnt : 1u;
}
__device__ __forceinline__ void xcd_barrier(const XcdBarrier& b) {
    asm volatile("s_waitcnt vmcnt(0)" ::: "memory");
    __syncthreads();
    if (threadIdx.x == 0) {
        unsigned* bar = b.bar;
        __builtin_amdgcn_s_waitcnt(0);
        unsigned nloc = b.st[0], nx = b.st[1];
        if (nloc == 0u) { xcd_barrier_complete(bar, b.x, nloc, nx); b.st[0] = nloc; b.st[1] = nx; }
        const unsigned old = xb_add(&bar[XB_XSUB(b.x)], 1u);
        const unsigned gen = old / nloc;
        if (old + 1u == (gen + 1u) * nloc) {
            __builtin_amdgcn_fence(__ATOMIC_RELEASE, "agent");
            asm volatile("s_waitcnt vmcnt(0)" ::: "memory");
            const unsigned og = xb_add(&bar[XB_TOP], 1u);
            const unsigned tg = og / nx;
            if (og + 1u == (tg + 1u) * nx) xb_add(&bar[XB_TOPGEN], 1u);
            else XB_SPIN(xb_ld(&bar[XB_TOPGEN]) == tg, bar);
            __builtin_amdgcn_fence(__ATOMIC_ACQUIRE, "agent");
            xb_add(&bar[XB_XGEN(b.x)], 1u);
            asm volatile("s_waitcnt vmcnt(0)" ::: "memory");
        } else {
            XB_SPIN(xb_ld(&bar[XB_XGEN(b.x)]) == gen, bar);
            __builtin_amdgcn_fence(__ATOMIC_ACQUIRE, "agent");
            asm volatile("s_waitcnt vmcnt(0)" ::: "memory");
        }
    }
    __syncthreads();
}

constexpr int BM = 256, BK = 64, HALF = 128, HTB = HALF * BK * 2, STAGE_BYTES = 8 * HTB;
__device__ __forceinline__ int lds_byte(int r, int c) { const int st = (r >> 4) * 2 + (c >> 5), rr = r & 15, cc = c & 31, ob = rr * 64 + cc * 2; return st * 1024 + (ob ^ (((ob >> 9) & 1) << 5)); }
__device__ __forceinline__ void stage_rc(int b, int& R, int& C) { const int st = b / 1024, sb = b % 1024, swz = sb ^ (((sb >> 9) & 1) << 5); R = (st >> 1) * 16 + swz / 64; C = (st & 1) * 32 + (swz % 64) / 2; }
__device__ __forceinline__ int perm32(int rho) { const int n = rho >> 4, i = rho & 15; return 8 * (i >> 2) + 4 * n + (i & 3); }
__device__ __forceinline__ unsigned cvt_pk_bf16(float lo, float hi) { unsigned r; asm("v_cvt_pk_bf16_f32 %0, %1, %2" : "=v"(r) : "v"(lo), "v"(hi)); return r; }

__device__ __forceinline__ void glds16_s(const void* sbase, unsigned voff, unsigned lds_dst) { unsigned keep;
    asm volatile("s_mov_b32 %0, m0\n\ts_mov_b32 m0, %3\n\ts_nop 0\n\tglobal_load_lds_dwordx4 %1, %2\n\ts_mov_b32 m0, %0" : "=&s"(keep) : "v"(voff), "s"(sbase), "s"(lds_dst) : "memory"); }

struct Unit { const char* A; const char* B; char* C; int ldc; int mode; int rows; int aux; int pm, pn, bjs, rmin, e, nt, keep; };

typedef int i32x8 __attribute__((ext_vector_type(8)));
typedef int i32x4 __attribute__((ext_vector_type(4)));
template <class Epi, class Sched, bool GATHER, bool F8 = false>
__device__ __forceinline__ void gemm_phase(LAS unsigned char* lds, const int K, const int lda, const int ldb, const Sched& S, const Epi& E, const int i0 = 0, const int i1 = 0x7fffffff) {
    const int tid = threadIdx.x, wid = __builtin_amdgcn_readfirstlane(tid >> 6), lane = tid & 63, wr = wid >> 2, wc = wid & 3, fr = lane & 15, fq = lane >> 4;
    unsigned voffA[2], voffB[2];
#pragma unroll
    for (int i = 0; i < 2; ++i) { int R, C; stage_rc(tid * 16 + i * 8192, R, C); const int Rb = (R & ~31) + perm32(R & 31);
        voffA[i] = (unsigned)(R * lda + C) * 2u; voffB[i] = (unsigned)(Rb * ldb + C) * 2u; }
    const size_t kstep = (size_t)(BK * 2);
    const size_t hstepA = (size_t)HALF * lda * 2, hstepB = (size_t)HALF * ldb * 2;
    const unsigned ldsw = (unsigned)wid * 1024u;
    const unsigned ldsbase = (unsigned)__builtin_amdgcn_readfirstlane((int)(unsigned)(uintptr_t)lds);
    const int aoff = F8 ? lds_byte(wr * 64 + fr, (fq >> 1) * 32 + (fq & 1) * 16) : lds_byte(wr * 64 + fr, fq * 8), boff = F8 ? lds_byte(wc * 32 + fr, (fq >> 1) * 32 + (fq & 1) * 16) : lds_byte(wc * 32 + fr, fq * 8);

#define MK_SA(b, h) (((b) * 2 + (h)) * HTB)
#define MK_SB(b, h) ((4 + (b) * 2 + (h)) * HTB)
#define MK_STAGE2(bufoff, gbase, v0, v1) do { \
        __builtin_amdgcn_global_load_lds((const unsigned*)((const char*)(gbase) + (v0)), (LAS unsigned*)(lds + (bufoff) + ldsw), 16, 0, 0); \
        __builtin_amdgcn_global_load_lds((const unsigned*)((const char*)(gbase) + (v1)), (LAS unsigned*)(lds + (bufoff) + ldsw + 8192), 16, 0, 0); } while (0)
#define MK_STAGE_B(bufoff, gbase) do { glds16_s((gbase), voffB[0], ldsbase + (bufoff) + ldsw); glds16_s((gbase), voffB[1], ldsbase + (bufoff) + ldsw + 8192u); } while (0)
#define MK_STAGE_A(bufoff, gbase, h, VA) do { if constexpr (GATHER) { glds16_s((gbase), (VA)[h][0], ldsbase + (bufoff) + ldsw); glds16_s((gbase), (VA)[h][1], ldsbase + (bufoff) + ldsw + 8192u); } \
        else { glds16_s((gbase) + (h) * hstepA, voffA[0], ldsbase + (bufoff) + ldsw); glds16_s((gbase) + (h) * hstepA, voffA[1], ldsbase + (bufoff) + ldsw + 8192u); } } while (0)
#define MK_LDA(dst, b, h) do { if constexpr (F8) { _Pragma("unroll") for (int m = 0; m < 4; ++m) dst##8[m] = *(const LAS i32x8*)(lds + MK_SA(b, h) + aoff + m * 2048); } \
        else { _Pragma("unroll") for (int m = 0; m < 4; ++m) _Pragma("unroll") for (int k = 0; k < 2; ++k) dst[m][k] = *(const LAS bf16x8*)(lds + MK_SA(b, h) + aoff + m * 2048 + k * 1024); } } while (0)
#define MK_LDB(dst, b, h) do { if constexpr (F8) { _Pragma("unroll") for (int n = 0; n < 2; ++n) dst##8[n] = *(const LAS i32x8*)(lds + MK_SB(b, h) + boff + n * 2048); } \
        else { _Pragma("unroll") for (int n = 0; n < 2; ++n) _Pragma("unroll") for (int k = 0; k < 2; ++k) dst[n][k] = *(const LAS bf16x8*)(lds + MK_SB(b, h) + boff + n * 2048 + k * 1024); } } while (0)
#define MK_MMA(ai, bj, At, Bt) do { __builtin_amdgcn_s_setprio(1); \
        if constexpr (F8) { _Pragma("unroll") for (int m = 0; m < 4; ++m) _Pragma("unroll") for (int n = 0; n < 2; ++n) \
            acc[ai][bj][m][n] = __builtin_amdgcn_mfma_scale_f32_16x16x128_f8f6f4(Bt##8[n], At##8[m], acc[ai][bj][m][n], 0, 0, 0, 0x7d, 0, 0x7d  ); } \
        else { _Pragma("unroll") for (int m = 0; m < 4; ++m) _Pragma("unroll") for (int n = 0; n < 2; ++n) _Pragma("unroll") for (int k = 0; k < 2; ++k) \
            acc[ai][bj][m][n] = __builtin_amdgcn_mfma_f32_16x16x32_bf16(Bt[n][k], At[m][k], acc[ai][bj][m][n], 0, 0, 0); } \
        __builtin_amdgcn_s_setprio(0); } while (0)
#define MK_WAIT_V(n) asm volatile("s_waitcnt vmcnt(" #n ")" ::: "memory")
#define MK_WAIT_L(n) asm volatile("s_waitcnt lgkmcnt(" #n ")" ::: "memory")
#define MK_BAR __builtin_amdgcn_s_barrier()
#define MK_SCHED __builtin_amdgcn_sched_barrier(0)
    Unit cur, nxt; int ui = i0;
    if (i0 >= i1 || !S.next(i0, cur)) return;
    f32x4 acc[2][2][4][2];
#pragma unroll
    for (int a = 0; a < 2; ++a)
#pragma unroll
        for (int b = 0; b < 2; ++b)
#pragma unroll
            for (int m = 0; m < 4; ++m)
#pragma unroll
                for (int n = 0; n < 2; ++n) acc[a][b][m][n] = (f32x4){0.f, 0.f, 0.f, 0.f};
    bf16x8 At[4][2], B0[2][2], B1[2][2]; i32x8 At8[4], B08[2], B18[2];
    unsigned vC[2][2];
    LAS u32x4* vpark = (LAS u32x4*)(lds + GPARK_OFF) + tid;
    if constexpr (GATHER) {
#pragma unroll
        for (int h = 0; h < 2; ++h)
#pragma unroll
            for (int i = 0; i < 2; ++i) { int R, C; stage_rc(tid * 16 + i * 8192, R, C); vC[h][i] = S.arow(cur, h * HALF + R) + (unsigned)(C * 2); }
    }
    const char* cA = cur.A; const char* cB = cur.B;
    MK_STAGE_B(MK_SB(0, 0), cB); MK_STAGE_B(MK_SB(0, 1), cB + hstepB); MK_STAGE_A(MK_SA(0, 0), cA, 0, vC); MK_STAGE_A(MK_SA(0, 1), cA, 1, vC);
    if (wr == 1) MK_BAR;
    MK_WAIT_V(2); MK_BAR;
    MK_STAGE_B(MK_SB(1, 0), cB + kstep); MK_STAGE_A(MK_SA(1, 0), cA + kstep, 0, vC); MK_STAGE_B(MK_SB(1, 1), cB + hstepB + kstep);
    MK_WAIT_V(6); MK_BAR;
    for (;;) {
        const bool has_next = (ui + 1 < i1) && S.next(ui + 1, nxt);
        const char* nA = has_next ? nxt.A : cA; const char* nB = has_next ? nxt.B : cB;
        if constexpr (GATHER) {
            u32x4 pv;
#pragma unroll
            for (int h = 0; h < 2; ++h)
#pragma unroll
                for (int i = 0; i < 2; ++i) { int R, C; stage_rc(tid * 16 + i * 8192, R, C); pv[h * 2 + i] = has_next ? (S.arow(nxt, h * HALF + R) + (unsigned)(C * 2)) : vC[h][i]; }
            *vpark = pv;
        }
        int nt = cur.nt; asm volatile("" : "+s"(nt));
#pragma nounroll
        for (int t = 0; t < nt; t += 2) {
            const bool last = (t == nt - 2);
            const char* a1 = cA + (size_t)(t + 1) * kstep;
            const char* a2 = last ? nA : cA + (size_t)(t + 2) * kstep; const char* b2 = last ? nB : cB + (size_t)(t + 2) * kstep;
            const char* a3 = a2 + kstep; const char* b3 = b2 + kstep;
            MK_LDB(B0, 0, 0); MK_LDB(B1, 0, 1); MK_SCHED; MK_LDA(At, 0, 0); MK_STAGE_A(MK_SA(1, 1), a1, 1, vC);
            if constexpr (GATHER) { if (last) { const u32x4 pv = *vpark; vC[0][0] = pv[0]; vC[0][1] = pv[1]; vC[1][0] = pv[2]; vC[1][1] = pv[3]; } }
            MK_WAIT_V(8); MK_WAIT_L(0); MK_BAR; MK_MMA(0, 0, At, B0); MK_MMA(0, 1, At, B1); MK_BAR; MK_SCHED;
            MK_LDA(At, 0, 1); MK_STAGE_B(MK_SB(0, 0), b2); MK_STAGE_B(MK_SB(0, 1), b2 + hstepB); MK_STAGE_A(MK_SA(0, 0), a2, 0, vC);
            MK_WAIT_V(8); MK_WAIT_L(0); MK_BAR; MK_MMA(1, 0, At, B0); MK_MMA(1, 1, At, B1); MK_BAR; MK_SCHED;
            MK_LDB(B0, 1, 0); MK_LDB(B1, 1, 1); MK_SCHED; MK_LDA(At, 1, 0); MK_STAGE_A(MK_SA(0, 1), a2, 1, vC);
            MK_WAIT_V(8); MK_WAIT_L(0); MK_BAR; MK_MMA(0, 0, At, B0); MK_MMA(0, 1, At, B1); MK_BAR; MK_SCHED;
            MK_LDA(At, 1, 1); MK_STAGE_B(MK_SB(1, 0), b3); MK_STAGE_B(MK_SB(1, 1), b3 + hstepB); MK_STAGE_A(MK_SA(1, 0), a3, 0, vC);
            MK_WAIT_V(8); MK_WAIT_L(0); MK_BAR; MK_MMA(1, 0, At, B0); MK_MMA(1, 1, At, B1); MK_BAR; MK_SCHED;
        }
        if (wr == 0) MK_BAR;
        { int fr2 = fr, fq2 = fq; asm volatile("" : "+v"(fr2), "+v"(fq2));
          E(acc, cur, wr, wc, fr2, fq2); }
        if (!has_next) break;
        if (!cur.keep)
#pragma unroll
        for (int a = 0; a < 2; ++a)
#pragma unroll
            for (int b = 0; b < 2; ++b)
#pragma unroll
                for (int m = 0; m < 4; ++m)
#pragma unroll
                    for (int n = 0; n < 2; ++n) acc[a][b][m][n] = (f32x4){0.f, 0.f, 0.f, 0.f};
        cur = nxt; cA = nA; cB = nB; ++ui;
        if (wr == 1) MK_BAR;
    }
    MK_WAIT_V(0);
    MK_BAR;
#undef MK_SA
#undef MK_SB
#undef MK_STAGE2
#undef MK_STAGE_B
#undef MK_STAGE_A
#undef MK_LDA
#undef MK_LDB
#undef MK_MMA
#undef MK_WAIT_V
#undef MK_WAIT_L
#undef MK_BAR
#undef MK_SCHED
}

__device__ __forceinline__ void grid_map(int L, int nM, int nN, int& pm, int& pn) {
    const int nwg = nM * nN, q = nwg / 8, xcd = L % 8, off = L / 8; const int wgid = xcd * q + off;
    const int nig = 8 * nN, gid = wgid / nig, fm = gid * 8, gsz = (nM - fm) < 8 ? (nM - fm) : 8;
    pm = fm + ((wgid % nig) % gsz); pn = (wgid % nig) / gsz;
}

struct EpiStore {
    const float* w2048;
    __device__ __forceinline__ void operator()(f32x4 (&acc)[2][2][4][2], const Unit& u, int wr, int wc, int fr, int fq) const {
        const int col0 = wc * 32 + 8 * fq;
#pragma unroll
        for (int ai = 0; ai < 2; ++ai)
#pragma unroll
            for (int m = 0; m < 4; ++m) {
                const int r = ai * HALF + wr * 64 + m * 16 + fr;
                if (r < u.rows && r >= u.rmin) {
#pragma unroll
                    for (int bj = 0; bj < 2; ++bj) {
                        f32x4 v0 = acc[ai][bj][m][0], v1 = acc[ai][bj][m][1];
                        if (u.mode == 1) { float* p = (float*)u.C + (long)r * u.ldc + col0 + bj * u.bjs; *(f32x4*)p = v0; *(f32x4*)(p + 4) = v1; }
                        else {
                            if (u.mode == 2) {
#pragma unroll
                                for (int c = 0; c < 4; ++c) { v0[c] = __builtin_amdgcn_rcpf(1.0f + __expf(-v0[c])); v1[c] = __builtin_amdgcn_rcpf(1.0f + __expf(-v1[c])); }
                            } else if (u.mode == 3) {
                                const float* wp = w2048 + u.pn + bj * HALF + col0; const float sg = (r & 1) ? -1.0f : 1.0f;
                                v0 += *(const f32x4*)wp * sg; v1 += *(const f32x4*)(wp + 4) * sg;
                            }
                            u32x4 w; w.x = cvt_pk_bf16(v0[0], v0[1]); w.y = cvt_pk_bf16(v0[2], v0[3]); w.z = cvt_pk_bf16(v1[0], v1[1]); w.w = cvt_pk_bf16(v1[2], v1[3]);
                            *(u32x4*)((bf16_t*)u.C + (long)r * u.ldc + col0 + bj * u.bjs) = w;
                        }
                    }
                }
            }
    }
};


struct EpiIn { EpiStore base; LAS float* red; const float* qnw; const float* knw; const float* rope;
    __device__ __forceinline__ void operator()(f32x4 (&acc)[2][2][4][2], const Unit& u, int wr, int wc, int fr, int fq) const {
        if (u.mode < 5) { base(acc, u, wr, wc, fr, fq); return; }
#pragma unroll
        for (int ai = 0; ai < 2; ++ai)
#pragma unroll
            for (int m = 0; m < 4; ++m)
#pragma unroll
                for (int bj = 0; bj < 2; ++bj) { const f32x4 a = acc[ai][bj][m][0], b = acc[ai][bj][m][1];
                    float s = (a[0] * a[0] + a[1] * a[1]) + (a[2] * a[2] + a[3] * a[3]) + (b[0] * b[0] + b[1] * b[1]) + (b[2] * b[2] + b[3] * b[3]);
                    s += __shfl_xor(s, 16); s += __shfl_xor(s, 32);
                    if (fq == 0) red[((ai * HALF + wr * 64 + m * 16 + fr) * 2 + bj) * 4 + wc] = s; }
        asm volatile("s_waitcnt lgkmcnt(0)" ::: "memory"); __builtin_amdgcn_s_barrier(); asm volatile("" ::: "memory");
        const float* nw = u.mode == 5 ? qnw : knw;
        const int axis = wc >> 1, f0 = (wc & 1) * 16 + fq * 4, da = axis * 64 + f0;
        const f32x4 wa = *(const f32x4*)(nw + da), wb = *(const f32x4*)(nw + da + 32);
#pragma unroll
        for (int ai = 0; ai < 2; ++ai)
#pragma unroll
            for (int m = 0; m < 4; ++m) { const int r = ai * HALF + wr * 64 + m * 16 + fr;
                f32x4 cs = {1.f, 1.f, 1.f, 1.f}, sn = {0.f, 0.f, 0.f, 0.f};
                if (u.mode != 7) { const int t = u.pm + r, pos = axis ? (t & 63) : (t >> 6); const float* rp = rope + (pos * 32 + f0) * 2;
                    const f32x4 p0 = *(const f32x4*)rp, p1 = *(const f32x4*)(rp + 4); cs = (f32x4){p0[0], p0[2], p1[0], p1[2]}; sn = (f32x4){p0[1], p0[3], p1[1], p1[3]}; }
#pragma unroll
                for (int bj = 0; bj < 2; ++bj) { const LAS f32x4* pp = (const LAS f32x4*)(red + (r * 2 + bj) * 4); const f32x4 ps = *pp;
                    const float rstd = 1.0f / sqrtf(((ps[0] + ps[1]) + (ps[2] + ps[3])) * (1.0f / HD) + 1e-6f);
                    const f32x4 xa = acc[ai][bj][m][0] * rstd * wa, xb = acc[ai][bj][m][1] * rstd * wb;
                    const f32x4 oa = xa * cs - xb * sn, ob = xb * cs + xa * sn;
                    u32x4 w; w.x = cvt_pk_bf16(oa[0], oa[1]); w.y = cvt_pk_bf16(oa[2], oa[3]); w.z = cvt_pk_bf16(ob[0], ob[1]); w.w = cvt_pk_bf16(ob[2], ob[3]);
                    *(u32x4*)((bf16_t*)u.C + (long)r * u.ldc + bj * HALF + wc * 32 + 8 * fq) = w; } }
    } };


struct EpiY8 {
    __device__ __forceinline__ void operator()(f32x4 (&acc)[2][2][4][2], const Unit& u, int wr, int wc, int fr, int fq) const {
        unsigned char* base = (unsigned char*)u.C + (size_t)(wr * 64 + fr) * u.ldc + wc * 32 + 8 * fq;
        const int r0 = wr * 64 + fr;
#pragma unroll
        for (int ai = 0; ai < 2; ++ai)
#pragma unroll
            for (int m = 0; m < 4; ++m) {
                if (r0 + ai * HALF + m * 16 < u.rows) { unsigned char* p = base + (size_t)(ai * HALF + m * 16) * u.ldc;
#pragma unroll
                    for (int bj = 0; bj < 2; ++bj) { f32x4 v0 = acc[ai][bj][m][0], v1 = acc[ai][bj][m][1];
#pragma unroll
                        for (int c = 0; c < 4; ++c) { v0[c] = fminf(fmaxf(v0[c], -448.f), 448.f); v1[c] = fminf(fmaxf(v1[c], -448.f), 448.f); }
                        int w0 = 0, w1 = 0;
                        w0 = __builtin_amdgcn_cvt_pk_fp8_f32(v0[0], v0[1], w0, false); w0 = __builtin_amdgcn_cvt_pk_fp8_f32(v0[2], v0[3], w0, true);
                        w1 = __builtin_amdgcn_cvt_pk_fp8_f32(v1[0], v1[1], w1, false); w1 = __builtin_amdgcn_cvt_pk_fp8_f32(v1[2], v1[3], w1, true);
                        *(unsigned long long*)(p + bj * HALF) = (unsigned long long)(unsigned)w0 | ((unsigned long long)(unsigned)w1 << 32); } } }
    } };

struct Args { const float* in[22]; float* out; unsigned char* ws; int ph_lo, ph_hi, use_ut, mod_off, do_attn, bar_idx; };
struct Frame {
    LAS unsigned char* lds; volatile LAS unsigned* MISC; unsigned char* ws;
    int tid, lane, wave, vcu, G;
};

__device__ __forceinline__ int qk_col_of_dim(int d) { const int a = d >> 6, half = (d >> 5) & 1, f = d & 31; return 32 * (2 * a + (f >> 4)) + 8 * ((f >> 2) & 3) + 4 * half + (f & 3); }
__device__ __forceinline__ void t64_load(f32x4 (&v)[16], const float* W, int ldw, int lane) {
    const unsigned off = (unsigned)(((lane >> 4) * ldw + (lane & 15) * 4) * 4);
#pragma unroll
    for (int j = 0; j < 16; ++j) { const char* bj = (const char*)W + (size_t)(j * 4) * ldw * 4; v[j] = __builtin_nontemporal_load((const GAS f32x4*)(bj + off)); }
}
template <bool QKPERM = false, bool F8OUT = false>
__device__ __forceinline__ void t64_store(const f32x4 (&v)[16], bf16_t* dst, int ldd, LAS float* scr, int lane, int d0 = 0) {
    const int kk = lane >> 4, nc = (lane & 15) * 4;
#pragma unroll
    for (int j = 0; j < 16; ++j) {
#pragma unroll
        for (int c = 0; c < 4; ++c) scr[(j * 4 + kk) * 65 + nc + c] = v[j][c]; }
    LDS_WAIT(); asm volatile("" ::: "memory");
    const int kc = lane & 7; const unsigned soff = F8OUT ? (unsigned)((lane >> 3) * ldd + 8 * kc) : (unsigned)(((lane >> 3) * ldd + 8 * kc) * 2);
#pragma unroll
    for (int jj = 0; jj < 8; jj += 2) {
        float t[2][8];
#pragma unroll
        for (int q = 0; q < 2; ++q) { const int n = (lane >> 3) + 8 * (jj + q); const LAS float* s = scr + (8 * kc) * 65 + n;
#pragma unroll
            for (int i = 0; i < 8; ++i) t[q][i] = s[i * 65]; }
#pragma unroll
        for (int q = 0; q < 2; ++q) { char* bq = (char*)dst + (size_t)(8 * (jj + q)) * ldd * (F8OUT ? 1 : 2);
            if constexpr (QKPERM) bq = (char*)dst + (size_t)(qk_col_of_dim(d0 + (lane >> 3) + 8 * (jj + q)) - (lane >> 3)) * ldd * 2;
            if constexpr (F8OUT) { float s[8];
#pragma unroll
                for (int i = 0; i < 8; ++i) s[i] = fminf(fmaxf(t[q][i] * 16.0f, -448.f), 448.f);
                int w0 = 0, w1 = 0; w0 = __builtin_amdgcn_cvt_pk_fp8_f32(s[0], s[1], w0, false); w0 = __builtin_amdgcn_cvt_pk_fp8_f32(s[2], s[3], w0, true);
                w1 = __builtin_amdgcn_cvt_pk_fp8_f32(s[4], s[5], w1, false); w1 = __builtin_amdgcn_cvt_pk_fp8_f32(s[6], s[7], w1, true);
                __builtin_nontemporal_store((unsigned long long)(unsigned)w0 | ((unsigned long long)(unsigned)w1 << 32), (GAS unsigned long long*)(bq + soff)); }
            else { u32x4 o; o.x = cvt_pk_bf16(t[q][0], t[q][1]); o.y = cvt_pk_bf16(t[q][2], t[q][3]); o.z = cvt_pk_bf16(t[q][4], t[q][5]); o.w = cvt_pk_bf16(t[q][6], t[q][7]);
                __builtin_nontemporal_store(o, (GAS u32x4*)(bq + soff)); } } }
    LDS_WAIT(); asm volatile("" ::: "memory");
}
__device__ __forceinline__ void transpose64(const float* W, int ldw, bf16_t* dst, int ldd, LAS float* scr, int lane) {
    f32x4 v[16]; t64_load(v, W, ldw, lane); t64_store(v, dst, ldd, scr, lane);
}

constexpr int IT_IN = 32 * 128, IT_FO = 16 * 32, IT_AO = 32 * 32, IT_O = 32 * 32, IT_EG = 64 * 256, IT_EU = 64 * 256, IT_ED = 64 * 256, IT_SH = 256;
constexpr int IT_T_END = IT_IN + IT_FO + IT_AO + IT_O + 3 * IT_SH;
constexpr int IT_MOD = MODC / 32, IT_CST = 4096, IT_BD2 = 512, IT_RWT = 32, IT_ROPE = 1;
constexpr int IT_ALL = IT_T_END + IT_MOD + IT_CST + IT_BD2 + IT_RWT + IT_ROPE;

__device__ __forceinline__ void mod_item(const Args& args, unsigned char* ws, int r, int lane) {
            const int kq = lane >> 3, col = r * 32 + (lane & 7) * 4;
            f32x4 a0 = {0.f, 0.f, 0.f, 0.f}, a1 = a0, a2 = a0;
            for (int jb = 0; jb < 256; jb += 8) {
                f32x4 w[8]; float c0[8], c1[8], c2[8];
#pragma unroll
                for (int j = 0; j < 8; ++j) { const int k = kq + 8 * (jb + j); w[j] = *(const GAS f32x4*)(args.in[4] + (size_t)k * MODC + col); c0[j] = args.in[1][k]; c1[j] = args.in[1][DM + k]; c2[j] = args.in[3][k]; }
#pragma unroll
                for (int j = 0; j < 8; ++j) { a0 += w[j] * (c0[j] * __builtin_amdgcn_rcpf(1.0f + __expf(-c0[j]))); a1 += w[j] * (c1[j] * __builtin_amdgcn_rcpf(1.0f + __expf(-c1[j]))); a2 += w[j] * (c2[j] * __builtin_amdgcn_rcpf(1.0f + __expf(-c2[j]))); }
            }
#pragma unroll
            for (int c = 0; c < 4; ++c) {
#pragma unroll
                for (int o = 8; o < 64; o <<= 1) { a0[c] += __shfl_xor(a0[c], o); a1[c] += __shfl_xor(a1[c], o); a2[c] += __shfl_xor(a2[c], o); } }
            if (kq == 0) { const f32x4 bb = *(const GAS f32x4*)(args.in[5] + col); float* MODP = (float*)(ws + WS_MOD);
                *(GAS f32x4*)(MODP + col) = a0 + bb; *(GAS f32x4*)(MODP + MODC + col) = a1 + bb; *(GAS f32x4*)(MODP + 2 * MODC + col) = a2 + bb; }
}
__device__ __forceinline__ void p0_prologue(Frame& F, const Args& args) {
    LAS float* scr = (LAS float*)(F.lds + F.wave * 16640);
    const int gw = F.vcu * NWAVES + F.wave, NGW = F.G * NWAVES, lane = F.lane;
    unsigned char* ws = F.ws;
    bf16_t* WT_IN = (bf16_t*)(ws + WS_WT_IN); bf16_t* WT_FO = (bf16_t*)(ws + WS_WT_FO); bf16_t* WT_AO = (bf16_t*)(ws + WS_WT_AO); bf16_t* WT_O = (bf16_t*)(ws + WS_WT_O);
    bf16_t* WT_GU = (bf16_t*)(ws + WS_WT_GU); bf16_t* WT_D = (bf16_t*)(ws + WS_WT_D);
    if (NGW >= 5 * IT_MOD) { if (gw % 5 == 0 && gw / 5 < IT_MOD) mod_item(args, ws, gw / 5, lane); }
    else for (int m = gw; m < IT_MOD; m += NGW) mod_item(args, ws, m, lane);
    for (int it = gw; it < IT_ALL - IT_MOD; it += NGW) {
        int r = it;
        if (r < IT_IN) { const int kb = r / 128, nb = r % 128, n0 = nb * 64;
            if (n0 >= Q_OFF && n0 < V_OFF) { f32x4 v[16]; t64_load(v, args.in[7] + (size_t)(kb * 64) * INC + n0, INC, lane);
                t64_store<true>(v, WT_IN + (size_t)(n0 & ~127) * DM + kb * 64, DM, scr, lane, n0 & 127); }
            else transpose64(args.in[7] + (size_t)(kb * 64) * INC + n0, INC, WT_IN + (size_t)n0 * DM + kb * 64, DM, scr, lane);
            continue; } r -= IT_IN;
        if (r < IT_FO) { const int kb = r / 32, nb = r % 32; transpose64(args.in[10] + (size_t)(kb * 64) * DM + nb * 64, DM, WT_FO + (size_t)(nb * 64) * YFP + kb * 64, YFP, scr, lane); continue; } r -= IT_FO;
        if (r < IT_AO) { const int kb = r / 32, nb = r % 32; transpose64(args.in[11] + (size_t)(kb * 64) * DM + nb * 64, DM, WT_AO + (size_t)(nb * 64) * DM + kb * 64, DM, scr, lane); continue; } r -= IT_AO;
        if (r < IT_O) { const int kb = r / 32, nb = r % 32; transpose64(args.in[12] + (size_t)(kb * 64) * DM + nb * 64, DM, WT_O + (size_t)(nb * 64) * DM + kb * 64, DM, scr, lane); continue; } r -= IT_O;
        if (r < 2 * IT_SH) { const int up = r >= IT_SH; if (up) r -= IT_SH; const int kb = r / 8, nb = r % 8, n0 = nb * 64;
            transpose64((up ? args.in[20] : args.in[19]) + (size_t)(kb * 64) * EFF + n0, EFF, WT_GU + ((size_t)64 * 1024 + (n0 >> 7) * 256 + (up ? 128 : 0) + (n0 & 127)) * DM + kb * 64, DM, scr, lane); continue; } r -= 2 * IT_SH;
        if (r < IT_SH) { const int kb = r / 32, nb = r % 32;
            { f32x4 v[16]; t64_load(v, args.in[21] + (size_t)(kb * 64) * DM + nb * 64, DM, lane); t64_store<false, true>(v, (bf16_t*)((unsigned char*)WT_D + ((size_t)64 * DM + nb * 64) * EFF + kb * 64), EFF, scr, lane); } continue; } r -= IT_SH;

        if (r < IT_CST) {
            const int k1 = r & 2047; bf16_t* dst = (bf16_t*)(ws + WS_CST) + (size_t)r * 2048;
#pragma unroll
            for (int j = 0; j < 4; ++j) { const int n0 = j * 512 + lane * 8; float f[8];
#pragma unroll
                for (int i = 0; i < 8; ++i) { const float ph = (float)((k1 * (n0 + i)) & 4095) * (1.0f / 2048.0f); f[i] = r < 2048 ? cospif(ph) : sinpif(ph); }
                u32x4 o; o.x = cvt_pk_bf16(f[0], f[1]); o.y = cvt_pk_bf16(f[2], f[3]); o.z = cvt_pk_bf16(f[4], f[5]); o.w = cvt_pk_bf16(f[6], f[7]);
                *(GAS u32x4*)(dst + n0) = o; }
            continue; } r -= IT_CST;
        if (r < IT_BD2) {
            const int t = r >> 8, o = r & 255, gp = o >> 7, k2 = o & 127; bf16_t* dst = (bf16_t*)(ws + WS_BD2) + (size_t)r * 512; float f[8];
#pragma unroll
            for (int i = 0; i < 8; ++i) { const int j = lane * 8 + i, cg = j >> 8, jj = j & 255, c = jj & 127; const float ph = (float)((32 * c * k2) & 4095) * (1.0f / 2048.0f);
                const float v = jj < 128 ? cospif(ph) : (t ? sinpif(ph) : -sinpif(ph)); f[i] = cg == gp ? v * 0.0013810679320049757f : 0.f; }
            u32x4 w; w.x = cvt_pk_bf16(f[0], f[1]); w.y = cvt_pk_bf16(f[2], f[3]); w.z = cvt_pk_bf16(f[4], f[5]); w.w = cvt_pk_bf16(f[6], f[7]);
            *(GAS u32x4*)(dst + lane * 8) = w;
            continue; } r -= IT_BD2;
        if (r >= IT_RWT) {
            float* RT = (float*)(ws + WS_ROPE);
            for (int idx = lane; idx < 64 * 32; idx += 64) { const float ang = (float)(idx >> 5) * exp2f(-(float)(idx & 31) * (13.287712379549449f / 32.0f)); RT[2 * idx] = cosf(ang); RT[2 * idx + 1] = sinf(ang); }
            continue; }
        {
            f32x4 v[16]; t64_load(v, args.in[14] + (size_t)(r * 64) * NE, NE, lane);
            const int kk = lane >> 4, nc = (lane & 15) * 4;
#pragma unroll
            for (int j = 0; j < 16; ++j) {
#pragma unroll
                for (int c = 0; c < 4; ++c) scr[(j * 4 + kk) * 65 + nc + c] = v[j][c]; }
            LDS_WAIT(); asm volatile("" ::: "memory");
            const int kc = lane & 7; bf16_t* RWT = (bf16_t*)(ws + WS_RWT);
#pragma unroll
            for (int jj = 0; jj < 8; ++jj) { const int e = (lane >> 3) + 8 * jj; const LAS float* s = scr + (8 * kc) * 65 + e; float t[8], l[8];
#pragma unroll
                for (int i = 0; i < 8; ++i) { t[i] = s[i * 65]; l[i] = t[i] - bf2f(f2bf(t[i])); }
                u32x4 h, lo; h.x = cvt_pk_bf16(t[0], t[1]); h.y = cvt_pk_bf16(t[2], t[3]); h.z = cvt_pk_bf16(t[4], t[5]); h.w = cvt_pk_bf16(t[6], t[7]);
                lo.x = cvt_pk_bf16(l[0], l[1]); lo.y = cvt_pk_bf16(l[2], l[3]); lo.z = cvt_pk_bf16(l[4], l[5]); lo.w = cvt_pk_bf16(l[6], l[7]);
                *(GAS u32x4*)(RWT + (size_t)e * DM + r * 64 + 8 * kc) = h; *(GAS u32x4*)(RWT + (size_t)(NE + e) * DM + r * 64 + 8 * kc) = lo; }
            LDS_WAIT(); asm volatile("" ::: "memory");
        }
    }
}


__device__ __forceinline__ void conv_addr(const Args& args, unsigned char* ws, bool down, int it, const float*& W, int& ldw, bf16_t*& dst, int& ldd) {
    if (!down) { int r = it; const int up = r >= IT_EG; if (up) r -= IT_EG;
        const int e = r / 256, q = r % 256, kb = q / 8, nb = q % 8, n0 = nb * 64;
        W = (up ? args.in[17] : args.in[16]) + (size_t)e * DM * EFF + (size_t)(kb * 64) * EFF + n0; ldw = EFF;
        dst = (bf16_t*)(ws + WS_WT_GU) + ((size_t)e * 1024 + (n0 >> 7) * 256 + (up ? 128 : 0) + (n0 & 127)) * DM + kb * 64; ldd = DM;
    } else { const int r = it, e = r / 256, q = r % 256, kb = q / 32, nb = q % 32;
        W = args.in[18] + (size_t)e * EFF * DM + (size_t)(kb * 64) * DM + nb * 64; ldw = DM;
        dst = (bf16_t*)(ws + WS_WT_D + ((size_t)e * DM + nb * 64) * EFF + kb * 64); ldd = EFF; }
}
__device__ __forceinline__ void conv_items(Frame& F, const Args& args, bool down, int first, int count) {
    LAS float* scr = (LAS float*)(F.lds + F.wave * 16640);
    const int end = first + count; int it = first + F.wave;
    if (it >= end) return;
    f32x4 va[16], vb[16]; const float* W; int ldw; bf16_t* da; bf16_t* db; int ldd;
    conv_addr(args, F.ws, down, it, W, ldw, da, ldd); t64_load(va, W, ldw, F.lane);
    for (;;) {
        const bool hb = it + NWAVES < end;
        if (hb) { conv_addr(args, F.ws, down, it + NWAVES, W, ldw, db, ldd); t64_load(vb, W, ldw, F.lane); }
        if (down) t64_store<false, true>(va, da, ldd, scr, F.lane); else t64_store(va, da, ldd, scr, F.lane);
        if (!hb) break;
        const bool ha = it + 2 * NWAVES < end;
        if (ha) { conv_addr(args, F.ws, down, it + 2 * NWAVES, W, ldw, da, ldd); t64_load(va, W, ldw, F.lane); }
        if (down) t64_store<false, true>(vb, db, ldd, scr, F.lane); else t64_store(vb, db, ldd, scr, F.lane);
        if (!ha) break;
        it += 2 * NWAVES;
    }
}
struct SchedIn {
    int G, c; unsigned char* ws; int use_ut;
    __device__ __forceinline__ bool next(int i, Unit& u) const {
        const int L = i * G + c; if (L >= 1024) return false;
        const char* H = (const char*)(ws + WS_H); const char* WT = (const char*)(ws + WS_WT_IN);
        u.rows = 256; u.aux = 0; u.bjs = HALF; u.pm = 0; u.pn = 0; u.rmin = 0; u.nt = DM / BK; u.keep = 0;
        if (L < 896) {
            int pm, ct; grid_map(L, 32, 28, pm, ct);
            const int row0 = pm * 256, b = row0 / SEQ, t0 = row0 % SEQ;
            u.A = H + (size_t)row0 * DM * 2; u.B = WT + (size_t)ct * 256 * DM * 2;
            if (ct < 4) {
                if (use_ut) { u.A = WT + (size_t)ct * 256 * DM * 2; u.B = H + (size_t)row0 * DM * 2;
                              u.C = (char*)(ws + WS_UT) + (((size_t)b * FW + ct * 256) * SEQ + t0) * 2; u.ldc = SEQ; u.mode = 0; }
                else { u.C = (char*)(ws + WS_U) + ((size_t)row0 * FW + ct * 256) * 2; u.ldc = FW; u.mode = 0; }
            }
            else if (ct < 12) { u.C = (char*)(ws + WS_Q) + ((size_t)row0 * DM + (ct - 4) * 256) * 2; u.ldc = DM; u.mode = 5; u.pm = t0; }
            else if (ct < 14) { u.C = (char*)(ws + WS_KALL) + (((size_t)b * SKV + t0) * KVW + (ct - 12) * 256) * 2; u.ldc = KVW; u.mode = 6; u.pm = t0; }
            else if (ct < 16) { u.C = (char*)(ws + WS_VALL) + (((size_t)b * SKV + t0) * KVW + (ct - 14) * 256) * 2; u.ldc = KVW; u.mode = 0; }
            else if (ct < 24) { u.C = (char*)(ws + WS_SGF) + ((size_t)row0 * DM + (ct - 16) * 256) * 2; u.ldc = DM; u.mode = 2; }
            else              { u.C = (char*)(ws + WS_SGA) + ((size_t)row0 * DM + (ct - 24) * 256) * 2; u.ldc = DM; u.mode = 2; }
        } else if (L >= 904) {
            int pm, q; grid_map(L - 904, 32, 4, pm, q); const int ct = 28 + q;
            u.A = H + (size_t)pm * 256 * DM * 2; u.B = WT + (size_t)ct * 256 * DM * 2;
            u.C = (char*)(ws + WS_SGA) + ((size_t)pm * 256 * DM + (ct - 24) * 256) * 2; u.ldc = DM; u.mode = 2;
        } else {
            const int l = L - 896, pm = l & 1, ct = l >> 1;
            u.A = H + (size_t)(NTOK + pm * 256) * DM * 2; u.B = WT + (size_t)(K_OFF + ct * 256) * DM * 2;
            if (ct < 2) { u.C = (char*)(ws + WS_KALL) + (((size_t)pm * SKV + SEQ) * KVW + ct * 256) * 2; u.ldc = KVW; u.mode = 7; }
            else        { u.C = (char*)(ws + WS_VALL) + (((size_t)pm * SKV + SEQ) * KVW + (ct - 2) * 256) * 2; u.ldc = KVW; u.mode = 0; }
        }
        return true;
    }
    __device__ __forceinline__ unsigned arow(const Unit&, int) const { return 0u; }
};


__device__ __forceinline__ void unpack8(u32x4 w, float (&f)[8]) {
#pragma unroll
    for (int i = 0; i < 4; ++i) { f[2 * i] = __uint_as_float(w[i] << 16); f[2 * i + 1] = __uint_as_float(w[i] & 0xffff0000u); }
}
struct EpiMerge { const bf16_t* SGF; const bf16_t* SGA; bf16_t* YM;
    __device__ __forceinline__ void operator()(f32x4 (&acc)[2][2][4][2], const Unit& u, int wr, int wc, int fr, int fq) const {
#pragma unroll
        for (int ai = 0; ai < 2; ++ai)
#pragma unroll
            for (int m = 0; m < 4; ++m) { const size_t row = (size_t)u.pm * 256 + ai * HALF + wr * 64 + m * 16 + fr;
#pragma unroll
                for (int bj = 0; bj < 2; ++bj) { const size_t o = row * DM + u.pn * 256 + bj * HALF + wc * 32 + 8 * fq;
                    float ga[8]; unpack8(*(const u32x4*)(SGA + o), ga);
#pragma unroll
                    for (int c = 0; c < 8; ++c) ga[c] = fmaxf(ga[c], 1e-20f);
                    if (u.keep) { float gf[8]; unpack8(*(const u32x4*)(SGF + o), gf);
#pragma unroll
                        for (int c = 0; c < 4; ++c) { acc[ai][bj][m][0][c] *= gf[c] * __builtin_amdgcn_rcpf(ga[c]); acc[ai][bj][m][1][c] *= gf[4 + c] * __builtin_amdgcn_rcpf(ga[4 + c]); }
                    } else { const f32x4 v0 = acc[ai][bj][m][0], v1 = acc[ai][bj][m][1];
                        u32x4 w; w.x = cvt_pk_bf16(ga[0] * v0[0], ga[1] * v0[1]); w.y = cvt_pk_bf16(ga[2] * v0[2], ga[3] * v0[3]); w.z = cvt_pk_bf16(ga[4] * v1[0], ga[5] * v1[1]); w.w = cvt_pk_bf16(ga[6] * v1[2], ga[7] * v1[3]);
                        *(u32x4*)(YM + o) = w; } } }
    } };
struct SchedMerge { int G, c; unsigned char* ws;
    __device__ __forceinline__ bool next(int i, Unit& u) const {
        const int L = (i >> 1) * G + c; if (L >= 256) return false;
        int pm, pn; grid_map(L, 32, 8, pm, pn); const int kb = i & 1;
        u.A = (const char*)(ws + (kb ? WS_YA : WS_YF)) + (size_t)pm * 256 * DM * 2; u.B = (const char*)(ws + (kb ? WS_WT_AO : WS_WT_FO)) + (size_t)pn * 256 * DM * 2;
        u.C = nullptr; u.ldc = DM; u.mode = 0; u.rows = 256; u.aux = 0; u.pm = pm; u.pn = pn; u.bjs = HALF; u.rmin = 0; u.nt = kb ? DM / BK : FW / BK; u.keep = kb ? 0 : 1;
        return true; }
    __device__ __forceinline__ unsigned arow(const Unit&, int) const { return 0u; } };
struct EpiX2 { const float* x; const float* mod; float* X2;
    __device__ __forceinline__ void operator()(f32x4 (&acc)[2][2][4][2], const Unit& u, int wr, int wc, int fr, int fq) const {
        const float* g1 = mod + ((u.pm * 256) / SEQ) * MODC + 2 * DM;
#pragma unroll
        for (int ai = 0; ai < 2; ++ai)
#pragma unroll
            for (int m = 0; m < 4; ++m) { const size_t row = (size_t)u.pm * 256 + ai * HALF + wr * 64 + m * 16 + fr;
#pragma unroll
                for (int bj = 0; bj < 2; ++bj) { const int col = u.pn * 256 + bj * HALF + wc * 32 + 8 * fq; const size_t o = row * DM + col;
#pragma unroll
                    for (int n = 0; n < 2; ++n) { const f32x4 xv = *(const f32x4*)(x + o + 4 * n), gv = *(const f32x4*)(g1 + col + 4 * n); *(f32x4*)(X2 + o + 4 * n) = xv + gv * acc[ai][bj][m][n]; } } }
    } };
struct EpiAct {
    __device__ __forceinline__ void operator()(f32x4 (&acc)[2][2][4][2], const Unit& u, int wr, int wc, int fr, int fq) const {
#pragma unroll
        for (int ai = 0; ai < 2; ++ai)
#pragma unroll
            for (int m = 0; m < 4; ++m) { const int r = ai * HALF + wr * 64 + m * 16 + fr;
                if (r < u.rows) { float a[8];
#pragma unroll
                    for (int n = 0; n < 2; ++n)
#pragma unroll
                        for (int c = 0; c < 4; ++c) { const float g = acc[ai][0][m][n][c], up = acc[ai][1][m][n][c]; a[4 * n + c] = g * __builtin_amdgcn_rcpf(1.0f + __expf(-g)) * up; }
#pragma unroll
                    for (int c = 0; c < 8; ++c) a[c] = fminf(fmaxf(a[c], -448.f), 448.f);
                    int w0 = 0, w1 = 0; w0 = __builtin_amdgcn_cvt_pk_fp8_f32(a[0], a[1], w0, false); w0 = __builtin_amdgcn_cvt_pk_fp8_f32(a[2], a[3], w0, true);
                    w1 = __builtin_amdgcn_cvt_pk_fp8_f32(a[4], a[5], w1, false); w1 = __builtin_amdgcn_cvt_pk_fp8_f32(a[6], a[7], w1, true);
                    *(unsigned long long*)((unsigned char*)u.C + (size_t)r * u.ldc + wc * 32 + 8 * fq) = (unsigned long long)(unsigned)w0 | ((unsigned long long)(unsigned)w1 << 32); } }
    } };

struct SchedGrid {
    int G, c, nM, nN; const char* A; const char* B; char* C; size_t astride, bstride; int ldc, esz, mode, nt;
    __device__ __forceinline__ bool next(int i, Unit& u) const {
        const int L = i * G + c; if (L >= nM * nN) return false;
        int pm, pn; grid_map(L, nM, nN, pm, pn);
        u.A = A + (size_t)pm * astride; u.B = B + (size_t)pn * bstride; u.C = C + ((size_t)pm * 256 * ldc + pn * 256) * esz; u.ldc = ldc; u.mode = mode; u.rows = 256; u.aux = 0; u.pm = pm; u.pn = pn; u.bjs = HALF; u.rmin = 0; u.nt = nt; u.keep = 0;
        return true; }
    __device__ __forceinline__ unsigned arow(const Unit&, int) const { return 0u; } };
struct SchedAG { int G, c; unsigned char* ws;
    __device__ __forceinline__ bool next(int i, Unit& u) const {
        const int L = i * G + c; if (L >= 136) return false;
        u.rows = 256; u.aux = 0; u.rmin = 0; u.nt = DM / BK; u.keep = 0;
        if (L < 128) {
            int pm, pn8; grid_map(L, 16, 8, pm, pn8); const int b = pn8 >> 2, pn = pn8 & 3, sn = pm >> 3, k1t = pm & 7;
            u.A = (const char*)(ws + WS_CST) + (size_t)pm * 256 * 2048 * 2; u.B = (const char*)(ws + (sn ? WS_OT : WS_ET)) + ((size_t)b * FW + pn * 256) * 2048 * 2;
            u.C = (char*)(ws + WS_TT) + (((size_t)b * 2048 + k1t * 256) * DM + pn * 512 + sn * 128) * 2; u.ldc = DM; u.mode = sn ? 0 : 3; u.pm = k1t; u.pn = b * FW + pn * 256; u.bjs = 256;
        } else {
            int pm, q; grid_map(L - 128 + 120, 32, 4, pm, q); const int ct = 28 + q;
            u.A = (const char*)(ws + WS_H) + (size_t)pm * 256 * DM * 2; u.B = (const char*)(ws + WS_WT_IN) + (size_t)ct * 256 * DM * 2;
            u.C = (char*)(ws + WS_SGA) + ((size_t)pm * 256 * DM + (ct - 24) * 256) * 2; u.ldc = DM; u.mode = 2; u.pm = pm; u.pn = ct; u.bjs = HALF;
        }
        return true; }
    __device__ __forceinline__ unsigned arow(const Unit&, int) const { return 0u; } };
struct SchedF2 { int G, c; unsigned char* ws;
    __device__ __forceinline__ bool next(int i, Unit& u) const {
        const int L = i * G + c; if (L >= 128) return false;
        int pm, q; grid_map(L, 16, 8, pm, q); const int b = pm >> 3, k1t = pm & 7, j = q & 3, mir = q >> 2;
        u.A = (const char*)(ws + WS_TT) + (((size_t)b * 2048 + k1t * 256) * DM + j * 512) * 2; u.B = (const char*)(ws + WS_BD2) + (size_t)mir * 256 * 512 * 2;
        u.mode = 0; u.rows = 256; u.aux = 0; u.pm = pm; u.pn = j; u.bjs = HALF; u.nt = 512 / BK; u.keep = 0;
        if (!mir) { u.C = (char*)(ws + WS_YF) + (((size_t)b * SEQ + k1t * 256) * YFP + j * 256) * 2; u.ldc = YFP; u.rmin = 0; }
        else { u.C = (char*)(ws + WS_YF) + (((size_t)b * SEQ + SEQ - k1t * 256) * YFP + j * 256) * 2; u.ldc = -YFP; u.rmin = k1t == 0 ? 1 : 0; }
        return true; }
    __device__ __forceinline__ unsigned arow(const Unit&, int) const { return 0u; } };
constexpr int SCHT_OFF = LDSCTL_OFF + 1024;
__device__ __forceinline__ void moe_tables(Frame& F, int ncol_tiles) {
    LAS int* T = (LAS int*)(F.lds + SCHT_OFF);
    __syncthreads();
    if (F.tid == 0) { const int* CNT = (const int*)(F.ws + CTL_CNT); int up = 0, of = 0;
        for (int e = 0; e <= NE; ++e) { const int cn = e < NE ? CNT[e * 64] : NTOK; T[e] = up; T[80 + e] = e < NE ? of : NSLOT; T[160 + e] = cn; up += ((cn + 255) >> 8) * ncol_tiles; of += cn; }
        T[NE + 1] = up; }
    __syncthreads();
}
template <int NCT, bool FIRST> struct SchedMoe {
    int G, c; unsigned char* ws; LAS int* T; const int* TOK;
    __device__ __forceinline__ int tl(int i) const { return __builtin_amdgcn_readfirstlane(T[i]); }
    __device__ __forceinline__ bool next(int i, Unit& u) const {
        const int L = i * G + c; if (L >= tl(NE + 1)) return false;
        int lo = 0, hi = NE;
#pragma unroll 1
        while (lo < hi) { const int mid = (lo + hi + 1) >> 1; if (tl(mid) <= L) lo = mid; else hi = mid - 1; }
        const int e = lo, cn = tl(160 + e), ntile = (cn + 255) >> 8, local = L - tl(e), ct = local / ntile, mt = local % ntile, slot0 = tl(80 + e) + mt * 256;
        u.rows = (cn - mt * 256) < 256 ? (cn - mt * 256) : 256; u.aux = slot0; u.pm = mt; u.pn = ct; u.bjs = HALF; u.mode = 0; u.rmin = 0; u.e = e; u.nt = FIRST ? DM / BK : EFF / 128; u.keep = 0;
        if (FIRST) { u.A = (const char*)(ws + WS_H2); u.B = (const char*)(ws + WS_WT_GU) + ((size_t)e * 4 + ct) * 256 * DM * 2; u.C = (char*)(ws + WS_ACT) + ((size_t)slot0 * EFF + ct * 128); u.ldc = EFF; }
        else { u.A = (const char*)(ws + WS_ACT) + (size_t)slot0 * EFF; u.B = (const char*)(ws + WS_WT_D) + ((size_t)e * DM + ct * 256) * EFF; u.C = (char*)(ws + WS_YBIG) + ((size_t)slot0 * DM + ct * 256); u.ldc = DM; u.mode = 8; }
        return true; }
    __device__ __forceinline__ unsigned arow(const Unit& u, int r) const { const int rr = u.pm * 256 + (r < u.rows ? r : u.rows - 1); const int tok = u.e < NE ? TOK[u.e * NTOK + rr] : rr; return (unsigned)tok * (unsigned)(DM * 2); } };

namespace attn {
using s16x4 = __attribute__((ext_vector_type(4))) short;
using f32x8 = __attribute__((ext_vector_type(8))) float;
constexpr int D = 128, NW = 8, QBLK = 32, KVBLK = 64;
constexpr float SCALE = 0.088388347648318440f;
constexpr float THR = 8.f;
constexpr int LDQ = DM, LDK = KVW, LDO = DM;
constexpr size_t SHM_V = KVBLK * D * 2, SHM_K = KVBLK * D * 2, SHM_ATTN = 2 * SHM_V + 2 * SHM_K + NW * 64 * 4;
#define KSWZ(row, colB) ((row) * 256 + ((colB) ^ (((row) & 7) << 4)))
#define SBAR() __builtin_amdgcn_sched_barrier(0)
__device__ __forceinline__ unsigned cvtpk(float lo, float hi) { unsigned r; asm volatile("v_cvt_pk_bf16_f32 %0, %1, %2" : "=v"(r) : "v"(lo), "v"(hi)); return r; }
__device__ __forceinline__ void partialSM(f32x16& p0, f32x16& p1, float& m_reg, float& mn, float& alpha) {
  constexpr float C = SCALE * 1.4426950408889634f;
  float pmax = p0[0]; for (int r = 1; r < 16; ++r) pmax = fmaxf(pmax, p0[r]); for (int r = 0; r < 16; ++r) pmax = fmaxf(pmax, p1[r]);
  { auto rr = __builtin_amdgcn_permlane32_swap(__float_as_uint(pmax), __float_as_uint(pmax), false, false);
    pmax = fmaxf(__uint_as_float(rr[0]), __uint_as_float(rr[1])); }
  if (__builtin_expect(__all(pmax - m_reg <= THR / SCALE), 1)) { mn = m_reg; alpha = 1.f; }
  else { mn = fmaxf(m_reg, pmax); alpha = __builtin_amdgcn_exp2f((m_reg - mn) * C); m_reg = mn; }
  float mnC = -mn * C;
  for (int r = 0; r < 16; ++r) p0[r] = fmaf(p0[r], C, mnC); for (int r = 0; r < 16; ++r) p1[r] = fmaf(p1[r], C, mnC);
  for (int r = 0; r < 16; ++r) p0[r] = __builtin_amdgcn_exp2f(p0[r]);
}
__device__ __forceinline__ void finishSM(f32x16& p0, f32x16& p1, float alpha, float& l_reg, bf16x8& pa0, bf16x8& pa1, bf16x8& pa2, bf16x8& pa3) {
  for (int r = 0; r < 16; ++r) p1[r] = __builtin_amdgcn_exp2f(p1[r]);
  float ps = 0; for (int r = 0; r < 16; ++r) ps += p0[r]; for (int r = 0; r < 16; ++r) ps += p1[r];
  { auto rr = __builtin_amdgcn_permlane32_swap(__float_as_uint(ps), __float_as_uint(ps), false, false);
    ps = __uint_as_float(rr[0]) + __uint_as_float(rr[1]); }
  l_reg = l_reg * alpha + ps;
#define PK4(P, BASE, OUT) do { unsigned a0 = cvtpk(P[BASE + 0], P[BASE + 1]), a1 = cvtpk(P[BASE + 2], P[BASE + 3]);   \
    unsigned b0 = cvtpk(P[BASE + 4], P[BASE + 5]), b1 = cvtpk(P[BASE + 6], P[BASE + 7]);                              \
    auto r0 = __builtin_amdgcn_permlane32_swap(a0, b0, false, false); auto r1 = __builtin_amdgcn_permlane32_swap(a1, b1, false, false); \
    u32x4 w = {r0[0], r1[0], r0[1], r1[1]}; OUT = *reinterpret_cast<bf16x8*>(&w); } while (0)
  PK4(p0, 0, pa0); PK4(p0, 8, pa1); PK4(p1, 0, pa2); PK4(p1, 8, pa3);
#undef PK4
}
__device__ __forceinline__ void qkt(f32x16& p0, f32x16& p1, const bf16_t* Ks, const bf16x8* qr, int r32, int hi) {
  p0 = f32x16{}; p1 = f32x16{};
  for (int d0 = 0; d0 < 8; ++d0) { int cb = (d0 * 16 + hi * 8) * 2;
    bf16x8 b0 = *reinterpret_cast<const bf16x8*>((const char*)Ks + KSWZ(r32, cb));
    bf16x8 b1 = *reinterpret_cast<const bf16x8*>((const char*)Ks + KSWZ(32 + r32, cb));
    p0 = __builtin_amdgcn_mfma_f32_32x32x16_bf16(b0, qr[d0], p0, 0, 0, 0);
    p1 = __builtin_amdgcn_mfma_f32_32x32x16_bf16(b1, qr[d0], p1, 0, 0, 0); }
}
__device__ __forceinline__ int v_st(int k, int c) { const int kk = (k & ~0xC) | ((k & 4) << 1) | ((k & 8) >> 1); return ((kk >> 3) * 4 + (c >> 5)) * 512 + ((kk & 7) * 32 + (c & 31)) * 2; }
__device__ __forceinline__ int v_rd_base(int lane) { return ((lane & 3) << 3) | (((lane >> 2) & 3) << 6) | (((lane >> 4) & 1) << 5) | (((lane >> 5) & 1) << 8); }
constexpr int v_rd_off(int d0, int ks, int half) { return d0 * 512 + ks * 4096 + half * 2048; }
template <int OFF> __device__ __forceinline__ s16x4 tr_read(int vb) {
  s16x4 r; asm volatile("ds_read_b64_tr_b16 %0, %1 offset:%2" : "=&v"(r) : "v"(vb), "i"(OFF) : "memory"); return r;
}
template <int D0> __device__ __forceinline__ void pv_one(f32x16& od, int vb, bf16x8 pa0, bf16x8 pa1, bf16x8 pa2, bf16x8 pa3) {
  const s16x4 l0 = tr_read<v_rd_off(D0, 0, 0)>(vb), h0 = tr_read<v_rd_off(D0, 0, 1)>(vb), l1 = tr_read<v_rd_off(D0, 1, 0)>(vb), h1 = tr_read<v_rd_off(D0, 1, 1)>(vb);
  const s16x4 l2 = tr_read<v_rd_off(D0, 2, 0)>(vb), h2 = tr_read<v_rd_off(D0, 2, 1)>(vb), l3 = tr_read<v_rd_off(D0, 3, 0)>(vb), h3 = tr_read<v_rd_off(D0, 3, 1)>(vb);
  asm volatile("s_waitcnt lgkmcnt(0)" ::: "memory"); SBAR();
#define PK(L, H) (bf16x8){L[0], L[1], L[2], L[3], H[0], H[1], H[2], H[3]}
  od = __builtin_amdgcn_mfma_f32_32x32x16_bf16(pa0, PK(l0, h0), od, 0, 0, 0);
  od = __builtin_amdgcn_mfma_f32_32x32x16_bf16(pa1, PK(l1, h1), od, 0, 0, 0);
  od = __builtin_amdgcn_mfma_f32_32x32x16_bf16(pa2, PK(l2, h2), od, 0, 0, 0);
  od = __builtin_amdgcn_mfma_f32_32x32x16_bf16(pa3, PK(l3, h3), od, 0, 0, 0);
#undef PK
}
__device__ __forceinline__ void pv_d0(f32x16* o, int vb, bf16x8 pa0, bf16x8 pa1, bf16x8 pa2, bf16x8 pa3) {
  pv_one<0>(o[0], vb, pa0, pa1, pa2, pa3); pv_one<1>(o[1], vb, pa0, pa1, pa2, pa3); pv_one<2>(o[2], vb, pa0, pa1, pa2, pa3); pv_one<3>(o[3], vb, pa0, pa1, pa2, pa3);
}
__device__ __forceinline__ void attn_dense_body(const bf16_t* __restrict__ Qb, const bf16_t* __restrict__ Kh, const bf16_t* __restrict__ Vh, bf16_t* __restrict__ Ob, int seq, char* lds) {
  const int tid = threadIdx.x, wid = tid >> 6, lane = tid & 63, r32 = lane & 31, hi = lane >> 5;
  bf16_t* V_lds = (bf16_t*)lds; bf16_t* K_lds = (bf16_t*)(lds + 2 * SHM_V);
  float* ws = (float*)(lds + 2 * SHM_V + 2 * SHM_K) + wid * 64; float* li_l = ws; float* al_l = ws + 32;
  float m_reg = -1e30f, l_reg = 0; f32x16 o[4] = {}; bf16x8 qr[8];
  const bf16_t* Qw = Qb + (long)(wid * QBLK + r32) * LDQ + hi * 8;
#pragma unroll
  for (int d0 = 0; d0 < 8; ++d0) qr[d0] = *reinterpret_cast<const bf16x8*>(Qw + d0 * 16);
  const int sr = tid >> 4, sc = (tid & 15) * 8, vst0 = v_st(sr, sc), vst1 = v_st(32 + sr, sc);
  const int vb0 = (int)(uintptr_t)V_lds + v_rd_base(lane);
  struct { bf16x8 vs0, vs1, ks0, ks1; } sr_[2];
#define SLOAD(i, k0) do { sr_[i].vs0 = *reinterpret_cast<const bf16x8*>(&Vh[(long)((k0) + sr) * LDK + sc]); sr_[i].vs1 = *reinterpret_cast<const bf16x8*>(&Vh[(long)((k0) + 32 + sr) * LDK + sc]); \
    sr_[i].ks0 = *reinterpret_cast<const bf16x8*>(&Kh[(long)((k0) + sr) * LDK + sc]); sr_[i].ks1 = *reinterpret_cast<const bf16x8*>(&Kh[(long)((k0) + 32 + sr) * LDK + sc]); } while (0)
#define SWRITE(b, i) do { *(bf16x8*)((char*)V_lds + (b) * SHM_V + vst0) = sr_[i].vs0;          \
    *(bf16x8*)((char*)V_lds + (b) * SHM_V + vst1) = sr_[i].vs1; int kc = sc * 2;               \
    *(bf16x8*)((char*)K_lds + (b) * SHM_K + KSWZ(sr, kc)) = sr_[i].ks0;                       \
    *(bf16x8*)((char*)K_lds + (b) * SHM_K + KSWZ(32 + sr, kc)) = sr_[i].ks1; } while (0)
#define SWAIT() asm volatile("s_waitcnt vmcnt(4)" ::: "memory")
#define RESC(a) do { if (__any((a) < 1.f)) { if (hi == 0) al_l[r32] = (a); asm volatile("s_waitcnt lgkmcnt(0)" ::: "memory"); \
    for (int d = 0; d < 4; ++d) for (int r = 0; r < 16; ++r) o[d][r] *= al_l[crow(r, hi)]; } } while (0)
  f32x16 pA0, pA1, pB0, pB1; float mnA, mnB, alA, alB; bf16x8 pa0, pa1, pa2, pa3; const int NT = seq / KVBLK;
  constexpr int SE = 0, SO = 1;
  SLOAD(SE, 0); asm volatile("s_waitcnt vmcnt(0)" ::: "memory"); SWRITE(0, SE); __syncthreads();
  qkt(pA0, pA1, K_lds, qr, r32, hi); partialSM(pA0, pA1, m_reg, mnA, alA);
  SLOAD(SO, KVBLK); if (2 < NT) SLOAD(SE, 2 * KVBLK);
  SWAIT(); SWRITE(1, SO); __syncthreads();
  for (int j = 1; j + 1 < NT; j += 2) {
    SBAR(); qkt(pB0, pB1, (bf16_t*)((char*)K_lds + SHM_K), qr, r32, hi);
    finishSM(pA0, pA1, alA, l_reg, pa0, pa1, pa2, pa3); SBAR();
    SLOAD(SO, (j + 2) * KVBLK); SBAR();
    pv_d0(o, vb0, pa0, pa1, pa2, pa3); partialSM(pB0, pB1, m_reg, mnB, alB);
    __syncthreads(); SWAIT(); SWRITE(0, SE);
    RESC(alB); __syncthreads();
    SBAR(); qkt(pA0, pA1, K_lds, qr, r32, hi);
    finishSM(pB0, pB1, alB, l_reg, pa0, pa1, pa2, pa3); SBAR();
    if (j + 3 < NT) SLOAD(SE, (j + 3) * KVBLK); SBAR();
    pv_d0(o, vb0 + (int)SHM_V, pa0, pa1, pa2, pa3); partialSM(pA0, pA1, m_reg, mnA, alA);
    __syncthreads(); SWAIT(); SWRITE(1, SO);
    RESC(alA); __syncthreads();
  }
  SBAR(); qkt(pB0, pB1, (bf16_t*)((char*)K_lds + SHM_K), qr, r32, hi);
  finishSM(pA0, pA1, alA, l_reg, pa0, pa1, pa2, pa3); SBAR();
  pv_d0(o, vb0, pa0, pa1, pa2, pa3); partialSM(pB0, pB1, m_reg, mnB, alB);
  __syncthreads(); RESC(alB);
  finishSM(pB0, pB1, alB, l_reg, pa0, pa1, pa2, pa3); SBAR();
  pv_d0(o, vb0 + (int)SHM_V, pa0, pa1, pa2, pa3);
  if (hi == 0) li_l[r32] = l_reg; asm volatile("s_waitcnt lgkmcnt(0)" ::: "memory");
  float rli[16];
#pragma unroll
  for (int r = 0; r < 16; ++r) rli[r] = __builtin_amdgcn_rcpf(li_l[crow(r, hi)]);
  bf16_t* Ow = Ob + (long)(wid * QBLK) * LDO;
#pragma unroll
  for (int r = 0; r < 16; ++r) { int orow = crow(r, hi);
    for (int d0 = 0; d0 < 4; ++d0) Ow[(long)orow * LDO + d0 * 32 + r32] = f2bf(o[d0][r] * rli[r]); }
#undef SLOAD
#undef SWRITE
#undef SWAIT
#undef RESC
}
#undef KSWZ
#undef SBAR
}

__device__ __forceinline__ void ph_norm1(Frame& F, const Args& args, const float* mod) {
    const int gw = F.vcu * NWAVES + F.wave, NGW = F.G * NWAVES, lane = F.lane;
    bf16_t* H = (bf16_t*)(F.ws + WS_H); const float* nw = args.in[6];
    for (int row = gw; row < NTOK + NCTX; row += NGW) {
        const float* src = row < NTOK ? args.in[0] + (size_t)row * DM : args.in[2] + (size_t)(row - NTOK) * DM;
        const float* mr = mod + (row < NTOK ? row / SEQ : 2) * MODC;
        f32x4 v[8]; float ss = 0.f;
#pragma unroll
        for (int j = 0; j < 8; ++j) { v[j] = *(const GAS f32x4*)(src + (j * 64 + lane) * 4); ss += v[j].x * v[j].x + v[j].y * v[j].y + v[j].z * v[j].z + v[j].w * v[j].w; }
        ss = wave_sum(ss);
        const float rstd = 1.0f / sqrtf(ss * (1.0f / DM) + 1e-6f);
#pragma unroll
        for (int j = 0; j < 8; ++j) { const int i = (j * 64 + lane) * 4;
            const f32x4 w = *(const GAS f32x4*)(nw + i), sc = *(const GAS f32x4*)(mr + DM + i), sh = *(const GAS f32x4*)(mr + i);
            const f32x4 h = v[j] * rstd * w * (sc + 1.0f) + sh;
            unsigned lo = cvt_pk_bf16(h[0], h[1]), hi = cvt_pk_bf16(h[2], h[3]);
            *(GAS unsigned long long*)(H + (size_t)row * DM + i) = (unsigned long long)lo | ((unsigned long long)hi << 32); }
    }
}
__device__ __forceinline__ void ph_evenodd(Frame& F, const Args& args) {
    const int gw = F.vcu * NWAVES + F.wave, NGW = F.G * NWAVES, lane = F.lane;
    LAS bf16_t* scr = (LAS bf16_t*)(F.lds + F.wave * 16640);
    const bf16_t* UT = (const bf16_t*)(F.ws + WS_UT); bf16_t* ET = (bf16_t*)(F.ws + WS_ET); bf16_t* OT = (bf16_t*)(F.ws + WS_OT);
    float* W2 = (float*)(F.ws + WS_W2048); float* AL = (float*)(F.ws + WS_ALT);
    for (int row = gw; row < 2 * FW; row += NGW) {
        const bf16_t* src = UT + (size_t)row * SEQ; float alt = 0.f;
#pragma unroll
        for (int j = 0; j < 8; ++j) { const u32x4 w = *(const GAS u32x4*)(src + (j * 64 + lane) * 8); *(LAS u32x4*)(scr + (j * 64 + lane) * 8) = w;
            float f[8]; unpack8(w, f); alt += (f[0] - f[1]) + (f[2] - f[3]) + (f[4] - f[5]) + (f[6] - f[7]); }
        alt = wave_sum(alt);
        LDS_WAIT(); asm volatile("" ::: "memory");
        if (lane == 0) { AL[row] = alt; W2[row] = bf2f(scr[SEQ / 2]); }
#pragma unroll
        for (int j = 0; j < 4; ++j) { const int n0 = (j * 64 + lane) * 8; float e[8], o[8];
#pragma unroll
            for (int i = 0; i < 8; ++i) { const int n = n0 + i; const float a = bf2f(scr[n]), bb = bf2f(scr[(SEQ - n) & (SEQ - 1)]); e[i] = n == 0 ? a : a + bb; o[i] = n == 0 ? 0.f : a - bb; }
            u32x4 we, wo; we.x = cvt_pk_bf16(e[0], e[1]); we.y = cvt_pk_bf16(e[2], e[3]); we.z = cvt_pk_bf16(e[4], e[5]); we.w = cvt_pk_bf16(e[6], e[7]);
            wo.x = cvt_pk_bf16(o[0], o[1]); wo.y = cvt_pk_bf16(o[2], o[3]); wo.z = cvt_pk_bf16(o[4], o[5]); wo.w = cvt_pk_bf16(o[6], o[7]);
            *(GAS u32x4*)(ET + (size_t)row * 2048 + n0) = we; *(GAS u32x4*)(OT + (size_t)row * 2048 + n0) = wo; }
        LDS_WAIT(); asm volatile("" ::: "memory");
    }
}
__device__ __forceinline__ void ph_route(Frame& F, const Args& args, const float* mod) {
    const int lane = F.lane, wv = F.wave, r32 = lane & 31, hi = lane >> 5;
    LAS float* rs = (LAS float*)F.lds;
    LAS float* part = (LAS float*)(F.lds + 1024);
    LAS int* lcnt = (LAS int*)(F.lds + 1024 + 65536);
    LAS int* lbase = lcnt + 64;
    LAS int* lent = lcnt + 128;
    const float* X2 = (const float*)(F.ws + WS_X2); const float* nw = args.in[13]; const float* rb = args.in[15];
    const bf16_t* RWT = (const bf16_t*)(F.ws + WS_RWT);
    bf16_t* H2 = (bf16_t*)(F.ws + WS_H2); int* EIDX = (int*)(F.ws + WS_EIDX); float* EW = (float*)(F.ws + WS_EW); int* EPOS = (int*)(F.ws + WS_EPOS); int* CNT = (int*)(F.ws + CTL_CNT); int* TOKE = (int*)(F.ws + WS_TOKE);
    if (F.tid < NE) lcnt[F.tid] = 0;
    __syncthreads();
    int nb = 0;
    for (int blk = F.vcu; blk < NTOK / 32; blk += F.G, ++nb) {
        const int row0 = blk * 32; const float* mr = mod + (row0 / SEQ) * MODC;
#pragma unroll
        for (int i = 0; i < 4; ++i) { const float* src = X2 + (size_t)(row0 + wv * 4 + i) * DM; float ss = 0.f;
#pragma unroll
            for (int j = 0; j < 8; ++j) { const f32x4 v = *(const GAS f32x4*)(src + (j * 64 + lane) * 4); ss += v.x * v.x + v.y * v.y + v.z * v.z + v.w * v.w; }
            ss = wave_sum(ss);
            if (lane == 0) rs[wv * 4 + i] = 1.0f / sqrtf(ss * (1.0f / DM) + 1e-6f); }
        __syncthreads();
        { const float rstd = rs[r32]; const float* xr = X2 + (size_t)(row0 + r32) * DM; bf16_t* hr = H2 + (size_t)(row0 + r32) * DM;
          f32x16 acc0 = {}, acc1 = {};
#pragma unroll 4
          for (int ks = 0; ks < 16; ++ks) { const int k = wv * 256 + ks * 16 + hi * 8;
              float h[8];
#pragma unroll
              for (int q = 0; q < 2; ++q) { const f32x4 x = *(const GAS f32x4*)(xr + k + 4 * q), w = *(const GAS f32x4*)(nw + k + 4 * q), sc = *(const GAS f32x4*)(mr + 4 * DM + k + 4 * q), sh = *(const GAS f32x4*)(mr + 3 * DM + k + 4 * q);
                  const f32x4 t = x * rstd * w * (sc + 1.0f) + sh; h[4 * q] = t[0]; h[4 * q + 1] = t[1]; h[4 * q + 2] = t[2]; h[4 * q + 3] = t[3]; }
              u32x4 wh, wl; float l[8];
              wh.x = cvt_pk_bf16(h[0], h[1]); wh.y = cvt_pk_bf16(h[2], h[3]); wh.z = cvt_pk_bf16(h[4], h[5]); wh.w = cvt_pk_bf16(h[6], h[7]);
#pragma unroll
              for (int i = 0; i < 4; ++i) { l[2 * i] = h[2 * i] - __uint_as_float(wh[i] << 16); l[2 * i + 1] = h[2 * i + 1] - __uint_as_float(wh[i] & 0xffff0000u); }
              wl.x = cvt_pk_bf16(l[0], l[1]); wl.y = cvt_pk_bf16(l[2], l[3]); wl.z = cvt_pk_bf16(l[4], l[5]); wl.w = cvt_pk_bf16(l[6], l[7]);
              *(GAS u32x4*)(hr + k) = wh;
              const bf16x8 ah = __builtin_bit_cast(bf16x8, wh), al = __builtin_bit_cast(bf16x8, wl);
              const bf16x8 bh0 = *(const GAS bf16x8*)(RWT + (size_t)r32 * DM + k), bh1 = *(const GAS bf16x8*)(RWT + (size_t)(32 + r32) * DM + k);
              const bf16x8 bl0 = *(const GAS bf16x8*)(RWT + (size_t)(NE + r32) * DM + k), bl1 = *(const GAS bf16x8*)(RWT + (size_t)(NE + 32 + r32) * DM + k);
              acc0 = __builtin_amdgcn_mfma_f32_32x32x16_bf16(ah, bh0, acc0, 0, 0, 0); acc0 = __builtin_amdgcn_mfma_f32_32x32x16_bf16(ah, bl0, acc0, 0, 0, 0); acc0 = __builtin_amdgcn_mfma_f32_32x32x16_bf16(al, bh0, acc0, 0, 0, 0);
              acc1 = __builtin_amdgcn_mfma_f32_32x32x16_bf16(ah, bh1, acc1, 0, 0, 0); acc1 = __builtin_amdgcn_mfma_f32_32x32x16_bf16(ah, bl1, acc1, 0, 0, 0); acc1 = __builtin_amdgcn_mfma_f32_32x32x16_bf16(al, bh1, acc1, 0, 0, 0); }
#pragma unroll
          for (int r = 0; r < 16; ++r) { part[(wv * 32 + crow(r, hi)) * 64 + r32] = acc0[r]; part[(wv * 32 + crow(r, hi)) * 64 + 32 + r32] = acc1[r]; } }
        __syncthreads();
        for (int i = 0; i < 4; ++i) { const int rbk = wv * 4 + i, row = row0 + rbk; float logit = 0.f;
#pragma unroll
          for (int w = 0; w < 8; ++w) logit += part[(w * 32 + rbk) * 64 + lane];
          const float score = 1.0f / (1.0f + expf(-logit)), bsd = score + rb[lane];
          const int g = lane >> 3;
          int rk = 0;
#pragma unroll
          for (int q = 0; q < 8; ++q) { const int o = (lane & ~7) + q; const float vv = __shfl(bsd, o); rk += (vv > bsd) || (vv == bsd && o < lane); }
          float gs = rk < 2 ? bsd : 0.f;
          gs += __shfl_xor(gs, 1); gs += __shfl_xor(gs, 2); gs += __shfl_xor(gs, 4);
          int grk = 0;
#pragma unroll
          for (int gg = 0; gg < 8; ++gg) { const float vv = __shfl(gs, gg * 8); grk += (vv > gs) || (vv == gs && gg < g); }
          const bool gsel = grk < 4;
          const float mb = gsel ? bsd : -INFINITY;
          int erk = 0;
          for (int o = 0; o < 64; ++o) { const float vv = __shfl(mb, o); erk += (vv > mb) || (vv == mb && o < lane); }
          const bool sel = gsel && erk < TOPK;
          const float ssum = wave_sum(sel ? score : 0.f);
          if (sel) { const int lp = __hip_atomic_fetch_add(lcnt + lane, 1, __ATOMIC_RELAXED, __HIP_MEMORY_SCOPE_WORKGROUP);
                     EIDX[row * TOPK + erk] = lane; EW[row * TOPK + erk] = score / ssum * 2.5f; lent[(nb * 32 + rbk) * TOPK + erk] = (lane << 16) | lp; } }
        __syncthreads();
    }
    if (F.tid < NE) { const int c = lcnt[F.tid]; lbase[F.tid] = c ? atomicAdd(&CNT[F.tid * 64], c) : 0; }
    __syncthreads();
    for (int i = F.tid; i < nb * 256; i += NTHREADS) { const int blk = F.vcu + (i >> 8) * F.G, row = blk * 32 + ((i >> 3) & 31), v = lent[i]; const int pos = lbase[v >> 16] + (v & 0xffff); EPOS[row * TOPK + (i & 7)] = pos; TOKE[(v >> 16) * NTOK + pos] = row; }
    __syncthreads();
}
__device__ __forceinline__ void y16(const unsigned char* p, float (&f)[16]) {
    const u32x4 w = *(const GAS u32x4*)p;
#pragma unroll
    for (int i = 0; i < 4; ++i) { const auto lo = __builtin_amdgcn_cvt_pk_f32_fp8((int)w[i], false), hi = __builtin_amdgcn_cvt_pk_f32_fp8((int)w[i], true); f[4 * i] = lo[0]; f[4 * i + 1] = lo[1]; f[4 * i + 2] = hi[0]; f[4 * i + 3] = hi[1]; }
}
__device__ __forceinline__ void ph_comb(Frame& F, const Args& args, const float* mod) {
    const int gw = F.vcu * NWAVES + F.wave, NGW = F.G * NWAVES, lane = F.lane;
    moe_tables(F, 4);
    LAS int* T = (LAS int*)(F.lds + SCHT_OFF);
    const float* EW = (const float*)(F.ws + WS_EW); const int* EIDX = (const int*)(F.ws + WS_EIDX); const int* EPOS = (const int*)(F.ws + WS_EPOS); const unsigned char* Y = (const unsigned char*)(F.ws + WS_YBIG);
    for (int t = gw; t < NTOK; t += NGW) {
        const float* g2 = mod + (t / SEQ) * MODC + 5 * DM;
        int sl[TOPK]; float wk[TOPK];
#pragma unroll
        for (int k = 0; k < TOPK; ++k) { sl[k] = T[80 + EIDX[t * TOPK + k]] + EPOS[t * TOPK + k]; wk[k] = EW[t * TOPK + k]; }
#pragma unroll
        for (int j = 0; j < 2; ++j) { const int col = j * 1024 + lane * 16;
            float a[16]; y16(Y + (size_t)(NSLOT + t) * DM + col, a);
#pragma unroll
            for (int k = 0; k < TOPK; ++k) { float y[16]; y16(Y + (size_t)sl[k] * DM + col, y);
#pragma unroll
                for (int c = 0; c < 16; ++c) a[c] += wk[k] * y[c]; }
            float* o = args.out + (size_t)t * DM + col; const float* xi = (const float*)(F.ws + WS_X2) + (size_t)t * DM + col;
#pragma unroll
            for (int n = 0; n < 4; ++n) { const f32x4 xv = *(const GAS f32x4*)(xi + 4 * n), gv = *(const GAS f32x4*)(g2 + col + 4 * n);
                *(GAS f32x4*)(o + 4 * n) = xv + gv * (f32x4){a[4 * n], a[4 * n + 1], a[4 * n + 2], a[4 * n + 3]}; } }
    }
}

enum { PH_PRO = 0, PH_NORM1, PH_INPROJ, PH_QKNORM, PH_ATTN, PH_F2, PH_MERGE, PH_OUT, PH_ROUTE, PH_EXP1, PH_EXP2, PH_COMB, PH_END };


__global__ void __launch_bounds__(NTHREADS, 2) fwd(Args args) {
    extern __shared__ __attribute__((aligned(16))) unsigned char lds_raw[];
    Frame F;
    F.lds = (LAS unsigned char*)lds_raw; F.MISC = (volatile LAS unsigned*)(F.lds + MISC_OFF); F.ws = args.ws;
    F.tid = threadIdx.x; F.lane = F.tid & 63; F.wave = __builtin_amdgcn_readfirstlane(F.tid >> 6);
    F.G = gridDim.x; { const int bx = blockIdx.x; F.vcu = (F.G % 8 == 0) ? (bx % 8) * (F.G / 8) + bx / 8 : bx; }
    for (int u = F.tid; u < (LDS_BYTES - LDSCTL_OFF) / 4; u += NTHREADS) ((LAS unsigned*)(F.lds + LDSCTL_OFF))[u] = 0u;
    __syncthreads();
    const int lo = args.ph_lo, hi = args.ph_hi;
    const bool multi = (hi - lo) > 1;
    unsigned* barw = (unsigned*)(args.ws + CTL_BAR) + args.bar_idx * XCD_BAR_WORDS;
    XcdBarrier bar; bar.bar = barw; bar.x = 0; bar.st = nullptr;
    if (multi) bar = xcd_barrier_post(barw, F.MISC + 8);
#define IN(k) (lo <= (k) && (k) < hi)
#define SEAM(k) do { if (IN((k) + 1)) xcd_barrier(bar); } while (0)

    const float* modp = (const float*)(args.ws + args.mod_off);
    if (IN(PH_PRO)) { p0_prologue(F, args); SEAM(PH_PRO); }
    if (IN(PH_NORM1)) { ph_norm1(F, args, modp); SEAM(PH_NORM1); }
    if (IN(PH_INPROJ)) {
        SchedIn S{F.G, (int)blockIdx.x, args.ws, args.use_ut};
        EpiIn E{EpiStore{(const float*)(args.ws + WS_W2048)}, (LAS float*)(F.lds + GPARK_OFF), args.in[8], args.in[9], (const float*)(args.ws + WS_ROPE)};
        gemm_phase<EpiIn, SchedIn, false>(F.lds, DM, DM, DM, S, E);
        SEAM(PH_INPROJ);
    }
    if (IN(PH_QKNORM)) { ph_evenodd(F, args); SEAM(PH_QKNORM); }
    if (IN(PH_ATTN)) {
        const int cs = F.vcu & 3;
        constexpr int NCONV = IT_EG + IT_EU + IT_ED;
        int qfirst, qcnt; { const int c = (int)blockIdx.x; if (F.G == 256) { qfirst = c < 136 ? c * 162 : 136 * 162 + (c - 136) * 226; qcnt = c < 136 ? 162 : 226; }
                             else { const int per = (NCONV + F.G - 1) / F.G; qfirst = c * per; qcnt = qfirst + per <= NCONV ? per : (NCONV - qfirst > 0 ? NCONV - qfirst : 0); } }
        const int gcnt = qfirst < IT_EG + IT_EU ? (qfirst + qcnt <= IT_EG + IT_EU ? qcnt : IT_EG + IT_EU - qfirst) : 0, gfirst = qfirst;
        const int ccnt = qcnt - gcnt, cfirst = qfirst + gcnt - (IT_EG + IT_EU);
#define CONV_ALL() do { conv_items(F, args, false, gfirst, gcnt); conv_items(F, args, true, cfirst, ccnt); } while (0)
        const bf16_t* Qp = (const bf16_t*)(args.ws + WS_Q); const bf16_t* Kp = (const bf16_t*)(args.ws + WS_KALL); const bf16_t* Vp = (const bf16_t*)(args.ws + WS_VALL); bf16_t* Op = (bf16_t*)(args.ws + WS_YA);
#define ATTN_UNIT(lin_) do { const int lin = (lin_); if (lin < 512) { const int x = (lin >> 5) & 7, j = (lin & 31) + 32 * (lin >> 8), b = x >> 2, kvh = x & 3, head = kvh * 4 + (j >> 4), qb = j & 15; \
            const size_t qo = ((size_t)(b * SEQ + qb * 256)) * DM + head * HD, ko = (size_t)b * SKV * KVW + kvh * HD; \
            attn::attn_dense_body(Qp + qo, Kp + ko, Vp + ko, Op + qo, SKV, (char*)lds_raw); __syncthreads(); } } while (0)
        if (cs == 0) { CONV_ALL(); __syncthreads(); }
        ATTN_UNIT(F.vcu);
        if (cs == 1) { CONV_ALL(); __syncthreads(); }
        ATTN_UNIT(F.vcu + F.G);
        for (int lin2 = F.vcu + 2 * F.G; lin2 < 512; lin2 += F.G) ATTN_UNIT(lin2);
        if (cs == 2) { CONV_ALL(); __syncthreads(); }
#undef ATTN_UNIT
        SchedAG S{F.G, (int)blockIdx.x, args.ws};
        gemm_phase<EpiStore, SchedAG, false>(F.lds, DM, DM, DM, S, EpiStore{(const float*)(args.ws + WS_W2048)});
        if (cs == 3) { __syncthreads(); CONV_ALL(); }
#undef CONV_ALL
        SEAM(PH_ATTN);
    }
    if (IN(PH_F2)) {
        SchedF2 S{F.G, (int)blockIdx.x, args.ws};
        gemm_phase<EpiStore, SchedF2, false>(F.lds, 512, DM, 512, S, EpiStore{(const float*)(args.ws + WS_W2048)});
        {
            const int idx = F.vcu * NTHREADS + F.tid;
            if (idx < 2 * FW) { const int b = idx >> 10, col = idx & 1023, k2 = col & 127; const float* al = (const float*)(args.ws + WS_ALT) + b * FW + (col & ~127); float s = 0.f;
                for (int c = 0; c < 128; ++c) s += al[c] * cospif((float)((c * k2) & 127) * (1.0f / 64.0f));
                ((bf16_t*)(args.ws + WS_YF))[((size_t)b * SEQ + SEQ / 2) * YFP + col] = f2bf(s * 0.0013810679320049757f); }
        }
        SEAM(PH_F2);
    }
    if (IN(PH_MERGE)) {
        unsigned char* ws = args.ws;
        SchedMerge S{F.G, (int)blockIdx.x, ws};
        gemm_phase<EpiMerge, SchedMerge, false>(F.lds, DM, DM, DM, S, EpiMerge{(const bf16_t*)(ws + WS_SGF), (const bf16_t*)(ws + WS_SGA), (bf16_t*)(ws + WS_YM)});
        SEAM(PH_MERGE);
    }
    if (IN(PH_OUT)) {
        unsigned char* ws = args.ws;
        SchedGrid S{F.G, (int)blockIdx.x, 32, 8, (const char*)(ws + WS_YM), (const char*)(ws + WS_WT_O), nullptr, (size_t)256 * DM * 2, (size_t)256 * DM * 2, DM, 4, 1, DM / BK};
        gemm_phase<EpiX2, SchedGrid, false>(F.lds, DM, DM, DM, S, EpiX2{args.in[0], modp, (float*)(ws + WS_X2)});
        SEAM(PH_OUT);
    }
    if (IN(PH_ROUTE)) { ph_route(F, args, modp); SEAM(PH_ROUTE); }
    if (IN(PH_EXP1)) {
        moe_tables(F, 4);
        SchedMoe<4, true> S{F.G, F.vcu, args.ws, (LAS int*)(F.lds + SCHT_OFF), (const int*)(args.ws + WS_TOKE)};
        gemm_phase<EpiAct, SchedMoe<4, true>, true>(F.lds, DM, DM, DM, S, EpiAct{});
        SEAM(PH_EXP1);
    }
    if (IN(PH_EXP2)) {
        moe_tables(F, 8);
        SchedMoe<8, false> S{F.G, F.vcu, args.ws, (LAS int*)(F.lds + SCHT_OFF), (const int*)(args.ws + WS_TOKE)};
        gemm_phase<EpiY8, SchedMoe<8, false>, false, true>(F.lds, EFF, EFF / 2, EFF / 2, S, EpiY8{});
        SEAM(PH_EXP2);
    }
    if (IN(PH_COMB)) { ph_comb(F, args, modp); }
#undef IN
#undef SEAM
}
}

extern "C" void kernel_launch(void* const* d_in, const int* in_sizes, int n_in, void* d_out, int out_size, void* d_ws, size_t ws_size, hipStream_t stream) {
    if (n_in != 22 || ws_size < WS_END2) return;
    float* out = (float*)d_out;
    unsigned char* ws = (unsigned char*)d_ws;
    hipMemsetAsync(ws + WS_CTL, 0, CTL_ZERO_BYTES, stream);
    static int grid = 0;
    if (!grid) {
        int dev = 0, cus = 0;
        if (hipGetDevice(&dev) != hipSuccess || hipDeviceGetAttribute(&cus, hipDeviceAttributeMultiprocessorCount, dev) != hipSuccess) { grid = -1; return; }
        if (hipFuncSetAttribute((const void*)mk::fwd, hipFuncAttributeMaxDynamicSharedMemorySize, mk::LDS_BYTES) != hipSuccess) { grid = -1; return; }
        grid = cus;
    }
    if (grid < 0) return;
    mk::Args a{}; int nlaunch = 0;
    for (int i = 0; i < 22; ++i) a.in[i] = (const float*)d_in[i];
    a.out = out; a.ws = ws; a.use_ut = 1; a.mod_off = (int)WS_MOD; a.do_attn = 1;
#define MK_LAUNCH(lo_, hi_) do { a.ph_lo = (lo_); a.ph_hi = (hi_); a.bar_idx = nlaunch++; hipLaunchKernelGGL(mk::fwd, dim3(grid), dim3(mk::NTHREADS), mk::LDS_BYTES, stream, a); } while (0)
    MK_LAUNCH(mk::PH_PRO, mk::PH_END);
}
```

```cpp
#include <hip/hip_runtime.h>
#include <stdint.h>
#include <math.h>

typedef unsigned short bf16_t;
typedef short bf16x8 __attribute__((ext_vector_type(8)));
typedef float f32x16 __attribute__((ext_vector_type(16)));
typedef float f32x4 __attribute__((ext_vector_type(4)));

constexpr int NB = 2, SEQ = 4096, DM = 2048, NTOK = NB * SEQ, CTXL = 256, NCTX = NB * CTXL, HD = 128, NH = 16, NKV = 4;
constexpr int SKV = SEQ + CTXL;
constexpr int FW = 1024, INC = 8192, Q_OFF = 1024, K_OFF = 3072, V_OFF = 3584, GF_OFF = 4096, GA_OFF = 6144;
constexpr int KVW = NKV * HD;
constexpr int NE = 64, TOPK = 8, EFF = 512, MODC = 6 * DM;
constexpr int NSLOT = NTOK * TOPK;
constexpr int NSLOT_ALL = NSLOT + NTOK;

constexpr size_t MiB = 1u << 20;
constexpr size_t WS_CTL = 0, CTL_ZERO_BYTES = 1 * MiB;
constexpr size_t CTL_CNT = 64 * 1024;
constexpr size_t WS_TW = 1 * MiB;
constexpr size_t WS_MOD = 1 * MiB + 64 * 1024;
constexpr size_t WS_OFFS = 1 * MiB + 256 * 1024;
constexpr size_t WS_EIDX = 2 * MiB;
constexpr size_t WS_EW = WS_EIDX + 256 * 1024;
constexpr size_t WS_EPOS = WS_EW + 256 * 1024;
constexpr size_t WS_SLOTOF = WS_EPOS + 256 * 1024;
constexpr size_t WS_TOKE = 300 * MiB;
constexpr size_t WS_H = 4 * MiB;
constexpr size_t WS_U = 38 * MiB;
constexpr size_t WS_Q = 54 * MiB;
constexpr size_t WS_KALL = 86 * MiB;
constexpr size_t WS_VALL = 95 * MiB;
constexpr size_t WS_SGF = 104 * MiB;
constexpr size_t WS_SGA = 136 * MiB;
constexpr size_t WS_YA = 168 * MiB;
constexpr size_t WS_YF = 38 * MiB;
constexpr int YFP = 2048;
constexpr size_t WS_PR = 216 * MiB;
constexpr size_t WS_T1 = 248 * MiB;
constexpr size_t WS_YM = 312 * MiB;
constexpr size_t WS_QKRAW = 248 * MiB;
constexpr size_t WS_KCRAW = 330 * MiB;
constexpr size_t WS_H2 = 344 * MiB;
constexpr size_t WS_ACT = 376 * MiB;
constexpr size_t WS_YBIG = 4 * MiB;
constexpr size_t WS_END = 740 * MiB;

__device__ __forceinline__ float bf2f(bf16_t h) { return __uint_as_float(((unsigned)h) << 16); }
__device__ __forceinline__ bf16_t f2bf(float f) { unsigned u = __float_as_uint(f); return (bf16_t)((u + 0x7fffu + ((u >> 16) & 1u)) >> 16); }
__device__ __forceinline__ int crow(int r, int hi) { return (r & 3) + 8 * (r >> 2) + 4 * hi; }
__device__ __forceinline__ float wave_sum(float v) {
#pragma unroll
    for (int o = 1; o < 64; o <<= 1) v += __shfl_xor(v, o);
    return v;
}
__device__ __forceinline__ float sigmoidf_(float v) { return 1.0f / (1.0f + expf(-v)); }
__device__ __forceinline__ bf16x8 pack8(const float* f) {
    bf16x8 r;
#pragma unroll
    for (int i = 0; i < 8; ++i) r[i] = (short)f2bf(f[i]);
    return r;
}

#define LAS __attribute__((address_space(3)))
#define GAS __attribute__((address_space(1)))
typedef unsigned u32x4 __attribute__((ext_vector_type(4)));
typedef GAS unsigned gu32;
#define RLX_AGENT __ATOMIC_RELAXED, __HIP_MEMORY_SCOPE_AGENT
#define LDS_WAIT() asm volatile("s_waitcnt lgkmcnt(0)" ::: "memory")
#define VM_WAIT() asm volatile("s_waitcnt vmcnt(0)" ::: "memory")

constexpr size_t CTL_BAR = 16384;
constexpr size_t CTL_MODZ = 512 * 1024;
constexpr size_t WS_UT = 38 * MiB;
constexpr size_t WS_TT = 216 * MiB;
constexpr size_t WS_WT_GU = 450 * MiB;
constexpr size_t WS_WT_D = 710 * MiB;
constexpr size_t WS_WT_IN = 840 * MiB;
constexpr size_t WS_WT_FO = 924 * MiB;
constexpr size_t WS_WT_AO = 876 * MiB;
constexpr size_t WS_WT_O = 884 * MiB;
constexpr size_t WS_CST = 892 * MiB;
constexpr size_t WS_ET = 908 * MiB;
constexpr size_t WS_OT = 916 * MiB;
constexpr size_t WS_W2048 = 1 * MiB + 512 * 1024;
constexpr size_t WS_ALT = 1 * MiB + 520 * 1024;
constexpr size_t WS_ROPE = 1 * MiB + 528 * 1024;
constexpr size_t WS_RWT = 3 * MiB + 512 * 1024;
constexpr size_t WS_BD2 = 956 * MiB;
constexpr size_t WS_X2 = 960 * MiB;
constexpr size_t WS_END2 = 1024 * MiB;

namespace mk {
constexpr int NWAVES = 8, NTHREADS = 512;
constexpr int RING_BYTES = 131072, SCR_BYTES = 8 * 16640, LDSCTL_OFF = 135168, MISC_OFF = LDSCTL_OFF + 320, GPARK_OFF = LDSCTL_OFF + 2048  , LDS_BYTES = 147456;
static_assert(GPARK_OFF + 8192 <= LDS_BYTES, "LDS map");
static_assert(SCR_BYTES <= LDSCTL_OFF && MISC_OFF + 128 <= LDS_BYTES, "LDS map");

#define XB_TMO      128
#define XB_XCNT(j)  (256  + 64 * (j))
#define XB_XSUB(j)  (1280 + 64 * (j))
#define XB_XGEN(j)  (2304 + 64 * (j))
#define XB_TOP      3328
#define XB_TOPGEN   3392
#define XCD_BAR_WORDS 3456
#define XB_SPIN_CAP (1u << 18)
__device__ __forceinline__ unsigned xb_ld(unsigned* p)              { return __hip_atomic_load(p, __ATOMIC_RELAXED, __HIP_MEMORY_SCOPE_AGENT); }
__device__ __forceinline__ unsigned xb_add(unsigned* p, unsigned v) { return __hip_atomic_fetch_add(p, v, __ATOMIC_RELAXED, __HIP_MEMORY_SCOPE_AGENT); }
__device__ __forceinline__ unsigned xb_xcc_id() { return (unsigned)__builtin_amdgcn_s_getreg((3 << 11) | 20) & 0xFu; }
#define XB_SPIN(cond, bar) do { unsigned _sp = 0; while (cond) { __builtin_amdgcn_s_sleep(1); \
    if ((++_sp & 255u) == 0u) { if (xb_ld(&(bar)[XB_TMO])) break; if (_sp > XB_SPIN_CAP) { atomicAdd(&(bar)[XB_TMO], 1u); break; } } } } while (0)
struct XcdBarrier { unsigned* bar; unsigned x; volatile LAS unsigned* st; };
__device__ __forceinline__ XcdBarrier xcd_barrier_post(unsigned* bar, volatile LAS unsigned* st) {
    XcdBarrier b; b.bar = bar; b.x = xb_xcc_id(); b.st = st;
    if (threadIdx.x == 0) (void)xb_add(&bar[XB_XCNT(b.x)], 1u);
    return b;
}
__device__ __forceinline__ void xcd_barrier_complete(unsigned* bar, unsigned x, unsigned& nloc, unsigned& nx) {
    const unsigned G = gridDim.x * gridDim.y * gridDim.z;
    unsigned sum, cnt, mine, sp = 0u;
    for (;;) {
        sum = 0u; cnt = 0u; mine = 0u;
#pragma unroll
        for (unsigned j = 0; j < 16; ++j) { const unsigned c = xb_ld(&bar[XB_XCNT(j)]); sum += c; cnt += (c > 0u) ? 1u : 0u; mine = (j == x) ? c : mine; }
        if (sum == G) break;
        __builtin_amdgcn_s_sleep(1);
        if ((++sp & 255u) == 0u) { if (xb_ld(&bar[XB_TMO])) break; if (sp > XB_SPIN_CAP) { atomicAdd(&bar[XB_TMO], 1u); break; } }
    }
    nloc = mine > 0u ? mine : 1u; nx = cnt > 0u ? cnt : 1u;
}
__device__ __forceinline__ void xcd_barrier(const XcdBarrier& b) {
    asm volatile("s_waitcnt vmcnt(0)" ::: "memory");
    __syncthreads();
    if (threadIdx.x == 0) {
        unsigned* bar = b.bar;
        __builtin_amdgcn_s_waitcnt(0);
        unsigned nloc = b.st[0], nx = b.st[1];
        if (nloc == 0u) { xcd_barrier_complete(bar, b.x, nloc, nx); b.st[0] = nloc; b.st[1] = nx; }
        const unsigned old = xb_add(&bar[XB_XSUB(b.x)], 1u);
        const unsigned gen = old / nloc;
        if (old + 1u == (gen + 1u) * nloc) {
            __builtin_amdgcn_fence(__ATOMIC_RELEASE, "agent");
            asm volatile("s_waitcnt vmcnt(0)" ::: "memory");
            const unsigned og = xb_add(&bar[XB_TOP], 1u);
            const unsigned tg = og / nx;
            if (og + 1u == (tg + 1u) * nx) xb_add(&bar[XB_TOPGEN], 1u);
            else XB_SPIN(xb_ld(&bar[XB_TOPGEN]) == tg, bar);
            __builtin_amdgcn_fence(__ATOMIC_ACQUIRE, "agent");
            xb_add(&bar[XB_XGEN(b.x)], 1u);
            asm volatile("s_waitcnt vmcnt(0)" ::: "memory");
        } else {
            XB_SPIN(xb_ld(&bar[XB_XGEN(b.x)]) == gen, bar);
            __builtin_amdgcn_fence(__ATOMIC_ACQUIRE, "agent");
            asm volatile("s_waitcnt vmcnt(0)" ::: "memory");
        }
    }
    __syncthreads();
}

constexpr int BM = 256, BK = 64, HALF = 128, HTB = HALF * BK * 2, STAGE_BYTES = 8 * HTB;
__device__ __forceinline__ int lds_byte(int r, int c) { const int st = (r >> 4) * 2 + (c >> 5), rr = r & 15, cc = c & 31, ob = rr * 64 + cc * 2; return st * 1024 + (ob ^ (((ob >> 9) & 1) << 5)); }
__device__ __forceinline__ void stage_rc(int b, int& R, int& C) { const int st = b / 1024, sb = b % 1024, swz = sb ^ (((sb >> 9) & 1) << 5); R = (st >> 1) * 16 + swz / 64; C = (st & 1) * 32 + (swz % 64) / 2; }
__device__ __forceinline__ int perm32(int rho) { const int n = rho >> 4, i = rho & 15; return 8 * (i >> 2) + 4 * n + (i & 3); }
__device__ __forceinline__ unsigned cvt_pk_bf16(float lo, float hi) { unsigned r; asm("v_cvt_pk_bf16_f32 %0, %1, %2" : "=v"(r) : "v"(lo), "v"(hi)); return r; }

__device__ __forceinline__ void glds16_s(const void* sbase, unsigned voff, unsigned lds_dst) { unsigned keep;
    asm volatile("s_mov_b32 %0, m0\n\ts_mov_b32 m0, %3\n\ts_nop 0\n\tglobal_load_lds_dwordx4 %1, %2\n\ts_mov_b32 m0, %0" : "=&s"(keep) : "v"(voff), "s"(sbase), "s"(lds_dst) : "memory"); }

struct Unit { const char* A; const char* B; char* C; int ldc; int mode; int rows; int aux; int pm, pn, bjs, rmin, e, nt, keep; };

typedef int i32x8 __attribute__((ext_vector_type(8)));
typedef int i32x4 __attribute__((ext_vector_type(4)));
template <class Epi, class Sched, bool GATHER, bool F8 = false>
__device__ __forceinline__ void gemm_phase(LAS unsigned char* lds, const int K, const int lda, const int ldb, const Sched& S, const Epi& E, const int i0 = 0, const int i1 = 0x7fffffff) {
    const int tid = threadIdx.x, wid = __builtin_amdgcn_readfirstlane(tid >> 6), lane = tid & 63, wr = wid >> 2, wc = wid & 3, fr = lane & 15, fq = lane >> 4;
    unsigned voffA[2], voffB[2];
#pragma unroll
    for (int i = 0; i < 2; ++i) { int R, C; stage_rc(tid * 16 + i * 8192, R, C); const int Rb = (R & ~31) + perm32(R & 31);
        voffA[i] = (unsigned)(R * lda + C) * 2u; voffB[i] = (unsigned)(Rb * ldb + C) * 2u; }
    const size_t kstep = (size_t)(BK * 2);
    const size_t hstepA = (size_t)HALF * lda * 2, hstepB = (size_t)HALF * ldb * 2;
    const unsigned ldsw = (unsigned)wid * 1024u;
    const unsigned ldsbase = (unsigned)__builtin_amdgcn_readfirstlane((int)(unsigned)(uintptr_t)lds);
    const int aoff = F8 ? lds_byte(wr * 64 + fr, (fq >> 1) * 32 + (fq & 1) * 16) : lds_byte(wr * 64 + fr, fq * 8), boff = F8 ? lds_byte(wc * 32 + fr, (fq >> 1) * 32 + (fq & 1) * 16) : lds_byte(wc * 32 + fr, fq * 8);

#define MK_SA(b, h) (((b) * 2 + (h)) * HTB)
#define MK_SB(b, h) ((4 + (b) * 2 + (h)) * HTB)
#define MK_STAGE2(bufoff, gbase, v0, v1) do { \
        __builtin_amdgcn_global_load_lds((const unsigned*)((const char*)(gbase) + (v0)), (LAS unsigned*)(lds + (bufoff) + ldsw), 16, 0, 0); \
        __builtin_amdgcn_global_load_lds((const unsigned*)((const char*)(gbase) + (v1)), (LAS unsigned*)(lds + (bufoff) + ldsw + 8192), 16, 0, 0); } while (0)
#define MK_STAGE_B(bufoff, gbase) do { glds16_s((gbase), voffB[0], ldsbase + (bufoff) + ldsw); glds16_s((gbase), voffB[1], ldsbase + (bufoff) + ldsw + 8192u); } while (0)
#define MK_STAGE_A(bufoff, gbase, h, VA) do { if constexpr (GATHER) { glds16_s((gbase), (VA)[h][0], ldsbase + (bufoff) + ldsw); glds16_s((gbase), (VA)[h][1], ldsbase + (bufoff) + ldsw + 8192u); } \
        else { glds16_s((gbase) + (h) * hstepA, voffA[0], ldsbase + (bufoff) + ldsw); glds16_s((gbase) + (h) * hstepA, voffA[1], ldsbase + (bufoff) + ldsw + 8192u); } } while (0)
#define MK_LDA(dst, b, h) do { if constexpr (F8) { _Pragma("unroll") for (int m = 0; m < 4; ++m) dst##8[m] = *(const LAS i32x8*)(lds + MK_SA(b, h) + aoff + m * 2048); } \
        else { _Pragma("unroll") for (int m = 0; m < 4; ++m) _Pragma("unroll") for (int k = 0; k < 2; ++k) dst[m][k] = *(const LAS bf16x8*)(lds + MK_SA(b, h) + aoff + m * 2048 + k * 1024); } } while (0)
#define MK_LDB(dst, b, h) do { if constexpr (F8) { _Pragma("unroll") for (int n = 0; n < 2; ++n) dst##8[n] = *(const LAS i32x8*)(lds + MK_SB(b, h) + boff + n * 2048); } \
        else { _Pragma("unroll") for (int n = 0; n < 2; ++n) _Pragma("unroll") for (int k = 0; k < 2; ++k) dst[n][k] = *(const LAS bf16x8*)(lds + MK_SB(b, h) + boff + n * 2048 + k * 1024); } } while (0)
#define MK_MMA(ai, bj, At, Bt) do { __builtin_amdgcn_s_setprio(1); \
        if constexpr (F8) { _Pragma("unroll") for (int m = 0; m < 4; ++m) _Pragma("unroll") for (int n = 0; n < 2; ++n) \
            acc[ai][bj][m][n] = __builtin_amdgcn_mfma_scale_f32_16x16x128_f8f6f4(Bt##8[n], At##8[m], acc[ai][bj][m][n], 0, 0, 0, 0x7d, 0, 0x7d  ); } \
        else { _Pragma("unroll") for (int m = 0; m < 4; ++m) _Pragma("unroll") for (int n = 0; n < 2; ++n) _Pragma("unroll") for (int k = 0; k < 2; ++k) \
            acc[ai][bj][m][n] = __builtin_amdgcn_mfma_f32_16x16x32_bf16(Bt[n][k], At[m][k], acc[ai][bj][m][n], 0, 0, 0); } \
        __builtin_amdgcn_s_setprio(0); } while (0)
#define MK_WAIT_V(n) asm volatile("s_waitcnt vmcnt(" #n ")" ::: "memory")
#define MK_WAIT_L(n) asm volatile("s_waitcnt lgkmcnt(" #n ")" ::: "memory")
#define MK_BAR __builtin_amdgcn_s_barrier()
#define MK_SCHED __builtin_amdgcn_sched_barrier(0)
    Unit cur, nxt; int ui = i0;
    if (i0 >= i1 || !S.next(i0, cur)) return;
    f32x4 acc[2][2][4][2];
#pragma unroll
    for (int a = 0; a < 2; ++a)
#pragma unroll
        for (int b = 0; b < 2; ++b)
#pragma unroll
            for (int m = 0; m < 4; ++m)
#pragma unroll
                for (int n = 0; n < 2; ++n) acc[a][b][m][n] = (f32x4){0.f, 0.f, 0.f, 0.f};
    bf16x8 At[4][2], B0[2][2], B1[2][2]; i32x8 At8[4], B08[2], B18[2];
    unsigned vC[2][2];
    LAS u32x4* vpark = (LAS u32x4*)(lds + GPARK_OFF) + tid;
    if constexpr (GATHER) {
#pragma unroll
        for (int h = 0; h < 2; ++h)
#pragma unroll
            for (int i = 0; i < 2; ++i) { int R, C; stage_rc(tid * 16 + i * 8192, R, C); vC[h][i] = S.arow(cur, h * HALF + R) + (unsigned)(C * 2); }
    }
    const char* cA = cur.A; const char* cB = cur.B;
    MK_STAGE_B(MK_SB(0, 0), cB); MK_STAGE_B(MK_SB(0, 1), cB + hstepB); MK_STAGE_A(MK_SA(0, 0), cA, 0, vC); MK_STAGE_A(MK_SA(0, 1), cA, 1, vC);
    if (wr == 1) MK_BAR;
    MK_WAIT_V(2); MK_BAR;
    MK_STAGE_B(MK_SB(1, 0), cB + kstep); MK_STAGE_A(MK_SA(1, 0), cA + kstep, 0, vC); MK_STAGE_B(MK_SB(1, 1), cB + hstepB + kstep);
    MK_WAIT_V(6); MK_BAR;
    for (;;) {
        const bool has_next = (ui + 1 < i1) && S.next(ui + 1, nxt);
        const char* nA = has_next ? nxt.A : cA; const char* nB = has_next ? nxt.B : cB;
        if constexpr (GATHER) {
            u32x4 pv;
#pragma unroll
            for (int h = 0; h < 2; ++h)
#pragma unroll
                for (int i = 0; i < 2; ++i) { int R, C; stage_rc(tid * 16 + i * 8192, R, C); pv[h * 2 + i] = has_next ? (S.arow(nxt, h * HALF + R) + (unsigned)(C * 2)) : vC[h][i]; }
            *vpark = pv;
        }
        int nt = cur.nt; asm volatile("" : "+s"(nt));
#pragma nounroll
        for (int t = 0; t < nt; t += 2) {
            const bool last = (t == nt - 2);
            const char* a1 = cA + (size_t)(t + 1) * kstep;
            const char* a2 = last ? nA : cA + (size_t)(t + 2) * kstep; const char* b2 = last ? nB : cB + (size_t)(t + 2) * kstep;
            const char* a3 = a2 + kstep; const char* b3 = b2 + kstep;
            MK_LDB(B0, 0, 0); MK_LDB(B1, 0, 1); MK_SCHED; MK_LDA(At, 0, 0); MK_STAGE_A(MK_SA(1, 1), a1, 1, vC);
            if constexpr (GATHER) { if (last) { const u32x4 pv = *vpark; vC[0][0] = pv[0]; vC[0][1] = pv[1]; vC[1][0] = pv[2]; vC[1][1] = pv[3]; } }
            MK_WAIT_V(8); MK_WAIT_L(0); MK_BAR; MK_MMA(0, 0, At, B0); MK_MMA(0, 1, At, B1); MK_BAR; MK_SCHED;
            MK_LDA(At, 0, 1); MK_STAGE_B(MK_SB(0, 0), b2); MK_STAGE_B(MK_SB(0, 1), b2 + hstepB); MK_STAGE_A(MK_SA(0, 0), a2, 0, vC);
            MK_WAIT_V(8); MK_WAIT_L(0); MK_BAR; MK_MMA(1, 0, At, B0); MK_MMA(1, 1, At, B1); MK_BAR; MK_SCHED;
            MK_LDB(B0, 1, 0); MK_LDB(B1, 1, 1); MK_SCHED; MK_LDA(At, 1, 0); MK_STAGE_A(MK_SA(0, 1), a2, 1, vC);
            MK_WAIT_V(8); MK_WAIT_L(0); MK_BAR; MK_MMA(0, 0, At, B0); MK_MMA(0, 1, At, B1); MK_BAR; MK_SCHED;
            MK_LDA(At, 1, 1); MK_STAGE_B(MK_SB(1, 0), b3); MK_STAGE_B(MK_SB(1, 1), b3 + hstepB); MK_STAGE_A(MK_SA(1, 0), a3, 0, vC);
            MK_WAIT_V(8); MK_WAIT_L(0); MK_BAR; MK_MMA(1, 0, At, B0); MK_MMA(1, 1, At, B1); MK_BAR; MK_SCHED;
        }
        if (wr == 0) MK_BAR;
        { int fr2 = fr, fq2 = fq; asm volatile("" : "+v"(fr2), "+v"(fq2));
          E(acc, cur, wr, wc, fr2, fq2); }
        if (!has_next) break;
        if (!cur.keep)
#pragma unroll
        for (int a = 0; a < 2; ++a)
#pragma unroll
            for (int b = 0; b < 2; ++b)
#pragma unroll
                for (int m = 0; m < 4; ++m)
#pragma unroll
                    for (int n = 0; n < 2; ++n) acc[a][b][m][n] = (f32x4){0.f, 0.f, 0.f, 0.f};
        cur = nxt; cA = nA; cB = nB; ++ui;
        if (wr == 1) MK_BAR;
    }
    MK_WAIT_V(0);
    MK_BAR;
#undef MK_SA
#undef MK_SB
#undef MK_STAGE2
#undef MK_STAGE_B
#undef MK_STAGE_A
#undef MK_LDA
#undef MK_LDB
#undef MK_MMA
#undef MK_WAIT_V
#undef MK_WAIT_L
#undef MK_BAR
#undef MK_SCHED
}

__device__ __forceinline__ void grid_map(int L, int nM, int nN, int& pm, int& pn) {
    const int nwg = nM * nN, q = nwg / 8, xcd = L % 8, off = L / 8; const int wgid = xcd * q + off;
    const int nig = 8 * nN, gid = wgid / nig, fm = gid * 8, gsz = (nM - fm) < 8 ? (nM - fm) : 8;
    pm = fm + ((wgid % nig) % gsz); pn = (wgid % nig) / gsz;
}

struct EpiStore {
    const float* w2048;
    __device__ __forceinline__ void operator()(f32x4 (&acc)[2][2][4][2], const Unit& u, int wr, int wc, int fr, int fq) const {
        const int col0 = wc * 32 + 8 * fq;
#pragma unroll
        for (int ai = 0; ai < 2; ++ai)
#pragma unroll
            for (int m = 0; m < 4; ++m) {
                const int r = ai * HALF + wr * 64 + m * 16 + fr;
                if (r < u.rows && r >= u.rmin) {
#pragma unroll
                    for (int bj = 0; bj < 2; ++bj) {
                        f32x4 v0 = acc[ai][bj][m][0], v1 = acc[ai][bj][m][1];
                        if (u.mode == 1) { float* p = (float*)u.C + (long)r * u.ldc + col0 + bj * u.bjs; *(f32x4*)p = v0; *(f32x4*)(p + 4) = v1; }
                        else {
                            if (u.mode == 2) {
#pragma unroll
                                for (int c = 0; c < 4; ++c) { v0[c] = __builtin_amdgcn_rcpf(1.0f + __expf(-v0[c])); v1[c] = __builtin_amdgcn_rcpf(1.0f + __expf(-v1[c])); }
                            } else if (u.mode == 3) {
                                const float* wp = w2048 + u.pn + bj * HALF + col0; const float sg = (r & 1) ? -1.0f : 1.0f;
                                v0 += *(const f32x4*)wp * sg; v1 += *(const f32x4*)(wp + 4) * sg;
                            }
                            u32x4 w; w.x = cvt_pk_bf16(v0[0], v0[1]); w.y = cvt_pk_bf16(v0[2], v0[3]); w.z = cvt_pk_bf16(v1[0], v1[1]); w.w = cvt_pk_bf16(v1[2], v1[3]);
                            *(u32x4*)((bf16_t*)u.C + (long)r * u.ldc + col0 + bj * u.bjs) = w;
                        }
                    }
                }
            }
    }
};


struct EpiIn { EpiStore base; LAS float* red; const float* qnw; const float* knw; const float* rope;
    __device__ __forceinline__ void operator()(f32x4 (&acc)[2][2][4][2], const Unit& u, int wr, int wc, int fr, int fq) const {
        if (u.mode < 5) { base(acc, u, wr, wc, fr, fq); return; }
#pragma unroll
        for (int ai = 0; ai < 2; ++ai)
#pragma unroll
            for (int m = 0; m < 4; ++m)
#pragma unroll
                for (int bj = 0; bj < 2; ++bj) { const f32x4 a = acc[ai][bj][m][0], b = acc[ai][bj][m][1];
                    float s = (a[0] * a[0] + a[1] * a[1]) + (a[2] * a[2] + a[3] * a[3]) + (b[0] * b[0] + b[1] * b[1]) + (b[2] * b[2] + b[3] * b[3]);
                    s += __shfl_xor(s, 16); s += __shfl_xor(s, 32);
                    if (fq == 0) red[((ai * HALF + wr * 64 + m * 16 + fr) * 2 + bj) * 4 + wc] = s; }
        asm volatile("s_waitcnt lgkmcnt(0)" ::: "memory"); __builtin_amdgcn_s_barrier(); asm volatile("" ::: "memory");
        const float* nw = u.mode == 5 ? qnw : knw;
        const int axis = wc >> 1, f0 = (wc & 1) * 16 + fq * 4, da = axis * 64 + f0;
        const f32x4 wa = *(const f32x4*)(nw + da), wb = *(const f32x4*)(nw + da + 32);
#pragma unroll
        for (int ai = 0; ai < 2; ++ai)
#pragma unroll
            for (int m = 0; m < 4; ++m) { const int r = ai * HALF + wr * 64 + m * 16 + fr;
                f32x4 cs = {1.f, 1.f, 1.f, 1.f}, sn = {0.f, 0.f, 0.f, 0.f};
                if (u.mode != 7) { const int t = u.pm + r, pos = axis ? (t & 63) : (t >> 6); const float* rp = rope + (pos * 32 + f0) * 2;
                    const f32x4 p0 = *(const f32x4*)rp, p1 = *(const f32x4*)(rp + 4); cs = (f32x4){p0[0], p0[2], p1[0], p1[2]}; sn = (f32x4){p0[1], p0[3], p1[1], p1[3]}; }
#pragma unroll
                for (int bj = 0; bj < 2; ++bj) { const LAS f32x4* pp = (const LAS f32x4*)(red + (r * 2 + bj) * 4); const f32x4 ps = *pp;
                    const float rstd = 1.0f / sqrtf(((ps[0] + ps[1]) + (ps[2] + ps[3])) * (1.0f / HD) + 1e-6f);
                    const f32x4 xa = acc[ai][bj][m][0] * rstd * wa, xb = acc[ai][bj][m][1] * rstd * wb;
                    const f32x4 oa = xa * cs - xb * sn, ob = xb * cs + xa * sn;
                    u32x4 w; w.x = cvt_pk_bf16(oa[0], oa[1]); w.y = cvt_pk_bf16(oa[2], oa[3]); w.z = cvt_pk_bf16(ob[0], ob[1]); w.w = cvt_pk_bf16(ob[2], ob[3]);
                    *(u32x4*)((bf16_t*)u.C + (long)r * u.ldc + bj * HALF + wc * 32 + 8 * fq) = w; } }
    } };


struct EpiY8 {
    __device__ __forceinline__ void operator()(f32x4 (&acc)[2][2][4][2], const Unit& u, int wr, int wc, int fr, int fq) const {
        unsigned char* base = (unsigned char*)u.C + (size_t)(wr * 64 + fr) * u.ldc + wc * 32 + 8 * fq;
        const int r0 = wr * 64 + fr;
#pragma unroll
        for (int ai = 0; ai < 2; ++ai)
#pragma unroll
            for (int m = 0; m < 4; ++m) {
                if (r0 + ai * HALF + m * 16 < u.rows) { unsigned char* p = base + (size_t)(ai * HALF + m * 16) * u.ldc;
#pragma unroll
                    for (int bj = 0; bj < 2; ++bj) { f32x4 v0 = acc[ai][bj][m][0], v1 = acc[ai][bj][m][1];
#pragma unroll
                        for (int c = 0; c < 4; ++c) { v0[c] = fminf(fmaxf(v0[c], -448.f), 448.f); v1[c] = fminf(fmaxf(v1[c], -448.f), 448.f); }
                        int w0 = 0, w1 = 0;
                        w0 = __builtin_amdgcn_cvt_pk_fp8_f32(v0[0], v0[1], w0, false); w0 = __builtin_amdgcn_cvt_pk_fp8_f32(v0[2], v0[3], w0, true);
                        w1 = __builtin_amdgcn_cvt_pk_fp8_f32(v1[0], v1[1], w1, false); w1 = __builtin_amdgcn_cvt_pk_fp8_f32(v1[2], v1[3], w1, true);
                        *(unsigned long long*)(p + bj * HALF) = (unsigned long long)(unsigned)w0 | ((unsigned long long)(unsigned)w1 << 32); } } }
    } };

struct Args { const float* in[22]; float* out; unsigned char* ws; int ph_lo, ph_hi, use_ut, mod_off, do_attn, bar_idx; };
struct Frame {
    LAS unsigned char* lds; volatile LAS unsigned* MISC; unsigned char* ws;
    int tid, lane, wave, vcu, G;
};

__device__ __forceinline__ int qk_col_of_dim(int d) { const int a = d >> 6, half = (d >> 5) & 1, f = d & 31; return 32 * (2 * a + (f >> 4)) + 8 * ((f >> 2) & 3) + 4 * half + (f & 3); }
__device__ __forceinline__ void t64_load(f32x4 (&v)[16], const float* W, int ldw, int lane) {
    const unsigned off = (unsigned)(((lane >> 4) * ldw + (lane & 15) * 4) * 4);
#pragma unroll
    for (int j = 0; j < 16; ++j) { const char* bj = (const char*)W + (size_t)(j * 4) * ldw * 4; v[j] = __builtin_nontemporal_load((const GAS f32x4*)(bj + off)); }
}
template <bool QKPERM = false, bool F8OUT = false>
__device__ __forceinline__ void t64_store(const f32x4 (&v)[16], bf16_t* dst, int ldd, LAS float* scr, int lane, int d0 = 0) {
    const int kk = lane >> 4, nc = (lane & 15) * 4;
#pragma unroll
    for (int j = 0; j < 16; ++j) {
#pragma unroll
        for (int c = 0; c < 4; ++c) scr[(j * 4 + kk) * 65 + nc + c] = v[j][c]; }
    LDS_WAIT(); asm volatile("" ::: "memory");
    const int kc = lane & 7; const unsigned soff = F8OUT ? (unsigned)((lane >> 3) * ldd + 8 * kc) : (unsigned)(((lane >> 3) * ldd + 8 * kc) * 2);
#pragma unroll
    for (int jj = 0; jj < 8; jj += 2) {
        float t[2][8];
#pragma unroll
        for (int q = 0; q < 2; ++q) { const int n = (lane >> 3) + 8 * (jj + q); const LAS float* s = scr + (8 * kc) * 65 + n;
#pragma unroll
            for (int i = 0; i < 8; ++i) t[q][i] = s[i * 65]; }
#pragma unroll
        for (int q = 0; q < 2; ++q) { char* bq = (char*)dst + (size_t)(8 * (jj + q)) * ldd * (F8OUT ? 1 : 2);
            if constexpr (QKPERM) bq = (char*)dst + (size_t)(qk_col_of_dim(d0 + (lane >> 3) + 8 * (jj + q)) - (lane >> 3)) * ldd * 2;
            if constexpr (F8OUT) { float s[8];
#pragma unroll
                for (int i = 0; i < 8; ++i) s[i] = fminf(fmaxf(t[q][i] * 16.0f, -448.f), 448.f);
                int w0 = 0, w1 = 0; w0 = __builtin_amdgcn_cvt_pk_fp8_f32(s[0], s[1], w0, false); w0 = __builtin_amdgcn_cvt_pk_fp8_f32(s[2], s[3], w0, true);
                w1 = __builtin_amdgcn_cvt_pk_fp8_f32(s[4], s[5], w1, false); w1 = __builtin_amdgcn_cvt_pk_fp8_f32(s[6], s[7], w1, true);
                __builtin_nontemporal_store((unsigned long long)(unsigned)w0 | ((unsigned long long)(unsigned)w1 << 32), (GAS unsigned long long*)(bq + soff)); }
            else { u32x4 o; o.x = cvt_pk_bf16(t[q][0], t[q][1]); o.y = cvt_pk_bf16(t[q][2], t[q][3]); o.z = cvt_pk_bf16(t[q][4], t[q][5]); o.w = cvt_pk_bf16(t[q][6], t[q][7]);
                __builtin_nontemporal_store(o, (GAS u32x4*)(bq + soff)); } } }
    LDS_WAIT(); asm volatile("" ::: "memory");
}
__device__ __forceinline__ void transpose64(const float* W, int ldw, bf16_t* dst, int ldd, LAS float* scr, int lane) {
    f32x4 v[16]; t64_load(v, W, ldw, lane); t64_store(v, dst, ldd, scr, lane);
}

constexpr int IT_IN = 32 * 128, IT_FO = 16 * 32, IT_AO = 32 * 32, IT_O = 32 * 32, IT_EG = 64 * 256, IT_EU = 64 * 256, IT_ED = 64 * 256, IT_SH = 256;
constexpr int IT_T_END = IT_IN + IT_FO + IT_AO + IT_O + 3 * IT_SH;
constexpr int IT_MOD = MODC / 32, IT_CST = 4096, IT_BD2 = 512, IT_RWT = 32, IT_ROPE = 1;
constexpr int IT_ALL = IT_T_END + IT_MOD + IT_CST + IT_BD2 + IT_RWT + IT_ROPE;

__device__ __forceinline__ void mod_item(const Args& args, unsigned char* ws, int r, int lane) {
            const int kq = lane >> 3, col = r * 32 + (lane & 7) * 4;
            f32x4 a0 = {0.f, 0.f, 0.f, 0.f}, a1 = a0, a2 = a0;
            for (int jb = 0; jb < 256; jb += 8) {
                f32x4 w[8]; float c0[8], c1[8], c2[8];
#pragma unroll
                for (int j = 0; j < 8; ++j) { const int k = kq + 8 * (jb + j); w[j] = *(const GAS f32x4*)(args.in[4] + (size_t)k * MODC + col); c0[j] = args.in[1][k]; c1[j] = args.in[1][DM + k]; c2[j] = args.in[3][k]; }
#pragma unroll
                for (int j = 0; j < 8; ++j) { a0 += w[j] * (c0[j] * __builtin_amdgcn_rcpf(1.0f + __expf(-c0[j]))); a1 += w[j] * (c1[j] * __builtin_amdgcn_rcpf(1.0f + __expf(-c1[j]))); a2 += w[j] * (c2[j] * __builtin_amdgcn_rcpf(1.0f + __expf(-c2[j]))); }
            }
#pragma unroll
            for (int c = 0; c < 4; ++c) {
#pragma unroll
                for (int o = 8; o < 64; o <<= 1) { a0[c] += __shfl_xor(a0[c], o); a1[c] += __shfl_xor(a1[c], o); a2[c] += __shfl_xor(a2[c], o); } }
            if (kq == 0) { const f32x4 bb = *(const GAS f32x4*)(args.in[5] + col); float* MODP = (float*)(ws + WS_MOD);
                *(GAS f32x4*)(MODP + col) = a0 + bb; *(GAS f32x4*)(MODP + MODC + col) = a1 + bb; *(GAS f32x4*)(MODP + 2 * MODC + col) = a2 + bb; }
}
__device__ __forceinline__ void p0_prologue(Frame& F, const Args& args) {
    LAS float* scr = (LAS float*)(F.lds + F.wave * 16640);
    const int gw = F.vcu * NWAVES + F.wave, NGW = F.G * NWAVES, lane = F.lane;
    unsigned char* ws = F.ws;
    bf16_t* WT_IN = (bf16_t*)(ws + WS_WT_IN); bf16_t* WT_FO = (bf16_t*)(ws + WS_WT_FO); bf16_t* WT_AO = (bf16_t*)(ws + WS_WT_AO); bf16_t* WT_O = (bf16_t*)(ws + WS_WT_O);
    bf16_t* WT_GU = (bf16_t*)(ws + WS_WT_GU); bf16_t* WT_D = (bf16_t*)(ws + WS_WT_D);
    if (NGW >= 5 * IT_MOD) { if (gw % 5 == 0 && gw / 5 < IT_MOD) mod_item(args, ws, gw / 5, lane); }
    else for (int m = gw; m < IT_MOD; m += NGW) mod_item(args, ws, m, lane);
    for (int it = gw; it < IT_ALL - IT_MOD; it += NGW) {
        int r = it;
        if (r < IT_IN) { const int kb = r / 128, nb = r % 128, n0 = nb * 64;
            if (n0 >= Q_OFF && n0 < V_OFF) { f32x4 v[16]; t64_load(v, args.in[7] + (size_t)(kb * 64) * INC + n0, INC, lane);
                t64_store<true>(v, WT_IN + (size_t)(n0 & ~127) * DM + kb * 64, DM, scr, lane, n0 & 127); }
            else transpose64(args.in[7] + (size_t)(kb * 64) * INC + n0, INC, WT_IN + (size_t)n0 * DM + kb * 64, DM, scr, lane);
            continue; } r -= IT_IN;
        if (r < IT_FO) { const int kb = r / 32, nb = r % 32; transpose64(args.in[10] + (size_t)(kb * 64) * DM + nb * 64, DM, WT_FO + (size_t)(nb * 64) * YFP + kb * 64, YFP, scr, lane); continue; } r -= IT_FO;
        if (r < IT_AO) { const int kb = r / 32, nb = r % 32; transpose64(args.in[11] + (size_t)(kb * 64) * DM + nb * 64, DM, WT_AO + (size_t)(nb * 64) * DM + kb * 64, DM, scr, lane); continue; } r -= IT_AO;
        if (r < IT_O) { const int kb = r / 32, nb = r % 32; transpose64(args.in[12] + (size_t)(kb * 64) * DM + nb * 64, DM, WT_O + (size_t)(nb * 64) * DM + kb * 64, DM, scr, lane); continue; } r -= IT_O;
        if (r < 2 * IT_SH) { const int up = r >= IT_SH; if (up) r -= IT_SH; const int kb = r / 8, nb = r % 8, n0 = nb * 64;
            { f32x4 v[16]; t64_load(v, (up ? args.in[20] : args.in[19]) + (size_t)(kb * 64) * EFF + n0, EFF, lane);
              t64_store<false, true>(v, (bf16_t*)((unsigned char*)WT_GU + ((size_t)64 * 1024 + (n0 >> 7) * 256 + (up ? 128 : 0) + (n0 & 127)) * DM + kb * 64), DM, scr, lane); } continue; } r -= 2 * IT_SH;
        if (r < IT_SH) { const int kb = r / 32, nb = r % 32;
            { f32x4 v[16]; t64_load(v, args.in[21] + (size_t)(kb * 64) * DM + nb * 64, DM, lane); t64_store<false, true>(v, (bf16_t*)((unsigned char*)WT_D + ((size_t)64 * DM + nb * 64) * EFF + kb * 64), EFF, scr, lane); } continue; } r -= IT_SH;

        if (r < IT_CST) {
            const int k1 = r & 2047; bf16_t* dst = (bf16_t*)(ws + WS_CST) + (size_t)r * 2048;
#pragma unroll
            for (int j = 0; j < 4; ++j) { const int n0 = j * 512 + lane * 8; float f[8];
#pragma unroll
                for (int i = 0; i < 8; ++i) { const float ph = (float)((k1 * (n0 + i)) & 4095) * (1.0f / 2048.0f); f[i] = r < 2048 ? cospif(ph) : sinpif(ph); }
                u32x4 o; o.x = cvt_pk_bf16(f[0], f[1]); o.y = cvt_pk_bf16(f[2], f[3]); o.z = cvt_pk_bf16(f[4], f[5]); o.w = cvt_pk_bf16(f[6], f[7]);
                *(GAS u32x4*)(dst + n0) = o; }
            continue; } r -= IT_CST;
        if (r < IT_BD2) {
            const int t = r >> 8, o = r & 255, gp = o >> 7, k2 = o & 127; bf16_t* dst = (bf16_t*)(ws + WS_BD2) + (size_t)r * 512; float f[8];
#pragma unroll
            for (int i = 0; i < 8; ++i) { const int j = lane * 8 + i, cg = j >> 8, jj = j & 255, c = jj & 127; const float ph = (float)((32 * c * k2) & 4095) * (1.0f / 2048.0f);
                const float v = jj < 128 ? cospif(ph) : (t ? sinpif(ph) : -sinpif(ph)); f[i] = cg == gp ? v * 0.0013810679320049757f : 0.f; }
            u32x4 w; w.x = cvt_pk_bf16(f[0], f[1]); w.y = cvt_pk_bf16(f[2], f[3]); w.z = cvt_pk_bf16(f[4], f[5]); w.w = cvt_pk_bf16(f[6], f[7]);
            *(GAS u32x4*)(dst + lane * 8) = w;
            continue; } r -= IT_BD2;
        if (r >= IT_RWT) {
            float* RT = (float*)(ws + WS_ROPE);
            for (int idx = lane; idx < 64 * 32; idx += 64) { const float ang = (float)(idx >> 5) * exp2f(-(float)(idx & 31) * (13.287712379549449f / 32.0f)); RT[2 * idx] = cosf(ang); RT[2 * idx + 1] = sinf(ang); }
            continue; }
        {
            f32x4 v[16]; t64_load(v, args.in[14] + (size_t)(r * 64) * NE, NE, lane);
            const int kk = lane >> 4, nc = (lane & 15) * 4;
#pragma unroll
            for (int j = 0; j < 16; ++j) {
#pragma unroll
                for (int c = 0; c < 4; ++c) scr[(j * 4 + kk) * 65 + nc + c] = v[j][c]; }
            LDS_WAIT(); asm volatile("" ::: "memory");
            const int kc = lane & 7; bf16_t* RWT = (bf16_t*)(ws + WS_RWT);
#pragma unroll
            for (int jj = 0; jj < 8; ++jj) { const int e = (lane >> 3) + 8 * jj; const LAS float* s = scr + (8 * kc) * 65 + e; float t[8], l[8];
#pragma unroll
                for (int i = 0; i < 8; ++i) { t[i] = s[i * 65]; l[i] = t[i] - bf2f(f2bf(t[i])); }
                u32x4 h, lo; h.x = cvt_pk_bf16(t[0], t[1]); h.y = cvt_pk_bf16(t[2], t[3]); h.z = cvt_pk_bf16(t[4], t[5]); h.w = cvt_pk_bf16(t[6], t[7]);
                lo.x = cvt_pk_bf16(l[0], l[1]); lo.y = cvt_pk_bf16(l[2], l[3]); lo.z = cvt_pk_bf16(l[4], l[5]); lo.w = cvt_pk_bf16(l[6], l[7]);
                *(GAS u32x4*)(RWT + (size_t)e * DM + r * 64 + 8 * kc) = h; *(GAS u32x4*)(RWT + (size_t)(NE + e) * DM + r * 64 + 8 * kc) = lo; }
            LDS_WAIT(); asm volatile("" ::: "memory");
        }
    }
}


__device__ __forceinline__ void conv_addr(const Args& args, unsigned char* ws, bool down, int it, const float*& W, int& ldw, bf16_t*& dst, int& ldd) {
    if (!down) { int r = it; const int up = r >= IT_EG; if (up) r -= IT_EG;
        const int e = r / 256, q = r % 256, kb = q / 8, nb = q % 8, n0 = nb * 64;
        W = (up ? args.in[17] : args.in[16]) + (size_t)e * DM * EFF + (size_t)(kb * 64) * EFF + n0; ldw = EFF;
        dst = (bf16_t*)(ws + WS_WT_GU + ((size_t)e * 1024 + (n0 >> 7) * 256 + (up ? 128 : 0) + (n0 & 127)) * DM + kb * 64); ldd = DM;
    } else { const int r = it, e = r / 256, q = r % 256, kb = q / 32, nb = q % 32;
        W = args.in[18] + (size_t)e * EFF * DM + (size_t)(kb * 64) * DM + nb * 64; ldw = DM;
        dst = (bf16_t*)(ws + WS_WT_D + ((size_t)e * DM + nb * 64) * EFF + kb * 64); ldd = EFF; }
}
__device__ __forceinline__ void conv_items(Frame& F, const Args& args, bool down, int first, int count) {
    LAS float* scr = (LAS float*)(F.lds + F.wave * 16640);
    const int end = first + count; int it = first + F.wave;
    if (it >= end) return;
    f32x4 va[16], vb[16]; const float* W; int ldw; bf16_t* da; bf16_t* db; int ldd;
    conv_addr(args, F.ws, down, it, W, ldw, da, ldd); t64_load(va, W, ldw, F.lane);
    for (;;) {
        const bool hb = it + NWAVES < end;
        if (hb) { conv_addr(args, F.ws, down, it + NWAVES, W, ldw, db, ldd); t64_load(vb, W, ldw, F.lane); }
        t64_store<false, true>(va, da, ldd, scr, F.lane);
        if (!hb) break;
        const bool ha = it + 2 * NWAVES < end;
        if (ha) { conv_addr(args, F.ws, down, it + 2 * NWAVES, W, ldw, da, ldd); t64_load(va, W, ldw, F.lane); }
        t64_store<false, true>(vb, db, ldd, scr, F.lane);
        if (!ha) break;
        it += 2 * NWAVES;
    }
}
struct SchedIn {
    int G, c; unsigned char* ws; int use_ut;
    __device__ __forceinline__ bool next(int i, Unit& u) const {
        const int L = i * G + c; if (L >= 1024) return false;
        const char* H = (const char*)(ws + WS_H); const char* WT = (const char*)(ws + WS_WT_IN);
        u.rows = 256; u.aux = 0; u.bjs = HALF; u.pm = 0; u.pn = 0; u.rmin = 0; u.nt = DM / BK; u.keep = 0;
        if (L < 896) {
            int pm, ct; grid_map(L, 32, 28, pm, ct);
            const int row0 = pm * 256, b = row0 / SEQ, t0 = row0 % SEQ;
            u.A = H + (size_t)row0 * DM * 2; u.B = WT + (size_t)ct * 256 * DM * 2;
            if (ct < 4) {
                if (use_ut) { u.A = WT + (size_t)ct * 256 * DM * 2; u.B = H + (size_t)row0 * DM * 2;
                              u.C = (char*)(ws + WS_UT) + (((size_t)b * FW + ct * 256) * SEQ + t0) * 2; u.ldc = SEQ; u.mode = 0; }
                else { u.C = (char*)(ws + WS_U) + ((size_t)row0 * FW + ct * 256) * 2; u.ldc = FW; u.mode = 0; }
            }
            else if (ct < 12) { u.C = (char*)(ws + WS_Q) + ((size_t)row0 * DM + (ct - 4) * 256) * 2; u.ldc = DM; u.mode = 5; u.pm = t0; }
            else if (ct < 14) { u.C = (char*)(ws + WS_KALL) + (((size_t)b * SKV + t0) * KVW + (ct - 12) * 256) * 2; u.ldc = KVW; u.mode = 6; u.pm = t0; }
            else if (ct < 16) { u.C = (char*)(ws + WS_VALL) + (((size_t)b * SKV + t0) * KVW + (ct - 14) * 256) * 2; u.ldc = KVW; u.mode = 0; }
            else if (ct < 24) { u.C = (char*)(ws + WS_SGF) + ((size_t)row0 * DM + (ct - 16) * 256) * 2; u.ldc = DM; u.mode = 2; }
            else              { u.C = (char*)(ws + WS_SGA) + ((size_t)row0 * DM + (ct - 24) * 256) * 2; u.ldc = DM; u.mode = 2; }
        } else if (L >= 904) {
            int pm, q; grid_map(L - 904, 32, 4, pm, q); const int ct = 28 + q;
            u.A = H + (size_t)pm * 256 * DM * 2; u.B = WT + (size_t)ct * 256 * DM * 2;
            u.C = (char*)(ws + WS_SGA) + ((size_t)pm * 256 * DM + (ct - 24) * 256) * 2; u.ldc = DM; u.mode = 2;
        } else {
            const int l = L - 896, pm = l & 1, ct = l >> 1;
            u.A = H + (size_t)(NTOK + pm * 256) * DM * 2; u.B = WT + (size_t)(K_OFF + ct * 256) * DM * 2;
            if (ct < 2) { u.C = (char*)(ws + WS_KALL) + (((size_t)pm * SKV + SEQ) * KVW + ct * 256) * 2; u.ldc = KVW; u.mode = 7; }
            else        { u.C = (char*)(ws + WS_VALL) + (((size_t)pm * SKV + SEQ) * KVW + (ct - 2) * 256) * 2; u.ldc = KVW; u.mode = 0; }
        }
        return true;
    }
    __device__ __forceinline__ unsigned arow(const Unit&, int) const { return 0u; }
};


__device__ __forceinline__ void unpack8(u32x4 w, float (&f)[8]) {
#pragma unroll
    for (int i = 0; i < 4; ++i) { f[2 * i] = __uint_as_float(w[i] << 16); f[2 * i + 1] = __uint_as_float(w[i] & 0xffff0000u); }
}
struct EpiMerge { const bf16_t* SGF; const bf16_t* SGA; bf16_t* YM;
    __device__ __forceinline__ void operator()(f32x4 (&acc)[2][2][4][2], const Unit& u, int wr, int wc, int fr, int fq) const {
#pragma unroll
        for (int ai = 0; ai < 2; ++ai)
#pragma unroll
            for (int m = 0; m < 4; ++m) { const size_t row = (size_t)u.pm * 256 + ai * HALF + wr * 64 + m * 16 + fr;
#pragma unroll
                for (int bj = 0; bj < 2; ++bj) { const size_t o = row * DM + u.pn * 256 + bj * HALF + wc * 32 + 8 * fq;
                    float ga[8]; unpack8(*(const u32x4*)(SGA + o), ga);
#pragma unroll
                    for (int c = 0; c < 8; ++c) ga[c] = fmaxf(ga[c], 1e-20f);
                    if (u.keep) { float gf[8]; unpack8(*(const u32x4*)(SGF + o), gf);
#pragma unroll
                        for (int c = 0; c < 4; ++c) { acc[ai][bj][m][0][c] *= gf[c] * __builtin_amdgcn_rcpf(ga[c]); acc[ai][bj][m][1][c] *= gf[4 + c] * __builtin_amdgcn_rcpf(ga[4 + c]); }
                    } else { const f32x4 v0 = acc[ai][bj][m][0], v1 = acc[ai][bj][m][1];
                        u32x4 w; w.x = cvt_pk_bf16(ga[0] * v0[0], ga[1] * v0[1]); w.y = cvt_pk_bf16(ga[2] * v0[2], ga[3] * v0[3]); w.z = cvt_pk_bf16(ga[4] * v1[0], ga[5] * v1[1]); w.w = cvt_pk_bf16(ga[6] * v1[2], ga[7] * v1[3]);
                        *(u32x4*)(YM + o) = w; } } }
    } };
struct SchedMerge { int G, c; unsigned char* ws;
    __device__ __forceinline__ bool next(int i, Unit& u) const {
        const int L = (i >> 1) * G + c; if (L >= 256) return false;
        int pm, pn; grid_map(L, 32, 8, pm, pn); const int kb = i & 1;
        u.A = (const char*)(ws + (kb ? WS_YA : WS_YF)) + (size_t)pm * 256 * DM * 2; u.B = (const char*)(ws + (kb ? WS_WT_AO : WS_WT_FO)) + (size_t)pn * 256 * DM * 2;
        u.C = nullptr; u.ldc = DM; u.mode = 0; u.rows = 256; u.aux = 0; u.pm = pm; u.pn = pn; u.bjs = HALF; u.rmin = 0; u.nt = kb ? DM / BK : FW / BK; u.keep = kb ? 0 : 1;
        return true; }
    __device__ __forceinline__ unsigned arow(const Unit&, int) const { return 0u; } };
struct EpiX2 { const float* x; const float* mod; float* X2;
    __device__ __forceinline__ void operator()(f32x4 (&acc)[2][2][4][2], const Unit& u, int wr, int wc, int fr, int fq) const {
        const float* g1 = mod + ((u.pm * 256) / SEQ) * MODC + 2 * DM;
#pragma unroll
        for (int ai = 0; ai < 2; ++ai)
#pragma unroll
            for (int m = 0; m < 4; ++m) { const size_t row = (size_t)u.pm * 256 + ai * HALF + wr * 64 + m * 16 + fr;
#pragma unroll
                for (int bj = 0; bj < 2; ++bj) { const int col = u.pn * 256 + bj * HALF + wc * 32 + 8 * fq; const size_t o = row * DM + col;
#pragma unroll
                    for (int n = 0; n < 2; ++n) { const f32x4 xv = *(const f32x4*)(x + o + 4 * n), gv = *(const f32x4*)(g1 + col + 4 * n); *(f32x4*)(X2 + o + 4 * n) = xv + gv * acc[ai][bj][m][n]; } } }
    } };
struct EpiAct {
    __device__ __forceinline__ void operator()(f32x4 (&acc)[2][2][4][2], const Unit& u, int wr, int wc, int fr, int fq) const {
#pragma unroll
        for (int ai = 0; ai < 2; ++ai)
#pragma unroll
            for (int m = 0; m < 4; ++m) { const int r = ai * HALF + wr * 64 + m * 16 + fr;
                if (r < u.rows) { float a[8];
#pragma unroll
                    for (int n = 0; n < 2; ++n)
#pragma unroll
                        for (int c = 0; c < 4; ++c) { const float g = acc[ai][0][m][n][c], up = acc[ai][1][m][n][c]; a[4 * n + c] = g * __builtin_amdgcn_rcpf(1.0f + __expf(-g)) * up; }
#pragma unroll
                    for (int c = 0; c < 8; ++c) a[c] = fminf(fmaxf(a[c], -448.f), 448.f);
                    int w0 = 0, w1 = 0; w0 = __builtin_amdgcn_cvt_pk_fp8_f32(a[0], a[1], w0, false); w0 = __builtin_amdgcn_cvt_pk_fp8_f32(a[2], a[3], w0, true);
                    w1 = __builtin_amdgcn_cvt_pk_fp8_f32(a[4], a[5], w1, false); w1 = __builtin_amdgcn_cvt_pk_fp8_f32(a[6], a[7], w1, true);
                    *(unsigned long long*)((unsigned char*)u.C + (size_t)r * u.ldc + wc * 32 + 8 * fq) = (unsigned long long)(unsigned)w0 | ((unsigned long long)(unsigned)w1 << 32); } }
    } };

struct SchedGrid {
    int G, c, nM, nN; const char* A; const char* B; char* C; size_t astride, bstride; int ldc, esz, mode, nt;
    __device__ __forceinline__ bool next(int i, Unit& u) const {
        const int L = i * G + c; if (L >= nM * nN) return false;
        int pm, pn; grid_map(L, nM, nN, pm, pn);
        u.A = A + (size_t)pm * astride; u.B = B + (size_t)pn * bstride; u.C = C + ((size_t)pm * 256 * ldc + pn * 256) * esz; u.ldc = ldc; u.mode = mode; u.rows = 256; u.aux = 0; u.pm = pm; u.pn = pn; u.bjs = HALF; u.rmin = 0; u.nt = nt; u.keep = 0;
        return true; }
    __device__ __forceinline__ unsigned arow(const Unit&, int) const { return 0u; } };
struct SchedAG { int G, c; unsigned char* ws;
    __device__ __forceinline__ bool next(int i, Unit& u) const {
        const int L = i * G + c; if (L >= 136) return false;
        u.rows = 256; u.aux = 0; u.rmin = 0; u.nt = DM / BK; u.keep = 0;
        if (L < 128) {
            int pm, pn8; grid_map(L, 16, 8, pm, pn8); const int b = pn8 >> 2, pn = pn8 & 3, sn = pm >> 3, k1t = pm & 7;
            u.A = (const char*)(ws + WS_CST) + (size_t)pm * 256 * 2048 * 2; u.B = (const char*)(ws + (sn ? WS_OT : WS_ET)) + ((size_t)b * FW + pn * 256) * 2048 * 2;
            u.C = (char*)(ws + WS_TT) + (((size_t)b * 2048 + k1t * 256) * DM + pn * 512 + sn * 128) * 2; u.ldc = DM; u.mode = sn ? 0 : 3; u.pm = k1t; u.pn = b * FW + pn * 256; u.bjs = 256;
        } else {
            int pm, q; grid_map(L - 128 + 120, 32, 4, pm, q); const int ct = 28 + q;
            u.A = (const char*)(ws + WS_H) + (size_t)pm * 256 * DM * 2; u.B = (const char*)(ws + WS_WT_IN) + (size_t)ct * 256 * DM * 2;
            u.C = (char*)(ws + WS_SGA) + ((size_t)pm * 256 * DM + (ct - 24) * 256) * 2; u.ldc = DM; u.mode = 2; u.pm = pm; u.pn = ct; u.bjs = HALF;
        }
        return true; }
    __device__ __forceinline__ unsigned arow(const Unit&, int) const { return 0u; } };
struct SchedF2 { int G, c; unsigned char* ws;
    __device__ __forceinline__ bool next(int i, Unit& u) const {
        const int L = i * G + c; if (L >= 128) return false;
        int pm, q; grid_map(L, 16, 8, pm, q); const int b = pm >> 3, k1t = pm & 7, j = q & 3, mir = q >> 2;
        u.A = (const char*)(ws + WS_TT) + (((size_t)b * 2048 + k1t * 256) * DM + j * 512) * 2; u.B = (const char*)(ws + WS_BD2) + (size_t)mir * 256 * 512 * 2;
        u.mode = 0; u.rows = 256; u.aux = 0; u.pm = pm; u.pn = j; u.bjs = HALF; u.nt = 512 / BK; u.keep = 0;
        if (!mir) { u.C = (char*)(ws + WS_YF) + (((size_t)b * SEQ + k1t * 256) * YFP + j * 256) * 2; u.ldc = YFP; u.rmin = 0; }
        else { u.C = (char*)(ws + WS_YF) + (((size_t)b * SEQ + SEQ - k1t * 256) * YFP + j * 256) * 2; u.ldc = -YFP; u.rmin = k1t == 0 ? 1 : 0; }
        return true; }
    __device__ __forceinline__ unsigned arow(const Unit&, int) const { return 0u; } };
constexpr int SCHT_OFF = LDSCTL_OFF + 1024;
__device__ __forceinline__ void moe_tables(Frame& F, int ncol_tiles) {
    LAS int* T = (LAS int*)(F.lds + SCHT_OFF);
    __syncthreads();
    if (F.tid == 0) { const int* CNT = (const int*)(F.ws + CTL_CNT); int up = 0, of = 0;
        for (int e = 0; e <= NE; ++e) { const int cn = e < NE ? CNT[e * 64] : NTOK; T[e] = up; T[80 + e] = e < NE ? of : NSLOT; T[160 + e] = cn; up += ((cn + 255) >> 8) * ncol_tiles; of += cn; }
        T[NE + 1] = up; }
    __syncthreads();
}
template <int NCT, bool FIRST> struct SchedMoe {
    int G, c; unsigned char* ws; LAS int* T; const int* TOK;
    __device__ __forceinline__ int tl(int i) const { return __builtin_amdgcn_readfirstlane(T[i]); }
    __device__ __forceinline__ bool next(int i, Unit& u) const {
        const int L = i * G + c; if (L >= tl(NE + 1)) return false;
        int lo = 0, hi = NE;
#pragma unroll 1
        while (lo < hi) { const int mid = (lo + hi + 1) >> 1; if (tl(mid) <= L) lo = mid; else hi = mid - 1; }
        const int e = lo, cn = tl(160 + e), ntile = (cn + 255) >> 8, local = L - tl(e), ct = local / ntile, mt = local % ntile, slot0 = tl(80 + e) + mt * 256;
        u.rows = (cn - mt * 256) < 256 ? (cn - mt * 256) : 256; u.aux = slot0; u.pm = mt; u.pn = ct; u.bjs = HALF; u.mode = 0; u.rmin = 0; u.e = e; u.nt = (FIRST ? DM : EFF) / 128; u.keep = 0;
        if (FIRST) { u.A = (const char*)(ws + WS_H2); u.B = (const char*)(ws + WS_WT_GU) + ((size_t)e * 4 + ct) * 256 * DM; u.C = (char*)(ws + WS_ACT) + ((size_t)slot0 * EFF + ct * 128); u.ldc = EFF; }
        else { u.A = (const char*)(ws + WS_ACT) + (size_t)slot0 * EFF; u.B = (const char*)(ws + WS_WT_D) + ((size_t)e * DM + ct * 256) * EFF; u.C = (char*)(ws + WS_YBIG) + ((size_t)slot0 * DM + ct * 256); u.ldc = DM; u.mode = 8; }
        return true; }
    __device__ __forceinline__ unsigned arow(const Unit& u, int r) const { const int rr = u.pm * 256 + (r < u.rows ? r : u.rows - 1); const int tok = u.e < NE ? TOK[u.e * NTOK + rr] : rr; return (unsigned)tok * (unsigned)DM; } };

namespace attn {
using s16x4 = __attribute__((ext_vector_type(4))) short;
using f32x8 = __attribute__((ext_vector_type(8))) float;
constexpr int D = 128, NW = 8, QBLK = 32, KVBLK = 64;
constexpr float SCALE = 0.088388347648318440f;
constexpr float THR = 8.f;
constexpr int LDQ = DM, LDK = KVW, LDO = DM;
constexpr size_t SHM_V = KVBLK * D * 2, SHM_K = KVBLK * D * 2, SHM_ATTN = 2 * SHM_V + 2 * SHM_K + NW * 64 * 4;
#define KSWZ(row, colB) ((row) * 256 + ((colB) ^ (((row) & 7) << 4)))
#define SBAR() __builtin_amdgcn_sched_barrier(0)
__device__ __forceinline__ unsigned cvtpk(float lo, float hi) { unsigned r; asm volatile("v_cvt_pk_bf16_f32 %0, %1, %2" : "=v"(r) : "v"(lo), "v"(hi)); return r; }
__device__ __forceinline__ void partialSM(f32x16& p0, f32x16& p1, float& m_reg, float& mn, float& alpha) {
  constexpr float C = SCALE * 1.4426950408889634f;
  float pmax = p0[0]; for (int r = 1; r < 16; ++r) pmax = fmaxf(pmax, p0[r]); for (int r = 0; r < 16; ++r) pmax = fmaxf(pmax, p1[r]);
  { auto rr = __builtin_amdgcn_permlane32_swap(__float_as_uint(pmax), __float_as_uint(pmax), false, false);
    pmax = fmaxf(__uint_as_float(rr[0]), __uint_as_float(rr[1])); }
  if (__builtin_expect(__all(pmax - m_reg <= THR / SCALE), 1)) { mn = m_reg; alpha = 1.f; }
  else { mn = fmaxf(m_reg, pmax); alpha = __builtin_amdgcn_exp2f((m_reg - mn) * C); m_reg = mn; }
  float mnC = -mn * C;
  for (int r = 0; r < 16; ++r) p0[r] = fmaf(p0[r], C, mnC); for (int r = 0; r < 16; ++r) p1[r] = fmaf(p1[r], C, mnC);
  for (int r = 0; r < 16; ++r) p0[r] = __builtin_amdgcn_exp2f(p0[r]);
}
__device__ __forceinline__ void finishSM(f32x16& p0, f32x16& p1, float alpha, float& l_reg, bf16x8& pa0, bf16x8& pa1, bf16x8& pa2, bf16x8& pa3) {
  for (int r = 0; r < 16; ++r) p1[r] = __builtin_amdgcn_exp2f(p1[r]);
  float ps = 0; for (int r = 0; r < 16; ++r) ps += p0[r]; for (int r = 0; r < 16; ++r) ps += p1[r];
  { auto rr = __builtin_amdgcn_permlane32_swap(__float_as_uint(ps), __float_as_uint(ps), false, false);
    ps = __uint_as_float(rr[0]) + __uint_as_float(rr[1]); }
  l_reg = l_reg * alpha + ps;
#define PK4(P, BASE, OUT) do { unsigned a0 = cvtpk(P[BASE + 0], P[BASE + 1]), a1 = cvtpk(P[BASE + 2], P[BASE + 3]);   \
    unsigned b0 = cvtpk(P[BASE + 4], P[BASE + 5]), b1 = cvtpk(P[BASE + 6], P[BASE + 7]);                              \
    auto r0 = __builtin_amdgcn_permlane32_swap(a0, b0, false, false); auto r1 = __builtin_amdgcn_permlane32_swap(a1, b1, false, false); \
    u32x4 w = {r0[0], r1[0], r0[1], r1[1]}; OUT = *reinterpret_cast<bf16x8*>(&w); } while (0)
  PK4(p0, 0, pa0); PK4(p0, 8, pa1); PK4(p1, 0, pa2); PK4(p1, 8, pa3);
#undef PK4
}
__device__ __forceinline__ void qkt(f32x16& p0, f32x16& p1, const bf16_t* Ks, const bf16x8* qr, int r32, int hi) {
  p0 = f32x16{}; p1 = f32x16{};
  for (int d0 = 0; d0 < 8; ++d0) { int cb = (d0 * 16 + hi * 8) * 2;
    bf16x8 b0 = *reinterpret_cast<const bf16x8*>((const char*)Ks + KSWZ(r32, cb));
    bf16x8 b1 = *reinterpret_cast<const bf16x8*>((const char*)Ks + KSWZ(32 + r32, cb));
    p0 = __builtin_amdgcn_mfma_f32_32x32x16_bf16(b0, qr[d0], p0, 0, 0, 0);
    p1 = __builtin_amdgcn_mfma_f32_32x32x16_bf16(b1, qr[d0], p1, 0, 0, 0); }
}
__device__ __forceinline__ int v_st(int k, int c) { const int kk = (k & ~0xC) | ((k & 4) << 1) | ((k & 8) >> 1); return ((kk >> 3) * 4 + (c >> 5)) * 512 + ((kk & 7) * 32 + (c & 31)) * 2; }
__device__ __forceinline__ int v_rd_base(int lane) { return ((lane & 3) << 3) | (((lane >> 2) & 3) << 6) | (((lane >> 4) & 1) << 5) | (((lane >> 5) & 1) << 8); }
constexpr int v_rd_off(int d0, int ks, int half) { return d0 * 512 + ks * 4096 + half * 2048; }
template <int OFF> __device__ __forceinline__ s16x4 tr_read(int vb) {
  s16x4 r; asm volatile("ds_read_b64_tr_b16 %0, %1 offset:%2" : "=&v"(r) : "v"(vb), "i"(OFF) : "memory"); return r;
}
template <int D0> __device__ __forceinline__ void pv_one(f32x16& od, int vb, bf16x8 pa0, bf16x8 pa1, bf16x8 pa2, bf16x8 pa3) {
  const s16x4 l0 = tr_read<v_rd_off(D0, 0, 0)>(vb), h0 = tr_read<v_rd_off(D0, 0, 1)>(vb), l1 = tr_read<v_rd_off(D0, 1, 0)>(vb), h1 = tr_read<v_rd_off(D0, 1, 1)>(vb);
  const s16x4 l2 = tr_read<v_rd_off(D0, 2, 0)>(vb), h2 = tr_read<v_rd_off(D0, 2, 1)>(vb), l3 = tr_read<v_rd_off(D0, 3, 0)>(vb), h3 = tr_read<v_rd_off(D0, 3, 1)>(vb);
  asm volatile("s_waitcnt lgkmcnt(0)" ::: "memory"); SBAR();
#define PK(L, H) (bf16x8){L[0], L[1], L[2], L[3], H[0], H[1], H[2], H[3]}
  od = __builtin_amdgcn_mfma_f32_32x32x16_bf16(pa0, PK(l0, h0), od, 0, 0, 0);
  od = __builtin_amdgcn_mfma_f32_32x32x16_bf16(pa1, PK(l1, h1), od, 0, 0, 0);
  od = __builtin_amdgcn_mfma_f32_32x32x16_bf16(pa2, PK(l2, h2), od, 0, 0, 0);
  od = __builtin_amdgcn_mfma_f32_32x32x16_bf16(pa3, PK(l3, h3), od, 0, 0, 0);
#undef PK
}
__device__ __forceinline__ void pv_d0(f32x16* o, int vb, bf16x8 pa0, bf16x8 pa1, bf16x8 pa2, bf16x8 pa3) {
  pv_one<0>(o[0], vb, pa0, pa1, pa2, pa3); pv_one<1>(o[1], vb, pa0, pa1, pa2, pa3); pv_one<2>(o[2], vb, pa0, pa1, pa2, pa3); pv_one<3>(o[3], vb, pa0, pa1, pa2, pa3);
}
__device__ __forceinline__ void attn_dense_body(const bf16_t* __restrict__ Qb, const bf16_t* __restrict__ Kh, const bf16_t* __restrict__ Vh, bf16_t* __restrict__ Ob, int seq, char* lds) {
  const int tid = threadIdx.x, wid = tid >> 6, lane = tid & 63, r32 = lane & 31, hi = lane >> 5;
  bf16_t* V_lds = (bf16_t*)lds; bf16_t* K_lds = (bf16_t*)(lds + 2 * SHM_V);
  float* ws = (float*)(lds + 2 * SHM_V + 2 * SHM_K) + wid * 64; float* li_l = ws; float* al_l = ws + 32;
  float m_reg = -1e30f, l_reg = 0; f32x16 o[4] = {}; bf16x8 qr[8];
  const bf16_t* Qw = Qb + (long)(wid * QBLK + r32) * LDQ + hi * 8;
#pragma unroll
  for (int d0 = 0; d0 < 8; ++d0) qr[d0] = *reinterpret_cast<const bf16x8*>(Qw + d0 * 16);
  const int sr = tid >> 4, sc = (tid & 15) * 8, vst0 = v_st(sr, sc), vst1 = v_st(32 + sr, sc);
  const int vb0 = (int)(uintptr_t)V_lds + v_rd_base(lane);
  struct { bf16x8 vs0, vs1, ks0, ks1; } sr_[2];
#define SLOAD(i, k0) do { sr_[i].vs0 = *reinterpret_cast<const bf16x8*>(&Vh[(long)((k0) + sr) * LDK + sc]); sr_[i].vs1 = *reinterpret_cast<const bf16x8*>(&Vh[(long)((k0) + 32 + sr) * LDK + sc]); \
    sr_[i].ks0 = *reinterpret_cast<const bf16x8*>(&Kh[(long)((k0) + sr) * LDK + sc]); sr_[i].ks1 = *reinterpret_cast<const bf16x8*>(&Kh[(long)((k0) + 32 + sr) * LDK + sc]); } while (0)
#define SWRITE(b, i) do { *(bf16x8*)((char*)V_lds + (b) * SHM_V + vst0) = sr_[i].vs0;          \
    *(bf16x8*)((char*)V_lds + (b) * SHM_V + vst1) = sr_[i].vs1; int kc = sc * 2;               \
    *(bf16x8*)((char*)K_lds + (b) * SHM_K + KSWZ(sr, kc)) = sr_[i].ks0;                       \
    *(bf16x8*)((char*)K_lds + (b) * SHM_K + KSWZ(32 + sr, kc)) = sr_[i].ks1; } while (0)
#define SWAIT() asm volatile("s_waitcnt vmcnt(4)" ::: "memory")
#define RESC(a) do { if (__any((a) < 1.f)) { if (hi == 0) al_l[r32] = (a); asm volatile("s_waitcnt lgkmcnt(0)" ::: "memory"); \
    for (int d = 0; d < 4; ++d) for (int r = 0; r < 16; ++r) o[d][r] *= al_l[crow(r, hi)]; } } while (0)
  f32x16 pA0, pA1, pB0, pB1; float mnA, mnB, alA, alB; bf16x8 pa0, pa1, pa2, pa3; const int NT = seq / KVBLK;
  constexpr int SE = 0, SO = 1;
  SLOAD(SE, 0); asm volatile("s_waitcnt vmcnt(0)" ::: "memory"); SWRITE(0, SE); __syncthreads();
  qkt(pA0, pA1, K_lds, qr, r32, hi); partialSM(pA0, pA1, m_reg, mnA, alA);
  SLOAD(SO, KVBLK); if (2 < NT) SLOAD(SE, 2 * KVBLK);
  SWAIT(); SWRITE(1, SO); __syncthreads();
  for (int j = 1; j + 1 < NT; j += 2) {
    SBAR(); qkt(pB0, pB1, (bf16_t*)((char*)K_lds + SHM_K), qr, r32, hi);
    finishSM(pA0, pA1, alA, l_reg, pa0, pa1, pa2, pa3); SBAR();
    SLOAD(SO, (j + 2) * KVBLK); SBAR();
    pv_d0(o, vb0, pa0, pa1, pa2, pa3); partialSM(pB0, pB1, m_reg, mnB, alB);
    __syncthreads(); SWAIT(); SWRITE(0, SE);
    RESC(alB); __syncthreads();
    SBAR(); qkt(pA0, pA1, K_lds, qr, r32, hi);
    finishSM(pB0, pB1, alB, l_reg, pa0, pa1, pa2, pa3); SBAR();
    if (j + 3 < NT) SLOAD(SE, (j + 3) * KVBLK); SBAR();
    pv_d0(o, vb0 + (int)SHM_V, pa0, pa1, pa2, pa3); partialSM(pA0, pA1, m_reg, mnA, alA);
    __syncthreads(); SWAIT(); SWRITE(1, SO);
    RESC(alA); __syncthreads();
  }
  SBAR(); qkt(pB0, pB1, (bf16_t*)((char*)K_lds + SHM_K), qr, r32, hi);
  finishSM(pA0, pA1, alA, l_reg, pa0, pa1, pa2, pa3); SBAR();
  pv_d0(o, vb0, pa0, pa1, pa2, pa3); partialSM(pB0, pB1, m_reg, mnB, alB);
  __syncthreads(); RESC(alB);
  finishSM(pB0, pB1, alB, l_reg, pa0, pa1, pa2, pa3); SBAR();
  pv_d0(o, vb0 + (int)SHM_V, pa0, pa1, pa2, pa3);
  if (hi == 0) li_l[r32] = l_reg; asm volatile("s_waitcnt lgkmcnt(0)" ::: "memory");
  float rli[16];
#pragma unroll
  for (int r = 0; r < 16; ++r) rli[r] = __builtin_amdgcn_rcpf(li_l[crow(r, hi)]);
  bf16_t* Ow = Ob + (long)(wid * QBLK) * LDO;
#pragma unroll
  for (int r = 0; r < 16; ++r) { int orow = crow(r, hi);
    for (int d0 = 0; d0 < 4; ++d0) Ow[(long)orow * LDO + d0 * 32 + r32] = f2bf(o[d0][r] * rli[r]); }
#undef SLOAD
#undef SWRITE
#undef SWAIT
#undef RESC
}
#undef KSWZ
#undef SBAR
}

__device__ __forceinline__ void ph_norm1(Frame& F, const Args& args, const float* mod) {
    const int gw = F.vcu * NWAVES + F.wave, NGW = F.G * NWAVES, lane = F.lane;
    bf16_t* H = (bf16_t*)(F.ws + WS_H); const float* nw = args.in[6];
    for (int row = gw; row < NTOK + NCTX; row += NGW) {
        const float* src = row < NTOK ? args.in[0] + (size_t)row * DM : args.in[2] + (size_t)(row - NTOK) * DM;
        const float* mr = mod + (row < NTOK ? row / SEQ : 2) * MODC;
        f32x4 v[8]; float ss = 0.f;
#pragma unroll
        for (int j = 0; j < 8; ++j) { v[j] = *(const GAS f32x4*)(src + (j * 64 + lane) * 4); ss += v[j].x * v[j].x + v[j].y * v[j].y + v[j].z * v[j].z + v[j].w * v[j].w; }
        ss = wave_sum(ss);
        const float rstd = 1.0f / sqrtf(ss * (1.0f / DM) + 1e-6f);
#pragma unroll
        for (int j = 0; j < 8; ++j) { const int i = (j * 64 + lane) * 4;
            const f32x4 w = *(const GAS f32x4*)(nw + i), sc = *(const GAS f32x4*)(mr + DM + i), sh = *(const GAS f32x4*)(mr + i);
            const f32x4 h = v[j] * rstd * w * (sc + 1.0f) + sh;
            unsigned lo = cvt_pk_bf16(h[0], h[1]), hi = cvt_pk_bf16(h[2], h[3]);
            *(GAS unsigned long long*)(H + (size_t)row * DM + i) = (unsigned long long)lo | ((unsigned long long)hi << 32); }
    }
}
__device__ __forceinline__ void ph_evenodd(Frame& F, const Args& args) {
    const int gw = F.vcu * NWAVES + F.wave, NGW = F.G * NWAVES, lane = F.lane;
    LAS bf16_t* scr = (LAS bf16_t*)(F.lds + F.wave * 16640);
    const bf16_t* UT = (const bf16_t*)(F.ws + WS_UT); bf16_t* ET = (bf16_t*)(F.ws + WS_ET); bf16_t* OT = (bf16_t*)(F.ws + WS_OT);
    float* W2 = (float*)(F.ws + WS_W2048); float* AL = (float*)(F.ws + WS_ALT);
    for (int row = gw; row < 2 * FW; row += NGW) {
        const bf16_t* src = UT + (size_t)row * SEQ; float alt = 0.f;
#pragma unroll
        for (int j = 0; j < 8; ++j) { const u32x4 w = *(const GAS u32x4*)(src + (j * 64 + lane) * 8); *(LAS u32x4*)(scr + (j * 64 + lane) * 8) = w;
            float f[8]; unpack8(w, f); alt += (f[0] - f[1]) + (f[2] - f[3]) + (f[4] - f[5]) + (f[6] - f[7]); }
        alt = wave_sum(alt);
        LDS_WAIT(); asm volatile("" ::: "memory");
        if (lane == 0) { AL[row] = alt; W2[row] = bf2f(scr[SEQ / 2]); }
#pragma unroll
        for (int j = 0; j < 4; ++j) { const int n0 = (j * 64 + lane) * 8; float e[8], o[8];
#pragma unroll
            for (int i = 0; i < 8; ++i) { const int n = n0 + i; const float a = bf2f(scr[n]), bb = bf2f(scr[(SEQ - n) & (SEQ - 1)]); e[i] = n == 0 ? a : a + bb; o[i] = n == 0 ? 0.f : a - bb; }
            u32x4 we, wo; we.x = cvt_pk_bf16(e[0], e[1]); we.y = cvt_pk_bf16(e[2], e[3]); we.z = cvt_pk_bf16(e[4], e[5]); we.w = cvt_pk_bf16(e[6], e[7]);
            wo.x = cvt_pk_bf16(o[0], o[1]); wo.y = cvt_pk_bf16(o[2], o[3]); wo.z = cvt_pk_bf16(o[4], o[5]); wo.w = cvt_pk_bf16(o[6], o[7]);
            *(GAS u32x4*)(ET + (size_t)row * 2048 + n0) = we; *(GAS u32x4*)(OT + (size_t)row * 2048 + n0) = wo; }
        LDS_WAIT(); asm volatile("" ::: "memory");
    }
}
__device__ __forceinline__ void ph_route(Frame& F, const Args& args, const float* mod) {
    const int lane = F.lane, wv = F.wave, r32 = lane & 31, hi = lane >> 5;
    LAS float* rs = (LAS float*)F.lds;
    LAS float* part = (LAS float*)(F.lds + 1024);
    LAS int* lcnt = (LAS int*)(F.lds + 1024 + 65536);
    LAS int* lbase = lcnt + 64;
    LAS int* lent = lcnt + 128;
    const float* X2 = (const float*)(F.ws + WS_X2); const float* nw = args.in[13]; const float* rb = args.in[15];
    const bf16_t* RWT = (const bf16_t*)(F.ws + WS_RWT);
    bf16_t* H2 = (bf16_t*)(F.ws + WS_H2); int* EIDX = (int*)(F.ws + WS_EIDX); float* EW = (float*)(F.ws + WS_EW); int* EPOS = (int*)(F.ws + WS_EPOS); int* CNT = (int*)(F.ws + CTL_CNT); int* TOKE = (int*)(F.ws + WS_TOKE);
    if (F.tid < NE) lcnt[F.tid] = 0;
    __syncthreads();
    int nb = 0;
    for (int blk = F.vcu; blk < NTOK / 32; blk += F.G, ++nb) {
        const int row0 = blk * 32; const float* mr = mod + (row0 / SEQ) * MODC;
#pragma unroll
        for (int i = 0; i < 4; ++i) { const float* src = X2 + (size_t)(row0 + wv * 4 + i) * DM; float ss = 0.f;
#pragma unroll
            for (int j = 0; j < 8; ++j) { const f32x4 v = *(const GAS f32x4*)(src + (j * 64 + lane) * 4); ss += v.x * v.x + v.y * v.y + v.z * v.z + v.w * v.w; }
            ss = wave_sum(ss);
            if (lane == 0) rs[wv * 4 + i] = 1.0f / sqrtf(ss * (1.0f / DM) + 1e-6f); }
        __syncthreads();
        { const float rstd = rs[r32]; const float* xr = X2 + (size_t)(row0 + r32) * DM; unsigned char* hr = (unsigned char*)H2 + (size_t)(row0 + r32) * DM;
          f32x16 acc0 = {}, acc1 = {};
#pragma unroll 4
          for (int ks = 0; ks < 16; ++ks) { const int k = wv * 256 + ks * 16 + hi * 8;
              float h[8];
#pragma unroll
              for (int q = 0; q < 2; ++q) { const f32x4 x = *(const GAS f32x4*)(xr + k + 4 * q), w = *(const GAS f32x4*)(nw + k + 4 * q), sc = *(const GAS f32x4*)(mr + 4 * DM + k + 4 * q), sh = *(const GAS f32x4*)(mr + 3 * DM + k + 4 * q);
                  const f32x4 t = x * rstd * w * (sc + 1.0f) + sh; h[4 * q] = t[0]; h[4 * q + 1] = t[1]; h[4 * q + 2] = t[2]; h[4 * q + 3] = t[3]; }
              u32x4 wh, wl; float l[8];
              wh.x = cvt_pk_bf16(h[0], h[1]); wh.y = cvt_pk_bf16(h[2], h[3]); wh.z = cvt_pk_bf16(h[4], h[5]); wh.w = cvt_pk_bf16(h[6], h[7]);
#pragma unroll
              for (int i = 0; i < 4; ++i) { l[2 * i] = h[2 * i] - __uint_as_float(wh[i] << 16); l[2 * i + 1] = h[2 * i + 1] - __uint_as_float(wh[i] & 0xffff0000u); }
              wl.x = cvt_pk_bf16(l[0], l[1]); wl.y = cvt_pk_bf16(l[2], l[3]); wl.z = cvt_pk_bf16(l[4], l[5]); wl.w = cvt_pk_bf16(l[6], l[7]);
              { float hc[8];
#pragma unroll
                for (int i = 0; i < 8; ++i) hc[i] = fminf(fmaxf(h[i], -448.f), 448.f);
                int w0 = 0, w1 = 0; w0 = __builtin_amdgcn_cvt_pk_fp8_f32(hc[0], hc[1], w0, false); w0 = __builtin_amdgcn_cvt_pk_fp8_f32(hc[2], hc[3], w0, true);
                w1 = __builtin_amdgcn_cvt_pk_fp8_f32(hc[4], hc[5], w1, false); w1 = __builtin_amdgcn_cvt_pk_fp8_f32(hc[6], hc[7], w1, true);
                *(GAS unsigned long long*)(hr + k) = (unsigned long long)(unsigned)w0 | ((unsigned long long)(unsigned)w1 << 32); }
              const bf16x8 ah = __builtin_bit_cast(bf16x8, wh), al = __builtin_bit_cast(bf16x8, wl);
              const bf16x8 bh0 = *(const GAS bf16x8*)(RWT + (size_t)r32 * DM + k), bh1 = *(const GAS bf16x8*)(RWT + (size_t)(32 + r32) * DM + k);
              const bf16x8 bl0 = *(const GAS bf16x8*)(RWT + (size_t)(NE + r32) * DM + k), bl1 = *(const GAS bf16x8*)(RWT + (size_t)(NE + 32 + r32) * DM + k);
              acc0 = __builtin_amdgcn_mfma_f32_32x32x16_bf16(ah, bh0, acc0, 0, 0, 0); acc0 = __builtin_amdgcn_mfma_f32_32x32x16_bf16(ah, bl0, acc0, 0, 0, 0); acc0 = __builtin_amdgcn_mfma_f32_32x32x16_bf16(al, bh0, acc0, 0, 0, 0);
              acc1 = __builtin_amdgcn_mfma_f32_32x32x16_bf16(ah, bh1, acc1, 0, 0, 0); acc1 = __builtin_amdgcn_mfma_f32_32x32x16_bf16(ah, bl1, acc1, 0, 0, 0); acc1 = __builtin_amdgcn_mfma_f32_32x32x16_bf16(al, bh1, acc1, 0, 0, 0); }
#pragma unroll
          for (int r = 0; r < 16; ++r) { part[(wv * 32 + crow(r, hi)) * 64 + r32] = acc0[r]; part[(wv * 32 + crow(r, hi)) * 64 + 32 + r32] = acc1[r]; } }
        __syncthreads();
        for (int i = 0; i < 4; ++i) { const int rbk = wv * 4 + i, row = row0 + rbk; float logit = 0.f;
#pragma unroll
          for (int w = 0; w < 8; ++w) logit += part[(w * 32 + rbk) * 64 + lane];
          const float score = 1.0f / (1.0f + expf(-logit)), bsd = score + rb[lane];
          const int g = lane >> 3;
          int rk = 0;
#pragma unroll
          for (int q = 0; q < 8; ++q) { const int o = (lane & ~7) + q; const float vv = __shfl(bsd, o); rk += (vv > bsd) || (vv == bsd && o < lane); }
          float gs = rk < 2 ? bsd : 0.f;
          gs += __shfl_xor(gs, 1); gs += __shfl_xor(gs, 2); gs += __shfl_xor(gs, 4);
          int grk = 0;
#pragma unroll
          for (int gg = 0; gg < 8; ++gg) { const float vv = __shfl(gs, gg * 8); grk += (vv > gs) || (vv == gs && gg < g); }
          const bool gsel = grk < 4;
          const float mb = gsel ? bsd : -INFINITY;
          int erk = 0;
          for (int o = 0; o < 64; ++o) { const float vv = __shfl(mb, o); erk += (vv > mb) || (vv == mb && o < lane); }
          const bool sel = gsel && erk < TOPK;
          const float ssum = wave_sum(sel ? score : 0.f);
          if (sel) { const int lp = __hip_atomic_fetch_add(lcnt + lane, 1, __ATOMIC_RELAXED, __HIP_MEMORY_SCOPE_WORKGROUP);
                     EIDX[row * TOPK + erk] = lane; EW[row * TOPK + erk] = score / ssum * 2.5f; lent[(nb * 32 + rbk) * TOPK + erk] = (lane << 16) | lp; } }
        __syncthreads();
    }
    if (F.tid < NE) { const int c = lcnt[F.tid]; lbase[F.tid] = c ? atomicAdd(&CNT[F.tid * 64], c) : 0; }
    __syncthreads();
    for (int i = F.tid; i < nb * 256; i += NTHREADS) { const int blk = F.vcu + (i >> 8) * F.G, row = blk * 32 + ((i >> 3) & 31), v = lent[i]; const int pos = lbase[v >> 16] + (v & 0xffff); EPOS[row * TOPK + (i & 7)] = pos; TOKE[(v >> 16) * NTOK + pos] = row; }
    __syncthreads();
}
__device__ __forceinline__ void y16(const unsigned char* p, float (&f)[16]) {
    const u32x4 w = *(const GAS u32x4*)p;
#pragma unroll
    for (int i = 0; i < 4; ++i) { const auto lo = __builtin_amdgcn_cvt_pk_f32_fp8((int)w[i], false), hi = __builtin_amdgcn_cvt_pk_f32_fp8((int)w[i], true); f[4 * i] = lo[0]; f[4 * i + 1] = lo[1]; f[4 * i + 2] = hi[0]; f[4 * i + 3] = hi[1]; }
}
__device__ __forceinline__ void ph_comb(Frame& F, const Args& args, const float* mod) {
    const int gw = F.vcu * NWAVES + F.wave, NGW = F.G * NWAVES, lane = F.lane;
    moe_tables(F, 4);
    LAS int* T = (LAS int*)(F.lds + SCHT_OFF);
    const float* EW = (const float*)(F.ws + WS_EW); const int* EIDX = (const int*)(F.ws + WS_EIDX); const int* EPOS = (const int*)(F.ws + WS_EPOS); const unsigned char* Y = (const unsigned char*)(F.ws + WS_YBIG);
    for (int t = gw; t < NTOK; t += NGW) {
        const float* g2 = mod + (t / SEQ) * MODC + 5 * DM;
        int sl[TOPK]; float wk[TOPK];
#pragma unroll
        for (int k = 0; k < TOPK; ++k) { sl[k] = T[80 + EIDX[t * TOPK + k]] + EPOS[t * TOPK + k]; wk[k] = EW[t * TOPK + k]; }
#pragma unroll
        for (int j = 0; j < 2; ++j) { const int col = j * 1024 + lane * 16;
            float a[16]; y16(Y + (size_t)(NSLOT + t) * DM + col, a);
#pragma unroll
            for (int k = 0; k < TOPK; ++k) { float y[16]; y16(Y + (size_t)sl[k] * DM + col, y);
#pragma unroll
                for (int c = 0; c < 16; ++c) a[c] += wk[k] * y[c]; }
            float* o = args.out + (size_t)t * DM + col; const float* xi = (const float*)(F.ws + WS_X2) + (size_t)t * DM + col;
#pragma unroll
            for (int n = 0; n < 4; ++n) { const f32x4 xv = *(const GAS f32x4*)(xi + 4 * n), gv = *(const GAS f32x4*)(g2 + col + 4 * n);
                *(GAS f32x4*)(o + 4 * n) = xv + gv * (f32x4){a[4 * n], a[4 * n + 1], a[4 * n + 2], a[4 * n + 3]}; } }
    }
}

enum { PH_PRO = 0, PH_NORM1, PH_INPROJ, PH_QKNORM, PH_ATTN, PH_F2, PH_MERGE, PH_OUT, PH_ROUTE, PH_EXP1, PH_EXP2, PH_COMB, PH_END };


__global__ void __launch_bounds__(NTHREADS, 2) fwd(Args args) {
    extern __shared__ __attribute__((aligned(16))) unsigned char lds_raw[];
    Frame F;
    F.lds = (LAS unsigned char*)lds_raw; F.MISC = (volatile LAS unsigned*)(F.lds + MISC_OFF); F.ws = args.ws;
    F.tid = threadIdx.x; F.lane = F.tid & 63; F.wave = __builtin_amdgcn_readfirstlane(F.tid >> 6);
    F.G = gridDim.x; { const int bx = blockIdx.x; F.vcu = (F.G % 8 == 0) ? (bx % 8) * (F.G / 8) + bx / 8 : bx; }
    for (int u = F.tid; u < (LDS_BYTES - LDSCTL_OFF) / 4; u += NTHREADS) ((LAS unsigned*)(F.lds + LDSCTL_OFF))[u] = 0u;
    __syncthreads();
    const int lo = args.ph_lo, hi = args.ph_hi;
    const bool multi = (hi - lo) > 1;
    unsigned* barw = (unsigned*)(args.ws + CTL_BAR) + args.bar_idx * XCD_BAR_WORDS;
    XcdBarrier bar; bar.bar = barw; bar.x = 0; bar.st = nullptr;
    if (multi) bar = xcd_barrier_post(barw, F.MISC + 8);
#define IN(k) (lo <= (k) && (k) < hi)
#define SEAM(k) do { if (IN((k) + 1)) xcd_barrier(bar); } while (0)

    const float* modp = (const float*)(args.ws + args.mod_off);
    if (IN(PH_PRO)) { p0_prologue(F, args); SEAM(PH_PRO); }
    if (IN(PH_NORM1)) { ph_norm1(F, args, modp); SEAM(PH_NORM1); }
    if (IN(PH_INPROJ)) {
        SchedIn S{F.G, (int)blockIdx.x, args.ws, args.use_ut};
        EpiIn E{EpiStore{(const float*)(args.ws + WS_W2048)}, (LAS float*)(F.lds + GPARK_OFF), args.in[8], args.in[9], (const float*)(args.ws + WS_ROPE)};
        gemm_phase<EpiIn, SchedIn, false>(F.lds, DM, DM, DM, S, E);
        SEAM(PH_INPROJ);
    }
    if (IN(PH_QKNORM)) { ph_evenodd(F, args); SEAM(PH_QKNORM); }
    if (IN(PH_ATTN)) {
        const int cs = F.vcu & 3;
        constexpr int NCONV = IT_EG + IT_EU + IT_ED;
        int qfirst, qcnt; { const int c = (int)blockIdx.x; if (F.G == 256) { qfirst = c < 136 ? c * 162 : 136 * 162 + (c - 136) * 226; qcnt = c < 136 ? 162 : 226; }
                             else { const int per = (NCONV + F.G - 1) / F.G; qfirst = c * per; qcnt = qfirst + per <= NCONV ? per : (NCONV - qfirst > 0 ? NCONV - qfirst : 0); } }
        const int gcnt = qfirst < IT_EG + IT_EU ? (qfirst + qcnt <= IT_EG + IT_EU ? qcnt : IT_EG + IT_EU - qfirst) : 0, gfirst = qfirst;
        const int ccnt = qcnt - gcnt, cfirst = qfirst + gcnt - (IT_EG + IT_EU);
#define CONV_ALL() do { conv_items(F, args, false, gfirst, gcnt); conv_items(F, args, true, cfirst, ccnt); } while (0)
        const bf16_t* Qp = (const bf16_t*)(args.ws + WS_Q); const bf16_t* Kp = (const bf16_t*)(args.ws + WS_KALL); const bf16_t* Vp = (const bf16_t*)(args.ws + WS_VALL); bf16_t* Op = (bf16_t*)(args.ws + WS_YA);
#define ATTN_UNIT(lin_) do { const int lin = (lin_); if (lin < 512) { const int x = (lin >> 5) & 7, j = (lin & 31) + 32 * (lin >> 8), b = x >> 2, kvh = x & 3, head = kvh * 4 + (j >> 4), qb = j & 15; \
            const size_t qo = ((size_t)(b * SEQ + qb * 256)) * DM + head * HD, ko = (size_t)b * SKV * KVW + kvh * HD; \
            attn::attn_dense_body(Qp + qo, Kp + ko, Vp + ko, Op + qo, SKV, (char*)lds_raw); __syncthreads(); } } while (0)
        if (cs == 0) { CONV_ALL(); __syncthreads(); }
        ATTN_UNIT(F.vcu);
        if (cs == 1) { CONV_ALL(); __syncthreads(); }
        ATTN_UNIT(F.vcu + F.G);
        for (int lin2 = F.vcu + 2 * F.G; lin2 < 512; lin2 += F.G) ATTN_UNIT(lin2);
        if (cs == 2) { CONV_ALL(); __syncthreads(); }
#undef ATTN_UNIT
        SchedAG S{F.G, (int)blockIdx.x, args.ws};
        gemm_phase<EpiStore, SchedAG, false>(F.lds, DM, DM, DM, S, EpiStore{(const float*)(args.ws + WS_W2048)});
        if (cs == 3) { __syncthreads(); CONV_ALL(); }
#undef CONV_ALL
        SEAM(PH_ATTN);
    }
    if (IN(PH_F2)) {
        SchedF2 S{F.G, (int)blockIdx.x, args.ws};
        gemm_phase<EpiStore, SchedF2, false>(F.lds, 512, DM, 512, S, EpiStore{(const float*)(args.ws + WS_W2048)});
        {
            const int idx = F.vcu * NTHREADS + F.tid;
            if (idx < 2 * FW) { const int b = idx >> 10, col = idx & 1023, k2 = col & 127; const float* al = (const float*)(args.ws + WS_ALT) + b * FW + (col & ~127); float s = 0.f;
                for (int c = 0; c < 128; ++c) s += al[c] * cospif((float)((c * k2) & 127) * (1.0f / 64.0f));
                ((bf16_t*)(args.ws + WS_YF))[((size_t)b * SEQ + SEQ / 2) * YFP + col] = f2bf(s * 0.0013810679320049757f); }
        }
        SEAM(PH_F2);
    }
    if (IN(PH_MERGE)) {
        unsigned char* ws = args.ws;
        SchedMerge S{F.G, (int)blockIdx.x, ws};
        gemm_phase<EpiMerge, SchedMerge, false>(F.lds, DM, DM, DM, S, EpiMerge{(const bf16_t*)(ws + WS_SGF), (const bf16_t*)(ws + WS_SGA), (bf16_t*)(ws + WS_YM)});
        SEAM(PH_MERGE);
    }
    if (IN(PH_OUT)) {
        unsigned char* ws = args.ws;
        SchedGrid S{F.G, (int)blockIdx.x, 32, 8, (const char*)(ws + WS_YM), (const char*)(ws + WS_WT_O), nullptr, (size_t)256 * DM * 2, (size_t)256 * DM * 2, DM, 4, 1, DM / BK};
        gemm_phase<EpiX2, SchedGrid, false>(F.lds, DM, DM, DM, S, EpiX2{args.in[0], modp, (float*)(ws + WS_X2)});
        SEAM(PH_OUT);
    }
    if (IN(PH_ROUTE)) { ph_route(F, args, modp); SEAM(PH_ROUTE); }
    if (IN(PH_EXP1)) {
        moe_tables(F, 4);
        SchedMoe<4, true> S{F.G, F.vcu, args.ws, (LAS int*)(F.lds + SCHT_OFF), (const int*)(args.ws + WS_TOKE)};
        gemm_phase<EpiAct, SchedMoe<4, true>, true, true>(F.lds, DM, DM / 2, DM / 2, S, EpiAct{});
        SEAM(PH_EXP1);
    }
    if (IN(PH_EXP2)) {
        moe_tables(F, 8);
        SchedMoe<8, false> S{F.G, F.vcu, args.ws, (LAS int*)(F.lds + SCHT_OFF), (const int*)(args.ws + WS_TOKE)};
        gemm_phase<EpiY8, SchedMoe<8, false>, false, true>(F.lds, EFF, EFF / 2, EFF / 2, S, EpiY8{});
        SEAM(PH_EXP2);
    }
    if (IN(PH_COMB)) { ph_comb(F, args, modp); }
#undef IN
#undef SEAM
}
}

extern "C" void kernel_launch(void* const* d_in, const int* in_sizes, int n_in, void* d_out, int out_size, void* d_ws, size_t ws_size, hipStream_t stream) {
    if (n_in != 22 || ws_size < WS_END2) return;
    float* out = (float*)d_out;
    unsigned char* ws = (unsigned char*)d_ws;
    hipMemsetAsync(ws + WS_CTL, 0, CTL_ZERO_BYTES, stream);
    static int grid = 0;
    if (!grid) {
        int dev = 0, cus = 0;
        if (hipGetDevice(&dev) != hipSuccess || hipDeviceGetAttribute(&cus, hipDeviceAttributeMultiprocessorCount, dev) != hipSuccess) { grid = -1; return; }
        if (hipFuncSetAttribute((const void*)mk::fwd, hipFuncAttributeMaxDynamicSharedMemorySize, mk::LDS_BYTES) != hipSuccess) { grid = -1; return; }
        grid = cus;
    }
    if (grid < 0) return;
    mk::Args a{}; int nlaunch = 0;
    for (int i = 0; i < 22; ++i) a.in[i] = (const float*)d_in[i];
    a.out = out; a.ws = ws; a.use_ut = 1; a.mod_off = (int)WS_MOD; a.do_attn = 1;
#define MK_LAUNCH(lo_, hi_) do { a.ph_lo = (lo_); a.ph_hi = (hi_); a.bar_idx = nlaunch++; hipLaunchKernelGGL(mk::fwd, dim3(grid), dim3(mk::NTHREADS), mk::LDS_BYTES, stream, a); } while (0)
    MK_LAUNCH(mk::PH_PRO, mk::PH_END);
}
```

```cpp
#include <hip/hip_runtime.h>
#include <stdint.h>
#include <math.h>

typedef unsigned short bf16_t;
typedef short bf16x8 __attribute__((ext_vector_type(8)));
typedef float f32x16 __attribute__((ext_vector_type(16)));
typedef float f32x4 __attribute__((ext_vector_type(4)));

constexpr int NB = 2, SEQ = 4096, DM = 2048, NTOK = NB * SEQ, CTXL = 256, NCTX = NB * CTXL, HD = 128, NH = 16, NKV = 4;
constexpr int SKV = SEQ + CTXL;
constexpr int FW = 1024, INC = 8192, Q_OFF = 1024, K_OFF = 3072, V_OFF = 3584, GF_OFF = 4096, GA_OFF = 6144;
constexpr int KVW = NKV * HD;
constexpr int NE = 64, TOPK = 8, EFF = 512, MODC = 6 * DM;
constexpr int NSLOT = NTOK * TOPK;
constexpr int NSLOT_ALL = NSLOT + NTOK;

constexpr size_t MiB = 1u << 20;
constexpr size_t WS_CTL = 0, CTL_ZERO_BYTES = 1 * MiB;
constexpr size_t CTL_CNT = 64 * 1024;
constexpr size_t WS_TW = 1 * MiB;
constexpr size_t WS_MOD = 1 * MiB + 64 * 1024;
constexpr size_t WS_OFFS = 1 * MiB + 256 * 1024;
constexpr size_t WS_EIDX = 2 * MiB;
constexpr size_t WS_EW = WS_EIDX + 256 * 1024;
constexpr size_t WS_EPOS = WS_EW + 256 * 1024;
constexpr size_t WS_SLOTOF = WS_EPOS + 256 * 1024;
constexpr size_t WS_TOKE = 300 * MiB;
constexpr size_t WS_H = 4 * MiB;
constexpr size_t WS_U = 38 * MiB;
constexpr size_t WS_Q = 54 * MiB;
constexpr size_t WS_KALL = 86 * MiB;
constexpr size_t WS_VALL = 95 * MiB;
constexpr size_t WS_SGF = 104 * MiB;
constexpr size_t WS_SGA = 136 * MiB;
constexpr size_t WS_YA = 168 * MiB;
constexpr size_t WS_YF = 38 * MiB;
constexpr int YFP = 2048;
constexpr size_t WS_PR = 216 * MiB;
constexpr size_t WS_T1 = 248 * MiB;
constexpr size_t WS_YM = 312 * MiB;
constexpr size_t WS_QKRAW = 248 * MiB;
constexpr size_t WS_KCRAW = 330 * MiB;
constexpr size_t WS_H2 = 344 * MiB;
constexpr size_t WS_ACT = 376 * MiB;
constexpr size_t WS_YBIG = 4 * MiB;
constexpr size_t WS_END = 740 * MiB;

__device__ __forceinline__ float bf2f(bf16_t h) { return __uint_as_float(((unsigned)h) << 16); }
__device__ __forceinline__ bf16_t f2bf(float f) { unsigned u = __float_as_uint(f); return (bf16_t)((u + 0x7fffu + ((u >> 16) & 1u)) >> 16); }
__device__ __forceinline__ int crow(int r, int hi) { return (r & 3) + 8 * (r >> 2) + 4 * hi; }
__device__ __forceinline__ float wave_sum(float v) {
#pragma unroll
    for (int o = 1; o < 64; o <<= 1) v += __shfl_xor(v, o);
    return v;
}
__device__ __forceinline__ float sigmoidf_(float v) { return 1.0f / (1.0f + expf(-v)); }
__device__ __forceinline__ bf16x8 pack8(const float* f) {
    bf16x8 r;
#pragma unroll
    for (int i = 0; i < 8; ++i) r[i] = (short)f2bf(f[i]);
    return r;
}

#define LAS __attribute__((address_space(3)))
#define GAS __attribute__((address_space(1)))
typedef unsigned u32x4 __attribute__((ext_vector_type(4)));
typedef GAS unsigned gu32;
#define RLX_AGENT __ATOMIC_RELAXED, __HIP_MEMORY_SCOPE_AGENT
#define LDS_WAIT() asm volatile("s_waitcnt lgkmcnt(0)" ::: "memory")
#define VM_WAIT() asm volatile("s_waitcnt vmcnt(0)" ::: "memory")

constexpr size_t CTL_BAR = 16384;
constexpr size_t CTL_MODZ = 512 * 1024;
constexpr size_t WS_UT = 38 * MiB;
constexpr size_t WS_TT = 216 * MiB;
constexpr size_t WS_WT_GU = 450 * MiB;
constexpr size_t WS_WT_D = 710 * MiB;
constexpr size_t WS_WT_IN = 840 * MiB;
constexpr size_t WS_WT_FO = 924 * MiB;
constexpr size_t WS_WT_AO = 876 * MiB;
constexpr size_t WS_WT_O = 884 * MiB;
constexpr size_t WS_CST = 892 * MiB;
constexpr size_t WS_ET = 908 * MiB;
constexpr size_t WS_OT = 916 * MiB;
constexpr size_t WS_W2048 = 1 * MiB + 512 * 1024;
constexpr size_t WS_ALT = 1 * MiB + 520 * 1024;
constexpr size_t WS_ROPE = 1 * MiB + 528 * 1024;
constexpr size_t WS_RWT = 3 * MiB + 512 * 1024;
constexpr size_t WS_BD2 = 956 * MiB;
constexpr size_t WS_X2 = 960 * MiB;
constexpr size_t WS_END2 = 1024 * MiB;

namespace mk {
constexpr int NWAVES = 8, NTHREADS = 512;
constexpr int RING_BYTES = 131072, SCR_BYTES = 8 * 16640, LDSCTL_OFF = 135168, MISC_OFF = LDSCTL_OFF + 320, GPARK_OFF = LDSCTL_OFF + 2048  , LDS_BYTES = 147456;
static_assert(GPARK_OFF + 8192 <= LDS_BYTES, "LDS map");
static_assert(SCR_BYTES <= LDSCTL_OFF && MISC_OFF + 128 <= LDS_BYTES, "LDS map");

#define XB_TMO      128
#define XB_XCNT(j)  (256  + 64 * (j))
#define XB_XSUB(j)  (1280 + 64 * (j))
#define XB_XGEN(j)  (2304 + 64 * (j))
#define XB_TOP      3328
#define XB_TOPGEN   3392
#define XCD_BAR_WORDS 3456
#define XB_SPIN_CAP (1u << 18)
__device__ __forceinline__ unsigned xb_ld(unsigned* p)              { return __hip_atomic_load(p, __ATOMIC_RELAXED, __HIP_MEMORY_SCOPE_AGENT); }
__device__ __forceinline__ unsigned xb_add(unsigned* p, unsigned v) { return __hip_atomic_fetch_add(p, v, __ATOMIC_RELAXED, __HIP_MEMORY_SCOPE_AGENT); }
__device__ __forceinline__ unsigned xb_xcc_id() { return (unsigned)__builtin_amdgcn_s_getreg((3 << 11) | 20) & 0xFu; }
#define XB_SPIN(cond, bar) do { unsigned _sp = 0; while (cond) { __builtin_amdgcn_s_sleep(1); \
    if ((++_sp & 255u) == 0u) { if (xb_ld(&(bar)[XB_TMO])) break; if (_sp > XB_SPIN_CAP) { atomicAdd(&(bar)[XB_TMO], 1u); break; } } } } while (0)
struct XcdBarrier { unsigned* bar; unsigned x; volatile LAS unsigned* st; };
__device__ __forceinline__ XcdBarrier xcd_barrier_post(unsigned* bar, volatile LAS unsigned* st) {
    XcdBarrier b; b.bar = bar; b.x = xb_xcc_id(); b.st = st;
    if (threadIdx.x == 0) (void)xb_add(&bar[XB_XCNT(b.x)], 1u);
    return b;
}
__device__ __forceinline__ void xcd_barrier_complete(unsigned* bar, unsigned x, unsigned& nloc, unsigned& nx) {
    const unsigned G = gridDim.x * gridDim.y * gridDim.z;
    unsigned sum, cnt, mine, sp = 0u;
    for (;;) {
        sum = 0u; cnt = 0u; mine = 0u;
#pragma unroll
        for (unsigned j = 0; j < 16; ++j) { const unsigned c = xb_ld(&bar[XB_XCNT(j)]); sum += c; cnt += (c > 0u) ? 1u : 0u; mine = (j == x) ? c : mine; }
        if (sum == G) break;
        __builtin_amdgcn_s_sleep(1);
        if ((++sp & 255u) == 0u) { if (xb_ld(&bar[XB_TMO])) break; if (sp > XB_SPIN_CAP) { atomicAdd(&bar[XB_TMO], 1u); break; } }
    }
    nloc = mine > 0u ? mine : 1u; nx = cnt > 0u ? cnt : 1u;
}
__device__ __forceinline__ void xcd_barrier(const XcdBarrier& b) {
    asm volatile("s_waitcnt vmcnt(0)" ::: "memory");
    __syncthreads();
    if (threadIdx.x == 0) {
        unsigned* bar = b.bar;
        __builtin_amdgcn_s_waitcnt(0);
        unsigned nloc = b.st[0], nx = b.st[1];
        if (nloc == 0u) { xcd_barrier_complete(bar, b.x, nloc, nx); b.st[0] = nloc; b.st[1] = nx; }
        const unsigned old = xb_add(&bar[XB_XSUB(b.x)], 1u);
        const unsigned gen = old / nloc;
        if (old + 1u == (gen + 1u) * nloc) {
            __builtin_amdgcn_fence(__ATOMIC_RELEASE, "agent");
            asm volatile("s_waitcnt vmcnt(0)" ::: "memory");
            const unsigned og = xb_add(&bar[XB_TOP], 1u);
            const unsigned tg = og / nx;
            if (og + 1u == (tg + 1u) * nx) xb_add(&bar[XB_TOPGEN], 1u);
            else XB_SPIN(xb_ld(&bar[XB_TOPGEN]) == tg, bar);
            __builtin_amdgcn_fence(__ATOMIC_ACQUIRE, "agent");
            xb_add(&bar[XB_XGEN(b.x)], 1u);
            asm volatile("s_waitcnt vmcnt(0)" ::: "memory");
        } else {
            XB_SPIN(xb_ld(&bar[XB_XGEN(b.x)]) == gen, bar);
            __builtin_amdgcn_fence(__ATOMIC_ACQUIRE, "agent");
            asm volatile("s_waitcnt vmcnt(0)" ::: "memory");
        }
    }
    __syncthreads();
}

constexpr int BM = 256, BK = 64, HALF = 128, HTB = HALF * BK * 2, STAGE_BYTES = 8 * HTB;
__device__ __forceinline__ int lds_byte(int r, int c) { const int st = (r >> 4) * 2 + (c >> 5), rr = r & 15, cc = c & 31, ob = rr * 64 + cc * 2; return st * 1024 + (ob ^ (((ob >> 9) & 1) << 5)); }
__device__ __forceinline__ void stage_rc(int b, int& R, int& C) { const int st = b / 1024, sb = b % 1024, swz = sb ^ (((sb >> 9) & 1) << 5); R = (st >> 1) * 16 + swz / 64; C = (st & 1) * 32 + (swz % 64) / 2; }
__device__ __forceinline__ int perm32(int rho) { const int n = rho >> 4, i = rho & 15; return 8 * (i >> 2) + 4 * n + (i & 3); }
__device__ __forceinline__ unsigned cvt_pk_bf16(float lo, float hi) { unsigned r; asm("v_cvt_pk_bf16_f32 %0, %1, %2" : "=v"(r) : "v"(lo), "v"(hi)); return r; }

__device__ __forceinline__ void glds16_s(const void* sbase, unsigned voff, unsigned lds_dst) { unsigned keep;
    asm volatile("s_mov_b32 %0, m0\n\ts_mov_b32 m0, %3\n\ts_nop 0\n\tglobal_load_lds_dwordx4 %1, %2\n\ts_mov_b32 m0, %0" : "=&s"(keep) : "v"(voff), "s"(sbase), "s"(lds_dst) : "memory"); }

struct Unit { const char* A; const char* B; char* C; int ldc; int mode; int rows; int aux; int pm, pn, bjs, rmin, e, nt, keep; };

typedef int i32x8 __attribute__((ext_vector_type(8)));
typedef int i32x4 __attribute__((ext_vector_type(4)));
template <class Epi, class Sched, bool GATHER, bool F8 = false>
__device__ __forceinline__ void gemm_phase(LAS unsigned char* lds, const int K, const int lda, const int ldb, const Sched& S, const Epi& E, const int i0 = 0, const int i1 = 0x7fffffff) {
    const int tid = threadIdx.x, wid = __builtin_amdgcn_readfirstlane(tid >> 6), lane = tid & 63, wr = wid >> 2, wc = wid & 3, fr = lane & 15, fq = lane >> 4;
    unsigned voffA[2], voffB[2];
#pragma unroll
    for (int i = 0; i < 2; ++i) { int R, C; stage_rc(tid * 16 + i * 8192, R, C); const int Rb = (R & ~31) + perm32(R & 31);
        voffA[i] = (unsigned)(R * lda + C) * 2u; voffB[i] = (unsigned)(Rb * ldb + C) * 2u; }
    const size_t kstep = (size_t)(BK * 2);
    const size_t hstepA = (size_t)HALF * lda * 2, hstepB = (size_t)HALF * ldb * 2;
    const unsigned ldsw = (unsigned)wid * 1024u;
    const unsigned ldsbase = (unsigned)__builtin_amdgcn_readfirstlane((int)(unsigned)(uintptr_t)lds);
    const int aoff = F8 ? lds_byte(wr * 64 + fr, (fq >> 1) * 32 + (fq & 1) * 16) : lds_byte(wr * 64 + fr, fq * 8), boff = F8 ? lds_byte(wc * 32 + fr, (fq >> 1) * 32 + (fq & 1) * 16) : lds_byte(wc * 32 + fr, fq * 8);

#define MK_SA(b, h) (((b) * 2 + (h)) * HTB)
#define MK_SB(b, h) ((4 + (b) * 2 + (h)) * HTB)
#define MK_STAGE2(bufoff, gbase, v0, v1) do { \
        __builtin_amdgcn_global_load_lds((const unsigned*)((const char*)(gbase) + (v0)), (LAS unsigned*)(lds + (bufoff) + ldsw), 16, 0, 0); \
        __builtin_amdgcn_global_load_lds((const unsigned*)((const char*)(gbase) + (v1)), (LAS unsigned*)(lds + (bufoff) + ldsw + 8192), 16, 0, 0); } while (0)
#define MK_STAGE_B(bufoff, gbase) do { glds16_s((gbase), voffB[0], ldsbase + (bufoff) + ldsw); glds16_s((gbase), voffB[1], ldsbase + (bufoff) + ldsw + 8192u); } while (0)
#define MK_STAGE_A(bufoff, gbase, h, VA) do { if constexpr (GATHER) { glds16_s((gbase), (VA)[h][0], ldsbase + (bufoff) + ldsw); glds16_s((gbase), (VA)[h][1], ldsbase + (bufoff) + ldsw + 8192u); } \
        else { glds16_s((gbase) + (h) * hstepA, voffA[0], ldsbase + (bufoff) + ldsw); glds16_s((gbase) + (h) * hstepA, voffA[1], ldsbase + (bufoff) + ldsw + 8192u); } } while (0)
#define MK_LDA(dst, b, h) do { if constexpr (F8) { _Pragma("unroll") for (int m = 0; m < 4; ++m) dst##8[m] = *(const LAS i32x8*)(lds + MK_SA(b, h) + aoff + m * 2048); } \
        else { _Pragma("unroll") for (int m = 0; m < 4; ++m) _Pragma("unroll") for (int k = 0; k < 2; ++k) dst[m][k] = *(const LAS bf16x8*)(lds + MK_SA(b, h) + aoff + m * 2048 + k * 1024); } } while (0)
#define MK_LDB(dst, b, h) do { if constexpr (F8) { _Pragma("unroll") for (int n = 0; n < 2; ++n) dst##8[n] = *(const LAS i32x8*)(lds + MK_SB(b, h) + boff + n * 2048); } \
        else { _Pragma("unroll") for (int n = 0; n < 2; ++n) _Pragma("unroll") for (int k = 0; k < 2; ++k) dst[n][k] = *(const LAS bf16x8*)(lds + MK_SB(b, h) + boff + n * 2048 + k * 1024); } } while (0)
#define MK_MMA(ai, bj, At, Bt) do { __builtin_amdgcn_s_setprio(1); \
        if constexpr (F8) { _Pragma("unroll") for (int m = 0; m < 4; ++m) _Pragma("unroll") for (int n = 0; n < 2; ++n) \
            acc[ai][bj][m][n] = __builtin_amdgcn_mfma_scale_f32_16x16x128_f8f6f4(Bt##8[n], At##8[m], acc[ai][bj][m][n], 0, 0, 0, 0x7d, 0, 0x7d  ); } \
        else { _Pragma("unroll") for (int m = 0; m < 4; ++m) _Pragma("unroll") for (int n = 0; n < 2; ++n) _Pragma("unroll") for (int k = 0; k < 2; ++k) \
            acc[ai][bj][m][n] = __builtin_amdgcn_mfma_f32_16x16x32_bf16(Bt[n][k], At[m][k], acc[ai][bj][m][n], 0, 0, 0); } \
        __builtin_amdgcn_s_setprio(0); } while (0)
#define MK_WAIT_V(n) asm volatile("s_waitcnt vmcnt(" #n ")" ::: "memory")
#define MK_WAIT_L(n) asm volatile("s_waitcnt lgkmcnt(" #n ")" ::: "memory")
#define MK_BAR __builtin_amdgcn_s_barrier()
#define MK_SCHED __builtin_amdgcn_sched_barrier(0)
    Unit cur, nxt; int ui = i0;
    if (i0 >= i1 || !S.next(i0, cur)) return;
    f32x4 acc[2][2][4][2];
#pragma unroll
    for (int a = 0; a < 2; ++a)
#pragma unroll
        for (int b = 0; b < 2; ++b)
#pragma unroll
            for (int m = 0; m < 4; ++m)
#pragma unroll
                for (int n = 0; n < 2; ++n) acc[a][b][m][n] = (f32x4){0.f, 0.f, 0.f, 0.f};
    bf16x8 At[4][2], B0[2][2], B1[2][2]; i32x8 At8[4], B08[2], B18[2];
    unsigned vC[2][2];
    LAS u32x4* vpark = (LAS u32x4*)(lds + GPARK_OFF) + tid;
    if constexpr (GATHER) {
#pragma unroll
        for (int h = 0; h < 2; ++h)
#pragma unroll
            for (int i = 0; i < 2; ++i) { int R, C; stage_rc(tid * 16 + i * 8192, R, C); vC[h][i] = S.arow(cur, h * HALF + R) + (unsigned)(C * 2); }
    }
    const char* cA = cur.A; const char* cB = cur.B;
    MK_STAGE_B(MK_SB(0, 0), cB); MK_STAGE_B(MK_SB(0, 1), cB + hstepB); MK_STAGE_A(MK_SA(0, 0), cA, 0, vC); MK_STAGE_A(MK_SA(0, 1), cA, 1, vC);
    if (wr == 1) MK_BAR;
    MK_WAIT_V(2); MK_BAR;
    MK_STAGE_B(MK_SB(1, 0), cB + kstep); MK_STAGE_A(MK_SA(1, 0), cA + kstep, 0, vC); MK_STAGE_B(MK_SB(1, 1), cB + hstepB + kstep);
    MK_WAIT_V(6); MK_BAR;
    for (;;) {
        const bool has_next = (ui + 1 < i1) && S.next(ui + 1, nxt);
        const char* nA = has_next ? nxt.A : cA; const char* nB = has_next ? nxt.B : cB;
        if constexpr (GATHER) {
            u32x4 pv;
#pragma unroll
            for (int h = 0; h < 2; ++h)
#pragma unroll
                for (int i = 0; i < 2; ++i) { int R, C; stage_rc(tid * 16 + i * 8192, R, C); pv[h * 2 + i] = has_next ? (S.arow(nxt, h * HALF + R) + (unsigned)(C * 2)) : vC[h][i]; }
            *vpark = pv;
        }
        int nt = cur.nt; asm volatile("" : "+s"(nt));
#pragma nounroll
        for (int t = 0; t < nt; t += 2) {
            const bool last = (t == nt - 2);
            const char* a1 = cA + (size_t)(t + 1) * kstep;
            const char* a2 = last ? nA : cA + (size_t)(t + 2) * kstep; const char* b2 = last ? nB : cB + (size_t)(t + 2) * kstep;
            const char* a3 = a2 + kstep; const char* b3 = b2 + kstep;
            MK_LDB(B0, 0, 0); MK_LDB(B1, 0, 1); MK_SCHED; MK_LDA(At, 0, 0); MK_STAGE_A(MK_SA(1, 1), a1, 1, vC);
            if constexpr (GATHER) { if (last) { const u32x4 pv = *vpark; vC[0][0] = pv[0]; vC[0][1] = pv[1]; vC[1][0] = pv[2]; vC[1][1] = pv[3]; } }
            MK_WAIT_V(8); MK_WAIT_L(0); MK_BAR; MK_MMA(0, 0, At, B0); MK_MMA(0, 1, At, B1); MK_BAR; MK_SCHED;
            MK_LDA(At, 0, 1); MK_STAGE_B(MK_SB(0, 0), b2); MK_STAGE_B(MK_SB(0, 1), b2 + hstepB); MK_STAGE_A(MK_SA(0, 0), a2, 0, vC);
            MK_WAIT_V(8); MK_WAIT_L(0); MK_BAR; MK_MMA(1, 0, At, B0); MK_MMA(1, 1, At, B1); MK_BAR; MK_SCHED;
            MK_LDB(B0, 1, 0); MK_LDB(B1, 1, 1); MK_SCHED; MK_LDA(At, 1, 0); MK_STAGE_A(MK_SA(0, 1), a2, 1, vC);
            MK_WAIT_V(8); MK_WAIT_L(0); MK_BAR; MK_MMA(0, 0, At, B0); MK_MMA(0, 1, At, B1); MK_BAR; MK_SCHED;
            MK_LDA(At, 1, 1); MK_STAGE_B(MK_SB(1, 0), b3); MK_STAGE_B(MK_SB(1, 1), b3 + hstepB); MK_STAGE_A(MK_SA(1, 0), a3, 0, vC);
            MK_WAIT_V(8); MK_WAIT_L(0); MK_BAR; MK_MMA(1, 0, At, B0); MK_MMA(1, 1, At, B1); MK_BAR; MK_SCHED;
        }
        if (wr == 0) MK_BAR;
        { int l2; asm volatile("v_mbcnt_lo_u32_b32 %0, -1, 0\n\tv_mbcnt_hi_u32_b32 %0, -1, %0" : "=v"(l2));
          E(acc, cur, wr, wc, l2 & 15, l2 >> 4); }
        if (!has_next) break;
        if (!cur.keep)
#pragma unroll
        for (int a = 0; a < 2; ++a)
#pragma unroll
            for (int b = 0; b < 2; ++b)
#pragma unroll
                for (int m = 0; m < 4; ++m)
#pragma unroll
                    for (int n = 0; n < 2; ++n) acc[a][b][m][n] = (f32x4){0.f, 0.f, 0.f, 0.f};
        cur = nxt; cA = nA; cB = nB; ++ui;
        if (wr == 1) MK_BAR;
    }
    MK_WAIT_V(0);
    MK_BAR;
#undef MK_SA
#undef MK_SB
#undef MK_STAGE2
#undef MK_STAGE_B
#undef MK_STAGE_A
#undef MK_LDA
#undef MK_LDB
#undef MK_MMA
#undef MK_WAIT_V
#undef MK_WAIT_L
#undef MK_BAR
#undef MK_SCHED
}

__device__ __forceinline__ void grid_map(int L, int nM, int nN, int& pm, int& pn) {
    const int nwg = nM * nN, q = nwg / 8, xcd = L % 8, off = L / 8; const int wgid = xcd * q + off;
    const int nig = 8 * nN, gid = wgid / nig, fm = gid * 8, gsz = (nM - fm) < 8 ? (nM - fm) : 8;
    pm = fm + ((wgid % nig) % gsz); pn = (wgid % nig) / gsz;
}

struct EpiStore {
    const float* w2048;
    __device__ __forceinline__ void operator()(f32x4 (&acc)[2][2][4][2], const Unit& u, int wr, int wc, int fr, int fq) const {
        const int col0 = wc * 32 + 8 * fq;
#pragma unroll
        for (int ai = 0; ai < 2; ++ai)
#pragma unroll
            for (int m = 0; m < 4; ++m) {
                const int r = ai * HALF + wr * 64 + m * 16 + fr;
                if (r < u.rows && r >= u.rmin) {
#pragma unroll
                    for (int bj = 0; bj < 2; ++bj) {
                        f32x4 v0 = acc[ai][bj][m][0], v1 = acc[ai][bj][m][1];
                        if (u.mode == 1) { float* p = (float*)u.C + (long)r * u.ldc + col0 + bj * u.bjs; *(f32x4*)p = v0; *(f32x4*)(p + 4) = v1; }
                        else {
                            if (u.mode == 2) {
#pragma unroll
                                for (int c = 0; c < 4; ++c) { v0[c] = __builtin_amdgcn_rcpf(1.0f + __expf(-v0[c])); v1[c] = __builtin_amdgcn_rcpf(1.0f + __expf(-v1[c])); }
                            } else if (u.mode == 3) {
                                const float* wp = w2048 + u.pn + bj * HALF + col0; const float sg = (r & 1) ? -1.0f : 1.0f;
                                v0 += *(const f32x4*)wp * sg; v1 += *(const f32x4*)(wp + 4) * sg;
                            }
                            u32x4 w; w.x = cvt_pk_bf16(v0[0], v0[1]); w.y = cvt_pk_bf16(v0[2], v0[3]); w.z = cvt_pk_bf16(v1[0], v1[1]); w.w = cvt_pk_bf16(v1[2], v1[3]);
                            *(u32x4*)((bf16_t*)u.C + (long)r * u.ldc + col0 + bj * u.bjs) = w;
                        }
                    }
                }
            }
    }
};


struct EpiIn { EpiStore base; LAS float* red; const float* qnw; const float* knw; const float* rope;
    __device__ __forceinline__ void operator()(f32x4 (&acc)[2][2][4][2], const Unit& u, int wr, int wc, int fr, int fq) const {
        if (u.mode < 5) { base(acc, u, wr, wc, fr, fq); return; }
#pragma unroll
        for (int ai = 0; ai < 2; ++ai)
#pragma unroll
            for (int m = 0; m < 4; ++m)
#pragma unroll
                for (int bj = 0; bj < 2; ++bj) { const f32x4 a = acc[ai][bj][m][0], b = acc[ai][bj][m][1];
                    float s = (a[0] * a[0] + a[1] * a[1]) + (a[2] * a[2] + a[3] * a[3]) + (b[0] * b[0] + b[1] * b[1]) + (b[2] * b[2] + b[3] * b[3]);
                    s += __shfl_xor(s, 16); s += __shfl_xor(s, 32);
                    if (fq == 0) red[((ai * HALF + wr * 64 + m * 16 + fr) * 2 + bj) * 4 + wc] = s; }
        asm volatile("s_waitcnt lgkmcnt(0)" ::: "memory"); __builtin_amdgcn_s_barrier(); asm volatile("" ::: "memory");
        const float* nw = u.mode == 5 ? qnw : knw;
        const int axis = wc >> 1, f0 = (wc & 1) * 16 + fq * 4, da = axis * 64 + f0;
        const f32x4 wa = *(const f32x4*)(nw + da), wb = *(const f32x4*)(nw + da + 32);
#pragma unroll
        for (int ai = 0; ai < 2; ++ai)
#pragma unroll
            for (int m = 0; m < 4; ++m) { const int r = ai * HALF + wr * 64 + m * 16 + fr;
                f32x4 cs = {1.f, 1.f, 1.f, 1.f}, sn = {0.f, 0.f, 0.f, 0.f};
                if (u.mode != 7) { const int t = u.pm + r, pos = axis ? (t & 63) : (t >> 6); const float* rp = rope + (pos * 32 + f0) * 2;
                    const f32x4 p0 = *(const f32x4*)rp, p1 = *(const f32x4*)(rp + 4); cs = (f32x4){p0[0], p0[2], p1[0], p1[2]}; sn = (f32x4){p0[1], p0[3], p1[1], p1[3]}; }
#pragma unroll
                for (int bj = 0; bj < 2; ++bj) { const LAS f32x4* pp = (const LAS f32x4*)(red + (r * 2 + bj) * 4); const f32x4 ps = *pp;
                    const float rstd = 1.0f / sqrtf(((ps[0] + ps[1]) + (ps[2] + ps[3])) * (1.0f / HD) + 1e-6f);
                    const f32x4 xa = acc[ai][bj][m][0] * rstd * wa, xb = acc[ai][bj][m][1] * rstd * wb;
                    const f32x4 oa = xa * cs - xb * sn, ob = xb * cs + xa * sn;
                    u32x4 w; w.x = cvt_pk_bf16(oa[0], oa[1]); w.y = cvt_pk_bf16(oa[2], oa[3]); w.z = cvt_pk_bf16(ob[0], ob[1]); w.w = cvt_pk_bf16(ob[2], ob[3]);
                    *(u32x4*)((bf16_t*)u.C + (long)r * u.ldc + bj * HALF + wc * 32 + 8 * fq) = w; } }
    } };


__device__ __forceinline__ void pack8_fp8(const f32x4& a, const f32x4& b, unsigned& w0, unsigned& w1) {
    f32x4 v0 = a, v1 = b;
#pragma unroll
    for (int c = 0; c < 4; ++c) { v0[c] = fminf(fmaxf(v0[c], -448.f), 448.f); v1[c] = fminf(fmaxf(v1[c], -448.f), 448.f); }
    int x0 = 0, x1 = 0;
    x0 = __builtin_amdgcn_cvt_pk_fp8_f32(v0[0], v0[1], x0, false); x0 = __builtin_amdgcn_cvt_pk_fp8_f32(v0[2], v0[3], x0, true);
    x1 = __builtin_amdgcn_cvt_pk_fp8_f32(v1[0], v1[1], x1, false); x1 = __builtin_amdgcn_cvt_pk_fp8_f32(v1[2], v1[3], x1, true);
    w0 = (unsigned)x0; w1 = (unsigned)x1;
}
struct EpiY8 {
    __device__ __forceinline__ void operator()(f32x4 (&acc)[2][2][4][2], const Unit& u, int wr, int wc, int fr, int fq) const {
        const int odd = fq & 1;
        unsigned char* base = (unsigned char*)u.C + (size_t)(wr * 64 + fr) * u.ldc + odd * HALF + wc * 32 + 8 * (fq - odd);
        const int r0 = wr * 64 + fr;
#pragma unroll
        for (int ai = 0; ai < 2; ++ai)
#pragma unroll
            for (int m = 0; m < 4; ++m) {
                unsigned a0, a1, b0, b1; pack8_fp8(acc[ai][0][m][0], acc[ai][0][m][1], a0, a1); pack8_fp8(acc[ai][1][m][0], acc[ai][1][m][1], b0, b1);
                const auto s0 = __builtin_amdgcn_permlane16_swap(a0, b0, false, false), s1 = __builtin_amdgcn_permlane16_swap(a1, b1, false, false);
                if (r0 + ai * HALF + m * 16 < u.rows) { const u32x4 w = {s0[0], s1[0], s0[1], s1[1]}; *(u32x4*)(base + (size_t)(ai * HALF + m * 16) * u.ldc) = w; } }
    } };

struct Args { const float* in[22]; float* out; unsigned char* ws; int ph_lo, ph_hi, use_ut, mod_off, do_attn, bar_idx; };
struct Frame {
    LAS unsigned char* lds; volatile LAS unsigned* MISC; unsigned char* ws;
    int tid, lane, wave, vcu, G;
};

__device__ __forceinline__ int qk_col_of_dim(int d) { const int a = d >> 6, half = (d >> 5) & 1, f = d & 31; return 32 * (2 * a + (f >> 4)) + 8 * ((f >> 2) & 3) + 4 * half + (f & 3); }
__device__ __forceinline__ void t64_load(f32x4 (&v)[16], const float* W, int ldw, int lane) {
    const unsigned off = (unsigned)(((lane >> 4) * ldw + (lane & 15) * 4) * 4);
#pragma unroll
    for (int j = 0; j < 16; ++j) { const char* bj = (const char*)W + (size_t)(j * 4) * ldw * 4; v[j] = __builtin_nontemporal_load((const GAS f32x4*)(bj + off)); }
}
template <bool QKPERM = false, bool F8OUT = false>
__device__ __forceinline__ void t64_store(const f32x4 (&v)[16], bf16_t* dst, int ldd, LAS float* scr, int lane, int d0 = 0) {
    const int kk = lane >> 4, nc = (lane & 15) * 4;
#pragma unroll
    for (int j = 0; j < 16; ++j) {
#pragma unroll
        for (int c = 0; c < 4; ++c) scr[(j * 4 + kk) * 65 + nc + c] = v[j][c]; }
    LDS_WAIT(); asm volatile("" ::: "memory");
    const int kc = lane & 7; const unsigned soff = F8OUT ? (unsigned)((lane >> 3) * ldd + 8 * kc) : (unsigned)(((lane >> 3) * ldd + 8 * kc) * 2);
#pragma unroll
    for (int jj = 0; jj < 8; jj += 2) {
        float t[2][8];
#pragma unroll
        for (int q = 0; q < 2; ++q) { const int n = (lane >> 3) + 8 * (jj + q); const LAS float* s = scr + (8 * kc) * 65 + n;
#pragma unroll
            for (int i = 0; i < 8; ++i) t[q][i] = s[i * 65]; }
#pragma unroll
        for (int q = 0; q < 2; ++q) { char* bq = (char*)dst + (size_t)(8 * (jj + q)) * ldd * (F8OUT ? 1 : 2);
            if constexpr (QKPERM) bq = (char*)dst + (size_t)(qk_col_of_dim(d0 + (lane >> 3) + 8 * (jj + q)) - (lane >> 3)) * ldd * 2;
            if constexpr (F8OUT) { float s[8];
#pragma unroll
                for (int i = 0; i < 8; ++i) s[i] = fminf(fmaxf(t[q][i] * 16.0f, -448.f), 448.f);
                int w0 = 0, w1 = 0; w0 = __builtin_amdgcn_cvt_pk_fp8_f32(s[0], s[1], w0, false); w0 = __builtin_amdgcn_cvt_pk_fp8_f32(s[2], s[3], w0, true);
                w1 = __builtin_amdgcn_cvt_pk_fp8_f32(s[4], s[5], w1, false); w1 = __builtin_amdgcn_cvt_pk_fp8_f32(s[6], s[7], w1, true);
                __builtin_nontemporal_store((unsigned long long)(unsigned)w0 | ((unsigned long long)(unsigned)w1 << 32), (GAS unsigned long long*)(bq + soff)); }
            else { u32x4 o; o.x = cvt_pk_bf16(t[q][0], t[q][1]); o.y = cvt_pk_bf16(t[q][2], t[q][3]); o.z = cvt_pk_bf16(t[q][4], t[q][5]); o.w = cvt_pk_bf16(t[q][6], t[q][7]);
                __builtin_nontemporal_store(o, (GAS u32x4*)(bq + soff)); } } }
    LDS_WAIT(); asm volatile("" ::: "memory");
}
__device__ __forceinline__ void transpose64(const float* W, int ldw, bf16_t* dst, int ldd, LAS float* scr, int lane) {
    f32x4 v[16]; t64_load(v, W, ldw, lane); t64_store(v, dst, ldd, scr, lane);
}

constexpr int IT_IN = 32 * 128, IT_FO = 16 * 32, IT_AO = 32 * 32, IT_O = 32 * 32, IT_EG = 64 * 256, IT_EU = 64 * 256, IT_ED = 64 * 256, IT_SH = 256;
constexpr int IT_T_END = IT_IN + IT_FO + IT_AO + IT_O + 3 * IT_SH;
constexpr int IT_MOD = MODC / 32, IT_CST = 4096, IT_BD2 = 512, IT_RWT = 32, IT_ROPE = 1;
constexpr int IT_ALL = IT_T_END + IT_MOD + IT_CST + IT_BD2 + IT_RWT + IT_ROPE;

__device__ __forceinline__ void mod_item(const Args& args, unsigned char* ws, int r, int lane) {
            const int kq = lane >> 3, col = r * 32 + (lane & 7) * 4;
            f32x4 a0 = {0.f, 0.f, 0.f, 0.f}, a1 = a0, a2 = a0;
            for (int jb = 0; jb < 256; jb += 8) {
                f32x4 w[8]; float c0[8], c1[8], c2[8];
#pragma unroll
                for (int j = 0; j < 8; ++j) { const int k = kq + 8 * (jb + j); w[j] = *(const GAS f32x4*)(args.in[4] + (size_t)k * MODC + col); c0[j] = args.in[1][k]; c1[j] = args.in[1][DM + k]; c2[j] = args.in[3][k]; }
#pragma unroll
                for (int j = 0; j < 8; ++j) { a0 += w[j] * (c0[j] * __builtin_amdgcn_rcpf(1.0f + __expf(-c0[j]))); a1 += w[j] * (c1[j] * __builtin_amdgcn_rcpf(1.0f + __expf(-c1[j]))); a2 += w[j] * (c2[j] * __builtin_amdgcn_rcpf(1.0f + __expf(-c2[j]))); }
            }
#pragma unroll
            for (int c = 0; c < 4; ++c) {
#pragma unroll
                for (int o = 8; o < 64; o <<= 1) { a0[c] += __shfl_xor(a0[c], o); a1[c] += __shfl_xor(a1[c], o); a2[c] += __shfl_xor(a2[c], o); } }
            if (kq == 0) { const f32x4 bb = *(const GAS f32x4*)(args.in[5] + col); float* MODP = (float*)(ws + WS_MOD);
                *(GAS f32x4*)(MODP + col) = a0 + bb; *(GAS f32x4*)(MODP + MODC + col) = a1 + bb; *(GAS f32x4*)(MODP + 2 * MODC + col) = a2 + bb; }
}
__device__ __forceinline__ void p0_prologue(Frame& F, const Args& args) {
    LAS float* scr = (LAS float*)(F.lds + F.wave * 16640);
    const int gw = F.vcu * NWAVES + F.wave, NGW = F.G * NWAVES, lane = F.lane;
    unsigned char* ws = F.ws;
    bf16_t* WT_IN = (bf16_t*)(ws + WS_WT_IN); bf16_t* WT_FO = (bf16_t*)(ws + WS_WT_FO); bf16_t* WT_AO = (bf16_t*)(ws + WS_WT_AO); bf16_t* WT_O = (bf16_t*)(ws + WS_WT_O);
    bf16_t* WT_GU = (bf16_t*)(ws + WS_WT_GU); bf16_t* WT_D = (bf16_t*)(ws + WS_WT_D);
    if (NGW >= 5 * IT_MOD) { if (gw % 5 == 0 && gw / 5 < IT_MOD) mod_item(args, ws, gw / 5, lane); }
    else for (int m = gw; m < IT_MOD; m += NGW) mod_item(args, ws, m, lane);
    for (int it = gw; it < IT_ALL - IT_MOD; it += NGW) {
        int r = it;
        if (r < IT_IN) { const int kb = r / 128, nb = r % 128, n0 = nb * 64;
            if (n0 >= Q_OFF && n0 < V_OFF) { f32x4 v[16]; t64_load(v, args.in[7] + (size_t)(kb * 64) * INC + n0, INC, lane);
                t64_store<true>(v, WT_IN + (size_t)(n0 & ~127) * DM + kb * 64, DM, scr, lane, n0 & 127); }
            else transpose64(args.in[7] + (size_t)(kb * 64) * INC + n0, INC, WT_IN + (size_t)n0 * DM + kb * 64, DM, scr, lane);
            continue; } r -= IT_IN;
        if (r < IT_FO) { const int kb = r / 32, nb = r % 32; transpose64(args.in[10] + (size_t)(kb * 64) * DM + nb * 64, DM, WT_FO + (size_t)(nb * 64) * YFP + kb * 64, YFP, scr, lane); continue; } r -= IT_FO;
        if (r < IT_AO) { const int kb = r / 32, nb = r % 32; transpose64(args.in[11] + (size_t)(kb * 64) * DM + nb * 64, DM, WT_AO + (size_t)(nb * 64) * DM + kb * 64, DM, scr, lane); continue; } r -= IT_AO;
        if (r < IT_O) { const int kb = r / 32, nb = r % 32; transpose64(args.in[12] + (size_t)(kb * 64) * DM + nb * 64, DM, WT_O + (size_t)(nb * 64) * DM + kb * 64, DM, scr, lane); continue; } r -= IT_O;
        if (r < 2 * IT_SH) { const int up = r >= IT_SH; if (up) r -= IT_SH; const int kb = r / 8, nb = r % 8, n0 = nb * 64;
            { f32x4 v[16]; t64_load(v, (up ? args.in[20] : args.in[19]) + (size_t)(kb * 64) * EFF + n0, EFF, lane);
              t64_store<false, true>(v, (bf16_t*)((unsigned char*)WT_GU + ((size_t)64 * 1024 + (n0 >> 7) * 256 + (up ? 128 : 0) + (n0 & 127)) * DM + kb * 64), DM, scr, lane); } continue; } r -= 2 * IT_SH;
        if (r < IT_SH) { const int kb = r / 32, nb = r % 32;
            { f32x4 v[16]; t64_load(v, args.in[21] + (size_t)(kb * 64) * DM + nb * 64, DM, lane); t64_store<false, true>(v, (bf16_t*)((unsigned char*)WT_D + ((size_t)64 * DM + nb * 64) * EFF + kb * 64), EFF, scr, lane); } continue; } r -= IT_SH;

        if (r < IT_CST) {
            const int k1 = r & 2047; bf16_t* dst = (bf16_t*)(ws + WS_CST) + (size_t)r * 2048;
#pragma unroll
            for (int j = 0; j < 4; ++j) { const int n0 = j * 512 + lane * 8; float f[8];
#pragma unroll
                for (int i = 0; i < 8; ++i) { const float ph = (float)((k1 * (n0 + i)) & 4095) * (1.0f / 2048.0f); f[i] = r < 2048 ? cospif(ph) : sinpif(ph); }
                u32x4 o; o.x = cvt_pk_bf16(f[0], f[1]); o.y = cvt_pk_bf16(f[2], f[3]); o.z = cvt_pk_bf16(f[4], f[5]); o.w = cvt_pk_bf16(f[6], f[7]);
                *(GAS u32x4*)(dst + n0) = o; }
            continue; } r -= IT_CST;
        if (r < IT_BD2) {
            const int t = r >> 8, o = r & 255, gp = o >> 7, k2 = o & 127; bf16_t* dst = (bf16_t*)(ws + WS_BD2) + (size_t)r * 512; float f[8];
#pragma unroll
            for (int i = 0; i < 8; ++i) { const int j = lane * 8 + i, cg = j >> 8, jj = j & 255, c = jj & 127; const float ph = (float)((32 * c * k2) & 4095) * (1.0f / 2048.0f);
                const float v = jj < 128 ? cospif(ph) : (t ? sinpif(ph) : -sinpif(ph)); f[i] = cg == gp ? v * 0.0013810679320049757f : 0.f; }
            u32x4 w; w.x = cvt_pk_bf16(f[0], f[1]); w.y = cvt_pk_bf16(f[2], f[3]); w.z = cvt_pk_bf16(f[4], f[5]); w.w = cvt_pk_bf16(f[6], f[7]);
            *(GAS u32x4*)(dst + lane * 8) = w;
            continue; } r -= IT_BD2;
        if (r >= IT_RWT) {
            float* RT = (float*)(ws + WS_ROPE);
            for (int idx = lane; idx < 64 * 32; idx += 64) { const float ang = (float)(idx >> 5) * exp2f(-(float)(idx & 31) * (13.287712379549449f / 32.0f)); RT[2 * idx] = cosf(ang); RT[2 * idx + 1] = sinf(ang); }
            continue; }
        {
            f32x4 v[16]; t64_load(v, args.in[14] + (size_t)(r * 64) * NE, NE, lane);
            const int kk = lane >> 4, nc = (lane & 15) * 4;
#pragma unroll
            for (int j = 0; j < 16; ++j) {
#pragma unroll
                for (int c = 0; c < 4; ++c) scr[(j * 4 + kk) * 65 + nc + c] = v[j][c]; }
            LDS_WAIT(); asm volatile("" ::: "memory");
            const int kc = lane & 7; bf16_t* RWT = (bf16_t*)(ws + WS_RWT);
#pragma unroll
            for (int jj = 0; jj < 8; ++jj) { const int e = (lane >> 3) + 8 * jj; const LAS float* s = scr + (8 * kc) * 65 + e; float t[8], l[8];
#pragma unroll
                for (int i = 0; i < 8; ++i) { t[i] = s[i * 65]; l[i] = t[i] - bf2f(f2bf(t[i])); }
                u32x4 h, lo; h.x = cvt_pk_bf16(t[0], t[1]); h.y = cvt_pk_bf16(t[2], t[3]); h.z = cvt_pk_bf16(t[4], t[5]); h.w = cvt_pk_bf16(t[6], t[7]);
                lo.x = cvt_pk_bf16(l[0], l[1]); lo.y = cvt_pk_bf16(l[2], l[3]); lo.z = cvt_pk_bf16(l[4], l[5]); lo.w = cvt_pk_bf16(l[6], l[7]);
                *(GAS u32x4*)(RWT + (size_t)e * DM + r * 64 + 8 * kc) = h; *(GAS u32x4*)(RWT + (size_t)(NE + e) * DM + r * 64 + 8 * kc) = lo; }
            LDS_WAIT(); asm volatile("" ::: "memory");
        }
    }
}


__device__ __forceinline__ void conv_addr(const Args& args, unsigned char* ws, bool down, int it, const float*& W, int& ldw, bf16_t*& dst, int& ldd) {
    if (!down) { int r = it; const int up = r >= IT_EG; if (up) r -= IT_EG;
        const int e = r / 256, q = r % 256, kb = q / 8, nb = q % 8, n0 = nb * 64;
        W = (up ? args.in[17] : args.in[16]) + (size_t)e * DM * EFF + (size_t)(kb * 64) * EFF + n0; ldw = EFF;
        dst = (bf16_t*)(ws + WS_WT_GU + ((size_t)e * 1024 + (n0 >> 7) * 256 + (up ? 128 : 0) + (n0 & 127)) * DM + kb * 64); ldd = DM;
    } else { const int r = it, e = r / 256, q = r % 256, kb = q / 32, nb = q % 32;
        W = args.in[18] + (size_t)e * EFF * DM + (size_t)(kb * 64) * DM + nb * 64; ldw = DM;
        dst = (bf16_t*)(ws + WS_WT_D + ((size_t)e * DM + nb * 64) * EFF + kb * 64); ldd = EFF; }
}
__device__ __forceinline__ void conv_items(Frame& F, const Args& args, bool down, int first, int count) {
    LAS float* scr = (LAS float*)(F.lds + F.wave * 16640);
    const int end = first + count; int it = first + F.wave;
    if (it >= end) return;
    f32x4 va[16], vb[16]; const float* W; int ldw; bf16_t* da; bf16_t* db; int ldd;
    conv_addr(args, F.ws, down, it, W, ldw, da, ldd); t64_load(va, W, ldw, F.lane);
    for (;;) {
        const bool hb = it + NWAVES < end;
        if (hb) { conv_addr(args, F.ws, down, it + NWAVES, W, ldw, db, ldd); t64_load(vb, W, ldw, F.lane); }
        t64_store<false, true>(va, da, ldd, scr, F.lane);
        if (!hb) break;
        const bool ha = it + 2 * NWAVES < end;
        if (ha) { conv_addr(args, F.ws, down, it + 2 * NWAVES, W, ldw, da, ldd); t64_load(va, W, ldw, F.lane); }
        t64_store<false, true>(vb, db, ldd, scr, F.lane);
        if (!ha) break;
        it += 2 * NWAVES;
    }
}
struct SchedIn {
    int G, c; unsigned char* ws; int use_ut;
    __device__ __forceinline__ bool next(int i, Unit& u) const {
        const int L = i * G + c; if (L >= 1024) return false;
        const char* H = (const char*)(ws + WS_H); const char* WT = (const char*)(ws + WS_WT_IN);
        u.rows = 256; u.aux = 0; u.bjs = HALF; u.pm = 0; u.pn = 0; u.rmin = 0; u.nt = DM / BK; u.keep = 0;
        if (L < 896) {
            int pm, ct; grid_map(L, 32, 28, pm, ct);
            const int row0 = pm * 256, b = row0 / SEQ, t0 = row0 % SEQ;
            u.A = H + (size_t)row0 * DM * 2; u.B = WT + (size_t)ct * 256 * DM * 2;
            if (ct < 4) {
                if (use_ut) { u.A = WT + (size_t)ct * 256 * DM * 2; u.B = H + (size_t)row0 * DM * 2;
                              u.C = (char*)(ws + WS_UT) + (((size_t)b * FW + ct * 256) * SEQ + t0) * 2; u.ldc = SEQ; u.mode = 0; }
                else { u.C = (char*)(ws + WS_U) + ((size_t)row0 * FW + ct * 256) * 2; u.ldc = FW; u.mode = 0; }
            }
            else if (ct < 12) { u.C = (char*)(ws + WS_Q) + ((size_t)row0 * DM + (ct - 4) * 256) * 2; u.ldc = DM; u.mode = 5; u.pm = t0; }
            else if (ct < 14) { u.C = (char*)(ws + WS_KALL) + (((size_t)b * SKV + t0) * KVW + (ct - 12) * 256) * 2; u.ldc = KVW; u.mode = 6; u.pm = t0; }
            else if (ct < 16) { u.C = (char*)(ws + WS_VALL) + (((size_t)b * SKV + t0) * KVW + (ct - 14) * 256) * 2; u.ldc = KVW; u.mode = 0; }
            else if (ct < 24) { u.C = (char*)(ws + WS_SGF) + ((size_t)row0 * DM + (ct - 16) * 256) * 2; u.ldc = DM; u.mode = 2; }
            else              { u.C = (char*)(ws + WS_SGA) + ((size_t)row0 * DM + (ct - 24) * 256) * 2; u.ldc = DM; u.mode = 2; }
        } else if (L >= 904) {
            int pm, q; grid_map(L - 904, 32, 4, pm, q); const int ct = 28 + q;
            u.A = H + (size_t)pm * 256 * DM * 2; u.B = WT + (size_t)ct * 256 * DM * 2;
            u.C = (char*)(ws + WS_SGA) + ((size_t)pm * 256 * DM + (ct - 24) * 256) * 2; u.ldc = DM; u.mode = 2;
        } else {
            const int l = L - 896, pm = l & 1, ct = l >> 1;
            u.A = H + (size_t)(NTOK + pm * 256) * DM * 2; u.B = WT + (size_t)(K_OFF + ct * 256) * DM * 2;
            if (ct < 2) { u.C = (char*)(ws + WS_KALL) + (((size_t)pm * SKV + SEQ) * KVW + ct * 256) * 2; u.ldc = KVW; u.mode = 7; }
            else        { u.C = (char*)(ws + WS_VALL) + (((size_t)pm * SKV + SEQ) * KVW + (ct - 2) * 256) * 2; u.ldc = KVW; u.mode = 0; }
        }
        return true;
    }
    __device__ __forceinline__ unsigned arow(const Unit&, int) const { return 0u; }
};


__device__ __forceinline__ void unpack8(u32x4 w, float (&f)[8]) {
#pragma unroll
    for (int i = 0; i < 4; ++i) { f[2 * i] = __uint_as_float(w[i] << 16); f[2 * i + 1] = __uint_as_float(w[i] & 0xffff0000u); }
}
struct EpiMerge { const bf16_t* SGF; const bf16_t* SGA; bf16_t* YM;
    __device__ __forceinline__ void operator()(f32x4 (&acc)[2][2][4][2], const Unit& u, int wr, int wc, int fr, int fq) const {
#pragma unroll
        for (int ai = 0; ai < 2; ++ai)
#pragma unroll
            for (int m = 0; m < 4; ++m) { const size_t row = (size_t)u.pm * 256 + ai * HALF + wr * 64 + m * 16 + fr;
#pragma unroll
                for (int bj = 0; bj < 2; ++bj) { const size_t o = row * DM + u.pn * 256 + bj * HALF + wc * 32 + 8 * fq;
                    float ga[8]; unpack8(*(const u32x4*)(SGA + o), ga);
#pragma unroll
                    for (int c = 0; c < 8; ++c) ga[c] = fmaxf(ga[c], 1e-20f);
                    if (u.keep) { float gf[8]; unpack8(*(const u32x4*)(SGF + o), gf);
#pragma unroll
                        for (int c = 0; c < 4; ++c) { acc[ai][bj][m][0][c] *= gf[c] * __builtin_amdgcn_rcpf(ga[c]); acc[ai][bj][m][1][c] *= gf[4 + c] * __builtin_amdgcn_rcpf(ga[4 + c]); }
                    } else { const f32x4 v0 = acc[ai][bj][m][0], v1 = acc[ai][bj][m][1];
                        u32x4 w; w.x = cvt_pk_bf16(ga[0] * v0[0], ga[1] * v0[1]); w.y = cvt_pk_bf16(ga[2] * v0[2], ga[3] * v0[3]); w.z = cvt_pk_bf16(ga[4] * v1[0], ga[5] * v1[1]); w.w = cvt_pk_bf16(ga[6] * v1[2], ga[7] * v1[3]);
                        *(u32x4*)(YM + o) = w; } } }
    } };
struct SchedMerge { int G, c; unsigned char* ws;
    __device__ __forceinline__ bool next(int i, Unit& u) const {
        const int L = (i >> 1) * G + c; if (L >= 256) return false;
        int pm, pn; grid_map(L, 32, 8, pm, pn); const int kb = i & 1;
        u.A = (const char*)(ws + (kb ? WS_YA : WS_YF)) + (size_t)pm * 256 * DM * 2; u.B = (const char*)(ws + (kb ? WS_WT_AO : WS_WT_FO)) + (size_t)pn * 256 * DM * 2;
        u.C = nullptr; u.ldc = DM; u.mode = 0; u.rows = 256; u.aux = 0; u.pm = pm; u.pn = pn; u.bjs = HALF; u.rmin = 0; u.nt = kb ? DM / BK : FW / BK; u.keep = kb ? 0 : 1;
        return true; }
    __device__ __forceinline__ unsigned arow(const Unit&, int) const { return 0u; } };
struct EpiX2 { const float* x; const float* mod; float* X2;
    __device__ __forceinline__ void operator()(f32x4 (&acc)[2][2][4][2], const Unit& u, int wr, int wc, int fr, int fq) const {
        const float* g1 = mod + ((u.pm * 256) / SEQ) * MODC + 2 * DM;
#pragma unroll
        for (int ai = 0; ai < 2; ++ai)
#pragma unroll
            for (int m = 0; m < 4; ++m) { const size_t row = (size_t)u.pm * 256 + ai * HALF + wr * 64 + m * 16 + fr;
#pragma unroll
                for (int bj = 0; bj < 2; ++bj) { const int col = u.pn * 256 + bj * HALF + wc * 32 + 8 * fq; const size_t o = row * DM + col;
#pragma unroll
                    for (int n = 0; n < 2; ++n) { const f32x4 xv = *(const f32x4*)(x + o + 4 * n), gv = *(const f32x4*)(g1 + col + 4 * n); *(f32x4*)(X2 + o + 4 * n) = xv + gv * acc[ai][bj][m][n]; } } }
    } };
__device__ __forceinline__ void act8(const f32x4 (&g)[2], const f32x4 (&up)[2], unsigned& w0, unsigned& w1) {
    f32x4 a[2];
#pragma unroll
    for (int n = 0; n < 2; ++n)
#pragma unroll
        for (int c = 0; c < 4; ++c) { const float x = g[n][c]; a[n][c] = fminf(fmaxf(x * __builtin_amdgcn_rcpf(1.0f + __expf(-x)) * up[n][c], -448.f), 448.f); }
    int x0 = 0, x1 = 0;
    x0 = __builtin_amdgcn_cvt_pk_fp8_f32(a[0][0], a[0][1], x0, false); x0 = __builtin_amdgcn_cvt_pk_fp8_f32(a[0][2], a[0][3], x0, true);
    x1 = __builtin_amdgcn_cvt_pk_fp8_f32(a[1][0], a[1][1], x1, false); x1 = __builtin_amdgcn_cvt_pk_fp8_f32(a[1][2], a[1][3], x1, true);
    w0 = (unsigned)x0; w1 = (unsigned)x1;
}
struct EpiAct {
    __device__ __forceinline__ void operator()(f32x4 (&acc)[2][2][4][2], const Unit& u, int wr, int wc, int fr, int fq) const {
        const int odd = fq & 1;
        unsigned char* base = (unsigned char*)u.C + (size_t)(wr * 64 + odd * 16 + fr) * u.ldc + wc * 32 + 8 * (fq - odd);
        const int r0 = wr * 64 + odd * 16 + fr;
#pragma unroll
        for (int ai = 0; ai < 2; ++ai)
#pragma unroll
            for (int m = 0; m < 4; m += 2) {
                unsigned a0, a1, b0, b1; act8(acc[ai][0][m], acc[ai][1][m], a0, a1); act8(acc[ai][0][m + 1], acc[ai][1][m + 1], b0, b1);
                const auto s0 = __builtin_amdgcn_permlane16_swap(a0, b0, false, false), s1 = __builtin_amdgcn_permlane16_swap(a1, b1, false, false);
                if (r0 + ai * HALF + m * 16 < u.rows) { const u32x4 w = {s0[0], s1[0], s0[1], s1[1]}; *(u32x4*)(base + (size_t)(ai * HALF + m * 16) * u.ldc) = w; } }
    } };

struct SchedGrid {
    int G, c, nM, nN; const char* A; const char* B; char* C; size_t astride, bstride; int ldc, esz, mode, nt;
    __device__ __forceinline__ bool next(int i, Unit& u) const {
        const int L = i * G + c; if (L >= nM * nN) return false;
        int pm, pn; grid_map(L, nM, nN, pm, pn);
        u.A = A + (size_t)pm * astride; u.B = B + (size_t)pn * bstride; u.C = C + ((size_t)pm * 256 * ldc + pn * 256) * esz; u.ldc = ldc; u.mode = mode; u.rows = 256; u.aux = 0; u.pm = pm; u.pn = pn; u.bjs = HALF; u.rmin = 0; u.nt = nt; u.keep = 0;
        return true; }
    __device__ __forceinline__ unsigned arow(const Unit&, int) const { return 0u; } };
struct SchedAG { int G, c; unsigned char* ws;
    __device__ __forceinline__ bool next(int i, Unit& u) const {
        const int L = i * G + c; if (L >= 136) return false;
        u.rows = 256; u.aux = 0; u.rmin = 0; u.nt = DM / BK; u.keep = 0;
        if (L < 128) {
            int pm, pn8; grid_map(L, 16, 8, pm, pn8); const int b = pn8 >> 2, pn = pn8 & 3, sn = pm >> 3, k1t = pm & 7;
            u.A = (const char*)(ws + WS_CST) + (size_t)pm * 256 * 2048 * 2; u.B = (const char*)(ws + (sn ? WS_OT : WS_ET)) + ((size_t)b * FW + pn * 256) * 2048 * 2;
            u.C = (char*)(ws + WS_TT) + (((size_t)b * 2048 + k1t * 256) * DM + pn * 512 + sn * 128) * 2; u.ldc = DM; u.mode = sn ? 0 : 3; u.pm = k1t; u.pn = b * FW + pn * 256; u.bjs = 256;
        } else {
            int pm, q; grid_map(L - 128 + 120, 32, 4, pm, q); const int ct = 28 + q;
            u.A = (const char*)(ws + WS_H) + (size_t)pm * 256 * DM * 2; u.B = (const char*)(ws + WS_WT_IN) + (size_t)ct * 256 * DM * 2;
            u.C = (char*)(ws + WS_SGA) + ((size_t)pm * 256 * DM + (ct - 24) * 256) * 2; u.ldc = DM; u.mode = 2; u.pm = pm; u.pn = ct; u.bjs = HALF;
        }
        return true; }
    __device__ __forceinline__ unsigned arow(const Unit&, int) const { return 0u; } };
struct SchedF2 { int G, c; unsigned char* ws;
    __device__ __forceinline__ bool next(int i, Unit& u) const {
        const int L = i * G + c; if (L >= 128) return false;
        int pm, q; grid_map(L, 16, 8, pm, q); const int b = pm >> 3, k1t = pm & 7, j = q & 3, mir = q >> 2;
        u.A = (const char*)(ws + WS_TT) + (((size_t)b * 2048 + k1t * 256) * DM + j * 512) * 2; u.B = (const char*)(ws + WS_BD2) + (size_t)mir * 256 * 512 * 2;
        u.mode = 0; u.rows = 256; u.aux = 0; u.pm = pm; u.pn = j; u.bjs = HALF; u.nt = 512 / BK; u.keep = 0;
        if (!mir) { u.C = (char*)(ws + WS_YF) + (((size_t)b * SEQ + k1t * 256) * YFP + j * 256) * 2; u.ldc = YFP; u.rmin = 0; }
        else { u.C = (char*)(ws + WS_YF) + (((size_t)b * SEQ + SEQ - k1t * 256) * YFP + j * 256) * 2; u.ldc = -YFP; u.rmin = k1t == 0 ? 1 : 0; }
        return true; }
    __device__ __forceinline__ unsigned arow(const Unit&, int) const { return 0u; } };
constexpr int SCHT_OFF = LDSCTL_OFF + 1024;
__device__ __forceinline__ void moe_tables(Frame& F, int ncol_tiles) {
    LAS int* T = (LAS int*)(F.lds + SCHT_OFF);
    __syncthreads();
    if (F.tid == 0) { const int* CNT = (const int*)(F.ws + CTL_CNT); int up = 0, of = 0;
        for (int e = 0; e <= NE; ++e) { const int cn = e < NE ? CNT[e * 64] : NTOK; T[e] = up; T[80 + e] = e < NE ? of : NSLOT; T[160 + e] = cn; up += ((cn + 255) >> 8) * ncol_tiles; of += cn; }
        T[NE + 1] = up; }
    __syncthreads();
}
template <int NCT, bool FIRST> struct SchedMoe {
    int G, c; unsigned char* ws; LAS int* T; const int* TOK;
    __device__ __forceinline__ int tl(int i) const { return __builtin_amdgcn_readfirstlane(T[i]); }
    __device__ __forceinline__ bool next(int i, Unit& u) const {
        const int L = i * G + c; if (L >= tl(NE + 1)) return false;
        int lo = 0, hi = NE;
#pragma unroll 1
        while (lo < hi) { const int mid = (lo + hi + 1) >> 1; if (tl(mid) <= L) lo = mid; else hi = mid - 1; }
        const int e = lo, cn = tl(160 + e), ntile = (cn + 255) >> 8, local = L - tl(e), ct = local / ntile, mt = local % ntile, slot0 = tl(80 + e) + mt * 256;
        u.rows = (cn - mt * 256) < 256 ? (cn - mt * 256) : 256; u.aux = slot0; u.pm = mt; u.pn = ct; u.bjs = HALF; u.mode = 0; u.rmin = 0; u.e = e; u.nt = (FIRST ? DM : EFF) / 128; u.keep = 0;
        if (FIRST) { u.A = (const char*)(ws + WS_H2); u.B = (const char*)(ws + WS_WT_GU) + ((size_t)e * 4 + ct) * 256 * DM; u.C = (char*)(ws + WS_ACT) + ((size_t)slot0 * EFF + ct * 128); u.ldc = EFF; }
        else { u.A = (const char*)(ws + WS_ACT) + (size_t)slot0 * EFF; u.B = (const char*)(ws + WS_WT_D) + ((size_t)e * DM + ct * 256) * EFF; u.C = (char*)(ws + WS_YBIG) + ((size_t)slot0 * DM + ct * 256); u.ldc = DM; u.mode = 8; }
        return true; }
    __device__ __forceinline__ unsigned arow(const Unit& u, int r) const { const int rr = u.pm * 256 + (r < u.rows ? r : u.rows - 1); const int tok = u.e < NE ? TOK[u.e * NTOK + rr] : rr; return (unsigned)tok * (unsigned)DM; } };

namespace attn {
using s16x4 = __attribute__((ext_vector_type(4))) short;
using f32x8 = __attribute__((ext_vector_type(8))) float;
constexpr int D = 128, NW = 8, QBLK = 32, KVBLK = 64;
constexpr float SCALE = 0.088388347648318440f;
constexpr float THR = 8.f;
constexpr int LDQ = DM, LDK = KVW, LDO = DM;
constexpr size_t SHM_V = KVBLK * D * 2, SHM_K = KVBLK * D * 2, SHM_ATTN = 2 * SHM_V + 2 * SHM_K + NW * 64 * 4;
#define KSWZ(row, colB) ((row) * 256 + ((colB) ^ (((row) & 7) << 4)))
#define SBAR() __builtin_amdgcn_sched_barrier(0)
__device__ __forceinline__ unsigned cvtpk(float lo, float hi) { unsigned r; asm volatile("v_cvt_pk_bf16_f32 %0, %1, %2" : "=v"(r) : "v"(lo), "v"(hi)); return r; }
__device__ __forceinline__ void partialSM(f32x16& p0, f32x16& p1, float& m_reg, float& mn, float& alpha) {
  constexpr float C = SCALE * 1.4426950408889634f;
  float pmax = p0[0]; for (int r = 1; r < 16; ++r) pmax = fmaxf(pmax, p0[r]); for (int r = 0; r < 16; ++r) pmax = fmaxf(pmax, p1[r]);
  { auto rr = __builtin_amdgcn_permlane32_swap(__float_as_uint(pmax), __float_as_uint(pmax), false, false);
    pmax = fmaxf(__uint_as_float(rr[0]), __uint_as_float(rr[1])); }
  if (__builtin_expect(__all(pmax - m_reg <= THR / SCALE), 1)) { mn = m_reg; alpha = 1.f; }
  else { mn = fmaxf(m_reg, pmax); alpha = __builtin_amdgcn_exp2f((m_reg - mn) * C); m_reg = mn; }
  float mnC = -mn * C;
  for (int r = 0; r < 16; ++r) p0[r] = fmaf(p0[r], C, mnC); for (int r = 0; r < 16; ++r) p1[r] = fmaf(p1[r], C, mnC);
  for (int r = 0; r < 16; ++r) p0[r] = __builtin_amdgcn_exp2f(p0[r]);
}
__device__ __forceinline__ void finishSM(f32x16& p0, f32x16& p1, float alpha, float& l_reg, bf16x8& pa0, bf16x8& pa1, bf16x8& pa2, bf16x8& pa3) {
  for (int r = 0; r < 16; ++r) p1[r] = __builtin_amdgcn_exp2f(p1[r]);
  float ps = 0; for (int r = 0; r < 16; ++r) ps += p0[r]; for (int r = 0; r < 16; ++r) ps += p1[r];
  { auto rr = __builtin_amdgcn_permlane32_swap(__float_as_uint(ps), __float_as_uint(ps), false, false);
    ps = __uint_as_float(rr[0]) + __uint_as_float(rr[1]); }
  l_reg = l_reg * alpha + ps;
#define PK4(P, BASE, OUT) do { unsigned a0 = cvtpk(P[BASE + 0], P[BASE + 1]), a1 = cvtpk(P[BASE + 2], P[BASE + 3]);   \
    unsigned b0 = cvtpk(P[BASE + 4], P[BASE + 5]), b1 = cvtpk(P[BASE + 6], P[BASE + 7]);                              \
    auto r0 = __builtin_amdgcn_permlane32_swap(a0, b0, false, false); auto r1 = __builtin_amdgcn_permlane32_swap(a1, b1, false, false); \
    u32x4 w = {r0[0], r1[0], r0[1], r1[1]}; OUT = *reinterpret_cast<bf16x8*>(&w); } while (0)
  PK4(p0, 0, pa0); PK4(p0, 8, pa1); PK4(p1, 0, pa2); PK4(p1, 8, pa3);
#undef PK4
}
__device__ __forceinline__ void qkt(f32x16& p0, f32x16& p1, const bf16_t* Ks, const bf16x8* qr, int r32, int hi) {
  p0 = f32x16{}; p1 = f32x16{};
  for (int d0 = 0; d0 < 8; ++d0) { int cb = (d0 * 16 + hi * 8) * 2;
    bf16x8 b0 = *reinterpret_cast<const bf16x8*>((const char*)Ks + KSWZ(r32, cb));
    bf16x8 b1 = *reinterpret_cast<const bf16x8*>((const char*)Ks + KSWZ(32 + r32, cb));
    p0 = __builtin_amdgcn_mfma_f32_32x32x16_bf16(b0, qr[d0], p0, 0, 0, 0);
    p1 = __builtin_amdgcn_mfma_f32_32x32x16_bf16(b1, qr[d0], p1, 0, 0, 0); }
}
__device__ __forceinline__ int v_st(int k, int c) { const int kk = (k & ~0xC) | ((k & 4) << 1) | ((k & 8) >> 1); return ((kk >> 3) * 4 + (c >> 5)) * 512 + ((kk & 7) * 32 + (c & 31)) * 2; }
__device__ __forceinline__ int v_rd_base(int lane) { return ((lane & 3) << 3) | (((lane >> 2) & 3) << 6) | (((lane >> 4) & 1) << 5) | (((lane >> 5) & 1) << 8); }
constexpr int v_rd_off(int d0, int ks, int half) { return d0 * 512 + ks * 4096 + half * 2048; }
template <int OFF> __device__ __forceinline__ s16x4 tr_read(int vb) {
  s16x4 r; asm volatile("ds_read_b64_tr_b16 %0, %1 offset:%2" : "=&v"(r) : "v"(vb), "i"(OFF) : "memory"); return r;
}
template <int D0> __device__ __forceinline__ void pv_one(f32x16& od, int vb, bf16x8 pa0, bf16x8 pa1, bf16x8 pa2, bf16x8 pa3) {
  const s16x4 l0 = tr_read<v_rd_off(D0, 0, 0)>(vb), h0 = tr_read<v_rd_off(D0, 0, 1)>(vb), l1 = tr_read<v_rd_off(D0, 1, 0)>(vb), h1 = tr_read<v_rd_off(D0, 1, 1)>(vb);
  const s16x4 l2 = tr_read<v_rd_off(D0, 2, 0)>(vb), h2 = tr_read<v_rd_off(D0, 2, 1)>(vb), l3 = tr_read<v_rd_off(D0, 3, 0)>(vb), h3 = tr_read<v_rd_off(D0, 3, 1)>(vb);
  asm volatile("s_waitcnt lgkmcnt(0)" ::: "memory"); SBAR();
#define PK(L, H) (bf16x8){L[0], L[1], L[2], L[3], H[0], H[1], H[2], H[3]}
  od = __builtin_amdgcn_mfma_f32_32x32x16_bf16(pa0, PK(l0, h0), od, 0, 0, 0);
  od = __builtin_amdgcn_mfma_f32_32x32x16_bf16(pa1, PK(l1, h1), od, 0, 0, 0);
  od = __builtin_amdgcn_mfma_f32_32x32x16_bf16(pa2, PK(l2, h2), od, 0, 0, 0);
  od = __builtin_amdgcn_mfma_f32_32x32x16_bf16(pa3, PK(l3, h3), od, 0, 0, 0);
#undef PK
}
__device__ __forceinline__ void pv_d0(f32x16* o, int vb, bf16x8 pa0, bf16x8 pa1, bf16x8 pa2, bf16x8 pa3) {
  pv_one<0>(o[0], vb, pa0, pa1, pa2, pa3); pv_one<1>(o[1], vb, pa0, pa1, pa2, pa3); pv_one<2>(o[2], vb, pa0, pa1, pa2, pa3); pv_one<3>(o[3], vb, pa0, pa1, pa2, pa3);
}
__device__ __forceinline__ void attn_dense_body(const bf16_t* __restrict__ Qb, const bf16_t* __restrict__ Kh, const bf16_t* __restrict__ Vh, bf16_t* __restrict__ Ob, int seq, char* lds) {
  const int tid = threadIdx.x, wid = tid >> 6, lane = tid & 63, r32 = lane & 31, hi = lane >> 5;
  bf16_t* V_lds = (bf16_t*)lds; bf16_t* K_lds = (bf16_t*)(lds + 2 * SHM_V);
  float* ws = (float*)(lds + 2 * SHM_V + 2 * SHM_K) + wid * 64; float* li_l = ws; float* al_l = ws + 32;
  float m_reg = -1e30f, l_reg = 0; f32x16 o[4] = {}; bf16x8 qr[8];
  const bf16_t* Qw = Qb + (long)(wid * QBLK + r32) * LDQ + hi * 8;
#pragma unroll
  for (int d0 = 0; d0 < 8; ++d0) qr[d0] = *reinterpret_cast<const bf16x8*>(Qw + d0 * 16);
  const int sr = tid >> 4, sc = (tid & 15) * 8, vst0 = v_st(sr, sc), vst1 = v_st(32 + sr, sc);
  const int vb0 = (int)(uintptr_t)V_lds + v_rd_base(lane);
  struct { bf16x8 vs0, vs1, ks0, ks1; } sr_[2];
#define SLOAD(i, k0) do { sr_[i].vs0 = *reinterpret_cast<const bf16x8*>(&Vh[(long)((k0) + sr) * LDK + sc]); sr_[i].vs1 = *reinterpret_cast<const bf16x8*>(&Vh[(long)((k0) + 32 + sr) * LDK + sc]); \
    sr_[i].ks0 = *reinterpret_cast<const bf16x8*>(&Kh[(long)((k0) + sr) * LDK + sc]); sr_[i].ks1 = *reinterpret_cast<const bf16x8*>(&Kh[(long)((k0) + 32 + sr) * LDK + sc]); } while (0)
#define SWRITE(b, i) do { *(bf16x8*)((char*)V_lds + (b) * SHM_V + vst0) = sr_[i].vs0;          \
    *(bf16x8*)((char*)V_lds + (b) * SHM_V + vst1) = sr_[i].vs1; int kc = sc * 2;               \
    *(bf16x8*)((char*)K_lds + (b) * SHM_K + KSWZ(sr, kc)) = sr_[i].ks0;                       \
    *(bf16x8*)((char*)K_lds + (b) * SHM_K + KSWZ(32 + sr, kc)) = sr_[i].ks1; } while (0)
#define SWAIT() asm volatile("s_waitcnt vmcnt(4)" ::: "memory")
#define RESC(a) do { if (__any((a) < 1.f)) { if (hi == 0) al_l[r32] = (a); asm volatile("s_waitcnt lgkmcnt(0)" ::: "memory"); \
    for (int d = 0; d < 4; ++d) for (int r = 0; r < 16; ++r) o[d][r] *= al_l[crow(r, hi)]; } } while (0)
  f32x16 pA0, pA1, pB0, pB1; float mnA, mnB, alA, alB; bf16x8 pa0, pa1, pa2, pa3; const int NT = seq / KVBLK;
  constexpr int SE = 0, SO = 1;
  SLOAD(SE, 0); asm volatile("s_waitcnt vmcnt(0)" ::: "memory"); SWRITE(0, SE); __syncthreads();
  qkt(pA0, pA1, K_lds, qr, r32, hi); partialSM(pA0, pA1, m_reg, mnA, alA);
  SLOAD(SO, KVBLK); if (2 < NT) SLOAD(SE, 2 * KVBLK);
  SWAIT(); SWRITE(1, SO); __syncthreads();
  for (int j = 1; j + 1 < NT; j += 2) {
    SBAR(); qkt(pB0, pB1, (bf16_t*)((char*)K_lds + SHM_K), qr, r32, hi);
    finishSM(pA0, pA1, alA, l_reg, pa0, pa1, pa2, pa3); SBAR();
    SLOAD(SO, (j + 2) * KVBLK); SBAR();
    pv_d0(o, vb0, pa0, pa1, pa2, pa3); partialSM(pB0, pB1, m_reg, mnB, alB);
    __syncthreads(); SWAIT(); SWRITE(0, SE);
    RESC(alB); __syncthreads();
    SBAR(); qkt(pA0, pA1, K_lds, qr, r32, hi);
    finishSM(pB0, pB1, alB, l_reg, pa0, pa1, pa2, pa3); SBAR();
    if (j + 3 < NT) SLOAD(SE, (j + 3) * KVBLK); SBAR();
    pv_d0(o, vb0 + (int)SHM_V, pa0, pa1, pa2, pa3); partialSM(pA0, pA1, m_reg, mnA, alA);
    __syncthreads(); SWAIT(); SWRITE(1, SO);
    RESC(alA); __syncthreads();
  }
  SBAR(); qkt(pB0, pB1, (bf16_t*)((char*)K_lds + SHM_K), qr, r32, hi);
  finishSM(pA0, pA1, alA, l_reg, pa0, pa1, pa2, pa3); SBAR();
  pv_d0(o, vb0, pa0, pa1, pa2, pa3); partialSM(pB0, pB1, m_reg, mnB, alB);
  __syncthreads(); RESC(alB);
  finishSM(pB0, pB1, alB, l_reg, pa0, pa1, pa2, pa3); SBAR();
  pv_d0(o, vb0 + (int)SHM_V, pa0, pa1, pa2, pa3);
  if (hi == 0) li_l[r32] = l_reg; asm volatile("s_waitcnt lgkmcnt(0)" ::: "memory");
  float rli[16];
#pragma unroll
  for (int r = 0; r < 16; ++r) rli[r] = __builtin_amdgcn_rcpf(li_l[crow(r, hi)]);
  bf16_t* Ow = Ob + (long)(wid * QBLK) * LDO;
#pragma unroll
  for (int r = 0; r < 16; ++r) { int orow = crow(r, hi);
    for (int d0 = 0; d0 < 4; ++d0) Ow[(long)orow * LDO + d0 * 32 + r32] = f2bf(o[d0][r] * rli[r]); }
#undef SLOAD
#undef SWRITE
#undef SWAIT
#undef RESC
}
#undef KSWZ
#undef SBAR
}

__device__ __forceinline__ void ph_norm1(Frame& F, const Args& args, const float* mod) {
    const int gw = F.vcu * NWAVES + F.wave, NGW = F.G * NWAVES, lane = F.lane;
    bf16_t* H = (bf16_t*)(F.ws + WS_H); const float* nw = args.in[6];
    for (int row = gw; row < NTOK + NCTX; row += NGW) {
        const float* src = row < NTOK ? args.in[0] + (size_t)row * DM : args.in[2] + (size_t)(row - NTOK) * DM;
        const float* mr = mod + (row < NTOK ? row / SEQ : 2) * MODC;
        f32x4 v[8]; float ss = 0.f;
#pragma unroll
        for (int j = 0; j < 8; ++j) { v[j] = *(const GAS f32x4*)(src + (j * 64 + lane) * 4); ss += v[j].x * v[j].x + v[j].y * v[j].y + v[j].z * v[j].z + v[j].w * v[j].w; }
        ss = wave_sum(ss);
        const float rstd = 1.0f / sqrtf(ss * (1.0f / DM) + 1e-6f);
#pragma unroll
        for (int j = 0; j < 8; ++j) { const int i = (j * 64 + lane) * 4;
            const f32x4 w = *(const GAS f32x4*)(nw + i), sc = *(const GAS f32x4*)(mr + DM + i), sh = *(const GAS f32x4*)(mr + i);
            const f32x4 h = v[j] * rstd * w * (sc + 1.0f) + sh;
            unsigned lo = cvt_pk_bf16(h[0], h[1]), hi = cvt_pk_bf16(h[2], h[3]);
            *(GAS unsigned long long*)(H + (size_t)row * DM + i) = (unsigned long long)lo | ((unsigned long long)hi << 32); }
    }
}
__device__ __forceinline__ void ph_evenodd(Frame& F, const Args& args) {
    const int gw = F.vcu * NWAVES + F.wave, NGW = F.G * NWAVES, lane = F.lane;
    LAS bf16_t* scr = (LAS bf16_t*)(F.lds + F.wave * 16640);
    const bf16_t* UT = (const bf16_t*)(F.ws + WS_UT); bf16_t* ET = (bf16_t*)(F.ws + WS_ET); bf16_t* OT = (bf16_t*)(F.ws + WS_OT);
    float* W2 = (float*)(F.ws + WS_W2048); float* AL = (float*)(F.ws + WS_ALT);
    for (int row = gw; row < 2 * FW; row += NGW) {
        const bf16_t* src = UT + (size_t)row * SEQ; float alt = 0.f;
#pragma unroll
        for (int j = 0; j < 8; ++j) { const u32x4 w = *(const GAS u32x4*)(src + (j * 64 + lane) * 8); *(LAS u32x4*)(scr + (j * 64 + lane) * 8) = w;
            float f[8]; unpack8(w, f); alt += (f[0] - f[1]) + (f[2] - f[3]) + (f[4] - f[5]) + (f[6] - f[7]); }
        alt = wave_sum(alt);
        LDS_WAIT(); asm volatile("" ::: "memory");
        if (lane == 0) { AL[row] = alt; W2[row] = bf2f(scr[SEQ / 2]); }
#pragma unroll
        for (int j = 0; j < 4; ++j) { const int n0 = (j * 64 + lane) * 8; float e[8], o[8];
#pragma unroll
            for (int i = 0; i < 8; ++i) { const int n = n0 + i; const float a = bf2f(scr[n]), bb = bf2f(scr[(SEQ - n) & (SEQ - 1)]); e[i] = n == 0 ? a : a + bb; o[i] = n == 0 ? 0.f : a - bb; }
            u32x4 we, wo; we.x = cvt_pk_bf16(e[0], e[1]); we.y = cvt_pk_bf16(e[2], e[3]); we.z = cvt_pk_bf16(e[4], e[5]); we.w = cvt_pk_bf16(e[6], e[7]);
            wo.x = cvt_pk_bf16(o[0], o[1]); wo.y = cvt_pk_bf16(o[2], o[3]); wo.z = cvt_pk_bf16(o[4], o[5]); wo.w = cvt_pk_bf16(o[6], o[7]);
            *(GAS u32x4*)(ET + (size_t)row * 2048 + n0) = we; *(GAS u32x4*)(OT + (size_t)row * 2048 + n0) = wo; }
        LDS_WAIT(); asm volatile("" ::: "memory");
    }
}
__device__ __forceinline__ void ph_route(Frame& F, const Args& args, const float* mod) {
    const int lane = F.lane, wv = F.wave, r32 = lane & 31, hi = lane >> 5;
    LAS float* rs = (LAS float*)F.lds;
    LAS float* part = (LAS float*)(F.lds + 1024);
    LAS int* lcnt = (LAS int*)(F.lds + 1024 + 65536);
    LAS int* lbase = lcnt + 64;
    LAS int* lent = lcnt + 128;
    const float* X2 = (const float*)(F.ws + WS_X2); const float* nw = args.in[13]; const float* rb = args.in[15];
    const bf16_t* RWT = (const bf16_t*)(F.ws + WS_RWT);
    bf16_t* H2 = (bf16_t*)(F.ws + WS_H2); int* EIDX = (int*)(F.ws + WS_EIDX); float* EW = (float*)(F.ws + WS_EW); int* EPOS = (int*)(F.ws + WS_EPOS); int* CNT = (int*)(F.ws + CTL_CNT); int* TOKE = (int*)(F.ws + WS_TOKE);
    if (F.tid < NE) lcnt[F.tid] = 0;
    __syncthreads();
    int nb = 0;
    for (int blk = F.vcu; blk < NTOK / 32; blk += F.G, ++nb) {
        const int row0 = blk * 32; const float* mr = mod + (row0 / SEQ) * MODC;
#pragma unroll
        for (int i = 0; i < 4; ++i) { const float* src = X2 + (size_t)(row0 + wv * 4 + i) * DM; float ss = 0.f;
#pragma unroll
            for (int j = 0; j < 8; ++j) { const f32x4 v = *(const GAS f32x4*)(src + (j * 64 + lane) * 4); ss += v.x * v.x + v.y * v.y + v.z * v.z + v.w * v.w; }
            ss = wave_sum(ss);
            if (lane == 0) rs[wv * 4 + i] = 1.0f / sqrtf(ss * (1.0f / DM) + 1e-6f); }
        __syncthreads();
        { const float rstd = rs[r32]; const float* xr = X2 + (size_t)(row0 + r32) * DM; unsigned char* hr = (unsigned char*)H2 + (size_t)(row0 + r32) * DM;
          f32x16 acc0 = {}, acc1 = {};
#pragma unroll 4
          for (int ks = 0; ks < 16; ++ks) { const int k = wv * 256 + ks * 16 + hi * 8;
              float h[8];
#pragma unroll
              for (int q = 0; q < 2; ++q) { const f32x4 x = *(const GAS f32x4*)(xr + k + 4 * q), w = *(const GAS f32x4*)(nw + k + 4 * q), sc = *(const GAS f32x4*)(mr + 4 * DM + k + 4 * q), sh = *(const GAS f32x4*)(mr + 3 * DM + k + 4 * q);
                  const f32x4 t = x * rstd * w * (sc + 1.0f) + sh; h[4 * q] = t[0]; h[4 * q + 1] = t[1]; h[4 * q + 2] = t[2]; h[4 * q + 3] = t[3]; }
              u32x4 wh, wl; float l[8];
              wh.x = cvt_pk_bf16(h[0], h[1]); wh.y = cvt_pk_bf16(h[2], h[3]); wh.z = cvt_pk_bf16(h[4], h[5]); wh.w = cvt_pk_bf16(h[6], h[7]);
#pragma unroll
              for (int i = 0; i < 4; ++i) { l[2 * i] = h[2 * i] - __uint_as_float(wh[i] << 16); l[2 * i + 1] = h[2 * i + 1] - __uint_as_float(wh[i] & 0xffff0000u); }
              wl.x = cvt_pk_bf16(l[0], l[1]); wl.y = cvt_pk_bf16(l[2], l[3]); wl.z = cvt_pk_bf16(l[4], l[5]); wl.w = cvt_pk_bf16(l[6], l[7]);
              { float hc[8];
#pragma unroll
                for (int i = 0; i < 8; ++i) hc[i] = fminf(fmaxf(h[i], -448.f), 448.f);
                int w0 = 0, w1 = 0; w0 = __builtin_amdgcn_cvt_pk_fp8_f32(hc[0], hc[1], w0, false); w0 = __builtin_amdgcn_cvt_pk_fp8_f32(hc[2], hc[3], w0, true);
                w1 = __builtin_amdgcn_cvt_pk_fp8_f32(hc[4], hc[5], w1, false); w1 = __builtin_amdgcn_cvt_pk_fp8_f32(hc[6], hc[7], w1, true);
                *(GAS unsigned long long*)(hr + k) = (unsigned long long)(unsigned)w0 | ((unsigned long long)(unsigned)w1 << 32); }
              const bf16x8 ah = __builtin_bit_cast(bf16x8, wh), al = __builtin_bit_cast(bf16x8, wl);
              const bf16x8 bh0 = *(const GAS bf16x8*)(RWT + (size_t)r32 * DM + k), bh1 = *(const GAS bf16x8*)(RWT + (size_t)(32 + r32) * DM + k);
              const bf16x8 bl0 = *(const GAS bf16x8*)(RWT + (size_t)(NE + r32) * DM + k), bl1 = *(const GAS bf16x8*)(RWT + (size_t)(NE + 32 + r32) * DM + k);
              acc0 = __builtin_amdgcn_mfma_f32_32x32x16_bf16(ah, bh0, acc0, 0, 0, 0); acc0 = __builtin_amdgcn_mfma_f32_32x32x16_bf16(ah, bl0, acc0, 0, 0, 0); acc0 = __builtin_amdgcn_mfma_f32_32x32x16_bf16(al, bh0, acc0, 0, 0, 0);
              acc1 = __builtin_amdgcn_mfma_f32_32x32x16_bf16(ah, bh1, acc1, 0, 0, 0); acc1 = __builtin_amdgcn_mfma_f32_32x32x16_bf16(ah, bl1, acc1, 0, 0, 0); acc1 = __builtin_amdgcn_mfma_f32_32x32x16_bf16(al, bh1, acc1, 0, 0, 0); }
#pragma unroll
          for (int r = 0; r < 16; ++r) { part[(wv * 32 + crow(r, hi)) * 64 + r32] = acc0[r]; part[(wv * 32 + crow(r, hi)) * 64 + 32 + r32] = acc1[r]; } }
        __syncthreads();
        for (int i = 0; i < 4; ++i) { const int rbk = wv * 4 + i, row = row0 + rbk; float logit = 0.f;
#pragma unroll
          for (int w = 0; w < 8; ++w) logit += part[(w * 32 + rbk) * 64 + lane];
          const float score = 1.0f / (1.0f + expf(-logit)), bsd = score + rb[lane];
          const int g = lane >> 3;
          int rk = 0;
#pragma unroll
          for (int q = 0; q < 8; ++q) { const int o = (lane & ~7) + q; const float vv = __shfl(bsd, o); rk += (vv > bsd) || (vv == bsd && o < lane); }
          float gs = rk < 2 ? bsd : 0.f;
          gs += __shfl_xor(gs, 1); gs += __shfl_xor(gs, 2); gs += __shfl_xor(gs, 4);
          int grk = 0;
#pragma unroll
          for (int gg = 0; gg < 8; ++gg) { const float vv = __shfl(gs, gg * 8); grk += (vv > gs) || (vv == gs && gg < g); }
          const bool gsel = grk < 4;
          const float mb = gsel ? bsd : -INFINITY;
          int erk = 0;
          for (int o = 0; o < 64; ++o) { const float vv = __shfl(mb, o); erk += (vv > mb) || (vv == mb && o < lane); }
          const bool sel = gsel && erk < TOPK;
          const float ssum = wave_sum(sel ? score : 0.f);
          if (sel) { const int lp = __hip_atomic_fetch_add(lcnt + lane, 1, __ATOMIC_RELAXED, __HIP_MEMORY_SCOPE_WORKGROUP);
                     EIDX[row * TOPK + erk] = lane; EW[row * TOPK + erk] = score / ssum * 2.5f; lent[(nb * 32 + rbk) * TOPK + erk] = (lane << 16) | lp; } }
        __syncthreads();
    }
    if (F.tid < NE) { const int c = lcnt[F.tid]; lbase[F.tid] = c ? atomicAdd(&CNT[F.tid * 64], c) : 0; }
    __syncthreads();
    for (int i = F.tid; i < nb * 256; i += NTHREADS) { const int blk = F.vcu + (i >> 8) * F.G, row = blk * 32 + ((i >> 3) & 31), v = lent[i]; const int pos = lbase[v >> 16] + (v & 0xffff); EPOS[row * TOPK + (i & 7)] = pos; TOKE[(v >> 16) * NTOK + pos] = row; }
    __syncthreads();
}
__device__ __forceinline__ void y16(const unsigned char* p, float (&f)[16]) {
    const u32x4 w = *(const GAS u32x4*)p;
#pragma unroll
    for (int i = 0; i < 4; ++i) { const auto lo = __builtin_amdgcn_cvt_pk_f32_fp8((int)w[i], false), hi = __builtin_amdgcn_cvt_pk_f32_fp8((int)w[i], true); f[4 * i] = lo[0]; f[4 * i + 1] = lo[1]; f[4 * i + 2] = hi[0]; f[4 * i + 3] = hi[1]; }
}
__device__ __forceinline__ void ph_comb(Frame& F, const Args& args, const float* mod) {
    const int gw = F.vcu * NWAVES + F.wave, NGW = F.G * NWAVES, lane = F.lane;
    moe_tables(F, 4);
    LAS int* T = (LAS int*)(F.lds + SCHT_OFF);
    const float* EW = (const float*)(F.ws + WS_EW); const int* EIDX = (const int*)(F.ws + WS_EIDX); const int* EPOS = (const int*)(F.ws + WS_EPOS); const unsigned char* Y = (const unsigned char*)(F.ws + WS_YBIG);
    for (int t = gw; t < NTOK; t += NGW) {
        const float* g2 = mod + (t / SEQ) * MODC + 5 * DM;
        int sl[TOPK]; float wk[TOPK];
#pragma unroll
        for (int k = 0; k < TOPK; ++k) { sl[k] = T[80 + EIDX[t * TOPK + k]] + EPOS[t * TOPK + k]; wk[k] = EW[t * TOPK + k]; }
#pragma unroll
        for (int j = 0; j < 2; ++j) { const int col = j * 1024 + lane * 16;
            float a[16]; y16(Y + (size_t)(NSLOT + t) * DM + col, a);
#pragma unroll
            for (int k = 0; k < TOPK; ++k) { float y[16]; y16(Y + (size_t)sl[k] * DM + col, y);
#pragma unroll
                for (int c = 0; c < 16; ++c) a[c] += wk[k] * y[c]; }
            float* o = args.out + (size_t)t * DM + col; const float* xi = (const float*)(F.ws + WS_X2) + (size_t)t * DM + col;
#pragma unroll
            for (int n = 0; n < 4; ++n) { const f32x4 xv = *(const GAS f32x4*)(xi + 4 * n), gv = *(const GAS f32x4*)(g2 + col + 4 * n);
                *(GAS f32x4*)(o + 4 * n) = xv + gv * (f32x4){a[4 * n], a[4 * n + 1], a[4 * n + 2], a[4 * n + 3]}; } }
    }
}

enum { PH_PRO = 0, PH_NORM1, PH_INPROJ, PH_QKNORM, PH_ATTN, PH_F2, PH_MERGE, PH_OUT, PH_ROUTE, PH_EXP1, PH_EXP2, PH_COMB, PH_END };


__global__ void __launch_bounds__(NTHREADS, 2) fwd(Args args) {
    extern __shared__ __attribute__((aligned(16))) unsigned char lds_raw[];
    Frame F;
    F.lds = (LAS unsigned char*)lds_raw; F.MISC = (volatile LAS unsigned*)(F.lds + MISC_OFF); F.ws = args.ws;
    F.tid = threadIdx.x; F.lane = F.tid & 63; F.wave = __builtin_amdgcn_readfirstlane(F.tid >> 6);
    F.G = gridDim.x; { const int bx = blockIdx.x; F.vcu = (F.G % 8 == 0) ? (bx % 8) * (F.G / 8) + bx / 8 : bx; }
    for (int u = F.tid; u < (LDS_BYTES - LDSCTL_OFF) / 4; u += NTHREADS) ((LAS unsigned*)(F.lds + LDSCTL_OFF))[u] = 0u;
    __syncthreads();
    const int lo = args.ph_lo, hi = args.ph_hi;
    const bool multi = (hi - lo) > 1;
    unsigned* barw = (unsigned*)(args.ws + CTL_BAR) + args.bar_idx * XCD_BAR_WORDS;
    XcdBarrier bar; bar.bar = barw; bar.x = 0; bar.st = nullptr;
    if (multi) bar = xcd_barrier_post(barw, F.MISC + 8);
#define IN(k) (lo <= (k) && (k) < hi)
#define SEAM(k) do { if (IN((k) + 1)) xcd_barrier(bar); } while (0)

    const float* modp = (const float*)(args.ws + args.mod_off);
    if (IN(PH_PRO)) { p0_prologue(F, args); SEAM(PH_PRO); }
    if (IN(PH_NORM1)) { ph_norm1(F, args, modp); SEAM(PH_NORM1); }
    if (IN(PH_INPROJ)) {
        SchedIn S{F.G, (int)blockIdx.x, args.ws, args.use_ut};
        EpiIn E{EpiStore{(const float*)(args.ws + WS_W2048)}, (LAS float*)(F.lds + GPARK_OFF), args.in[8], args.in[9], (const float*)(args.ws + WS_ROPE)};
        gemm_phase<EpiIn, SchedIn, false>(F.lds, DM, DM, DM, S, E);
        SEAM(PH_INPROJ);
    }
    if (IN(PH_QKNORM)) { ph_evenodd(F, args); SEAM(PH_QKNORM); }
    if (IN(PH_ATTN)) {
        const int cs = F.vcu & 3;
        constexpr int NCONV = IT_EG + IT_EU + IT_ED;
        int qfirst, qcnt; { const int c = (int)blockIdx.x; if (F.G == 256) { qfirst = c < 136 ? c * 162 : 136 * 162 + (c - 136) * 226; qcnt = c < 136 ? 162 : 226; }
                             else { const int per = (NCONV + F.G - 1) / F.G; qfirst = c * per; qcnt = qfirst + per <= NCONV ? per : (NCONV - qfirst > 0 ? NCONV - qfirst : 0); } }
        const int gcnt = qfirst < IT_EG + IT_EU ? (qfirst + qcnt <= IT_EG + IT_EU ? qcnt : IT_EG + IT_EU - qfirst) : 0, gfirst = qfirst;
        const int ccnt = qcnt - gcnt, cfirst = qfirst + gcnt - (IT_EG + IT_EU);
#define CONV_ALL() do { conv_items(F, args, false, gfirst, gcnt); conv_items(F, args, true, cfirst, ccnt); } while (0)
        const bf16_t* Qp = (const bf16_t*)(args.ws + WS_Q); const bf16_t* Kp = (const bf16_t*)(args.ws + WS_KALL); const bf16_t* Vp = (const bf16_t*)(args.ws + WS_VALL); bf16_t* Op = (bf16_t*)(args.ws + WS_YA);
#define ATTN_UNIT(lin_) do { const int lin = (lin_); if (lin < 512) { const int x = (lin >> 5) & 7, j = (lin & 31) + 32 * (lin >> 8), b = x >> 2, kvh = x & 3, head = kvh * 4 + (j >> 4), qb = j & 15; \
            const size_t qo = ((size_t)(b * SEQ + qb * 256)) * DM + head * HD, ko = (size_t)b * SKV * KVW + kvh * HD; \
            attn::attn_dense_body(Qp + qo, Kp + ko, Vp + ko, Op + qo, SKV, (char*)lds_raw); __syncthreads(); } } while (0)
        if (cs == 0) { CONV_ALL(); __syncthreads(); }
        ATTN_UNIT(F.vcu);
        if (cs == 1) { CONV_ALL(); __syncthreads(); }
        ATTN_UNIT(F.vcu + F.G);
        for (int lin2 = F.vcu + 2 * F.G; lin2 < 512; lin2 += F.G) ATTN_UNIT(lin2);
        if (cs == 2) { CONV_ALL(); __syncthreads(); }
#undef ATTN_UNIT
        SchedAG S{F.G, (int)blockIdx.x, args.ws};
        gemm_phase<EpiStore, SchedAG, false>(F.lds, DM, DM, DM, S, EpiStore{(const float*)(args.ws + WS_W2048)});
        if (cs == 3) { __syncthreads(); CONV_ALL(); }
#undef CONV_ALL
        SEAM(PH_ATTN);
    }
    if (IN(PH_F2)) {
        SchedF2 S{F.G, (int)blockIdx.x, args.ws};
        gemm_phase<EpiStore, SchedF2, false>(F.lds, 512, DM, 512, S, EpiStore{(const float*)(args.ws + WS_W2048)});
        {
            const int idx = F.vcu * NTHREADS + F.tid;
            if (idx < 2 * FW) { const int b = idx >> 10, col = idx & 1023, k2 = col & 127; const float* al = (const float*)(args.ws + WS_ALT) + b * FW + (col & ~127); float s = 0.f;
                for (int c = 0; c < 128; ++c) s += al[c] * cospif((float)((c * k2) & 127) * (1.0f / 64.0f));
                ((bf16_t*)(args.ws + WS_YF))[((size_t)b * SEQ + SEQ / 2) * YFP + col] = f2bf(s * 0.0013810679320049757f); }
        }
        SEAM(PH_F2);
    }
    if (IN(PH_MERGE)) {
        unsigned char* ws = args.ws;
        SchedMerge S{F.G, (int)blockIdx.x, ws};
        gemm_phase<EpiMerge, SchedMerge, false>(F.lds, DM, DM, DM, S, EpiMerge{(const bf16_t*)(ws + WS_SGF), (const bf16_t*)(ws + WS_SGA), (bf16_t*)(ws + WS_YM)});
        SEAM(PH_MERGE);
    }
    if (IN(PH_OUT)) {
        unsigned char* ws = args.ws;
        SchedGrid S{F.G, (int)blockIdx.x, 32, 8, (const char*)(ws + WS_YM), (const char*)(ws + WS_WT_O), nullptr, (size_t)256 * DM * 2, (size_t)256 * DM * 2, DM, 4, 1, DM / BK};
        gemm_phase<EpiX2, SchedGrid, false>(F.lds, DM, DM, DM, S, EpiX2{args.in[0], modp, (float*)(ws + WS_X2)});
        SEAM(PH_OUT);
    }
    if (IN(PH_ROUTE)) { ph_route(F, args, modp); SEAM(PH_ROUTE); }
    if (IN(PH_EXP1)) {
        moe_tables(F, 4);
        SchedMoe<4, true> S{F.G, F.vcu, args.ws, (LAS int*)(F.lds + SCHT_OFF), (const int*)(args.ws + WS_TOKE)};
        gemm_phase<EpiAct, SchedMoe<4, true>, true, true>(F.lds, DM, DM / 2, DM / 2, S, EpiAct{});
        SEAM(PH_EXP1);
    }
    if (IN(PH_EXP2)) {
        moe_tables(F, 8);
        SchedMoe<8, false> S{F.G, F.vcu, args.ws, (LAS int*)(F.lds + SCHT_OFF), (const int*)(args.ws + WS_TOKE)};
        gemm_phase<EpiY8, SchedMoe<8, false>, false, true>(F.lds, EFF, EFF / 2, EFF / 2, S, EpiY8{});
        SEAM(PH_EXP2);
    }
    if (IN(PH_COMB)) { ph_comb(F, args, modp); }
#undef IN
#undef SEAM
}
}

extern "C" void kernel_launch(void* const* d_in, const int* in_sizes, int n_in, void* d_out, int out_size, void* d_ws, size_t ws_size, hipStream_t stream) {
    if (n_in != 22 || ws_size < WS_END2) return;
    float* out = (float*)d_out;
    unsigned char* ws = (unsigned char*)d_ws;
    hipMemsetAsync(ws + WS_CTL, 0, CTL_ZERO_BYTES, stream);
    static int grid = 0;
    if (!grid) {
        int dev = 0, cus = 0;
        if (hipGetDevice(&dev) != hipSuccess || hipDeviceGetAttribute(&cus, hipDeviceAttributeMultiprocessorCount, dev) != hipSuccess) { grid = -1; return; }
        if (hipFuncSetAttribute((const void*)mk::fwd, hipFuncAttributeMaxDynamicSharedMemorySize, mk::LDS_BYTES) != hipSuccess) { grid = -1; return; }
        grid = cus;
    }
    if (grid < 0) return;
    mk::Args a{}; int nlaunch = 0;
    for (int i = 0; i < 22; ++i) a.in[i] = (const float*)d_in[i];
    a.out = out; a.ws = ws; a.use_ut = 1; a.mod_off = (int)WS_MOD; a.do_attn = 1;
#define MK_LAUNCH(lo_, hi_) do { a.ph_lo = (lo_); a.ph_hi = (hi_); a.bar_idx = nlaunch++; hipLaunchKernelGGL(mk::fwd, dim3(grid), dim3(mk::NTHREADS), mk::LDS_BYTES, stream, a); } while (0)
    MK_LAUNCH(mk::PH_PRO, mk::PH_END);
}
```

```cpp
#include <hip/hip_runtime.h>
#include <stdint.h>
#include <math.h>

typedef unsigned short bf16_t;
typedef short bf16x8 __attribute__((ext_vector_type(8)));
typedef float f32x16 __attribute__((ext_vector_type(16)));
typedef float f32x4 __attribute__((ext_vector_type(4)));

constexpr int NB = 2, SEQ = 4096, DM = 2048, NTOK = NB * SEQ, CTXL = 256, NCTX = NB * CTXL, HD = 128, NH = 16, NKV = 4;
constexpr int SKV = SEQ + CTXL;
constexpr int FW = 1024, INC = 8192, Q_OFF = 1024, K_OFF = 3072, V_OFF = 3584, GF_OFF = 4096, GA_OFF = 6144;
constexpr int KVW = NKV * HD;
constexpr int NE = 64, TOPK = 8, EFF = 512, MODC = 6 * DM;
constexpr int NSLOT = NTOK * TOPK;
constexpr int NSLOT_ALL = NSLOT + NTOK;

constexpr size_t MiB = 1u << 20;
constexpr size_t WS_CTL = 0, CTL_ZERO_BYTES = 1 * MiB;
constexpr size_t CTL_CNT = 64 * 1024;
constexpr size_t WS_TW = 1 * MiB;
constexpr size_t WS_MOD = 1 * MiB + 64 * 1024;
constexpr size_t WS_OFFS = 1 * MiB + 256 * 1024;
constexpr size_t WS_EIDX = 2 * MiB;
constexpr size_t WS_EW = WS_EIDX + 256 * 1024;
constexpr size_t WS_EPOS = WS_EW + 256 * 1024;
constexpr size_t WS_SLOTOF = WS_EPOS + 256 * 1024;
constexpr size_t WS_TOKE = 300 * MiB;
constexpr size_t WS_H = 4 * MiB;
constexpr size_t WS_U = 38 * MiB;
constexpr size_t WS_Q = 54 * MiB;
constexpr size_t WS_KALL = 86 * MiB;
constexpr size_t WS_VALL = 95 * MiB;
constexpr size_t WS_SGF = 104 * MiB;
constexpr size_t WS_SGA = 136 * MiB;
constexpr size_t WS_YA = 168 * MiB;
constexpr size_t WS_YF = 38 * MiB;
constexpr int YFP = 2048;
constexpr size_t WS_PR = 216 * MiB;
constexpr size_t WS_T1 = 248 * MiB;
constexpr size_t WS_YM = 312 * MiB;
constexpr size_t WS_QKRAW = 248 * MiB;
constexpr size_t WS_KCRAW = 330 * MiB;
constexpr size_t WS_H2 = 344 * MiB;
constexpr size_t WS_ACT = 376 * MiB;
constexpr size_t WS_YBIG = 4 * MiB;
constexpr size_t WS_END = 740 * MiB;

__device__ __forceinline__ float bf2f(bf16_t h) { return __uint_as_float(((unsigned)h) << 16); }
__device__ __forceinline__ bf16_t f2bf(float f) { unsigned u = __float_as_uint(f); return (bf16_t)((u + 0x7fffu + ((u >> 16) & 1u)) >> 16); }
__device__ __forceinline__ int crow(int r, int hi) { return (r & 3) + 8 * (r >> 2) + 4 * hi; }
__device__ __forceinline__ float wave_sum(float v) {
#pragma unroll
    for (int o = 1; o < 64; o <<= 1) v += __shfl_xor(v, o);
    return v;
}
__device__ __forceinline__ float sigmoidf_(float v) { return 1.0f / (1.0f + expf(-v)); }
__device__ __forceinline__ bf16x8 pack8(const float* f) {
    bf16x8 r;
#pragma unroll
    for (int i = 0; i < 8; ++i) r[i] = (short)f2bf(f[i]);
    return r;
}

#define LAS __attribute__((address_space(3)))
#define GAS __attribute__((address_space(1)))
typedef unsigned u32x4 __attribute__((ext_vector_type(4)));
typedef GAS unsigned gu32;
#define RLX_AGENT __ATOMIC_RELAXED, __HIP_MEMORY_SCOPE_AGENT
#define LDS_WAIT() asm volatile("s_waitcnt lgkmcnt(0)" ::: "memory")
#define VM_WAIT() asm volatile("s_waitcnt vmcnt(0)" ::: "memory")

constexpr size_t CTL_BAR = 16384;
constexpr size_t CTL_MODZ = 512 * 1024;
constexpr size_t WS_UT = 38 * MiB;
constexpr size_t WS_TT = 216 * MiB;
constexpr size_t WS_WT_GU = 450 * MiB;
constexpr size_t WS_WT_D = 710 * MiB;
constexpr size_t WS_WT_IN = 840 * MiB;
constexpr size_t WS_WT_FO = 924 * MiB;
constexpr size_t WS_WT_AO = 876 * MiB;
constexpr size_t WS_WT_O = 884 * MiB;
constexpr size_t WS_CST = 892 * MiB;
constexpr size_t WS_ET = 908 * MiB;
constexpr size_t WS_OT = 916 * MiB;
constexpr size_t WS_W2048 = 1 * MiB + 512 * 1024;
constexpr size_t WS_ALT = 1 * MiB + 520 * 1024;
constexpr size_t WS_ROPE = 1 * MiB + 528 * 1024;
constexpr size_t WS_RWT = 3 * MiB + 512 * 1024;
constexpr size_t WS_BD2 = 956 * MiB;
constexpr size_t WS_X2 = 960 * MiB;
constexpr size_t WS_END2 = 1024 * MiB;

namespace mk {
constexpr int NWAVES = 8, NTHREADS = 512;
constexpr int RING_BYTES = 131072, SCR_BYTES = 8 * 16640, LDSCTL_OFF = 135168, MISC_OFF = LDSCTL_OFF + 320, GPARK_OFF = LDSCTL_OFF + 2048  , LDS_BYTES = 147456;
static_assert(GPARK_OFF + 8192 <= LDS_BYTES, "LDS map");
static_assert(SCR_BYTES <= LDSCTL_OFF && MISC_OFF + 128 <= LDS_BYTES, "LDS map");

#define XB_TMO      128
#define XB_XCNT(j)  (256  + 64 * (j))
#define XB_XSUB(j)  (1280 + 64 * (j))
#define XB_XGEN(j)  (2304 + 64 * (j))
#define XB_TOP      3328
#define XB_TOPGEN   3392
#define XCD_BAR_WORDS 3456
#define XB_SPIN_CAP (1u << 18)
__device__ __forceinline__ unsigned xb_ld(unsigned* p)              { return __hip_atomic_load(p, __ATOMIC_RELAXED, __HIP_MEMORY_SCOPE_AGENT); }
__device__ __forceinline__ unsigned xb_add(unsigned* p, unsigned v) { return __hip_atomic_fetch_add(p, v, __ATOMIC_RELAXED, __HIP_MEMORY_SCOPE_AGENT); }
__device__ __forceinline__ unsigned xb_xcc_id() { return (unsigned)__builtin_amdgcn_s_getreg((3 << 11) | 20) & 0xFu; }
#define XB_SPIN(cond, bar) do { unsigned _sp = 0; while (cond) { __builtin_amdgcn_s_sleep(1); \
    if ((++_sp & 255u) == 0u) { if (xb_ld(&(bar)[XB_TMO])) break; if (_sp > XB_SPIN_CAP) { atomicAdd(&(bar)[XB_TMO], 1u); break; } } } } while (0)
struct XcdBarrier { unsigned* bar; unsigned x; volatile LAS unsigned* st; };
__device__ __forceinline__ XcdBarrier xcd_barrier_post(unsigned* bar, volatile LAS unsigned* st) {
    XcdBarrier b; b.bar = bar; b.x = xb_xcc_id(); b.st = st;
    if (threadIdx.x == 0) (void)xb_add(&bar[XB_XCNT(b.x)], 1u);
    return b;
}
__device__ __forceinline__ void xcd_barrier_complete(unsigned* bar, unsigned x, unsigned& nloc, unsigned& nx) {
    const unsigned G = gridDim.x * gridDim.y * gridDim.z;
    unsigned sum, cnt, mine, sp = 0u;
    for (;;) {
        sum = 0u; cnt = 0u; mine = 0u;
#pragma unroll
        for (unsigned j = 0; j < 16; ++j) { const unsigned c = xb_ld(&bar[XB_XCNT(j)]); sum += c; cnt += (c > 0u) ? 1u : 0u; mine = (j == x) ? c : mine; }
        if (sum == G) break;
        __builtin_amdgcn_s_sleep(1);
        if ((++sp & 255u) == 0u) { if (xb_ld(&bar[XB_TMO])) break; if (sp > XB_SPIN_CAP) { atomicAdd(&bar[XB_TMO], 1u); break; } }
    }
    nloc = mine > 0u ? mine : 1u; nx = cnt > 0u ? cnt : 1u;
}
__device__ __forceinline__ void xcd_barrier(const XcdBarrier& b) {
    asm volatile("s_waitcnt vmcnt(0)" ::: "memory");
    __syncthreads();
    if (threadIdx.x == 0) {
        unsigned* bar = b.bar;
        __builtin_amdgcn_s_waitcnt(0);
        unsigned nloc = b.st[0], nx = b.st[1];
        if (nloc == 0u) { xcd_barrier_complete(bar, b.x, nloc, nx); b.st[0] = nloc; b.st[1] = nx; }
        const unsigned old = xb_add(&bar[XB_XSUB(b.x)], 1u);
        const unsigned gen = old / nloc;
        if (old + 1u == (gen + 1u) * nloc) {
            __builtin_amdgcn_fence(__ATOMIC_RELEASE, "agent");
            asm volatile("s_waitcnt vmcnt(0)" ::: "memory");
            const unsigned og = xb_add(&bar[XB_TOP], 1u);
            const unsigned tg = og / nx;
            if (og + 1u == (tg + 1u) * nx) xb_add(&bar[XB_TOPGEN], 1u);
            else XB_SPIN(xb_ld(&bar[XB_TOPGEN]) == tg, bar);
            __builtin_amdgcn_fence(__ATOMIC_ACQUIRE, "agent");
            xb_add(&bar[XB_XGEN(b.x)], 1u);
            asm volatile("s_waitcnt vmcnt(0)" ::: "memory");
        } else {
            XB_SPIN(xb_ld(&bar[XB_XGEN(b.x)]) == gen, bar);
            __builtin_amdgcn_fence(__ATOMIC_ACQUIRE, "agent");
            asm volatile("s_waitcnt vmcnt(0)" ::: "memory");
        }
    }
    __syncthreads();
}

constexpr int BM = 256, BK = 64, HALF = 128, HTB = HALF * BK * 2, STAGE_BYTES = 8 * HTB;
__device__ __forceinline__ int lds_byte(int r, int c) { const int st = (r >> 4) * 2 + (c >> 5), rr = r & 15, cc = c & 31, ob = rr * 64 + cc * 2; return st * 1024 + (ob ^ (((ob >> 9) & 1) << 5)); }
__device__ __forceinline__ void stage_rc(int b, int& R, int& C) { const int st = b / 1024, sb = b % 1024, swz = sb ^ (((sb >> 9) & 1) << 5); R = (st >> 1) * 16 + swz / 64; C = (st & 1) * 32 + (swz % 64) / 2; }
__device__ __forceinline__ int perm32(int rho) { const int n = rho >> 4, i = rho & 15; return 8 * (i >> 2) + 4 * n + (i & 3); }
__device__ __forceinline__ unsigned cvt_pk_bf16(float lo, float hi) { unsigned r; asm("v_cvt_pk_bf16_f32 %0, %1, %2" : "=v"(r) : "v"(lo), "v"(hi)); return r; }

__device__ __forceinline__ void glds16_s(const void* sbase, unsigned voff, unsigned lds_dst) { unsigned keep;
    asm volatile("s_mov_b32 %0, m0\n\ts_mov_b32 m0, %3\n\ts_nop 0\n\tglobal_load_lds_dwordx4 %1, %2\n\ts_mov_b32 m0, %0" : "=&s"(keep) : "v"(voff), "s"(sbase), "s"(lds_dst) : "memory"); }

struct Unit { const char* A; const char* B; char* C; int ldc; int mode; int rows; int aux; int pm, pn, bjs, rmin, e, nt, keep; };

typedef int i32x8 __attribute__((ext_vector_type(8)));
typedef int i32x4 __attribute__((ext_vector_type(4)));
template <class Epi, class Sched, bool GATHER, bool F8 = false>
__device__ __forceinline__ void gemm_phase(LAS unsigned char* lds, const int K, const int lda, const int ldb, const Sched& S, const Epi& E, const int i0 = 0, const int i1 = 0x7fffffff) {
    const int tid = threadIdx.x, wid = __builtin_amdgcn_readfirstlane(tid >> 6), lane = tid & 63, wr = wid >> 2, wc = wid & 3, fr = lane & 15, fq = lane >> 4;
    unsigned voffA[2], voffB[2];
#pragma unroll
    for (int i = 0; i < 2; ++i) { int R, C; stage_rc(tid * 16 + i * 8192, R, C); const int Rb = (R & ~31) + perm32(R & 31);
        voffA[i] = (unsigned)(R * lda + C) * 2u; voffB[i] = (unsigned)(Rb * ldb + C) * 2u; }
    const size_t kstep = (size_t)(BK * 2);
    const size_t hstepA = (size_t)HALF * lda * 2, hstepB = (size_t)HALF * ldb * 2;
    const unsigned ldsw = (unsigned)wid * 1024u;
    const unsigned ldsbase = (unsigned)__builtin_amdgcn_readfirstlane((int)(unsigned)(uintptr_t)lds);
    const int aoff = F8 ? lds_byte(wr * 64 + fr, (fq >> 1) * 32 + (fq & 1) * 16) : lds_byte(wr * 64 + fr, fq * 8), boff = F8 ? lds_byte(wc * 32 + fr, (fq >> 1) * 32 + (fq & 1) * 16) : lds_byte(wc * 32 + fr, fq * 8);

#define MK_SA(b, h) (((b) * 2 + (h)) * HTB)
#define MK_SB(b, h) ((4 + (b) * 2 + (h)) * HTB)
#define MK_STAGE2(bufoff, gbase, v0, v1) do { \
        __builtin_amdgcn_global_load_lds((const unsigned*)((const char*)(gbase) + (v0)), (LAS unsigned*)(lds + (bufoff) + ldsw), 16, 0, 0); \
        __builtin_amdgcn_global_load_lds((const unsigned*)((const char*)(gbase) + (v1)), (LAS unsigned*)(lds + (bufoff) + ldsw + 8192), 16, 0, 0); } while (0)
#define MK_STAGE_B(bufoff, gbase) do { glds16_s((gbase), voffB[0], ldsbase + (bufoff) + ldsw); glds16_s((gbase), voffB[1], ldsbase + (bufoff) + ldsw + 8192u); } while (0)
#define MK_STAGE_A(bufoff, gbase, h, VA) do { if constexpr (GATHER) { glds16_s((gbase), (VA)[h][0], ldsbase + (bufoff) + ldsw); glds16_s((gbase), (VA)[h][1], ldsbase + (bufoff) + ldsw + 8192u); } \
        else { glds16_s((gbase) + (h) * hstepA, voffA[0], ldsbase + (bufoff) + ldsw); glds16_s((gbase) + (h) * hstepA, voffA[1], ldsbase + (bufoff) + ldsw + 8192u); } } while (0)
#define MK_LDA(dst, b, h) do { if constexpr (F8) { _Pragma("unroll") for (int m = 0; m < 4; ++m) dst##8[m] = *(const LAS i32x8*)(lds + MK_SA(b, h) + aoff + m * 2048); } \
        else { _Pragma("unroll") for (int m = 0; m < 4; ++m) _Pragma("unroll") for (int k = 0; k < 2; ++k) dst[m][k] = *(const LAS bf16x8*)(lds + MK_SA(b, h) + aoff + m * 2048 + k * 1024); } } while (0)
#define MK_LDB(dst, b, h) do { if constexpr (F8) { _Pragma("unroll") for (int n = 0; n < 2; ++n) dst##8[n] = *(const LAS i32x8*)(lds + MK_SB(b, h) + boff + n * 2048); } \
        else { _Pragma("unroll") for (int n = 0; n < 2; ++n) _Pragma("unroll") for (int k = 0; k < 2; ++k) dst[n][k] = *(const LAS bf16x8*)(lds + MK_SB(b, h) + boff + n * 2048 + k * 1024); } } while (0)
#define MK_MMA(ai, bj, At, Bt) do { __builtin_amdgcn_s_setprio(1); \
        if constexpr (F8) { _Pragma("unroll") for (int m = 0; m < 4; ++m) _Pragma("unroll") for (int n = 0; n < 2; ++n) \
            acc[ai][bj][m][n] = __builtin_amdgcn_mfma_scale_f32_16x16x128_f8f6f4(Bt##8[n], At##8[m], acc[ai][bj][m][n], 0, 0, 0, 0x7d, 0, 0x7d  ); } \
        else { _Pragma("unroll") for (int m = 0; m < 4; ++m) _Pragma("unroll") for (int n = 0; n < 2; ++n) _Pragma("unroll") for (int k = 0; k < 2; ++k) \
            acc[ai][bj][m][n] = __builtin_amdgcn_mfma_f32_16x16x32_bf16(Bt[n][k], At[m][k], acc[ai][bj][m][n], 0, 0, 0); } \
        __builtin_amdgcn_s_setprio(0); } while (0)
#define MK_WAIT_V(n) asm volatile("s_waitcnt vmcnt(" #n ")" ::: "memory")
#define MK_WAIT_L(n) asm volatile("s_waitcnt lgkmcnt(" #n ")" ::: "memory")
#define MK_BAR __builtin_amdgcn_s_barrier()
#define MK_SCHED __builtin_amdgcn_sched_barrier(0)
    Unit cur, nxt; int ui = i0;
    if (i0 >= i1 || !S.next(i0, cur)) return;
    f32x4 acc[2][2][4][2];
#pragma unroll
    for (int a = 0; a < 2; ++a)
#pragma unroll
        for (int b = 0; b < 2; ++b)
#pragma unroll
            for (int m = 0; m < 4; ++m)
#pragma unroll
                for (int n = 0; n < 2; ++n) acc[a][b][m][n] = (f32x4){0.f, 0.f, 0.f, 0.f};
    bf16x8 At[4][2], B0[2][2], B1[2][2]; i32x8 At8[4], B08[2], B18[2];
    unsigned vC[2][2];
    LAS u32x4* vpark = (LAS u32x4*)(lds + GPARK_OFF) + tid;
    if constexpr (GATHER) {
#pragma unroll
        for (int h = 0; h < 2; ++h)
#pragma unroll
            for (int i = 0; i < 2; ++i) { int R, C; stage_rc(tid * 16 + i * 8192, R, C); vC[h][i] = S.arow(cur, h * HALF + R) + (unsigned)(C * 2); }
    }
    const char* cA = cur.A; const char* cB = cur.B;
    MK_STAGE_B(MK_SB(0, 0), cB); MK_STAGE_B(MK_SB(0, 1), cB + hstepB); MK_STAGE_A(MK_SA(0, 0), cA, 0, vC); MK_STAGE_A(MK_SA(0, 1), cA, 1, vC);
    if (wr == 1) MK_BAR;
    MK_WAIT_V(2); MK_BAR;
    MK_STAGE_B(MK_SB(1, 0), cB + kstep); MK_STAGE_A(MK_SA(1, 0), cA + kstep, 0, vC); MK_STAGE_B(MK_SB(1, 1), cB + hstepB + kstep);
    MK_WAIT_V(6); MK_BAR;
    for (;;) {
        const bool has_next = (ui + 1 < i1) && S.next(ui + 1, nxt);
        const char* nA = has_next ? nxt.A : cA; const char* nB = has_next ? nxt.B : cB;
        if constexpr (GATHER) {
            u32x4 pv;
#pragma unroll
            for (int h = 0; h < 2; ++h)
#pragma unroll
                for (int i = 0; i < 2; ++i) { int R, C; stage_rc(tid * 16 + i * 8192, R, C); pv[h * 2 + i] = has_next ? (S.arow(nxt, h * HALF + R) + (unsigned)(C * 2)) : vC[h][i]; }
            *vpark = pv;
        }
        int nt = cur.nt; asm volatile("" : "+s"(nt));
#pragma nounroll
        for (int t = 0; t < nt; t += 2) {
            const bool last = (t == nt - 2);
            const char* a1 = cA + (size_t)(t + 1) * kstep;
            const char* a2 = last ? nA : cA + (size_t)(t + 2) * kstep; const char* b2 = last ? nB : cB + (size_t)(t + 2) * kstep;
            const char* a3 = a2 + kstep; const char* b3 = b2 + kstep;
            MK_LDB(B0, 0, 0); MK_LDB(B1, 0, 1); MK_SCHED; MK_LDA(At, 0, 0); MK_STAGE_A(MK_SA(1, 1), a1, 1, vC);
            if constexpr (GATHER) { if (last) { const u32x4 pv = *vpark; vC[0][0] = pv[0]; vC[0][1] = pv[1]; vC[1][0] = pv[2]; vC[1][1] = pv[3]; } }
            MK_WAIT_V(8); MK_WAIT_L(0); MK_BAR; MK_MMA(0, 0, At, B0); MK_MMA(0, 1, At, B1); MK_BAR; MK_SCHED;
            MK_LDA(At, 0, 1); MK_STAGE_B(MK_SB(0, 0), b2); MK_STAGE_B(MK_SB(0, 1), b2 + hstepB); MK_STAGE_A(MK_SA(0, 0), a2, 0, vC);
            MK_WAIT_V(8); MK_WAIT_L(0); MK_BAR; MK_MMA(1, 0, At, B0); MK_MMA(1, 1, At, B1); MK_BAR; MK_SCHED;
            MK_LDB(B0, 1, 0); MK_LDB(B1, 1, 1); MK_SCHED; MK_LDA(At, 1, 0); MK_STAGE_A(MK_SA(0, 1), a2, 1, vC);
            MK_WAIT_V(8); MK_WAIT_L(0); MK_BAR; MK_MMA(0, 0, At, B0); MK_MMA(0, 1, At, B1); MK_BAR; MK_SCHED;
            MK_LDA(At, 1, 1); MK_STAGE_B(MK_SB(1, 0), b3); MK_STAGE_B(MK_SB(1, 1), b3 + hstepB); MK_STAGE_A(MK_SA(1, 0), a3, 0, vC);
            MK_WAIT_V(8); MK_WAIT_L(0); MK_BAR; MK_MMA(1, 0, At, B0); MK_MMA(1, 1, At, B1); MK_BAR; MK_SCHED;
        }
        if (wr == 0) MK_BAR;
        { int l2; asm volatile("v_mbcnt_lo_u32_b32 %0, -1, 0\n\tv_mbcnt_hi_u32_b32 %0, -1, %0" : "=v"(l2));
          E(acc, cur, wr, wc, l2 & 15, l2 >> 4); }
        if (!has_next) break;
        if (!cur.keep)
#pragma unroll
        for (int a = 0; a < 2; ++a)
#pragma unroll
            for (int b = 0; b < 2; ++b)
#pragma unroll
                for (int m = 0; m < 4; ++m)
#pragma unroll
                    for (int n = 0; n < 2; ++n) acc[a][b][m][n] = (f32x4){0.f, 0.f, 0.f, 0.f};
        cur = nxt; cA = nA; cB = nB; ++ui;
        if (wr == 1) MK_BAR;
    }
    MK_WAIT_V(0);
    MK_BAR;
#undef MK_SA
#undef MK_SB
#undef MK_STAGE2
#undef MK_STAGE_B
#undef MK_STAGE_A
#undef MK_LDA
#undef MK_LDB
#undef MK_MMA
#undef MK_WAIT_V
#undef MK_WAIT_L
#undef MK_BAR
#undef MK_SCHED
}

__device__ __forceinline__ void grid_map(int L, int nM, int nN, int& pm, int& pn) {
    const int nwg = nM * nN, q = nwg / 8, xcd = L % 8, off = L / 8; const int wgid = xcd * q + off;
    const int nig = 8 * nN, gid = wgid / nig, fm = gid * 8, gsz = (nM - fm) < 8 ? (nM - fm) : 8;
    pm = fm + ((wgid % nig) % gsz); pn = (wgid % nig) / gsz;
}

struct EpiStore {
    const float* w2048;
    __device__ __forceinline__ void operator()(f32x4 (&acc)[2][2][4][2], const Unit& u, int wr, int wc, int fr, int fq) const {
        const int col0 = wc * 32 + 8 * fq;
#pragma unroll
        for (int ai = 0; ai < 2; ++ai)
#pragma unroll
            for (int m = 0; m < 4; ++m) {
                const int r = ai * HALF + wr * 64 + m * 16 + fr;
                if (r < u.rows && r >= u.rmin) {
#pragma unroll
                    for (int bj = 0; bj < 2; ++bj) {
                        f32x4 v0 = acc[ai][bj][m][0], v1 = acc[ai][bj][m][1];
                        if (u.mode == 1) { float* p = (float*)u.C + (long)r * u.ldc + col0 + bj * u.bjs; *(f32x4*)p = v0; *(f32x4*)(p + 4) = v1; }
                        else {
                            if (u.mode == 2) {
#pragma unroll
                                for (int c = 0; c < 4; ++c) { v0[c] = __builtin_amdgcn_rcpf(1.0f + __expf(-v0[c])); v1[c] = __builtin_amdgcn_rcpf(1.0f + __expf(-v1[c])); }
                            } else if (u.mode == 3) {
                                const float* wp = w2048 + u.pn + bj * HALF + col0; const float sg = (r & 1) ? -1.0f : 1.0f;
                                v0 += *(const f32x4*)wp * sg; v1 += *(const f32x4*)(wp + 4) * sg;
                            }
                            u32x4 w; w.x = cvt_pk_bf16(v0[0], v0[1]); w.y = cvt_pk_bf16(v0[2], v0[3]); w.z = cvt_pk_bf16(v1[0], v1[1]); w.w = cvt_pk_bf16(v1[2], v1[3]);
                            *(u32x4*)((bf16_t*)u.C + (long)r * u.ldc + col0 + bj * u.bjs) = w;
                        }
                    }
                }
            }
    }
};


struct EpiIn { EpiStore base; LAS float* red; const float* qnw; const float* knw; const float* rope;
    __device__ __forceinline__ void operator()(f32x4 (&acc)[2][2][4][2], const Unit& u, int wr, int wc, int fr, int fq) const {
        if (u.mode < 5) { base(acc, u, wr, wc, fr, fq); return; }
#pragma unroll
        for (int ai = 0; ai < 2; ++ai)
#pragma unroll
            for (int m = 0; m < 4; ++m)
#pragma unroll
                for (int bj = 0; bj < 2; ++bj) { const f32x4 a = acc[ai][bj][m][0], b = acc[ai][bj][m][1];
                    float s = (a[0] * a[0] + a[1] * a[1]) + (a[2] * a[2] + a[3] * a[3]) + (b[0] * b[0] + b[1] * b[1]) + (b[2] * b[2] + b[3] * b[3]);
                    s += __shfl_xor(s, 16); s += __shfl_xor(s, 32);
                    if (fq == 0) red[((ai * HALF + wr * 64 + m * 16 + fr) * 2 + bj) * 4 + wc] = s; }
        asm volatile("s_waitcnt lgkmcnt(0)" ::: "memory"); __builtin_amdgcn_s_barrier(); asm volatile("" ::: "memory");
        const float* nw = u.mode == 5 ? qnw : knw;
        const int axis = wc >> 1, f0 = (wc & 1) * 16 + fq * 4, da = axis * 64 + f0;
        const f32x4 wa = *(const f32x4*)(nw + da), wb = *(const f32x4*)(nw + da + 32);
#pragma unroll
        for (int ai = 0; ai < 2; ++ai)
#pragma unroll
            for (int m = 0; m < 4; ++m) { const int r = ai * HALF + wr * 64 + m * 16 + fr;
                f32x4 cs = {1.f, 1.f, 1.f, 1.f}, sn = {0.f, 0.f, 0.f, 0.f};
                if (u.mode != 7) { const int t = u.pm + r, pos = axis ? (t & 63) : (t >> 6); const float* rp = rope + (pos * 32 + f0) * 2;
                    const f32x4 p0 = *(const f32x4*)rp, p1 = *(const f32x4*)(rp + 4); cs = (f32x4){p0[0], p0[2], p1[0], p1[2]}; sn = (f32x4){p0[1], p0[3], p1[1], p1[3]}; }
#pragma unroll
                for (int bj = 0; bj < 2; ++bj) { const LAS f32x4* pp = (const LAS f32x4*)(red + (r * 2 + bj) * 4); const f32x4 ps = *pp;
                    const float rstd = 1.0f / sqrtf(((ps[0] + ps[1]) + (ps[2] + ps[3])) * (1.0f / HD) + 1e-6f);
                    const f32x4 xa = acc[ai][bj][m][0] * rstd * wa, xb = acc[ai][bj][m][1] * rstd * wb;
                    const f32x4 oa = xa * cs - xb * sn, ob = xb * cs + xa * sn;
                    u32x4 w; w.x = cvt_pk_bf16(oa[0], oa[1]); w.y = cvt_pk_bf16(oa[2], oa[3]); w.z = cvt_pk_bf16(ob[0], ob[1]); w.w = cvt_pk_bf16(ob[2], ob[3]);
                    *(u32x4*)((bf16_t*)u.C + (long)r * u.ldc + bj * HALF + wc * 32 + 8 * fq) = w; } }
    } };


__device__ __forceinline__ void pack8_fp8(const f32x4& a, const f32x4& b, unsigned& w0, unsigned& w1) {
    f32x4 v0 = a, v1 = b;
#pragma unroll
    for (int c = 0; c < 4; ++c) { v0[c] = fminf(fmaxf(v0[c], -448.f), 448.f); v1[c] = fminf(fmaxf(v1[c], -448.f), 448.f); }
    int x0 = 0, x1 = 0;
    x0 = __builtin_amdgcn_cvt_pk_fp8_f32(v0[0], v0[1], x0, false); x0 = __builtin_amdgcn_cvt_pk_fp8_f32(v0[2], v0[3], x0, true);
    x1 = __builtin_amdgcn_cvt_pk_fp8_f32(v1[0], v1[1], x1, false); x1 = __builtin_amdgcn_cvt_pk_fp8_f32(v1[2], v1[3], x1, true);
    w0 = (unsigned)x0; w1 = (unsigned)x1;
}
struct EpiY8 {
    __device__ __forceinline__ void operator()(f32x4 (&acc)[2][2][4][2], const Unit& u, int wr, int wc, int fr, int fq) const {
        const int odd = fq & 1;
        unsigned char* base = (unsigned char*)u.C + (size_t)(wr * 64 + fr) * u.ldc + odd * HALF + wc * 32 + 8 * (fq - odd);
        const int r0 = wr * 64 + fr;
#pragma unroll
        for (int ai = 0; ai < 2; ++ai)
#pragma unroll
            for (int m = 0; m < 4; ++m) {
                unsigned a0, a1, b0, b1; pack8_fp8(acc[ai][0][m][0], acc[ai][0][m][1], a0, a1); pack8_fp8(acc[ai][1][m][0], acc[ai][1][m][1], b0, b1);
                const auto s0 = __builtin_amdgcn_permlane16_swap(a0, b0, false, false), s1 = __builtin_amdgcn_permlane16_swap(a1, b1, false, false);
                if (r0 + ai * HALF + m * 16 < u.rows) { const u32x4 w = {s0[0], s1[0], s0[1], s1[1]}; *(u32x4*)(base + (size_t)(ai * HALF + m * 16) * u.ldc) = w; } }
    } };

struct Args { const float* in[22]; float* out; unsigned char* ws; int ph_lo, ph_hi, use_ut, mod_off, do_attn, bar_idx; };
struct Frame {
    LAS unsigned char* lds; volatile LAS unsigned* MISC; unsigned char* ws;
    int tid, lane, wave, vcu, G;
};

__device__ __forceinline__ int qk_col_of_dim(int d) { const int a = d >> 6, half = (d >> 5) & 1, f = d & 31; return 32 * (2 * a + (f >> 4)) + 8 * ((f >> 2) & 3) + 4 * half + (f & 3); }
__device__ __forceinline__ void t64_load(f32x4 (&v)[16], const float* W, int ldw, int lane) {
    const unsigned off = (unsigned)(((lane >> 4) * ldw + (lane & 15) * 4) * 4);
#pragma unroll
    for (int j = 0; j < 16; ++j) { const char* bj = (const char*)W + (size_t)(j * 4) * ldw * 4; v[j] = __builtin_nontemporal_load((const GAS f32x4*)(bj + off)); }
}
template <bool QKPERM = false, bool F8OUT = false>
__device__ __forceinline__ void t64_store(const f32x4 (&v)[16], bf16_t* dst, int ldd, LAS float* scr, int lane, int d0 = 0) {
    const int kk = lane >> 4, nc = (lane & 15) * 4;
#pragma unroll
    for (int j = 0; j < 16; ++j) {
#pragma unroll
        for (int c = 0; c < 4; ++c) scr[(j * 4 + kk) * 65 + nc + c] = v[j][c]; }
    LDS_WAIT(); asm volatile("" ::: "memory");
    const int kc = lane & 7; const unsigned soff = F8OUT ? (unsigned)((lane >> 3) * ldd + 8 * kc) : (unsigned)(((lane >> 3) * ldd + 8 * kc) * 2);
#pragma unroll
    for (int jj = 0; jj < 8; jj += 2) {
        float t[2][8];
#pragma unroll
        for (int q = 0; q < 2; ++q) { const int n = (lane >> 3) + 8 * (jj + q); const LAS float* s = scr + (8 * kc) * 65 + n;
#pragma unroll
            for (int i = 0; i < 8; ++i) t[q][i] = s[i * 65]; }
#pragma unroll
        for (int q = 0; q < 2; ++q) { char* bq = (char*)dst + (size_t)(8 * (jj + q)) * ldd * (F8OUT ? 1 : 2);
            if constexpr (QKPERM) bq = (char*)dst + (size_t)(qk_col_of_dim(d0 + (lane >> 3) + 8 * (jj + q)) - (lane >> 3)) * ldd * 2;
            if constexpr (F8OUT) { float s[8];
#pragma unroll
                for (int i = 0; i < 8; ++i) s[i] = fminf(fmaxf(t[q][i] * 16.0f, -448.f), 448.f);
                int w0 = 0, w1 = 0; w0 = __builtin_amdgcn_cvt_pk_fp8_f32(s[0], s[1], w0, false); w0 = __builtin_amdgcn_cvt_pk_fp8_f32(s[2], s[3], w0, true);
                w1 = __builtin_amdgcn_cvt_pk_fp8_f32(s[4], s[5], w1, false); w1 = __builtin_amdgcn_cvt_pk_fp8_f32(s[6], s[7], w1, true);
                __builtin_nontemporal_store((unsigned long long)(unsigned)w0 | ((unsigned long long)(unsigned)w1 << 32), (GAS unsigned long long*)(bq + soff)); }
            else { u32x4 o; o.x = cvt_pk_bf16(t[q][0], t[q][1]); o.y = cvt_pk_bf16(t[q][2], t[q][3]); o.z = cvt_pk_bf16(t[q][4], t[q][5]); o.w = cvt_pk_bf16(t[q][6], t[q][7]);
                __builtin_nontemporal_store(o, (GAS u32x4*)(bq + soff)); } } }
    LDS_WAIT(); asm volatile("" ::: "memory");
}
__device__ __forceinline__ void transpose64(const float* W, int ldw, bf16_t* dst, int ldd, LAS float* scr, int lane) {
    f32x4 v[16]; t64_load(v, W, ldw, lane); t64_store(v, dst, ldd, scr, lane);
}

constexpr int IT_IN = 32 * 128, IT_FO = 16 * 32, IT_AO = 32 * 32, IT_O = 32 * 32, IT_EG = 64 * 256, IT_EU = 64 * 256, IT_ED = 64 * 256, IT_SH = 256;
constexpr int IT_T_END = IT_IN + IT_FO + IT_AO + IT_O + 3 * IT_SH;
constexpr int IT_MOD = MODC / 32, IT_CST = 4096, IT_BD2 = 512, IT_RWT = 32, IT_ROPE = 1;
constexpr int IT_ALL = IT_T_END + IT_MOD + IT_CST + IT_BD2 + IT_RWT + IT_ROPE;

__device__ __forceinline__ void mod_item(const Args& args, unsigned char* ws, int r, int lane) {
            const int kq = lane >> 3, col = r * 32 + (lane & 7) * 4;
            f32x4 a0 = {0.f, 0.f, 0.f, 0.f}, a1 = a0, a2 = a0;
            for (int jb = 0; jb < 256; jb += 8) {
                f32x4 w[8]; float c0[8], c1[8], c2[8];
#pragma unroll
                for (int j = 0; j < 8; ++j) { const int k = kq + 8 * (jb + j); w[j] = *(const GAS f32x4*)(args.in[4] + (size_t)k * MODC + col); c0[j] = args.in[1][k]; c1[j] = args.in[1][DM + k]; c2[j] = args.in[3][k]; }
#pragma unroll
                for (int j = 0; j < 8; ++j) { a0 += w[j] * (c0[j] * __builtin_amdgcn_rcpf(1.0f + __expf(-c0[j]))); a1 += w[j] * (c1[j] * __builtin_amdgcn_rcpf(1.0f + __expf(-c1[j]))); a2 += w[j] * (c2[j] * __builtin_amdgcn_rcpf(1.0f + __expf(-c2[j]))); }
            }
#pragma unroll
            for (int c = 0; c < 4; ++c) {
#pragma unroll
                for (int o = 8; o < 64; o <<= 1) { a0[c] += __shfl_xor(a0[c], o); a1[c] += __shfl_xor(a1[c], o); a2[c] += __shfl_xor(a2[c], o); } }
            if (kq == 0) { const f32x4 bb = *(const GAS f32x4*)(args.in[5] + col); float* MODP = (float*)(ws + WS_MOD);
                *(GAS f32x4*)(MODP + col) = a0 + bb; *(GAS f32x4*)(MODP + MODC + col) = a1 + bb; *(GAS f32x4*)(MODP + 2 * MODC + col) = a2 + bb; }
}
__device__ __forceinline__ void p0_prologue(Frame& F, const Args& args) {
    LAS float* scr = (LAS float*)(F.lds + F.wave * 16640);
    const int gw = F.vcu * NWAVES + F.wave, NGW = F.G * NWAVES, lane = F.lane;
    unsigned char* ws = F.ws;
    bf16_t* WT_IN = (bf16_t*)(ws + WS_WT_IN); bf16_t* WT_FO = (bf16_t*)(ws + WS_WT_FO); bf16_t* WT_AO = (bf16_t*)(ws + WS_WT_AO); bf16_t* WT_O = (bf16_t*)(ws + WS_WT_O);
    bf16_t* WT_GU = (bf16_t*)(ws + WS_WT_GU); bf16_t* WT_D = (bf16_t*)(ws + WS_WT_D);
    if (NGW >= 5 * IT_MOD) { if (gw % 5 == 0 && gw / 5 < IT_MOD) mod_item(args, ws, gw / 5, lane); }
    else for (int m = gw; m < IT_MOD; m += NGW) mod_item(args, ws, m, lane);
    for (int it = gw; it < IT_ALL - IT_MOD; it += NGW) {
        int r = it;
        if (r < IT_IN) { const int kb = r / 128, nb = r % 128, n0 = nb * 64;
            if (n0 >= Q_OFF && n0 < V_OFF) { f32x4 v[16]; t64_load(v, args.in[7] + (size_t)(kb * 64) * INC + n0, INC, lane);
                t64_store<true>(v, WT_IN + (size_t)(n0 & ~127) * DM + kb * 64, DM, scr, lane, n0 & 127); }
            else transpose64(args.in[7] + (size_t)(kb * 64) * INC + n0, INC, WT_IN + (size_t)n0 * DM + kb * 64, DM, scr, lane);
            continue; } r -= IT_IN;
        if (r < IT_FO) { const int kb = r / 32, nb = r % 32; transpose64(args.in[10] + (size_t)(kb * 64) * DM + nb * 64, DM, WT_FO + (size_t)(nb * 64) * YFP + kb * 64, YFP, scr, lane); continue; } r -= IT_FO;
        if (r < IT_AO) { const int kb = r / 32, nb = r % 32; transpose64(args.in[11] + (size_t)(kb * 64) * DM + nb * 64, DM, WT_AO + (size_t)(nb * 64) * DM + kb * 64, DM, scr, lane); continue; } r -= IT_AO;
        if (r < IT_O) { const int kb = r / 32, nb = r % 32; transpose64(args.in[12] + (size_t)(kb * 64) * DM + nb * 64, DM, WT_O + (size_t)(nb * 64) * DM + kb * 64, DM, scr, lane); continue; } r -= IT_O;
        if (r < 2 * IT_SH) { const int up = r >= IT_SH; if (up) r -= IT_SH; const int kb = r / 8, nb = r % 8, n0 = nb * 64;
            { f32x4 v[16]; t64_load(v, (up ? args.in[20] : args.in[19]) + (size_t)(kb * 64) * EFF + n0, EFF, lane);
              t64_store<false, true>(v, (bf16_t*)((unsigned char*)WT_GU + ((size_t)64 * 1024 + (n0 >> 7) * 256 + (up ? 128 : 0) + (n0 & 127)) * DM + kb * 64), DM, scr, lane); } continue; } r -= 2 * IT_SH;
        if (r < IT_SH) { const int kb = r / 32, nb = r % 32;
            { f32x4 v[16]; t64_load(v, args.in[21] + (size_t)(kb * 64) * DM + nb * 64, DM, lane); t64_store<false, true>(v, (bf16_t*)((unsigned char*)WT_D + ((size_t)64 * DM + nb * 64) * EFF + kb * 64), EFF, scr, lane); } continue; } r -= IT_SH;

        if (r < IT_CST) {
            const int k1 = r & 2047; bf16_t* dst = (bf16_t*)(ws + WS_CST) + (size_t)r * 2048;
#pragma unroll
            for (int j = 0; j < 4; ++j) { const int n0 = j * 512 + lane * 8; float f[8];
#pragma unroll
                for (int i = 0; i < 8; ++i) { const float ph = (float)((k1 * (n0 + i)) & 4095) * (1.0f / 2048.0f); f[i] = r < 2048 ? cospif(ph) : sinpif(ph); }
                u32x4 o; o.x = cvt_pk_bf16(f[0], f[1]); o.y = cvt_pk_bf16(f[2], f[3]); o.z = cvt_pk_bf16(f[4], f[5]); o.w = cvt_pk_bf16(f[6], f[7]);
                *(GAS u32x4*)(dst + n0) = o; }
            continue; } r -= IT_CST;
        if (r < IT_BD2) {
            const int t = r >> 8, o = r & 255, gp = o >> 7, k2 = o & 127; bf16_t* dst = (bf16_t*)(ws + WS_BD2) + (size_t)r * 512; float f[8];
#pragma unroll
            for (int i = 0; i < 8; ++i) { const int j = lane * 8 + i, cg = j >> 8, jj = j & 255, c = jj & 127; const float ph = (float)((32 * c * k2) & 4095) * (1.0f / 2048.0f);
                const float v = jj < 128 ? cospif(ph) : (t ? sinpif(ph) : -sinpif(ph)); f[i] = cg == gp ? v * 0.0013810679320049757f : 0.f; }
            u32x4 w; w.x = cvt_pk_bf16(f[0], f[1]); w.y = cvt_pk_bf16(f[2], f[3]); w.z = cvt_pk_bf16(f[4], f[5]); w.w = cvt_pk_bf16(f[6], f[7]);
            *(GAS u32x4*)(dst + lane * 8) = w;
            continue; } r -= IT_BD2;
        if (r >= IT_RWT) {
            float* RT = (float*)(ws + WS_ROPE);
            for (int idx = lane; idx < 64 * 32; idx += 64) { const float ang = (float)(idx >> 5) * exp2f(-(float)(idx & 31) * (13.287712379549449f / 32.0f)); RT[2 * idx] = cosf(ang); RT[2 * idx + 1] = sinf(ang); }
            continue; }
        {
            f32x4 v[16]; t64_load(v, args.in[14] + (size_t)(r * 64) * NE, NE, lane);
            const int kk = lane >> 4, nc = (lane & 15) * 4;
#pragma unroll
            for (int j = 0; j < 16; ++j) {
#pragma unroll
                for (int c = 0; c < 4; ++c) scr[(j * 4 + kk) * 65 + nc + c] = v[j][c]; }
            LDS_WAIT(); asm volatile("" ::: "memory");
            const int kc = lane & 7; bf16_t* RWT = (bf16_t*)(ws + WS_RWT);
#pragma unroll
            for (int jj = 0; jj < 8; ++jj) { const int e = (lane >> 3) + 8 * jj; const LAS float* s = scr + (8 * kc) * 65 + e; float t[8], l[8];
#pragma unroll
                for (int i = 0; i < 8; ++i) { t[i] = s[i * 65]; l[i] = t[i] - bf2f(f2bf(t[i])); }
                u32x4 h, lo; h.x = cvt_pk_bf16(t[0], t[1]); h.y = cvt_pk_bf16(t[2], t[3]); h.z = cvt_pk_bf16(t[4], t[5]); h.w = cvt_pk_bf16(t[6], t[7]);
                lo.x = cvt_pk_bf16(l[0], l[1]); lo.y = cvt_pk_bf16(l[2], l[3]); lo.z = cvt_pk_bf16(l[4], l[5]); lo.w = cvt_pk_bf16(l[6], l[7]);
                *(GAS u32x4*)(RWT + (size_t)e * DM + r * 64 + 8 * kc) = h; *(GAS u32x4*)(RWT + (size_t)(NE + e) * DM + r * 64 + 8 * kc) = lo; }
            LDS_WAIT(); asm volatile("" ::: "memory");
        }
    }
}


__device__ __forceinline__ void conv_addr(const Args& args, unsigned char* ws, bool down, int it, const float*& W, int& ldw, bf16_t*& dst, int& ldd) {
    if (!down) { int r = it; const int up = r >= IT_EG; if (up) r -= IT_EG;
        const int e = r / 256, q = r % 256, kb = q / 8, nb = q % 8, n0 = nb * 64;
        W = (up ? args.in[17] : args.in[16]) + (size_t)e * DM * EFF + (size_t)(kb * 64) * EFF + n0; ldw = EFF;
        dst = (bf16_t*)(ws + WS_WT_GU + ((size_t)e * 1024 + (n0 >> 7) * 256 + (up ? 128 : 0) + (n0 & 127)) * DM + kb * 64); ldd = DM;
    } else { const int r = it, e = r / 256, q = r % 256, kb = q / 32, nb = q % 32;
        W = args.in[18] + (size_t)e * EFF * DM + (size_t)(kb * 64) * DM + nb * 64; ldw = DM;
        dst = (bf16_t*)(ws + WS_WT_D + ((size_t)e * DM + nb * 64) * EFF + kb * 64); ldd = EFF; }
}
__device__ __forceinline__ void conv_items(Frame& F, const Args& args, bool down, int first, int count) {
    LAS float* scr = (LAS float*)(F.lds + F.wave * 16640);
    const int end = first + count; int it = first + F.wave;
    if (it >= end) return;
    f32x4 va[16], vb[16]; const float* W; int ldw; bf16_t* da; bf16_t* db; int ldd;
    conv_addr(args, F.ws, down, it, W, ldw, da, ldd); t64_load(va, W, ldw, F.lane);
    for (;;) {
        const bool hb = it + NWAVES < end;
        if (hb) { conv_addr(args, F.ws, down, it + NWAVES, W, ldw, db, ldd); t64_load(vb, W, ldw, F.lane); }
        t64_store<false, true>(va, da, ldd, scr, F.lane);
        if (!hb) break;
        const bool ha = it + 2 * NWAVES < end;
        if (ha) { conv_addr(args, F.ws, down, it + 2 * NWAVES, W, ldw, da, ldd); t64_load(va, W, ldw, F.lane); }
        t64_store<false, true>(vb, db, ldd, scr, F.lane);
        if (!ha) break;
        it += 2 * NWAVES;
    }
}
struct SchedIn {
    int G, c; unsigned char* ws; int use_ut;
    __device__ __forceinline__ bool next(int i, Unit& u) const {
        const int L = i * G + c; if (L >= 1024) return false;
        const char* H = (const char*)(ws + WS_H); const char* WT = (const char*)(ws + WS_WT_IN);
        u.rows = 256; u.aux = 0; u.bjs = HALF; u.pm = 0; u.pn = 0; u.rmin = 0; u.nt = DM / BK; u.keep = 0;
        if (L < 896) {
            int pm, ct; grid_map(L, 32, 28, pm, ct);
            const int row0 = pm * 256, b = row0 / SEQ, t0 = row0 % SEQ;
            u.A = H + (size_t)row0 * DM * 2; u.B = WT + (size_t)ct * 256 * DM * 2;
            if (ct < 4) {
                if (use_ut) { u.A = WT + (size_t)ct * 256 * DM * 2; u.B = H + (size_t)row0 * DM * 2;
                              u.C = (char*)(ws + WS_UT) + (((size_t)b * FW + ct * 256) * SEQ + t0) * 2; u.ldc = SEQ; u.mode = 0; }
                else { u.C = (char*)(ws + WS_U) + ((size_t)row0 * FW + ct * 256) * 2; u.ldc = FW; u.mode = 0; }
            }
            else if (ct < 12) { u.C = (char*)(ws + WS_Q) + ((size_t)row0 * DM + (ct - 4) * 256) * 2; u.ldc = DM; u.mode = 5; u.pm = t0; }
            else if (ct < 14) { u.C = (char*)(ws + WS_KALL) + (((size_t)b * SKV + t0) * KVW + (ct - 12) * 256) * 2; u.ldc = KVW; u.mode = 6; u.pm = t0; }
            else if (ct < 16) { u.C = (char*)(ws + WS_VALL) + (((size_t)b * SKV + t0) * KVW + (ct - 14) * 256) * 2; u.ldc = KVW; u.mode = 0; }
            else if (ct < 24) { u.C = (char*)(ws + WS_SGF) + ((size_t)row0 * DM + (ct - 16) * 256) * 2; u.ldc = DM; u.mode = 2; }
            else              { u.C = (char*)(ws + WS_SGA) + ((size_t)row0 * DM + (ct - 24) * 256) * 2; u.ldc = DM; u.mode = 2; }
        } else if (L >= 904) {
            int pm, q; grid_map(L - 904, 32, 4, pm, q); const int ct = 28 + q;
            u.A = H + (size_t)pm * 256 * DM * 2; u.B = WT + (size_t)ct * 256 * DM * 2;
            u.C = (char*)(ws + WS_SGA) + ((size_t)pm * 256 * DM + (ct - 24) * 256) * 2; u.ldc = DM; u.mode = 2;
        } else {
            const int l = L - 896, pm = l & 1, ct = l >> 1;
            u.A = H + (size_t)(NTOK + pm * 256) * DM * 2; u.B = WT + (size_t)(K_OFF + ct * 256) * DM * 2;
            if (ct < 2) { u.C = (char*)(ws + WS_KALL) + (((size_t)pm * SKV + SEQ) * KVW + ct * 256) * 2; u.ldc = KVW; u.mode = 7; }
            else        { u.C = (char*)(ws + WS_VALL) + (((size_t)pm * SKV + SEQ) * KVW + (ct - 2) * 256) * 2; u.ldc = KVW; u.mode = 0; }
        }
        return true;
    }
    __device__ __forceinline__ unsigned arow(const Unit&, int) const { return 0u; }
};


__device__ __forceinline__ void unpack8(u32x4 w, float (&f)[8]) {
#pragma unroll
    for (int i = 0; i < 4; ++i) { f[2 * i] = __uint_as_float(w[i] << 16); f[2 * i + 1] = __uint_as_float(w[i] & 0xffff0000u); }
}
struct EpiMerge { const bf16_t* SGF; const bf16_t* SGA; bf16_t* YM;
    __device__ __forceinline__ void operator()(f32x4 (&acc)[2][2][4][2], const Unit& u, int wr, int wc, int fr, int fq) const {
#pragma unroll
        for (int ai = 0; ai < 2; ++ai)
#pragma unroll
            for (int m = 0; m < 4; ++m) { const size_t row = (size_t)u.pm * 256 + ai * HALF + wr * 64 + m * 16 + fr;
#pragma unroll
                for (int bj = 0; bj < 2; ++bj) { const size_t o = row * DM + u.pn * 256 + bj * HALF + wc * 32 + 8 * fq;
                    float ga[8]; unpack8(*(const u32x4*)(SGA + o), ga);
#pragma unroll
                    for (int c = 0; c < 8; ++c) ga[c] = fmaxf(ga[c], 1e-20f);
                    if (u.keep) { float gf[8]; unpack8(*(const u32x4*)(SGF + o), gf);
#pragma unroll
                        for (int c = 0; c < 4; ++c) { acc[ai][bj][m][0][c] *= gf[c] * __builtin_amdgcn_rcpf(ga[c]); acc[ai][bj][m][1][c] *= gf[4 + c] * __builtin_amdgcn_rcpf(ga[4 + c]); }
                    } else { const f32x4 v0 = acc[ai][bj][m][0], v1 = acc[ai][bj][m][1];
                        u32x4 w; w.x = cvt_pk_bf16(ga[0] * v0[0], ga[1] * v0[1]); w.y = cvt_pk_bf16(ga[2] * v0[2], ga[3] * v0[3]); w.z = cvt_pk_bf16(ga[4] * v1[0], ga[5] * v1[1]); w.w = cvt_pk_bf16(ga[6] * v1[2], ga[7] * v1[3]);
                        *(u32x4*)(YM + o) = w; } } }
    } };
struct SchedMerge { int G, c; unsigned char* ws;
    __device__ __forceinline__ bool next(int i, Unit& u) const {
        const int L = (i >> 1) * G + c; if (L >= 256) return false;
        int pm, pn; grid_map(L, 32, 8, pm, pn); const int kb = i & 1;
        u.A = (const char*)(ws + (kb ? WS_YA : WS_YF)) + (size_t)pm * 256 * DM * 2; u.B = (const char*)(ws + (kb ? WS_WT_AO : WS_WT_FO)) + (size_t)pn * 256 * DM * 2;
        u.C = nullptr; u.ldc = DM; u.mode = 0; u.rows = 256; u.aux = 0; u.pm = pm; u.pn = pn; u.bjs = HALF; u.rmin = 0; u.nt = kb ? DM / BK : FW / BK; u.keep = kb ? 0 : 1;
        return true; }
    __device__ __forceinline__ unsigned arow(const Unit&, int) const { return 0u; } };
struct EpiX2 { const float* x; const float* mod; float* X2;
    __device__ __forceinline__ void operator()(f32x4 (&acc)[2][2][4][2], const Unit& u, int wr, int wc, int fr, int fq) const {
        const float* g1 = mod + ((u.pm * 256) / SEQ) * MODC + 2 * DM;
#pragma unroll
        for (int ai = 0; ai < 2; ++ai)
#pragma unroll
            for (int m = 0; m < 4; ++m) { const size_t row = (size_t)u.pm * 256 + ai * HALF + wr * 64 + m * 16 + fr;
#pragma unroll
                for (int bj = 0; bj < 2; ++bj) { const int col = u.pn * 256 + bj * HALF + wc * 32 + 8 * fq; const size_t o = row * DM + col;
#pragma unroll
                    for (int n = 0; n < 2; ++n) { const f32x4 xv = *(const f32x4*)(x + o + 4 * n), gv = *(const f32x4*)(g1 + col + 4 * n); *(f32x4*)(X2 + o + 4 * n) = xv + gv * acc[ai][bj][m][n]; } } }
    } };
__device__ __forceinline__ void act8(const f32x4 (&g)[2], const f32x4 (&up)[2], unsigned& w0, unsigned& w1) {
    f32x4 a[2];
#pragma unroll
    for (int n = 0; n < 2; ++n)
#pragma unroll
        for (int c = 0; c < 4; ++c) { const float x = g[n][c]; a[n][c] = fminf(fmaxf(x * __builtin_amdgcn_rcpf(1.0f + __expf(-x)) * up[n][c], -448.f), 448.f); }
    int x0 = 0, x1 = 0;
    x0 = __builtin_amdgcn_cvt_pk_fp8_f32(a[0][0], a[0][1], x0, false); x0 = __builtin_amdgcn_cvt_pk_fp8_f32(a[0][2], a[0][3], x0, true);
    x1 = __builtin_amdgcn_cvt_pk_fp8_f32(a[1][0], a[1][1], x1, false); x1 = __builtin_amdgcn_cvt_pk_fp8_f32(a[1][2], a[1][3], x1, true);
    w0 = (unsigned)x0; w1 = (unsigned)x1;
}
struct EpiAct {
    __device__ __forceinline__ void operator()(f32x4 (&acc)[2][2][4][2], const Unit& u, int wr, int wc, int fr, int fq) const {
        const int odd = fq & 1;
        unsigned char* base = (unsigned char*)u.C + (size_t)(wr * 64 + odd * 16 + fr) * u.ldc + wc * 32 + 8 * (fq - odd);
        const int r0 = wr * 64 + odd * 16 + fr;
#pragma unroll
        for (int ai = 0; ai < 2; ++ai)
#pragma unroll
            for (int m = 0; m < 4; m += 2) {
                unsigned a0, a1, b0, b1; act8(acc[ai][0][m], acc[ai][1][m], a0, a1); act8(acc[ai][0][m + 1], acc[ai][1][m + 1], b0, b1);
                const auto s0 = __builtin_amdgcn_permlane16_swap(a0, b0, false, false), s1 = __builtin_amdgcn_permlane16_swap(a1, b1, false, false);
                if (r0 + ai * HALF + m * 16 < u.rows) { const u32x4 w = {s0[0], s1[0], s0[1], s1[1]}; *(u32x4*)(base + (size_t)(ai * HALF + m * 16) * u.ldc) = w; } }
    } };

struct SchedGrid {
    int G, c, nM, nN; const char* A; const char* B; char* C; size_t astride, bstride; int ldc, esz, mode, nt;
    __device__ __forceinline__ bool next(int i, Unit& u) const {
        const int L = i * G + c; if (L >= nM * nN) return false;
        int pm, pn; grid_map(L, nM, nN, pm, pn);
        u.A = A + (size_t)pm * astride; u.B = B + (size_t)pn * bstride; u.C = C + ((size_t)pm * 256 * ldc + pn * 256) * esz; u.ldc = ldc; u.mode = mode; u.rows = 256; u.aux = 0; u.pm = pm; u.pn = pn; u.bjs = HALF; u.rmin = 0; u.nt = nt; u.keep = 0;
        return true; }
    __device__ __forceinline__ unsigned arow(const Unit&, int) const { return 0u; } };
struct SchedAG { int G, c; unsigned char* ws;
    __device__ __forceinline__ bool next(int i, Unit& u) const {
        const int L = i * G + c; if (L >= 136) return false;
        u.rows = 256; u.aux = 0; u.rmin = 0; u.nt = DM / BK; u.keep = 0;
        if (L < 128) {
            int pm, pn8; grid_map(L, 16, 8, pm, pn8); const int b = pn8 >> 2, pn = pn8 & 3, sn = pm >> 3, k1t = pm & 7;
            u.A = (const char*)(ws + WS_CST) + (size_t)pm * 256 * 2048 * 2; u.B = (const char*)(ws + (sn ? WS_OT : WS_ET)) + ((size_t)b * FW + pn * 256) * 2048 * 2;
            u.C = (char*)(ws + WS_TT) + (((size_t)b * 2048 + k1t * 256) * DM + pn * 512 + sn * 128) * 2; u.ldc = DM; u.mode = sn ? 0 : 3; u.pm = k1t; u.pn = b * FW + pn * 256; u.bjs = 256;
        } else {
            int pm, q; grid_map(L - 128 + 120, 32, 4, pm, q); const int ct = 28 + q;
            u.A = (const char*)(ws + WS_H) + (size_t)pm * 256 * DM * 2; u.B = (const char*)(ws + WS_WT_IN) + (size_t)ct * 256 * DM * 2;
            u.C = (char*)(ws + WS_SGA) + ((size_t)pm * 256 * DM + (ct - 24) * 256) * 2; u.ldc = DM; u.mode = 2; u.pm = pm; u.pn = ct; u.bjs = HALF;
        }
        return true; }
    __device__ __forceinline__ unsigned arow(const Unit&, int) const { return 0u; } };
struct SchedF2 { int G, c; unsigned char* ws;
    __device__ __forceinline__ bool next(int i, Unit& u) const {
        const int L = i * G + c; if (L >= 128) return false;
        int pm, q; grid_map(L, 16, 8, pm, q); const int b = pm >> 3, k1t = pm & 7, j = q & 3, mir = q >> 2;
        u.A = (const char*)(ws + WS_TT) + (((size_t)b * 2048 + k1t * 256) * DM + j * 512) * 2; u.B = (const char*)(ws + WS_BD2) + (size_t)mir * 256 * 512 * 2;
        u.mode = 0; u.rows = 256; u.aux = 0; u.pm = pm; u.pn = j; u.bjs = HALF; u.nt = 512 / BK; u.keep = 0;
        if (!mir) { u.C = (char*)(ws + WS_YF) + (((size_t)b * SEQ + k1t * 256) * YFP + j * 256) * 2; u.ldc = YFP; u.rmin = 0; }
        else { u.C = (char*)(ws + WS_YF) + (((size_t)b * SEQ + SEQ - k1t * 256) * YFP + j * 256) * 2; u.ldc = -YFP; u.rmin = k1t == 0 ? 1 : 0; }
        return true; }
    __device__ __forceinline__ unsigned arow(const Unit&, int) const { return 0u; } };
constexpr int SCHT_OFF = LDSCTL_OFF + 1024;
__device__ __forceinline__ void moe_tables(Frame& F, int ncol_tiles) {
    LAS int* T = (LAS int*)(F.lds + SCHT_OFF);
    __syncthreads();
    if (F.tid == 0) { const int* CNT = (const int*)(F.ws + CTL_CNT); int up = 0, of = 0;
        for (int e = 0; e <= NE; ++e) { const int cn = e < NE ? CNT[e * 64] : NTOK; T[e] = up; T[80 + e] = e < NE ? of : NSLOT; T[160 + e] = cn; up += ((cn + 255) >> 8) * ncol_tiles; of += cn; }
        T[NE + 1] = up; }
    __syncthreads();
}
template <int NCT, bool FIRST> struct SchedMoe {
    int G, c; unsigned char* ws; LAS int* T; const int* TOK;
    __device__ __forceinline__ int tl(int i) const { return __builtin_amdgcn_readfirstlane(T[i]); }
    __device__ __forceinline__ bool next(int i, Unit& u) const {
        const int L = i * G + c; if (L >= tl(NE + 1)) return false;
        int lo = 0, hi = NE;
#pragma unroll 1
        while (lo < hi) { const int mid = (lo + hi + 1) >> 1; if (tl(mid) <= L) lo = mid; else hi = mid - 1; }
        const int e = lo, cn = tl(160 + e), ntile = (cn + 255) >> 8, local = L - tl(e), ct = local / ntile, mt = local % ntile, slot0 = tl(80 + e) + mt * 256;
        u.rows = (cn - mt * 256) < 256 ? (cn - mt * 256) : 256; u.aux = slot0; u.pm = mt; u.pn = ct; u.bjs = HALF; u.mode = 0; u.rmin = 0; u.e = e; u.nt = (FIRST ? DM : EFF) / 128; u.keep = 0;
        if (FIRST) { u.A = (const char*)(ws + WS_H2); u.B = (const char*)(ws + WS_WT_GU) + ((size_t)e * 4 + ct) * 256 * DM; u.C = (char*)(ws + WS_ACT) + ((size_t)slot0 * EFF + ct * 128); u.ldc = EFF; }
        else { u.A = (const char*)(ws + WS_ACT) + (size_t)slot0 * EFF; u.B = (const char*)(ws + WS_WT_D) + ((size_t)e * DM + ct * 256) * EFF; u.C = (char*)(ws + WS_YBIG) + ((size_t)slot0 * DM + ct * 256); u.ldc = DM; u.mode = 8; }
        return true; }
    __device__ __forceinline__ unsigned arow(const Unit& u, int r) const { const int rr = u.pm * 256 + (r < u.rows ? r : u.rows - 1); const int tok = u.e < NE ? TOK[u.e * NTOK + rr] : rr; return (unsigned)tok * (unsigned)DM; } };

namespace attn {
using s16x4 = __attribute__((ext_vector_type(4))) short;
using f32x8 = __attribute__((ext_vector_type(8))) float;
constexpr int D = 128, NW = 8, QBLK = 32, KVBLK = 64;
constexpr float SCALE = 0.088388347648318440f;
constexpr float THR = 8.f;
constexpr int LDQ = DM, LDK = KVW, LDO = DM;
constexpr size_t SHM_V = KVBLK * D * 2, SHM_K = KVBLK * D * 2, SHM_ATTN = 2 * SHM_V + 2 * SHM_K + NW * 64 * 4;
#define KSWZ(row, colB) ((row) * 256 + ((colB) ^ (((row) & 7) << 4)))
#define SBAR() __builtin_amdgcn_sched_barrier(0)
__device__ __forceinline__ unsigned cvtpk(float lo, float hi) { unsigned r; asm volatile("v_cvt_pk_bf16_f32 %0, %1, %2" : "=v"(r) : "v"(lo), "v"(hi)); return r; }
__device__ __forceinline__ void partialSM(f32x16& p0, f32x16& p1, float& m_reg, float& mn, float& alpha) {
  constexpr float C = SCALE * 1.4426950408889634f;
  float pmax = p0[0]; for (int r = 1; r < 16; ++r) pmax = fmaxf(pmax, p0[r]); for (int r = 0; r < 16; ++r) pmax = fmaxf(pmax, p1[r]);
  { auto rr = __builtin_amdgcn_permlane32_swap(__float_as_uint(pmax), __float_as_uint(pmax), false, false);
    pmax = fmaxf(__uint_as_float(rr[0]), __uint_as_float(rr[1])); }
  if (__builtin_expect(__all(pmax - m_reg <= THR / SCALE), 1)) { mn = m_reg; alpha = 1.f; }
  else { mn = fmaxf(m_reg, pmax); alpha = __builtin_amdgcn_exp2f((m_reg - mn) * C); m_reg = mn; }
  float mnC = -mn * C;
  for (int r = 0; r < 16; ++r) p0[r] = fmaf(p0[r], C, mnC); for (int r = 0; r < 16; ++r) p1[r] = fmaf(p1[r], C, mnC);
  for (int r = 0; r < 16; ++r) p0[r] = __builtin_amdgcn_exp2f(p0[r]);
}
__device__ __forceinline__ void finishSM(f32x16& p0, f32x16& p1, float alpha, float& l_reg, bf16x8& pa0, bf16x8& pa1, bf16x8& pa2, bf16x8& pa3) {
  for (int r = 0; r < 16; ++r) p1[r] = __builtin_amdgcn_exp2f(p1[r]);
  float ps = 0; for (int r = 0; r < 16; ++r) ps += p0[r]; for (int r = 0; r < 16; ++r) ps += p1[r];
  { auto rr = __builtin_amdgcn_permlane32_swap(__float_as_uint(ps), __float_as_uint(ps), false, false);
    ps = __uint_as_float(rr[0]) + __uint_as_float(rr[1]); }
  l_reg = l_reg * alpha + ps;
#define PK4(P, BASE, OUT) do { unsigned a0 = cvtpk(P[BASE + 0], P[BASE + 1]), a1 = cvtpk(P[BASE + 2], P[BASE + 3]);   \
    unsigned b0 = cvtpk(P[BASE + 4], P[BASE + 5]), b1 = cvtpk(P[BASE + 6], P[BASE + 7]);                              \
    auto r0 = __builtin_amdgcn_permlane32_swap(a0, b0, false, false); auto r1 = __builtin_amdgcn_permlane32_swap(a1, b1, false, false); \
    u32x4 w = {r0[0], r1[0], r0[1], r1[1]}; OUT = *reinterpret_cast<bf16x8*>(&w); } while (0)
  PK4(p0, 0, pa0); PK4(p0, 8, pa1); PK4(p1, 0, pa2); PK4(p1, 8, pa3);
#undef PK4
}
__device__ __forceinline__ void qkt(f32x16& p0, f32x16& p1, const bf16_t* Ks, const bf16x8* qr, int r32, int hi) {
  p0 = f32x16{}; p1 = f32x16{};
  for (int d0 = 0; d0 < 8; ++d0) { int cb = (d0 * 16 + hi * 8) * 2;
    bf16x8 b0 = *reinterpret_cast<const bf16x8*>((const char*)Ks + KSWZ(r32, cb));
    bf16x8 b1 = *reinterpret_cast<const bf16x8*>((const char*)Ks + KSWZ(32 + r32, cb));
    p0 = __builtin_amdgcn_mfma_f32_32x32x16_bf16(b0, qr[d0], p0, 0, 0, 0);
    p1 = __builtin_amdgcn_mfma_f32_32x32x16_bf16(b1, qr[d0], p1, 0, 0, 0); }
}
__device__ __forceinline__ int v_st(int k, int c) { const int kk = (k & ~0xC) | ((k & 4) << 1) | ((k & 8) >> 1); return ((kk >> 3) * 4 + (c >> 5)) * 512 + ((kk & 7) * 32 + (c & 31)) * 2; }
__device__ __forceinline__ int v_rd_base(int lane) { return ((lane & 3) << 3) | (((lane >> 2) & 3) << 6) | (((lane >> 4) & 1) << 5) | (((lane >> 5) & 1) << 8); }
constexpr int v_rd_off(int d0, int ks, int half) { return d0 * 512 + ks * 4096 + half * 2048; }
template <int OFF> __device__ __forceinline__ s16x4 tr_read(int vb) {
  s16x4 r; asm volatile("ds_read_b64_tr_b16 %0, %1 offset:%2" : "=&v"(r) : "v"(vb), "i"(OFF) : "memory"); return r;
}
template <int D0> __device__ __forceinline__ void pv_one(f32x16& od, int vb, bf16x8 pa0, bf16x8 pa1, bf16x8 pa2, bf16x8 pa3) {
  const s16x4 l0 = tr_read<v_rd_off(D0, 0, 0)>(vb), h0 = tr_read<v_rd_off(D0, 0, 1)>(vb), l1 = tr_read<v_rd_off(D0, 1, 0)>(vb), h1 = tr_read<v_rd_off(D0, 1, 1)>(vb);
  const s16x4 l2 = tr_read<v_rd_off(D0, 2, 0)>(vb), h2 = tr_read<v_rd_off(D0, 2, 1)>(vb), l3 = tr_read<v_rd_off(D0, 3, 0)>(vb), h3 = tr_read<v_rd_off(D0, 3, 1)>(vb);
  asm volatile("s_waitcnt lgkmcnt(0)" ::: "memory"); SBAR();
#define PK(L, H) (bf16x8){L[0], L[1], L[2], L[3], H[0], H[1], H[2], H[3]}
  od = __builtin_amdgcn_mfma_f32_32x32x16_bf16(pa0, PK(l0, h0), od, 0, 0, 0);
  od = __builtin_amdgcn_mfma_f32_32x32x16_bf16(pa1, PK(l1, h1), od, 0, 0, 0);
  od = __builtin_amdgcn_mfma_f32_32x32x16_bf16(pa2, PK(l2, h2), od, 0, 0, 0);
  od = __builtin_amdgcn_mfma_f32_32x32x16_bf16(pa3, PK(l3, h3), od, 0, 0, 0);
#undef PK
}
__device__ __forceinline__ void pv_d0(f32x16* o, int vb, bf16x8 pa0, bf16x8 pa1, bf16x8 pa2, bf16x8 pa3) {
  pv_one<0>(o[0], vb, pa0, pa1, pa2, pa3); pv_one<1>(o[1], vb, pa0, pa1, pa2, pa3); pv_one<2>(o[2], vb, pa0, pa1, pa2, pa3); pv_one<3>(o[3], vb, pa0, pa1, pa2, pa3);
}
__device__ __forceinline__ void attn_dense_body(const bf16_t* __restrict__ Qb, const bf16_t* __restrict__ Kh, const bf16_t* __restrict__ Vh, bf16_t* __restrict__ Ob, int seq, char* lds) {
  const int tid = threadIdx.x, wid = tid >> 6, lane = tid & 63, r32 = lane & 31, hi = lane >> 5;
  bf16_t* V_lds = (bf16_t*)lds; bf16_t* K_lds = (bf16_t*)(lds + 2 * SHM_V);
  float* ws = (float*)(lds + 2 * SHM_V + 2 * SHM_K) + wid * 64; float* li_l = ws; float* al_l = ws + 32;
  float m_reg = -1e30f, l_reg = 0; f32x16 o[4] = {}; bf16x8 qr[8];
  const bf16_t* Qw = Qb + (long)(wid * QBLK + r32) * LDQ + hi * 8;
#pragma unroll
  for (int d0 = 0; d0 < 8; ++d0) qr[d0] = *reinterpret_cast<const bf16x8*>(Qw + d0 * 16);
  const int sr = tid >> 4, sc = (tid & 15) * 8, vst0 = v_st(sr, sc), vst1 = v_st(32 + sr, sc);
  const int vb0 = (int)(uintptr_t)V_lds + v_rd_base(lane);
  struct { bf16x8 vs0, vs1, ks0, ks1; } sr_[2];
#define SLOAD(i, k0) do { sr_[i].vs0 = *reinterpret_cast<const bf16x8*>(&Vh[(long)((k0) + sr) * LDK + sc]); sr_[i].vs1 = *reinterpret_cast<const bf16x8*>(&Vh[(long)((k0) + 32 + sr) * LDK + sc]); \
    sr_[i].ks0 = *reinterpret_cast<const bf16x8*>(&Kh[(long)((k0) + sr) * LDK + sc]); sr_[i].ks1 = *reinterpret_cast<const bf16x8*>(&Kh[(long)((k0) + 32 + sr) * LDK + sc]); } while (0)
#define SWRITE(b, i) do { *(bf16x8*)((char*)V_lds + (b) * SHM_V + vst0) = sr_[i].vs0;          \
    *(bf16x8*)((char*)V_lds + (b) * SHM_V + vst1) = sr_[i].vs1; int kc = sc * 2;               \
    *(bf16x8*)((char*)K_lds + (b) * SHM_K + KSWZ(sr, kc)) = sr_[i].ks0;                       \
    *(bf16x8*)((char*)K_lds + (b) * SHM_K + KSWZ(32 + sr, kc)) = sr_[i].ks1; } while (0)
#define SWAIT() asm volatile("s_waitcnt vmcnt(4)" ::: "memory")
#define RESC(a) do { if (__any((a) < 1.f)) { if (hi == 0) al_l[r32] = (a); asm volatile("s_waitcnt lgkmcnt(0)" ::: "memory"); \
    for (int d = 0; d < 4; ++d) for (int r = 0; r < 16; ++r) o[d][r] *= al_l[crow(r, hi)]; } } while (0)
  f32x16 pA0, pA1, pB0, pB1; float mnA, mnB, alA, alB; bf16x8 pa0, pa1, pa2, pa3; const int NT = seq / KVBLK;
  constexpr int SE = 0, SO = 1;
  SLOAD(SE, 0); asm volatile("s_waitcnt vmcnt(0)" ::: "memory"); SWRITE(0, SE); __syncthreads();
  qkt(pA0, pA1, K_lds, qr, r32, hi); partialSM(pA0, pA1, m_reg, mnA, alA);
  SLOAD(SO, KVBLK); if (2 < NT) SLOAD(SE, 2 * KVBLK);
  SWAIT(); SWRITE(1, SO); __syncthreads();
  for (int j = 1; j + 1 < NT; j += 2) {
    SBAR(); qkt(pB0, pB1, (bf16_t*)((char*)K_lds + SHM_K), qr, r32, hi);
    finishSM(pA0, pA1, alA, l_reg, pa0, pa1, pa2, pa3); SBAR();
    SLOAD(SO, (j + 2) * KVBLK); SBAR();
    pv_d0(o, vb0, pa0, pa1, pa2, pa3); partialSM(pB0, pB1, m_reg, mnB, alB);
    __syncthreads(); SWAIT(); SWRITE(0, SE);
    RESC(alB); __syncthreads();
    SBAR(); qkt(pA0, pA1, K_lds, qr, r32, hi);
    finishSM(pB0, pB1, alB, l_reg, pa0, pa1, pa2, pa3); SBAR();
    if (j + 3 < NT) SLOAD(SE, (j + 3) * KVBLK); SBAR();
    pv_d0(o, vb0 + (int)SHM_V, pa0, pa1, pa2, pa3); partialSM(pA0, pA1, m_reg, mnA, alA);
    __syncthreads(); SWAIT(); SWRITE(1, SO);
    RESC(alA); __syncthreads();
  }
  SBAR(); qkt(pB0, pB1, (bf16_t*)((char*)K_lds + SHM_K), qr, r32, hi);
  finishSM(pA0, pA1, alA, l_reg, pa0, pa1, pa2, pa3); SBAR();
  pv_d0(o, vb0, pa0, pa1, pa2, pa3); partialSM(pB0, pB1, m_reg, mnB, alB);
  __syncthreads(); RESC(alB);
  finishSM(pB0, pB1, alB, l_reg, pa0, pa1, pa2, pa3); SBAR();
  pv_d0(o, vb0 + (int)SHM_V, pa0, pa1, pa2, pa3);
  if (hi == 0) li_l[r32] = l_reg; asm volatile("s_waitcnt lgkmcnt(0)" ::: "memory");
  float rli[16];
#pragma unroll
  for (int r = 0; r < 16; ++r) rli[r] = __builtin_amdgcn_rcpf(li_l[crow(r, hi)]);
  typedef __attribute__((address_space(3))) unsigned char lds8_t;
  lds8_t* ost = (lds8_t*)(lds + SHM_ATTN + wid * 8192);
  lds8_t* wbase = ost + hi * 1024 + r32 * 2;
#pragma unroll
  for (int d0 = 0; d0 < 4; ++d0)
#pragma unroll
    for (int r = 0; r < 16; r += 2) { const unsigned w = cvtpk(o[d0][r] * rli[r], o[d0][r + 1] * rli[r + 1]);
      *(__attribute__((address_space(3))) unsigned short*)(wbase + (((r & 3) + 8 * (r >> 2)) * 256 + d0 * 64)) = (unsigned short)w;
      *(__attribute__((address_space(3))) unsigned short*)(wbase + ((((r + 1) & 3) + 8 * ((r + 1) >> 2)) * 256 + d0 * 64)) = (unsigned short)(w >> 16); }
  asm volatile("s_waitcnt lgkmcnt(0)" ::: "memory");
  bf16_t* Ow = Ob + (long)(wid * QBLK) * LDO;
  { const lds8_t* rbase = ost + (lane >> 4) * 256 + (lane & 15) * 16; bf16_t* gbase = Ow + (long)(lane >> 4) * LDO + (lane & 15) * 8;
#pragma unroll
    for (int j = 0; j < 8; ++j) { const u32x4 v = *(const __attribute__((address_space(3))) u32x4*)(rbase + j * 1024); *(u32x4*)(gbase + (long)(j * 4) * LDO) = v; } }
  asm volatile("s_waitcnt lgkmcnt(0)" ::: "memory");
#undef SLOAD
#undef SWRITE
#undef SWAIT
#undef RESC
}
#undef KSWZ
#undef SBAR
}

__device__ __forceinline__ void ph_norm1(Frame& F, const Args& args, const float* mod) {
    const int gw = F.vcu * NWAVES + F.wave, NGW = F.G * NWAVES, lane = F.lane;
    bf16_t* H = (bf16_t*)(F.ws + WS_H); const float* nw = args.in[6];
    for (int row = gw; row < NTOK + NCTX; row += NGW) {
        const float* src = row < NTOK ? args.in[0] + (size_t)row * DM : args.in[2] + (size_t)(row - NTOK) * DM;
        const float* mr = mod + (row < NTOK ? row / SEQ : 2) * MODC;
        f32x4 v[8]; float ss = 0.f;
#pragma unroll
        for (int j = 0; j < 8; ++j) { v[j] = *(const GAS f32x4*)(src + (j * 64 + lane) * 4); ss += v[j].x * v[j].x + v[j].y * v[j].y + v[j].z * v[j].z + v[j].w * v[j].w; }
        ss = wave_sum(ss);
        const float rstd = 1.0f / sqrtf(ss * (1.0f / DM) + 1e-6f);
#pragma unroll
        for (int j = 0; j < 8; ++j) { const int i = (j * 64 + lane) * 4;
            const f32x4 w = *(const GAS f32x4*)(nw + i), sc = *(const GAS f32x4*)(mr + DM + i), sh = *(const GAS f32x4*)(mr + i);
            const f32x4 h = v[j] * rstd * w * (sc + 1.0f) + sh;
            unsigned lo = cvt_pk_bf16(h[0], h[1]), hi = cvt_pk_bf16(h[2], h[3]);
            *(GAS unsigned long long*)(H + (size_t)row * DM + i) = (unsigned long long)lo | ((unsigned long long)hi << 32); }
    }
}
__device__ __forceinline__ void ph_evenodd(Frame& F, const Args& args) {
    const int gw = F.vcu * NWAVES + F.wave, NGW = F.G * NWAVES, lane = F.lane;
    LAS bf16_t* scr = (LAS bf16_t*)(F.lds + F.wave * 16640);
    const bf16_t* UT = (const bf16_t*)(F.ws + WS_UT); bf16_t* ET = (bf16_t*)(F.ws + WS_ET); bf16_t* OT = (bf16_t*)(F.ws + WS_OT);
    float* W2 = (float*)(F.ws + WS_W2048); float* AL = (float*)(F.ws + WS_ALT);
    for (int row = gw; row < 2 * FW; row += NGW) {
        const bf16_t* src = UT + (size_t)row * SEQ; float alt = 0.f;
#pragma unroll
        for (int j = 0; j < 8; ++j) { const u32x4 w = *(const GAS u32x4*)(src + (j * 64 + lane) * 8); *(LAS u32x4*)(scr + (j * 64 + lane) * 8) = w;
            float f[8]; unpack8(w, f); alt += (f[0] - f[1]) + (f[2] - f[3]) + (f[4] - f[5]) + (f[6] - f[7]); }
        alt = wave_sum(alt);
        LDS_WAIT(); asm volatile("" ::: "memory");
        if (lane == 0) { AL[row] = alt; W2[row] = bf2f(scr[SEQ / 2]); }
#pragma unroll
        for (int j = 0; j < 4; ++j) { const int n0 = (j * 64 + lane) * 8; float e[8], o[8];
#pragma unroll
            for (int i = 0; i < 8; ++i) { const int n = n0 + i; const float a = bf2f(scr[n]), bb = bf2f(scr[(SEQ - n) & (SEQ - 1)]); e[i] = n == 0 ? a : a + bb; o[i] = n == 0 ? 0.f : a - bb; }
            u32x4 we, wo; we.x = cvt_pk_bf16(e[0], e[1]); we.y = cvt_pk_bf16(e[2], e[3]); we.z = cvt_pk_bf16(e[4], e[5]); we.w = cvt_pk_bf16(e[6], e[7]);
            wo.x = cvt_pk_bf16(o[0], o[1]); wo.y = cvt_pk_bf16(o[2], o[3]); wo.z = cvt_pk_bf16(o[4], o[5]); wo.w = cvt_pk_bf16(o[6], o[7]);
            *(GAS u32x4*)(ET + (size_t)row * 2048 + n0) = we; *(GAS u32x4*)(OT + (size_t)row * 2048 + n0) = wo; }
        LDS_WAIT(); asm volatile("" ::: "memory");
    }
}
__device__ __forceinline__ void ph_route(Frame& F, const Args& args, const float* mod) {
    const int lane = F.lane, wv = F.wave, r32 = lane & 31, hi = lane >> 5;
    LAS float* rs = (LAS float*)F.lds;
    LAS float* part = (LAS float*)(F.lds + 1024);
    LAS int* lcnt = (LAS int*)(F.lds + 1024 + 65536);
    LAS int* lbase = lcnt + 64;
    LAS int* lent = lcnt + 128;
    const float* X2 = (const float*)(F.ws + WS_X2); const float* nw = args.in[13]; const float* rb = args.in[15];
    const bf16_t* RWT = (const bf16_t*)(F.ws + WS_RWT);
    bf16_t* H2 = (bf16_t*)(F.ws + WS_H2); int* EIDX = (int*)(F.ws + WS_EIDX); float* EW = (float*)(F.ws + WS_EW); int* EPOS = (int*)(F.ws + WS_EPOS); int* CNT = (int*)(F.ws + CTL_CNT); int* TOKE = (int*)(F.ws + WS_TOKE);
    if (F.tid < NE) lcnt[F.tid] = 0;
    __syncthreads();
    int nb = 0;
    for (int blk = F.vcu; blk < NTOK / 32; blk += F.G, ++nb) {
        const int row0 = blk * 32; const float* mr = mod + (row0 / SEQ) * MODC;
#pragma unroll
        for (int i = 0; i < 4; ++i) { const float* src = X2 + (size_t)(row0 + wv * 4 + i) * DM; float ss = 0.f;
#pragma unroll
            for (int j = 0; j < 8; ++j) { const f32x4 v = *(const GAS f32x4*)(src + (j * 64 + lane) * 4); ss += v.x * v.x + v.y * v.y + v.z * v.z + v.w * v.w; }
            ss = wave_sum(ss);
            if (lane == 0) rs[wv * 4 + i] = 1.0f / sqrtf(ss * (1.0f / DM) + 1e-6f); }
        __syncthreads();
        { const float rstd = rs[r32]; const float* xr = X2 + (size_t)(row0 + r32) * DM; unsigned char* hr = (unsigned char*)H2 + (size_t)(row0 + r32) * DM;
          f32x16 acc0 = {}, acc1 = {};
#pragma unroll 4
          for (int ks = 0; ks < 16; ++ks) { const int k = wv * 256 + ks * 16 + hi * 8;
              float h[8];
#pragma unroll
              for (int q = 0; q < 2; ++q) { const f32x4 x = *(const GAS f32x4*)(xr + k + 4 * q), w = *(const GAS f32x4*)(nw + k + 4 * q), sc = *(const GAS f32x4*)(mr + 4 * DM + k + 4 * q), sh = *(const GAS f32x4*)(mr + 3 * DM + k + 4 * q);
                  const f32x4 t = x * rstd * w * (sc + 1.0f) + sh; h[4 * q] = t[0]; h[4 * q + 1] = t[1]; h[4 * q + 2] = t[2]; h[4 * q + 3] = t[3]; }
              u32x4 wh, wl; float l[8];
              wh.x = cvt_pk_bf16(h[0], h[1]); wh.y = cvt_pk_bf16(h[2], h[3]); wh.z = cvt_pk_bf16(h[4], h[5]); wh.w = cvt_pk_bf16(h[6], h[7]);
#pragma unroll
              for (int i = 0; i < 4; ++i) { l[2 * i] = h[2 * i] - __uint_as_float(wh[i] << 16); l[2 * i + 1] = h[2 * i + 1] - __uint_as_float(wh[i] & 0xffff0000u); }
              wl.x = cvt_pk_bf16(l[0], l[1]); wl.y = cvt_pk_bf16(l[2], l[3]); wl.z = cvt_pk_bf16(l[4], l[5]); wl.w = cvt_pk_bf16(l[6], l[7]);
              { float hc[8];
#pragma unroll
                for (int i = 0; i < 8; ++i) hc[i] = fminf(fmaxf(h[i], -448.f), 448.f);
                int w0 = 0, w1 = 0; w0 = __builtin_amdgcn_cvt_pk_fp8_f32(hc[0], hc[1], w0, false); w0 = __builtin_amdgcn_cvt_pk_fp8_f32(hc[2], hc[3], w0, true);
                w1 = __builtin_amdgcn_cvt_pk_fp8_f32(hc[4], hc[5], w1, false); w1 = __builtin_amdgcn_cvt_pk_fp8_f32(hc[6], hc[7], w1, true);
                *(GAS unsigned long long*)(hr + k) = (unsigned long long)(unsigned)w0 | ((unsigned long long)(unsigned)w1 << 32); }
              const bf16x8 ah = __builtin_bit_cast(bf16x8, wh), al = __builtin_bit_cast(bf16x8, wl);
              const bf16x8 bh0 = *(const GAS bf16x8*)(RWT + (size_t)r32 * DM + k), bh1 = *(const GAS bf16x8*)(RWT + (size_t)(32 + r32) * DM + k);
              const bf16x8 bl0 = *(const GAS bf16x8*)(RWT + (size_t)(NE + r32) * DM + k), bl1 = *(const GAS bf16x8*)(RWT + (size_t)(NE + 32 + r32) * DM + k);
              acc0 = __builtin_amdgcn_mfma_f32_32x32x16_bf16(ah, bh0, acc0, 0, 0, 0); acc0 = __builtin_amdgcn_mfma_f32_32x32x16_bf16(ah, bl0, acc0, 0, 0, 0); acc0 = __builtin_amdgcn_mfma_f32_32x32x16_bf16(al, bh0, acc0, 0, 0, 0);
              acc1 = __builtin_amdgcn_mfma_f32_32x32x16_bf16(ah, bh1, acc1, 0, 0, 0); acc1 = __builtin_amdgcn_mfma_f32_32x32x16_bf16(ah, bl1, acc1, 0, 0, 0); acc1 = __builtin_amdgcn_mfma_f32_32x32x16_bf16(al, bh1, acc1, 0, 0, 0); }
#pragma unroll
          for (int r = 0; r < 16; ++r) { part[(wv * 32 + crow(r, hi)) * 64 + r32] = acc0[r]; part[(wv * 32 + crow(r, hi)) * 64 + 32 + r32] = acc1[r]; } }
        __syncthreads();
        for (int i = 0; i < 4; ++i) { const int rbk = wv * 4 + i, row = row0 + rbk; float logit = 0.f;
#pragma unroll
          for (int w = 0; w < 8; ++w) logit += part[(w * 32 + rbk) * 64 + lane];
          const float score = 1.0f / (1.0f + expf(-logit)), bsd = score + rb[lane];
          const int g = lane >> 3;
          int rk = 0;
#pragma unroll
          for (int q = 0; q < 8; ++q) { const int o = (lane & ~7) + q; const float vv = __shfl(bsd, o); rk += (vv > bsd) || (vv == bsd && o < lane); }
          float gs = rk < 2 ? bsd : 0.f;
          gs += __shfl_xor(gs, 1); gs += __shfl_xor(gs, 2); gs += __shfl_xor(gs, 4);
          int grk = 0;
#pragma unroll
          for (int gg = 0; gg < 8; ++gg) { const float vv = __shfl(gs, gg * 8); grk += (vv > gs) || (vv == gs && gg < g); }
          const bool gsel = grk < 4;
          const float mb = gsel ? bsd : -INFINITY;
          int erk = 0;
          for (int o = 0; o < 64; ++o) { const float vv = __shfl(mb, o); erk += (vv > mb) || (vv == mb && o < lane); }
          const bool sel = gsel && erk < TOPK;
          const float ssum = wave_sum(sel ? score : 0.f);
          if (sel) { const int lp = __hip_atomic_fetch_add(lcnt + lane, 1, __ATOMIC_RELAXED, __HIP_MEMORY_SCOPE_WORKGROUP);
                     EIDX[row * TOPK + erk] = lane; EW[row * TOPK + erk] = score / ssum * 2.5f; lent[(nb * 32 + rbk) * TOPK + erk] = (lane << 16) | lp; } }
        __syncthreads();
    }
    if (F.tid < NE) { const int c = lcnt[F.tid]; lbase[F.tid] = c ? atomicAdd(&CNT[F.tid * 64], c) : 0; }
    __syncthreads();
    for (int i = F.tid; i < nb * 256; i += NTHREADS) { const int blk = F.vcu + (i >> 8) * F.G, row = blk * 32 + ((i >> 3) & 31), v = lent[i]; const int pos = lbase[v >> 16] + (v & 0xffff); EPOS[row * TOPK + (i & 7)] = pos; TOKE[(v >> 16) * NTOK + pos] = row; }
    __syncthreads();
}
__device__ __forceinline__ void y16(const unsigned char* p, float (&f)[16]) {
    const u32x4 w = *(const GAS u32x4*)p;
#pragma unroll
    for (int i = 0; i < 4; ++i) { const auto lo = __builtin_amdgcn_cvt_pk_f32_fp8((int)w[i], false), hi = __builtin_amdgcn_cvt_pk_f32_fp8((int)w[i], true); f[4 * i] = lo[0]; f[4 * i + 1] = lo[1]; f[4 * i + 2] = hi[0]; f[4 * i + 3] = hi[1]; }
}
__device__ __forceinline__ void ph_comb(Frame& F, const Args& args, const float* mod) {
    const int gw = F.vcu * NWAVES + F.wave, NGW = F.G * NWAVES, lane = F.lane;
    moe_tables(F, 4);
    LAS int* T = (LAS int*)(F.lds + SCHT_OFF);
    const float* EW = (const float*)(F.ws + WS_EW); const int* EIDX = (const int*)(F.ws + WS_EIDX); const int* EPOS = (const int*)(F.ws + WS_EPOS); const unsigned char* Y = (const unsigned char*)(F.ws + WS_YBIG);
    for (int t = gw; t < NTOK; t += NGW) {
        const float* g2 = mod + (t / SEQ) * MODC + 5 * DM;
        int sl[TOPK]; float wk[TOPK];
#pragma unroll
        for (int k = 0; k < TOPK; ++k) { sl[k] = T[80 + EIDX[t * TOPK + k]] + EPOS[t * TOPK + k]; wk[k] = EW[t * TOPK + k]; }
#pragma unroll
        for (int j = 0; j < 2; ++j) { const int col = j * 1024 + lane * 16;
            float a[16]; y16(Y + (size_t)(NSLOT + t) * DM + col, a);
#pragma unroll
            for (int k = 0; k < TOPK; ++k) { float y[16]; y16(Y + (size_t)sl[k] * DM + col, y);
#pragma unroll
                for (int c = 0; c < 16; ++c) a[c] += wk[k] * y[c]; }
            float* o = args.out + (size_t)t * DM + col; const float* xi = (const float*)(F.ws + WS_X2) + (size_t)t * DM + col;
#pragma unroll
            for (int n = 0; n < 4; ++n) { const f32x4 xv = *(const GAS f32x4*)(xi + 4 * n), gv = *(const GAS f32x4*)(g2 + col + 4 * n);
                *(GAS f32x4*)(o + 4 * n) = xv + gv * (f32x4){a[4 * n], a[4 * n + 1], a[4 * n + 2], a[4 * n + 3]}; } }
    }
}

enum { PH_PRO = 0, PH_NORM1, PH_INPROJ, PH_QKNORM, PH_ATTN, PH_F2, PH_MERGE, PH_OUT, PH_ROUTE, PH_EXP1, PH_EXP2, PH_COMB, PH_END };


__global__ void __launch_bounds__(NTHREADS, 2) fwd(Args args) {
    extern __shared__ __attribute__((aligned(16))) unsigned char lds_raw[];
    Frame F;
    F.lds = (LAS unsigned char*)lds_raw; F.MISC = (volatile LAS unsigned*)(F.lds + MISC_OFF); F.ws = args.ws;
    F.tid = threadIdx.x; F.lane = F.tid & 63; F.wave = __builtin_amdgcn_readfirstlane(F.tid >> 6);
    F.G = gridDim.x; { const int bx = blockIdx.x; F.vcu = (F.G % 8 == 0) ? (bx % 8) * (F.G / 8) + bx / 8 : bx; }
    for (int u = F.tid; u < (LDS_BYTES - LDSCTL_OFF) / 4; u += NTHREADS) ((LAS unsigned*)(F.lds + LDSCTL_OFF))[u] = 0u;
    __syncthreads();
    const int lo = args.ph_lo, hi = args.ph_hi;
    const bool multi = (hi - lo) > 1;
    unsigned* barw = (unsigned*)(args.ws + CTL_BAR) + args.bar_idx * XCD_BAR_WORDS;
    XcdBarrier bar; bar.bar = barw; bar.x = 0; bar.st = nullptr;
    if (multi) bar = xcd_barrier_post(barw, F.MISC + 8);
#define IN(k) (lo <= (k) && (k) < hi)
#define SEAM(k) do { if (IN((k) + 1)) xcd_barrier(bar); } while (0)

    const float* modp = (const float*)(args.ws + args.mod_off);
    if (IN(PH_PRO)) { p0_prologue(F, args); SEAM(PH_PRO); }
    if (IN(PH_NORM1)) { ph_norm1(F, args, modp); SEAM(PH_NORM1); }
    if (IN(PH_INPROJ)) {
        SchedIn S{F.G, (int)blockIdx.x, args.ws, args.use_ut};
        EpiIn E{EpiStore{(const float*)(args.ws + WS_W2048)}, (LAS float*)(F.lds + GPARK_OFF), args.in[8], args.in[9], (const float*)(args.ws + WS_ROPE)};
        gemm_phase<EpiIn, SchedIn, false>(F.lds, DM, DM, DM, S, E);
        SEAM(PH_INPROJ);
    }
    if (IN(PH_QKNORM)) { ph_evenodd(F, args); SEAM(PH_QKNORM); }
    if (IN(PH_ATTN)) {
        const int cs = F.vcu & 3;
        constexpr int NCONV = IT_EG + IT_EU + IT_ED;
        int qfirst, qcnt; { const int c = (int)blockIdx.x; if (F.G == 256) { qfirst = c < 136 ? c * 162 : 136 * 162 + (c - 136) * 226; qcnt = c < 136 ? 162 : 226; }
                             else { const int per = (NCONV + F.G - 1) / F.G; qfirst = c * per; qcnt = qfirst + per <= NCONV ? per : (NCONV - qfirst > 0 ? NCONV - qfirst : 0); } }
        const int gcnt = qfirst < IT_EG + IT_EU ? (qfirst + qcnt <= IT_EG + IT_EU ? qcnt : IT_EG + IT_EU - qfirst) : 0, gfirst = qfirst;
        const int ccnt = qcnt - gcnt, cfirst = qfirst + gcnt - (IT_EG + IT_EU);
#define CONV_ALL() do { conv_items(F, args, false, gfirst, gcnt); conv_items(F, args, true, cfirst, ccnt); } while (0)
        const bf16_t* Qp = (const bf16_t*)(args.ws + WS_Q); const bf16_t* Kp = (const bf16_t*)(args.ws + WS_KALL); const bf16_t* Vp = (const bf16_t*)(args.ws + WS_VALL); bf16_t* Op = (bf16_t*)(args.ws + WS_YA);
#define ATTN_UNIT(lin_) do { const int lin = (lin_); if (lin < 512) { const int x = (lin >> 5) & 7, j = (lin & 31) + 32 * (lin >> 8), b = x >> 2, kvh = x & 3, head = kvh * 4 + (j >> 4), qb = j & 15; \
            const size_t qo = ((size_t)(b * SEQ + qb * 256)) * DM + head * HD, ko = (size_t)b * SKV * KVW + kvh * HD; \
            attn::attn_dense_body(Qp + qo, Kp + ko, Vp + ko, Op + qo, SKV, (char*)lds_raw); __syncthreads(); } } while (0)
        if (cs == 0) { CONV_ALL(); __syncthreads(); }
        ATTN_UNIT(F.vcu);
        if (cs == 1) { CONV_ALL(); __syncthreads(); }
        ATTN_UNIT(F.vcu + F.G);
        for (int lin2 = F.vcu + 2 * F.G; lin2 < 512; lin2 += F.G) ATTN_UNIT(lin2);
        if (cs == 2) { CONV_ALL(); __syncthreads(); }
#undef ATTN_UNIT
        SchedAG S{F.G, (int)blockIdx.x, args.ws};
        gemm_phase<EpiStore, SchedAG, false>(F.lds, DM, DM, DM, S, EpiStore{(const float*)(args.ws + WS_W2048)});
        if (cs == 3) { __syncthreads(); CONV_ALL(); }
#undef CONV_ALL
        SEAM(PH_ATTN);
    }
    if (IN(PH_F2)) {
        SchedF2 S{F.G, (int)blockIdx.x, args.ws};
        gemm_phase<EpiStore, SchedF2, false>(F.lds, 512, DM, 512, S, EpiStore{(const float*)(args.ws + WS_W2048)});
        {
            const int idx = F.vcu * NTHREADS + F.tid;
            if (idx < 2 * FW) { const int b = idx >> 10, col = idx & 1023, k2 = col & 127; const float* al = (const float*)(args.ws + WS_ALT) + b * FW + (col & ~127); float s = 0.f;
                for (int c = 0; c < 128; ++c) s += al[c] * cospif((float)((c * k2) & 127) * (1.0f / 64.0f));
                ((bf16_t*)(args.ws + WS_YF))[((size_t)b * SEQ + SEQ / 2) * YFP + col] = f2bf(s * 0.0013810679320049757f); }
        }
        SEAM(PH_F2);
    }
    if (IN(PH_MERGE)) {
        unsigned char* ws = args.ws;
        SchedMerge S{F.G, (int)blockIdx.x, ws};
        gemm_phase<EpiMerge, SchedMerge, false>(F.lds, DM, DM, DM, S, EpiMerge{(const bf16_t*)(ws + WS_SGF), (const bf16_t*)(ws + WS_SGA), (bf16_t*)(ws + WS_YM)});
        SEAM(PH_MERGE);
    }
    if (IN(PH_OUT)) {
        unsigned char* ws = args.ws;
        SchedGrid S{F.G, (int)blockIdx.x, 32, 8, (const char*)(ws + WS_YM), (const char*)(ws + WS_WT_O), nullptr, (size_t)256 * DM * 2, (size_t)256 * DM * 2, DM, 4, 1, DM / BK};
        gemm_phase<EpiX2, SchedGrid, false>(F.lds, DM, DM, DM, S, EpiX2{args.in[0], modp, (float*)(ws + WS_X2)});
        SEAM(PH_OUT);
    }
    if (IN(PH_ROUTE)) { ph_route(F, args, modp); SEAM(PH_ROUTE); }
    if (IN(PH_EXP1)) {
        moe_tables(F, 4);
        SchedMoe<4, true> S{F.G, F.vcu, args.ws, (LAS int*)(F.lds + SCHT_OFF), (const int*)(args.ws + WS_TOKE)};
        gemm_phase<EpiAct, SchedMoe<4, true>, true, true>(F.lds, DM, DM / 2, DM / 2, S, EpiAct{});
        SEAM(PH_EXP1);
    }
    if (IN(PH_EXP2)) {
        moe_tables(F, 8);
        SchedMoe<8, false> S{F.G, F.vcu, args.ws, (LAS int*)(F.lds + SCHT_OFF), (const int*)(args.ws + WS_TOKE)};
        gemm_phase<EpiY8, SchedMoe<8, false>, false, true>(F.lds, EFF, EFF / 2, EFF / 2, S, EpiY8{});
        SEAM(PH_EXP2);
    }
    if (IN(PH_COMB)) { ph_comb(F, args, modp); }
#undef IN
#undef SEAM
}
}

extern "C" void kernel_launch(void* const* d_in, const int* in_sizes, int n_in, void* d_out, int out_size, void* d_ws, size_t ws_size, hipStream_t stream) {
    if (n_in != 22 || ws_size < WS_END2) return;
    float* out = (float*)d_out;
    unsigned char* ws = (unsigned char*)d_ws;
    hipMemsetAsync(ws + WS_CTL, 0, CTL_ZERO_BYTES, stream);
    static int grid = 0;
    if (!grid) {
        int dev = 0, cus = 0;
        if (hipGetDevice(&dev) != hipSuccess || hipDeviceGetAttribute(&cus, hipDeviceAttributeMultiprocessorCount, dev) != hipSuccess) { grid = -1; return; }
        if (hipFuncSetAttribute((const void*)mk::fwd, hipFuncAttributeMaxDynamicSharedMemorySize, mk::LDS_BYTES) != hipSuccess) { grid = -1; return; }
        grid = cus;
    }
    if (grid < 0) return;
    mk::Args a{}; int nlaunch = 0;
    for (int i = 0; i < 22; ++i) a.in[i] = (const float*)d_in[i];
    a.out = out; a.ws = ws; a.use_ut = 1; a.mod_off = (int)WS_MOD; a.do_attn = 1;
#define MK_LAUNCH(lo_, hi_) do { a.ph_lo = (lo_); a.ph_hi = (hi_); a.bar_idx = nlaunch++; hipLaunchKernelGGL(mk::fwd, dim3(grid), dim3(mk::NTHREADS), mk::LDS_BYTES, stream, a); } while (0)
    MK_LAUNCH(mk::PH_PRO, mk::PH_END);
}
```

```cpp
#include <hip/hip_runtime.h>
#include <stdint.h>
#include <math.h>

typedef unsigned short bf16_t;
typedef short bf16x8 __attribute__((ext_vector_type(8)));
typedef float f32x16 __attribute__((ext_vector_type(16)));
typedef float f32x4 __attribute__((ext_vector_type(4)));

constexpr int NB = 2, SEQ = 4096, DM = 2048, NTOK = NB * SEQ, CTXL = 256, NCTX = NB * CTXL, HD = 128, NH = 16, NKV = 4;
constexpr int SKV = SEQ + CTXL;
constexpr int FW = 1024, INC = 8192, Q_OFF = 1024, K_OFF = 3072, V_OFF = 3584, GF_OFF = 4096, GA_OFF = 6144;
constexpr int KVW = NKV * HD;
constexpr int NE = 64, TOPK = 8, EFF = 512, MODC = 6 * DM;
constexpr int NSLOT = NTOK * TOPK;
constexpr int NSLOT_ALL = NSLOT + NTOK;

constexpr size_t MiB = 1u << 20;
constexpr size_t WS_CTL = 0, CTL_ZERO_BYTES = 1 * MiB;
constexpr size_t CTL_CNT = 64 * 1024;
constexpr size_t WS_TW = 1 * MiB;
constexpr size_t WS_MOD = 1 * MiB + 64 * 1024;
constexpr size_t WS_OFFS = 1 * MiB + 256 * 1024;
constexpr size_t WS_EIDX = 2 * MiB;
constexpr size_t WS_EW = WS_EIDX + 256 * 1024;
constexpr size_t WS_EPOS = WS_EW + 256 * 1024;
constexpr size_t WS_SLOTOF = WS_EPOS + 256 * 1024;
constexpr size_t WS_TOKE = 300 * MiB;
constexpr size_t WS_H = 4 * MiB;
constexpr size_t WS_U = 38 * MiB;
constexpr size_t WS_Q = 54 * MiB;
constexpr size_t WS_KALL = 86 * MiB;
constexpr size_t WS_VALL = 95 * MiB;
constexpr size_t WS_SGF = 104 * MiB;
constexpr size_t WS_SGA = 136 * MiB;
constexpr size_t WS_YA = 168 * MiB;
constexpr size_t WS_YF = 38 * MiB;
constexpr int YFP = 2048;
constexpr size_t WS_PR = 216 * MiB;
constexpr size_t WS_T1 = 248 * MiB;
constexpr size_t WS_YM = 312 * MiB;
constexpr size_t WS_QKRAW = 248 * MiB;
constexpr size_t WS_KCRAW = 330 * MiB;
constexpr size_t WS_H2 = 344 * MiB;
constexpr size_t WS_ACT = 376 * MiB;
constexpr size_t WS_YBIG = 4 * MiB;
constexpr size_t WS_END = 740 * MiB;

__device__ __forceinline__ float bf2f(bf16_t h) { return __uint_as_float(((unsigned)h) << 16); }
__device__ __forceinline__ bf16_t f2bf(float f) { unsigned u = __float_as_uint(f); return (bf16_t)((u + 0x7fffu + ((u >> 16) & 1u)) >> 16); }
__device__ __forceinline__ int crow(int r, int hi) { return (r & 3) + 8 * (r >> 2) + 4 * hi; }
__device__ __forceinline__ float wave_sum(float v) {
#pragma unroll
    for (int o = 1; o < 64; o <<= 1) v += __shfl_xor(v, o);
    return v;
}
__device__ __forceinline__ float sigmoidf_(float v) { return 1.0f / (1.0f + expf(-v)); }
__device__ __forceinline__ bf16x8 pack8(const float* f) {
    bf16x8 r;
#pragma unroll
    for (int i = 0; i < 8; ++i) r[i] = (short)f2bf(f[i]);
    return r;
}

#define LAS __attribute__((address_space(3)))
#define GAS __attribute__((address_space(1)))
typedef unsigned u32x4 __attribute__((ext_vector_type(4)));
typedef GAS unsigned gu32;
#define RLX_AGENT __ATOMIC_RELAXED, __HIP_MEMORY_SCOPE_AGENT
#define LDS_WAIT() asm volatile("s_waitcnt lgkmcnt(0)" ::: "memory")
#define VM_WAIT() asm volatile("s_waitcnt vmcnt(0)" ::: "memory")

constexpr size_t CTL_BAR = 16384;
constexpr size_t CTL_MODZ = 512 * 1024;
constexpr size_t WS_UT = 38 * MiB;
constexpr size_t WS_TT = 216 * MiB;
constexpr size_t WS_WT_GU = 450 * MiB;
constexpr size_t WS_WT_D = 710 * MiB;
constexpr size_t WS_WT_IN = 840 * MiB;
constexpr size_t WS_WT_FO = 924 * MiB;
constexpr size_t WS_WT_AO = 876 * MiB;
constexpr size_t WS_WT_O = 884 * MiB;
constexpr size_t WS_CST = 892 * MiB;
constexpr size_t WS_ET = 908 * MiB;
constexpr size_t WS_OT = 916 * MiB;
constexpr size_t WS_W2048 = 1 * MiB + 512 * 1024;
constexpr size_t WS_ALT = 1 * MiB + 520 * 1024;
constexpr size_t WS_ROPE = 1 * MiB + 528 * 1024;
constexpr size_t WS_RWT = 3 * MiB + 512 * 1024;
constexpr size_t WS_BD2 = 956 * MiB;
constexpr size_t WS_H8 = 200 * MiB;
constexpr size_t WS_WT_G8 = 932 * MiB;
constexpr size_t WS_X2 = 960 * MiB;
constexpr size_t WS_END2 = 1024 * MiB;

namespace mk {
constexpr int NWAVES = 8, NTHREADS = 512;
constexpr int RING_BYTES = 131072, SCR_BYTES = 8 * 16640, LDSCTL_OFF = 135168, MISC_OFF = LDSCTL_OFF + 320, GPARK_OFF = LDSCTL_OFF + 2048  , LDS_BYTES = 147456;
static_assert(GPARK_OFF + 8192 <= LDS_BYTES, "LDS map");
static_assert(SCR_BYTES <= LDSCTL_OFF && MISC_OFF + 128 <= LDS_BYTES, "LDS map");

#define XB_TMO      128
#define XB_XCNT(j)  (256  + 64 * (j))
#define XB_XSUB(j)  (1280 + 64 * (j))
#define XB_XGEN(j)  (2304 + 64 * (j))
#define XB_TOP      3328
#define XB_TOPGEN   3392
#define XCD_BAR_WORDS 3456
#define XB_SPIN_CAP (1u << 18)
__device__ __forceinline__ unsigned xb_ld(unsigned* p)              { return __hip_atomic_load(p, __ATOMIC_RELAXED, __HIP_MEMORY_SCOPE_AGENT); }
__device__ __forceinline__ unsigned xb_add(unsigned* p, unsigned v) { return __hip_atomic_fetch_add(p, v, __ATOMIC_RELAXED, __HIP_MEMORY_SCOPE_AGENT); }
__device__ __forceinline__ unsigned xb_xcc_id() { return (unsigned)__builtin_amdgcn_s_getreg((3 << 11) | 20) & 0xFu; }
#define XB_SPIN(cond, bar) do { unsigned _sp = 0; while (cond) { __builtin_amdgcn_s_sleep(1); \
    if ((++_sp & 255u) == 0u) { if (xb_ld(&(bar)[XB_TMO])) break; if (_sp > XB_SPIN_CAP) { atomicAdd(&(bar)[XB_TMO], 1u); break; } } } } while (0)
struct XcdBarrier { unsigned* bar; unsigned x; volatile LAS unsigned* st; };
__device__ __forceinline__ XcdBarrier xcd_barrier_post(unsigned* bar, volatile LAS unsigned* st) {
    XcdBarrier b; b.bar = bar; b.x = xb_xcc_id(); b.st = st;
    if (threadIdx.x == 0) (void)xb_add(&bar[XB_XCNT(b.x)], 1u);
    return b;
}
__device__ __forceinline__ void xcd_barrier_complete(unsigned* bar, unsigned x, unsigned& nloc, unsigned& nx) {
    const unsigned G = gridDim.x * gridDim.y * gridDim.z;
    unsigned sum, cnt, mine, sp = 0u;
    for (;;) {
        sum = 0u; cnt = 0u; mine = 0u;
#pragma unroll
        for (unsigned j = 0; j < 16; ++j) { const unsigned c = xb_ld(&bar[XB_XCNT(j)]); sum += c; cnt += (c > 0u) ? 1u : 0u; mine = (j == x) ? c : mine; }
        if (sum == G) break;
        __builtin_amdgcn_s_sleep(1);
        if ((++sp & 255u) == 0u) { if (xb_ld(&bar[XB_TMO])) break; if (sp > XB_SPIN_CAP) { atomicAdd(&bar[XB_TMO], 1u); break; } }
    }
    nloc = mine > 0u ? mine : 1u; nx = cnt > 0u ? cnt : 1u;
}
__device__ __forceinline__ void xcd_barrier(const XcdBarrier& b) {
    asm volatile("s_waitcnt vmcnt(0)" ::: "memory");
    __syncthreads();
    if (threadIdx.x == 0) {
        unsigned* bar = b.bar;
        __builtin_amdgcn_s_waitcnt(0);
        unsigned nloc = b.st[0], nx = b.st[1];
        if (nloc == 0u) { xcd_barrier_complete(bar, b.x, nloc, nx); b.st[0] = nloc; b.st[1] = nx; }
        const unsigned old = xb_add(&bar[XB_XSUB(b.x)], 1u);
        const unsigned gen = old / nloc;
        if (old + 1u == (gen + 1u) * nloc) {
            __builtin_amdgcn_fence(__ATOMIC_RELEASE, "agent");
            asm volatile("s_waitcnt vmcnt(0)" ::: "memory");
            const unsigned og = xb_add(&bar[XB_TOP], 1u);
            const unsigned tg = og / nx;
            if (og + 1u == (tg + 1u) * nx) xb_add(&bar[XB_TOPGEN], 1u);
            else XB_SPIN(xb_ld(&bar[XB_TOPGEN]) == tg, bar);
            __builtin_amdgcn_fence(__ATOMIC_ACQUIRE, "agent");
            xb_add(&bar[XB_XGEN(b.x)], 1u);
            asm volatile("s_waitcnt vmcnt(0)" ::: "memory");
        } else {
            XB_SPIN(xb_ld(&bar[XB_XGEN(b.x)]) == gen, bar);
            __builtin_amdgcn_fence(__ATOMIC_ACQUIRE, "agent");
            asm volatile("s_waitcnt vmcnt(0)" ::: "memory");
        }
    }
    __syncthreads();
}

constexpr int BM = 256, BK = 64, HALF = 128, HTB = HALF * BK * 2, STAGE_BYTES = 8 * HTB;
__device__ __forceinline__ int lds_byte(int r, int c) { const int st = (r >> 4) * 2 + (c >> 5), rr = r & 15, cc = c & 31, ob = rr * 64 + cc * 2; return st * 1024 + (ob ^ (((ob >> 9) & 1) << 5)); }
__device__ __forceinline__ void stage_rc(int b, int& R, int& C) { const int st = b / 1024, sb = b % 1024, swz = sb ^ (((sb >> 9) & 1) << 5); R = (st >> 1) * 16 + swz / 64; C = (st & 1) * 32 + (swz % 64) / 2; }
__device__ __forceinline__ int perm32(int rho) { const int n = rho >> 4, i = rho & 15; return 8 * (i >> 2) + 4 * n + (i & 3); }
__device__ __forceinline__ unsigned cvt_pk_bf16(float lo, float hi) { unsigned r; asm("v_cvt_pk_bf16_f32 %0, %1, %2" : "=v"(r) : "v"(lo), "v"(hi)); return r; }

__device__ __forceinline__ void glds16_s(const void* sbase, unsigned voff, unsigned lds_dst) { unsigned keep;
    asm volatile("s_mov_b32 %0, m0\n\ts_mov_b32 m0, %3\n\ts_nop 0\n\tglobal_load_lds_dwordx4 %1, %2\n\ts_mov_b32 m0, %0" : "=&s"(keep) : "v"(voff), "s"(sbase), "s"(lds_dst) : "memory"); }

struct Unit { const char* A; const char* B; char* C; int ldc; int mode; int rows; int aux; int pm, pn, bjs, rmin, e, nt, keep; };

typedef int i32x8 __attribute__((ext_vector_type(8)));
typedef int i32x4 __attribute__((ext_vector_type(4)));
template <class Epi, class Sched, bool GATHER, bool F8 = false>
__device__ __forceinline__ void gemm_phase(LAS unsigned char* lds, const int K, const int lda, const int ldb, const Sched& S, const Epi& E, const int i0 = 0, const int i1 = 0x7fffffff) {
    const int tid = threadIdx.x, wid = __builtin_amdgcn_readfirstlane(tid >> 6), lane = tid & 63, wr = wid >> 2, wc = wid & 3, fr = lane & 15, fq = lane >> 4;
    unsigned voffA[2], voffB[2];
#pragma unroll
    for (int i = 0; i < 2; ++i) { int R, C; stage_rc(tid * 16 + i * 8192, R, C); const int Rb = (R & ~31) + perm32(R & 31);
        voffA[i] = (unsigned)(R * lda + C) * 2u; voffB[i] = (unsigned)(Rb * ldb + C) * 2u; }
    const size_t kstep = (size_t)(BK * 2);
    const size_t hstepA = (size_t)HALF * lda * 2, hstepB = (size_t)HALF * ldb * 2;
    const unsigned ldsw = (unsigned)wid * 1024u;
    const unsigned ldsbase = (unsigned)__builtin_amdgcn_readfirstlane((int)(unsigned)(uintptr_t)lds);
    const int aoff = F8 ? lds_byte(wr * 64 + fr, (fq >> 1) * 32 + (fq & 1) * 16) : lds_byte(wr * 64 + fr, fq * 8), boff = F8 ? lds_byte(wc * 32 + fr, (fq >> 1) * 32 + (fq & 1) * 16) : lds_byte(wc * 32 + fr, fq * 8);

#define MK_SA(b, h) (((b) * 2 + (h)) * HTB)
#define MK_SB(b, h) ((4 + (b) * 2 + (h)) * HTB)
#define MK_STAGE2(bufoff, gbase, v0, v1) do { \
        __builtin_amdgcn_global_load_lds((const unsigned*)((const char*)(gbase) + (v0)), (LAS unsigned*)(lds + (bufoff) + ldsw), 16, 0, 0); \
        __builtin_amdgcn_global_load_lds((const unsigned*)((const char*)(gbase) + (v1)), (LAS unsigned*)(lds + (bufoff) + ldsw + 8192), 16, 0, 0); } while (0)
#define MK_STAGE_B(bufoff, gbase) do { glds16_s((gbase), voffB[0], ldsbase + (bufoff) + ldsw); glds16_s((gbase), voffB[1], ldsbase + (bufoff) + ldsw + 8192u); } while (0)
#define MK_STAGE_A(bufoff, gbase, h, VA) do { if constexpr (GATHER) { glds16_s((gbase), (VA)[h][0], ldsbase + (bufoff) + ldsw); glds16_s((gbase), (VA)[h][1], ldsbase + (bufoff) + ldsw + 8192u); } \
        else { glds16_s((gbase) + (h) * hstepA, voffA[0], ldsbase + (bufoff) + ldsw); glds16_s((gbase) + (h) * hstepA, voffA[1], ldsbase + (bufoff) + ldsw + 8192u); } } while (0)
#define MK_LDA(dst, b, h) do { if constexpr (F8) { _Pragma("unroll") for (int m = 0; m < 4; ++m) dst##8[m] = *(const LAS i32x8*)(lds + MK_SA(b, h) + aoff + m * 2048); } \
        else { _Pragma("unroll") for (int m = 0; m < 4; ++m) _Pragma("unroll") for (int k = 0; k < 2; ++k) dst[m][k] = *(const LAS bf16x8*)(lds + MK_SA(b, h) + aoff + m * 2048 + k * 1024); } } while (0)
#define MK_LDB(dst, b, h) do { if constexpr (F8) { _Pragma("unroll") for (int n = 0; n < 2; ++n) dst##8[n] = *(const LAS i32x8*)(lds + MK_SB(b, h) + boff + n * 2048); } \
        else { _Pragma("unroll") for (int n = 0; n < 2; ++n) _Pragma("unroll") for (int k = 0; k < 2; ++k) dst[n][k] = *(const LAS bf16x8*)(lds + MK_SB(b, h) + boff + n * 2048 + k * 1024); } } while (0)
#define MK_MMA(ai, bj, At, Bt) do { __builtin_amdgcn_s_setprio(1); \
        if constexpr (F8) { _Pragma("unroll") for (int m = 0; m < 4; ++m) _Pragma("unroll") for (int n = 0; n < 2; ++n) \
            acc[ai][bj][m][n] = __builtin_amdgcn_mfma_scale_f32_16x16x128_f8f6f4(Bt##8[n], At##8[m], acc[ai][bj][m][n], 0, 0, 0, 0x7d, 0, 0x7d  ); } \
        else { _Pragma("unroll") for (int m = 0; m < 4; ++m) _Pragma("unroll") for (int n = 0; n < 2; ++n) _Pragma("unroll") for (int k = 0; k < 2; ++k) \
            acc[ai][bj][m][n] = __builtin_amdgcn_mfma_f32_16x16x32_bf16(Bt[n][k], At[m][k], acc[ai][bj][m][n], 0, 0, 0); } \
        __builtin_amdgcn_s_setprio(0); } while (0)
#define MK_WAIT_V(n) asm volatile("s_waitcnt vmcnt(" #n ")" ::: "memory")
#define MK_WAIT_L(n) asm volatile("s_waitcnt lgkmcnt(" #n ")" ::: "memory")
#define MK_BAR __builtin_amdgcn_s_barrier()
#define MK_SCHED __builtin_amdgcn_sched_barrier(0)
    Unit cur, nxt; int ui = i0;
    if (i0 >= i1 || !S.next(i0, cur)) return;
    f32x4 acc[2][2][4][2];
#pragma unroll
    for (int a = 0; a < 2; ++a)
#pragma unroll
        for (int b = 0; b < 2; ++b)
#pragma unroll
            for (int m = 0; m < 4; ++m)
#pragma unroll
                for (int n = 0; n < 2; ++n) acc[a][b][m][n] = (f32x4){0.f, 0.f, 0.f, 0.f};
    bf16x8 At[4][2], B0[2][2], B1[2][2]; i32x8 At8[4], B08[2], B18[2];
    unsigned vC[2][2];
    LAS u32x4* vpark = (LAS u32x4*)(lds + GPARK_OFF) + tid;
    if constexpr (GATHER) {
#pragma unroll
        for (int h = 0; h < 2; ++h)
#pragma unroll
            for (int i = 0; i < 2; ++i) { int R, C; stage_rc(tid * 16 + i * 8192, R, C); vC[h][i] = S.arow(cur, h * HALF + R) + (unsigned)(C * 2); }
    }
    const char* cA = cur.A; const char* cB = cur.B;
    MK_STAGE_B(MK_SB(0, 0), cB); MK_STAGE_B(MK_SB(0, 1), cB + hstepB); MK_STAGE_A(MK_SA(0, 0), cA, 0, vC); MK_STAGE_A(MK_SA(0, 1), cA, 1, vC);
    if (wr == 1) MK_BAR;
    MK_WAIT_V(2); MK_BAR;
    MK_STAGE_B(MK_SB(1, 0), cB + kstep); MK_STAGE_A(MK_SA(1, 0), cA + kstep, 0, vC); MK_STAGE_B(MK_SB(1, 1), cB + hstepB + kstep);
    MK_WAIT_V(6); MK_BAR;
    for (;;) {
        const bool has_next = (ui + 1 < i1) && S.next(ui + 1, nxt);
        const char* nA = has_next ? nxt.A : cA; const char* nB = has_next ? nxt.B : cB;
        if constexpr (GATHER) {
            u32x4 pv;
#pragma unroll
            for (int h = 0; h < 2; ++h)
#pragma unroll
                for (int i = 0; i < 2; ++i) { int R, C; stage_rc(tid * 16 + i * 8192, R, C); pv[h * 2 + i] = has_next ? (S.arow(nxt, h * HALF + R) + (unsigned)(C * 2)) : vC[h][i]; }
            *vpark = pv;
        }
        int nt = cur.nt; asm volatile("" : "+s"(nt));
#pragma nounroll
        for (int t = 0; t < nt; t += 2) {
            const bool last = (t == nt - 2);
            const char* a1 = cA + (size_t)(t + 1) * kstep;
            const char* a2 = last ? nA : cA + (size_t)(t + 2) * kstep; const char* b2 = last ? nB : cB + (size_t)(t + 2) * kstep;
            const char* a3 = a2 + kstep; const char* b3 = b2 + kstep;
            MK_LDB(B0, 0, 0); MK_LDB(B1, 0, 1); MK_SCHED; MK_LDA(At, 0, 0); MK_STAGE_A(MK_SA(1, 1), a1, 1, vC);
            if constexpr (GATHER) { if (last) { const u32x4 pv = *vpark; vC[0][0] = pv[0]; vC[0][1] = pv[1]; vC[1][0] = pv[2]; vC[1][1] = pv[3]; } }
            MK_WAIT_V(8); MK_WAIT_L(0); MK_BAR; MK_MMA(0, 0, At, B0); MK_MMA(0, 1, At, B1); MK_BAR; MK_SCHED;
            MK_LDA(At, 0, 1); MK_STAGE_B(MK_SB(0, 0), b2); MK_STAGE_B(MK_SB(0, 1), b2 + hstepB); MK_STAGE_A(MK_SA(0, 0), a2, 0, vC);
            MK_WAIT_V(8); MK_WAIT_L(0); MK_BAR; MK_MMA(1, 0, At, B0); MK_MMA(1, 1, At, B1); MK_BAR; MK_SCHED;
            MK_LDB(B0, 1, 0); MK_LDB(B1, 1, 1); MK_SCHED; MK_LDA(At, 1, 0); MK_STAGE_A(MK_SA(0, 1), a2, 1, vC);
            MK_WAIT_V(8); MK_WAIT_L(0); MK_BAR; MK_MMA(0, 0, At, B0); MK_MMA(0, 1, At, B1); MK_BAR; MK_SCHED;
            MK_LDA(At, 1, 1); MK_STAGE_B(MK_SB(1, 0), b3); MK_STAGE_B(MK_SB(1, 1), b3 + hstepB); MK_STAGE_A(MK_SA(1, 0), a3, 0, vC);
            MK_WAIT_V(8); MK_WAIT_L(0); MK_BAR; MK_MMA(1, 0, At, B0); MK_MMA(1, 1, At, B1); MK_BAR; MK_SCHED;
        }
        if (wr == 0) MK_BAR;
        { int l2; asm volatile("v_mbcnt_lo_u32_b32 %0, -1, 0\n\tv_mbcnt_hi_u32_b32 %0, -1, %0" : "=v"(l2));
          E(acc, cur, wr, wc, l2 & 15, l2 >> 4); }
        if (!has_next) break;
        if (!cur.keep)
#pragma unroll
        for (int a = 0; a < 2; ++a)
#pragma unroll
            for (int b = 0; b < 2; ++b)
#pragma unroll
                for (int m = 0; m < 4; ++m)
#pragma unroll
                    for (int n = 0; n < 2; ++n) acc[a][b][m][n] = (f32x4){0.f, 0.f, 0.f, 0.f};
        cur = nxt; cA = nA; cB = nB; ++ui;
        if (wr == 1) MK_BAR;
    }
    MK_WAIT_V(0);
    MK_BAR;
#undef MK_SA
#undef MK_SB
#undef MK_STAGE2
#undef MK_STAGE_B
#undef MK_STAGE_A
#undef MK_LDA
#undef MK_LDB
#undef MK_MMA
#undef MK_WAIT_V
#undef MK_WAIT_L
#undef MK_BAR
#undef MK_SCHED
}

__device__ __forceinline__ void grid_map(int L, int nM, int nN, int& pm, int& pn) {
    const int nwg = nM * nN, q = nwg / 8, xcd = L % 8, off = L / 8; const int wgid = xcd * q + off;
    const int nig = 8 * nN, gid = wgid / nig, fm = gid * 8, gsz = (nM - fm) < 8 ? (nM - fm) : 8;
    pm = fm + ((wgid % nig) % gsz); pn = (wgid % nig) / gsz;
}

struct EpiStore {
    const float* w2048;
    __device__ __forceinline__ void operator()(f32x4 (&acc)[2][2][4][2], const Unit& u, int wr, int wc, int fr, int fq) const {
        const int col0 = wc * 32 + 8 * fq;
#pragma unroll
        for (int ai = 0; ai < 2; ++ai)
#pragma unroll
            for (int m = 0; m < 4; ++m) {
                const int r = ai * HALF + wr * 64 + m * 16 + fr;
                if (r < u.rows && r >= u.rmin) {
#pragma unroll
                    for (int bj = 0; bj < 2; ++bj) {
                        f32x4 v0 = acc[ai][bj][m][0], v1 = acc[ai][bj][m][1];
                        if (u.mode == 1) { float* p = (float*)u.C + (long)r * u.ldc + col0 + bj * u.bjs; *(f32x4*)p = v0; *(f32x4*)(p + 4) = v1; }
                        else {
                            if (u.mode == 2) {
#pragma unroll
                                for (int c = 0; c < 4; ++c) { v0[c] = __builtin_amdgcn_rcpf(1.0f + __expf(-v0[c])); v1[c] = __builtin_amdgcn_rcpf(1.0f + __expf(-v1[c])); }
                            } else if (u.mode == 3) {
                                const float* wp = w2048 + u.pn + bj * HALF + col0; const float sg = (r & 1) ? -1.0f : 1.0f;
                                v0 += *(const f32x4*)wp * sg; v1 += *(const f32x4*)(wp + 4) * sg;
                            }
                            u32x4 w; w.x = cvt_pk_bf16(v0[0], v0[1]); w.y = cvt_pk_bf16(v0[2], v0[3]); w.z = cvt_pk_bf16(v1[0], v1[1]); w.w = cvt_pk_bf16(v1[2], v1[3]);
                            *(u32x4*)((bf16_t*)u.C + (long)r * u.ldc + col0 + bj * u.bjs) = w;
                        }
                    }
                }
            }
    }
};


struct EpiIn { EpiStore base; LAS float* red; const float* qnw; const float* knw; const float* rope;
    __device__ __forceinline__ void operator()(f32x4 (&acc)[2][2][4][2], const Unit& u, int wr, int wc, int fr, int fq) const {
        if (u.mode < 5) { base(acc, u, wr, wc, fr, fq); return; }
#pragma unroll
        for (int ai = 0; ai < 2; ++ai)
#pragma unroll
            for (int m = 0; m < 4; ++m)
#pragma unroll
                for (int bj = 0; bj < 2; ++bj) { const f32x4 a = acc[ai][bj][m][0], b = acc[ai][bj][m][1];
                    float s = (a[0] * a[0] + a[1] * a[1]) + (a[2] * a[2] + a[3] * a[3]) + (b[0] * b[0] + b[1] * b[1]) + (b[2] * b[2] + b[3] * b[3]);
                    s += __shfl_xor(s, 16); s += __shfl_xor(s, 32);
                    if (fq == 0) red[((ai * HALF + wr * 64 + m * 16 + fr) * 2 + bj) * 4 + wc] = s; }
        asm volatile("s_waitcnt lgkmcnt(0)" ::: "memory"); __builtin_amdgcn_s_barrier(); asm volatile("" ::: "memory");
        const float* nw = u.mode == 5 ? qnw : knw;
        const int axis = wc >> 1, f0 = (wc & 1) * 16 + fq * 4, da = axis * 64 + f0;
        const f32x4 wa = *(const f32x4*)(nw + da), wb = *(const f32x4*)(nw + da + 32);
#pragma unroll
        for (int ai = 0; ai < 2; ++ai)
#pragma unroll
            for (int m = 0; m < 4; ++m) { const int r = ai * HALF + wr * 64 + m * 16 + fr;
                f32x4 cs = {1.f, 1.f, 1.f, 1.f}, sn = {0.f, 0.f, 0.f, 0.f};
                if (u.mode != 7) { const int t = u.pm + r, pos = axis ? (t & 63) : (t >> 6); const float* rp = rope + (pos * 32 + f0) * 2;
                    const f32x4 p0 = *(const f32x4*)rp, p1 = *(const f32x4*)(rp + 4); cs = (f32x4){p0[0], p0[2], p1[0], p1[2]}; sn = (f32x4){p0[1], p0[3], p1[1], p1[3]}; }
#pragma unroll
                for (int bj = 0; bj < 2; ++bj) { const LAS f32x4* pp = (const LAS f32x4*)(red + (r * 2 + bj) * 4); const f32x4 ps = *pp;
                    const float rstd = 1.0f / sqrtf(((ps[0] + ps[1]) + (ps[2] + ps[3])) * (1.0f / HD) + 1e-6f);
                    const f32x4 xa = acc[ai][bj][m][0] * rstd * wa, xb = acc[ai][bj][m][1] * rstd * wb;
                    const f32x4 oa = xa * cs - xb * sn, ob = xb * cs + xa * sn;
                    u32x4 w; w.x = cvt_pk_bf16(oa[0], oa[1]); w.y = cvt_pk_bf16(oa[2], oa[3]); w.z = cvt_pk_bf16(ob[0], ob[1]); w.w = cvt_pk_bf16(ob[2], ob[3]);
                    *(u32x4*)((bf16_t*)u.C + (long)r * u.ldc + bj * HALF + wc * 32 + 8 * fq) = w; } }
    } };


__device__ __forceinline__ void pack8_fp8(const f32x4& a, const f32x4& b, unsigned& w0, unsigned& w1) {
    f32x4 v0 = a, v1 = b;
#pragma unroll
    for (int c = 0; c < 4; ++c) { v0[c] = fminf(fmaxf(v0[c], -448.f), 448.f); v1[c] = fminf(fmaxf(v1[c], -448.f), 448.f); }
    int x0 = 0, x1 = 0;
    x0 = __builtin_amdgcn_cvt_pk_fp8_f32(v0[0], v0[1], x0, false); x0 = __builtin_amdgcn_cvt_pk_fp8_f32(v0[2], v0[3], x0, true);
    x1 = __builtin_amdgcn_cvt_pk_fp8_f32(v1[0], v1[1], x1, false); x1 = __builtin_amdgcn_cvt_pk_fp8_f32(v1[2], v1[3], x1, true);
    w0 = (unsigned)x0; w1 = (unsigned)x1;
}
__device__ __forceinline__ void store16_s(const void* sbase, unsigned voff, u32x4 v) { asm volatile("global_store_dwordx4 %0, %1, %2\n\ts_nop 0" :: "v"(voff), "v"(v), "s"(sbase) : "memory"); }
struct EpiY8 {
    __device__ __forceinline__ void operator()(f32x4 (&acc)[2][2][4][2], const Unit& u, int wr, int wc, int fr, int fq) const {
        const int odd = fq & 1;
        const unsigned off0 = (unsigned)((wr * 64 + fr) * u.ldc + odd * HALF + wc * 32 + 8 * (fq - odd));
        const int r0 = wr * 64 + fr;
#pragma unroll
        for (int ai = 0; ai < 2; ++ai)
#pragma unroll
            for (int m = 0; m < 4; ++m) {
                unsigned a0, a1, b0, b1; pack8_fp8(acc[ai][0][m][0], acc[ai][0][m][1], a0, a1); pack8_fp8(acc[ai][1][m][0], acc[ai][1][m][1], b0, b1);
                const auto s0 = __builtin_amdgcn_permlane16_swap(a0, b0, false, false), s1 = __builtin_amdgcn_permlane16_swap(a1, b1, false, false);
                if (r0 + ai * HALF + m * 16 < u.rows) { const u32x4 w = {s0[0], s1[0], s0[1], s1[1]}; store16_s(u.C, off0 + (unsigned)((ai * HALF + m * 16) * u.ldc), w); } }
    } };


struct EpiGate {
    __device__ __forceinline__ void operator()(f32x4 (&acc)[2][2][4][2], const Unit& u, int wr, int wc, int fr, int fq) const {
        bf16_t* base = (bf16_t*)u.C + (size_t)(wr * 64 + fr) * u.ldc + wc * 32 + 8 * fq;
#pragma unroll
        for (int ai = 0; ai < 2; ++ai)
#pragma unroll
            for (int m = 0; m < 4; ++m) { bf16_t* p = base + (size_t)(ai * HALF + m * 16) * u.ldc;
#pragma unroll
                for (int bj = 0; bj < 2; ++bj) { f32x4 v0 = acc[ai][bj][m][0], v1 = acc[ai][bj][m][1];
#pragma unroll
                    for (int c = 0; c < 4; ++c) { v0[c] = __builtin_amdgcn_rcpf(1.0f + __expf(-v0[c])); v1[c] = __builtin_amdgcn_rcpf(1.0f + __expf(-v1[c])); }
                    u32x4 w; w.x = cvt_pk_bf16(v0[0], v0[1]); w.y = cvt_pk_bf16(v0[2], v0[3]); w.z = cvt_pk_bf16(v1[0], v1[1]); w.w = cvt_pk_bf16(v1[2], v1[3]);
                    *(u32x4*)(p + bj * HALF) = w; } }
    } };

struct Args { const float* in[22]; float* out; unsigned char* ws; int ph_lo, ph_hi, use_ut, mod_off, do_attn, bar_idx; };
struct Frame {
    LAS unsigned char* lds; volatile LAS unsigned* MISC; unsigned char* ws;
    int tid, lane, wave, vcu, G;
};

__device__ __forceinline__ int qk_col_of_dim(int d) { const int a = d >> 6, half = (d >> 5) & 1, f = d & 31; return 32 * (2 * a + (f >> 4)) + 8 * ((f >> 2) & 3) + 4 * half + (f & 3); }
__device__ __forceinline__ void t64_load(f32x4 (&v)[16], const float* W, int ldw, int lane) {
    const unsigned off = (unsigned)(((lane >> 4) * ldw + (lane & 15) * 4) * 4);
#pragma unroll
    for (int j = 0; j < 16; ++j) { const char* bj = (const char*)W + (size_t)(j * 4) * ldw * 4; v[j] = __builtin_nontemporal_load((const GAS f32x4*)(bj + off)); }
}
template <bool QKPERM = false, bool F8OUT = false>
__device__ __forceinline__ void t64_store(const f32x4 (&v)[16], bf16_t* dst, int ldd, LAS float* scr, int lane, int d0 = 0) {
    const int kk = lane >> 4, nc = (lane & 15) * 4;
#pragma unroll
    for (int j = 0; j < 16; ++j) {
#pragma unroll
        for (int c = 0; c < 4; ++c) scr[(j * 4 + kk) * 65 + nc + c] = v[j][c]; }
    LDS_WAIT(); asm volatile("" ::: "memory");
    const int kc = lane & 7; const unsigned soff = F8OUT ? (unsigned)((lane >> 3) * ldd + 8 * kc) : (unsigned)(((lane >> 3) * ldd + 8 * kc) * 2);
#pragma unroll
    for (int jj = 0; jj < 8; jj += 2) {
        float t[2][8];
#pragma unroll
        for (int q = 0; q < 2; ++q) { const int n = (lane >> 3) + 8 * (jj + q); const LAS float* s = scr + (8 * kc) * 65 + n;
#pragma unroll
            for (int i = 0; i < 8; ++i) t[q][i] = s[i * 65]; }
#pragma unroll
        for (int q = 0; q < 2; ++q) { char* bq = (char*)dst + (size_t)(8 * (jj + q)) * ldd * (F8OUT ? 1 : 2);
            if constexpr (QKPERM) bq = (char*)dst + (size_t)(qk_col_of_dim(d0 + (lane >> 3) + 8 * (jj + q)) - (lane >> 3)) * ldd * 2;
            if constexpr (F8OUT) { float s[8];
#pragma unroll
                for (int i = 0; i < 8; ++i) s[i] = fminf(fmaxf(t[q][i] * 16.0f, -448.f), 448.f);
                int w0 = 0, w1 = 0; w0 = __builtin_amdgcn_cvt_pk_fp8_f32(s[0], s[1], w0, false); w0 = __builtin_amdgcn_cvt_pk_fp8_f32(s[2], s[3], w0, true);
                w1 = __builtin_amdgcn_cvt_pk_fp8_f32(s[4], s[5], w1, false); w1 = __builtin_amdgcn_cvt_pk_fp8_f32(s[6], s[7], w1, true);
                __builtin_nontemporal_store((unsigned long long)(unsigned)w0 | ((unsigned long long)(unsigned)w1 << 32), (GAS unsigned long long*)(bq + soff)); }
            else { u32x4 o; o.x = cvt_pk_bf16(t[q][0], t[q][1]); o.y = cvt_pk_bf16(t[q][2], t[q][3]); o.z = cvt_pk_bf16(t[q][4], t[q][5]); o.w = cvt_pk_bf16(t[q][6], t[q][7]);
                __builtin_nontemporal_store(o, (GAS u32x4*)(bq + soff)); } } }
    LDS_WAIT(); asm volatile("" ::: "memory");
}
__device__ __forceinline__ void transpose64(const float* W, int ldw, bf16_t* dst, int ldd, LAS float* scr, int lane) {
    f32x4 v[16]; t64_load(v, W, ldw, lane); t64_store(v, dst, ldd, scr, lane);
}

constexpr int IT_IN = 32 * 128, IT_FO = 16 * 32, IT_AO = 32 * 32, IT_O = 32 * 32, IT_EG = 64 * 256, IT_EU = 64 * 256, IT_ED = 64 * 256, IT_SH = 256;
constexpr int IT_T_END = IT_IN + IT_FO + IT_AO + IT_O + 3 * IT_SH;
constexpr int IT_MOD = MODC / 32, IT_CST = 4096, IT_BD2 = 512, IT_RWT = 32, IT_ROPE = 1;
constexpr int IT_ALL = IT_T_END + IT_MOD + IT_CST + IT_BD2 + IT_RWT + IT_ROPE;

__device__ __forceinline__ void mod_item(const Args& args, unsigned char* ws, int r, int lane) {
            const int kq = lane >> 3, col = r * 32 + (lane & 7) * 4;
            f32x4 a0 = {0.f, 0.f, 0.f, 0.f}, a1 = a0, a2 = a0;
            for (int jb = 0; jb < 256; jb += 8) {
                f32x4 w[8]; float c0[8], c1[8], c2[8];
#pragma unroll
                for (int j = 0; j < 8; ++j) { const int k = kq + 8 * (jb + j); w[j] = *(const GAS f32x4*)(args.in[4] + (size_t)k * MODC + col); c0[j] = args.in[1][k]; c1[j] = args.in[1][DM + k]; c2[j] = args.in[3][k]; }
#pragma unroll
                for (int j = 0; j < 8; ++j) { a0 += w[j] * (c0[j] * __builtin_amdgcn_rcpf(1.0f + __expf(-c0[j]))); a1 += w[j] * (c1[j] * __builtin_amdgcn_rcpf(1.0f + __expf(-c1[j]))); a2 += w[j] * (c2[j] * __builtin_amdgcn_rcpf(1.0f + __expf(-c2[j]))); }
            }
#pragma unroll
            for (int c = 0; c < 4; ++c) {
#pragma unroll
                for (int o = 8; o < 64; o <<= 1) { a0[c] += __shfl_xor(a0[c], o); a1[c] += __shfl_xor(a1[c], o); a2[c] += __shfl_xor(a2[c], o); } }
            if (kq == 0) { const f32x4 bb = *(const GAS f32x4*)(args.in[5] + col); float* MODP = (float*)(ws + WS_MOD);
                *(GAS f32x4*)(MODP + col) = a0 + bb; *(GAS f32x4*)(MODP + MODC + col) = a1 + bb; *(GAS f32x4*)(MODP + 2 * MODC + col) = a2 + bb; }
}
__device__ __forceinline__ void p0_prologue(Frame& F, const Args& args) {
    LAS float* scr = (LAS float*)(F.lds + F.wave * 16640);
    const int gw = F.vcu * NWAVES + F.wave, NGW = F.G * NWAVES, lane = F.lane;
    unsigned char* ws = F.ws;
    bf16_t* WT_IN = (bf16_t*)(ws + WS_WT_IN); bf16_t* WT_FO = (bf16_t*)(ws + WS_WT_FO); bf16_t* WT_AO = (bf16_t*)(ws + WS_WT_AO); bf16_t* WT_O = (bf16_t*)(ws + WS_WT_O);
    bf16_t* WT_GU = (bf16_t*)(ws + WS_WT_GU); bf16_t* WT_D = (bf16_t*)(ws + WS_WT_D);
    if (NGW >= 5 * IT_MOD) { if (gw % 5 == 0 && gw / 5 < IT_MOD) mod_item(args, ws, gw / 5, lane); }
    else for (int m = gw; m < IT_MOD; m += NGW) mod_item(args, ws, m, lane);
    for (int it = gw; it < IT_ALL - IT_MOD; it += NGW) {
        int r = it;
        if (r < IT_IN) { const int kb = r / 128, nb = r % 128, n0 = nb * 64;
            if (n0 >= Q_OFF && n0 < V_OFF) { f32x4 v[16]; t64_load(v, args.in[7] + (size_t)(kb * 64) * INC + n0, INC, lane);
                t64_store<true>(v, WT_IN + (size_t)(n0 & ~127) * DM + kb * 64, DM, scr, lane, n0 & 127); }
            else if (n0 >= GF_OFF) { f32x4 v[16]; t64_load(v, args.in[7] + (size_t)(kb * 64) * INC + n0, INC, lane);
                t64_store(v, WT_IN + (size_t)n0 * DM + kb * 64, DM, scr, lane);
                t64_store<false, true>(v, (bf16_t*)(ws + WS_WT_G8 + (size_t)(n0 - GF_OFF) * DM + kb * 64), DM, scr, lane); }
            else transpose64(args.in[7] + (size_t)(kb * 64) * INC + n0, INC, WT_IN + (size_t)n0 * DM + kb * 64, DM, scr, lane);
            continue; } r -= IT_IN;
        if (r < IT_FO) { const int kb = r / 32, nb = r % 32; transpose64(args.in[10] + (size_t)(kb * 64) * DM + nb * 64, DM, WT_FO + (size_t)(nb * 64) * YFP + kb * 64, YFP, scr, lane); continue; } r -= IT_FO;
        if (r < IT_AO) { const int kb = r / 32, nb = r % 32; transpose64(args.in[11] + (size_t)(kb * 64) * DM + nb * 64, DM, WT_AO + (size_t)(nb * 64) * DM + kb * 64, DM, scr, lane); continue; } r -= IT_AO;
        if (r < IT_O) { const int kb = r / 32, nb = r % 32; transpose64(args.in[12] + (size_t)(kb * 64) * DM + nb * 64, DM, WT_O + (size_t)(nb * 64) * DM + kb * 64, DM, scr, lane); continue; } r -= IT_O;
        if (r < 2 * IT_SH) { const int up = r >= IT_SH; if (up) r -= IT_SH; const int kb = r / 8, nb = r % 8, n0 = nb * 64;
            { f32x4 v[16]; t64_load(v, (up ? args.in[20] : args.in[19]) + (size_t)(kb * 64) * EFF + n0, EFF, lane);
              t64_store<false, true>(v, (bf16_t*)((unsigned char*)WT_GU + ((size_t)64 * 1024 + (n0 >> 7) * 256 + (up ? 128 : 0) + (n0 & 127)) * DM + kb * 64), DM, scr, lane); } continue; } r -= 2 * IT_SH;
        if (r < IT_SH) { const int kb = r / 32, nb = r % 32;
            { f32x4 v[16]; t64_load(v, args.in[21] + (size_t)(kb * 64) * DM + nb * 64, DM, lane); t64_store<false, true>(v, (bf16_t*)((unsigned char*)WT_D + ((size_t)64 * DM + nb * 64) * EFF + kb * 64), EFF, scr, lane); } continue; } r -= IT_SH;

        if (r < IT_CST) {
            const int k1 = r & 2047; bf16_t* dst = (bf16_t*)(ws + WS_CST) + (size_t)r * 2048;
#pragma unroll
            for (int j = 0; j < 4; ++j) { const int n0 = j * 512 + lane * 8; float f[8];
#pragma unroll
                for (int i = 0; i < 8; ++i) { const float ph = (float)((k1 * (n0 + i)) & 4095) * (1.0f / 2048.0f); f[i] = r < 2048 ? cospif(ph) : sinpif(ph); }
                u32x4 o; o.x = cvt_pk_bf16(f[0], f[1]); o.y = cvt_pk_bf16(f[2], f[3]); o.z = cvt_pk_bf16(f[4], f[5]); o.w = cvt_pk_bf16(f[6], f[7]);
                *(GAS u32x4*)(dst + n0) = o; }
            continue; } r -= IT_CST;
        if (r < IT_BD2) {
            const int t = r >> 8, o = r & 255, gp = o >> 7, k2 = o & 127; bf16_t* dst = (bf16_t*)(ws + WS_BD2) + (size_t)r * 512; float f[8];
#pragma unroll
            for (int i = 0; i < 8; ++i) { const int j = lane * 8 + i, cg = j >> 8, jj = j & 255, c = jj & 127; const float ph = (float)((32 * c * k2) & 4095) * (1.0f / 2048.0f);
                const float v = jj < 128 ? cospif(ph) : (t ? sinpif(ph) : -sinpif(ph)); f[i] = cg == gp ? v * 0.0013810679320049757f : 0.f; }
            u32x4 w; w.x = cvt_pk_bf16(f[0], f[1]); w.y = cvt_pk_bf16(f[2], f[3]); w.z = cvt_pk_bf16(f[4], f[5]); w.w = cvt_pk_bf16(f[6], f[7]);
            *(GAS u32x4*)(dst + lane * 8) = w;
            continue; } r -= IT_BD2;
        if (r >= IT_RWT) {
            float* RT = (float*)(ws + WS_ROPE);
            for (int idx = lane; idx < 64 * 32; idx += 64) { const float ang = (float)(idx >> 5) * exp2f(-(float)(idx & 31) * (13.287712379549449f / 32.0f)); RT[2 * idx] = cosf(ang); RT[2 * idx + 1] = sinf(ang); }
            continue; }
        {
            f32x4 v[16]; t64_load(v, args.in[14] + (size_t)(r * 64) * NE, NE, lane);
            const int kk = lane >> 4, nc = (lane & 15) * 4;
#pragma unroll
            for (int j = 0; j < 16; ++j) {
#pragma unroll
                for (int c = 0; c < 4; ++c) scr[(j * 4 + kk) * 65 + nc + c] = v[j][c]; }
            LDS_WAIT(); asm volatile("" ::: "memory");
            const int kc = lane & 7; bf16_t* RWT = (bf16_t*)(ws + WS_RWT);
#pragma unroll
            for (int jj = 0; jj < 8; ++jj) { const int e = (lane >> 3) + 8 * jj; const LAS float* s = scr + (8 * kc) * 65 + e; float t[8], l[8];
#pragma unroll
                for (int i = 0; i < 8; ++i) { t[i] = s[i * 65]; l[i] = t[i] - bf2f(f2bf(t[i])); }
                u32x4 h, lo; h.x = cvt_pk_bf16(t[0], t[1]); h.y = cvt_pk_bf16(t[2], t[3]); h.z = cvt_pk_bf16(t[4], t[5]); h.w = cvt_pk_bf16(t[6], t[7]);
                lo.x = cvt_pk_bf16(l[0], l[1]); lo.y = cvt_pk_bf16(l[2], l[3]); lo.z = cvt_pk_bf16(l[4], l[5]); lo.w = cvt_pk_bf16(l[6], l[7]);
                *(GAS u32x4*)(RWT + (size_t)e * DM + r * 64 + 8 * kc) = h; *(GAS u32x4*)(RWT + (size_t)(NE + e) * DM + r * 64 + 8 * kc) = lo; }
            LDS_WAIT(); asm volatile("" ::: "memory");
        }
    }
}


__device__ __forceinline__ void conv_addr(const Args& args, unsigned char* ws, bool down, int it, const float*& W, int& ldw, bf16_t*& dst, int& ldd) {
    if (!down) { int r = it; const int up = r >= IT_EG; if (up) r -= IT_EG;
        const int e = r / 256, q = r % 256, kb = q / 8, nb = q % 8, n0 = nb * 64;
        W = (up ? args.in[17] : args.in[16]) + (size_t)e * DM * EFF + (size_t)(kb * 64) * EFF + n0; ldw = EFF;
        dst = (bf16_t*)(ws + WS_WT_GU + ((size_t)e * 1024 + (n0 >> 7) * 256 + (up ? 128 : 0) + (n0 & 127)) * DM + kb * 64); ldd = DM;
    } else { const int r = it, e = r / 256, q = r % 256, kb = q / 32, nb = q % 32;
        W = args.in[18] + (size_t)e * EFF * DM + (size_t)(kb * 64) * DM + nb * 64; ldw = DM;
        dst = (bf16_t*)(ws + WS_WT_D + ((size_t)e * DM + nb * 64) * EFF + kb * 64); ldd = EFF; }
}
__device__ __forceinline__ void conv_items(Frame& F, const Args& args, bool down, int first, int count) {
    LAS float* scr = (LAS float*)(F.lds + F.wave * 16640);
    const int end = first + count; int it = first + F.wave;
    if (it >= end) return;
    f32x4 va[16], vb[16]; const float* W; int ldw; bf16_t* da; bf16_t* db; int ldd;
    conv_addr(args, F.ws, down, it, W, ldw, da, ldd); t64_load(va, W, ldw, F.lane);
    for (;;) {
        const bool hb = it + NWAVES < end;
        if (hb) { conv_addr(args, F.ws, down, it + NWAVES, W, ldw, db, ldd); t64_load(vb, W, ldw, F.lane); }
        t64_store<false, true>(va, da, ldd, scr, F.lane);
        if (!hb) break;
        const bool ha = it + 2 * NWAVES < end;
        if (ha) { conv_addr(args, F.ws, down, it + 2 * NWAVES, W, ldw, da, ldd); t64_load(va, W, ldw, F.lane); }
        t64_store<false, true>(vb, db, ldd, scr, F.lane);
        if (!ha) break;
        it += 2 * NWAVES;
    }
}
struct SchedIn {
    int G, c; unsigned char* ws; int use_ut;
    __device__ __forceinline__ bool next(int i, Unit& u) const {
        const int L = i * G + c; if (L >= 520) return false;
        const char* H = (const char*)(ws + WS_H); const char* WT = (const char*)(ws + WS_WT_IN);
        u.rows = 256; u.aux = 0; u.bjs = HALF; u.pm = 0; u.pn = 0; u.rmin = 0; u.nt = DM / BK; u.keep = 0;
        if (L < 512) {
            int pm, ct; grid_map(L, 32, 16, pm, ct);
            const int row0 = pm * 256, b = row0 / SEQ, t0 = row0 % SEQ;
            u.A = H + (size_t)row0 * DM * 2; u.B = WT + (size_t)ct * 256 * DM * 2;
            if (ct < 4) { u.A = WT + (size_t)ct * 256 * DM * 2; u.B = H + (size_t)row0 * DM * 2;
                          u.C = (char*)(ws + WS_UT) + (((size_t)b * FW + ct * 256) * SEQ + t0) * 2; u.ldc = SEQ; u.mode = 0; }
            else if (ct < 12) { u.C = (char*)(ws + WS_Q) + ((size_t)row0 * DM + (ct - 4) * 256) * 2; u.ldc = DM; u.mode = 5; u.pm = t0; }
            else if (ct < 14) { u.C = (char*)(ws + WS_KALL) + (((size_t)b * SKV + t0) * KVW + (ct - 12) * 256) * 2; u.ldc = KVW; u.mode = 6; u.pm = t0; }
            else { u.C = (char*)(ws + WS_VALL) + (((size_t)b * SKV + t0) * KVW + (ct - 14) * 256) * 2; u.ldc = KVW; u.mode = 0; }
        } else {
            const int l = L - 512, pm = l & 1, ct = l >> 1;
            u.A = H + (size_t)(NTOK + pm * 256) * DM * 2; u.B = WT + (size_t)(K_OFF + ct * 256) * DM * 2;
            if (ct < 2) { u.C = (char*)(ws + WS_KALL) + (((size_t)pm * SKV + SEQ) * KVW + ct * 256) * 2; u.ldc = KVW; u.mode = 7; }
            else        { u.C = (char*)(ws + WS_VALL) + (((size_t)pm * SKV + SEQ) * KVW + (ct - 2) * 256) * 2; u.ldc = KVW; u.mode = 0; }
        }
        return true;
    }
    __device__ __forceinline__ unsigned arow(const Unit&, int) const { return 0u; }
    __device__ __forceinline__ void a_ready(const Unit&) const {}
};
struct SchedGate { int G, c; unsigned char* ws;
    __device__ __forceinline__ bool next(int i, Unit& u) const {
        int g;
        if (G == 256) { if (c < 8 || i >= 2) return false; g = (c - 8) + 248 * i; }
        else { g = i * G + c; if (g >= 496) return false; }
        const int pm = g & 31, gt = g >> 5;
        u.A = (const char*)(ws + WS_H8) + (size_t)pm * 256 * DM; u.B = (const char*)(ws + WS_WT_G8) + (size_t)gt * 256 * DM;
        u.C = (char*)(ws + (gt < 8 ? WS_SGF : WS_SGA)) + ((size_t)pm * 256 * DM + (gt & 7) * 256) * 2; { int md = 2, ld = DM, rw = 256; asm volatile("" : "+s"(md), "+s"(ld), "+s"(rw)); u.ldc = ld; u.mode = md; u.rows = rw; }
        u.aux = 0; u.bjs = HALF; u.pm = pm; u.pn = gt; u.rmin = 0; u.nt = DM / 128; u.keep = 0;
        return true; }
    __device__ __forceinline__ unsigned arow(const Unit&, int) const { return 0u; }
    __device__ __forceinline__ void a_ready(const Unit&) const {} };

__device__ __forceinline__ void unpack8(u32x4 w, float (&f)[8]) {
#pragma unroll
    for (int i = 0; i < 4; ++i) { f[2 * i] = __uint_as_float(w[i] << 16); f[2 * i + 1] = __uint_as_float(w[i] & 0xffff0000u); }
}
struct EpiMerge { const bf16_t* SGF; const bf16_t* SGA; bf16_t* YM;
    __device__ __forceinline__ void operator()(f32x4 (&acc)[2][2][4][2], const Unit& u, int wr, int wc, int fr, int fq) const {
#pragma unroll
        for (int ai = 0; ai < 2; ++ai)
#pragma unroll
            for (int m = 0; m < 4; ++m) { const size_t row = (size_t)u.pm * 256 + ai * HALF + wr * 64 + m * 16 + fr;
#pragma unroll
                for (int bj = 0; bj < 2; ++bj) { const size_t o = row * DM + u.pn * 256 + bj * HALF + wc * 32 + 8 * fq;
                    float ga[8]; unpack8(*(const u32x4*)(SGA + o), ga);
#pragma unroll
                    for (int c = 0; c < 8; ++c) ga[c] = fmaxf(ga[c], 1e-20f);
                    if (u.keep) { float gf[8]; unpack8(*(const u32x4*)(SGF + o), gf);
#pragma unroll
                        for (int c = 0; c < 4; ++c) { acc[ai][bj][m][0][c] *= gf[c] * __builtin_amdgcn_rcpf(ga[c]); acc[ai][bj][m][1][c] *= gf[4 + c] * __builtin_amdgcn_rcpf(ga[4 + c]); }
                    } else { const f32x4 v0 = acc[ai][bj][m][0], v1 = acc[ai][bj][m][1];
                        u32x4 w; w.x = cvt_pk_bf16(ga[0] * v0[0], ga[1] * v0[1]); w.y = cvt_pk_bf16(ga[2] * v0[2], ga[3] * v0[3]); w.z = cvt_pk_bf16(ga[4] * v1[0], ga[5] * v1[1]); w.w = cvt_pk_bf16(ga[6] * v1[2], ga[7] * v1[3]);
                        *(u32x4*)(YM + o) = w; } } }
    } };
struct SchedMerge { int G, c; unsigned char* ws;
    __device__ __forceinline__ bool next(int i, Unit& u) const {
        const int L = (i >> 1) * G + c; if (L >= 256) return false;
        int pm, pn; grid_map(L, 32, 8, pm, pn); const int kb = i & 1;
        u.A = (const char*)(ws + (kb ? WS_YA : WS_YF)) + (size_t)pm * 256 * DM * 2; u.B = (const char*)(ws + (kb ? WS_WT_AO : WS_WT_FO)) + (size_t)pn * 256 * DM * 2;
        u.C = nullptr; u.ldc = DM; u.mode = 0; u.rows = 256; u.aux = 0; u.pm = pm; u.pn = pn; u.bjs = HALF; u.rmin = 0; u.nt = kb ? DM / BK : FW / BK; u.keep = kb ? 0 : 1;
        return true; }
    __device__ __forceinline__ unsigned arow(const Unit&, int) const { return 0u; } };
struct EpiX2 { const float* x; const float* mod; float* X2;
    __device__ __forceinline__ void operator()(f32x4 (&acc)[2][2][4][2], const Unit& u, int wr, int wc, int fr, int fq) const {
        const float* g1 = mod + ((u.pm * 256) / SEQ) * MODC + 2 * DM;
#pragma unroll
        for (int ai = 0; ai < 2; ++ai)
#pragma unroll
            for (int m = 0; m < 4; ++m) { const size_t row = (size_t)u.pm * 256 + ai * HALF + wr * 64 + m * 16 + fr;
#pragma unroll
                for (int bj = 0; bj < 2; ++bj) { const int col = u.pn * 256 + bj * HALF + wc * 32 + 8 * fq; const size_t o = row * DM + col;
#pragma unroll
                    for (int n = 0; n < 2; ++n) { const f32x4 xv = *(const f32x4*)(x + o + 4 * n), gv = *(const f32x4*)(g1 + col + 4 * n); *(f32x4*)(X2 + o + 4 * n) = xv + gv * acc[ai][bj][m][n]; } } }
    } };
__device__ __forceinline__ void act8(const f32x4 (&g)[2], const f32x4 (&up)[2], unsigned& w0, unsigned& w1) {
    f32x4 a[2];
#pragma unroll
    for (int n = 0; n < 2; ++n)
#pragma unroll
        for (int c = 0; c < 4; ++c) { const float x = g[n][c]; a[n][c] = fminf(fmaxf(x * __builtin_amdgcn_rcpf(1.0f + __expf(-x)) * up[n][c], -448.f), 448.f); }
    int x0 = 0, x1 = 0;
    x0 = __builtin_amdgcn_cvt_pk_fp8_f32(a[0][0], a[0][1], x0, false); x0 = __builtin_amdgcn_cvt_pk_fp8_f32(a[0][2], a[0][3], x0, true);
    x1 = __builtin_amdgcn_cvt_pk_fp8_f32(a[1][0], a[1][1], x1, false); x1 = __builtin_amdgcn_cvt_pk_fp8_f32(a[1][2], a[1][3], x1, true);
    w0 = (unsigned)x0; w1 = (unsigned)x1;
}
struct EpiAct {
    __device__ __forceinline__ void operator()(f32x4 (&acc)[2][2][4][2], const Unit& u, int wr, int wc, int fr, int fq) const {
        const int odd = fq & 1;
        unsigned char* base = (unsigned char*)u.C + (size_t)(wr * 64 + odd * 16 + fr) * u.ldc + wc * 32 + 8 * (fq - odd);
        const int r0 = wr * 64 + odd * 16 + fr;
#pragma unroll
        for (int ai = 0; ai < 2; ++ai)
#pragma unroll
            for (int m = 0; m < 4; m += 2) {
                unsigned a0, a1, b0, b1; act8(acc[ai][0][m], acc[ai][1][m], a0, a1); act8(acc[ai][0][m + 1], acc[ai][1][m + 1], b0, b1);
                const auto s0 = __builtin_amdgcn_permlane16_swap(a0, b0, false, false), s1 = __builtin_amdgcn_permlane16_swap(a1, b1, false, false);
                if (r0 + ai * HALF + m * 16 < u.rows) { const u32x4 w = {s0[0], s1[0], s0[1], s1[1]}; *(u32x4*)(base + (size_t)(ai * HALF + m * 16) * u.ldc) = w; } }
    } };

struct SchedGrid {
    int G, c, nM, nN; const char* A; const char* B; char* C; size_t astride, bstride; int ldc, esz, mode, nt;
    __device__ __forceinline__ bool next(int i, Unit& u) const {
        const int L = i * G + c; if (L >= nM * nN) return false;
        int pm, pn; grid_map(L, nM, nN, pm, pn);
        u.A = A + (size_t)pm * astride; u.B = B + (size_t)pn * bstride; u.C = C + ((size_t)pm * 256 * ldc + pn * 256) * esz; u.ldc = ldc; u.mode = mode; u.rows = 256; u.aux = 0; u.pm = pm; u.pn = pn; u.bjs = HALF; u.rmin = 0; u.nt = nt; u.keep = 0;
        return true; }
    __device__ __forceinline__ unsigned arow(const Unit&, int) const { return 0u; } };
struct SchedAG { int G, c; unsigned char* ws;
    __device__ __forceinline__ bool next(int i, Unit& u) const {
        const int L = i * G + c; if (L >= 144) return false;
        u.rows = 256; u.aux = 0; u.rmin = 0; u.nt = DM / BK; u.keep = 0;
        if (L < 128) {
            int pm, pn8; grid_map(L, 16, 8, pm, pn8); const int b = pn8 >> 2, pn = pn8 & 3, sn = pm >> 3, k1t = pm & 7;
            u.A = (const char*)(ws + WS_CST) + (size_t)pm * 256 * 2048 * 2; u.B = (const char*)(ws + (sn ? WS_OT : WS_ET)) + ((size_t)b * FW + pn * 256) * 2048 * 2;
            u.C = (char*)(ws + WS_TT) + (((size_t)b * 2048 + k1t * 256) * DM + pn * 512 + sn * 128) * 2; u.ldc = DM; u.mode = sn ? 0 : 3; u.pm = k1t; u.pn = b * FW + pn * 256; u.bjs = 256;
        } else {
            const int g = 496 + (L - 128), pm = g & 31, ct = 16 + (g >> 5);
            u.A = (const char*)(ws + WS_H) + (size_t)pm * 256 * DM * 2; u.B = (const char*)(ws + WS_WT_IN) + (size_t)ct * 256 * DM * 2;
            u.C = (char*)(ws + WS_SGA) + ((size_t)pm * 256 * DM + (ct - 24) * 256) * 2; u.ldc = DM; u.mode = 2; u.pm = pm; u.pn = ct; u.bjs = HALF;
        }
        return true; }
    __device__ __forceinline__ unsigned arow(const Unit&, int) const { return 0u; } };
struct SchedF2 { int G, c; unsigned char* ws;
    __device__ __forceinline__ bool next(int i, Unit& u) const {
        const int L = i * G + c; if (L >= 128) return false;
        int pm, q; grid_map(L, 16, 8, pm, q); const int b = pm >> 3, k1t = pm & 7, j = q & 3, mir = q >> 2;
        u.A = (const char*)(ws + WS_TT) + (((size_t)b * 2048 + k1t * 256) * DM + j * 512) * 2; u.B = (const char*)(ws + WS_BD2) + (size_t)mir * 256 * 512 * 2;
        u.mode = 0; u.rows = 256; u.aux = 0; u.pm = pm; u.pn = j; u.bjs = HALF; u.nt = 512 / BK; u.keep = 0;
        if (!mir) { u.C = (char*)(ws + WS_YF) + (((size_t)b * SEQ + k1t * 256) * YFP + j * 256) * 2; u.ldc = YFP; u.rmin = 0; }
        else { u.C = (char*)(ws + WS_YF) + (((size_t)b * SEQ + SEQ - k1t * 256) * YFP + j * 256) * 2; u.ldc = -YFP; u.rmin = k1t == 0 ? 1 : 0; }
        return true; }
    __device__ __forceinline__ unsigned arow(const Unit&, int) const { return 0u; } };
constexpr int SCHT_OFF = LDSCTL_OFF + 1024;
__device__ __forceinline__ void moe_tables(Frame& F, int ncol_tiles) {
    LAS int* T = (LAS int*)(F.lds + SCHT_OFF);
    __syncthreads();
    if (F.tid == 0) { const int* CNT = (const int*)(F.ws + CTL_CNT); int up = 0, of = 0;
        for (int e = 0; e <= NE; ++e) { const int cn = e < NE ? CNT[e * 64] : NTOK; T[e] = up; T[80 + e] = e < NE ? of : NSLOT; T[160 + e] = cn; up += ((cn + 255) >> 8) * ncol_tiles; of += cn; }
        T[NE + 1] = up; }
    __syncthreads();
}
template <int NCT, bool FIRST> struct SchedMoe {
    int G, c; unsigned char* ws; LAS int* T; const int* TOK;
    __device__ __forceinline__ int tl(int i) const { return __builtin_amdgcn_readfirstlane(T[i]); }
    __device__ __forceinline__ bool next(int i, Unit& u) const {
        const int L = i * G + c; if (L >= tl(NE + 1)) return false;
        int lo = 0, hi = NE;
#pragma unroll 1
        while (lo < hi) { const int mid = (lo + hi + 1) >> 1; if (tl(mid) <= L) lo = mid; else hi = mid - 1; }
        const int e = lo, cn = tl(160 + e), ntile = (cn + 255) >> 8, local = L - tl(e), ct = local / ntile, mt = local % ntile, slot0 = tl(80 + e) + mt * 256;
        u.rows = (cn - mt * 256) < 256 ? (cn - mt * 256) : 256; u.aux = slot0; u.pm = mt; u.pn = ct; u.bjs = HALF; u.mode = 0; u.rmin = 0; u.e = e; u.nt = (FIRST ? DM : EFF) / 128; u.keep = 0;
        if (FIRST) { u.A = (const char*)(ws + WS_H2); u.B = (const char*)(ws + WS_WT_GU) + ((size_t)e * 4 + ct) * 256 * DM; u.C = (char*)(ws + WS_ACT) + ((size_t)slot0 * EFF + ct * 128); u.ldc = EFF; }
        else { u.A = (const char*)(ws + WS_ACT) + (size_t)slot0 * EFF; u.B = (const char*)(ws + WS_WT_D) + ((size_t)e * DM + ct * 256) * EFF; u.C = (char*)(ws + WS_YBIG) + ((size_t)slot0 * DM + ct * 256); u.ldc = DM; u.mode = 8; }
        return true; }
    __device__ __forceinline__ unsigned arow(const Unit& u, int r) const { const int rr = u.pm * 256 + (r < u.rows ? r : u.rows - 1); const int tok = u.e < NE ? TOK[u.e * NTOK + rr] : rr; return (unsigned)tok * (unsigned)DM; } };

namespace attn {
using s16x4 = __attribute__((ext_vector_type(4))) short;
using f32x8 = __attribute__((ext_vector_type(8))) float;
constexpr int D = 128, NW = 8, QBLK = 32, KVBLK = 64;
constexpr float SCALE = 0.088388347648318440f;
constexpr float THR = 8.f;
constexpr int LDQ = DM, LDK = KVW, LDO = DM;
constexpr size_t SHM_V = KVBLK * D * 2, SHM_K = KVBLK * D * 2, SHM_ATTN = 2 * SHM_V + 2 * SHM_K + NW * 64 * 4;
#define KSWZ(row, colB) ((row) * 256 + ((colB) ^ (((row) & 7) << 4)))
#define SBAR() __builtin_amdgcn_sched_barrier(0)
__device__ __forceinline__ unsigned cvtpk(float lo, float hi) { unsigned r; asm volatile("v_cvt_pk_bf16_f32 %0, %1, %2" : "=v"(r) : "v"(lo), "v"(hi)); return r; }
__device__ __forceinline__ void partialSM(f32x16& p0, f32x16& p1, float& m_reg, float& mn, float& alpha) {
  constexpr float C = SCALE * 1.4426950408889634f;
  float pmax = p0[0]; for (int r = 1; r < 16; ++r) pmax = fmaxf(pmax, p0[r]); for (int r = 0; r < 16; ++r) pmax = fmaxf(pmax, p1[r]);
  { auto rr = __builtin_amdgcn_permlane32_swap(__float_as_uint(pmax), __float_as_uint(pmax), false, false);
    pmax = fmaxf(__uint_as_float(rr[0]), __uint_as_float(rr[1])); }
  if (__builtin_expect(__all(pmax - m_reg <= THR / SCALE), 1)) { mn = m_reg; alpha = 1.f; }
  else { mn = fmaxf(m_reg, pmax); alpha = __builtin_amdgcn_exp2f((m_reg - mn) * C); m_reg = mn; }
  float mnC = -mn * C;
  for (int r = 0; r < 16; ++r) p0[r] = fmaf(p0[r], C, mnC); for (int r = 0; r < 16; ++r) p1[r] = fmaf(p1[r], C, mnC);
  for (int r = 0; r < 16; ++r) p0[r] = __builtin_amdgcn_exp2f(p0[r]);
}
__device__ __forceinline__ void finishSM(f32x16& p0, f32x16& p1, float alpha, float& l_reg, bf16x8& pa0, bf16x8& pa1, bf16x8& pa2, bf16x8& pa3) {
  for (int r = 0; r < 16; ++r) p1[r] = __builtin_amdgcn_exp2f(p1[r]);
  float ps = 0; for (int r = 0; r < 16; ++r) ps += p0[r]; for (int r = 0; r < 16; ++r) ps += p1[r];
  { auto rr = __builtin_amdgcn_permlane32_swap(__float_as_uint(ps), __float_as_uint(ps), false, false);
    ps = __uint_as_float(rr[0]) + __uint_as_float(rr[1]); }
  l_reg = l_reg * alpha + ps;
#define PK4(P, BASE, OUT) do { unsigned a0 = cvtpk(P[BASE + 0], P[BASE + 1]), a1 = cvtpk(P[BASE + 2], P[BASE + 3]);   \
    unsigned b0 = cvtpk(P[BASE + 4], P[BASE + 5]), b1 = cvtpk(P[BASE + 6], P[BASE + 7]);                              \
    auto r0 = __builtin_amdgcn_permlane32_swap(a0, b0, false, false); auto r1 = __builtin_amdgcn_permlane32_swap(a1, b1, false, false); \
    u32x4 w = {r0[0], r1[0], r0[1], r1[1]}; OUT = *reinterpret_cast<bf16x8*>(&w); } while (0)
  PK4(p0, 0, pa0); PK4(p0, 8, pa1); PK4(p1, 0, pa2); PK4(p1, 8, pa3);
#undef PK4
}
__device__ __forceinline__ void qkt(f32x16& p0, f32x16& p1, const bf16_t* Ks, const bf16x8* qr, int r32, int hi) {
  p0 = f32x16{}; p1 = f32x16{};
  for (int d0 = 0; d0 < 8; ++d0) { int cb = (d0 * 16 + hi * 8) * 2;
    bf16x8 b0 = *reinterpret_cast<const bf16x8*>((const char*)Ks + KSWZ(r32, cb));
    bf16x8 b1 = *reinterpret_cast<const bf16x8*>((const char*)Ks + KSWZ(32 + r32, cb));
    p0 = __builtin_amdgcn_mfma_f32_32x32x16_bf16(b0, qr[d0], p0, 0, 0, 0);
    p1 = __builtin_amdgcn_mfma_f32_32x32x16_bf16(b1, qr[d0], p1, 0, 0, 0); }
}
__device__ __forceinline__ int v_st(int k, int c) { const int kk = (k & ~0xC) | ((k & 4) << 1) | ((k & 8) >> 1); return ((kk >> 3) * 4 + (c >> 5)) * 512 + ((kk & 7) * 32 + (c & 31)) * 2; }
__device__ __forceinline__ int v_rd_base(int lane) { return ((lane & 3) << 3) | (((lane >> 2) & 3) << 6) | (((lane >> 4) & 1) << 5) | (((lane >> 5) & 1) << 8); }
constexpr int v_rd_off(int d0, int ks, int half) { return d0 * 512 + ks * 4096 + half * 2048; }
template <int OFF> __device__ __forceinline__ s16x4 tr_read(int vb) {
  s16x4 r; asm volatile("ds_read_b64_tr_b16 %0, %1 offset:%2" : "=&v"(r) : "v"(vb), "i"(OFF) : "memory"); return r;
}
template <int D0> __device__ __forceinline__ void pv_one(f32x16& od, int vb, bf16x8 pa0, bf16x8 pa1, bf16x8 pa2, bf16x8 pa3) {
  const s16x4 l0 = tr_read<v_rd_off(D0, 0, 0)>(vb), h0 = tr_read<v_rd_off(D0, 0, 1)>(vb), l1 = tr_read<v_rd_off(D0, 1, 0)>(vb), h1 = tr_read<v_rd_off(D0, 1, 1)>(vb);
  const s16x4 l2 = tr_read<v_rd_off(D0, 2, 0)>(vb), h2 = tr_read<v_rd_off(D0, 2, 1)>(vb), l3 = tr_read<v_rd_off(D0, 3, 0)>(vb), h3 = tr_read<v_rd_off(D0, 3, 1)>(vb);
  asm volatile("s_waitcnt lgkmcnt(0)" ::: "memory"); SBAR();
#define PK(L, H) (bf16x8){L[0], L[1], L[2], L[3], H[0], H[1], H[2], H[3]}
  od = __builtin_amdgcn_mfma_f32_32x32x16_bf16(pa0, PK(l0, h0), od, 0, 0, 0);
  od = __builtin_amdgcn_mfma_f32_32x32x16_bf16(pa1, PK(l1, h1), od, 0, 0, 0);
  od = __builtin_amdgcn_mfma_f32_32x32x16_bf16(pa2, PK(l2, h2), od, 0, 0, 0);
  od = __builtin_amdgcn_mfma_f32_32x32x16_bf16(pa3, PK(l3, h3), od, 0, 0, 0);
#undef PK
}
__device__ __forceinline__ void pv_d0(f32x16* o, int vb, bf16x8 pa0, bf16x8 pa1, bf16x8 pa2, bf16x8 pa3) {
  pv_one<0>(o[0], vb, pa0, pa1, pa2, pa3); pv_one<1>(o[1], vb, pa0, pa1, pa2, pa3); pv_one<2>(o[2], vb, pa0, pa1, pa2, pa3); pv_one<3>(o[3], vb, pa0, pa1, pa2, pa3);
}
__device__ __forceinline__ void attn_dense_body(const bf16_t* __restrict__ Qb, const bf16_t* __restrict__ Kh, const bf16_t* __restrict__ Vh, bf16_t* __restrict__ Ob, int seq, char* lds) {
  const int tid = threadIdx.x, wid = tid >> 6, lane = tid & 63, r32 = lane & 31, hi = lane >> 5;
  bf16_t* V_lds = (bf16_t*)lds; bf16_t* K_lds = (bf16_t*)(lds + 2 * SHM_V);
  float* ws = (float*)(lds + 2 * SHM_V + 2 * SHM_K) + wid * 64; float* li_l = ws; float* al_l = ws + 32;
  float m_reg = -1e30f, l_reg = 0; f32x16 o[4] = {}; bf16x8 qr[8];
  const bf16_t* Qw = Qb + (long)(wid * QBLK + r32) * LDQ + hi * 8;
#pragma unroll
  for (int d0 = 0; d0 < 8; ++d0) qr[d0] = *reinterpret_cast<const bf16x8*>(Qw + d0 * 16);
  const int sr = tid >> 4, sc = (tid & 15) * 8, vst0 = v_st(sr, sc), vst1 = v_st(32 + sr, sc);
  const int vb0 = (int)(uintptr_t)V_lds + v_rd_base(lane);
  struct { bf16x8 vs0, vs1, ks0, ks1; } sr_[2];
#define SLOAD(i, k0) do { sr_[i].vs0 = *reinterpret_cast<const bf16x8*>(&Vh[(long)((k0) + sr) * LDK + sc]); sr_[i].vs1 = *reinterpret_cast<const bf16x8*>(&Vh[(long)((k0) + 32 + sr) * LDK + sc]); \
    sr_[i].ks0 = *reinterpret_cast<const bf16x8*>(&Kh[(long)((k0) + sr) * LDK + sc]); sr_[i].ks1 = *reinterpret_cast<const bf16x8*>(&Kh[(long)((k0) + 32 + sr) * LDK + sc]); } while (0)
#define SWRITE(b, i) do { *(bf16x8*)((char*)V_lds + (b) * SHM_V + vst0) = sr_[i].vs0;          \
    *(bf16x8*)((char*)V_lds + (b) * SHM_V + vst1) = sr_[i].vs1; int kc = sc * 2;               \
    *(bf16x8*)((char*)K_lds + (b) * SHM_K + KSWZ(sr, kc)) = sr_[i].ks0;                       \
    *(bf16x8*)((char*)K_lds + (b) * SHM_K + KSWZ(32 + sr, kc)) = sr_[i].ks1; } while (0)
#define SWAIT() asm volatile("s_waitcnt vmcnt(4)" ::: "memory")
#define RESC(a) do { if (__any((a) < 1.f)) { if (hi == 0) al_l[r32] = (a); asm volatile("s_waitcnt lgkmcnt(0)" ::: "memory"); \
    for (int d = 0; d < 4; ++d) for (int r = 0; r < 16; ++r) o[d][r] *= al_l[crow(r, hi)]; } } while (0)
  f32x16 pA0, pA1, pB0, pB1; float mnA, mnB, alA, alB; bf16x8 pa0, pa1, pa2, pa3; const int NT = seq / KVBLK;
  constexpr int SE = 0, SO = 1;
  SLOAD(SE, 0); asm volatile("s_waitcnt vmcnt(0)" ::: "memory"); SWRITE(0, SE); __syncthreads();
  qkt(pA0, pA1, K_lds, qr, r32, hi); partialSM(pA0, pA1, m_reg, mnA, alA);
  SLOAD(SO, KVBLK); if (2 < NT) SLOAD(SE, 2 * KVBLK);
  SWAIT(); SWRITE(1, SO); __syncthreads();
  for (int j = 1; j + 1 < NT; j += 2) {
    SBAR(); qkt(pB0, pB1, (bf16_t*)((char*)K_lds + SHM_K), qr, r32, hi);
    finishSM(pA0, pA1, alA, l_reg, pa0, pa1, pa2, pa3); SBAR();
    SLOAD(SO, (j + 2) * KVBLK); SBAR();
    pv_d0(o, vb0, pa0, pa1, pa2, pa3); partialSM(pB0, pB1, m_reg, mnB, alB);
    __syncthreads(); SWAIT(); SWRITE(0, SE);
    RESC(alB); __syncthreads();
    SBAR(); qkt(pA0, pA1, K_lds, qr, r32, hi);
    finishSM(pB0, pB1, alB, l_reg, pa0, pa1, pa2, pa3); SBAR();
    if (j + 3 < NT) SLOAD(SE, (j + 3) * KVBLK); SBAR();
    pv_d0(o, vb0 + (int)SHM_V, pa0, pa1, pa2, pa3); partialSM(pA0, pA1, m_reg, mnA, alA);
    __syncthreads(); SWAIT(); SWRITE(1, SO);
    RESC(alA); __syncthreads();
  }
  SBAR(); qkt(pB0, pB1, (bf16_t*)((char*)K_lds + SHM_K), qr, r32, hi);
  finishSM(pA0, pA1, alA, l_reg, pa0, pa1, pa2, pa3); SBAR();
  pv_d0(o, vb0, pa0, pa1, pa2, pa3); partialSM(pB0, pB1, m_reg, mnB, alB);
  __syncthreads(); RESC(alB);
  finishSM(pB0, pB1, alB, l_reg, pa0, pa1, pa2, pa3); SBAR();
  pv_d0(o, vb0 + (int)SHM_V, pa0, pa1, pa2, pa3);
  if (hi == 0) li_l[r32] = l_reg; asm volatile("s_waitcnt lgkmcnt(0)" ::: "memory");
  float rli[16];
#pragma unroll
  for (int r = 0; r < 16; ++r) rli[r] = __builtin_amdgcn_rcpf(li_l[crow(r, hi)]);
  typedef __attribute__((address_space(3))) unsigned char lds8_t;
  lds8_t* ost = (lds8_t*)(lds + SHM_ATTN + wid * 8192);
  lds8_t* wbase = ost + hi * 1024 + r32 * 2;
#pragma unroll
  for (int d0 = 0; d0 < 4; ++d0)
#pragma unroll
    for (int r = 0; r < 16; r += 2) { const unsigned w = cvtpk(o[d0][r] * rli[r], o[d0][r + 1] * rli[r + 1]);
      *(__attribute__((address_space(3))) unsigned short*)(wbase + (((r & 3) + 8 * (r >> 2)) * 256 + d0 * 64)) = (unsigned short)w;
      *(__attribute__((address_space(3))) unsigned short*)(wbase + ((((r + 1) & 3) + 8 * ((r + 1) >> 2)) * 256 + d0 * 64)) = (unsigned short)(w >> 16); }
  asm volatile("s_waitcnt lgkmcnt(0)" ::: "memory");
  bf16_t* Ow = Ob + (long)(wid * QBLK) * LDO;
  { const lds8_t* rbase = ost + (lane >> 4) * 256 + (lane & 15) * 16; bf16_t* gbase = Ow + (long)(lane >> 4) * LDO + (lane & 15) * 8;
#pragma unroll
    for (int j = 0; j < 8; ++j) { const u32x4 v = *(const __attribute__((address_space(3))) u32x4*)(rbase + j * 1024); *(u32x4*)(gbase + (long)(j * 4) * LDO) = v; } }
  asm volatile("s_waitcnt lgkmcnt(0)" ::: "memory");
#undef SLOAD
#undef SWRITE
#undef SWAIT
#undef RESC
}
#undef KSWZ
#undef SBAR
}

__device__ __forceinline__ void ph_norm1(Frame& F, const Args& args, const float* mod) {
    const int gw = F.vcu * NWAVES + F.wave, NGW = F.G * NWAVES, lane = F.lane;
    bf16_t* H = (bf16_t*)(F.ws + WS_H); const float* nw = args.in[6];
    for (int row = gw; row < NTOK + NCTX; row += NGW) {
        const float* src = row < NTOK ? args.in[0] + (size_t)row * DM : args.in[2] + (size_t)(row - NTOK) * DM;
        const float* mr = mod + (row < NTOK ? row / SEQ : 2) * MODC;
        f32x4 v[8]; float ss = 0.f;
#pragma unroll
        for (int j = 0; j < 8; ++j) { v[j] = *(const GAS f32x4*)(src + (j * 64 + lane) * 4); ss += v[j].x * v[j].x + v[j].y * v[j].y + v[j].z * v[j].z + v[j].w * v[j].w; }
        ss = wave_sum(ss);
        const float rstd = 1.0f / sqrtf(ss * (1.0f / DM) + 1e-6f);
#pragma unroll
        for (int j = 0; j < 8; ++j) { const int i = (j * 64 + lane) * 4;
            const f32x4 w = *(const GAS f32x4*)(nw + i), sc = *(const GAS f32x4*)(mr + DM + i), sh = *(const GAS f32x4*)(mr + i);
            const f32x4 h = v[j] * rstd * w * (sc + 1.0f) + sh;
            unsigned lo = cvt_pk_bf16(h[0], h[1]), hi = cvt_pk_bf16(h[2], h[3]);
            *(GAS unsigned long long*)(H + (size_t)row * DM + i) = (unsigned long long)lo | ((unsigned long long)hi << 32);
            if (row < NTOK) { int w8 = 0; w8 = __builtin_amdgcn_cvt_pk_fp8_f32(fminf(fmaxf(h[0], -448.f), 448.f), fminf(fmaxf(h[1], -448.f), 448.f), w8, false);
                w8 = __builtin_amdgcn_cvt_pk_fp8_f32(fminf(fmaxf(h[2], -448.f), 448.f), fminf(fmaxf(h[3], -448.f), 448.f), w8, true);
                *(GAS unsigned*)(F.ws + WS_H8 + (size_t)row * DM + i) = (unsigned)w8; } }
    }
}
__device__ __forceinline__ void ph_evenodd(Frame& F, const Args& args) {
    const int gw = F.vcu * NWAVES + F.wave, NGW = F.G * NWAVES, lane = F.lane;
    LAS bf16_t* scr = (LAS bf16_t*)(F.lds + F.wave * 16640);
    const bf16_t* UT = (const bf16_t*)(F.ws + WS_UT); bf16_t* ET = (bf16_t*)(F.ws + WS_ET); bf16_t* OT = (bf16_t*)(F.ws + WS_OT);
    float* W2 = (float*)(F.ws + WS_W2048); float* AL = (float*)(F.ws + WS_ALT);
    for (int row = gw; row < 2 * FW; row += NGW) {
        const bf16_t* src = UT + (size_t)row * SEQ; float alt = 0.f;
#pragma unroll
        for (int j = 0; j < 8; ++j) { const u32x4 w = *(const GAS u32x4*)(src + (j * 64 + lane) * 8); *(LAS u32x4*)(scr + (j * 64 + lane) * 8) = w;
            float f[8]; unpack8(w, f); alt += (f[0] - f[1]) + (f[2] - f[3]) + (f[4] - f[5]) + (f[6] - f[7]); }
        alt = wave_sum(alt);
        LDS_WAIT(); asm volatile("" ::: "memory");
        if (lane == 0) { AL[row] = alt; W2[row] = bf2f(scr[SEQ / 2]); }
#pragma unroll
        for (int j = 0; j < 4; ++j) { const int n0 = (j * 64 + lane) * 8; float e[8], o[8];
#pragma unroll
            for (int i = 0; i < 8; ++i) { const int n = n0 + i; const float a = bf2f(scr[n]), bb = bf2f(scr[(SEQ - n) & (SEQ - 1)]); e[i] = n == 0 ? a : a + bb; o[i] = n == 0 ? 0.f : a - bb; }
            u32x4 we, wo; we.x = cvt_pk_bf16(e[0], e[1]); we.y = cvt_pk_bf16(e[2], e[3]); we.z = cvt_pk_bf16(e[4], e[5]); we.w = cvt_pk_bf16(e[6], e[7]);
            wo.x = cvt_pk_bf16(o[0], o[1]); wo.y = cvt_pk_bf16(o[2], o[3]); wo.z = cvt_pk_bf16(o[4], o[5]); wo.w = cvt_pk_bf16(o[6], o[7]);
            *(GAS u32x4*)(ET + (size_t)row * 2048 + n0) = we; *(GAS u32x4*)(OT + (size_t)row * 2048 + n0) = wo; }
        LDS_WAIT(); asm volatile("" ::: "memory");
    }
}
__device__ __forceinline__ void ph_route(Frame& F, const Args& args, const float* mod) {
    const int lane = F.lane, wv = F.wave, r32 = lane & 31, hi = lane >> 5;
    LAS float* rs = (LAS float*)F.lds;
    LAS float* part = (LAS float*)(F.lds + 1024);
    LAS int* lcnt = (LAS int*)(F.lds + 1024 + 65536);
    LAS int* lbase = lcnt + 64;
    LAS int* lent = lcnt + 128;
    const float* X2 = (const float*)(F.ws + WS_X2); const float* nw = args.in[13]; const float* rb = args.in[15];
    const bf16_t* RWT = (const bf16_t*)(F.ws + WS_RWT);
    bf16_t* H2 = (bf16_t*)(F.ws + WS_H2); int* EIDX = (int*)(F.ws + WS_EIDX); float* EW = (float*)(F.ws + WS_EW); int* EPOS = (int*)(F.ws + WS_EPOS); int* CNT = (int*)(F.ws + CTL_CNT); int* TOKE = (int*)(F.ws + WS_TOKE);
    if (F.tid < NE) lcnt[F.tid] = 0;
    __syncthreads();
    int nb = 0;
    for (int blk = F.vcu; blk < NTOK / 32; blk += F.G, ++nb) {
        const int row0 = blk * 32; const float* mr = mod + (row0 / SEQ) * MODC;
#pragma unroll
        for (int i = 0; i < 4; ++i) { const float* src = X2 + (size_t)(row0 + wv * 4 + i) * DM; float ss = 0.f;
#pragma unroll
            for (int j = 0; j < 8; ++j) { const f32x4 v = *(const GAS f32x4*)(src + (j * 64 + lane) * 4); ss += v.x * v.x + v.y * v.y + v.z * v.z + v.w * v.w; }
            ss = wave_sum(ss);
            if (lane == 0) rs[wv * 4 + i] = 1.0f / sqrtf(ss * (1.0f / DM) + 1e-6f); }
        __syncthreads();
        { const float rstd = rs[r32]; const float* xr = X2 + (size_t)(row0 + r32) * DM; unsigned char* hr = (unsigned char*)H2 + (size_t)(row0 + r32) * DM;
          f32x16 acc0 = {}, acc1 = {};
#pragma unroll 4
          for (int ks = 0; ks < 16; ++ks) { const int k = wv * 256 + ks * 16 + hi * 8;
              float h[8];
#pragma unroll
              for (int q = 0; q < 2; ++q) { const f32x4 x = *(const GAS f32x4*)(xr + k + 4 * q), w = *(const GAS f32x4*)(nw + k + 4 * q), sc = *(const GAS f32x4*)(mr + 4 * DM + k + 4 * q), sh = *(const GAS f32x4*)(mr + 3 * DM + k + 4 * q);
                  const f32x4 t = x * rstd * w * (sc + 1.0f) + sh; h[4 * q] = t[0]; h[4 * q + 1] = t[1]; h[4 * q + 2] = t[2]; h[4 * q + 3] = t[3]; }
              u32x4 wh, wl; float l[8];
              wh.x = cvt_pk_bf16(h[0], h[1]); wh.y = cvt_pk_bf16(h[2], h[3]); wh.z = cvt_pk_bf16(h[4], h[5]); wh.w = cvt_pk_bf16(h[6], h[7]);
#pragma unroll
              for (int i = 0; i < 4; ++i) { l[2 * i] = h[2 * i] - __uint_as_float(wh[i] << 16); l[2 * i + 1] = h[2 * i + 1] - __uint_as_float(wh[i] & 0xffff0000u); }
              wl.x = cvt_pk_bf16(l[0], l[1]); wl.y = cvt_pk_bf16(l[2], l[3]); wl.z = cvt_pk_bf16(l[4], l[5]); wl.w = cvt_pk_bf16(l[6], l[7]);
              { float hc[8];
#pragma unroll
                for (int i = 0; i < 8; ++i) hc[i] = fminf(fmaxf(h[i], -448.f), 448.f);
                int w0 = 0, w1 = 0; w0 = __builtin_amdgcn_cvt_pk_fp8_f32(hc[0], hc[1], w0, false); w0 = __builtin_amdgcn_cvt_pk_fp8_f32(hc[2], hc[3], w0, true);
                w1 = __builtin_amdgcn_cvt_pk_fp8_f32(hc[4], hc[5], w1, false); w1 = __builtin_amdgcn_cvt_pk_fp8_f32(hc[6], hc[7], w1, true);
                *(GAS unsigned long long*)(hr + k) = (unsigned long long)(unsigned)w0 | ((unsigned long long)(unsigned)w1 << 32); }
              const bf16x8 ah = __builtin_bit_cast(bf16x8, wh), al = __builtin_bit_cast(bf16x8, wl);
              const bf16x8 bh0 = *(const GAS bf16x8*)(RWT + (size_t)r32 * DM + k), bh1 = *(const GAS bf16x8*)(RWT + (size_t)(32 + r32) * DM + k);
              const bf16x8 bl0 = *(const GAS bf16x8*)(RWT + (size_t)(NE + r32) * DM + k), bl1 = *(const GAS bf16x8*)(RWT + (size_t)(NE + 32 + r32) * DM + k);
              acc0 = __builtin_amdgcn_mfma_f32_32x32x16_bf16(ah, bh0, acc0, 0, 0, 0); acc0 = __builtin_amdgcn_mfma_f32_32x32x16_bf16(ah, bl0, acc0, 0, 0, 0); acc0 = __builtin_amdgcn_mfma_f32_32x32x16_bf16(al, bh0, acc0, 0, 0, 0);
              acc1 = __builtin_amdgcn_mfma_f32_32x32x16_bf16(ah, bh1, acc1, 0, 0, 0); acc1 = __builtin_amdgcn_mfma_f32_32x32x16_bf16(ah, bl1, acc1, 0, 0, 0); acc1 = __builtin_amdgcn_mfma_f32_32x32x16_bf16(al, bh1, acc1, 0, 0, 0); }
#pragma unroll
          for (int r = 0; r < 16; ++r) { part[(wv * 32 + crow(r, hi)) * 64 + r32] = acc0[r]; part[(wv * 32 + crow(r, hi)) * 64 + 32 + r32] = acc1[r]; } }
        __syncthreads();
        for (int i = 0; i < 4; ++i) { const int rbk = wv * 4 + i, row = row0 + rbk; float logit = 0.f;
#pragma unroll
          for (int w = 0; w < 8; ++w) logit += part[(w * 32 + rbk) * 64 + lane];
          const float score = 1.0f / (1.0f + expf(-logit)), bsd = score + rb[lane];
          const int g = lane >> 3;
          int rk = 0;
#pragma unroll
          for (int q = 0; q < 8; ++q) { const int o = (lane & ~7) + q; const float vv = __shfl(bsd, o); rk += (vv > bsd) || (vv == bsd && o < lane); }
          float gs = rk < 2 ? bsd : 0.f;
          gs += __shfl_xor(gs, 1); gs += __shfl_xor(gs, 2); gs += __shfl_xor(gs, 4);
          int grk = 0;
#pragma unroll
          for (int gg = 0; gg < 8; ++gg) { const float vv = __shfl(gs, gg * 8); grk += (vv > gs) || (vv == gs && gg < g); }
          const bool gsel = grk < 4;
          const float mb = gsel ? bsd : -INFINITY;
          int erk = 0;
          for (int o = 0; o < 64; ++o) { const float vv = __shfl(mb, o); erk += (vv > mb) || (vv == mb && o < lane); }
          const bool sel = gsel && erk < TOPK;
          const float ssum = wave_sum(sel ? score : 0.f);
          if (sel) { const int lp = __hip_atomic_fetch_add(lcnt + lane, 1, __ATOMIC_RELAXED, __HIP_MEMORY_SCOPE_WORKGROUP);
                     EIDX[row * TOPK + erk] = lane; EW[row * TOPK + erk] = score / ssum * 2.5f; lent[(nb * 32 + rbk) * TOPK + erk] = (lane << 16) | lp; } }
        __syncthreads();
    }
    if (F.tid < NE) { const int c = lcnt[F.tid]; lbase[F.tid] = c ? atomicAdd(&CNT[F.tid * 64], c) : 0; }
    __syncthreads();
    for (int i = F.tid; i < nb * 256; i += NTHREADS) { const int blk = F.vcu + (i >> 8) * F.G, row = blk * 32 + ((i >> 3) & 31), v = lent[i]; const int pos = lbase[v >> 16] + (v & 0xffff); EPOS[row * TOPK + (i & 7)] = pos; TOKE[(v >> 16) * NTOK + pos] = row; }
    __syncthreads();
}
__device__ __forceinline__ void y16(const unsigned char* p, float (&f)[16]) {
    const u32x4 w = *(const GAS u32x4*)p;
#pragma unroll
    for (int i = 0; i < 4; ++i) { const auto lo = __builtin_amdgcn_cvt_pk_f32_fp8((int)w[i], false), hi = __builtin_amdgcn_cvt_pk_f32_fp8((int)w[i], true); f[4 * i] = lo[0]; f[4 * i + 1] = lo[1]; f[4 * i + 2] = hi[0]; f[4 * i + 3] = hi[1]; }
}
__device__ __forceinline__ void ph_comb(Frame& F, const Args& args, const float* mod) {
    const int gw = F.vcu * NWAVES + F.wave, NGW = F.G * NWAVES, lane = F.lane;
    moe_tables(F, 4);
    LAS int* T = (LAS int*)(F.lds + SCHT_OFF);
    const float* EW = (const float*)(F.ws + WS_EW); const int* EIDX = (const int*)(F.ws + WS_EIDX); const int* EPOS = (const int*)(F.ws + WS_EPOS); const unsigned char* Y = (const unsigned char*)(F.ws + WS_YBIG);
    for (int t = gw; t < NTOK; t += NGW) {
        const float* g2 = mod + (t / SEQ) * MODC + 5 * DM;
        int sl[TOPK]; float wk[TOPK];
#pragma unroll
        for (int k = 0; k < TOPK; ++k) { sl[k] = T[80 + EIDX[t * TOPK + k]] + EPOS[t * TOPK + k]; wk[k] = EW[t * TOPK + k]; }
#pragma unroll
        for (int j = 0; j < 2; ++j) { const int col = j * 1024 + lane * 16;
            float a[16]; y16(Y + (size_t)(NSLOT + t) * DM + col, a);
#pragma unroll
            for (int k = 0; k < TOPK; ++k) { float y[16]; y16(Y + (size_t)sl[k] * DM + col, y);
#pragma unroll
                for (int c = 0; c < 16; ++c) a[c] += wk[k] * y[c]; }
            float* o = args.out + (size_t)t * DM + col; const float* xi = (const float*)(F.ws + WS_X2) + (size_t)t * DM + col;
#pragma unroll
            for (int n = 0; n < 4; ++n) { const f32x4 xv = *(const GAS f32x4*)(xi + 4 * n), gv = *(const GAS f32x4*)(g2 + col + 4 * n);
                *(GAS f32x4*)(o + 4 * n) = xv + gv * (f32x4){a[4 * n], a[4 * n + 1], a[4 * n + 2], a[4 * n + 3]}; } }
    }
}

enum { PH_PRO = 0, PH_NORM1, PH_INPROJ, PH_QKNORM, PH_ATTN, PH_F2, PH_MERGE, PH_OUT, PH_ROUTE, PH_EXP1, PH_EXP2, PH_COMB, PH_END };


__global__ void __launch_bounds__(NTHREADS, 2) fwd(Args args) {
    extern __shared__ __attribute__((aligned(16))) unsigned char lds_raw[];
    Frame F;
    F.lds = (LAS unsigned char*)lds_raw; F.MISC = (volatile LAS unsigned*)(F.lds + MISC_OFF); F.ws = args.ws;
    F.tid = threadIdx.x; F.lane = F.tid & 63; F.wave = __builtin_amdgcn_readfirstlane(F.tid >> 6);
    F.G = gridDim.x; { const int bx = blockIdx.x; F.vcu = (F.G % 8 == 0) ? (bx % 8) * (F.G / 8) + bx / 8 : bx; }
    for (int u = F.tid; u < (LDS_BYTES - LDSCTL_OFF) / 4; u += NTHREADS) ((LAS unsigned*)(F.lds + LDSCTL_OFF))[u] = 0u;
    __syncthreads();
    const int lo = args.ph_lo, hi = args.ph_hi;
    const bool multi = (hi - lo) > 1;
    unsigned* barw = (unsigned*)(args.ws + CTL_BAR) + args.bar_idx * XCD_BAR_WORDS;
    XcdBarrier bar; bar.bar = barw; bar.x = 0; bar.st = nullptr;
    if (multi) bar = xcd_barrier_post(barw, F.MISC + 8);
#define IN(k) (lo <= (k) && (k) < hi)
#define SEAM(k) do { if (IN((k) + 1)) xcd_barrier(bar); } while (0)

    const float* modp = (const float*)(args.ws + args.mod_off);
    if (IN(PH_PRO)) { p0_prologue(F, args); SEAM(PH_PRO); }
    if (IN(PH_NORM1)) { ph_norm1(F, args, modp); SEAM(PH_NORM1); }
    if (IN(PH_INPROJ)) {
        { SchedIn S{F.G, (int)blockIdx.x, args.ws, args.use_ut};
          EpiIn E{EpiStore{(const float*)(args.ws + WS_W2048)}, (LAS float*)(F.lds + GPARK_OFF), args.in[8], args.in[9], (const float*)(args.ws + WS_ROPE)};
          gemm_phase<EpiIn, SchedIn, false>(F.lds, DM, DM, DM, S, E); }
        { SchedGate S{F.G, (int)blockIdx.x, args.ws};
          gemm_phase<EpiStore, SchedGate, false, true>(F.lds, DM, DM / 2, DM / 2, S, EpiStore{(const float*)(args.ws + WS_W2048)}); }
        SEAM(PH_INPROJ);
    }
    if (IN(PH_QKNORM)) { ph_evenodd(F, args); SEAM(PH_QKNORM); }
    if (IN(PH_ATTN)) {
        const int cs = F.vcu & 3;
        constexpr int NCONV = IT_EG + IT_EU + IT_ED;
        int qfirst, qcnt; { const int c = (int)blockIdx.x; if (F.G == 256) { qfirst = c < 144 ? c * 164 : 144 * 164 + (c - 144) * 228; qcnt = c < 144 ? 164 : 228; }
                             else { const int per = (NCONV + F.G - 1) / F.G; qfirst = c * per; qcnt = qfirst + per <= NCONV ? per : (NCONV - qfirst > 0 ? NCONV - qfirst : 0); } }
        const int gcnt = qfirst < IT_EG + IT_EU ? (qfirst + qcnt <= IT_EG + IT_EU ? qcnt : IT_EG + IT_EU - qfirst) : 0, gfirst = qfirst;
        const int ccnt = qcnt - gcnt, cfirst = qfirst + gcnt - (IT_EG + IT_EU);
#define CONV_ALL() do { conv_items(F, args, false, gfirst, gcnt); conv_items(F, args, true, cfirst, ccnt); } while (0)
        const bf16_t* Qp = (const bf16_t*)(args.ws + WS_Q); const bf16_t* Kp = (const bf16_t*)(args.ws + WS_KALL); const bf16_t* Vp = (const bf16_t*)(args.ws + WS_VALL); bf16_t* Op = (bf16_t*)(args.ws + WS_YA);
#define ATTN_UNIT(lin_) do { const int lin = (lin_); if (lin < 512) { const int x = (lin >> 5) & 7, j = (lin & 31) + 32 * (lin >> 8), b = x >> 2, kvh = x & 3, head = kvh * 4 + (j >> 4), qb = j & 15; \
            const size_t qo = ((size_t)(b * SEQ + qb * 256)) * DM + head * HD, ko = (size_t)b * SKV * KVW + kvh * HD; \
            attn::attn_dense_body(Qp + qo, Kp + ko, Vp + ko, Op + qo, SKV, (char*)lds_raw); __syncthreads(); } } while (0)
        if (cs == 0) { CONV_ALL(); __syncthreads(); }
        ATTN_UNIT(F.vcu);
        if (cs == 1) { CONV_ALL(); __syncthreads(); }
        ATTN_UNIT(F.vcu + F.G);
        for (int lin2 = F.vcu + 2 * F.G; lin2 < 512; lin2 += F.G) ATTN_UNIT(lin2);
        if (cs == 2) { CONV_ALL(); __syncthreads(); }
#undef ATTN_UNIT
        SchedAG S{F.G, (int)blockIdx.x, args.ws};
        gemm_phase<EpiStore, SchedAG, false>(F.lds, DM, DM, DM, S, EpiStore{(const float*)(args.ws + WS_W2048)});
        if (cs == 3) { __syncthreads(); CONV_ALL(); }
#undef CONV_ALL
        SEAM(PH_ATTN);
    }
    if (IN(PH_F2)) {
        SchedF2 S{F.G, (int)blockIdx.x, args.ws};
        gemm_phase<EpiStore, SchedF2, false>(F.lds, 512, DM, 512, S, EpiStore{(const float*)(args.ws + WS_W2048)});
        {
            const int idx = F.vcu * NTHREADS + F.tid;
            if (idx < 2 * FW) { const int b = idx >> 10, col = idx & 1023, k2 = col & 127; const float* al = (const float*)(args.ws + WS_ALT) + b * FW + (col & ~127); float s = 0.f;
                for (int c = 0; c < 128; ++c) s += al[c] * cospif((float)((c * k2) & 127) * (1.0f / 64.0f));
                ((bf16_t*)(args.ws + WS_YF))[((size_t)b * SEQ + SEQ / 2) * YFP + col] = f2bf(s * 0.0013810679320049757f); }
        }
        SEAM(PH_F2);
    }
    if (IN(PH_MERGE)) {
        unsigned char* ws = args.ws;
        SchedMerge S{F.G, (int)blockIdx.x, ws};
        gemm_phase<EpiMerge, SchedMerge, false>(F.lds, DM, DM, DM, S, EpiMerge{(const bf16_t*)(ws + WS_SGF), (const bf16_t*)(ws + WS_SGA), (bf16_t*)(ws + WS_YM)});
        SEAM(PH_MERGE);
    }
    if (IN(PH_OUT)) {
        unsigned char* ws = args.ws;
        SchedGrid S{F.G, (int)blockIdx.x, 32, 8, (const char*)(ws + WS_YM), (const char*)(ws + WS_WT_O), nullptr, (size_t)256 * DM * 2, (size_t)256 * DM * 2, DM, 4, 1, DM / BK};
        gemm_phase<EpiX2, SchedGrid, false>(F.lds, DM, DM, DM, S, EpiX2{args.in[0], modp, (float*)(ws + WS_X2)});
        SEAM(PH_OUT);
    }
    if (IN(PH_ROUTE)) { ph_route(F, args, modp); SEAM(PH_ROUTE); }
    if (IN(PH_EXP1)) {
        moe_tables(F, 4);
        SchedMoe<4, true> S{F.G, F.vcu, args.ws, (LAS int*)(F.lds + SCHT_OFF), (const int*)(args.ws + WS_TOKE)};
        gemm_phase<EpiAct, SchedMoe<4, true>, true, true>(F.lds, DM, DM / 2, DM / 2, S, EpiAct{});
        SEAM(PH_EXP1);
    }
    if (IN(PH_EXP2)) {
        moe_tables(F, 8);
        SchedMoe<8, false> S{F.G, F.vcu, args.ws, (LAS int*)(F.lds + SCHT_OFF), (const int*)(args.ws + WS_TOKE)};
        gemm_phase<EpiY8, SchedMoe<8, false>, false, true>(F.lds, EFF, EFF / 2, EFF / 2, S, EpiY8{});
        SEAM(PH_EXP2);
    }
    if (IN(PH_COMB)) { ph_comb(F, args, modp); }
#undef IN
#undef SEAM
}
}

extern "C" void kernel_launch(void* const* d_in, const int* in_sizes, int n_in, void* d_out, int out_size, void* d_ws, size_t ws_size, hipStream_t stream) {
    if (n_in != 22 || ws_size < WS_END2) return;
    float* out = (float*)d_out;
    unsigned char* ws = (unsigned char*)d_ws;
    hipMemsetAsync(ws + WS_CTL, 0, CTL_ZERO_BYTES, stream);
    static int grid = 0;
    if (!grid) {
        int dev = 0, cus = 0;
        if (hipGetDevice(&dev) != hipSuccess || hipDeviceGetAttribute(&cus, hipDeviceAttributeMultiprocessorCount, dev) != hipSuccess) { grid = -1; return; }
        if (hipFuncSetAttribute((const void*)mk::fwd, hipFuncAttributeMaxDynamicSharedMemorySize, mk::LDS_BYTES) != hipSuccess) { grid = -1; return; }
        grid = cus;
    }
    if (grid < 0) return;
    mk::Args a{}; int nlaunch = 0;
    for (int i = 0; i < 22; ++i) a.in[i] = (const float*)d_in[i];
    a.out = out; a.ws = ws; a.use_ut = 1; a.mod_off = (int)WS_MOD; a.do_attn = 1;
#define MK_LAUNCH(lo_, hi_) do { a.ph_lo = (lo_); a.ph_hi = (hi_); a.bar_idx = nlaunch++; hipLaunchKernelGGL(mk::fwd, dim3(grid), dim3(mk::NTHREADS), mk::LDS_BYTES, stream, a); } while (0)
    MK_LAUNCH(mk::PH_PRO, mk::PH_END);
}
```

```cpp
#include <hip/hip_runtime.h>
#include <stdint.h>
#include <math.h>

typedef unsigned short bf16_t;
typedef short bf16x8 __attribute__((ext_vector_type(8)));
typedef float f32x16 __attribute__((ext_vector_type(16)));
typedef float f32x4 __attribute__((ext_vector_type(4)));

constexpr int NB = 2, SEQ = 4096, DM = 2048, NTOK = NB * SEQ, CTXL = 256, NCTX = NB * CTXL, HD = 128, NH = 16, NKV = 4;
constexpr int SKV = SEQ + CTXL;
constexpr int FW = 1024, INC = 8192, Q_OFF = 1024, K_OFF = 3072, V_OFF = 3584, GF_OFF = 4096, GA_OFF = 6144;
constexpr int KVW = NKV * HD;
constexpr int NE = 64, TOPK = 8, EFF = 512, MODC = 6 * DM;
constexpr int NSLOT = NTOK * TOPK;
constexpr int NSLOT_ALL = NSLOT + NTOK;

constexpr size_t MiB = 1u << 20;
constexpr size_t WS_CTL = 0, CTL_ZERO_BYTES = 1 * MiB;
constexpr size_t CTL_CNT = 64 * 1024;
constexpr size_t WS_TW = 1 * MiB;
constexpr size_t WS_MOD = 1 * MiB + 64 * 1024;
constexpr size_t WS_OFFS = 1 * MiB + 256 * 1024;
constexpr size_t WS_EIDX = 2 * MiB;
constexpr size_t WS_EW = WS_EIDX + 256 * 1024;
constexpr size_t WS_EPOS = WS_EW + 256 * 1024;
constexpr size_t WS_SLOTOF = WS_EPOS + 256 * 1024;
constexpr size_t WS_TOKE = 300 * MiB;
constexpr size_t WS_H = 4 * MiB;
constexpr size_t WS_U = 38 * MiB;
constexpr size_t WS_Q = 54 * MiB;
constexpr size_t WS_KALL = 86 * MiB;
constexpr size_t WS_VALL = 95 * MiB;
constexpr size_t WS_SGF = 104 * MiB;
constexpr size_t WS_SGA = 136 * MiB;
constexpr size_t WS_YA = 168 * MiB;
constexpr size_t WS_YF = 38 * MiB;
constexpr int YFP = 2048;
constexpr size_t WS_PR = 216 * MiB;
constexpr size_t WS_T1 = 248 * MiB;
constexpr size_t WS_YM = 312 * MiB;
constexpr size_t WS_QKRAW = 248 * MiB;
constexpr size_t WS_KCRAW = 330 * MiB;
constexpr size_t WS_H2 = 344 * MiB;
constexpr size_t WS_ACT = 376 * MiB;
constexpr size_t WS_YBIG = 4 * MiB;
constexpr size_t WS_END = 740 * MiB;

__device__ __forceinline__ float bf2f(bf16_t h) { return __uint_as_float(((unsigned)h) << 16); }
__device__ __forceinline__ bf16_t f2bf(float f) { unsigned u = __float_as_uint(f); return (bf16_t)((u + 0x7fffu + ((u >> 16) & 1u)) >> 16); }
__device__ __forceinline__ int crow(int r, int hi) { return (r & 3) + 8 * (r >> 2) + 4 * hi; }
__device__ __forceinline__ float wave_sum(float v) {
#pragma unroll
    for (int o = 1; o < 64; o <<= 1) v += __shfl_xor(v, o);
    return v;
}
__device__ __forceinline__ float sigmoidf_(float v) { return 1.0f / (1.0f + expf(-v)); }
__device__ __forceinline__ bf16x8 pack8(const float* f) {
    bf16x8 r;
#pragma unroll
    for (int i = 0; i < 8; ++i) r[i] = (short)f2bf(f[i]);
    return r;
}

#define LAS __attribute__((address_space(3)))
#define GAS __attribute__((address_space(1)))
typedef unsigned u32x4 __attribute__((ext_vector_type(4)));
typedef GAS unsigned gu32;
#define RLX_AGENT __ATOMIC_RELAXED, __HIP_MEMORY_SCOPE_AGENT
#define LDS_WAIT() asm volatile("s_waitcnt lgkmcnt(0)" ::: "memory")
#define VM_WAIT() asm volatile("s_waitcnt vmcnt(0)" ::: "memory")

constexpr size_t CTL_BAR = 16384;
constexpr size_t CTL_MODZ = 512 * 1024;
constexpr size_t WS_UT = 38 * MiB;
constexpr size_t WS_TT = 216 * MiB;
constexpr size_t WS_WT_GU = 450 * MiB;
constexpr size_t WS_WT_D = 710 * MiB;
constexpr size_t WS_WT_IN = 840 * MiB;
constexpr size_t WS_WT_FO = 924 * MiB;
constexpr size_t WS_WT_AO = 876 * MiB;
constexpr size_t WS_WT_O = 884 * MiB;
constexpr size_t WS_CST = 892 * MiB;
constexpr size_t WS_ET = 908 * MiB;
constexpr size_t WS_OT = 916 * MiB;
constexpr size_t WS_W2048 = 1 * MiB + 512 * 1024;
constexpr size_t WS_ALT = 1 * MiB + 520 * 1024;
constexpr size_t WS_ROPE = 1 * MiB + 528 * 1024;
constexpr size_t WS_RWT = 3 * MiB + 512 * 1024;
constexpr size_t WS_BD2 = 956 * MiB;
constexpr size_t WS_H8 = 200 * MiB;
constexpr size_t WS_WT_G8 = 932 * MiB;
constexpr size_t WS_X2 = 960 * MiB;
constexpr size_t WS_END2 = 1024 * MiB;

namespace mk {
constexpr int NWAVES = 8, NTHREADS = 512;
constexpr int RING_BYTES = 131072, SCR_BYTES = 8 * 16640, LDSCTL_OFF = 135168, MISC_OFF = LDSCTL_OFF + 320, GPARK_OFF = LDSCTL_OFF + 2048  , LDS_BYTES = 147456;
static_assert(GPARK_OFF + 8192 <= LDS_BYTES, "LDS map");
static_assert(SCR_BYTES <= LDSCTL_OFF && MISC_OFF + 128 <= LDS_BYTES, "LDS map");

#define XB_TMO      128
#define XB_XCNT(j)  (256  + 64 * (j))
#define XB_XSUB(j)  (1280 + 64 * (j))
#define XB_XGEN(j)  (2304 + 64 * (j))
#define XB_TOP      3328
#define XB_TOPGEN   3392
#define XCD_BAR_WORDS 3456
#define XB_SPIN_CAP (1u << 18)
__device__ __forceinline__ unsigned xb_ld(unsigned* p)              { return __hip_atomic_load(p, __ATOMIC_RELAXED, __HIP_MEMORY_SCOPE_AGENT); }
__device__ __forceinline__ unsigned xb_add(unsigned* p, unsigned v) { return __hip_atomic_fetch_add(p, v, __ATOMIC_RELAXED, __HIP_MEMORY_SCOPE_AGENT); }
__device__ __forceinline__ unsigned xb_xcc_id() { return (unsigned)__builtin_amdgcn_s_getreg((3 << 11) | 20) & 0xFu; }
#define XB_SPIN(cond, bar) do { unsigned _sp = 0; while (cond) { __builtin_amdgcn_s_sleep(1); \
    if ((++_sp & 255u) == 0u) { if (xb_ld(&(bar)[XB_TMO])) break; if (_sp > XB_SPIN_CAP) { atomicAdd(&(bar)[XB_TMO], 1u); break; } } } } while (0)
struct XcdBarrier { unsigned* bar; unsigned x; volatile LAS unsigned* st; };
__device__ __forceinline__ XcdBarrier xcd_barrier_post(unsigned* bar, volatile LAS unsigned* st) {
    XcdBarrier b; b.bar = bar; b.x = xb_xcc_id(); b.st = st;
    if (threadIdx.x == 0) (void)xb_add(&bar[XB_XCNT(b.x)], 1u);
    return b;
}
__device__ __forceinline__ void xcd_barrier_complete(unsigned* bar, unsigned x, unsigned& nloc, unsigned& nx) {
    const unsigned G = gridDim.x * gridDim.y * gridDim.z;
    unsigned sum, cnt, mine, sp = 0u;
    for (;;) {
        sum = 0u; cnt = 0u; mine = 0u;
#pragma unroll
        for (unsigned j = 0; j < 16; ++j) { const unsigned c = xb_ld(&bar[XB_XCNT(j)]); sum += c; cnt += (c > 0u) ? 1u : 0u; mine = (j == x) ? c : mine; }
        if (sum == G) break;
        __builtin_amdgcn_s_sleep(1);
        if ((++sp & 255u) == 0u) { if (xb_ld(&bar[XB_TMO])) break; if (sp > XB_SPIN_CAP) { atomicAdd(&bar[XB_TMO], 1u); break; } }
    }
    nloc = mine > 0u ? mine : 1u; nx = cnt > 0u ? cnt : 1u;
}
__device__ __forceinline__ void xcd_barrier(const XcdBarrier& b) {
    asm volatile("s_waitcnt vmcnt(0)" ::: "memory");
    __syncthreads();
    if (threadIdx.x == 0) {
        unsigned* bar = b.bar;
        __builtin_amdgcn_s_waitcnt(0);
        unsigned nloc = b.st[0], nx = b.st[1];
        if (nloc == 0u) { xcd_barrier_complete(bar, b.x, nloc, nx); b.st[0] = nloc; b.st[1] = nx; }
        const unsigned old = xb_add(&bar[XB_XSUB(b.x)], 1u);
        const unsigned gen = old / nloc;
        if (old + 1u == (gen + 1u) * nloc) {
            __builtin_amdgcn_fence(__ATOMIC_RELEASE, "agent");
            asm volatile("s_waitcnt vmcnt(0)" ::: "memory");
            const unsigned og = xb_add(&bar[XB_TOP], 1u);
            const unsigned tg = og / nx;
            if (og + 1u == (tg + 1u) * nx) xb_add(&bar[XB_TOPGEN], 1u);
            else XB_SPIN(xb_ld(&bar[XB_TOPGEN]) == tg, bar);
            __builtin_amdgcn_fence(__ATOMIC_ACQUIRE, "agent");
            xb_add(&bar[XB_XGEN(b.x)], 1u);
            asm volatile("s_waitcnt vmcnt(0)" ::: "memory");
        } else {
            XB_SPIN(xb_ld(&bar[XB_XGEN(b.x)]) == gen, bar);
            __builtin_amdgcn_fence(__ATOMIC_ACQUIRE, "agent");
            asm volatile("s_waitcnt vmcnt(0)" ::: "memory");
        }
    }
    __syncthreads();
}

constexpr int BM = 256, BK = 64, HALF = 128, HTB = HALF * BK * 2, STAGE_BYTES = 8 * HTB;
__device__ __forceinline__ int lds_byte(int r, int c) { const int st = (r >> 4) * 2 + (c >> 5), rr = r & 15, cc = c & 31, ob = rr * 64 + cc * 2; return st * 1024 + (ob ^ (((ob >> 9) & 1) << 5)); }
__device__ __forceinline__ void stage_rc(int b, int& R, int& C) { const int st = b / 1024, sb = b % 1024, swz = sb ^ (((sb >> 9) & 1) << 5); R = (st >> 1) * 16 + swz / 64; C = (st & 1) * 32 + (swz % 64) / 2; }
__device__ __forceinline__ int perm32(int rho) { const int n = rho >> 4, i = rho & 15; return 8 * (i >> 2) + 4 * n + (i & 3); }
__device__ __forceinline__ unsigned cvt_pk_bf16(float lo, float hi) { unsigned r; asm("v_cvt_pk_bf16_f32 %0, %1, %2" : "=v"(r) : "v"(lo), "v"(hi)); return r; }

__device__ __forceinline__ void glds16_s(const void* sbase, unsigned voff, unsigned lds_dst) { unsigned keep;
    asm volatile("s_mov_b32 %0, m0\n\ts_mov_b32 m0, %3\n\ts_nop 0\n\tglobal_load_lds_dwordx4 %1, %2\n\ts_mov_b32 m0, %0" : "=&s"(keep) : "v"(voff), "s"(sbase), "s"(lds_dst) : "memory"); }

struct Unit { const char* A; const char* B; char* C; int ldc; int mode; int rows; int aux; int pm, pn, bjs, rmin, e, nt, keep; };

typedef int i32x8 __attribute__((ext_vector_type(8)));
typedef int i32x4 __attribute__((ext_vector_type(4)));
template <class Epi, class Sched, bool GATHER, bool F8 = false>
__device__ __forceinline__ void gemm_phase(LAS unsigned char* lds, const int K, const int lda, const int ldb, const Sched& S, const Epi& E, const int i0 = 0, const int i1 = 0x7fffffff) {
    const int tid = threadIdx.x, wid = __builtin_amdgcn_readfirstlane(tid >> 6), lane = tid & 63, wr = wid >> 2, wc = wid & 3, fr = lane & 15, fq = lane >> 4;
    unsigned voffA[2], voffB[2];
#pragma unroll
    for (int i = 0; i < 2; ++i) { int R, C; stage_rc(tid * 16 + i * 8192, R, C); const int Rb = (R & ~31) + perm32(R & 31);
        voffA[i] = (unsigned)(R * lda + C) * 2u; voffB[i] = (unsigned)(Rb * ldb + C) * 2u; }
    const size_t kstep = (size_t)(BK * 2);
    const size_t hstepA = (size_t)HALF * lda * 2, hstepB = (size_t)HALF * ldb * 2;
    const unsigned ldsw = (unsigned)wid * 1024u;
    const unsigned ldsbase = (unsigned)__builtin_amdgcn_readfirstlane((int)(unsigned)(uintptr_t)lds);
    const int aoff = F8 ? lds_byte(wr * 64 + fr, (fq >> 1) * 32 + (fq & 1) * 16) : lds_byte(wr * 64 + fr, fq * 8), boff = F8 ? lds_byte(wc * 32 + fr, (fq >> 1) * 32 + (fq & 1) * 16) : lds_byte(wc * 32 + fr, fq * 8);

#define MK_SA(b, h) (((b) * 2 + (h)) * HTB)
#define MK_SB(b, h) ((4 + (b) * 2 + (h)) * HTB)
#define MK_STAGE2(bufoff, gbase, v0, v1) do { \
        __builtin_amdgcn_global_load_lds((const unsigned*)((const char*)(gbase) + (v0)), (LAS unsigned*)(lds + (bufoff) + ldsw), 16, 0, 0); \
        __builtin_amdgcn_global_load_lds((const unsigned*)((const char*)(gbase) + (v1)), (LAS unsigned*)(lds + (bufoff) + ldsw + 8192), 16, 0, 0); } while (0)
#define MK_STAGE_B(bufoff, gbase) do { glds16_s((gbase), voffB[0], ldsbase + (bufoff) + ldsw); glds16_s((gbase), voffB[1], ldsbase + (bufoff) + ldsw + 8192u); } while (0)
#define MK_STAGE_A(bufoff, gbase, h, VA) do { if constexpr (GATHER) { glds16_s((gbase), (VA)[h][0], ldsbase + (bufoff) + ldsw); glds16_s((gbase), (VA)[h][1], ldsbase + (bufoff) + ldsw + 8192u); } \
        else { glds16_s((gbase) + (h) * hstepA, voffA[0], ldsbase + (bufoff) + ldsw); glds16_s((gbase) + (h) * hstepA, voffA[1], ldsbase + (bufoff) + ldsw + 8192u); } } while (0)
#define MK_LDA(dst, b, h) do { if constexpr (F8) { _Pragma("unroll") for (int m = 0; m < 4; ++m) dst##8[m] = *(const LAS i32x8*)(lds + MK_SA(b, h) + aoff + m * 2048); } \
        else { _Pragma("unroll") for (int m = 0; m < 4; ++m) _Pragma("unroll") for (int k = 0; k < 2; ++k) dst[m][k] = *(const LAS bf16x8*)(lds + MK_SA(b, h) + aoff + m * 2048 + k * 1024); } } while (0)
#define MK_LDB(dst, b, h) do { if constexpr (F8) { _Pragma("unroll") for (int n = 0; n < 2; ++n) dst##8[n] = *(const LAS i32x8*)(lds + MK_SB(b, h) + boff + n * 2048); } \
        else { _Pragma("unroll") for (int n = 0; n < 2; ++n) _Pragma("unroll") for (int k = 0; k < 2; ++k) dst[n][k] = *(const LAS bf16x8*)(lds + MK_SB(b, h) + boff + n * 2048 + k * 1024); } } while (0)
#define MK_MMA(ai, bj, At, Bt) do { __builtin_amdgcn_s_setprio(1); \
        if constexpr (F8) { _Pragma("unroll") for (int m = 0; m < 4; ++m) _Pragma("unroll") for (int n = 0; n < 2; ++n) \
            acc[ai][bj][m][n] = __builtin_amdgcn_mfma_scale_f32_16x16x128_f8f6f4(Bt##8[n], At##8[m], acc[ai][bj][m][n], 0, 0, 0, 0x7d, 0, 0x7d  ); } \
        else { _Pragma("unroll") for (int m = 0; m < 4; ++m) _Pragma("unroll") for (int n = 0; n < 2; ++n) _Pragma("unroll") for (int k = 0; k < 2; ++k) \
            acc[ai][bj][m][n] = __builtin_amdgcn_mfma_f32_16x16x32_bf16(Bt[n][k], At[m][k], acc[ai][bj][m][n], 0, 0, 0); } \
        __builtin_amdgcn_s_setprio(0); } while (0)
#define MK_WAIT_V(n) asm volatile("s_waitcnt vmcnt(" #n ")" ::: "memory")
#define MK_WAIT_L(n) asm volatile("s_waitcnt lgkmcnt(" #n ")" ::: "memory")
#define MK_BAR __builtin_amdgcn_s_barrier()
#define MK_SCHED __builtin_amdgcn_sched_barrier(0)
    Unit cur, nxt; int ui = i0;
    if (i0 >= i1 || !S.next(i0, cur)) return;
    f32x4 acc[2][2][4][2];
#pragma unroll
    for (int a = 0; a < 2; ++a)
#pragma unroll
        for (int b = 0; b < 2; ++b)
#pragma unroll
            for (int m = 0; m < 4; ++m)
#pragma unroll
                for (int n = 0; n < 2; ++n) acc[a][b][m][n] = (f32x4){0.f, 0.f, 0.f, 0.f};
    bf16x8 At[4][2], B0[2][2], B1[2][2]; i32x8 At8[4], B08[2], B18[2];
    unsigned vC[2][2];
    LAS u32x4* vpark = (LAS u32x4*)(lds + GPARK_OFF) + tid;
    if constexpr (GATHER) {
#pragma unroll
        for (int h = 0; h < 2; ++h)
#pragma unroll
            for (int i = 0; i < 2; ++i) { int R, C; stage_rc(tid * 16 + i * 8192, R, C); vC[h][i] = S.arow(cur, h * HALF + R) + (unsigned)(C * 2); }
    }
    const char* cA = cur.A; const char* cB = cur.B;
    MK_STAGE_B(MK_SB(0, 0), cB); MK_STAGE_B(MK_SB(0, 1), cB + hstepB); MK_STAGE_A(MK_SA(0, 0), cA, 0, vC); MK_STAGE_A(MK_SA(0, 1), cA, 1, vC);
    if (wr == 1) MK_BAR;
    MK_WAIT_V(2); MK_BAR;
    MK_STAGE_B(MK_SB(1, 0), cB + kstep); MK_STAGE_A(MK_SA(1, 0), cA + kstep, 0, vC); MK_STAGE_B(MK_SB(1, 1), cB + hstepB + kstep);
    MK_WAIT_V(6); MK_BAR;
    for (;;) {
        const bool has_next = (ui + 1 < i1) && S.next(ui + 1, nxt);
        const char* nA = has_next ? nxt.A : cA; const char* nB = has_next ? nxt.B : cB;
        if constexpr (GATHER) {
            u32x4 pv;
#pragma unroll
            for (int h = 0; h < 2; ++h)
#pragma unroll
                for (int i = 0; i < 2; ++i) { int R, C; stage_rc(tid * 16 + i * 8192, R, C); pv[h * 2 + i] = has_next ? (S.arow(nxt, h * HALF + R) + (unsigned)(C * 2)) : vC[h][i]; }
            *vpark = pv;
        }
        int nt = cur.nt; asm volatile("" : "+s"(nt));
#pragma nounroll
        for (int t = 0; t < nt; t += 2) {
            const bool last = (t == nt - 2);
            const char* a1 = cA + (size_t)(t + 1) * kstep;
            const char* a2 = last ? nA : cA + (size_t)(t + 2) * kstep; const char* b2 = last ? nB : cB + (size_t)(t + 2) * kstep;
            const char* a3 = a2 + kstep; const char* b3 = b2 + kstep;
            MK_LDB(B0, 0, 0); MK_LDB(B1, 0, 1); MK_SCHED; MK_LDA(At, 0, 0); MK_STAGE_A(MK_SA(1, 1), a1, 1, vC);
            if constexpr (GATHER) { if (last) { const u32x4 pv = *vpark; vC[0][0] = pv[0]; vC[0][1] = pv[1]; vC[1][0] = pv[2]; vC[1][1] = pv[3]; } }
            MK_WAIT_V(8); MK_WAIT_L(0); MK_BAR; MK_MMA(0, 0, At, B0); MK_MMA(0, 1, At, B1); MK_BAR; MK_SCHED;
            MK_LDA(At, 0, 1); MK_STAGE_B(MK_SB(0, 0), b2); MK_STAGE_B(MK_SB(0, 1), b2 + hstepB); MK_STAGE_A(MK_SA(0, 0), a2, 0, vC);
            MK_WAIT_V(8); MK_WAIT_L(0); MK_BAR; MK_MMA(1, 0, At, B0); MK_MMA(1, 1, At, B1); MK_BAR; MK_SCHED;
            MK_LDB(B0, 1, 0); MK_LDB(B1, 1, 1); MK_SCHED; MK_LDA(At, 1, 0); MK_STAGE_A(MK_SA(0, 1), a2, 1, vC);
            MK_WAIT_V(8); MK_WAIT_L(0); MK_BAR; MK_MMA(0, 0, At, B0); MK_MMA(0, 1, At, B1); MK_BAR; MK_SCHED;
            MK_LDA(At, 1, 1); MK_STAGE_B(MK_SB(1, 0), b3); MK_STAGE_B(MK_SB(1, 1), b3 + hstepB); MK_STAGE_A(MK_SA(1, 0), a3, 0, vC);
            MK_WAIT_V(8); MK_WAIT_L(0); MK_BAR; MK_MMA(1, 0, At, B0); MK_MMA(1, 1, At, B1); MK_BAR; MK_SCHED;
        }
        if (wr == 0) MK_BAR;
        { int l2; asm volatile("v_mbcnt_lo_u32_b32 %0, -1, 0\n\tv_mbcnt_hi_u32_b32 %0, -1, %0" : "=v"(l2));
          E(acc, cur, wr, wc, l2 & 15, l2 >> 4); }
        if (!has_next) break;
        if (!cur.keep)
#pragma unroll
        for (int a = 0; a < 2; ++a)
#pragma unroll
            for (int b = 0; b < 2; ++b)
#pragma unroll
                for (int m = 0; m < 4; ++m)
#pragma unroll
                    for (int n = 0; n < 2; ++n) acc[a][b][m][n] = (f32x4){0.f, 0.f, 0.f, 0.f};
        cur = nxt; cA = nA; cB = nB; ++ui;
        if (wr == 1) MK_BAR;
    }
    MK_WAIT_V(0);
    MK_BAR;
#undef MK_SA
#undef MK_SB
#undef MK_STAGE2
#undef MK_STAGE_B
#undef MK_STAGE_A
#undef MK_LDA
#undef MK_LDB
#undef MK_MMA
#undef MK_WAIT_V
#undef MK_WAIT_L
#undef MK_BAR
#undef MK_SCHED
}

__device__ __forceinline__ void grid_map(int L, int nM, int nN, int& pm, int& pn) {
    const int nwg = nM * nN, q = nwg / 8, xcd = L % 8, off = L / 8; const int wgid = xcd * q + off;
    const int nig = 8 * nN, gid = wgid / nig, fm = gid * 8, gsz = (nM - fm) < 8 ? (nM - fm) : 8;
    pm = fm + ((wgid % nig) % gsz); pn = (wgid % nig) / gsz;
}

struct EpiStore {
    const float* w2048;
    __device__ __forceinline__ void operator()(f32x4 (&acc)[2][2][4][2], const Unit& u, int wr, int wc, int fr, int fq) const {
        const int col0 = wc * 32 + 8 * fq;
#pragma unroll
        for (int ai = 0; ai < 2; ++ai)
#pragma unroll
            for (int m = 0; m < 4; ++m) {
                const int r = ai * HALF + wr * 64 + m * 16 + fr;
                if (r < u.rows && r >= u.rmin) {
#pragma unroll
                    for (int bj = 0; bj < 2; ++bj) {
                        f32x4 v0 = acc[ai][bj][m][0], v1 = acc[ai][bj][m][1];
                        if (u.mode == 1) { float* p = (float*)u.C + (long)r * u.ldc + col0 + bj * u.bjs; *(f32x4*)p = v0; *(f32x4*)(p + 4) = v1; }
                        else {
                            if (u.mode == 2) {
#pragma unroll
                                for (int c = 0; c < 4; ++c) { v0[c] = __builtin_amdgcn_rcpf(1.0f + __expf(-v0[c])); v1[c] = __builtin_amdgcn_rcpf(1.0f + __expf(-v1[c])); }
                            } else if (u.mode == 3) {
                                const float* wp = w2048 + u.pn + bj * HALF + col0; const float sg = (r & 1) ? -1.0f : 1.0f;
                                v0 += *(const f32x4*)wp * sg; v1 += *(const f32x4*)(wp + 4) * sg;
                            }
                            u32x4 w; w.x = cvt_pk_bf16(v0[0], v0[1]); w.y = cvt_pk_bf16(v0[2], v0[3]); w.z = cvt_pk_bf16(v1[0], v1[1]); w.w = cvt_pk_bf16(v1[2], v1[3]);
                            *(u32x4*)((bf16_t*)u.C + (long)r * u.ldc + col0 + bj * u.bjs) = w;
                        }
                    }
                }
            }
    }
};


struct EpiIn { EpiStore base; LAS float* red; const float* qnw; const float* knw; const float* rope;
    __device__ __forceinline__ void operator()(f32x4 (&acc)[2][2][4][2], const Unit& u, int wr, int wc, int fr, int fq) const {
        if (u.mode < 5) { base(acc, u, wr, wc, fr, fq); return; }
#pragma unroll
        for (int ai = 0; ai < 2; ++ai)
#pragma unroll
            for (int m = 0; m < 4; ++m)
#pragma unroll
                for (int bj = 0; bj < 2; ++bj) { const f32x4 a = acc[ai][bj][m][0], b = acc[ai][bj][m][1];
                    float s = (a[0] * a[0] + a[1] * a[1]) + (a[2] * a[2] + a[3] * a[3]) + (b[0] * b[0] + b[1] * b[1]) + (b[2] * b[2] + b[3] * b[3]);
                    s += __shfl_xor(s, 16); s += __shfl_xor(s, 32);
                    if (fq == 0) red[((ai * HALF + wr * 64 + m * 16 + fr) * 2 + bj) * 4 + wc] = s; }
        asm volatile("s_waitcnt lgkmcnt(0)" ::: "memory"); __builtin_amdgcn_s_barrier(); asm volatile("" ::: "memory");
        const float* nw = u.mode == 5 ? qnw : knw;
        const int axis = wc >> 1, f0 = (wc & 1) * 16 + fq * 4, da = axis * 64 + f0;
        const f32x4 wa = *(const f32x4*)(nw + da), wb = *(const f32x4*)(nw + da + 32);
#pragma unroll
        for (int ai = 0; ai < 2; ++ai)
#pragma unroll
            for (int m = 0; m < 4; ++m) { const int r = ai * HALF + wr * 64 + m * 16 + fr;
                f32x4 cs = {1.f, 1.f, 1.f, 1.f}, sn = {0.f, 0.f, 0.f, 0.f};
                if (u.mode != 7) { const int t = u.pm + r, pos = axis ? (t & 63) : (t >> 6); const float* rp = rope + (pos * 32 + f0) * 2;
                    const f32x4 p0 = *(const f32x4*)rp, p1 = *(const f32x4*)(rp + 4); cs = (f32x4){p0[0], p0[2], p1[0], p1[2]}; sn = (f32x4){p0[1], p0[3], p1[1], p1[3]}; }
#pragma unroll
                for (int bj = 0; bj < 2; ++bj) { const LAS f32x4* pp = (const LAS f32x4*)(red + (r * 2 + bj) * 4); const f32x4 ps = *pp;
                    const float rstd = 1.0f / sqrtf(((ps[0] + ps[1]) + (ps[2] + ps[3])) * (1.0f / HD) + 1e-6f);
                    const f32x4 xa = acc[ai][bj][m][0] * rstd * wa, xb = acc[ai][bj][m][1] * rstd * wb;
                    const f32x4 oa = xa * cs - xb * sn, ob = xb * cs + xa * sn;
                    u32x4 w; w.x = cvt_pk_bf16(oa[0], oa[1]); w.y = cvt_pk_bf16(oa[2], oa[3]); w.z = cvt_pk_bf16(ob[0], ob[1]); w.w = cvt_pk_bf16(ob[2], ob[3]);
                    *(u32x4*)((bf16_t*)u.C + (long)r * u.ldc + bj * HALF + wc * 32 + 8 * fq) = w; } }
    } };


__device__ __forceinline__ void pack8_fp8(const f32x4& a, const f32x4& b, unsigned& w0, unsigned& w1) {
    f32x4 v0 = a, v1 = b;
#pragma unroll
    for (int c = 0; c < 4; ++c) { v0[c] = fminf(fmaxf(v0[c], -448.f), 448.f); v1[c] = fminf(fmaxf(v1[c], -448.f), 448.f); }
    int x0 = 0, x1 = 0;
    x0 = __builtin_amdgcn_cvt_pk_fp8_f32(v0[0], v0[1], x0, false); x0 = __builtin_amdgcn_cvt_pk_fp8_f32(v0[2], v0[3], x0, true);
    x1 = __builtin_amdgcn_cvt_pk_fp8_f32(v1[0], v1[1], x1, false); x1 = __builtin_amdgcn_cvt_pk_fp8_f32(v1[2], v1[3], x1, true);
    w0 = (unsigned)x0; w1 = (unsigned)x1;
}
__device__ __forceinline__ void store16_s(const void* sbase, unsigned voff, u32x4 v) { asm volatile("global_store_dwordx4 %0, %1, %2\n\ts_nop 1" :: "v"(voff), "v"(v), "s"(sbase) : "memory"); }
struct EpiY8 {
    __device__ __forceinline__ void operator()(f32x4 (&acc)[2][2][4][2], const Unit& u, int wr, int wc, int fr, int fq) const {
        const int odd = fq & 1;
        const unsigned off0 = (unsigned)((wr * 64 + fr) * u.ldc + odd * HALF + wc * 32 + 8 * (fq - odd));
        const int r0 = wr * 64 + fr;
#pragma unroll
        for (int ai = 0; ai < 2; ++ai)
#pragma unroll
            for (int m = 0; m < 4; ++m) {
                unsigned a0, a1, b0, b1; pack8_fp8(acc[ai][0][m][0], acc[ai][0][m][1], a0, a1); pack8_fp8(acc[ai][1][m][0], acc[ai][1][m][1], b0, b1);
                const auto s0 = __builtin_amdgcn_permlane16_swap(a0, b0, false, false), s1 = __builtin_amdgcn_permlane16_swap(a1, b1, false, false);
                if (r0 + ai * HALF + m * 16 < u.rows) { const u32x4 w = {s0[0], s1[0], s0[1], s1[1]}; store16_s(u.C, off0 + (unsigned)((ai * HALF + m * 16) * u.ldc), w); } }
    } };


struct EpiGate {
    __device__ __forceinline__ void operator()(f32x4 (&acc)[2][2][4][2], const Unit& u, int wr, int wc, int fr, int fq) const {
        bf16_t* base = (bf16_t*)u.C + (size_t)(wr * 64 + fr) * u.ldc + wc * 32 + 8 * fq;
#pragma unroll
        for (int ai = 0; ai < 2; ++ai)
#pragma unroll
            for (int m = 0; m < 4; ++m) { bf16_t* p = base + (size_t)(ai * HALF + m * 16) * u.ldc;
#pragma unroll
                for (int bj = 0; bj < 2; ++bj) { f32x4 v0 = acc[ai][bj][m][0], v1 = acc[ai][bj][m][1];
#pragma unroll
                    for (int c = 0; c < 4; ++c) { v0[c] = __builtin_amdgcn_rcpf(1.0f + __expf(-v0[c])); v1[c] = __builtin_amdgcn_rcpf(1.0f + __expf(-v1[c])); }
                    u32x4 w; w.x = cvt_pk_bf16(v0[0], v0[1]); w.y = cvt_pk_bf16(v0[2], v0[3]); w.z = cvt_pk_bf16(v1[0], v1[1]); w.w = cvt_pk_bf16(v1[2], v1[3]);
                    *(u32x4*)(p + bj * HALF) = w; } }
    } };

struct Args { const float* in[22]; float* out; unsigned char* ws; int ph_lo, ph_hi, use_ut, mod_off, do_attn, bar_idx; };
struct Frame {
    LAS unsigned char* lds; volatile LAS unsigned* MISC; unsigned char* ws;
    int tid, lane, wave, vcu, G;
};

__device__ __forceinline__ int qk_col_of_dim(int d) { const int a = d >> 6, half = (d >> 5) & 1, f = d & 31; return 32 * (2 * a + (f >> 4)) + 8 * ((f >> 2) & 3) + 4 * half + (f & 3); }
__device__ __forceinline__ void t64_load(f32x4 (&v)[16], const float* W, int ldw, int lane) {
    const unsigned off = (unsigned)(((lane >> 4) * ldw + (lane & 15) * 4) * 4);
#pragma unroll
    for (int j = 0; j < 16; ++j) { const char* bj = (const char*)W + (size_t)(j * 4) * ldw * 4; v[j] = __builtin_nontemporal_load((const GAS f32x4*)(bj + off)); }
}
template <bool QKPERM = false, bool F8OUT = false>
__device__ __forceinline__ void t64_store(const f32x4 (&v)[16], bf16_t* dst, int ldd, LAS float* scr, int lane, int d0 = 0) {
    const int kk = lane >> 4, nc = (lane & 15) * 4;
#pragma unroll
    for (int j = 0; j < 16; ++j) {
#pragma unroll
        for (int c = 0; c < 4; ++c) scr[(j * 4 + kk) * 65 + nc + c] = v[j][c]; }
    LDS_WAIT(); asm volatile("" ::: "memory");
    const int kc = lane & 7; const unsigned soff = F8OUT ? (unsigned)((lane >> 3) * ldd + 8 * kc) : (unsigned)(((lane >> 3) * ldd + 8 * kc) * 2);
#pragma unroll
    for (int jj = 0; jj < 8; jj += 2) {
        float t[2][8];
#pragma unroll
        for (int q = 0; q < 2; ++q) { const int n = (lane >> 3) + 8 * (jj + q); const LAS float* s = scr + (8 * kc) * 65 + n;
#pragma unroll
            for (int i = 0; i < 8; ++i) t[q][i] = s[i * 65]; }
#pragma unroll
        for (int q = 0; q < 2; ++q) { char* bq = (char*)dst + (size_t)(8 * (jj + q)) * ldd * (F8OUT ? 1 : 2);
            if constexpr (QKPERM) bq = (char*)dst + (size_t)(qk_col_of_dim(d0 + (lane >> 3) + 8 * (jj + q)) - (lane >> 3)) * ldd * 2;
            if constexpr (F8OUT) { float s[8];
#pragma unroll
                for (int i = 0; i < 8; ++i) s[i] = fminf(fmaxf(t[q][i] * 16.0f, -448.f), 448.f);
                int w0 = 0, w1 = 0; w0 = __builtin_amdgcn_cvt_pk_fp8_f32(s[0], s[1], w0, false); w0 = __builtin_amdgcn_cvt_pk_fp8_f32(s[2], s[3], w0, true);
                w1 = __builtin_amdgcn_cvt_pk_fp8_f32(s[4], s[5], w1, false); w1 = __builtin_amdgcn_cvt_pk_fp8_f32(s[6], s[7], w1, true);
                __builtin_nontemporal_store((unsigned long long)(unsigned)w0 | ((unsigned long long)(unsigned)w1 << 32), (GAS unsigned long long*)(bq + soff)); }
            else { u32x4 o; o.x = cvt_pk_bf16(t[q][0], t[q][1]); o.y = cvt_pk_bf16(t[q][2], t[q][3]); o.z = cvt_pk_bf16(t[q][4], t[q][5]); o.w = cvt_pk_bf16(t[q][6], t[q][7]);
                __builtin_nontemporal_store(o, (GAS u32x4*)(bq + soff)); } } }
    LDS_WAIT(); asm volatile("" ::: "memory");
}
__device__ __forceinline__ void transpose64(const float* W, int ldw, bf16_t* dst, int ldd, LAS float* scr, int lane) {
    f32x4 v[16]; t64_load(v, W, ldw, lane); t64_store(v, dst, ldd, scr, lane);
}

constexpr int IT_IN = 32 * 128, IT_FO = 16 * 32, IT_AO = 32 * 32, IT_O = 32 * 32, IT_EG = 64 * 256, IT_EU = 64 * 256, IT_ED = 64 * 256, IT_SH = 256;
constexpr int IT_T_END = IT_IN + IT_FO + IT_AO + IT_O + 3 * IT_SH;
constexpr int IT_MOD = MODC / 32, IT_CST = 4096, IT_BD2 = 512, IT_RWT = 32, IT_ROPE = 1;
constexpr int IT_ALL = IT_T_END + IT_MOD + IT_CST + IT_BD2 + IT_RWT + IT_ROPE;

__device__ __forceinline__ void mod_item(const Args& args, unsigned char* ws, int r, int lane) {
            const int kq = lane >> 3, col = r * 32 + (lane & 7) * 4;
            f32x4 a0 = {0.f, 0.f, 0.f, 0.f}, a1 = a0, a2 = a0;
            for (int jb = 0; jb < 256; jb += 8) {
                f32x4 w[8]; float c0[8], c1[8], c2[8];
#pragma unroll
                for (int j = 0; j < 8; ++j) { const int k = kq + 8 * (jb + j); w[j] = *(const GAS f32x4*)(args.in[4] + (size_t)k * MODC + col); c0[j] = args.in[1][k]; c1[j] = args.in[1][DM + k]; c2[j] = args.in[3][k]; }
#pragma unroll
                for (int j = 0; j < 8; ++j) { a0 += w[j] * (c0[j] * __builtin_amdgcn_rcpf(1.0f + __expf(-c0[j]))); a1 += w[j] * (c1[j] * __builtin_amdgcn_rcpf(1.0f + __expf(-c1[j]))); a2 += w[j] * (c2[j] * __builtin_amdgcn_rcpf(1.0f + __expf(-c2[j]))); }
            }
#pragma unroll
            for (int c = 0; c < 4; ++c) {
#pragma unroll
                for (int o = 8; o < 64; o <<= 1) { a0[c] += __shfl_xor(a0[c], o); a1[c] += __shfl_xor(a1[c], o); a2[c] += __shfl_xor(a2[c], o); } }
            if (kq == 0) { const f32x4 bb = *(const GAS f32x4*)(args.in[5] + col); float* MODP = (float*)(ws + WS_MOD);
                *(GAS f32x4*)(MODP + col) = a0 + bb; *(GAS f32x4*)(MODP + MODC + col) = a1 + bb; *(GAS f32x4*)(MODP + 2 * MODC + col) = a2 + bb; }
}
__device__ __forceinline__ void p0_prologue(Frame& F, const Args& args) {
    LAS float* scr = (LAS float*)(F.lds + F.wave * 16640);
    const int gw = F.vcu * NWAVES + F.wave, NGW = F.G * NWAVES, lane = F.lane;
    unsigned char* ws = F.ws;
    bf16_t* WT_IN = (bf16_t*)(ws + WS_WT_IN); bf16_t* WT_FO = (bf16_t*)(ws + WS_WT_FO); bf16_t* WT_AO = (bf16_t*)(ws + WS_WT_AO); bf16_t* WT_O = (bf16_t*)(ws + WS_WT_O);
    bf16_t* WT_GU = (bf16_t*)(ws + WS_WT_GU); bf16_t* WT_D = (bf16_t*)(ws + WS_WT_D);
    if (NGW >= 5 * IT_MOD) { if (gw % 5 == 0 && gw / 5 < IT_MOD) mod_item(args, ws, gw / 5, lane); }
    else for (int m = gw; m < IT_MOD; m += NGW) mod_item(args, ws, m, lane);
    for (int it = gw; it < IT_ALL - IT_MOD; it += NGW) {
        int r = it;
        if (r < IT_IN) { const int kb = r / 128, nb = r % 128, n0 = nb * 64;
            if (n0 >= Q_OFF && n0 < V_OFF) { f32x4 v[16]; t64_load(v, args.in[7] + (size_t)(kb * 64) * INC + n0, INC, lane);
                t64_store<true>(v, WT_IN + (size_t)(n0 & ~127) * DM + kb * 64, DM, scr, lane, n0 & 127); }
            else if (n0 >= GF_OFF) { f32x4 v[16]; t64_load(v, args.in[7] + (size_t)(kb * 64) * INC + n0, INC, lane);
                t64_store(v, WT_IN + (size_t)n0 * DM + kb * 64, DM, scr, lane);
                t64_store<false, true>(v, (bf16_t*)(ws + WS_WT_G8 + (size_t)(n0 - GF_OFF) * DM + kb * 64), DM, scr, lane); }
            else transpose64(args.in[7] + (size_t)(kb * 64) * INC + n0, INC, WT_IN + (size_t)n0 * DM + kb * 64, DM, scr, lane);
            continue; } r -= IT_IN;
        if (r < IT_FO) { const int kb = r / 32, nb = r % 32; transpose64(args.in[10] + (size_t)(kb * 64) * DM + nb * 64, DM, WT_FO + (size_t)(nb * 64) * YFP + kb * 64, YFP, scr, lane); continue; } r -= IT_FO;
        if (r < IT_AO) { const int kb = r / 32, nb = r % 32; transpose64(args.in[11] + (size_t)(kb * 64) * DM + nb * 64, DM, WT_AO + (size_t)(nb * 64) * DM + kb * 64, DM, scr, lane); continue; } r -= IT_AO;
        if (r < IT_O) { const int kb = r / 32, nb = r % 32; transpose64(args.in[12] + (size_t)(kb * 64) * DM + nb * 64, DM, WT_O + (size_t)(nb * 64) * DM + kb * 64, DM, scr, lane); continue; } r -= IT_O;
        if (r < 2 * IT_SH) { const int up = r >= IT_SH; if (up) r -= IT_SH; const int kb = r / 8, nb = r % 8, n0 = nb * 64;
            { f32x4 v[16]; t64_load(v, (up ? args.in[20] : args.in[19]) + (size_t)(kb * 64) * EFF + n0, EFF, lane);
              t64_store<false, true>(v, (bf16_t*)((unsigned char*)WT_GU + ((size_t)64 * 1024 + (n0 >> 7) * 256 + (up ? 128 : 0) + (n0 & 127)) * DM + kb * 64), DM, scr, lane); } continue; } r -= 2 * IT_SH;
        if (r < IT_SH) { const int kb = r / 32, nb = r % 32;
            { f32x4 v[16]; t64_load(v, args.in[21] + (size_t)(kb * 64) * DM + nb * 64, DM, lane); t64_store<false, true>(v, (bf16_t*)((unsigned char*)WT_D + ((size_t)64 * DM + nb * 64) * EFF + kb * 64), EFF, scr, lane); } continue; } r -= IT_SH;

        if (r < IT_CST) {
            const int k1 = r & 2047; unsigned char* dst = ws + WS_CST + (size_t)r * 2048;
#pragma unroll
            for (int j = 0; j < 4; ++j) { const int n0 = j * 512 + lane * 8; float f[8];
#pragma unroll
                for (int i = 0; i < 8; ++i) { const float ph = (float)((k1 * (n0 + i)) & 4095) * (1.0f / 2048.0f); f[i] = 16.0f * (r < 2048 ? cospif(ph) : sinpif(ph)); }
                int w0 = 0, w1 = 0; w0 = __builtin_amdgcn_cvt_pk_fp8_f32(f[0], f[1], w0, false); w0 = __builtin_amdgcn_cvt_pk_fp8_f32(f[2], f[3], w0, true);
                w1 = __builtin_amdgcn_cvt_pk_fp8_f32(f[4], f[5], w1, false); w1 = __builtin_amdgcn_cvt_pk_fp8_f32(f[6], f[7], w1, true);
                *(GAS unsigned long long*)(dst + n0) = (unsigned long long)(unsigned)w0 | ((unsigned long long)(unsigned)w1 << 32); }
            continue; } r -= IT_CST;
        if (r < IT_BD2) {
            const int t = r >> 8, o = r & 255, gp = o >> 7, k2 = o & 127; bf16_t* dst = (bf16_t*)(ws + WS_BD2) + (size_t)r * 512; float f[8];
#pragma unroll
            for (int i = 0; i < 8; ++i) { const int j = lane * 8 + i, cg = j >> 8, jj = j & 255, c = jj & 127; const float ph = (float)((32 * c * k2) & 4095) * (1.0f / 2048.0f);
                const float v = jj < 128 ? cospif(ph) : (t ? sinpif(ph) : -sinpif(ph)); f[i] = cg == gp ? v * 0.0013810679320049757f : 0.f; }
            u32x4 w; w.x = cvt_pk_bf16(f[0], f[1]); w.y = cvt_pk_bf16(f[2], f[3]); w.z = cvt_pk_bf16(f[4], f[5]); w.w = cvt_pk_bf16(f[6], f[7]);
            *(GAS u32x4*)(dst + lane * 8) = w;
            continue; } r -= IT_BD2;
        if (r >= IT_RWT) {
            float* RT = (float*)(ws + WS_ROPE);
            for (int idx = lane; idx < 64 * 32; idx += 64) { const float ang = (float)(idx >> 5) * exp2f(-(float)(idx & 31) * (13.287712379549449f / 32.0f)); RT[2 * idx] = cosf(ang); RT[2 * idx + 1] = sinf(ang); }
            continue; }
        {
            f32x4 v[16]; t64_load(v, args.in[14] + (size_t)(r * 64) * NE, NE, lane);
            const int kk = lane >> 4, nc = (lane & 15) * 4;
#pragma unroll
            for (int j = 0; j < 16; ++j) {
#pragma unroll
                for (int c = 0; c < 4; ++c) scr[(j * 4 + kk) * 65 + nc + c] = v[j][c]; }
            LDS_WAIT(); asm volatile("" ::: "memory");
            const int kc = lane & 7; bf16_t* RWT = (bf16_t*)(ws + WS_RWT);
#pragma unroll
            for (int jj = 0; jj < 8; ++jj) { const int e = (lane >> 3) + 8 * jj; const LAS float* s = scr + (8 * kc) * 65 + e; float t[8], l[8];
#pragma unroll
                for (int i = 0; i < 8; ++i) { t[i] = s[i * 65]; l[i] = t[i] - bf2f(f2bf(t[i])); }
                u32x4 h, lo; h.x = cvt_pk_bf16(t[0], t[1]); h.y = cvt_pk_bf16(t[2], t[3]); h.z = cvt_pk_bf16(t[4], t[5]); h.w = cvt_pk_bf16(t[6], t[7]);
                lo.x = cvt_pk_bf16(l[0], l[1]); lo.y = cvt_pk_bf16(l[2], l[3]); lo.z = cvt_pk_bf16(l[4], l[5]); lo.w = cvt_pk_bf16(l[6], l[7]);
                *(GAS u32x4*)(RWT + (size_t)e * DM + r * 64 + 8 * kc) = h; *(GAS u32x4*)(RWT + (size_t)(NE + e) * DM + r * 64 + 8 * kc) = lo; }
            LDS_WAIT(); asm volatile("" ::: "memory");
        }
    }
}


__device__ __forceinline__ void conv_addr(const Args& args, unsigned char* ws, bool down, int it, const float*& W, int& ldw, bf16_t*& dst, int& ldd) {
    if (!down) { int r = it; const int up = r >= IT_EG; if (up) r -= IT_EG;
        const int e = r / 256, q = r % 256, kb = q / 8, nb = q % 8, n0 = nb * 64;
        W = (up ? args.in[17] : args.in[16]) + (size_t)e * DM * EFF + (size_t)(kb * 64) * EFF + n0; ldw = EFF;
        dst = (bf16_t*)(ws + WS_WT_GU + ((size_t)e * 1024 + (n0 >> 7) * 256 + (up ? 128 : 0) + (n0 & 127)) * DM + kb * 64); ldd = DM;
    } else { const int r = it, e = r / 256, q = r % 256, kb = q / 32, nb = q % 32;
        W = args.in[18] + (size_t)e * EFF * DM + (size_t)(kb * 64) * DM + nb * 64; ldw = DM;
        dst = (bf16_t*)(ws + WS_WT_D + ((size_t)e * DM + nb * 64) * EFF + kb * 64); ldd = EFF; }
}
__device__ __forceinline__ void conv_items(Frame& F, const Args& args, bool down, int first, int count) {
    LAS float* scr = (LAS float*)(F.lds + F.wave * 16640);
    const int end = first + count; int it = first + F.wave;
    if (it >= end) return;
    f32x4 va[16], vb[16]; const float* W; int ldw; bf16_t* da; bf16_t* db; int ldd;
    conv_addr(args, F.ws, down, it, W, ldw, da, ldd); t64_load(va, W, ldw, F.lane);
    for (;;) {
        const bool hb = it + NWAVES < end;
        if (hb) { conv_addr(args, F.ws, down, it + NWAVES, W, ldw, db, ldd); t64_load(vb, W, ldw, F.lane); }
        t64_store<false, true>(va, da, ldd, scr, F.lane);
        if (!hb) break;
        const bool ha = it + 2 * NWAVES < end;
        if (ha) { conv_addr(args, F.ws, down, it + 2 * NWAVES, W, ldw, da, ldd); t64_load(va, W, ldw, F.lane); }
        t64_store<false, true>(vb, db, ldd, scr, F.lane);
        if (!ha) break;
        it += 2 * NWAVES;
    }
}
struct SchedIn {
    int G, c; unsigned char* ws; int use_ut;
    __device__ __forceinline__ bool next(int i, Unit& u) const {
        const int L = i * G + c; if (L >= 520) return false;
        const char* H = (const char*)(ws + WS_H); const char* WT = (const char*)(ws + WS_WT_IN);
        u.rows = 256; u.aux = 0; u.bjs = HALF; u.pm = 0; u.pn = 0; u.rmin = 0; u.nt = DM / BK; u.keep = 0;
        if (L < 512) {
            int pm, ct; grid_map(L, 32, 16, pm, ct);
            const int row0 = pm * 256, b = row0 / SEQ, t0 = row0 % SEQ;
            u.A = H + (size_t)row0 * DM * 2; u.B = WT + (size_t)ct * 256 * DM * 2;
            if (ct < 4) { u.A = WT + (size_t)ct * 256 * DM * 2; u.B = H + (size_t)row0 * DM * 2;
                          u.C = (char*)(ws + WS_UT) + (((size_t)b * FW + ct * 256) * SEQ + t0) * 2; u.ldc = SEQ; u.mode = 0; }
            else if (ct < 12) { u.C = (char*)(ws + WS_Q) + ((size_t)row0 * DM + (ct - 4) * 256) * 2; u.ldc = DM; u.mode = 5; u.pm = t0; }
            else if (ct < 14) { u.C = (char*)(ws + WS_KALL) + (((size_t)b * SKV + t0) * KVW + (ct - 12) * 256) * 2; u.ldc = KVW; u.mode = 6; u.pm = t0; }
            else { u.C = (char*)(ws + WS_VALL) + (((size_t)b * SKV + t0) * KVW + (ct - 14) * 256) * 2; u.ldc = KVW; u.mode = 0; }
        } else {
            const int l = L - 512, pm = l & 1, ct = l >> 1;
            u.A = H + (size_t)(NTOK + pm * 256) * DM * 2; u.B = WT + (size_t)(K_OFF + ct * 256) * DM * 2;
            if (ct < 2) { u.C = (char*)(ws + WS_KALL) + (((size_t)pm * SKV + SEQ) * KVW + ct * 256) * 2; u.ldc = KVW; u.mode = 7; }
            else        { u.C = (char*)(ws + WS_VALL) + (((size_t)pm * SKV + SEQ) * KVW + (ct - 2) * 256) * 2; u.ldc = KVW; u.mode = 0; }
        }
        return true;
    }
    __device__ __forceinline__ unsigned arow(const Unit&, int) const { return 0u; }
    __device__ __forceinline__ void a_ready(const Unit&) const {}
};
struct SchedGate { int G, c; unsigned char* ws;
    __device__ __forceinline__ bool next(int i, Unit& u) const {
        int g;
        if (G == 256) { if (c < 8 || i >= 2) return false; g = (c - 8) + 248 * i; }
        else { g = i * G + c; if (g >= 496) return false; }
        const int pm = g & 31, gt = g >> 5;
        u.A = (const char*)(ws + WS_H8) + (size_t)pm * 256 * DM; u.B = (const char*)(ws + WS_WT_G8) + (size_t)gt * 256 * DM;
        u.C = (char*)(ws + (gt < 8 ? WS_SGF : WS_SGA)) + ((size_t)pm * 256 * DM + (gt & 7) * 256) * 2; { int md = 2, ld = DM, rw = 256; asm volatile("" : "+s"(md), "+s"(ld), "+s"(rw)); u.ldc = ld; u.mode = md; u.rows = rw; }
        u.aux = 0; u.bjs = HALF; u.pm = pm; u.pn = gt; u.rmin = 0; u.nt = DM / 128; u.keep = 0;
        return true; }
    __device__ __forceinline__ unsigned arow(const Unit&, int) const { return 0u; }
    __device__ __forceinline__ void a_ready(const Unit&) const {} };

__device__ __forceinline__ void unpack8(u32x4 w, float (&f)[8]) {
#pragma unroll
    for (int i = 0; i < 4; ++i) { f[2 * i] = __uint_as_float(w[i] << 16); f[2 * i + 1] = __uint_as_float(w[i] & 0xffff0000u); }
}
struct EpiMerge { const bf16_t* SGF; const bf16_t* SGA; bf16_t* YM;
    __device__ __forceinline__ void operator()(f32x4 (&acc)[2][2][4][2], const Unit& u, int wr, int wc, int fr, int fq) const {
#pragma unroll
        for (int ai = 0; ai < 2; ++ai)
#pragma unroll
            for (int m = 0; m < 4; ++m) { const size_t row = (size_t)u.pm * 256 + ai * HALF + wr * 64 + m * 16 + fr;
#pragma unroll
                for (int bj = 0; bj < 2; ++bj) { const size_t o = row * DM + u.pn * 256 + bj * HALF + wc * 32 + 8 * fq;
                    float ga[8]; unpack8(*(const u32x4*)(SGA + o), ga);
#pragma unroll
                    for (int c = 0; c < 8; ++c) ga[c] = fmaxf(ga[c], 1e-20f);
                    if (u.keep) { float gf[8]; unpack8(*(const u32x4*)(SGF + o), gf);
#pragma unroll
                        for (int c = 0; c < 4; ++c) { acc[ai][bj][m][0][c] *= gf[c] * __builtin_amdgcn_rcpf(ga[c]); acc[ai][bj][m][1][c] *= gf[4 + c] * __builtin_amdgcn_rcpf(ga[4 + c]); }
                    } else { const f32x4 v0 = acc[ai][bj][m][0], v1 = acc[ai][bj][m][1];
                        u32x4 w; w.x = cvt_pk_bf16(ga[0] * v0[0], ga[1] * v0[1]); w.y = cvt_pk_bf16(ga[2] * v0[2], ga[3] * v0[3]); w.z = cvt_pk_bf16(ga[4] * v1[0], ga[5] * v1[1]); w.w = cvt_pk_bf16(ga[6] * v1[2], ga[7] * v1[3]);
                        *(u32x4*)(YM + o) = w; } } }
    } };
struct SchedMerge { int G, c; unsigned char* ws;
    __device__ __forceinline__ bool next(int i, Unit& u) const {
        const int L = (i >> 1) * G + c; if (L >= 256) return false;
        int pm, pn; grid_map(L, 32, 8, pm, pn); const int kb = i & 1;
        u.A = (const char*)(ws + (kb ? WS_YA : WS_YF)) + (size_t)pm * 256 * DM * 2; u.B = (const char*)(ws + (kb ? WS_WT_AO : WS_WT_FO)) + (size_t)pn * 256 * DM * 2;
        u.C = nullptr; u.ldc = DM; u.mode = 0; u.rows = 256; u.aux = 0; u.pm = pm; u.pn = pn; u.bjs = HALF; u.rmin = 0; u.nt = kb ? DM / BK : FW / BK; u.keep = kb ? 0 : 1;
        return true; }
    __device__ __forceinline__ unsigned arow(const Unit&, int) const { return 0u; } };
struct EpiX2 { const float* x; const float* mod; float* X2;
    __device__ __forceinline__ void operator()(f32x4 (&acc)[2][2][4][2], const Unit& u, int wr, int wc, int fr, int fq) const {
        const float* g1 = mod + ((u.pm * 256) / SEQ) * MODC + 2 * DM;
#pragma unroll
        for (int ai = 0; ai < 2; ++ai)
#pragma unroll
            for (int m = 0; m < 4; ++m) { const size_t row = (size_t)u.pm * 256 + ai * HALF + wr * 64 + m * 16 + fr;
#pragma unroll
                for (int bj = 0; bj < 2; ++bj) { const int col = u.pn * 256 + bj * HALF + wc * 32 + 8 * fq; const size_t o = row * DM + col;
#pragma unroll
                    for (int n = 0; n < 2; ++n) { const f32x4 xv = *(const f32x4*)(x + o + 4 * n), gv = *(const f32x4*)(g1 + col + 4 * n); *(f32x4*)(X2 + o + 4 * n) = xv + gv * acc[ai][bj][m][n]; } } }
    } };
__device__ __forceinline__ void act8(const f32x4 (&g)[2], const f32x4 (&up)[2], unsigned& w0, unsigned& w1) {
    f32x4 a[2];
#pragma unroll
    for (int n = 0; n < 2; ++n)
#pragma unroll
        for (int c = 0; c < 4; ++c) { const float x = g[n][c]; a[n][c] = fminf(fmaxf(x * __builtin_amdgcn_rcpf(1.0f + __expf(-x)) * up[n][c], -448.f), 448.f); }
    int x0 = 0, x1 = 0;
    x0 = __builtin_amdgcn_cvt_pk_fp8_f32(a[0][0], a[0][1], x0, false); x0 = __builtin_amdgcn_cvt_pk_fp8_f32(a[0][2], a[0][3], x0, true);
    x1 = __builtin_amdgcn_cvt_pk_fp8_f32(a[1][0], a[1][1], x1, false); x1 = __builtin_amdgcn_cvt_pk_fp8_f32(a[1][2], a[1][3], x1, true);
    w0 = (unsigned)x0; w1 = (unsigned)x1;
}
struct EpiAct {
    __device__ __forceinline__ void operator()(f32x4 (&acc)[2][2][4][2], const Unit& u, int wr, int wc, int fr, int fq) const {
        const int odd = fq & 1;
        unsigned char* base = (unsigned char*)u.C + (size_t)(wr * 64 + odd * 16 + fr) * u.ldc + wc * 32 + 8 * (fq - odd);
        const int r0 = wr * 64 + odd * 16 + fr;
#pragma unroll
        for (int ai = 0; ai < 2; ++ai)
#pragma unroll
            for (int m = 0; m < 4; m += 2) {
                unsigned a0, a1, b0, b1; act8(acc[ai][0][m], acc[ai][1][m], a0, a1); act8(acc[ai][0][m + 1], acc[ai][1][m + 1], b0, b1);
                const auto s0 = __builtin_amdgcn_permlane16_swap(a0, b0, false, false), s1 = __builtin_amdgcn_permlane16_swap(a1, b1, false, false);
                if (r0 + ai * HALF + m * 16 < u.rows) { const u32x4 w = {s0[0], s1[0], s0[1], s1[1]}; *(u32x4*)(base + (size_t)(ai * HALF + m * 16) * u.ldc) = w; } }
    } };

struct SchedGrid {
    int G, c, nM, nN; const char* A; const char* B; char* C; size_t astride, bstride; int ldc, esz, mode, nt;
    __device__ __forceinline__ bool next(int i, Unit& u) const {
        const int L = i * G + c; if (L >= nM * nN) return false;
        int pm, pn; grid_map(L, nM, nN, pm, pn);
        u.A = A + (size_t)pm * astride; u.B = B + (size_t)pn * bstride; u.C = C + ((size_t)pm * 256 * ldc + pn * 256) * esz; u.ldc = ldc; u.mode = mode; u.rows = 256; u.aux = 0; u.pm = pm; u.pn = pn; u.bjs = HALF; u.rmin = 0; u.nt = nt; u.keep = 0;
        return true; }
    __device__ __forceinline__ unsigned arow(const Unit&, int) const { return 0u; } };
struct SchedAG { int G, c; unsigned char* ws;
    __device__ __forceinline__ bool next(int i, Unit& u) const {
        const int L = i * G + c; if (L >= 144) return false;
        u.rows = 256; u.aux = 0; u.rmin = 0; u.nt = DM / 128; u.keep = 0;
        if (L < 128) {
            int pm, pn8; grid_map(L, 16, 8, pm, pn8); const int b = pn8 >> 2, pn = pn8 & 3, sn = pm >> 3, k1t = pm & 7;
            u.A = (const char*)(ws + WS_CST) + (size_t)pm * 256 * 2048; u.B = (const char*)(ws + (sn ? WS_OT : WS_ET)) + ((size_t)b * FW + pn * 256) * 2048;
            u.C = (char*)(ws + WS_TT) + (((size_t)b * 2048 + k1t * 256) * DM + pn * 512 + sn * 128) * 2; u.ldc = DM; u.mode = sn ? 0 : 3; u.pm = k1t; u.pn = b * FW + pn * 256; u.bjs = 256;
        } else {
            const int g = 496 + (L - 128), pm = g & 31, ct = 16 + (g >> 5);
            u.A = (const char*)(ws + WS_H8) + (size_t)pm * 256 * DM; u.B = (const char*)(ws + WS_WT_G8) + (size_t)(ct - 16) * 256 * DM;
            u.C = (char*)(ws + WS_SGA) + ((size_t)pm * 256 * DM + (ct - 24) * 256) * 2; u.ldc = DM; u.mode = 2; u.pm = pm; u.pn = ct; u.bjs = HALF;
        }
        return true; }
    __device__ __forceinline__ unsigned arow(const Unit&, int) const { return 0u; } };
struct SchedF2 { int G, c; unsigned char* ws;
    __device__ __forceinline__ bool next(int i, Unit& u) const {
        const int L = i * G + c; if (L >= 128) return false;
        int pm, q; grid_map(L, 16, 8, pm, q); const int b = pm >> 3, k1t = pm & 7, j = q & 3, mir = q >> 2;
        u.A = (const char*)(ws + WS_TT) + (((size_t)b * 2048 + k1t * 256) * DM + j * 512) * 2; u.B = (const char*)(ws + WS_BD2) + (size_t)mir * 256 * 512 * 2;
        u.mode = 0; u.rows = 256; u.aux = 0; u.pm = pm; u.pn = j; u.bjs = HALF; u.nt = 512 / BK; u.keep = 0;
        if (!mir) { u.C = (char*)(ws + WS_YF) + (((size_t)b * SEQ + k1t * 256) * YFP + j * 256) * 2; u.ldc = YFP; u.rmin = 0; }
        else { u.C = (char*)(ws + WS_YF) + (((size_t)b * SEQ + SEQ - k1t * 256) * YFP + j * 256) * 2; u.ldc = -YFP; u.rmin = k1t == 0 ? 1 : 0; }
        return true; }
    __device__ __forceinline__ unsigned arow(const Unit&, int) const { return 0u; } };
constexpr int SCHT_OFF = LDSCTL_OFF + 1024;
__device__ __forceinline__ void moe_tables(Frame& F, int ncol_tiles) {
    LAS int* T = (LAS int*)(F.lds + SCHT_OFF);
    __syncthreads();
    if (F.tid == 0) { const int* CNT = (const int*)(F.ws + CTL_CNT); int up = 0, of = 0;
        for (int e = 0; e <= NE; ++e) { const int cn = e < NE ? CNT[e * 64] : NTOK; T[e] = up; T[80 + e] = e < NE ? of : NSLOT; T[160 + e] = cn; up += ((cn + 255) >> 8) * ncol_tiles; of += cn; }
        T[NE + 1] = up; }
    __syncthreads();
}
template <int NCT, bool FIRST> struct SchedMoe {
    int G, c; unsigned char* ws; LAS int* T; const int* TOK;
    __device__ __forceinline__ int tl(int i) const { return __builtin_amdgcn_readfirstlane(T[i]); }
    __device__ __forceinline__ bool next(int i, Unit& u) const {
        const int L = i * G + c; if (L >= tl(NE + 1)) return false;
        int lo = 0, hi = NE;
#pragma unroll 1
        while (lo < hi) { const int mid = (lo + hi + 1) >> 1; if (tl(mid) <= L) lo = mid; else hi = mid - 1; }
        const int e = lo, cn = tl(160 + e), ntile = (cn + 255) >> 8, local = L - tl(e), ct = local / ntile, mt = local % ntile, slot0 = tl(80 + e) + mt * 256;
        u.rows = (cn - mt * 256) < 256 ? (cn - mt * 256) : 256; u.aux = slot0; u.pm = mt; u.pn = ct; u.bjs = HALF; u.mode = 0; u.rmin = 0; u.e = e; u.nt = (FIRST ? DM : EFF) / 128; u.keep = 0;
        if (FIRST) { u.A = (const char*)(ws + WS_H2); u.B = (const char*)(ws + WS_WT_GU) + ((size_t)e * 4 + ct) * 256 * DM; u.C = (char*)(ws + WS_ACT) + ((size_t)slot0 * EFF + ct * 128); u.ldc = EFF; }
        else { u.A = (const char*)(ws + WS_ACT) + (size_t)slot0 * EFF; u.B = (const char*)(ws + WS_WT_D) + ((size_t)e * DM + ct * 256) * EFF; u.C = (char*)(ws + WS_YBIG) + ((size_t)slot0 * DM + ct * 256); u.ldc = DM; u.mode = 8; }
        return true; }
    __device__ __forceinline__ unsigned arow(const Unit& u, int r) const { const int rr = u.pm * 256 + (r < u.rows ? r : u.rows - 1); const int tok = u.e < NE ? TOK[u.e * NTOK + rr] : rr; return (unsigned)tok * (unsigned)DM; } };

namespace attn {
using s16x4 = __attribute__((ext_vector_type(4))) short;
using f32x8 = __attribute__((ext_vector_type(8))) float;
constexpr int D = 128, NW = 8, QBLK = 32, KVBLK = 64;
constexpr float SCALE = 0.088388347648318440f;
constexpr float THR = 8.f;
constexpr int LDQ = DM, LDK = KVW, LDO = DM;
constexpr size_t SHM_V = KVBLK * D * 2, SHM_K = KVBLK * D * 2, SHM_ATTN = 2 * SHM_V + 2 * SHM_K + NW * 64 * 4;
#define KSWZ(row, colB) ((row) * 256 + ((colB) ^ (((row) & 7) << 4)))
#define SBAR() __builtin_amdgcn_sched_barrier(0)
__device__ __forceinline__ unsigned cvtpk(float lo, float hi) { unsigned r; asm volatile("v_cvt_pk_bf16_f32 %0, %1, %2" : "=v"(r) : "v"(lo), "v"(hi)); return r; }
__device__ __forceinline__ void partialSM(f32x16& p0, f32x16& p1, float& m_reg, float& mn, float& alpha) {
  constexpr float C = SCALE * 1.4426950408889634f;
  float pmax = p0[0]; for (int r = 1; r < 16; ++r) pmax = fmaxf(pmax, p0[r]); for (int r = 0; r < 16; ++r) pmax = fmaxf(pmax, p1[r]);
  { auto rr = __builtin_amdgcn_permlane32_swap(__float_as_uint(pmax), __float_as_uint(pmax), false, false);
    pmax = fmaxf(__uint_as_float(rr[0]), __uint_as_float(rr[1])); }
  if (__builtin_expect(__all(pmax - m_reg <= THR / SCALE), 1)) { mn = m_reg; alpha = 1.f; }
  else { mn = fmaxf(m_reg, pmax); alpha = __builtin_amdgcn_exp2f((m_reg - mn) * C); m_reg = mn; }
  float mnC = -mn * C;
  for (int r = 0; r < 16; ++r) p0[r] = fmaf(p0[r], C, mnC); for (int r = 0; r < 16; ++r) p1[r] = fmaf(p1[r], C, mnC);
  for (int r = 0; r < 16; ++r) p0[r] = __builtin_amdgcn_exp2f(p0[r]);
}
__device__ __forceinline__ void finishSM(f32x16& p0, f32x16& p1, float alpha, float& l_reg, bf16x8& pa0, bf16x8& pa1, bf16x8& pa2, bf16x8& pa3) {
  for (int r = 0; r < 16; ++r) p1[r] = __builtin_amdgcn_exp2f(p1[r]);
  float ps = 0; for (int r = 0; r < 16; ++r) ps += p0[r]; for (int r = 0; r < 16; ++r) ps += p1[r];
  { auto rr = __builtin_amdgcn_permlane32_swap(__float_as_uint(ps), __float_as_uint(ps), false, false);
    ps = __uint_as_float(rr[0]) + __uint_as_float(rr[1]); }
  l_reg = l_reg * alpha + ps;
#define PK4(P, BASE, OUT) do { unsigned a0 = cvtpk(P[BASE + 0], P[BASE + 1]), a1 = cvtpk(P[BASE + 2], P[BASE + 3]);   \
    unsigned b0 = cvtpk(P[BASE + 4], P[BASE + 5]), b1 = cvtpk(P[BASE + 6], P[BASE + 7]);                              \
    auto r0 = __builtin_amdgcn_permlane32_swap(a0, b0, false, false); auto r1 = __builtin_amdgcn_permlane32_swap(a1, b1, false, false); \
    u32x4 w = {r0[0], r1[0], r0[1], r1[1]}; OUT = *reinterpret_cast<bf16x8*>(&w); } while (0)
  PK4(p0, 0, pa0); PK4(p0, 8, pa1); PK4(p1, 0, pa2); PK4(p1, 8, pa3);
#undef PK4
}
__device__ __forceinline__ void qkt(f32x16& p0, f32x16& p1, const bf16_t* Ks, const bf16x8* qr, int r32, int hi) {
  p0 = f32x16{}; p1 = f32x16{};
  for (int d0 = 0; d0 < 8; ++d0) { int cb = (d0 * 16 + hi * 8) * 2;
    bf16x8 b0 = *reinterpret_cast<const bf16x8*>((const char*)Ks + KSWZ(r32, cb));
    bf16x8 b1 = *reinterpret_cast<const bf16x8*>((const char*)Ks + KSWZ(32 + r32, cb));
    p0 = __builtin_amdgcn_mfma_f32_32x32x16_bf16(b0, qr[d0], p0, 0, 0, 0);
    p1 = __builtin_amdgcn_mfma_f32_32x32x16_bf16(b1, qr[d0], p1, 0, 0, 0); }
}
__device__ __forceinline__ int v_st(int k, int c) { const int kk = (k & ~0xC) | ((k & 4) << 1) | ((k & 8) >> 1); return ((kk >> 3) * 4 + (c >> 5)) * 512 + ((kk & 7) * 32 + (c & 31)) * 2; }
__device__ __forceinline__ int v_rd_base(int lane) { return ((lane & 3) << 3) | (((lane >> 2) & 3) << 6) | (((lane >> 4) & 1) << 5) | (((lane >> 5) & 1) << 8); }
constexpr int v_rd_off(int d0, int ks, int half) { return d0 * 512 + ks * 4096 + half * 2048; }
template <int OFF> __device__ __forceinline__ s16x4 tr_read(int vb) {
  s16x4 r; asm volatile("ds_read_b64_tr_b16 %0, %1 offset:%2" : "=&v"(r) : "v"(vb), "i"(OFF) : "memory"); return r;
}
template <int D0> __device__ __forceinline__ void pv_one(f32x16& od, int vb, bf16x8 pa0, bf16x8 pa1, bf16x8 pa2, bf16x8 pa3) {
  const s16x4 l0 = tr_read<v_rd_off(D0, 0, 0)>(vb), h0 = tr_read<v_rd_off(D0, 0, 1)>(vb), l1 = tr_read<v_rd_off(D0, 1, 0)>(vb), h1 = tr_read<v_rd_off(D0, 1, 1)>(vb);
  const s16x4 l2 = tr_read<v_rd_off(D0, 2, 0)>(vb), h2 = tr_read<v_rd_off(D0, 2, 1)>(vb), l3 = tr_read<v_rd_off(D0, 3, 0)>(vb), h3 = tr_read<v_rd_off(D0, 3, 1)>(vb);
  asm volatile("s_waitcnt lgkmcnt(0)" ::: "memory"); SBAR();
#define PK(L, H) (bf16x8){L[0], L[1], L[2], L[3], H[0], H[1], H[2], H[3]}
  od = __builtin_amdgcn_mfma_f32_32x32x16_bf16(pa0, PK(l0, h0), od, 0, 0, 0);
  od = __builtin_amdgcn_mfma_f32_32x32x16_bf16(pa1, PK(l1, h1), od, 0, 0, 0);
  od = __builtin_amdgcn_mfma_f32_32x32x16_bf16(pa2, PK(l2, h2), od, 0, 0, 0);
  od = __builtin_amdgcn_mfma_f32_32x32x16_bf16(pa3, PK(l3, h3), od, 0, 0, 0);
#undef PK
}
__device__ __forceinline__ void pv_d0(f32x16* o, int vb, bf16x8 pa0, bf16x8 pa1, bf16x8 pa2, bf16x8 pa3) {
  pv_one<0>(o[0], vb, pa0, pa1, pa2, pa3); pv_one<1>(o[1], vb, pa0, pa1, pa2, pa3); pv_one<2>(o[2], vb, pa0, pa1, pa2, pa3); pv_one<3>(o[3], vb, pa0, pa1, pa2, pa3);
}
__device__ __forceinline__ void attn_dense_body(const bf16_t* __restrict__ Qb, const bf16_t* __restrict__ Kh, const bf16_t* __restrict__ Vh, bf16_t* __restrict__ Ob, int seq, char* lds) {
  const int tid = threadIdx.x, wid = tid >> 6, lane = tid & 63, r32 = lane & 31, hi = lane >> 5;
  bf16_t* V_lds = (bf16_t*)lds; bf16_t* K_lds = (bf16_t*)(lds + 2 * SHM_V);
  float* ws = (float*)(lds + 2 * SHM_V + 2 * SHM_K) + wid * 64; float* li_l = ws; float* al_l = ws + 32;
  float m_reg = -1e30f, l_reg = 0; f32x16 o[4] = {}; bf16x8 qr[8];
  const bf16_t* Qw = Qb + (long)(wid * QBLK + r32) * LDQ + hi * 8;
#pragma unroll
  for (int d0 = 0; d0 < 8; ++d0) qr[d0] = *reinterpret_cast<const bf16x8*>(Qw + d0 * 16);
  const int sr = tid >> 4, sc = (tid & 15) * 8, vst0 = v_st(sr, sc), vst1 = v_st(32 + sr, sc);
  const int vb0 = (int)(uintptr_t)V_lds + v_rd_base(lane);
  struct { bf16x8 vs0, vs1, ks0, ks1; } sr_[2];
#define SLOAD(i, k0) do { sr_[i].vs0 = *reinterpret_cast<const bf16x8*>(&Vh[(long)((k0) + sr) * LDK + sc]); sr_[i].vs1 = *reinterpret_cast<const bf16x8*>(&Vh[(long)((k0) + 32 + sr) * LDK + sc]); \
    sr_[i].ks0 = *reinterpret_cast<const bf16x8*>(&Kh[(long)((k0) + sr) * LDK + sc]); sr_[i].ks1 = *reinterpret_cast<const bf16x8*>(&Kh[(long)((k0) + 32 + sr) * LDK + sc]); } while (0)
#define SWRITE(b, i) do { *(bf16x8*)((char*)V_lds + (b) * SHM_V + vst0) = sr_[i].vs0;          \
    *(bf16x8*)((char*)V_lds + (b) * SHM_V + vst1) = sr_[i].vs1; int kc = sc * 2;               \
    *(bf16x8*)((char*)K_lds + (b) * SHM_K + KSWZ(sr, kc)) = sr_[i].ks0;                       \
    *(bf16x8*)((char*)K_lds + (b) * SHM_K + KSWZ(32 + sr, kc)) = sr_[i].ks1; } while (0)
#define SWAIT() asm volatile("s_waitcnt vmcnt(4)" ::: "memory")
#define RESC(a) do { if (__any((a) < 1.f)) { if (hi == 0) al_l[r32] = (a); asm volatile("s_waitcnt lgkmcnt(0)" ::: "memory"); \
    for (int d = 0; d < 4; ++d) for (int r = 0; r < 16; ++r) o[d][r] *= al_l[crow(r, hi)]; } } while (0)
  f32x16 pA0, pA1, pB0, pB1; float mnA, mnB, alA, alB; bf16x8 pa0, pa1, pa2, pa3; const int NT = seq / KVBLK;
  constexpr int SE = 0, SO = 1;
  SLOAD(SE, 0); asm volatile("s_waitcnt vmcnt(0)" ::: "memory"); SWRITE(0, SE); __syncthreads();
  qkt(pA0, pA1, K_lds, qr, r32, hi); partialSM(pA0, pA1, m_reg, mnA, alA);
  SLOAD(SO, KVBLK); if (2 < NT) SLOAD(SE, 2 * KVBLK);
  SWAIT(); SWRITE(1, SO); __syncthreads();
  for (int j = 1; j + 1 < NT; j += 2) {
    SBAR(); qkt(pB0, pB1, (bf16_t*)((char*)K_lds + SHM_K), qr, r32, hi);
    finishSM(pA0, pA1, alA, l_reg, pa0, pa1, pa2, pa3); SBAR();
    SLOAD(SO, (j + 2) * KVBLK); SBAR();
    pv_d0(o, vb0, pa0, pa1, pa2, pa3); partialSM(pB0, pB1, m_reg, mnB, alB);
    __syncthreads(); SWAIT(); SWRITE(0, SE);
    RESC(alB); __syncthreads();
    SBAR(); qkt(pA0, pA1, K_lds, qr, r32, hi);
    finishSM(pB0, pB1, alB, l_reg, pa0, pa1, pa2, pa3); SBAR();
    if (j + 3 < NT) SLOAD(SE, (j + 3) * KVBLK); SBAR();
    pv_d0(o, vb0 + (int)SHM_V, pa0, pa1, pa2, pa3); partialSM(pA0, pA1, m_reg, mnA, alA);
    __syncthreads(); SWAIT(); SWRITE(1, SO);
    RESC(alA); __syncthreads();
  }
  SBAR(); qkt(pB0, pB1, (bf16_t*)((char*)K_lds + SHM_K), qr, r32, hi);
  finishSM(pA0, pA1, alA, l_reg, pa0, pa1, pa2, pa3); SBAR();
  pv_d0(o, vb0, pa0, pa1, pa2, pa3); partialSM(pB0, pB1, m_reg, mnB, alB);
  __syncthreads(); RESC(alB);
  finishSM(pB0, pB1, alB, l_reg, pa0, pa1, pa2, pa3); SBAR();
  pv_d0(o, vb0 + (int)SHM_V, pa0, pa1, pa2, pa3);
  if (hi == 0) li_l[r32] = l_reg; asm volatile("s_waitcnt lgkmcnt(0)" ::: "memory");
  float rli[16];
#pragma unroll
  for (int r = 0; r < 16; ++r) rli[r] = __builtin_amdgcn_rcpf(li_l[crow(r, hi)]);
  typedef __attribute__((address_space(3))) unsigned char lds8_t;
  lds8_t* ost = (lds8_t*)(lds + SHM_ATTN + wid * 8192);
  lds8_t* wbase = ost + hi * 1024 + r32 * 2;
#pragma unroll
  for (int d0 = 0; d0 < 4; ++d0)
#pragma unroll
    for (int r = 0; r < 16; r += 2) { const unsigned w = cvtpk(o[d0][r] * rli[r], o[d0][r + 1] * rli[r + 1]);
      *(__attribute__((address_space(3))) unsigned short*)(wbase + (((r & 3) + 8 * (r >> 2)) * 256 + d0 * 64)) = (unsigned short)w;
      *(__attribute__((address_space(3))) unsigned short*)(wbase + ((((r + 1) & 3) + 8 * ((r + 1) >> 2)) * 256 + d0 * 64)) = (unsigned short)(w >> 16); }
  asm volatile("s_waitcnt lgkmcnt(0)" ::: "memory");
  bf16_t* Ow = Ob + (long)(wid * QBLK) * LDO;
  { const lds8_t* rbase = ost + (lane >> 4) * 256 + (lane & 15) * 16; bf16_t* gbase = Ow + (long)(lane >> 4) * LDO + (lane & 15) * 8;
#pragma unroll
    for (int j = 0; j < 8; ++j) { const u32x4 v = *(const __attribute__((address_space(3))) u32x4*)(rbase + j * 1024); *(u32x4*)(gbase + (long)(j * 4) * LDO) = v; } }
  asm volatile("s_waitcnt lgkmcnt(0)" ::: "memory");
#undef SLOAD
#undef SWRITE
#undef SWAIT
#undef RESC
}
#undef KSWZ
#undef SBAR
}

__device__ __forceinline__ void ph_norm1(Frame& F, const Args& args, const float* mod) {
    const int gw = F.vcu * NWAVES + F.wave, NGW = F.G * NWAVES, lane = F.lane;
    bf16_t* H = (bf16_t*)(F.ws + WS_H); const float* nw = args.in[6];
    for (int row = gw; row < NTOK + NCTX; row += NGW) {
        const float* src = row < NTOK ? args.in[0] + (size_t)row * DM : args.in[2] + (size_t)(row - NTOK) * DM;
        const float* mr = mod + (row < NTOK ? row / SEQ : 2) * MODC;
        f32x4 v[8]; float ss = 0.f;
#pragma unroll
        for (int j = 0; j < 8; ++j) { v[j] = *(const GAS f32x4*)(src + (j * 64 + lane) * 4); ss += v[j].x * v[j].x + v[j].y * v[j].y + v[j].z * v[j].z + v[j].w * v[j].w; }
        ss = wave_sum(ss);
        const float rstd = 1.0f / sqrtf(ss * (1.0f / DM) + 1e-6f);
#pragma unroll
        for (int j = 0; j < 8; ++j) { const int i = (j * 64 + lane) * 4;
            const f32x4 w = *(const GAS f32x4*)(nw + i), sc = *(const GAS f32x4*)(mr + DM + i), sh = *(const GAS f32x4*)(mr + i);
            const f32x4 h = v[j] * rstd * w * (sc + 1.0f) + sh;
            unsigned lo = cvt_pk_bf16(h[0], h[1]), hi = cvt_pk_bf16(h[2], h[3]);
            *(GAS unsigned long long*)(H + (size_t)row * DM + i) = (unsigned long long)lo | ((unsigned long long)hi << 32);
            if (row < NTOK) { int w8 = 0; w8 = __builtin_amdgcn_cvt_pk_fp8_f32(fminf(fmaxf(h[0], -448.f), 448.f), fminf(fmaxf(h[1], -448.f), 448.f), w8, false);
                w8 = __builtin_amdgcn_cvt_pk_fp8_f32(fminf(fmaxf(h[2], -448.f), 448.f), fminf(fmaxf(h[3], -448.f), 448.f), w8, true);
                *(GAS unsigned*)(F.ws + WS_H8 + (size_t)row * DM + i) = (unsigned)w8; } }
    }
}
__device__ __forceinline__ void ph_evenodd(Frame& F, const Args& args) {
    const int gw = F.vcu * NWAVES + F.wave, NGW = F.G * NWAVES, lane = F.lane;
    LAS bf16_t* scr = (LAS bf16_t*)(F.lds + F.wave * 16640);
    const bf16_t* UT = (const bf16_t*)(F.ws + WS_UT); unsigned char* ET = F.ws + WS_ET; unsigned char* OT = F.ws + WS_OT;
    float* W2 = (float*)(F.ws + WS_W2048); float* AL = (float*)(F.ws + WS_ALT);
    for (int row = gw; row < 2 * FW; row += NGW) {
        const bf16_t* src = UT + (size_t)row * SEQ; float alt = 0.f;
#pragma unroll
        for (int j = 0; j < 8; ++j) { const u32x4 w = *(const GAS u32x4*)(src + (j * 64 + lane) * 8); *(LAS u32x4*)(scr + (j * 64 + lane) * 8) = w;
            float f[8]; unpack8(w, f); alt += (f[0] - f[1]) + (f[2] - f[3]) + (f[4] - f[5]) + (f[6] - f[7]); }
        alt = wave_sum(alt);
        LDS_WAIT(); asm volatile("" ::: "memory");
        if (lane == 0) { AL[row] = alt; W2[row] = bf2f(scr[SEQ / 2]); }
#pragma unroll
        for (int j = 0; j < 4; ++j) { const int n0 = (j * 64 + lane) * 8; float e[8], o[8];
#pragma unroll
            for (int i = 0; i < 8; ++i) { const int n = n0 + i; const float a = bf2f(scr[n]), bb = bf2f(scr[(SEQ - n) & (SEQ - 1)]); e[i] = n == 0 ? a : a + bb; o[i] = n == 0 ? 0.f : a - bb; }
#pragma unroll
            for (int i = 0; i < 8; ++i) { e[i] = fminf(fmaxf(e[i], -448.f), 448.f); o[i] = fminf(fmaxf(o[i], -448.f), 448.f); }
            int e0 = 0, e1 = 0, o0 = 0, o1 = 0;
            e0 = __builtin_amdgcn_cvt_pk_fp8_f32(e[0], e[1], e0, false); e0 = __builtin_amdgcn_cvt_pk_fp8_f32(e[2], e[3], e0, true); e1 = __builtin_amdgcn_cvt_pk_fp8_f32(e[4], e[5], e1, false); e1 = __builtin_amdgcn_cvt_pk_fp8_f32(e[6], e[7], e1, true);
            o0 = __builtin_amdgcn_cvt_pk_fp8_f32(o[0], o[1], o0, false); o0 = __builtin_amdgcn_cvt_pk_fp8_f32(o[2], o[3], o0, true); o1 = __builtin_amdgcn_cvt_pk_fp8_f32(o[4], o[5], o1, false); o1 = __builtin_amdgcn_cvt_pk_fp8_f32(o[6], o[7], o1, true);
            *(GAS unsigned long long*)(ET + (size_t)row * 2048 + n0) = (unsigned long long)(unsigned)e0 | ((unsigned long long)(unsigned)e1 << 32);
            *(GAS unsigned long long*)(OT + (size_t)row * 2048 + n0) = (unsigned long long)(unsigned)o0 | ((unsigned long long)(unsigned)o1 << 32); }
        LDS_WAIT(); asm volatile("" ::: "memory");
    }
}
__device__ __forceinline__ void ph_route(Frame& F, const Args& args, const float* mod) {
    const int lane = F.lane, wv = F.wave, r32 = lane & 31, hi = lane >> 5;
    LAS float* rs = (LAS float*)F.lds;
    LAS float* part = (LAS float*)(F.lds + 1024);
    LAS int* lcnt = (LAS int*)(F.lds + 1024 + 65536);
    LAS int* lbase = lcnt + 64;
    LAS int* lent = lcnt + 128;
    const float* X2 = (const float*)(F.ws + WS_X2); const float* nw = args.in[13]; const float* rb = args.in[15];
    const bf16_t* RWT = (const bf16_t*)(F.ws + WS_RWT);
    bf16_t* H2 = (bf16_t*)(F.ws + WS_H2); int* EIDX = (int*)(F.ws + WS_EIDX); float* EW = (float*)(F.ws + WS_EW); int* EPOS = (int*)(F.ws + WS_EPOS); int* CNT = (int*)(F.ws + CTL_CNT); int* TOKE = (int*)(F.ws + WS_TOKE);
    if (F.tid < NE) lcnt[F.tid] = 0;
    __syncthreads();
    int nb = 0;
    for (int blk = F.vcu; blk < NTOK / 32; blk += F.G, ++nb) {
        const int row0 = blk * 32; const float* mr = mod + (row0 / SEQ) * MODC;
#pragma unroll
        for (int i = 0; i < 4; ++i) { const float* src = X2 + (size_t)(row0 + wv * 4 + i) * DM; float ss = 0.f;
#pragma unroll
            for (int j = 0; j < 8; ++j) { const f32x4 v = *(const GAS f32x4*)(src + (j * 64 + lane) * 4); ss += v.x * v.x + v.y * v.y + v.z * v.z + v.w * v.w; }
            ss = wave_sum(ss);
            if (lane == 0) rs[wv * 4 + i] = 1.0f / sqrtf(ss * (1.0f / DM) + 1e-6f); }
        __syncthreads();
        { const float rstd = rs[r32]; const float* xr = X2 + (size_t)(row0 + r32) * DM; unsigned char* hr = (unsigned char*)H2 + (size_t)(row0 + r32) * DM;
          f32x16 acc0 = {}, acc1 = {};
#pragma unroll 4
          for (int ks = 0; ks < 16; ++ks) { const int k = wv * 256 + ks * 16 + hi * 8;
              float h[8];
#pragma unroll
              for (int q = 0; q < 2; ++q) { const f32x4 x = *(const GAS f32x4*)(xr + k + 4 * q), w = *(const GAS f32x4*)(nw + k + 4 * q), sc = *(const GAS f32x4*)(mr + 4 * DM + k + 4 * q), sh = *(const GAS f32x4*)(mr + 3 * DM + k + 4 * q);
                  const f32x4 t = x * rstd * w * (sc + 1.0f) + sh; h[4 * q] = t[0]; h[4 * q + 1] = t[1]; h[4 * q + 2] = t[2]; h[4 * q + 3] = t[3]; }
              u32x4 wh, wl; float l[8];
              wh.x = cvt_pk_bf16(h[0], h[1]); wh.y = cvt_pk_bf16(h[2], h[3]); wh.z = cvt_pk_bf16(h[4], h[5]); wh.w = cvt_pk_bf16(h[6], h[7]);
#pragma unroll
              for (int i = 0; i < 4; ++i) { l[2 * i] = h[2 * i] - __uint_as_float(wh[i] << 16); l[2 * i + 1] = h[2 * i + 1] - __uint_as_float(wh[i] & 0xffff0000u); }
              wl.x = cvt_pk_bf16(l[0], l[1]); wl.y = cvt_pk_bf16(l[2], l[3]); wl.z = cvt_pk_bf16(l[4], l[5]); wl.w = cvt_pk_bf16(l[6], l[7]);
              { float hc[8];
#pragma unroll
                for (int i = 0; i < 8; ++i) hc[i] = fminf(fmaxf(h[i], -448.f), 448.f);
                int w0 = 0, w1 = 0; w0 = __builtin_amdgcn_cvt_pk_fp8_f32(hc[0], hc[1], w0, false); w0 = __builtin_amdgcn_cvt_pk_fp8_f32(hc[2], hc[3], w0, true);
                w1 = __builtin_amdgcn_cvt_pk_fp8_f32(hc[4], hc[5], w1, false); w1 = __builtin_amdgcn_cvt_pk_fp8_f32(hc[6], hc[7], w1, true);
                *(GAS unsigned long long*)(hr + k) = (unsigned long long)(unsigned)w0 | ((unsigned long long)(unsigned)w1 << 32); }
              const bf16x8 ah = __builtin_bit_cast(bf16x8, wh), al = __builtin_bit_cast(bf16x8, wl);
              const bf16x8 bh0 = *(const GAS bf16x8*)(RWT + (size_t)r32 * DM + k), bh1 = *(const GAS bf16x8*)(RWT + (size_t)(32 + r32) * DM + k);
              const bf16x8 bl0 = *(const GAS bf16x8*)(RWT + (size_t)(NE + r32) * DM + k), bl1 = *(const GAS bf16x8*)(RWT + (size_t)(NE + 32 + r32) * DM + k);
              acc0 = __builtin_amdgcn_mfma_f32_32x32x16_bf16(ah, bh0, acc0, 0, 0, 0); acc0 = __builtin_amdgcn_mfma_f32_32x32x16_bf16(ah, bl0, acc0, 0, 0, 0); acc0 = __builtin_amdgcn_mfma_f32_32x32x16_bf16(al, bh0, acc0, 0, 0, 0);
              acc1 = __builtin_amdgcn_mfma_f32_32x32x16_bf16(ah, bh1, acc1, 0, 0, 0); acc1 = __builtin_amdgcn_mfma_f32_32x32x16_bf16(ah, bl1, acc1, 0, 0, 0); acc1 = __builtin_amdgcn_mfma_f32_32x32x16_bf16(al, bh1, acc1, 0, 0, 0); }
#pragma unroll
          for (int r = 0; r < 16; ++r) { part[(wv * 32 + crow(r, hi)) * 64 + r32] = acc0[r]; part[(wv * 32 + crow(r, hi)) * 64 + 32 + r32] = acc1[r]; } }
        __syncthreads();
        for (int i = 0; i < 4; ++i) { const int rbk = wv * 4 + i, row = row0 + rbk; float logit = 0.f;
#pragma unroll
          for (int w = 0; w < 8; ++w) logit += part[(w * 32 + rbk) * 64 + lane];
          const float score = 1.0f / (1.0f + expf(-logit)), bsd = score + rb[lane];
          const int g = lane >> 3;
          int rk = 0;
#pragma unroll
          for (int q = 0; q < 8; ++q) { const int o = (lane & ~7) + q; const float vv = __shfl(bsd, o); rk += (vv > bsd) || (vv == bsd && o < lane); }
          float gs = rk < 2 ? bsd : 0.f;
          gs += __shfl_xor(gs, 1); gs += __shfl_xor(gs, 2); gs += __shfl_xor(gs, 4);
          int grk = 0;
#pragma unroll
          for (int gg = 0; gg < 8; ++gg) { const float vv = __shfl(gs, gg * 8); grk += (vv > gs) || (vv == gs && gg < g); }
          const bool gsel = grk < 4;
          const float mb = gsel ? bsd : -INFINITY;
          int erk = 0;
          for (int o = 0; o < 64; ++o) { const float vv = __shfl(mb, o); erk += (vv > mb) || (vv == mb && o < lane); }
          const bool sel = gsel && erk < TOPK;
          const float ssum = wave_sum(sel ? score : 0.f);
          if (sel) { const int lp = __hip_atomic_fetch_add(lcnt + lane, 1, __ATOMIC_RELAXED, __HIP_MEMORY_SCOPE_WORKGROUP);
                     EIDX[row * TOPK + erk] = lane; EW[row * TOPK + erk] = score / ssum * 2.5f; lent[(nb * 32 + rbk) * TOPK + erk] = (lane << 16) | lp; } }
        __syncthreads();
    }
    if (F.tid < NE) { const int c = lcnt[F.tid]; lbase[F.tid] = c ? atomicAdd(&CNT[F.tid * 64], c) : 0; }
    __syncthreads();
    int it0 = F.tid; asm volatile("" : "+v"(it0));
    for (int i = it0; i < nb * 256; i += NTHREADS) { const int blk = F.vcu + (i >> 8) * F.G, row = blk * 32 + ((i >> 3) & 31), v = lent[i]; const int pos = lbase[v >> 16] + (v & 0xffff); EPOS[row * TOPK + (i & 7)] = pos; TOKE[(v >> 16) * NTOK + pos] = row; }
    __syncthreads();
}
__device__ __forceinline__ void y16(const unsigned char* p, float (&f)[16]) {
    const u32x4 w = *(const GAS u32x4*)p;
#pragma unroll
    for (int i = 0; i < 4; ++i) { const auto lo = __builtin_amdgcn_cvt_pk_f32_fp8((int)w[i], false), hi = __builtin_amdgcn_cvt_pk_f32_fp8((int)w[i], true); f[4 * i] = lo[0]; f[4 * i + 1] = lo[1]; f[4 * i + 2] = hi[0]; f[4 * i + 3] = hi[1]; }
}
__device__ __forceinline__ void ph_comb(Frame& F, const Args& args, const float* mod) {
    const int gw = F.vcu * NWAVES + F.wave, NGW = F.G * NWAVES, lane = F.lane;
    moe_tables(F, 4);
    LAS int* T = (LAS int*)(F.lds + SCHT_OFF);
    const float* EW = (const float*)(F.ws + WS_EW); const int* EIDX = (const int*)(F.ws + WS_EIDX); const int* EPOS = (const int*)(F.ws + WS_EPOS); const unsigned char* Y = (const unsigned char*)(F.ws + WS_YBIG);
    for (int t = gw; t < NTOK; t += NGW) {
        const float* g2 = mod + (t / SEQ) * MODC + 5 * DM;
        int sl[TOPK]; float wk[TOPK];
#pragma unroll
        for (int k = 0; k < TOPK; ++k) { sl[k] = T[80 + EIDX[t * TOPK + k]] + EPOS[t * TOPK + k]; wk[k] = EW[t * TOPK + k]; }
#pragma unroll
        for (int j = 0; j < 2; ++j) { const int col = j * 1024 + lane * 16;
            float a[16]; y16(Y + (size_t)(NSLOT + t) * DM + col, a);
#pragma unroll
            for (int k = 0; k < TOPK; ++k) { float y[16]; y16(Y + (size_t)sl[k] * DM + col, y);
#pragma unroll
                for (int c = 0; c < 16; ++c) a[c] += wk[k] * y[c]; }
            float* o = args.out + (size_t)t * DM + col; const float* xi = (const float*)(F.ws + WS_X2) + (size_t)t * DM + col;
#pragma unroll
            for (int n = 0; n < 4; ++n) { const f32x4 xv = *(const GAS f32x4*)(xi + 4 * n), gv = *(const GAS f32x4*)(g2 + col + 4 * n);
                *(GAS f32x4*)(o + 4 * n) = xv + gv * (f32x4){a[4 * n], a[4 * n + 1], a[4 * n + 2], a[4 * n + 3]}; } }
    }
}

enum { PH_PRO = 0, PH_NORM1, PH_INPROJ, PH_QKNORM, PH_ATTN, PH_F2, PH_MERGE, PH_OUT, PH_ROUTE, PH_EXP1, PH_EXP2, PH_COMB, PH_END };


__global__ void __launch_bounds__(NTHREADS, 2) fwd(Args args) {
    extern __shared__ __attribute__((aligned(16))) unsigned char lds_raw[];
    Frame F;
    F.lds = (LAS unsigned char*)lds_raw; F.MISC = (volatile LAS unsigned*)(F.lds + MISC_OFF); F.ws = args.ws;
    F.tid = threadIdx.x; F.lane = F.tid & 63; F.wave = __builtin_amdgcn_readfirstlane(F.tid >> 6);
    F.G = gridDim.x; { const int bx = blockIdx.x; F.vcu = (F.G % 8 == 0) ? (bx % 8) * (F.G / 8) + bx / 8 : bx; }
    for (int u = F.tid; u < (LDS_BYTES - LDSCTL_OFF) / 4; u += NTHREADS) ((LAS unsigned*)(F.lds + LDSCTL_OFF))[u] = 0u;
    __syncthreads();
    const int lo = args.ph_lo, hi = args.ph_hi;
    const bool multi = (hi - lo) > 1;
    unsigned* barw = (unsigned*)(args.ws + CTL_BAR) + args.bar_idx * XCD_BAR_WORDS;
    XcdBarrier bar; bar.bar = barw; bar.x = 0; bar.st = nullptr;
    if (multi) bar = xcd_barrier_post(barw, F.MISC + 8);
#define IN(k) (lo <= (k) && (k) < hi)
#define SEAM(k) do { if (IN((k) + 1)) xcd_barrier(bar); } while (0)

    const float* modp = (const float*)(args.ws + args.mod_off);
    if (IN(PH_PRO)) { p0_prologue(F, args); SEAM(PH_PRO); }
    if (IN(PH_NORM1)) { ph_norm1(F, args, modp); SEAM(PH_NORM1); }
    if (IN(PH_INPROJ)) {
        { SchedIn S{F.G, (int)blockIdx.x, args.ws, args.use_ut};
          EpiIn E{EpiStore{(const float*)(args.ws + WS_W2048)}, (LAS float*)(F.lds + GPARK_OFF), args.in[8], args.in[9], (const float*)(args.ws + WS_ROPE)};
          gemm_phase<EpiIn, SchedIn, false>(F.lds, DM, DM, DM, S, E); }
        { SchedGate S{F.G, (int)blockIdx.x, args.ws};
          gemm_phase<EpiStore, SchedGate, false, true>(F.lds, DM, DM / 2, DM / 2, S, EpiStore{(const float*)(args.ws + WS_W2048)}); }
        SEAM(PH_INPROJ);
    }
    if (IN(PH_QKNORM)) { ph_evenodd(F, args); SEAM(PH_QKNORM); }
    if (IN(PH_ATTN)) {
        const int cs = F.vcu & 3;
        constexpr int NCONV = IT_EG + IT_EU + IT_ED;
        int qfirst, qcnt; { const int c = (int)blockIdx.x; if (F.G == 256) { qfirst = c < 144 ? c * 171 : 144 * 171 + (c - 144) * 219; qcnt = c < 144 ? 171 : 219; }
                             else { const int per = (NCONV + F.G - 1) / F.G; qfirst = c * per; qcnt = qfirst + per <= NCONV ? per : (NCONV - qfirst > 0 ? NCONV - qfirst : 0); } }
        const int gcnt = qfirst < IT_EG + IT_EU ? (qfirst + qcnt <= IT_EG + IT_EU ? qcnt : IT_EG + IT_EU - qfirst) : 0, gfirst = qfirst;
        const int ccnt = qcnt - gcnt, cfirst = qfirst + gcnt - (IT_EG + IT_EU);
#define CONV_ALL() do { conv_items(F, args, false, gfirst, gcnt); conv_items(F, args, true, cfirst, ccnt); } while (0)
        const bf16_t* Qp = (const bf16_t*)(args.ws + WS_Q); const bf16_t* Kp = (const bf16_t*)(args.ws + WS_KALL); const bf16_t* Vp = (const bf16_t*)(args.ws + WS_VALL); bf16_t* Op = (bf16_t*)(args.ws + WS_YA);
#define ATTN_UNIT(lin_) do { const int lin = (lin_); if (lin < 512) { const int x = (lin >> 5) & 7, j = (lin & 31) + 32 * (lin >> 8), b = x >> 2, kvh = x & 3, head = kvh * 4 + (j >> 4), qb = j & 15; \
            const size_t qo = ((size_t)(b * SEQ + qb * 256)) * DM + head * HD, ko = (size_t)b * SKV * KVW + kvh * HD; \
            attn::attn_dense_body(Qp + qo, Kp + ko, Vp + ko, Op + qo, SKV, (char*)lds_raw); __syncthreads(); } } while (0)
        if (cs == 0) { CONV_ALL(); __syncthreads(); }
        ATTN_UNIT(F.vcu);
        if (cs == 1) { CONV_ALL(); __syncthreads(); }
        ATTN_UNIT(F.vcu + F.G);
        for (int lin2 = F.vcu + 2 * F.G; lin2 < 512; lin2 += F.G) ATTN_UNIT(lin2);
        if (cs == 2) { CONV_ALL(); __syncthreads(); }
#undef ATTN_UNIT
        SchedAG S{F.G, (int)blockIdx.x, args.ws};
        gemm_phase<EpiStore, SchedAG, false, true>(F.lds, DM, DM / 2, DM / 2, S, EpiStore{(const float*)(args.ws + WS_W2048)});
        if (cs == 3) { __syncthreads(); CONV_ALL(); }
#undef CONV_ALL
        SEAM(PH_ATTN);
    }
    if (IN(PH_F2)) {
        SchedF2 S{F.G, (int)blockIdx.x, args.ws};
        gemm_phase<EpiStore, SchedF2, false>(F.lds, 512, DM, 512, S, EpiStore{(const float*)(args.ws + WS_W2048)});
        {
            const int idx = F.vcu * NTHREADS + F.tid;
            if (idx < 2 * FW) { const int b = idx >> 10, col = idx & 1023, k2 = col & 127; const float* al = (const float*)(args.ws + WS_ALT) + b * FW + (col & ~127); float s = 0.f;
                for (int c = 0; c < 128; ++c) s += al[c] * cospif((float)((c * k2) & 127) * (1.0f / 64.0f));
                ((bf16_t*)(args.ws + WS_YF))[((size_t)b * SEQ + SEQ / 2) * YFP + col] = f2bf(s * 0.0013810679320049757f); }
        }
        SEAM(PH_F2);
    }
    if (IN(PH_MERGE)) {
        unsigned char* ws = args.ws;
        SchedMerge S{F.G, (int)blockIdx.x, ws};
        gemm_phase<EpiMerge, SchedMerge, false>(F.lds, DM, DM, DM, S, EpiMerge{(const bf16_t*)(ws + WS_SGF), (const bf16_t*)(ws + WS_SGA), (bf16_t*)(ws + WS_YM)});
        SEAM(PH_MERGE);
    }
    if (IN(PH_OUT)) {
        unsigned char* ws = args.ws;
        SchedGrid S{F.G, (int)blockIdx.x, 32, 8, (const char*)(ws + WS_YM), (const char*)(ws + WS_WT_O), nullptr, (size_t)256 * DM * 2, (size_t)256 * DM * 2, DM, 4, 1, DM / BK};
        gemm_phase<EpiX2, SchedGrid, false>(F.lds, DM, DM, DM, S, EpiX2{args.in[0], modp, (float*)(ws + WS_X2)});
        SEAM(PH_OUT);
    }
    if (IN(PH_ROUTE)) { ph_route(F, args, modp); SEAM(PH_ROUTE); }
    if (IN(PH_EXP1)) {
        moe_tables(F, 4);
        SchedMoe<4, true> S{F.G, F.vcu, args.ws, (LAS int*)(F.lds + SCHT_OFF), (const int*)(args.ws + WS_TOKE)};
        gemm_phase<EpiAct, SchedMoe<4, true>, true, true>(F.lds, DM, DM / 2, DM / 2, S, EpiAct{});
        SEAM(PH_EXP1);
    }
    if (IN(PH_EXP2)) {
        moe_tables(F, 8);
        SchedMoe<8, false> S{F.G, F.vcu, args.ws, (LAS int*)(F.lds + SCHT_OFF), (const int*)(args.ws + WS_TOKE)};
        gemm_phase<EpiY8, SchedMoe<8, false>, false, true>(F.lds, EFF, EFF / 2, EFF / 2, S, EpiY8{});
        SEAM(PH_EXP2);
    }
    if (IN(PH_COMB)) { ph_comb(F, args, modp); }
#undef IN
#undef SEAM
}
}

extern "C" void kernel_launch(void* const* d_in, const int* in_sizes, int n_in, void* d_out, int out_size, void* d_ws, size_t ws_size, hipStream_t stream) {
    if (n_in != 22 || ws_size < WS_END2) return;
    float* out = (float*)d_out;
    unsigned char* ws = (unsigned char*)d_ws;
    hipMemsetAsync(ws + WS_CTL, 0, CTL_ZERO_BYTES, stream);
    static int grid = 0;
    if (!grid) {
        int dev = 0, cus = 0;
        if (hipGetDevice(&dev) != hipSuccess || hipDeviceGetAttribute(&cus, hipDeviceAttributeMultiprocessorCount, dev) != hipSuccess) { grid = -1; return; }
        if (hipFuncSetAttribute((const void*)mk::fwd, hipFuncAttributeMaxDynamicSharedMemorySize, mk::LDS_BYTES) != hipSuccess) { grid = -1; return; }
        grid = cus;
    }
    if (grid < 0) return;
    mk::Args a{}; int nlaunch = 0;
    for (int i = 0; i < 22; ++i) a.in[i] = (const float*)d_in[i];
    a.out = out; a.ws = ws; a.use_ut = 1; a.mod_off = (int)WS_MOD; a.do_attn = 1;
#define MK_LAUNCH(lo_, hi_) do { a.ph_lo = (lo_); a.ph_hi = (hi_); a.bar_idx = nlaunch++; hipLaunchKernelGGL(mk::fwd, dim3(grid), dim3(mk::NTHREADS), mk::LDS_BYTES, stream, a); } while (0)
    MK_LAUNCH(mk::PH_PRO, mk::PH_END);
}
```

```cpp
#include <hip/hip_runtime.h>
#include <stdint.h>
#include <math.h>

typedef unsigned short bf16_t;
typedef short bf16x8 __attribute__((ext_vector_type(8)));
typedef float f32x16 __attribute__((ext_vector_type(16)));
typedef float f32x4 __attribute__((ext_vector_type(4)));

constexpr int NB = 2, SEQ = 4096, DM = 2048, NTOK = NB * SEQ, CTXL = 256, NCTX = NB * CTXL, HD = 128, NH = 16, NKV = 4;
constexpr int SKV = SEQ + CTXL;
constexpr int FW = 1024, INC = 8192, Q_OFF = 1024, K_OFF = 3072, V_OFF = 3584, GF_OFF = 4096, GA_OFF = 6144;
constexpr int KVW = NKV * HD;
constexpr int NE = 64, TOPK = 8, EFF = 512, MODC = 6 * DM;
constexpr int NSLOT = NTOK * TOPK;
constexpr int NSLOT_ALL = NSLOT + NTOK;

constexpr size_t MiB = 1u << 20;
constexpr size_t WS_CTL = 0, CTL_ZERO_BYTES = 1 * MiB;
constexpr size_t CTL_CNT = 64 * 1024;
constexpr size_t WS_TW = 1 * MiB;
constexpr size_t WS_MOD = 1 * MiB + 64 * 1024;
constexpr size_t WS_OFFS = 1 * MiB + 256 * 1024;
constexpr size_t WS_EIDX = 2 * MiB;
constexpr size_t WS_EW = WS_EIDX + 256 * 1024;
constexpr size_t WS_EPOS = WS_EW + 256 * 1024;
constexpr size_t WS_SLOTOF = WS_EPOS + 256 * 1024;
constexpr size_t WS_TOKE = 300 * MiB;
constexpr size_t WS_H = 4 * MiB;
constexpr size_t WS_U = 38 * MiB;
constexpr size_t WS_Q = 54 * MiB;
constexpr size_t WS_KALL = 86 * MiB;
constexpr size_t WS_VALL = 95 * MiB;
constexpr size_t WS_SGF = 104 * MiB;
constexpr size_t WS_SGA = 136 * MiB;
constexpr size_t WS_YA = 168 * MiB;
constexpr size_t WS_YF = 38 * MiB;
constexpr int YFP = 2048;
constexpr size_t WS_PR = 216 * MiB;
constexpr size_t WS_T1 = 248 * MiB;
constexpr size_t WS_YM = 312 * MiB;
constexpr size_t WS_QKRAW = 248 * MiB;
constexpr size_t WS_KCRAW = 330 * MiB;
constexpr size_t WS_H2 = 344 * MiB;
constexpr size_t WS_ACT = 376 * MiB;
constexpr size_t WS_YBIG = 4 * MiB;
constexpr size_t WS_END = 740 * MiB;

__device__ __forceinline__ float bf2f(bf16_t h) { return __uint_as_float(((unsigned)h) << 16); }
__device__ __forceinline__ bf16_t f2bf(float f) { unsigned u = __float_as_uint(f); return (bf16_t)((u + 0x7fffu + ((u >> 16) & 1u)) >> 16); }
__device__ __forceinline__ int crow(int r, int hi) { return (r & 3) + 8 * (r >> 2) + 4 * hi; }
__device__ __forceinline__ float wave_sum(float v) {
#pragma unroll
    for (int o = 1; o < 64; o <<= 1) v += __shfl_xor(v, o);
    return v;
}
__device__ __forceinline__ float sigmoidf_(float v) { return 1.0f / (1.0f + expf(-v)); }
__device__ __forceinline__ bf16x8 pack8(const float* f) {
    bf16x8 r;
#pragma unroll
    for (int i = 0; i < 8; ++i) r[i] = (short)f2bf(f[i]);
    return r;
}

#define LAS __attribute__((address_space(3)))
#define GAS __attribute__((address_space(1)))
typedef unsigned u32x4 __attribute__((ext_vector_type(4)));
typedef GAS unsigned gu32;
#define RLX_AGENT __ATOMIC_RELAXED, __HIP_MEMORY_SCOPE_AGENT
#define LDS_WAIT() asm volatile("s_waitcnt lgkmcnt(0)" ::: "memory")
#define VM_WAIT() asm volatile("s_waitcnt vmcnt(0)" ::: "memory")

constexpr size_t CTL_BAR = 16384;
constexpr size_t CTL_MODZ = 512 * 1024;
constexpr size_t WS_UT = 38 * MiB;
constexpr size_t WS_TT = 216 * MiB;
constexpr size_t WS_WT_GU = 450 * MiB;
constexpr size_t WS_WT_D = 710 * MiB;
constexpr size_t WS_WT_IN = 840 * MiB;
constexpr size_t WS_WT_FO = 924 * MiB;
constexpr size_t WS_WT_AO = 876 * MiB;
constexpr size_t WS_WT_O = 884 * MiB;
constexpr size_t WS_CST = 892 * MiB;
constexpr size_t WS_ET = 908 * MiB;
constexpr size_t WS_OT = 916 * MiB;
constexpr size_t WS_W2048 = 1 * MiB + 512 * 1024;
constexpr size_t WS_ALT = 1 * MiB + 520 * 1024;
constexpr size_t WS_ROPE = 1 * MiB + 528 * 1024;
constexpr size_t WS_RWT = 3 * MiB + 512 * 1024;
constexpr size_t WS_BD2 = 956 * MiB;
constexpr size_t WS_H8 = 200 * MiB;
constexpr size_t WS_WT_G8 = 932 * MiB;
constexpr size_t WS_X2 = 960 * MiB;
constexpr size_t WS_END2 = 1024 * MiB;

namespace mk {
constexpr int NWAVES = 8, NTHREADS = 512;
constexpr int RING_BYTES = 131072, SCR_BYTES = 8 * 16640, LDSCTL_OFF = 135168, MISC_OFF = LDSCTL_OFF + 320, GPARK_OFF = LDSCTL_OFF + 2048  , LDS_BYTES = 147456;
static_assert(GPARK_OFF + 8192 <= LDS_BYTES, "LDS map");
static_assert(SCR_BYTES <= LDSCTL_OFF && MISC_OFF + 128 <= LDS_BYTES, "LDS map");

#define XB_TMO      128
#define XB_XCNT(j)  (256  + 64 * (j))
#define XB_XSUB(j)  (1280 + 64 * (j))
#define XB_XGEN(j)  (2304 + 64 * (j))
#define XB_TOP      3328
#define XB_TOPGEN   3392
#define XCD_BAR_WORDS 3456
#define XB_SPIN_CAP (1u << 18)
__device__ __forceinline__ unsigned xb_ld(unsigned* p)              { return __hip_atomic_load(p, __ATOMIC_RELAXED, __HIP_MEMORY_SCOPE_AGENT); }
__device__ __forceinline__ unsigned xb_add(unsigned* p, unsigned v) { return __hip_atomic_fetch_add(p, v, __ATOMIC_RELAXED, __HIP_MEMORY_SCOPE_AGENT); }
__device__ __forceinline__ unsigned xb_xcc_id() { return (unsigned)__builtin_amdgcn_s_getreg((3 << 11) | 20) & 0xFu; }
#define XB_SPIN(cond, bar) do { unsigned _sp = 0; while (cond) { __builtin_amdgcn_s_sleep(1); \
    if ((++_sp & 255u) == 0u) { if (xb_ld(&(bar)[XB_TMO])) break; if (_sp > XB_SPIN_CAP) { atomicAdd(&(bar)[XB_TMO], 1u); break; } } } } while (0)
struct XcdBarrier { unsigned* bar; unsigned x; volatile LAS unsigned* st; };
__device__ __forceinline__ XcdBarrier xcd_barrier_post(unsigned* bar, volatile LAS unsigned* st) {
    XcdBarrier b; b.bar = bar; b.x = xb_xcc_id(); b.st = st;
    if (threadIdx.x == 0) (void)xb_add(&bar[XB_XCNT(b.x)], 1u);
    return b;
}
__device__ __forceinline__ void xcd_barrier_complete(unsigned* bar, unsigned x, unsigned& nloc, unsigned& nx) {
    const unsigned G = gridDim.x * gridDim.y * gridDim.z;
    unsigned sum, cnt, mine, sp = 0u;
    for (;;) {
        sum = 0u; cnt = 0u; mine = 0u;
#pragma unroll
        for (unsigned j = 0; j < 16; ++j) { const unsigned c = xb_ld(&bar[XB_XCNT(j)]); sum += c; cnt += (c > 0u) ? 1u : 0u; mine = (j == x) ? c : mine; }
        if (sum == G) break;
        __builtin_amdgcn_s_sleep(1);
        if ((++sp & 255u) == 0u) { if (xb_ld(&bar[XB_TMO])) break; if (sp > XB_SPIN_CAP) { atomicAdd(&bar[XB_TMO], 1u); break; } }
    }
    nloc = mine > 0u ? mine : 1u; nx = cnt > 0u ? cnt : 1u;
}
__device__ __forceinline__ void xcd_barrier(const XcdBarrier& b) {
    asm volatile("s_waitcnt vmcnt(0)" ::: "memory");
    __syncthreads();
    if (threadIdx.x == 0) {
        unsigned* bar = b.bar;
        __builtin_amdgcn_s_waitcnt(0);
        unsigned nloc = b.st[0], nx = b.st[1];
        if (nloc == 0u) { xcd_barrier_complete(bar, b.x, nloc, nx); b.st[0] = nloc; b.st[1] = nx; }
        const unsigned old = xb_add(&bar[XB_XSUB(b.x)], 1u);
        const unsigned gen = old / nloc;
        if (old + 1u == (gen + 1u) * nloc) {
            __builtin_amdgcn_fence(__ATOMIC_RELEASE, "agent");
            asm volatile("s_waitcnt vmcnt(0)" ::: "memory");
            const unsigned og = xb_add(&bar[XB_TOP], 1u);
            const unsigned tg = og / nx;
            if (og + 1u == (tg + 1u) * nx) xb_add(&bar[XB_TOPGEN], 1u);
            else XB_SPIN(xb_ld(&bar[XB_TOPGEN]) == tg, bar);
            __builtin_amdgcn_fence(__ATOMIC_ACQUIRE, "agent");
            xb_add(&bar[XB_XGEN(b.x)], 1u);
            asm volatile("s_waitcnt vmcnt(0)" ::: "memory");
        } else {
            XB_SPIN(xb_ld(&bar[XB_XGEN(b.x)]) == gen, bar);
            __builtin_amdgcn_fence(__ATOMIC_ACQUIRE, "agent");
            asm volatile("s_waitcnt vmcnt(0)" ::: "memory");
        }
    }
    __syncthreads();
}

constexpr int BM = 256, BK = 64, HALF = 128, HTB = HALF * BK * 2, STAGE_BYTES = 8 * HTB;
__device__ __forceinline__ int lds_byte(int r, int c) { const int st = (r >> 4) * 2 + (c >> 5), rr = r & 15, cc = c & 31, ob = rr * 64 + cc * 2; return st * 1024 + (ob ^ (((ob >> 9) & 1) << 5)); }
__device__ __forceinline__ void stage_rc(int b, int& R, int& C) { const int st = b / 1024, sb = b % 1024, swz = sb ^ (((sb >> 9) & 1) << 5); R = (st >> 1) * 16 + swz / 64; C = (st & 1) * 32 + (swz % 64) / 2; }
__device__ __forceinline__ int perm32(int rho) { const int n = rho >> 4, i = rho & 15; return 8 * (i >> 2) + 4 * n + (i & 3); }
__device__ __forceinline__ unsigned cvt_pk_bf16(float lo, float hi) { unsigned r; asm("v_cvt_pk_bf16_f32 %0, %1, %2" : "=v"(r) : "v"(lo), "v"(hi)); return r; }

__device__ __forceinline__ void glds16_s(const void* sbase, unsigned voff, unsigned lds_dst) { unsigned keep;
    asm volatile("s_mov_b32 %0, m0\n\ts_mov_b32 m0, %3\n\ts_nop 0\n\tglobal_load_lds_dwordx4 %1, %2\n\ts_mov_b32 m0, %0" : "=&s"(keep) : "v"(voff), "s"(sbase), "s"(lds_dst) : "memory"); }

struct Unit { const char* A; const char* B; char* C; int ldc; int mode; int rows; int aux; int pm, pn, bjs, rmin, e, nt, keep; };

typedef int i32x8 __attribute__((ext_vector_type(8)));
typedef int i32x4 __attribute__((ext_vector_type(4)));
template <class Epi, class Sched, bool GATHER, bool F8 = false>
__device__ __forceinline__ void gemm_phase(LAS unsigned char* lds, const int K, const int lda, const int ldb, const Sched& S, const Epi& E, const int i0 = 0, const int i1 = 0x7fffffff) {
    const int tid = threadIdx.x, wid = __builtin_amdgcn_readfirstlane(tid >> 6), lane = tid & 63, wr = wid >> 2, wc = wid & 3, fr = lane & 15, fq = lane >> 4;
    unsigned voffA[2], voffB[2];
#pragma unroll
    for (int i = 0; i < 2; ++i) { int R, C; stage_rc(tid * 16 + i * 8192, R, C); const int Rb = (R & ~31) + perm32(R & 31);
        voffA[i] = (unsigned)(R * lda + C) * 2u; voffB[i] = (unsigned)(Rb * ldb + C) * 2u; }
    const size_t kstep = (size_t)(BK * 2);
    const size_t hstepA = (size_t)HALF * lda * 2, hstepB = (size_t)HALF * ldb * 2;
    const unsigned ldsw = (unsigned)wid * 1024u;
    const unsigned ldsbase = (unsigned)__builtin_amdgcn_readfirstlane((int)(unsigned)(uintptr_t)lds);
    const int aoff = F8 ? lds_byte(wr * 64 + fr, (fq >> 1) * 32 + (fq & 1) * 16) : lds_byte(wr * 64 + fr, fq * 8), boff = F8 ? lds_byte(wc * 32 + fr, (fq >> 1) * 32 + (fq & 1) * 16) : lds_byte(wc * 32 + fr, fq * 8);

#define MK_SA(b, h) (((b) * 2 + (h)) * HTB)
#define MK_SB(b, h) ((4 + (b) * 2 + (h)) * HTB)
#define MK_STAGE2(bufoff, gbase, v0, v1) do { \
        __builtin_amdgcn_global_load_lds((const unsigned*)((const char*)(gbase) + (v0)), (LAS unsigned*)(lds + (bufoff) + ldsw), 16, 0, 0); \
        __builtin_amdgcn_global_load_lds((const unsigned*)((const char*)(gbase) + (v1)), (LAS unsigned*)(lds + (bufoff) + ldsw + 8192), 16, 0, 0); } while (0)
#define MK_STAGE_B(bufoff, gbase) do { glds16_s((gbase), voffB[0], ldsbase + (bufoff) + ldsw); glds16_s((gbase), voffB[1], ldsbase + (bufoff) + ldsw + 8192u); } while (0)
#define MK_STAGE_A(bufoff, gbase, h, VA) do { if constexpr (GATHER) { glds16_s((gbase), (VA)[h][0], ldsbase + (bufoff) + ldsw); glds16_s((gbase), (VA)[h][1], ldsbase + (bufoff) + ldsw + 8192u); } \
        else { glds16_s((gbase) + (h) * hstepA, voffA[0], ldsbase + (bufoff) + ldsw); glds16_s((gbase) + (h) * hstepA, voffA[1], ldsbase + (bufoff) + ldsw + 8192u); } } while (0)
#define MK_LDA(dst, b, h) do { if constexpr (F8) { _Pragma("unroll") for (int m = 0; m < 4; ++m) dst##8[m] = *(const LAS i32x8*)(lds + MK_SA(b, h) + aoff + m * 2048); } \
        else { _Pragma("unroll") for (int m = 0; m < 4; ++m) _Pragma("unroll") for (int k = 0; k < 2; ++k) dst[m][k] = *(const LAS bf16x8*)(lds + MK_SA(b, h) + aoff + m * 2048 + k * 1024); } } while (0)
#define MK_LDB(dst, b, h) do { if constexpr (F8) { _Pragma("unroll") for (int n = 0; n < 2; ++n) dst##8[n] = *(const LAS i32x8*)(lds + MK_SB(b, h) + boff + n * 2048); } \
        else { _Pragma("unroll") for (int n = 0; n < 2; ++n) _Pragma("unroll") for (int k = 0; k < 2; ++k) dst[n][k] = *(const LAS bf16x8*)(lds + MK_SB(b, h) + boff + n * 2048 + k * 1024); } } while (0)
#define MK_MMA(ai, bj, At, Bt) do { __builtin_amdgcn_s_setprio(1); \
        if constexpr (F8) { _Pragma("unroll") for (int m = 0; m < 4; ++m) _Pragma("unroll") for (int n = 0; n < 2; ++n) \
            acc[ai][bj][m][n] = __builtin_amdgcn_mfma_scale_f32_16x16x128_f8f6f4(Bt##8[n], At##8[m], acc[ai][bj][m][n], 0, 0, 0, 0x7d, 0, 0x7d  ); } \
        else { _Pragma("unroll") for (int m = 0; m < 4; ++m) _Pragma("unroll") for (int n = 0; n < 2; ++n) _Pragma("unroll") for (int k = 0; k < 2; ++k) \
            acc[ai][bj][m][n] = __builtin_amdgcn_mfma_f32_16x16x32_bf16(Bt[n][k], At[m][k], acc[ai][bj][m][n], 0, 0, 0); } \
        __builtin_amdgcn_s_setprio(0); } while (0)
#define MK_WAIT_V(n) asm volatile("s_waitcnt vmcnt(" #n ")" ::: "memory")
#define MK_WAIT_L(n) asm volatile("s_waitcnt lgkmcnt(" #n ")" ::: "memory")
#define MK_BAR __builtin_amdgcn_s_barrier()
#define MK_SCHED __builtin_amdgcn_sched_barrier(0)
    Unit cur, nxt; int ui = i0;
    if (i0 >= i1 || !S.next(i0, cur)) return;
    f32x4 acc[2][2][4][2];
#pragma unroll
    for (int a = 0; a < 2; ++a)
#pragma unroll
        for (int b = 0; b < 2; ++b)
#pragma unroll
            for (int m = 0; m < 4; ++m)
#pragma unroll
                for (int n = 0; n < 2; ++n) acc[a][b][m][n] = (f32x4){0.f, 0.f, 0.f, 0.f};
    bf16x8 At[4][2], B0[2][2], B1[2][2]; i32x8 At8[4], B08[2], B18[2];
    unsigned vC[2][2];
    LAS u32x4* vpark = (LAS u32x4*)(lds + GPARK_OFF) + tid;
    if constexpr (GATHER) {
#pragma unroll
        for (int h = 0; h < 2; ++h)
#pragma unroll
            for (int i = 0; i < 2; ++i) { int R, C; stage_rc(tid * 16 + i * 8192, R, C); vC[h][i] = S.arow(cur, h * HALF + R) + (unsigned)(C * 2); }
    }
    const char* cA = cur.A; const char* cB = cur.B;
    MK_STAGE_B(MK_SB(0, 0), cB); MK_STAGE_B(MK_SB(0, 1), cB + hstepB); MK_STAGE_A(MK_SA(0, 0), cA, 0, vC); MK_STAGE_A(MK_SA(0, 1), cA, 1, vC);
    if (wr == 1) MK_BAR;
    MK_WAIT_V(2); MK_BAR;
    MK_STAGE_B(MK_SB(1, 0), cB + kstep); MK_STAGE_A(MK_SA(1, 0), cA + kstep, 0, vC); MK_STAGE_B(MK_SB(1, 1), cB + hstepB + kstep);
    MK_WAIT_V(6); MK_BAR;
    for (;;) {
        const bool has_next = (ui + 1 < i1) && S.next(ui + 1, nxt);
        const char* nA = has_next ? nxt.A : cA; const char* nB = has_next ? nxt.B : cB;
        if constexpr (GATHER) {
            u32x4 pv;
#pragma unroll
            for (int h = 0; h < 2; ++h)
#pragma unroll
                for (int i = 0; i < 2; ++i) { int R, C; stage_rc(tid * 16 + i * 8192, R, C); pv[h * 2 + i] = has_next ? (S.arow(nxt, h * HALF + R) + (unsigned)(C * 2)) : vC[h][i]; }
            *vpark = pv;
        }
        int nt = cur.nt; asm volatile("" : "+s"(nt));
#pragma nounroll
        for (int t = 0; t < nt; t += 2) {
            const bool last = (t == nt - 2);
            const char* a1 = cA + (size_t)(t + 1) * kstep;
            const char* a2 = last ? nA : cA + (size_t)(t + 2) * kstep; const char* b2 = last ? nB : cB + (size_t)(t + 2) * kstep;
            const char* a3 = a2 + kstep; const char* b3 = b2 + kstep;
            MK_LDB(B0, 0, 0); MK_LDB(B1, 0, 1); MK_SCHED; MK_LDA(At, 0, 0); MK_STAGE_A(MK_SA(1, 1), a1, 1, vC);
            if constexpr (GATHER) { if (last) { const u32x4 pv = *vpark; vC[0][0] = pv[0]; vC[0][1] = pv[1]; vC[1][0] = pv[2]; vC[1][1] = pv[3]; } }
            MK_WAIT_V(8); MK_WAIT_L(0); MK_BAR; MK_MMA(0, 0, At, B0); MK_MMA(0, 1, At, B1); MK_BAR; MK_SCHED;
            MK_LDA(At, 0, 1); MK_STAGE_B(MK_SB(0, 0), b2); MK_STAGE_B(MK_SB(0, 1), b2 + hstepB); MK_STAGE_A(MK_SA(0, 0), a2, 0, vC);
            MK_WAIT_V(8); MK_WAIT_L(0); MK_BAR; MK_MMA(1, 0, At, B0); MK_MMA(1, 1, At, B1); MK_BAR; MK_SCHED;
            MK_LDB(B0, 1, 0); MK_LDB(B1, 1, 1); MK_SCHED; MK_LDA(At, 1, 0); MK_STAGE_A(MK_SA(0, 1), a2, 1, vC);
            MK_WAIT_V(8); MK_WAIT_L(0); MK_BAR; MK_MMA(0, 0, At, B0); MK_MMA(0, 1, At, B1); MK_BAR; MK_SCHED;
            MK_LDA(At, 1, 1); MK_STAGE_B(MK_SB(1, 0), b3); MK_STAGE_B(MK_SB(1, 1), b3 + hstepB); MK_STAGE_A(MK_SA(1, 0), a3, 0, vC);
            MK_WAIT_V(8); MK_WAIT_L(0); MK_BAR; MK_MMA(1, 0, At, B0); MK_MMA(1, 1, At, B1); MK_BAR; MK_SCHED;
        }
        if (wr == 0) MK_BAR;
        { int l2; asm volatile("v_mbcnt_lo_u32_b32 %0, -1, 0\n\tv_mbcnt_hi_u32_b32 %0, -1, %0" : "=v"(l2));
          E(acc, cur, wr, wc, l2 & 15, l2 >> 4); }
        if (!has_next) break;
        if (!cur.keep)
#pragma unroll
        for (int a = 0; a < 2; ++a)
#pragma unroll
            for (int b = 0; b < 2; ++b)
#pragma unroll
                for (int m = 0; m < 4; ++m)
#pragma unroll
                    for (int n = 0; n < 2; ++n) acc[a][b][m][n] = (f32x4){0.f, 0.f, 0.f, 0.f};
        cur = nxt; cA = nA; cB = nB; ++ui;
        if (wr == 1) MK_BAR;
    }
    MK_WAIT_V(0);
    MK_BAR;
#undef MK_SA
#undef MK_SB
#undef MK_STAGE2
#undef MK_STAGE_B
#undef MK_STAGE_A
#undef MK_LDA
#undef MK_LDB
#undef MK_MMA
#undef MK_WAIT_V
#undef MK_WAIT_L
#undef MK_BAR
#undef MK_SCHED
}

__device__ __forceinline__ void grid_map(int L, int nM, int nN, int& pm, int& pn) {
    const int nwg = nM * nN, q = nwg / 8, xcd = L % 8, off = L / 8; const int wgid = xcd * q + off;
    const int nig = 8 * nN, gid = wgid / nig, fm = gid * 8, gsz = (nM - fm) < 8 ? (nM - fm) : 8;
    pm = fm + ((wgid % nig) % gsz); pn = (wgid % nig) / gsz;
}

struct EpiStore {
    const float* w2048;
    __device__ __forceinline__ void operator()(f32x4 (&acc)[2][2][4][2], const Unit& u, int wr, int wc, int fr, int fq) const {
        const int col0 = wc * 32 + 8 * fq;
#pragma unroll
        for (int ai = 0; ai < 2; ++ai)
#pragma unroll
            for (int m = 0; m < 4; ++m) {
                const int r = ai * HALF + wr * 64 + m * 16 + fr;
                if (r < u.rows && r >= u.rmin) {
#pragma unroll
                    for (int bj = 0; bj < 2; ++bj) {
                        f32x4 v0 = acc[ai][bj][m][0], v1 = acc[ai][bj][m][1];
                        if (u.mode == 1) { float* p = (float*)u.C + (long)r * u.ldc + col0 + bj * u.bjs; *(f32x4*)p = v0; *(f32x4*)(p + 4) = v1; }
                        else {
                            if (u.mode == 2) {
#pragma unroll
                                for (int c = 0; c < 4; ++c) { v0[c] = __builtin_amdgcn_rcpf(1.0f + __expf(-v0[c])); v1[c] = __builtin_amdgcn_rcpf(1.0f + __expf(-v1[c])); }
                            } else if (u.mode == 3) {
                                const float* wp = w2048 + u.pn + bj * HALF + col0; const float sg = (r & 1) ? -1.0f : 1.0f;
                                v0 += *(const f32x4*)wp * sg; v1 += *(const f32x4*)(wp + 4) * sg;
                            }
                            u32x4 w; w.x = cvt_pk_bf16(v0[0], v0[1]); w.y = cvt_pk_bf16(v0[2], v0[3]); w.z = cvt_pk_bf16(v1[0], v1[1]); w.w = cvt_pk_bf16(v1[2], v1[3]);
                            *(u32x4*)((bf16_t*)u.C + (long)r * u.ldc + col0 + bj * u.bjs) = w;
                        }
                    }
                }
            }
    }
};


struct EpiIn { EpiStore base; LAS float* red; const float* qnw; const float* knw; const float* rope;
    __device__ __forceinline__ void operator()(f32x4 (&acc)[2][2][4][2], const Unit& u, int wr, int wc, int fr, int fq) const {
        if (u.mode < 5) { base(acc, u, wr, wc, fr, fq); return; }
#pragma unroll
        for (int ai = 0; ai < 2; ++ai)
#pragma unroll
            for (int m = 0; m < 4; ++m)
#pragma unroll
                for (int bj = 0; bj < 2; ++bj) { const f32x4 a = acc[ai][bj][m][0], b = acc[ai][bj][m][1];
                    float s = (a[0] * a[0] + a[1] * a[1]) + (a[2] * a[2] + a[3] * a[3]) + (b[0] * b[0] + b[1] * b[1]) + (b[2] * b[2] + b[3] * b[3]);
                    s += __shfl_xor(s, 16); s += __shfl_xor(s, 32);
                    if (fq == 0) red[((ai * HALF + wr * 64 + m * 16 + fr) * 2 + bj) * 4 + wc] = s; }
        asm volatile("s_waitcnt lgkmcnt(0)" ::: "memory"); __builtin_amdgcn_s_barrier(); asm volatile("" ::: "memory");
        const float* nw = u.mode == 5 ? qnw : knw;
        const int axis = wc >> 1, f0 = (wc & 1) * 16 + fq * 4, da = axis * 64 + f0;
        const f32x4 wa = *(const f32x4*)(nw + da), wb = *(const f32x4*)(nw + da + 32);
#pragma unroll
        for (int ai = 0; ai < 2; ++ai)
#pragma unroll
            for (int m = 0; m < 4; ++m) { const int r = ai * HALF + wr * 64 + m * 16 + fr;
                f32x4 cs = {1.f, 1.f, 1.f, 1.f}, sn = {0.f, 0.f, 0.f, 0.f};
                if (u.mode != 7) { const int t = u.pm + r, pos = axis ? (t & 63) : (t >> 6); const float* rp = rope + (pos * 32 + f0) * 2;
                    const f32x4 p0 = *(const f32x4*)rp, p1 = *(const f32x4*)(rp + 4); cs = (f32x4){p0[0], p0[2], p1[0], p1[2]}; sn = (f32x4){p0[1], p0[3], p1[1], p1[3]}; }
#pragma unroll
                for (int bj = 0; bj < 2; ++bj) { const LAS f32x4* pp = (const LAS f32x4*)(red + (r * 2 + bj) * 4); const f32x4 ps = *pp;
                    const float rstd = 1.0f / sqrtf(((ps[0] + ps[1]) + (ps[2] + ps[3])) * (1.0f / HD) + 1e-6f);
                    const f32x4 xa = acc[ai][bj][m][0] * rstd * wa, xb = acc[ai][bj][m][1] * rstd * wb;
                    const f32x4 oa = xa * cs - xb * sn, ob = xb * cs + xa * sn;
                    u32x4 w; w.x = cvt_pk_bf16(oa[0], oa[1]); w.y = cvt_pk_bf16(oa[2], oa[3]); w.z = cvt_pk_bf16(ob[0], ob[1]); w.w = cvt_pk_bf16(ob[2], ob[3]);
                    *(u32x4*)((bf16_t*)u.C + (long)r * u.ldc + bj * HALF + wc * 32 + 8 * fq) = w; } }
    } };


__device__ __forceinline__ void pack8_fp8(const f32x4& a, const f32x4& b, unsigned& w0, unsigned& w1) {
    f32x4 v0 = a, v1 = b;
#pragma unroll
    for (int c = 0; c < 4; ++c) { v0[c] = fminf(fmaxf(v0[c], -448.f), 448.f); v1[c] = fminf(fmaxf(v1[c], -448.f), 448.f); }
    int x0 = 0, x1 = 0;
    x0 = __builtin_amdgcn_cvt_pk_fp8_f32(v0[0], v0[1], x0, false); x0 = __builtin_amdgcn_cvt_pk_fp8_f32(v0[2], v0[3], x0, true);
    x1 = __builtin_amdgcn_cvt_pk_fp8_f32(v1[0], v1[1], x1, false); x1 = __builtin_amdgcn_cvt_pk_fp8_f32(v1[2], v1[3], x1, true);
    w0 = (unsigned)x0; w1 = (unsigned)x1;
}
__device__ __forceinline__ void store16_s(const void* sbase, unsigned voff, u32x4 v) { asm volatile("global_store_dwordx4 %0, %1, %2\n\ts_nop 1" :: "v"(voff), "v"(v), "s"(sbase) : "memory"); }
struct EpiY8 {
    __device__ __forceinline__ void operator()(f32x4 (&acc)[2][2][4][2], const Unit& u, int wr, int wc, int fr, int fq) const {
        const int odd = fq & 1;
        const unsigned off0 = (unsigned)((wr * 64 + fr) * u.ldc + odd * HALF + wc * 32 + 8 * (fq - odd));
        const int r0 = wr * 64 + fr;
#pragma unroll
        for (int ai = 0; ai < 2; ++ai)
#pragma unroll
            for (int m = 0; m < 4; ++m) {
                unsigned a0, a1, b0, b1; pack8_fp8(acc[ai][0][m][0], acc[ai][0][m][1], a0, a1); pack8_fp8(acc[ai][1][m][0], acc[ai][1][m][1], b0, b1);
                const auto s0 = __builtin_amdgcn_permlane16_swap(a0, b0, false, false), s1 = __builtin_amdgcn_permlane16_swap(a1, b1, false, false);
                if (r0 + ai * HALF + m * 16 < u.rows) { const u32x4 w = {s0[0], s1[0], s0[1], s1[1]}; store16_s(u.C, off0 + (unsigned)((ai * HALF + m * 16) * u.ldc), w); } }
    } };


struct EpiGate {
    __device__ __forceinline__ void operator()(f32x4 (&acc)[2][2][4][2], const Unit& u, int wr, int wc, int fr, int fq) const {
        bf16_t* base = (bf16_t*)u.C + (size_t)(wr * 64 + fr) * u.ldc + wc * 32 + 8 * fq;
#pragma unroll
        for (int ai = 0; ai < 2; ++ai)
#pragma unroll
            for (int m = 0; m < 4; ++m) { bf16_t* p = base + (size_t)(ai * HALF + m * 16) * u.ldc;
#pragma unroll
                for (int bj = 0; bj < 2; ++bj) { f32x4 v0 = acc[ai][bj][m][0], v1 = acc[ai][bj][m][1];
#pragma unroll
                    for (int c = 0; c < 4; ++c) { v0[c] = __builtin_amdgcn_rcpf(1.0f + __expf(-v0[c])); v1[c] = __builtin_amdgcn_rcpf(1.0f + __expf(-v1[c])); }
                    u32x4 w; w.x = cvt_pk_bf16(v0[0], v0[1]); w.y = cvt_pk_bf16(v0[2], v0[3]); w.z = cvt_pk_bf16(v1[0], v1[1]); w.w = cvt_pk_bf16(v1[2], v1[3]);
                    *(u32x4*)(p + bj * HALF) = w; } }
    } };

struct Args { const float* in[22]; float* out; unsigned char* ws; int ph_lo, ph_hi, use_ut, mod_off, do_attn, bar_idx; };
struct Frame {
    LAS unsigned char* lds; volatile LAS unsigned* MISC; unsigned char* ws;
    int tid, lane, wave, vcu, G;
};

__device__ __forceinline__ int qk_col_of_dim(int d) { const int a = d >> 6, half = (d >> 5) & 1, f = d & 31; return 32 * (2 * a + (f >> 4)) + 8 * ((f >> 2) & 3) + 4 * half + (f & 3); }
__device__ __forceinline__ void t64_load(f32x4 (&v)[16], const float* W, int ldw, int lane) {
    const unsigned off = (unsigned)(((lane >> 4) * ldw + (lane & 15) * 4) * 4);
#pragma unroll
    for (int j = 0; j < 16; ++j) { const char* bj = (const char*)W + (size_t)(j * 4) * ldw * 4; v[j] = __builtin_nontemporal_load((const GAS f32x4*)(bj + off)); }
}
template <bool QKPERM = false, bool F8OUT = false>
__device__ __forceinline__ void t64_store(const f32x4 (&v)[16], bf16_t* dst, int ldd, LAS float* scr, int lane, int d0 = 0) {
    const int kk = lane >> 4, nc = (lane & 15) * 4;
#pragma unroll
    for (int j = 0; j < 16; ++j) {
#pragma unroll
        for (int c = 0; c < 4; ++c) scr[(j * 4 + kk) * 65 + nc + c] = v[j][c]; }
    LDS_WAIT(); asm volatile("" ::: "memory");
    const int kc = lane & 7; const unsigned soff = F8OUT ? (unsigned)((lane >> 3) * ldd + 8 * kc) : (unsigned)(((lane >> 3) * ldd + 8 * kc) * 2);
#pragma unroll
    for (int jj = 0; jj < 8; jj += 2) {
        float t[2][8];
#pragma unroll
        for (int q = 0; q < 2; ++q) { const int n = (lane >> 3) + 8 * (jj + q); const LAS float* s = scr + (8 * kc) * 65 + n;
#pragma unroll
            for (int i = 0; i < 8; ++i) t[q][i] = s[i * 65]; }
#pragma unroll
        for (int q = 0; q < 2; ++q) { char* bq = (char*)dst + (size_t)(8 * (jj + q)) * ldd * (F8OUT ? 1 : 2);
            if constexpr (QKPERM) bq = (char*)dst + (size_t)(qk_col_of_dim(d0 + (lane >> 3) + 8 * (jj + q)) - (lane >> 3)) * ldd * 2;
            if constexpr (F8OUT) { float s[8];
#pragma unroll
                for (int i = 0; i < 8; ++i) s[i] = fminf(fmaxf(t[q][i] * 16.0f, -448.f), 448.f);
                int w0 = 0, w1 = 0; w0 = __builtin_amdgcn_cvt_pk_fp8_f32(s[0], s[1], w0, false); w0 = __builtin_amdgcn_cvt_pk_fp8_f32(s[2], s[3], w0, true);
                w1 = __builtin_amdgcn_cvt_pk_fp8_f32(s[4], s[5], w1, false); w1 = __builtin_amdgcn_cvt_pk_fp8_f32(s[6], s[7], w1, true);
                __builtin_nontemporal_store((unsigned long long)(unsigned)w0 | ((unsigned long long)(unsigned)w1 << 32), (GAS unsigned long long*)(bq + soff)); }
            else { u32x4 o; o.x = cvt_pk_bf16(t[q][0], t[q][1]); o.y = cvt_pk_bf16(t[q][2], t[q][3]); o.z = cvt_pk_bf16(t[q][4], t[q][5]); o.w = cvt_pk_bf16(t[q][6], t[q][7]);
                __builtin_nontemporal_store(o, (GAS u32x4*)(bq + soff)); } } }
    LDS_WAIT(); asm volatile("" ::: "memory");
}
__device__ __forceinline__ void transpose64(const float* W, int ldw, bf16_t* dst, int ldd, LAS float* scr, int lane) {
    f32x4 v[16]; t64_load(v, W, ldw, lane); t64_store(v, dst, ldd, scr, lane);
}

constexpr int IT_IN = 32 * 128, IT_FO = 16 * 32, IT_AO = 32 * 32, IT_O = 32 * 32, IT_EG = 64 * 256, IT_EU = 64 * 256, IT_ED = 64 * 256, IT_SH = 256;
constexpr int IT_T_END = IT_IN + IT_FO + IT_AO + IT_O + 3 * IT_SH;
constexpr int IT_MOD = MODC / 32, IT_CST = 4096, IT_BD2 = 512, IT_RWT = 32, IT_ROPE = 1;
constexpr int IT_ALL = IT_T_END + IT_MOD + IT_CST + IT_BD2 + IT_RWT + IT_ROPE;

__device__ __forceinline__ void mod_item(const Args& args, unsigned char* ws, int r, int lane) {
            const int kq = lane >> 3, col = r * 32 + (lane & 7) * 4;
            f32x4 a0 = {0.f, 0.f, 0.f, 0.f}, a1 = a0, a2 = a0;
            for (int jb = 0; jb < 256; jb += 8) {
                f32x4 w[8]; float c0[8], c1[8], c2[8];
#pragma unroll
                for (int j = 0; j < 8; ++j) { const int k = kq + 8 * (jb + j); w[j] = *(const GAS f32x4*)(args.in[4] + (size_t)k * MODC + col); c0[j] = args.in[1][k]; c1[j] = args.in[1][DM + k]; c2[j] = args.in[3][k]; }
#pragma unroll
                for (int j = 0; j < 8; ++j) { a0 += w[j] * (c0[j] * __builtin_amdgcn_rcpf(1.0f + __expf(-c0[j]))); a1 += w[j] * (c1[j] * __builtin_amdgcn_rcpf(1.0f + __expf(-c1[j]))); a2 += w[j] * (c2[j] * __builtin_amdgcn_rcpf(1.0f + __expf(-c2[j]))); }
            }
#pragma unroll
            for (int c = 0; c < 4; ++c) {
#pragma unroll
                for (int o = 8; o < 64; o <<= 1) { a0[c] += __shfl_xor(a0[c], o); a1[c] += __shfl_xor(a1[c], o); a2[c] += __shfl_xor(a2[c], o); } }
            if (kq == 0) { const f32x4 bb = *(const GAS f32x4*)(args.in[5] + col); float* MODP = (float*)(ws + WS_MOD);
                *(GAS f32x4*)(MODP + col) = a0 + bb; *(GAS f32x4*)(MODP + MODC + col) = a1 + bb; *(GAS f32x4*)(MODP + 2 * MODC + col) = a2 + bb; }
}
__device__ __forceinline__ void p0_prologue(Frame& F, const Args& args) {
    LAS float* scr = (LAS float*)(F.lds + F.wave * 16640);
    const int gw = F.vcu * NWAVES + F.wave, NGW = F.G * NWAVES, lane = F.lane;
    unsigned char* ws = F.ws;
    bf16_t* WT_IN = (bf16_t*)(ws + WS_WT_IN); bf16_t* WT_FO = (bf16_t*)(ws + WS_WT_FO); bf16_t* WT_AO = (bf16_t*)(ws + WS_WT_AO); bf16_t* WT_O = (bf16_t*)(ws + WS_WT_O);
    bf16_t* WT_GU = (bf16_t*)(ws + WS_WT_GU); bf16_t* WT_D = (bf16_t*)(ws + WS_WT_D);
    if (NGW >= 5 * IT_MOD) { if (gw % 5 == 0 && gw / 5 < IT_MOD) mod_item(args, ws, gw / 5, lane); }
    else for (int m = gw; m < IT_MOD; m += NGW) mod_item(args, ws, m, lane);
    for (int it = gw; it < IT_ALL - IT_MOD; it += NGW) {
        int r = it;
        if (r < IT_IN) { const int kb = r / 128, nb = r % 128, n0 = nb * 64;
            if (n0 >= Q_OFF && n0 < V_OFF) { f32x4 v[16]; t64_load(v, args.in[7] + (size_t)(kb * 64) * INC + n0, INC, lane);
                t64_store<true>(v, WT_IN + (size_t)(n0 & ~127) * DM + kb * 64, DM, scr, lane, n0 & 127); }
            else if (n0 >= GF_OFF) { f32x4 v[16]; t64_load(v, args.in[7] + (size_t)(kb * 64) * INC + n0, INC, lane);
                t64_store(v, WT_IN + (size_t)n0 * DM + kb * 64, DM, scr, lane);
                t64_store<false, true>(v, (bf16_t*)(ws + WS_WT_G8 + (size_t)(n0 - GF_OFF) * DM + kb * 64), DM, scr, lane); }
            else transpose64(args.in[7] + (size_t)(kb * 64) * INC + n0, INC, WT_IN + (size_t)n0 * DM + kb * 64, DM, scr, lane);
            continue; } r -= IT_IN;
        if (r < IT_FO) { const int kb = r / 32, nb = r % 32; transpose64(args.in[10] + (size_t)(kb * 64) * DM + nb * 64, DM, WT_FO + (size_t)(nb * 64) * YFP + kb * 64, YFP, scr, lane); continue; } r -= IT_FO;
        if (r < IT_AO) { const int kb = r / 32, nb = r % 32; transpose64(args.in[11] + (size_t)(kb * 64) * DM + nb * 64, DM, WT_AO + (size_t)(nb * 64) * DM + kb * 64, DM, scr, lane); continue; } r -= IT_AO;
        if (r < IT_O) { const int kb = r / 32, nb = r % 32; transpose64(args.in[12] + (size_t)(kb * 64) * DM + nb * 64, DM, WT_O + (size_t)(nb * 64) * DM + kb * 64, DM, scr, lane); continue; } r -= IT_O;
        if (r < 2 * IT_SH) { const int up = r >= IT_SH; if (up) r -= IT_SH; const int kb = r / 8, nb = r % 8, n0 = nb * 64;
            { f32x4 v[16]; t64_load(v, (up ? args.in[20] : args.in[19]) + (size_t)(kb * 64) * EFF + n0, EFF, lane);
              t64_store<false, true>(v, (bf16_t*)((unsigned char*)WT_GU + ((size_t)64 * 1024 + (n0 >> 7) * 256 + (up ? 128 : 0) + (n0 & 127)) * DM + kb * 64), DM, scr, lane); } continue; } r -= 2 * IT_SH;
        if (r < IT_SH) { const int kb = r / 32, nb = r % 32;
            { f32x4 v[16]; t64_load(v, args.in[21] + (size_t)(kb * 64) * DM + nb * 64, DM, lane); t64_store<false, true>(v, (bf16_t*)((unsigned char*)WT_D + ((size_t)64 * DM + nb * 64) * EFF + kb * 64), EFF, scr, lane); } continue; } r -= IT_SH;

        if (r < IT_CST) {
            const int k1 = r & 2047; unsigned char* dst = ws + WS_CST + (size_t)r * 2048;
#pragma unroll
            for (int j = 0; j < 4; ++j) { const int n0 = j * 512 + lane * 8; float f[8];
#pragma unroll
                for (int i = 0; i < 8; ++i) { const float ph = (float)((k1 * (n0 + i)) & 4095) * (1.0f / 2048.0f); f[i] = 16.0f * (r < 2048 ? cospif(ph) : sinpif(ph)); }
                int w0 = 0, w1 = 0; w0 = __builtin_amdgcn_cvt_pk_fp8_f32(f[0], f[1], w0, false); w0 = __builtin_amdgcn_cvt_pk_fp8_f32(f[2], f[3], w0, true);
                w1 = __builtin_amdgcn_cvt_pk_fp8_f32(f[4], f[5], w1, false); w1 = __builtin_amdgcn_cvt_pk_fp8_f32(f[6], f[7], w1, true);
                *(GAS unsigned long long*)(dst + n0) = (unsigned long long)(unsigned)w0 | ((unsigned long long)(unsigned)w1 << 32); }
            continue; } r -= IT_CST;
        if (r < IT_BD2) {
            const int t = r >> 8, o = r & 255, gp = o >> 7, k2 = o & 127; bf16_t* dst = (bf16_t*)(ws + WS_BD2) + (size_t)r * 512; float f[8];
#pragma unroll
            for (int i = 0; i < 8; ++i) { const int j = lane * 8 + i, cg = j >> 8, jj = j & 255, c = jj & 127; const float ph = (float)((32 * c * k2) & 4095) * (1.0f / 2048.0f);
                const float v = jj < 128 ? cospif(ph) : (t ? sinpif(ph) : -sinpif(ph)); f[i] = cg == gp ? v * 0.0013810679320049757f : 0.f; }
            u32x4 w; w.x = cvt_pk_bf16(f[0], f[1]); w.y = cvt_pk_bf16(f[2], f[3]); w.z = cvt_pk_bf16(f[4], f[5]); w.w = cvt_pk_bf16(f[6], f[7]);
            *(GAS u32x4*)(dst + lane * 8) = w;
            continue; } r -= IT_BD2;
        if (r >= IT_RWT) {
            float* RT = (float*)(ws + WS_ROPE);
            for (int idx = lane; idx < 64 * 32; idx += 64) { const float ang = (float)(idx >> 5) * exp2f(-(float)(idx & 31) * (13.287712379549449f / 32.0f)); RT[2 * idx] = cosf(ang); RT[2 * idx + 1] = sinf(ang); }
            continue; }
        {
            f32x4 v[16]; t64_load(v, args.in[14] + (size_t)(r * 64) * NE, NE, lane);
            const int kk = lane >> 4, nc = (lane & 15) * 4;
#pragma unroll
            for (int j = 0; j < 16; ++j) {
#pragma unroll
                for (int c = 0; c < 4; ++c) scr[(j * 4 + kk) * 65 + nc + c] = v[j][c]; }
            LDS_WAIT(); asm volatile("" ::: "memory");
            const int kc = lane & 7; bf16_t* RWT = (bf16_t*)(ws + WS_RWT);
#pragma unroll
            for (int jj = 0; jj < 8; ++jj) { const int e = (lane >> 3) + 8 * jj; const LAS float* s = scr + (8 * kc) * 65 + e; float t[8], l[8];
#pragma unroll
                for (int i = 0; i < 8; ++i) { t[i] = s[i * 65]; l[i] = t[i] - bf2f(f2bf(t[i])); }
                u32x4 h, lo; h.x = cvt_pk_bf16(t[0], t[1]); h.y = cvt_pk_bf16(t[2], t[3]); h.z = cvt_pk_bf16(t[4], t[5]); h.w = cvt_pk_bf16(t[6], t[7]);
                lo.x = cvt_pk_bf16(l[0], l[1]); lo.y = cvt_pk_bf16(l[2], l[3]); lo.z = cvt_pk_bf16(l[4], l[5]); lo.w = cvt_pk_bf16(l[6], l[7]);
                *(GAS u32x4*)(RWT + (size_t)e * DM + r * 64 + 8 * kc) = h; *(GAS u32x4*)(RWT + (size_t)(NE + e) * DM + r * 64 + 8 * kc) = lo; }
            LDS_WAIT(); asm volatile("" ::: "memory");
        }
    }
}


__device__ __forceinline__ void conv_addr(const Args& args, unsigned char* ws, bool down, int it, const float*& W, int& ldw, bf16_t*& dst, int& ldd) {
    if (!down) { int r = it; const int up = r >= IT_EG; if (up) r -= IT_EG;
        const int e = r / 256, q = r % 256, kb = q / 8, nb = q % 8, n0 = nb * 64;
        W = (up ? args.in[17] : args.in[16]) + (size_t)e * DM * EFF + (size_t)(kb * 64) * EFF + n0; ldw = EFF;
        dst = (bf16_t*)(ws + WS_WT_GU + ((size_t)e * 1024 + (n0 >> 7) * 256 + (up ? 128 : 0) + (n0 & 127)) * DM + kb * 64); ldd = DM;
    } else { const int r = it, e = r / 256, q = r % 256, kb = q / 32, nb = q % 32;
        W = args.in[18] + (size_t)e * EFF * DM + (size_t)(kb * 64) * DM + nb * 64; ldw = DM;
        dst = (bf16_t*)(ws + WS_WT_D + ((size_t)e * DM + nb * 64) * EFF + kb * 64); ldd = EFF; }
}
__device__ __forceinline__ void conv_items(Frame& F, const Args& args, bool down, int first, int count) {
    LAS float* scr = (LAS float*)(F.lds + F.wave * 16640);
    const int end = first + count; int it = first + F.wave;
    if (it >= end) return;
    f32x4 va[16], vb[16]; const float* W; int ldw; bf16_t* da; bf16_t* db; int ldd;
    conv_addr(args, F.ws, down, it, W, ldw, da, ldd); t64_load(va, W, ldw, F.lane);
    for (;;) {
        const bool hb = it + NWAVES < end;
        if (hb) { conv_addr(args, F.ws, down, it + NWAVES, W, ldw, db, ldd); t64_load(vb, W, ldw, F.lane); }
        t64_store<false, true>(va, da, ldd, scr, F.lane);
        if (!hb) break;
        const bool ha = it + 2 * NWAVES < end;
        if (ha) { conv_addr(args, F.ws, down, it + 2 * NWAVES, W, ldw, da, ldd); t64_load(va, W, ldw, F.lane); }
        t64_store<false, true>(vb, db, ldd, scr, F.lane);
        if (!ha) break;
        it += 2 * NWAVES;
    }
}
struct SchedIn {
    int G, c; unsigned char* ws; int use_ut;
    __device__ __forceinline__ bool next(int i, Unit& u) const {
        const int L = i * G + c; if (L >= 520) return false;
        const char* H = (const char*)(ws + WS_H); const char* WT = (const char*)(ws + WS_WT_IN);
        u.rows = 256; u.aux = 0; u.bjs = HALF; u.pm = 0; u.pn = 0; u.rmin = 0; u.nt = DM / BK; u.keep = 0;
        if (L < 512) {
            int pm, ct; grid_map(L, 32, 16, pm, ct);
            const int row0 = pm * 256, b = row0 / SEQ, t0 = row0 % SEQ;
            u.A = H + (size_t)row0 * DM * 2; u.B = WT + (size_t)ct * 256 * DM * 2;
            if (ct < 4) { u.A = WT + (size_t)ct * 256 * DM * 2; u.B = H + (size_t)row0 * DM * 2;
                          u.C = (char*)(ws + WS_UT) + (((size_t)b * FW + ct * 256) * SEQ + t0) * 2; u.ldc = SEQ; u.mode = 0; }
            else if (ct < 12) { u.C = (char*)(ws + WS_Q) + ((size_t)row0 * DM + (ct - 4) * 256) * 2; u.ldc = DM; u.mode = 5; u.pm = t0; }
            else if (ct < 14) { u.C = (char*)(ws + WS_KALL) + (((size_t)b * SKV + t0) * KVW + (ct - 12) * 256) * 2; u.ldc = KVW; u.mode = 6; u.pm = t0; }
            else { u.C = (char*)(ws + WS_VALL) + (((size_t)b * SKV + t0) * KVW + (ct - 14) * 256) * 2; u.ldc = KVW; u.mode = 0; }
        } else {
            const int l = L - 512, pm = l & 1, ct = l >> 1;
            u.A = H + (size_t)(NTOK + pm * 256) * DM * 2; u.B = WT + (size_t)(K_OFF + ct * 256) * DM * 2;
            if (ct < 2) { u.C = (char*)(ws + WS_KALL) + (((size_t)pm * SKV + SEQ) * KVW + ct * 256) * 2; u.ldc = KVW; u.mode = 7; }
            else        { u.C = (char*)(ws + WS_VALL) + (((size_t)pm * SKV + SEQ) * KVW + (ct - 2) * 256) * 2; u.ldc = KVW; u.mode = 0; }
        }
        return true;
    }
    __device__ __forceinline__ unsigned arow(const Unit&, int) const { return 0u; }
    __device__ __forceinline__ void a_ready(const Unit&) const {}
};
struct SchedGate { int G, c; unsigned char* ws;
    __device__ __forceinline__ bool next(int i, Unit& u) const {
        int g;
        if (G == 256) { if (c < 8 || i >= 2) return false; g = (c - 8) + 248 * i; }
        else { g = i * G + c; if (g >= 496) return false; }
        const int pm = g & 31, gt = g >> 5;
        u.A = (const char*)(ws + WS_H8) + (size_t)pm * 256 * DM; u.B = (const char*)(ws + WS_WT_G8) + (size_t)gt * 256 * DM;
        u.C = (char*)(ws + (gt < 8 ? WS_SGF : WS_SGA)) + ((size_t)pm * 256 * DM + (gt & 7) * 256) * 2; { int md = 2, ld = DM, rw = 256; asm volatile("" : "+s"(md), "+s"(ld), "+s"(rw)); u.ldc = ld; u.mode = md; u.rows = rw; }
        u.aux = 0; u.bjs = HALF; u.pm = pm; u.pn = gt; u.rmin = 0; u.nt = DM / 128; u.keep = 0;
        return true; }
    __device__ __forceinline__ unsigned arow(const Unit&, int) const { return 0u; }
    __device__ __forceinline__ void a_ready(const Unit&) const {} };

__device__ __forceinline__ void unpack8(u32x4 w, float (&f)[8]) {
#pragma unroll
    for (int i = 0; i < 4; ++i) { f[2 * i] = __uint_as_float(w[i] << 16); f[2 * i + 1] = __uint_as_float(w[i] & 0xffff0000u); }
}
struct EpiMerge { const bf16_t* SGF; const bf16_t* SGA; bf16_t* YM;
    __device__ __forceinline__ void operator()(f32x4 (&acc)[2][2][4][2], const Unit& u, int wr, int wc, int fr, int fq) const {
#pragma unroll
        for (int ai = 0; ai < 2; ++ai)
#pragma unroll
            for (int m = 0; m < 4; ++m) { const size_t row = (size_t)u.pm * 256 + ai * HALF + wr * 64 + m * 16 + fr;
#pragma unroll
                for (int bj = 0; bj < 2; ++bj) { const size_t o = row * DM + u.pn * 256 + bj * HALF + wc * 32 + 8 * fq;
                    float ga[8]; unpack8(*(const u32x4*)(SGA + o), ga);
#pragma unroll
                    for (int c = 0; c < 8; ++c) ga[c] = fmaxf(ga[c], 1e-20f);
                    if (u.keep) { float gf[8]; unpack8(*(const u32x4*)(SGF + o), gf);
#pragma unroll
                        for (int c = 0; c < 4; ++c) { acc[ai][bj][m][0][c] *= gf[c] * __builtin_amdgcn_rcpf(ga[c]); acc[ai][bj][m][1][c] *= gf[4 + c] * __builtin_amdgcn_rcpf(ga[4 + c]); }
                    } else { const f32x4 v0 = acc[ai][bj][m][0], v1 = acc[ai][bj][m][1];
                        u32x4 w; w.x = cvt_pk_bf16(ga[0] * v0[0], ga[1] * v0[1]); w.y = cvt_pk_bf16(ga[2] * v0[2], ga[3] * v0[3]); w.z = cvt_pk_bf16(ga[4] * v1[0], ga[5] * v1[1]); w.w = cvt_pk_bf16(ga[6] * v1[2], ga[7] * v1[3]);
                        *(u32x4*)(YM + o) = w; } } }
    } };
struct SchedMerge { int G, c; unsigned char* ws;
    __device__ __forceinline__ bool next(int i, Unit& u) const {
        const int L = (i >> 1) * G + c; if (L >= 256) return false;
        int pm, pn; grid_map(L, 32, 8, pm, pn); const int kb = i & 1;
        u.A = (const char*)(ws + (kb ? WS_YA : WS_YF)) + (size_t)pm * 256 * DM * 2; u.B = (const char*)(ws + (kb ? WS_WT_AO : WS_WT_FO)) + (size_t)pn * 256 * DM * 2;
        u.C = nullptr; u.ldc = DM; u.mode = 0; u.rows = 256; u.aux = 0; u.pm = pm; u.pn = pn; u.bjs = HALF; u.rmin = 0; u.nt = kb ? DM / BK : FW / BK; u.keep = kb ? 0 : 1;
        return true; }
    __device__ __forceinline__ unsigned arow(const Unit&, int) const { return 0u; } };
struct EpiX2 { const float* x; const float* mod; float* X2;
    __device__ __forceinline__ void operator()(f32x4 (&acc)[2][2][4][2], const Unit& u, int wr, int wc, int fr, int fq) const {
        const float* g1 = mod + ((u.pm * 256) / SEQ) * MODC + 2 * DM;
#pragma unroll
        for (int ai = 0; ai < 2; ++ai)
#pragma unroll
            for (int m = 0; m < 4; ++m) { const size_t row = (size_t)u.pm * 256 + ai * HALF + wr * 64 + m * 16 + fr;
#pragma unroll
                for (int bj = 0; bj < 2; ++bj) { const int col = u.pn * 256 + bj * HALF + wc * 32 + 8 * fq; const size_t o = row * DM + col;
#pragma unroll
                    for (int n = 0; n < 2; ++n) { const f32x4 xv = *(const f32x4*)(x + o + 4 * n), gv = *(const f32x4*)(g1 + col + 4 * n); *(f32x4*)(X2 + o + 4 * n) = xv + gv * acc[ai][bj][m][n]; } } }
    } };
__device__ __forceinline__ void act8(const f32x4 (&g)[2], const f32x4 (&up)[2], unsigned& w0, unsigned& w1) {
    f32x4 a[2];
#pragma unroll
    for (int n = 0; n < 2; ++n)
#pragma unroll
        for (int c = 0; c < 4; ++c) { const float x = g[n][c]; a[n][c] = fminf(fmaxf(x * __builtin_amdgcn_rcpf(1.0f + __expf(-x)) * up[n][c], -448.f), 448.f); }
    int x0 = 0, x1 = 0;
    x0 = __builtin_amdgcn_cvt_pk_fp8_f32(a[0][0], a[0][1], x0, false); x0 = __builtin_amdgcn_cvt_pk_fp8_f32(a[0][2], a[0][3], x0, true);
    x1 = __builtin_amdgcn_cvt_pk_fp8_f32(a[1][0], a[1][1], x1, false); x1 = __builtin_amdgcn_cvt_pk_fp8_f32(a[1][2], a[1][3], x1, true);
    w0 = (unsigned)x0; w1 = (unsigned)x1;
}
struct EpiAct {
    __device__ __forceinline__ void operator()(f32x4 (&acc)[2][2][4][2], const Unit& u, int wr, int wc, int fr, int fq) const {
        const int odd = fq & 1;
        unsigned char* base = (unsigned char*)u.C + (size_t)(wr * 64 + odd * 16 + fr) * u.ldc + wc * 32 + 8 * (fq - odd);
        const int r0 = wr * 64 + odd * 16 + fr;
#pragma unroll
        for (int ai = 0; ai < 2; ++ai)
#pragma unroll
            for (int m = 0; m < 4; m += 2) {
                unsigned a0, a1, b0, b1; act8(acc[ai][0][m], acc[ai][1][m], a0, a1); act8(acc[ai][0][m + 1], acc[ai][1][m + 1], b0, b1);
                const auto s0 = __builtin_amdgcn_permlane16_swap(a0, b0, false, false), s1 = __builtin_amdgcn_permlane16_swap(a1, b1, false, false);
                if (r0 + ai * HALF + m * 16 < u.rows) { const u32x4 w = {s0[0], s1[0], s0[1], s1[1]}; *(u32x4*)(base + (size_t)(ai * HALF + m * 16) * u.ldc) = w; } }
    } };

struct SchedGrid {
    int G, c, nM, nN; const char* A; const char* B; char* C; size_t astride, bstride; int ldc, esz, mode, nt;
    __device__ __forceinline__ bool next(int i, Unit& u) const {
        const int L = i * G + c; if (L >= nM * nN) return false;
        int pm, pn; grid_map(L, nM, nN, pm, pn);
        u.A = A + (size_t)pm * astride; u.B = B + (size_t)pn * bstride; u.C = C + ((size_t)pm * 256 * ldc + pn * 256) * esz; u.ldc = ldc; u.mode = mode; u.rows = 256; u.aux = 0; u.pm = pm; u.pn = pn; u.bjs = HALF; u.rmin = 0; u.nt = nt; u.keep = 0;
        return true; }
    __device__ __forceinline__ unsigned arow(const Unit&, int) const { return 0u; } };
struct SchedAG { int G, c; unsigned char* ws;
    __device__ __forceinline__ bool next(int i, Unit& u) const {
        const int L = i * G + c; if (L >= 144) return false;
        u.rows = 256; u.aux = 0; u.rmin = 0; u.nt = DM / 128; u.keep = 0;
        if (L < 128) {
            int pm, pn8; grid_map(L, 16, 8, pm, pn8); const int b = pn8 >> 2, pn = pn8 & 3, sn = pm >> 3, k1t = pm & 7;
            u.A = (const char*)(ws + WS_CST) + (size_t)pm * 256 * 2048; u.B = (const char*)(ws + (sn ? WS_OT : WS_ET)) + ((size_t)b * FW + pn * 256) * 2048;
            u.C = (char*)(ws + WS_TT) + (((size_t)b * 2048 + k1t * 256) * DM + pn * 512 + sn * 128) * 2; u.ldc = DM; u.mode = sn ? 0 : 3; u.pm = k1t; u.pn = b * FW + pn * 256; u.bjs = 256;
        } else {
            const int g = 496 + (L - 128), pm = g & 31, ct = 16 + (g >> 5);
            u.A = (const char*)(ws + WS_H8) + (size_t)pm * 256 * DM; u.B = (const char*)(ws + WS_WT_G8) + (size_t)(ct - 16) * 256 * DM;
            u.C = (char*)(ws + WS_SGA) + ((size_t)pm * 256 * DM + (ct - 24) * 256) * 2; u.ldc = DM; u.mode = 2; u.pm = pm; u.pn = ct; u.bjs = HALF;
        }
        return true; }
    __device__ __forceinline__ unsigned arow(const Unit&, int) const { return 0u; } };
struct SchedF2 { int G, c; unsigned char* ws;
    __device__ __forceinline__ bool next(int i, Unit& u) const {
        const int L = i * G + c; if (L >= 128) return false;
        int pm, q; grid_map(L, 16, 8, pm, q); const int b = pm >> 3, k1t = pm & 7, j = q & 3, mir = q >> 2;
        u.A = (const char*)(ws + WS_TT) + (((size_t)b * 2048 + k1t * 256) * DM + j * 512) * 2; u.B = (const char*)(ws + WS_BD2) + (size_t)mir * 256 * 512 * 2;
        u.mode = 0; u.rows = 256; u.aux = 0; u.pm = pm; u.pn = j; u.bjs = HALF; u.nt = 512 / BK; u.keep = 0;
        if (!mir) { u.C = (char*)(ws + WS_YF) + (((size_t)b * SEQ + k1t * 256) * YFP + j * 256) * 2; u.ldc = YFP; u.rmin = 0; }
        else { u.C = (char*)(ws + WS_YF) + (((size_t)b * SEQ + SEQ - k1t * 256) * YFP + j * 256) * 2; u.ldc = -YFP; u.rmin = k1t == 0 ? 1 : 0; }
        return true; }
    __device__ __forceinline__ unsigned arow(const Unit&, int) const { return 0u; } };
constexpr int SCHT_OFF = LDSCTL_OFF + 1024;
__device__ __forceinline__ void moe_tables(Frame& F, int ncol_tiles) {
    LAS int* T = (LAS int*)(F.lds + SCHT_OFF);
    __syncthreads();
    if (F.tid == 0) { const int* CNT = (const int*)(F.ws + CTL_CNT); int up = 0, of = 0;
        for (int e = 0; e <= NE; ++e) { const int cn = e < NE ? CNT[e * 64] : NTOK; T[e] = up; T[80 + e] = e < NE ? of : NSLOT; T[160 + e] = cn; up += ((cn + 255) >> 8) * ncol_tiles; of += cn; }
        T[NE + 1] = up; }
    __syncthreads();
}
template <int NCT, bool FIRST> struct SchedMoe {
    int G, c; unsigned char* ws; LAS int* T; const int* TOK;
    __device__ __forceinline__ int tl(int i) const { return __builtin_amdgcn_readfirstlane(T[i]); }
    __device__ __forceinline__ bool next(int i, Unit& u) const {
        const int L = i * G + c; if (L >= tl(NE + 1)) return false;
        int lo = 0, hi = NE;
#pragma unroll 1
        while (lo < hi) { const int mid = (lo + hi + 1) >> 1; if (tl(mid) <= L) lo = mid; else hi = mid - 1; }
        const int e = lo, cn = tl(160 + e), ntile = (cn + 255) >> 8, local = L - tl(e), ct = local / ntile, mt = local % ntile, slot0 = tl(80 + e) + mt * 256;
        u.rows = (cn - mt * 256) < 256 ? (cn - mt * 256) : 256; u.aux = slot0; u.pm = mt; u.pn = ct; u.bjs = HALF; u.mode = 0; u.rmin = 0; u.e = e; u.nt = (FIRST ? DM : EFF) / 128; u.keep = 0;
        if (FIRST) { u.A = (const char*)(ws + WS_H2); u.B = (const char*)(ws + WS_WT_GU) + ((size_t)e * 4 + ct) * 256 * DM; u.C = (char*)(ws + WS_ACT) + ((size_t)slot0 * EFF + ct * 128); u.ldc = EFF; }
        else { u.A = (const char*)(ws + WS_ACT) + (size_t)slot0 * EFF; u.B = (const char*)(ws + WS_WT_D) + ((size_t)e * DM + ct * 256) * EFF; u.C = (char*)(ws + WS_YBIG) + ((size_t)slot0 * DM + ct * 256); u.ldc = DM; u.mode = 8; }
        return true; }
    __device__ __forceinline__ unsigned arow(const Unit& u, int r) const { const int rr = u.pm * 256 + (r < u.rows ? r : u.rows - 1); const int tok = u.e < NE ? TOK[u.e * NTOK + rr] : rr; return (unsigned)tok * (unsigned)DM; } };

namespace attn {
using s16x4 = __attribute__((ext_vector_type(4))) short;
using f32x8 = __attribute__((ext_vector_type(8))) float;
constexpr int D = 128, NW = 8, QBLK = 32, KVBLK = 64;
constexpr float SCALE = 0.088388347648318440f;
constexpr float THR = 8.f;
constexpr int LDQ = DM, LDK = KVW, LDO = DM;
constexpr size_t SHM_V = KVBLK * D * 2, SHM_K = KVBLK * D * 2, SHM_ATTN = 2 * SHM_V + 2 * SHM_K + NW * 64 * 4;
#define KSWZ(row, colB) ((row) * 256 + ((colB) ^ (((row) & 7) << 4)))
#define SBAR() __builtin_amdgcn_sched_barrier(0)
__device__ __forceinline__ unsigned cvtpk(float lo, float hi) { unsigned r; asm volatile("v_cvt_pk_bf16_f32 %0, %1, %2" : "=v"(r) : "v"(lo), "v"(hi)); return r; }
__device__ __forceinline__ void partialSM(f32x16& p0, f32x16& p1, float& m_reg, float& mn, float& alpha) {
  constexpr float C = SCALE * 1.4426950408889634f;
  float pmax = p0[0]; for (int r = 1; r < 16; ++r) pmax = fmaxf(pmax, p0[r]); for (int r = 0; r < 16; ++r) pmax = fmaxf(pmax, p1[r]);
  { auto rr = __builtin_amdgcn_permlane32_swap(__float_as_uint(pmax), __float_as_uint(pmax), false, false);
    pmax = fmaxf(__uint_as_float(rr[0]), __uint_as_float(rr[1])); }
  if (__builtin_expect(__all(pmax - m_reg <= THR / SCALE), 1)) { mn = m_reg; alpha = 1.f; }
  else { mn = fmaxf(m_reg, pmax); alpha = __builtin_amdgcn_exp2f((m_reg - mn) * C); m_reg = mn; }
  float mnC = -mn * C;
  for (int r = 0; r < 16; ++r) p0[r] = fmaf(p0[r], C, mnC); for (int r = 0; r < 16; ++r) p1[r] = fmaf(p1[r], C, mnC);
  for (int r = 0; r < 16; ++r) p0[r] = __builtin_amdgcn_exp2f(p0[r]);
}
__device__ __forceinline__ void finishSM(f32x16& p0, f32x16& p1, float alpha, float& l_reg, bf16x8& pa0, bf16x8& pa1, bf16x8& pa2, bf16x8& pa3) {
  for (int r = 0; r < 16; ++r) p1[r] = __builtin_amdgcn_exp2f(p1[r]);
  float ps = 0; for (int r = 0; r < 16; ++r) ps += p0[r]; for (int r = 0; r < 16; ++r) ps += p1[r];
  { auto rr = __builtin_amdgcn_permlane32_swap(__float_as_uint(ps), __float_as_uint(ps), false, false);
    ps = __uint_as_float(rr[0]) + __uint_as_float(rr[1]); }
  l_reg = l_reg * alpha + ps;
#define PK4(P, BASE, OUT) do { unsigned a0 = cvtpk(P[BASE + 0], P[BASE + 1]), a1 = cvtpk(P[BASE + 2], P[BASE + 3]);   \
    unsigned b0 = cvtpk(P[BASE + 4], P[BASE + 5]), b1 = cvtpk(P[BASE + 6], P[BASE + 7]);                              \
    auto r0 = __builtin_amdgcn_permlane32_swap(a0, b0, false, false); auto r1 = __builtin_amdgcn_permlane32_swap(a1, b1, false, false); \
    u32x4 w = {r0[0], r1[0], r0[1], r1[1]}; OUT = *reinterpret_cast<bf16x8*>(&w); } while (0)
  PK4(p0, 0, pa0); PK4(p0, 8, pa1); PK4(p1, 0, pa2); PK4(p1, 8, pa3);
#undef PK4
}
__device__ __forceinline__ void qkt(f32x16& p0, f32x16& p1, const bf16_t* Ks, const bf16x8* qr, int r32, int hi) {
  p0 = f32x16{}; p1 = f32x16{};
  for (int d0 = 0; d0 < 8; ++d0) { int cb = (d0 * 16 + hi * 8) * 2;
    bf16x8 b0 = *reinterpret_cast<const bf16x8*>((const char*)Ks + KSWZ(r32, cb));
    bf16x8 b1 = *reinterpret_cast<const bf16x8*>((const char*)Ks + KSWZ(32 + r32, cb));
    p0 = __builtin_amdgcn_mfma_f32_32x32x16_bf16(b0, qr[d0], p0, 0, 0, 0);
    p1 = __builtin_amdgcn_mfma_f32_32x32x16_bf16(b1, qr[d0], p1, 0, 0, 0); }
}
__device__ __forceinline__ int v_st(int k, int c) { const int kk = (k & ~0xC) | ((k & 4) << 1) | ((k & 8) >> 1); return ((kk >> 3) * 4 + (c >> 5)) * 512 + ((kk & 7) * 32 + (c & 31)) * 2; }
__device__ __forceinline__ int v_rd_base(int lane) { return ((lane & 3) << 3) | (((lane >> 2) & 3) << 6) | (((lane >> 4) & 1) << 5) | (((lane >> 5) & 1) << 8); }
constexpr int v_rd_off(int d0, int ks, int half) { return d0 * 512 + ks * 4096 + half * 2048; }
template <int OFF> __device__ __forceinline__ s16x4 tr_read(int vb) {
  s16x4 r; asm volatile("ds_read_b64_tr_b16 %0, %1 offset:%2" : "=&v"(r) : "v"(vb), "i"(OFF) : "memory"); return r;
}
template <int D0> __device__ __forceinline__ void pv_one(f32x16& od, int vb, bf16x8 pa0, bf16x8 pa1, bf16x8 pa2, bf16x8 pa3) {
  const s16x4 l0 = tr_read<v_rd_off(D0, 0, 0)>(vb), h0 = tr_read<v_rd_off(D0, 0, 1)>(vb), l1 = tr_read<v_rd_off(D0, 1, 0)>(vb), h1 = tr_read<v_rd_off(D0, 1, 1)>(vb);
  const s16x4 l2 = tr_read<v_rd_off(D0, 2, 0)>(vb), h2 = tr_read<v_rd_off(D0, 2, 1)>(vb), l3 = tr_read<v_rd_off(D0, 3, 0)>(vb), h3 = tr_read<v_rd_off(D0, 3, 1)>(vb);
  asm volatile("s_waitcnt lgkmcnt(0)" ::: "memory"); SBAR();
#define PK(L, H) (bf16x8){L[0], L[1], L[2], L[3], H[0], H[1], H[2], H[3]}
  od = __builtin_amdgcn_mfma_f32_32x32x16_bf16(pa0, PK(l0, h0), od, 0, 0, 0);
  od = __builtin_amdgcn_mfma_f32_32x32x16_bf16(pa1, PK(l1, h1), od, 0, 0, 0);
  od = __builtin_amdgcn_mfma_f32_32x32x16_bf16(pa2, PK(l2, h2), od, 0, 0, 0);
  od = __builtin_amdgcn_mfma_f32_32x32x16_bf16(pa3, PK(l3, h3), od, 0, 0, 0);
#undef PK
}
__device__ __forceinline__ void pv_d0(f32x16* o, int vb, bf16x8 pa0, bf16x8 pa1, bf16x8 pa2, bf16x8 pa3) {
  pv_one<0>(o[0], vb, pa0, pa1, pa2, pa3); pv_one<1>(o[1], vb, pa0, pa1, pa2, pa3); pv_one<2>(o[2], vb, pa0, pa1, pa2, pa3); pv_one<3>(o[3], vb, pa0, pa1, pa2, pa3);
}
__device__ __forceinline__ void attn_dense_body(const bf16_t* __restrict__ Qb, const bf16_t* __restrict__ Kh, const bf16_t* __restrict__ Vh, bf16_t* __restrict__ Ob, int seq, char* lds) {
  const int tid = threadIdx.x, wid = tid >> 6, lane = tid & 63, r32 = lane & 31, hi = lane >> 5;
  bf16_t* V_lds = (bf16_t*)lds; bf16_t* K_lds = (bf16_t*)(lds + 2 * SHM_V);
  float* ws = (float*)(lds + 2 * SHM_V + 2 * SHM_K) + wid * 64; float* li_l = ws; float* al_l = ws + 32;
  float m_reg = -1e30f, l_reg = 0; f32x16 o[4] = {}; bf16x8 qr[8];
  const bf16_t* Qw = Qb + (long)(wid * QBLK + r32) * LDQ + hi * 8;
#pragma unroll
  for (int d0 = 0; d0 < 8; ++d0) qr[d0] = *reinterpret_cast<const bf16x8*>(Qw + d0 * 16);
  const int sr = tid >> 4, sc = (tid & 15) * 8, vst0 = v_st(sr, sc), vst1 = v_st(32 + sr, sc);
  const int vb0 = (int)(uintptr_t)V_lds + v_rd_base(lane);
  struct { bf16x8 vs0, vs1, ks0, ks1; } sr_[2];
#define SLOAD(i, k0) do { sr_[i].vs0 = *reinterpret_cast<const bf16x8*>(&Vh[(long)((k0) + sr) * LDK + sc]); sr_[i].vs1 = *reinterpret_cast<const bf16x8*>(&Vh[(long)((k0) + 32 + sr) * LDK + sc]); \
    sr_[i].ks0 = *reinterpret_cast<const bf16x8*>(&Kh[(long)((k0) + sr) * LDK + sc]); sr_[i].ks1 = *reinterpret_cast<const bf16x8*>(&Kh[(long)((k0) + 32 + sr) * LDK + sc]); } while (0)
#define SWRITE(b, i) do { *(bf16x8*)((char*)V_lds + (b) * SHM_V + vst0) = sr_[i].vs0;          \
    *(bf16x8*)((char*)V_lds + (b) * SHM_V + vst1) = sr_[i].vs1; int kc = sc * 2;               \
    *(bf16x8*)((char*)K_lds + (b) * SHM_K + KSWZ(sr, kc)) = sr_[i].ks0;                       \
    *(bf16x8*)((char*)K_lds + (b) * SHM_K + KSWZ(32 + sr, kc)) = sr_[i].ks1; } while (0)
#define SWAIT() asm volatile("s_waitcnt vmcnt(4)" ::: "memory")
#define RESC(a) do { if (__any((a) < 1.f)) { if (hi == 0) al_l[r32] = (a); asm volatile("s_waitcnt lgkmcnt(0)" ::: "memory"); \
    for (int d = 0; d < 4; ++d) for (int r = 0; r < 16; ++r) o[d][r] *= al_l[crow(r, hi)]; } } while (0)
  f32x16 pA0, pA1, pB0, pB1; float mnA, mnB, alA, alB; bf16x8 pa0, pa1, pa2, pa3; const int NT = seq / KVBLK;
  constexpr int SE = 0, SO = 1;
  SLOAD(SE, 0); asm volatile("s_waitcnt vmcnt(0)" ::: "memory"); SWRITE(0, SE); __syncthreads();
  qkt(pA0, pA1, K_lds, qr, r32, hi); partialSM(pA0, pA1, m_reg, mnA, alA);
  SLOAD(SO, KVBLK); if (2 < NT) SLOAD(SE, 2 * KVBLK);
  SWAIT(); SWRITE(1, SO); __syncthreads();
  for (int j = 1; j + 1 < NT; j += 2) {
    SBAR(); qkt(pB0, pB1, (bf16_t*)((char*)K_lds + SHM_K), qr, r32, hi);
    finishSM(pA0, pA1, alA, l_reg, pa0, pa1, pa2, pa3); SBAR();
    SLOAD(SO, (j + 2) * KVBLK); SBAR();
    pv_d0(o, vb0, pa0, pa1, pa2, pa3); partialSM(pB0, pB1, m_reg, mnB, alB);
    __syncthreads(); SWAIT(); SWRITE(0, SE);
    RESC(alB); __syncthreads();
    SBAR(); qkt(pA0, pA1, K_lds, qr, r32, hi);
    finishSM(pB0, pB1, alB, l_reg, pa0, pa1, pa2, pa3); SBAR();
    if (j + 3 < NT) SLOAD(SE, (j + 3) * KVBLK); SBAR();
    pv_d0(o, vb0 + (int)SHM_V, pa0, pa1, pa2, pa3); partialSM(pA0, pA1, m_reg, mnA, alA);
    __syncthreads(); SWAIT(); SWRITE(1, SO);
    RESC(alA); __syncthreads();
  }
  SBAR(); qkt(pB0, pB1, (bf16_t*)((char*)K_lds + SHM_K), qr, r32, hi);
  finishSM(pA0, pA1, alA, l_reg, pa0, pa1, pa2, pa3); SBAR();
  pv_d0(o, vb0, pa0, pa1, pa2, pa3); partialSM(pB0, pB1, m_reg, mnB, alB);
  __syncthreads(); RESC(alB);
  finishSM(pB0, pB1, alB, l_reg, pa0, pa1, pa2, pa3); SBAR();
  pv_d0(o, vb0 + (int)SHM_V, pa0, pa1, pa2, pa3);
  if (hi == 0) li_l[r32] = l_reg; asm volatile("s_waitcnt lgkmcnt(0)" ::: "memory");
  float rli[16];
#pragma unroll
  for (int r = 0; r < 16; ++r) rli[r] = __builtin_amdgcn_rcpf(li_l[crow(r, hi)]);
  typedef __attribute__((address_space(3))) unsigned char lds8_t;
  lds8_t* ost = (lds8_t*)(lds + SHM_ATTN + wid * 8192);
  lds8_t* wbase = ost + hi * 1024 + r32 * 2;
#pragma unroll
  for (int d0 = 0; d0 < 4; ++d0)
#pragma unroll
    for (int r = 0; r < 16; r += 2) { const unsigned w = cvtpk(o[d0][r] * rli[r], o[d0][r + 1] * rli[r + 1]);
      *(__attribute__((address_space(3))) unsigned short*)(wbase + (((r & 3) + 8 * (r >> 2)) * 256 + d0 * 64)) = (unsigned short)w;
      *(__attribute__((address_space(3))) unsigned short*)(wbase + ((((r + 1) & 3) + 8 * ((r + 1) >> 2)) * 256 + d0 * 64)) = (unsigned short)(w >> 16); }
  asm volatile("s_waitcnt lgkmcnt(0)" ::: "memory");
  bf16_t* Ow = Ob + (long)(wid * QBLK) * LDO;
  { const lds8_t* rbase = ost + (lane >> 4) * 256 + (lane & 15) * 16; bf16_t* gbase = Ow + (long)(lane >> 4) * LDO + (lane & 15) * 8;
#pragma unroll
    for (int j = 0; j < 8; ++j) { const u32x4 v = *(const __attribute__((address_space(3))) u32x4*)(rbase + j * 1024); *(u32x4*)(gbase + (long)(j * 4) * LDO) = v; } }
  asm volatile("s_waitcnt lgkmcnt(0)" ::: "memory");
#undef SLOAD
#undef SWRITE
#undef SWAIT
#undef RESC
}
#undef KSWZ
#undef SBAR
}

__device__ __forceinline__ void ph_norm1(Frame& F, const Args& args, const float* mod) {
    const int gw = F.vcu * NWAVES + F.wave, NGW = F.G * NWAVES, lane = F.lane;
    bf16_t* H = (bf16_t*)(F.ws + WS_H); const float* nw = args.in[6];
    for (int row = gw; row < NTOK + NCTX; row += NGW) {
        const float* src = row < NTOK ? args.in[0] + (size_t)row * DM : args.in[2] + (size_t)(row - NTOK) * DM;
        const float* mr = mod + (row < NTOK ? row / SEQ : 2) * MODC;
        f32x4 v[8]; float ss = 0.f;
#pragma unroll
        for (int j = 0; j < 8; ++j) { v[j] = *(const GAS f32x4*)(src + (j * 64 + lane) * 4); ss += v[j].x * v[j].x + v[j].y * v[j].y + v[j].z * v[j].z + v[j].w * v[j].w; }
        ss = wave_sum(ss);
        const float rstd = 1.0f / sqrtf(ss * (1.0f / DM) + 1e-6f);
#pragma unroll
        for (int j = 0; j < 8; ++j) { const int i = (j * 64 + lane) * 4;
            const f32x4 w = *(const GAS f32x4*)(nw + i), sc = *(const GAS f32x4*)(mr + DM + i), sh = *(const GAS f32x4*)(mr + i);
            const f32x4 h = v[j] * rstd * w * (sc + 1.0f) + sh;
            unsigned lo = cvt_pk_bf16(h[0], h[1]), hi = cvt_pk_bf16(h[2], h[3]);
            *(GAS unsigned long long*)(H + (size_t)row * DM + i) = (unsigned long long)lo | ((unsigned long long)hi << 32);
            if (row < NTOK) { int w8 = 0; w8 = __builtin_amdgcn_cvt_pk_fp8_f32(fminf(fmaxf(h[0], -448.f), 448.f), fminf(fmaxf(h[1], -448.f), 448.f), w8, false);
                w8 = __builtin_amdgcn_cvt_pk_fp8_f32(fminf(fmaxf(h[2], -448.f), 448.f), fminf(fmaxf(h[3], -448.f), 448.f), w8, true);
                *(GAS unsigned*)(F.ws + WS_H8 + (size_t)row * DM + i) = (unsigned)w8; } }
    }
}
__device__ __forceinline__ void ph_evenodd(Frame& F, const Args& args) {
    const int gw = F.vcu * NWAVES + F.wave, NGW = F.G * NWAVES, lane = F.lane;
    LAS bf16_t* scr = (LAS bf16_t*)(F.lds + F.wave * 16640);
    const bf16_t* UT = (const bf16_t*)(F.ws + WS_UT); unsigned char* ET = F.ws + WS_ET; unsigned char* OT = F.ws + WS_OT;
    float* W2 = (float*)(F.ws + WS_W2048); float* AL = (float*)(F.ws + WS_ALT);
    for (int row = gw; row < 2 * FW; row += NGW) {
        const bf16_t* src = UT + (size_t)row * SEQ; float alt = 0.f;
#pragma unroll
        for (int j = 0; j < 8; ++j) { const u32x4 w = *(const GAS u32x4*)(src + (j * 64 + lane) * 8); *(LAS u32x4*)(scr + (j * 64 + lane) * 8) = w;
            float f[8]; unpack8(w, f); alt += (f[0] - f[1]) + (f[2] - f[3]) + (f[4] - f[5]) + (f[6] - f[7]); }
        alt = wave_sum(alt);
        LDS_WAIT(); asm volatile("" ::: "memory");
        if (lane == 0) { AL[row] = alt; W2[row] = bf2f(scr[SEQ / 2]); }
#pragma unroll
        for (int j = 0; j < 4; ++j) { const int n0 = (j * 64 + lane) * 8; float e[8], o[8];
#pragma unroll
            for (int i = 0; i < 8; ++i) { const int n = n0 + i; const float a = bf2f(scr[n]), bb = bf2f(scr[(SEQ - n) & (SEQ - 1)]); e[i] = n == 0 ? a : a + bb; o[i] = n == 0 ? 0.f : a - bb; }
#pragma unroll
            for (int i = 0; i < 8; ++i) { e[i] = fminf(fmaxf(e[i], -448.f), 448.f); o[i] = fminf(fmaxf(o[i], -448.f), 448.f); }
            int e0 = 0, e1 = 0, o0 = 0, o1 = 0;
            e0 = __builtin_amdgcn_cvt_pk_fp8_f32(e[0], e[1], e0, false); e0 = __builtin_amdgcn_cvt_pk_fp8_f32(e[2], e[3], e0, true); e1 = __builtin_amdgcn_cvt_pk_fp8_f32(e[4], e[5], e1, false); e1 = __builtin_amdgcn_cvt_pk_fp8_f32(e[6], e[7], e1, true);
            o0 = __builtin_amdgcn_cvt_pk_fp8_f32(o[0], o[1], o0, false); o0 = __builtin_amdgcn_cvt_pk_fp8_f32(o[2], o[3], o0, true); o1 = __builtin_amdgcn_cvt_pk_fp8_f32(o[4], o[5], o1, false); o1 = __builtin_amdgcn_cvt_pk_fp8_f32(o[6], o[7], o1, true);
            *(GAS unsigned long long*)(ET + (size_t)row * 2048 + n0) = (unsigned long long)(unsigned)e0 | ((unsigned long long)(unsigned)e1 << 32);
            *(GAS unsigned long long*)(OT + (size_t)row * 2048 + n0) = (unsigned long long)(unsigned)o0 | ((unsigned long long)(unsigned)o1 << 32); }
        LDS_WAIT(); asm volatile("" ::: "memory");
    }
}
__device__ __forceinline__ void ph_route(Frame& F, const Args& args, const float* mod) {
    const int lane = F.lane, wv = F.wave, r32 = lane & 31, hi = lane >> 5;
    LAS float* rs = (LAS float*)F.lds;
    LAS float* part = (LAS float*)(F.lds + 1024);
    LAS int* lcnt = (LAS int*)(F.lds + 1024 + 65536);
    LAS int* lbase = lcnt + 64;
    LAS int* lent = lcnt + 128;
    const float* X2 = (const float*)(F.ws + WS_X2); const float* nw = args.in[13]; const float* rb = args.in[15];
    const bf16_t* RWT = (const bf16_t*)(F.ws + WS_RWT);
    bf16_t* H2 = (bf16_t*)(F.ws + WS_H2); int* EIDX = (int*)(F.ws + WS_EIDX); float* EW = (float*)(F.ws + WS_EW); int* EPOS = (int*)(F.ws + WS_EPOS); int* CNT = (int*)(F.ws + CTL_CNT); int* TOKE = (int*)(F.ws + WS_TOKE);
    if (F.tid < NE) lcnt[F.tid] = 0;
    __syncthreads();
    int nb = 0;
    for (int blk = F.vcu; blk < NTOK / 32; blk += F.G, ++nb) {
        const int row0 = blk * 32; const float* mr = mod + (row0 / SEQ) * MODC;
#pragma unroll
        for (int i = 0; i < 4; ++i) { const float* src = X2 + (size_t)(row0 + wv * 4 + i) * DM; float ss = 0.f;
#pragma unroll
            for (int j = 0; j < 8; ++j) { const f32x4 v = *(const GAS f32x4*)(src + (j * 64 + lane) * 4); ss += v.x * v.x + v.y * v.y + v.z * v.z + v.w * v.w; }
            ss = wave_sum(ss);
            if (lane == 0) rs[wv * 4 + i] = 1.0f / sqrtf(ss * (1.0f / DM) + 1e-6f); }
        __syncthreads();
        { const float rstd = rs[r32]; const float* xr = X2 + (size_t)(row0 + r32) * DM; unsigned char* hr = (unsigned char*)H2 + (size_t)(row0 + r32) * DM;
          f32x16 acc0 = {}, acc1 = {};
#pragma unroll 4
          for (int ks = 0; ks < 16; ++ks) { const int k = wv * 256 + ks * 16 + hi * 8;
              float h[8];
#pragma unroll
              for (int q = 0; q < 2; ++q) { const f32x4 x = *(const GAS f32x4*)(xr + k + 4 * q), w = *(const GAS f32x4*)(nw + k + 4 * q), sc = *(const GAS f32x4*)(mr + 4 * DM + k + 4 * q), sh = *(const GAS f32x4*)(mr + 3 * DM + k + 4 * q);
                  const f32x4 t = x * rstd * w * (sc + 1.0f) + sh; h[4 * q] = t[0]; h[4 * q + 1] = t[1]; h[4 * q + 2] = t[2]; h[4 * q + 3] = t[3]; }
              u32x4 wh, wl; float l[8];
              wh.x = cvt_pk_bf16(h[0], h[1]); wh.y = cvt_pk_bf16(h[2], h[3]); wh.z = cvt_pk_bf16(h[4], h[5]); wh.w = cvt_pk_bf16(h[6], h[7]);
#pragma unroll
              for (int i = 0; i < 4; ++i) { l[2 * i] = h[2 * i] - __uint_as_float(wh[i] << 16); l[2 * i + 1] = h[2 * i + 1] - __uint_as_float(wh[i] & 0xffff0000u); }
              wl.x = cvt_pk_bf16(l[0], l[1]); wl.y = cvt_pk_bf16(l[2], l[3]); wl.z = cvt_pk_bf16(l[4], l[5]); wl.w = cvt_pk_bf16(l[6], l[7]);
              { float hc[8];
#pragma unroll
                for (int i = 0; i < 8; ++i) hc[i] = fminf(fmaxf(h[i], -448.f), 448.f);
                int w0 = 0, w1 = 0; w0 = __builtin_amdgcn_cvt_pk_fp8_f32(hc[0], hc[1], w0, false); w0 = __builtin_amdgcn_cvt_pk_fp8_f32(hc[2], hc[3], w0, true);
                w1 = __builtin_amdgcn_cvt_pk_fp8_f32(hc[4], hc[5], w1, false); w1 = __builtin_amdgcn_cvt_pk_fp8_f32(hc[6], hc[7], w1, true);
                *(GAS unsigned long long*)(hr + k) = (unsigned long long)(unsigned)w0 | ((unsigned long long)(unsigned)w1 << 32); }
              const bf16x8 ah = __builtin_bit_cast(bf16x8, wh), al = __builtin_bit_cast(bf16x8, wl);
              const bf16x8 bh0 = *(const GAS bf16x8*)(RWT + (size_t)r32 * DM + k), bh1 = *(const GAS bf16x8*)(RWT + (size_t)(32 + r32) * DM + k);
              const bf16x8 bl0 = *(const GAS bf16x8*)(RWT + (size_t)(NE + r32) * DM + k), bl1 = *(const GAS bf16x8*)(RWT + (size_t)(NE + 32 + r32) * DM + k);
              acc0 = __builtin_amdgcn_mfma_f32_32x32x16_bf16(ah, bh0, acc0, 0, 0, 0); acc0 = __builtin_amdgcn_mfma_f32_32x32x16_bf16(ah, bl0, acc0, 0, 0, 0); acc0 = __builtin_amdgcn_mfma_f32_32x32x16_bf16(al, bh0, acc0, 0, 0, 0);
              acc1 = __builtin_amdgcn_mfma_f32_32x32x16_bf16(ah, bh1, acc1, 0, 0, 0); acc1 = __builtin_amdgcn_mfma_f32_32x32x16_bf16(ah, bl1, acc1, 0, 0, 0); acc1 = __builtin_amdgcn_mfma_f32_32x32x16_bf16(al, bh1, acc1, 0, 0, 0); }
#pragma unroll
          for (int r = 0; r < 16; ++r) { part[(wv * 32 + crow(r, hi)) * 64 + r32] = acc0[r]; part[(wv * 32 + crow(r, hi)) * 64 + 32 + r32] = acc1[r]; } }
        __syncthreads();
        for (int i = 0; i < 4; ++i) { const int rbk = wv * 4 + i, row = row0 + rbk; float logit = 0.f;
#pragma unroll
          for (int w = 0; w < 8; ++w) logit += part[(w * 32 + rbk) * 64 + lane];
          const float score = 1.0f / (1.0f + expf(-logit)), bsd = score + rb[lane];
          const int g = lane >> 3;
          int rk = 0;
#pragma unroll
          for (int q = 0; q < 8; ++q) { const int o = (lane & ~7) + q; const float vv = __shfl(bsd, o); rk += (vv > bsd) || (vv == bsd && o < lane); }
          float gs = rk < 2 ? bsd : 0.f;
          gs += __shfl_xor(gs, 1); gs += __shfl_xor(gs, 2); gs += __shfl_xor(gs, 4);
          int grk = 0;
#pragma unroll
          for (int gg = 0; gg < 8; ++gg) { const float vv = __shfl(gs, gg * 8); grk += (vv > gs) || (vv == gs && gg < g); }
          const bool gsel = grk < 4;
          const float mb = gsel ? bsd : -INFINITY;
          int erk = 0;
          for (int o = 0; o < 64; ++o) { const float vv = __shfl(mb, o); erk += (vv > mb) || (vv == mb && o < lane); }
          const bool sel = gsel && erk < TOPK;
          const float ssum = wave_sum(sel ? score : 0.f);
          if (sel) { const int lp = __hip_atomic_fetch_add(lcnt + lane, 1, __ATOMIC_RELAXED, __HIP_MEMORY_SCOPE_WORKGROUP);
                     EIDX[row * TOPK + erk] = lane; EW[row * TOPK + erk] = score / ssum * 2.5f; lent[(nb * 32 + rbk) * TOPK + erk] = (lane << 16) | lp; } }
        __syncthreads();
    }
    if (F.tid < NE) { const int c = lcnt[F.tid]; lbase[F.tid] = c ? atomicAdd(&CNT[F.tid * 64], c) : 0; }
    __syncthreads();
    int it0 = F.tid; asm volatile("" : "+v"(it0));
    for (int i = it0; i < nb * 256; i += NTHREADS) { const int blk = F.vcu + (i >> 8) * F.G, row = blk * 32 + ((i >> 3) & 31), v = lent[i]; const int pos = lbase[v >> 16] + (v & 0xffff); EPOS[row * TOPK + (i & 7)] = pos; TOKE[(v >> 16) * NTOK + pos] = row; }
    __syncthreads();
}
__device__ __forceinline__ void y16(const unsigned char* p, float (&f)[16]) {
    const u32x4 w = *(const GAS u32x4*)p;
#pragma unroll
    for (int i = 0; i < 4; ++i) { const auto lo = __builtin_amdgcn_cvt_pk_f32_fp8((int)w[i], false), hi = __builtin_amdgcn_cvt_pk_f32_fp8((int)w[i], true); f[4 * i] = lo[0]; f[4 * i + 1] = lo[1]; f[4 * i + 2] = hi[0]; f[4 * i + 3] = hi[1]; }
}
__device__ __forceinline__ void ph_comb(Frame& F, const Args& args, const float* mod) {
    const int gw = F.vcu * NWAVES + F.wave, NGW = F.G * NWAVES, lane = F.lane;
    moe_tables(F, 4);
    LAS int* T = (LAS int*)(F.lds + SCHT_OFF);
    const float* EW = (const float*)(F.ws + WS_EW); const int* EIDX = (const int*)(F.ws + WS_EIDX); const int* EPOS = (const int*)(F.ws + WS_EPOS); const unsigned char* Y = (const unsigned char*)(F.ws + WS_YBIG);
    for (int t = gw; t < NTOK; t += NGW) {
        const float* g2 = mod + (t / SEQ) * MODC + 5 * DM;
        int sl[TOPK]; float wk[TOPK];
#pragma unroll
        for (int k = 0; k < TOPK; ++k) { sl[k] = T[80 + EIDX[t * TOPK + k]] + EPOS[t * TOPK + k]; wk[k] = EW[t * TOPK + k]; }
#pragma unroll
        for (int j = 0; j < 2; ++j) { const int col = j * 1024 + lane * 16;
            float a[16]; y16(Y + (size_t)(NSLOT + t) * DM + col, a);
#pragma unroll
            for (int k = 0; k < TOPK; ++k) { float y[16]; y16(Y + (size_t)sl[k] * DM + col, y);
#pragma unroll
                for (int c = 0; c < 16; ++c) a[c] += wk[k] * y[c]; }
            float* o = args.out + (size_t)t * DM + col; const float* xi = (const float*)(F.ws + WS_X2) + (size_t)t * DM + col;
#pragma unroll
            for (int n = 0; n < 4; ++n) { const f32x4 xv = *(const GAS f32x4*)(xi + 4 * n), gv = *(const GAS f32x4*)(g2 + col + 4 * n);
                *(GAS f32x4*)(o + 4 * n) = xv + gv * (f32x4){a[4 * n], a[4 * n + 1], a[4 * n + 2], a[4 * n + 3]}; } }
    }
}

enum { PH_PRO = 0, PH_NORM1, PH_INPROJ, PH_QKNORM, PH_ATTN, PH_F2, PH_MERGE, PH_OUT, PH_ROUTE, PH_EXP1, PH_EXP2, PH_COMB, PH_END };


__global__ void __launch_bounds__(NTHREADS, 2) fwd(Args args) {
    extern __shared__ __attribute__((aligned(16))) unsigned char lds_raw[];
    Frame F;
    F.lds = (LAS unsigned char*)lds_raw; F.MISC = (volatile LAS unsigned*)(F.lds + MISC_OFF); F.ws = args.ws;
    F.tid = threadIdx.x; F.lane = F.tid & 63; F.wave = __builtin_amdgcn_readfirstlane(F.tid >> 6);
    F.G = gridDim.x; { const int bx = blockIdx.x; F.vcu = (F.G % 8 == 0) ? (bx % 8) * (F.G / 8) + bx / 8 : bx; }
    for (int u = F.tid; u < (LDS_BYTES - LDSCTL_OFF) / 4; u += NTHREADS) ((LAS unsigned*)(F.lds + LDSCTL_OFF))[u] = 0u;
    __syncthreads();
    const int lo = args.ph_lo, hi = args.ph_hi;
    const bool multi = (hi - lo) > 1;
    unsigned* barw = (unsigned*)(args.ws + CTL_BAR) + args.bar_idx * XCD_BAR_WORDS;
    XcdBarrier bar; bar.bar = barw; bar.x = 0; bar.st = nullptr;
    if (multi) bar = xcd_barrier_post(barw, F.MISC + 8);
#define IN(k) (lo <= (k) && (k) < hi)
#define SEAM(k) do { if (IN((k) + 1)) xcd_barrier(bar); } while (0)

    const float* modp = (const float*)(args.ws + args.mod_off);
    if (IN(PH_PRO)) { p0_prologue(F, args); SEAM(PH_PRO); }
    if (IN(PH_NORM1)) { ph_norm1(F, args, modp); SEAM(PH_NORM1); }
    if (IN(PH_INPROJ)) {
        { SchedIn S{F.G, (int)blockIdx.x, args.ws, args.use_ut};
          EpiIn E{EpiStore{(const float*)(args.ws + WS_W2048)}, (LAS float*)(F.lds + GPARK_OFF), args.in[8], args.in[9], (const float*)(args.ws + WS_ROPE)};
          gemm_phase<EpiIn, SchedIn, false>(F.lds, DM, DM, DM, S, E); }
        { SchedGate S{F.G, (int)blockIdx.x, args.ws};
          gemm_phase<EpiStore, SchedGate, false, true>(F.lds, DM, DM / 2, DM / 2, S, EpiStore{(const float*)(args.ws + WS_W2048)}); }
        SEAM(PH_INPROJ);
    }
    if (IN(PH_QKNORM)) { ph_evenodd(F, args); SEAM(PH_QKNORM); }
    if (IN(PH_ATTN)) {
        const int cs = F.vcu & 3;
        constexpr int NCONV = IT_EG + IT_EU + IT_ED;
        int qfirst, qcnt; { const int c = (int)blockIdx.x; if (F.G == 256) { qfirst = c < 144 ? c * 178 : 144 * 178 + (c - 144) * 210; qcnt = c < 144 ? 178 : 210; }
                             else { const int per = (NCONV + F.G - 1) / F.G; qfirst = c * per; qcnt = qfirst + per <= NCONV ? per : (NCONV - qfirst > 0 ? NCONV - qfirst : 0); } }
        const int gcnt = qfirst < IT_EG + IT_EU ? (qfirst + qcnt <= IT_EG + IT_EU ? qcnt : IT_EG + IT_EU - qfirst) : 0, gfirst = qfirst;
        const int ccnt = qcnt - gcnt, cfirst = qfirst + gcnt - (IT_EG + IT_EU);
#define CONV_ALL() do { conv_items(F, args, false, gfirst, gcnt); conv_items(F, args, true, cfirst, ccnt); } while (0)
        const bf16_t* Qp = (const bf16_t*)(args.ws + WS_Q); const bf16_t* Kp = (const bf16_t*)(args.ws + WS_KALL); const bf16_t* Vp = (const bf16_t*)(args.ws + WS_VALL); bf16_t* Op = (bf16_t*)(args.ws + WS_YA);
#define ATTN_UNIT(lin_) do { const int lin = (lin_); if (lin < 512) { const int x = (lin >> 5) & 7, j = (lin & 31) + 32 * (lin >> 8), b = x >> 2, kvh = x & 3, head = kvh * 4 + (j >> 4), qb = j & 15; \
            const size_t qo = ((size_t)(b * SEQ + qb * 256)) * DM + head * HD, ko = (size_t)b * SKV * KVW + kvh * HD; \
            attn::attn_dense_body(Qp + qo, Kp + ko, Vp + ko, Op + qo, SKV, (char*)lds_raw); __syncthreads(); } } while (0)
        if (cs == 0) { CONV_ALL(); __syncthreads(); }
        ATTN_UNIT(F.vcu);
        if (cs == 1) { CONV_ALL(); __syncthreads(); }
        ATTN_UNIT(F.vcu + F.G);
        for (int lin2 = F.vcu + 2 * F.G; lin2 < 512; lin2 += F.G) ATTN_UNIT(lin2);
        if (cs == 2) { CONV_ALL(); __syncthreads(); }
#undef ATTN_UNIT
        SchedAG S{F.G, (int)blockIdx.x, args.ws};
        gemm_phase<EpiStore, SchedAG, false, true>(F.lds, DM, DM / 2, DM / 2, S, EpiStore{(const float*)(args.ws + WS_W2048)});
        if (cs == 3) { __syncthreads(); CONV_ALL(); }
#undef CONV_ALL
        SEAM(PH_ATTN);
    }
    if (IN(PH_F2)) {
        SchedF2 S{F.G, (int)blockIdx.x, args.ws};
        gemm_phase<EpiStore, SchedF2, false>(F.lds, 512, DM, 512, S, EpiStore{(const float*)(args.ws + WS_W2048)});
        {
            const int idx = F.vcu * NTHREADS + F.tid;
            if (idx < 2 * FW) { const int b = idx >> 10, col = idx & 1023, k2 = col & 127; const float* al = (const float*)(args.ws + WS_ALT) + b * FW + (col & ~127); float s = 0.f;
                for (int c = 0; c < 128; ++c) s += al[c] * cospif((float)((c * k2) & 127) * (1.0f / 64.0f));
                ((bf16_t*)(args.ws + WS_YF))[((size_t)b * SEQ + SEQ / 2) * YFP + col] = f2bf(s * 0.0013810679320049757f); }
        }
        SEAM(PH_F2);
    }
    if (IN(PH_MERGE)) {
        unsigned char* ws = args.ws;
        SchedMerge S{F.G, (int)blockIdx.x, ws};
        gemm_phase<EpiMerge, SchedMerge, false>(F.lds, DM, DM, DM, S, EpiMerge{(const bf16_t*)(ws + WS_SGF), (const bf16_t*)(ws + WS_SGA), (bf16_t*)(ws + WS_YM)});
        SEAM(PH_MERGE);
    }
    if (IN(PH_OUT)) {
        unsigned char* ws = args.ws;
        SchedGrid S{F.G, (int)blockIdx.x, 32, 8, (const char*)(ws + WS_YM), (const char*)(ws + WS_WT_O), nullptr, (size_t)256 * DM * 2, (size_t)256 * DM * 2, DM, 4, 1, DM / BK};
        gemm_phase<EpiX2, SchedGrid, false>(F.lds, DM, DM, DM, S, EpiX2{args.in[0], modp, (float*)(ws + WS_X2)});
        SEAM(PH_OUT);
    }
    if (IN(PH_ROUTE)) { ph_route(F, args, modp); SEAM(PH_ROUTE); }
    if (IN(PH_EXP1)) {
        moe_tables(F, 4);
        SchedMoe<4, true> S{F.G, F.vcu, args.ws, (LAS int*)(F.lds + SCHT_OFF), (const int*)(args.ws + WS_TOKE)};
        gemm_phase<EpiAct, SchedMoe<4, true>, true, true>(F.lds, DM, DM / 2, DM / 2, S, EpiAct{});
        SEAM(PH_EXP1);
    }
    if (IN(PH_EXP2)) {
        moe_tables(F, 8);
        SchedMoe<8, false> S{F.G, F.vcu, args.ws, (LAS int*)(F.lds + SCHT_OFF), (const int*)(args.ws + WS_TOKE)};
        gemm_phase<EpiY8, SchedMoe<8, false>, false, true>(F.lds, EFF, EFF / 2, EFF / 2, S, EpiY8{});
        SEAM(PH_EXP2);
    }
    if (IN(PH_COMB)) { ph_comb(F, args, modp); }
#undef IN
#undef SEAM
}
}

extern "C" void kernel_launch(void* const* d_in, const int* in_sizes, int n_in, void* d_out, int out_size, void* d_ws, size_t ws_size, hipStream_t stream) {
    if (n_in != 22 || ws_size < WS_END2) return;
    float* out = (float*)d_out;
    unsigned char* ws = (unsigned char*)d_ws;
    hipMemsetAsync(ws + WS_CTL, 0, CTL_ZERO_BYTES, stream);
    static int grid = 0;
    if (!grid) {
        int dev = 0, cus = 0;
        if (hipGetDevice(&dev) != hipSuccess || hipDeviceGetAttribute(&cus, hipDeviceAttributeMultiprocessorCount, dev) != hipSuccess) { grid = -1; return; }
        if (hipFuncSetAttribute((const void*)mk::fwd, hipFuncAttributeMaxDynamicSharedMemorySize, mk::LDS_BYTES) != hipSuccess) { grid = -1; return; }
        grid = cus;
    }
    if (grid < 0) return;
    mk::Args a{}; int nlaunch = 0;
    for (int i = 0; i < 22; ++i) a.in[i] = (const float*)d_in[i];
    a.out = out; a.ws = ws; a.use_ut = 1; a.mod_off = (int)WS_MOD; a.do_attn = 1;
#define MK_LAUNCH(lo_, hi_) do { a.ph_lo = (lo_); a.ph_hi = (hi_); a.bar_idx = nlaunch++; hipLaunchKernelGGL(mk::fwd, dim3(grid), dim3(mk::NTHREADS), mk::LDS_BYTES, stream, a); } while (0)
    MK_LAUNCH(mk::PH_PRO, mk::PH_END);
}
```

```cpp
#include <hip/hip_runtime.h>
#include <stdint.h>
#include <math.h>

typedef unsigned short bf16_t;
typedef short bf16x8 __attribute__((ext_vector_type(8)));
typedef float f32x16 __attribute__((ext_vector_type(16)));
typedef float f32x4 __attribute__((ext_vector_type(4)));

constexpr int NB = 2, SEQ = 4096, DM = 2048, NTOK = NB * SEQ, CTXL = 256, NCTX = NB * CTXL, HD = 128, NH = 16, NKV = 4;
constexpr int SKV = SEQ + CTXL;
constexpr int FW = 1024, INC = 8192, Q_OFF = 1024, K_OFF = 3072, V_OFF = 3584, GF_OFF = 4096, GA_OFF = 6144;
constexpr int KVW = NKV * HD;
constexpr int NE = 64, TOPK = 8, EFF = 512, MODC = 6 * DM;
constexpr int NSLOT = NTOK * TOPK;
constexpr int NSLOT_ALL = NSLOT + NTOK;

constexpr size_t MiB = 1u << 20;
constexpr size_t WS_CTL = 0, CTL_ZERO_BYTES = 128 * 1024;
constexpr size_t CTL_CNT = 64 * 1024;
constexpr size_t WS_TW = 1 * MiB;
constexpr size_t WS_MOD = 1 * MiB + 64 * 1024;
constexpr size_t WS_OFFS = 1 * MiB + 256 * 1024;
constexpr size_t WS_EIDX = 2 * MiB;
constexpr size_t WS_EW = WS_EIDX + 256 * 1024;
constexpr size_t WS_EPOS = WS_EW + 256 * 1024;
constexpr size_t WS_SLOTOF = WS_EPOS + 256 * 1024;
constexpr size_t WS_TOKE = 300 * MiB;
constexpr size_t WS_H = 4 * MiB;
constexpr size_t WS_U = 38 * MiB;
constexpr size_t WS_Q = 54 * MiB;
constexpr size_t WS_KALL = 86 * MiB;
constexpr size_t WS_VALL = 95 * MiB;
constexpr size_t WS_SGF = 104 * MiB;
constexpr size_t WS_SGA = 136 * MiB;
constexpr size_t WS_YA = 168 * MiB;
constexpr size_t WS_YF = 38 * MiB;
constexpr int YFP = 2048;
constexpr size_t WS_PR = 216 * MiB;
constexpr size_t WS_T1 = 248 * MiB;
constexpr size_t WS_YM = 312 * MiB;
constexpr size_t WS_QKRAW = 248 * MiB;
constexpr size_t WS_KCRAW = 330 * MiB;
constexpr size_t WS_H2 = 344 * MiB;
constexpr size_t WS_ACT = 376 * MiB;
constexpr size_t WS_YBIG = 4 * MiB;
constexpr size_t WS_END = 740 * MiB;

__device__ __forceinline__ float bf2f(bf16_t h) { return __uint_as_float(((unsigned)h) << 16); }
__device__ __forceinline__ bf16_t f2bf(float f) { unsigned u = __float_as_uint(f); return (bf16_t)((u + 0x7fffu + ((u >> 16) & 1u)) >> 16); }
__device__ __forceinline__ int crow(int r, int hi) { return (r & 3) + 8 * (r >> 2) + 4 * hi; }
__device__ __forceinline__ float wave_sum(float v) {
#pragma unroll
    for (int o = 1; o < 64; o <<= 1) v += __shfl_xor(v, o);
    return v;
}
__device__ __forceinline__ float sigmoidf_(float v) { return 1.0f / (1.0f + expf(-v)); }
__device__ __forceinline__ bf16x8 pack8(const float* f) {
    bf16x8 r;
#pragma unroll
    for (int i = 0; i < 8; ++i) r[i] = (short)f2bf(f[i]);
    return r;
}

#define LAS __attribute__((address_space(3)))
#define GAS __attribute__((address_space(1)))
typedef unsigned u32x4 __attribute__((ext_vector_type(4)));
typedef GAS unsigned gu32;
#define RLX_AGENT __ATOMIC_RELAXED, __HIP_MEMORY_SCOPE_AGENT
#define LDS_WAIT() asm volatile("s_waitcnt lgkmcnt(0)" ::: "memory")
#define VM_WAIT() asm volatile("s_waitcnt vmcnt(0)" ::: "memory")

constexpr size_t CTL_BAR = 16384;
constexpr size_t CTL_MODZ = 512 * 1024;
constexpr size_t WS_UT = 38 * MiB;
constexpr size_t WS_TT = 216 * MiB;
constexpr size_t WS_WT_GU = 450 * MiB;
constexpr size_t WS_WT_D = 710 * MiB;
constexpr size_t WS_WT_IN = 840 * MiB;
constexpr size_t WS_WT_FO = 924 * MiB;
constexpr size_t WS_WT_AO = 876 * MiB;
constexpr size_t WS_WT_O = 884 * MiB;
constexpr size_t WS_CST = 892 * MiB;
constexpr size_t WS_ET = 908 * MiB;
constexpr size_t WS_OT = 916 * MiB;
constexpr size_t WS_W2048 = 1 * MiB + 512 * 1024;
constexpr size_t WS_ALT = 1 * MiB + 520 * 1024;
constexpr size_t WS_ROPE = 1 * MiB + 528 * 1024;
constexpr size_t WS_RWT = 3 * MiB + 512 * 1024;
constexpr size_t WS_BD2 = 956 * MiB;
constexpr size_t WS_H8 = 200 * MiB;
constexpr size_t WS_WT_G8 = 932 * MiB;
constexpr size_t WS_X2 = 960 * MiB;
constexpr size_t WS_END2 = 1024 * MiB;

namespace mk {
constexpr int NWAVES = 8, NTHREADS = 512;
constexpr int RING_BYTES = 131072, SCR_BYTES = 8 * 16640, LDSCTL_OFF = 135168, MISC_OFF = LDSCTL_OFF + 320, GPARK_OFF = LDSCTL_OFF + 2048  , LDS_BYTES = 147456;
static_assert(GPARK_OFF + 8192 <= LDS_BYTES, "LDS map");
static_assert(SCR_BYTES <= LDSCTL_OFF && MISC_OFF + 128 <= LDS_BYTES, "LDS map");

#define XB_TMO      128
#define XB_XCNT(j)  (256  + 64 * (j))
#define XB_XSUB(j)  (1280 + 64 * (j))
#define XB_XGEN(j)  (2304 + 64 * (j))
#define XB_TOP      3328
#define XB_TOPGEN   3392
#define XCD_BAR_WORDS 3456
#define XB_SPIN_CAP (1u << 18)
__device__ __forceinline__ unsigned xb_ld(unsigned* p)              { return __hip_atomic_load(p, __ATOMIC_RELAXED, __HIP_MEMORY_SCOPE_AGENT); }
__device__ __forceinline__ unsigned xb_add(unsigned* p, unsigned v) { return __hip_atomic_fetch_add(p, v, __ATOMIC_RELAXED, __HIP_MEMORY_SCOPE_AGENT); }
__device__ __forceinline__ unsigned xb_xcc_id() { return (unsigned)__builtin_amdgcn_s_getreg((3 << 11) | 20) & 0xFu; }
#define XB_SPIN(cond, bar) do { unsigned _sp = 0; while (cond) { __builtin_amdgcn_s_sleep(1); \
    if ((++_sp & 255u) == 0u) { if (xb_ld(&(bar)[XB_TMO])) break; if (_sp > XB_SPIN_CAP) { atomicAdd(&(bar)[XB_TMO], 1u); break; } } } } while (0)
struct XcdBarrier { unsigned* bar; unsigned x; volatile LAS unsigned* st; };
__device__ __forceinline__ XcdBarrier xcd_barrier_post(unsigned* bar, volatile LAS unsigned* st) {
    XcdBarrier b; b.bar = bar; b.x = xb_xcc_id(); b.st = st;
    if (threadIdx.x == 0) (void)xb_add(&bar[XB_XCNT(b.x)], 1u);
    return b;
}
__device__ __forceinline__ void xcd_barrier_complete(unsigned* bar, unsigned x, unsigned& nloc, unsigned& nx) {
    const unsigned G = gridDim.x * gridDim.y * gridDim.z;
    unsigned sum, cnt, mine, sp = 0u;
    for (;;) {
        sum = 0u; cnt = 0u; mine = 0u;
#pragma unroll
        for (unsigned j = 0; j < 16; ++j) { const unsigned c = xb_ld(&bar[XB_XCNT(j)]); sum += c; cnt += (c > 0u) ? 1u : 0u; mine = (j == x) ? c : mine; }
        if (sum == G) break;
        __builtin_amdgcn_s_sleep(1);
        if ((++sp & 255u) == 0u) { if (xb_ld(&bar[XB_TMO])) break; if (sp > XB_SPIN_CAP) { atomicAdd(&bar[XB_TMO], 1u); break; } }
    }
    nloc = mine > 0u ? mine : 1u; nx = cnt > 0u ? cnt : 1u;
}
__device__ __forceinline__ void xcd_barrier(const XcdBarrier& b) {
    asm volatile("s_waitcnt vmcnt(0)" ::: "memory");
    __syncthreads();
    if (threadIdx.x == 0) {
        unsigned* bar = b.bar;
        __builtin_amdgcn_s_waitcnt(0);
        unsigned nloc = b.st[0], nx = b.st[1];
        if (nloc == 0u) { xcd_barrier_complete(bar, b.x, nloc, nx); b.st[0] = nloc; b.st[1] = nx; }
        const unsigned old = xb_add(&bar[XB_XSUB(b.x)], 1u);
        const unsigned gen = old / nloc;
        if (old + 1u == (gen + 1u) * nloc) {
            __builtin_amdgcn_fence(__ATOMIC_RELEASE, "agent");
            asm volatile("s_waitcnt vmcnt(0)" ::: "memory");
            const unsigned og = xb_add(&bar[XB_TOP], 1u);
            const unsigned tg = og / nx;
            if (og + 1u == (tg + 1u) * nx) xb_add(&bar[XB_TOPGEN], 1u);
            else XB_SPIN(xb_ld(&bar[XB_TOPGEN]) == tg, bar);
            __builtin_amdgcn_fence(__ATOMIC_ACQUIRE, "agent");
            xb_add(&bar[XB_XGEN(b.x)], 1u);
            asm volatile("s_waitcnt vmcnt(0)" ::: "memory");
        } else {
            XB_SPIN(xb_ld(&bar[XB_XGEN(b.x)]) == gen, bar);
            __builtin_amdgcn_fence(__ATOMIC_ACQUIRE, "agent");
            asm volatile("s_waitcnt vmcnt(0)" ::: "memory");
        }
    }
    __syncthreads();
}

constexpr int BM = 256, BK = 64, HALF = 128, HTB = HALF * BK * 2, STAGE_BYTES = 8 * HTB;
__device__ __forceinline__ int lds_byte(int r, int c) { const int st = (r >> 4) * 2 + (c >> 5), rr = r & 15, cc = c & 31, ob = rr * 64 + cc * 2; return st * 1024 + (ob ^ (((ob >> 9) & 1) << 5)); }
__device__ __forceinline__ void stage_rc(int b, int& R, int& C) { const int st = b / 1024, sb = b % 1024, swz = sb ^ (((sb >> 9) & 1) << 5); R = (st >> 1) * 16 + swz / 64; C = (st & 1) * 32 + (swz % 64) / 2; }
__device__ __forceinline__ int perm32(int rho) { const int n = rho >> 4, i = rho & 15; return 8 * (i >> 2) + 4 * n + (i & 3); }
__device__ __forceinline__ unsigned cvt_pk_bf16(float lo, float hi) { unsigned r; asm("v_cvt_pk_bf16_f32 %0, %1, %2" : "=v"(r) : "v"(lo), "v"(hi)); return r; }

__device__ __forceinline__ void glds16_s(const void* sbase, unsigned voff, unsigned lds_dst) { unsigned keep;
    asm volatile("s_mov_b32 %0, m0\n\ts_mov_b32 m0, %3\n\ts_nop 0\n\tglobal_load_lds_dwordx4 %1, %2\n\ts_mov_b32 m0, %0" : "=&s"(keep) : "v"(voff), "s"(sbase), "s"(lds_dst) : "memory"); }

struct Unit { const char* A; const char* B; char* C; int ldc; int mode; int rows; int aux; int pm, pn, bjs, rmin, e, nt, keep; };

typedef int i32x8 __attribute__((ext_vector_type(8)));
typedef int i32x4 __attribute__((ext_vector_type(4)));
template <class Epi, class Sched, bool GATHER, bool F8 = false, bool ALIGN = true>
__device__ __forceinline__ void gemm_phase(
    LAS unsigned char* lds, const int K, const int lda, const int ldb, const Sched& S, const Epi& E, const int i0 = 0, const int i1 = 0x7fffffff) {
    const int tid = threadIdx.x, wid = __builtin_amdgcn_readfirstlane(tid >> 6), lane = tid & 63, wr = wid >> 2, wc = wid & 3, fr = lane & 15, fq = lane >> 4;
    unsigned voffA[2], voffB[2];
#pragma unroll
    for (int i = 0; i < 2; ++i) { int R, C; stage_rc(tid * 16 + i * 8192, R, C); const int Rb = (R & ~31) + perm32(R & 31);
        voffA[i] = (unsigned)(R * lda + C) * 2u; voffB[i] = (unsigned)(Rb * ldb + C) * 2u; }
    const size_t kstep = (size_t)(BK * 2);
    const size_t hstepA = (size_t)HALF * lda * 2, hstepB = (size_t)HALF * ldb * 2;
    const unsigned ldsw = (unsigned)wid * 1024u;
    const unsigned ldsbase = (unsigned)__builtin_amdgcn_readfirstlane((int)(unsigned)(uintptr_t)lds);
    const int aoff = F8 ? lds_byte(wr * 64 + fr, (fq >> 1) * 32 + (fq & 1) * 16) : lds_byte(wr * 64 + fr, fq * 8), boff = F8 ? lds_byte(wc * 32 + fr, (fq >> 1) * 32 + (fq & 1) * 16) : lds_byte(wc * 32 + fr, fq * 8);

#define MK_SA(b, h) (((b) * 2 + (h)) * HTB)
#define MK_SB(b, h) ((4 + (b) * 2 + (h)) * HTB)
#define MK_STAGE2(bufoff, gbase, v0, v1) do { \
        __builtin_amdgcn_global_load_lds((const unsigned*)((const char*)(gbase) + (v0)), (LAS unsigned*)(lds + (bufoff) + ldsw), 16, 0, 0); \
        __builtin_amdgcn_global_load_lds((const unsigned*)((const char*)(gbase) + (v1)), (LAS unsigned*)(lds + (bufoff) + ldsw + 8192), 16, 0, 0); } while (0)
#define MK_STAGE_B(bufoff, gbase) do { glds16_s((gbase), voffB[0], ldsbase + (bufoff) + ldsw); glds16_s((gbase), voffB[1], ldsbase + (bufoff) + ldsw + 8192u); } while (0)
#define MK_STAGE_A(bufoff, gbase, h, VA) do { if constexpr (GATHER) { glds16_s((gbase), (VA)[h][0], ldsbase + (bufoff) + ldsw); glds16_s((gbase), (VA)[h][1], ldsbase + (bufoff) + ldsw + 8192u); } \
        else { glds16_s((gbase) + (h) * hstepA, voffA[0], ldsbase + (bufoff) + ldsw); glds16_s((gbase) + (h) * hstepA, voffA[1], ldsbase + (bufoff) + ldsw + 8192u); } } while (0)
#define MK_LDA(dst, b, h) do { if constexpr (F8) { _Pragma("unroll") for (int m = 0; m < 4; ++m) dst##8[m] = *(const LAS i32x8*)(lds + MK_SA(b, h) + aoff + m * 2048); } \
        else { _Pragma("unroll") for (int m = 0; m < 4; ++m) _Pragma("unroll") for (int k = 0; k < 2; ++k) dst[m][k] = *(const LAS bf16x8*)(lds + MK_SA(b, h) + aoff + m * 2048 + k * 1024); } } while (0)
#define MK_LDB(dst, b, h) do { if constexpr (F8) { _Pragma("unroll") for (int n = 0; n < 2; ++n) dst##8[n] = *(const LAS i32x8*)(lds + MK_SB(b, h) + boff + n * 2048); } \
        else { _Pragma("unroll") for (int n = 0; n < 2; ++n) _Pragma("unroll") for (int k = 0; k < 2; ++k) dst[n][k] = *(const LAS bf16x8*)(lds + MK_SB(b, h) + boff + n * 2048 + k * 1024); } } while (0)
#define MK_MMA(ai, bj, At, Bt) do { __builtin_amdgcn_s_setprio(1); \
        if constexpr (F8) { _Pragma("unroll") for (int m = 0; m < 4; ++m) _Pragma("unroll") for (int n = 0; n < 2; ++n) \
            acc[ai][bj][m][n] = __builtin_amdgcn_mfma_scale_f32_16x16x128_f8f6f4(Bt##8[n], At##8[m], acc[ai][bj][m][n], 0, 0, 0, 0x7d, 0, 0x7d  ); } \
        else { _Pragma("unroll") for (int m = 0; m < 4; ++m) _Pragma("unroll") for (int n = 0; n < 2; ++n) _Pragma("unroll") for (int k = 0; k < 2; ++k) \
            acc[ai][bj][m][n] = __builtin_amdgcn_mfma_f32_16x16x32_bf16(Bt[n][k], At[m][k], acc[ai][bj][m][n], 0, 0, 0); } \
        __builtin_amdgcn_s_setprio(0); } while (0)
#define MK_WAIT_V(n) asm volatile("s_waitcnt vmcnt(" #n ")" ::: "memory")
#define MK_WAIT_L(n) asm volatile("s_waitcnt lgkmcnt(" #n ")" ::: "memory")
#define MK_BAR __builtin_amdgcn_s_barrier()
#define MK_SCHED __builtin_amdgcn_sched_barrier(0)
    Unit cur, nxt; int ui = i0;
    if (i0 >= i1 || !S.next(i0, cur)) return;
    f32x4 acc[2][2][4][2];
#pragma unroll
    for (int a = 0; a < 2; ++a)
#pragma unroll
        for (int b = 0; b < 2; ++b)
#pragma unroll
            for (int m = 0; m < 4; ++m)
#pragma unroll
                for (int n = 0; n < 2; ++n) acc[a][b][m][n] = (f32x4){0.f, 0.f, 0.f, 0.f};
    bf16x8 At[4][2], B0[2][2], B1[2][2]; i32x8 At8[4], B08[2], B18[2];
    unsigned vC[2][2];
    LAS u32x4* vpark = (LAS u32x4*)(lds + GPARK_OFF) + tid;
    if constexpr (GATHER) {
#pragma unroll
        for (int h = 0; h < 2; ++h)
#pragma unroll
            for (int i = 0; i < 2; ++i) { int R, C; stage_rc(tid * 16 + i * 8192, R, C); vC[h][i] = S.arow(cur, h * HALF + R) + (unsigned)(C * 2); }
    }
    const char* cA = cur.A; const char* cB = cur.B;
    MK_STAGE_B(MK_SB(0, 0), cB); MK_STAGE_B(MK_SB(0, 1), cB + hstepB); MK_STAGE_A(MK_SA(0, 0), cA, 0, vC); MK_STAGE_A(MK_SA(0, 1), cA, 1, vC);
    if (wr == 1) MK_BAR;
    MK_WAIT_V(2); MK_BAR;
    MK_STAGE_B(MK_SB(1, 0), cB + kstep); MK_STAGE_A(MK_SA(1, 0), cA + kstep, 0, vC); MK_STAGE_B(MK_SB(1, 1), cB + hstepB + kstep);
    MK_WAIT_V(6); MK_BAR;
    for (;;) {
        const bool has_next = (ui + 1 < i1) && S.next(ui + 1, nxt);
        const char* nA = has_next ? nxt.A : cA; const char* nB = has_next ? nxt.B : cB;
        if constexpr (GATHER) {
            u32x4 pv;
#pragma unroll
            for (int h = 0; h < 2; ++h)
#pragma unroll
                for (int i = 0; i < 2; ++i) { int R, C; stage_rc(tid * 16 + i * 8192, R, C); pv[h * 2 + i] = has_next ? (S.arow(nxt, h * HALF + R) + (unsigned)(C * 2)) : vC[h][i]; }
            *vpark = pv;
        }
        int nt = cur.nt; asm volatile("" : "+s"(nt));
#pragma nounroll
        for (int t = 0; t < nt; t += 2) {
            const bool last = (t == nt - 2);
            const char* a1 = cA + (size_t)(t + 1) * kstep;
            const char* a2 = last ? nA : cA + (size_t)(t + 2) * kstep; const char* b2 = last ? nB : cB + (size_t)(t + 2) * kstep;
            const char* a3 = a2 + kstep; const char* b3 = b2 + kstep;
            MK_LDB(B0, 0, 0); MK_LDB(B1, 0, 1); MK_SCHED; MK_LDA(At, 0, 0); MK_STAGE_A(MK_SA(1, 1), a1, 1, vC);
            if constexpr (GATHER) { if (last) { const u32x4 pv = *vpark; vC[0][0] = pv[0]; vC[0][1] = pv[1]; vC[1][0] = pv[2]; vC[1][1] = pv[3]; } }
            MK_WAIT_V(8); MK_WAIT_L(0); MK_BAR; MK_MMA(0, 0, At, B0); MK_MMA(0, 1, At, B1); MK_BAR; MK_SCHED;
            MK_LDA(At, 0, 1); MK_STAGE_B(MK_SB(0, 0), b2); MK_STAGE_B(MK_SB(0, 1), b2 + hstepB); MK_STAGE_A(MK_SA(0, 0), a2, 0, vC);
            MK_WAIT_V(8); MK_WAIT_L(0); MK_BAR; MK_MMA(1, 0, At, B0); MK_MMA(1, 1, At, B1); MK_BAR; MK_SCHED;
            MK_LDB(B0, 1, 0); MK_LDB(B1, 1, 1); MK_SCHED; MK_LDA(At, 1, 0); MK_STAGE_A(MK_SA(0, 1), a2, 1, vC);
            MK_WAIT_V(8); MK_WAIT_L(0); MK_BAR; MK_MMA(0, 0, At, B0); MK_MMA(0, 1, At, B1); MK_BAR; MK_SCHED;
            MK_LDA(At, 1, 1); MK_STAGE_B(MK_SB(1, 0), b3); MK_STAGE_B(MK_SB(1, 1), b3 + hstepB); MK_STAGE_A(MK_SA(1, 0), a3, 0, vC);
            MK_WAIT_V(8); MK_WAIT_L(0); MK_BAR; MK_MMA(1, 0, At, B0); MK_MMA(1, 1, At, B1); MK_BAR; MK_SCHED;
        }
        if (wr == 0 && (ALIGN || !has_next)) MK_BAR;
        { int l2; asm volatile("v_mbcnt_lo_u32_b32 %0, -1, 0\n\tv_mbcnt_hi_u32_b32 %0, -1, %0" : "=v"(l2));
          E(acc, cur, wr, wc, l2 & 15, l2 >> 4); }
        if (!has_next) break;
        if (!cur.keep)
#pragma unroll
        for (int a = 0; a < 2; ++a)
#pragma unroll
            for (int b = 0; b < 2; ++b)
#pragma unroll
                for (int m = 0; m < 4; ++m)
#pragma unroll
                    for (int n = 0; n < 2; ++n) acc[a][b][m][n] = (f32x4){0.f, 0.f, 0.f, 0.f};
        cur = nxt; cA = nA; cB = nB; ++ui;
        if (ALIGN && wr == 1) MK_BAR;
    }
    MK_WAIT_V(0);
    MK_BAR;
#undef MK_SA
#undef MK_SB
#undef MK_STAGE2
#undef MK_STAGE_B
#undef MK_STAGE_A
#undef MK_LDA
#undef MK_LDB
#undef MK_MMA
#undef MK_WAIT_V
#undef MK_WAIT_L
#undef MK_BAR
#undef MK_SCHED
}

__device__ __forceinline__ void grid_map(int L, int nM, int nN, int& pm, int& pn) {
    const int nwg = nM * nN, q = nwg / 8, xcd = L % 8, off = L / 8; const int wgid = xcd * q + off;
    const int nig = 8 * nN, gid = wgid / nig, fm = gid * 8, gsz = (nM - fm) < 8 ? (nM - fm) : 8;
    pm = fm + ((wgid % nig) % gsz); pn = (wgid % nig) / gsz;
}

struct EpiStore {
    const float* w2048;
    __device__ __forceinline__ void operator()(f32x4 (&acc)[2][2][4][2], const Unit& u, int wr, int wc, int fr, int fq) const {
        const int col0 = wc * 32 + 8 * fq;
#pragma unroll
        for (int ai = 0; ai < 2; ++ai)
#pragma unroll
            for (int m = 0; m < 4; ++m) {
                const int r = ai * HALF + wr * 64 + m * 16 + fr;
                if (r < u.rows && r >= u.rmin) {
#pragma unroll
                    for (int bj = 0; bj < 2; ++bj) {
                        f32x4 v0 = acc[ai][bj][m][0], v1 = acc[ai][bj][m][1];
                        if (u.mode == 1) { float* p = (float*)u.C + (long)r * u.ldc + col0 + bj * u.bjs; *(f32x4*)p = v0; *(f32x4*)(p + 4) = v1; }
                        else if (u.mode == 2) {
                            unsigned q[8];
#pragma unroll
                            for (int c = 0; c < 4; ++c) { q[c] = (unsigned)(255.0f * __builtin_amdgcn_rcpf(1.0f + __expf(-v0[c])) + 0.5f); q[4 + c] = (unsigned)(255.0f * __builtin_amdgcn_rcpf(1.0f + __expf(-v1[c])) + 0.5f); }
                            const unsigned lo = q[0] | (q[1] << 8) | (q[2] << 16) | (q[3] << 24), hi = q[4] | (q[5] << 8) | (q[6] << 16) | (q[7] << 24);
                            *(unsigned long long*)((unsigned char*)u.C + (long)r * u.ldc + col0 + bj * u.bjs) = (unsigned long long)lo | ((unsigned long long)hi << 32); }
                        else {
                            if (u.mode == 3) {
                                const float* wp = w2048 + u.pn + bj * HALF + col0; const float sg = (r & 1) ? -1.0f : 1.0f;
                                v0 += *(const f32x4*)wp * sg; v1 += *(const f32x4*)(wp + 4) * sg;
                            }
                            u32x4 w; w.x = cvt_pk_bf16(v0[0], v0[1]); w.y = cvt_pk_bf16(v0[2], v0[3]); w.z = cvt_pk_bf16(v1[0], v1[1]); w.w = cvt_pk_bf16(v1[2], v1[3]);
                            *(u32x4*)((bf16_t*)u.C + (long)r * u.ldc + col0 + bj * u.bjs) = w;
                        }
                    }
                }
            }
    }
};


struct EpiIn { EpiStore base; LAS float* red; const float* qnw; const float* knw; const float* rope;
    __device__ __forceinline__ void operator()(f32x4 (&acc)[2][2][4][2], const Unit& u, int wr, int wc, int fr, int fq) const {
        if (u.mode < 5) { base(acc, u, wr, wc, fr, fq); return; }
#pragma unroll
        for (int ai = 0; ai < 2; ++ai)
#pragma unroll
            for (int m = 0; m < 4; ++m)
#pragma unroll
                for (int bj = 0; bj < 2; ++bj) { const f32x4 a = acc[ai][bj][m][0], b = acc[ai][bj][m][1];
                    float s = (a[0] * a[0] + a[1] * a[1]) + (a[2] * a[2] + a[3] * a[3]) + (b[0] * b[0] + b[1] * b[1]) + (b[2] * b[2] + b[3] * b[3]);
                    s += __shfl_xor(s, 16); s += __shfl_xor(s, 32);
                    if (fq == 0) red[((ai * HALF + wr * 64 + m * 16 + fr) * 2 + bj) * 4 + wc] = s; }
        asm volatile("s_waitcnt lgkmcnt(0)" ::: "memory"); __builtin_amdgcn_s_barrier(); asm volatile("" ::: "memory");
        const float* nw = u.mode == 5 ? qnw : knw;
        const int axis = wc >> 1, f0 = (wc & 1) * 16 + fq * 4, da = axis * 64 + f0;
        const f32x4 wa = *(const f32x4*)(nw + da), wb = *(const f32x4*)(nw + da + 32);
#pragma unroll
        for (int ai = 0; ai < 2; ++ai)
#pragma unroll
            for (int m = 0; m < 4; ++m) { const int r = ai * HALF + wr * 64 + m * 16 + fr;
                f32x4 cs = {1.f, 1.f, 1.f, 1.f}, sn = {0.f, 0.f, 0.f, 0.f};
                if (u.mode != 7) { const int t = u.pm + r, pos = axis ? (t & 63) : (t >> 6); const float* rp = rope + (pos * 32 + f0) * 2;
                    const f32x4 p0 = *(const f32x4*)rp, p1 = *(const f32x4*)(rp + 4); cs = (f32x4){p0[0], p0[2], p1[0], p1[2]}; sn = (f32x4){p0[1], p0[3], p1[1], p1[3]}; }
#pragma unroll
                for (int bj = 0; bj < 2; ++bj) { const LAS f32x4* pp = (const LAS f32x4*)(red + (r * 2 + bj) * 4); const f32x4 ps = *pp;
                    const float rstd = 1.0f / sqrtf(((ps[0] + ps[1]) + (ps[2] + ps[3])) * (1.0f / HD) + 1e-6f);
                    const f32x4 xa = acc[ai][bj][m][0] * rstd * wa, xb = acc[ai][bj][m][1] * rstd * wb;
                    const f32x4 oa = xa * cs - xb * sn, ob = xb * cs + xa * sn;
                    u32x4 w; w.x = cvt_pk_bf16(oa[0], oa[1]); w.y = cvt_pk_bf16(oa[2], oa[3]); w.z = cvt_pk_bf16(ob[0], ob[1]); w.w = cvt_pk_bf16(ob[2], ob[3]);
                    *(u32x4*)((bf16_t*)u.C + (long)r * u.ldc + bj * HALF + wc * 32 + 8 * fq) = w; } }
    } };


__device__ __forceinline__ void pack8_fp8(const f32x4& a, const f32x4& b, unsigned& w0, unsigned& w1) {
    f32x4 v0 = a, v1 = b;
#pragma unroll
    for (int c = 0; c < 4; ++c) { v0[c] = fminf(fmaxf(v0[c], -448.f), 448.f); v1[c] = fminf(fmaxf(v1[c], -448.f), 448.f); }
    int x0 = 0, x1 = 0;
    x0 = __builtin_amdgcn_cvt_pk_fp8_f32(v0[0], v0[1], x0, false); x0 = __builtin_amdgcn_cvt_pk_fp8_f32(v0[2], v0[3], x0, true);
    x1 = __builtin_amdgcn_cvt_pk_fp8_f32(v1[0], v1[1], x1, false); x1 = __builtin_amdgcn_cvt_pk_fp8_f32(v1[2], v1[3], x1, true);
    w0 = (unsigned)x0; w1 = (unsigned)x1;
}
__device__ __forceinline__ void store16_s(const void* sbase, unsigned voff, u32x4 v) { asm volatile("global_store_dwordx4 %0, %1, %2\n\ts_nop 1" :: "v"(voff), "v"(v), "s"(sbase) : "memory"); }
struct EpiY8 {
    __device__ __forceinline__ void operator()(f32x4 (&acc)[2][2][4][2], const Unit& u, int wr, int wc, int fr, int fq) const {
        const int odd = fq & 1;
        const unsigned off0 = (unsigned)((wr * 64 + fr) * u.ldc + odd * HALF + wc * 32 + 8 * (fq - odd));
        const int r0 = wr * 64 + fr;
#pragma unroll
        for (int ai = 0; ai < 2; ++ai)
#pragma unroll
            for (int m = 0; m < 4; ++m) {
                unsigned a0, a1, b0, b1; pack8_fp8(acc[ai][0][m][0], acc[ai][0][m][1], a0, a1); pack8_fp8(acc[ai][1][m][0], acc[ai][1][m][1], b0, b1);
                const auto s0 = __builtin_amdgcn_permlane16_swap(a0, b0, false, false), s1 = __builtin_amdgcn_permlane16_swap(a1, b1, false, false);
                if (r0 + ai * HALF + m * 16 < u.rows) { const u32x4 w = {s0[0], s1[0], s0[1], s1[1]}; store16_s(u.C, off0 + (unsigned)((ai * HALF + m * 16) * u.ldc), w); } }
    } };


struct EpiGate {
    __device__ __forceinline__ void operator()(f32x4 (&acc)[2][2][4][2], const Unit& u, int wr, int wc, int fr, int fq) const {
        bf16_t* base = (bf16_t*)u.C + (size_t)(wr * 64 + fr) * u.ldc + wc * 32 + 8 * fq;
#pragma unroll
        for (int ai = 0; ai < 2; ++ai)
#pragma unroll
            for (int m = 0; m < 4; ++m) { bf16_t* p = base + (size_t)(ai * HALF + m * 16) * u.ldc;
#pragma unroll
                for (int bj = 0; bj < 2; ++bj) { f32x4 v0 = acc[ai][bj][m][0], v1 = acc[ai][bj][m][1];
#pragma unroll
                    for (int c = 0; c < 4; ++c) { v0[c] = __builtin_amdgcn_rcpf(1.0f + __expf(-v0[c])); v1[c] = __builtin_amdgcn_rcpf(1.0f + __expf(-v1[c])); }
                    u32x4 w; w.x = cvt_pk_bf16(v0[0], v0[1]); w.y = cvt_pk_bf16(v0[2], v0[3]); w.z = cvt_pk_bf16(v1[0], v1[1]); w.w = cvt_pk_bf16(v1[2], v1[3]);
                    *(u32x4*)(p + bj * HALF) = w; } }
    } };

struct Args { const float* in[22]; float* out; unsigned char* ws; int ph_lo, ph_hi, use_ut, mod_off, do_attn, bar_idx; };
struct Frame {
    LAS unsigned char* lds; volatile LAS unsigned* MISC; unsigned char* ws;
    int tid, lane, wave, vcu, G;
};

__device__ __forceinline__ int qk_col_of_dim(int d) { const int a = d >> 6, half = (d >> 5) & 1, f = d & 31; return 32 * (2 * a + (f >> 4)) + 8 * ((f >> 2) & 3) + 4 * half + (f & 3); }
__device__ __forceinline__ void t64_load(f32x4 (&v)[16], const float* W, int ldw, int lane) {
    const unsigned off = (unsigned)(((lane >> 4) * ldw + (lane & 15) * 4) * 4);
#pragma unroll
    for (int j = 0; j < 16; ++j) { const char* bj = (const char*)W + (size_t)(j * 4) * ldw * 4; v[j] = __builtin_nontemporal_load((const GAS f32x4*)(bj + off)); }
}
template <bool QKPERM = false, bool F8OUT = false>
__device__ __forceinline__ void t64_store(const f32x4 (&v)[16], bf16_t* dst, int ldd, LAS float* scr, int lane, int d0 = 0) {
    const int kk = lane >> 4, nc = (lane & 15) * 4;
#pragma unroll
    for (int j = 0; j < 16; ++j) {
#pragma unroll
        for (int c = 0; c < 4; ++c) scr[(j * 4 + kk) * 65 + nc + c] = v[j][c]; }
    LDS_WAIT(); asm volatile("" ::: "memory");
    const int kc = lane & 7; const unsigned soff = F8OUT ? (unsigned)((lane >> 3) * ldd + 8 * kc) : (unsigned)(((lane >> 3) * ldd + 8 * kc) * 2);
#pragma unroll
    for (int jj = 0; jj < 8; jj += 2) {
        float t[2][8];
#pragma unroll
        for (int q = 0; q < 2; ++q) { const int n = (lane >> 3) + 8 * (jj + q); const LAS float* s = scr + (8 * kc) * 65 + n;
#pragma unroll
            for (int i = 0; i < 8; ++i) t[q][i] = s[i * 65]; }
#pragma unroll
        for (int q = 0; q < 2; ++q) { char* bq = (char*)dst + (size_t)(8 * (jj + q)) * ldd * (F8OUT ? 1 : 2);
            if constexpr (QKPERM) bq = (char*)dst + (size_t)(qk_col_of_dim(d0 + (lane >> 3) + 8 * (jj + q)) - (lane >> 3)) * ldd * 2;
            if constexpr (F8OUT) { float s[8];
#pragma unroll
                for (int i = 0; i < 8; ++i) s[i] = fminf(fmaxf(t[q][i] * 16.0f, -448.f), 448.f);
                int w0 = 0, w1 = 0; w0 = __builtin_amdgcn_cvt_pk_fp8_f32(s[0], s[1], w0, false); w0 = __builtin_amdgcn_cvt_pk_fp8_f32(s[2], s[3], w0, true);
                w1 = __builtin_amdgcn_cvt_pk_fp8_f32(s[4], s[5], w1, false); w1 = __builtin_amdgcn_cvt_pk_fp8_f32(s[6], s[7], w1, true);
                __builtin_nontemporal_store((unsigned long long)(unsigned)w0 | ((unsigned long long)(unsigned)w1 << 32), (GAS unsigned long long*)(bq + soff)); }
            else { u32x4 o; o.x = cvt_pk_bf16(t[q][0], t[q][1]); o.y = cvt_pk_bf16(t[q][2], t[q][3]); o.z = cvt_pk_bf16(t[q][4], t[q][5]); o.w = cvt_pk_bf16(t[q][6], t[q][7]);
                __builtin_nontemporal_store(o, (GAS u32x4*)(bq + soff)); } } }
    LDS_WAIT(); asm volatile("" ::: "memory");
}
__device__ __forceinline__ void transpose64(const float* W, int ldw, bf16_t* dst, int ldd, LAS float* scr, int lane) {
    f32x4 v[16]; t64_load(v, W, ldw, lane); t64_store(v, dst, ldd, scr, lane);
}

constexpr int IT_IN = 32 * 128, IT_FO = 16 * 32, IT_AO = 32 * 32, IT_O = 32 * 32, IT_EG = 64 * 256, IT_EU = 64 * 256, IT_ED = 64 * 256, IT_SH = 256;
constexpr int IT_T_END = IT_IN + IT_FO + IT_AO + IT_O + 3 * IT_SH;
constexpr int IT_MOD = MODC / 32, IT_CST = 4096, IT_BD2 = 512, IT_RWT = 32, IT_ROPE = 32;
constexpr int IT_ALL = IT_T_END + IT_MOD + IT_CST + IT_BD2 + IT_RWT + IT_ROPE;

__device__ __forceinline__ void mod_item(const Args& args, unsigned char* ws, int r, int lane) {
            const int kq = lane >> 3, col = r * 32 + (lane & 7) * 4;
            f32x4 a0 = {0.f, 0.f, 0.f, 0.f}, a1 = a0, a2 = a0;
            for (int jb = 0; jb < 256; jb += 8) {
                f32x4 w[8]; float c0[8], c1[8], c2[8];
#pragma unroll
                for (int j = 0; j < 8; ++j) { const int k = kq + 8 * (jb + j); w[j] = *(const GAS f32x4*)(args.in[4] + (size_t)k * MODC + col); c0[j] = args.in[1][k]; c1[j] = args.in[1][DM + k]; c2[j] = args.in[3][k]; }
#pragma unroll
                for (int j = 0; j < 8; ++j) { a0 += w[j] * (c0[j] * __builtin_amdgcn_rcpf(1.0f + __expf(-c0[j]))); a1 += w[j] * (c1[j] * __builtin_amdgcn_rcpf(1.0f + __expf(-c1[j]))); a2 += w[j] * (c2[j] * __builtin_amdgcn_rcpf(1.0f + __expf(-c2[j]))); }
            }
#pragma unroll
            for (int c = 0; c < 4; ++c) {
#pragma unroll
                for (int o = 8; o < 64; o <<= 1) { a0[c] += __shfl_xor(a0[c], o); a1[c] += __shfl_xor(a1[c], o); a2[c] += __shfl_xor(a2[c], o); } }
            if (kq == 0) { const f32x4 bb = *(const GAS f32x4*)(args.in[5] + col); float* MODP = (float*)(ws + WS_MOD);
                *(GAS f32x4*)(MODP + col) = a0 + bb; *(GAS f32x4*)(MODP + MODC + col) = a1 + bb; *(GAS f32x4*)(MODP + 2 * MODC + col) = a2 + bb; }
}
__device__ __forceinline__ void p0_prologue(Frame& F, const Args& args) {
    LAS float* scr = (LAS float*)(F.lds + F.wave * 16640);
    const int gw = F.vcu * NWAVES + F.wave, NGW = F.G * NWAVES, lane = F.lane;
    unsigned char* ws = F.ws;
    bf16_t* WT_IN = (bf16_t*)(ws + WS_WT_IN); bf16_t* WT_FO = (bf16_t*)(ws + WS_WT_FO); bf16_t* WT_AO = (bf16_t*)(ws + WS_WT_AO); bf16_t* WT_O = (bf16_t*)(ws + WS_WT_O);
    bf16_t* WT_GU = (bf16_t*)(ws + WS_WT_GU); bf16_t* WT_D = (bf16_t*)(ws + WS_WT_D);
    int rank = gw, nreg = NGW;
    if (NGW >= 5 * IT_MOD) {
        if (gw % 5 == 0 && gw / 5 < IT_MOD) { mod_item(args, ws, gw / 5, lane); return; }
        rank = gw < 5 * IT_MOD ? gw - gw / 5 - 1 : gw - IT_MOD; nreg = NGW - IT_MOD; }
    else for (int m = gw; m < IT_MOD; m += NGW) mod_item(args, ws, m, lane);
    for (int it = rank; it < IT_ALL - IT_MOD; it += nreg) {
        int r = it;
        if (r < IT_IN) { const int kb = r / 128, nb = r % 128, n0 = nb * 64;
            if (n0 >= Q_OFF && n0 < V_OFF) { f32x4 v[16]; t64_load(v, args.in[7] + (size_t)(kb * 64) * INC + n0, INC, lane);
                t64_store<true>(v, WT_IN + (size_t)(n0 & ~127) * DM + kb * 64, DM, scr, lane, n0 & 127); }
            else if (n0 >= GF_OFF) { f32x4 v[16]; t64_load(v, args.in[7] + (size_t)(kb * 64) * INC + n0, INC, lane);
                t64_store<false, true>(v, (bf16_t*)(ws + WS_WT_G8 + (size_t)(n0 - GF_OFF) * DM + kb * 64), DM, scr, lane); }
            else transpose64(args.in[7] + (size_t)(kb * 64) * INC + n0, INC, WT_IN + (size_t)n0 * DM + kb * 64, DM, scr, lane);
            continue; } r -= IT_IN;
        if (r < IT_FO) { const int kb = r / 32, nb = r % 32; transpose64(args.in[10] + (size_t)(kb * 64) * DM + nb * 64, DM, WT_FO + (size_t)(nb * 64) * YFP + kb * 64, YFP, scr, lane); continue; } r -= IT_FO;
        if (r < IT_AO) { const int kb = r / 32, nb = r % 32; transpose64(args.in[11] + (size_t)(kb * 64) * DM + nb * 64, DM, WT_AO + (size_t)(nb * 64) * DM + kb * 64, DM, scr, lane); continue; } r -= IT_AO;
        if (r < IT_O) { const int kb = r / 32, nb = r % 32; transpose64(args.in[12] + (size_t)(kb * 64) * DM + nb * 64, DM, WT_O + (size_t)(nb * 64) * DM + kb * 64, DM, scr, lane); continue; } r -= IT_O;
        if (r < 2 * IT_SH) { const int up = r >= IT_SH; if (up) r -= IT_SH; const int kb = r / 8, nb = r % 8, n0 = nb * 64;
            { f32x4 v[16]; t64_load(v, (up ? args.in[20] : args.in[19]) + (size_t)(kb * 64) * EFF + n0, EFF, lane);
              t64_store<false, true>(v, (bf16_t*)((unsigned char*)WT_GU + ((size_t)64 * 1024 + (n0 >> 7) * 256 + (up ? 128 : 0) + (n0 & 127)) * DM + kb * 64), DM, scr, lane); } continue; } r -= 2 * IT_SH;
        if (r < IT_SH) { const int kb = r / 32, nb = r % 32;
            { f32x4 v[16]; t64_load(v, args.in[21] + (size_t)(kb * 64) * DM + nb * 64, DM, lane); t64_store<false, true>(v, (bf16_t*)((unsigned char*)WT_D + ((size_t)64 * DM + nb * 64) * EFF + kb * 64), EFF, scr, lane); } continue; } r -= IT_SH;

        if (r < IT_CST) {
            const int k1 = r & 2047; unsigned char* dst = ws + WS_CST + (size_t)r * 2048;
#pragma unroll
            for (int j = 0; j < 4; ++j) { const int n0 = j * 512 + lane * 8; float f[8];
#pragma unroll
                for (int i = 0; i < 8; ++i) { const float ph = (float)((k1 * (n0 + i)) & 4095) * (1.0f / 2048.0f); f[i] = 16.0f * (r < 2048 ? cospif(ph) : sinpif(ph)); }
                int w0 = 0, w1 = 0; w0 = __builtin_amdgcn_cvt_pk_fp8_f32(f[0], f[1], w0, false); w0 = __builtin_amdgcn_cvt_pk_fp8_f32(f[2], f[3], w0, true);
                w1 = __builtin_amdgcn_cvt_pk_fp8_f32(f[4], f[5], w1, false); w1 = __builtin_amdgcn_cvt_pk_fp8_f32(f[6], f[7], w1, true);
                *(GAS unsigned long long*)(dst + n0) = (unsigned long long)(unsigned)w0 | ((unsigned long long)(unsigned)w1 << 32); }
            continue; } r -= IT_CST;
        if (r < IT_BD2) {
            const int t = r >> 8, o = r & 255, gp = o >> 7, k2 = o & 127; bf16_t* dst = (bf16_t*)(ws + WS_BD2) + (size_t)r * 512; float f[8];
#pragma unroll
            for (int i = 0; i < 8; ++i) { const int j = lane * 8 + i, cg = j >> 8, jj = j & 255, c = jj & 127; const float ph = (float)((32 * c * k2) & 4095) * (1.0f / 2048.0f);
                const float v = jj < 128 ? cospif(ph) : (t ? sinpif(ph) : -sinpif(ph)); f[i] = cg == gp ? v * 0.0013810679320049757f : 0.f; }
            u32x4 w; w.x = cvt_pk_bf16(f[0], f[1]); w.y = cvt_pk_bf16(f[2], f[3]); w.z = cvt_pk_bf16(f[4], f[5]); w.w = cvt_pk_bf16(f[6], f[7]);
            *(GAS u32x4*)(dst + lane * 8) = w;
            continue; } r -= IT_BD2;
        if (r >= IT_RWT) {
            float* RT = (float*)(ws + WS_ROPE);
            { const int idx = (r - IT_RWT) * 64 + lane; const float ang = (float)(idx >> 5) * exp2f(-(float)(idx & 31) * (13.287712379549449f / 32.0f)); RT[2 * idx] = cosf(ang); RT[2 * idx + 1] = sinf(ang); }
            continue; }
        {
            f32x4 v[16]; t64_load(v, args.in[14] + (size_t)(r * 64) * NE, NE, lane);
            const int kk = lane >> 4, nc = (lane & 15) * 4;
#pragma unroll
            for (int j = 0; j < 16; ++j) {
#pragma unroll
                for (int c = 0; c < 4; ++c) scr[(j * 4 + kk) * 65 + nc + c] = v[j][c]; }
            LDS_WAIT(); asm volatile("" ::: "memory");
            const int kc = lane & 7; bf16_t* RWT = (bf16_t*)(ws + WS_RWT);
#pragma unroll
            for (int jj = 0; jj < 8; ++jj) { const int e = (lane >> 3) + 8 * jj; const LAS float* s = scr + (8 * kc) * 65 + e; float t[8], l[8];
#pragma unroll
                for (int i = 0; i < 8; ++i) { t[i] = s[i * 65]; l[i] = t[i] - bf2f(f2bf(t[i])); }
                u32x4 h, lo; h.x = cvt_pk_bf16(t[0], t[1]); h.y = cvt_pk_bf16(t[2], t[3]); h.z = cvt_pk_bf16(t[4], t[5]); h.w = cvt_pk_bf16(t[6], t[7]);
                lo.x = cvt_pk_bf16(l[0], l[1]); lo.y = cvt_pk_bf16(l[2], l[3]); lo.z = cvt_pk_bf16(l[4], l[5]); lo.w = cvt_pk_bf16(l[6], l[7]);
                *(GAS u32x4*)(RWT + (size_t)e * DM + r * 64 + 8 * kc) = h; *(GAS u32x4*)(RWT + (size_t)(NE + e) * DM + r * 64 + 8 * kc) = lo; }
            LDS_WAIT(); asm volatile("" ::: "memory");
        }
    }
}


__device__ __forceinline__ void conv_addr(const Args& args, unsigned char* ws, bool down, int it, const float*& W, int& ldw, bf16_t*& dst, int& ldd) {
    if (!down) { int r = it; const int up = r >= IT_EG; if (up) r -= IT_EG;
        const int e = r / 256, q = r % 256, kb = q / 8, nb = q % 8, n0 = nb * 64;
        W = (up ? args.in[17] : args.in[16]) + (size_t)e * DM * EFF + (size_t)(kb * 64) * EFF + n0; ldw = EFF;
        dst = (bf16_t*)(ws + WS_WT_GU + ((size_t)e * 1024 + (n0 >> 7) * 256 + (up ? 128 : 0) + (n0 & 127)) * DM + kb * 64); ldd = DM;
    } else { const int r = it, e = r / 256, q = r % 256, kb = q / 32, nb = q % 32;
        W = args.in[18] + (size_t)e * EFF * DM + (size_t)(kb * 64) * DM + nb * 64; ldw = DM;
        dst = (bf16_t*)(ws + WS_WT_D + ((size_t)e * DM + nb * 64) * EFF + kb * 64); ldd = EFF; }
}
__device__ __forceinline__ void conv_items(Frame& F, const Args& args, bool down, int first, int count) {
    LAS float* scr = (LAS float*)(F.lds + F.wave * 16640);
    const int end = first + count; int it = first + F.wave;
    if (it >= end) return;
    f32x4 va[16], vb[16]; const float* W; int ldw; bf16_t* da; bf16_t* db; int ldd;
    conv_addr(args, F.ws, down, it, W, ldw, da, ldd); t64_load(va, W, ldw, F.lane);
    for (;;) {
        const bool hb = it + NWAVES < end;
        if (hb) { conv_addr(args, F.ws, down, it + NWAVES, W, ldw, db, ldd); t64_load(vb, W, ldw, F.lane); }
        t64_store<false, true>(va, da, ldd, scr, F.lane);
        if (!hb) break;
        const bool ha = it + 2 * NWAVES < end;
        if (ha) { conv_addr(args, F.ws, down, it + 2 * NWAVES, W, ldw, da, ldd); t64_load(va, W, ldw, F.lane); }
        t64_store<false, true>(vb, db, ldd, scr, F.lane);
        if (!ha) break;
        it += 2 * NWAVES;
    }
}
struct SchedIn {
    int G, c; unsigned char* ws; int use_ut;
    __device__ __forceinline__ bool next(int i, Unit& u) const {
        const int L = i * G + c; if (L >= 520) return false;
        const char* H = (const char*)(ws + WS_H); const char* WT = (const char*)(ws + WS_WT_IN);
        u.rows = 256; u.aux = 0; u.bjs = HALF; u.pm = 0; u.pn = 0; u.rmin = 0; u.nt = DM / BK; u.keep = 0;
        if (L < 512) {
            int pm, ct; grid_map(L, 32, 16, pm, ct);
            const int row0 = pm * 256, b = row0 / SEQ, t0 = row0 % SEQ;
            u.A = H + (size_t)row0 * DM * 2; u.B = WT + (size_t)ct * 256 * DM * 2;
            if (ct < 4) { u.A = WT + (size_t)ct * 256 * DM * 2; u.B = H + (size_t)row0 * DM * 2;
                          u.C = (char*)(ws + WS_UT) + (((size_t)b * FW + ct * 256) * SEQ + t0) * 2; u.ldc = SEQ; u.mode = 0; }
            else if (ct < 12) { u.C = (char*)(ws + WS_Q) + ((size_t)row0 * DM + (ct - 4) * 256) * 2; u.ldc = DM; u.mode = 5; u.pm = t0; }
            else if (ct < 14) { u.C = (char*)(ws + WS_KALL) + (((size_t)b * SKV + t0) * KVW + (ct - 12) * 256) * 2; u.ldc = KVW; u.mode = 6; u.pm = t0; }
            else { u.C = (char*)(ws + WS_VALL) + (((size_t)b * SKV + t0) * KVW + (ct - 14) * 256) * 2; u.ldc = KVW; u.mode = 0; }
        } else {
            const int l = L - 512, pm = l & 1, ct = l >> 1;
            u.A = H + (size_t)(NTOK + pm * 256) * DM * 2; u.B = WT + (size_t)(K_OFF + ct * 256) * DM * 2;
            if (ct < 2) { u.C = (char*)(ws + WS_KALL) + (((size_t)pm * SKV + SEQ) * KVW + ct * 256) * 2; u.ldc = KVW; u.mode = 7; }
            else        { u.C = (char*)(ws + WS_VALL) + (((size_t)pm * SKV + SEQ) * KVW + (ct - 2) * 256) * 2; u.ldc = KVW; u.mode = 0; }
        }
        return true;
    }
    __device__ __forceinline__ unsigned arow(const Unit&, int) const { return 0u; }
    __device__ __forceinline__ void a_ready(const Unit&) const {}
};
struct SchedGate { int G, c; unsigned char* ws;
    __device__ __forceinline__ bool next(int i, Unit& u) const {
        int g;
        if (G == 256) { if (c < 8 || i >= 2) return false; g = (c - 8) + 248 * i; }
        else { g = i * G + c; if (g >= 496) return false; }
        const int pm = g & 31, gt = g >> 5;
        u.A = (const char*)(ws + WS_H8) + (size_t)pm * 256 * DM; u.B = (const char*)(ws + WS_WT_G8) + (size_t)gt * 256 * DM;
        u.C = (char*)(ws + (gt < 8 ? WS_SGF : WS_SGA)) + ((size_t)pm * 256 * DM + (gt & 7) * 256); { int md = 2, ld = DM, rw = 256; asm volatile("" : "+s"(md), "+s"(ld), "+s"(rw)); u.ldc = ld; u.mode = md; u.rows = rw; }
        u.aux = 0; u.bjs = HALF; u.pm = pm; u.pn = gt; u.rmin = 0; u.nt = DM / 128; u.keep = 0;
        return true; }
    __device__ __forceinline__ unsigned arow(const Unit&, int) const { return 0u; }
    __device__ __forceinline__ void a_ready(const Unit&) const {} };

__device__ __forceinline__ void unpack8(u32x4 w, float (&f)[8]) {
#pragma unroll
    for (int i = 0; i < 4; ++i) { f[2 * i] = __uint_as_float(w[i] << 16); f[2 * i + 1] = __uint_as_float(w[i] & 0xffff0000u); }
}
struct EpiMerge { const unsigned char* SGF; const unsigned char* SGA; bf16_t* YM;
    static __device__ __forceinline__ void gate8(const unsigned char* p, float (&g)[8]) { const unsigned long long w = *(const unsigned long long*)p; const unsigned lo = (unsigned)w, hi = (unsigned)(w >> 32);
#pragma unroll
        for (int c = 0; c < 4; ++c) { g[c] = (float)((lo >> (8 * c)) & 0xffu) * (1.0f / 255.0f); g[4 + c] = (float)((hi >> (8 * c)) & 0xffu) * (1.0f / 255.0f); } }
    __device__ __forceinline__ void operator()(f32x4 (&acc)[2][2][4][2], const Unit& u, int wr, int wc, int fr, int fq) const {
#pragma unroll
        for (int ai = 0; ai < 2; ++ai)
#pragma unroll
            for (int m = 0; m < 4; ++m) { const size_t row = (size_t)u.pm * 256 + ai * HALF + wr * 64 + m * 16 + fr;
#pragma unroll
                for (int bj = 0; bj < 2; ++bj) { const size_t o = row * DM + u.pn * 256 + bj * HALF + wc * 32 + 8 * fq;
                    float ga[8]; gate8(SGA + o, ga);
#pragma unroll
                    for (int c = 0; c < 8; ++c) ga[c] = fmaxf(ga[c], 1e-20f);
                    if (u.keep) { float gf[8]; gate8(SGF + o, gf);
#pragma unroll
                        for (int c = 0; c < 4; ++c) { acc[ai][bj][m][0][c] *= gf[c] * __builtin_amdgcn_rcpf(ga[c]); acc[ai][bj][m][1][c] *= gf[4 + c] * __builtin_amdgcn_rcpf(ga[4 + c]); }
                    } else { const f32x4 v0 = acc[ai][bj][m][0], v1 = acc[ai][bj][m][1];
                        u32x4 w; w.x = cvt_pk_bf16(ga[0] * v0[0], ga[1] * v0[1]); w.y = cvt_pk_bf16(ga[2] * v0[2], ga[3] * v0[3]); w.z = cvt_pk_bf16(ga[4] * v1[0], ga[5] * v1[1]); w.w = cvt_pk_bf16(ga[6] * v1[2], ga[7] * v1[3]);
                        *(u32x4*)(YM + o) = w; } } }
    } };
struct SchedMerge { int G, c; unsigned char* ws;
    __device__ __forceinline__ bool next(int i, Unit& u) const {
        const int L = (i >> 1) * G + c; if (L >= 256) return false;
        int pm, pn; grid_map(L, 32, 8, pm, pn); const int kb = i & 1;
        u.A = (const char*)(ws + (kb ? WS_YA : WS_YF)) + (size_t)pm * 256 * DM * 2; u.B = (const char*)(ws + (kb ? WS_WT_AO : WS_WT_FO)) + (size_t)pn * 256 * DM * 2;
        u.C = nullptr; u.ldc = DM; u.mode = 0; u.rows = 256; u.aux = 0; u.pm = pm; u.pn = pn; u.bjs = HALF; u.rmin = 0; u.nt = kb ? DM / BK : FW / BK; u.keep = kb ? 0 : 1;
        return true; }
    __device__ __forceinline__ unsigned arow(const Unit&, int) const { return 0u; } };
struct EpiX2 { const float* x; const float* mod; bf16_t* X2;
    __device__ __forceinline__ void operator()(f32x4 (&acc)[2][2][4][2], const Unit& u, int wr, int wc, int fr, int fq) const {
        const float* g1 = mod + ((u.pm * 256) / SEQ) * MODC + 2 * DM;
#pragma unroll
        for (int ai = 0; ai < 2; ++ai)
#pragma unroll
            for (int m = 0; m < 4; ++m) { const size_t row = (size_t)u.pm * 256 + ai * HALF + wr * 64 + m * 16 + fr;
#pragma unroll
                for (int bj = 0; bj < 2; ++bj) { const int col = u.pn * 256 + bj * HALF + wc * 32 + 8 * fq; const size_t o = row * DM + col;
                    f32x4 r[2];
#pragma unroll
                    for (int n = 0; n < 2; ++n) { const f32x4 xv = *(const f32x4*)(x + o + 4 * n), gv = *(const f32x4*)(g1 + col + 4 * n); r[n] = xv + gv * acc[ai][bj][m][n]; }
                    u32x4 w; w.x = cvt_pk_bf16(r[0][0], r[0][1]); w.y = cvt_pk_bf16(r[0][2], r[0][3]); w.z = cvt_pk_bf16(r[1][0], r[1][1]); w.w = cvt_pk_bf16(r[1][2], r[1][3]);
                    *(u32x4*)(X2 + o) = w; } }
    } };
__device__ __forceinline__ void act8(const f32x4 (&g)[2], const f32x4 (&up)[2], unsigned& w0, unsigned& w1) {
    f32x4 a[2];
#pragma unroll
    for (int n = 0; n < 2; ++n)
#pragma unroll
        for (int c = 0; c < 4; ++c) { const float x = g[n][c]; a[n][c] = fminf(fmaxf(x * __builtin_amdgcn_rcpf(1.0f + __expf(-x)) * up[n][c], -448.f), 448.f); }
    int x0 = 0, x1 = 0;
    x0 = __builtin_amdgcn_cvt_pk_fp8_f32(a[0][0], a[0][1], x0, false); x0 = __builtin_amdgcn_cvt_pk_fp8_f32(a[0][2], a[0][3], x0, true);
    x1 = __builtin_amdgcn_cvt_pk_fp8_f32(a[1][0], a[1][1], x1, false); x1 = __builtin_amdgcn_cvt_pk_fp8_f32(a[1][2], a[1][3], x1, true);
    w0 = (unsigned)x0; w1 = (unsigned)x1;
}
struct EpiAct {
    __device__ __forceinline__ void operator()(f32x4 (&acc)[2][2][4][2], const Unit& u, int wr, int wc, int fr, int fq) const {
        const int odd = fq & 1;
        unsigned char* base = (unsigned char*)u.C + (size_t)(wr * 64 + odd * 16 + fr) * u.ldc + wc * 32 + 8 * (fq - odd);
        const int r0 = wr * 64 + odd * 16 + fr;
#pragma unroll
        for (int ai = 0; ai < 2; ++ai)
#pragma unroll
            for (int m = 0; m < 4; m += 2) {
                unsigned a0, a1, b0, b1; act8(acc[ai][0][m], acc[ai][1][m], a0, a1); act8(acc[ai][0][m + 1], acc[ai][1][m + 1], b0, b1);
                const auto s0 = __builtin_amdgcn_permlane16_swap(a0, b0, false, false), s1 = __builtin_amdgcn_permlane16_swap(a1, b1, false, false);
                if (r0 + ai * HALF + m * 16 < u.rows) { const u32x4 w = {s0[0], s1[0], s0[1], s1[1]}; *(u32x4*)(base + (size_t)(ai * HALF + m * 16) * u.ldc) = w; } }
    } };

struct SchedGrid {
    int G, c, nM, nN; const char* A; const char* B; char* C; size_t astride, bstride; int ldc, esz, mode, nt;
    __device__ __forceinline__ bool next(int i, Unit& u) const {
        const int L = i * G + c; if (L >= nM * nN) return false;
        int pm, pn; grid_map(L, nM, nN, pm, pn);
        u.A = A + (size_t)pm * astride; u.B = B + (size_t)pn * bstride; u.C = C + ((size_t)pm * 256 * ldc + pn * 256) * esz; u.ldc = ldc; u.mode = mode; u.rows = 256; u.aux = 0; u.pm = pm; u.pn = pn; u.bjs = HALF; u.rmin = 0; u.nt = nt; u.keep = 0;
        return true; }
    __device__ __forceinline__ unsigned arow(const Unit&, int) const { return 0u; } };
struct SchedAG { int G, c; unsigned char* ws;
    __device__ __forceinline__ bool next(int i, Unit& u) const {
        const int L = i * G + c; if (L >= 144) return false;
        u.rows = 256; u.aux = 0; u.rmin = 0; u.nt = DM / 128; u.keep = 0;
        if (L < 128) {
            int pm, pn8; grid_map(L, 16, 8, pm, pn8); const int b = pn8 >> 2, pn = pn8 & 3, sn = pm >> 3, k1t = pm & 7;
            u.A = (const char*)(ws + WS_CST) + (size_t)pm * 256 * 2048; u.B = (const char*)(ws + (sn ? WS_OT : WS_ET)) + ((size_t)b * FW + pn * 256) * 2048;
            u.C = (char*)(ws + WS_TT) + (((size_t)b * 2048 + k1t * 256) * DM + pn * 512 + sn * 128) * 2; u.ldc = DM; u.mode = sn ? 0 : 3; u.pm = k1t; u.pn = b * FW + pn * 256; u.bjs = 256;
        } else {
            const int g = 496 + (L - 128), pm = g & 31, ct = 16 + (g >> 5);
            u.A = (const char*)(ws + WS_H8) + (size_t)pm * 256 * DM; u.B = (const char*)(ws + WS_WT_G8) + (size_t)(ct - 16) * 256 * DM;
            u.C = (char*)(ws + WS_SGA) + ((size_t)pm * 256 * DM + (ct - 24) * 256); u.ldc = DM; u.mode = 2; u.pm = pm; u.pn = ct; u.bjs = HALF;
        }
        return true; }
    __device__ __forceinline__ unsigned arow(const Unit&, int) const { return 0u; } };
struct SchedF2 { int G, c; unsigned char* ws;
    __device__ __forceinline__ bool next(int i, Unit& u) const {
        const int L = i * G + c; if (L >= 128) return false;
        int pm, q; grid_map(L, 16, 8, pm, q); const int b = pm >> 3, k1t = pm & 7, j = q & 3, mir = q >> 2;
        u.A = (const char*)(ws + WS_TT) + (((size_t)b * 2048 + k1t * 256) * DM + j * 512) * 2; u.B = (const char*)(ws + WS_BD2) + (size_t)mir * 256 * 512 * 2;
        u.mode = 0; u.rows = 256; u.aux = 0; u.pm = pm; u.pn = j; u.bjs = HALF; u.nt = 512 / BK; u.keep = 0;
        if (!mir) { u.C = (char*)(ws + WS_YF) + (((size_t)b * SEQ + k1t * 256) * YFP + j * 256) * 2; u.ldc = YFP; u.rmin = 0; }
        else { u.C = (char*)(ws + WS_YF) + (((size_t)b * SEQ + SEQ - k1t * 256) * YFP + j * 256) * 2; u.ldc = -YFP; u.rmin = k1t == 0 ? 1 : 0; }
        return true; }
    __device__ __forceinline__ unsigned arow(const Unit&, int) const { return 0u; } };
constexpr int SCHT_OFF = LDSCTL_OFF + 1024;
__device__ __forceinline__ void moe_tables(Frame& F, int ncol_tiles) {
    LAS int* T = (LAS int*)(F.lds + SCHT_OFF);
    __syncthreads();
    if (F.wave == 0) { const int* CNT = (const int*)(F.ws + CTL_CNT); const int e = F.lane, cn = CNT[e * 64], nt = ((cn + 255) >> 8) * ncol_tiles;
        int su = nt, so = cn;
#pragma unroll
        for (int o = 1; o < 64; o <<= 1) { const int a = __shfl_up(su, o), b = __shfl_up(so, o); if (e >= o) { su += a; so += b; } }
        T[e] = su - nt; T[80 + e] = so - cn; T[160 + e] = cn;
        if (e == 63) { T[NE] = su; T[80 + NE] = NSLOT; T[160 + NE] = NTOK; T[NE + 1] = su + ((NTOK + 255) >> 8) * ncol_tiles; } }
    __syncthreads();
}
template <int NCT, bool FIRST> struct SchedMoe {
    int G, c; unsigned char* ws; LAS int* T; const int* TOK;
    __device__ __forceinline__ int tl(int i) const { return __builtin_amdgcn_readfirstlane(T[i]); }
    __device__ __forceinline__ bool next(int i, Unit& u) const {
        const int L = i * G + c; if (L >= tl(NE + 1)) return false;
        int lo = 0, hi = NE;
#pragma unroll 1
        while (lo < hi) { const int mid = (lo + hi + 1) >> 1; if (tl(mid) <= L) lo = mid; else hi = mid - 1; }
        const int e = lo, cn = tl(160 + e), ntile = (cn + 255) >> 8, local = L - tl(e), ct = local / ntile, mt = local % ntile, slot0 = tl(80 + e) + mt * 256;
        u.rows = (cn - mt * 256) < 256 ? (cn - mt * 256) : 256; u.aux = slot0; u.pm = mt; u.pn = ct; u.bjs = HALF; u.mode = 0; u.rmin = 0; u.e = e; u.nt = (FIRST ? DM : EFF) / 128; u.keep = 0;
        if (FIRST) { u.A = (const char*)(ws + WS_H2); u.B = (const char*)(ws + WS_WT_GU) + ((size_t)e * 4 + ct) * 256 * DM; u.C = (char*)(ws + WS_ACT) + ((size_t)slot0 * EFF + ct * 128); u.ldc = EFF; }
        else { u.A = (const char*)(ws + WS_ACT) + (size_t)slot0 * EFF; u.B = (const char*)(ws + WS_WT_D) + ((size_t)e * DM + ct * 256) * EFF; u.C = (char*)(ws + WS_YBIG) + ((size_t)slot0 * DM + ct * 256); u.ldc = DM; u.mode = 8; }
        return true; }
    __device__ __forceinline__ unsigned arow(const Unit& u, int r) const { const int rr = u.pm * 256 + (r < u.rows ? r : u.rows - 1); const int tok = u.e < NE ? TOK[u.e * NTOK + rr] : rr; return (unsigned)tok * (unsigned)DM; } };

namespace attn {
using s16x4 = __attribute__((ext_vector_type(4))) short;
using f32x8 = __attribute__((ext_vector_type(8))) float;
constexpr int D = 128, NW = 8, QBLK = 32, KVBLK = 64;
constexpr float SCALE = 0.088388347648318440f;
constexpr float THR = 8.f;
constexpr int LDQ = DM, LDK = KVW, LDO = DM;
constexpr size_t SHM_V = KVBLK * D * 2, SHM_K = KVBLK * D * 2, SHM_ATTN = 2 * SHM_V + 2 * SHM_K + NW * 64 * 4;
#define KSWZ(row, colB) ((row) * 256 + ((colB) ^ (((row) & 7) << 4)))
#define SBAR() __builtin_amdgcn_sched_barrier(0)
__device__ __forceinline__ unsigned cvtpk(float lo, float hi) { unsigned r; asm volatile("v_cvt_pk_bf16_f32 %0, %1, %2" : "=v"(r) : "v"(lo), "v"(hi)); return r; }
__device__ __forceinline__ void partialSM(f32x16& p0, f32x16& p1, float& m_reg, float& mn, float& alpha) {
  constexpr float C = SCALE * 1.4426950408889634f;
  float pmax = p0[0]; for (int r = 1; r < 16; ++r) pmax = fmaxf(pmax, p0[r]); for (int r = 0; r < 16; ++r) pmax = fmaxf(pmax, p1[r]);
  { auto rr = __builtin_amdgcn_permlane32_swap(__float_as_uint(pmax), __float_as_uint(pmax), false, false);
    pmax = fmaxf(__uint_as_float(rr[0]), __uint_as_float(rr[1])); }
  if (__builtin_expect(__all(pmax - m_reg <= THR / SCALE), 1)) { mn = m_reg; alpha = 1.f; }
  else { mn = fmaxf(m_reg, pmax); alpha = __builtin_amdgcn_exp2f((m_reg - mn) * C); m_reg = mn; }
  float mnC = -mn * C;
  for (int r = 0; r < 16; ++r) p0[r] = fmaf(p0[r], C, mnC); for (int r = 0; r < 16; ++r) p1[r] = fmaf(p1[r], C, mnC);
  for (int r = 0; r < 16; ++r) p0[r] = __builtin_amdgcn_exp2f(p0[r]);
}
__device__ __forceinline__ void finishSM(f32x16& p0, f32x16& p1, float alpha, float& l_reg, bf16x8& pa0, bf16x8& pa1, bf16x8& pa2, bf16x8& pa3) {
  for (int r = 0; r < 16; ++r) p1[r] = __builtin_amdgcn_exp2f(p1[r]);
  float ps = 0; for (int r = 0; r < 16; ++r) ps += p0[r]; for (int r = 0; r < 16; ++r) ps += p1[r];
  { auto rr = __builtin_amdgcn_permlane32_swap(__float_as_uint(ps), __float_as_uint(ps), false, false);
    ps = __uint_as_float(rr[0]) + __uint_as_float(rr[1]); }
  l_reg = l_reg * alpha + ps;
#define PK4(P, BASE, OUT) do { unsigned a0 = cvtpk(P[BASE + 0], P[BASE + 1]), a1 = cvtpk(P[BASE + 2], P[BASE + 3]);   \
    unsigned b0 = cvtpk(P[BASE + 4], P[BASE + 5]), b1 = cvtpk(P[BASE + 6], P[BASE + 7]);                              \
    auto r0 = __builtin_amdgcn_permlane32_swap(a0, b0, false, false); auto r1 = __builtin_amdgcn_permlane32_swap(a1, b1, false, false); \
    u32x4 w = {r0[0], r1[0], r0[1], r1[1]}; OUT = *reinterpret_cast<bf16x8*>(&w); } while (0)
  PK4(p0, 0, pa0); PK4(p0, 8, pa1); PK4(p1, 0, pa2); PK4(p1, 8, pa3);
#undef PK4
}
__device__ __forceinline__ void qkt(f32x16& p0, f32x16& p1, const bf16_t* Ks, const bf16x8* qr, int r32, int hi) {
  p0 = f32x16{}; p1 = f32x16{};
  for (int d0 = 0; d0 < 8; ++d0) { int cb = (d0 * 16 + hi * 8) * 2;
    bf16x8 b0 = *reinterpret_cast<const bf16x8*>((const char*)Ks + KSWZ(r32, cb));
    bf16x8 b1 = *reinterpret_cast<const bf16x8*>((const char*)Ks + KSWZ(32 + r32, cb));
    p0 = __builtin_amdgcn_mfma_f32_32x32x16_bf16(b0, qr[d0], p0, 0, 0, 0);
    p1 = __builtin_amdgcn_mfma_f32_32x32x16_bf16(b1, qr[d0], p1, 0, 0, 0); }
}
__device__ __forceinline__ int v_st(int k, int c) { const int kk = (k & ~0xC) | ((k & 4) << 1) | ((k & 8) >> 1); return ((kk >> 3) * 4 + (c >> 5)) * 512 + ((kk & 7) * 32 + (c & 31)) * 2; }
__device__ __forceinline__ int v_rd_base(int lane) { return ((lane & 3) << 3) | (((lane >> 2) & 3) << 6) | (((lane >> 4) & 1) << 5) | (((lane >> 5) & 1) << 8); }
constexpr int v_rd_off(int d0, int ks, int half) { return d0 * 512 + ks * 4096 + half * 2048; }
template <int OFF> __device__ __forceinline__ s16x4 tr_read(int vb) {
  s16x4 r; asm volatile("ds_read_b64_tr_b16 %0, %1 offset:%2" : "=&v"(r) : "v"(vb), "i"(OFF) : "memory"); return r;
}
template <int D0> __device__ __forceinline__ void pv_one(f32x16& od, int vb, bf16x8 pa0, bf16x8 pa1, bf16x8 pa2, bf16x8 pa3) {
  const s16x4 l0 = tr_read<v_rd_off(D0, 0, 0)>(vb), h0 = tr_read<v_rd_off(D0, 0, 1)>(vb), l1 = tr_read<v_rd_off(D0, 1, 0)>(vb), h1 = tr_read<v_rd_off(D0, 1, 1)>(vb);
  const s16x4 l2 = tr_read<v_rd_off(D0, 2, 0)>(vb), h2 = tr_read<v_rd_off(D0, 2, 1)>(vb), l3 = tr_read<v_rd_off(D0, 3, 0)>(vb), h3 = tr_read<v_rd_off(D0, 3, 1)>(vb);
  asm volatile("s_waitcnt lgkmcnt(0)" ::: "memory"); SBAR();
#define PK(L, H) (bf16x8){L[0], L[1], L[2], L[3], H[0], H[1], H[2], H[3]}
  od = __builtin_amdgcn_mfma_f32_32x32x16_bf16(pa0, PK(l0, h0), od, 0, 0, 0);
  od = __builtin_amdgcn_mfma_f32_32x32x16_bf16(pa1, PK(l1, h1), od, 0, 0, 0);
  od = __builtin_amdgcn_mfma_f32_32x32x16_bf16(pa2, PK(l2, h2), od, 0, 0, 0);
  od = __builtin_amdgcn_mfma_f32_32x32x16_bf16(pa3, PK(l3, h3), od, 0, 0, 0);
#undef PK
}
__device__ __forceinline__ void pv_d0(f32x16* o, int vb, bf16x8 pa0, bf16x8 pa1, bf16x8 pa2, bf16x8 pa3) {
  pv_one<0>(o[0], vb, pa0, pa1, pa2, pa3); pv_one<1>(o[1], vb, pa0, pa1, pa2, pa3); pv_one<2>(o[2], vb, pa0, pa1, pa2, pa3); pv_one<3>(o[3], vb, pa0, pa1, pa2, pa3);
}
__device__ __forceinline__ void attn_dense_body(const bf16_t* __restrict__ Qb, const bf16_t* __restrict__ Kh, const bf16_t* __restrict__ Vh, bf16_t* __restrict__ Ob, int seq, char* lds) {
  const int tid = threadIdx.x, wid = tid >> 6, lane = tid & 63, r32 = lane & 31, hi = lane >> 5;
  bf16_t* V_lds = (bf16_t*)lds; bf16_t* K_lds = (bf16_t*)(lds + 2 * SHM_V);
  float* ws = (float*)(lds + 2 * SHM_V + 2 * SHM_K) + wid * 64; float* li_l = ws; float* al_l = ws + 32;
  float m_reg = -1e30f, l_reg = 0; f32x16 o[4] = {}; bf16x8 qr[8];
  const bf16_t* Qw = Qb + (long)(wid * QBLK + r32) * LDQ + hi * 8;
#pragma unroll
  for (int d0 = 0; d0 < 8; ++d0) qr[d0] = *reinterpret_cast<const bf16x8*>(Qw + d0 * 16);
  const int sr = tid >> 4, sc = (tid & 15) * 8, vst0 = v_st(sr, sc), vst1 = v_st(32 + sr, sc);
  const int vb0 = (int)(uintptr_t)V_lds + v_rd_base(lane);
  struct { bf16x8 vs0, vs1, ks0, ks1; } sr_[2];
#define SLOAD(i, k0) do { sr_[i].vs0 = *reinterpret_cast<const bf16x8*>(&Vh[(long)((k0) + sr) * LDK + sc]); sr_[i].vs1 = *reinterpret_cast<const bf16x8*>(&Vh[(long)((k0) + 32 + sr) * LDK + sc]); \
    sr_[i].ks0 = *reinterpret_cast<const bf16x8*>(&Kh[(long)((k0) + sr) * LDK + sc]); sr_[i].ks1 = *reinterpret_cast<const bf16x8*>(&Kh[(long)((k0) + 32 + sr) * LDK + sc]); } while (0)
#define SWRITE(b, i) do { *(bf16x8*)((char*)V_lds + (b) * SHM_V + vst0) = sr_[i].vs0;          \
    *(bf16x8*)((char*)V_lds + (b) * SHM_V + vst1) = sr_[i].vs1; int kc = sc * 2;               \
    *(bf16x8*)((char*)K_lds + (b) * SHM_K + KSWZ(sr, kc)) = sr_[i].ks0;                       \
    *(bf16x8*)((char*)K_lds + (b) * SHM_K + KSWZ(32 + sr, kc)) = sr_[i].ks1; } while (0)
#define SWAIT() asm volatile("s_waitcnt vmcnt(4)" ::: "memory")
#define RESC(a) do { if (__any((a) < 1.f)) { if (hi == 0) al_l[r32] = (a); asm volatile("s_waitcnt lgkmcnt(0)" ::: "memory"); \
    for (int d = 0; d < 4; ++d) for (int r = 0; r < 16; ++r) o[d][r] *= al_l[crow(r, hi)]; } } while (0)
  f32x16 pA0, pA1, pB0, pB1; float mnA, mnB, alA, alB; bf16x8 pa0, pa1, pa2, pa3; const int NT = seq / KVBLK;
  constexpr int SE = 0, SO = 1;
  SLOAD(SE, 0); asm volatile("s_waitcnt vmcnt(0)" ::: "memory"); SWRITE(0, SE); __syncthreads();
  qkt(pA0, pA1, K_lds, qr, r32, hi); partialSM(pA0, pA1, m_reg, mnA, alA);
  SLOAD(SO, KVBLK); if (2 < NT) SLOAD(SE, 2 * KVBLK);
  SWAIT(); SWRITE(1, SO); __syncthreads();
  for (int j = 1; j + 1 < NT; j += 2) {
    SBAR(); qkt(pB0, pB1, (bf16_t*)((char*)K_lds + SHM_K), qr, r32, hi);
    finishSM(pA0, pA1, alA, l_reg, pa0, pa1, pa2, pa3); SBAR();
    SLOAD(SO, (j + 2) * KVBLK); SBAR();
    pv_d0(o, vb0, pa0, pa1, pa2, pa3); partialSM(pB0, pB1, m_reg, mnB, alB);
    __syncthreads(); SWAIT(); SWRITE(0, SE);
    RESC(alB); __syncthreads();
    SBAR(); qkt(pA0, pA1, K_lds, qr, r32, hi);
    finishSM(pB0, pB1, alB, l_reg, pa0, pa1, pa2, pa3); SBAR();
    if (j + 3 < NT) SLOAD(SE, (j + 3) * KVBLK); SBAR();
    pv_d0(o, vb0 + (int)SHM_V, pa0, pa1, pa2, pa3); partialSM(pA0, pA1, m_reg, mnA, alA);
    __syncthreads(); SWAIT(); SWRITE(1, SO);
    RESC(alA); __syncthreads();
  }
  SBAR(); qkt(pB0, pB1, (bf16_t*)((char*)K_lds + SHM_K), qr, r32, hi);
  finishSM(pA0, pA1, alA, l_reg, pa0, pa1, pa2, pa3); SBAR();
  pv_d0(o, vb0, pa0, pa1, pa2, pa3); partialSM(pB0, pB1, m_reg, mnB, alB);
  __syncthreads(); RESC(alB);
  finishSM(pB0, pB1, alB, l_reg, pa0, pa1, pa2, pa3); SBAR();
  pv_d0(o, vb0 + (int)SHM_V, pa0, pa1, pa2, pa3);
  if (hi == 0) li_l[r32] = l_reg; asm volatile("s_waitcnt lgkmcnt(0)" ::: "memory");
  float rli[16];
#pragma unroll
  for (int r = 0; r < 16; ++r) rli[r] = __builtin_amdgcn_rcpf(li_l[crow(r, hi)]);
  typedef __attribute__((address_space(3))) unsigned char lds8_t;
  lds8_t* ost = (lds8_t*)(lds + SHM_ATTN + wid * 8192);
  lds8_t* wbase = ost + hi * 1024 + r32 * 2;
#pragma unroll
  for (int d0 = 0; d0 < 4; ++d0)
#pragma unroll
    for (int r = 0; r < 16; r += 2) { const unsigned w = cvtpk(o[d0][r] * rli[r], o[d0][r + 1] * rli[r + 1]);
      *(__attribute__((address_space(3))) unsigned short*)(wbase + (((r & 3) + 8 * (r >> 2)) * 256 + d0 * 64)) = (unsigned short)w;
      *(__attribute__((address_space(3))) unsigned short*)(wbase + ((((r + 1) & 3) + 8 * ((r + 1) >> 2)) * 256 + d0 * 64)) = (unsigned short)(w >> 16); }
  asm volatile("s_waitcnt lgkmcnt(0)" ::: "memory");
  bf16_t* Ow = Ob + (long)(wid * QBLK) * LDO;
  { const lds8_t* rbase = ost + (lane >> 4) * 256 + (lane & 15) * 16; bf16_t* gbase = Ow + (long)(lane >> 4) * LDO + (lane & 15) * 8;
#pragma unroll
    for (int j = 0; j < 8; ++j) { const u32x4 v = *(const __attribute__((address_space(3))) u32x4*)(rbase + j * 1024); *(u32x4*)(gbase + (long)(j * 4) * LDO) = v; } }
  asm volatile("s_waitcnt lgkmcnt(0)" ::: "memory");
#undef SLOAD
#undef SWRITE
#undef SWAIT
#undef RESC
}
#undef KSWZ
#undef SBAR
}

__device__ __forceinline__ void ph_norm1(Frame& F, const Args& args, const float* mod) {
    const int gw = F.vcu * NWAVES + F.wave, NGW = F.G * NWAVES, lane = F.lane;
    bf16_t* H = (bf16_t*)(F.ws + WS_H); const float* nw = args.in[6];
    for (int row = gw; row < NTOK + NCTX; row += NGW) {
        const float* src = row < NTOK ? args.in[0] + (size_t)row * DM : args.in[2] + (size_t)(row - NTOK) * DM;
        const float* mr = mod + (row < NTOK ? row / SEQ : 2) * MODC;
        f32x4 v[8]; float ss = 0.f;
#pragma unroll
        for (int j = 0; j < 8; ++j) { v[j] = *(const GAS f32x4*)(src + (j * 64 + lane) * 4); ss += v[j].x * v[j].x + v[j].y * v[j].y + v[j].z * v[j].z + v[j].w * v[j].w; }
        ss = wave_sum(ss);
        const float rstd = 1.0f / sqrtf(ss * (1.0f / DM) + 1e-6f);
#pragma unroll
        for (int j = 0; j < 8; ++j) { const int i = (j * 64 + lane) * 4;
            const f32x4 w = *(const GAS f32x4*)(nw + i), sc = *(const GAS f32x4*)(mr + DM + i), sh = *(const GAS f32x4*)(mr + i);
            const f32x4 h = v[j] * rstd * w * (sc + 1.0f) + sh;
            unsigned lo = cvt_pk_bf16(h[0], h[1]), hi = cvt_pk_bf16(h[2], h[3]);
            *(GAS unsigned long long*)(H + (size_t)row * DM + i) = (unsigned long long)lo | ((unsigned long long)hi << 32);
            if (row < NTOK) { int w8 = 0; w8 = __builtin_amdgcn_cvt_pk_fp8_f32(fminf(fmaxf(h[0], -448.f), 448.f), fminf(fmaxf(h[1], -448.f), 448.f), w8, false);
                w8 = __builtin_amdgcn_cvt_pk_fp8_f32(fminf(fmaxf(h[2], -448.f), 448.f), fminf(fmaxf(h[3], -448.f), 448.f), w8, true);
                *(GAS unsigned*)(F.ws + WS_H8 + (size_t)row * DM + i) = (unsigned)w8; } }
    }
}
__device__ __forceinline__ void ph_evenodd(Frame& F, const Args& args) {
    const int gw = F.vcu * NWAVES + F.wave, NGW = F.G * NWAVES, lane = F.lane;
    LAS bf16_t* scr = (LAS bf16_t*)(F.lds + F.wave * 16640);
    const bf16_t* UT = (const bf16_t*)(F.ws + WS_UT); unsigned char* ET = F.ws + WS_ET; unsigned char* OT = F.ws + WS_OT;
    float* W2 = (float*)(F.ws + WS_W2048); float* AL = (float*)(F.ws + WS_ALT);
    for (int row = gw; row < 2 * FW; row += NGW) {
        const bf16_t* src = UT + (size_t)row * SEQ; float alt = 0.f;
#pragma unroll
        for (int j = 0; j < 8; ++j) { const u32x4 w = *(const GAS u32x4*)(src + (j * 64 + lane) * 8); *(LAS u32x4*)(scr + (j * 64 + lane) * 8) = w;
            float f[8]; unpack8(w, f); alt += (f[0] - f[1]) + (f[2] - f[3]) + (f[4] - f[5]) + (f[6] - f[7]); }
        alt = wave_sum(alt);
        LDS_WAIT(); asm volatile("" ::: "memory");
        if (lane == 0) { AL[row] = alt; W2[row] = bf2f(scr[SEQ / 2]); }
#pragma unroll
        for (int j = 0; j < 4; ++j) { const int n0 = (j * 64 + lane) * 8; float e[8], o[8];
#pragma unroll
            for (int i = 0; i < 8; ++i) { const int n = n0 + i; const float a = bf2f(scr[n]), bb = bf2f(scr[(SEQ - n) & (SEQ - 1)]); e[i] = n == 0 ? a : a + bb; o[i] = n == 0 ? 0.f : a - bb; }
#pragma unroll
            for (int i = 0; i < 8; ++i) { e[i] = fminf(fmaxf(e[i], -448.f), 448.f); o[i] = fminf(fmaxf(o[i], -448.f), 448.f); }
            int e0 = 0, e1 = 0, o0 = 0, o1 = 0;
            e0 = __builtin_amdgcn_cvt_pk_fp8_f32(e[0], e[1], e0, false); e0 = __builtin_amdgcn_cvt_pk_fp8_f32(e[2], e[3], e0, true); e1 = __builtin_amdgcn_cvt_pk_fp8_f32(e[4], e[5], e1, false); e1 = __builtin_amdgcn_cvt_pk_fp8_f32(e[6], e[7], e1, true);
            o0 = __builtin_amdgcn_cvt_pk_fp8_f32(o[0], o[1], o0, false); o0 = __builtin_amdgcn_cvt_pk_fp8_f32(o[2], o[3], o0, true); o1 = __builtin_amdgcn_cvt_pk_fp8_f32(o[4], o[5], o1, false); o1 = __builtin_amdgcn_cvt_pk_fp8_f32(o[6], o[7], o1, true);
            *(GAS unsigned long long*)(ET + (size_t)row * 2048 + n0) = (unsigned long long)(unsigned)e0 | ((unsigned long long)(unsigned)e1 << 32);
            *(GAS unsigned long long*)(OT + (size_t)row * 2048 + n0) = (unsigned long long)(unsigned)o0 | ((unsigned long long)(unsigned)o1 << 32); }
        LDS_WAIT(); asm volatile("" ::: "memory");
    }
}
__device__ __forceinline__ void ph_route(Frame& F, const Args& args, const float* mod) {
    const int lane = F.lane, wv = F.wave, r32 = lane & 31, hi = lane >> 5;
    LAS float* rs = (LAS float*)F.lds;
    LAS float* part = (LAS float*)(F.lds + 1024);
    LAS int* lcnt = (LAS int*)(F.lds + 1024 + 65536);
    LAS int* lbase = lcnt + 64;
    LAS int* lent = lcnt + 128;
    const bf16_t* X2 = (const bf16_t*)(F.ws + WS_X2); const float* nw = args.in[13]; const float* rb = args.in[15];
    const bf16_t* RWT = (const bf16_t*)(F.ws + WS_RWT);
    bf16_t* H2 = (bf16_t*)(F.ws + WS_H2); int* EIDX = (int*)(F.ws + WS_EIDX); float* EW = (float*)(F.ws + WS_EW); int* EPOS = (int*)(F.ws + WS_EPOS); int* CNT = (int*)(F.ws + CTL_CNT); int* TOKE = (int*)(F.ws + WS_TOKE);
    if (F.tid < NE) lcnt[F.tid] = 0;
    __syncthreads();
    int nb = 0;
    for (int blk = F.vcu; blk < NTOK / 32; blk += F.G, ++nb) {
        const int row0 = blk * 32; const float* mr = mod + (row0 / SEQ) * MODC;
#pragma unroll
        for (int i = 0; i < 4; ++i) { const bf16_t* src = X2 + (size_t)(row0 + wv * 4 + i) * DM; float ss = 0.f;
#pragma unroll
            for (int j = 0; j < 4; ++j) { float v[8]; unpack8(*(const GAS u32x4*)(src + (j * 64 + lane) * 8), v);
#pragma unroll
                for (int c = 0; c < 8; ++c) ss += v[c] * v[c]; }
            ss = wave_sum(ss);
            if (lane == 0) rs[wv * 4 + i] = 1.0f / sqrtf(ss * (1.0f / DM) + 1e-6f); }
        __syncthreads();
        { const float rstd = rs[r32]; const bf16_t* xr = X2 + (size_t)(row0 + r32) * DM; unsigned char* hr = (unsigned char*)H2 + (size_t)(row0 + r32) * DM;
          f32x16 acc0 = {}, acc1 = {};
#pragma unroll 4
          for (int ks = 0; ks < 16; ++ks) { const int k = wv * 256 + ks * 16 + hi * 8;
              float h[8], xf[8]; unpack8(*(const GAS u32x4*)(xr + k), xf);
#pragma unroll
              for (int q = 0; q < 2; ++q) { const f32x4 x = {xf[4 * q], xf[4 * q + 1], xf[4 * q + 2], xf[4 * q + 3]}, w = *(const GAS f32x4*)(nw + k + 4 * q), sc = *(const GAS f32x4*)(mr + 4 * DM + k + 4 * q), sh = *(const GAS f32x4*)(mr + 3 * DM + k + 4 * q);
                  const f32x4 t = x * rstd * w * (sc + 1.0f) + sh; h[4 * q] = t[0]; h[4 * q + 1] = t[1]; h[4 * q + 2] = t[2]; h[4 * q + 3] = t[3]; }
              u32x4 wh, wl; float l[8];
              wh.x = cvt_pk_bf16(h[0], h[1]); wh.y = cvt_pk_bf16(h[2], h[3]); wh.z = cvt_pk_bf16(h[4], h[5]); wh.w = cvt_pk_bf16(h[6], h[7]);
#pragma unroll
              for (int i = 0; i < 4; ++i) { l[2 * i] = h[2 * i] - __uint_as_float(wh[i] << 16); l[2 * i + 1] = h[2 * i + 1] - __uint_as_float(wh[i] & 0xffff0000u); }
              wl.x = cvt_pk_bf16(l[0], l[1]); wl.y = cvt_pk_bf16(l[2], l[3]); wl.z = cvt_pk_bf16(l[4], l[5]); wl.w = cvt_pk_bf16(l[6], l[7]);
              { float hc[8];
#pragma unroll
                for (int i = 0; i < 8; ++i) hc[i] = fminf(fmaxf(h[i], -448.f), 448.f);
                int w0 = 0, w1 = 0; w0 = __builtin_amdgcn_cvt_pk_fp8_f32(hc[0], hc[1], w0, false); w0 = __builtin_amdgcn_cvt_pk_fp8_f32(hc[2], hc[3], w0, true);
                w1 = __builtin_amdgcn_cvt_pk_fp8_f32(hc[4], hc[5], w1, false); w1 = __builtin_amdgcn_cvt_pk_fp8_f32(hc[6], hc[7], w1, true);
                *(GAS unsigned long long*)(hr + k) = (unsigned long long)(unsigned)w0 | ((unsigned long long)(unsigned)w1 << 32); }
              const bf16x8 ah = __builtin_bit_cast(bf16x8, wh), al = __builtin_bit_cast(bf16x8, wl);
              const bf16x8 bh0 = *(const GAS bf16x8*)(RWT + (size_t)r32 * DM + k), bh1 = *(const GAS bf16x8*)(RWT + (size_t)(32 + r32) * DM + k);
              const bf16x8 bl0 = *(const GAS bf16x8*)(RWT + (size_t)(NE + r32) * DM + k), bl1 = *(const GAS bf16x8*)(RWT + (size_t)(NE + 32 + r32) * DM + k);
              acc0 = __builtin_amdgcn_mfma_f32_32x32x16_bf16(ah, bh0, acc0, 0, 0, 0); acc0 = __builtin_amdgcn_mfma_f32_32x32x16_bf16(ah, bl0, acc0, 0, 0, 0); acc0 = __builtin_amdgcn_mfma_f32_32x32x16_bf16(al, bh0, acc0, 0, 0, 0);
              acc1 = __builtin_amdgcn_mfma_f32_32x32x16_bf16(ah, bh1, acc1, 0, 0, 0); acc1 = __builtin_amdgcn_mfma_f32_32x32x16_bf16(ah, bl1, acc1, 0, 0, 0); acc1 = __builtin_amdgcn_mfma_f32_32x32x16_bf16(al, bh1, acc1, 0, 0, 0); }
#pragma unroll
          for (int r = 0; r < 16; ++r) { part[(wv * 32 + crow(r, hi)) * 64 + r32] = acc0[r]; part[(wv * 32 + crow(r, hi)) * 64 + 32 + r32] = acc1[r]; } }
        __syncthreads();
        for (int i = 0; i < 4; ++i) { const int rbk = wv * 4 + i, row = row0 + rbk; float logit = 0.f;
#pragma unroll
          for (int w = 0; w < 8; ++w) logit += part[(w * 32 + rbk) * 64 + lane];
          const float score = 1.0f / (1.0f + expf(-logit)), bsd = score + rb[lane];
          const int g = lane >> 3;
          int rk = 0;
#pragma unroll
          for (int q = 0; q < 8; ++q) { const int o = (lane & ~7) + q; const float vv = __shfl(bsd, o); rk += (vv > bsd) || (vv == bsd && o < lane); }
          float gs = rk < 2 ? bsd : 0.f;
          gs += __shfl_xor(gs, 1); gs += __shfl_xor(gs, 2); gs += __shfl_xor(gs, 4);
          int grk = 0;
#pragma unroll
          for (int gg = 0; gg < 8; ++gg) { const float vv = __shfl(gs, gg * 8); grk += (vv > gs) || (vv == gs && gg < g); }
          const bool gsel = grk < 4;
          const float mb = gsel ? bsd : -INFINITY;
          int erk = 0;
          for (int o = 0; o < 64; ++o) { const float vv = __shfl(mb, o); erk += (vv > mb) || (vv == mb && o < lane); }
          const bool sel = gsel && erk < TOPK;
          const float ssum = wave_sum(sel ? score : 0.f);
          if (sel) { const int lp = __hip_atomic_fetch_add(lcnt + lane, 1, __ATOMIC_RELAXED, __HIP_MEMORY_SCOPE_WORKGROUP);
                     EIDX[row * TOPK + erk] = lane; EW[row * TOPK + erk] = score / ssum * 2.5f; lent[(nb * 32 + rbk) * TOPK + erk] = (lane << 16) | lp; } }
        __syncthreads();
    }
    if (F.tid < NE) { const int c = lcnt[F.tid]; lbase[F.tid] = c ? atomicAdd(&CNT[F.tid * 64], c) : 0; }
    __syncthreads();
    int it0 = F.tid; asm volatile("" : "+v"(it0));
    for (int i = it0; i < nb * 256; i += NTHREADS) { const int blk = F.vcu + (i >> 8) * F.G, row = blk * 32 + ((i >> 3) & 31), v = lent[i]; const int pos = lbase[v >> 16] + (v & 0xffff); EPOS[row * TOPK + (i & 7)] = pos; TOKE[(v >> 16) * NTOK + pos] = row; }
    __syncthreads();
}
__device__ __forceinline__ void y16(const unsigned char* p, float (&f)[16]) {
    const u32x4 w = *(const GAS u32x4*)p;
#pragma unroll
    for (int i = 0; i < 4; ++i) { const auto lo = __builtin_amdgcn_cvt_pk_f32_fp8((int)w[i], false), hi = __builtin_amdgcn_cvt_pk_f32_fp8((int)w[i], true); f[4 * i] = lo[0]; f[4 * i + 1] = lo[1]; f[4 * i + 2] = hi[0]; f[4 * i + 3] = hi[1]; }
}
__device__ __forceinline__ void ph_comb(Frame& F, const Args& args, const float* mod) {
    const int gw = F.vcu * NWAVES + F.wave, NGW = F.G * NWAVES, lane = F.lane;
    moe_tables(F, 4);
    LAS int* T = (LAS int*)(F.lds + SCHT_OFF);
    const float* EW = (const float*)(F.ws + WS_EW); const int* EIDX = (const int*)(F.ws + WS_EIDX); const int* EPOS = (const int*)(F.ws + WS_EPOS); const unsigned char* Y = (const unsigned char*)(F.ws + WS_YBIG);
    for (int t = gw; t < NTOK; t += NGW) {
        const float* g2 = mod + (t / SEQ) * MODC + 5 * DM;
        int sl[TOPK]; float wk[TOPK];
#pragma unroll
        for (int k = 0; k < TOPK; ++k) { sl[k] = T[80 + EIDX[t * TOPK + k]] + EPOS[t * TOPK + k]; wk[k] = EW[t * TOPK + k]; }
#pragma unroll
        for (int j = 0; j < 2; ++j) { const int col = j * 1024 + lane * 16;
            float a[16]; y16(Y + (size_t)(NSLOT + t) * DM + col, a);
#pragma unroll
            for (int k = 0; k < TOPK; ++k) { float y[16]; y16(Y + (size_t)sl[k] * DM + col, y);
#pragma unroll
                for (int c = 0; c < 16; ++c) a[c] += wk[k] * y[c]; }
            float* o = args.out + (size_t)t * DM + col; const bf16_t* xi = (const bf16_t*)(F.ws + WS_X2) + (size_t)t * DM + col;
            float xf[16]; { float t8[8]; unpack8(*(const GAS u32x4*)xi, t8);
#pragma unroll
                for (int c = 0; c < 8; ++c) xf[c] = t8[c];
                unpack8(*(const GAS u32x4*)(xi + 8), t8);
#pragma unroll
                for (int c = 0; c < 8; ++c) xf[8 + c] = t8[c]; }
#pragma unroll
            for (int n = 0; n < 4; ++n) { const f32x4 xv = {xf[4 * n], xf[4 * n + 1], xf[4 * n + 2], xf[4 * n + 3]}, gv = *(const GAS f32x4*)(g2 + col + 4 * n);
                *(GAS f32x4*)(o + 4 * n) = xv + gv * (f32x4){a[4 * n], a[4 * n + 1], a[4 * n + 2], a[4 * n + 3]}; } }
    }
}

enum { PH_PRO = 0, PH_NORM1, PH_INPROJ, PH_QKNORM, PH_ATTN, PH_F2, PH_MERGE, PH_OUT, PH_ROUTE, PH_EXP1, PH_EXP2, PH_COMB, PH_END };


__global__ void __launch_bounds__(NTHREADS, 2) fwd(Args args) {
    extern __shared__ __attribute__((aligned(16))) unsigned char lds_raw[];
    Frame F;
    F.lds = (LAS unsigned char*)lds_raw; F.MISC = (volatile LAS unsigned*)(F.lds + MISC_OFF); F.ws = args.ws;
    F.tid = threadIdx.x; F.lane = F.tid & 63; F.wave = __builtin_amdgcn_readfirstlane(F.tid >> 6);
    F.G = gridDim.x; { const int bx = blockIdx.x; F.vcu = (F.G % 8 == 0) ? (bx % 8) * (F.G / 8) + bx / 8 : bx; }
    for (int u = F.tid; u < (LDS_BYTES - LDSCTL_OFF) / 4; u += NTHREADS) ((LAS unsigned*)(F.lds + LDSCTL_OFF))[u] = 0u;
    __syncthreads();
    const int lo = args.ph_lo, hi = args.ph_hi;
    const bool multi = (hi - lo) > 1;
    unsigned* barw = (unsigned*)(args.ws + CTL_BAR) + args.bar_idx * XCD_BAR_WORDS;
    XcdBarrier bar; bar.bar = barw; bar.x = 0; bar.st = nullptr;
    if (multi) bar = xcd_barrier_post(barw, F.MISC + 8);
#define IN(k) (lo <= (k) && (k) < hi)
#define SEAM(k) do { if (IN((k) + 1)) xcd_barrier(bar); } while (0)

    const float* modp = (const float*)(args.ws + args.mod_off);
    if (IN(PH_PRO)) { p0_prologue(F, args); SEAM(PH_PRO); }
    if (IN(PH_NORM1)) { ph_norm1(F, args, modp); SEAM(PH_NORM1); }
    if (IN(PH_INPROJ)) {
        { SchedIn S{F.G, (int)blockIdx.x, args.ws, args.use_ut};
          EpiIn E{EpiStore{(const float*)(args.ws + WS_W2048)}, (LAS float*)(F.lds + GPARK_OFF), args.in[8], args.in[9], (const float*)(args.ws + WS_ROPE)};
          gemm_phase<EpiIn, SchedIn, false>(F.lds, DM, DM, DM, S, E); }
        { SchedGate S{F.G, (int)blockIdx.x, args.ws};
          gemm_phase<EpiStore, SchedGate, false, true, false>(F.lds, DM, DM / 2, DM / 2, S, EpiStore{(const float*)(args.ws + WS_W2048)}); }
        SEAM(PH_INPROJ);
    }
    if (IN(PH_QKNORM)) { ph_evenodd(F, args); SEAM(PH_QKNORM); }
    if (IN(PH_ATTN)) {
        const int cs = F.vcu & 3;
        constexpr int NCONV = IT_EG + IT_EU + IT_ED;
        int qfirst, qcnt; { const int c = (int)blockIdx.x; if (F.G == 256) { qfirst = c < 144 ? c * 178 : 144 * 178 + (c - 144) * 210; qcnt = c < 144 ? 178 : 210; }
                             else { const int per = (NCONV + F.G - 1) / F.G; qfirst = c * per; qcnt = qfirst + per <= NCONV ? per : (NCONV - qfirst > 0 ? NCONV - qfirst : 0); } }
        const int gcnt = qfirst < IT_EG + IT_EU ? (qfirst + qcnt <= IT_EG + IT_EU ? qcnt : IT_EG + IT_EU - qfirst) : 0, gfirst = qfirst;
        const int ccnt = qcnt - gcnt, cfirst = qfirst + gcnt - (IT_EG + IT_EU);
#define CONV_ALL() do { conv_items(F, args, false, gfirst, gcnt); conv_items(F, args, true, cfirst, ccnt); } while (0)
        const bf16_t* Qp = (const bf16_t*)(args.ws + WS_Q); const bf16_t* Kp = (const bf16_t*)(args.ws + WS_KALL); const bf16_t* Vp = (const bf16_t*)(args.ws + WS_VALL); bf16_t* Op = (bf16_t*)(args.ws + WS_YA);
#define ATTN_UNIT(lin_) do { const int lin = (lin_); if (lin < 512) { const int x = (lin >> 5) & 7, j = (lin & 31) + 32 * (lin >> 8), b = x >> 2, kvh = x & 3, head = kvh * 4 + (j >> 4), qb = j & 15; \
            const size_t qo = ((size_t)(b * SEQ + qb * 256)) * DM + head * HD, ko = (size_t)b * SKV * KVW + kvh * HD; \
            attn::attn_dense_body(Qp + qo, Kp + ko, Vp + ko, Op + qo, SKV, (char*)lds_raw); __syncthreads(); } } while (0)
        if (cs == 0) { CONV_ALL(); __syncthreads(); }
        ATTN_UNIT(F.vcu);
        if (cs == 1) { CONV_ALL(); __syncthreads(); }
        ATTN_UNIT(F.vcu + F.G);
        for (int lin2 = F.vcu + 2 * F.G; lin2 < 512; lin2 += F.G) ATTN_UNIT(lin2);
        if (cs == 2) { CONV_ALL(); __syncthreads(); }
#undef ATTN_UNIT
        SchedAG S{F.G, (int)blockIdx.x, args.ws};
        gemm_phase<EpiStore, SchedAG, false, true>(F.lds, DM, DM / 2, DM / 2, S, EpiStore{(const float*)(args.ws + WS_W2048)});
        if (cs == 3) { __syncthreads(); CONV_ALL(); }
#undef CONV_ALL
        SEAM(PH_ATTN);
    }
    if (IN(PH_F2)) {
        SchedF2 S{F.G, (int)blockIdx.x, args.ws};
        gemm_phase<EpiStore, SchedF2, false>(F.lds, 512, DM, 512, S, EpiStore{(const float*)(args.ws + WS_W2048)});
        {
            if (F.G == 256) {
                if (blockIdx.x >= 128) { const int w = ((int)blockIdx.x - 128) * NWAVES + F.wave;
#pragma unroll
                    for (int q = 0; q < 2; ++q) { const int o = w + 1024 * q, b = o >> 10, col = o & 1023, k2 = col & 127; const float* al = (const float*)(args.ws + WS_ALT) + b * FW + (col & ~127);
                        float s = al[F.lane] * cospif((float)((F.lane * k2) & 127) * (1.0f / 64.0f)) + al[F.lane + 64] * cospif((float)(((F.lane + 64) * k2) & 127) * (1.0f / 64.0f));
                        s = wave_sum(s);
                        if (F.lane == 0) ((bf16_t*)(args.ws + WS_YF))[((size_t)b * SEQ + SEQ / 2) * YFP + col] = f2bf(s * 0.0013810679320049757f); } }
            } else {
            const int idx = F.vcu * NTHREADS + F.tid;
            if (idx < 2 * FW) { const int b = idx >> 10, col = idx & 1023, k2 = col & 127; const float* al = (const float*)(args.ws + WS_ALT) + b * FW + (col & ~127); float s = 0.f;
                for (int c = 0; c < 128; ++c) s += al[c] * cospif((float)((c * k2) & 127) * (1.0f / 64.0f));
                ((bf16_t*)(args.ws + WS_YF))[((size_t)b * SEQ + SEQ / 2) * YFP + col] = f2bf(s * 0.0013810679320049757f); } }
        }
        SEAM(PH_F2);
    }
    if (IN(PH_MERGE)) {
        unsigned char* ws = args.ws;
        SchedMerge S{F.G, (int)blockIdx.x, ws};
        gemm_phase<EpiMerge, SchedMerge, false>(F.lds, DM, DM, DM, S, EpiMerge{(const unsigned char*)(ws + WS_SGF), (const unsigned char*)(ws + WS_SGA), (bf16_t*)(ws + WS_YM)});
        SEAM(PH_MERGE);
    }
    if (IN(PH_OUT)) {
        unsigned char* ws = args.ws;
        SchedGrid S{F.G, (int)blockIdx.x, 32, 8, (const char*)(ws + WS_YM), (const char*)(ws + WS_WT_O), nullptr, (size_t)256 * DM * 2, (size_t)256 * DM * 2, DM, 4, 1, DM / BK};
        gemm_phase<EpiX2, SchedGrid, false>(F.lds, DM, DM, DM, S, EpiX2{args.in[0], modp, (bf16_t*)(ws + WS_X2)});
        SEAM(PH_OUT);
    }
    if (IN(PH_ROUTE)) { ph_route(F, args, modp); SEAM(PH_ROUTE); }
    if (IN(PH_EXP1)) {
        moe_tables(F, 4);
        SchedMoe<4, true> S{F.G, F.vcu, args.ws, (LAS int*)(F.lds + SCHT_OFF), (const int*)(args.ws + WS_TOKE)};
        gemm_phase<EpiAct, SchedMoe<4, true>, true, true, false>(F.lds, DM, DM / 2, DM / 2, S, EpiAct{});
        SEAM(PH_EXP1);
    }
    if (IN(PH_EXP2)) {
        moe_tables(F, 8);
        SchedMoe<8, false> S{F.G, F.vcu, args.ws, (LAS int*)(F.lds + SCHT_OFF), (const int*)(args.ws + WS_TOKE)};
        gemm_phase<EpiY8, SchedMoe<8, false>, false, true, false>(F.lds, EFF, EFF / 2, EFF / 2, S, EpiY8{});
        SEAM(PH_EXP2);
    }
    if (IN(PH_COMB)) { ph_comb(F, args, modp); }
#undef IN
#undef SEAM
}
}

extern "C" void kernel_launch(void* const* d_in, const int* in_sizes, int n_in, void* d_out, int out_size, void* d_ws, size_t ws_size, hipStream_t stream) {
    if (n_in != 22 || ws_size < WS_END2) return;
    float* out = (float*)d_out;
    unsigned char* ws = (unsigned char*)d_ws;
    hipMemsetAsync(ws + WS_CTL, 0, CTL_ZERO_BYTES, stream);
    static int grid = 0;
    if (!grid) {
        int dev = 0, cus = 0;
        if (hipGetDevice(&dev) != hipSuccess || hipDeviceGetAttribute(&cus, hipDeviceAttributeMultiprocessorCount, dev) != hipSuccess) { grid = -1; return; }
        if (hipFuncSetAttribute((const void*)mk::fwd, hipFuncAttributeMaxDynamicSharedMemorySize, mk::LDS_BYTES) != hipSuccess) { grid = -1; return; }
        grid = cus;
    }
    if (grid < 0) return;
    mk::Args a{}; int nlaunch = 0;
    for (int i = 0; i < 22; ++i) a.in[i] = (const float*)d_in[i];
    a.out = out; a.ws = ws; a.use_ut = 1; a.mod_off = (int)WS_MOD; a.do_attn = 1;
#define MK_LAUNCH(lo_, hi_) do { a.ph_lo = (lo_); a.ph_hi = (hi_); a.bar_idx = nlaunch++; hipLaunchKernelGGL(mk::fwd, dim3(grid), dim3(mk::NTHREADS), mk::LDS_BYTES, stream, a); } while (0)
    MK_LAUNCH(mk::PH_PRO, mk::PH_END);
}
```

```cpp
#include <hip/hip_runtime.h>
#include <stdint.h>
#include <math.h>

typedef unsigned short bf16_t;
typedef short bf16x8 __attribute__((ext_vector_type(8)));
typedef float f32x16 __attribute__((ext_vector_type(16)));
typedef float f32x4 __attribute__((ext_vector_type(4)));

constexpr int NB = 2, SEQ = 4096, DM = 2048, NTOK = NB * SEQ, CTXL = 256, NCTX = NB * CTXL, HD = 128, NH = 16, NKV = 4;
constexpr int SKV = SEQ + CTXL;
constexpr int FW = 1024, INC = 8192, Q_OFF = 1024, K_OFF = 3072, V_OFF = 3584, GF_OFF = 4096, GA_OFF = 6144;
constexpr int KVW = NKV * HD;
constexpr int NE = 64, TOPK = 8, EFF = 512, MODC = 6 * DM;
constexpr int NSLOT = NTOK * TOPK;
constexpr int NSLOT_ALL = NSLOT + NTOK;

constexpr size_t MiB = 1u << 20;
constexpr size_t WS_CTL = 0, CTL_ZERO_BYTES = 128 * 1024;
constexpr size_t CTL_CNT = 64 * 1024;
constexpr size_t WS_TW = 1 * MiB;
constexpr size_t WS_MOD = 1 * MiB + 64 * 1024;
constexpr size_t WS_OFFS = 1 * MiB + 256 * 1024;
constexpr size_t WS_EIDX = 2 * MiB;
constexpr size_t WS_EW = WS_EIDX + 256 * 1024;
constexpr size_t WS_EPOS = WS_EW + 256 * 1024;
constexpr size_t WS_SLOTOF = WS_EPOS + 256 * 1024;
constexpr size_t WS_TOKE = 300 * MiB;
constexpr size_t WS_H = 4 * MiB;
constexpr size_t WS_U = 38 * MiB;
constexpr size_t WS_Q = 54 * MiB;
constexpr size_t WS_KALL = 86 * MiB;
constexpr size_t WS_VALL = 95 * MiB;
constexpr size_t WS_SGF = 104 * MiB;
constexpr size_t WS_SGA = 136 * MiB;
constexpr size_t WS_YA = 168 * MiB;
constexpr size_t WS_YF = 38 * MiB;
constexpr int YFP = 2048;
constexpr size_t WS_PR = 216 * MiB;
constexpr size_t WS_T1 = 248 * MiB;
constexpr size_t WS_YM = 312 * MiB;
constexpr size_t WS_QKRAW = 248 * MiB;
constexpr size_t WS_KCRAW = 330 * MiB;
constexpr size_t WS_H2 = 344 * MiB;
constexpr size_t WS_ACT = 376 * MiB;
constexpr size_t WS_YBIG = 4 * MiB;
constexpr size_t WS_END = 740 * MiB;

__device__ __forceinline__ float bf2f(bf16_t h) { return __uint_as_float(((unsigned)h) << 16); }
__device__ __forceinline__ bf16_t f2bf(float f) { unsigned u = __float_as_uint(f); return (bf16_t)((u + 0x7fffu + ((u >> 16) & 1u)) >> 16); }
__device__ __forceinline__ int crow(int r, int hi) { return (r & 3) + 8 * (r >> 2) + 4 * hi; }
__device__ __forceinline__ float wave_sum(float v) {
#pragma unroll
    for (int o = 1; o < 64; o <<= 1) v += __shfl_xor(v, o);
    return v;
}
__device__ __forceinline__ float sigmoidf_(float v) { return 1.0f / (1.0f + expf(-v)); }
__device__ __forceinline__ bf16x8 pack8(const float* f) {
    bf16x8 r;
#pragma unroll
    for (int i = 0; i < 8; ++i) r[i] = (short)f2bf(f[i]);
    return r;
}

#define LAS __attribute__((address_space(3)))
#define GAS __attribute__((address_space(1)))
typedef unsigned u32x4 __attribute__((ext_vector_type(4)));
typedef GAS unsigned gu32;
#define RLX_AGENT __ATOMIC_RELAXED, __HIP_MEMORY_SCOPE_AGENT
#define LDS_WAIT() asm volatile("s_waitcnt lgkmcnt(0)" ::: "memory")
#define VM_WAIT() asm volatile("s_waitcnt vmcnt(0)" ::: "memory")

constexpr size_t CTL_BAR = 16384;
constexpr size_t CTL_MODZ = 512 * 1024;
constexpr size_t WS_UT = 38 * MiB;
constexpr size_t WS_TT = 216 * MiB;
constexpr size_t WS_WT_GU = 450 * MiB;
constexpr size_t WS_WT_D = 710 * MiB;
constexpr size_t WS_WT_IN = 840 * MiB;
constexpr size_t WS_WT_FO = 924 * MiB;
constexpr size_t WS_WT_AO = 876 * MiB;
constexpr size_t WS_WT_O = 884 * MiB;
constexpr size_t WS_CST = 892 * MiB;
constexpr size_t WS_ET = 908 * MiB;
constexpr size_t WS_OT = 916 * MiB;
constexpr size_t WS_W2048 = 1 * MiB + 512 * 1024;
constexpr size_t WS_ALT = 1 * MiB + 520 * 1024;
constexpr size_t WS_ROPE = 1 * MiB + 528 * 1024;
constexpr size_t WS_RWT = 3 * MiB + 512 * 1024;
constexpr size_t WS_BD2 = 956 * MiB;
constexpr size_t WS_H8 = 200 * MiB;
constexpr size_t WS_WT_G8 = 932 * MiB;
constexpr size_t WS_X2 = 960 * MiB;
constexpr size_t WS_END2 = 1024 * MiB;

namespace mk {
constexpr int NWAVES = 8, NTHREADS = 512;
constexpr int RING_BYTES = 131072, SCR_BYTES = 8 * 16640, LDSCTL_OFF = 135168, MISC_OFF = LDSCTL_OFF + 320, GPARK_OFF = LDSCTL_OFF + 2048  , LDS_BYTES = 147456;
static_assert(GPARK_OFF + 8192 <= LDS_BYTES, "LDS map");
static_assert(SCR_BYTES <= LDSCTL_OFF && MISC_OFF + 128 <= LDS_BYTES, "LDS map");

#define XB_TMO      128
#define XB_XCNT(j)  (256  + 64 * (j))
#define XB_XSUB(j)  (1280 + 64 * (j))
#define XB_XGEN(j)  (2304 + 64 * (j))
#define XB_TOP      3328
#define XB_TOPGEN   3392
#define XCD_BAR_WORDS 3456
#define XB_SPIN_CAP (1u << 18)
__device__ __forceinline__ unsigned xb_ld(unsigned* p)              { return __hip_atomic_load(p, __ATOMIC_RELAXED, __HIP_MEMORY_SCOPE_AGENT); }
__device__ __forceinline__ unsigned xb_add(unsigned* p, unsigned v) { return __hip_atomic_fetch_add(p, v, __ATOMIC_RELAXED, __HIP_MEMORY_SCOPE_AGENT); }
__device__ __forceinline__ unsigned xb_xcc_id() { return (unsigned)__builtin_amdgcn_s_getreg((3 << 11) | 20) & 0xFu; }
#define XB_SPIN(cond, bar) do { unsigned _sp = 0; while (cond) { __builtin_amdgcn_s_sleep(1); \
    if ((++_sp & 255u) == 0u) { if (xb_ld(&(bar)[XB_TMO])) break; if (_sp > XB_SPIN_CAP) { atomicAdd(&(bar)[XB_TMO], 1u); break; } } } } while (0)
struct XcdBarrier { unsigned* bar; unsigned x; volatile LAS unsigned* st; };
__device__ __forceinline__ XcdBarrier xcd_barrier_post(unsigned* bar, volatile LAS unsigned* st) {
    XcdBarrier b; b.bar = bar; b.x = xb_xcc_id(); b.st = st;
    if (threadIdx.x == 0) (void)xb_add(&bar[XB_XCNT(b.x)], 1u);
    return b;
}
__device__ __forceinline__ void xcd_barrier_complete(unsigned* bar, unsigned x, unsigned& nloc, unsigned& nx) {
    const unsigned G = gridDim.x * gridDim.y * gridDim.z;
    unsigned sum, cnt, mine, sp = 0u;
    for (;;) {
        sum = 0u; cnt = 0u; mine = 0u;
#pragma unroll
        for (unsigned j = 0; j < 16; ++j) { const unsigned c = xb_ld(&bar[XB_XCNT(j)]); sum += c; cnt += (c > 0u) ? 1u : 0u; mine = (j == x) ? c : mine; }
        if (sum == G) break;
        __builtin_amdgcn_s_sleep(1);
        if ((++sp & 255u) == 0u) { if (xb_ld(&bar[XB_TMO])) break; if (sp > XB_SPIN_CAP) { atomicAdd(&bar[XB_TMO], 1u); break; } }
    }
    nloc = mine > 0u ? mine : 1u; nx = cnt > 0u ? cnt : 1u;
}
__device__ __forceinline__ void xcd_barrier(const XcdBarrier& b) {
    asm volatile("s_waitcnt vmcnt(0)" ::: "memory");
    __syncthreads();
    if (threadIdx.x == 0) {
        unsigned* bar = b.bar;
        __builtin_amdgcn_s_waitcnt(0);
        unsigned nloc = b.st[0], nx = b.st[1];
        if (nloc == 0u) { xcd_barrier_complete(bar, b.x, nloc, nx); b.st[0] = nloc; b.st[1] = nx; }
        const unsigned old = xb_add(&bar[XB_XSUB(b.x)], 1u);
        const unsigned gen = old / nloc;
        if (old + 1u == (gen + 1u) * nloc) {
            __builtin_amdgcn_fence(__ATOMIC_RELEASE, "agent");
            asm volatile("s_waitcnt vmcnt(0)" ::: "memory");
            const unsigned og = xb_add(&bar[XB_TOP], 1u);
            const unsigned tg = og / nx;
            if (og + 1u == (tg + 1u) * nx) xb_add(&bar[XB_TOPGEN], 1u);
            else XB_SPIN(xb_ld(&bar[XB_TOPGEN]) == tg, bar);
            __builtin_amdgcn_fence(__ATOMIC_ACQUIRE, "agent");
            xb_add(&bar[XB_XGEN(b.x)], 1u);
            asm volatile("s_waitcnt vmcnt(0)" ::: "memory");
        } else {
            XB_SPIN(xb_ld(&bar[XB_XGEN(b.x)]) == gen, bar);
            __builtin_amdgcn_fence(__ATOMIC_ACQUIRE, "agent");
            asm volatile("s_waitcnt vmcnt(0)" ::: "memory");
        }
    }
    __syncthreads();
}

constexpr int BM = 256, BK = 64, HALF = 128, HTB = HALF * BK * 2, STAGE_BYTES = 8 * HTB;
__device__ __forceinline__ int lds_byte(int r, int c) { const int st = (r >> 4) * 2 + (c >> 5), rr = r & 15, cc = c & 31, ob = rr * 64 + cc * 2; return st * 1024 + (ob ^ (((ob >> 9) & 1) << 5)); }
__device__ __forceinline__ void stage_rc(int b, int& R, int& C) { const int st = b / 1024, sb = b % 1024, swz = sb ^ (((sb >> 9) & 1) << 5); R = (st >> 1) * 16 + swz / 64; C = (st & 1) * 32 + (swz % 64) / 2; }
__device__ __forceinline__ int perm32(int rho) { const int n = rho >> 4, i = rho & 15; return 8 * (i >> 2) + 4 * n + (i & 3); }
__device__ __forceinline__ unsigned cvt_pk_bf16(float lo, float hi) { unsigned r; asm("v_cvt_pk_bf16_f32 %0, %1, %2" : "=v"(r) : "v"(lo), "v"(hi)); return r; }

__device__ __forceinline__ void glds16_s(const void* sbase, unsigned voff, unsigned lds_dst) { unsigned keep;
    asm volatile("s_mov_b32 %0, m0\n\ts_mov_b32 m0, %3\n\ts_nop 0\n\tglobal_load_lds_dwordx4 %1, %2\n\ts_mov_b32 m0, %0" : "=&s"(keep) : "v"(voff), "s"(sbase), "s"(lds_dst) : "memory"); }

struct Unit { const char* A; const char* B; char* C; int ldc; int mode; int rows; int aux; int pm, pn, bjs, rmin, e, nt, keep; };

typedef int i32x8 __attribute__((ext_vector_type(8)));
typedef int i32x4 __attribute__((ext_vector_type(4)));
template <class Epi, class Sched, bool GATHER, bool F8 = false, bool OPQ = false>
__device__ __forceinline__ void gemm_phase(LAS unsigned char* lds, const int K, const int lda, const int ldb, const Sched& S, const Epi& E, const int i0 = 0, const int i1 = 0x7fffffff) {
    int tid_ = threadIdx.x; if constexpr (OPQ) asm volatile("" : "+v"(tid_));
    const int tid = tid_, wid = __builtin_amdgcn_readfirstlane(tid >> 6), lane = tid & 63, wr = wid >> 2, wc = wid & 3, fr = lane & 15, fq = lane >> 4;
    unsigned voffA[2], voffB[2];
#pragma unroll
    for (int i = 0; i < 2; ++i) { int R, C; stage_rc(tid * 16 + i * 8192, R, C); const int Rb = (R & ~31) + perm32(R & 31);
        voffA[i] = (unsigned)(R * lda + C) * 2u; voffB[i] = (unsigned)(Rb * ldb + C) * 2u; }
    const size_t kstep = (size_t)(BK * 2);
    const size_t hstepA = (size_t)HALF * lda * 2, hstepB = (size_t)HALF * ldb * 2;
    const unsigned ldsw = (unsigned)wid * 1024u;
    const unsigned ldsbase = (unsigned)__builtin_amdgcn_readfirstlane((int)(unsigned)(uintptr_t)lds);
    const int aoff = lds_byte(wr * 64 + fr, fq * 8), boff = lds_byte(wc * 32 + fr, fq * 8);

#define MK_SA(b, h) (((b) * 2 + (h)) * HTB)
#define MK_SB(b, h) ((4 + (b) * 2 + (h)) * HTB)
#define MK_STAGE2(bufoff, gbase, v0, v1) do { \
        __builtin_amdgcn_global_load_lds((const unsigned*)((const char*)(gbase) + (v0)), (LAS unsigned*)(lds + (bufoff) + ldsw), 16, 0, 0); \
        __builtin_amdgcn_global_load_lds((const unsigned*)((const char*)(gbase) + (v1)), (LAS unsigned*)(lds + (bufoff) + ldsw + 8192), 16, 0, 0); } while (0)
#define MK_STAGE_B(bufoff, gbase) do { glds16_s((gbase), voffB[0], ldsbase + (bufoff) + ldsw); glds16_s((gbase), voffB[1], ldsbase + (bufoff) + ldsw + 8192u); } while (0)
#define MK_STAGE_A(bufoff, gbase, h, VA) do { if constexpr (GATHER) { glds16_s((gbase), (VA)[h][0], ldsbase + (bufoff) + ldsw); glds16_s((gbase), (VA)[h][1], ldsbase + (bufoff) + ldsw + 8192u); } \
        else { glds16_s((gbase) + (h) * hstepA, voffA[0], ldsbase + (bufoff) + ldsw); glds16_s((gbase) + (h) * hstepA, voffA[1], ldsbase + (bufoff) + ldsw + 8192u); } } while (0)
#define MK_LDA(dst, b, h) do { if constexpr (F8) { _Pragma("unroll") for (int m = 0; m < 4; ++m) { const i32x4 p0 = *(const LAS i32x4*)(lds + MK_SA(b, h) + aoff + m * 2048), p1 = *(const LAS i32x4*)(lds + MK_SA(b, h) + aoff + m * 2048 + 1024); dst##8[m] = (i32x8){p0[0], p0[1], p0[2], p0[3], p1[0], p1[1], p1[2], p1[3]}; } } \
        else { _Pragma("unroll") for (int m = 0; m < 4; ++m) _Pragma("unroll") for (int k = 0; k < 2; ++k) dst[m][k] = *(const LAS bf16x8*)(lds + MK_SA(b, h) + aoff + m * 2048 + k * 1024); } } while (0)
#define MK_LDB(dst, b, h) do { if constexpr (F8) { _Pragma("unroll") for (int n = 0; n < 2; ++n) { const i32x4 p0 = *(const LAS i32x4*)(lds + MK_SB(b, h) + boff + n * 2048), p1 = *(const LAS i32x4*)(lds + MK_SB(b, h) + boff + n * 2048 + 1024); dst##8[n] = (i32x8){p0[0], p0[1], p0[2], p0[3], p1[0], p1[1], p1[2], p1[3]}; } } \
        else { _Pragma("unroll") for (int n = 0; n < 2; ++n) _Pragma("unroll") for (int k = 0; k < 2; ++k) dst[n][k] = *(const LAS bf16x8*)(lds + MK_SB(b, h) + boff + n * 2048 + k * 1024); } } while (0)
#define MK_MMA(ai, bj, At, Bt) do { __builtin_amdgcn_s_setprio(1); \
        if constexpr (F8) { _Pragma("unroll") for (int m = 0; m < 4; ++m) _Pragma("unroll") for (int n = 0; n < 2; ++n) \
            acc[ai][bj][m][n] = __builtin_amdgcn_mfma_scale_f32_16x16x128_f8f6f4(Bt##8[n], At##8[m], acc[ai][bj][m][n], 0, 0, 0, 0x7d, 0, 0x7d  ); } \
        else { _Pragma("unroll") for (int m = 0; m < 4; ++m) _Pragma("unroll") for (int n = 0; n < 2; ++n) _Pragma("unroll") for (int k = 0; k < 2; ++k) \
            acc[ai][bj][m][n] = __builtin_amdgcn_mfma_f32_16x16x32_bf16(Bt[n][k], At[m][k], acc[ai][bj][m][n], 0, 0, 0); } \
        __builtin_amdgcn_s_setprio(0); } while (0)
#define MK_WAIT_V(n) asm volatile("s_waitcnt vmcnt(" #n ")" ::: "memory")
#define MK_WAIT_L(n) asm volatile("s_waitcnt lgkmcnt(" #n ")" ::: "memory")
#define MK_BAR __builtin_amdgcn_s_barrier()
#define MK_SCHED __builtin_amdgcn_sched_barrier(0)
    Unit cur, nxt; int ui = i0;
    if (i0 >= i1 || !S.next(i0, cur)) return;
    f32x4 acc[2][2][4][2];
#pragma unroll
    for (int a = 0; a < 2; ++a)
#pragma unroll
        for (int b = 0; b < 2; ++b)
#pragma unroll
            for (int m = 0; m < 4; ++m)
#pragma unroll
                for (int n = 0; n < 2; ++n) acc[a][b][m][n] = (f32x4){0.f, 0.f, 0.f, 0.f};
    bf16x8 At[4][2], B0[2][2], B1[2][2]; i32x8 At8[4], B08[2], B18[2];
    unsigned vC[2][2];
    LAS u32x4* vpark = (LAS u32x4*)(lds + GPARK_OFF) + tid;
    if constexpr (GATHER) {
#pragma unroll
        for (int h = 0; h < 2; ++h)
#pragma unroll
            for (int i = 0; i < 2; ++i) { int R, C; stage_rc(tid * 16 + i * 8192, R, C); vC[h][i] = S.arow(cur, h * HALF + R) + (unsigned)(C * 2); }
    }
    const char* cA = cur.A; const char* cB = cur.B;
    MK_STAGE_B(MK_SB(0, 0), cB); MK_STAGE_B(MK_SB(0, 1), cB + hstepB); MK_STAGE_A(MK_SA(0, 0), cA, 0, vC); MK_STAGE_A(MK_SA(0, 1), cA, 1, vC);
    if (wr == 1) MK_BAR;
    MK_WAIT_V(2); MK_BAR;
    MK_STAGE_B(MK_SB(1, 0), cB + kstep); MK_STAGE_A(MK_SA(1, 0), cA + kstep, 0, vC); MK_STAGE_B(MK_SB(1, 1), cB + hstepB + kstep);
    MK_WAIT_V(6); MK_BAR;
    for (;;) {
        const bool has_next = (ui + 1 < i1) && S.next(ui + 1, nxt);
        const char* nA = has_next ? nxt.A : cA; const char* nB = has_next ? nxt.B : cB;
        if constexpr (GATHER) {
            u32x4 pv;
#pragma unroll
            for (int h = 0; h < 2; ++h)
#pragma unroll
                for (int i = 0; i < 2; ++i) { int R, C; stage_rc(tid * 16 + i * 8192, R, C); pv[h * 2 + i] = has_next ? (S.arow(nxt, h * HALF + R) + (unsigned)(C * 2)) : vC[h][i]; }
            *vpark = pv;
        }
        int nt = cur.nt; asm volatile("" : "+s"(nt));
#pragma nounroll
        for (int t = 0; t < nt; t += 2) {
            const bool last = (t == nt - 2);
            const char* a1 = cA + (size_t)(t + 1) * kstep;
            const char* a2 = last ? nA : cA + (size_t)(t + 2) * kstep; const char* b2 = last ? nB : cB + (size_t)(t + 2) * kstep;
            const char* a3 = a2 + kstep; const char* b3 = b2 + kstep;
            MK_LDB(B0, 0, 0); MK_LDB(B1, 0, 1); MK_SCHED; MK_LDA(At, 0, 0); MK_STAGE_A(MK_SA(1, 1), a1, 1, vC);
            if constexpr (GATHER) { if (last) { const u32x4 pv = *vpark; vC[0][0] = pv[0]; vC[0][1] = pv[1]; vC[1][0] = pv[2]; vC[1][1] = pv[3]; } }
            MK_WAIT_V(8); MK_WAIT_L(0); MK_BAR; MK_MMA(0, 0, At, B0); MK_MMA(0, 1, At, B1); MK_BAR; MK_SCHED;
            MK_LDA(At, 0, 1); MK_STAGE_B(MK_SB(0, 0), b2); MK_STAGE_B(MK_SB(0, 1), b2 + hstepB); MK_STAGE_A(MK_SA(0, 0), a2, 0, vC);
            MK_WAIT_V(8); MK_WAIT_L(0); MK_BAR; MK_MMA(1, 0, At, B0); MK_MMA(1, 1, At, B1); MK_BAR; MK_SCHED;
            MK_LDB(B0, 1, 0); MK_LDB(B1, 1, 1); MK_SCHED; MK_LDA(At, 1, 0); MK_STAGE_A(MK_SA(0, 1), a2, 1, vC);
            MK_WAIT_V(8); MK_WAIT_L(0); MK_BAR; MK_MMA(0, 0, At, B0); MK_MMA(0, 1, At, B1); MK_BAR; MK_SCHED;
            MK_LDA(At, 1, 1); MK_STAGE_B(MK_SB(1, 0), b3); MK_STAGE_B(MK_SB(1, 1), b3 + hstepB); MK_STAGE_A(MK_SA(1, 0), a3, 0, vC);
            MK_WAIT_V(8); MK_WAIT_L(0); MK_BAR; MK_MMA(1, 0, At, B0); MK_MMA(1, 1, At, B1); MK_BAR; MK_SCHED;
        }
        if (wr == 0) MK_BAR;
        { int l2; asm volatile("v_mbcnt_lo_u32_b32 %0, -1, 0\n\tv_mbcnt_hi_u32_b32 %0, -1, %0" : "=v"(l2));
          E(acc, cur, wr, wc, l2 & 15, l2 >> 4); }
        if (!has_next) break;
        if (!cur.keep)
#pragma unroll
        for (int a = 0; a < 2; ++a)
#pragma unroll
            for (int b = 0; b < 2; ++b)
#pragma unroll
                for (int m = 0; m < 4; ++m)
#pragma unroll
                    for (int n = 0; n < 2; ++n) acc[a][b][m][n] = (f32x4){0.f, 0.f, 0.f, 0.f};
        cur = nxt; cA = nA; cB = nB; ++ui;
        if (wr == 1) MK_BAR;
    }
    MK_WAIT_V(0);
    MK_BAR;
#undef MK_SA
#undef MK_SB
#undef MK_STAGE2
#undef MK_STAGE_B
#undef MK_STAGE_A
#undef MK_LDA
#undef MK_LDB
#undef MK_MMA
#undef MK_WAIT_V
#undef MK_WAIT_L
#undef MK_BAR
#undef MK_SCHED
}

__device__ __forceinline__ void grid_map(int L, int nM, int nN, int& pm, int& pn) {
    const int nwg = nM * nN, q = nwg / 8, xcd = L % 8, off = L / 8; const int wgid = xcd * q + off;
    const int nig = 8 * nN, gid = wgid / nig, fm = gid * 8, gsz = (nM - fm) < 8 ? (nM - fm) : 8;
    pm = fm + ((wgid % nig) % gsz); pn = (wgid % nig) / gsz;
}

struct EpiStore {
    const float* w2048;
    __device__ __forceinline__ void operator()(f32x4 (&acc)[2][2][4][2], const Unit& u, int wr, int wc, int fr, int fq) const {
        const int col0 = wc * 32 + 8 * fq;
#pragma unroll
        for (int ai = 0; ai < 2; ++ai)
#pragma unroll
            for (int m = 0; m < 4; ++m) {
                const int r = ai * HALF + wr * 64 + m * 16 + fr;
                if (r < u.rows && r >= u.rmin) {
#pragma unroll
                    for (int bj = 0; bj < 2; ++bj) {
                        f32x4 v0 = acc[ai][bj][m][0], v1 = acc[ai][bj][m][1];
                        if (u.mode == 1) { float* p = (float*)u.C + (long)r * u.ldc + col0 + bj * u.bjs; *(f32x4*)p = v0; *(f32x4*)(p + 4) = v1; }
                        else if (u.mode == 2) {
                            unsigned q[8];
#pragma unroll
                            for (int c = 0; c < 4; ++c) { q[c] = (unsigned)(255.0f * __builtin_amdgcn_rcpf(1.0f + __expf(-v0[c])) + 0.5f); q[4 + c] = (unsigned)(255.0f * __builtin_amdgcn_rcpf(1.0f + __expf(-v1[c])) + 0.5f); }
                            const unsigned lo = q[0] | (q[1] << 8) | (q[2] << 16) | (q[3] << 24), hi = q[4] | (q[5] << 8) | (q[6] << 16) | (q[7] << 24);
                            *(unsigned long long*)((unsigned char*)u.C + (long)r * u.ldc + col0 + bj * u.bjs) = (unsigned long long)lo | ((unsigned long long)hi << 32); }
                        else {
                            if (u.mode == 3) {
                                const float* wp = w2048 + u.pn + bj * HALF + col0; const float sg = (r & 1) ? -1.0f : 1.0f;
                                v0 += *(const f32x4*)wp * sg; v1 += *(const f32x4*)(wp + 4) * sg;
                            }
                            u32x4 w; w.x = cvt_pk_bf16(v0[0], v0[1]); w.y = cvt_pk_bf16(v0[2], v0[3]); w.z = cvt_pk_bf16(v1[0], v1[1]); w.w = cvt_pk_bf16(v1[2], v1[3]);
                            *(u32x4*)((bf16_t*)u.C + (long)r * u.ldc + col0 + bj * u.bjs) = w;
                        }
                    }
                }
            }
    }
};


struct EpiYF8 {
    __device__ __forceinline__ void operator()(f32x4 (&acc)[2][2][4][2], const Unit& u, int wr, int wc, int fr, int fq) const {
        const int col0 = wc * 32 + 8 * fq;
#pragma unroll
        for (int ai = 0; ai < 2; ++ai)
#pragma unroll
            for (int m = 0; m < 4; ++m) { const int r = ai * HALF + wr * 64 + m * 16 + fr;
                if (r < u.rows && r >= u.rmin) {
#pragma unroll
                    for (int bj = 0; bj < 2; ++bj) { const f32x4 v0 = acc[ai][bj][m][0], v1 = acc[ai][bj][m][1]; int w0 = 0, w1 = 0;
                        w0 = __builtin_amdgcn_cvt_pk_fp8_f32(fminf(fmaxf(v0[0], -448.f), 448.f), fminf(fmaxf(v0[1], -448.f), 448.f), w0, false); w0 = __builtin_amdgcn_cvt_pk_fp8_f32(fminf(fmaxf(v0[2], -448.f), 448.f), fminf(fmaxf(v0[3], -448.f), 448.f), w0, true);
                        w1 = __builtin_amdgcn_cvt_pk_fp8_f32(fminf(fmaxf(v1[0], -448.f), 448.f), fminf(fmaxf(v1[1], -448.f), 448.f), w1, false); w1 = __builtin_amdgcn_cvt_pk_fp8_f32(fminf(fmaxf(v1[2], -448.f), 448.f), fminf(fmaxf(v1[3], -448.f), 448.f), w1, true);
                        *(unsigned long long*)((unsigned char*)u.C + (long)r * u.ldc + col0 + bj * u.bjs) = (unsigned long long)(unsigned)w0 | ((unsigned long long)(unsigned)w1 << 32); } } }
    } };
struct EpiIn { EpiStore base; LAS float* red; const float* qnw; const float* knw; const float* rope;
    __device__ __forceinline__ void operator()(f32x4 (&acc)[2][2][4][2], const Unit& u, int wr, int wc, int fr, int fq) const {
        if (u.mode < 5) { base(acc, u, wr, wc, fr, fq); return; }
#pragma unroll
        for (int ai = 0; ai < 2; ++ai)
#pragma unroll
            for (int m = 0; m < 4; ++m)
#pragma unroll
                for (int bj = 0; bj < 2; ++bj) { const f32x4 a = acc[ai][bj][m][0], b = acc[ai][bj][m][1];
                    float s = (a[0] * a[0] + a[1] * a[1]) + (a[2] * a[2] + a[3] * a[3]) + (b[0] * b[0] + b[1] * b[1]) + (b[2] * b[2] + b[3] * b[3]);
                    { const int lid = fq * 16 + fr;
                      s += __int_as_float(__builtin_amdgcn_ds_bpermute((lid ^ 16) << 2, __float_as_int(s))); s += __int_as_float(__builtin_amdgcn_ds_bpermute((lid ^ 32) << 2, __float_as_int(s))); }
                    if (fq == 0) red[((ai * HALF + wr * 64 + m * 16 + fr) * 2 + bj) * 4 + wc] = s; }
        asm volatile("s_waitcnt lgkmcnt(0)" ::: "memory"); __builtin_amdgcn_s_barrier(); asm volatile("" ::: "memory");
        const float* nw = u.mode == 5 ? qnw : knw;
        float eps = 1e-6f; asm volatile("" : "+s"(eps));
        const int axis = wc >> 1, f0 = (wc & 1) * 16 + fq * 4, da = axis * 64 + f0;
        const f32x4 wa = *(const f32x4*)(nw + da), wb = *(const f32x4*)(nw + da + 32);
#pragma unroll
        for (int ai = 0; ai < 2; ++ai)
#pragma unroll
            for (int m = 0; m < 4; ++m) { const int r = ai * HALF + wr * 64 + m * 16 + fr;
                f32x4 cs = {1.f, 1.f, 1.f, 1.f}, sn = {0.f, 0.f, 0.f, 0.f};
                if (u.mode != 7) { const int t = u.pm + r, pos = axis ? (t & 63) : (t >> 6); const float* rp = rope + (pos * 32 + f0) * 2;
                    const f32x4 p0 = *(const f32x4*)rp, p1 = *(const f32x4*)(rp + 4); cs = (f32x4){p0[0], p0[2], p1[0], p1[2]}; sn = (f32x4){p0[1], p0[3], p1[1], p1[3]}; }
#pragma unroll
                for (int bj = 0; bj < 2; ++bj) { const LAS f32x4* pp = (const LAS f32x4*)(red + (r * 2 + bj) * 4); const f32x4 ps = *pp;
                    const float rstd = __builtin_amdgcn_rsqf(((ps[0] + ps[1]) + (ps[2] + ps[3])) * (1.0f / HD) + eps);
                    const f32x4 xa = acc[ai][bj][m][0] * rstd * wa, xb = acc[ai][bj][m][1] * rstd * wb;
                    const f32x4 oa = xa * cs - xb * sn, ob = xb * cs + xa * sn;
                    u32x4 w; w.x = cvt_pk_bf16(oa[0], oa[1]); w.y = cvt_pk_bf16(oa[2], oa[3]); w.z = cvt_pk_bf16(ob[0], ob[1]); w.w = cvt_pk_bf16(ob[2], ob[3]);
                    *(u32x4*)((bf16_t*)u.C + (long)r * u.ldc + bj * HALF + wc * 32 + 8 * fq) = w; } }
    } };


__device__ __forceinline__ void pack8_fp8(const f32x4& a, const f32x4& b, unsigned& w0, unsigned& w1) {
    f32x4 v0 = a, v1 = b;
#pragma unroll
    for (int c = 0; c < 4; ++c) { v0[c] = fminf(fmaxf(v0[c], -448.f), 448.f); v1[c] = fminf(fmaxf(v1[c], -448.f), 448.f); }
    int x0 = 0, x1 = 0;
    x0 = __builtin_amdgcn_cvt_pk_fp8_f32(v0[0], v0[1], x0, false); x0 = __builtin_amdgcn_cvt_pk_fp8_f32(v0[2], v0[3], x0, true);
    x1 = __builtin_amdgcn_cvt_pk_fp8_f32(v1[0], v1[1], x1, false); x1 = __builtin_amdgcn_cvt_pk_fp8_f32(v1[2], v1[3], x1, true);
    w0 = (unsigned)x0; w1 = (unsigned)x1;
}
__device__ __forceinline__ void store16_s(const void* sbase, unsigned voff, u32x4 v) { asm volatile("global_store_dwordx4 %0, %1, %2\n\ts_nop 1" :: "v"(voff), "v"(v), "s"(sbase) : "memory"); }
struct EpiY8 {
    __device__ __forceinline__ void operator()(f32x4 (&acc)[2][2][4][2], const Unit& u, int wr, int wc, int fr, int fq) const {
        const int odd = fq & 1;
        const unsigned off0 = (unsigned)((wr * 64 + fr) * u.ldc + odd * HALF + wc * 32 + 8 * (fq - odd));
        const int r0 = wr * 64 + fr;
#pragma unroll
        for (int ai = 0; ai < 2; ++ai)
#pragma unroll
            for (int m = 0; m < 4; ++m) {
                unsigned a0, a1, b0, b1; pack8_fp8(acc[ai][0][m][0], acc[ai][0][m][1], a0, a1); pack8_fp8(acc[ai][1][m][0], acc[ai][1][m][1], b0, b1);
                const auto s0 = __builtin_amdgcn_permlane16_swap(a0, b0, false, false), s1 = __builtin_amdgcn_permlane16_swap(a1, b1, false, false);
                if (r0 + ai * HALF + m * 16 < u.rows) { const u32x4 w = {s0[0], s1[0], s0[1], s1[1]}; store16_s(u.C, off0 + (unsigned)((ai * HALF + m * 16) * u.ldc), w); } }
    } };


struct EpiGate {
    __device__ __forceinline__ void operator()(f32x4 (&acc)[2][2][4][2], const Unit& u, int wr, int wc, int fr, int fq) const {
        bf16_t* base = (bf16_t*)u.C + (size_t)(wr * 64 + fr) * u.ldc + wc * 32 + 8 * fq;
#pragma unroll
        for (int ai = 0; ai < 2; ++ai)
#pragma unroll
            for (int m = 0; m < 4; ++m) { bf16_t* p = base + (size_t)(ai * HALF + m * 16) * u.ldc;
#pragma unroll
                for (int bj = 0; bj < 2; ++bj) { f32x4 v0 = acc[ai][bj][m][0], v1 = acc[ai][bj][m][1];
#pragma unroll
                    for (int c = 0; c < 4; ++c) { v0[c] = __builtin_amdgcn_rcpf(1.0f + __expf(-v0[c])); v1[c] = __builtin_amdgcn_rcpf(1.0f + __expf(-v1[c])); }
                    u32x4 w; w.x = cvt_pk_bf16(v0[0], v0[1]); w.y = cvt_pk_bf16(v0[2], v0[3]); w.z = cvt_pk_bf16(v1[0], v1[1]); w.w = cvt_pk_bf16(v1[2], v1[3]);
                    *(u32x4*)(p + bj * HALF) = w; } }
    } };

struct Args { const float* in[22]; float* out; unsigned char* ws; int ph_lo, ph_hi, use_ut, mod_off, do_attn, bar_idx; };
struct Frame {
    LAS unsigned char* lds; volatile LAS unsigned* MISC; unsigned char* ws;
    int tid, lane, wave, vcu, G;
};

__device__ __forceinline__ int qk_col_of_dim(int d) { const int a = d >> 6, half = (d >> 5) & 1, f = d & 31; return 32 * (2 * a + (f >> 4)) + 8 * ((f >> 2) & 3) + 4 * half + (f & 3); }
__device__ __forceinline__ void t64_load(f32x4 (&v)[16], const float* W, int ldw, int lane) {
    const unsigned off = (unsigned)(((lane >> 4) * ldw + (lane & 15) * 4) * 4);
#pragma unroll
    for (int j = 0; j < 16; ++j) { const char* bj = (const char*)W + (size_t)(j * 4) * ldw * 4; v[j] = __builtin_nontemporal_load((const GAS f32x4*)(bj + off)); }
}
template <bool QKPERM = false, bool F8OUT = false>
__device__ __forceinline__ void t64_store(const f32x4 (&v)[16], bf16_t* dst, int ldd, LAS float* scr, int lane, int d0 = 0) {
    const int kk = lane >> 4, nc = (lane & 15) * 4;
#pragma unroll
    for (int j = 0; j < 16; ++j) {
#pragma unroll
        for (int c = 0; c < 4; ++c) scr[(j * 4 + kk) * 65 + nc + c] = v[j][c]; }
    LDS_WAIT(); asm volatile("" ::: "memory");
    const int kc = lane & 7; const unsigned soff = F8OUT ? (unsigned)((lane >> 3) * ldd + 8 * kc) : (unsigned)(((lane >> 3) * ldd + 8 * kc) * 2);
#pragma unroll
    for (int jj = 0; jj < 8; jj += 2) {
        float t[2][8];
#pragma unroll
        for (int q = 0; q < 2; ++q) { const int n = (lane >> 3) + 8 * (jj + q); const LAS float* s = scr + (8 * kc) * 65 + n;
#pragma unroll
            for (int i = 0; i < 8; ++i) t[q][i] = s[i * 65]; }
#pragma unroll
        for (int q = 0; q < 2; ++q) { char* bq = (char*)dst + (size_t)(8 * (jj + q)) * ldd * (F8OUT ? 1 : 2);
            if constexpr (QKPERM) bq = (char*)dst + (size_t)(qk_col_of_dim(d0 + (lane >> 3) + 8 * (jj + q)) - (lane >> 3)) * ldd * (F8OUT ? 1 : 2);
            if constexpr (F8OUT) { float s[8];
#pragma unroll
                for (int i = 0; i < 8; ++i) s[i] = fminf(fmaxf(t[q][i] * 16.0f, -448.f), 448.f);
                int w0 = 0, w1 = 0; w0 = __builtin_amdgcn_cvt_pk_fp8_f32(s[0], s[1], w0, false); w0 = __builtin_amdgcn_cvt_pk_fp8_f32(s[2], s[3], w0, true);
                w1 = __builtin_amdgcn_cvt_pk_fp8_f32(s[4], s[5], w1, false); w1 = __builtin_amdgcn_cvt_pk_fp8_f32(s[6], s[7], w1, true);
                __builtin_nontemporal_store((unsigned long long)(unsigned)w0 | ((unsigned long long)(unsigned)w1 << 32), (GAS unsigned long long*)(bq + soff)); }
            else { u32x4 o; o.x = cvt_pk_bf16(t[q][0], t[q][1]); o.y = cvt_pk_bf16(t[q][2], t[q][3]); o.z = cvt_pk_bf16(t[q][4], t[q][5]); o.w = cvt_pk_bf16(t[q][6], t[q][7]);
                __builtin_nontemporal_store(o, (GAS u32x4*)(bq + soff)); } } }
    LDS_WAIT(); asm volatile("" ::: "memory");
}
__device__ __forceinline__ void transpose64_f8(const float* W, int ldw, unsigned char* dst, int ldd, LAS float* scr, int lane) {
    f32x4 v[16]; t64_load(v, W, ldw, lane); t64_store<false, true>(v, (bf16_t*)dst, ldd, scr, lane);
}
__device__ __forceinline__ void transpose64(const float* W, int ldw, bf16_t* dst, int ldd, LAS float* scr, int lane) {
    f32x4 v[16]; t64_load(v, W, ldw, lane); t64_store(v, dst, ldd, scr, lane);
}

constexpr int IT_IN = 32 * 128, IT_FO = 16 * 32, IT_AO = 32 * 32, IT_O = 32 * 32, IT_EG = 64 * 256, IT_EU = 64 * 256, IT_ED = 64 * 256, IT_SH = 256;
constexpr int IT_T_END = IT_IN + IT_FO + IT_AO + IT_O + 3 * IT_SH;
constexpr int IT_MOD = MODC / 32, IT_CST = 4096, IT_BD2 = 512, IT_RWT = 32, IT_ROPE = 32;
constexpr int IT_ALL = IT_T_END + IT_MOD + IT_CST + IT_BD2 + IT_RWT + IT_ROPE;

__device__ __forceinline__ void mod_item(const Args& args, unsigned char* ws, int r, int lane) {
            const int kq = lane >> 3, col = r * 32 + (lane & 7) * 4;
            f32x4 a0 = {0.f, 0.f, 0.f, 0.f}, a1 = a0, a2 = a0;
            for (int jb = 0; jb < 256; jb += 8) {
                f32x4 w[8]; float c0[8], c1[8], c2[8];
#pragma unroll
                for (int j = 0; j < 8; ++j) { const int k = kq + 8 * (jb + j); w[j] = __builtin_nontemporal_load((const GAS f32x4*)(args.in[4] + (size_t)k * MODC + col)); c0[j] = args.in[1][k]; c1[j] = args.in[1][DM + k]; c2[j] = args.in[3][k]; }
#pragma unroll
                for (int j = 0; j < 8; ++j) { a0 += w[j] * (c0[j] * __builtin_amdgcn_rcpf(1.0f + __expf(-c0[j]))); a1 += w[j] * (c1[j] * __builtin_amdgcn_rcpf(1.0f + __expf(-c1[j]))); a2 += w[j] * (c2[j] * __builtin_amdgcn_rcpf(1.0f + __expf(-c2[j]))); }
            }
#pragma unroll
            for (int c = 0; c < 4; ++c) {
#pragma unroll
                for (int o = 8; o < 64; o <<= 1) { a0[c] += __shfl_xor(a0[c], o); a1[c] += __shfl_xor(a1[c], o); a2[c] += __shfl_xor(a2[c], o); } }
            if (kq == 0) { const f32x4 bb = *(const GAS f32x4*)(args.in[5] + col); float* MODP = (float*)(ws + WS_MOD);
                *(GAS f32x4*)(MODP + col) = a0 + bb; *(GAS f32x4*)(MODP + MODC + col) = a1 + bb; *(GAS f32x4*)(MODP + 2 * MODC + col) = a2 + bb; }
}
__device__ __forceinline__ void p0_prologue(Frame& F, const Args& args) {
    LAS float* scr = (LAS float*)(F.lds + F.wave * 16640);
    const int gw = F.vcu * NWAVES + F.wave, NGW = F.G * NWAVES, lane = F.lane;
    unsigned char* ws = F.ws;
    bf16_t* WT_IN = (bf16_t*)(ws + WS_WT_IN); bf16_t* WT_FO = (bf16_t*)(ws + WS_WT_FO); bf16_t* WT_AO = (bf16_t*)(ws + WS_WT_AO); bf16_t* WT_O = (bf16_t*)(ws + WS_WT_O);
    bf16_t* WT_GU = (bf16_t*)(ws + WS_WT_GU); bf16_t* WT_D = (bf16_t*)(ws + WS_WT_D);
    int rank = gw, nreg = NGW;
    if (NGW >= 5 * IT_MOD) {
        if (gw % 5 == 0 && gw / 5 < IT_MOD) { mod_item(args, ws, gw / 5, lane); return; }
        rank = gw < 5 * IT_MOD ? gw - gw / 5 - 1 : gw - IT_MOD; nreg = NGW - IT_MOD; }
    else for (int m = gw; m < IT_MOD; m += NGW) mod_item(args, ws, m, lane);
    for (int it = rank; it < IT_ALL - IT_MOD; it += nreg) {
        int r = it;
        if (r < IT_IN) { const int kb = r / 128, nb = r % 128, n0 = nb * 64;
            if (n0 >= Q_OFF && n0 < V_OFF) { f32x4 v[16]; t64_load(v, args.in[7] + (size_t)(kb * 64) * INC + n0, INC, lane);
                t64_store<true, true>(v, (bf16_t*)(ws + WS_WT_IN + (size_t)(n0 & ~127) * DM + kb * 64), DM, scr, lane, n0 & 127); }
            else if (n0 >= GF_OFF) { f32x4 v[16]; t64_load(v, args.in[7] + (size_t)(kb * 64) * INC + n0, INC, lane);
                t64_store<false, true>(v, (bf16_t*)(ws + WS_WT_G8 + (size_t)(n0 - GF_OFF) * DM + kb * 64), DM, scr, lane); }
            else transpose64_f8(args.in[7] + (size_t)(kb * 64) * INC + n0, INC, ws + WS_WT_IN + (size_t)n0 * DM + kb * 64, DM, scr, lane);
            continue; } r -= IT_IN;
        if (r < IT_FO) { const int kb = r / 32, nb = r % 32; transpose64_f8(args.in[10] + (size_t)(kb * 64) * DM + nb * 64, DM, (unsigned char*)WT_FO + (size_t)(nb * 64) * YFP + kb * 64, YFP, scr, lane); continue; } r -= IT_FO;
        if (r < IT_AO) { const int kb = r / 32, nb = r % 32; transpose64_f8(args.in[11] + (size_t)(kb * 64) * DM + nb * 64, DM, (unsigned char*)WT_AO + (size_t)(nb * 64) * DM + kb * 64, DM, scr, lane); continue; } r -= IT_AO;
        if (r < IT_O) { const int kb = r / 32, nb = r % 32; transpose64_f8(args.in[12] + (size_t)(kb * 64) * DM + nb * 64, DM, (unsigned char*)WT_O + (size_t)(nb * 64) * DM + kb * 64, DM, scr, lane); continue; } r -= IT_O;
        if (r < 2 * IT_SH) { const int up = r >= IT_SH; if (up) r -= IT_SH; const int kb = r / 8, nb = r % 8, n0 = nb * 64;
            { f32x4 v[16]; t64_load(v, (up ? args.in[20] : args.in[19]) + (size_t)(kb * 64) * EFF + n0, EFF, lane);
              t64_store<false, true>(v, (bf16_t*)((unsigned char*)WT_GU + ((size_t)64 * 1024 + (n0 >> 7) * 256 + (up ? 128 : 0) + (n0 & 127)) * DM + kb * 64), DM, scr, lane); } continue; } r -= 2 * IT_SH;
        if (r < IT_SH) { const int kb = r / 32, nb = r % 32;
            { f32x4 v[16]; t64_load(v, args.in[21] + (size_t)(kb * 64) * DM + nb * 64, DM, lane); t64_store<false, true>(v, (bf16_t*)((unsigned char*)WT_D + ((size_t)64 * DM + nb * 64) * EFF + kb * 64), EFF, scr, lane); } continue; } r -= IT_SH;

        if (r < IT_CST) {
            const int k1 = r & 2047; unsigned char* dst = ws + WS_CST + (size_t)r * 2048;
#pragma unroll
            for (int j = 0; j < 4; ++j) { const int n0 = j * 512 + lane * 8; float f[8];
#pragma unroll
                for (int i = 0; i < 8; ++i) { const float ph = (float)((k1 * (n0 + i)) & 4095) * (1.0f / 2048.0f); f[i] = 16.0f * (r < 2048 ? cospif(ph) : sinpif(ph)); }
                int w0 = 0, w1 = 0; w0 = __builtin_amdgcn_cvt_pk_fp8_f32(f[0], f[1], w0, false); w0 = __builtin_amdgcn_cvt_pk_fp8_f32(f[2], f[3], w0, true);
                w1 = __builtin_amdgcn_cvt_pk_fp8_f32(f[4], f[5], w1, false); w1 = __builtin_amdgcn_cvt_pk_fp8_f32(f[6], f[7], w1, true);
                *(GAS unsigned long long*)(dst + n0) = (unsigned long long)(unsigned)w0 | ((unsigned long long)(unsigned)w1 << 32); }
            continue; } r -= IT_CST;
        if (r < IT_BD2) {
            const int t = r >> 8, o = r & 255, gp = o >> 7, k2 = o & 127; bf16_t* dst = (bf16_t*)(ws + WS_BD2) + (size_t)r * 512; float f[8];
#pragma unroll
            for (int i = 0; i < 8; ++i) { const int j = lane * 8 + i, cg = j >> 8, jj = j & 255, c = jj & 127; const float ph = (float)((32 * c * k2) & 4095) * (1.0f / 2048.0f);
                const float v = jj < 128 ? cospif(ph) : (t ? sinpif(ph) : -sinpif(ph)); f[i] = cg == gp ? v * 0.0013810679320049757f : 0.f; }
            u32x4 w; w.x = cvt_pk_bf16(f[0], f[1]); w.y = cvt_pk_bf16(f[2], f[3]); w.z = cvt_pk_bf16(f[4], f[5]); w.w = cvt_pk_bf16(f[6], f[7]);
            *(GAS u32x4*)(dst + lane * 8) = w;
            continue; } r -= IT_BD2;
        if (r >= IT_RWT) {
            float* RT = (float*)(ws + WS_ROPE);
            { const int idx = (r - IT_RWT) * 64 + lane; const float ang = (float)(idx >> 5) * exp2f(-(float)(idx & 31) * (13.287712379549449f / 32.0f)); RT[2 * idx] = cosf(ang); RT[2 * idx + 1] = sinf(ang); }
            continue; }
        {
            f32x4 v[16]; t64_load(v, args.in[14] + (size_t)(r * 64) * NE, NE, lane);
            const int kk = lane >> 4, nc = (lane & 15) * 4;
#pragma unroll
            for (int j = 0; j < 16; ++j) {
#pragma unroll
                for (int c = 0; c < 4; ++c) scr[(j * 4 + kk) * 65 + nc + c] = v[j][c]; }
            LDS_WAIT(); asm volatile("" ::: "memory");
            const int kc = lane & 7; bf16_t* RWT = (bf16_t*)(ws + WS_RWT);
#pragma unroll
            for (int jj = 0; jj < 8; ++jj) { const int e = (lane >> 3) + 8 * jj; const LAS float* s = scr + (8 * kc) * 65 + e; float t[8], l[8];
#pragma unroll
                for (int i = 0; i < 8; ++i) { t[i] = s[i * 65]; l[i] = t[i] - bf2f(f2bf(t[i])); }
                u32x4 h, lo; h.x = cvt_pk_bf16(t[0], t[1]); h.y = cvt_pk_bf16(t[2], t[3]); h.z = cvt_pk_bf16(t[4], t[5]); h.w = cvt_pk_bf16(t[6], t[7]);
                lo.x = cvt_pk_bf16(l[0], l[1]); lo.y = cvt_pk_bf16(l[2], l[3]); lo.z = cvt_pk_bf16(l[4], l[5]); lo.w = cvt_pk_bf16(l[6], l[7]);
                *(GAS u32x4*)(RWT + (size_t)e * DM + r * 64 + 8 * kc) = h; *(GAS u32x4*)(RWT + (size_t)(NE + e) * DM + r * 64 + 8 * kc) = lo; }
            LDS_WAIT(); asm volatile("" ::: "memory");
        }
    }
}


__device__ __forceinline__ void conv_addr(const Args& args, unsigned char* ws, bool down, int it, const float*& W, int& ldw, bf16_t*& dst, int& ldd) {
    if (!down) { int r = it; const int up = r >= IT_EG; if (up) r -= IT_EG;
        const int e = r / 256, q = r % 256, kb = q / 8, nb = q % 8, n0 = nb * 64;
        W = (up ? args.in[17] : args.in[16]) + (size_t)e * DM * EFF + (size_t)(kb * 64) * EFF + n0; ldw = EFF;
        dst = (bf16_t*)(ws + WS_WT_GU + ((size_t)e * 1024 + (n0 >> 7) * 256 + (up ? 128 : 0) + (n0 & 127)) * DM + kb * 64); ldd = DM;
    } else { const int r = it, e = r / 256, q = r % 256, kb = q / 32, nb = q % 32;
        W = args.in[18] + (size_t)e * EFF * DM + (size_t)(kb * 64) * DM + nb * 64; ldw = DM;
        dst = (bf16_t*)(ws + WS_WT_D + ((size_t)e * DM + nb * 64) * EFF + kb * 64); ldd = EFF; }
}
__device__ __forceinline__ void conv_items(Frame& F, const Args& args, bool down, int first, int count) {
    LAS float* scr = (LAS float*)(F.lds + F.wave * 16640);
    const int end = first + count; int it = first + F.wave;
    if (it >= end) return;
    f32x4 va[16], vb[16]; const float* W; int ldw; bf16_t* da; bf16_t* db; int ldd;
    conv_addr(args, F.ws, down, it, W, ldw, da, ldd); t64_load(va, W, ldw, F.lane);
    for (;;) {
        const bool hb = it + NWAVES < end;
        if (hb) { conv_addr(args, F.ws, down, it + NWAVES, W, ldw, db, ldd); t64_load(vb, W, ldw, F.lane); }
        t64_store<false, true>(va, da, ldd, scr, F.lane);
        if (!hb) break;
        const bool ha = it + 2 * NWAVES < end;
        if (ha) { conv_addr(args, F.ws, down, it + 2 * NWAVES, W, ldw, da, ldd); t64_load(va, W, ldw, F.lane); }
        t64_store<false, true>(vb, db, ldd, scr, F.lane);
        if (!ha) break;
        it += 2 * NWAVES;
    }
}
struct SchedIn {
    int G, c; unsigned char* ws; int use_ut;
    __device__ __forceinline__ bool next(int i, Unit& u) const {
        const int L = i * G + c; if (L >= 520) return false;
        const char* H = (const char*)(ws + WS_H8); const char* WT = (const char*)(ws + WS_WT_IN);
        u.rows = 256; u.aux = 0; u.bjs = HALF; u.pm = 0; u.pn = 0; u.rmin = 0; u.nt = DM / 128; u.keep = 0;
        if (L < 512) {
            int pm, ct; grid_map(L, 32, 16, pm, ct);
            const int row0 = pm * 256, b = row0 / SEQ, t0 = row0 % SEQ;
            u.A = H + (size_t)row0 * DM; u.B = WT + (size_t)ct * 256 * DM;
            if (ct < 4) { u.A = WT + (size_t)ct * 256 * DM; u.B = H + (size_t)row0 * DM;
                          u.C = (char*)(ws + WS_UT) + (((size_t)b * FW + ct * 256) * SEQ + t0) * 2; u.ldc = SEQ; u.mode = 0; }
            else if (ct < 12) { u.C = (char*)(ws + WS_Q) + ((size_t)row0 * DM + (ct - 4) * 256) * 2; u.ldc = DM; u.mode = 5; u.pm = t0; }
            else if (ct < 14) { u.C = (char*)(ws + WS_KALL) + (((size_t)b * SKV + t0) * KVW + (ct - 12) * 256) * 2; u.ldc = KVW; u.mode = 6; u.pm = t0; }
            else { u.C = (char*)(ws + WS_VALL) + (((size_t)b * SKV + t0) * KVW + (ct - 14) * 256) * 2; u.ldc = KVW; u.mode = 0; }
        } else {
            const int l = L - 512, pm = l & 1, ct = l >> 1;
            u.A = (const char*)(ws + WS_H) + (size_t)(pm * 256) * DM; u.B = WT + (size_t)(K_OFF + ct * 256) * DM;
            if (ct < 2) { u.C = (char*)(ws + WS_KALL) + (((size_t)pm * SKV + SEQ) * KVW + ct * 256) * 2; u.ldc = KVW; u.mode = 7; }
            else        { u.C = (char*)(ws + WS_VALL) + (((size_t)pm * SKV + SEQ) * KVW + (ct - 2) * 256) * 2; u.ldc = KVW; u.mode = 0; }
        }
        return true;
    }
    __device__ __forceinline__ unsigned arow(const Unit&, int) const { return 0u; }
    __device__ __forceinline__ void a_ready(const Unit&) const {}
};
struct SchedGate { int G, c; unsigned char* ws;
    __device__ __forceinline__ bool next(int i, Unit& u) const {
        int g;
        if (G == 256) { if (c < 8 || i >= 2) return false; g = (c - 8) + 248 * i; }
        else { g = i * G + c; if (g >= 496) return false; }
        const int pm = g & 31, gt = g >> 5;
        u.A = (const char*)(ws + WS_H8) + (size_t)pm * 256 * DM; u.B = (const char*)(ws + WS_WT_G8) + (size_t)gt * 256 * DM;
        u.C = (char*)(ws + (gt < 8 ? WS_SGF : WS_SGA)) + ((size_t)pm * 256 * DM + (gt & 7) * 256); { int md = 2, ld = DM, rw = 256; asm volatile("" : "+s"(md), "+s"(ld), "+s"(rw)); u.ldc = ld; u.mode = md; u.rows = rw; }
        u.aux = 0; u.bjs = HALF; u.pm = pm; u.pn = gt; u.rmin = 0; u.nt = DM / 128; u.keep = 0;
        return true; }
    __device__ __forceinline__ unsigned arow(const Unit&, int) const { return 0u; }
    __device__ __forceinline__ void a_ready(const Unit&) const {} };

__device__ __forceinline__ void unpack8(u32x4 w, float (&f)[8]) {
#pragma unroll
    for (int i = 0; i < 4; ++i) { f[2 * i] = __uint_as_float(w[i] << 16); f[2 * i + 1] = __uint_as_float(w[i] & 0xffff0000u); }
}
struct EpiMerge { const unsigned char* SGF; const unsigned char* SGA; bf16_t* YM;
    static __device__ __forceinline__ void gate8(const unsigned char* p, float (&g)[8]) { const unsigned long long w = *(const unsigned long long*)p; const unsigned lo = (unsigned)w, hi = (unsigned)(w >> 32);
#pragma unroll
        for (int c = 0; c < 4; ++c) { g[c] = (float)((lo >> (8 * c)) & 0xffu) * (1.0f / 255.0f); g[4 + c] = (float)((hi >> (8 * c)) & 0xffu) * (1.0f / 255.0f); } }
    __device__ __forceinline__ void operator()(f32x4 (&acc)[2][2][4][2], const Unit& u, int wr, int wc, int fr, int fq) const {
#pragma unroll
        for (int ai = 0; ai < 2; ++ai)
#pragma unroll
            for (int m = 0; m < 4; ++m) { const size_t row = (size_t)u.pm * 256 + ai * HALF + wr * 64 + m * 16 + fr;
#pragma unroll
                for (int bj = 0; bj < 2; ++bj) { const size_t o = row * DM + u.pn * 256 + bj * HALF + wc * 32 + 8 * fq;
                    float ga[8]; gate8(SGA + o, ga);
#pragma unroll
                    for (int c = 0; c < 8; ++c) ga[c] = fmaxf(ga[c], 1e-20f);
                    if (u.keep) { float gf[8]; gate8(SGF + o, gf);
#pragma unroll
                        for (int c = 0; c < 4; ++c) { acc[ai][bj][m][0][c] *= gf[c] * __builtin_amdgcn_rcpf(ga[c]); acc[ai][bj][m][1][c] *= gf[4 + c] * __builtin_amdgcn_rcpf(ga[4 + c]); }
                    } else { const f32x4 v0 = acc[ai][bj][m][0], v1 = acc[ai][bj][m][1];
                        float y[8];
#pragma unroll
                        for (int c = 0; c < 4; ++c) { y[c] = fminf(fmaxf(ga[c] * v0[c], -448.f), 448.f); y[4 + c] = fminf(fmaxf(ga[4 + c] * v1[c], -448.f), 448.f); }
                        int w0 = 0, w1 = 0; w0 = __builtin_amdgcn_cvt_pk_fp8_f32(y[0], y[1], w0, false); w0 = __builtin_amdgcn_cvt_pk_fp8_f32(y[2], y[3], w0, true); w1 = __builtin_amdgcn_cvt_pk_fp8_f32(y[4], y[5], w1, false); w1 = __builtin_amdgcn_cvt_pk_fp8_f32(y[6], y[7], w1, true);
                        *(unsigned long long*)((unsigned char*)YM + o) = (unsigned long long)(unsigned)w0 | ((unsigned long long)(unsigned)w1 << 32); } } }
    } };
struct SchedMerge { int G, c; unsigned char* ws;
    __device__ __forceinline__ bool next(int i, Unit& u) const {
        const int L = (i >> 1) * G + c; if (L >= 256) return false;
        int pm, pn; grid_map(L, 32, 8, pm, pn); const int kb = i & 1;
        u.A = (const char*)(ws + (kb ? WS_YA : WS_YF)) + (size_t)pm * 256 * DM; u.B = (const char*)(ws + (kb ? WS_WT_AO : WS_WT_FO)) + (size_t)pn * 256 * DM;
        u.C = nullptr; u.ldc = DM; u.mode = 0; u.rows = 256; u.aux = 0; u.pm = pm; u.pn = pn; u.bjs = HALF; u.rmin = 0; u.nt = kb ? DM / 128 : FW / 128; u.keep = kb ? 0 : 1;
        return true; }
    __device__ __forceinline__ unsigned arow(const Unit&, int) const { return 0u; } };
struct EpiX2 { const float* x; const float* mod; bf16_t* X2;
    __device__ __forceinline__ void operator()(f32x4 (&acc)[2][2][4][2], const Unit& u, int wr, int wc, int fr, int fq) const {
        const float* g1 = mod + ((u.pm * 256) / SEQ) * MODC + 2 * DM;
#pragma unroll
        for (int ai = 0; ai < 2; ++ai)
#pragma unroll
            for (int m = 0; m < 4; ++m) { const size_t row = (size_t)u.pm * 256 + ai * HALF + wr * 64 + m * 16 + fr;
#pragma unroll
                for (int bj = 0; bj < 2; ++bj) { const int col = u.pn * 256 + bj * HALF + wc * 32 + 8 * fq; const size_t o = row * DM + col;
                    f32x4 r[2];
#pragma unroll
                    for (int n = 0; n < 2; ++n) { const f32x4 xv = __builtin_nontemporal_load((const f32x4*)(x + o + 4 * n)), gv = *(const f32x4*)(g1 + col + 4 * n); r[n] = xv + gv * acc[ai][bj][m][n]; }
                    u32x4 w; w.x = cvt_pk_bf16(r[0][0], r[0][1]); w.y = cvt_pk_bf16(r[0][2], r[0][3]); w.z = cvt_pk_bf16(r[1][0], r[1][1]); w.w = cvt_pk_bf16(r[1][2], r[1][3]);
                    *(u32x4*)(X2 + o) = w; } }
    } };
__device__ __forceinline__ void act8(const f32x4 (&g)[2], const f32x4 (&up)[2], unsigned& w0, unsigned& w1) {
    f32x4 a[2];
#pragma unroll
    for (int n = 0; n < 2; ++n)
#pragma unroll
        for (int c = 0; c < 4; ++c) { const float x = g[n][c]; a[n][c] = fminf(fmaxf(x * __builtin_amdgcn_rcpf(1.0f + __expf(-x)) * up[n][c], -448.f), 448.f); }
    int x0 = 0, x1 = 0;
    x0 = __builtin_amdgcn_cvt_pk_fp8_f32(a[0][0], a[0][1], x0, false); x0 = __builtin_amdgcn_cvt_pk_fp8_f32(a[0][2], a[0][3], x0, true);
    x1 = __builtin_amdgcn_cvt_pk_fp8_f32(a[1][0], a[1][1], x1, false); x1 = __builtin_amdgcn_cvt_pk_fp8_f32(a[1][2], a[1][3], x1, true);
    w0 = (unsigned)x0; w1 = (unsigned)x1;
}
struct EpiAct {
    __device__ __forceinline__ void operator()(f32x4 (&acc)[2][2][4][2], const Unit& u, int wr, int wc, int fr, int fq) const {
        const int odd = fq & 1;
        unsigned char* base = (unsigned char*)u.C + (size_t)(wr * 64 + odd * 16 + fr) * u.ldc + wc * 32 + 8 * (fq - odd);
        const int r0 = wr * 64 + odd * 16 + fr;
#pragma unroll
        for (int ai = 0; ai < 2; ++ai)
#pragma unroll
            for (int m = 0; m < 4; m += 2) {
                unsigned a0, a1, b0, b1; act8(acc[ai][0][m], acc[ai][1][m], a0, a1); act8(acc[ai][0][m + 1], acc[ai][1][m + 1], b0, b1);
                const auto s0 = __builtin_amdgcn_permlane16_swap(a0, b0, false, false), s1 = __builtin_amdgcn_permlane16_swap(a1, b1, false, false);
                if (r0 + ai * HALF + m * 16 < u.rows) { const u32x4 w = {s0[0], s1[0], s0[1], s1[1]}; *(u32x4*)(base + (size_t)(ai * HALF + m * 16) * u.ldc) = w; } }
    } };

struct SchedGrid {
    int G, c, nM, nN; const char* A; const char* B; char* C; size_t astride, bstride; int ldc, esz, mode, nt;
    __device__ __forceinline__ bool next(int i, Unit& u) const {
        const int L = i * G + c; if (L >= nM * nN) return false;
        int pm, pn; grid_map(L, nM, nN, pm, pn);
        u.A = A + (size_t)pm * astride; u.B = B + (size_t)pn * bstride; u.C = C + ((size_t)pm * 256 * ldc + pn * 256) * esz; u.ldc = ldc; u.mode = mode; u.rows = 256; u.aux = 0; u.pm = pm; u.pn = pn; u.bjs = HALF; u.rmin = 0; u.nt = nt; u.keep = 0;
        return true; }
    __device__ __forceinline__ unsigned arow(const Unit&, int) const { return 0u; } };
struct SchedAG { int G, c; unsigned char* ws;
    __device__ __forceinline__ bool next(int i, Unit& u) const {
        const int L = i * G + c; if (L >= 144) return false;
        u.rows = 256; u.aux = 0; u.rmin = 0; u.nt = DM / 128; u.keep = 0;
        if (L < 128) {
            int pm, pn8; grid_map(L, 16, 8, pm, pn8); const int b = pn8 >> 2, pn = pn8 & 3, sn = pm >> 3, k1t = pm & 7;
            u.A = (const char*)(ws + WS_CST) + (size_t)pm * 256 * 2048; u.B = (const char*)(ws + (sn ? WS_OT : WS_ET)) + ((size_t)b * FW + pn * 256) * 2048;
            u.C = (char*)(ws + WS_TT) + (((size_t)b * 2048 + k1t * 256) * DM + pn * 512 + sn * 128) * 2; u.ldc = DM; u.mode = sn ? 0 : 3; u.pm = k1t; u.pn = b * FW + pn * 256; u.bjs = 256;
        } else {
            const int g = 496 + (L - 128), pm = g & 31, ct = 16 + (g >> 5);
            u.A = (const char*)(ws + WS_H8) + (size_t)pm * 256 * DM; u.B = (const char*)(ws + WS_WT_G8) + (size_t)(ct - 16) * 256 * DM;
            u.C = (char*)(ws + WS_SGA) + ((size_t)pm * 256 * DM + (ct - 24) * 256); u.ldc = DM; u.mode = 2; u.pm = pm; u.pn = ct; u.bjs = HALF;
        }
        return true; }
    __device__ __forceinline__ unsigned arow(const Unit&, int) const { return 0u; } };
struct SchedF2 { int G, c; unsigned char* ws;
    __device__ __forceinline__ bool next(int i, Unit& u) const {
        const int L = i * G + c; if (L >= 128) return false;
        int pm, q; grid_map(L, 16, 8, pm, q); const int b = pm >> 3, k1t = pm & 7, j = q & 3, mir = q >> 2;
        u.A = (const char*)(ws + WS_TT) + (((size_t)b * 2048 + k1t * 256) * DM + j * 512) * 2; u.B = (const char*)(ws + WS_BD2) + (size_t)mir * 256 * 512 * 2;
        u.mode = 4; u.rows = 256; u.aux = 0; u.pm = pm; u.pn = j; u.bjs = HALF; u.nt = 512 / BK; u.keep = 0;
        if (!mir) { u.C = (char*)(ws + WS_YF) + (((size_t)b * SEQ + k1t * 256) * YFP + j * 256); u.ldc = YFP; u.rmin = 0; }
        else { u.C = (char*)(ws + WS_YF) + (((size_t)b * SEQ + SEQ - k1t * 256) * YFP + j * 256); u.ldc = -YFP; u.rmin = k1t == 0 ? 1 : 0; }
        return true; }
    __device__ __forceinline__ unsigned arow(const Unit&, int) const { return 0u; } };
constexpr int SCHT_OFF = LDSCTL_OFF + 1024;
__device__ __forceinline__ void moe_tables(Frame& F, int ncol_tiles) {
    LAS int* T = (LAS int*)(F.lds + SCHT_OFF);
    __syncthreads();
    if (F.wave == 0) { const int* CNT = (const int*)(F.ws + CTL_CNT); const int e = F.lane, cn = CNT[e * 64], nt = ((cn + 255) >> 8) * ncol_tiles;
        int su = nt, so = cn;
#pragma unroll
        for (int o = 1; o < 64; o <<= 1) { const int a = __shfl_up(su, o), b = __shfl_up(so, o); if (e >= o) { su += a; so += b; } }
        T[e] = su - nt; T[80 + e] = so - cn; T[160 + e] = cn;
        if (e == 63) { T[NE] = su; T[80 + NE] = NSLOT; T[160 + NE] = NTOK; T[NE + 1] = su + ((NTOK + 255) >> 8) * ncol_tiles; } }
    __syncthreads();
}
template <int NCT, bool FIRST> struct SchedMoe {
    int G, c; unsigned char* ws; LAS int* T; const int* TOK;
    __device__ __forceinline__ int tl(int i) const { return __builtin_amdgcn_readfirstlane(T[i]); }
    __device__ __forceinline__ bool next(int i, Unit& u) const {
        const int L = i * G + c; if (L >= tl(NE + 1)) return false;
        int lo = 0, hi = NE;
#pragma unroll 1
        while (lo < hi) { const int mid = (lo + hi + 1) >> 1; if (tl(mid) <= L) lo = mid; else hi = mid - 1; }
        const int e = lo, cn = tl(160 + e), ntile = (cn + 255) >> 8, local = L - tl(e), ct = local / ntile, mt = local % ntile, slot0 = tl(80 + e) + mt * 256;
        u.rows = (cn - mt * 256) < 256 ? (cn - mt * 256) : 256; u.aux = slot0; u.pm = mt; u.pn = ct; u.bjs = HALF; u.mode = 0; u.rmin = 0; u.e = e; u.nt = (FIRST ? DM : EFF) / 128; u.keep = 0;
        if (FIRST) { u.A = (const char*)(ws + WS_H2); u.B = (const char*)(ws + WS_WT_GU) + ((size_t)e * 4 + ct) * 256 * DM; u.C = (char*)(ws + WS_ACT) + ((size_t)slot0 * EFF + ct * 128); u.ldc = EFF; }
        else { u.A = (const char*)(ws + WS_ACT) + (size_t)slot0 * EFF; u.B = (const char*)(ws + WS_WT_D) + ((size_t)e * DM + ct * 256) * EFF; u.C = (char*)(ws + WS_YBIG) + ((size_t)slot0 * DM + ct * 256); u.ldc = DM; u.mode = 8; }
        return true; }
    __device__ __forceinline__ unsigned arow(const Unit& u, int r) const { const int rr = u.pm * 256 + (r < u.rows ? r : u.rows - 1); const int tok = u.e < NE ? TOK[u.e * NTOK + rr] : rr; return (unsigned)tok * (unsigned)DM; } };

namespace attn {
using s16x4 = __attribute__((ext_vector_type(4))) short;
using f32x8 = __attribute__((ext_vector_type(8))) float;
constexpr int D = 128, NW = 8, QBLK = 32, KVBLK = 64;
constexpr float SCALE = 0.088388347648318440f;
constexpr float THR = 8.f;
constexpr int LDQ = DM, LDK = KVW, LDO = DM;
constexpr size_t SHM_V = KVBLK * D * 2, SHM_K = KVBLK * D * 2, SHM_ATTN = 2 * SHM_V + 2 * SHM_K + NW * 64 * 4;
#define KSWZ(row, colB) ((row) * 256 + ((colB) ^ (((row) & 7) << 4)))
#define SBAR() __builtin_amdgcn_sched_barrier(0)
__device__ __forceinline__ unsigned cvtpk(float lo, float hi) { unsigned r; asm volatile("v_cvt_pk_bf16_f32 %0, %1, %2" : "=v"(r) : "v"(lo), "v"(hi)); return r; }
__device__ __forceinline__ void partialSM(f32x16& p0, f32x16& p1, float& m_reg, float& mn, float& alpha) {
  constexpr float C = SCALE * 1.4426950408889634f;
  float pmax = p0[0]; for (int r = 1; r < 16; ++r) pmax = fmaxf(pmax, p0[r]); for (int r = 0; r < 16; ++r) pmax = fmaxf(pmax, p1[r]);
  { auto rr = __builtin_amdgcn_permlane32_swap(__float_as_uint(pmax), __float_as_uint(pmax), false, false);
    pmax = fmaxf(__uint_as_float(rr[0]), __uint_as_float(rr[1])); }
  if (__builtin_expect(__all(pmax - m_reg <= THR / SCALE), 1)) { mn = m_reg; alpha = 1.f; }
  else { mn = fmaxf(m_reg, pmax); alpha = __builtin_amdgcn_exp2f((m_reg - mn) * C); m_reg = mn; }
  float mnC = -mn * C;
  for (int r = 0; r < 16; ++r) p0[r] = fmaf(p0[r], C, mnC); for (int r = 0; r < 16; ++r) p1[r] = fmaf(p1[r], C, mnC);
  for (int r = 0; r < 16; ++r) p0[r] = __builtin_amdgcn_exp2f(p0[r]);
}
__device__ __forceinline__ void finishSM(f32x16& p0, f32x16& p1, float alpha, float& l_reg, bf16x8& pa0, bf16x8& pa1, bf16x8& pa2, bf16x8& pa3) {
  for (int r = 0; r < 16; ++r) p1[r] = __builtin_amdgcn_exp2f(p1[r]);
  float ps = 0; for (int r = 0; r < 16; ++r) ps += p0[r]; for (int r = 0; r < 16; ++r) ps += p1[r];
  { auto rr = __builtin_amdgcn_permlane32_swap(__float_as_uint(ps), __float_as_uint(ps), false, false);
    ps = __uint_as_float(rr[0]) + __uint_as_float(rr[1]); }
  l_reg = l_reg * alpha + ps;
#define PK4(P, BASE, OUT) do { unsigned a0 = cvtpk(P[BASE + 0], P[BASE + 1]), a1 = cvtpk(P[BASE + 2], P[BASE + 3]);   \
    unsigned b0 = cvtpk(P[BASE + 4], P[BASE + 5]), b1 = cvtpk(P[BASE + 6], P[BASE + 7]);                              \
    auto r0 = __builtin_amdgcn_permlane32_swap(a0, b0, false, false); auto r1 = __builtin_amdgcn_permlane32_swap(a1, b1, false, false); \
    u32x4 w = {r0[0], r1[0], r0[1], r1[1]}; OUT = *reinterpret_cast<bf16x8*>(&w); } while (0)
  PK4(p0, 0, pa0); PK4(p0, 8, pa1); PK4(p1, 0, pa2); PK4(p1, 8, pa3);
#undef PK4
}
__device__ __forceinline__ void qkt(f32x16& p0, f32x16& p1, const bf16_t* Ks, const bf16x8* qr, int r32, int hi) {
  p0 = f32x16{}; p1 = f32x16{};
  for (int d0 = 0; d0 < 8; ++d0) { int cb = (d0 * 16 + hi * 8) * 2;
    bf16x8 b0 = *reinterpret_cast<const bf16x8*>((const char*)Ks + KSWZ(r32, cb));
    bf16x8 b1 = *reinterpret_cast<const bf16x8*>((const char*)Ks + KSWZ(32 + r32, cb));
    p0 = __builtin_amdgcn_mfma_f32_32x32x16_bf16(b0, qr[d0], p0, 0, 0, 0);
    p1 = __builtin_amdgcn_mfma_f32_32x32x16_bf16(b1, qr[d0], p1, 0, 0, 0); }
}
__device__ __forceinline__ int v_st(int k, int c) { const int kk = (k & ~0xC) | ((k & 4) << 1) | ((k & 8) >> 1); return ((kk >> 3) * 4 + (c >> 5)) * 512 + ((kk & 7) * 32 + (c & 31)) * 2; }
__device__ __forceinline__ int v_rd_base(int lane) { return ((lane & 3) << 3) | (((lane >> 2) & 3) << 6) | (((lane >> 4) & 1) << 5) | (((lane >> 5) & 1) << 8); }
constexpr int v_rd_off(int d0, int ks, int half) { return d0 * 512 + ks * 4096 + half * 2048; }
template <int OFF> __device__ __forceinline__ s16x4 tr_read(int vb) {
  s16x4 r; asm volatile("ds_read_b64_tr_b16 %0, %1 offset:%2" : "=&v"(r) : "v"(vb), "i"(OFF) : "memory"); return r;
}
template <int D0> __device__ __forceinline__ void pv_one(f32x16& od, int vb, bf16x8 pa0, bf16x8 pa1, bf16x8 pa2, bf16x8 pa3) {
  const s16x4 l0 = tr_read<v_rd_off(D0, 0, 0)>(vb), h0 = tr_read<v_rd_off(D0, 0, 1)>(vb), l1 = tr_read<v_rd_off(D0, 1, 0)>(vb), h1 = tr_read<v_rd_off(D0, 1, 1)>(vb);
  const s16x4 l2 = tr_read<v_rd_off(D0, 2, 0)>(vb), h2 = tr_read<v_rd_off(D0, 2, 1)>(vb), l3 = tr_read<v_rd_off(D0, 3, 0)>(vb), h3 = tr_read<v_rd_off(D0, 3, 1)>(vb);
  asm volatile("s_waitcnt lgkmcnt(0)" ::: "memory"); SBAR();
#define PK(L, H) (bf16x8){L[0], L[1], L[2], L[3], H[0], H[1], H[2], H[3]}
  od = __builtin_amdgcn_mfma_f32_32x32x16_bf16(pa0, PK(l0, h0), od, 0, 0, 0);
  od = __builtin_amdgcn_mfma_f32_32x32x16_bf16(pa1, PK(l1, h1), od, 0, 0, 0);
  od = __builtin_amdgcn_mfma_f32_32x32x16_bf16(pa2, PK(l2, h2), od, 0, 0, 0);
  od = __builtin_amdgcn_mfma_f32_32x32x16_bf16(pa3, PK(l3, h3), od, 0, 0, 0);
#undef PK
}
__device__ __forceinline__ void pv_d0(f32x16* o, int vb, bf16x8 pa0, bf16x8 pa1, bf16x8 pa2, bf16x8 pa3) {
  pv_one<0>(o[0], vb, pa0, pa1, pa2, pa3); pv_one<1>(o[1], vb, pa0, pa1, pa2, pa3); pv_one<2>(o[2], vb, pa0, pa1, pa2, pa3); pv_one<3>(o[3], vb, pa0, pa1, pa2, pa3);
}
__device__ __forceinline__ void attn_dense_body(const bf16_t* __restrict__ Qb, const bf16_t* __restrict__ Kh, const bf16_t* __restrict__ Vh, bf16_t* __restrict__ Ob, int seq, char* lds) {
  const int tid = threadIdx.x, wid = tid >> 6, lane = tid & 63, r32 = lane & 31, hi = lane >> 5;
  bf16_t* V_lds = (bf16_t*)lds; bf16_t* K_lds = (bf16_t*)(lds + 2 * SHM_V);
  float* ws = (float*)(lds + 2 * SHM_V + 2 * SHM_K) + wid * 64; float* li_l = ws; float* al_l = ws + 32;
  float m_reg = -1e30f, l_reg = 0; f32x16 o[4] = {}; bf16x8 qr[8];
  const bf16_t* Qw = Qb + (long)(wid * QBLK + r32) * LDQ + hi * 8;
#pragma unroll
  for (int d0 = 0; d0 < 8; ++d0) qr[d0] = __builtin_nontemporal_load(reinterpret_cast<const bf16x8*>(Qw + d0 * 16));
  const int sr = tid >> 4, sc = (tid & 15) * 8, vst0 = v_st(sr, sc), vst1 = v_st(32 + sr, sc);
  const int vb0 = (int)(uintptr_t)V_lds + v_rd_base(lane);
  struct { bf16x8 vs0, vs1, ks0, ks1; } sr_[2];
#define SLOAD(i, k0) do { sr_[i].vs0 = *reinterpret_cast<const bf16x8*>(&Vh[(long)((k0) + sr) * LDK + sc]); sr_[i].vs1 = *reinterpret_cast<const bf16x8*>(&Vh[(long)((k0) + 32 + sr) * LDK + sc]); \
    sr_[i].ks0 = *reinterpret_cast<const bf16x8*>(&Kh[(long)((k0) + sr) * LDK + sc]); sr_[i].ks1 = *reinterpret_cast<const bf16x8*>(&Kh[(long)((k0) + 32 + sr) * LDK + sc]); } while (0)
#define SWRITE(b, i) do { *(bf16x8*)((char*)V_lds + (b) * SHM_V + vst0) = sr_[i].vs0;          \
    *(bf16x8*)((char*)V_lds + (b) * SHM_V + vst1) = sr_[i].vs1; int kc = sc * 2;               \
    *(bf16x8*)((char*)K_lds + (b) * SHM_K + KSWZ(sr, kc)) = sr_[i].ks0;                       \
    *(bf16x8*)((char*)K_lds + (b) * SHM_K + KSWZ(32 + sr, kc)) = sr_[i].ks1; } while (0)
#define SWAIT() asm volatile("s_waitcnt vmcnt(4)" ::: "memory")
#define RESC(a) do { if (__any((a) < 1.f)) { if (hi == 0) al_l[r32] = (a); asm volatile("s_waitcnt lgkmcnt(0)" ::: "memory"); \
    for (int d = 0; d < 4; ++d) for (int r = 0; r < 16; ++r) o[d][r] *= al_l[crow(r, hi)]; } } while (0)
  f32x16 pA0, pA1, pB0, pB1; float mnA, mnB, alA, alB; bf16x8 pa0, pa1, pa2, pa3; const int NT = seq / KVBLK;
  constexpr int SE = 0, SO = 1;
  SLOAD(SE, 0); asm volatile("s_waitcnt vmcnt(0)" ::: "memory"); SWRITE(0, SE); __syncthreads();
  qkt(pA0, pA1, K_lds, qr, r32, hi); partialSM(pA0, pA1, m_reg, mnA, alA);
  SLOAD(SO, KVBLK); if (2 < NT) SLOAD(SE, 2 * KVBLK);
  SWAIT(); SWRITE(1, SO); __syncthreads();
  for (int j = 1; j + 1 < NT; j += 2) {
    SBAR(); qkt(pB0, pB1, (bf16_t*)((char*)K_lds + SHM_K), qr, r32, hi);
    finishSM(pA0, pA1, alA, l_reg, pa0, pa1, pa2, pa3); SBAR();
    SLOAD(SO, (j + 2) * KVBLK); SBAR();
    pv_d0(o, vb0, pa0, pa1, pa2, pa3); partialSM(pB0, pB1, m_reg, mnB, alB);
    __syncthreads(); SWAIT(); SWRITE(0, SE);
    RESC(alB); __syncthreads();
    SBAR(); qkt(pA0, pA1, K_lds, qr, r32, hi);
    finishSM(pB0, pB1, alB, l_reg, pa0, pa1, pa2, pa3); SBAR();
    if (j + 3 < NT) SLOAD(SE, (j + 3) * KVBLK); SBAR();
    pv_d0(o, vb0 + (int)SHM_V, pa0, pa1, pa2, pa3); partialSM(pA0, pA1, m_reg, mnA, alA);
    __syncthreads(); SWAIT(); SWRITE(1, SO);
    RESC(alA); __syncthreads();
  }
  SBAR(); qkt(pB0, pB1, (bf16_t*)((char*)K_lds + SHM_K), qr, r32, hi);
  finishSM(pA0, pA1, alA, l_reg, pa0, pa1, pa2, pa3); SBAR();
  pv_d0(o, vb0, pa0, pa1, pa2, pa3); partialSM(pB0, pB1, m_reg, mnB, alB);
  __syncthreads(); RESC(alB);
  finishSM(pB0, pB1, alB, l_reg, pa0, pa1, pa2, pa3); SBAR();
  pv_d0(o, vb0 + (int)SHM_V, pa0, pa1, pa2, pa3);
  if (hi == 0) li_l[r32] = l_reg; asm volatile("s_waitcnt lgkmcnt(0)" ::: "memory");
  float rli[16];
#pragma unroll
  for (int r = 0; r < 16; ++r) rli[r] = __builtin_amdgcn_rcpf(li_l[crow(r, hi)]);
  typedef __attribute__((address_space(3))) unsigned char lds8_t;
  lds8_t* ost = (lds8_t*)(lds + SHM_ATTN + wid * 8192);
  lds8_t* wbase = ost + hi * 512 + r32;
#pragma unroll
  for (int d0 = 0; d0 < 4; ++d0)
#pragma unroll
    for (int r = 0; r < 16; r += 2) { const int w = __builtin_amdgcn_cvt_pk_fp8_f32(fminf(fmaxf(o[d0][r] * rli[r], -448.f), 448.f), fminf(fmaxf(o[d0][r + 1] * rli[r + 1], -448.f), 448.f), 0, false);
      *(lds8_t*)(wbase + (((r & 3) + 8 * (r >> 2)) * 128 + d0 * 32)) = (unsigned char)w;
      *(lds8_t*)(wbase + ((((r + 1) & 3) + 8 * ((r + 1) >> 2)) * 128 + d0 * 32)) = (unsigned char)(w >> 8); }
  asm volatile("s_waitcnt lgkmcnt(0)" ::: "memory");
  unsigned char* Ow = (unsigned char*)Ob + (long)(wid * QBLK) * LDO;
  { const lds8_t* rbase = ost + (lane >> 3) * 128 + (lane & 7) * 16; unsigned char* gbase = Ow + (long)(lane >> 3) * LDO + (lane & 7) * 16;
#pragma unroll
    for (int j = 0; j < 4; ++j) { const u32x4 v = *(const __attribute__((address_space(3))) u32x4*)(rbase + j * 1024); *(u32x4*)(gbase + (long)(j * 8) * LDO) = v; } }
  asm volatile("s_waitcnt lgkmcnt(0)" ::: "memory");
#undef SLOAD
#undef SWRITE
#undef SWAIT
#undef RESC
}
#undef KSWZ
#undef SBAR
}

__device__ __forceinline__ void ph_norm1(Frame& F, const Args& args, const float* mod) {
    const int gw = F.vcu * NWAVES + F.wave, NGW = F.G * NWAVES, lane = F.lane;
    const float* nw = args.in[6];
    for (int row = gw; row < NTOK + NCTX; row += NGW) {
        const float* src = row < NTOK ? args.in[0] + (size_t)row * DM : args.in[2] + (size_t)(row - NTOK) * DM;
        const float* mr = mod + (row < NTOK ? row / SEQ : 2) * MODC;
        f32x4 v[8]; float ss = 0.f;
#pragma unroll
        for (int j = 0; j < 8; ++j) { v[j] = __builtin_nontemporal_load((const GAS f32x4*)(src + (j * 64 + lane) * 4)); ss += v[j].x * v[j].x + v[j].y * v[j].y + v[j].z * v[j].z + v[j].w * v[j].w; }
        ss = wave_sum(ss);
        const float rstd = 1.0f / sqrtf(ss * (1.0f / DM) + 1e-6f);
#pragma unroll
        for (int j = 0; j < 8; ++j) { const int i = (j * 64 + lane) * 4;
            const f32x4 w = *(const GAS f32x4*)(nw + i), sc = *(const GAS f32x4*)(mr + DM + i), sh = *(const GAS f32x4*)(mr + i);
            const f32x4 h = v[j] * rstd * w * (sc + 1.0f) + sh;
            { int w8 = 0; w8 = __builtin_amdgcn_cvt_pk_fp8_f32(fminf(fmaxf(h[0], -448.f), 448.f), fminf(fmaxf(h[1], -448.f), 448.f), w8, false);
                w8 = __builtin_amdgcn_cvt_pk_fp8_f32(fminf(fmaxf(h[2], -448.f), 448.f), fminf(fmaxf(h[3], -448.f), 448.f), w8, true);
                *(GAS unsigned*)(F.ws + (row < NTOK ? WS_H8 + (size_t)row * DM : WS_H + (size_t)(row - NTOK) * DM) + i) = (unsigned)w8; } }
    }
}
__device__ __forceinline__ void ph_evenodd(Frame& F, const Args& args) {
    const int gw = F.vcu * NWAVES + F.wave, NGW = F.G * NWAVES, lane = F.lane;
    LAS bf16_t* scr = (LAS bf16_t*)(F.lds + F.wave * 16640);
    const bf16_t* UT = (const bf16_t*)(F.ws + WS_UT); unsigned char* ET = F.ws + WS_ET; unsigned char* OT = F.ws + WS_OT;
    float* W2 = (float*)(F.ws + WS_W2048); float* AL = (float*)(F.ws + WS_ALT);
    for (int row = gw; row < 2 * FW; row += NGW) {
        const bf16_t* src = UT + (size_t)row * SEQ; float alt = 0.f;
#pragma unroll
        for (int j = 0; j < 8; ++j) { const u32x4 w = __builtin_nontemporal_load((const GAS u32x4*)(src + (j * 64 + lane) * 8)); *(LAS u32x4*)(scr + (j * 64 + lane) * 8) = w;
            float f[8]; unpack8(w, f); alt += (f[0] - f[1]) + (f[2] - f[3]) + (f[4] - f[5]) + (f[6] - f[7]); }
        alt = wave_sum(alt);
        LDS_WAIT(); asm volatile("" ::: "memory");
        if (lane == 0) { AL[row] = alt; W2[row] = bf2f(scr[SEQ / 2]); }
#pragma unroll
        for (int j = 0; j < 4; ++j) { const int n0 = (j * 64 + lane) * 8; float e[8], o[8];
#pragma unroll
            for (int i = 0; i < 8; ++i) { const int n = n0 + i; const float a = bf2f(scr[n]), bb = bf2f(scr[(SEQ - n) & (SEQ - 1)]); e[i] = n == 0 ? a : a + bb; o[i] = n == 0 ? 0.f : a - bb; }
#pragma unroll
            for (int i = 0; i < 8; ++i) { e[i] = fminf(fmaxf(e[i], -448.f), 448.f); o[i] = fminf(fmaxf(o[i], -448.f), 448.f); }
            int e0 = 0, e1 = 0, o0 = 0, o1 = 0;
            e0 = __builtin_amdgcn_cvt_pk_fp8_f32(e[0], e[1], e0, false); e0 = __builtin_amdgcn_cvt_pk_fp8_f32(e[2], e[3], e0, true); e1 = __builtin_amdgcn_cvt_pk_fp8_f32(e[4], e[5], e1, false); e1 = __builtin_amdgcn_cvt_pk_fp8_f32(e[6], e[7], e1, true);
            o0 = __builtin_amdgcn_cvt_pk_fp8_f32(o[0], o[1], o0, false); o0 = __builtin_amdgcn_cvt_pk_fp8_f32(o[2], o[3], o0, true); o1 = __builtin_amdgcn_cvt_pk_fp8_f32(o[4], o[5], o1, false); o1 = __builtin_amdgcn_cvt_pk_fp8_f32(o[6], o[7], o1, true);
            *(GAS unsigned long long*)(ET + (size_t)row * 2048 + n0) = (unsigned long long)(unsigned)e0 | ((unsigned long long)(unsigned)e1 << 32);
            *(GAS unsigned long long*)(OT + (size_t)row * 2048 + n0) = (unsigned long long)(unsigned)o0 | ((unsigned long long)(unsigned)o1 << 32); }
        LDS_WAIT(); asm volatile("" ::: "memory");
    }
}
__device__ __forceinline__ void ph_route(Frame& F, const Args& args, const float* mod) {
    const int lane = F.lane, wv = F.wave, r32 = lane & 31, hi = lane >> 5;
    LAS float* rs = (LAS float*)F.lds;
    LAS float* part = (LAS float*)(F.lds + 1024);
    LAS int* lcnt = (LAS int*)(F.lds + 1024 + 65536);
    LAS int* lbase = lcnt + 64;
    LAS int* lent = lcnt + 128;
    const bf16_t* X2 = (const bf16_t*)(F.ws + WS_X2); const float* nw = args.in[13]; const float* rb = args.in[15];
    const bf16_t* RWT = (const bf16_t*)(F.ws + WS_RWT);
    bf16_t* H2 = (bf16_t*)(F.ws + WS_H2); int* EIDX = (int*)(F.ws + WS_EIDX); float* EW = (float*)(F.ws + WS_EW); int* EPOS = (int*)(F.ws + WS_EPOS); int* CNT = (int*)(F.ws + CTL_CNT); int* TOKE = (int*)(F.ws + WS_TOKE);
    if (F.tid < NE) lcnt[F.tid] = 0;
    __syncthreads();
    int nb = 0;
    for (int blk = F.vcu; blk < NTOK / 32; blk += F.G, ++nb) {
        const int row0 = blk * 32; const float* mr = mod + (row0 / SEQ) * MODC;
#pragma unroll
        for (int i = 0; i < 4; ++i) { const bf16_t* src = X2 + (size_t)(row0 + wv * 4 + i) * DM; float ss = 0.f;
#pragma unroll
            for (int j = 0; j < 4; ++j) { float v[8]; unpack8(*(const GAS u32x4*)(src + (j * 64 + lane) * 8), v);
#pragma unroll
                for (int c = 0; c < 8; ++c) ss += v[c] * v[c]; }
            ss = wave_sum(ss);
            if (lane == 0) rs[wv * 4 + i] = 1.0f / sqrtf(ss * (1.0f / DM) + 1e-6f); }
        __syncthreads();
        { const float rstd = rs[r32]; const bf16_t* xr = X2 + (size_t)(row0 + r32) * DM; unsigned char* hr = (unsigned char*)H2 + (size_t)(row0 + r32) * DM;
          f32x16 acc0 = {}, acc1 = {};
#pragma unroll 4
          for (int ks = 0; ks < 16; ++ks) { const int k = wv * 256 + ks * 16 + hi * 8;
              float h[8], xf[8]; unpack8(*(const GAS u32x4*)(xr + k), xf);
#pragma unroll
              for (int q = 0; q < 2; ++q) { const f32x4 x = {xf[4 * q], xf[4 * q + 1], xf[4 * q + 2], xf[4 * q + 3]}, w = *(const GAS f32x4*)(nw + k + 4 * q), sc = *(const GAS f32x4*)(mr + 4 * DM + k + 4 * q), sh = *(const GAS f32x4*)(mr + 3 * DM + k + 4 * q);
                  const f32x4 t = x * rstd * w * (sc + 1.0f) + sh; h[4 * q] = t[0]; h[4 * q + 1] = t[1]; h[4 * q + 2] = t[2]; h[4 * q + 3] = t[3]; }
              u32x4 wh, wl; float l[8];
              wh.x = cvt_pk_bf16(h[0], h[1]); wh.y = cvt_pk_bf16(h[2], h[3]); wh.z = cvt_pk_bf16(h[4], h[5]); wh.w = cvt_pk_bf16(h[6], h[7]);
#pragma unroll
              for (int i = 0; i < 4; ++i) { l[2 * i] = h[2 * i] - __uint_as_float(wh[i] << 16); l[2 * i + 1] = h[2 * i + 1] - __uint_as_float(wh[i] & 0xffff0000u); }
              wl.x = cvt_pk_bf16(l[0], l[1]); wl.y = cvt_pk_bf16(l[2], l[3]); wl.z = cvt_pk_bf16(l[4], l[5]); wl.w = cvt_pk_bf16(l[6], l[7]);
              { float hc[8];
#pragma unroll
                for (int i = 0; i < 8; ++i) hc[i] = fminf(fmaxf(h[i], -448.f), 448.f);
                int w0 = 0, w1 = 0; w0 = __builtin_amdgcn_cvt_pk_fp8_f32(hc[0], hc[1], w0, false); w0 = __builtin_amdgcn_cvt_pk_fp8_f32(hc[2], hc[3], w0, true);
                w1 = __builtin_amdgcn_cvt_pk_fp8_f32(hc[4], hc[5], w1, false); w1 = __builtin_amdgcn_cvt_pk_fp8_f32(hc[6], hc[7], w1, true);
                *(GAS unsigned long long*)(hr + k) = (unsigned long long)(unsigned)w0 | ((unsigned long long)(unsigned)w1 << 32); }
              const bf16x8 ah = __builtin_bit_cast(bf16x8, wh), al = __builtin_bit_cast(bf16x8, wl);
              const bf16x8 bh0 = *(const GAS bf16x8*)(RWT + (size_t)r32 * DM + k), bh1 = *(const GAS bf16x8*)(RWT + (size_t)(32 + r32) * DM + k);
              const bf16x8 bl0 = *(const GAS bf16x8*)(RWT + (size_t)(NE + r32) * DM + k), bl1 = *(const GAS bf16x8*)(RWT + (size_t)(NE + 32 + r32) * DM + k);
              acc0 = __builtin_amdgcn_mfma_f32_32x32x16_bf16(ah, bh0, acc0, 0, 0, 0); acc0 = __builtin_amdgcn_mfma_f32_32x32x16_bf16(ah, bl0, acc0, 0, 0, 0); acc0 = __builtin_amdgcn_mfma_f32_32x32x16_bf16(al, bh0, acc0, 0, 0, 0);
              acc1 = __builtin_amdgcn_mfma_f32_32x32x16_bf16(ah, bh1, acc1, 0, 0, 0); acc1 = __builtin_amdgcn_mfma_f32_32x32x16_bf16(ah, bl1, acc1, 0, 0, 0); acc1 = __builtin_amdgcn_mfma_f32_32x32x16_bf16(al, bh1, acc1, 0, 0, 0); }
#pragma unroll
          for (int r = 0; r < 16; ++r) { part[(wv * 32 + crow(r, hi)) * 64 + r32] = acc0[r]; part[(wv * 32 + crow(r, hi)) * 64 + 32 + r32] = acc1[r]; } }
        __syncthreads();
        for (int i = 0; i < 4; ++i) { const int rbk = wv * 4 + i, row = row0 + rbk; float logit = 0.f;
#pragma unroll
          for (int w = 0; w < 8; ++w) logit += part[(w * 32 + rbk) * 64 + lane];
          const float score = 1.0f / (1.0f + expf(-logit)), bsd = score + rb[lane];
          const int g = lane >> 3;
          int rk = 0;
#pragma unroll
          for (int q = 0; q < 8; ++q) { const int o = (lane & ~7) + q; const float vv = __shfl(bsd, o); rk += (vv > bsd) || (vv == bsd && o < lane); }
          float gs = rk < 2 ? bsd : 0.f;
          gs += __shfl_xor(gs, 1); gs += __shfl_xor(gs, 2); gs += __shfl_xor(gs, 4);
          int grk = 0;
#pragma unroll
          for (int gg = 0; gg < 8; ++gg) { const float vv = __shfl(gs, gg * 8); grk += (vv > gs) || (vv == gs && gg < g); }
          const bool gsel = grk < 4;
          const float mb = gsel ? bsd : -INFINITY;
          int erk = 0;
          for (int o = 0; o < 64; ++o) { const float vv = __shfl(mb, o); erk += (vv > mb) || (vv == mb && o < lane); }
          const bool sel = gsel && erk < TOPK;
          const float ssum = wave_sum(sel ? score : 0.f);
          if (sel) { const int lp = __hip_atomic_fetch_add(lcnt + lane, 1, __ATOMIC_RELAXED, __HIP_MEMORY_SCOPE_WORKGROUP);
                     EIDX[row * TOPK + erk] = lane; EW[row * TOPK + erk] = score / ssum * 2.5f; lent[(nb * 32 + rbk) * TOPK + erk] = (lane << 16) | lp; } }
        __syncthreads();
    }
    if (F.tid < NE) { const int c = lcnt[F.tid]; lbase[F.tid] = c ? atomicAdd(&CNT[F.tid * 64], c) : 0; }
    __syncthreads();
    int it0 = F.tid; asm volatile("" : "+v"(it0));
    for (int i = it0; i < nb * 256; i += NTHREADS) { const int blk = F.vcu + (i >> 8) * F.G, row = blk * 32 + ((i >> 3) & 31), v = lent[i]; const int pos = lbase[v >> 16] + (v & 0xffff); EPOS[row * TOPK + (i & 7)] = pos; TOKE[(v >> 16) * NTOK + pos] = row; }
    __syncthreads();
}
__device__ __forceinline__ void y16(const unsigned char* p, float (&f)[16]) {
    const u32x4 w = __builtin_nontemporal_load((const GAS u32x4*)p);
#pragma unroll
    for (int i = 0; i < 4; ++i) { const auto lo = __builtin_amdgcn_cvt_pk_f32_fp8((int)w[i], false), hi = __builtin_amdgcn_cvt_pk_f32_fp8((int)w[i], true); f[4 * i] = lo[0]; f[4 * i + 1] = lo[1]; f[4 * i + 2] = hi[0]; f[4 * i + 3] = hi[1]; }
}
__device__ __forceinline__ void ph_comb(Frame& F, const Args& args, const float* mod) {
    const int gw = F.vcu * NWAVES + F.wave, NGW = F.G * NWAVES, lane = F.lane;
    moe_tables(F, 4);
    LAS int* T = (LAS int*)(F.lds + SCHT_OFF);
    const float* EW = (const float*)(F.ws + WS_EW); const int* EIDX = (const int*)(F.ws + WS_EIDX); const int* EPOS = (const int*)(F.ws + WS_EPOS); const unsigned char* Y = (const unsigned char*)(F.ws + WS_YBIG);
    for (int t = gw; t < NTOK; t += NGW) {
        const float* g2 = mod + (t / SEQ) * MODC + 5 * DM;
        int sl[TOPK]; float wk[TOPK];
#pragma unroll
        for (int k = 0; k < TOPK; ++k) { sl[k] = T[80 + EIDX[t * TOPK + k]] + EPOS[t * TOPK + k]; wk[k] = EW[t * TOPK + k]; }
#pragma unroll
        for (int j = 0; j < 2; ++j) { const int col = j * 1024 + lane * 16;
            float a[16]; y16(Y + (size_t)(NSLOT + t) * DM + col, a);
#pragma unroll
            for (int k = 0; k < TOPK; ++k) { float y[16]; y16(Y + (size_t)sl[k] * DM + col, y);
#pragma unroll
                for (int c = 0; c < 16; ++c) a[c] += wk[k] * y[c]; }
            float* o = args.out + (size_t)t * DM + col; const bf16_t* xi = (const bf16_t*)(F.ws + WS_X2) + (size_t)t * DM + col;
            float xf[16]; { float t8[8]; unpack8(__builtin_nontemporal_load((const GAS u32x4*)xi), t8);
#pragma unroll
                for (int c = 0; c < 8; ++c) xf[c] = t8[c];
                unpack8(__builtin_nontemporal_load((const GAS u32x4*)(xi + 8)), t8);
#pragma unroll
                for (int c = 0; c < 8; ++c) xf[8 + c] = t8[c]; }
#pragma unroll
            for (int n = 0; n < 4; ++n) { const f32x4 xv = {xf[4 * n], xf[4 * n + 1], xf[4 * n + 2], xf[4 * n + 3]}, gv = *(const GAS f32x4*)(g2 + col + 4 * n);
                *(GAS f32x4*)(o + 4 * n) = xv + gv * (f32x4){a[4 * n], a[4 * n + 1], a[4 * n + 2], a[4 * n + 3]}; } }
    }
}

enum { PH_PRO = 0, PH_NORM1, PH_INPROJ, PH_QKNORM, PH_ATTN, PH_F2, PH_MERGE, PH_OUT, PH_ROUTE, PH_EXP1, PH_EXP2, PH_COMB, PH_END };


__global__ void __launch_bounds__(NTHREADS, 2) fwd(Args args) {
    extern __shared__ __attribute__((aligned(16))) unsigned char lds_raw[];
    Frame F;
    F.lds = (LAS unsigned char*)lds_raw; F.MISC = (volatile LAS unsigned*)(F.lds + MISC_OFF); F.ws = args.ws;
    F.tid = threadIdx.x; F.lane = F.tid & 63; F.wave = __builtin_amdgcn_readfirstlane(F.tid >> 6);
    F.G = gridDim.x; { const int bx = blockIdx.x; F.vcu = (F.G % 8 == 0) ? (bx % 8) * (F.G / 8) + bx / 8 : bx; }
    for (int u = F.tid; u < (LDS_BYTES - LDSCTL_OFF) / 4; u += NTHREADS) ((LAS unsigned*)(F.lds + LDSCTL_OFF))[u] = 0u;
    __syncthreads();
    const int lo = args.ph_lo, hi = args.ph_hi;
    const bool multi = (hi - lo) > 1;
    unsigned* barw = (unsigned*)(args.ws + CTL_BAR) + args.bar_idx * XCD_BAR_WORDS;
    XcdBarrier bar; bar.bar = barw; bar.x = 0; bar.st = nullptr;
    if (multi) bar = xcd_barrier_post(barw, F.MISC + 8);
#define IN(k) (lo <= (k) && (k) < hi)
#define SEAM(k) do { if (IN((k) + 1)) xcd_barrier(bar); } while (0)

    const float* modp = (const float*)(args.ws + args.mod_off);
    if (IN(PH_PRO)) { p0_prologue(F, args); SEAM(PH_PRO); }
    if (IN(PH_NORM1)) { ph_norm1(F, args, modp); SEAM(PH_NORM1); }
    if (IN(PH_INPROJ)) {
        { SchedIn S{F.G, (int)blockIdx.x, args.ws, args.use_ut};
          EpiIn E{EpiStore{(const float*)(args.ws + WS_W2048)}, (LAS float*)(F.lds + GPARK_OFF), args.in[8], args.in[9], (const float*)(args.ws + WS_ROPE)};
          gemm_phase<EpiIn, SchedIn, false, true, true>(F.lds, DM, DM / 2, DM / 2, S, E); }
        { SchedGate S{F.G, (int)blockIdx.x, args.ws};
          gemm_phase<EpiStore, SchedGate, false, true>(F.lds, DM, DM / 2, DM / 2, S, EpiStore{(const float*)(args.ws + WS_W2048)}); }
        SEAM(PH_INPROJ);
    }
    if (IN(PH_QKNORM)) { ph_evenodd(F, args); SEAM(PH_QKNORM); }
    if (IN(PH_ATTN)) {
        const int cs = F.vcu & 3;
        constexpr int NCONV = IT_EG + IT_EU + IT_ED;
        int qfirst, qcnt; { const int c = (int)blockIdx.x; if (F.G == 256) { qfirst = c < 144 ? c * 178 : 144 * 178 + (c - 144) * 210; qcnt = c < 144 ? 178 : 210; }
                             else { const int per = (NCONV + F.G - 1) / F.G; qfirst = c * per; qcnt = qfirst + per <= NCONV ? per : (NCONV - qfirst > 0 ? NCONV - qfirst : 0); } }
        const int gcnt = qfirst < IT_EG + IT_EU ? (qfirst + qcnt <= IT_EG + IT_EU ? qcnt : IT_EG + IT_EU - qfirst) : 0, gfirst = qfirst;
        const int ccnt = qcnt - gcnt, cfirst = qfirst + gcnt - (IT_EG + IT_EU);
#define CONV_ALL() do { conv_items(F, args, false, gfirst, gcnt); conv_items(F, args, true, cfirst, ccnt); } while (0)
        const bf16_t* Qp = (const bf16_t*)(args.ws + WS_Q); const bf16_t* Kp = (const bf16_t*)(args.ws + WS_KALL); const bf16_t* Vp = (const bf16_t*)(args.ws + WS_VALL); bf16_t* Op = (bf16_t*)(args.ws + WS_YA);
#define ATTN_UNIT(lin_) do { const int lin = (lin_); if (lin < 512) { const int x = (lin >> 5) & 7, j = (lin & 31) + 32 * (lin >> 8), b = x >> 2, kvh = x & 3, head = kvh * 4 + (j >> 4), qb = j & 15; \
            const size_t qo = ((size_t)(b * SEQ + qb * 256)) * DM + head * HD, ko = (size_t)b * SKV * KVW + kvh * HD; \
            attn::attn_dense_body(Qp + qo, Kp + ko, Vp + ko, (bf16_t*)((unsigned char*)Op + qo), SKV, (char*)lds_raw); __syncthreads(); } } while (0)
        if (cs == 0) { CONV_ALL(); __syncthreads(); }
        ATTN_UNIT(F.vcu);
        if (cs == 1) { CONV_ALL(); __syncthreads(); }
        ATTN_UNIT(F.vcu + F.G);
        for (int lin2 = F.vcu + 2 * F.G; lin2 < 512; lin2 += F.G) ATTN_UNIT(lin2);
        if (cs == 2) { CONV_ALL(); __syncthreads(); }
#undef ATTN_UNIT
        SchedAG S{F.G, (int)blockIdx.x, args.ws};
        gemm_phase<EpiStore, SchedAG, false, true>(F.lds, DM, DM / 2, DM / 2, S, EpiStore{(const float*)(args.ws + WS_W2048)});
        if (cs == 3) { __syncthreads(); CONV_ALL(); }
#undef CONV_ALL
        SEAM(PH_ATTN);
    }
    if (IN(PH_F2)) {
        SchedF2 S{F.G, (int)blockIdx.x, args.ws};
        gemm_phase<EpiYF8, SchedF2, false>(F.lds, 512, DM, 512, S, EpiYF8{});
        {
            if (F.G == 256) {
                if (blockIdx.x >= 128) { const int w = ((int)blockIdx.x - 128) * NWAVES + F.wave;
#pragma unroll
                    for (int q = 0; q < 2; ++q) { const int o = w + 1024 * q, b = o >> 10, col = o & 1023, k2 = col & 127; const float* al = (const float*)(args.ws + WS_ALT) + b * FW + (col & ~127);
                        float s = al[F.lane] * cospif((float)((F.lane * k2) & 127) * (1.0f / 64.0f)) + al[F.lane + 64] * cospif((float)(((F.lane + 64) * k2) & 127) * (1.0f / 64.0f));
                        s = wave_sum(s);
                        if (F.lane == 0) (args.ws + WS_YF)[((size_t)b * SEQ + SEQ / 2) * YFP + col] = (unsigned char)(__builtin_amdgcn_cvt_pk_fp8_f32(fminf(fmaxf(s * 0.0013810679320049757f, -448.f), 448.f), 0.f, 0, false) & 0xff); } }
            } else {
            const int idx = F.vcu * NTHREADS + F.tid;
            if (idx < 2 * FW) { const int b = idx >> 10, col = idx & 1023, k2 = col & 127; const float* al = (const float*)(args.ws + WS_ALT) + b * FW + (col & ~127); float s = 0.f;
                for (int c = 0; c < 128; ++c) s += al[c] * cospif((float)((c * k2) & 127) * (1.0f / 64.0f));
                (args.ws + WS_YF)[((size_t)b * SEQ + SEQ / 2) * YFP + col] = (unsigned char)(__builtin_amdgcn_cvt_pk_fp8_f32(fminf(fmaxf(s * 0.0013810679320049757f, -448.f), 448.f), 0.f, 0, false) & 0xff); } }
        }
        SEAM(PH_F2);
    }
    if (IN(PH_MERGE)) {
        unsigned char* ws = args.ws;
        SchedMerge S{F.G, (int)blockIdx.x, ws};
        gemm_phase<EpiMerge, SchedMerge, false, true>(F.lds, DM, DM / 2, DM / 2, S, EpiMerge{(const unsigned char*)(ws + WS_SGF), (const unsigned char*)(ws + WS_SGA), (bf16_t*)(ws + WS_YM)});
        SEAM(PH_MERGE);
    }
    if (IN(PH_OUT)) {
        unsigned char* ws = args.ws;
        SchedGrid S{F.G, (int)blockIdx.x, 32, 8, (const char*)(ws + WS_YM), (const char*)(ws + WS_WT_O), nullptr, (size_t)256 * DM, (size_t)256 * DM, DM, 4, 1, DM / 128};
        gemm_phase<EpiX2, SchedGrid, false, true>(F.lds, DM, DM / 2, DM / 2, S, EpiX2{args.in[0], modp, (bf16_t*)(ws + WS_X2)});
        SEAM(PH_OUT);
    }
    if (IN(PH_ROUTE)) { ph_route(F, args, modp); SEAM(PH_ROUTE); }
    if (IN(PH_EXP1)) {
        moe_tables(F, 4);
        SchedMoe<4, true> S{F.G, F.vcu, args.ws, (LAS int*)(F.lds + SCHT_OFF), (const int*)(args.ws + WS_TOKE)};
        gemm_phase<EpiAct, SchedMoe<4, true>, true, true>(F.lds, DM, DM / 2, DM / 2, S, EpiAct{});
        SEAM(PH_EXP1);
    }
    if (IN(PH_EXP2)) {
        moe_tables(F, 8);
        SchedMoe<8, false> S{F.G, F.vcu, args.ws, (LAS int*)(F.lds + SCHT_OFF), (const int*)(args.ws + WS_TOKE)};
        gemm_phase<EpiY8, SchedMoe<8, false>, false, true>(F.lds, EFF, EFF / 2, EFF / 2, S, EpiY8{});
        SEAM(PH_EXP2);
    }
    if (IN(PH_COMB)) { ph_comb(F, args, modp); }
#undef IN
#undef SEAM
}
}

extern "C" void kernel_launch(void* const* d_in, const int* in_sizes, int n_in, void* d_out, int out_size, void* d_ws, size_t ws_size, hipStream_t stream) {
    if (n_in != 22 || ws_size < WS_END2) return;
    float* out = (float*)d_out;
    unsigned char* ws = (unsigned char*)d_ws;
    hipMemsetAsync(ws + WS_CTL, 0, CTL_ZERO_BYTES, stream);
    static int grid = 0;
    if (!grid) {
        int dev = 0, cus = 0;
        if (hipGetDevice(&dev) != hipSuccess || hipDeviceGetAttribute(&cus, hipDeviceAttributeMultiprocessorCount, dev) != hipSuccess) { grid = -1; return; }
        if (hipFuncSetAttribute((const void*)mk::fwd, hipFuncAttributeMaxDynamicSharedMemorySize, mk::LDS_BYTES) != hipSuccess) { grid = -1; return; }
        grid = cus;
    }
    if (grid < 0) return;
    mk::Args a{}; int nlaunch = 0;
    for (int i = 0; i < 22; ++i) a.in[i] = (const float*)d_in[i];
    a.out = out; a.ws = ws; a.use_ut = 1; a.mod_off = (int)WS_MOD; a.do_attn = 1;
#define MK_LAUNCH(lo_, hi_) do { a.ph_lo = (lo_); a.ph_hi = (hi_); a.bar_idx = nlaunch++; hipLaunchKernelGGL(mk::fwd, dim3(grid), dim3(mk::NTHREADS), mk::LDS_BYTES, stream, a); } while (0)
    MK_LAUNCH(mk::PH_PRO, mk::PH_END);
}
```
